# Optimizing an MI355X kernel written in HIP

```python
import math
import jax
import jax.numpy as jnp
from jax import lax
import numpy as np

D_MODEL = 1024
BATCH = 8
SEQ = 8192
DEPTH = 2

CHUNK = 64
EPS = 1e-6
D_MIX = D_MODEL
HEAD_DIM = 64

A_WIDTH = 3 * D_MIX // 8
A_HEADS = A_WIDTH // HEAD_DIM
A_BLOCK = 128

B_WIDTH = 3 * D_MIX // 8
B_HEADS = B_WIDTH // HEAD_DIM
CONV_WIDTH = 4
LRU_C = 8.0

C_WIDTH = D_MIX - A_WIDTH - B_WIDTH
C_GROUP_DIM = 16
C_GROUPS = C_WIDTH // C_GROUP_DIM
C_STATE = 64

OFF_A_U = 0
OFF_A_V = OFF_A_U + A_WIDTH
OFF_B_X = OFF_A_V + A_WIDTH
OFF_B_G = OFF_B_X + B_WIDTH
OFF_C_X = OFF_B_G + B_WIDTH
IN_COLS = OFF_C_X + C_WIDTH

N_GROUPS = 4
EXPERTS_PER_GROUP = 4
N_EXPERTS = N_GROUPS * EXPERTS_PER_GROUP
TOP_K = 2
D_EXPERT = D_MODEL // 2
MOE_BLOCK = 256

kernel_name = "hybrid_gmlp_rglru_s5_hmoe"


def rms_norm(x, g):
    xf = x.astype(jnp.float32)
    y = xf * lax.rsqrt(jnp.mean(xf * xf, axis=-1, keepdims=True) + EPS)
    return (y * g.astype(jnp.float32)).astype(x.dtype)


def _linear_combine(left, right):
    a_l, b_l = left
    a_r, b_r = right
    return a_r * a_l, a_r * b_l + b_r


def linear_recurrence(a, b):
    _, h = lax.associative_scan(_linear_combine, (a, b), axis=1)
    return h


def causal_depthwise_conv(x, w, b):
    k_w = w.shape[0]
    seq = x.shape[1]
    xp = jnp.pad(x, ((0, 0), (k_w - 1, 0), (0, 0)))
    y = b + w[k_w - 1] * x
    for k in range(k_w - 1):
        y = y + w[k] * xp[:, k:k + seq]
    return y


def mixer_spatial_gating(u_raw, v_raw, v_norm_g, w_s, b_s):
    bsz, seq, _ = u_raw.shape
    u = jax.nn.gelu(u_raw)
    v = rms_norm(jax.nn.gelu(v_raw), v_norm_g)
    v = v.reshape(bsz, seq // A_BLOCK, A_BLOCK, A_HEADS, HEAD_DIM)
    chunk_id = jnp.arange(A_BLOCK) // CHUNK
    mask = chunk_id[None, :] <= chunk_id[:, None]
    w = jnp.where(mask[None], w_s, 0.0)
    sv = jnp.einsum("hij,bnjhd->bnihd", w, v) + b_s.T[:, :, None]
    return u * sv.reshape(bsz, seq, A_WIDTH)


def mixer_rglru(x_raw, g_raw, conv_w, conv_b, rg_w, rg_b, ig_w, ig_b, lam):
    bsz, seq, width = x_raw.shape
    xc = causal_depthwise_conv(x_raw, conv_w, conv_b)
    xh = xc.reshape(bsz, seq, B_HEADS, HEAD_DIM)
    r = jax.nn.sigmoid(jnp.einsum("bshi,hij->bshj", xh, rg_w).reshape(bsz, seq, width) + rg_b)
    i = jax.nn.sigmoid(jnp.einsum("bshi,hij->bshj", xh, ig_w).reshape(bsz, seq, width) + ig_b)
    log_a = -LRU_C * r.astype(jnp.float32) * jax.nn.softplus(-lam.astype(jnp.float32))
    a = jnp.exp(log_a)
    b = jnp.sqrt(-jnp.expm1(2.0 * log_a)) * (i * xc).astype(jnp.float32)
    h = linear_recurrence(a, b)
    return (h * jax.nn.gelu(g_raw.astype(jnp.float32))).astype(x_raw.dtype)


def mixer_s5(x_raw, a_re, a_im, log_dt, b_re, b_im, c_re, c_im, d, glu_w, glu_b):
    bsz, seq, width = x_raw.shape
    f32 = jnp.float32
    xf = x_raw.astype(f32)
    lam = lax.complex(a_re.astype(f32), a_im.astype(f32))
    dt = jnp.exp(log_dt.astype(f32))[:, None]
    lam_bar = jnp.exp(lam * dt)
    b_bar = ((lam_bar - 1.0) / lam)[:, :, None] * lax.complex(b_re.astype(f32), b_im.astype(f32))
    c_mat = lax.complex(c_re.astype(f32), c_im.astype(f32))
    xg = xf.reshape(bsz, seq, C_GROUPS, C_GROUP_DIM)
    bu = jnp.einsum("gpc,bsgc->bsgp", b_bar, xg.astype(jnp.complex64))
    state = linear_recurrence(jnp.broadcast_to(lam_bar, bu.shape), bu)
    y = jnp.einsum("gcp,bsgp->bsgc", c_mat, state).real.reshape(bsz, seq, width) + d.astype(f32) * xf
    y = jax.nn.gelu(y)
    y = y * jax.nn.sigmoid(y @ glu_w.astype(f32) + glu_b.astype(f32))
    return y.astype(x_raw.dtype)


def hybrid_mixer(h, norm_g, w_in, a_v_norm_g, a_spatial_w, a_spatial_b,
                 b_conv_w, b_conv_b, b_rg_w, b_rg_b, b_ig_w, b_ig_b, b_lambda,
                 c_a_re, c_a_im, c_log_dt, c_b_re, c_b_im, c_c_re, c_c_im, c_d, c_glu_w, c_glu_b,
                 mix_out_norm_g, w_out):
    z = rms_norm(h, norm_g) @ w_in
    y_a = mixer_spatial_gating(z[..., OFF_A_U:OFF_A_V], z[..., OFF_A_V:OFF_B_X],
                               a_v_norm_g, a_spatial_w, a_spatial_b)
    y_b = mixer_rglru(z[..., OFF_B_X:OFF_B_G], z[..., OFF_B_G:OFF_C_X],
                      b_conv_w, b_conv_b, b_rg_w, b_rg_b, b_ig_w, b_ig_b, b_lambda)
    y_c = mixer_s5(z[..., OFF_C_X:IN_COLS], c_a_re, c_a_im, c_log_dt, c_b_re, c_b_im,
                   c_c_re, c_c_im, c_d, c_glu_w, c_glu_b)
    y = jnp.concatenate([
        rms_norm(y_a, mix_out_norm_g[:A_WIDTH]),
        rms_norm(y_b, mix_out_norm_g[A_WIDTH:A_WIDTH + B_WIDTH]),
        rms_norm(y_c, mix_out_norm_g[A_WIDTH + B_WIDTH:]),
    ], axis=-1)
    return y @ w_out


def hierarchical_moe(hn, rg_w, rg_b, re_w, re_b, w_gate, w_up, w_down):
    bsz, seq, dm = hn.shape
    n_tok = bsz * seq
    xt = hn.reshape(n_tok, dm)
    f32 = jnp.float32
    g_logits = (xt @ rg_w).astype(f32) + rg_b.astype(f32)
    g_prob = jax.nn.softmax(g_logits, axis=-1)
    g_sel = jnp.argmax(g_logits, axis=-1).astype(jnp.int32)
    g_w = jnp.take_along_axis(g_prob, g_sel[:, None], axis=-1)[:, 0]
    e_all = jnp.einsum("td,gde->tge", xt, re_w).astype(f32) + re_b.astype(f32)
    e_logits = jnp.take_along_axis(e_all, g_sel[:, None, None], axis=1)[:, 0]
    e_top, e_idx = lax.top_k(e_logits, TOP_K)
    e_w = jax.nn.softmax(e_top, axis=-1)
    expert_id = g_sel[:, None] * EXPERTS_PER_GROUP + e_idx.astype(jnp.int32)
    gate = g_w[:, None] * e_w
    n_assign = n_tok * TOP_K
    flat_e = expert_id.reshape(n_assign)
    flat_tok = jnp.arange(n_assign, dtype=jnp.int32) // TOP_K
    flat_gate = gate.reshape(n_assign)
    order = jnp.argsort(flat_e)
    sorted_e = flat_e[order]
    counts = jnp.bincount(flat_e, length=N_EXPERTS)
    start = jnp.cumsum(counts) - counts
    padded = ((counts + MOE_BLOCK - 1) // MOE_BLOCK) * MOE_BLOCK
    pad_end = jnp.cumsum(padded)
    pad_start = pad_end - padded
    dest = pad_start[sorted_e] + (jnp.arange(n_assign, dtype=jnp.int32) - start[sorted_e])
    n_blocks = -(-n_assign // MOE_BLOCK) + N_EXPERTS
    n_rows = n_blocks * MOE_BLOCK
    row_tok = jnp.zeros((n_rows,), jnp.int32).at[dest].set(flat_tok[order])
    row_gate = jnp.zeros((n_rows,), f32).at[dest].set(flat_gate[order])
    block_e = jnp.minimum(
        jnp.searchsorted(pad_end, jnp.arange(n_blocks, dtype=pad_end.dtype) * MOE_BLOCK, side="right"),
        N_EXPERTS - 1).astype(jnp.int32)
    xs = jnp.take(xt, row_tok, axis=0).reshape(n_blocks, MOE_BLOCK, dm)

    def expert_block(args):
        xb, e = args
        return (jax.nn.silu(xb @ w_gate[e]) * (xb @ w_up[e])) @ w_down[e]

    ys = lax.map(expert_block, (xs, block_e)).reshape(n_rows, dm)
    ys = ys * row_gate[:, None].astype(ys.dtype)
    out = jnp.zeros((n_tok, dm), ys.dtype).at[row_tok].add(ys)
    return out.reshape(bsz, seq, dm)


def setup_inputs(seed: int = 0) -> dict:
    key = jax.random.key(seed)
    ks = iter(jax.random.split(key, 48))
    f32 = jnp.float32
    L = DEPTH

    def nrm(shape, scale):
        return scale * jax.random.normal(next(ks), shape, f32)

    x = jax.random.normal(next(ks), (BATCH, SEQ, D_MODEL), f32)
    norm_mix_g = 1.0 + nrm((L, D_MODEL), 0.02)
    w_in = nrm((L, D_MODEL, IN_COLS), D_MODEL ** -0.5)
    a_v_norm_g = 1.0 + nrm((L, A_WIDTH), 0.02)
    a_spatial_w = nrm((L, A_HEADS, A_BLOCK, A_BLOCK), A_BLOCK ** -0.5)
    a_spatial_b = 1.0 + nrm((L, A_HEADS, A_BLOCK), 0.02)
    b_conv_w = nrm((L, CONV_WIDTH, B_WIDTH), CONV_WIDTH ** -0.5)
    b_conv_b = nrm((L, B_WIDTH), 0.02)
    b_rg_w = nrm((L, B_HEADS, HEAD_DIM, HEAD_DIM), HEAD_DIM ** -0.5)
    b_rg_b = nrm((L, B_WIDTH), 0.02)
    b_ig_w = nrm((L, B_HEADS, HEAD_DIM, HEAD_DIM), HEAD_DIM ** -0.5)
    b_ig_b = nrm((L, B_WIDTH), 0.02)
    a_pow = jax.random.uniform(next(ks), (L, B_WIDTH), f32, 0.9, 0.999)
    a0 = a_pow ** (1.0 / LRU_C)
    b_lambda = jnp.log(a0) - jnp.log1p(-a0)
    n_idx = jnp.arange(C_STATE, dtype=f32)
    c_a_re = -0.5 * jnp.exp(nrm((L, C_GROUPS, C_STATE), 0.05))
    c_a_im = math.pi * n_idx + nrm((L, C_GROUPS, C_STATE), 0.01)
    c_log_dt = jax.random.uniform(next(ks), (L, C_GROUPS), f32, math.log(1e-3), math.log(1e-1))
    c_b_re = nrm((L, C_GROUPS, C_STATE, C_GROUP_DIM), (2 * C_GROUP_DIM) ** -0.5)
    c_b_im = nrm((L, C_GROUPS, C_STATE, C_GROUP_DIM), (2 * C_GROUP_DIM) ** -0.5)
    c_c_re = nrm((L, C_GROUPS, C_GROUP_DIM, C_STATE), 0.5)
    c_c_im = nrm((L, C_GROUPS, C_GROUP_DIM, C_STATE), 0.5)
    c_d = nrm((L, C_WIDTH), 1.0)
    c_glu_w = nrm((L, C_WIDTH, C_WIDTH), C_WIDTH ** -0.5)
    c_glu_b = nrm((L, C_WIDTH), 0.02)
    mix_out_norm_g = 1.0 + nrm((L, D_MIX), 0.02)
    w_out = nrm((L, D_MIX, D_MODEL), D_MIX ** -0.5)
    norm_ffn_g = 1.0 + nrm((L, D_MODEL), 0.02)
    router_group_w = nrm((L, D_MODEL, N_GROUPS), D_MODEL ** -0.5)
    router_group_b = nrm((L, N_GROUPS), 0.01)
    router_expert_w = nrm((L, N_GROUPS, D_MODEL, EXPERTS_PER_GROUP), D_MODEL ** -0.5)
    router_expert_b = nrm((L, N_GROUPS, EXPERTS_PER_GROUP), 0.01)
    expert_w_gate = nrm((L, N_EXPERTS, D_MODEL, D_EXPERT), D_MODEL ** -0.5)
    expert_w_up = nrm((L, N_EXPERTS, D_MODEL, D_EXPERT), D_MODEL ** -0.5)
    expert_w_down = nrm((L, N_EXPERTS, D_EXPERT, D_MODEL), D_EXPERT ** -0.5)
    final_norm_g = 1.0 + nrm((D_MODEL,), 0.02)
    return {
        "x": x, "norm_mix_g": norm_mix_g, "w_in": w_in,
        "a_v_norm_g": a_v_norm_g, "a_spatial_w": a_spatial_w, "a_spatial_b": a_spatial_b,
        "b_conv_w": b_conv_w, "b_conv_b": b_conv_b, "b_rg_w": b_rg_w, "b_rg_b": b_rg_b,
        "b_ig_w": b_ig_w, "b_ig_b": b_ig_b, "b_lambda": b_lambda,
        "c_a_re": c_a_re, "c_a_im": c_a_im, "c_log_dt": c_log_dt, "c_b_re": c_b_re, "c_b_im": c_b_im,
        "c_c_re": c_c_re, "c_c_im": c_c_im, "c_d": c_d, "c_glu_w": c_glu_w, "c_glu_b": c_glu_b,
        "mix_out_norm_g": mix_out_norm_g, "w_out": w_out, "norm_ffn_g": norm_ffn_g,
        "router_group_w": router_group_w, "router_group_b": router_group_b,
        "router_expert_w": router_expert_w, "router_expert_b": router_expert_b,
        "expert_w_gate": expert_w_gate, "expert_w_up": expert_w_up, "expert_w_down": expert_w_down,
        "final_norm_g": final_norm_g,
    }


def reference(x, norm_mix_g, w_in, a_v_norm_g, a_spatial_w, a_spatial_b,
              b_conv_w, b_conv_b, b_rg_w, b_rg_b, b_ig_w, b_ig_b, b_lambda,
              c_a_re, c_a_im, c_log_dt, c_b_re, c_b_im, c_c_re, c_c_im, c_d, c_glu_w, c_glu_b,
              mix_out_norm_g, w_out, norm_ffn_g,
              router_group_w, router_group_b, router_expert_w, router_expert_b,
              expert_w_gate, expert_w_up, expert_w_down, final_norm_g):
    h = x
    for l in range(DEPTH):
        mix = hybrid_mixer(h, norm_mix_g[l], w_in[l], a_v_norm_g[l], a_spatial_w[l], a_spatial_b[l],
                           b_conv_w[l], b_conv_b[l], b_rg_w[l], b_rg_b[l], b_ig_w[l], b_ig_b[l], b_lambda[l],
                           c_a_re[l], c_a_im[l], c_log_dt[l], c_b_re[l], c_b_im[l], c_c_re[l], c_c_im[l],
                           c_d[l], c_glu_w[l], c_glu_b[l], mix_out_norm_g[l], w_out[l])
        h = h + mix.astype(h.dtype)
        ffn = hierarchical_moe(rms_norm(h, norm_ffn_g[l]), router_group_w[l], router_group_b[l],
                               router_expert_w[l], router_expert_b[l],
                               expert_w_gate[l], expert_w_up[l], expert_w_down[l])
        h = h + ffn.astype(h.dtype)
    return rms_norm(h, final_norm_g).astype(x.dtype)
```

```cpp
#include <hip/hip_runtime.h>
#include <cstdio>
#include <cstdint>

namespace nv {
constexpr int D = 1024, BATCH = 8, SEQ = 8192, T = BATCH * SEQ, DEPTH = 2;
constexpr int AW = 384, BW = 384, CW = 256, HD = 64, ABLK = 128, CHUNK = 64;
constexpr int OFF_AU = 0, OFF_AV = 384, OFF_BX = 768, OFF_BG = 1152, OFF_CX = 1536, INC = 1792;
constexpr int CG = 16, CGD = 16, CS = 64;
constexpr int NE = 16, DE = 512;
constexpr float EPS = 1e-6f;

__device__ __forceinline__ float gelu_f(float x) { const float u = 0.7978845608028654f * (x + 0.044715f * x * x * x); return 0.5f * x * (1.0f + tanhf(u)); }
__device__ __forceinline__ float sigmoid_f(float x) { return 1.0f / (1.0f + expf(-x)); }
__device__ __forceinline__ float wave_sum(float v) {
#pragma unroll
    for (int o = 32; o >= 1; o >>= 1) v += __shfl_xor(v, o);
    return v;
}

__global__ void k_rmsnorm(const float* in, int ld_in, float* out, int ld_out, const float* g, int ncols, int nrows) {
    const int wave = (blockIdx.x * blockDim.x + threadIdx.x) >> 6, lane = threadIdx.x & 63;
    if (wave >= nrows) return;
    const float* r = in + (size_t)wave * ld_in; float s = 0.f;
    for (int c = lane; c < ncols; c += 64) { const float v = r[c]; s += v * v; }
    s = wave_sum(s);
    const float rs = rsqrtf(s / (float)ncols + EPS);
    float* o = out + (size_t)wave * ld_out;
    for (int c = lane; c < ncols; c += 64) o[c] = r[c] * rs * g[c];
}

struct GemmArgs {
    const float* A; const int* rowmap; const float* B; float* C;
    int lda, ldb, ldc, M, N, K;
};
template <class Epi>
__global__ void __launch_bounds__(256) k_gemm(GemmArgs g) {
    const Epi epi{};
    __shared__ float As[16][68];
    __shared__ float Bs[16][68];
    const int tid = threadIdx.x, tx = tid & 15, ty = tid >> 4;
    const int m0 = blockIdx.y * 64, n0 = blockIdx.x * 64;
    if (m0 >= g.M) return;
    float acc[4][4];
#pragma unroll
    for (int i = 0; i < 4; ++i)
#pragma unroll
        for (int j = 0; j < 4; ++j) acc[i][j] = 0.f;
    const int ar = tid >> 2, ak = (tid & 3) * 4;
    const float* arow = nullptr;
    { const int m = m0 + ar; if (m < g.M) { if (g.rowmap) { const int rr = g.rowmap[m]; if (rr >= 0) arow = g.A + (size_t)rr * g.lda; } else arow = g.A + (size_t)m * g.lda; } }
    const int bk = tid >> 4, bn = (tid & 15) * 4;
    for (int k0 = 0; k0 < g.K; k0 += 16) {
        float4 av = make_float4(0.f, 0.f, 0.f, 0.f);
        if (arow) av = *(const float4*)(arow + k0 + ak);
        As[ak + 0][ar] = av.x; As[ak + 1][ar] = av.y; As[ak + 2][ar] = av.z; As[ak + 3][ar] = av.w;
        const float4 bv = *(const float4*)(g.B + (size_t)(k0 + bk) * g.ldb + n0 + bn);
        *(float4*)&Bs[bk][bn] = bv;
        __syncthreads();
#pragma unroll
        for (int k = 0; k < 16; ++k) {
            const float4 a4 = *(const float4*)&As[k][ty * 4];
            const float4 b4 = *(const float4*)&Bs[k][tx * 4];
            const float a[4] = {a4.x, a4.y, a4.z, a4.w}, b[4] = {b4.x, b4.y, b4.z, b4.w};
#pragma unroll
            for (int i = 0; i < 4; ++i)
#pragma unroll
                for (int j = 0; j < 4; ++j) acc[i][j] = fmaf(a[i], b[j], acc[i][j]);
        }
        __syncthreads();
    }
#pragma unroll
    for (int i = 0; i < 4; ++i) { const int m = m0 + ty * 4 + i; if (m >= g.M) continue;
#pragma unroll
        for (int j = 0; j < 4; ++j) epi(g, m, n0 + tx * 4 + j, acc[i][j]); }
}
struct EpiStore { __device__ void operator()(const GemmArgs& g, int m, int n, float v) const { g.C[(size_t)m * g.ldc + n] = v; } };
struct EpiAdd { __device__ void operator()(const GemmArgs& g, int m, int n, float v) const { g.C[(size_t)m * g.ldc + n] += v; } };

__global__ void k_mixA_prep(float* z, const float* vg) {
    const int wave = (blockIdx.x * blockDim.x + threadIdx.x) >> 6, lane = threadIdx.x & 63;
    if (wave >= T) return;
    float* r = z + (size_t)wave * INC; float gv[6]; float s = 0.f;
#pragma unroll
    for (int i = 0; i < 6; ++i) { const int c = lane + 64 * i; r[OFF_AU + c] = gelu_f(r[OFF_AU + c]); gv[i] = gelu_f(r[OFF_AV + c]); s += gv[i] * gv[i]; }
    s = wave_sum(s); const float rs = rsqrtf(s / (float)AW + EPS);
#pragma unroll
    for (int i = 0; i < 6; ++i) { const int c = lane + 64 * i; r[OFF_AV + c] = gv[i] * rs * vg[c]; }
}
__global__ void k_mixA(const float* z, const float* ws, const float* bs, float* y) {
    const size_t idx = (size_t)blockIdx.x * blockDim.x + threadIdx.x;
    if (idx >= (size_t)T * AW) return;
    const int t = (int)(idx / AW), c = (int)(idx % AW), h = c / HD, i = t % ABLK, t0 = t - i;
    const int jmax = ((i / CHUNK) + 1) * CHUNK;
    const float* w = ws + ((size_t)h * ABLK + i) * ABLK;
    float s = 0.f;
    for (int j = 0; j < jmax; ++j) s = fmaf(w[j], z[(size_t)(t0 + j) * INC + OFF_AV + c], s);
    s += bs[h * ABLK + i];
    y[(size_t)t * D + c] = z[(size_t)t * INC + OFF_AU + c] * s;
}
__global__ void k_conv(const float* z, const float* cw, const float* cb, float* xc) {
    const size_t idx = (size_t)blockIdx.x * blockDim.x + threadIdx.x;
    if (idx >= (size_t)T * BW) return;
    const int t = (int)(idx / BW), c = (int)(idx % BW), s = t % SEQ;
    float v = cb[c] + cw[3 * BW + c] * z[(size_t)t * INC + OFF_BX + c];
    if (s >= 1) v += cw[2 * BW + c] * z[(size_t)(t - 1) * INC + OFF_BX + c];
    if (s >= 2) v += cw[1 * BW + c] * z[(size_t)(t - 2) * INC + OFF_BX + c];
    if (s >= 3) v += cw[0 * BW + c] * z[(size_t)(t - 3) * INC + OFF_BX + c];
    xc[idx] = v;
}
__global__ void k_gates(const float* xc, const float* rgw, const float* rgb, const float* igw, const float* igb, const float* lam, float* av, float* bv) {
    const size_t idx = (size_t)blockIdx.x * blockDim.x + threadIdx.x;
    if (idx >= (size_t)T * BW) return;
    const int t = (int)(idx / BW), c = (int)(idx % BW), h = c / HD, j = c % HD;
    const float* xr = xc + (size_t)t * BW + h * HD;
    float sr = 0.f, si = 0.f;
    for (int i = 0; i < HD; ++i) { const float x = xr[i]; sr = fmaf(x, rgw[((size_t)h * HD + i) * HD + j], sr); si = fmaf(x, igw[((size_t)h * HD + i) * HD + j], si); }
    const float r = sigmoid_f(sr + rgb[c]), ig = sigmoid_f(si + igb[c]);
    const float l = lam[c]; const float sp = (-l > 20.f) ? -l : log1pf(expf(-l));
    const float log_a = -8.0f * r * sp;
    const float a = expf(log_a);
    const float b = sqrtf(-expm1f(2.0f * log_a)) * (ig * xc[idx]);
    av[idx] = a; bv[idx] = b;
}
__global__ void k_scanB(const float* av, const float* bv, const float* z, float* y) {
    const int idx = blockIdx.x * blockDim.x + threadIdx.x;
    if (idx >= BATCH * BW) return;
    const int b = idx / BW, c = idx % BW;
    float h = 0.f;
    for (int s = 0; s < SEQ; ++s) { const size_t t = (size_t)b * SEQ + s;
        h = fmaf(av[t * BW + c], h, bv[t * BW + c]);
        y[t * D + AW + c] = h * gelu_f(z[t * INC + OFF_BG + c]); }
}
__global__ void __launch_bounds__(64) k_s5(const float* z, const float* a_re, const float* a_im, const float* log_dt, const float* b_re, const float* b_im,
                                           const float* c_re, const float* c_im, const float* dd, float* y) {
    const int b = blockIdx.x / CG, g = blockIdx.x % CG, p = threadIdx.x;
    __shared__ float sre[CS], sim[CS], xs[CGD];
    const float dt = expf(log_dt[g]);
    const float lr = a_re[g * CS + p], li = a_im[g * CS + p];
    const float mag = expf(lr * dt); const float lbr = mag * cosf(li * dt), lbi = mag * sinf(li * dt);
    const float nr = lbr - 1.0f, ni = lbi, den = lr * lr + li * li;
    const float cr = (nr * lr + ni * li) / den, ci = (ni * lr - nr * li) / den;
    float bbr[CGD], bbi[CGD];
#pragma unroll
    for (int c = 0; c < CGD; ++c) { const float br = b_re[((size_t)g * CS + p) * CGD + c], bi = b_im[((size_t)g * CS + p) * CGD + c]; bbr[c] = cr * br - ci * bi; bbi[c] = cr * bi + ci * br; }
    float str = 0.f, sti = 0.f;
    for (int s = 0; s < SEQ; ++s) { const size_t t = (size_t)b * SEQ + s;
        if (p < CGD) xs[p] = z[t * INC + OFF_CX + g * CGD + p];
        __syncthreads();
        float ur = 0.f, ui = 0.f;
#pragma unroll
        for (int c = 0; c < CGD; ++c) { ur = fmaf(bbr[c], xs[c], ur); ui = fmaf(bbi[c], xs[c], ui); }
        const float nr2 = lbr * str - lbi * sti + ur, ni2 = lbr * sti + lbi * str + ui; str = nr2; sti = ni2;
        sre[p] = str; sim[p] = sti;
        __syncthreads();
        if (p < CGD) { float acc = 0.f; const float* cre = c_re + ((size_t)g * CGD + p) * CS; const float* cim = c_im + ((size_t)g * CGD + p) * CS;
            for (int q = 0; q < CS; ++q) acc += cre[q] * sre[q] - cim[q] * sim[q];
            acc += dd[g * CGD + p] * xs[p];
            y[t * D + AW + BW + g * CGD + p] = gelu_f(acc); }
        __syncthreads();
    }
}
__global__ void __launch_bounds__(256) k_glu(float* y, const float* gw, const float* gb) {
    __shared__ float ys[CW];
    const size_t t = blockIdx.x; const int c = threadIdx.x;
    float* r = y + t * D + AW + BW;
    ys[c] = r[c]; __syncthreads();
    float s = gb[c];
    for (int k = 0; k < CW; ++k) s = fmaf(ys[k], gw[(size_t)k * CW + c], s);
    r[c] = ys[c] * sigmoid_f(s);
}
__global__ void k_router(const float* hn, const float* rgw, const float* rgb, const float* rew, const float* reb, int* eid, float* egate) {
    const int wave = (blockIdx.x * blockDim.x + threadIdx.x) >> 6, lane = threadIdx.x & 63;
    if (wave >= T) return;
    const float* r = hn + (size_t)wave * D;
    float gl[4] = {0.f, 0.f, 0.f, 0.f};
    for (int d = lane; d < D; d += 64) { const float x = r[d];
#pragma unroll
        for (int j = 0; j < 4; ++j) gl[j] = fmaf(x, rgw[(size_t)d * 4 + j], gl[j]); }
#pragma unroll
    for (int j = 0; j < 4; ++j) gl[j] = wave_sum(gl[j]) + rgb[j];
    int gs = 0; float gm = gl[0];
#pragma unroll
    for (int j = 1; j < 4; ++j) if (gl[j] > gm) { gm = gl[j]; gs = j; }
    float den = 0.f;
#pragma unroll
    for (int j = 0; j < 4; ++j) den += expf(gl[j] - gm);
    const float gw = 1.0f / den;
    float el[4] = {0.f, 0.f, 0.f, 0.f};
    const float* w = rew + (size_t)gs * D * 4;
    for (int d = lane; d < D; d += 64) { const float x = r[d];
#pragma unroll
        for (int j = 0; j < 4; ++j) el[j] = fmaf(x, w[(size_t)d * 4 + j], el[j]); }
#pragma unroll
    for (int j = 0; j < 4; ++j) el[j] = wave_sum(el[j]) + reb[gs * 4 + j];
    int i0 = 0; float v0 = el[0];
#pragma unroll
    for (int j = 1; j < 4; ++j) if (el[j] > v0) { v0 = el[j]; i0 = j; }
    int i1 = -1; float v1 = -3.0e38f;
#pragma unroll
    for (int j = 0; j < 4; ++j) if (j != i0 && el[j] > v1) { v1 = el[j]; i1 = j; }
    const float e1 = expf(v1 - v0); const float w0 = 1.0f / (1.0f + e1), w1 = e1 / (1.0f + e1);
    if (lane == 0) { eid[wave * 2 + 0] = gs * 4 + i0; eid[wave * 2 + 1] = gs * 4 + i1; egate[wave * 2 + 0] = gw * w0; egate[wave * 2 + 1] = gw * w1; }
}
__global__ void k_zero_int(int* p, int n) { const int i = blockIdx.x * blockDim.x + threadIdx.x; if (i < n) p[i] = 0; }
__global__ void k_build_lists(const int* eid, int* cnt, int* list) {
    const int i = blockIdx.x * blockDim.x + threadIdx.x; if (i >= 2 * T) return;
    const int e = eid[i]; const int pos = atomicAdd(&cnt[e], 1); list[(size_t)e * 2 * T + pos] = i;
}
__global__ void __launch_bounds__(256) k_moe_up(const float* hn, const int* cnt, const int* list, const float* wg, const float* wu, float* act) {
    const int e = blockIdx.z; const int M = cnt[e];
    const int m0 = blockIdx.y * 64, n0 = blockIdx.x * 64;
    if (m0 >= M) return;
    __shared__ float As[16][68]; __shared__ float Bg[16][68]; __shared__ float Bu[16][68];
    const int tid = threadIdx.x, tx = tid & 15, ty = tid >> 4;
    float ag[4][4], au[4][4];
#pragma unroll
    for (int i = 0; i < 4; ++i)
#pragma unroll
        for (int j = 0; j < 4; ++j) { ag[i][j] = 0.f; au[i][j] = 0.f; }
    const int ar = tid >> 2, ak = (tid & 3) * 4;
    const int* lst = list + (size_t)e * 2 * T;
    const float* arow = (m0 + ar < M) ? hn + (size_t)(lst[m0 + ar] >> 1) * D : nullptr;
    const int bk = tid >> 4, bn = (tid & 15) * 4;
    const float* Wg = wg + (size_t)e * D * DE; const float* Wu = wu + (size_t)e * D * DE;
    for (int k0 = 0; k0 < D; k0 += 16) {
        float4 av = make_float4(0.f, 0.f, 0.f, 0.f); if (arow) av = *(const float4*)(arow + k0 + ak);
        As[ak + 0][ar] = av.x; As[ak + 1][ar] = av.y; As[ak + 2][ar] = av.z; As[ak + 3][ar] = av.w;
        *(float4*)&Bg[bk][bn] = *(const float4*)(Wg + (size_t)(k0 + bk) * DE + n0 + bn);
        *(float4*)&Bu[bk][bn] = *(const float4*)(Wu + (size_t)(k0 + bk) * DE + n0 + bn);
        __syncthreads();
#pragma unroll
        for (int k = 0; k < 16; ++k) {
            const float4 a4 = *(const float4*)&As[k][ty * 4]; const float4 g4 = *(const float4*)&Bg[k][tx * 4]; const float4 u4 = *(const float4*)&Bu[k][tx * 4];
            const float a[4] = {a4.x, a4.y, a4.z, a4.w}, gg[4] = {g4.x, g4.y, g4.z, g4.w}, uu[4] = {u4.x, u4.y, u4.z, u4.w};
#pragma unroll
            for (int i = 0; i < 4; ++i)
#pragma unroll
                for (int j = 0; j < 4; ++j) { ag[i][j] = fmaf(a[i], gg[j], ag[i][j]); au[i][j] = fmaf(a[i], uu[j], au[i][j]); }
        }
        __syncthreads();
    }
#pragma unroll
    for (int i = 0; i < 4; ++i) { const int m = m0 + ty * 4 + i; if (m >= M) continue; const int ai = lst[m];
#pragma unroll
        for (int j = 0; j < 4; ++j) { const float gv = ag[i][j]; act[(size_t)ai * DE + n0 + tx * 4 + j] = (gv * sigmoid_f(gv)) * au[i][j]; } }
}
__global__ void __launch_bounds__(256) k_moe_down(const float* act, const int* cnt, const int* list, const float* egate, const float* wd, float* h) {
    const int e = blockIdx.z; const int M = cnt[e];
    const int m0 = blockIdx.y * 64, n0 = blockIdx.x * 64;
    if (m0 >= M) return;
    __shared__ float As[16][68]; __shared__ float Bs[16][68];
    const int tid = threadIdx.x, tx = tid & 15, ty = tid >> 4;
    float acc[4][4];
#pragma unroll
    for (int i = 0; i < 4; ++i)
#pragma unroll
        for (int j = 0; j < 4; ++j) acc[i][j] = 0.f;
    const int ar = tid >> 2, ak = (tid & 3) * 4;
    const int* lst = list + (size_t)e * 2 * T;
    const float* arow = (m0 + ar < M) ? act + (size_t)lst[m0 + ar] * DE : nullptr;
    const int bk = tid >> 4, bn = (tid & 15) * 4;
    const float* Wd = wd + (size_t)e * DE * D;
    for (int k0 = 0; k0 < DE; k0 += 16) {
        float4 av = make_float4(0.f, 0.f, 0.f, 0.f); if (arow) av = *(const float4*)(arow + k0 + ak);
        As[ak + 0][ar] = av.x; As[ak + 1][ar] = av.y; As[ak + 2][ar] = av.z; As[ak + 3][ar] = av.w;
        *(float4*)&Bs[bk][bn] = *(const float4*)(Wd + (size_t)(k0 + bk) * D + n0 + bn);
        __syncthreads();
#pragma unroll
        for (int k = 0; k < 16; ++k) {
            const float4 a4 = *(const float4*)&As[k][ty * 4]; const float4 b4 = *(const float4*)&Bs[k][tx * 4];
            const float a[4] = {a4.x, a4.y, a4.z, a4.w}, b[4] = {b4.x, b4.y, b4.z, b4.w};
#pragma unroll
            for (int i = 0; i < 4; ++i)
#pragma unroll
                for (int j = 0; j < 4; ++j) acc[i][j] = fmaf(a[i], b[j], acc[i][j]);
        }
        __syncthreads();
    }
#pragma unroll
    for (int i = 0; i < 4; ++i) { const int m = m0 + ty * 4 + i; if (m >= M) continue; const int ai = lst[m]; const float gt = egate[ai]; const int tok = ai >> 1;
#pragma unroll
        for (int j = 0; j < 4; ++j) atomicAdd(&h[(size_t)tok * D + n0 + tx * 4 + j], gt * acc[i][j]); }
}
__global__ void k_copy(const float* a, float* b, size_t n) { for (size_t i = (size_t)blockIdx.x * blockDim.x + threadIdx.x; i < n; i += (size_t)gridDim.x * blockDim.x) b[i] = a[i]; }
}

extern "C" void kernel_launch(void* const* d_in, const int* in_sizes, int n_in, void* d_out, int out_size, void* d_ws, size_t ws_size, hipStream_t stream) {
    using namespace nv;
    (void)in_sizes; (void)n_in; (void)out_size; (void)ws_size;
    const float* const* in = (const float* const*)d_in;
    float* H = (float*)d_out;
    char* ws = (char*)d_ws;
    const size_t MB = 1u << 20;
    float* XN = (float*)(ws);
    float* Z = (float*)(ws + 256 * MB);
    float* XC = (float*)(ws + 704 * MB);
    float* AV = (float*)(ws + 800 * MB);
    float* BV = (float*)(ws + 896 * MB);
    int* EID = (int*)(ws + 992 * MB);
    float* EG = (float*)(ws + 993 * MB);
    int* CNT = (int*)(ws + 994 * MB);
    int* LIST = (int*)(ws + 995 * MB);
    float* Y = XN; float* ACT = Z;

    hipLaunchKernelGGL(k_copy, dim3(4096), dim3(256), 0, stream, in[0], H, (size_t)T * D);
    for (int l = 0; l < DEPTH; ++l) {
        const float* norm_mix_g = in[1] + (size_t)l * D;
        const float* w_in = in[2] + (size_t)l * D * INC;
        const float* a_v_norm_g = in[3] + (size_t)l * AW;
        const float* a_sw = in[4] + (size_t)l * 6 * 128 * 128;
        const float* a_sb = in[5] + (size_t)l * 6 * 128;
        const float* conv_w = in[6] + (size_t)l * 4 * BW;
        const float* conv_b = in[7] + (size_t)l * BW;
        const float* rg_w = in[8] + (size_t)l * 6 * 64 * 64;
        const float* rg_b = in[9] + (size_t)l * BW;
        const float* ig_w = in[10] + (size_t)l * 6 * 64 * 64;
        const float* ig_b = in[11] + (size_t)l * BW;
        const float* lam = in[12] + (size_t)l * BW;
        const float* c_a_re = in[13] + (size_t)l * CG * CS;
        const float* c_a_im = in[14] + (size_t)l * CG * CS;
        const float* c_log_dt = in[15] + (size_t)l * CG;
        const float* c_b_re = in[16] + (size_t)l * CG * CS * CGD;
        const float* c_b_im = in[17] + (size_t)l * CG * CS * CGD;
        const float* c_c_re = in[18] + (size_t)l * CG * CGD * CS;
        const float* c_c_im = in[19] + (size_t)l * CG * CGD * CS;
        const float* c_d = in[20] + (size_t)l * CW;
        const float* glu_w = in[21] + (size_t)l * CW * CW;
        const float* glu_b = in[22] + (size_t)l * CW;
        const float* mo_g = in[23] + (size_t)l * D;
        const float* w_out = in[24] + (size_t)l * D * D;
        const float* ffn_g = in[25] + (size_t)l * D;
        const float* rgw = in[26] + (size_t)l * D * 4;
        const float* rgb = in[27] + (size_t)l * 4;
        const float* rew = in[28] + (size_t)l * 4 * D * 4;
        const float* reb = in[29] + (size_t)l * 16;
        const float* wg = in[30] + (size_t)l * NE * D * DE;
        const float* wu = in[31] + (size_t)l * NE * D * DE;
        const float* wd = in[32] + (size_t)l * NE * DE * D;

        hipLaunchKernelGGL(k_rmsnorm, dim3(T / 4), dim3(256), 0, stream, H, D, XN, D, norm_mix_g, D, T);
        { GemmArgs g{}; g.A = XN; g.rowmap = nullptr; g.B = w_in; g.C = Z; g.lda = D; g.ldb = INC; g.ldc = INC; g.M = T; g.N = INC; g.K = D; hipLaunchKernelGGL((k_gemm<EpiStore>), dim3(INC / 64, T / 64), dim3(256), 0, stream, g); }
        hipLaunchKernelGGL(k_mixA_prep, dim3(T / 4), dim3(256), 0, stream, Z, a_v_norm_g);
        hipLaunchKernelGGL(k_mixA, dim3((unsigned)(((size_t)T * AW + 255) / 256)), dim3(256), 0, stream, Z, a_sw, a_sb, Y);
        hipLaunchKernelGGL(k_conv, dim3((unsigned)(((size_t)T * BW + 255) / 256)), dim3(256), 0, stream, Z, conv_w, conv_b, XC);
        hipLaunchKernelGGL(k_gates, dim3((unsigned)(((size_t)T * BW + 255) / 256)), dim3(256), 0, stream, XC, rg_w, rg_b, ig_w, ig_b, lam, AV, BV);
        hipLaunchKernelGGL(k_scanB, dim3((BATCH * BW + 63) / 64), dim3(64), 0, stream, AV, BV, Z, Y);
        hipLaunchKernelGGL(k_s5, dim3(BATCH * CG), dim3(64), 0, stream, Z, c_a_re, c_a_im, c_log_dt, c_b_re, c_b_im, c_c_re, c_c_im, c_d, Y);
        hipLaunchKernelGGL(k_glu, dim3(T), dim3(256), 0, stream, Y, glu_w, glu_b);
        hipLaunchKernelGGL(k_rmsnorm, dim3(T / 4), dim3(256), 0, stream, Y, D, Y, D, mo_g, AW, T);
        hipLaunchKernelGGL(k_rmsnorm, dim3(T / 4), dim3(256), 0, stream, Y + AW, D, Y + AW, D, mo_g + AW, BW, T);
        hipLaunchKernelGGL(k_rmsnorm, dim3(T / 4), dim3(256), 0, stream, Y + AW + BW, D, Y + AW + BW, D, mo_g + AW + BW, CW, T);
        { GemmArgs g{}; g.A = Y; g.rowmap = nullptr; g.B = w_out; g.C = H; g.lda = D; g.ldb = D; g.ldc = D; g.M = T; g.N = D; g.K = D; hipLaunchKernelGGL((k_gemm<EpiAdd>), dim3(D / 64, T / 64), dim3(256), 0, stream, g); }
        hipLaunchKernelGGL(k_rmsnorm, dim3(T / 4), dim3(256), 0, stream, H, D, XN, D, ffn_g, D, T);
        hipLaunchKernelGGL(k_router, dim3(T / 4), dim3(256), 0, stream, XN, rgw, rgb, rew, reb, EID, EG);
        hipLaunchKernelGGL(k_zero_int, dim3(1), dim3(64), 0, stream, CNT, NE);
        hipLaunchKernelGGL(k_build_lists, dim3(2 * T / 256), dim3(256), 0, stream, EID, CNT, LIST);
        hipLaunchKernelGGL(k_moe_up, dim3(DE / 64, 2 * T / 64 / 2, NE), dim3(256), 0, stream, XN, CNT, LIST, wg, wu, ACT);
        hipLaunchKernelGGL(k_moe_down, dim3(D / 64, 2 * T / 64 / 2, NE), dim3(256), 0, stream, ACT, CNT, LIST, EG, wd, H);
    }
    hipLaunchKernelGGL(k_rmsnorm, dim3(T / 4), dim3(256), 0, stream, H, D, H, D, in[33], D, T);
}
```

```cpp
#include <hip/hip_runtime.h>
#include <cstdio>
#include <cstdint>

#define LAS __attribute__((address_space(3)))
typedef unsigned short bf16_t;
typedef short bf16x8 __attribute__((ext_vector_type(8)));
typedef float f32x4 __attribute__((ext_vector_type(4)));
typedef float f32x2 __attribute__((ext_vector_type(2)));
typedef unsigned u32x4 __attribute__((ext_vector_type(4)));
typedef unsigned u32x2 __attribute__((ext_vector_type(2)));

constexpr int D = 1024, BATCH = 8, SEQ = 8192, T = BATCH * SEQ, DEPTH = 2;
constexpr int AW = 384, BW = 384, CW = 256, HD = 64, ABLK = 128, CHUNK = 64;
constexpr int INC = 1792;
constexpr int ZU = 0, ZV = 384, ZG = 768, ZX = 1152, ZC = 1536, ZGELU_END = 1152;
constexpr int CG = 16, CGD = 16, CS = 64;
constexpr int NE = 16, DE = 512, NCLS = 24;
constexpr float EPS = 1e-6f;
constexpr int UT = 256;
constexpr int NU = T / UT;
constexpr int MAXROWS = T + NCLS * 256;

constexpr size_t MiB = 1u << 20;
constexpr size_t WS_CTL = 0, CTL_ZERO_BYTES = 1 * MiB;
constexpr size_t WS_WIN = 2 * MiB;
constexpr size_t WS_WOUT = 10 * MiB;
constexpr size_t WS_WGU = 16 * MiB;
constexpr size_t WS_WD2 = 80 * MiB;
constexpr size_t WS_SSQ = 176 * MiB;
constexpr size_t WS_RS = 180 * MiB;
constexpr size_t WS_CLS = WS_RS + 256 * 1024;
constexpr size_t WS_G2 = WS_CLS + 256 * 1024;
constexpr size_t WS_HIST = 181 * MiB;
constexpr size_t WS_CTOT = WS_HIST + 64 * 1024;
constexpr size_t WS_ROWTOK = WS_HIST + 256 * 1024;
constexpr size_t WS_ROWG = 182 * MiB;
constexpr size_t WS_SUMA = 183 * MiB;
constexpr size_t WS_SUMH = WS_SUMA + 512 * 1024;
constexpr size_t WS_HB = 192 * MiB;
constexpr size_t WS_Z = 320 * MiB;
constexpr size_t WS_HBS = WS_Z;
constexpr size_t WS_Y = 544 * MiB;
constexpr size_t WS_ACT = 672 * MiB;
constexpr size_t WS_AV = 672 * MiB;
constexpr size_t WS_BV = 768 * MiB;
constexpr size_t WS_END = 864 * MiB;
constexpr int CW_BAR = 4096;

constexpr int RING_BYTES = 131072;
constexpr int LDSCTL_OFF = RING_BYTES;
constexpr int LDS_BYTES = 147456;
constexpr int LW_BAR = 8, LW_TST = 64, LW_HIST = 96, LW_TOT = 128, LW_BASE = 160, LW_CLS = 256  , LW_DEST = 512  , LW_UTAB = 768  , LW_DTAB = 800  ;

__device__ __forceinline__ float bf2f(bf16_t v) { return __uint_as_float(((unsigned)v) << 16); }
__device__ __forceinline__ unsigned cvt_pk_bf16(float lo, float hi) { unsigned r; asm volatile("v_cvt_pk_bf16_f32 %0, %1, %2" : "=v"(r) : "v"(lo), "v"(hi)); return r; }
__device__ __forceinline__ bf16_t f2bf(float v) { return (bf16_t)(cvt_pk_bf16(v, 0.f) & 0xffffu); }
__device__ __forceinline__ float wave_sum(float v) {
#pragma unroll
    for (int o = 32; o >= 1; o >>= 1) v += __shfl_xor(v, o);
    return v;
}
__device__ __forceinline__ float gelu_fast(float x) {
    const float u2 = 1.5957691216057308f * (x + 0.044715f * x * x * x);
    const float e = __builtin_amdgcn_exp2f(-1.4426950408889634f * u2);
    return x * __builtin_amdgcn_rcpf(1.0f + e);
}
__device__ __forceinline__ float sigmoid_fast(float x) { return __builtin_amdgcn_rcpf(1.0f + __builtin_amdgcn_exp2f(-1.4426950408889634f * x)); }
__device__ __forceinline__ float sigmoid_f(float x) { return 1.0f / (1.0f + expf(-x)); }
__device__ __forceinline__ int pair_lo(int pi) { return pi < 3 ? 0 : (pi < 5 ? 1 : 2); }
__device__ __forceinline__ int pair_hi(int pi) { return pi < 3 ? pi + 1 : (pi < 5 ? pi - 1 : 3); }
__device__ __forceinline__ int pair_idx(int lo, int hi) { return lo == 0 ? hi - 1 : (lo == 1 ? hi + 1 : 5); }

#define XB_TMO      128
#define XB_XCNT(j)  (256  + 64 * (j))
#define XB_XSUB(j)  (1280 + 64 * (j))
#define XB_XGEN(j)  (2304 + 64 * (j))
#define XB_TOP      3328
#define XB_TOPGEN   3392
#define XCD_BAR_WORDS 3456
#define XB_SPIN_CAP (1u << 18)
__device__ __forceinline__ unsigned xb_ld(unsigned* p)              { return __hip_atomic_load(p, __ATOMIC_RELAXED, __HIP_MEMORY_SCOPE_AGENT); }
__device__ __forceinline__ unsigned xb_add(unsigned* p, unsigned v) { return __hip_atomic_fetch_add(p, v, __ATOMIC_RELAXED, __HIP_MEMORY_SCOPE_AGENT); }
__device__ __forceinline__ unsigned xb_xcc_id() { return (unsigned)__builtin_amdgcn_s_getreg((3 << 11) | 20) & 0xFu; }
#define XB_SPIN(cond, bar) do { unsigned _sp = 0; while (cond) { __builtin_amdgcn_s_sleep(1); \
    if ((++_sp & 255u) == 0u) { if (xb_ld(&(bar)[XB_TMO])) break; if (_sp > XB_SPIN_CAP) { atomicAdd(&(bar)[XB_TMO], 1u); break; } } } } while (0)
struct XcdBarrier { unsigned* bar; unsigned x; volatile LAS unsigned* st; };
__device__ __forceinline__ XcdBarrier xcd_barrier_post(unsigned* bar, volatile LAS unsigned* st) {
    XcdBarrier b; b.bar = bar; b.x = xb_xcc_id(); b.st = st;
    if (threadIdx.x == 0) (void)xb_add(&bar[XB_XCNT(b.x)], 1u);
    return b;
}
__device__ __forceinline__ void xcd_barrier_complete(unsigned* bar, unsigned x, unsigned& nloc, unsigned& nx) {
    const unsigned G = gridDim.x * gridDim.y * gridDim.z;
    unsigned sum, cnt, mine, sp = 0u;
    for (;;) {
        sum = 0u; cnt = 0u; mine = 0u;
#pragma unroll
        for (unsigned j = 0; j < 16; ++j) { const unsigned c = xb_ld(&bar[XB_XCNT(j)]); sum += c; cnt += (c > 0u) ? 1u : 0u; mine = (j == x) ? c : mine; }
        if (sum == G) break;
        __builtin_amdgcn_s_sleep(1);
        if ((++sp & 255u) == 0u) { if (xb_ld(&bar[XB_TMO])) break; if (sp > XB_SPIN_CAP) { atomicAdd(&bar[XB_TMO], 1u); break; } }
    }
    nloc = mine > 0u ? mine : 1u; nx = cnt > 0u ? cnt : 1u;
}
__device__ __forceinline__ void xcd_barrier(const XcdBarrier& b) {
    asm volatile("s_waitcnt vmcnt(0)" ::: "memory");
    __syncthreads();
    if (threadIdx.x == 0) {
        unsigned* bar = b.bar;
        __builtin_amdgcn_s_waitcnt(0);
        unsigned nloc = b.st[0], nx = b.st[1];
        if (nloc == 0u) { xcd_barrier_complete(bar, b.x, nloc, nx); b.st[0] = nloc; b.st[1] = nx; }
        const unsigned old = xb_add(&bar[XB_XSUB(b.x)], 1u);
        const unsigned gen = old / nloc;
        if (old + 1u == (gen + 1u) * nloc) {
            __builtin_amdgcn_fence(__ATOMIC_RELEASE, "agent");
            asm volatile("s_waitcnt vmcnt(0)" ::: "memory");
            const unsigned og = xb_add(&bar[XB_TOP], 1u);
            const unsigned tg = og / nx;
            if (og + 1u == (tg + 1u) * nx) xb_add(&bar[XB_TOPGEN], 1u);
            else XB_SPIN(xb_ld(&bar[XB_TOPGEN]) == tg, bar);
            __builtin_amdgcn_fence(__ATOMIC_ACQUIRE, "agent");
            xb_add(&bar[XB_XGEN(b.x)], 1u);
            asm volatile("s_waitcnt vmcnt(0)" ::: "memory");
        } else {
            XB_SPIN(xb_ld(&bar[XB_XGEN(b.x)]) == gen, bar);
            __builtin_amdgcn_fence(__ATOMIC_ACQUIRE, "agent");
            asm volatile("s_waitcnt vmcnt(0)" ::: "memory");
        }
    }
    __syncthreads();
}

namespace pg8 {
#define PG8_LAS __attribute__((address_space(3)))
constexpr int BM = 256, BK = 64, HALF = 128, HTB = HALF * BK * 2, STAGE_BYTES = 8 * HTB, NXCD = 8, WGM = 8;
__host__ __device__ __forceinline__ int lds_byte(int r, int c) { const int st = (r >> 4) * 2 + (c >> 5), rr = r & 15, cc = c & 31, ob = rr * 64 + cc * 2; return st * 1024 + (ob ^ (((ob >> 9) & 1) << 5)); }
__host__ __device__ __forceinline__ void stage_rc(int b, int& R, int& C) { const int st = b / 1024, sb = b % 1024, swz = sb ^ (((sb >> 9) & 1) << 5); R = (st >> 1) * 16 + swz / 64; C = (st & 1) * 32 + (swz % 64) / 2; }
__host__ __device__ __forceinline__ int perm32(int rho) { const int n = rho >> 4, i = rho & 15; return 8 * (i >> 2) + 4 * n + (i & 3); }
struct Unit { int pm, pn; const char* A; const char* B; };

template <int M_, int N_> struct StaticOrder {
    static constexpr int nM = M_ / BM, nN = N_ / BM, nwg = nM * nN; static constexpr size_t tstep = (size_t)BM * 1024 * 2;
    int G, c; const char* A; const char* Bt;
    __device__ void init(const void* A_, const void* Bt_, int G_, int c_) { G = G_; c = c_; A = (const char*)A_; Bt = (const char*)Bt_; }
    __device__ bool next(int i, Unit& u) const {
        const long L = (long)i * G + c; if (L >= nwg) return false;
        int wgid = (int)L; { constexpr int q = nwg / NXCD, r = nwg % NXCD; const int xcd = wgid % NXCD, off = wgid / NXCD; wgid = (xcd < r ? xcd * (q + 1) : r * (q + 1) + (xcd - r) * q) + off; }
        constexpr int nig = WGM * nN; const int gid = wgid / nig, fm = gid * WGM, gsz = (nM - fm) < WGM ? (nM - fm) : WGM;
        u.pm = fm + ((wgid % nig) % gsz); u.pn = (wgid % nig) / gsz; u.A = A + (size_t)u.pm * tstep; u.B = Bt + (size_t)u.pn * tstep; return true;
    }
    __device__ __forceinline__ void a_ready(const Unit&) const {}
    __device__ __forceinline__ void done(const Unit&) const {}
};
template <class Epi, class Sched, bool ALIGN_EPI = false, bool SP2 = false>
__device__ __forceinline__ void gemm_phase(PG8_LAS unsigned char* lds, const int Kdim, const Sched& S, const Epi& E) {
    const int tid = threadIdx.x, wid = __builtin_amdgcn_readfirstlane(tid >> 6), lane = tid & 63, wr = wid >> 2, wc = wid & 3, fr = lane & 15, fq = lane >> 4;
    constexpr int K = 1024, nt = K / BK; (void)Kdim;
    unsigned voffA[2], voffB[2];
#pragma unroll
    for (int i = 0; i < 2; ++i) { int R, C; stage_rc(tid * 16 + i * 8192, R, C); const int Rb = Epi::PERM ? ((R & ~31) + perm32(R & 31)) : R;
        voffA[i] = (unsigned)(R * K + C) * 2u; voffB[i] = (unsigned)(Rb * K + C) * 2u; }
    constexpr size_t kstep = (size_t)(BK * 2);
    constexpr size_t hstep = (size_t)HALF * K * 2;
    constexpr size_t tstep = 2 * hstep; (void)tstep;
    const unsigned ldsw = (unsigned)wid * 1024u;
    const int aoff = lds_byte(wr * 64 + fr, fq * 8), boff = lds_byte(wc * 32 + fr, fq * 8);
#define PG8_SA(b, h) (((b) * 2 + (h)) * HTB)
#define PG8_SB(b, h) ((4 + (b) * 2 + (h)) * HTB)
#define PG8_STAGE(bufoff, gbase, voff) do { _Pragma("unroll") for (int _i = 0; _i < 2; ++_i) \
        __builtin_amdgcn_global_load_lds((const unsigned*)((const char*)(gbase) + (voff)[_i]), (PG8_LAS unsigned*)(lds + (bufoff) + ldsw + _i * 8192), 16, 0, 0); } while (0)
#define PG8_LDA(dst, b, h) do { _Pragma("unroll") for (int m = 0; m < 4; ++m) _Pragma("unroll") for (int k = 0; k < 2; ++k) dst[m][k] = *(const PG8_LAS bf16x8*)(lds + PG8_SA(b, h) + aoff + m * 2048 + k * 1024); } while (0)
#define PG8_LDB(dst, b, h) do { _Pragma("unroll") for (int n = 0; n < 2; ++n) _Pragma("unroll") for (int k = 0; k < 2; ++k) dst[n][k] = *(const PG8_LAS bf16x8*)(lds + PG8_SB(b, h) + boff + n * 2048 + k * 1024); } while (0)
#define PG8_MMA(ai, bj, At, Bt) do { __builtin_amdgcn_s_setprio(1); _Pragma("unroll") for (int m = 0; m < 4; ++m) _Pragma("unroll") for (int n = 0; n < 2; ++n) _Pragma("unroll") for (int k = 0; k < 2; ++k) \
        acc[ai][bj][m][n] = __builtin_amdgcn_mfma_f32_16x16x32_bf16(Bt[n][k], At[m][k], acc[ai][bj][m][n], 0, 0, 0); __builtin_amdgcn_s_setprio(0); } while (0)
#define PG8_WAIT_V(n) asm volatile("s_waitcnt vmcnt(" #n ")" ::: "memory")
#define PG8_WAIT_L(n) asm volatile("s_waitcnt lgkmcnt(" #n ")" ::: "memory")
#define PG8_BAR __builtin_amdgcn_s_barrier()
#define PG8_SCHED __builtin_amdgcn_sched_barrier(0)
    Unit cur, nxt; int ui = 0;
    if (!S.next(0, cur)) return;
    f32x4 acc[2][2][4][2];
#pragma unroll
    for (int a = 0; a < 2; ++a)
#pragma unroll
        for (int b = 0; b < 2; ++b)
#pragma unroll
            for (int m = 0; m < 4; ++m)
#pragma unroll
                for (int n = 0; n < 2; ++n) acc[a][b][m][n] = (f32x4){0.f, 0.f, 0.f, 0.f};
    bf16x8 At[4][2], B0[2][2], B1[2][2];
    const char* cA = cur.A; const char* cB = cur.B;
    S.a_ready(cur);
    if constexpr (SP2) {
        PG8_STAGE(PG8_SB(0, 0), cB, voffB); PG8_STAGE(PG8_SB(0, 1), cB + hstep, voffB); PG8_STAGE(PG8_SA(0, 0), cA, voffA); PG8_STAGE(PG8_SA(0, 1), cA + hstep, voffA);
        if (wr == 1) PG8_BAR;
        PG8_WAIT_V(2); PG8_BAR;
        PG8_STAGE(PG8_SB(1, 0), cB + kstep, voffB); PG8_STAGE(PG8_SA(1, 0), cA + kstep, voffA); PG8_STAGE(PG8_SB(1, 1), cB + hstep + kstep, voffB);
        PG8_WAIT_V(6); PG8_BAR;
    } else {
        PG8_STAGE(PG8_SB(0, 0), cB, voffB); PG8_STAGE(PG8_SA(0, 0), cA, voffA); PG8_STAGE(PG8_SB(0, 1), cB + hstep, voffB); PG8_STAGE(PG8_SA(0, 1), cA + hstep, voffA);
        if (wr == 1) PG8_BAR;
        PG8_WAIT_V(4); PG8_BAR;
        PG8_STAGE(PG8_SB(1, 0), cB + kstep, voffB); PG8_STAGE(PG8_SA(1, 0), cA + kstep, voffA); PG8_STAGE(PG8_SB(1, 1), cB + hstep + kstep, voffB);
        PG8_WAIT_V(6); PG8_BAR;
    }
    for (;;) {
        const bool has_next = S.next(ui + 1, nxt);
        const char* nA = has_next ? nxt.A : cA; const char* nB = has_next ? nxt.B : cB;
        for (int t = 0; t < nt; t += 2) {
            const bool last = (t == nt - 2);
            const char* a1 = cA + (size_t)(t + 1) * kstep;
            const char* a2 = last ? nA : cA + (size_t)(t + 2) * kstep; const char* b2 = last ? nB : cB + (size_t)(t + 2) * kstep;
            const char* a3 = a2 + kstep; const char* b3 = b2 + kstep;
            if (last && has_next) S.a_ready(nxt);
            if constexpr (SP2) {
            PG8_LDB(B0, 0, 0); PG8_LDB(B1, 0, 1); PG8_SCHED; PG8_LDA(At, 0, 0); PG8_STAGE(PG8_SA(1, 1), a1 + hstep, voffA);
            PG8_WAIT_V(8); PG8_WAIT_L(0); PG8_BAR; PG8_MMA(0, 0, At, B0); PG8_MMA(0, 1, At, B1); PG8_BAR; PG8_SCHED;
            PG8_LDA(At, 0, 1); PG8_STAGE(PG8_SB(0, 0), b2, voffB); PG8_STAGE(PG8_SB(0, 1), b2 + hstep, voffB); PG8_STAGE(PG8_SA(0, 0), a2, voffA);
            PG8_WAIT_V(8); PG8_WAIT_L(0); PG8_BAR; PG8_MMA(1, 0, At, B0); PG8_MMA(1, 1, At, B1); PG8_BAR; PG8_SCHED;
            PG8_LDB(B0, 1, 0); PG8_LDB(B1, 1, 1); PG8_SCHED; PG8_LDA(At, 1, 0); PG8_STAGE(PG8_SA(0, 1), a2 + hstep, voffA);
            PG8_WAIT_V(8); PG8_WAIT_L(0); PG8_BAR; PG8_MMA(0, 0, At, B0); PG8_MMA(0, 1, At, B1); PG8_BAR; PG8_SCHED;
            PG8_LDA(At, 1, 1); PG8_STAGE(PG8_SB(1, 0), b3, voffB); PG8_STAGE(PG8_SB(1, 1), b3 + hstep, voffB); PG8_STAGE(PG8_SA(1, 0), a3, voffA);
            PG8_WAIT_V(8); PG8_WAIT_L(0); PG8_BAR; PG8_MMA(1, 0, At, B0); PG8_MMA(1, 1, At, B1); PG8_BAR; PG8_SCHED;
            } else {
            PG8_LDB(B0, 0, 0); PG8_SCHED; PG8_LDA(At, 0, 0); PG8_STAGE(PG8_SA(1, 1), a1 + hstep, voffA);
            PG8_WAIT_L(8); PG8_BAR; PG8_WAIT_L(0); PG8_MMA(0, 0, At, B0); PG8_BAR; PG8_SCHED;
            PG8_LDB(B1, 0, 1); PG8_STAGE(PG8_SB(0, 0), b2, voffB);
            PG8_BAR; PG8_WAIT_L(0); PG8_MMA(0, 1, At, B1); PG8_BAR;
            PG8_LDA(At, 0, 1); PG8_STAGE(PG8_SA(0, 0), a2, voffA);
            PG8_BAR; PG8_WAIT_L(0); PG8_MMA(1, 0, At, B0); PG8_BAR; PG8_SCHED;
            PG8_STAGE(PG8_SB(0, 1), b2 + hstep, voffB);
            PG8_WAIT_V(6); PG8_BAR; PG8_MMA(1, 1, At, B1); PG8_BAR;
            PG8_LDB(B0, 1, 0); PG8_SCHED; PG8_LDA(At, 1, 0); PG8_STAGE(PG8_SA(0, 1), a2 + hstep, voffA);
            PG8_WAIT_L(8); PG8_BAR; PG8_WAIT_L(0); PG8_MMA(0, 0, At, B0); PG8_BAR; PG8_SCHED;
            PG8_LDB(B1, 1, 1); PG8_STAGE(PG8_SB(1, 0), b3, voffB);
            PG8_BAR; PG8_WAIT_L(0); PG8_MMA(0, 1, At, B1); PG8_BAR;
            PG8_LDA(At, 1, 1); PG8_STAGE(PG8_SA(1, 0), a3, voffA);
            PG8_BAR; PG8_WAIT_L(0); PG8_MMA(1, 0, At, B0); PG8_BAR; PG8_SCHED;
            PG8_STAGE(PG8_SB(1, 1), b3 + hstep, voffB);
            PG8_WAIT_V(6); PG8_BAR; PG8_MMA(1, 1, At, B1); PG8_BAR;
            }
        }
        if constexpr (ALIGN_EPI) { if (wr == 0) PG8_BAR; }
        if constexpr (!Epi::AFTER_DRAIN) { E(acc, cur, wr, wc, fr, fq); S.done(cur); }
        if (!has_next) break;
#pragma unroll
        for (int a = 0; a < 2; ++a)
#pragma unroll
            for (int b = 0; b < 2; ++b)
#pragma unroll
                for (int m = 0; m < 4; ++m)
#pragma unroll
                    for (int n = 0; n < 2; ++n) acc[a][b][m][n] = (f32x4){0.f, 0.f, 0.f, 0.f};
        cur = nxt; cA = nA; cB = nB; ++ui;
        if constexpr (ALIGN_EPI) { if (wr == 1) PG8_BAR; }
    }
    PG8_WAIT_V(0);
    if constexpr (!ALIGN_EPI) { if (wr == 0) PG8_BAR; }
    PG8_BAR;
    if constexpr (Epi::AFTER_DRAIN) { E.fused(acc, cur, wr, wc, fr, fq, lds, wid, lane); S.done(cur); }
#undef PG8_SA
#undef PG8_SB
#undef PG8_STAGE
#undef PG8_LDA
#undef PG8_LDB
#undef PG8_MMA
#undef PG8_WAIT_V
#undef PG8_WAIT_L
#undef PG8_BAR
#undef PG8_SCHED
}

template <int NP, bool UP> struct MoeOrder {
    const volatile LAS int* tab; int layer; const char* A; const char* W;
    __device__ bool next(int i, Unit& u) const {
        const int e = tab[i]; if (e < 0) return false;
        const int mt = e & 0xffff, pn = (e >> 16) & 0xff, cls = e >> 24;
        u.pm = mt; u.pn = pn; u.A = A + (size_t)mt * ((size_t)BM * 1024 * 2);
        if (UP) { const int g = cls / 6, pi = cls % 6, s = pn >> 2, ex = g * 4 + (s ? pair_hi(pi) : pair_lo(pi));
            u.B = W + ((size_t)(layer * NE + ex) * 1024 + (size_t)(pn & 3) * 256) * 1024 * 2; }
        else u.B = W + ((size_t)(layer * NCLS + cls) * 1024 + (size_t)pn * 256) * 1024 * 2;
        return true;
    }
    __device__ __forceinline__ void a_ready(const Unit&) const {}
    __device__ __forceinline__ void done(const Unit&) const {}
};

struct EpiZ {
    static constexpr bool PERM = true, AFTER_DRAIN = false;
    bf16_t* Z; const float* ssq;
    __device__ __forceinline__ void operator()(const f32x4 (&acc)[2][2][4][2], const Unit& u, int wr, int wc, int fr, int fq) const {
        const int row0 = u.pm * BM + wr * 64 + fr, col0 = u.pn * BM + wc * 32 + 8 * fq;
#pragma unroll
        for (int ai = 0; ai < 2; ++ai)
#pragma unroll
            for (int m = 0; m < 4; ++m) { const int row = row0 + ai * HALF + m * 16;
                const f32x4* sp = (const f32x4*)(ssq + (size_t)row * 16); const f32x4 s0 = sp[0], s1 = sp[1], s2 = sp[2], s3 = sp[3];
                const float ss = ((s0[0] + s0[1]) + (s0[2] + s0[3])) + ((s1[0] + s1[1]) + (s1[2] + s1[3])) + ((s2[0] + s2[1]) + (s2[2] + s2[3])) + ((s3[0] + s3[1]) + (s3[2] + s3[3]));
                const float r = __builtin_amdgcn_rsqf(ss * (1.0f / D) + EPS);
                bf16_t* rowp = Z + (size_t)row * INC + col0;
#pragma unroll
                for (int bj = 0; bj < 2; ++bj) { f32x4 v0 = acc[ai][bj][m][0] * r, v1 = acc[ai][bj][m][1] * r;
                    if (u.pn * BM + bj * HALF < ZGELU_END) {
#pragma unroll
                        for (int j = 0; j < 4; ++j) { v0[j] = gelu_fast(v0[j]); v1[j] = gelu_fast(v1[j]); } }
                    u32x4 w; w.x = cvt_pk_bf16(v0[0], v0[1]); w.y = cvt_pk_bf16(v0[2], v0[3]); w.z = cvt_pk_bf16(v1[0], v1[1]); w.w = cvt_pk_bf16(v1[2], v1[3]);
                    *(u32x4*)(rowp + bj * HALF) = w; } }
    }
};
template <bool SCATTER> struct EpiRes {
    static constexpr bool PERM = true, AFTER_DRAIN = false;
    bf16_t* H; float* ssq; const int* rowtok;
    __device__ __forceinline__ void operator()(const f32x4 (&acc)[2][2][4][2], const Unit& u, int wr, int wc, int fr, int fq) const {
        const int row0 = u.pm * BM + wr * 64 + fr, col0 = u.pn * BM + wc * 32 + 8 * fq;
#pragma unroll
        for (int ai = 0; ai < 2; ++ai)
#pragma unroll
            for (int m = 0; m < 4; ++m) { const int row = row0 + ai * HALF + m * 16; int tok = row; if (SCATTER) tok = rowtok[row];
                float s = 0.f;
                if (tok >= 0) { bf16_t* rowp = H + (size_t)tok * D + col0;
#pragma unroll
                    for (int bj = 0; bj < 2; ++bj) { const u32x4 o = *(const u32x4*)(rowp + bj * HALF);
                        f32x4 v0 = acc[ai][bj][m][0], v1 = acc[ai][bj][m][1];
                        v0[0] += __uint_as_float(o.x << 16); v0[1] += __uint_as_float(o.x & 0xffff0000u); v0[2] += __uint_as_float(o.y << 16); v0[3] += __uint_as_float(o.y & 0xffff0000u);
                        v1[0] += __uint_as_float(o.z << 16); v1[1] += __uint_as_float(o.z & 0xffff0000u); v1[2] += __uint_as_float(o.w << 16); v1[3] += __uint_as_float(o.w & 0xffff0000u);
                        s += (v0[0] * v0[0] + v0[1] * v0[1]) + (v0[2] * v0[2] + v0[3] * v0[3]) + (v1[0] * v1[0] + v1[1] * v1[1]) + (v1[2] * v1[2] + v1[3] * v1[3]);
                        u32x4 w; w.x = cvt_pk_bf16(v0[0], v0[1]); w.y = cvt_pk_bf16(v0[2], v0[3]); w.z = cvt_pk_bf16(v1[0], v1[1]); w.w = cvt_pk_bf16(v1[2], v1[3]);
                        *(u32x4*)(rowp + bj * HALF) = w; } }
                s += __shfl_xor(s, 16); s += __shfl_xor(s, 32);
                if (fq == 0 && tok >= 0) ssq[(size_t)tok * 16 + u.pn * 4 + wc] = s; }
    }
};
struct EpiUp {
    static constexpr bool PERM = true, AFTER_DRAIN = false;
    bf16_t* ACT; const float* rowg;
    __device__ __forceinline__ void operator()(const f32x4 (&acc)[2][2][4][2], const Unit& u, int wr, int wc, int fr, int fq) const {
        const int row0 = u.pm * BM + wr * 64 + fr, s = u.pn >> 2, col0 = s * 512 + (u.pn & 3) * 128 + wc * 32 + 8 * fq;
#pragma unroll
        for (int ai = 0; ai < 2; ++ai)
#pragma unroll
            for (int m = 0; m < 4; ++m) { const int row = row0 + ai * HALF + m * 16; const float gt = rowg[(size_t)row * 2 + s];
                float o[8];
#pragma unroll
                for (int n = 0; n < 2; ++n)
#pragma unroll
                    for (int j = 0; j < 4; ++j) { const float g = acc[ai][0][m][n][j], up = acc[ai][1][m][n][j]; o[n * 4 + j] = g * sigmoid_fast(g) * up * gt; }
                u32x4 w; w.x = cvt_pk_bf16(o[0], o[1]); w.y = cvt_pk_bf16(o[2], o[3]); w.z = cvt_pk_bf16(o[4], o[5]); w.w = cvt_pk_bf16(o[6], o[7]);
                *(u32x4*)(ACT + (size_t)row * 1024 + col0) = w; }
    }
};
}

__device__ __forceinline__ void tr_item(const float* W, int ldw, int k0, int scol0, const float* gk, bf16_t* WT, int ldo, int drow0, int dk0, LAS float* scr, int lane) {
#pragma unroll 8
    for (int i = 0; i < 32; ++i) { const int kk = 2 * i + (lane >> 5); float v = W[(size_t)(k0 + kk) * ldw + scol0 + (lane & 31)]; if (gk) v *= gk[k0 + kk]; scr[kk * 33 + (lane & 31)] = v; }
    asm volatile("s_waitcnt lgkmcnt(0)" ::: "memory");
    const int c = lane & 7;
#pragma unroll
    for (int j = 0; j < 4; ++j) { const int n = (lane >> 3) + 8 * j; const LAS float* s = scr + (8 * c) * 33 + n;
        u32x4 o; o.x = cvt_pk_bf16(s[0 * 33], s[1 * 33]); o.y = cvt_pk_bf16(s[2 * 33], s[3 * 33]); o.z = cvt_pk_bf16(s[4 * 33], s[5 * 33]); o.w = cvt_pk_bf16(s[6 * 33], s[7 * 33]);
        *(u32x4*)(WT + (size_t)(drow0 + n) * ldo + dk0 + 8 * c) = o; }
    asm volatile("s_waitcnt lgkmcnt(0)" ::: "memory");
}

struct Args { const float* in[34]; float* out; unsigned char* ws; };

__global__ void __launch_bounds__(512, 2) mega_fwd(Args a) {
    extern __shared__ __attribute__((aligned(16))) unsigned char lds_raw[];
    LAS unsigned char* lds = (LAS unsigned char*)lds_raw;
    volatile LAS unsigned* LW = (volatile LAS unsigned*)(lds + LDSCTL_OFF);
    volatile LAS int* LWI = (volatile LAS int*)(lds + LDSCTL_OFF);
    const int G = gridDim.x, bid = blockIdx.x;
#define PHASE_IDS() int tid = threadIdx.x; asm volatile("" : "+v"(tid)); const int lane = tid & 63, wave = __builtin_amdgcn_readfirstlane(tid >> 6); const int gw = bid * 8 + wave, NGW = G * 8; \
    const size_t gt = (size_t)bid * 512 + tid, NGT = (size_t)G * 512; (void)lane; (void)wave; (void)gw; (void)NGW; (void)gt; (void)NGT
#define WSB() ({ unsigned char* _w = a.ws; asm volatile("" : "+s"(_w)); _w; })
#define INP(i) ({ int _k = (i); asm volatile("" : "+s"(_k)); a.in[_k]; })
    for (int u = threadIdx.x; u < (LDS_BYTES - LDSCTL_OFF) / 4; u += 512) LW[u] = 0u;
    __syncthreads();
    XcdBarrier bar = xcd_barrier_post((unsigned*)(a.ws + WS_CTL) + CW_BAR, LW + LW_BAR);

    {
        PHASE_IDS(); unsigned char* ws = WSB(); bf16_t* WIN = (bf16_t*)(ws + WS_WIN); bf16_t* WOUT = (bf16_t*)(ws + WS_WOUT); bf16_t* WGU = (bf16_t*)(ws + WS_WGU); bf16_t* WD2 = (bf16_t*)(ws + WS_WD2);
        bf16_t* HB = (bf16_t*)(ws + WS_HB); float* SSQ = (float*)(ws + WS_SSQ);
        LAS float* scr = (LAS float*)(lds + wave * 16384);
        constexpr int I_IN = 16 * 56, I_OUT = 16 * 32, I_GU = 2 * 16 * 256, I_D2 = 48 * 256, I_L = I_IN + I_OUT + I_GU + I_D2;
        for (int it = gw; it < 2 * I_L; it += NGW) {
            const int l = it / I_L; int r = it % I_L;
            if (r < I_IN) { const int kb = r / 56, nb = r % 56, j0 = nb * 32; const int sc = j0 < 768 ? j0 : (j0 < 1152 ? j0 + 384 : (j0 < 1536 ? j0 - 384 : j0));
                tr_item(INP(2) + (size_t)l * D * INC, INC, kb * 64, sc, INP(1) + (size_t)l * D, WIN + (size_t)l * INC * D, D, j0, kb * 64, scr, lane); continue; }
            r -= I_IN;
            if (r < I_OUT) { const int kb = r / 32, nb = r % 32; tr_item(INP(24) + (size_t)l * D * D, D, kb * 64, nb * 32, nullptr, WOUT + (size_t)l * D * D, D, nb * 32, kb * 64, scr, lane); continue; }
            r -= I_OUT;
            if (r < I_GU) { const int which = r / (16 * 256), e = (r / 256) % 16, q = r % 256, kb = q / 16, nb = q % 16, n0 = nb * 32;
                const float* src = INP(30 + which) + ((size_t)l * NE + e) * D * DE;
                tr_item(src, DE, kb * 64, n0, nullptr, WGU + ((size_t)l * NE + e) * 1024 * 1024, 1024, (n0 / 128) * 256 + which * 128 + (n0 % 128), kb * 64, scr, lane); continue; }
            r -= I_GU;
            { const int ch = r / 256, cls = ch >> 1, half = ch & 1, q = r % 256, kb = q / 32, nb = q % 32; const int g = cls / 6, pi = cls % 6, e = g * 4 + (half ? pair_hi(pi) : pair_lo(pi));
                tr_item(INP(32) + ((size_t)l * NE + e) * DE * D, D, kb * 64, nb * 32, nullptr, WD2 + ((size_t)l * NCLS + cls) * 1024 * 1024, 1024, nb * 32, half * 512 + kb * 64, scr, lane); }
        }
        const float* xin = INP(0);
        for (int t = gw; t < T; t += NGW) {
            const f32x4* xr = (const f32x4*)(xin + (size_t)t * D) + lane; f32x4 v[4]; float s = 0.f;
#pragma unroll
            for (int j = 0; j < 4; ++j) { v[j] = xr[64 * j]; s += (v[j][0] * v[j][0] + v[j][1] * v[j][1]) + (v[j][2] * v[j][2] + v[j][3] * v[j][3]); }
            s = wave_sum(s);
            u32x2* o8 = (u32x2*)(HB + (size_t)t * D) + lane;
#pragma unroll
            for (int j = 0; j < 4; ++j) { u32x2 w; w.x = cvt_pk_bf16(v[j][0], v[j][1]); w.y = cvt_pk_bf16(v[j][2], v[j][3]); o8[64 * j] = w; }
            if (lane < 16) SSQ[(size_t)t * 16 + lane] = lane == 0 ? s : 0.f;
        }
    }
    xcd_barrier(bar);

    for (int l = 0; l < DEPTH; ++l) {
        { PHASE_IDS(); unsigned char* ws = WSB(); bf16_t* WIN = (bf16_t*)(ws + WS_WIN); bf16_t* HB = (bf16_t*)(ws + WS_HB); float* SSQ = (float*)(ws + WS_SSQ); bf16_t* Z = (bf16_t*)(ws + WS_Z);
          pg8::StaticOrder<T, INC> S; S.init(HB, WIN + (size_t)l * INC * D, G, bid);
          pg8::EpiZ E{Z, SSQ};
          pg8::gemm_phase<pg8::EpiZ, pg8::StaticOrder<T, INC>, true, true>(lds, D, S, E); }
        xcd_barrier(bar);

        {
            PHASE_IDS(); unsigned char* ws = WSB(); const bf16_t* Z = (const bf16_t*)(ws + WS_Z); float* RS = (float*)(ws + WS_RS); float* AV = (float*)(ws + WS_AV); float* BV = (float*)(ws + WS_BV);
            const float* conv_w = INP(6) + (size_t)l * 4 * BW; const float* conv_b = INP(7) + (size_t)l * BW; const float* rg_w = INP(8) + (size_t)l * 6 * 64 * 64; const float* rg_b = INP(9) + (size_t)l * BW;
            const float* ig_w = INP(10) + (size_t)l * 6 * 64 * 64; const float* ig_b = INP(11) + (size_t)l * BW; const float* lam = INP(12) + (size_t)l * BW;
            LAS float* xcs = (LAS float*)(lds + wave * 2048);
            for (int t = gw; t < T; t += NGW) {
                const bf16_t* zr = Z + (size_t)t * INC; const int s = t % SEQ;
                float ss = 0.f;
#pragma unroll
                for (int i = 0; i < 6; ++i) { const float v = bf2f(zr[ZV + lane + 64 * i]); ss += v * v; }
                ss = wave_sum(ss); if (lane == 0) RS[t] = rsqrtf(ss * (1.0f / AW) + EPS);
                float xc[6];
#pragma unroll
                for (int i = 0; i < 6; ++i) { const int c = lane + 64 * i; float v = conv_b[c] + conv_w[3 * BW + c] * bf2f(zr[ZX + c]);
                    if (s >= 1) v += conv_w[2 * BW + c] * bf2f(zr[ZX + c - INC]);
                    if (s >= 2) v += conv_w[1 * BW + c] * bf2f(zr[ZX + c - 2 * INC]);
                    if (s >= 3) v += conv_w[0 * BW + c] * bf2f(zr[ZX + c - 3 * INC]);
                    xc[i] = v; xcs[c] = v; }
#pragma unroll
                for (int i = 0; i < 6; ++i) { const int c = lane + 64 * i; float sr = 0.f, si = 0.f;
                    for (int k = 0; k < HD; ++k) { const float x = xcs[i * 64 + k]; sr = fmaf(x, rg_w[(size_t)(i * 64 + k) * 64 + lane], sr); si = fmaf(x, ig_w[(size_t)(i * 64 + k) * 64 + lane], si); }
                    const float r = sigmoid_f(sr + rg_b[c]), ig = sigmoid_f(si + ig_b[c]);
                    const float sp = log1pf(expf(-lam[c])); const float la = -8.0f * r * sp;
                    AV[(size_t)t * BW + c] = expf(la); BV[(size_t)t * BW + c] = sqrtf(-expm1f(2.0f * la)) * (ig * xc[i]); }
            }
        }
        xcd_barrier(bar);

        {
            PHASE_IDS(); unsigned char* ws = WSB(); const bf16_t* Z = (const bf16_t*)(ws + WS_Z); bf16_t* Y = (bf16_t*)(ws + WS_Y); const float* RS = (const float*)(ws + WS_RS); const float* AV = (const float*)(ws + WS_AV); const float* BV = (const float*)(ws + WS_BV);
            float* SUMA = (float*)(ws + WS_SUMA); float* SUMH = (float*)(ws + WS_SUMH);
            const float* a_v_norm_g = INP(3) + (size_t)l * AW; const float* a_sw = INP(4) + (size_t)l * 6 * 128 * 128; const float* a_sb = INP(5) + (size_t)l * 6 * 128;
            for (size_t idx = gt; idx < (size_t)T * AW; idx += NGT) {
                const int t = (int)(idx / AW), c = (int)(idx % AW), h = c / HD, i = t % ABLK, t0 = t - i;
                const int jmax = ((i / CHUNK) + 1) * CHUNK; const float* w = a_sw + ((size_t)h * ABLK + i) * ABLK; float s = 0.f;
                for (int j = 0; j < jmax; ++j) s = fmaf(w[j] * RS[t0 + j], bf2f(Z[(size_t)(t0 + j) * INC + ZV + c]), s);
                s = s * a_v_norm_g[c] + a_sb[h * ABLK + i];
                Y[(size_t)t * D + c] = f2bf(bf2f(Z[(size_t)t * INC + ZU + c]) * s);
            }
            for (size_t idx = gt; idx < (size_t)NU * BW; idx += NGT) {
                const int u = (int)(idx / BW), c = (int)(idx % BW); float P = 1.f, H = 0.f;
                for (int s = 0; s < UT; ++s) { const size_t t = (size_t)u * UT + s; const float av = AV[t * BW + c]; H = fmaf(av, H, BV[t * BW + c]); P *= av; }
                SUMA[idx] = P; SUMH[idx] = H;
            }
            if (bid < BATCH * CG) {
                const float* c_a_re = INP(13) + (size_t)l * CG * CS; const float* c_a_im = INP(14) + (size_t)l * CG * CS; const float* c_log_dt = INP(15) + (size_t)l * CG;
                const float* c_b_re = INP(16) + (size_t)l * CG * CS * CGD; const float* c_b_im = INP(17) + (size_t)l * CG * CS * CGD; const float* c_c_re = INP(18) + (size_t)l * CG * CGD * CS; const float* c_c_im = INP(19) + (size_t)l * CG * CGD * CS;
                const float* c_d = INP(20) + (size_t)l * CW;
                const int b = bid / CG, g = bid % CG, p = tid & 63;
                LAS float* sre = (LAS float*)(lds + 32768); LAS float* sim = sre + 64; LAS float* xs = sim + 64;
                const float dt = expf(c_log_dt[g]); const float lr = c_a_re[g * CS + p], li = c_a_im[g * CS + p];
                const float mag = expf(lr * dt); const float lbr = mag * cosf(li * dt), lbi = mag * sinf(li * dt);
                const float nr = lbr - 1.0f, ni = lbi, den = lr * lr + li * li; const float cr = (nr * lr + ni * li) / den, ci = (ni * lr - nr * li) / den;
                float bbr[CGD], bbi[CGD];
#pragma unroll
                for (int c = 0; c < CGD; ++c) { const float br = c_b_re[((size_t)g * CS + p) * CGD + c], bi = c_b_im[((size_t)g * CS + p) * CGD + c]; bbr[c] = cr * br - ci * bi; bbi[c] = cr * bi + ci * br; }
                float str = 0.f, sti = 0.f;
                for (int s = 0; s < SEQ; ++s) { const size_t t = (size_t)b * SEQ + s;
                    if (tid < CGD) xs[tid] = bf2f(Z[t * INC + ZC + g * CGD + tid]);
                    __syncthreads();
                    float ur = 0.f, ui = 0.f;
#pragma unroll
                    for (int c = 0; c < CGD; ++c) { ur = fmaf(bbr[c], xs[c], ur); ui = fmaf(bbi[c], xs[c], ui); }
                    const float nr2 = lbr * str - lbi * sti + ur, ni2 = lbr * sti + lbi * str + ui; str = nr2; sti = ni2;
                    if (tid < 64) { sre[p] = str; sim[p] = sti; }
                    __syncthreads();
                    if (tid < CGD) { float acc = 0.f; const float* cre = c_c_re + ((size_t)g * CGD + tid) * CS; const float* cim = c_c_im + ((size_t)g * CGD + tid) * CS;
                        for (int q = 0; q < CS; ++q) acc += cre[q] * sre[q] - cim[q] * sim[q];
                        acc += c_d[g * CGD + tid] * xs[tid];
                        const float uu = 0.7978845608028654f * (acc + 0.044715f * acc * acc * acc);
                        Y[t * D + AW + BW + g * CGD + tid] = f2bf(0.5f * acc * (1.0f + tanhf(uu))); }
                    __syncthreads();
                }
            }
        }
        xcd_barrier(bar);

        { PHASE_IDS(); unsigned char* ws = WSB(); const bf16_t* Z = (const bf16_t*)(ws + WS_Z); bf16_t* Y = (bf16_t*)(ws + WS_Y); const float* AV = (const float*)(ws + WS_AV); const float* BV = (const float*)(ws + WS_BV);
          const float* SUMA = (const float*)(ws + WS_SUMA); const float* SUMH = (const float*)(ws + WS_SUMH);
        for (size_t idx = gt; idx < (size_t)NU * BW; idx += NGT) {
            const int u = (int)(idx / BW), c = (int)(idx % BW); const int u0 = (u / (SEQ / UT)) * (SEQ / UT); float h = 0.f;
            for (int j = u0; j < u; ++j) h = fmaf(SUMA[(size_t)j * BW + c], h, SUMH[(size_t)j * BW + c]);
            for (int s = 0; s < UT; ++s) { const size_t t = (size_t)u * UT + s; h = fmaf(AV[t * BW + c], h, BV[t * BW + c]);
                Y[t * D + AW + c] = f2bf(h * bf2f(Z[t * INC + ZG + c])); }
        } }
        xcd_barrier(bar);

        {
            PHASE_IDS(); unsigned char* ws = WSB(); bf16_t* Y = (bf16_t*)(ws + WS_Y); const float* glu_w = INP(21) + (size_t)l * CW * CW; const float* glu_b = INP(22) + (size_t)l * CW; const float* mo_g = INP(23) + (size_t)l * D;
            LAS float* ycs = (LAS float*)(lds + wave * 2048);
            for (int t = gw; t < T; t += NGW) {
                bf16_t* yr = Y + (size_t)t * D;
                float yc[4], ya[6], yb[6];
#pragma unroll
                for (int i = 0; i < 4; ++i) { yc[i] = bf2f(yr[AW + BW + lane + 64 * i]); ycs[lane + 64 * i] = yc[i]; }
                float sa = 0.f, sb = 0.f, sc = 0.f;
#pragma unroll
                for (int i = 0; i < 6; ++i) { ya[i] = bf2f(yr[lane + 64 * i]); yb[i] = bf2f(yr[AW + lane + 64 * i]); sa += ya[i] * ya[i]; sb += yb[i] * yb[i]; }
#pragma unroll
                for (int i = 0; i < 4; ++i) { const int c = lane + 64 * i; float s = glu_b[c];
                    for (int k = 0; k < CW; ++k) s = fmaf(ycs[k], glu_w[(size_t)k * CW + c], s);
                    yc[i] = yc[i] * sigmoid_f(s); sc += yc[i] * yc[i]; }
                sa = wave_sum(sa); sb = wave_sum(sb); sc = wave_sum(sc);
                const float ra = rsqrtf(sa * (1.0f / AW) + EPS), rb = rsqrtf(sb * (1.0f / BW) + EPS), rc = rsqrtf(sc * (1.0f / CW) + EPS);
#pragma unroll
                for (int i = 0; i < 6; ++i) { const int c = lane + 64 * i; yr[c] = f2bf(ya[i] * ra * mo_g[c]); yr[AW + c] = f2bf(yb[i] * rb * mo_g[AW + c]); }
#pragma unroll
                for (int i = 0; i < 4; ++i) { const int c = lane + 64 * i; yr[AW + BW + c] = f2bf(yc[i] * rc * mo_g[AW + BW + c]); }
            }
        }
        xcd_barrier(bar);

        { PHASE_IDS(); unsigned char* ws = WSB(); bf16_t* WOUT = (bf16_t*)(ws + WS_WOUT); bf16_t* HB = (bf16_t*)(ws + WS_HB); float* SSQ = (float*)(ws + WS_SSQ); bf16_t* Y = (bf16_t*)(ws + WS_Y);
          pg8::StaticOrder<T, D> S; S.init(Y, WOUT + (size_t)l * D * D, G, bid);
          pg8::EpiRes<false> E{HB, SSQ, nullptr};
          pg8::gemm_phase<pg8::EpiRes<false>, pg8::StaticOrder<T, D>, true, true>(lds, D, S, E); }
        xcd_barrier(bar);

        { PHASE_IDS(); unsigned char* ws = WSB(); const bf16_t* HB = (const bf16_t*)(ws + WS_HB); const float* SSQ = (const float*)(ws + WS_SSQ); int* CLS = (int*)(ws + WS_CLS); float* G2 = (float*)(ws + WS_G2); int* HIST = (int*)(ws + WS_HIST);
          const float* ffn_g = INP(25) + (size_t)l * D; const float* rgw = INP(26) + (size_t)l * D * 4; const float* rgb = INP(27) + (size_t)l * 4; const float* rew = INP(28) + (size_t)l * 4 * D * 4; const float* reb = INP(29) + (size_t)l * 16;
        for (int u = bid; u < NU; u += G) {
            for (int i = 0; i < 32; ++i) { const int t = u * UT + wave * 32 + i;
                float sq = lane < 16 ? SSQ[(size_t)t * 16 + lane] : 0.f; sq = wave_sum(sq); const float r = rsqrtf(sq * (1.0f / D) + EPS);
                const bf16_t* hr = HB + (size_t)t * D; float hn[16];
#pragma unroll
                for (int j = 0; j < 16; ++j) { const int d = lane + 64 * j; hn[j] = bf2f(hr[d]) * r * ffn_g[d]; }
                float gl[4] = {0.f, 0.f, 0.f, 0.f};
#pragma unroll
                for (int j = 0; j < 16; ++j) { const f32x4 w = *(const f32x4*)(rgw + (size_t)(lane + 64 * j) * 4); gl[0] = fmaf(hn[j], w[0], gl[0]); gl[1] = fmaf(hn[j], w[1], gl[1]); gl[2] = fmaf(hn[j], w[2], gl[2]); gl[3] = fmaf(hn[j], w[3], gl[3]); }
#pragma unroll
                for (int j = 0; j < 4; ++j) gl[j] = wave_sum(gl[j]) + rgb[j];
                int gs = 0; float gm = gl[0];
#pragma unroll
                for (int j = 1; j < 4; ++j) if (gl[j] > gm) { gm = gl[j]; gs = j; }
                float den = 0.f;
#pragma unroll
                for (int j = 0; j < 4; ++j) den += expf(gl[j] - gm);
                const float gwt = 1.0f / den;
                float el[4] = {0.f, 0.f, 0.f, 0.f}; const float* w4 = rew + (size_t)gs * D * 4;
#pragma unroll
                for (int j = 0; j < 16; ++j) { const f32x4 w = *(const f32x4*)(w4 + (size_t)(lane + 64 * j) * 4); el[0] = fmaf(hn[j], w[0], el[0]); el[1] = fmaf(hn[j], w[1], el[1]); el[2] = fmaf(hn[j], w[2], el[2]); el[3] = fmaf(hn[j], w[3], el[3]); }
#pragma unroll
                for (int j = 0; j < 4; ++j) el[j] = wave_sum(el[j]) + reb[gs * 4 + j];
                int i0 = 0; float v0 = el[0];
#pragma unroll
                for (int j = 1; j < 4; ++j) if (el[j] > v0) { v0 = el[j]; i0 = j; }
                int i1 = 0; float v1 = -3.0e38f;
#pragma unroll
                for (int j = 0; j < 4; ++j) if (j != i0 && el[j] > v1) { v1 = el[j]; i1 = j; }
                const float e1 = expf(v1 - v0); const float w0 = gwt / (1.0f + e1), w1 = gwt * e1 / (1.0f + e1);
                const int lo = i0 < i1 ? i0 : i1, hi = i0 < i1 ? i1 : i0; const int cls = gs * 6 + pair_idx(lo, hi);
                if (lane == 0) { CLS[t] = cls; G2[(size_t)t * 2 + 0] = i0 < i1 ? w0 : w1; G2[(size_t)t * 2 + 1] = i0 < i1 ? w1 : w0; __hip_atomic_fetch_add((LAS int*)(lds + LDSCTL_OFF) + LW_HIST + cls, 1, __ATOMIC_RELAXED, __HIP_MEMORY_SCOPE_WORKGROUP); }
            }
            __syncthreads();
            if (tid < 32) { HIST[u * 32 + tid] = tid < NCLS ? LWI[LW_HIST + tid] : 0; LWI[LW_HIST + tid] = 0; }
            __syncthreads();
        } }
        xcd_barrier(bar);

        { PHASE_IDS(); unsigned char* ws = WSB(); const bf16_t* HB = (const bf16_t*)(ws + WS_HB); const float* SSQ = (const float*)(ws + WS_SSQ); const int* CLS = (const int*)(ws + WS_CLS); const float* G2 = (const float*)(ws + WS_G2); const int* HIST = (const int*)(ws + WS_HIST);
          int* CTOT = (int*)(ws + WS_CTOT); int* ROWTOK = (int*)(ws + WS_ROWTOK); float* ROWG = (float*)(ws + WS_ROWG); bf16_t* HBS = (bf16_t*)(ws + WS_HBS); const float* ffn_g = INP(25) + (size_t)l * D;
        for (int u = bid; u < NU; u += G) {
            if (tid < NCLS) { int tot = 0, pre = 0;
_Pragma("unroll 4")
                for (int k = 0; k < NU; ++k) { const int v = HIST[k * 32 + tid]; tot += v; pre += k < u ? v : 0; } LWI[LW_TOT + tid] = tot; LWI[LW_BASE + tid] = pre; }
            __syncthreads();
            if (tid == 0) { int ps = 0;
_Pragma("unroll 1")
                for (int c = 0; c < NCLS; ++c) { const int tot = LWI[LW_TOT + c]; LWI[LW_BASE + c] += ps; LWI[LW_TST + c] = ps; ps += ((tot + 255) >> 8) << 8; if (bid == 0) CTOT[c] = tot; } LWI[LW_TST + NCLS] = ps; }
            if (tid < UT) LWI[LW_CLS + tid] = CLS[u * UT + tid];
            __syncthreads();
            if (tid < UT) { const int cls = LWI[LW_CLS + tid]; int rank = 0;
_Pragma("unroll 1")
                for (int i = 0; i < tid; ++i) rank += LWI[LW_CLS + i] == cls ? 1 : 0;
                const int dest = LWI[LW_BASE + cls] + rank; LWI[LW_DEST + tid] = dest; const int t = u * UT + tid;
                ROWTOK[dest] = t; ROWG[(size_t)dest * 2 + 0] = G2[(size_t)t * 2 + 0]; ROWG[(size_t)dest * 2 + 1] = G2[(size_t)t * 2 + 1]; }
            __syncthreads();
            for (int i = 0; i < 32; ++i) { const int tl = wave * 32 + i, t = u * UT + tl, dest = LWI[LW_DEST + tl];
                float sq = lane < 16 ? SSQ[(size_t)t * 16 + lane] : 0.f; sq = wave_sum(sq); const float r = rsqrtf(sq * (1.0f / D) + EPS);
#pragma unroll
                for (int hh = 0; hh < 2; ++hh) { const int d0 = hh * 512 + lane * 8; const u32x4 o = *(const u32x4*)(HB + (size_t)t * D + d0);
                    const f32x4 g0 = *(const f32x4*)(ffn_g + d0), g1 = *(const f32x4*)(ffn_g + d0 + 4);
                    u32x4 w; w.x = cvt_pk_bf16(__uint_as_float(o.x << 16) * r * g0[0], __uint_as_float(o.x & 0xffff0000u) * r * g0[1]);
                    w.y = cvt_pk_bf16(__uint_as_float(o.y << 16) * r * g0[2], __uint_as_float(o.y & 0xffff0000u) * r * g0[3]);
                    w.z = cvt_pk_bf16(__uint_as_float(o.z << 16) * r * g1[0], __uint_as_float(o.z & 0xffff0000u) * r * g1[1]);
                    w.w = cvt_pk_bf16(__uint_as_float(o.w << 16) * r * g1[2], __uint_as_float(o.w & 0xffff0000u) * r * g1[3]);
                    *(u32x4*)(HBS + (size_t)dest * D + d0) = w; } }
            if (u == bid)
_Pragma("unroll 1")
            for (int c = bid; c < NCLS; c += G) { const int tot = LWI[LW_TOT + c], r0 = LWI[LW_TST + c] + tot, r1 = LWI[LW_TST + c + 1];
                for (int r = r0 + wave; r < r1; r += 8) { if (lane == 0) { ROWTOK[r] = -1; ROWG[(size_t)r * 2] = 0.f; ROWG[(size_t)r * 2 + 1] = 0.f; }
                    *(u32x4*)(HBS + (size_t)r * D + lane * 8) = (u32x4){0u, 0u, 0u, 0u}; *(u32x4*)(HBS + (size_t)r * D + 512 + lane * 8) = (u32x4){0u, 0u, 0u, 0u}; } }
            __syncthreads();
        } }
        xcd_barrier(bar);

        { PHASE_IDS(); unsigned char* ws = WSB(); const int* CTOT = (const int*)(ws + WS_CTOT); bf16_t* HBS = (bf16_t*)(ws + WS_HBS); bf16_t* WGU = (bf16_t*)(ws + WS_WGU); bf16_t* ACT = (bf16_t*)(ws + WS_ACT); const float* ROWG = (const float*)(ws + WS_ROWG);
        if (tid == 0) { int ps = 0;
_Pragma("unroll 1")
            for (int c = 0; c < NCLS; ++c) { LWI[LW_TST + c] = ps; ps += (CTOT[c] + 255) >> 8; } LWI[LW_TST + NCLS] = ps; }
        __syncthreads();
        if (tid < 32) { const int ntile = LWI[LW_TST + NCLS]; const long L = (long)tid * G + bid; int e = -1;
            if (L < (long)ntile * 8) { const int mt = (int)(L / 8), pn = (int)(L % 8); int cls = 0;
_Pragma("unroll 1")
                for (int k = 1; k < NCLS; ++k) cls += (LWI[LW_TST + k] <= mt) ? 1 : 0;
                e = (cls << 24) | (pn << 16) | mt; }
            LWI[LW_UTAB + tid] = e; e = -1;
            if (L < (long)ntile * 4) { const int mt = (int)(L / 4), pn = (int)(L % 4); int cls = 0;
_Pragma("unroll 1")
                for (int k = 1; k < NCLS; ++k) cls += (LWI[LW_TST + k] <= mt) ? 1 : 0;
                e = (cls << 24) | (pn << 16) | mt; }
            LWI[LW_DTAB + tid] = e; }
        __syncthreads();
        { pg8::MoeOrder<8, true> S{LWI + LW_UTAB, l, (const char*)HBS, (const char*)WGU};
          pg8::EpiUp E{ACT, ROWG};
          pg8::gemm_phase<pg8::EpiUp, pg8::MoeOrder<8, true>, true, true>(lds, D, S, E); } }
        xcd_barrier(bar);

        { PHASE_IDS(); unsigned char* ws = WSB(); bf16_t* ACT = (bf16_t*)(ws + WS_ACT); bf16_t* WD2 = (bf16_t*)(ws + WS_WD2); bf16_t* HB = (bf16_t*)(ws + WS_HB); float* SSQ = (float*)(ws + WS_SSQ); const int* ROWTOK = (const int*)(ws + WS_ROWTOK);
          pg8::MoeOrder<4, false> S{LWI + LW_DTAB, l, (const char*)ACT, (const char*)WD2};
          pg8::EpiRes<true> E{HB, SSQ, ROWTOK};
          pg8::gemm_phase<pg8::EpiRes<true>, pg8::MoeOrder<4, false>, true, true>(lds, D, S, E); }
        xcd_barrier(bar);
    }

    { PHASE_IDS(); unsigned char* ws = WSB(); const bf16_t* HB = (const bf16_t*)(ws + WS_HB); const float* SSQ = (const float*)(ws + WS_SSQ); const float* fg = INP(33); float* outp = a.out;
    for (int t = gw; t < T; t += NGW) {
        float sq = lane < 16 ? SSQ[(size_t)t * 16 + lane] : 0.f; sq = wave_sum(sq); const float r = rsqrtf(sq * (1.0f / D) + EPS);
#pragma unroll
        for (int hh = 0; hh < 2; ++hh) { const int d0 = hh * 512 + lane * 8; const u32x4 o = *(const u32x4*)(HB + (size_t)t * D + d0);
            const f32x4 g0 = *(const f32x4*)(fg + d0), g1 = *(const f32x4*)(fg + d0 + 4);
            f32x4 w0, w1; w0[0] = __uint_as_float(o.x << 16) * r * g0[0]; w0[1] = __uint_as_float(o.x & 0xffff0000u) * r * g0[1]; w0[2] = __uint_as_float(o.y << 16) * r * g0[2]; w0[3] = __uint_as_float(o.y & 0xffff0000u) * r * g0[3];
            w1[0] = __uint_as_float(o.z << 16) * r * g1[0]; w1[1] = __uint_as_float(o.z & 0xffff0000u) * r * g1[1]; w1[2] = __uint_as_float(o.w << 16) * r * g1[2]; w1[3] = __uint_as_float(o.w & 0xffff0000u) * r * g1[3];
            *(f32x4*)(outp + (size_t)t * D + d0) = w0; *(f32x4*)(outp + (size_t)t * D + d0 + 4) = w1; }
    } }
}

extern "C" void kernel_launch(void* const* d_in, const int* in_sizes, int n_in, void* d_out, int out_size, void* d_ws, size_t ws_size, hipStream_t stream) {
    static int grid = 0;
    if (grid == 0) {
        if (n_in != 34 || in_sizes[0] != T * D || out_size != T * D || ws_size < WS_END) { fprintf(stderr, "kernel_launch: unexpected shapes (n_in %d, ws %zu)\n", n_in, ws_size); grid = -1; return; }
        int dev = 0, cus = 0, per_cu = 0;
        if (hipGetDevice(&dev) != hipSuccess || hipDeviceGetAttribute(&cus, hipDeviceAttributeMultiprocessorCount, dev) != hipSuccess) { grid = -1; return; }
        if (hipFuncSetAttribute((const void*)mega_fwd, hipFuncAttributeMaxDynamicSharedMemorySize, LDS_BYTES) != hipSuccess) { fprintf(stderr, "kernel_launch: hipFuncSetAttribute failed\n"); grid = -1; return; }
        if (hipOccupancyMaxActiveBlocksPerMultiprocessor(&per_cu, (const void*)mega_fwd, 512, LDS_BYTES) != hipSuccess || per_cu < 1) { fprintf(stderr, "kernel_launch: occupancy query says %d\n", per_cu); }
        (void)hipGetLastError();
        grid = cus;
    }
    if (grid < 0) return;
    (void)hipMemsetAsync((char*)d_ws + WS_CTL, 0, CTL_ZERO_BYTES, stream);
    Args a{};
    for (int i = 0; i < 34; ++i) a.in[i] = (const float*)d_in[i];
    a.out = (float*)d_out; a.ws = (unsigned char*)d_ws;
    hipLaunchKernelGGL(mega_fwd, dim3(grid), dim3(512), LDS_BYTES, stream, a);
}
```

```cpp
#include <hip/hip_runtime.h>
#include <cstdio>
#include <cstdint>

#define LAS __attribute__((address_space(3)))
typedef unsigned short bf16_t;
typedef short bf16x8 __attribute__((ext_vector_type(8)));
typedef float f32x4 __attribute__((ext_vector_type(4)));
typedef float f32x2 __attribute__((ext_vector_type(2)));
typedef unsigned u32x4 __attribute__((ext_vector_type(4)));
typedef unsigned u32x2 __attribute__((ext_vector_type(2)));

constexpr int D = 1024, BATCH = 8, SEQ = 8192, T = BATCH * SEQ, DEPTH = 2;
constexpr int AW = 384, BW = 384, CW = 256, HD = 64, ABLK = 128, CHUNK = 64;
constexpr int INC = 1792;
constexpr int ZU = 0, ZV = 384, ZG = 768, ZX = 1152, ZC = 1536, ZGELU_END = 1152;
constexpr int CG = 16, CGD = 16, CS = 64;
constexpr int NE = 16, DE = 512, NCLS = 24;
constexpr float EPS = 1e-6f;
constexpr int UT = 256;
constexpr int NU = T / UT;
constexpr int MAXROWS = T + NCLS * 256;

constexpr size_t MiB = 1u << 20;
constexpr size_t WS_CTL = 0, CTL_ZERO_BYTES = 1 * MiB;
constexpr size_t WS_WIN = 2 * MiB;
constexpr size_t WS_WOUT = 10 * MiB;
constexpr size_t WS_WGLU = 14 * MiB;
constexpr size_t WS_WRG = 15 * MiB;
constexpr size_t WS_WSP = 15 * MiB + 256 * 1024;
constexpr size_t WS_WGU = 16 * MiB;
constexpr size_t WS_WD2 = 80 * MiB;
constexpr size_t WS_SSQ = 176 * MiB;
constexpr size_t WS_RS = 180 * MiB;
constexpr size_t WS_CLS = WS_RS + 256 * 1024;
constexpr size_t WS_G2 = WS_CLS + 256 * 1024;
constexpr size_t WS_HIST = 181 * MiB;
constexpr size_t WS_CTOT = WS_HIST + 64 * 1024;
constexpr size_t WS_ROWTOK = WS_HIST + 256 * 1024;
constexpr size_t WS_ROWG = 182 * MiB;
constexpr size_t WS_SUMA = 183 * MiB;
constexpr size_t WS_SUMH = 191 * MiB;
constexpr size_t WS_S5 = 184 * MiB;
constexpr size_t WS_SEND = 187 * MiB;
constexpr size_t WS_HB = 192 * MiB;
constexpr size_t WS_Z = 320 * MiB;
constexpr size_t WS_HBS = WS_Z;
constexpr size_t WS_Y = 544 * MiB;
constexpr size_t WS_ACT = 672 * MiB;
constexpr size_t WS_AV = 672 * MiB;
constexpr size_t WS_BV = 768 * MiB;
constexpr size_t WS_END = 864 * MiB;
constexpr int CW_BAR = 4096;

constexpr int RING_BYTES = 131072;
constexpr int LDSCTL_OFF = 143360;
constexpr int LDS_BYTES = 147456;
constexpr int LW_BAR = 8, LW_TST = 64, LW_HIST = 96, LW_TOT = 128, LW_BASE = 160, LW_CLS = 256  , LW_DEST = 512  , LW_UTAB = 768  , LW_DTAB = 800  ;

__device__ __forceinline__ float bf2f(bf16_t v) { return __uint_as_float(((unsigned)v) << 16); }
__device__ __forceinline__ unsigned cvt_pk_bf16(float lo, float hi) { unsigned r; asm volatile("v_cvt_pk_bf16_f32 %0, %1, %2" : "=v"(r) : "v"(lo), "v"(hi)); return r; }
__device__ __forceinline__ bf16_t f2bf(float v) { return (bf16_t)(cvt_pk_bf16(v, 0.f) & 0xffffu); }
__device__ __forceinline__ float wave_sum(float v) {
#pragma unroll
    for (int o = 32; o >= 1; o >>= 1) v += __shfl_xor(v, o);
    return v;
}
__device__ __forceinline__ float gelu_fast(float x) {
    const float u2 = 1.5957691216057308f * (x + 0.044715f * x * x * x);
    const float e = __builtin_amdgcn_exp2f(-1.4426950408889634f * u2);
    return x * __builtin_amdgcn_rcpf(1.0f + e);
}
__device__ __forceinline__ float sigmoid_fast(float x) { return __builtin_amdgcn_rcpf(1.0f + __builtin_amdgcn_exp2f(-1.4426950408889634f * x)); }
__device__ __forceinline__ float sigmoid_f(float x) { return 1.0f / (1.0f + expf(-x)); }
__device__ __forceinline__ int pair_lo(int pi) { return pi < 3 ? 0 : (pi < 5 ? 1 : 2); }
__device__ __forceinline__ int pair_hi(int pi) { return pi < 3 ? pi + 1 : (pi < 5 ? pi - 1 : 3); }
__device__ __forceinline__ int pair_idx(int lo, int hi) { return lo == 0 ? hi - 1 : (lo == 1 ? hi + 1 : 5); }

#define XB_TMO      128
#define XB_XCNT(j)  (256  + 64 * (j))
#define XB_XSUB(j)  (1280 + 64 * (j))
#define XB_XGEN(j)  (2304 + 64 * (j))
#define XB_TOP      3328
#define XB_TOPGEN   3392
#define XCD_BAR_WORDS 3456
#define XB_SPIN_CAP (1u << 18)
__device__ __forceinline__ unsigned xb_ld(unsigned* p)              { return __hip_atomic_load(p, __ATOMIC_RELAXED, __HIP_MEMORY_SCOPE_AGENT); }
__device__ __forceinline__ unsigned xb_add(unsigned* p, unsigned v) { return __hip_atomic_fetch_add(p, v, __ATOMIC_RELAXED, __HIP_MEMORY_SCOPE_AGENT); }
__device__ __forceinline__ unsigned xb_xcc_id() { return (unsigned)__builtin_amdgcn_s_getreg((3 << 11) | 20) & 0xFu; }
#define XB_SPIN(cond, bar) do { unsigned _sp = 0; while (cond) { __builtin_amdgcn_s_sleep(1); \
    if ((++_sp & 255u) == 0u) { if (xb_ld(&(bar)[XB_TMO])) break; if (_sp > XB_SPIN_CAP) { atomicAdd(&(bar)[XB_TMO], 1u); break; } } } } while (0)
struct XcdBarrier { unsigned* bar; unsigned x; volatile LAS unsigned* st; };
__device__ __forceinline__ XcdBarrier xcd_barrier_post(unsigned* bar, volatile LAS unsigned* st) {
    XcdBarrier b; b.bar = bar; b.x = xb_xcc_id(); b.st = st;
    if (threadIdx.x == 0) (void)xb_add(&bar[XB_XCNT(b.x)], 1u);
    return b;
}
__device__ __forceinline__ void xcd_barrier_complete(unsigned* bar, unsigned x, unsigned& nloc, unsigned& nx) {
    const unsigned G = gridDim.x * gridDim.y * gridDim.z;
    unsigned sum, cnt, mine, sp = 0u;
    for (;;) {
        sum = 0u; cnt = 0u; mine = 0u;
#pragma unroll
        for (unsigned j = 0; j < 16; ++j) { const unsigned c = xb_ld(&bar[XB_XCNT(j)]); sum += c; cnt += (c > 0u) ? 1u : 0u; mine = (j == x) ? c : mine; }
        if (sum == G) break;
        __builtin_amdgcn_s_sleep(1);
        if ((++sp & 255u) == 0u) { if (xb_ld(&bar[XB_TMO])) break; if (sp > XB_SPIN_CAP) { atomicAdd(&bar[XB_TMO], 1u); break; } }
    }
    nloc = mine > 0u ? mine : 1u; nx = cnt > 0u ? cnt : 1u;
}
__device__ __forceinline__ void xcd_barrier(const XcdBarrier& b) {
    asm volatile("s_waitcnt vmcnt(0)" ::: "memory");
    __syncthreads();
    if (threadIdx.x == 0) {
        unsigned* bar = b.bar;
        __builtin_amdgcn_s_waitcnt(0);
        unsigned nloc = b.st[0], nx = b.st[1];
        if (nloc == 0u) { xcd_barrier_complete(bar, b.x, nloc, nx); b.st[0] = nloc; b.st[1] = nx; }
        const unsigned old = xb_add(&bar[XB_XSUB(b.x)], 1u);
        const unsigned gen = old / nloc;
        if (old + 1u == (gen + 1u) * nloc) {
            __builtin_amdgcn_fence(__ATOMIC_RELEASE, "agent");
            asm volatile("s_waitcnt vmcnt(0)" ::: "memory");
            const unsigned og = xb_add(&bar[XB_TOP], 1u);
            const unsigned tg = og / nx;
            if (og + 1u == (tg + 1u) * nx) xb_add(&bar[XB_TOPGEN], 1u);
            else XB_SPIN(xb_ld(&bar[XB_TOPGEN]) == tg, bar);
            __builtin_amdgcn_fence(__ATOMIC_ACQUIRE, "agent");
            xb_add(&bar[XB_XGEN(b.x)], 1u);
            asm volatile("s_waitcnt vmcnt(0)" ::: "memory");
        } else {
            XB_SPIN(xb_ld(&bar[XB_XGEN(b.x)]) == gen, bar);
            __builtin_amdgcn_fence(__ATOMIC_ACQUIRE, "agent");
            asm volatile("s_waitcnt vmcnt(0)" ::: "memory");
        }
    }
    __syncthreads();
}

namespace pg8 {
#define PG8_LAS __attribute__((address_space(3)))
constexpr int BM = 256, BK = 64, HALF = 128, HTB = HALF * BK * 2, STAGE_BYTES = 8 * HTB, NXCD = 8, WGM = 8;
__host__ __device__ __forceinline__ int lds_byte(int r, int c) { const int st = (r >> 4) * 2 + (c >> 5), rr = r & 15, cc = c & 31, ob = rr * 64 + cc * 2; return st * 1024 + (ob ^ (((ob >> 9) & 1) << 5)); }
__host__ __device__ __forceinline__ void stage_rc(int b, int& R, int& C) { const int st = b / 1024, sb = b % 1024, swz = sb ^ (((sb >> 9) & 1) << 5); R = (st >> 1) * 16 + swz / 64; C = (st & 1) * 32 + (swz % 64) / 2; }
__host__ __device__ __forceinline__ int perm32(int rho) { const int n = rho >> 4, i = rho & 15; return 8 * (i >> 2) + 4 * n + (i & 3); }
struct Unit { int pm, pn; const char* A; const char* B; };

template <int M_, int N_> struct StaticOrder {
    static constexpr int nM = M_ / BM, nN = N_ / BM, nwg = nM * nN; static constexpr size_t tstep = (size_t)BM * 1024 * 2;
    int G, c; const char* A; const char* Bt;
    __device__ void init(const void* A_, const void* Bt_, int G_, int c_) { G = G_; c = c_; A = (const char*)A_; Bt = (const char*)Bt_; }
    __device__ bool next(int i, Unit& u) const {
        const long L = (long)i * G + c; if (L >= nwg) return false;
        int wgid = (int)L; { constexpr int q = nwg / NXCD, r = nwg % NXCD; const int xcd = wgid % NXCD, off = wgid / NXCD; wgid = (xcd < r ? xcd * (q + 1) : r * (q + 1) + (xcd - r) * q) + off; }
        constexpr int nig = WGM * nN; const int gid = wgid / nig, fm = gid * WGM, gsz = (nM - fm) < WGM ? (nM - fm) : WGM;
        u.pm = fm + ((wgid % nig) % gsz); u.pn = (wgid % nig) / gsz; u.A = A + (size_t)u.pm * tstep; u.B = Bt + (size_t)u.pn * tstep; return true;
    }
    __device__ __forceinline__ void a_ready(const Unit&) const {}
    __device__ __forceinline__ void done(const Unit&) const {}
};
template <class Epi, class Sched, bool ALIGN_EPI = false, bool SP2 = false>
__device__ __forceinline__ void gemm_phase(PG8_LAS unsigned char* lds, const int Kdim, const Sched& S, const Epi& E) {
    int tid = threadIdx.x; asm volatile("" : "+v"(tid)); const int wid = __builtin_amdgcn_readfirstlane(tid >> 6), lane = tid & 63, wr = wid >> 2, wc = wid & 3, fr = lane & 15, fq = lane >> 4;
    constexpr int K = 1024, nt = K / BK; (void)Kdim;
    unsigned voffA, voffB;
    { int R, C; stage_rc(tid * 16, R, C); const int Rb = Epi::PERM ? ((R & ~31) + perm32(R & 31)) : R; voffA = (unsigned)(R * K + C) * 2u; voffB = (unsigned)(Rb * K + C) * 2u; }
    constexpr size_t kstep = (size_t)(BK * 2);
    constexpr size_t hstep = (size_t)HALF * K * 2;
    constexpr size_t tstep = 2 * hstep; (void)tstep;
    const unsigned ldsw = (unsigned)wid * 1024u;
    const int aoff = lds_byte(wr * 64 + fr, fq * 8), boff = lds_byte(wc * 32 + fr, fq * 8);
#define PG8_SA(b, h) (((b) * 2 + (h)) * HTB)
#define PG8_SB(b, h) ((4 + (b) * 2 + (h)) * HTB)
#define PG8_STAGE(bufoff, gbase, voff) do { _Pragma("unroll") for (int _i = 0; _i < 2; ++_i) \
        __builtin_amdgcn_global_load_lds((const unsigned*)((const char*)(gbase) + (size_t)_i * (64 * 1024 * 2) + (voff)), (PG8_LAS unsigned*)(lds + (bufoff) + ldsw + _i * 8192), 16, 0, 0); } while (0)
#define PG8_LDA(dst, b, h) do { _Pragma("unroll") for (int m = 0; m < 4; ++m) _Pragma("unroll") for (int k = 0; k < 2; ++k) dst[m][k] = *(const PG8_LAS bf16x8*)(lds + PG8_SA(b, h) + aoff + m * 2048 + k * 1024); } while (0)
#define PG8_LDB(dst, b, h) do { _Pragma("unroll") for (int n = 0; n < 2; ++n) _Pragma("unroll") for (int k = 0; k < 2; ++k) dst[n][k] = *(const PG8_LAS bf16x8*)(lds + PG8_SB(b, h) + boff + n * 2048 + k * 1024); } while (0)
#define PG8_MMA(ai, bj, At, Bt) do { __builtin_amdgcn_s_setprio(1); _Pragma("unroll") for (int m = 0; m < 4; ++m) _Pragma("unroll") for (int n = 0; n < 2; ++n) _Pragma("unroll") for (int k = 0; k < 2; ++k) \
        acc[ai][bj][m][n] = __builtin_amdgcn_mfma_f32_16x16x32_bf16(Bt[n][k], At[m][k], acc[ai][bj][m][n], 0, 0, 0); __builtin_amdgcn_s_setprio(0); } while (0)
#define PG8_WAIT_V(n) asm volatile("s_waitcnt vmcnt(" #n ")" ::: "memory")
#define PG8_WAIT_L(n) asm volatile("s_waitcnt lgkmcnt(" #n ")" ::: "memory")
#define PG8_BAR __builtin_amdgcn_s_barrier()
#define PG8_SCHED __builtin_amdgcn_sched_barrier(0)
    Unit cur, nxt; int ui = 0;
    if (!S.next(0, cur)) return;
    f32x4 acc[2][2][4][2];
#pragma unroll
    for (int a = 0; a < 2; ++a)
#pragma unroll
        for (int b = 0; b < 2; ++b)
#pragma unroll
            for (int m = 0; m < 4; ++m)
#pragma unroll
                for (int n = 0; n < 2; ++n) acc[a][b][m][n] = (f32x4){0.f, 0.f, 0.f, 0.f};
    bf16x8 At[4][2], B0[2][2], B1[2][2];
    const char* cA = cur.A; const char* cB = cur.B;
    S.a_ready(cur);
    if constexpr (SP2) {
        PG8_STAGE(PG8_SB(0, 0), cB, voffB); PG8_STAGE(PG8_SB(0, 1), cB + hstep, voffB); PG8_STAGE(PG8_SA(0, 0), cA, voffA); PG8_STAGE(PG8_SA(0, 1), cA + hstep, voffA);
        if (wr == 1) PG8_BAR;
        PG8_WAIT_V(2); PG8_BAR;
        PG8_STAGE(PG8_SB(1, 0), cB + kstep, voffB); PG8_STAGE(PG8_SA(1, 0), cA + kstep, voffA); PG8_STAGE(PG8_SB(1, 1), cB + hstep + kstep, voffB);
        PG8_WAIT_V(6); PG8_BAR;
    } else {
        PG8_STAGE(PG8_SB(0, 0), cB, voffB); PG8_STAGE(PG8_SA(0, 0), cA, voffA); PG8_STAGE(PG8_SB(0, 1), cB + hstep, voffB); PG8_STAGE(PG8_SA(0, 1), cA + hstep, voffA);
        if (wr == 1) PG8_BAR;
        PG8_WAIT_V(4); PG8_BAR;
        PG8_STAGE(PG8_SB(1, 0), cB + kstep, voffB); PG8_STAGE(PG8_SA(1, 0), cA + kstep, voffA); PG8_STAGE(PG8_SB(1, 1), cB + hstep + kstep, voffB);
        PG8_WAIT_V(6); PG8_BAR;
    }
    for (;;) {
        const bool has_next = S.next(ui + 1, nxt);
        const char* nA = has_next ? nxt.A : cA; const char* nB = has_next ? nxt.B : cB;
        for (int t = 0; t < nt; t += 2) {
            const bool last = (t == nt - 2);
            const char* a1 = cA + (size_t)(t + 1) * kstep;
            const char* a2 = last ? nA : cA + (size_t)(t + 2) * kstep; const char* b2 = last ? nB : cB + (size_t)(t + 2) * kstep;
            const char* a3 = a2 + kstep; const char* b3 = b2 + kstep;
            if (last && has_next) S.a_ready(nxt);
            if constexpr (SP2) {
            PG8_LDB(B0, 0, 0); PG8_LDB(B1, 0, 1); PG8_SCHED; PG8_LDA(At, 0, 0); PG8_STAGE(PG8_SA(1, 1), a1 + hstep, voffA);
            PG8_WAIT_V(8); PG8_WAIT_L(0); PG8_BAR; PG8_MMA(0, 0, At, B0); PG8_MMA(0, 1, At, B1); PG8_BAR; PG8_SCHED;
            PG8_LDA(At, 0, 1); PG8_STAGE(PG8_SB(0, 0), b2, voffB); PG8_STAGE(PG8_SB(0, 1), b2 + hstep, voffB); PG8_STAGE(PG8_SA(0, 0), a2, voffA);
            PG8_WAIT_V(8); PG8_WAIT_L(0); PG8_BAR; PG8_MMA(1, 0, At, B0); PG8_MMA(1, 1, At, B1); PG8_BAR; PG8_SCHED;
            PG8_LDB(B0, 1, 0); PG8_LDB(B1, 1, 1); PG8_SCHED; PG8_LDA(At, 1, 0); PG8_STAGE(PG8_SA(0, 1), a2 + hstep, voffA);
            PG8_WAIT_V(8); PG8_WAIT_L(0); PG8_BAR; PG8_MMA(0, 0, At, B0); PG8_MMA(0, 1, At, B1); PG8_BAR; PG8_SCHED;
            PG8_LDA(At, 1, 1); PG8_STAGE(PG8_SB(1, 0), b3, voffB); PG8_STAGE(PG8_SB(1, 1), b3 + hstep, voffB); PG8_STAGE(PG8_SA(1, 0), a3, voffA);
            PG8_WAIT_V(8); PG8_WAIT_L(0); PG8_BAR; PG8_MMA(1, 0, At, B0); PG8_MMA(1, 1, At, B1); PG8_BAR; PG8_SCHED;
            } else {
            PG8_LDB(B0, 0, 0); PG8_SCHED; PG8_LDA(At, 0, 0); PG8_STAGE(PG8_SA(1, 1), a1 + hstep, voffA);
            PG8_WAIT_L(8); PG8_BAR; PG8_WAIT_L(0); PG8_MMA(0, 0, At, B0); PG8_BAR; PG8_SCHED;
            PG8_LDB(B1, 0, 1); PG8_STAGE(PG8_SB(0, 0), b2, voffB);
            PG8_BAR; PG8_WAIT_L(0); PG8_MMA(0, 1, At, B1); PG8_BAR;
            PG8_LDA(At, 0, 1); PG8_STAGE(PG8_SA(0, 0), a2, voffA);
            PG8_BAR; PG8_WAIT_L(0); PG8_MMA(1, 0, At, B0); PG8_BAR; PG8_SCHED;
            PG8_STAGE(PG8_SB(0, 1), b2 + hstep, voffB);
            PG8_WAIT_V(6); PG8_BAR; PG8_MMA(1, 1, At, B1); PG8_BAR;
            PG8_LDB(B0, 1, 0); PG8_SCHED; PG8_LDA(At, 1, 0); PG8_STAGE(PG8_SA(0, 1), a2 + hstep, voffA);
            PG8_WAIT_L(8); PG8_BAR; PG8_WAIT_L(0); PG8_MMA(0, 0, At, B0); PG8_BAR; PG8_SCHED;
            PG8_LDB(B1, 1, 1); PG8_STAGE(PG8_SB(1, 0), b3, voffB);
            PG8_BAR; PG8_WAIT_L(0); PG8_MMA(0, 1, At, B1); PG8_BAR;
            PG8_LDA(At, 1, 1); PG8_STAGE(PG8_SA(1, 0), a3, voffA);
            PG8_BAR; PG8_WAIT_L(0); PG8_MMA(1, 0, At, B0); PG8_BAR; PG8_SCHED;
            PG8_STAGE(PG8_SB(1, 1), b3 + hstep, voffB);
            PG8_WAIT_V(6); PG8_BAR; PG8_MMA(1, 1, At, B1); PG8_BAR;
            }
        }
        if constexpr (ALIGN_EPI) { if (wr == 0) PG8_BAR; }
        if constexpr (!Epi::AFTER_DRAIN) { E(acc, cur, wr, wc, fr, fq); S.done(cur); }
        if (!has_next) break;
#pragma unroll
        for (int a = 0; a < 2; ++a)
#pragma unroll
            for (int b = 0; b < 2; ++b)
#pragma unroll
                for (int m = 0; m < 4; ++m)
#pragma unroll
                    for (int n = 0; n < 2; ++n) acc[a][b][m][n] = (f32x4){0.f, 0.f, 0.f, 0.f};
        cur = nxt; cA = nA; cB = nB; ++ui;
        if constexpr (ALIGN_EPI) { if (wr == 1) PG8_BAR; }
    }
    PG8_WAIT_V(0);
    if constexpr (!ALIGN_EPI) { if (wr == 0) PG8_BAR; }
    PG8_BAR;
    if constexpr (Epi::AFTER_DRAIN) { E.fused(acc, cur, wr, wc, fr, fq, lds, wid, lane); S.done(cur); }
#undef PG8_SA
#undef PG8_SB
#undef PG8_STAGE
#undef PG8_LDA
#undef PG8_LDB
#undef PG8_MMA
#undef PG8_WAIT_V
#undef PG8_WAIT_L
#undef PG8_BAR
#undef PG8_SCHED
}

template <int NP, bool UP> struct MoeOrder {
    const volatile LAS int* tab; int layer; const char* A; const char* W;
    __device__ bool next(int i, Unit& u) const {
        const int e = tab[i]; if (e < 0) return false;
        const int mt = e & 0xffff, pn = (e >> 16) & 0xff, cls = e >> 24;
        u.pm = mt; u.pn = pn; u.A = A + (size_t)mt * ((size_t)BM * 1024 * 2);
        if (UP) { const int g = cls / 6, pi = cls % 6, s = pn >> 2, ex = g * 4 + (s ? pair_hi(pi) : pair_lo(pi));
            u.B = W + ((size_t)(layer * NE + ex) * 1024 + (size_t)(pn & 3) * 256) * 1024 * 2; }
        else u.B = W + ((size_t)(layer * NCLS + cls) * 1024 + (size_t)pn * 256) * 1024 * 2;
        return true;
    }
    __device__ __forceinline__ void a_ready(const Unit&) const {}
    __device__ __forceinline__ void done(const Unit&) const {}
};

struct EpiZ {
    static constexpr bool PERM = true, AFTER_DRAIN = false;
    bf16_t* Z; const float* ssq;
    __device__ __forceinline__ void operator()(const f32x4 (&acc)[2][2][4][2], const Unit& u, int wr, int wc, int fr, int fq) const {
        const int row0 = u.pm * BM + wr * 64 + fr, col0 = u.pn * BM + wc * 32 + 8 * fq;
#pragma unroll
        for (int ai = 0; ai < 2; ++ai)
#pragma unroll
            for (int m = 0; m < 4; ++m) { const int row = row0 + ai * HALF + m * 16;
                const f32x4* sp = (const f32x4*)(ssq + (size_t)row * 16); const f32x4 s0 = sp[0], s1 = sp[1], s2 = sp[2], s3 = sp[3];
                const float ss = ((s0[0] + s0[1]) + (s0[2] + s0[3])) + ((s1[0] + s1[1]) + (s1[2] + s1[3])) + ((s2[0] + s2[1]) + (s2[2] + s2[3])) + ((s3[0] + s3[1]) + (s3[2] + s3[3]));
                const float r = __builtin_amdgcn_rsqf(ss * (1.0f / D) + EPS);
                bf16_t* rowp = Z + (size_t)row * INC + col0;
#pragma unroll
                for (int bj = 0; bj < 2; ++bj) { f32x4 v0 = acc[ai][bj][m][0] * r, v1 = acc[ai][bj][m][1] * r;
                    if (u.pn * BM + bj * HALF < ZGELU_END) {
#pragma unroll
                        for (int j = 0; j < 4; ++j) { v0[j] = gelu_fast(v0[j]); v1[j] = gelu_fast(v1[j]); } }
                    u32x4 w; w.x = cvt_pk_bf16(v0[0], v0[1]); w.y = cvt_pk_bf16(v0[2], v0[3]); w.z = cvt_pk_bf16(v1[0], v1[1]); w.w = cvt_pk_bf16(v1[2], v1[3]);
                    *(u32x4*)(rowp + bj * HALF) = w; }
                asm volatile("" ::: "memory"); }
    }
};
template <bool SCATTER> struct EpiRes {
    static constexpr bool PERM = true, AFTER_DRAIN = false;
    bf16_t* H; float* ssq; const int* rowtok;
    __device__ __forceinline__ void operator()(const f32x4 (&acc)[2][2][4][2], const Unit& u, int wr, int wc, int fr, int fq) const {
        const int row0 = u.pm * BM + wr * 64 + fr, col0 = u.pn * BM + wc * 32 + 8 * fq;
#pragma unroll
        for (int ai = 0; ai < 2; ++ai)
#pragma unroll
            for (int m = 0; m < 4; ++m) { const int row = row0 + ai * HALF + m * 16; int tok = row; if (SCATTER) tok = rowtok[row];
                float s = 0.f;
                if (tok >= 0) { bf16_t* rowp = H + (size_t)tok * D + col0;
#pragma unroll
                    for (int bj = 0; bj < 2; ++bj) { const u32x4 o = *(const u32x4*)(rowp + bj * HALF);
                        f32x4 v0 = acc[ai][bj][m][0], v1 = acc[ai][bj][m][1];
                        v0[0] += __uint_as_float(o.x << 16); v0[1] += __uint_as_float(o.x & 0xffff0000u); v0[2] += __uint_as_float(o.y << 16); v0[3] += __uint_as_float(o.y & 0xffff0000u);
                        v1[0] += __uint_as_float(o.z << 16); v1[1] += __uint_as_float(o.z & 0xffff0000u); v1[2] += __uint_as_float(o.w << 16); v1[3] += __uint_as_float(o.w & 0xffff0000u);
                        s += (v0[0] * v0[0] + v0[1] * v0[1]) + (v0[2] * v0[2] + v0[3] * v0[3]) + (v1[0] * v1[0] + v1[1] * v1[1]) + (v1[2] * v1[2] + v1[3] * v1[3]);
                        u32x4 w; w.x = cvt_pk_bf16(v0[0], v0[1]); w.y = cvt_pk_bf16(v0[2], v0[3]); w.z = cvt_pk_bf16(v1[0], v1[1]); w.w = cvt_pk_bf16(v1[2], v1[3]);
                        *(u32x4*)(rowp + bj * HALF) = w; } }
                s += __shfl_xor(s, 16); s += __shfl_xor(s, 32);
                if (fq == 0 && tok >= 0) ssq[(size_t)tok * 16 + u.pn * 4 + wc] = s;
                asm volatile("" ::: "memory"); }
    }
};
struct EpiUp {
    static constexpr bool PERM = true, AFTER_DRAIN = false;
    bf16_t* ACT; const float* rowg;
    __device__ __forceinline__ void operator()(const f32x4 (&acc)[2][2][4][2], const Unit& u, int wr, int wc, int fr, int fq) const {
        const int row0 = u.pm * BM + wr * 64 + fr, s = u.pn >> 2, col0 = s * 512 + (u.pn & 3) * 128 + wc * 32 + 8 * fq;
#pragma unroll
        for (int ai = 0; ai < 2; ++ai)
#pragma unroll
            for (int m = 0; m < 4; ++m) { const int row = row0 + ai * HALF + m * 16; const float gt = rowg[(size_t)row * 2 + s];
                float o[8];
#pragma unroll
                for (int n = 0; n < 2; ++n)
#pragma unroll
                    for (int j = 0; j < 4; ++j) { const float g = acc[ai][0][m][n][j], up = acc[ai][1][m][n][j]; o[n * 4 + j] = g * sigmoid_fast(g) * up * gt; }
                u32x4 w; w.x = cvt_pk_bf16(o[0], o[1]); w.y = cvt_pk_bf16(o[2], o[3]); w.z = cvt_pk_bf16(o[4], o[5]); w.w = cvt_pk_bf16(o[6], o[7]);
                *(u32x4*)(ACT + (size_t)row * 1024 + col0) = w;
                asm volatile("" ::: "memory"); }
    }
};
}

__device__ __forceinline__ void tr_item(const float* W, int ldw, int k0, int scol0, const float* gk, bf16_t* WT, int ldo, int drow0, int dk0, LAS float* scr, int lane) {
#pragma unroll 8
    for (int i = 0; i < 32; ++i) { const int kk = 2 * i + (lane >> 5); float v = W[(size_t)(k0 + kk) * ldw + scol0 + (lane & 31)]; if (gk) v *= gk[k0 + kk]; scr[kk * 33 + (lane & 31)] = v; }
    asm volatile("s_waitcnt lgkmcnt(0)" ::: "memory");
    const int c = lane & 7;
#pragma unroll
    for (int j = 0; j < 4; ++j) { const int n = (lane >> 3) + 8 * j; const LAS float* s = scr + (8 * c) * 33 + n;
        u32x4 o; o.x = cvt_pk_bf16(s[0 * 33], s[1 * 33]); o.y = cvt_pk_bf16(s[2 * 33], s[3 * 33]); o.z = cvt_pk_bf16(s[4 * 33], s[5 * 33]); o.w = cvt_pk_bf16(s[6 * 33], s[7 * 33]);
        *(u32x4*)(WT + (size_t)(drow0 + n) * ldo + dk0 + 8 * c) = o; }
    asm volatile("s_waitcnt lgkmcnt(0)" ::: "memory");
}

constexpr size_t S5_L_STRIDE = 1310720, S5_KT = 0, S5_ET = 131072, S5_FT = 655360, S5_LAMP = 1179648;
constexpr int S5_WSCR = 8192, S5_YST = 65536, YST_LD = 264;
constexpr int NU128 = T / 128, UPB128 = SEQ / 128;
__device__ __forceinline__ f32x4 mfma16(bf16x8 a, bf16x8 b, f32x4 c) { return __builtin_amdgcn_mfma_f32_16x16x32_bf16(a, b, c, 0, 0, 0); }

__device__ __forceinline__ void s5_table_elem(int g, int e, const float* a_re, const float* a_im, const float* log_dt, const float* b_re, const float* b_im,
                                              const float* c_re, const float* c_im, const float* dvec, unsigned char* tab) {
    const float dt = expf(log_dt[g]);
    if (e < 4096) {
        const int dd = e >> 9, c = (e >> 5) & 15, ee = (e >> 4) & 1, cp = e & 15, d = dd - ee; float s = 0.f;
        if (d >= 0) {
            for (int p = 0; p < CS; ++p) { const float lr = a_re[g * CS + p], li = a_im[g * CS + p], zr = lr * dt, zi = li * dt;
                const float sh = sinf(0.5f * zi); const float nr = expm1f(zr) * cosf(zi) - 2.0f * sh * sh, ni = expf(zr) * sinf(zi), den = lr * lr + li * li;
                const float cr = (nr * lr + ni * li) / den, ci = (ni * lr - nr * li) / den;
                const float br = b_re[((size_t)g * CS + p) * CGD + cp], bi = b_im[((size_t)g * CS + p) * CGD + cp]; const float bbr = cr * br - ci * bi, bbi = cr * bi + ci * br;
                const float mag = expf(zr * (float)d), pr = mag * cosf(zi * (float)d), pi = mag * sinf(zi * (float)d);
                const float vr = pr * bbr - pi * bbi, vi = pr * bbi + pi * bbr;
                s += c_re[((size_t)g * CGD + c) * CS + p] * vr - c_im[((size_t)g * CGD + c) * CS + p] * vi; }
            if (d == 0 && c == cp) s += dvec[g * CGD + c];
        }
        ((bf16_t*)(tab + S5_KT))[(size_t)g * 4096 + e] = f2bf(s); return;
    }
    e -= 4096;
    if (e < 16384) {
        const int n = e >> 7, k = e & 127, ri = n >> 6, p = n & 63, sp = k >> 4, cp = k & 15;
        const float lr = a_re[g * CS + p], li = a_im[g * CS + p], zr = lr * dt, zi = li * dt;
        const float sh = sinf(0.5f * zi); const float nr = expm1f(zr) * cosf(zi) - 2.0f * sh * sh, ni = expf(zr) * sinf(zi), den = lr * lr + li * li;
        const float cr = (nr * lr + ni * li) / den, ci = (ni * lr - nr * li) / den;
        const float br = b_re[((size_t)g * CS + p) * CGD + cp], bi = b_im[((size_t)g * CS + p) * CGD + cp]; const float bbr = cr * br - ci * bi, bbi = cr * bi + ci * br;
        const float d = (float)(7 - sp); const float mag = expf(zr * d), pr = mag * cosf(zi * d), pi = mag * sinf(zi * d);
        ((bf16_t*)(tab + S5_ET))[(size_t)g * 16384 + e] = f2bf(ri ? (pr * bbi + pi * bbr) : (pr * bbr - pi * bbi)); return;
    }
    e -= 16384;
    if (e < 16384) {
        const int n = e >> 7, k = e & 127, tp = n >> 4, c = n & 15, ri = k >> 6, p = k & 63;
        const float lr = a_re[g * CS + p], li = a_im[g * CS + p], zr = lr * dt, zi = li * dt;
        const float d = (float)(tp + 1); const float mag = expf(zr * d), pr = mag * cosf(zi * d), pi = mag * sinf(zi * d);
        const float cre = c_re[((size_t)g * CGD + c) * CS + p], cim = c_im[((size_t)g * CGD + c) * CS + p];
        ((bf16_t*)(tab + S5_FT))[(size_t)g * 16384 + e] = f2bf(ri ? -(cre * pi + cim * pr) : (cre * pr - cim * pi)); return;
    }
    e -= 16384;
    { const int p = e; const float lr = a_re[g * CS + p], li = a_im[g * CS + p], zr = lr * dt, zi = li * dt; float* o = (float*)(tab + S5_LAMP) + ((size_t)g * CS + p) * 8;
      float mag = expf(zr); o[0] = mag * cosf(zi); o[1] = mag * sinf(zi);
      mag = expf(zr * 8.f); o[2] = mag * cosf(zi * 8.f); o[3] = mag * sinf(zi * 8.f);
      mag = expf(zr * 128.f); o[4] = mag * cosf(zi * 128.f); o[5] = mag * sinf(zi * 128.f); o[6] = 0.f; o[7] = 0.f; }
}

template <int PASS>
__device__ __forceinline__ void s5_groups(int unit, int wave, int lane, const bf16_t* Z, const unsigned char* tab, float* SEND, LAS unsigned char* lds) {
    const int ln = lane & 15, q = lane >> 4; const int t0 = unit * 128;
    const bf16_t* KT = (const bf16_t*)(tab + S5_KT); const bf16_t* ET = (const bf16_t*)(tab + S5_ET); const bf16_t* FT = (const bf16_t*)(tab + S5_FT); const float* LAMP = (const float*)(tab + S5_LAMP);
    LAS float* Sb = (LAS float*)(lds + wave * S5_WSCR); LAS bf16_t* Tb = (LAS bf16_t*)(lds + wave * S5_WSCR); LAS bf16_t* yst = (LAS bf16_t*)(lds + S5_YST);
#pragma unroll 1
    for (int gi = 0; gi < 2; ++gi) {
        const int g = wave * 2 + gi;
        bf16x8 X0, X1, X2, X3;
        { const bf16_t* zp = Z + (size_t)(t0 + ln * 8 + (q >> 1)) * INC + ZC + g * 16 + 8 * (q & 1);
          X0 = *(const bf16x8*)(zp); X1 = *(const bf16x8*)(zp + 2 * INC); X2 = *(const bf16x8*)(zp + 4 * INC); X3 = *(const bf16x8*)(zp + 6 * INC); }
        float cr = 0.f, ci = 0.f;
        if (PASS == 2) { const int u0 = unit - (unit % UPB128); const float lur = LAMP[((size_t)g * CS + lane) * 8 + 4], lui = LAMP[((size_t)g * CS + lane) * 8 + 5];
            const float* sp = SEND + (((size_t)u0 * CG + g) * 2) * CS + lane;
#pragma unroll 4
            for (int j = u0; j < unit; ++j) { const float sr = sp[0], si = sp[CS]; sp += (size_t)CG * 2 * CS;
                const float nr = lur * cr - lui * ci + sr, ni = lur * ci + lui * cr + si; cr = nr; ci = ni; } }
        { const bf16_t* ep = ET + ((size_t)(g * 128 + ln)) * 128 + 8 * q; LAS float* sw = Sb + (4 * q) * 128 + ln;
#pragma unroll 2
          for (int j = 0; j < 8; ++j) { f32x4 se = (f32x4){0.f, 0.f, 0.f, 0.f};
              const bf16x8 e0 = *(const bf16x8*)(ep), e1 = *(const bf16x8*)(ep + 32), e2 = *(const bf16x8*)(ep + 64), e3 = *(const bf16x8*)(ep + 96);
              se = mfma16(X0, e0, se); se = mfma16(X1, e1, se); se = mfma16(X2, e2, se); se = mfma16(X3, e3, se);
              sw[0] = se[0]; sw[128] = se[1]; sw[256] = se[2]; sw[384] = se[3];
              ep += 16 * 128; sw += 16; } }
        asm volatile("" ::: "memory");
        float sre[16], sim[16];
#pragma unroll
        for (int s = 0; s < 16; ++s) { sre[s] = Sb[s * 128 + lane]; sim[s] = Sb[s * 128 + 64 + lane]; }
        asm volatile("s_waitcnt lgkmcnt(0)" ::: "memory");
        const float l8r = LAMP[((size_t)g * CS + lane) * 8 + 2], l8i = LAMP[((size_t)g * CS + lane) * 8 + 3];
        float sr = cr, si = ci;
#pragma unroll
        for (int s = 0; s < 16; ++s) { if (PASS == 2) { Tb[s * 128 + lane] = f2bf(sr); Tb[s * 128 + 64 + lane] = f2bf(si); }
            const float nr = l8r * sr - l8i * si + sre[s], ni = l8r * si + l8i * sr + sim[s]; sr = nr; si = ni; }
        if (PASS == 1) { SEND[(((size_t)unit * CG + g) * 2 + 0) * CS + lane] = sr; SEND[(((size_t)unit * CG + g) * 2 + 1) * CS + lane] = si; asm volatile("" ::: "memory"); continue; }
        asm volatile("" ::: "memory");
        const bf16x8 T0 = *(const LAS bf16x8*)(Tb + ln * 128 + 8 * q), T1 = *(const LAS bf16x8*)(Tb + ln * 128 + 32 + 8 * q), T2 = *(const LAS bf16x8*)(Tb + ln * 128 + 64 + 8 * q), T3 = *(const LAS bf16x8*)(Tb + ln * 128 + 96 + 8 * q);
        { const bf16_t* fp = FT + ((size_t)(g * 128 + ln)) * 128 + 8 * q; const bf16_t* kp = KT + (((size_t)g * 8) * 16 + ln) * 32 + 8 * q; LAS bf16_t* yw = yst + (ln * 8) * YST_LD + g * 16 + 4 * q;
#pragma unroll 2
          for (int tp = 0; tp < 8; ++tp) { f32x4 acc = (f32x4){0.f, 0.f, 0.f, 0.f};
              const bf16x8 f0 = *(const bf16x8*)(fp), f1 = *(const bf16x8*)(fp + 32), f2 = *(const bf16x8*)(fp + 64), f3 = *(const bf16x8*)(fp + 96);
              const bf16x8 k0 = *(const bf16x8*)(kp + (size_t)tp * 512);
              acc = mfma16(k0, X0, acc);
              if (tp >= 2) { const bf16x8 k1 = *(const bf16x8*)(kp + (size_t)(tp - 2) * 512); acc = mfma16(k1, X1, acc); }
              if (tp >= 4) { const bf16x8 k2 = *(const bf16x8*)(kp + (size_t)(tp - 4) * 512); acc = mfma16(k2, X2, acc); }
              if (tp >= 6) { const bf16x8 k3 = *(const bf16x8*)(kp + (size_t)(tp - 6) * 512); acc = mfma16(k3, X3, acc); }
              acc = mfma16(f0, T0, acc); acc = mfma16(f1, T1, acc); acc = mfma16(f2, T2, acc); acc = mfma16(f3, T3, acc);
              u32x2 w; w.x = cvt_pk_bf16(gelu_fast(acc[0]), gelu_fast(acc[1])); w.y = cvt_pk_bf16(gelu_fast(acc[2]), gelu_fast(acc[3]));
              *(LAS u32x2*)(yw) = w;
              fp += 16 * 128; yw += YST_LD; } }
        asm volatile("s_waitcnt lgkmcnt(0)" ::: "memory");
    }
}
__device__ __forceinline__ void s5_glu(int unit, int wave, int lane, const bf16_t* WGLU, const float* glu_b, const float* mo_gc, bf16_t* Y, LAS unsigned char* lds) {
    const int ln = lane & 15, q = lane >> 4; LAS bf16_t* yst = (LAS bf16_t*)(lds + S5_YST); const int tl = 16 * wave + ln;
    bf16x8 YF[8];
#pragma unroll
    for (int ks = 0; ks < 8; ++ks) YF[ks] = *(const LAS bf16x8*)(yst + tl * YST_LD + 32 * ks + 8 * q);
    asm volatile("s_waitcnt lgkmcnt(0)" ::: "memory");
    float ss = 0.f;
    { const bf16_t* wp = WGLU + (size_t)ln * 256 + 8 * q; LAS bf16_t* yp = yst + tl * YST_LD + 4 * q; const float* bp = glu_b + 4 * q;
#pragma unroll 2
      for (int jn = 0; jn < 16; ++jn) { f32x4 a2 = (f32x4){0.f, 0.f, 0.f, 0.f};
#pragma unroll
          for (int ks = 0; ks < 8; ++ks) { const bf16x8 wf = *(const bf16x8*)(wp + 32 * ks); a2 = mfma16(wf, YF[ks], a2); }
          const u32x2 yv = *(const LAS u32x2*)(yp); const f32x4 gb = *(const f32x4*)(bp);
          f32x4 y4; y4[0] = __uint_as_float(yv.x << 16); y4[1] = __uint_as_float(yv.x & 0xffff0000u); y4[2] = __uint_as_float(yv.y << 16); y4[3] = __uint_as_float(yv.y & 0xffff0000u);
          f32x4 o;
#pragma unroll
          for (int r = 0; r < 4; ++r) { o[r] = y4[r] * sigmoid_fast(a2[r] + gb[r]); ss += o[r] * o[r]; }
          u32x2 w; w.x = cvt_pk_bf16(o[0], o[1]); w.y = cvt_pk_bf16(o[2], o[3]); *(LAS u32x2*)(yp) = w;
          wp += 16 * 256; yp += 16; bp += 16; } }
    ss += __shfl_xor(ss, 16); ss += __shfl_xor(ss, 32);
    const float rs = __builtin_amdgcn_rsqf(ss * (1.0f / CW) + EPS);
    asm volatile("s_waitcnt lgkmcnt(0)" ::: "memory");
    { bf16_t* yr = Y + (size_t)(unit * 128 + tl) * D + AW + BW + 4 * q; LAS bf16_t* yp = yst + tl * YST_LD + 4 * q; const float* gp = mo_gc + 4 * q;
#pragma unroll 4
      for (int jn = 0; jn < 16; ++jn) { const u32x2 yv = *(const LAS u32x2*)(yp); const f32x4 gg = *(const f32x4*)(gp);
          u32x2 w; w.x = cvt_pk_bf16(__uint_as_float(yv.x << 16) * rs * gg[0], __uint_as_float(yv.x & 0xffff0000u) * rs * gg[1]); w.y = cvt_pk_bf16(__uint_as_float(yv.y << 16) * rs * gg[2], __uint_as_float(yv.y & 0xffff0000u) * rs * gg[3]);
          *(u32x2*)(yr) = w; yr += 16; yp += 16; gp += 16; } }
}

constexpr int XC_LD = 392;
constexpr int RG_XC = 0, RG_PS = 100352, RG_CAR = 112640, RG_RSB = 114176;
template <int CTRL> __device__ __forceinline__ float dppf(float old, float v) { return __int_as_float(__builtin_amdgcn_update_dpp(__float_as_int(old), __float_as_int(v), CTRL, 0xf, 0xf, false)); }
__device__ __forceinline__ void bf8_to_f32(const u32x4 o, float (&v)[8]) {
    v[0] = __uint_as_float(o.x << 16); v[1] = __uint_as_float(o.x & 0xffff0000u); v[2] = __uint_as_float(o.y << 16); v[3] = __uint_as_float(o.y & 0xffff0000u);
    v[4] = __uint_as_float(o.z << 16); v[5] = __uint_as_float(o.z & 0xffff0000u); v[6] = __uint_as_float(o.w << 16); v[7] = __uint_as_float(o.w & 0xffff0000u);
}
template <int PASS>
__device__ __forceinline__ void rglru_unit(int unit, int tid, int wave, int lane, const bf16_t* Z, bf16_t* Y, const bf16_t* WRG, const bf16_t* WIG,
                                           const float* conv_w, const float* conv_b, const float* rg_b, const float* ig_b, const float* lam, const float* mo_gb,
                                           float* SUMA, float* SUMH, LAS unsigned char* lds) {
    LAS bf16_t* xcl = (LAS bf16_t*)(lds + RG_XC); LAS float* PS = (LAS float*)(lds + RG_PS); LAS float* CAR = (LAS float*)(lds + RG_CAR); LAS float* RSB = (LAS float*)(lds + RG_RSB);
    const int t0 = unit * 128; const int ln = lane & 15, q = lane >> 4;
    if (tid < 384) {
        const int c0 = (tid % 48) * 8, tg = tid / 48; const int tb = t0 + tg * 16, s0 = tb % SEQ;
        float w0[8], w1[8], w2[8], w3[8], bb[8];
#pragma unroll
        for (int hh = 0; hh < 2; ++hh) { const f32x4 a0 = *(const f32x4*)(conv_w + 0 * BW + c0 + 4 * hh), a1 = *(const f32x4*)(conv_w + 1 * BW + c0 + 4 * hh), a2 = *(const f32x4*)(conv_w + 2 * BW + c0 + 4 * hh), a3 = *(const f32x4*)(conv_w + 3 * BW + c0 + 4 * hh), a4 = *(const f32x4*)(conv_b + c0 + 4 * hh);
#pragma unroll
            for (int j = 0; j < 4; ++j) { w0[4 * hh + j] = a0[j]; w1[4 * hh + j] = a1[j]; w2[4 * hh + j] = a2[j]; w3[4 * hh + j] = a3[j]; bb[4 * hh + j] = a4[j]; } }
        float xm1[8], xm2[8], xm3[8];
        const bf16_t* zp = Z + (size_t)tb * INC + ZX + c0;
        { const u32x4 z4 = {0u, 0u, 0u, 0u}; const u32x4 o1 = s0 >= 1 ? *(const u32x4*)(zp - INC) : z4, o2 = s0 >= 2 ? *(const u32x4*)(zp - 2 * INC) : z4, o3 = s0 >= 3 ? *(const u32x4*)(zp - 3 * INC) : z4;
          bf8_to_f32(o1, xm1); bf8_to_f32(o2, xm2); bf8_to_f32(o3, xm3); }
        LAS bf16_t* xw = xcl + (tg * 16) * XC_LD + c0;
#pragma unroll 4
        for (int i = 0; i < 16; ++i) { float x0[8]; bf8_to_f32(*(const u32x4*)(zp), x0); float v[8];
#pragma unroll
            for (int j = 0; j < 8; ++j) { v[j] = bb[j] + w3[j] * x0[j] + w2[j] * xm1[j] + w1[j] * xm2[j] + w0[j] * xm3[j]; xm3[j] = xm2[j]; xm2[j] = xm1[j]; xm1[j] = x0[j]; }
            u32x4 w; w.x = cvt_pk_bf16(v[0], v[1]); w.y = cvt_pk_bf16(v[2], v[3]); w.z = cvt_pk_bf16(v[4], v[5]); w.w = cvt_pk_bf16(v[6], v[7]);
            *(LAS u32x4*)(xw) = w; zp += INC; xw += XC_LD; }
        if (PASS == 2) { const int c = tid, u0 = unit - (unit % UPB128); float h = 0.f; const float* pa = SUMA + (size_t)u0 * BW + c; const float* ph = SUMH + (size_t)u0 * BW + c;
#pragma unroll 4
            for (int j = u0; j < unit; ++j) { h = fmaf(*pa, h, *ph); pa += BW; ph += BW; }
            CAR[c] = h; }
    }
    __syncthreads();
#pragma unroll 1
    for (int ci = 0; ci < 3; ++ci) {
        const int combo = wave + 8 * ci, h = combo >> 2, jt = combo & 3, cb = h * 64 + jt * 16;
        const bf16_t* wr = WRG + ((size_t)(h * 64 + jt * 16 + ln)) * 64 + 8 * q; const bf16_t* wi = WIG + ((size_t)(h * 64 + jt * 16 + ln)) * 64 + 8 * q;
        const bf16x8 RG0 = *(const bf16x8*)(wr), RG1 = *(const bf16x8*)(wr + 32), IG0 = *(const bf16x8*)(wi), IG1 = *(const bf16x8*)(wi + 32);
        const f32x4 rgb4 = *(const f32x4*)(rg_b + cb + 4 * q), igb4 = *(const f32x4*)(ig_b + cb + 4 * q), lam4 = *(const f32x4*)(lam + cb + 4 * q);
        float spc[4], car[4], ptot[4];
#pragma unroll
        for (int r = 0; r < 4; ++r) { spc[r] = -8.0f * 1.4426950408889634f * log1pf(expf(-lam4[r])); car[r] = PASS == 2 ? CAR[cb + 4 * q + r] : 0.f; ptot[r] = 1.f; }
        const LAS bf16_t* xb = xcl + ln * XC_LD + h * 64 + 8 * q; const LAS bf16_t* xv = xcl + ln * XC_LD + cb + 4 * q;
        const bf16_t* zg = Z + (size_t)(t0 + ln) * INC + ZG + cb + 4 * q; bf16_t* yo = Y + (size_t)(t0 + ln) * D + AW + cb + 4 * q; LAS float* psw = PS + ln * 24 + combo;
#pragma unroll 1
        for (int tt = 0; tt < 8; ++tt) {
            const bf16x8 B0 = *(const LAS bf16x8*)(xb), B1 = *(const LAS bf16x8*)(xb + 32);
            f32x4 ar = (f32x4){0.f, 0.f, 0.f, 0.f}, ai = (f32x4){0.f, 0.f, 0.f, 0.f};
            ar = mfma16(RG0, B0, ar); ar = mfma16(RG1, B1, ar); ai = mfma16(IG0, B0, ai); ai = mfma16(IG1, B1, ai);
            const u32x2 xq = *(const LAS u32x2*)(xv); float xc4[4] = {__uint_as_float(xq.x << 16), __uint_as_float(xq.x & 0xffff0000u), __uint_as_float(xq.y << 16), __uint_as_float(xq.y & 0xffff0000u)};
            float hv[4];
#pragma unroll
            for (int r = 0; r < 4; ++r) {
                const float rr = sigmoid_fast(ar[r] + rgb4[r]), ii = sigmoid_fast(ai[r] + igb4[r]);
                float A = __builtin_amdgcn_exp2f(spc[r] * rr);
                float Bv = __builtin_amdgcn_sqrtf(fmaxf(1.0f - A * A, 0.f)) * (ii * xc4[r]);
                if (ln == 0) Bv = fmaf(A, car[r], Bv);
                { const float As = dppf<0x111>(1.0f, A), Bs = dppf<0x111>(0.0f, Bv); Bv = fmaf(A, Bs, Bv); A *= As; }
                { const float As = dppf<0x112>(1.0f, A), Bs = dppf<0x112>(0.0f, Bv); Bv = fmaf(A, Bs, Bv); A *= As; }
                { const float As = dppf<0x114>(1.0f, A), Bs = dppf<0x114>(0.0f, Bv); Bv = fmaf(A, Bs, Bv); A *= As; }
                { const float As = dppf<0x118>(1.0f, A), Bs = dppf<0x118>(0.0f, Bv); Bv = fmaf(A, Bs, Bv); A *= As; }
                hv[r] = Bv; car[r] = dppf<0x121>(Bv, Bv);
                if (PASS == 1) ptot[r] *= dppf<0x121>(A, A);
            }
            if (PASS == 2) { const u32x2 gq = *(const u32x2*)(zg);
                const float y0 = hv[0] * __uint_as_float(gq.x << 16), y1 = hv[1] * __uint_as_float(gq.x & 0xffff0000u), y2 = hv[2] * __uint_as_float(gq.y << 16), y3 = hv[3] * __uint_as_float(gq.y & 0xffff0000u);
                u32x2 w; w.x = cvt_pk_bf16(y0, y1); w.y = cvt_pk_bf16(y2, y3); *(u32x2*)(yo) = w;
                float ss = (y0 * y0 + y1 * y1) + (y2 * y2 + y3 * y3); ss += __shfl_xor(ss, 16); ss += __shfl_xor(ss, 32);
                if (q == 0) *psw = ss; }
            xb += 16 * XC_LD; xv += 16 * XC_LD; zg += 16 * INC; yo += 16 * D; psw += 16 * 24;
        }
        if (PASS == 1 && ln == 0) {
#pragma unroll
            for (int r = 0; r < 4; ++r) { SUMA[(size_t)unit * BW + cb + 4 * q + r] = ptot[r]; SUMH[(size_t)unit * BW + cb + 4 * q + r] = car[r]; } }
    }
    if (PASS == 2) {
        asm volatile("s_waitcnt vmcnt(0)" ::: "memory");
        __syncthreads();
        if (tid < 128) { float s = 0.f;
#pragma unroll
            for (int k = 0; k < 24; ++k) s += PS[tid * 24 + k];
            RSB[tid] = __builtin_amdgcn_rsqf(s * (1.0f / BW) + EPS); }
        __syncthreads();
#pragma unroll 2
        for (int k = 0; k < 12; ++k) { const int idx = tid + 512 * k, tl = idx / 48, c0 = (idx % 48) * 8; const float rs = RSB[tl];
            bf16_t* yp = Y + (size_t)(t0 + tl) * D + AW + c0; float v[8]; bf8_to_f32(*(const u32x4*)(yp), v);
            const f32x4 g0 = *(const f32x4*)(mo_gb + c0), g1 = *(const f32x4*)(mo_gb + c0 + 4);
            u32x4 w; w.x = cvt_pk_bf16(v[0] * rs * g0[0], v[1] * rs * g0[1]); w.y = cvt_pk_bf16(v[2] * rs * g0[2], v[3] * rs * g0[3]); w.z = cvt_pk_bf16(v[4] * rs * g1[0], v[5] * rs * g1[1]); w.w = cvt_pk_bf16(v[6] * rs * g1[2], v[7] * rs * g1[3]);
            *(u32x4*)(yp) = w; }
    }
    __syncthreads();
}

constexpr int VT_LD = 136;
__device__ __forceinline__ void mixa_unit(int unit, int tid, int wave, int lane, const bf16_t* Z, bf16_t* Y, const bf16_t* WSP, const float* a_sb, const float* vg, const float* mo_ga, LAS unsigned char* lds) {
    LAS bf16_t* vT = (LAS bf16_t*)lds; const int t0 = unit * 128; const int ln = lane & 15, q = lane >> 4;
    { const int j = tid >> 2, part = tid & 3; const bf16_t* zp = Z + (size_t)(t0 + j) * INC + ZV + part * 96;
      u32x4 raw[12]; float ss = 0.f;
#pragma unroll
      for (int k = 0; k < 12; ++k) { raw[k] = *(const u32x4*)(zp + 8 * k); float v[8]; bf8_to_f32(raw[k], v);
#pragma unroll
          for (int e = 0; e < 8; ++e) ss += v[e] * v[e]; }
      ss += __shfl_xor(ss, 1); ss += __shfl_xor(ss, 2);
      const float rs = __builtin_amdgcn_rsqf(ss * (1.0f / AW) + EPS);
      LAS bf16_t* vw = vT + (part * 96) * VT_LD + j; const float* gp = vg + part * 96;
#pragma unroll
      for (int k = 0; k < 12; ++k) { float v[8]; bf8_to_f32(raw[k], v); const f32x4 g0 = *(const f32x4*)(gp + 8 * k), g1 = *(const f32x4*)(gp + 8 * k + 4);
#pragma unroll
          for (int e = 0; e < 8; ++e) vw[(8 * k + e) * VT_LD] = f2bf(v[e] * rs * (e < 4 ? g0[e] : g1[e - 4])); } }
    __syncthreads();
    const bool full = wave >= 4;
    float ss = 0.f;
    const int tl = 16 * wave + ln;
    { const bf16_t* wp = WSP + (size_t)tl * 128 + 8 * q; const float* bp = a_sb + tl; const bf16_t* up = Z + (size_t)(t0 + tl) * INC + ZU + 4 * q;
      bf16_t* yw = Y + (size_t)(t0 + tl) * D + 4 * q; const LAS bf16_t* ap = vT + ln * VT_LD + 8 * q;
#pragma unroll 1
      for (int h = 0; h < 6; ++h) {
          const bf16x8 z8 = {0, 0, 0, 0, 0, 0, 0, 0};
          const bf16x8 W0 = *(const bf16x8*)(wp), W1 = *(const bf16x8*)(wp + 32); bf16x8 W2 = z8, W3 = z8;
          if (full) { W2 = *(const bf16x8*)(wp + 64); W3 = *(const bf16x8*)(wp + 96); }
          const float bias = *bp;
#pragma unroll 2
          for (int dt = 0; dt < 4; ++dt) { f32x4 acc = (f32x4){0.f, 0.f, 0.f, 0.f};
              const bf16x8 a0 = *(const LAS bf16x8*)(ap), a1 = *(const LAS bf16x8*)(ap + 32), a2 = *(const LAS bf16x8*)(ap + 64), a3 = *(const LAS bf16x8*)(ap + 96);
              acc = mfma16(a0, W0, acc); acc = mfma16(a1, W1, acc); acc = mfma16(a2, W2, acc); acc = mfma16(a3, W3, acc);
              const u32x2 uq = *(const u32x2*)(up);
              const float v0 = __uint_as_float(uq.x << 16) * (acc[0] + bias), v1 = __uint_as_float(uq.x & 0xffff0000u) * (acc[1] + bias), v2 = __uint_as_float(uq.y << 16) * (acc[2] + bias), v3 = __uint_as_float(uq.y & 0xffff0000u) * (acc[3] + bias);
              ss += (v0 * v0 + v1 * v1) + (v2 * v2 + v3 * v3);
              u32x2 pk; pk.x = cvt_pk_bf16(v0, v1); pk.y = cvt_pk_bf16(v2, v3); *(u32x2*)(yw) = pk;
              ap += 16 * VT_LD; up += 16; yw += 16; }
          wp += 128 * 128; bp += 128; } }
    ss += __shfl_xor(ss, 16); ss += __shfl_xor(ss, 32);
    const float rs = __builtin_amdgcn_rsqf(ss * (1.0f / AW) + EPS);
    asm volatile("s_waitcnt vmcnt(0)" ::: "memory");
    { bf16_t* yr = Y + (size_t)(t0 + tl) * D + 4 * q; const float* gp = mo_ga + 4 * q;
#pragma unroll 4
      for (int k = 0; k < 24; ++k) { const u32x2 pk = *(const u32x2*)(yr); const f32x4 gg = *(const f32x4*)(gp);
          u32x2 w; w.x = cvt_pk_bf16(__uint_as_float(pk.x << 16) * rs * gg[0], __uint_as_float(pk.x & 0xffff0000u) * rs * gg[1]); w.y = cvt_pk_bf16(__uint_as_float(pk.y << 16) * rs * gg[2], __uint_as_float(pk.y & 0xffff0000u) * rs * gg[3]);
          *(u32x2*)(yr) = w; yr += 16; gp += 16; } }
    __syncthreads();
}

struct Args { const float* in[34]; float* out; unsigned char* ws; };

__global__ void __launch_bounds__(512, 2) mega_fwd(Args a) {
    extern __shared__ __attribute__((aligned(16))) unsigned char lds_raw[];
    LAS unsigned char* lds = (LAS unsigned char*)lds_raw;
    volatile LAS unsigned* LW = (volatile LAS unsigned*)(lds + LDSCTL_OFF);
    volatile LAS int* LWI = (volatile LAS int*)(lds + LDSCTL_OFF);
    const int G = gridDim.x, bid = blockIdx.x;
#define PHASE_IDS() int tid = threadIdx.x; asm volatile("" : "+v"(tid)); const int lane = tid & 63, wave = __builtin_amdgcn_readfirstlane(tid >> 6); const int gw = bid * 8 + wave, NGW = G * 8; \
    const size_t gt = (size_t)bid * 512 + tid, NGT = (size_t)G * 512; (void)lane; (void)wave; (void)gw; (void)NGW; (void)gt; (void)NGT
#define WSB() ({ unsigned char* _w = a.ws; asm volatile("" : "+s"(_w)); _w; })
#define INP(i) ({ int _k = (i); asm volatile("" : "+s"(_k)); a.in[_k]; })
    for (int u = threadIdx.x; u < (LDS_BYTES - LDSCTL_OFF) / 4; u += 512) LW[u] = 0u;
    __syncthreads();
    XcdBarrier bar = xcd_barrier_post((unsigned*)(a.ws + WS_CTL) + CW_BAR, LW + LW_BAR);

    {
        PHASE_IDS(); unsigned char* ws = WSB(); bf16_t* WIN = (bf16_t*)(ws + WS_WIN); bf16_t* WOUT = (bf16_t*)(ws + WS_WOUT); bf16_t* WGU = (bf16_t*)(ws + WS_WGU); bf16_t* WD2 = (bf16_t*)(ws + WS_WD2);
        bf16_t* HB = (bf16_t*)(ws + WS_HB); float* SSQ = (float*)(ws + WS_SSQ);
        LAS float* scr = (LAS float*)(lds + wave * 16384);
        constexpr int I_IN = 16 * 56, I_OUT = 16 * 32, I_GU = 2 * 16 * 256, I_D2 = 48 * 256, I_GLU = 32, I_RG = 24, I_L = I_IN + I_OUT + I_GU + I_D2 + I_GLU + I_RG;
        for (int it = gw; it < 2 * I_L; it += NGW) {
            const int l = it / I_L; int r = it % I_L;
            if (r < I_IN) { const int kb = r / 56, nb = r % 56, j0 = nb * 32; const int sc = j0 < 768 ? j0 : (j0 < 1152 ? j0 + 384 : (j0 < 1536 ? j0 - 384 : j0));
                tr_item(INP(2) + (size_t)l * D * INC, INC, kb * 64, sc, INP(1) + (size_t)l * D, WIN + (size_t)l * INC * D, D, j0, kb * 64, scr, lane); continue; }
            r -= I_IN;
            if (r < I_OUT) { const int kb = r / 32, nb = r % 32; tr_item(INP(24) + (size_t)l * D * D, D, kb * 64, nb * 32, nullptr, WOUT + (size_t)l * D * D, D, nb * 32, kb * 64, scr, lane); continue; }
            r -= I_OUT;
            if (r < I_GU) { const int which = r / (16 * 256), e = (r / 256) % 16, q = r % 256, kb = q / 16, nb = q % 16, n0 = nb * 32;
                const float* src = INP(30 + which) + ((size_t)l * NE + e) * D * DE;
                tr_item(src, DE, kb * 64, n0, nullptr, WGU + ((size_t)l * NE + e) * 1024 * 1024, 1024, (n0 / 128) * 256 + which * 128 + (n0 % 128), kb * 64, scr, lane); continue; }
            r -= I_GU;
            if (r >= I_D2 + I_GLU) { r -= I_D2 + I_GLU; const int gate = r / 12, h = (r / 2) % 6, nb = r & 1;
                tr_item(INP(gate ? 10 : 8) + ((size_t)l * 6 + h) * 64 * 64, 64, 0, nb * 32, nullptr, (bf16_t*)(ws + WS_WRG) + (((size_t)l * 2 + gate) * 6 + h) * 64 * 64, 64, nb * 32, 0, scr, lane); continue; }
            if (r >= I_D2) { r -= I_D2; const int kb = r / 8, nb = r % 8; tr_item(INP(21) + (size_t)l * CW * CW, CW, kb * 64, nb * 32, nullptr, (bf16_t*)(ws + WS_WGLU) + (size_t)l * CW * CW, CW, nb * 32, kb * 64, scr, lane); continue; }
            { const int ch = r / 256, cls = ch >> 1, half = ch & 1, q = r % 256, kb = q / 32, nb = q % 32; const int g = cls / 6, pi = cls % 6, e = g * 4 + (half ? pair_hi(pi) : pair_lo(pi));
                tr_item(INP(32) + ((size_t)l * NE + e) * DE * D, D, kb * 64, nb * 32, nullptr, WD2 + ((size_t)l * NCLS + cls) * 1024 * 1024, 1024, nb * 32, half * 512 + kb * 64, scr, lane); }
        }
        { const float* s_are = INP(13); const float* s_aim = INP(14); const float* s_ldt = INP(15); const float* s_bre = INP(16); const float* s_bim = INP(17); const float* s_cre = INP(18); const float* s_cim = INP(19); const float* s_d = INP(20);
          for (size_t e = gt; e < (size_t)2 * CG * 36928; e += NGT) { const int l = (int)(e / (CG * 36928)), g = (int)((e / 36928) % CG), el = (int)(e % 36928);
              s5_table_elem(g, el, s_are + (size_t)l * CG * CS, s_aim + (size_t)l * CG * CS, s_ldt + (size_t)l * CG, s_bre + (size_t)l * CG * CS * CGD, s_bim + (size_t)l * CG * CS * CGD,
                            s_cre + (size_t)l * CG * CGD * CS, s_cim + (size_t)l * CG * CGD * CS, s_d + (size_t)l * CW, ws + WS_S5 + (size_t)l * S5_L_STRIDE); } }
        { const float* sw = INP(4); bf16_t* wsp = (bf16_t*)(ws + WS_WSP); for (size_t e = gt; e < (size_t)2 * 6 * 128 * 128; e += NGT) wsp[e] = f2bf(sw[e]); }
        const float* xin = INP(0);
        for (int t = gw; t < T; t += NGW) {
            const f32x4* xr = (const f32x4*)(xin + (size_t)t * D) + lane; f32x4 v[4]; float s = 0.f;
#pragma unroll
            for (int j = 0; j < 4; ++j) { v[j] = xr[64 * j]; s += (v[j][0] * v[j][0] + v[j][1] * v[j][1]) + (v[j][2] * v[j][2] + v[j][3] * v[j][3]); }
            s = wave_sum(s);
            u32x2* o8 = (u32x2*)(HB + (size_t)t * D) + lane;
#pragma unroll
            for (int j = 0; j < 4; ++j) { u32x2 w; w.x = cvt_pk_bf16(v[j][0], v[j][1]); w.y = cvt_pk_bf16(v[j][2], v[j][3]); o8[64 * j] = w; }
            if (lane < 16) SSQ[(size_t)t * 16 + lane] = lane == 0 ? s : 0.f;
        }
    }
    xcd_barrier(bar);

    for (int l = 0; l < DEPTH; ++l) {
        { PHASE_IDS(); unsigned char* ws = WSB(); bf16_t* WIN = (bf16_t*)(ws + WS_WIN); bf16_t* HB = (bf16_t*)(ws + WS_HB); float* SSQ = (float*)(ws + WS_SSQ); bf16_t* Z = (bf16_t*)(ws + WS_Z);
          pg8::StaticOrder<T, INC> S; S.init(HB, WIN + (size_t)l * INC * D, G, bid);
          pg8::EpiZ E{Z, SSQ};
          pg8::gemm_phase<pg8::EpiZ, pg8::StaticOrder<T, INC>, true, true>(lds, D, S, E); }
        xcd_barrier(bar);

        {
            PHASE_IDS(); unsigned char* ws = WSB(); const bf16_t* Z = (const bf16_t*)(ws + WS_Z);
            const float* conv_w = INP(6) + (size_t)l * 4 * BW; const float* conv_b = INP(7) + (size_t)l * BW; const float* rg_b = INP(9) + (size_t)l * BW;
            const float* ig_b = INP(11) + (size_t)l * BW; const float* lam = INP(12) + (size_t)l * BW;
            __syncthreads();
            { const bf16_t* WRG = (const bf16_t*)(ws + WS_WRG) + ((size_t)l * 2 + 0) * 6 * 4096; const bf16_t* WIG = (const bf16_t*)(ws + WS_WRG) + ((size_t)l * 2 + 1) * 6 * 4096;
              for (int u = bid; u < NU128; u += G) rglru_unit<1>(u, tid, wave, lane, Z, nullptr, WRG, WIG, conv_w, conv_b, rg_b, ig_b, lam, nullptr, (float*)(ws + WS_SUMA), (float*)(ws + WS_SUMH), lds); }
            for (int u = bid; u < NU128; u += G) s5_groups<1>(u, wave, lane, Z, ws + WS_S5 + (size_t)l * S5_L_STRIDE, (float*)(ws + WS_SEND), lds);
            __syncthreads();
            { const bf16_t* WSP = (const bf16_t*)(ws + WS_WSP) + (size_t)l * 6 * 128 * 128; const float* a_sb = INP(5) + (size_t)l * 6 * 128; const float* vg = INP(3) + (size_t)l * AW; const float* mo_ga = INP(23) + (size_t)l * D;
              for (int u = bid; u < NU128; u += G) mixa_unit(u, tid, wave, lane, Z, (bf16_t*)(ws + WS_Y), WSP, a_sb, vg, mo_ga, lds); }
        }
        xcd_barrier(bar);

        {
            PHASE_IDS(); unsigned char* ws = WSB(); const bf16_t* Z = (const bf16_t*)(ws + WS_Z); bf16_t* Y = (bf16_t*)(ws + WS_Y);
            const float* a_v_norm_g = INP(3) + (size_t)l * AW; const float* a_sw = INP(4) + (size_t)l * 6 * 128 * 128; const float* a_sb = INP(5) + (size_t)l * 6 * 128;
        }

        { PHASE_IDS(); unsigned char* ws = WSB(); const bf16_t* Z = (const bf16_t*)(ws + WS_Z); bf16_t* Y = (bf16_t*)(ws + WS_Y);
          { const bf16_t* WRG = (const bf16_t*)(ws + WS_WRG) + ((size_t)l * 2 + 0) * 6 * 4096; const bf16_t* WIG = (const bf16_t*)(ws + WS_WRG) + ((size_t)l * 2 + 1) * 6 * 4096;
            const float* conv_w = INP(6) + (size_t)l * 4 * BW; const float* conv_b = INP(7) + (size_t)l * BW; const float* rg_b = INP(9) + (size_t)l * BW; const float* ig_b = INP(11) + (size_t)l * BW; const float* lam = INP(12) + (size_t)l * BW;
            const float* mo_gb = INP(23) + (size_t)l * D + AW;
            __syncthreads();
            for (int u = bid; u < NU128; u += G) rglru_unit<2>(u, tid, wave, lane, Z, Y, WRG, WIG, conv_w, conv_b, rg_b, ig_b, lam, mo_gb, (float*)(ws + WS_SUMA), (float*)(ws + WS_SUMH), lds); }
          { const bf16_t* WGLU = (const bf16_t*)(ws + WS_WGLU) + (size_t)l * CW * CW; const float* glu_b = INP(22) + (size_t)l * CW; const float* mo_gc = INP(23) + (size_t)l * D + AW + BW;
            for (int u = bid; u < NU128; u += G) { __syncthreads(); s5_groups<2>(u, wave, lane, Z, ws + WS_S5 + (size_t)l * S5_L_STRIDE, (float*)(ws + WS_SEND), lds); __syncthreads(); s5_glu(u, wave, lane, WGLU, glu_b, mo_gc, Y, lds); } } }
        xcd_barrier(bar);

        { PHASE_IDS(); unsigned char* ws = WSB(); bf16_t* WOUT = (bf16_t*)(ws + WS_WOUT); bf16_t* HB = (bf16_t*)(ws + WS_HB); float* SSQ = (float*)(ws + WS_SSQ); bf16_t* Y = (bf16_t*)(ws + WS_Y);
          pg8::StaticOrder<T, D> S; S.init(Y, WOUT + (size_t)l * D * D, G, bid);
          pg8::EpiRes<false> E{HB, SSQ, nullptr};
          pg8::gemm_phase<pg8::EpiRes<false>, pg8::StaticOrder<T, D>, true, true>(lds, D, S, E); }
        xcd_barrier(bar);

        { PHASE_IDS(); unsigned char* ws = WSB(); const bf16_t* HB = (const bf16_t*)(ws + WS_HB); const float* SSQ = (const float*)(ws + WS_SSQ); int* CLS = (int*)(ws + WS_CLS); float* G2 = (float*)(ws + WS_G2); int* HIST = (int*)(ws + WS_HIST);
          const float* ffn_g = INP(25) + (size_t)l * D; const float* rgw = INP(26) + (size_t)l * D * 4; const float* rgb = INP(27) + (size_t)l * 4; const float* rew = INP(28) + (size_t)l * 4 * D * 4; const float* reb = INP(29) + (size_t)l * 16;
        for (int u = bid; u < NU; u += G) {
            for (int i = 0; i < 32; ++i) { const int t = u * UT + wave * 32 + i;
                float sq = lane < 16 ? SSQ[(size_t)t * 16 + lane] : 0.f; sq = wave_sum(sq); const float r = rsqrtf(sq * (1.0f / D) + EPS);
                const bf16_t* hr = HB + (size_t)t * D; float hn[16];
#pragma unroll
                for (int j = 0; j < 16; ++j) { const int d = lane + 64 * j; hn[j] = bf2f(hr[d]) * r * ffn_g[d]; }
                float gl[4] = {0.f, 0.f, 0.f, 0.f};
#pragma unroll
                for (int j = 0; j < 16; ++j) { const f32x4 w = *(const f32x4*)(rgw + (size_t)(lane + 64 * j) * 4); gl[0] = fmaf(hn[j], w[0], gl[0]); gl[1] = fmaf(hn[j], w[1], gl[1]); gl[2] = fmaf(hn[j], w[2], gl[2]); gl[3] = fmaf(hn[j], w[3], gl[3]); }
#pragma unroll
                for (int j = 0; j < 4; ++j) gl[j] = wave_sum(gl[j]) + rgb[j];
                int gs = 0; float gm = gl[0];
#pragma unroll
                for (int j = 1; j < 4; ++j) if (gl[j] > gm) { gm = gl[j]; gs = j; }
                float den = 0.f;
#pragma unroll
                for (int j = 0; j < 4; ++j) den += expf(gl[j] - gm);
                const float gwt = 1.0f / den;
                float el[4] = {0.f, 0.f, 0.f, 0.f}; const float* w4 = rew + (size_t)gs * D * 4;
#pragma unroll
                for (int j = 0; j < 16; ++j) { const f32x4 w = *(const f32x4*)(w4 + (size_t)(lane + 64 * j) * 4); el[0] = fmaf(hn[j], w[0], el[0]); el[1] = fmaf(hn[j], w[1], el[1]); el[2] = fmaf(hn[j], w[2], el[2]); el[3] = fmaf(hn[j], w[3], el[3]); }
#pragma unroll
                for (int j = 0; j < 4; ++j) el[j] = wave_sum(el[j]) + reb[gs * 4 + j];
                int i0 = 0; float v0 = el[0];
#pragma unroll
                for (int j = 1; j < 4; ++j) if (el[j] > v0) { v0 = el[j]; i0 = j; }
                int i1 = 0; float v1 = -3.0e38f;
#pragma unroll
                for (int j = 0; j < 4; ++j) if (j != i0 && el[j] > v1) { v1 = el[j]; i1 = j; }
                const float e1 = expf(v1 - v0); const float w0 = gwt / (1.0f + e1), w1 = gwt * e1 / (1.0f + e1);
                const int lo = i0 < i1 ? i0 : i1, hi = i0 < i1 ? i1 : i0; const int cls = gs * 6 + pair_idx(lo, hi);
                if (lane == 0) { CLS[t] = cls; G2[(size_t)t * 2 + 0] = i0 < i1 ? w0 : w1; G2[(size_t)t * 2 + 1] = i0 < i1 ? w1 : w0; __hip_atomic_fetch_add((LAS int*)(lds + LDSCTL_OFF) + LW_HIST + cls, 1, __ATOMIC_RELAXED, __HIP_MEMORY_SCOPE_WORKGROUP); }
            }
            __syncthreads();
            if (tid < 32) { HIST[u * 32 + tid] = tid < NCLS ? LWI[LW_HIST + tid] : 0; LWI[LW_HIST + tid] = 0; }
            __syncthreads();
        } }
        xcd_barrier(bar);

        { PHASE_IDS(); unsigned char* ws = WSB(); const bf16_t* HB = (const bf16_t*)(ws + WS_HB); const float* SSQ = (const float*)(ws + WS_SSQ); const int* CLS = (const int*)(ws + WS_CLS); const float* G2 = (const float*)(ws + WS_G2); const int* HIST = (const int*)(ws + WS_HIST);
          int* CTOT = (int*)(ws + WS_CTOT); int* ROWTOK = (int*)(ws + WS_ROWTOK); float* ROWG = (float*)(ws + WS_ROWG); bf16_t* HBS = (bf16_t*)(ws + WS_HBS); const float* ffn_g = INP(25) + (size_t)l * D;
        for (int u = bid; u < NU; u += G) {
            if (tid < NCLS) { int tot = 0, pre = 0;
_Pragma("unroll 4")
                for (int k = 0; k < NU; ++k) { const int v = HIST[k * 32 + tid]; tot += v; pre += k < u ? v : 0; } LWI[LW_TOT + tid] = tot; LWI[LW_BASE + tid] = pre; }
            __syncthreads();
            if (tid == 0) { int ps = 0;
_Pragma("unroll 1")
                for (int c = 0; c < NCLS; ++c) { const int tot = LWI[LW_TOT + c]; LWI[LW_BASE + c] += ps; LWI[LW_TST + c] = ps; ps += ((tot + 255) >> 8) << 8; if (bid == 0) CTOT[c] = tot; } LWI[LW_TST + NCLS] = ps; }
            if (tid < UT) LWI[LW_CLS + tid] = CLS[u * UT + tid];
            __syncthreads();
            if (tid < UT) { const int cls = LWI[LW_CLS + tid]; int rank = 0;
_Pragma("unroll 1")
                for (int i = 0; i < tid; ++i) rank += LWI[LW_CLS + i] == cls ? 1 : 0;
                const int dest = LWI[LW_BASE + cls] + rank; LWI[LW_DEST + tid] = dest; const int t = u * UT + tid;
                ROWTOK[dest] = t; ROWG[(size_t)dest * 2 + 0] = G2[(size_t)t * 2 + 0]; ROWG[(size_t)dest * 2 + 1] = G2[(size_t)t * 2 + 1]; }
            __syncthreads();
            for (int i = 0; i < 32; ++i) { const int tl = wave * 32 + i, t = u * UT + tl, dest = LWI[LW_DEST + tl];
                float sq = lane < 16 ? SSQ[(size_t)t * 16 + lane] : 0.f; sq = wave_sum(sq); const float r = rsqrtf(sq * (1.0f / D) + EPS);
#pragma unroll
                for (int hh = 0; hh < 2; ++hh) { const int d0 = hh * 512 + lane * 8; const u32x4 o = *(const u32x4*)(HB + (size_t)t * D + d0);
                    const f32x4 g0 = *(const f32x4*)(ffn_g + d0), g1 = *(const f32x4*)(ffn_g + d0 + 4);
                    u32x4 w; w.x = cvt_pk_bf16(__uint_as_float(o.x << 16) * r * g0[0], __uint_as_float(o.x & 0xffff0000u) * r * g0[1]);
                    w.y = cvt_pk_bf16(__uint_as_float(o.y << 16) * r * g0[2], __uint_as_float(o.y & 0xffff0000u) * r * g0[3]);
                    w.z = cvt_pk_bf16(__uint_as_float(o.z << 16) * r * g1[0], __uint_as_float(o.z & 0xffff0000u) * r * g1[1]);
                    w.w = cvt_pk_bf16(__uint_as_float(o.w << 16) * r * g1[2], __uint_as_float(o.w & 0xffff0000u) * r * g1[3]);
                    *(u32x4*)(HBS + (size_t)dest * D + d0) = w; } }
            if (u == bid)
_Pragma("unroll 1")
            for (int c = bid; c < NCLS; c += G) { const int tot = LWI[LW_TOT + c], r0 = LWI[LW_TST + c] + tot, r1 = LWI[LW_TST + c + 1];
                for (int r = r0 + wave; r < r1; r += 8) { if (lane == 0) { ROWTOK[r] = -1; ROWG[(size_t)r * 2] = 0.f; ROWG[(size_t)r * 2 + 1] = 0.f; }
                    *(u32x4*)(HBS + (size_t)r * D + lane * 8) = (u32x4){0u, 0u, 0u, 0u}; *(u32x4*)(HBS + (size_t)r * D + 512 + lane * 8) = (u32x4){0u, 0u, 0u, 0u}; } }
            __syncthreads();
        } }
        xcd_barrier(bar);

        { PHASE_IDS(); unsigned char* ws = WSB(); const int* CTOT = (const int*)(ws + WS_CTOT); bf16_t* HBS = (bf16_t*)(ws + WS_HBS); bf16_t* WGU = (bf16_t*)(ws + WS_WGU); bf16_t* ACT = (bf16_t*)(ws + WS_ACT); const float* ROWG = (const float*)(ws + WS_ROWG);
        if (tid == 0) { int ps = 0;
_Pragma("unroll 1")
            for (int c = 0; c < NCLS; ++c) { LWI[LW_TST + c] = ps; ps += (CTOT[c] + 255) >> 8; } LWI[LW_TST + NCLS] = ps; }
        __syncthreads();
        if (tid < 32) { const int ntile = LWI[LW_TST + NCLS]; const long L = (long)tid * G + bid; int e = -1;
            if (L < (long)ntile * 8) { const int mt = (int)(L / 8), pn = (int)(L % 8); int cls = 0;
_Pragma("unroll 1")
                for (int k = 1; k < NCLS; ++k) cls += (LWI[LW_TST + k] <= mt) ? 1 : 0;
                e = (cls << 24) | (pn << 16) | mt; }
            LWI[LW_UTAB + tid] = e; e = -1;
            if (L < (long)ntile * 4) { const int mt = (int)(L / 4), pn = (int)(L % 4); int cls = 0;
_Pragma("unroll 1")
                for (int k = 1; k < NCLS; ++k) cls += (LWI[LW_TST + k] <= mt) ? 1 : 0;
                e = (cls << 24) | (pn << 16) | mt; }
            LWI[LW_DTAB + tid] = e; }
        __syncthreads();
        { pg8::MoeOrder<8, true> S{LWI + LW_UTAB, l, (const char*)HBS, (const char*)WGU};
          pg8::EpiUp E{ACT, ROWG};
          pg8::gemm_phase<pg8::EpiUp, pg8::MoeOrder<8, true>, true, true>(lds, D, S, E); } }
        xcd_barrier(bar);

        { PHASE_IDS(); unsigned char* ws = WSB(); bf16_t* ACT = (bf16_t*)(ws + WS_ACT); bf16_t* WD2 = (bf16_t*)(ws + WS_WD2); bf16_t* HB = (bf16_t*)(ws + WS_HB); float* SSQ = (float*)(ws + WS_SSQ); const int* ROWTOK = (const int*)(ws + WS_ROWTOK);
          pg8::MoeOrder<4, false> S{LWI + LW_DTAB, l, (const char*)ACT, (const char*)WD2};
          pg8::EpiRes<true> E{HB, SSQ, ROWTOK};
          pg8::gemm_phase<pg8::EpiRes<true>, pg8::MoeOrder<4, false>, true, true>(lds, D, S, E); }
        xcd_barrier(bar);
    }

    { PHASE_IDS(); unsigned char* ws = WSB(); const bf16_t* HB = (const bf16_t*)(ws + WS_HB); const float* SSQ = (const float*)(ws + WS_SSQ); const float* fg = INP(33); float* outp = a.out;
    for (int t = gw; t < T; t += NGW) {
        float sq = lane < 16 ? SSQ[(size_t)t * 16 + lane] : 0.f; sq = wave_sum(sq); const float r = rsqrtf(sq * (1.0f / D) + EPS);
#pragma unroll
        for (int hh = 0; hh < 2; ++hh) { const int d0 = hh * 512 + lane * 8; const u32x4 o = *(const u32x4*)(HB + (size_t)t * D + d0);
            const f32x4 g0 = *(const f32x4*)(fg + d0), g1 = *(const f32x4*)(fg + d0 + 4);
            f32x4 w0, w1; w0[0] = __uint_as_float(o.x << 16) * r * g0[0]; w0[1] = __uint_as_float(o.x & 0xffff0000u) * r * g0[1]; w0[2] = __uint_as_float(o.y << 16) * r * g0[2]; w0[3] = __uint_as_float(o.y & 0xffff0000u) * r * g0[3];
            w1[0] = __uint_as_float(o.z << 16) * r * g1[0]; w1[1] = __uint_as_float(o.z & 0xffff0000u) * r * g1[1]; w1[2] = __uint_as_float(o.w << 16) * r * g1[2]; w1[3] = __uint_as_float(o.w & 0xffff0000u) * r * g1[3];
            *(f32x4*)(outp + (size_t)t * D + d0) = w0; *(f32x4*)(outp + (size_t)t * D + d0 + 4) = w1; }
    } }
}

extern "C" void kernel_launch(void* const* d_in, const int* in_sizes, int n_in, void* d_out, int out_size, void* d_ws, size_t ws_size, hipStream_t stream) {
    static int grid = 0;
    if (grid == 0) {
        if (n_in != 34 || in_sizes[0] != T * D || out_size != T * D || ws_size < WS_END) { fprintf(stderr, "kernel_launch: unexpected shapes (n_in %d, ws %zu)\n", n_in, ws_size); grid = -1; return; }
        int dev = 0, cus = 0, per_cu = 0;
        if (hipGetDevice(&dev) != hipSuccess || hipDeviceGetAttribute(&cus, hipDeviceAttributeMultiprocessorCount, dev) != hipSuccess) { grid = -1; return; }
        if (hipFuncSetAttribute((const void*)mega_fwd, hipFuncAttributeMaxDynamicSharedMemorySize, LDS_BYTES) != hipSuccess) { fprintf(stderr, "kernel_launch: hipFuncSetAttribute failed\n"); grid = -1; return; }
        if (hipOccupancyMaxActiveBlocksPerMultiprocessor(&per_cu, (const void*)mega_fwd, 512, LDS_BYTES) != hipSuccess || per_cu < 1) { fprintf(stderr, "kernel_launch: occupancy query says %d\n", per_cu); }
        (void)hipGetLastError();
        grid = cus;
    }
    if (grid < 0) return;
    (void)hipMemsetAsync((char*)d_ws + WS_CTL, 0, CTL_ZERO_BYTES, stream);
    Args a{};
    for (int i = 0; i < 34; ++i) a.in[i] = (const float*)d_in[i];
    a.out = (float*)d_out; a.ws = (unsigned char*)d_ws;
    hipLaunchKernelGGL(mega_fwd, dim3(grid), dim3(512), LDS_BYTES, stream, a);
}
```

```cpp
#include <hip/hip_runtime.h>
#include <cstdio>
#include <cstdint>

#define LAS __attribute__((address_space(3)))
typedef unsigned short bf16_t;
typedef short bf16x8 __attribute__((ext_vector_type(8)));
typedef float f32x4 __attribute__((ext_vector_type(4)));
typedef float f32x2 __attribute__((ext_vector_type(2)));
typedef unsigned u32x4 __attribute__((ext_vector_type(4)));
typedef unsigned u32x2 __attribute__((ext_vector_type(2)));

constexpr int D = 1024, BATCH = 8, SEQ = 8192, T = BATCH * SEQ, DEPTH = 2;
constexpr int AW = 384, BW = 384, CW = 256, HD = 64, ABLK = 128, CHUNK = 64;
constexpr int INC = 1792;
constexpr int ZU = 0, ZV = 384, ZG = 768, ZX = 1152, ZC = 1536, ZGELU_END = 1152;
constexpr int CG = 16, CGD = 16, CS = 64;
constexpr int NE = 16, DE = 512, NCLS = 24;
constexpr float EPS = 1e-6f;
constexpr int UT = 256;
constexpr int NU = T / UT;
constexpr int MAXROWS = T + NCLS * 256;

constexpr size_t MiB = 1u << 20;
constexpr size_t WS_CTL = 0, CTL_ZERO_BYTES = 1 * MiB;
constexpr size_t WS_WIN = 2 * MiB;
constexpr size_t WS_WOUT = 10 * MiB;
constexpr size_t WS_WGLU = 14 * MiB;
constexpr size_t WS_WRG = 15 * MiB;
constexpr size_t WS_WSP = 15 * MiB + 256 * 1024;
constexpr size_t WS_WRT = 15 * MiB + 768 * 1024;
constexpr size_t WS_WGU = 16 * MiB;
constexpr size_t WS_WD2 = 80 * MiB;
constexpr size_t WS_SSQ = 176 * MiB;
constexpr size_t WS_RS = 180 * MiB;
constexpr size_t WS_CLS = WS_RS + 256 * 1024;
constexpr size_t WS_G2 = WS_CLS + 256 * 1024;
constexpr size_t WS_HIST = 181 * MiB;
constexpr size_t WS_CTOT = WS_HIST + 64 * 1024;
constexpr size_t WS_ROWTOK = WS_HIST + 256 * 1024;
constexpr size_t WS_ROWG = 182 * MiB;
constexpr size_t WS_SUMA = 183 * MiB;
constexpr size_t WS_SUMH = 191 * MiB;
constexpr size_t WS_S5 = 184 * MiB;
constexpr size_t WS_SEND = 187 * MiB;
constexpr size_t WS_HB = 192 * MiB;
constexpr size_t WS_Z = 320 * MiB;
constexpr size_t WS_HBS = WS_Z;
constexpr size_t WS_Y = 544 * MiB;
constexpr size_t WS_ACT = 672 * MiB;
constexpr size_t WS_AV = 672 * MiB;
constexpr size_t WS_BV = 768 * MiB;
constexpr size_t WS_SEND2 = 864 * MiB;
constexpr size_t WS_SUMA2 = 866 * MiB;
constexpr size_t WS_SUMH2 = 867 * MiB;
constexpr size_t WS_END = 868 * MiB;
constexpr int CW_BAR = 4096;

constexpr int RING_BYTES = 131072;
constexpr int LDSCTL_OFF = 143360;
constexpr int LDS_BYTES = 147456;
constexpr int LW_BAR = 8, LW_TST = 64, LW_HIST = 96, LW_TOT = 128, LW_BASE = 160, LW_CLS = 256  , LW_DEST = 512  , LW_UTAB = 768  , LW_DTAB = 800  ;

__device__ __forceinline__ float bf2f(bf16_t v) { return __uint_as_float(((unsigned)v) << 16); }
__device__ __forceinline__ unsigned cvt_pk_bf16(float lo, float hi) { unsigned r; asm volatile("v_cvt_pk_bf16_f32 %0, %1, %2" : "=v"(r) : "v"(lo), "v"(hi)); return r; }
__device__ __forceinline__ bf16_t f2bf(float v) { return (bf16_t)(cvt_pk_bf16(v, 0.f) & 0xffffu); }
__device__ __forceinline__ float wave_sum(float v) {
#pragma unroll
    for (int o = 32; o >= 1; o >>= 1) v += __shfl_xor(v, o);
    return v;
}
__device__ __forceinline__ float gelu_fast(float x) {
    const float u2 = 1.5957691216057308f * (x + 0.044715f * x * x * x);
    const float e = __builtin_amdgcn_exp2f(-1.4426950408889634f * u2);
    return x * __builtin_amdgcn_rcpf(1.0f + e);
}
__device__ __forceinline__ float sigmoid_fast(float x) { return __builtin_amdgcn_rcpf(1.0f + __builtin_amdgcn_exp2f(-1.4426950408889634f * x)); }
__device__ __forceinline__ float sigmoid_f(float x) { return 1.0f / (1.0f + expf(-x)); }
__device__ __forceinline__ int pair_lo(int pi) { return pi < 3 ? 0 : (pi < 5 ? 1 : 2); }
__device__ __forceinline__ int pair_hi(int pi) { return pi < 3 ? pi + 1 : (pi < 5 ? pi - 1 : 3); }
__device__ __forceinline__ int pair_idx(int lo, int hi) { return lo == 0 ? hi - 1 : (lo == 1 ? hi + 1 : 5); }

#define XB_TMO      128
#define XB_XCNT(j)  (256  + 64 * (j))
#define XB_XSUB(j)  (1280 + 64 * (j))
#define XB_XGEN(j)  (2304 + 64 * (j))
#define XB_TOP      3328
#define XB_TOPGEN   3392
#define XCD_BAR_WORDS 3456
#define XB_SPIN_CAP (1u << 18)
__device__ __forceinline__ unsigned xb_ld(unsigned* p)              { return __hip_atomic_load(p, __ATOMIC_RELAXED, __HIP_MEMORY_SCOPE_AGENT); }
__device__ __forceinline__ unsigned xb_add(unsigned* p, unsigned v) { return __hip_atomic_fetch_add(p, v, __ATOMIC_RELAXED, __HIP_MEMORY_SCOPE_AGENT); }
__device__ __forceinline__ unsigned xb_xcc_id() { return (unsigned)__builtin_amdgcn_s_getreg((3 << 11) | 20) & 0xFu; }
#define XB_SPIN(cond, bar) do { unsigned _sp = 0; while (cond) { __builtin_amdgcn_s_sleep(1); \
    if ((++_sp & 255u) == 0u) { if (xb_ld(&(bar)[XB_TMO])) break; if (_sp > XB_SPIN_CAP) { atomicAdd(&(bar)[XB_TMO], 1u); break; } } } } while (0)
struct XcdBarrier { unsigned* bar; unsigned x; volatile LAS unsigned* st; };
__device__ __forceinline__ XcdBarrier xcd_barrier_post(unsigned* bar, volatile LAS unsigned* st) {
    XcdBarrier b; b.bar = bar; b.x = xb_xcc_id(); b.st = st;
    if (threadIdx.x == 0) (void)xb_add(&bar[XB_XCNT(b.x)], 1u);
    return b;
}
__device__ __forceinline__ void xcd_barrier_complete(unsigned* bar, unsigned x, unsigned& nloc, unsigned& nx) {
    const unsigned G = gridDim.x * gridDim.y * gridDim.z;
    unsigned sum, cnt, mine, sp = 0u;
    for (;;) {
        sum = 0u; cnt = 0u; mine = 0u;
#pragma unroll
        for (unsigned j = 0; j < 16; ++j) { const unsigned c = xb_ld(&bar[XB_XCNT(j)]); sum += c; cnt += (c > 0u) ? 1u : 0u; mine = (j == x) ? c : mine; }
        if (sum == G) break;
        __builtin_amdgcn_s_sleep(1);
        if ((++sp & 255u) == 0u) { if (xb_ld(&bar[XB_TMO])) break; if (sp > XB_SPIN_CAP) { atomicAdd(&bar[XB_TMO], 1u); break; } }
    }
    nloc = mine > 0u ? mine : 1u; nx = cnt > 0u ? cnt : 1u;
}
__device__ __forceinline__ void xcd_barrier(const XcdBarrier& b) {
    asm volatile("s_waitcnt vmcnt(0)" ::: "memory");
    __syncthreads();
    if (threadIdx.x == 0) {
        unsigned* bar = b.bar;
        __builtin_amdgcn_s_waitcnt(0);
        unsigned nloc = b.st[0], nx = b.st[1];
        if (nloc == 0u) { xcd_barrier_complete(bar, b.x, nloc, nx); b.st[0] = nloc; b.st[1] = nx; }
        const unsigned old = xb_add(&bar[XB_XSUB(b.x)], 1u);
        const unsigned gen = old / nloc;
        if (old + 1u == (gen + 1u) * nloc) {
            __builtin_amdgcn_fence(__ATOMIC_RELEASE, "agent");
            asm volatile("s_waitcnt vmcnt(0)" ::: "memory");
            const unsigned og = xb_add(&bar[XB_TOP], 1u);
            const unsigned tg = og / nx;
            if (og + 1u == (tg + 1u) * nx) xb_add(&bar[XB_TOPGEN], 1u);
            else XB_SPIN(xb_ld(&bar[XB_TOPGEN]) == tg, bar);
            __builtin_amdgcn_fence(__ATOMIC_ACQUIRE, "agent");
            xb_add(&bar[XB_XGEN(b.x)], 1u);
            asm volatile("s_waitcnt vmcnt(0)" ::: "memory");
        } else {
            XB_SPIN(xb_ld(&bar[XB_XGEN(b.x)]) == gen, bar);
            __builtin_amdgcn_fence(__ATOMIC_ACQUIRE, "agent");
            asm volatile("s_waitcnt vmcnt(0)" ::: "memory");
        }
    }
    __syncthreads();
}

namespace pg8 {
#define PG8_LAS __attribute__((address_space(3)))
constexpr int BM = 256, BK = 64, HALF = 128, HTB = HALF * BK * 2, STAGE_BYTES = 8 * HTB, NXCD = 8, WGM = 8;
__host__ __device__ __forceinline__ int lds_byte(int r, int c) { const int st = (r >> 4) * 2 + (c >> 5), rr = r & 15, cc = c & 31, ob = rr * 64 + cc * 2; return st * 1024 + (ob ^ (((ob >> 9) & 1) << 5)); }
__host__ __device__ __forceinline__ void stage_rc(int b, int& R, int& C) { const int st = b / 1024, sb = b % 1024, swz = sb ^ (((sb >> 9) & 1) << 5); R = (st >> 1) * 16 + swz / 64; C = (st & 1) * 32 + (swz % 64) / 2; }
__host__ __device__ __forceinline__ int perm32(int rho) { const int n = rho >> 4, i = rho & 15; return 8 * (i >> 2) + 4 * n + (i & 3); }
struct Unit { int pm, pn; const char* A; const char* B; };

template <int M_, int N_> struct StaticOrder {
    static constexpr int nM = M_ / BM, nN = N_ / BM, nwg = nM * nN; static constexpr size_t tstep = (size_t)BM * 1024 * 2;
    int G, c; const char* A; const char* Bt;
    __device__ void init(const void* A_, const void* Bt_, int G_, int c_) { G = G_; c = c_; A = (const char*)A_; Bt = (const char*)Bt_; }
    __device__ bool next(int i, Unit& u) const {
        const long L = (long)i * G + c; if (L >= nwg) return false;
        int wgid = (int)L; { constexpr int q = nwg / NXCD, r = nwg % NXCD; const int xcd = wgid % NXCD, off = wgid / NXCD; wgid = (xcd < r ? xcd * (q + 1) : r * (q + 1) + (xcd - r) * q) + off; }
        constexpr int nig = WGM * nN; const int gid = wgid / nig, fm = gid * WGM, gsz = (nM - fm) < WGM ? (nM - fm) : WGM;
        u.pm = fm + ((wgid % nig) % gsz); u.pn = (wgid % nig) / gsz; u.A = A + (size_t)u.pm * tstep; u.B = Bt + (size_t)u.pn * tstep; return true;
    }
    __device__ __forceinline__ void a_ready(const Unit&) const {}
    __device__ __forceinline__ void done(const Unit&) const {}
};
template <class Epi, class Sched, bool ALIGN_EPI = false, bool SP2 = false>
__device__ __forceinline__ void gemm_phase(PG8_LAS unsigned char* lds, const int Kdim, const Sched& S, const Epi& E) {
    int tid = threadIdx.x; asm volatile("" : "+v"(tid)); const int wid = __builtin_amdgcn_readfirstlane(tid >> 6), lane = tid & 63, wr = wid >> 2, wc = wid & 3, fr = lane & 15, fq = lane >> 4;
    constexpr int K = 1024, nt = K / BK; (void)Kdim;
    unsigned voffA, voffB;
    { int R, C; stage_rc(tid * 16, R, C); const int Rb = Epi::PERM ? ((R & ~31) + perm32(R & 31)) : R; voffA = (unsigned)(R * K + C) * 2u; voffB = (unsigned)(Rb * K + C) * 2u; }
    constexpr size_t kstep = (size_t)(BK * 2);
    constexpr size_t hstep = (size_t)HALF * K * 2;
    constexpr size_t tstep = 2 * hstep; (void)tstep;
    const unsigned ldsw = (unsigned)wid * 1024u;
    const int aoff = lds_byte(wr * 64 + fr, fq * 8), boff = lds_byte(wc * 32 + fr, fq * 8);
#define PG8_SA(b, h) (((b) * 2 + (h)) * HTB)
#define PG8_SB(b, h) ((4 + (b) * 2 + (h)) * HTB)
#define PG8_STAGE(bufoff, gbase, voff) do { _Pragma("unroll") for (int _i = 0; _i < 2; ++_i) \
        __builtin_amdgcn_global_load_lds((const unsigned*)((const char*)(gbase) + (size_t)_i * (64 * 1024 * 2) + (voff)), (PG8_LAS unsigned*)(lds + (bufoff) + ldsw + _i * 8192), 16, 0, 0); } while (0)
#define PG8_LDA(dst, b, h) do { _Pragma("unroll") for (int m = 0; m < 4; ++m) _Pragma("unroll") for (int k = 0; k < 2; ++k) dst[m][k] = *(const PG8_LAS bf16x8*)(lds + PG8_SA(b, h) + aoff + m * 2048 + k * 1024); } while (0)
#define PG8_LDB(dst, b, h) do { _Pragma("unroll") for (int n = 0; n < 2; ++n) _Pragma("unroll") for (int k = 0; k < 2; ++k) dst[n][k] = *(const PG8_LAS bf16x8*)(lds + PG8_SB(b, h) + boff + n * 2048 + k * 1024); } while (0)
#define PG8_MMA(ai, bj, At, Bt) do { __builtin_amdgcn_s_setprio(1); _Pragma("unroll") for (int m = 0; m < 4; ++m) _Pragma("unroll") for (int n = 0; n < 2; ++n) _Pragma("unroll") for (int k = 0; k < 2; ++k) \
        acc[ai][bj][m][n] = __builtin_amdgcn_mfma_f32_16x16x32_bf16(Bt[n][k], At[m][k], acc[ai][bj][m][n], 0, 0, 0); __builtin_amdgcn_s_setprio(0); } while (0)
#define PG8_WAIT_V(n) asm volatile("s_waitcnt vmcnt(" #n ")" ::: "memory")
#define PG8_WAIT_L(n) asm volatile("s_waitcnt lgkmcnt(" #n ")" ::: "memory")
#define PG8_BAR __builtin_amdgcn_s_barrier()
#define PG8_SCHED __builtin_amdgcn_sched_barrier(0)
    Unit cur, nxt; int ui = 0;
    if (!S.next(0, cur)) return;
    f32x4 acc[2][2][4][2];
#pragma unroll
    for (int a = 0; a < 2; ++a)
#pragma unroll
        for (int b = 0; b < 2; ++b)
#pragma unroll
            for (int m = 0; m < 4; ++m)
#pragma unroll
                for (int n = 0; n < 2; ++n) acc[a][b][m][n] = (f32x4){0.f, 0.f, 0.f, 0.f};
    bf16x8 At[4][2], B0[2][2], B1[2][2];
    const char* cA = cur.A; const char* cB = cur.B;
    S.a_ready(cur);
    if constexpr (SP2) {
        PG8_STAGE(PG8_SB(0, 0), cB, voffB); PG8_STAGE(PG8_SB(0, 1), cB + hstep, voffB); PG8_STAGE(PG8_SA(0, 0), cA, voffA); PG8_STAGE(PG8_SA(0, 1), cA + hstep, voffA);
        if (wr == 1) PG8_BAR;
        PG8_WAIT_V(2); PG8_BAR;
        PG8_STAGE(PG8_SB(1, 0), cB + kstep, voffB); PG8_STAGE(PG8_SA(1, 0), cA + kstep, voffA); PG8_STAGE(PG8_SB(1, 1), cB + hstep + kstep, voffB);
        PG8_WAIT_V(6); PG8_BAR;
    } else {
        PG8_STAGE(PG8_SB(0, 0), cB, voffB); PG8_STAGE(PG8_SA(0, 0), cA, voffA); PG8_STAGE(PG8_SB(0, 1), cB + hstep, voffB); PG8_STAGE(PG8_SA(0, 1), cA + hstep, voffA);
        if (wr == 1) PG8_BAR;
        PG8_WAIT_V(4); PG8_BAR;
        PG8_STAGE(PG8_SB(1, 0), cB + kstep, voffB); PG8_STAGE(PG8_SA(1, 0), cA + kstep, voffA); PG8_STAGE(PG8_SB(1, 1), cB + hstep + kstep, voffB);
        PG8_WAIT_V(6); PG8_BAR;
    }
    for (;;) {
        const bool has_next = S.next(ui + 1, nxt);
        const char* nA = has_next ? nxt.A : cA; const char* nB = has_next ? nxt.B : cB;
        for (int t = 0; t < nt; t += 2) {
            const bool last = (t == nt - 2);
            const char* a1 = cA + (size_t)(t + 1) * kstep;
            const char* a2 = last ? nA : cA + (size_t)(t + 2) * kstep; const char* b2 = last ? nB : cB + (size_t)(t + 2) * kstep;
            const char* a3 = a2 + kstep; const char* b3 = b2 + kstep;
            if (last && has_next) S.a_ready(nxt);
            if constexpr (SP2) {
            PG8_LDB(B0, 0, 0); PG8_LDB(B1, 0, 1); PG8_SCHED; PG8_LDA(At, 0, 0); PG8_STAGE(PG8_SA(1, 1), a1 + hstep, voffA);
            PG8_WAIT_V(8); PG8_WAIT_L(0); PG8_BAR; PG8_MMA(0, 0, At, B0); PG8_MMA(0, 1, At, B1); PG8_BAR; PG8_SCHED;
            PG8_LDA(At, 0, 1); PG8_STAGE(PG8_SB(0, 0), b2, voffB); PG8_STAGE(PG8_SB(0, 1), b2 + hstep, voffB); PG8_STAGE(PG8_SA(0, 0), a2, voffA);
            PG8_WAIT_V(8); PG8_WAIT_L(0); PG8_BAR; PG8_MMA(1, 0, At, B0); PG8_MMA(1, 1, At, B1); PG8_BAR; PG8_SCHED;
            PG8_LDB(B0, 1, 0); PG8_LDB(B1, 1, 1); PG8_SCHED; PG8_LDA(At, 1, 0); PG8_STAGE(PG8_SA(0, 1), a2 + hstep, voffA);
            PG8_WAIT_V(8); PG8_WAIT_L(0); PG8_BAR; PG8_MMA(0, 0, At, B0); PG8_MMA(0, 1, At, B1); PG8_BAR; PG8_SCHED;
            PG8_LDA(At, 1, 1); PG8_STAGE(PG8_SB(1, 0), b3, voffB); PG8_STAGE(PG8_SB(1, 1), b3 + hstep, voffB); PG8_STAGE(PG8_SA(1, 0), a3, voffA);
            PG8_WAIT_V(8); PG8_WAIT_L(0); PG8_BAR; PG8_MMA(1, 0, At, B0); PG8_MMA(1, 1, At, B1); PG8_BAR; PG8_SCHED;
            } else {
            PG8_LDB(B0, 0, 0); PG8_SCHED; PG8_LDA(At, 0, 0); PG8_STAGE(PG8_SA(1, 1), a1 + hstep, voffA);
            PG8_WAIT_L(8); PG8_BAR; PG8_WAIT_L(0); PG8_MMA(0, 0, At, B0); PG8_BAR; PG8_SCHED;
            PG8_LDB(B1, 0, 1); PG8_STAGE(PG8_SB(0, 0), b2, voffB);
            PG8_BAR; PG8_WAIT_L(0); PG8_MMA(0, 1, At, B1); PG8_BAR;
            PG8_LDA(At, 0, 1); PG8_STAGE(PG8_SA(0, 0), a2, voffA);
            PG8_BAR; PG8_WAIT_L(0); PG8_MMA(1, 0, At, B0); PG8_BAR; PG8_SCHED;
            PG8_STAGE(PG8_SB(0, 1), b2 + hstep, voffB);
            PG8_WAIT_V(6); PG8_BAR; PG8_MMA(1, 1, At, B1); PG8_BAR;
            PG8_LDB(B0, 1, 0); PG8_SCHED; PG8_LDA(At, 1, 0); PG8_STAGE(PG8_SA(0, 1), a2 + hstep, voffA);
            PG8_WAIT_L(8); PG8_BAR; PG8_WAIT_L(0); PG8_MMA(0, 0, At, B0); PG8_BAR; PG8_SCHED;
            PG8_LDB(B1, 1, 1); PG8_STAGE(PG8_SB(1, 0), b3, voffB);
            PG8_BAR; PG8_WAIT_L(0); PG8_MMA(0, 1, At, B1); PG8_BAR;
            PG8_LDA(At, 1, 1); PG8_STAGE(PG8_SA(1, 0), a3, voffA);
            PG8_BAR; PG8_WAIT_L(0); PG8_MMA(1, 0, At, B0); PG8_BAR; PG8_SCHED;
            PG8_STAGE(PG8_SB(1, 1), b3 + hstep, voffB);
            PG8_WAIT_V(6); PG8_BAR; PG8_MMA(1, 1, At, B1); PG8_BAR;
            }
        }
        if constexpr (ALIGN_EPI) { if (wr == 0) PG8_BAR; }
        if constexpr (!Epi::AFTER_DRAIN) { E(acc, cur, wr, wc, fr, fq); S.done(cur); }
        if (!has_next) break;
#pragma unroll
        for (int a = 0; a < 2; ++a)
#pragma unroll
            for (int b = 0; b < 2; ++b)
#pragma unroll
                for (int m = 0; m < 4; ++m)
#pragma unroll
                    for (int n = 0; n < 2; ++n) acc[a][b][m][n] = (f32x4){0.f, 0.f, 0.f, 0.f};
        cur = nxt; cA = nA; cB = nB; ++ui;
        if constexpr (ALIGN_EPI) { if (wr == 1) PG8_BAR; }
    }
    PG8_WAIT_V(0);
    if constexpr (!ALIGN_EPI) { if (wr == 0) PG8_BAR; }
    PG8_BAR;
    if constexpr (Epi::AFTER_DRAIN) { E.fused(acc, cur, wr, wc, fr, fq, lds, wid, lane); S.done(cur); }
#undef PG8_SA
#undef PG8_SB
#undef PG8_STAGE
#undef PG8_LDA
#undef PG8_LDB
#undef PG8_MMA
#undef PG8_WAIT_V
#undef PG8_WAIT_L
#undef PG8_BAR
#undef PG8_SCHED
}

template <int NP, bool UP> struct MoeOrder {
    const volatile LAS int* tab; int layer; const char* A; const char* W;
    __device__ bool next(int i, Unit& u) const {
        const int e = tab[i]; if (e < 0) return false;
        const int mt = e & 0xffff, pn = (e >> 16) & 0xff, cls = e >> 24;
        u.pm = mt; u.pn = pn; u.A = A + (size_t)mt * ((size_t)BM * 1024 * 2);
        if (UP) { const int g = cls / 6, pi = cls % 6, s = pn >> 2, ex = g * 4 + (s ? pair_hi(pi) : pair_lo(pi));
            u.B = W + ((size_t)(layer * NE + ex) * 1024 + (size_t)(pn & 3) * 256) * 1024 * 2; }
        else u.B = W + ((size_t)(layer * NCLS + cls) * 1024 + (size_t)pn * 256) * 1024 * 2;
        return true;
    }
    __device__ __forceinline__ void a_ready(const Unit&) const {}
    __device__ __forceinline__ void done(const Unit&) const {}
};

struct EpiZ {
    static constexpr bool PERM = true, AFTER_DRAIN = false;
    bf16_t* Z; const float* ssq;
    __device__ __forceinline__ void operator()(const f32x4 (&acc)[2][2][4][2], const Unit& u, int wr, int wc, int fr, int fq) const {
        const int row0 = u.pm * BM + wr * 64 + fr, col0 = u.pn * BM + wc * 32 + 8 * fq;
        float rr[2][4];
#pragma unroll
        for (int ai = 0; ai < 2; ++ai) {
            f32x4 sp[4];
#pragma unroll
            for (int m = 0; m < 4; ++m) sp[m] = *(const f32x4*)(ssq + (size_t)(row0 + ai * HALF + m * 16) * 16 + 4 * fq);
#pragma unroll
            for (int m = 0; m < 4; ++m) { float t = (sp[m][0] + sp[m][1]) + (sp[m][2] + sp[m][3]); t += __shfl_xor(t, 16); t += __shfl_xor(t, 32); rr[ai][m] = __builtin_amdgcn_rsqf(t * (1.0f / D) + EPS); }
        }
#pragma unroll
        for (int ai = 0; ai < 2; ++ai)
#pragma unroll
            for (int m = 0; m < 4; ++m) { const int row = row0 + ai * HALF + m * 16; const float r = rr[ai][m];
                bf16_t* rowp = Z + (size_t)row * INC + col0;
#pragma unroll
                for (int bj = 0; bj < 2; ++bj) { f32x4 v0 = acc[ai][bj][m][0] * r, v1 = acc[ai][bj][m][1] * r;
                    if (u.pn * BM + bj * HALF < ZGELU_END) {
#pragma unroll
                        for (int j = 0; j < 4; ++j) { v0[j] = gelu_fast(v0[j]); v1[j] = gelu_fast(v1[j]); } }
                    u32x4 w; w.x = cvt_pk_bf16(v0[0], v0[1]); w.y = cvt_pk_bf16(v0[2], v0[3]); w.z = cvt_pk_bf16(v1[0], v1[1]); w.w = cvt_pk_bf16(v1[2], v1[3]);
                    *(u32x4*)(rowp + bj * HALF) = w; } }
    }
};
template <bool SCATTER> struct EpiRes {
    static constexpr bool PERM = true, AFTER_DRAIN = false;
    bf16_t* H; float* ssq; const int* rowtok;
    __device__ __forceinline__ void operator()(const f32x4 (&acc)[2][2][4][2], const Unit& u, int wr, int wc, int fr, int fq) const {
        const int row0 = u.pm * BM + wr * 64 + fr, col0 = u.pn * BM + wc * 32 + 8 * fq;
        int tokv[2][4];
#pragma unroll
        for (int ai = 0; ai < 2; ++ai)
#pragma unroll
            for (int m = 0; m < 4; ++m) { const int row = row0 + ai * HALF + m * 16; tokv[ai][m] = SCATTER ? rowtok[row] : row; }
#pragma unroll
        for (int ai = 0; ai < 2; ++ai) {
            u32x4 o[4][2];
#pragma unroll
            for (int m = 0; m < 4; ++m) { const int tok = tokv[ai][m]; const bf16_t* rowp = H + (size_t)(tok < 0 ? 0 : tok) * D + col0; o[m][0] = *(const u32x4*)(rowp); o[m][1] = *(const u32x4*)(rowp + HALF); }
#pragma unroll
            for (int m = 0; m < 4; ++m) { const int tok = tokv[ai][m]; float s = 0.f; bf16_t* rowp = H + (size_t)(tok < 0 ? 0 : tok) * D + col0;
#pragma unroll
                for (int bj = 0; bj < 2; ++bj) { const u32x4 oo = o[m][bj];
                    f32x4 v0 = acc[ai][bj][m][0], v1 = acc[ai][bj][m][1];
                    v0[0] += __uint_as_float(oo.x << 16); v0[1] += __uint_as_float(oo.x & 0xffff0000u); v0[2] += __uint_as_float(oo.y << 16); v0[3] += __uint_as_float(oo.y & 0xffff0000u);
                    v1[0] += __uint_as_float(oo.z << 16); v1[1] += __uint_as_float(oo.z & 0xffff0000u); v1[2] += __uint_as_float(oo.w << 16); v1[3] += __uint_as_float(oo.w & 0xffff0000u);
                    s += (v0[0] * v0[0] + v0[1] * v0[1]) + (v0[2] * v0[2] + v0[3] * v0[3]) + (v1[0] * v1[0] + v1[1] * v1[1]) + (v1[2] * v1[2] + v1[3] * v1[3]);
                    u32x4 w; w.x = cvt_pk_bf16(v0[0], v0[1]); w.y = cvt_pk_bf16(v0[2], v0[3]); w.z = cvt_pk_bf16(v1[0], v1[1]); w.w = cvt_pk_bf16(v1[2], v1[3]);
                    if (tok >= 0) *(u32x4*)(rowp + bj * HALF) = w; }
                s += __shfl_xor(s, 16); s += __shfl_xor(s, 32);
                if (fq == 0 && tok >= 0) ssq[(size_t)tok * 16 + u.pn * 4 + wc] = s; }
            asm volatile("" ::: "memory"); }
    }
};
struct EpiUp {
    static constexpr bool PERM = true, AFTER_DRAIN = false;
    bf16_t* ACT; const float* rowg;
    __device__ __forceinline__ void operator()(const f32x4 (&acc)[2][2][4][2], const Unit& u, int wr, int wc, int fr, int fq) const {
        const int row0 = u.pm * BM + wr * 64 + fr, s = u.pn >> 2, col0 = s * 512 + (u.pn & 3) * 128 + wc * 32 + 8 * fq;
        float gt[2][4];
#pragma unroll
        for (int ai = 0; ai < 2; ++ai)
#pragma unroll
            for (int m = 0; m < 4; ++m) gt[ai][m] = rowg[(size_t)(row0 + ai * HALF + m * 16) * 2 + s];
#pragma unroll
        for (int ai = 0; ai < 2; ++ai)
#pragma unroll
            for (int m = 0; m < 4; ++m) { const int row = row0 + ai * HALF + m * 16; const float g1 = gt[ai][m];
                float o[8];
#pragma unroll
                for (int n = 0; n < 2; ++n)
#pragma unroll
                    for (int j = 0; j < 4; ++j) { const float g = acc[ai][0][m][n][j], up = acc[ai][1][m][n][j]; o[n * 4 + j] = g * sigmoid_fast(g) * up * g1; }
                u32x4 w; w.x = cvt_pk_bf16(o[0], o[1]); w.y = cvt_pk_bf16(o[2], o[3]); w.z = cvt_pk_bf16(o[4], o[5]); w.w = cvt_pk_bf16(o[6], o[7]);
                *(u32x4*)(ACT + (size_t)row * 1024 + col0) = w; }
    }
};
}

__device__ __forceinline__ void tr_item(const float* W, int ldw, int k0, int scol0, const float* gk, bf16_t* WT, int ldo, int drow0, int dk0, LAS float* scr, int lane) {
#pragma unroll 8
    for (int i = 0; i < 32; ++i) { const int kk = 2 * i + (lane >> 5); float v = W[(size_t)(k0 + kk) * ldw + scol0 + (lane & 31)]; if (gk) v *= gk[k0 + kk]; scr[kk * 33 + (lane & 31)] = v; }
    asm volatile("s_waitcnt lgkmcnt(0)" ::: "memory");
    const int c = lane & 7;
#pragma unroll
    for (int j = 0; j < 4; ++j) { const int n = (lane >> 3) + 8 * j; const LAS float* s = scr + (8 * c) * 33 + n;
        u32x4 o; o.x = cvt_pk_bf16(s[0 * 33], s[1 * 33]); o.y = cvt_pk_bf16(s[2 * 33], s[3 * 33]); o.z = cvt_pk_bf16(s[4 * 33], s[5 * 33]); o.w = cvt_pk_bf16(s[6 * 33], s[7 * 33]);
        *(u32x4*)(WT + (size_t)(drow0 + n) * ldo + dk0 + 8 * c) = o; }
    asm volatile("s_waitcnt lgkmcnt(0)" ::: "memory");
}

constexpr size_t S5_L_STRIDE = 1310720, S5_KT = 0, S5_ET = 131072, S5_FT = 655360, S5_LAMP = 1179648;
constexpr int S5_WSCR = 8192, S5_YST = 65536, YST_LD = 264;
constexpr int NU128 = T / 128, UPB128 = SEQ / 128;
__device__ __forceinline__ f32x4 mfma16(bf16x8 a, bf16x8 b, f32x4 c) { return __builtin_amdgcn_mfma_f32_16x16x32_bf16(a, b, c, 0, 0, 0); }

__device__ __forceinline__ void s5_table_elem(int g, int e, const float* a_re, const float* a_im, const float* log_dt, const float* b_re, const float* b_im,
                                              const float* c_re, const float* c_im, const float* dvec, unsigned char* tab) {
    const float dt = expf(log_dt[g]);
    if (e < 4096) {
        const int dd = e >> 9, c = (e >> 5) & 15, ee = (e >> 4) & 1, cp = e & 15, d = dd - ee; float s = 0.f;
        if (d >= 0) {
            for (int p = 0; p < CS; ++p) { const float lr = a_re[g * CS + p], li = a_im[g * CS + p], zr = lr * dt, zi = li * dt;
                const float sh = sinf(0.5f * zi); const float nr = expm1f(zr) * cosf(zi) - 2.0f * sh * sh, ni = expf(zr) * sinf(zi), den = lr * lr + li * li;
                const float cr = (nr * lr + ni * li) / den, ci = (ni * lr - nr * li) / den;
                const float br = b_re[((size_t)g * CS + p) * CGD + cp], bi = b_im[((size_t)g * CS + p) * CGD + cp]; const float bbr = cr * br - ci * bi, bbi = cr * bi + ci * br;
                const float mag = expf(zr * (float)d), pr = mag * cosf(zi * (float)d), pi = mag * sinf(zi * (float)d);
                const float vr = pr * bbr - pi * bbi, vi = pr * bbi + pi * bbr;
                s += c_re[((size_t)g * CGD + c) * CS + p] * vr - c_im[((size_t)g * CGD + c) * CS + p] * vi; }
            if (d == 0 && c == cp) s += dvec[g * CGD + c];
        }
        ((bf16_t*)(tab + S5_KT))[(size_t)g * 4096 + e] = f2bf(s); return;
    }
    e -= 4096;
    if (e < 16384) {
        const int n = e >> 7, k = e & 127, ri = n >> 6, p = n & 63, sp = k >> 4, cp = k & 15;
        const float lr = a_re[g * CS + p], li = a_im[g * CS + p], zr = lr * dt, zi = li * dt;
        const float sh = sinf(0.5f * zi); const float nr = expm1f(zr) * cosf(zi) - 2.0f * sh * sh, ni = expf(zr) * sinf(zi), den = lr * lr + li * li;
        const float cr = (nr * lr + ni * li) / den, ci = (ni * lr - nr * li) / den;
        const float br = b_re[((size_t)g * CS + p) * CGD + cp], bi = b_im[((size_t)g * CS + p) * CGD + cp]; const float bbr = cr * br - ci * bi, bbi = cr * bi + ci * br;
        const float d = (float)(7 - sp); const float mag = expf(zr * d), pr = mag * cosf(zi * d), pi = mag * sinf(zi * d);
        ((bf16_t*)(tab + S5_ET))[(size_t)g * 16384 + e] = f2bf(ri ? (pr * bbi + pi * bbr) : (pr * bbr - pi * bbi)); return;
    }
    e -= 16384;
    if (e < 16384) {
        const int n = e >> 7, k = e & 127, tp = n >> 4, c = n & 15, ri = k >> 6, p = k & 63;
        const float lr = a_re[g * CS + p], li = a_im[g * CS + p], zr = lr * dt, zi = li * dt;
        const float d = (float)(tp + 1); const float mag = expf(zr * d), pr = mag * cosf(zi * d), pi = mag * sinf(zi * d);
        const float cre = c_re[((size_t)g * CGD + c) * CS + p], cim = c_im[((size_t)g * CGD + c) * CS + p];
        ((bf16_t*)(tab + S5_FT))[(size_t)g * 16384 + e] = f2bf(ri ? -(cre * pi + cim * pr) : (cre * pr - cim * pi)); return;
    }
    e -= 16384;
    { const int p = e; const float lr = a_re[g * CS + p], li = a_im[g * CS + p], zr = lr * dt, zi = li * dt; float* o = (float*)(tab + S5_LAMP) + ((size_t)g * CS + p) * 8;
      float mag = expf(zr); o[0] = mag * cosf(zi); o[1] = mag * sinf(zi);
      mag = expf(zr * 8.f); o[2] = mag * cosf(zi * 8.f); o[3] = mag * sinf(zi * 8.f);
      mag = expf(zr * 128.f); o[4] = mag * cosf(zi * 128.f); o[5] = mag * sinf(zi * 128.f); o[6] = 0.f; o[7] = 0.f; }
}

template <class TT> __device__ __forceinline__ TT ldg(const void* ubase, unsigned voff) { return *(const TT*)((const char*)ubase + voff); }
template <int PASS>
__device__ __forceinline__ void s5_group(int unit, int g, bool first, float& kr, float& ki, int wave, int lane, const bf16_t* Z, const unsigned char* tab, float* SEND, float* SEND2, LAS unsigned char* lds) {
    const int ln = lane & 15, q = lane >> 4; const int t0 = unit * 128;
    const char* KTg = (const char*)(tab + S5_KT) + (size_t)g * 8192; const char* ETg = (const char*)(tab + S5_ET) + (size_t)g * 32768; const char* FTg = (const char*)(tab + S5_FT) + (size_t)g * 32768;
    const float* LAMPg = (const float*)(tab + S5_LAMP) + (size_t)g * CS * 8;
    const unsigned vo128 = (unsigned)(ln * 128 + 8 * q) * 2u;
    const unsigned vo32 = (unsigned)(ln * 32 + 8 * q) * 2u;
    LAS float* Sb = (LAS float*)(lds + wave * S5_WSCR); LAS bf16_t* Tb = (LAS bf16_t*)(lds + wave * S5_WSCR); LAS bf16_t* yst = (LAS bf16_t*)(lds + S5_YST);
    bf16x8 X0, X1, X2, X3;
    { const char* zb = (const char*)(Z + (size_t)t0 * INC + ZC + g * 16); const unsigned vz = (unsigned)((ln * 8 + (q >> 1)) * INC + 8 * (q & 1)) * 2u;
      X0 = ldg<bf16x8>(zb, vz); X1 = ldg<bf16x8>(zb + 2 * INC * 2, vz); X2 = ldg<bf16x8>(zb + 4 * INC * 2, vz); X3 = ldg<bf16x8>(zb + 6 * INC * 2, vz); }
    const float lur = LAMPg[lane * 8 + 4], lui = LAMPg[lane * 8 + 5];
    float cr = 0.f, ci = 0.f;
    if (PASS == 1) { if (!first) { cr = kr; ci = ki; } }
    else if (first) { const int pr = unit >> 1, p0 = pr - (pr % (UPB128 / 2)); const float l2r = lur * lur - lui * lui, l2i = 2.0f * lur * lui;
        const char* sb = (const char*)(SEND2 + (((size_t)p0 * CG + g) * 2) * CS); const unsigned vl = (unsigned)lane * 4u;
#pragma unroll 8
        for (int j = p0; j < pr; ++j) { const float sr = ldg<float>(sb, vl), si = ldg<float>(sb + CS * 4, vl); sb += (size_t)CG * 2 * CS * 4;
            const float nr = l2r * cr - l2i * ci + sr, ni = l2r * ci + l2i * cr + si; cr = nr; ci = ni; } }
    else { const float sr = SEND[(((size_t)(unit - 1) * CG + g) * 2 + 0) * CS + lane], si = SEND[(((size_t)(unit - 1) * CG + g) * 2 + 1) * CS + lane];
        cr = lur * kr - lui * ki + sr; ci = lur * ki + lui * kr + si; }
    if (PASS == 2) { kr = cr; ki = ci; }
    { LAS float* sw = Sb + (4 * q) * 128 + ln; const char* eb = ETg;
#pragma unroll 1
      for (int jh = 0; jh < 4; ++jh) { bf16x8 ef[2][4];
#pragma unroll
          for (int j = 0; j < 2; ++j)
#pragma unroll
              for (int ks = 0; ks < 4; ++ks) ef[j][ks] = ldg<bf16x8>(eb + j * 4096 + ks * 64, vo128);
#pragma unroll
          for (int j = 0; j < 2; ++j) { f32x4 se = (f32x4){0.f, 0.f, 0.f, 0.f};
              se = mfma16(X0, ef[j][0], se); se = mfma16(X1, ef[j][1], se); se = mfma16(X2, ef[j][2], se); se = mfma16(X3, ef[j][3], se);
              LAS float* s2 = sw + 16 * j; s2[0] = se[0]; s2[128] = se[1]; s2[256] = se[2]; s2[384] = se[3]; }
          eb += 8192; sw += 32; } }
    asm volatile("" ::: "memory");
    const float l8r = LAMPg[lane * 8 + 2], l8i = LAMPg[lane * 8 + 3];
    float sr = cr, si = ci;
    float sre[16], sim[16];
#pragma unroll
    for (int s = 0; s < 16; ++s) { sre[s] = Sb[s * 128 + lane]; sim[s] = Sb[s * 128 + 64 + lane]; }
    asm volatile("s_waitcnt lgkmcnt(0)" ::: "memory");
#pragma unroll
    for (int s = 0; s < 16; ++s) { if (PASS == 2) { Tb[s * 128 + lane] = f2bf(sr); Tb[s * 128 + 64 + lane] = f2bf(si); }
        const float nr = l8r * sr - l8i * si + sre[s], ni = l8r * si + l8i * sr + sim[s]; sr = nr; si = ni; }
    if (PASS == 1) { kr = sr; ki = si;
        float* dst = first ? SEND + (((size_t)unit * CG + g) * 2) * CS + lane : SEND2 + (((size_t)(unit >> 1) * CG + g) * 2) * CS + lane;
        dst[0] = sr; dst[CS] = si; asm volatile("" ::: "memory"); return; }
    asm volatile("" ::: "memory");
    const bf16x8 T0 = *(const LAS bf16x8*)(Tb + ln * 128 + 8 * q), T1 = *(const LAS bf16x8*)(Tb + ln * 128 + 32 + 8 * q), T2 = *(const LAS bf16x8*)(Tb + ln * 128 + 64 + 8 * q), T3 = *(const LAS bf16x8*)(Tb + ln * 128 + 96 + 8 * q);
    { LAS bf16_t* yw = yst + (ln * 8) * YST_LD + g * 16 + 4 * q; const char* fb = FTg; const char* kb = KTg;
#pragma unroll 1
      for (int th = 0; th < 4; ++th) { bf16x8 ff[2][4];
#pragma unroll
          for (int j = 0; j < 2; ++j)
#pragma unroll
              for (int ks = 0; ks < 4; ++ks) ff[j][ks] = ldg<bf16x8>(fb + j * 4096 + ks * 64, vo128);
          const bf16x8 ka = ldg<bf16x8>(kb, vo32), kc = ldg<bf16x8>(kb + 1024, vo32);
          f32x4 acc0 = (f32x4){0.f, 0.f, 0.f, 0.f}, acc1 = (f32x4){0.f, 0.f, 0.f, 0.f};
          acc0 = mfma16(ka, X0, acc0); acc1 = mfma16(kc, X0, acc1);
          if (th >= 1) { acc0 = mfma16(ldg<bf16x8>(kb - 2048, vo32), X1, acc0); acc1 = mfma16(ldg<bf16x8>(kb - 1024, vo32), X1, acc1); }
          if (th >= 2) { acc0 = mfma16(ldg<bf16x8>(kb - 4096, vo32), X2, acc0); acc1 = mfma16(ldg<bf16x8>(kb - 3072, vo32), X2, acc1); }
          if (th >= 3) { acc0 = mfma16(ldg<bf16x8>(kb - 6144, vo32), X3, acc0); acc1 = mfma16(ldg<bf16x8>(kb - 5120, vo32), X3, acc1); }
          acc0 = mfma16(ff[0][0], T0, acc0); acc0 = mfma16(ff[0][1], T1, acc0); acc0 = mfma16(ff[0][2], T2, acc0); acc0 = mfma16(ff[0][3], T3, acc0);
          acc1 = mfma16(ff[1][0], T0, acc1); acc1 = mfma16(ff[1][1], T1, acc1); acc1 = mfma16(ff[1][2], T2, acc1); acc1 = mfma16(ff[1][3], T3, acc1);
          u32x2 w; w.x = cvt_pk_bf16(gelu_fast(acc0[0]), gelu_fast(acc0[1])); w.y = cvt_pk_bf16(gelu_fast(acc0[2]), gelu_fast(acc0[3])); *(LAS u32x2*)(yw) = w;
          w.x = cvt_pk_bf16(gelu_fast(acc1[0]), gelu_fast(acc1[1])); w.y = cvt_pk_bf16(gelu_fast(acc1[2]), gelu_fast(acc1[3])); *(LAS u32x2*)(yw + YST_LD) = w;
          fb += 8192; kb += 2048; yw += 2 * YST_LD; } }
    asm volatile("s_waitcnt lgkmcnt(0)" ::: "memory");
}
__device__ __forceinline__ void s5_glu(int unit, int wave, int lane, const bf16_t* WGLU, const float* glu_b, const float* mo_gc, bf16_t* Y, LAS unsigned char* lds) {
    const int ln = lane & 15, q = lane >> 4; LAS bf16_t* yst = (LAS bf16_t*)(lds + S5_YST); const int tl = 16 * wave + ln;
    bf16x8 YF[8];
#pragma unroll
    for (int ks = 0; ks < 8; ++ks) YF[ks] = *(const LAS bf16x8*)(yst + tl * YST_LD + 32 * ks + 8 * q);
    asm volatile("s_waitcnt lgkmcnt(0)" ::: "memory");
    float ss = 0.f;
    { const char* wb = (const char*)WGLU; const unsigned vw = (unsigned)(ln * 256 + 8 * q) * 2u; LAS bf16_t* yp = yst + tl * YST_LD + 4 * q; const char* bb = (const char*)glu_b; const unsigned vb = (unsigned)(4 * q) * 4u;
#pragma unroll 1
      for (int jb = 0; jb < 8; ++jb) { bf16x8 wf[2][8];
#pragma unroll
          for (int j = 0; j < 2; ++j)
#pragma unroll
              for (int ks = 0; ks < 8; ++ks) wf[j][ks] = ldg<bf16x8>(wb + j * 8192 + ks * 64, vw);
#pragma unroll
          for (int j = 0; j < 2; ++j) { f32x4 a2 = (f32x4){0.f, 0.f, 0.f, 0.f};
#pragma unroll
              for (int ks = 0; ks < 8; ++ks) a2 = mfma16(wf[j][ks], YF[ks], a2);
              const u32x2 yv = *(const LAS u32x2*)(yp + 16 * j); const f32x4 gb = ldg<f32x4>(bb + j * 64, vb);
              f32x4 y4; y4[0] = __uint_as_float(yv.x << 16); y4[1] = __uint_as_float(yv.x & 0xffff0000u); y4[2] = __uint_as_float(yv.y << 16); y4[3] = __uint_as_float(yv.y & 0xffff0000u);
              f32x4 o;
#pragma unroll
              for (int r = 0; r < 4; ++r) { o[r] = y4[r] * sigmoid_fast(a2[r] + gb[r]); ss += o[r] * o[r]; }
              u32x2 w; w.x = cvt_pk_bf16(o[0], o[1]); w.y = cvt_pk_bf16(o[2], o[3]); *(LAS u32x2*)(yp + 16 * j) = w; }
          wb += 16384; yp += 32; bb += 128; } }
    ss += __shfl_xor(ss, 16); ss += __shfl_xor(ss, 32);
    const float rs = __builtin_amdgcn_rsqf(ss * (1.0f / CW) + EPS);
    asm volatile("s_waitcnt lgkmcnt(0)" ::: "memory");
    { bf16_t* yr = Y + (size_t)(unit * 128 + tl) * D + AW + BW + 4 * q; LAS bf16_t* yp = yst + tl * YST_LD + 4 * q; const float* gp = mo_gc + 4 * q;
#pragma unroll 4
      for (int jn = 0; jn < 16; ++jn) { const u32x2 yv = *(const LAS u32x2*)(yp); const f32x4 gg = *(const f32x4*)(gp);
          u32x2 w; w.x = cvt_pk_bf16(__uint_as_float(yv.x << 16) * rs * gg[0], __uint_as_float(yv.x & 0xffff0000u) * rs * gg[1]); w.y = cvt_pk_bf16(__uint_as_float(yv.y << 16) * rs * gg[2], __uint_as_float(yv.y & 0xffff0000u) * rs * gg[3]);
          *(u32x2*)(yr) = w; yr += 16; yp += 16; gp += 16; } }
}

constexpr int XC_LD = 392;
constexpr int RG_XC = 0, RG_PS = 100352, RG_CAR = 112640, RG_RSB = 114176, RG_PT = 114688, RG_HC = 116224;
template <int CTRL> __device__ __forceinline__ float dppf(float old, float v) { return __int_as_float(__builtin_amdgcn_update_dpp(__float_as_int(old), __float_as_int(v), CTRL, 0xf, 0xf, false)); }
__device__ __forceinline__ void bf8_to_f32(const u32x4 o, float (&v)[8]) {
    v[0] = __uint_as_float(o.x << 16); v[1] = __uint_as_float(o.x & 0xffff0000u); v[2] = __uint_as_float(o.y << 16); v[3] = __uint_as_float(o.y & 0xffff0000u);
    v[4] = __uint_as_float(o.z << 16); v[5] = __uint_as_float(o.z & 0xffff0000u); v[6] = __uint_as_float(o.w << 16); v[7] = __uint_as_float(o.w & 0xffff0000u);
}
template <int PASS>
__device__ __forceinline__ void rglru_unit(int unit, bool first, float& cprev, int tid, int wave, int lane, const bf16_t* Z, bf16_t* Y, const bf16_t* WRG, const bf16_t* WIG,
                                           const float* conv_w, const float* conv_b, const float* rg_b, const float* ig_b, const float* lam, const float* mo_gb,
                                           float* SUMA, float* SUMH, float* SUMA2, float* SUMH2, LAS unsigned char* lds) {
    LAS bf16_t* xcl = (LAS bf16_t*)(lds + RG_XC); LAS float* PS = (LAS float*)(lds + RG_PS); LAS float* CAR = (LAS float*)(lds + RG_CAR); LAS float* RSB = (LAS float*)(lds + RG_RSB); LAS float* PT = (LAS float*)(lds + RG_PT); LAS float* HC = (LAS float*)(lds + RG_HC);
    const int t0 = unit * 128; const int ln = lane & 15, q = lane >> 4;
    if (tid < 384) {
        const int c0 = (tid % 48) * 8, tg = tid / 48; const int tb = t0 + tg * 16, s0 = tb % SEQ;
        float w0[8], w1[8], w2[8], w3[8], bb[8];
#pragma unroll
        for (int hh = 0; hh < 2; ++hh) { const f32x4 a0 = *(const f32x4*)(conv_w + 0 * BW + c0 + 4 * hh), a1 = *(const f32x4*)(conv_w + 1 * BW + c0 + 4 * hh), a2 = *(const f32x4*)(conv_w + 2 * BW + c0 + 4 * hh), a3 = *(const f32x4*)(conv_w + 3 * BW + c0 + 4 * hh), a4 = *(const f32x4*)(conv_b + c0 + 4 * hh);
#pragma unroll
            for (int j = 0; j < 4; ++j) { w0[4 * hh + j] = a0[j]; w1[4 * hh + j] = a1[j]; w2[4 * hh + j] = a2[j]; w3[4 * hh + j] = a3[j]; bb[4 * hh + j] = a4[j]; } }
        float xm1[8], xm2[8], xm3[8];
        const bf16_t* zp = Z + (size_t)tb * INC + ZX + c0;
        { const u32x4 z4 = {0u, 0u, 0u, 0u}; const u32x4 o1 = s0 >= 1 ? *(const u32x4*)(zp - INC) : z4, o2 = s0 >= 2 ? *(const u32x4*)(zp - 2 * INC) : z4, o3 = s0 >= 3 ? *(const u32x4*)(zp - 3 * INC) : z4;
          bf8_to_f32(o1, xm1); bf8_to_f32(o2, xm2); bf8_to_f32(o3, xm3); }
        LAS bf16_t* xw = xcl + (tg * 16) * XC_LD + c0;
#pragma unroll 4
        for (int i = 0; i < 16; ++i) { float x0[8]; bf8_to_f32(*(const u32x4*)(zp), x0); float v[8];
#pragma unroll
            for (int j = 0; j < 8; ++j) { v[j] = bb[j] + w3[j] * x0[j] + w2[j] * xm1[j] + w1[j] * xm2[j] + w0[j] * xm3[j]; xm3[j] = xm2[j]; xm2[j] = xm1[j]; xm1[j] = x0[j]; }
            u32x4 w; w.x = cvt_pk_bf16(v[0], v[1]); w.y = cvt_pk_bf16(v[2], v[3]); w.z = cvt_pk_bf16(v[4], v[5]); w.w = cvt_pk_bf16(v[6], v[7]);
            *(LAS u32x4*)(xw) = w; zp += INC; xw += XC_LD; }
        if (PASS == 2) { const int c = tid; float h;
            if (first) { const int pr = unit >> 1, p0 = pr - (pr % (UPB128 / 2)); h = 0.f; const float* pa = SUMA2 + (size_t)p0 * BW + c; const float* ph = SUMH2 + (size_t)p0 * BW + c;
#pragma unroll 8
                for (int j = p0; j < pr; ++j) { h = fmaf(*pa, h, *ph); pa += BW; ph += BW; } }
            else h = fmaf(SUMA[(size_t)(unit - 1) * BW + c], cprev, SUMH[(size_t)(unit - 1) * BW + c]);
            cprev = h; CAR[c] = h; }
    }
    __syncthreads();
#pragma unroll 1
    for (int ci = 0; ci < 3; ++ci) {
        const int combo = wave + 8 * ci, h = combo >> 2, jt = combo & 3, cb = h * 64 + jt * 16;
        const bf16_t* wr = WRG + ((size_t)(h * 64 + jt * 16 + ln)) * 64 + 8 * q; const bf16_t* wi = WIG + ((size_t)(h * 64 + jt * 16 + ln)) * 64 + 8 * q;
        const bf16x8 RG0 = *(const bf16x8*)(wr), RG1 = *(const bf16x8*)(wr + 32), IG0 = *(const bf16x8*)(wi), IG1 = *(const bf16x8*)(wi + 32);
        const f32x4 rgb4 = *(const f32x4*)(rg_b + cb + 4 * q), igb4 = *(const f32x4*)(ig_b + cb + 4 * q), lam4 = *(const f32x4*)(lam + cb + 4 * q);
        float spc[4], car[4], ptot[4];
#pragma unroll
        for (int r = 0; r < 4; ++r) { spc[r] = -8.0f * 1.4426950408889634f * log1pf(expf(-lam4[r])); car[r] = PASS == 2 ? CAR[cb + 4 * q + r] : (first ? 0.f : HC[cb + 4 * q + r]); ptot[r] = (PASS == 1 && !first) ? PT[cb + 4 * q + r] : 1.f; }
        const LAS bf16_t* xb = xcl + ln * XC_LD + h * 64 + 8 * q; const LAS bf16_t* xv = xcl + ln * XC_LD + cb + 4 * q;
        const bf16_t* zg = Z + (size_t)(t0 + ln) * INC + ZG + cb + 4 * q; bf16_t* yo = Y + (size_t)(t0 + ln) * D + AW + cb + 4 * q; LAS float* psw = PS + ln * 24 + combo;
#pragma unroll 1
        for (int tt = 0; tt < 8; ++tt) {
            const bf16x8 B0 = *(const LAS bf16x8*)(xb), B1 = *(const LAS bf16x8*)(xb + 32);
            f32x4 ar = (f32x4){0.f, 0.f, 0.f, 0.f}, ai = (f32x4){0.f, 0.f, 0.f, 0.f};
            ar = mfma16(RG0, B0, ar); ar = mfma16(RG1, B1, ar); ai = mfma16(IG0, B0, ai); ai = mfma16(IG1, B1, ai);
            const u32x2 xq = *(const LAS u32x2*)(xv); float xc4[4] = {__uint_as_float(xq.x << 16), __uint_as_float(xq.x & 0xffff0000u), __uint_as_float(xq.y << 16), __uint_as_float(xq.y & 0xffff0000u)};
            float hv[4];
#pragma unroll
            for (int r = 0; r < 4; ++r) {
                const float rr = sigmoid_fast(ar[r] + rgb4[r]), ii = sigmoid_fast(ai[r] + igb4[r]);
                float A = __builtin_amdgcn_exp2f(spc[r] * rr);
                float Bv = __builtin_amdgcn_sqrtf(fmaxf(1.0f - A * A, 0.f)) * (ii * xc4[r]);
                if (ln == 0) Bv = fmaf(A, car[r], Bv);
                { const float As = dppf<0x111>(1.0f, A), Bs = dppf<0x111>(0.0f, Bv); Bv = fmaf(A, Bs, Bv); A *= As; }
                { const float As = dppf<0x112>(1.0f, A), Bs = dppf<0x112>(0.0f, Bv); Bv = fmaf(A, Bs, Bv); A *= As; }
                { const float As = dppf<0x114>(1.0f, A), Bs = dppf<0x114>(0.0f, Bv); Bv = fmaf(A, Bs, Bv); A *= As; }
                { const float As = dppf<0x118>(1.0f, A), Bs = dppf<0x118>(0.0f, Bv); Bv = fmaf(A, Bs, Bv); A *= As; }
                hv[r] = Bv; car[r] = dppf<0x121>(Bv, Bv);
                if (PASS == 1) ptot[r] *= dppf<0x121>(A, A);
            }
            if (PASS == 2) { const u32x2 gq = *(const u32x2*)(zg);
                const float y0 = hv[0] * __uint_as_float(gq.x << 16), y1 = hv[1] * __uint_as_float(gq.x & 0xffff0000u), y2 = hv[2] * __uint_as_float(gq.y << 16), y3 = hv[3] * __uint_as_float(gq.y & 0xffff0000u);
                u32x2 w; w.x = cvt_pk_bf16(y0, y1); w.y = cvt_pk_bf16(y2, y3); *(u32x2*)(yo) = w;
                float ss = (y0 * y0 + y1 * y1) + (y2 * y2 + y3 * y3); ss += __shfl_xor(ss, 16); ss += __shfl_xor(ss, 32);
                if (q == 0) *psw = ss; }
            xb += 16 * XC_LD; xv += 16 * XC_LD; zg += 16 * INC; yo += 16 * D; psw += 16 * 24;
        }
        if (PASS == 1 && ln == 0) {
            float* da = first ? SUMA + (size_t)unit * BW : SUMA2 + (size_t)(unit >> 1) * BW; float* dh = first ? SUMH + (size_t)unit * BW : SUMH2 + (size_t)(unit >> 1) * BW;
#pragma unroll
            for (int r = 0; r < 4; ++r) { da[cb + 4 * q + r] = ptot[r]; dh[cb + 4 * q + r] = car[r]; if (first) { PT[cb + 4 * q + r] = ptot[r]; HC[cb + 4 * q + r] = car[r]; } } }
    }
    if (PASS == 2) {
        asm volatile("s_waitcnt vmcnt(0)" ::: "memory");
        __syncthreads();
        if (tid < 128) { float s = 0.f;
#pragma unroll
            for (int k = 0; k < 24; ++k) s += PS[tid * 24 + k];
            RSB[tid] = __builtin_amdgcn_rsqf(s * (1.0f / BW) + EPS); }
        __syncthreads();
#pragma unroll 2
        for (int k = 0; k < 12; ++k) { const int idx = tid + 512 * k, tl = idx / 48, c0 = (idx % 48) * 8; const float rs = RSB[tl];
            bf16_t* yp = Y + (size_t)(t0 + tl) * D + AW + c0; float v[8]; bf8_to_f32(*(const u32x4*)(yp), v);
            const f32x4 g0 = *(const f32x4*)(mo_gb + c0), g1 = *(const f32x4*)(mo_gb + c0 + 4);
            u32x4 w; w.x = cvt_pk_bf16(v[0] * rs * g0[0], v[1] * rs * g0[1]); w.y = cvt_pk_bf16(v[2] * rs * g0[2], v[3] * rs * g0[3]); w.z = cvt_pk_bf16(v[4] * rs * g1[0], v[5] * rs * g1[1]); w.w = cvt_pk_bf16(v[6] * rs * g1[2], v[7] * rs * g1[3]);
            *(u32x4*)(yp) = w; }
    }
    __syncthreads();
}

constexpr int VT_LD = 136;
__device__ __forceinline__ void mixa_unit(int unit, int tid, int wave, int lane, const bf16_t* Z, bf16_t* Y, const bf16_t* WSP, const float* a_sb, const float* vg, const float* mo_ga, LAS unsigned char* lds) {
    LAS bf16_t* vT = (LAS bf16_t*)lds; const int t0 = unit * 128; const int ln = lane & 15, q = lane >> 4;
    { const int j = tid >> 2, part = tid & 3; const bf16_t* zp = Z + (size_t)(t0 + j) * INC + ZV + part * 96;
      u32x4 raw[12]; float ss = 0.f;
#pragma unroll
      for (int k = 0; k < 12; ++k) { raw[k] = *(const u32x4*)(zp + 8 * k); float v[8]; bf8_to_f32(raw[k], v);
#pragma unroll
          for (int e = 0; e < 8; ++e) ss += v[e] * v[e]; }
      ss += __shfl_xor(ss, 1); ss += __shfl_xor(ss, 2);
      const float rs = __builtin_amdgcn_rsqf(ss * (1.0f / AW) + EPS);
      LAS bf16_t* vw = vT + (part * 96) * VT_LD + j; const float* gp = vg + part * 96;
#pragma unroll
      for (int k = 0; k < 12; ++k) { float v[8]; bf8_to_f32(raw[k], v); const f32x4 g0 = *(const f32x4*)(gp + 8 * k), g1 = *(const f32x4*)(gp + 8 * k + 4);
#pragma unroll
          for (int e = 0; e < 8; ++e) vw[(8 * k + e) * VT_LD] = f2bf(v[e] * rs * (e < 4 ? g0[e] : g1[e - 4])); } }
    __syncthreads();
    const bool full = wave >= 4;
    float ss = 0.f;
    const int tl = 16 * wave + ln;
    const char* ub = (const char*)(Z + (size_t)t0 * INC + ZU); const unsigned vu = (unsigned)(tl * INC + 4 * q) * 2u;
    const char* wb = (const char*)WSP; const unsigned vw = (unsigned)(tl * 128 + 8 * q) * 2u;
    char* yb = (char*)(Y + (size_t)t0 * D); const unsigned vy = (unsigned)(tl * D + 4 * q) * 2u;
    const bf16x8 z8 = {0, 0, 0, 0, 0, 0, 0, 0};
    bf16x8 Wn0 = ldg<bf16x8>(wb, vw), Wn1 = ldg<bf16x8>(wb + 64, vw), Wn2 = z8, Wn3 = z8;
    if (full) { Wn2 = ldg<bf16x8>(wb + 128, vw); Wn3 = ldg<bf16x8>(wb + 192, vw); }
    u32x2 un0 = ldg<u32x2>(ub, vu), un1 = ldg<u32x2>(ub + 32, vu), un2 = ldg<u32x2>(ub + 64, vu), un3 = ldg<u32x2>(ub + 96, vu); float bn = a_sb[tl];
    const LAS bf16_t* ap = vT + ln * VT_LD + 8 * q;
#pragma unroll 1
    for (int h = 0; h < 6; ++h) {
        const bf16x8 W0 = Wn0, W1 = Wn1, W2 = Wn2, W3 = Wn3; const u32x2 uc[4] = {un0, un1, un2, un3}; const float b = bn;
        if (h < 5) { wb += 128 * 128 * 2; ub += 128; Wn0 = ldg<bf16x8>(wb, vw); Wn1 = ldg<bf16x8>(wb + 64, vw); if (full) { Wn2 = ldg<bf16x8>(wb + 128, vw); Wn3 = ldg<bf16x8>(wb + 192, vw); }
            un0 = ldg<u32x2>(ub, vu); un1 = ldg<u32x2>(ub + 32, vu); un2 = ldg<u32x2>(ub + 64, vu); un3 = ldg<u32x2>(ub + 96, vu); bn = a_sb[(h + 1) * 128 + tl]; }
#pragma unroll
        for (int dt = 0; dt < 4; ++dt) { f32x4 acc = (f32x4){0.f, 0.f, 0.f, 0.f};
            const bf16x8 a0 = *(const LAS bf16x8*)(ap + 16 * dt * VT_LD), a1 = *(const LAS bf16x8*)(ap + 16 * dt * VT_LD + 32), a2 = *(const LAS bf16x8*)(ap + 16 * dt * VT_LD + 64), a3 = *(const LAS bf16x8*)(ap + 16 * dt * VT_LD + 96);
            acc = mfma16(a0, W0, acc); acc = mfma16(a1, W1, acc); acc = mfma16(a2, W2, acc); acc = mfma16(a3, W3, acc);
            const u32x2 u2 = uc[dt];
            const float v0 = __uint_as_float(u2.x << 16) * (acc[0] + b), v1 = __uint_as_float(u2.x & 0xffff0000u) * (acc[1] + b), v2 = __uint_as_float(u2.y << 16) * (acc[2] + b), v3 = __uint_as_float(u2.y & 0xffff0000u) * (acc[3] + b);
            ss += (v0 * v0 + v1 * v1) + (v2 * v2 + v3 * v3);
            u32x2 pk; pk.x = cvt_pk_bf16(v0, v1); pk.y = cvt_pk_bf16(v2, v3); *(u32x2*)(yb + (h * 64 + 16 * dt) * 2 + vy) = pk; }
        ap += 64 * VT_LD;
    }
    ss += __shfl_xor(ss, 16); ss += __shfl_xor(ss, 32);
    const float rs = __builtin_amdgcn_rsqf(ss * (1.0f / AW) + EPS);
    asm volatile("s_waitcnt vmcnt(0)" ::: "memory");
    { const char* gb = (const char*)mo_ga; const unsigned vg4 = (unsigned)(4 * q) * 4u;
#pragma unroll 1
      for (int kb = 0; kb < 3; ++kb) { u32x2 pk[8];
#pragma unroll
          for (int k = 0; k < 8; ++k) pk[k] = ldg<u32x2>(yb + k * 32, vy);
#pragma unroll
          for (int k = 0; k < 8; ++k) { const f32x4 gg = ldg<f32x4>(gb + k * 64, vg4);
              u32x2 w; w.x = cvt_pk_bf16(__uint_as_float(pk[k].x << 16) * rs * gg[0], __uint_as_float(pk[k].x & 0xffff0000u) * rs * gg[1]); w.y = cvt_pk_bf16(__uint_as_float(pk[k].y << 16) * rs * gg[2], __uint_as_float(pk[k].y & 0xffff0000u) * rs * gg[3]);
              *(u32x2*)(yb + k * 32 + vy) = w; }
          yb += 256; gb += 512; } }
    __syncthreads();
}

__device__ __forceinline__ void router_unit(int unit, int wave, int lane, const bf16_t* HB, const float* SSQ, const bf16_t* WRT, const float* rgb, const float* reb,
                                            int* CLS, float* G2, LAS unsigned char* lds, LAS int* hist) {
    const int ln = lane & 15, q = lane >> 4; const int t0 = unit * UT + wave * 32;
    LAS float* LG = (LAS float*)(lds + wave * 8192);
    f32x4 acc[2][3];
#pragma unroll
    for (int tt = 0; tt < 2; ++tt)
#pragma unroll
        for (int j = 0; j < 3; ++j) acc[tt][j] = (f32x4){0.f, 0.f, 0.f, 0.f};
    const bf16_t* hp0 = HB + (size_t)(t0 + ln) * D + 8 * q; const bf16_t* hp1 = hp0 + (size_t)16 * D; const bf16_t* wp = WRT + (size_t)ln * D + 8 * q;
#pragma unroll 4
    for (int ks = 0; ks < 32; ++ks) {
        const bf16x8 b0 = *(const bf16x8*)(hp0), b1 = *(const bf16x8*)(hp1);
        const bf16x8 a0 = *(const bf16x8*)(wp), a1 = *(const bf16x8*)(wp + 16 * D), a2 = *(const bf16x8*)(wp + 32 * D);
        acc[0][0] = mfma16(a0, b0, acc[0][0]); acc[0][1] = mfma16(a1, b0, acc[0][1]); acc[0][2] = mfma16(a2, b0, acc[0][2]);
        acc[1][0] = mfma16(a0, b1, acc[1][0]); acc[1][1] = mfma16(a1, b1, acc[1][1]); acc[1][2] = mfma16(a2, b1, acc[1][2]);
        hp0 += 32; hp1 += 32; wp += 32; }
#pragma unroll
    for (int tt = 0; tt < 2; ++tt)
#pragma unroll
        for (int j = 0; j < 3; ++j) *(LAS f32x4*)(LG + (16 * tt + ln) * 48 + 16 * j + 4 * q) = acc[tt][j];
    asm volatile("s_waitcnt lgkmcnt(0)" ::: "memory");
    if (lane < 32) { const int t = t0 + lane; const LAS float* lg = LG + lane * 48;
        const f32x4* sp = (const f32x4*)(SSQ + (size_t)t * 16); const f32x4 s0 = sp[0], s1 = sp[1], s2 = sp[2], s3 = sp[3];
        const float sq = ((s0[0] + s0[1]) + (s0[2] + s0[3])) + ((s1[0] + s1[1]) + (s1[2] + s1[3])) + ((s2[0] + s2[1]) + (s2[2] + s2[3])) + ((s3[0] + s3[1]) + (s3[2] + s3[3]));
        const float r = rsqrtf(sq * (1.0f / D) + EPS);
        float gl[4];
#pragma unroll
        for (int j = 0; j < 4; ++j) gl[j] = r * (lg[j] + lg[16 + j]) + rgb[j];
        int gs = 0; float gm = gl[0];
#pragma unroll
        for (int j = 1; j < 4; ++j) if (gl[j] > gm) { gm = gl[j]; gs = j; }
        float den = 0.f;
#pragma unroll
        for (int j = 0; j < 4; ++j) den += expf(gl[j] - gm);
        const float gwt = 1.0f / den;
        float el[4];
#pragma unroll
        for (int j = 0; j < 4; ++j) { float v;
            if (gs < 3) v = lg[4 + 4 * gs + j] + lg[16 + 4 + 4 * gs + j]; else v = lg[32 + j] + lg[36 + j];
            el[j] = r * v + reb[gs * 4 + j]; }
        int i0 = 0; float v0 = el[0];
#pragma unroll
        for (int j = 1; j < 4; ++j) if (el[j] > v0) { v0 = el[j]; i0 = j; }
        int i1 = 0; float v1 = -3.0e38f;
#pragma unroll
        for (int j = 0; j < 4; ++j) if (j != i0 && el[j] > v1) { v1 = el[j]; i1 = j; }
        const float e1 = expf(v1 - v0); const float w0 = gwt / (1.0f + e1), w1 = gwt * e1 / (1.0f + e1);
        const int lo = i0 < i1 ? i0 : i1, hi = i0 < i1 ? i1 : i0; const int cls = gs * 6 + pair_idx(lo, hi);
        CLS[t] = cls; G2[(size_t)t * 2 + 0] = i0 < i1 ? w0 : w1; G2[(size_t)t * 2 + 1] = i0 < i1 ? w1 : w0;
        __hip_atomic_fetch_add(hist + cls, 1, __ATOMIC_RELAXED, __HIP_MEMORY_SCOPE_WORKGROUP); }
}

struct Args { const float* in[34]; float* out; unsigned char* ws; };

__global__ void __launch_bounds__(512, 2) mega_fwd(Args a) {
    extern __shared__ __attribute__((aligned(16))) unsigned char lds_raw[];
    LAS unsigned char* lds = (LAS unsigned char*)lds_raw;
    volatile LAS unsigned* LW = (volatile LAS unsigned*)(lds + LDSCTL_OFF);
    volatile LAS int* LWI = (volatile LAS int*)(lds + LDSCTL_OFF);
    const int G = gridDim.x, bid = blockIdx.x;
#define PHASE_IDS() int tid = threadIdx.x; asm volatile("" : "+v"(tid)); const int lane = tid & 63, wave = __builtin_amdgcn_readfirstlane(tid >> 6); const int gw = bid * 8 + wave, NGW = G * 8; \
    const size_t gt = (size_t)bid * 512 + tid, NGT = (size_t)G * 512; (void)lane; (void)wave; (void)gw; (void)NGW; (void)gt; (void)NGT
#define WSB() ({ unsigned char* _w = a.ws; asm volatile("" : "+s"(_w)); _w; })
#define INP(i) ({ int _k = (i); asm volatile("" : "+s"(_k)); a.in[_k]; })
    for (int u = threadIdx.x; u < (LDS_BYTES - LDSCTL_OFF) / 4; u += 512) LW[u] = 0u;
    __syncthreads();
    XcdBarrier bar = xcd_barrier_post((unsigned*)(a.ws + WS_CTL) + CW_BAR, LW + LW_BAR);

    {
        PHASE_IDS(); unsigned char* ws = WSB(); bf16_t* WIN = (bf16_t*)(ws + WS_WIN); bf16_t* WOUT = (bf16_t*)(ws + WS_WOUT); bf16_t* WGU = (bf16_t*)(ws + WS_WGU); bf16_t* WD2 = (bf16_t*)(ws + WS_WD2);
        bf16_t* HB = (bf16_t*)(ws + WS_HB); float* SSQ = (float*)(ws + WS_SSQ);
        LAS float* scr = (LAS float*)(lds + wave * 16384);
        constexpr int I_IN = 16 * 56, I_OUT = 16 * 32, I_GU = 2 * 16 * 256, I_D2 = 48 * 256, I_GLU = 32, I_RG = 24, I_L = I_IN + I_OUT + I_GU + I_D2 + I_GLU + I_RG;
        for (int it = gw; it < 2 * I_L; it += NGW) {
            const int l = it / I_L; int r = it % I_L;
            if (r < I_IN) { const int kb = r / 56, nb = r % 56, j0 = nb * 32; const int sc = j0 < 768 ? j0 : (j0 < 1152 ? j0 + 384 : (j0 < 1536 ? j0 - 384 : j0));
                tr_item(INP(2) + (size_t)l * D * INC, INC, kb * 64, sc, INP(1) + (size_t)l * D, WIN + (size_t)l * INC * D, D, j0, kb * 64, scr, lane); continue; }
            r -= I_IN;
            if (r < I_OUT) { const int kb = r / 32, nb = r % 32; tr_item(INP(24) + (size_t)l * D * D, D, kb * 64, nb * 32, nullptr, WOUT + (size_t)l * D * D, D, nb * 32, kb * 64, scr, lane); continue; }
            r -= I_OUT;
            if (r < I_GU) { const int which = r / (16 * 256), e = (r / 256) % 16, q = r % 256, kb = q / 16, nb = q % 16, n0 = nb * 32;
                const float* src = INP(30 + which) + ((size_t)l * NE + e) * D * DE;
                tr_item(src, DE, kb * 64, n0, nullptr, WGU + ((size_t)l * NE + e) * 1024 * 1024, 1024, (n0 / 128) * 256 + which * 128 + (n0 % 128), kb * 64, scr, lane); continue; }
            r -= I_GU;
            if (r >= I_D2 + I_GLU) { r -= I_D2 + I_GLU; const int gate = r / 12, h = (r / 2) % 6, nb = r & 1;
                tr_item(INP(gate ? 10 : 8) + ((size_t)l * 6 + h) * 64 * 64, 64, 0, nb * 32, nullptr, (bf16_t*)(ws + WS_WRG) + (((size_t)l * 2 + gate) * 6 + h) * 64 * 64, 64, nb * 32, 0, scr, lane); continue; }
            if (r >= I_D2) { r -= I_D2; const int kb = r / 8, nb = r % 8; tr_item(INP(21) + (size_t)l * CW * CW, CW, kb * 64, nb * 32, nullptr, (bf16_t*)(ws + WS_WGLU) + (size_t)l * CW * CW, CW, nb * 32, kb * 64, scr, lane); continue; }
            { const int ch = r / 256, cls = ch >> 1, half = ch & 1, q = r % 256, kb = q / 32, nb = q % 32; const int g = cls / 6, pi = cls % 6, e = g * 4 + (half ? pair_hi(pi) : pair_lo(pi));
                tr_item(INP(32) + ((size_t)l * NE + e) * DE * D, D, kb * 64, nb * 32, nullptr, WD2 + ((size_t)l * NCLS + cls) * 1024 * 1024, 1024, nb * 32, half * 512 + kb * 64, scr, lane); }
        }
        { const float* s_are = INP(13); const float* s_aim = INP(14); const float* s_ldt = INP(15); const float* s_bre = INP(16); const float* s_bim = INP(17); const float* s_cre = INP(18); const float* s_cim = INP(19); const float* s_d = INP(20);
          for (size_t e = gt; e < (size_t)2 * CG * 36928; e += NGT) { const int l = (int)(e / (CG * 36928)), g = (int)((e / 36928) % CG), el = (int)(e % 36928);
              s5_table_elem(g, el, s_are + (size_t)l * CG * CS, s_aim + (size_t)l * CG * CS, s_ldt + (size_t)l * CG, s_bre + (size_t)l * CG * CS * CGD, s_bim + (size_t)l * CG * CS * CGD,
                            s_cre + (size_t)l * CG * CGD * CS, s_cim + (size_t)l * CG * CGD * CS, s_d + (size_t)l * CW, ws + WS_S5 + (size_t)l * S5_L_STRIDE); } }
        { const float* sw = INP(4); bf16_t* wsp = (bf16_t*)(ws + WS_WSP); for (size_t e = gt; e < (size_t)2 * 6 * 128 * 128; e += NGT) wsp[e] = f2bf(sw[e]); }
        { const float* fg = INP(25); const float* rgw = INP(26); const float* rew = INP(28); bf16_t* wrt = (bf16_t*)(ws + WS_WRT);
          for (size_t e = gt; e < (size_t)2 * 48 * D; e += NGT) { const int l = (int)(e / (48 * D)), n = (int)((e / D) % 48), k = (int)(e % D);
              int j = -1, lo = 0; if (n < 16) j = n; else if (n < 32) { j = n - 16; lo = 1; } else if (n < 36) j = 16 + (n - 32); else if (n < 40) { j = 16 + (n - 36); lo = 1; }
              float v = 0.f;
              if (j >= 0) { const float w = fg[(size_t)l * D + k] * (j < 4 ? rgw[((size_t)l * D + k) * 4 + j] : rew[(((size_t)l * 4 + ((j - 4) >> 2)) * D + k) * 4 + ((j - 4) & 3)]);
                  const float hi = bf2f(f2bf(w)); v = lo ? (w - hi) : w; }
              wrt[e] = f2bf(v); } }
        const float* xin = INP(0);
        for (int t = gw; t < T; t += NGW) {
            const f32x4* xr = (const f32x4*)(xin + (size_t)t * D) + lane; f32x4 v[4]; float s = 0.f;
#pragma unroll
            for (int j = 0; j < 4; ++j) { v[j] = xr[64 * j]; s += (v[j][0] * v[j][0] + v[j][1] * v[j][1]) + (v[j][2] * v[j][2] + v[j][3] * v[j][3]); }
            s = wave_sum(s);
            u32x2* o8 = (u32x2*)(HB + (size_t)t * D) + lane;
#pragma unroll
            for (int j = 0; j < 4; ++j) { u32x2 w; w.x = cvt_pk_bf16(v[j][0], v[j][1]); w.y = cvt_pk_bf16(v[j][2], v[j][3]); o8[64 * j] = w; }
            if (lane < 16) SSQ[(size_t)t * 16 + lane] = lane == 0 ? s : 0.f;
        }
    }
    xcd_barrier(bar);

    for (int l = 0; l < DEPTH; ++l) {
        { PHASE_IDS(); unsigned char* ws = WSB(); bf16_t* WIN = (bf16_t*)(ws + WS_WIN); bf16_t* HB = (bf16_t*)(ws + WS_HB); float* SSQ = (float*)(ws + WS_SSQ); bf16_t* Z = (bf16_t*)(ws + WS_Z);
          pg8::StaticOrder<T, INC> S; S.init(HB, WIN + (size_t)l * INC * D, G, bid);
          pg8::EpiZ E{Z, SSQ};
          pg8::gemm_phase<pg8::EpiZ, pg8::StaticOrder<T, INC>, true, true>(lds, D, S, E); }
        xcd_barrier(bar);

        {
            PHASE_IDS(); unsigned char* ws = WSB(); const bf16_t* Z = (const bf16_t*)(ws + WS_Z);
            const float* conv_w = INP(6) + (size_t)l * 4 * BW; const float* conv_b = INP(7) + (size_t)l * BW; const float* rg_b = INP(9) + (size_t)l * BW;
            const float* ig_b = INP(11) + (size_t)l * BW; const float* lam = INP(12) + (size_t)l * BW;
            __syncthreads();
            { const bf16_t* WRG = (const bf16_t*)(ws + WS_WRG) + ((size_t)l * 2 + 0) * 6 * 4096; const bf16_t* WIG = (const bf16_t*)(ws + WS_WRG) + ((size_t)l * 2 + 1) * 6 * 4096;
              for (int pr = bid; pr < NU128 / 2; pr += G) { float cp = 0.f;
                  rglru_unit<1>(2 * pr, true, cp, tid, wave, lane, Z, nullptr, WRG, WIG, conv_w, conv_b, rg_b, ig_b, lam, nullptr, (float*)(ws + WS_SUMA), (float*)(ws + WS_SUMH), (float*)(ws + WS_SUMA2), (float*)(ws + WS_SUMH2), lds);
                  rglru_unit<1>(2 * pr + 1, false, cp, tid, wave, lane, Z, nullptr, WRG, WIG, conv_w, conv_b, rg_b, ig_b, lam, nullptr, (float*)(ws + WS_SUMA), (float*)(ws + WS_SUMH), (float*)(ws + WS_SUMA2), (float*)(ws + WS_SUMH2), lds); } }
            for (int pr = bid; pr < NU128 / 2; pr += G) { float k0r = 0.f, k0i = 0.f, k1r = 0.f, k1i = 0.f; const unsigned char* tab = ws + WS_S5 + (size_t)l * S5_L_STRIDE;
#pragma unroll 1
                for (int ui = 0; ui < 2; ++ui) { s5_group<1>(2 * pr + ui, 2 * wave, ui == 0, k0r, k0i, wave, lane, Z, tab, (float*)(ws + WS_SEND), (float*)(ws + WS_SEND2), lds);
                                                 s5_group<1>(2 * pr + ui, 2 * wave + 1, ui == 0, k1r, k1i, wave, lane, Z, tab, (float*)(ws + WS_SEND), (float*)(ws + WS_SEND2), lds); } }
            __syncthreads();
            { const bf16_t* WSP = (const bf16_t*)(ws + WS_WSP) + (size_t)l * 6 * 128 * 128; const float* a_sb = INP(5) + (size_t)l * 6 * 128; const float* vg = INP(3) + (size_t)l * AW; const float* mo_ga = INP(23) + (size_t)l * D;
              for (int u = bid; u < NU128; u += G) mixa_unit(u, tid, wave, lane, Z, (bf16_t*)(ws + WS_Y), WSP, a_sb, vg, mo_ga, lds); }
        }
        xcd_barrier(bar);

        {
            PHASE_IDS(); unsigned char* ws = WSB(); const bf16_t* Z = (const bf16_t*)(ws + WS_Z); bf16_t* Y = (bf16_t*)(ws + WS_Y);
            const float* a_v_norm_g = INP(3) + (size_t)l * AW; const float* a_sw = INP(4) + (size_t)l * 6 * 128 * 128; const float* a_sb = INP(5) + (size_t)l * 6 * 128;
        }

        { PHASE_IDS(); unsigned char* ws = WSB(); const bf16_t* Z = (const bf16_t*)(ws + WS_Z); bf16_t* Y = (bf16_t*)(ws + WS_Y);
          { const bf16_t* WRG = (const bf16_t*)(ws + WS_WRG) + ((size_t)l * 2 + 0) * 6 * 4096; const bf16_t* WIG = (const bf16_t*)(ws + WS_WRG) + ((size_t)l * 2 + 1) * 6 * 4096;
            const float* conv_w = INP(6) + (size_t)l * 4 * BW; const float* conv_b = INP(7) + (size_t)l * BW; const float* rg_b = INP(9) + (size_t)l * BW; const float* ig_b = INP(11) + (size_t)l * BW; const float* lam = INP(12) + (size_t)l * BW;
            const float* mo_gb = INP(23) + (size_t)l * D + AW;
            __syncthreads();
            for (int pr = bid; pr < NU128 / 2; pr += G) { float cp = 0.f;
                rglru_unit<2>(2 * pr, true, cp, tid, wave, lane, Z, Y, WRG, WIG, conv_w, conv_b, rg_b, ig_b, lam, mo_gb, (float*)(ws + WS_SUMA), (float*)(ws + WS_SUMH), (float*)(ws + WS_SUMA2), (float*)(ws + WS_SUMH2), lds);
                rglru_unit<2>(2 * pr + 1, false, cp, tid, wave, lane, Z, Y, WRG, WIG, conv_w, conv_b, rg_b, ig_b, lam, mo_gb, (float*)(ws + WS_SUMA), (float*)(ws + WS_SUMH), (float*)(ws + WS_SUMA2), (float*)(ws + WS_SUMH2), lds); } }
          { const bf16_t* WGLU = (const bf16_t*)(ws + WS_WGLU) + (size_t)l * CW * CW; const float* glu_b = INP(22) + (size_t)l * CW; const float* mo_gc = INP(23) + (size_t)l * D + AW + BW;
            for (int pr = bid; pr < NU128 / 2; pr += G) { float k0r = 0.f, k0i = 0.f, k1r = 0.f, k1i = 0.f; const unsigned char* tab = ws + WS_S5 + (size_t)l * S5_L_STRIDE;
#pragma unroll 1
                for (int ui = 0; ui < 2; ++ui) { const int u = 2 * pr + ui; __syncthreads();
                    s5_group<2>(u, 2 * wave, ui == 0, k0r, k0i, wave, lane, Z, tab, (float*)(ws + WS_SEND), (float*)(ws + WS_SEND2), lds);
                    s5_group<2>(u, 2 * wave + 1, ui == 0, k1r, k1i, wave, lane, Z, tab, (float*)(ws + WS_SEND), (float*)(ws + WS_SEND2), lds);
                    __syncthreads(); s5_glu(u, wave, lane, WGLU, glu_b, mo_gc, Y, lds); } } } }
        xcd_barrier(bar);

        { PHASE_IDS(); unsigned char* ws = WSB(); bf16_t* WOUT = (bf16_t*)(ws + WS_WOUT); bf16_t* HB = (bf16_t*)(ws + WS_HB); float* SSQ = (float*)(ws + WS_SSQ); bf16_t* Y = (bf16_t*)(ws + WS_Y);
          pg8::StaticOrder<T, D> S; S.init(Y, WOUT + (size_t)l * D * D, G, bid);
          pg8::EpiRes<false> E{HB, SSQ, nullptr};
          pg8::gemm_phase<pg8::EpiRes<false>, pg8::StaticOrder<T, D>, true, true>(lds, D, S, E); }
        xcd_barrier(bar);

        { PHASE_IDS(); unsigned char* ws = WSB(); const bf16_t* HB = (const bf16_t*)(ws + WS_HB); const float* SSQ = (const float*)(ws + WS_SSQ); int* CLS = (int*)(ws + WS_CLS); float* G2 = (float*)(ws + WS_G2); int* HIST = (int*)(ws + WS_HIST);
          const float* rgb = INP(27) + (size_t)l * 4; const float* reb = INP(29) + (size_t)l * 16;
        for (int u = bid; u < NU; u += G) {
            router_unit(u, wave, lane, HB, SSQ, (const bf16_t*)(ws + WS_WRT) + (size_t)l * 48 * D, rgb, reb, CLS, G2, lds, (LAS int*)(lds + LDSCTL_OFF) + LW_HIST);
            __syncthreads();
            if (tid < 32) { HIST[u * 32 + tid] = tid < NCLS ? LWI[LW_HIST + tid] : 0; LWI[LW_HIST + tid] = 0; }
            __syncthreads();
        } }
        xcd_barrier(bar);

        { PHASE_IDS(); unsigned char* ws = WSB(); const bf16_t* HB = (const bf16_t*)(ws + WS_HB); const float* SSQ = (const float*)(ws + WS_SSQ); const int* CLS = (const int*)(ws + WS_CLS); const float* G2 = (const float*)(ws + WS_G2); const int* HIST = (const int*)(ws + WS_HIST);
          int* CTOT = (int*)(ws + WS_CTOT); int* ROWTOK = (int*)(ws + WS_ROWTOK); float* ROWG = (float*)(ws + WS_ROWG); bf16_t* HBS = (bf16_t*)(ws + WS_HBS); const float* ffn_g = INP(25) + (size_t)l * D;
        for (int u = bid; u < NU; u += G) {
            { const int c = tid & 31, part = tid >> 5; int tot = 0, pre = 0;
_Pragma("unroll 16")
              for (int k = part * 16; k < part * 16 + 16; ++k) { const int v = HIST[k * 32 + c]; tot += v; pre += k < u ? v : 0; }
              ((volatile LAS int*)lds)[tid] = tot; ((volatile LAS int*)lds)[512 + tid] = pre; }
            __syncthreads();
            if (tid < NCLS) { int tot = 0, pre = 0;
_Pragma("unroll")
                for (int k = 0; k < 16; ++k) { tot += ((volatile LAS int*)lds)[k * 32 + tid]; pre += ((volatile LAS int*)lds)[512 + k * 32 + tid]; } LWI[LW_TOT + tid] = tot; LWI[LW_BASE + tid] = pre; }
            __syncthreads();
            if (tid == 0) { int ps = 0;
_Pragma("unroll 1")
                for (int c = 0; c < NCLS; ++c) { const int tot = LWI[LW_TOT + c]; LWI[LW_BASE + c] += ps; LWI[LW_TST + c] = ps; ps += ((tot + 255) >> 8) << 8; if (bid == 0) CTOT[c] = tot; } LWI[LW_TST + NCLS] = ps; }
            if (tid < UT) LWI[LW_CLS + tid] = CLS[u * UT + tid];
            __syncthreads();
            if (tid < UT) { const int cls = LWI[LW_CLS + tid]; int rank = 0;
_Pragma("unroll 1")
                for (int i = 0; i < tid; ++i) rank += LWI[LW_CLS + i] == cls ? 1 : 0;
                const int dest = LWI[LW_BASE + cls] + rank; LWI[LW_DEST + tid] = dest; const int t = u * UT + tid;
                ROWTOK[dest] = t; ROWG[(size_t)dest * 2 + 0] = G2[(size_t)t * 2 + 0]; ROWG[(size_t)dest * 2 + 1] = G2[(size_t)t * 2 + 1]; }
            __syncthreads();
            for (int i = 0; i < 32; ++i) { const int tl = wave * 32 + i, t = u * UT + tl, dest = LWI[LW_DEST + tl];
                float sq = lane < 16 ? SSQ[(size_t)t * 16 + lane] : 0.f; sq = wave_sum(sq); const float r = rsqrtf(sq * (1.0f / D) + EPS);
#pragma unroll
                for (int hh = 0; hh < 2; ++hh) { const int d0 = hh * 512 + lane * 8; const u32x4 o = *(const u32x4*)(HB + (size_t)t * D + d0);
                    const f32x4 g0 = *(const f32x4*)(ffn_g + d0), g1 = *(const f32x4*)(ffn_g + d0 + 4);
                    u32x4 w; w.x = cvt_pk_bf16(__uint_as_float(o.x << 16) * r * g0[0], __uint_as_float(o.x & 0xffff0000u) * r * g0[1]);
                    w.y = cvt_pk_bf16(__uint_as_float(o.y << 16) * r * g0[2], __uint_as_float(o.y & 0xffff0000u) * r * g0[3]);
                    w.z = cvt_pk_bf16(__uint_as_float(o.z << 16) * r * g1[0], __uint_as_float(o.z & 0xffff0000u) * r * g1[1]);
                    w.w = cvt_pk_bf16(__uint_as_float(o.w << 16) * r * g1[2], __uint_as_float(o.w & 0xffff0000u) * r * g1[3]);
                    *(u32x4*)(HBS + (size_t)dest * D + d0) = w; } }
            if (u == bid)
_Pragma("unroll 1")
            for (int c = bid; c < NCLS; c += G) { const int tot = LWI[LW_TOT + c], r0 = LWI[LW_TST + c] + tot, r1 = LWI[LW_TST + c + 1];
                for (int r = r0 + wave; r < r1; r += 8) { if (lane == 0) { ROWTOK[r] = -1; ROWG[(size_t)r * 2] = 0.f; ROWG[(size_t)r * 2 + 1] = 0.f; }
                    *(u32x4*)(HBS + (size_t)r * D + lane * 8) = (u32x4){0u, 0u, 0u, 0u}; *(u32x4*)(HBS + (size_t)r * D + 512 + lane * 8) = (u32x4){0u, 0u, 0u, 0u}; } }
            __syncthreads();
        } }
        xcd_barrier(bar);

        { PHASE_IDS(); unsigned char* ws = WSB(); const int* CTOT = (const int*)(ws + WS_CTOT); bf16_t* HBS = (bf16_t*)(ws + WS_HBS); bf16_t* WGU = (bf16_t*)(ws + WS_WGU); bf16_t* ACT = (bf16_t*)(ws + WS_ACT); const float* ROWG = (const float*)(ws + WS_ROWG);
        if (tid == 0) { int ps = 0;
_Pragma("unroll 1")
            for (int c = 0; c < NCLS; ++c) { LWI[LW_TST + c] = ps; ps += (CTOT[c] + 255) >> 8; } LWI[LW_TST + NCLS] = ps; }
        __syncthreads();
        if (tid < 32) { const int ntile = LWI[LW_TST + NCLS]; const long L = (long)tid * G + bid; int e = -1;
            if (L < (long)ntile * 8) { const int mt = (int)(L / 8), pn = (int)(L % 8); int cls = 0;
_Pragma("unroll 1")
                for (int k = 1; k < NCLS; ++k) cls += (LWI[LW_TST + k] <= mt) ? 1 : 0;
                e = (cls << 24) | (pn << 16) | mt; }
            LWI[LW_UTAB + tid] = e; e = -1;
            if (L < (long)ntile * 4) { const int mt = (int)(L / 4), pn = (int)(L % 4); int cls = 0;
_Pragma("unroll 1")
                for (int k = 1; k < NCLS; ++k) cls += (LWI[LW_TST + k] <= mt) ? 1 : 0;
                e = (cls << 24) | (pn << 16) | mt; }
            LWI[LW_DTAB + tid] = e; }
        __syncthreads();
        { pg8::MoeOrder<8, true> S{LWI + LW_UTAB, l, (const char*)HBS, (const char*)WGU};
          pg8::EpiUp E{ACT, ROWG};
          pg8::gemm_phase<pg8::EpiUp, pg8::MoeOrder<8, true>, true, true>(lds, D, S, E); } }
        xcd_barrier(bar);

        { PHASE_IDS(); unsigned char* ws = WSB(); bf16_t* ACT = (bf16_t*)(ws + WS_ACT); bf16_t* WD2 = (bf16_t*)(ws + WS_WD2); bf16_t* HB = (bf16_t*)(ws + WS_HB); float* SSQ = (float*)(ws + WS_SSQ); const int* ROWTOK = (const int*)(ws + WS_ROWTOK);
          pg8::MoeOrder<4, false> S{LWI + LW_DTAB, l, (const char*)ACT, (const char*)WD2};
          pg8::EpiRes<true> E{HB, SSQ, ROWTOK};
          pg8::gemm_phase<pg8::EpiRes<true>, pg8::MoeOrder<4, false>, true, true>(lds, D, S, E); }
        xcd_barrier(bar);
    }

    { PHASE_IDS(); unsigned char* ws = WSB(); const bf16_t* HB = (const bf16_t*)(ws + WS_HB); const float* SSQ = (const float*)(ws + WS_SSQ); const float* fg = INP(33); float* outp = a.out;
    for (int t = gw; t < T; t += NGW) {
        float sq = lane < 16 ? SSQ[(size_t)t * 16 + lane] : 0.f; sq = wave_sum(sq); const float r = rsqrtf(sq * (1.0f / D) + EPS);
#pragma unroll
        for (int hh = 0; hh < 2; ++hh) { const int d0 = hh * 512 + lane * 8; const u32x4 o = *(const u32x4*)(HB + (size_t)t * D + d0);
            const f32x4 g0 = *(const f32x4*)(fg + d0), g1 = *(const f32x4*)(fg + d0 + 4);
            f32x4 w0, w1; w0[0] = __uint_as_float(o.x << 16) * r * g0[0]; w0[1] = __uint_as_float(o.x & 0xffff0000u) * r * g0[1]; w0[2] = __uint_as_float(o.y << 16) * r * g0[2]; w0[3] = __uint_as_float(o.y & 0xffff0000u) * r * g0[3];
            w1[0] = __uint_as_float(o.z << 16) * r * g1[0]; w1[1] = __uint_as_float(o.z & 0xffff0000u) * r * g1[1]; w1[2] = __uint_as_float(o.w << 16) * r * g1[2]; w1[3] = __uint_as_float(o.w & 0xffff0000u) * r * g1[3];
            *(f32x4*)(outp + (size_t)t * D + d0) = w0; *(f32x4*)(outp + (size_t)t * D + d0 + 4) = w1; }
    } }
}

extern "C" void kernel_launch(void* const* d_in, const int* in_sizes, int n_in, void* d_out, int out_size, void* d_ws, size_t ws_size, hipStream_t stream) {
    static int grid = 0;
    if (grid == 0) {
        if (n_in != 34 || in_sizes[0] != T * D || out_size != T * D || ws_size < WS_END) { fprintf(stderr, "kernel_launch: unexpected shapes (n_in %d, ws %zu)\n", n_in, ws_size); grid = -1; return; }
        int dev = 0, cus = 0, per_cu = 0;
        if (hipGetDevice(&dev) != hipSuccess || hipDeviceGetAttribute(&cus, hipDeviceAttributeMultiprocessorCount, dev) != hipSuccess) { grid = -1; return; }
        if (hipFuncSetAttribute((const void*)mega_fwd, hipFuncAttributeMaxDynamicSharedMemorySize, LDS_BYTES) != hipSuccess) { fprintf(stderr, "kernel_launch: hipFuncSetAttribute failed\n"); grid = -1; return; }
        if (hipOccupancyMaxActiveBlocksPerMultiprocessor(&per_cu, (const void*)mega_fwd, 512, LDS_BYTES) != hipSuccess || per_cu < 1) { fprintf(stderr, "kernel_launch: occupancy query says %d\n", per_cu); }
        (void)hipGetLastError();
        grid = cus;
    }
    if (grid < 0) return;
    (void)hipMemsetAsync((char*)d_ws + WS_CTL, 0, CTL_ZERO_BYTES, stream);
    Args a{};
    for (int i = 0; i < 34; ++i) a.in[i] = (const float*)d_in[i];
    a.out = (float*)d_out; a.ws = (unsigned char*)d_ws;
    hipLaunchKernelGGL(mega_fwd, dim3(grid), dim3(512), LDS_BYTES, stream, a);
}
```

```cpp
#include <hip/hip_runtime.h>
#include <cstdio>
#include <cstdint>

#define LAS __attribute__((address_space(3)))
typedef unsigned short bf16_t;
typedef short bf16x8 __attribute__((ext_vector_type(8)));
typedef float f32x4 __attribute__((ext_vector_type(4)));
typedef float f32x2 __attribute__((ext_vector_type(2)));
typedef unsigned u32x4 __attribute__((ext_vector_type(4)));
typedef unsigned u32x2 __attribute__((ext_vector_type(2)));
typedef int i32x4 __attribute__((ext_vector_type(4)));
typedef int i32x8 __attribute__((ext_vector_type(8)));

constexpr int D = 1024, BATCH = 8, SEQ = 8192, T = BATCH * SEQ, DEPTH = 2;
constexpr int AW = 384, BW = 384, CW = 256, HD = 64, ABLK = 128, CHUNK = 64;
constexpr int INC = 1792;
constexpr int ZU = 0, ZV = 384, ZG = 768, ZX = 1152, ZC = 1536, ZGELU_END = 1152;
constexpr int CG = 16, CGD = 16, CS = 64;
constexpr int NE = 16, DE = 512, NCLS = 24;
constexpr float EPS = 1e-6f;
constexpr int UT = 256;
constexpr int NU = T / UT;
constexpr int MAXROWS = T + NCLS * 256;

constexpr size_t MiB = 1u << 20;
constexpr size_t WS_CTL = 0, CTL_ZERO_BYTES = 1 * MiB;
constexpr size_t WS_WIN = 2 * MiB;
constexpr size_t WS_WOUT = 10 * MiB;
constexpr size_t WS_WGLU = 14 * MiB;
constexpr size_t WS_WRG = 15 * MiB;
constexpr size_t WS_WSP = 15 * MiB + 256 * 1024;
constexpr size_t WS_WRT = 15 * MiB + 768 * 1024;
constexpr size_t WS_WGU = 16 * MiB;
constexpr size_t WS_WD2 = 80 * MiB;
constexpr size_t WS_SSQ = 176 * MiB;
constexpr size_t WS_RS = 180 * MiB;
constexpr size_t WS_CLS = WS_RS + 256 * 1024;
constexpr size_t WS_G2 = WS_CLS + 256 * 1024;
constexpr size_t WS_HIST = 181 * MiB;
constexpr size_t WS_CTOT = WS_HIST + 64 * 1024;
constexpr size_t WS_ROWTOK = WS_HIST + 256 * 1024;
constexpr size_t WS_ROWG = 182 * MiB;
constexpr size_t WS_SUMA = 183 * MiB;
constexpr size_t WS_SUMH = 191 * MiB;
constexpr size_t WS_S5 = 184 * MiB;
constexpr size_t WS_SEND = 187 * MiB;
constexpr size_t WS_HB = 192 * MiB;
constexpr size_t WS_Z = 320 * MiB;
constexpr size_t WS_HBS = WS_Z;
constexpr size_t WS_Y = 544 * MiB;
constexpr size_t WS_ACT = 672 * MiB;
constexpr size_t WS_AV = 672 * MiB;
constexpr size_t WS_BV = 768 * MiB;
constexpr size_t WS_SEND2 = 864 * MiB;
constexpr size_t WS_SUMA2 = 866 * MiB;
constexpr size_t WS_SUMH2 = 867 * MiB;
constexpr size_t WS_END = 868 * MiB;
constexpr int CW_BAR = 4096;

constexpr int RING_BYTES = 131072;
constexpr int LDSCTL_OFF = 143360;
constexpr int LDS_BYTES = 147456;
constexpr int LW_BAR = 8, LW_TST = 64, LW_HIST = 96, LW_TOT = 128, LW_BASE = 160, LW_CLS = 256  , LW_DEST = 512  , LW_UTAB = 768  , LW_DTAB = 800  ;

__device__ __forceinline__ float bf2f(bf16_t v) { return __uint_as_float(((unsigned)v) << 16); }
__device__ __forceinline__ unsigned cvt_pk_bf16(float lo, float hi) { unsigned r; asm volatile("v_cvt_pk_bf16_f32 %0, %1, %2" : "=v"(r) : "v"(lo), "v"(hi)); return r; }
__device__ __forceinline__ bf16_t f2bf(float v) { return (bf16_t)(cvt_pk_bf16(v, 0.f) & 0xffffu); }
__device__ __forceinline__ unsigned pk_fp8x4(float a, float b, float c, float d) {
    a = fminf(fmaxf(a, -448.f), 448.f); b = fminf(fmaxf(b, -448.f), 448.f); c = fminf(fmaxf(c, -448.f), 448.f); d = fminf(fmaxf(d, -448.f), 448.f);
    int r = __builtin_amdgcn_cvt_pk_fp8_f32(a, b, 0, false); r = __builtin_amdgcn_cvt_pk_fp8_f32(c, d, r, true); return (unsigned)r; }
__device__ __forceinline__ int fresh_lane() { unsigned z = 0u; asm volatile("" : "+s"(z)); return (int)__builtin_amdgcn_mbcnt_hi(~0u, __builtin_amdgcn_mbcnt_lo(~0u, z)); }
__device__ __forceinline__ float x_xor1(float v) { return __int_as_float(__builtin_amdgcn_update_dpp(0, __float_as_int(v), 0xB1, 0xf, 0xf, true)); }
__device__ __forceinline__ float x_xor2(float v) { return __int_as_float(__builtin_amdgcn_update_dpp(0, __float_as_int(v), 0x4E, 0xf, 0xf, true)); }
__device__ __forceinline__ float x_hmir(float v) { return __int_as_float(__builtin_amdgcn_update_dpp(0, __float_as_int(v), 0x141, 0xf, 0xf, true)); }
__device__ __forceinline__ float x_mir(float v) { return __int_as_float(__builtin_amdgcn_update_dpp(0, __float_as_int(v), 0x140, 0xf, 0xf, true)); }
__device__ __forceinline__ float x_xor16(float v) { return __int_as_float(__builtin_amdgcn_ds_swizzle(__float_as_int(v), 0x401F)); }
__device__ __forceinline__ float add_xor32(float v) { const auto r = __builtin_amdgcn_permlane32_swap(__float_as_uint(v), __float_as_uint(v), false, false); return __uint_as_float(r[0]) + __uint_as_float(r[1]); }
__device__ __forceinline__ float add_x16_x32(float v) { v += x_xor16(v); return add_xor32(v); }
__device__ __forceinline__ float wave_sum(float v) { v += x_xor1(v); v += x_xor2(v); v += x_hmir(v); v += x_mir(v); v += x_xor16(v); return add_xor32(v); }
__device__ __forceinline__ float gelu_fast(float x) {
    const float u2 = 1.5957691216057308f * (x + 0.044715f * x * x * x);
    const float e = __builtin_amdgcn_exp2f(-1.4426950408889634f * u2);
    return x * __builtin_amdgcn_rcpf(1.0f + e);
}
__device__ __forceinline__ float sigmoid_fast(float x) { return __builtin_amdgcn_rcpf(1.0f + __builtin_amdgcn_exp2f(-1.4426950408889634f * x)); }
__device__ __forceinline__ float sigmoid_f(float x) { return 1.0f / (1.0f + expf(-x)); }
__device__ __forceinline__ int pair_lo(int pi) { return pi < 3 ? 0 : (pi < 5 ? 1 : 2); }
__device__ __forceinline__ int pair_hi(int pi) { return pi < 3 ? pi + 1 : (pi < 5 ? pi - 1 : 3); }
__device__ __forceinline__ int pair_idx(int lo, int hi) { return lo == 0 ? hi - 1 : (lo == 1 ? hi + 1 : 5); }

#define XB_TMO      128
#define XB_XCNT(j)  (256  + 64 * (j))
#define XB_XSUB(j)  (1280 + 64 * (j))
#define XB_XGEN(j)  (2304 + 64 * (j))
#define XB_TOP      3328
#define XB_TOPGEN   3392
#define XCD_BAR_WORDS 3456
#define XB_SPIN_CAP (1u << 18)
__device__ __forceinline__ unsigned xb_ld(unsigned* p)              { return __hip_atomic_load(p, __ATOMIC_RELAXED, __HIP_MEMORY_SCOPE_AGENT); }
__device__ __forceinline__ unsigned xb_add(unsigned* p, unsigned v) { return __hip_atomic_fetch_add(p, v, __ATOMIC_RELAXED, __HIP_MEMORY_SCOPE_AGENT); }
__device__ __forceinline__ unsigned xb_xcc_id() { return (unsigned)__builtin_amdgcn_s_getreg((3 << 11) | 20) & 0xFu; }
#define XB_SPIN(cond, bar) do { unsigned _sp = 0; while (cond) { __builtin_amdgcn_s_sleep(1); \
    if ((++_sp & 255u) == 0u) { if (xb_ld(&(bar)[XB_TMO])) break; if (_sp > XB_SPIN_CAP) { atomicAdd(&(bar)[XB_TMO], 1u); break; } } } } while (0)
struct XcdBarrier { unsigned* bar; unsigned x; volatile LAS unsigned* st; };
__device__ __forceinline__ XcdBarrier xcd_barrier_post(unsigned* bar, volatile LAS unsigned* st) {
    XcdBarrier b; b.bar = bar; b.x = xb_xcc_id(); b.st = st;
    if (threadIdx.x == 0) (void)xb_add(&bar[XB_XCNT(b.x)], 1u);
    return b;
}
__device__ __forceinline__ void xcd_barrier_complete(unsigned* bar, unsigned x, unsigned& nloc, unsigned& nx) {
    const unsigned G = gridDim.x * gridDim.y * gridDim.z;
    unsigned sum, cnt, mine, sp = 0u;
    for (;;) {
        sum = 0u; cnt = 0u; mine = 0u;
#pragma unroll
        for (unsigned j = 0; j < 16; ++j) { const unsigned c = xb_ld(&bar[XB_XCNT(j)]); sum += c; cnt += (c > 0u) ? 1u : 0u; mine = (j == x) ? c : mine; }
        if (sum == G) break;
        __builtin_amdgcn_s_sleep(1);
        if ((++sp & 255u) == 0u) { if (xb_ld(&bar[XB_TMO])) break; if (sp > XB_SPIN_CAP) { atomicAdd(&bar[XB_TMO], 1u); break; } }
    }
    nloc = mine > 0u ? mine : 1u; nx = cnt > 0u ? cnt : 1u;
}
__device__ __forceinline__ void xcd_barrier(const XcdBarrier& b) {
    asm volatile("s_waitcnt vmcnt(0)" ::: "memory");
    __syncthreads();
    if (threadIdx.x == 0) {
        unsigned* bar = b.bar; asm volatile("" : "+s"(bar));
        __builtin_amdgcn_s_waitcnt(0);
        unsigned bx0 = b.x; asm volatile("" : "+s"(bx0));
        unsigned nloc = b.st[0], nx = b.st[1];
        if (nloc == 0u) { xcd_barrier_complete(bar, bx0, nloc, nx); b.st[0] = nloc; b.st[1] = nx; }
        unsigned bx = b.x; asm volatile("" : "+s"(bx));
        const unsigned old = xb_add(&bar[XB_XSUB(bx)], 1u);
        const unsigned gen = old / nloc;
        if (old + 1u == (gen + 1u) * nloc) {
            __builtin_amdgcn_fence(__ATOMIC_RELEASE, "agent");
            asm volatile("s_waitcnt vmcnt(0)" ::: "memory");
            const unsigned og = xb_add(&bar[XB_TOP], 1u);
            const unsigned tg = og / nx;
            if (og + 1u == (tg + 1u) * nx) xb_add(&bar[XB_TOPGEN], 1u);
            else XB_SPIN(xb_ld(&bar[XB_TOPGEN]) == tg, bar);
            __builtin_amdgcn_fence(__ATOMIC_ACQUIRE, "agent");
            xb_add(&bar[XB_XGEN(bx)], 1u);
            asm volatile("s_waitcnt vmcnt(0)" ::: "memory");
        } else {
            XB_SPIN(xb_ld(&bar[XB_XGEN(bx)]) == gen, bar);
            __builtin_amdgcn_fence(__ATOMIC_ACQUIRE, "agent");
            asm volatile("s_waitcnt vmcnt(0)" ::: "memory");
        }
    }
    __syncthreads();
}

namespace pg8 {
#define PG8_LAS __attribute__((address_space(3)))
constexpr int BM = 256, BK = 64, HALF = 128, HTB = HALF * BK * 2, STAGE_BYTES = 8 * HTB, NXCD = 8, WGM = 8;
__host__ __device__ __forceinline__ int lds_byte(int r, int c) { const int st = (r >> 4) * 2 + (c >> 5), rr = r & 15, cc = c & 31, ob = rr * 64 + cc * 2; return st * 1024 + (ob ^ (((ob >> 9) & 1) << 5)); }
__host__ __device__ __forceinline__ void stage_rc(int b, int& R, int& C) { const int st = b / 1024, sb = b % 1024, swz = sb ^ (((sb >> 9) & 1) << 5); R = (st >> 1) * 16 + swz / 64; C = (st & 1) * 32 + (swz % 64) / 2; }
__host__ __device__ __forceinline__ int perm32(int rho) { const int n = rho >> 4, i = rho & 15; return 8 * (i >> 2) + 4 * n + (i & 3); }
struct Unit { int pm, pn; const char* A; const char* B; };

template <int M_, int N_> struct StaticOrder {
    static constexpr int nM = M_ / BM, nN = N_ / BM, nwg = nM * nN; static constexpr size_t tstep = (size_t)BM * 1024 * 2;
    int G, c; const char* A; const char* Bt;
    __device__ void init(const void* A_, const void* Bt_, int G_, int c_) { G = G_; c = c_; A = (const char*)A_; Bt = (const char*)Bt_; }
    __device__ bool next(int i, Unit& u) const {
        const long L = (long)i * G + c; if (L >= nwg) return false;
        int wgid = (int)L; { constexpr int q = nwg / NXCD, r = nwg % NXCD; const int xcd = wgid % NXCD, off = wgid / NXCD; wgid = (xcd < r ? xcd * (q + 1) : r * (q + 1) + (xcd - r) * q) + off; }
        constexpr int nig = WGM * nN; const int gid = wgid / nig, fm = gid * WGM, gsz = (nM - fm) < WGM ? (nM - fm) : WGM;
        u.pm = fm + ((wgid % nig) % gsz); u.pn = (wgid % nig) / gsz; u.A = A + (size_t)u.pm * tstep; u.B = Bt + (size_t)u.pn * tstep; return true;
    }
    __device__ __forceinline__ void a_ready(const Unit&) const {}
    __device__ __forceinline__ void done(const Unit&) const {}
};
template <class Epi, class Sched, bool ALIGN_EPI = false, bool SP2 = false, int KB = 1024, bool FP8 = false>
__device__ __forceinline__ void gemm_phase(PG8_LAS unsigned char* lds, const int wave_s, const Sched& S, const Epi& E) { const int Kdim = 0;
    const int lane = fresh_lane(), wid = wave_s, tid = wid * 64 + lane, wr = wid >> 2, wc = wid & 3, fr = lane & 15, fq = lane >> 4;
    constexpr int K = KB, nt = K / BK; (void)Kdim;
    unsigned voffA, voffB;
    { int R, C; stage_rc(tid * 16, R, C); const int Rb = Epi::PERM ? ((R & ~31) + perm32(R & 31)) : R; voffA = (unsigned)(R * K + C) * 2u; voffB = (unsigned)(Rb * K + C) * 2u; }
    constexpr size_t kstep = (size_t)(BK * 2);
    constexpr size_t hstep = (size_t)HALF * K * 2;
    constexpr size_t tstep = 2 * hstep; (void)tstep;
    const unsigned ldsw = (unsigned)wid * 1024u; const unsigned ldsb = (unsigned)(size_t)lds + ldsw;
    const int aoff = lds_byte(wr * 64 + fr, fq * 8), boff = lds_byte(wc * 32 + fr, fq * 8);
#define PG8_SA(b, h) (((b) * 2 + (h)) * HTB)
#define PG8_SB(b, h) ((4 + (b) * 2 + (h)) * HTB)
#define PG8_STAGE(bufoff, gbase, voff) do { _Pragma("unroll") for (int _i = 0; _i < 2; ++_i) { unsigned _keep; \
        asm volatile("s_mov_b32 %0, m0\n\ts_mov_b32 m0, %3\n\ts_nop 0\n\tglobal_load_lds_dwordx4 %1, %2\n\ts_mov_b32 m0, %0" : "=&s"(_keep) \
            : "v"(voff), "s"((const char*)(gbase) + (size_t)_i * (64 * K * 2)), "s"(ldsb + (unsigned)((bufoff) + _i * 8192)) : "memory"); } } while (0)
#define PG8_LDA(dst, b, h) do { if constexpr (FP8) { _Pragma("unroll") for (int m = 0; m < 4; ++m) { const i32x4 _lo = *(const PG8_LAS i32x4*)(lds + PG8_SA(b, h) + aoff + m * 2048), _hi = *(const PG8_LAS i32x4*)(lds + PG8_SA(b, h) + aoff + m * 2048 + 1024); \
            dst##8[m] = __builtin_shufflevector(_lo, _hi, 0, 1, 2, 3, 4, 5, 6, 7); } } \
        else { _Pragma("unroll") for (int m = 0; m < 4; ++m) _Pragma("unroll") for (int k = 0; k < 2; ++k) dst[m][k] = *(const PG8_LAS bf16x8*)(lds + PG8_SA(b, h) + aoff + m * 2048 + k * 1024); } } while (0)
#define PG8_LDB(dst, b, h) do { if constexpr (FP8) { _Pragma("unroll") for (int n = 0; n < 2; ++n) { const i32x4 _lo = *(const PG8_LAS i32x4*)(lds + PG8_SB(b, h) + boff + n * 2048), _hi = *(const PG8_LAS i32x4*)(lds + PG8_SB(b, h) + boff + n * 2048 + 1024); \
            dst##8[n] = __builtin_shufflevector(_lo, _hi, 0, 1, 2, 3, 4, 5, 6, 7); } } \
        else { _Pragma("unroll") for (int n = 0; n < 2; ++n) _Pragma("unroll") for (int k = 0; k < 2; ++k) dst[n][k] = *(const PG8_LAS bf16x8*)(lds + PG8_SB(b, h) + boff + n * 2048 + k * 1024); } } while (0)
#define PG8_MMA(ai, bj, At, Bt) do { __builtin_amdgcn_s_setprio(1); \
        if constexpr (FP8) { _Pragma("unroll") for (int m = 0; m < 4; ++m) _Pragma("unroll") for (int n = 0; n < 2; ++n) \
            acc[ai][bj][m][n] = __builtin_amdgcn_mfma_scale_f32_16x16x128_f8f6f4(Bt##8[n], At##8[m], acc[ai][bj][m][n], 0, 0, 0, Epi::SCALE_W, 0, Epi::SCALE_A); } \
        else { _Pragma("unroll") for (int m = 0; m < 4; ++m) _Pragma("unroll") for (int n = 0; n < 2; ++n) _Pragma("unroll") for (int k = 0; k < 2; ++k) \
            acc[ai][bj][m][n] = __builtin_amdgcn_mfma_f32_16x16x32_bf16(Bt[n][k], At[m][k], acc[ai][bj][m][n], 0, 0, 0); } \
        __builtin_amdgcn_s_setprio(0); } while (0)
#define PG8_WAIT_V(n) asm volatile("s_waitcnt vmcnt(" #n ")" ::: "memory")
#define PG8_WAIT_L(n) asm volatile("s_waitcnt lgkmcnt(" #n ")" ::: "memory")
#define PG8_BAR __builtin_amdgcn_s_barrier()
#define PG8_SCHED __builtin_amdgcn_sched_barrier(0)
    Unit cur, nxt; int ui = 0;
    if (!S.next(0, cur)) return;
    f32x4 acc[2][2][4][2];
#pragma unroll
    for (int a = 0; a < 2; ++a)
#pragma unroll
        for (int b = 0; b < 2; ++b)
#pragma unroll
            for (int m = 0; m < 4; ++m)
#pragma unroll
                for (int n = 0; n < 2; ++n) acc[a][b][m][n] = (f32x4){0.f, 0.f, 0.f, 0.f};
    bf16x8 At[4][2], B0[2][2], B1[2][2]; i32x8 At8[4], B08[2], B18[2]; (void)At; (void)B0; (void)B1; (void)At8; (void)B08; (void)B18;
    const char* cA = cur.A; const char* cB = cur.B;
    S.a_ready(cur);
    if constexpr (SP2) {
        PG8_STAGE(PG8_SB(0, 0), cB, voffB); PG8_STAGE(PG8_SB(0, 1), cB + hstep, voffB); PG8_STAGE(PG8_SA(0, 0), cA, voffA); PG8_STAGE(PG8_SA(0, 1), cA + hstep, voffA);
        if (wr == 1) PG8_BAR;
        PG8_WAIT_V(2); PG8_BAR;
        PG8_STAGE(PG8_SB(1, 0), cB + kstep, voffB); PG8_STAGE(PG8_SA(1, 0), cA + kstep, voffA); PG8_STAGE(PG8_SB(1, 1), cB + hstep + kstep, voffB);
        PG8_WAIT_V(6); PG8_BAR;
    } else {
        PG8_STAGE(PG8_SB(0, 0), cB, voffB); PG8_STAGE(PG8_SA(0, 0), cA, voffA); PG8_STAGE(PG8_SB(0, 1), cB + hstep, voffB); PG8_STAGE(PG8_SA(0, 1), cA + hstep, voffA);
        if (wr == 1) PG8_BAR;
        PG8_WAIT_V(4); PG8_BAR;
        PG8_STAGE(PG8_SB(1, 0), cB + kstep, voffB); PG8_STAGE(PG8_SA(1, 0), cA + kstep, voffA); PG8_STAGE(PG8_SB(1, 1), cB + hstep + kstep, voffB);
        PG8_WAIT_V(6); PG8_BAR;
    }
    for (;;) {
        const bool has_next = S.next(ui + 1, nxt);
        const char* nA = has_next ? nxt.A : cA; const char* nB = has_next ? nxt.B : cB;
_Pragma("unroll 1")
        for (int t = 0; t < nt; t += 2) {
            const bool last = (t == nt - 2);
            const char* a1 = cA + (size_t)(t + 1) * kstep;
            const char* a2 = last ? nA : cA + (size_t)(t + 2) * kstep; const char* b2 = last ? nB : cB + (size_t)(t + 2) * kstep;
            const char* a3 = a2 + kstep; const char* b3 = b2 + kstep;
            if (last && has_next) S.a_ready(nxt);
            if constexpr (SP2) {
            PG8_LDB(B0, 0, 0); PG8_LDB(B1, 0, 1); PG8_SCHED; PG8_LDA(At, 0, 0); PG8_STAGE(PG8_SA(1, 1), a1 + hstep, voffA);
            PG8_WAIT_V(8); PG8_WAIT_L(0); PG8_BAR; PG8_MMA(0, 0, At, B0); PG8_MMA(0, 1, At, B1); PG8_BAR; PG8_SCHED;
            PG8_LDA(At, 0, 1); PG8_STAGE(PG8_SB(0, 0), b2, voffB); PG8_STAGE(PG8_SB(0, 1), b2 + hstep, voffB); PG8_STAGE(PG8_SA(0, 0), a2, voffA);
            PG8_WAIT_V(8); PG8_WAIT_L(0); PG8_BAR; PG8_MMA(1, 0, At, B0); PG8_MMA(1, 1, At, B1); PG8_BAR; PG8_SCHED;
            PG8_LDB(B0, 1, 0); PG8_LDB(B1, 1, 1); PG8_SCHED; PG8_LDA(At, 1, 0); PG8_STAGE(PG8_SA(0, 1), a2 + hstep, voffA);
            PG8_WAIT_V(8); PG8_WAIT_L(0); PG8_BAR; PG8_MMA(0, 0, At, B0); PG8_MMA(0, 1, At, B1); PG8_BAR; PG8_SCHED;
            PG8_LDA(At, 1, 1); PG8_STAGE(PG8_SB(1, 0), b3, voffB); PG8_STAGE(PG8_SB(1, 1), b3 + hstep, voffB); PG8_STAGE(PG8_SA(1, 0), a3, voffA);
            PG8_WAIT_V(8); PG8_WAIT_L(0); PG8_BAR; PG8_MMA(1, 0, At, B0); PG8_MMA(1, 1, At, B1); PG8_BAR; PG8_SCHED;
            } else {
            PG8_LDB(B0, 0, 0); PG8_SCHED; PG8_LDA(At, 0, 0); PG8_STAGE(PG8_SA(1, 1), a1 + hstep, voffA);
            PG8_WAIT_L(8); PG8_BAR; PG8_WAIT_L(0); PG8_MMA(0, 0, At, B0); PG8_BAR; PG8_SCHED;
            PG8_LDB(B1, 0, 1); PG8_STAGE(PG8_SB(0, 0), b2, voffB);
            PG8_BAR; PG8_WAIT_L(0); PG8_MMA(0, 1, At, B1); PG8_BAR;
            PG8_LDA(At, 0, 1); PG8_STAGE(PG8_SA(0, 0), a2, voffA);
            PG8_BAR; PG8_WAIT_L(0); PG8_MMA(1, 0, At, B0); PG8_BAR; PG8_SCHED;
            PG8_STAGE(PG8_SB(0, 1), b2 + hstep, voffB);
            PG8_WAIT_V(6); PG8_BAR; PG8_MMA(1, 1, At, B1); PG8_BAR;
            PG8_LDB(B0, 1, 0); PG8_SCHED; PG8_LDA(At, 1, 0); PG8_STAGE(PG8_SA(0, 1), a2 + hstep, voffA);
            PG8_WAIT_L(8); PG8_BAR; PG8_WAIT_L(0); PG8_MMA(0, 0, At, B0); PG8_BAR; PG8_SCHED;
            PG8_LDB(B1, 1, 1); PG8_STAGE(PG8_SB(1, 0), b3, voffB);
            PG8_BAR; PG8_WAIT_L(0); PG8_MMA(0, 1, At, B1); PG8_BAR;
            PG8_LDA(At, 1, 1); PG8_STAGE(PG8_SA(1, 0), a3, voffA);
            PG8_BAR; PG8_WAIT_L(0); PG8_MMA(1, 0, At, B0); PG8_BAR; PG8_SCHED;
            PG8_STAGE(PG8_SB(1, 1), b3 + hstep, voffB);
            PG8_WAIT_V(6); PG8_BAR; PG8_MMA(1, 1, At, B1); PG8_BAR;
            }
        }
        if constexpr (ALIGN_EPI) { if (wr == 0) PG8_BAR; }
        if constexpr (!Epi::AFTER_DRAIN) { E(acc, cur, wr, wc, fr, fq); S.done(cur); }
        if (!has_next) break;
#pragma unroll
        for (int a = 0; a < 2; ++a)
#pragma unroll
            for (int b = 0; b < 2; ++b)
#pragma unroll
                for (int m = 0; m < 4; ++m)
#pragma unroll
                    for (int n = 0; n < 2; ++n) acc[a][b][m][n] = (f32x4){0.f, 0.f, 0.f, 0.f};
        cur = nxt; cA = nA; cB = nB; ++ui;
        if constexpr (ALIGN_EPI) { if (wr == 1) PG8_BAR; }
    }
    PG8_WAIT_V(0);
    if constexpr (!ALIGN_EPI) { if (wr == 0) PG8_BAR; }
    PG8_BAR;
    if constexpr (Epi::AFTER_DRAIN) { E.fused(acc, cur, wr, wc, fr, fq, lds, wid, lane); S.done(cur); }
#undef PG8_SA
#undef PG8_SB
#undef PG8_STAGE
#undef PG8_LDA
#undef PG8_LDB
#undef PG8_MMA
#undef PG8_WAIT_V
#undef PG8_WAIT_L
#undef PG8_BAR
#undef PG8_SCHED
}

template <int NP, bool UP, int ROWB> struct MoeOrder {
    const volatile LAS int* tab; int layer; const char* A; const char* W;
    __device__ bool next(int i, Unit& u) const {
        const int e = tab[i]; if (e < 0) return false;
        const int mt = e & 0xffff, pn = (e >> 16) & 0xff, cls = e >> 24;
        u.pm = mt; u.pn = pn; u.A = A + (size_t)mt * ((size_t)BM * ROWB);
        if (UP) { const int g = cls / 6, pi = cls % 6, s = pn >> 2, ex = g * 4 + (s ? pair_hi(pi) : pair_lo(pi));
            u.B = W + ((size_t)(layer * NE + ex) * 1024 + (size_t)(pn & 3) * 256) * ROWB; }
        else u.B = W + ((size_t)(layer * NCLS + cls) * 1024 + (size_t)pn * 256) * ROWB;
        return true;
    }
    __device__ __forceinline__ void a_ready(const Unit&) const {}
    __device__ __forceinline__ void done(const Unit&) const {}
};

struct EpiZ {
    static constexpr bool PERM = true, AFTER_DRAIN = false;
    bf16_t* Z; const float* ssq;
    __device__ __forceinline__ void operator()(const f32x4 (&acc)[2][2][4][2], const Unit& u, int wr, int wc, int fr, int fq) const {
        { const int ln_ = fresh_lane(); fr = ln_ & 15; fq = ln_ >> 4; }
        const int row0 = u.pm * BM + wr * 64 + fr, col0 = u.pn * BM + wc * 32 + 8 * fq;
        float rr[2][4];
#pragma unroll
        for (int ai = 0; ai < 2; ++ai) {
            f32x4 sp[4];
#pragma unroll
            for (int m = 0; m < 4; ++m) sp[m] = *(const f32x4*)(ssq + (size_t)(row0 + ai * HALF + m * 16) * 16 + 4 * fq);
#pragma unroll
            for (int m = 0; m < 4; ++m) { float t = (sp[m][0] + sp[m][1]) + (sp[m][2] + sp[m][3]); t = add_x16_x32(t); rr[ai][m] = __builtin_amdgcn_rsqf(t * (1.0f / D) + EPS); }
        }
#pragma unroll
        for (int ai = 0; ai < 2; ++ai)
#pragma unroll
            for (int m = 0; m < 4; ++m) { const int row = row0 + ai * HALF + m * 16; const float r = rr[ai][m];
                bf16_t* rowp = Z + (size_t)row * INC + col0;
#pragma unroll
                for (int bj = 0; bj < 2; ++bj) { f32x4 v0 = acc[ai][bj][m][0] * r, v1 = acc[ai][bj][m][1] * r;
                    if (u.pn * BM + bj * HALF < ZGELU_END) {
#pragma unroll
                        for (int j = 0; j < 4; ++j) { v0[j] = gelu_fast(v0[j]); v1[j] = gelu_fast(v1[j]); } }
                    u32x4 w; w.x = cvt_pk_bf16(v0[0], v0[1]); w.y = cvt_pk_bf16(v0[2], v0[3]); w.z = cvt_pk_bf16(v1[0], v1[1]); w.w = cvt_pk_bf16(v1[2], v1[3]);
                    *(u32x4*)(rowp + bj * HALF) = w; } }
    }
};
template <bool SCATTER> struct EpiRes {
    static constexpr bool PERM = true, AFTER_DRAIN = false; static constexpr int SCALE_W = 0x7b7b7b7b, SCALE_A = 0x7b7b7b7b;
    bf16_t* H; float* ssq; const int* rowtok;
    __device__ __forceinline__ void operator()(const f32x4 (&acc)[2][2][4][2], const Unit& u, int wr, int wc, int fr, int fq) const {
        { const int ln_ = fresh_lane(); fr = ln_ & 15; fq = ln_ >> 4; }
        const int row0 = u.pm * BM + wr * 64 + fr, col0 = u.pn * BM + wc * 32 + 8 * fq;
        int tokv[2][4];
#pragma unroll
        for (int ai = 0; ai < 2; ++ai)
#pragma unroll
            for (int m = 0; m < 4; ++m) { const int row = row0 + ai * HALF + m * 16; tokv[ai][m] = SCATTER ? rowtok[row] : row; }
#pragma unroll
        for (int ai = 0; ai < 2; ++ai) {
            u32x4 o[4][2];
#pragma unroll
            for (int m = 0; m < 4; ++m) { const int tok = tokv[ai][m]; const bf16_t* rowp = H + (size_t)(tok < 0 ? 0 : tok) * D + col0; o[m][0] = *(const u32x4*)(rowp); o[m][1] = *(const u32x4*)(rowp + HALF); }
#pragma unroll
            for (int m = 0; m < 4; ++m) { const int tok = tokv[ai][m]; float s = 0.f; bf16_t* rowp = H + (size_t)(tok < 0 ? 0 : tok) * D + col0;
#pragma unroll
                for (int bj = 0; bj < 2; ++bj) { const u32x4 oo = o[m][bj];
                    f32x4 v0 = acc[ai][bj][m][0], v1 = acc[ai][bj][m][1];
                    v0[0] += __uint_as_float(oo.x << 16); v0[1] += __uint_as_float(oo.x & 0xffff0000u); v0[2] += __uint_as_float(oo.y << 16); v0[3] += __uint_as_float(oo.y & 0xffff0000u);
                    v1[0] += __uint_as_float(oo.z << 16); v1[1] += __uint_as_float(oo.z & 0xffff0000u); v1[2] += __uint_as_float(oo.w << 16); v1[3] += __uint_as_float(oo.w & 0xffff0000u);
                    s += (v0[0] * v0[0] + v0[1] * v0[1]) + (v0[2] * v0[2] + v0[3] * v0[3]) + (v1[0] * v1[0] + v1[1] * v1[1]) + (v1[2] * v1[2] + v1[3] * v1[3]);
                    u32x4 w; w.x = cvt_pk_bf16(v0[0], v0[1]); w.y = cvt_pk_bf16(v0[2], v0[3]); w.z = cvt_pk_bf16(v1[0], v1[1]); w.w = cvt_pk_bf16(v1[2], v1[3]);
                    if (tok >= 0) *(u32x4*)(rowp + bj * HALF) = w; }
                s = add_x16_x32(s);
                if (fq == 0 && tok >= 0) ssq[(size_t)tok * 16 + u.pn * 4 + wc] = s; }
            asm volatile("" ::: "memory"); }
    }
};
constexpr int SC_W = 0x7b7b7b7b, SC_H = 0x7b7b7b7b, SC_ACT = 0x7b7b7b7b;
constexpr float FS_W = 16.f, FS_H = 16.f, FS_ACT = 16.f;
struct EpiUp {
    static constexpr bool PERM = true, AFTER_DRAIN = false; static constexpr int SCALE_W = SC_W, SCALE_A = SC_H;
    unsigned char* ACT; const float* rowg;
    __device__ __forceinline__ void operator()(const f32x4 (&acc)[2][2][4][2], const Unit& u, int wr, int wc, int fr, int fq) const {
        { const int ln_ = fresh_lane(); fr = ln_ & 15; fq = ln_ >> 4; }
        const int row0 = u.pm * BM + wr * 64 + fr, s = u.pn >> 2, col0 = s * 512 + (u.pn & 3) * 128 + wc * 32 + 8 * fq;
        float gt[2][4];
#pragma unroll
        for (int ai = 0; ai < 2; ++ai)
#pragma unroll
            for (int m = 0; m < 4; ++m) gt[ai][m] = rowg[(size_t)(row0 + ai * HALF + m * 16) * 2 + s];
#pragma unroll
        for (int ai = 0; ai < 2; ++ai)
#pragma unroll
            for (int m = 0; m < 4; ++m) { const int row = row0 + ai * HALF + m * 16; const float g1 = gt[ai][m];
                float o[8];
#pragma unroll
                for (int n = 0; n < 2; ++n)
#pragma unroll
                    for (int j = 0; j < 4; ++j) { const float g = acc[ai][0][m][n][j], up = acc[ai][1][m][n][j]; o[n * 4 + j] = g * sigmoid_fast(g) * up * g1; }
                u32x2 w; w.x = pk_fp8x4(o[0] * FS_ACT, o[1] * FS_ACT, o[2] * FS_ACT, o[3] * FS_ACT); w.y = pk_fp8x4(o[4] * FS_ACT, o[5] * FS_ACT, o[6] * FS_ACT, o[7] * FS_ACT);
                *(u32x2*)(ACT + (size_t)row * 1024 + col0) = w; }
    }
};
}

__device__ __forceinline__ void tr_item(const float* W, int ldw, int k0, int scol0, const float* gk, bf16_t* WT, int ldo, int drow0, int dk0, LAS float* scr, int lane) {
#pragma unroll 8
    for (int i = 0; i < 32; ++i) { const int kk = 2 * i + (lane >> 5); float v = W[(size_t)(k0 + kk) * ldw + scol0 + (lane & 31)]; if (gk) v *= gk[k0 + kk]; scr[kk * 33 + (lane & 31)] = v; }
    asm volatile("s_waitcnt lgkmcnt(0)" ::: "memory");
    const int c = lane & 7;
#pragma unroll
    for (int j = 0; j < 4; ++j) { const int n = (lane >> 3) + 8 * j; const LAS float* s = scr + (8 * c) * 33 + n;
        u32x4 o; o.x = cvt_pk_bf16(s[0 * 33], s[1 * 33]); o.y = cvt_pk_bf16(s[2 * 33], s[3 * 33]); o.z = cvt_pk_bf16(s[4 * 33], s[5 * 33]); o.w = cvt_pk_bf16(s[6 * 33], s[7 * 33]);
        *(u32x4*)(WT + (size_t)(drow0 + n) * ldo + dk0 + 8 * c) = o; }
    asm volatile("s_waitcnt lgkmcnt(0)" ::: "memory");
}

constexpr size_t S5_L_STRIDE = 1310720, S5_KT = 0, S5_ET = 131072, S5_FT = 655360, S5_LAMP = 1179648;
constexpr int S5_WSCR = 8192, S5_YST = 65536, YST_LD = 264;
constexpr int NU128 = T / 128, UPB128 = SEQ / 128;
__device__ __forceinline__ f32x4 mfma16(bf16x8 a, bf16x8 b, f32x4 c) { return __builtin_amdgcn_mfma_f32_16x16x32_bf16(a, b, c, 0, 0, 0); }

__device__ __forceinline__ void s5_table_elem(int g, int e, const float* a_re, const float* a_im, const float* log_dt, const float* b_re, const float* b_im,
                                              const float* c_re, const float* c_im, const float* dvec, unsigned char* tab) {
    const float dt = expf(log_dt[g]);
    if (e < 4096) {
        const int dd = e >> 9, c = (e >> 5) & 15, ee = (e >> 4) & 1, cp = e & 15, d = dd - ee; float s = 0.f;
        if (d >= 0) {
            for (int p = 0; p < CS; ++p) { const float lr = a_re[g * CS + p], li = a_im[g * CS + p], zr = lr * dt, zi = li * dt;
                const float sh = sinf(0.5f * zi); const float nr = expm1f(zr) * cosf(zi) - 2.0f * sh * sh, ni = expf(zr) * sinf(zi), den = lr * lr + li * li;
                const float cr = (nr * lr + ni * li) / den, ci = (ni * lr - nr * li) / den;
                const float br = b_re[((size_t)g * CS + p) * CGD + cp], bi = b_im[((size_t)g * CS + p) * CGD + cp]; const float bbr = cr * br - ci * bi, bbi = cr * bi + ci * br;
                const float mag = expf(zr * (float)d), pr = mag * cosf(zi * (float)d), pi = mag * sinf(zi * (float)d);
                const float vr = pr * bbr - pi * bbi, vi = pr * bbi + pi * bbr;
                s += c_re[((size_t)g * CGD + c) * CS + p] * vr - c_im[((size_t)g * CGD + c) * CS + p] * vi; }
            if (d == 0 && c == cp) s += dvec[g * CGD + c];
        }
        ((bf16_t*)(tab + S5_KT))[(size_t)g * 4096 + e] = f2bf(s); return;
    }
    e -= 4096;
    if (e < 16384) {
        const int n = e >> 7, k = e & 127, ri = n >> 6, p = n & 63, sp = k >> 4, cp = k & 15;
        const float lr = a_re[g * CS + p], li = a_im[g * CS + p], zr = lr * dt, zi = li * dt;
        const float sh = sinf(0.5f * zi); const float nr = expm1f(zr) * cosf(zi) - 2.0f * sh * sh, ni = expf(zr) * sinf(zi), den = lr * lr + li * li;
        const float cr = (nr * lr + ni * li) / den, ci = (ni * lr - nr * li) / den;
        const float br = b_re[((size_t)g * CS + p) * CGD + cp], bi = b_im[((size_t)g * CS + p) * CGD + cp]; const float bbr = cr * br - ci * bi, bbi = cr * bi + ci * br;
        const float d = (float)(7 - sp); const float mag = expf(zr * d), pr = mag * cosf(zi * d), pi = mag * sinf(zi * d);
        ((bf16_t*)(tab + S5_ET))[(size_t)g * 16384 + e] = f2bf(ri ? (pr * bbi + pi * bbr) : (pr * bbr - pi * bbi)); return;
    }
    e -= 16384;
    if (e < 16384) {
        const int n = e >> 7, k = e & 127, tp = n >> 4, c = n & 15, ri = k >> 6, p = k & 63;
        const float lr = a_re[g * CS + p], li = a_im[g * CS + p], zr = lr * dt, zi = li * dt;
        const float d = (float)(tp + 1); const float mag = expf(zr * d), pr = mag * cosf(zi * d), pi = mag * sinf(zi * d);
        const float cre = c_re[((size_t)g * CGD + c) * CS + p], cim = c_im[((size_t)g * CGD + c) * CS + p];
        ((bf16_t*)(tab + S5_FT))[(size_t)g * 16384 + e] = f2bf(ri ? -(cre * pi + cim * pr) : (cre * pr - cim * pi)); return;
    }
    e -= 16384;
    { const int p = e; const float lr = a_re[g * CS + p], li = a_im[g * CS + p], zr = lr * dt, zi = li * dt; float* o = (float*)(tab + S5_LAMP) + ((size_t)g * CS + p) * 8;
      float mag = expf(zr); o[0] = mag * cosf(zi); o[1] = mag * sinf(zi);
      mag = expf(zr * 8.f); o[2] = mag * cosf(zi * 8.f); o[3] = mag * sinf(zi * 8.f);
      mag = expf(zr * 128.f); o[4] = mag * cosf(zi * 128.f); o[5] = mag * sinf(zi * 128.f); o[6] = 0.f; o[7] = 0.f; }
}

template <class TT> __device__ __forceinline__ TT ldg(const void* ubase, unsigned voff) { return *(const TT*)((const char*)ubase + voff); }
template <int PASS>
__device__ __forceinline__ void s5_group(int unit, int g, bool first, float& kr, float& ki, int wave, int lane, const bf16_t* Z, const unsigned char* tab, float* SEND, float* SEND2, LAS unsigned char* lds) {
    const int ln = lane & 15, q = lane >> 4; const int t0 = unit * 128;
    const char* KTg = (const char*)(tab + S5_KT) + (size_t)g * 8192; const char* ETg = (const char*)(tab + S5_ET) + (size_t)g * 32768; const char* FTg = (const char*)(tab + S5_FT) + (size_t)g * 32768;
    const float* LAMPg = (const float*)(tab + S5_LAMP) + (size_t)g * CS * 8;
    const unsigned vo128 = (unsigned)(ln * 128 + 8 * q) * 2u;
    const unsigned vo32 = (unsigned)(ln * 32 + 8 * q) * 2u;
    LAS float* Sb = (LAS float*)(lds + wave * S5_WSCR); LAS bf16_t* Tb = (LAS bf16_t*)(lds + wave * S5_WSCR); LAS bf16_t* yst = (LAS bf16_t*)(lds + S5_YST);
    bf16x8 X0, X1, X2, X3;
    { const char* zb = (const char*)(Z + (size_t)t0 * INC + ZC + g * 16); const unsigned vz = (unsigned)((ln * 8 + (q >> 1)) * INC + 8 * (q & 1)) * 2u;
      X0 = ldg<bf16x8>(zb, vz); X1 = ldg<bf16x8>(zb + 2 * INC * 2, vz); X2 = ldg<bf16x8>(zb + 4 * INC * 2, vz); X3 = ldg<bf16x8>(zb + 6 * INC * 2, vz); }
    const float lur = LAMPg[lane * 8 + 4], lui = LAMPg[lane * 8 + 5];
    float cr = 0.f, ci = 0.f;
    if (PASS == 1) { if (!first) { cr = kr; ci = ki; } }
    else if (first) { const int pr = unit >> 1, p0 = pr - (pr % (UPB128 / 2)); const float l2r = lur * lur - lui * lui, l2i = 2.0f * lur * lui;
        const char* sb = (const char*)(SEND2 + (((size_t)p0 * CG + g) * 2) * CS); const unsigned vl = (unsigned)lane * 4u;
#pragma unroll 8
        for (int j = p0; j < pr; ++j) { const float sr = ldg<float>(sb, vl), si = ldg<float>(sb + CS * 4, vl); sb += (size_t)CG * 2 * CS * 4;
            const float nr = l2r * cr - l2i * ci + sr, ni = l2r * ci + l2i * cr + si; cr = nr; ci = ni; } }
    else { const float sr = SEND[(((size_t)(unit - 1) * CG + g) * 2 + 0) * CS + lane], si = SEND[(((size_t)(unit - 1) * CG + g) * 2 + 1) * CS + lane];
        cr = lur * kr - lui * ki + sr; ci = lur * ki + lui * kr + si; }
    if (PASS == 2) { kr = cr; ki = ci; }
    { LAS float* sw = Sb + (4 * q) * 128 + ln; const char* eb = ETg;
#pragma unroll 1
      for (int jh = 0; jh < 4; ++jh) { bf16x8 ef[2][4];
#pragma unroll
          for (int j = 0; j < 2; ++j)
#pragma unroll
              for (int ks = 0; ks < 4; ++ks) ef[j][ks] = ldg<bf16x8>(eb + j * 4096 + ks * 64, vo128);
#pragma unroll
          for (int j = 0; j < 2; ++j) { f32x4 se = (f32x4){0.f, 0.f, 0.f, 0.f};
              se = mfma16(X0, ef[j][0], se); se = mfma16(X1, ef[j][1], se); se = mfma16(X2, ef[j][2], se); se = mfma16(X3, ef[j][3], se);
              LAS float* s2 = sw + 16 * j; s2[0] = se[0]; s2[128] = se[1]; s2[256] = se[2]; s2[384] = se[3]; }
          eb += 8192; sw += 32; } }
    asm volatile("" ::: "memory");
    const float l8r = LAMPg[lane * 8 + 2], l8i = LAMPg[lane * 8 + 3];
    float sr = cr, si = ci;
    float sre[16], sim[16];
#pragma unroll
    for (int s = 0; s < 16; ++s) { sre[s] = Sb[s * 128 + lane]; sim[s] = Sb[s * 128 + 64 + lane]; }
    asm volatile("s_waitcnt lgkmcnt(0)" ::: "memory");
#pragma unroll
    for (int s = 0; s < 16; ++s) { if (PASS == 2) { Tb[s * 128 + lane] = f2bf(sr); Tb[s * 128 + 64 + lane] = f2bf(si); }
        const float nr = l8r * sr - l8i * si + sre[s], ni = l8r * si + l8i * sr + sim[s]; sr = nr; si = ni; }
    if (PASS == 1) { kr = sr; ki = si;
        float* dst = first ? SEND + (((size_t)unit * CG + g) * 2) * CS + lane : SEND2 + (((size_t)(unit >> 1) * CG + g) * 2) * CS + lane;
        dst[0] = sr; dst[CS] = si; asm volatile("" ::: "memory"); return; }
    asm volatile("" ::: "memory");
    const bf16x8 T0 = *(const LAS bf16x8*)(Tb + ln * 128 + 8 * q), T1 = *(const LAS bf16x8*)(Tb + ln * 128 + 32 + 8 * q), T2 = *(const LAS bf16x8*)(Tb + ln * 128 + 64 + 8 * q), T3 = *(const LAS bf16x8*)(Tb + ln * 128 + 96 + 8 * q);
    { LAS bf16_t* yw = yst + (ln * 8) * YST_LD + g * 16 + 4 * q; const char* fb = FTg; const char* kb = KTg;
#pragma unroll 1
      for (int th = 0; th < 4; ++th) { bf16x8 ff[2][4];
#pragma unroll
          for (int j = 0; j < 2; ++j)
#pragma unroll
              for (int ks = 0; ks < 4; ++ks) ff[j][ks] = ldg<bf16x8>(fb + j * 4096 + ks * 64, vo128);
          const bf16x8 ka = ldg<bf16x8>(kb, vo32), kc = ldg<bf16x8>(kb + 1024, vo32);
          f32x4 acc0 = (f32x4){0.f, 0.f, 0.f, 0.f}, acc1 = (f32x4){0.f, 0.f, 0.f, 0.f};
          acc0 = mfma16(ka, X0, acc0); acc1 = mfma16(kc, X0, acc1);
          if (th >= 1) { acc0 = mfma16(ldg<bf16x8>(kb - 2048, vo32), X1, acc0); acc1 = mfma16(ldg<bf16x8>(kb - 1024, vo32), X1, acc1); }
          if (th >= 2) { acc0 = mfma16(ldg<bf16x8>(kb - 4096, vo32), X2, acc0); acc1 = mfma16(ldg<bf16x8>(kb - 3072, vo32), X2, acc1); }
          if (th >= 3) { acc0 = mfma16(ldg<bf16x8>(kb - 6144, vo32), X3, acc0); acc1 = mfma16(ldg<bf16x8>(kb - 5120, vo32), X3, acc1); }
          acc0 = mfma16(ff[0][0], T0, acc0); acc0 = mfma16(ff[0][1], T1, acc0); acc0 = mfma16(ff[0][2], T2, acc0); acc0 = mfma16(ff[0][3], T3, acc0);
          acc1 = mfma16(ff[1][0], T0, acc1); acc1 = mfma16(ff[1][1], T1, acc1); acc1 = mfma16(ff[1][2], T2, acc1); acc1 = mfma16(ff[1][3], T3, acc1);
          u32x2 w; w.x = cvt_pk_bf16(gelu_fast(acc0[0]), gelu_fast(acc0[1])); w.y = cvt_pk_bf16(gelu_fast(acc0[2]), gelu_fast(acc0[3])); *(LAS u32x2*)(yw) = w;
          w.x = cvt_pk_bf16(gelu_fast(acc1[0]), gelu_fast(acc1[1])); w.y = cvt_pk_bf16(gelu_fast(acc1[2]), gelu_fast(acc1[3])); *(LAS u32x2*)(yw + YST_LD) = w;
          fb += 8192; kb += 2048; yw += 2 * YST_LD; } }
    asm volatile("s_waitcnt lgkmcnt(0)" ::: "memory");
}
__device__ __forceinline__ void s5_glu(int unit, int wave, int lane, const bf16_t* WGLU, const float* glu_b, const float* mo_gc, bf16_t* Y, LAS unsigned char* lds) {
    const int ln = lane & 15, q = lane >> 4; LAS bf16_t* yst = (LAS bf16_t*)(lds + S5_YST); const int tl = 16 * wave + ln;
    bf16x8 YF[8];
#pragma unroll
    for (int ks = 0; ks < 8; ++ks) YF[ks] = *(const LAS bf16x8*)(yst + tl * YST_LD + 32 * ks + 8 * q);
    asm volatile("s_waitcnt lgkmcnt(0)" ::: "memory");
    float ss = 0.f;
    { const char* wb = (const char*)WGLU; const unsigned vw = (unsigned)(ln * 256 + 8 * q) * 2u; LAS bf16_t* yp = yst + tl * YST_LD + 4 * q; const char* bb = (const char*)glu_b; const unsigned vb = (unsigned)(4 * q) * 4u;
#pragma unroll 1
      for (int jb = 0; jb < 8; ++jb) { bf16x8 wf[2][8];
#pragma unroll
          for (int j = 0; j < 2; ++j)
#pragma unroll
              for (int ks = 0; ks < 8; ++ks) wf[j][ks] = ldg<bf16x8>(wb + j * 8192 + ks * 64, vw);
#pragma unroll
          for (int j = 0; j < 2; ++j) { f32x4 a2 = (f32x4){0.f, 0.f, 0.f, 0.f};
#pragma unroll
              for (int ks = 0; ks < 8; ++ks) a2 = mfma16(wf[j][ks], YF[ks], a2);
              const u32x2 yv = *(const LAS u32x2*)(yp + 16 * j); const f32x4 gb = ldg<f32x4>(bb + j * 64, vb);
              f32x4 y4; y4[0] = __uint_as_float(yv.x << 16); y4[1] = __uint_as_float(yv.x & 0xffff0000u); y4[2] = __uint_as_float(yv.y << 16); y4[3] = __uint_as_float(yv.y & 0xffff0000u);
              f32x4 o;
#pragma unroll
              for (int r = 0; r < 4; ++r) { o[r] = y4[r] * sigmoid_fast(a2[r] + gb[r]); ss += o[r] * o[r]; }
              u32x2 w; w.x = cvt_pk_bf16(o[0], o[1]); w.y = cvt_pk_bf16(o[2], o[3]); *(LAS u32x2*)(yp + 16 * j) = w; }
          wb += 16384; yp += 32; bb += 128; } }
    ss = add_x16_x32(ss);
    const float rs = __builtin_amdgcn_rsqf(ss * (1.0f / CW) + EPS);
    asm volatile("s_waitcnt lgkmcnt(0)" ::: "memory");
    { bf16_t* yr = Y + (size_t)(unit * 128 + tl) * D + AW + BW + 4 * q; LAS bf16_t* yp = yst + tl * YST_LD + 4 * q; const float* gp = mo_gc + 4 * q;
#pragma unroll 4
      for (int jn = 0; jn < 16; ++jn) { const u32x2 yv = *(const LAS u32x2*)(yp); const f32x4 gg = *(const f32x4*)(gp);
          u32x2 w; w.x = cvt_pk_bf16(__uint_as_float(yv.x << 16) * rs * gg[0], __uint_as_float(yv.x & 0xffff0000u) * rs * gg[1]); w.y = cvt_pk_bf16(__uint_as_float(yv.y << 16) * rs * gg[2], __uint_as_float(yv.y & 0xffff0000u) * rs * gg[3]);
          *(u32x2*)(yr) = w; yr += 16; yp += 16; gp += 16; } }
}

constexpr int XC_LD = 392;
constexpr int RG_XC = 0, RG_PS = 100352, RG_CAR = 112640, RG_RSB = 114176, RG_PT = 114688, RG_HC = 116224;
template <int CTRL> __device__ __forceinline__ float dppf(float old, float v) { return __int_as_float(__builtin_amdgcn_update_dpp(__float_as_int(old), __float_as_int(v), CTRL, 0xf, 0xf, false)); }
__device__ __forceinline__ void bf8_to_f32(const u32x4 o, float (&v)[8]) {
    v[0] = __uint_as_float(o.x << 16); v[1] = __uint_as_float(o.x & 0xffff0000u); v[2] = __uint_as_float(o.y << 16); v[3] = __uint_as_float(o.y & 0xffff0000u);
    v[4] = __uint_as_float(o.z << 16); v[5] = __uint_as_float(o.z & 0xffff0000u); v[6] = __uint_as_float(o.w << 16); v[7] = __uint_as_float(o.w & 0xffff0000u);
}
template <int PASS>
__device__ __forceinline__ void rglru_unit(int unit, bool first, float& cprev, int tid, int wave, int lane, const bf16_t* Z, bf16_t* Y, const bf16_t* WRG, const bf16_t* WIG,
                                           const float* conv_w, const float* conv_b, const float* rg_b, const float* ig_b, const float* lam, const float* mo_gb,
                                           float* SUMA, float* SUMH, float* SUMA2, float* SUMH2, LAS unsigned char* lds) {
    LAS bf16_t* xcl = (LAS bf16_t*)(lds + RG_XC); LAS float* PS = (LAS float*)(lds + RG_PS); LAS float* CAR = (LAS float*)(lds + RG_CAR); LAS float* RSB = (LAS float*)(lds + RG_RSB); LAS float* PT = (LAS float*)(lds + RG_PT); LAS float* HC = (LAS float*)(lds + RG_HC);
    const int t0 = unit * 128; const int ln = lane & 15, q = lane >> 4;
    if (tid < 384) {
        const int c0 = (tid % 48) * 8, tg = tid / 48; const int tb = t0 + tg * 16, s0 = tb % SEQ;
        float w0[8], w1[8], w2[8], w3[8], bb[8];
#pragma unroll
        for (int hh = 0; hh < 2; ++hh) { const f32x4 a0 = *(const f32x4*)(conv_w + 0 * BW + c0 + 4 * hh), a1 = *(const f32x4*)(conv_w + 1 * BW + c0 + 4 * hh), a2 = *(const f32x4*)(conv_w + 2 * BW + c0 + 4 * hh), a3 = *(const f32x4*)(conv_w + 3 * BW + c0 + 4 * hh), a4 = *(const f32x4*)(conv_b + c0 + 4 * hh);
#pragma unroll
            for (int j = 0; j < 4; ++j) { w0[4 * hh + j] = a0[j]; w1[4 * hh + j] = a1[j]; w2[4 * hh + j] = a2[j]; w3[4 * hh + j] = a3[j]; bb[4 * hh + j] = a4[j]; } }
        float xm1[8], xm2[8], xm3[8];
        const bf16_t* zp = Z + (size_t)tb * INC + ZX + c0;
        { const u32x4 z4 = {0u, 0u, 0u, 0u}; const u32x4 o1 = s0 >= 1 ? *(const u32x4*)(zp - INC) : z4, o2 = s0 >= 2 ? *(const u32x4*)(zp - 2 * INC) : z4, o3 = s0 >= 3 ? *(const u32x4*)(zp - 3 * INC) : z4;
          bf8_to_f32(o1, xm1); bf8_to_f32(o2, xm2); bf8_to_f32(o3, xm3); }
        LAS bf16_t* xw = xcl + (tg * 16) * XC_LD + c0;
#pragma unroll 4
        for (int i = 0; i < 16; ++i) { float x0[8]; bf8_to_f32(*(const u32x4*)(zp), x0); float v[8];
#pragma unroll
            for (int j = 0; j < 8; ++j) { v[j] = bb[j] + w3[j] * x0[j] + w2[j] * xm1[j] + w1[j] * xm2[j] + w0[j] * xm3[j]; xm3[j] = xm2[j]; xm2[j] = xm1[j]; xm1[j] = x0[j]; }
            u32x4 w; w.x = cvt_pk_bf16(v[0], v[1]); w.y = cvt_pk_bf16(v[2], v[3]); w.z = cvt_pk_bf16(v[4], v[5]); w.w = cvt_pk_bf16(v[6], v[7]);
            *(LAS u32x4*)(xw) = w; zp += INC; xw += XC_LD; }
        if (PASS == 2) { const int c = tid; float h;
            if (first) { const int pr = unit >> 1, p0 = pr - (pr % (UPB128 / 2)); h = 0.f; const float* pa = SUMA2 + (size_t)p0 * BW + c; const float* ph = SUMH2 + (size_t)p0 * BW + c;
#pragma unroll 8
                for (int j = p0; j < pr; ++j) { h = fmaf(*pa, h, *ph); pa += BW; ph += BW; } }
            else h = fmaf(SUMA[(size_t)(unit - 1) * BW + c], cprev, SUMH[(size_t)(unit - 1) * BW + c]);
            cprev = h; CAR[c] = h; }
    }
    __syncthreads();
#pragma unroll 1
    for (int ci = 0; ci < 3; ++ci) {
        const int combo = wave + 8 * ci, h = combo >> 2, jt = combo & 3, cb = h * 64 + jt * 16;
        const bf16_t* wr = WRG + ((size_t)(h * 64 + jt * 16 + ln)) * 64 + 8 * q; const bf16_t* wi = WIG + ((size_t)(h * 64 + jt * 16 + ln)) * 64 + 8 * q;
        const bf16x8 RG0 = *(const bf16x8*)(wr), RG1 = *(const bf16x8*)(wr + 32), IG0 = *(const bf16x8*)(wi), IG1 = *(const bf16x8*)(wi + 32);
        const f32x4 rgb4 = *(const f32x4*)(rg_b + cb + 4 * q), igb4 = *(const f32x4*)(ig_b + cb + 4 * q), lam4 = *(const f32x4*)(lam + cb + 4 * q);
        float spc[4], car[4], ptot[4];
#pragma unroll
        for (int r = 0; r < 4; ++r) { spc[r] = -8.0f * 1.4426950408889634f * log1pf(expf(-lam4[r])); car[r] = PASS == 2 ? CAR[cb + 4 * q + r] : (first ? 0.f : HC[cb + 4 * q + r]); ptot[r] = (PASS == 1 && !first) ? PT[cb + 4 * q + r] : 1.f; }
        const LAS bf16_t* xb = xcl + ln * XC_LD + h * 64 + 8 * q; const LAS bf16_t* xv = xcl + ln * XC_LD + cb + 4 * q;
        const bf16_t* zg = Z + (size_t)(t0 + ln) * INC + ZG + cb + 4 * q; bf16_t* yo = Y + (size_t)(t0 + ln) * D + AW + cb + 4 * q; LAS float* psw = PS + ln * 24 + combo;
#pragma unroll 1
        for (int tt = 0; tt < 8; ++tt) {
            const bf16x8 B0 = *(const LAS bf16x8*)(xb), B1 = *(const LAS bf16x8*)(xb + 32);
            f32x4 ar = (f32x4){0.f, 0.f, 0.f, 0.f}, ai = (f32x4){0.f, 0.f, 0.f, 0.f};
            ar = mfma16(RG0, B0, ar); ar = mfma16(RG1, B1, ar); ai = mfma16(IG0, B0, ai); ai = mfma16(IG1, B1, ai);
            const u32x2 xq = *(const LAS u32x2*)(xv); float xc4[4] = {__uint_as_float(xq.x << 16), __uint_as_float(xq.x & 0xffff0000u), __uint_as_float(xq.y << 16), __uint_as_float(xq.y & 0xffff0000u)};
            float hv[4];
#pragma unroll
            for (int r = 0; r < 4; ++r) {
                const float rr = sigmoid_fast(ar[r] + rgb4[r]), ii = sigmoid_fast(ai[r] + igb4[r]);
                float A = __builtin_amdgcn_exp2f(spc[r] * rr);
                float Bv = __builtin_amdgcn_sqrtf(fmaxf(1.0f - A * A, 0.f)) * (ii * xc4[r]);
                if (ln == 0) Bv = fmaf(A, car[r], Bv);
                { const float As = dppf<0x111>(1.0f, A), Bs = dppf<0x111>(0.0f, Bv); Bv = fmaf(A, Bs, Bv); A *= As; }
                { const float As = dppf<0x112>(1.0f, A), Bs = dppf<0x112>(0.0f, Bv); Bv = fmaf(A, Bs, Bv); A *= As; }
                { const float As = dppf<0x114>(1.0f, A), Bs = dppf<0x114>(0.0f, Bv); Bv = fmaf(A, Bs, Bv); A *= As; }
                { const float As = dppf<0x118>(1.0f, A), Bs = dppf<0x118>(0.0f, Bv); Bv = fmaf(A, Bs, Bv); A *= As; }
                hv[r] = Bv; car[r] = dppf<0x121>(Bv, Bv);
                if (PASS == 1) ptot[r] *= dppf<0x121>(A, A);
            }
            if (PASS == 2) { const u32x2 gq = *(const u32x2*)(zg);
                const float y0 = hv[0] * __uint_as_float(gq.x << 16), y1 = hv[1] * __uint_as_float(gq.x & 0xffff0000u), y2 = hv[2] * __uint_as_float(gq.y << 16), y3 = hv[3] * __uint_as_float(gq.y & 0xffff0000u);
                u32x2 w; w.x = cvt_pk_bf16(y0, y1); w.y = cvt_pk_bf16(y2, y3); *(u32x2*)(yo) = w;
                float ss = (y0 * y0 + y1 * y1) + (y2 * y2 + y3 * y3); ss = add_x16_x32(ss);
                if (q == 0) *psw = ss; }
            xb += 16 * XC_LD; xv += 16 * XC_LD; zg += 16 * INC; yo += 16 * D; psw += 16 * 24;
        }
        if (PASS == 1 && ln == 0) {
            float* da = first ? SUMA + (size_t)unit * BW : SUMA2 + (size_t)(unit >> 1) * BW; float* dh = first ? SUMH + (size_t)unit * BW : SUMH2 + (size_t)(unit >> 1) * BW;
#pragma unroll
            for (int r = 0; r < 4; ++r) { da[cb + 4 * q + r] = ptot[r]; dh[cb + 4 * q + r] = car[r]; if (first) { PT[cb + 4 * q + r] = ptot[r]; HC[cb + 4 * q + r] = car[r]; } } }
    }
    if (PASS == 2) {
        asm volatile("s_waitcnt vmcnt(0)" ::: "memory");
        __syncthreads();
        if (tid < 128) { float s = 0.f;
#pragma unroll
            for (int k = 0; k < 24; ++k) s += PS[tid * 24 + k];
            RSB[tid] = __builtin_amdgcn_rsqf(s * (1.0f / BW) + EPS); }
        __syncthreads();
#pragma unroll 2
        for (int k = 0; k < 12; ++k) { const int idx = tid + 512 * k, tl = idx / 48, c0 = (idx % 48) * 8; const float rs = RSB[tl];
            bf16_t* yp = Y + (size_t)(t0 + tl) * D + AW + c0; float v[8]; bf8_to_f32(*(const u32x4*)(yp), v);
            const f32x4 g0 = *(const f32x4*)(mo_gb + c0), g1 = *(const f32x4*)(mo_gb + c0 + 4);
            u32x4 w; w.x = cvt_pk_bf16(v[0] * rs * g0[0], v[1] * rs * g0[1]); w.y = cvt_pk_bf16(v[2] * rs * g0[2], v[3] * rs * g0[3]); w.z = cvt_pk_bf16(v[4] * rs * g1[0], v[5] * rs * g1[1]); w.w = cvt_pk_bf16(v[6] * rs * g1[2], v[7] * rs * g1[3]);
            *(u32x4*)(yp) = w; }
    }
    __syncthreads();
}

constexpr int VT_LD = 136;
__device__ __forceinline__ void mixa_unit(int unit, int tid, int wave, int lane, const bf16_t* Z, bf16_t* Y, const bf16_t* WSP, const float* a_sb, const float* vg, const float* mo_ga, LAS unsigned char* lds) {
    LAS bf16_t* vT = (LAS bf16_t*)lds; const int t0 = unit * 128; const int ln = lane & 15, q = lane >> 4;
    { const int j = tid >> 2, part = tid & 3; const bf16_t* zp = Z + (size_t)(t0 + j) * INC + ZV + part * 96;
      u32x4 raw[12]; float ss = 0.f;
#pragma unroll
      for (int k = 0; k < 12; ++k) { raw[k] = *(const u32x4*)(zp + 8 * k); float v[8]; bf8_to_f32(raw[k], v);
#pragma unroll
          for (int e = 0; e < 8; ++e) ss += v[e] * v[e]; }
      ss += x_xor1(ss); ss += x_xor2(ss);
      const float rs = __builtin_amdgcn_rsqf(ss * (1.0f / AW) + EPS);
      LAS bf16_t* vw = vT + (part * 96) * VT_LD + j; const float* gp = vg + part * 96;
#pragma unroll
      for (int k = 0; k < 12; ++k) { float v[8]; bf8_to_f32(raw[k], v); const f32x4 g0 = *(const f32x4*)(gp + 8 * k), g1 = *(const f32x4*)(gp + 8 * k + 4);
#pragma unroll
          for (int e = 0; e < 8; ++e) vw[(8 * k + e) * VT_LD] = f2bf(v[e] * rs * (e < 4 ? g0[e] : g1[e - 4])); } }
    __syncthreads();
    const bool full = wave >= 4;
    float ss = 0.f;
    const int tl = 16 * wave + ln;
    const char* ub = (const char*)(Z + (size_t)t0 * INC + ZU); const unsigned vu = (unsigned)(tl * INC + 4 * q) * 2u;
    const char* wb = (const char*)WSP; const unsigned vw = (unsigned)(tl * 128 + 8 * q) * 2u;
    char* yb = (char*)(Y + (size_t)t0 * D); const unsigned vy = (unsigned)(tl * D + 4 * q) * 2u;
    const bf16x8 z8 = {0, 0, 0, 0, 0, 0, 0, 0};
    bf16x8 Wn0 = ldg<bf16x8>(wb, vw), Wn1 = ldg<bf16x8>(wb + 64, vw), Wn2 = z8, Wn3 = z8;
    if (full) { Wn2 = ldg<bf16x8>(wb + 128, vw); Wn3 = ldg<bf16x8>(wb + 192, vw); }
    u32x2 un0 = ldg<u32x2>(ub, vu), un1 = ldg<u32x2>(ub + 32, vu), un2 = ldg<u32x2>(ub + 64, vu), un3 = ldg<u32x2>(ub + 96, vu); float bn = a_sb[tl];
    const LAS bf16_t* ap = vT + ln * VT_LD + 8 * q;
#pragma unroll 1
    for (int h = 0; h < 6; ++h) {
        const bf16x8 W0 = Wn0, W1 = Wn1, W2 = Wn2, W3 = Wn3; const u32x2 uc[4] = {un0, un1, un2, un3}; const float b = bn;
        if (h < 5) { wb += 128 * 128 * 2; ub += 128; Wn0 = ldg<bf16x8>(wb, vw); Wn1 = ldg<bf16x8>(wb + 64, vw); if (full) { Wn2 = ldg<bf16x8>(wb + 128, vw); Wn3 = ldg<bf16x8>(wb + 192, vw); }
            un0 = ldg<u32x2>(ub, vu); un1 = ldg<u32x2>(ub + 32, vu); un2 = ldg<u32x2>(ub + 64, vu); un3 = ldg<u32x2>(ub + 96, vu); bn = a_sb[(h + 1) * 128 + tl]; }
#pragma unroll
        for (int dt = 0; dt < 4; ++dt) { f32x4 acc = (f32x4){0.f, 0.f, 0.f, 0.f};
            const bf16x8 a0 = *(const LAS bf16x8*)(ap + 16 * dt * VT_LD), a1 = *(const LAS bf16x8*)(ap + 16 * dt * VT_LD + 32), a2 = *(const LAS bf16x8*)(ap + 16 * dt * VT_LD + 64), a3 = *(const LAS bf16x8*)(ap + 16 * dt * VT_LD + 96);
            acc = mfma16(a0, W0, acc); acc = mfma16(a1, W1, acc); acc = mfma16(a2, W2, acc); acc = mfma16(a3, W3, acc);
            const u32x2 u2 = uc[dt];
            const float v0 = __uint_as_float(u2.x << 16) * (acc[0] + b), v1 = __uint_as_float(u2.x & 0xffff0000u) * (acc[1] + b), v2 = __uint_as_float(u2.y << 16) * (acc[2] + b), v3 = __uint_as_float(u2.y & 0xffff0000u) * (acc[3] + b);
            ss += (v0 * v0 + v1 * v1) + (v2 * v2 + v3 * v3);
            u32x2 pk; pk.x = cvt_pk_bf16(v0, v1); pk.y = cvt_pk_bf16(v2, v3); *(u32x2*)(yb + (h * 64 + 16 * dt) * 2 + vy) = pk; }
        ap += 64 * VT_LD;
    }
    ss = add_x16_x32(ss);
    const float rs = __builtin_amdgcn_rsqf(ss * (1.0f / AW) + EPS);
    asm volatile("s_waitcnt vmcnt(0)" ::: "memory");
    { const char* gb = (const char*)mo_ga; const unsigned vg4 = (unsigned)(4 * q) * 4u;
#pragma unroll 1
      for (int kb = 0; kb < 3; ++kb) { u32x2 pk[8];
#pragma unroll
          for (int k = 0; k < 8; ++k) pk[k] = ldg<u32x2>(yb + k * 32, vy);
#pragma unroll
          for (int k = 0; k < 8; ++k) { const f32x4 gg = ldg<f32x4>(gb + k * 64, vg4);
              u32x2 w; w.x = cvt_pk_bf16(__uint_as_float(pk[k].x << 16) * rs * gg[0], __uint_as_float(pk[k].x & 0xffff0000u) * rs * gg[1]); w.y = cvt_pk_bf16(__uint_as_float(pk[k].y << 16) * rs * gg[2], __uint_as_float(pk[k].y & 0xffff0000u) * rs * gg[3]);
              *(u32x2*)(yb + k * 32 + vy) = w; }
          yb += 256; gb += 512; } }
    __syncthreads();
}

__device__ __forceinline__ void router_unit(int unit, int wave, int lane, const bf16_t* HB, const float* SSQ, const bf16_t* WRT, const float* rgb, const float* reb,
                                            int* CLS, float* G2, LAS unsigned char* lds, LAS int* hist) {
    const int ln = lane & 15, q = lane >> 4; const int t0 = unit * UT + wave * 32;
    LAS float* LG = (LAS float*)(lds + wave * 8192);
    f32x4 acc[2][3];
#pragma unroll
    for (int tt = 0; tt < 2; ++tt)
#pragma unroll
        for (int j = 0; j < 3; ++j) acc[tt][j] = (f32x4){0.f, 0.f, 0.f, 0.f};
    const bf16_t* hp0 = HB + (size_t)(t0 + ln) * D + 8 * q; const bf16_t* hp1 = hp0 + (size_t)16 * D; const bf16_t* wp = WRT + (size_t)ln * D + 8 * q;
#pragma unroll 4
    for (int ks = 0; ks < 32; ++ks) {
        const bf16x8 b0 = *(const bf16x8*)(hp0), b1 = *(const bf16x8*)(hp1);
        const bf16x8 a0 = *(const bf16x8*)(wp), a1 = *(const bf16x8*)(wp + 16 * D), a2 = *(const bf16x8*)(wp + 32 * D);
        acc[0][0] = mfma16(a0, b0, acc[0][0]); acc[0][1] = mfma16(a1, b0, acc[0][1]); acc[0][2] = mfma16(a2, b0, acc[0][2]);
        acc[1][0] = mfma16(a0, b1, acc[1][0]); acc[1][1] = mfma16(a1, b1, acc[1][1]); acc[1][2] = mfma16(a2, b1, acc[1][2]);
        hp0 += 32; hp1 += 32; wp += 32; }
#pragma unroll
    for (int tt = 0; tt < 2; ++tt)
#pragma unroll
        for (int j = 0; j < 3; ++j) *(LAS f32x4*)(LG + (16 * tt + ln) * 48 + 16 * j + 4 * q) = acc[tt][j];
    asm volatile("s_waitcnt lgkmcnt(0)" ::: "memory");
    if (lane < 32) { const int t = t0 + lane; const LAS float* lg = LG + lane * 48;
        const f32x4* sp = (const f32x4*)(SSQ + (size_t)t * 16); const f32x4 s0 = sp[0], s1 = sp[1], s2 = sp[2], s3 = sp[3];
        const float sq = ((s0[0] + s0[1]) + (s0[2] + s0[3])) + ((s1[0] + s1[1]) + (s1[2] + s1[3])) + ((s2[0] + s2[1]) + (s2[2] + s2[3])) + ((s3[0] + s3[1]) + (s3[2] + s3[3]));
        const float r = rsqrtf(sq * (1.0f / D) + EPS);
        float gl[4];
#pragma unroll
        for (int j = 0; j < 4; ++j) gl[j] = r * (lg[j] + lg[16 + j]) + rgb[j];
        int gs = 0; float gm = gl[0];
#pragma unroll
        for (int j = 1; j < 4; ++j) if (gl[j] > gm) { gm = gl[j]; gs = j; }
        float den = 0.f;
#pragma unroll
        for (int j = 0; j < 4; ++j) den += expf(gl[j] - gm);
        const float gwt = 1.0f / den;
        float el[4];
#pragma unroll
        for (int j = 0; j < 4; ++j) { float v;
            if (gs < 3) v = lg[4 + 4 * gs + j] + lg[16 + 4 + 4 * gs + j]; else v = lg[32 + j] + lg[36 + j];
            el[j] = r * v + reb[gs * 4 + j]; }
        int i0 = 0; float v0 = el[0];
#pragma unroll
        for (int j = 1; j < 4; ++j) if (el[j] > v0) { v0 = el[j]; i0 = j; }
        int i1 = 0; float v1 = -3.0e38f;
#pragma unroll
        for (int j = 0; j < 4; ++j) if (j != i0 && el[j] > v1) { v1 = el[j]; i1 = j; }
        const float e1 = expf(v1 - v0); const float w0 = gwt / (1.0f + e1), w1 = gwt * e1 / (1.0f + e1);
        const int lo = i0 < i1 ? i0 : i1, hi = i0 < i1 ? i1 : i0; const int cls = gs * 6 + pair_idx(lo, hi);
        CLS[t] = cls; G2[(size_t)t * 2 + 0] = i0 < i1 ? w0 : w1; G2[(size_t)t * 2 + 1] = i0 < i1 ? w1 : w0;
        __hip_atomic_fetch_add(hist + cls, 1, __ATOMIC_RELAXED, __HIP_MEMORY_SCOPE_WORKGROUP); }
}

__device__ __forceinline__ void tr_item8(const float* W, int ldw, int k0, int scol0, unsigned char* WT, int ldo, int drow0, int dk0, LAS float* scr, int lane) {
#pragma unroll 8
    for (int i = 0; i < 32; ++i) { const int kk = 2 * i + (lane >> 5); scr[kk * 33 + (lane & 31)] = W[(size_t)(k0 + kk) * ldw + scol0 + (lane & 31)] * pg8::FS_W; }
    asm volatile("s_waitcnt lgkmcnt(0)" ::: "memory");
    const int c = lane & 7;
#pragma unroll
    for (int j = 0; j < 4; ++j) { const int n = (lane >> 3) + 8 * j; const LAS float* s = scr + (8 * c) * 33 + n;
        u32x2 o; o.x = pk_fp8x4(s[0 * 33], s[1 * 33], s[2 * 33], s[3 * 33]); o.y = pk_fp8x4(s[4 * 33], s[5 * 33], s[6 * 33], s[7 * 33]);
        *(u32x2*)(WT + (size_t)(drow0 + n) * ldo + dk0 + 8 * c) = o; }
    asm volatile("s_waitcnt lgkmcnt(0)" ::: "memory");
}
struct Args { const float* in[34]; float* out; unsigned char* ws; };

__global__ void __launch_bounds__(512, 2) mega_fwd(Args a) {
    extern __shared__ __attribute__((aligned(16))) unsigned char lds_raw[];
    LAS unsigned char* lds = (LAS unsigned char*)lds_raw;
    volatile LAS unsigned* LW = (volatile LAS unsigned*)(lds + LDSCTL_OFF);
    volatile LAS int* LWI = (volatile LAS int*)(lds + LDSCTL_OFF);
    const int G = gridDim.x, bid0 = blockIdx.x; const int wave_s0 = __builtin_amdgcn_readfirstlane(threadIdx.x >> 6);
#define PHASE_IDS() int wv_ = wave_s0, bd_ = bid0; asm volatile("" : "+s"(wv_), "+s"(bd_)); const int wave_s = wv_, bid = bd_;     \
    const int lane = fresh_lane(), wave = wave_s, tid = wave * 64 + lane; const int gw = bid * 8 + wave, NGW = G * 8; \
    const size_t gt = (size_t)bid * 512 + tid, NGT = (size_t)G * 512; (void)lane; (void)wave; (void)gw; (void)NGW; (void)gt; (void)NGT
#define WSB() ({ unsigned char* _w = a.ws; asm volatile("" : "+s"(_w)); _w; })
#define INP(i) ({ int _k = (i); asm volatile("" : "+s"(_k)); a.in[_k]; })
    for (int u = threadIdx.x; u < (LDS_BYTES - LDSCTL_OFF) / 4; u += 512) LW[u] = 0u;
    __syncthreads();
    XcdBarrier bar = xcd_barrier_post((unsigned*)(a.ws + WS_CTL) + CW_BAR, LW + LW_BAR);

    {
        PHASE_IDS(); unsigned char* ws = WSB(); bf16_t* WIN = (bf16_t*)(ws + WS_WIN); bf16_t* WOUT = (bf16_t*)(ws + WS_WOUT); bf16_t* WGU = (bf16_t*)(ws + WS_WGU); bf16_t* WD2 = (bf16_t*)(ws + WS_WD2);
        bf16_t* HB = (bf16_t*)(ws + WS_HB); float* SSQ = (float*)(ws + WS_SSQ);
        LAS float* scr = (LAS float*)(lds + wave * 16384);
        constexpr int I_IN = 16 * 56, I_OUT = 16 * 32, I_GU = 2 * 16 * 256, I_D2 = 48 * 256, I_GLU = 32, I_RG = 24, I_L = I_IN + I_OUT + I_GU + I_D2 + I_GLU + I_RG;
        for (int it = gw; it < 2 * I_L; it += NGW) {
            const int l = it / I_L; int r = it % I_L;
            if (r < I_IN) { const int kb = r / 56, nb = r % 56, j0 = nb * 32; const int sc = j0 < 768 ? j0 : (j0 < 1152 ? j0 + 384 : (j0 < 1536 ? j0 - 384 : j0));
                tr_item(INP(2) + (size_t)l * D * INC, INC, kb * 64, sc, INP(1) + (size_t)l * D, WIN + (size_t)l * INC * D, D, j0, kb * 64, scr, lane); continue; }
            r -= I_IN;
            if (r < I_OUT) { const int kb = r / 32, nb = r % 32; tr_item(INP(24) + (size_t)l * D * D, D, kb * 64, nb * 32, nullptr, WOUT + (size_t)l * D * D, D, nb * 32, kb * 64, scr, lane); continue; }
            r -= I_OUT;
            if (r < I_GU) { const int which = r / (16 * 256), e = (r / 256) % 16, q = r % 256, kb = q / 16, nb = q % 16, n0 = nb * 32;
                const float* src = INP(30 + which) + ((size_t)l * NE + e) * D * DE;
                tr_item8(src, DE, kb * 64, n0, (unsigned char*)WGU + ((size_t)l * NE + e) * 1024 * 1024, 1024, (n0 / 128) * 256 + which * 128 + (n0 % 128), kb * 64, scr, lane); continue; }
            r -= I_GU;
            if (r >= I_D2 + I_GLU) { r -= I_D2 + I_GLU; const int gate = r / 12, h = (r / 2) % 6, nb = r & 1;
                tr_item(INP(gate ? 10 : 8) + ((size_t)l * 6 + h) * 64 * 64, 64, 0, nb * 32, nullptr, (bf16_t*)(ws + WS_WRG) + (((size_t)l * 2 + gate) * 6 + h) * 64 * 64, 64, nb * 32, 0, scr, lane); continue; }
            if (r >= I_D2) { r -= I_D2; const int kb = r / 8, nb = r % 8; tr_item(INP(21) + (size_t)l * CW * CW, CW, kb * 64, nb * 32, nullptr, (bf16_t*)(ws + WS_WGLU) + (size_t)l * CW * CW, CW, nb * 32, kb * 64, scr, lane); continue; }
            { const int ch = r / 256, cls = ch >> 1, half = ch & 1, q = r % 256, kb = q / 32, nb = q % 32; const int g = cls / 6, pi = cls % 6, e = g * 4 + (half ? pair_hi(pi) : pair_lo(pi));
                tr_item8(INP(32) + ((size_t)l * NE + e) * DE * D, D, kb * 64, nb * 32, (unsigned char*)WD2 + ((size_t)l * NCLS + cls) * 1024 * 1024, 1024, nb * 32, half * 512 + kb * 64, scr, lane); }
        }
        { const float* s_are = INP(13); const float* s_aim = INP(14); const float* s_ldt = INP(15); const float* s_bre = INP(16); const float* s_bim = INP(17); const float* s_cre = INP(18); const float* s_cim = INP(19); const float* s_d = INP(20);
          for (size_t e = gt; e < (size_t)2 * CG * 36928; e += NGT) { const int l = (int)(e / (CG * 36928)), g = (int)((e / 36928) % CG), el = (int)(e % 36928);
              s5_table_elem(g, el, s_are + (size_t)l * CG * CS, s_aim + (size_t)l * CG * CS, s_ldt + (size_t)l * CG, s_bre + (size_t)l * CG * CS * CGD, s_bim + (size_t)l * CG * CS * CGD,
                            s_cre + (size_t)l * CG * CGD * CS, s_cim + (size_t)l * CG * CGD * CS, s_d + (size_t)l * CW, ws + WS_S5 + (size_t)l * S5_L_STRIDE); } }
        { const float* sw = INP(4); bf16_t* wsp = (bf16_t*)(ws + WS_WSP); for (size_t e = gt; e < (size_t)2 * 6 * 128 * 128; e += NGT) wsp[e] = f2bf(sw[e]); }
        { const float* fg = INP(25); const float* rgw = INP(26); const float* rew = INP(28); bf16_t* wrt = (bf16_t*)(ws + WS_WRT);
          for (size_t e = gt; e < (size_t)2 * 48 * D; e += NGT) { const int l = (int)(e / (48 * D)), n = (int)((e / D) % 48), k = (int)(e % D);
              int j = -1, lo = 0; if (n < 16) j = n; else if (n < 32) { j = n - 16; lo = 1; } else if (n < 36) j = 16 + (n - 32); else if (n < 40) { j = 16 + (n - 36); lo = 1; }
              float v = 0.f;
              if (j >= 0) { const float w = fg[(size_t)l * D + k] * (j < 4 ? rgw[((size_t)l * D + k) * 4 + j] : rew[(((size_t)l * 4 + ((j - 4) >> 2)) * D + k) * 4 + ((j - 4) & 3)]);
                  const float hi = bf2f(f2bf(w)); v = lo ? (w - hi) : w; }
              wrt[e] = f2bf(v); } }
        const float* xin = INP(0);
        for (int t = gw; t < T; t += NGW) {
            const f32x4* xr = (const f32x4*)(xin + (size_t)t * D) + lane; f32x4 v[4]; float s = 0.f;
#pragma unroll
            for (int j = 0; j < 4; ++j) { v[j] = xr[64 * j]; s += (v[j][0] * v[j][0] + v[j][1] * v[j][1]) + (v[j][2] * v[j][2] + v[j][3] * v[j][3]); }
            s = wave_sum(s);
            u32x2* o8 = (u32x2*)(HB + (size_t)t * D) + lane;
#pragma unroll
            for (int j = 0; j < 4; ++j) { u32x2 w; w.x = cvt_pk_bf16(v[j][0], v[j][1]); w.y = cvt_pk_bf16(v[j][2], v[j][3]); o8[64 * j] = w; }
            if (lane < 16) SSQ[(size_t)t * 16 + lane] = lane == 0 ? s : 0.f;
        }
    }
    xcd_barrier(bar);

    for (int l = 0; l < DEPTH; ++l) {
        { PHASE_IDS(); unsigned char* ws = WSB(); bf16_t* WIN = (bf16_t*)(ws + WS_WIN); bf16_t* HB = (bf16_t*)(ws + WS_HB); float* SSQ = (float*)(ws + WS_SSQ); bf16_t* Z = (bf16_t*)(ws + WS_Z);
          pg8::StaticOrder<T, INC> S; S.init(HB, WIN + (size_t)l * INC * D, G, bid);
          pg8::EpiZ E{Z, SSQ};
          pg8::gemm_phase<pg8::EpiZ, pg8::StaticOrder<T, INC>, true, true>(lds, wave_s, S, E); }
        xcd_barrier(bar);

        {
            PHASE_IDS(); unsigned char* ws = WSB(); const bf16_t* Z = (const bf16_t*)(ws + WS_Z);
            const float* conv_w = INP(6) + (size_t)l * 4 * BW; const float* conv_b = INP(7) + (size_t)l * BW; const float* rg_b = INP(9) + (size_t)l * BW;
            const float* ig_b = INP(11) + (size_t)l * BW; const float* lam = INP(12) + (size_t)l * BW;
            __syncthreads();
            { const bf16_t* WRG = (const bf16_t*)(ws + WS_WRG) + ((size_t)l * 2 + 0) * 6 * 4096; const bf16_t* WIG = (const bf16_t*)(ws + WS_WRG) + ((size_t)l * 2 + 1) * 6 * 4096;
              for (int pr = bid; pr < NU128 / 2; pr += G) { float cp = 0.f;
                  rglru_unit<1>(2 * pr, true, cp, tid, wave, lane, Z, nullptr, WRG, WIG, conv_w, conv_b, rg_b, ig_b, lam, nullptr, (float*)(ws + WS_SUMA), (float*)(ws + WS_SUMH), (float*)(ws + WS_SUMA2), (float*)(ws + WS_SUMH2), lds);
                  rglru_unit<1>(2 * pr + 1, false, cp, tid, wave, lane, Z, nullptr, WRG, WIG, conv_w, conv_b, rg_b, ig_b, lam, nullptr, (float*)(ws + WS_SUMA), (float*)(ws + WS_SUMH), (float*)(ws + WS_SUMA2), (float*)(ws + WS_SUMH2), lds); } }
            for (int pr = bid; pr < NU128 / 2; pr += G) { float k0r = 0.f, k0i = 0.f, k1r = 0.f, k1i = 0.f; const unsigned char* tab = ws + WS_S5 + (size_t)l * S5_L_STRIDE;
#pragma unroll 1
                for (int ui = 0; ui < 2; ++ui) { s5_group<1>(2 * pr + ui, 2 * wave, ui == 0, k0r, k0i, wave, lane, Z, tab, (float*)(ws + WS_SEND), (float*)(ws + WS_SEND2), lds);
                                                 s5_group<1>(2 * pr + ui, 2 * wave + 1, ui == 0, k1r, k1i, wave, lane, Z, tab, (float*)(ws + WS_SEND), (float*)(ws + WS_SEND2), lds); } }
            __syncthreads();
            { const bf16_t* WSP = (const bf16_t*)(ws + WS_WSP) + (size_t)l * 6 * 128 * 128; const float* a_sb = INP(5) + (size_t)l * 6 * 128; const float* vg = INP(3) + (size_t)l * AW; const float* mo_ga = INP(23) + (size_t)l * D;
              for (int u = bid; u < NU128; u += G) mixa_unit(u, tid, wave, lane, Z, (bf16_t*)(ws + WS_Y), WSP, a_sb, vg, mo_ga, lds); }
        }
        xcd_barrier(bar);

        {
            PHASE_IDS(); unsigned char* ws = WSB(); const bf16_t* Z = (const bf16_t*)(ws + WS_Z); bf16_t* Y = (bf16_t*)(ws + WS_Y);
            const float* a_v_norm_g = INP(3) + (size_t)l * AW; const float* a_sw = INP(4) + (size_t)l * 6 * 128 * 128; const float* a_sb = INP(5) + (size_t)l * 6 * 128;
        }

        { PHASE_IDS(); unsigned char* ws = WSB(); const bf16_t* Z = (const bf16_t*)(ws + WS_Z); bf16_t* Y = (bf16_t*)(ws + WS_Y);
          { const bf16_t* WRG = (const bf16_t*)(ws + WS_WRG) + ((size_t)l * 2 + 0) * 6 * 4096; const bf16_t* WIG = (const bf16_t*)(ws + WS_WRG) + ((size_t)l * 2 + 1) * 6 * 4096;
            const float* conv_w = INP(6) + (size_t)l * 4 * BW; const float* conv_b = INP(7) + (size_t)l * BW; const float* rg_b = INP(9) + (size_t)l * BW; const float* ig_b = INP(11) + (size_t)l * BW; const float* lam = INP(12) + (size_t)l * BW;
            const float* mo_gb = INP(23) + (size_t)l * D + AW;
            __syncthreads();
            for (int pr = bid; pr < NU128 / 2; pr += G) { float cp = 0.f;
                rglru_unit<2>(2 * pr, true, cp, tid, wave, lane, Z, Y, WRG, WIG, conv_w, conv_b, rg_b, ig_b, lam, mo_gb, (float*)(ws + WS_SUMA), (float*)(ws + WS_SUMH), (float*)(ws + WS_SUMA2), (float*)(ws + WS_SUMH2), lds);
                rglru_unit<2>(2 * pr + 1, false, cp, tid, wave, lane, Z, Y, WRG, WIG, conv_w, conv_b, rg_b, ig_b, lam, mo_gb, (float*)(ws + WS_SUMA), (float*)(ws + WS_SUMH), (float*)(ws + WS_SUMA2), (float*)(ws + WS_SUMH2), lds); } }
          { const bf16_t* WGLU = (const bf16_t*)(ws + WS_WGLU) + (size_t)l * CW * CW; const float* glu_b = INP(22) + (size_t)l * CW; const float* mo_gc = INP(23) + (size_t)l * D + AW + BW;
            for (int pr = bid; pr < NU128 / 2; pr += G) { float k0r = 0.f, k0i = 0.f, k1r = 0.f, k1i = 0.f; const unsigned char* tab = ws + WS_S5 + (size_t)l * S5_L_STRIDE;
#pragma unroll 1
                for (int ui = 0; ui < 2; ++ui) { const int u = 2 * pr + ui; __syncthreads();
                    s5_group<2>(u, 2 * wave, ui == 0, k0r, k0i, wave, lane, Z, tab, (float*)(ws + WS_SEND), (float*)(ws + WS_SEND2), lds);
                    s5_group<2>(u, 2 * wave + 1, ui == 0, k1r, k1i, wave, lane, Z, tab, (float*)(ws + WS_SEND), (float*)(ws + WS_SEND2), lds);
                    __syncthreads(); s5_glu(u, wave, lane, WGLU, glu_b, mo_gc, Y, lds); } } } }
        xcd_barrier(bar);

        { PHASE_IDS(); unsigned char* ws = WSB(); bf16_t* WOUT = (bf16_t*)(ws + WS_WOUT); bf16_t* HB = (bf16_t*)(ws + WS_HB); float* SSQ = (float*)(ws + WS_SSQ); bf16_t* Y = (bf16_t*)(ws + WS_Y);
          pg8::StaticOrder<T, D> S; S.init(Y, WOUT + (size_t)l * D * D, G, bid);
          pg8::EpiRes<false> E{HB, SSQ, nullptr};
          pg8::gemm_phase<pg8::EpiRes<false>, pg8::StaticOrder<T, D>, true, true>(lds, wave_s, S, E); }
        xcd_barrier(bar);

        { PHASE_IDS(); unsigned char* ws = WSB(); const bf16_t* HB = (const bf16_t*)(ws + WS_HB); const float* SSQ = (const float*)(ws + WS_SSQ); int* CLS = (int*)(ws + WS_CLS); float* G2 = (float*)(ws + WS_G2); int* HIST = (int*)(ws + WS_HIST);
          const float* rgb = INP(27) + (size_t)l * 4; const float* reb = INP(29) + (size_t)l * 16;
        for (int u = bid; u < NU; u += G) {
            router_unit(u, wave, lane, HB, SSQ, (const bf16_t*)(ws + WS_WRT) + (size_t)l * 48 * D, rgb, reb, CLS, G2, lds, (LAS int*)(lds + LDSCTL_OFF) + LW_HIST);
            __syncthreads();
            if (tid < 32) { HIST[u * 32 + tid] = tid < NCLS ? LWI[LW_HIST + tid] : 0; LWI[LW_HIST + tid] = 0; }
            __syncthreads();
        } }
        xcd_barrier(bar);

        { PHASE_IDS(); unsigned char* ws = WSB(); const bf16_t* HB = (const bf16_t*)(ws + WS_HB); const float* SSQ = (const float*)(ws + WS_SSQ); const int* CLS = (const int*)(ws + WS_CLS); const float* G2 = (const float*)(ws + WS_G2); const int* HIST = (const int*)(ws + WS_HIST);
          int* CTOT = (int*)(ws + WS_CTOT); int* ROWTOK = (int*)(ws + WS_ROWTOK); float* ROWG = (float*)(ws + WS_ROWG); bf16_t* HBS = (bf16_t*)(ws + WS_HBS); const float* ffn_g = INP(25) + (size_t)l * D;
        for (int u = bid; u < NU; u += G) {
            { const int c = tid & 31, part = tid >> 5; int tot = 0, pre = 0;
_Pragma("unroll 16")
              for (int k = part * 16; k < part * 16 + 16; ++k) { const int v = HIST[k * 32 + c]; tot += v; pre += k < u ? v : 0; }
              ((volatile LAS int*)lds)[tid] = tot; ((volatile LAS int*)lds)[512 + tid] = pre; }
            __syncthreads();
            if (tid < NCLS) { int tot = 0, pre = 0;
_Pragma("unroll")
                for (int k = 0; k < 16; ++k) { tot += ((volatile LAS int*)lds)[k * 32 + tid]; pre += ((volatile LAS int*)lds)[512 + k * 32 + tid]; } LWI[LW_TOT + tid] = tot; LWI[LW_BASE + tid] = pre; }
            __syncthreads();
            if (tid == 0) { int ps = 0;
_Pragma("unroll 1")
                for (int c = 0; c < NCLS; ++c) { const int tot = LWI[LW_TOT + c]; LWI[LW_BASE + c] += ps; LWI[LW_TST + c] = ps; ps += ((tot + 255) >> 8) << 8; if (bid == 0) CTOT[c] = tot; } LWI[LW_TST + NCLS] = ps; }
            if (tid < UT) LWI[LW_CLS + tid] = CLS[u * UT + tid];
            __syncthreads();
            if (tid < UT) { const int cls = LWI[LW_CLS + tid]; int rank = 0;
_Pragma("unroll 1")
                for (int i = 0; i < tid; ++i) rank += LWI[LW_CLS + i] == cls ? 1 : 0;
                const int dest = LWI[LW_BASE + cls] + rank; LWI[LW_DEST + tid] = dest; const int t = u * UT + tid;
                ROWTOK[dest] = t; ROWG[(size_t)dest * 2 + 0] = G2[(size_t)t * 2 + 0]; ROWG[(size_t)dest * 2 + 1] = G2[(size_t)t * 2 + 1]; }
            __syncthreads();
            for (int i = 0; i < 32; ++i) { const int tl = wave * 32 + i, t = u * UT + tl, dest = LWI[LW_DEST + tl];
                float sq = lane < 16 ? SSQ[(size_t)t * 16 + lane] : 0.f; sq = wave_sum(sq); const float r = rsqrtf(sq * (1.0f / D) + EPS);
                { const float r4 = r * pg8::FS_H; u32x4 w;
#pragma unroll
                  for (int hh = 0; hh < 2; ++hh) { const int d0 = lane * 16 + hh * 8; const u32x4 o = *(const u32x4*)(HB + (size_t)t * D + d0);
                    const f32x4 g0 = *(const f32x4*)(ffn_g + d0), g1 = *(const f32x4*)(ffn_g + d0 + 4);
                    const unsigned lo = pk_fp8x4(__uint_as_float(o.x << 16) * r4 * g0[0], __uint_as_float(o.x & 0xffff0000u) * r4 * g0[1], __uint_as_float(o.y << 16) * r4 * g0[2], __uint_as_float(o.y & 0xffff0000u) * r4 * g0[3]);
                    const unsigned hi = pk_fp8x4(__uint_as_float(o.z << 16) * r4 * g1[0], __uint_as_float(o.z & 0xffff0000u) * r4 * g1[1], __uint_as_float(o.w << 16) * r4 * g1[2], __uint_as_float(o.w & 0xffff0000u) * r4 * g1[3]);
                    if (hh == 0) { w.x = lo; w.y = hi; } else { w.z = lo; w.w = hi; } }
                  *(u32x4*)((unsigned char*)HBS + (size_t)dest * D + lane * 16) = w; } }
            if (u == bid)
_Pragma("unroll 1")
            for (int c = bid; c < NCLS; c += G) { const int tot = LWI[LW_TOT + c], r0 = LWI[LW_TST + c] + tot, r1 = LWI[LW_TST + c + 1];
                unsigned zz = 0u; asm volatile("" : "+v"(zz));
                for (int r = r0 + wave; r < r1; r += 8) { if (lane == 0) { ROWTOK[r] = -1; ROWG[(size_t)r * 2] = __uint_as_float(zz); ROWG[(size_t)r * 2 + 1] = __uint_as_float(zz); }
                    *(u32x4*)((unsigned char*)HBS + (size_t)r * D + lane * 16) = (u32x4){zz, zz, zz, zz}; } }
            __syncthreads();
        } }
        xcd_barrier(bar);

        { PHASE_IDS(); unsigned char* ws = WSB(); const int* CTOT = (const int*)(ws + WS_CTOT); bf16_t* HBS = (bf16_t*)(ws + WS_HBS); bf16_t* WGU = (bf16_t*)(ws + WS_WGU); bf16_t* ACT = (bf16_t*)(ws + WS_ACT); const float* ROWG = (const float*)(ws + WS_ROWG);
        if (tid == 0) { int ps = 0;
_Pragma("unroll 1")
            for (int c = 0; c < NCLS; ++c) { LWI[LW_TST + c] = ps; ps += (CTOT[c] + 255) >> 8; } LWI[LW_TST + NCLS] = ps; }
        __syncthreads();
        if (tid < 32) { const int ntile = LWI[LW_TST + NCLS]; const long L = (long)tid * G + bid; int e = -1;
            if (L < (long)ntile * 8) { const int mt = (int)(L / 8), pn = (int)(L % 8); int cls = 0;
_Pragma("unroll 1")
                for (int k = 1; k < NCLS; ++k) cls += (LWI[LW_TST + k] <= mt) ? 1 : 0;
                e = (cls << 24) | (pn << 16) | mt; }
            LWI[LW_UTAB + tid] = e; e = -1;
            if (L < (long)ntile * 4) { const int mt = (int)(L / 4), pn = (int)(L % 4); int cls = 0;
_Pragma("unroll 1")
                for (int k = 1; k < NCLS; ++k) cls += (LWI[LW_TST + k] <= mt) ? 1 : 0;
                e = (cls << 24) | (pn << 16) | mt; }
            LWI[LW_DTAB + tid] = e; }
        __syncthreads();
        { pg8::MoeOrder<8, true, 1024> S{LWI + LW_UTAB, l, (const char*)HBS, (const char*)WGU};
          pg8::EpiUp E{(unsigned char*)ACT, ROWG};
          pg8::gemm_phase<pg8::EpiUp, pg8::MoeOrder<8, true, 1024>, true, true, 512, true>(lds, wave_s, S, E); } }
        xcd_barrier(bar);

        { PHASE_IDS(); unsigned char* ws = WSB(); bf16_t* ACT = (bf16_t*)(ws + WS_ACT); bf16_t* WD2 = (bf16_t*)(ws + WS_WD2); bf16_t* HB = (bf16_t*)(ws + WS_HB); float* SSQ = (float*)(ws + WS_SSQ); const int* ROWTOK = (const int*)(ws + WS_ROWTOK);
          pg8::MoeOrder<4, false, 1024> S{LWI + LW_DTAB, l, (const char*)ACT, (const char*)WD2};
          pg8::EpiRes<true> E{HB, SSQ, ROWTOK};
          pg8::gemm_phase<pg8::EpiRes<true>, pg8::MoeOrder<4, false, 1024>, true, true, 512, true>(lds, wave_s, S, E); }
        xcd_barrier(bar);
    }

    { PHASE_IDS(); unsigned char* ws = WSB(); const bf16_t* HB = (const bf16_t*)(ws + WS_HB); const float* SSQ = (const float*)(ws + WS_SSQ); const float* fg = INP(33); float* outp = a.out;
    for (int t = gw; t < T; t += NGW) {
        float sq = lane < 16 ? SSQ[(size_t)t * 16 + lane] : 0.f; sq = wave_sum(sq); const float r = rsqrtf(sq * (1.0f / D) + EPS);
#pragma unroll
        for (int hh = 0; hh < 2; ++hh) { const int d0 = hh * 512 + lane * 8; const u32x4 o = *(const u32x4*)(HB + (size_t)t * D + d0);
            const f32x4 g0 = *(const f32x4*)(fg + d0), g1 = *(const f32x4*)(fg + d0 + 4);
            f32x4 w0, w1; w0[0] = __uint_as_float(o.x << 16) * r * g0[0]; w0[1] = __uint_as_float(o.x & 0xffff0000u) * r * g0[1]; w0[2] = __uint_as_float(o.y << 16) * r * g0[2]; w0[3] = __uint_as_float(o.y & 0xffff0000u) * r * g0[3];
            w1[0] = __uint_as_float(o.z << 16) * r * g1[0]; w1[1] = __uint_as_float(o.z & 0xffff0000u) * r * g1[1]; w1[2] = __uint_as_float(o.w << 16) * r * g1[2]; w1[3] = __uint_as_float(o.w & 0xffff0000u) * r * g1[3];
            *(f32x4*)(outp + (size_t)t * D + d0) = w0; *(f32x4*)(outp + (size_t)t * D + d0 + 4) = w1; }
    } }
}

extern "C" void kernel_launch(void* const* d_in, const int* in_sizes, int n_in, void* d_out, int out_size, void* d_ws, size_t ws_size, hipStream_t stream) {
    static int grid = 0;
    if (grid == 0) {
        if (n_in != 34 || in_sizes[0] != T * D || out_size != T * D || ws_size < WS_END) { fprintf(stderr, "kernel_launch: unexpected shapes (n_in %d, ws %zu)\n", n_in, ws_size); grid = -1; return; }
        int dev = 0, cus = 0, per_cu = 0;
        if (hipGetDevice(&dev) != hipSuccess || hipDeviceGetAttribute(&cus, hipDeviceAttributeMultiprocessorCount, dev) != hipSuccess) { grid = -1; return; }
        if (hipFuncSetAttribute((const void*)mega_fwd, hipFuncAttributeMaxDynamicSharedMemorySize, LDS_BYTES) != hipSuccess) { fprintf(stderr, "kernel_launch: hipFuncSetAttribute failed\n"); grid = -1; return; }
        if (hipOccupancyMaxActiveBlocksPerMultiprocessor(&per_cu, (const void*)mega_fwd, 512, LDS_BYTES) != hipSuccess || per_cu < 1) { fprintf(stderr, "kernel_launch: occupancy query says %d\n", per_cu); }
        (void)hipGetLastError();
        grid = cus;
    }
    if (grid < 0) return;
    (void)hipMemsetAsync((char*)d_ws + WS_CTL, 0, CTL_ZERO_BYTES, stream);
    Args a{};
    for (int i = 0; i < 34; ++i) a.in[i] = (const float*)d_in[i];
    a.out = (float*)d_out; a.ws = (unsigned char*)d_ws;
    hipLaunchKernelGGL(mega_fwd, dim3(grid), dim3(512), LDS_BYTES, stream, a);
}
```

```cpp
#include <hip/hip_runtime.h>
#include <cstdio>
#include <cstdint>

#define LAS __attribute__((address_space(3)))
typedef unsigned short bf16_t;
typedef short bf16x8 __attribute__((ext_vector_type(8)));
typedef float f32x4 __attribute__((ext_vector_type(4)));
typedef float f32x2 __attribute__((ext_vector_type(2)));
typedef unsigned u32x4 __attribute__((ext_vector_type(4)));
typedef unsigned u32x2 __attribute__((ext_vector_type(2)));
typedef int i32x4 __attribute__((ext_vector_type(4)));
typedef int i32x8 __attribute__((ext_vector_type(8)));

constexpr int D = 1024, BATCH = 8, SEQ = 8192, T = BATCH * SEQ, DEPTH = 2;
constexpr int AW = 384, BW = 384, CW = 256, HD = 64, ABLK = 128, CHUNK = 64;
constexpr int INC = 1792;
constexpr int ZU = 0, ZV = 384, ZG = 768, ZX = 1152, ZC = 1536, ZGELU_END = 1152;
constexpr int CG = 16, CGD = 16, CS = 64;
constexpr int NE = 16, DE = 512, NCLS = 24;
constexpr float EPS = 1e-6f;
constexpr int UT = 256;
constexpr int NU = T / UT;
constexpr int MAXROWS = T + NCLS * 256;

constexpr size_t MiB = 1u << 20;
constexpr size_t WS_CTL = 0, CTL_ZERO_BYTES = 1 * MiB;
constexpr size_t WS_WIN = 2 * MiB;
constexpr size_t WS_WOUT = 10 * MiB;
constexpr size_t WS_WGLU = 14 * MiB;
constexpr size_t WS_WRG = 15 * MiB;
constexpr size_t WS_WSP = 15 * MiB + 256 * 1024;
constexpr size_t WS_WRT = 15 * MiB + 768 * 1024;
constexpr size_t WS_WGU = 16 * MiB;
constexpr size_t WS_WD2 = 80 * MiB;
constexpr size_t WS_SSQ = 176 * MiB;
constexpr size_t WS_RS = 180 * MiB;
constexpr size_t WS_CLS = WS_RS + 256 * 1024;
constexpr size_t WS_G2 = WS_CLS + 256 * 1024;
constexpr size_t WS_HIST = 181 * MiB;
constexpr size_t WS_CTOT = WS_HIST + 64 * 1024;
constexpr size_t WS_ROWTOK = WS_HIST + 256 * 1024;
constexpr size_t WS_ROWG = 182 * MiB;
constexpr size_t WS_SUMA = 183 * MiB;
constexpr size_t WS_SUMH = 191 * MiB;
constexpr size_t WS_S5 = 184 * MiB;
constexpr size_t WS_SEND = 187 * MiB;
constexpr size_t WS_HB = 192 * MiB;
constexpr size_t WS_Z = 320 * MiB;
constexpr size_t WS_HBS = WS_Z;
constexpr size_t WS_Y = 544 * MiB;
constexpr size_t WS_ACT = 672 * MiB;
constexpr size_t WS_HL = 672 * MiB;
constexpr size_t WS_PP = 736 * MiB;
constexpr size_t WS_SE = 800 * MiB;
constexpr size_t WS_AV = 672 * MiB;
constexpr size_t WS_BV = 768 * MiB;
constexpr size_t WS_SEND2 = 864 * MiB;
constexpr size_t WS_SUMA2 = 866 * MiB;
constexpr size_t WS_SUMH2 = 867 * MiB;
constexpr size_t WS_END = 868 * MiB;
constexpr int CW_BAR = 4096;

constexpr int RING_BYTES = 131072;
constexpr int LDSCTL_OFF = 143360;
constexpr int LDS_BYTES = 147456;
constexpr int LW_BAR = 8, LW_TST = 64, LW_HIST = 96, LW_TOT = 128, LW_BASE = 160, LW_CLS = 256  , LW_DEST = 512  , LW_UTAB = 768  , LW_DTAB = 800  ;

__device__ __forceinline__ float bf2f(bf16_t v) { return __uint_as_float(((unsigned)v) << 16); }
__device__ __forceinline__ unsigned cvt_pk_bf16(float lo, float hi) { unsigned r; asm volatile("v_cvt_pk_bf16_f32 %0, %1, %2" : "=v"(r) : "v"(lo), "v"(hi)); return r; }
__device__ __forceinline__ bf16_t f2bf(float v) { return (bf16_t)(cvt_pk_bf16(v, 0.f) & 0xffffu); }
__device__ __forceinline__ unsigned pk_fp8x4(float a, float b, float c, float d) {
    a = fminf(fmaxf(a, -448.f), 448.f); b = fminf(fmaxf(b, -448.f), 448.f); c = fminf(fmaxf(c, -448.f), 448.f); d = fminf(fmaxf(d, -448.f), 448.f);
    int r = __builtin_amdgcn_cvt_pk_fp8_f32(a, b, 0, false); r = __builtin_amdgcn_cvt_pk_fp8_f32(c, d, r, true); return (unsigned)r; }
__device__ __forceinline__ int fresh_lane() { unsigned z = 0u; asm volatile("" : "+s"(z)); return (int)__builtin_amdgcn_mbcnt_hi(~0u, __builtin_amdgcn_mbcnt_lo(~0u, z)); }
__device__ __forceinline__ float x_xor1(float v) { return __int_as_float(__builtin_amdgcn_update_dpp(0, __float_as_int(v), 0xB1, 0xf, 0xf, true)); }
__device__ __forceinline__ float x_xor2(float v) { return __int_as_float(__builtin_amdgcn_update_dpp(0, __float_as_int(v), 0x4E, 0xf, 0xf, true)); }
__device__ __forceinline__ float x_hmir(float v) { return __int_as_float(__builtin_amdgcn_update_dpp(0, __float_as_int(v), 0x141, 0xf, 0xf, true)); }
__device__ __forceinline__ float x_mir(float v) { return __int_as_float(__builtin_amdgcn_update_dpp(0, __float_as_int(v), 0x140, 0xf, 0xf, true)); }
__device__ __forceinline__ float x_xor16(float v) { return __int_as_float(__builtin_amdgcn_ds_swizzle(__float_as_int(v), 0x401F)); }
__device__ __forceinline__ float add_xor32(float v) { const auto r = __builtin_amdgcn_permlane32_swap(__float_as_uint(v), __float_as_uint(v), false, false); return __uint_as_float(r[0]) + __uint_as_float(r[1]); }
__device__ __forceinline__ float add_x16_x32(float v) { v += x_xor16(v); return add_xor32(v); }
__device__ __forceinline__ float wave_sum(float v) { v += x_xor1(v); v += x_xor2(v); v += x_hmir(v); v += x_mir(v); v += x_xor16(v); return add_xor32(v); }
__device__ __forceinline__ float gelu_fast(float x) {
    const float u2 = 1.5957691216057308f * (x + 0.044715f * x * x * x);
    const float e = __builtin_amdgcn_exp2f(-1.4426950408889634f * u2);
    return x * __builtin_amdgcn_rcpf(1.0f + e);
}
__device__ __forceinline__ float sigmoid_fast(float x) { return __builtin_amdgcn_rcpf(1.0f + __builtin_amdgcn_exp2f(-1.4426950408889634f * x)); }
__device__ __forceinline__ float sigmoid_f(float x) { return 1.0f / (1.0f + expf(-x)); }
__device__ __forceinline__ int pair_lo(int pi) { return pi < 3 ? 0 : (pi < 5 ? 1 : 2); }
__device__ __forceinline__ int pair_hi(int pi) { return pi < 3 ? pi + 1 : (pi < 5 ? pi - 1 : 3); }
__device__ __forceinline__ int pair_idx(int lo, int hi) { return lo == 0 ? hi - 1 : (lo == 1 ? hi + 1 : 5); }

#define XB_TMO      128
#define XB_XCNT(j)  (256  + 64 * (j))
#define XB_XSUB(j)  (1280 + 64 * (j))
#define XB_XGEN(j)  (2304 + 64 * (j))
#define XB_TOP      3328
#define XB_TOPGEN   3392
#define XCD_BAR_WORDS 3456
#define XB_SPIN_CAP (1u << 18)
__device__ __forceinline__ unsigned xb_ld(unsigned* p)              { return __hip_atomic_load(p, __ATOMIC_RELAXED, __HIP_MEMORY_SCOPE_AGENT); }
__device__ __forceinline__ unsigned xb_add(unsigned* p, unsigned v) { return __hip_atomic_fetch_add(p, v, __ATOMIC_RELAXED, __HIP_MEMORY_SCOPE_AGENT); }
__device__ __forceinline__ unsigned xb_xcc_id() { return (unsigned)__builtin_amdgcn_s_getreg((3 << 11) | 20) & 0xFu; }
#define XB_SPIN(cond, bar) do { unsigned _sp = 0; while (cond) { __builtin_amdgcn_s_sleep(1); \
    if ((++_sp & 255u) == 0u) { if (xb_ld(&(bar)[XB_TMO])) break; if (_sp > XB_SPIN_CAP) { atomicAdd(&(bar)[XB_TMO], 1u); break; } } } } while (0)
struct XcdBarrier { unsigned* bar; unsigned x; volatile LAS unsigned* st; };
__device__ __forceinline__ XcdBarrier xcd_barrier_post(unsigned* bar, volatile LAS unsigned* st) {
    XcdBarrier b; b.bar = bar; b.x = xb_xcc_id(); b.st = st;
    if (threadIdx.x == 0) (void)xb_add(&bar[XB_XCNT(b.x)], 1u);
    return b;
}
__device__ __forceinline__ void xcd_barrier_complete(unsigned* bar, unsigned x, unsigned& nloc, unsigned& nx) {
    const unsigned G = gridDim.x * gridDim.y * gridDim.z;
    unsigned sum, cnt, mine, sp = 0u;
    for (;;) {
        sum = 0u; cnt = 0u; mine = 0u;
#pragma unroll
        for (unsigned j = 0; j < 16; ++j) { const unsigned c = xb_ld(&bar[XB_XCNT(j)]); sum += c; cnt += (c > 0u) ? 1u : 0u; mine = (j == x) ? c : mine; }
        if (sum == G) break;
        __builtin_amdgcn_s_sleep(1);
        if ((++sp & 255u) == 0u) { if (xb_ld(&bar[XB_TMO])) break; if (sp > XB_SPIN_CAP) { atomicAdd(&bar[XB_TMO], 1u); break; } }
    }
    nloc = mine > 0u ? mine : 1u; nx = cnt > 0u ? cnt : 1u;
}
__device__ __forceinline__ void xcd_barrier(const XcdBarrier& b) {
    asm volatile("s_waitcnt vmcnt(0)" ::: "memory");
    __syncthreads();
    if (threadIdx.x == 0) {
        unsigned* bar = b.bar; asm volatile("" : "+s"(bar));
        __builtin_amdgcn_s_waitcnt(0);
        unsigned bx0 = b.x; asm volatile("" : "+s"(bx0));
        unsigned nloc = b.st[0], nx = b.st[1];
        if (nloc == 0u) { xcd_barrier_complete(bar, bx0, nloc, nx); b.st[0] = nloc; b.st[1] = nx; }
        unsigned bx = b.x; asm volatile("" : "+s"(bx));
        const unsigned old = xb_add(&bar[XB_XSUB(bx)], 1u);
        const unsigned gen = old / nloc;
        if (old + 1u == (gen + 1u) * nloc) {
            __builtin_amdgcn_fence(__ATOMIC_RELEASE, "agent");
            asm volatile("s_waitcnt vmcnt(0)" ::: "memory");
            const unsigned og = xb_add(&bar[XB_TOP], 1u);
            const unsigned tg = og / nx;
            if (og + 1u == (tg + 1u) * nx) xb_add(&bar[XB_TOPGEN], 1u);
            else XB_SPIN(xb_ld(&bar[XB_TOPGEN]) == tg, bar);
            __builtin_amdgcn_fence(__ATOMIC_ACQUIRE, "agent");
            xb_add(&bar[XB_XGEN(bx)], 1u);
            asm volatile("s_waitcnt vmcnt(0)" ::: "memory");
        } else {
            XB_SPIN(xb_ld(&bar[XB_XGEN(bx)]) == gen, bar);
            __builtin_amdgcn_fence(__ATOMIC_ACQUIRE, "agent");
            asm volatile("s_waitcnt vmcnt(0)" ::: "memory");
        }
    }
    __syncthreads();
}

namespace pg8 {
#define PG8_LAS __attribute__((address_space(3)))
constexpr int BM = 256, BK = 64, HALF = 128, HTB = HALF * BK * 2, STAGE_BYTES = 8 * HTB, NXCD = 8, WGM = 8;
__host__ __device__ __forceinline__ int lds_byte(int r, int c) { const int st = (r >> 4) * 2 + (c >> 5), rr = r & 15, cc = c & 31, ob = rr * 64 + cc * 2; return st * 1024 + (ob ^ (((ob >> 9) & 1) << 5)); }
__host__ __device__ __forceinline__ void stage_rc(int b, int& R, int& C) { const int st = b / 1024, sb = b % 1024, swz = sb ^ (((sb >> 9) & 1) << 5); R = (st >> 1) * 16 + swz / 64; C = (st & 1) * 32 + (swz % 64) / 2; }
__host__ __device__ __forceinline__ int perm32(int rho) { const int n = rho >> 4, i = rho & 15; return 8 * (i >> 2) + 4 * n + (i & 3); }
struct Unit { int pm, pn; const char* A; const char* B; };

template <int M_, int N_> struct StaticOrder {
    static constexpr int nM = M_ / BM, nN = N_ / BM, nwg = nM * nN; static constexpr size_t tstep = (size_t)BM * 1024 * 2;
    int G, c; const char* A; const char* Bt;
    __device__ void init(const void* A_, const void* Bt_, int G_, int c_) { G = G_; c = c_; A = (const char*)A_; Bt = (const char*)Bt_; }
    __device__ bool next(int i, Unit& u) const {
        const long L = (long)i * G + c; if (L >= nwg) return false;
        int wgid = (int)L; { constexpr int q = nwg / NXCD, r = nwg % NXCD; const int xcd = wgid % NXCD, off = wgid / NXCD; wgid = (xcd < r ? xcd * (q + 1) : r * (q + 1) + (xcd - r) * q) + off; }
        constexpr int nig = WGM * nN; const int gid = wgid / nig, fm = gid * WGM, gsz = (nM - fm) < WGM ? (nM - fm) : WGM;
        u.pm = fm + ((wgid % nig) % gsz); u.pn = (wgid % nig) / gsz; u.A = A + (size_t)u.pm * tstep; u.B = Bt + (size_t)u.pn * tstep; return true;
    }
    __device__ __forceinline__ void a_ready(const Unit&) const {}
    __device__ __forceinline__ void done(const Unit&) const {}
};
template <class Epi, class Sched, bool ALIGN_EPI = false, bool SP2 = false, int KB = 1024, bool FP8 = false>
__device__ __forceinline__ void gemm_phase(PG8_LAS unsigned char* lds, const int wave_s, const Sched& S, const Epi& E) { const int Kdim = 0;
    const int lane = fresh_lane(), wid = wave_s, tid = wid * 64 + lane, wr = wid >> 2, wc = wid & 3, fr = lane & 15, fq = lane >> 4;
    constexpr int K = KB, nt = K / BK; (void)Kdim;
    unsigned voffA, voffB;
    { int R, C; stage_rc(tid * 16, R, C); const int Rb = Epi::PERM ? ((R & ~31) + perm32(R & 31)) : R; voffA = (unsigned)(R * K + C) * 2u; voffB = (unsigned)(Rb * K + C) * 2u; }
    constexpr size_t kstep = (size_t)(BK * 2);
    constexpr size_t hstep = (size_t)HALF * K * 2;
    constexpr size_t tstep = 2 * hstep; (void)tstep;
    const unsigned ldsw = (unsigned)wid * 1024u; const unsigned ldsb = (unsigned)(size_t)lds + ldsw;
    const int aoff = lds_byte(wr * 64 + fr, fq * 8), boff = lds_byte(wc * 32 + fr, fq * 8);
#define PG8_SA(b, h) (((b) * 2 + (h)) * HTB)
#define PG8_SB(b, h) ((4 + (b) * 2 + (h)) * HTB)
#define PG8_STAGE(bufoff, gbase, voff) do { _Pragma("unroll") for (int _i = 0; _i < 2; ++_i) { unsigned _keep; \
        asm volatile("s_mov_b32 %0, m0\n\ts_mov_b32 m0, %3\n\ts_nop 0\n\tglobal_load_lds_dwordx4 %1, %2\n\ts_mov_b32 m0, %0" : "=&s"(_keep) \
            : "v"(voff), "s"((const char*)(gbase) + (size_t)_i * (64 * K * 2)), "s"(ldsb + (unsigned)((bufoff) + _i * 8192)) : "memory"); } } while (0)
#define PG8_LDA(dst, b, h) do { if constexpr (FP8) { _Pragma("unroll") for (int m = 0; m < 4; ++m) { const i32x4 _lo = *(const PG8_LAS i32x4*)(lds + PG8_SA(b, h) + aoff + m * 2048), _hi = *(const PG8_LAS i32x4*)(lds + PG8_SA(b, h) + aoff + m * 2048 + 1024); \
            dst##8[m] = __builtin_shufflevector(_lo, _hi, 0, 1, 2, 3, 4, 5, 6, 7); } } \
        else { _Pragma("unroll") for (int m = 0; m < 4; ++m) _Pragma("unroll") for (int k = 0; k < 2; ++k) dst[m][k] = *(const PG8_LAS bf16x8*)(lds + PG8_SA(b, h) + aoff + m * 2048 + k * 1024); } } while (0)
#define PG8_LDB(dst, b, h) do { if constexpr (FP8) { _Pragma("unroll") for (int n = 0; n < 2; ++n) { const i32x4 _lo = *(const PG8_LAS i32x4*)(lds + PG8_SB(b, h) + boff + n * 2048), _hi = *(const PG8_LAS i32x4*)(lds + PG8_SB(b, h) + boff + n * 2048 + 1024); \
            dst##8[n] = __builtin_shufflevector(_lo, _hi, 0, 1, 2, 3, 4, 5, 6, 7); } } \
        else { _Pragma("unroll") for (int n = 0; n < 2; ++n) _Pragma("unroll") for (int k = 0; k < 2; ++k) dst[n][k] = *(const PG8_LAS bf16x8*)(lds + PG8_SB(b, h) + boff + n * 2048 + k * 1024); } } while (0)
#define PG8_MMA(ai, bj, At, Bt) do { __builtin_amdgcn_s_setprio(1); \
        if constexpr (FP8) { _Pragma("unroll") for (int m = 0; m < 4; ++m) _Pragma("unroll") for (int n = 0; n < 2; ++n) \
            acc[ai][bj][m][n] = __builtin_amdgcn_mfma_scale_f32_16x16x128_f8f6f4(Bt##8[n], At##8[m], acc[ai][bj][m][n], 0, 0, 0, Epi::SCALE_W, 0, Epi::SCALE_A); } \
        else { _Pragma("unroll") for (int m = 0; m < 4; ++m) _Pragma("unroll") for (int n = 0; n < 2; ++n) _Pragma("unroll") for (int k = 0; k < 2; ++k) \
            acc[ai][bj][m][n] = __builtin_amdgcn_mfma_f32_16x16x32_bf16(Bt[n][k], At[m][k], acc[ai][bj][m][n], 0, 0, 0); } \
        __builtin_amdgcn_s_setprio(0); } while (0)
#define PG8_WAIT_V(n) asm volatile("s_waitcnt vmcnt(" #n ")" ::: "memory")
#define PG8_WAIT_L(n) asm volatile("s_waitcnt lgkmcnt(" #n ")" ::: "memory")
#define PG8_BAR __builtin_amdgcn_s_barrier()
#define PG8_SCHED __builtin_amdgcn_sched_barrier(0)
    Unit cur, nxt; int ui = 0;
    if (!S.next(0, cur)) return;
    f32x4 acc[2][2][4][2];
#pragma unroll
    for (int a = 0; a < 2; ++a)
#pragma unroll
        for (int b = 0; b < 2; ++b)
#pragma unroll
            for (int m = 0; m < 4; ++m)
#pragma unroll
                for (int n = 0; n < 2; ++n) acc[a][b][m][n] = (f32x4){0.f, 0.f, 0.f, 0.f};
    bf16x8 At[4][2], B0[2][2], B1[2][2]; i32x8 At8[4], B08[2], B18[2]; (void)At; (void)B0; (void)B1; (void)At8; (void)B08; (void)B18;
    const char* cA = cur.A; const char* cB = cur.B;
    S.a_ready(cur);
    if constexpr (SP2) {
        PG8_STAGE(PG8_SB(0, 0), cB, voffB); PG8_STAGE(PG8_SB(0, 1), cB + hstep, voffB); PG8_STAGE(PG8_SA(0, 0), cA, voffA); PG8_STAGE(PG8_SA(0, 1), cA + hstep, voffA);
        if (wr == 1) PG8_BAR;
        PG8_WAIT_V(2); PG8_BAR;
        PG8_STAGE(PG8_SB(1, 0), cB + kstep, voffB); PG8_STAGE(PG8_SA(1, 0), cA + kstep, voffA); PG8_STAGE(PG8_SB(1, 1), cB + hstep + kstep, voffB);
        PG8_WAIT_V(6); PG8_BAR;
    } else {
        PG8_STAGE(PG8_SB(0, 0), cB, voffB); PG8_STAGE(PG8_SA(0, 0), cA, voffA); PG8_STAGE(PG8_SB(0, 1), cB + hstep, voffB); PG8_STAGE(PG8_SA(0, 1), cA + hstep, voffA);
        if (wr == 1) PG8_BAR;
        PG8_WAIT_V(4); PG8_BAR;
        PG8_STAGE(PG8_SB(1, 0), cB + kstep, voffB); PG8_STAGE(PG8_SA(1, 0), cA + kstep, voffA); PG8_STAGE(PG8_SB(1, 1), cB + hstep + kstep, voffB);
        PG8_WAIT_V(6); PG8_BAR;
    }
    for (;;) {
        const bool has_next = S.next(ui + 1, nxt);
        const char* nA = has_next ? nxt.A : cA; const char* nB = has_next ? nxt.B : cB;
_Pragma("unroll 1")
        for (int t = 0; t < nt; t += 2) {
            const bool last = (t == nt - 2);
            const char* a1 = cA + (size_t)(t + 1) * kstep;
            const char* a2 = last ? nA : cA + (size_t)(t + 2) * kstep; const char* b2 = last ? nB : cB + (size_t)(t + 2) * kstep;
            const char* a3 = a2 + kstep; const char* b3 = b2 + kstep;
            if (last && has_next) S.a_ready(nxt);
            if constexpr (SP2) {
            PG8_LDB(B0, 0, 0); PG8_LDB(B1, 0, 1); PG8_SCHED; PG8_LDA(At, 0, 0); PG8_STAGE(PG8_SA(1, 1), a1 + hstep, voffA);
            PG8_WAIT_V(8); PG8_WAIT_L(0); PG8_BAR; PG8_MMA(0, 0, At, B0); PG8_MMA(0, 1, At, B1); PG8_BAR; PG8_SCHED;
            PG8_LDA(At, 0, 1); PG8_STAGE(PG8_SB(0, 0), b2, voffB); PG8_STAGE(PG8_SB(0, 1), b2 + hstep, voffB); PG8_STAGE(PG8_SA(0, 0), a2, voffA);
            PG8_WAIT_V(8); PG8_WAIT_L(0); PG8_BAR; PG8_MMA(1, 0, At, B0); PG8_MMA(1, 1, At, B1); PG8_BAR; PG8_SCHED;
            PG8_LDB(B0, 1, 0); PG8_LDB(B1, 1, 1); PG8_SCHED; PG8_LDA(At, 1, 0); PG8_STAGE(PG8_SA(0, 1), a2 + hstep, voffA);
            PG8_WAIT_V(8); PG8_WAIT_L(0); PG8_BAR; PG8_MMA(0, 0, At, B0); PG8_MMA(0, 1, At, B1); PG8_BAR; PG8_SCHED;
            PG8_LDA(At, 1, 1); PG8_STAGE(PG8_SB(1, 0), b3, voffB); PG8_STAGE(PG8_SB(1, 1), b3 + hstep, voffB); PG8_STAGE(PG8_SA(1, 0), a3, voffA);
            PG8_WAIT_V(8); PG8_WAIT_L(0); PG8_BAR; PG8_MMA(1, 0, At, B0); PG8_MMA(1, 1, At, B1); PG8_BAR; PG8_SCHED;
            } else {
            PG8_LDB(B0, 0, 0); PG8_SCHED; PG8_LDA(At, 0, 0); PG8_STAGE(PG8_SA(1, 1), a1 + hstep, voffA);
            PG8_WAIT_L(8); PG8_BAR; PG8_WAIT_L(0); PG8_MMA(0, 0, At, B0); PG8_BAR; PG8_SCHED;
            PG8_LDB(B1, 0, 1); PG8_STAGE(PG8_SB(0, 0), b2, voffB);
            PG8_BAR; PG8_WAIT_L(0); PG8_MMA(0, 1, At, B1); PG8_BAR;
            PG8_LDA(At, 0, 1); PG8_STAGE(PG8_SA(0, 0), a2, voffA);
            PG8_BAR; PG8_WAIT_L(0); PG8_MMA(1, 0, At, B0); PG8_BAR; PG8_SCHED;
            PG8_STAGE(PG8_SB(0, 1), b2 + hstep, voffB);
            PG8_WAIT_V(6); PG8_BAR; PG8_MMA(1, 1, At, B1); PG8_BAR;
            PG8_LDB(B0, 1, 0); PG8_SCHED; PG8_LDA(At, 1, 0); PG8_STAGE(PG8_SA(0, 1), a2 + hstep, voffA);
            PG8_WAIT_L(8); PG8_BAR; PG8_WAIT_L(0); PG8_MMA(0, 0, At, B0); PG8_BAR; PG8_SCHED;
            PG8_LDB(B1, 1, 1); PG8_STAGE(PG8_SB(1, 0), b3, voffB);
            PG8_BAR; PG8_WAIT_L(0); PG8_MMA(0, 1, At, B1); PG8_BAR;
            PG8_LDA(At, 1, 1); PG8_STAGE(PG8_SA(1, 0), a3, voffA);
            PG8_BAR; PG8_WAIT_L(0); PG8_MMA(1, 0, At, B0); PG8_BAR; PG8_SCHED;
            PG8_STAGE(PG8_SB(1, 1), b3 + hstep, voffB);
            PG8_WAIT_V(6); PG8_BAR; PG8_MMA(1, 1, At, B1); PG8_BAR;
            }
        }
        if constexpr (ALIGN_EPI) { if (wr == 0) PG8_BAR; }
        if constexpr (!Epi::AFTER_DRAIN) { E(acc, cur, wr, wc, fr, fq); S.done(cur); }
        if (!has_next) break;
#pragma unroll
        for (int a = 0; a < 2; ++a)
#pragma unroll
            for (int b = 0; b < 2; ++b)
#pragma unroll
                for (int m = 0; m < 4; ++m)
#pragma unroll
                    for (int n = 0; n < 2; ++n) acc[a][b][m][n] = (f32x4){0.f, 0.f, 0.f, 0.f};
        cur = nxt; cA = nA; cB = nB; ++ui;
        if constexpr (ALIGN_EPI) { if (wr == 1) PG8_BAR; }
    }
    PG8_WAIT_V(0);
    if constexpr (!ALIGN_EPI) { if (wr == 0) PG8_BAR; }
    PG8_BAR;
    if constexpr (Epi::AFTER_DRAIN) { E.fused(acc, cur, wr, wc, fr, fq, lds, wid, lane); S.done(cur); }
#undef PG8_SA
#undef PG8_SB
#undef PG8_STAGE
#undef PG8_LDA
#undef PG8_LDB
#undef PG8_MMA
#undef PG8_WAIT_V
#undef PG8_WAIT_L
#undef PG8_BAR
#undef PG8_SCHED
}

template <int NP, bool UP, int ROWB> struct MoeOrder {
    const volatile LAS int* tab; int layer; const char* A; const char* W;
    __device__ bool next(int i, Unit& u) const {
        const int e = tab[i]; if (e < 0) return false;
        const int mt = e & 0xffff, pn = (e >> 16) & 0xff, cls = e >> 24;
        u.pm = mt; u.pn = pn; u.A = A + (size_t)mt * ((size_t)BM * ROWB);
        if (UP) { const int g = cls / 6, pi = cls % 6, s = pn >> 2, ex = g * 4 + (s ? pair_hi(pi) : pair_lo(pi));
            u.B = W + ((size_t)(layer * NE + ex) * 1024 + (size_t)(pn & 3) * 256) * ROWB; }
        else u.B = W + ((size_t)(layer * NCLS + cls) * 1024 + (size_t)pn * 256) * ROWB;
        return true;
    }
    __device__ __forceinline__ void a_ready(const Unit&) const {}
    __device__ __forceinline__ void done(const Unit&) const {}
};

struct EpiZ {
    static constexpr bool PERM = true, AFTER_DRAIN = false;
    bf16_t* Z; const float* ssq;
    __device__ __forceinline__ void operator()(const f32x4 (&acc)[2][2][4][2], const Unit& u, int wr, int wc, int fr, int fq) const {
        { const int ln_ = fresh_lane(); fr = ln_ & 15; fq = ln_ >> 4; }
        const int row0 = u.pm * BM + wr * 64 + fr, col0 = u.pn * BM + wc * 32 + 8 * fq;
        float rr[2][4];
#pragma unroll
        for (int ai = 0; ai < 2; ++ai) {
            f32x4 sp[4];
#pragma unroll
            for (int m = 0; m < 4; ++m) sp[m] = *(const f32x4*)(ssq + (size_t)(row0 + ai * HALF + m * 16) * 16 + 4 * fq);
#pragma unroll
            for (int m = 0; m < 4; ++m) { float t = (sp[m][0] + sp[m][1]) + (sp[m][2] + sp[m][3]); t = add_x16_x32(t); rr[ai][m] = __builtin_amdgcn_rsqf(t * (1.0f / D) + EPS); }
        }
#pragma unroll
        for (int ai = 0; ai < 2; ++ai)
#pragma unroll
            for (int m = 0; m < 4; ++m) { const int row = row0 + ai * HALF + m * 16; const float r = rr[ai][m];
                bf16_t* rowp = Z + (size_t)row * INC + col0;
#pragma unroll
                for (int bj = 0; bj < 2; ++bj) { f32x4 v0 = acc[ai][bj][m][0] * r, v1 = acc[ai][bj][m][1] * r;
                    if (u.pn * BM + bj * HALF < ZGELU_END) {
#pragma unroll
                        for (int j = 0; j < 4; ++j) { v0[j] = gelu_fast(v0[j]); v1[j] = gelu_fast(v1[j]); } }
                    u32x4 w; w.x = cvt_pk_bf16(v0[0], v0[1]); w.y = cvt_pk_bf16(v0[2], v0[3]); w.z = cvt_pk_bf16(v1[0], v1[1]); w.w = cvt_pk_bf16(v1[2], v1[3]);
                    *(u32x4*)(rowp + bj * HALF) = w; } }
    }
};
template <bool SCATTER> struct EpiRes {
    static constexpr bool PERM = true, AFTER_DRAIN = false; static constexpr int SCALE_W = 0x7b7b7b7b, SCALE_A = 0x7b7b7b7b;
    bf16_t* H; float* ssq; const int* rowtok;
    __device__ __forceinline__ void operator()(const f32x4 (&acc)[2][2][4][2], const Unit& u, int wr, int wc, int fr, int fq) const {
        { const int ln_ = fresh_lane(); fr = ln_ & 15; fq = ln_ >> 4; }
        const int row0 = u.pm * BM + wr * 64 + fr, col0 = u.pn * BM + wc * 32 + 8 * fq;
        int tokv[2][4];
#pragma unroll
        for (int ai = 0; ai < 2; ++ai)
#pragma unroll
            for (int m = 0; m < 4; ++m) { const int row = row0 + ai * HALF + m * 16; tokv[ai][m] = SCATTER ? rowtok[row] : row; }
#pragma unroll
        for (int ai = 0; ai < 2; ++ai) {
            u32x4 o[4][2];
#pragma unroll
            for (int m = 0; m < 4; ++m) { const int tok = tokv[ai][m]; const bf16_t* rowp = H + (size_t)(tok < 0 ? 0 : tok) * D + col0; o[m][0] = *(const u32x4*)(rowp); o[m][1] = *(const u32x4*)(rowp + HALF); }
#pragma unroll
            for (int m = 0; m < 4; ++m) { const int tok = tokv[ai][m]; float s = 0.f; bf16_t* rowp = H + (size_t)(tok < 0 ? 0 : tok) * D + col0;
#pragma unroll
                for (int bj = 0; bj < 2; ++bj) { const u32x4 oo = o[m][bj];
                    f32x4 v0 = acc[ai][bj][m][0], v1 = acc[ai][bj][m][1];
                    v0[0] += __uint_as_float(oo.x << 16); v0[1] += __uint_as_float(oo.x & 0xffff0000u); v0[2] += __uint_as_float(oo.y << 16); v0[3] += __uint_as_float(oo.y & 0xffff0000u);
                    v1[0] += __uint_as_float(oo.z << 16); v1[1] += __uint_as_float(oo.z & 0xffff0000u); v1[2] += __uint_as_float(oo.w << 16); v1[3] += __uint_as_float(oo.w & 0xffff0000u);
                    s += (v0[0] * v0[0] + v0[1] * v0[1]) + (v0[2] * v0[2] + v0[3] * v0[3]) + (v1[0] * v1[0] + v1[1] * v1[1]) + (v1[2] * v1[2] + v1[3] * v1[3]);
                    u32x4 w; w.x = cvt_pk_bf16(v0[0], v0[1]); w.y = cvt_pk_bf16(v0[2], v0[3]); w.z = cvt_pk_bf16(v1[0], v1[1]); w.w = cvt_pk_bf16(v1[2], v1[3]);
                    if (tok >= 0) *(u32x4*)(rowp + bj * HALF) = w; }
                s = add_x16_x32(s);
                if (fq == 0 && tok >= 0) ssq[(size_t)tok * 16 + u.pn * 4 + wc] = s; }
            asm volatile("" ::: "memory"); }
    }
};
constexpr int SC_W = 0x7b7b7b7b, SC_H = 0x7b7b7b7b, SC_ACT = 0x7b7b7b7b;
constexpr float FS_W = 16.f, FS_H = 16.f, FS_ACT = 16.f;
struct EpiUp {
    static constexpr bool PERM = true, AFTER_DRAIN = false; static constexpr int SCALE_W = SC_W, SCALE_A = SC_H;
    unsigned char* ACT; const float* rowg;
    __device__ __forceinline__ void operator()(const f32x4 (&acc)[2][2][4][2], const Unit& u, int wr, int wc, int fr, int fq) const {
        { const int ln_ = fresh_lane(); fr = ln_ & 15; fq = ln_ >> 4; }
        const int row0 = u.pm * BM + wr * 64 + fr, s = u.pn >> 2, col0 = s * 512 + (u.pn & 3) * 128 + wc * 32 + 8 * fq;
        float gt[2][4];
#pragma unroll
        for (int ai = 0; ai < 2; ++ai)
#pragma unroll
            for (int m = 0; m < 4; ++m) gt[ai][m] = rowg[(size_t)(row0 + ai * HALF + m * 16) * 2 + s];
#pragma unroll
        for (int ai = 0; ai < 2; ++ai)
#pragma unroll
            for (int m = 0; m < 4; ++m) { const int row = row0 + ai * HALF + m * 16; const float g1 = gt[ai][m];
                float o[8];
#pragma unroll
                for (int n = 0; n < 2; ++n)
#pragma unroll
                    for (int j = 0; j < 4; ++j) { const float g = acc[ai][0][m][n][j], up = acc[ai][1][m][n][j]; o[n * 4 + j] = g * sigmoid_fast(g) * up * g1; }
                u32x2 w; w.x = pk_fp8x4(o[0] * FS_ACT, o[1] * FS_ACT, o[2] * FS_ACT, o[3] * FS_ACT); w.y = pk_fp8x4(o[4] * FS_ACT, o[5] * FS_ACT, o[6] * FS_ACT, o[7] * FS_ACT);
                *(u32x2*)(ACT + (size_t)row * 1024 + col0) = w; }
    }
};
}

__device__ __forceinline__ void tr_item(const float* W, int ldw, int k0, int scol0, const float* gk, bf16_t* WT, int ldo, int drow0, int dk0, LAS float* scr, int lane) {
#pragma unroll 8
    for (int i = 0; i < 32; ++i) { const int kk = 2 * i + (lane >> 5); float v = W[(size_t)(k0 + kk) * ldw + scol0 + (lane & 31)]; if (gk) v *= gk[k0 + kk]; scr[kk * 33 + (lane & 31)] = v; }
    asm volatile("s_waitcnt lgkmcnt(0)" ::: "memory");
    const int c = lane & 7;
#pragma unroll
    for (int j = 0; j < 4; ++j) { const int n = (lane >> 3) + 8 * j; const LAS float* s = scr + (8 * c) * 33 + n;
        u32x4 o; o.x = cvt_pk_bf16(s[0 * 33], s[1 * 33]); o.y = cvt_pk_bf16(s[2 * 33], s[3 * 33]); o.z = cvt_pk_bf16(s[4 * 33], s[5 * 33]); o.w = cvt_pk_bf16(s[6 * 33], s[7 * 33]);
        *(u32x4*)(WT + (size_t)(drow0 + n) * ldo + dk0 + 8 * c) = o; }
    asm volatile("s_waitcnt lgkmcnt(0)" ::: "memory");
}

constexpr size_t S5_L_STRIDE = 1310720, S5_KT = 0, S5_ET = 131072, S5_FT = 655360, S5_LAMP = 1179648;
constexpr int S5_WSCR = 8192, S5_YST = 65536, YST_LD = 264;
constexpr int NU128 = T / 128, UPB128 = SEQ / 128;
__device__ __forceinline__ f32x4 mfma16(bf16x8 a, bf16x8 b, f32x4 c) { return __builtin_amdgcn_mfma_f32_16x16x32_bf16(a, b, c, 0, 0, 0); }

__device__ __forceinline__ void s5_table_elem(int g, int e, const float* a_re, const float* a_im, const float* log_dt, const float* b_re, const float* b_im,
                                              const float* c_re, const float* c_im, const float* dvec, unsigned char* tab) {
    const float dt = expf(log_dt[g]);
    if (e < 4096) {
        const int dd = e >> 9, c = (e >> 5) & 15, ee = (e >> 4) & 1, cp = e & 15, d = dd - ee; float s = 0.f;
        if (d >= 0) {
            for (int p = 0; p < CS; ++p) { const float lr = a_re[g * CS + p], li = a_im[g * CS + p], zr = lr * dt, zi = li * dt;
                const float sh = sinf(0.5f * zi); const float nr = expm1f(zr) * cosf(zi) - 2.0f * sh * sh, ni = expf(zr) * sinf(zi), den = lr * lr + li * li;
                const float cr = (nr * lr + ni * li) / den, ci = (ni * lr - nr * li) / den;
                const float br = b_re[((size_t)g * CS + p) * CGD + cp], bi = b_im[((size_t)g * CS + p) * CGD + cp]; const float bbr = cr * br - ci * bi, bbi = cr * bi + ci * br;
                const float mag = expf(zr * (float)d), pr = mag * cosf(zi * (float)d), pi = mag * sinf(zi * (float)d);
                const float vr = pr * bbr - pi * bbi, vi = pr * bbi + pi * bbr;
                s += c_re[((size_t)g * CGD + c) * CS + p] * vr - c_im[((size_t)g * CGD + c) * CS + p] * vi; }
            if (d == 0 && c == cp) s += dvec[g * CGD + c];
        }
        ((bf16_t*)(tab + S5_KT))[(size_t)g * 4096 + e] = f2bf(s); return;
    }
    e -= 4096;
    if (e < 16384) {
        const int n = e >> 7, k = e & 127, ri = n >> 6, p = n & 63, sp = k >> 4, cp = k & 15;
        const float lr = a_re[g * CS + p], li = a_im[g * CS + p], zr = lr * dt, zi = li * dt;
        const float sh = sinf(0.5f * zi); const float nr = expm1f(zr) * cosf(zi) - 2.0f * sh * sh, ni = expf(zr) * sinf(zi), den = lr * lr + li * li;
        const float cr = (nr * lr + ni * li) / den, ci = (ni * lr - nr * li) / den;
        const float br = b_re[((size_t)g * CS + p) * CGD + cp], bi = b_im[((size_t)g * CS + p) * CGD + cp]; const float bbr = cr * br - ci * bi, bbi = cr * bi + ci * br;
        const float d = (float)(7 - sp); const float mag = expf(zr * d), pr = mag * cosf(zi * d), pi = mag * sinf(zi * d);
        ((bf16_t*)(tab + S5_ET))[(size_t)g * 16384 + e] = f2bf(ri ? (pr * bbi + pi * bbr) : (pr * bbr - pi * bbi)); return;
    }
    e -= 16384;
    if (e < 16384) {
        const int n = e >> 7, k = e & 127, tp = n >> 4, c = n & 15, ri = k >> 6, p = k & 63;
        const float lr = a_re[g * CS + p], li = a_im[g * CS + p], zr = lr * dt, zi = li * dt;
        const float d = (float)(tp + 1); const float mag = expf(zr * d), pr = mag * cosf(zi * d), pi = mag * sinf(zi * d);
        const float cre = c_re[((size_t)g * CGD + c) * CS + p], cim = c_im[((size_t)g * CGD + c) * CS + p];
        ((bf16_t*)(tab + S5_FT))[(size_t)g * 16384 + e] = f2bf(ri ? -(cre * pi + cim * pr) : (cre * pr - cim * pi)); return;
    }
    e -= 16384;
    { const int p = e; const float lr = a_re[g * CS + p], li = a_im[g * CS + p], zr = lr * dt, zi = li * dt; float* o = (float*)(tab + S5_LAMP) + ((size_t)g * CS + p) * 8;
      float mag = expf(zr); o[0] = mag * cosf(zi); o[1] = mag * sinf(zi);
      mag = expf(zr * 8.f); o[2] = mag * cosf(zi * 8.f); o[3] = mag * sinf(zi * 8.f);
      mag = expf(zr * 128.f); o[4] = mag * cosf(zi * 128.f); o[5] = mag * sinf(zi * 128.f); o[6] = 0.f; o[7] = 0.f; }
}

template <class TT> __device__ __forceinline__ TT ldg(const void* ubase, unsigned voff) { return *(const TT*)((const char*)ubase + voff); }
template <int PASS>
__device__ __forceinline__ void s5_group(int unit, int g, bool first, float& kr, float& ki, int wave, int lane, const bf16_t* Z, bf16_t* Y, const unsigned char* tab, float* SEND, float* SEND2, float* SE, LAS unsigned char* lds) {
    const int ln = lane & 15, q = lane >> 4; const int t0 = unit * 128;
    const char* KTg = (const char*)(tab + S5_KT) + (size_t)g * 8192; const char* ETg = (const char*)(tab + S5_ET) + (size_t)g * 32768; const char* FTg = (const char*)(tab + S5_FT) + (size_t)g * 32768;
    const float* LAMPg = (const float*)(tab + S5_LAMP) + (size_t)g * CS * 8;
    const unsigned vo128 = (unsigned)(ln * 128 + 8 * q) * 2u;
    const unsigned vo32 = (unsigned)(ln * 32 + 8 * q) * 2u;
    LAS float* Sb = (LAS float*)(lds + wave * S5_WSCR); LAS bf16_t* Tb = (LAS bf16_t*)(lds + wave * S5_WSCR); LAS bf16_t* yst = (LAS bf16_t*)(lds + S5_YST);
    char* seb = (char*)(SE + ((size_t)unit * CG + g) * 16 * 128); const unsigned vl = (unsigned)lane * 4u;
    char* ylb = (char*)(Y + (size_t)t0 * D + AW + BW + g * 16); const unsigned vy = (unsigned)((ln * 8) * D + 4 * q) * 2u;
    const float lur = LAMPg[lane * 8 + 4], lui = LAMPg[lane * 8 + 5], l8r = LAMPg[lane * 8 + 2], l8i = LAMPg[lane * 8 + 3];
    float cr = 0.f, ci = 0.f;
    if (PASS == 1) {
        if (!first) { cr = kr; ci = ki; }
        bf16x8 X0, X1, X2, X3;
        { const char* zb = (const char*)(Z + (size_t)t0 * INC + ZC + g * 16); const unsigned vz = (unsigned)((ln * 8 + (q >> 1)) * INC + 8 * (q & 1)) * 2u;
          X0 = ldg<bf16x8>(zb, vz); X1 = ldg<bf16x8>(zb + 2 * INC * 2, vz); X2 = ldg<bf16x8>(zb + 4 * INC * 2, vz); X3 = ldg<bf16x8>(zb + 6 * INC * 2, vz); }
        { LAS float* sw = Sb + (4 * q) * 128 + ln; const char* eb = ETg;
#pragma unroll 1
          for (int jh = 0; jh < 2; ++jh) { bf16x8 ef[4][4];
#pragma unroll
            for (int j = 0; j < 4; ++j)
#pragma unroll
              for (int ks = 0; ks < 4; ++ks) ef[j][ks] = ldg<bf16x8>(eb + j * 4096 + ks * 64, vo128);
#pragma unroll
            for (int j = 0; j < 4; ++j) { f32x4 se = (f32x4){0.f, 0.f, 0.f, 0.f};
              se = mfma16(X0, ef[j][0], se); se = mfma16(X1, ef[j][1], se); se = mfma16(X2, ef[j][2], se); se = mfma16(X3, ef[j][3], se);
              LAS float* s2 = sw + 16 * j; s2[0] = se[0]; s2[128] = se[1]; s2[256] = se[2]; s2[384] = se[3]; }
            eb += 16384; sw += 64; } }
        asm volatile("" ::: "memory");
        { const char* kb = KTg; char* yq = ylb;
#pragma unroll 1
          for (int th = 0; th < 4; ++th) {
              const bf16x8 ka = ldg<bf16x8>(kb, vo32), kc = ldg<bf16x8>(kb + 1024, vo32);
              f32x4 acc0 = (f32x4){0.f, 0.f, 0.f, 0.f}, acc1 = (f32x4){0.f, 0.f, 0.f, 0.f};
              acc0 = mfma16(ka, X0, acc0); acc1 = mfma16(kc, X0, acc1);
              if (th >= 1) { acc0 = mfma16(ldg<bf16x8>(kb - 2048, vo32), X1, acc0); acc1 = mfma16(ldg<bf16x8>(kb - 1024, vo32), X1, acc1); }
              if (th >= 2) { acc0 = mfma16(ldg<bf16x8>(kb - 4096, vo32), X2, acc0); acc1 = mfma16(ldg<bf16x8>(kb - 3072, vo32), X2, acc1); }
              if (th >= 3) { acc0 = mfma16(ldg<bf16x8>(kb - 6144, vo32), X3, acc0); acc1 = mfma16(ldg<bf16x8>(kb - 5120, vo32), X3, acc1); }
              u32x2 w; w.x = cvt_pk_bf16(acc0[0], acc0[1]); w.y = cvt_pk_bf16(acc0[2], acc0[3]); *(u32x2*)(yq + vy) = w;
              w.x = cvt_pk_bf16(acc1[0], acc1[1]); w.y = cvt_pk_bf16(acc1[2], acc1[3]); *(u32x2*)(yq + (size_t)D * 2 + vy) = w;
              kb += 2048; yq += (size_t)2 * D * 2; } }
        asm volatile("" ::: "memory");
        float sr = cr, si = ci;
#pragma unroll
        for (int s = 0; s < 16; ++s) { const float er = Sb[s * 128 + lane], ei = Sb[s * 128 + 64 + lane];
            *(float*)(seb + s * 512 + vl) = er; *(float*)(seb + s * 512 + 256 + vl) = ei;
            const float nr = l8r * sr - l8i * si + er, ni = l8r * si + l8i * sr + ei; sr = nr; si = ni; }
        kr = sr; ki = si;
        float* dst = first ? SEND + (((size_t)unit * CG + g) * 2) * CS + lane : SEND2 + (((size_t)(unit >> 1) * CG + g) * 2) * CS + lane;
        dst[0] = sr; dst[CS] = si; asm volatile("" ::: "memory"); return;
    }
    if (first) { const int pr = unit >> 1, p0 = pr - (pr % (UPB128 / 2)); const float l2r = lur * lur - lui * lui, l2i = 2.0f * lur * lui;
        const char* sb = (const char*)(SEND2 + (((size_t)p0 * CG + g) * 2) * CS);
#pragma unroll 8
        for (int j = p0; j < pr; ++j) { const float sr = ldg<float>(sb, vl), si = ldg<float>(sb + CS * 4, vl); sb += (size_t)CG * 2 * CS * 4;
            const float nr = l2r * cr - l2i * ci + sr, ni = l2r * ci + l2i * cr + si; cr = nr; ci = ni; } }
    else { const float sr = SEND[(((size_t)(unit - 1) * CG + g) * 2 + 0) * CS + lane], si = SEND[(((size_t)(unit - 1) * CG + g) * 2 + 1) * CS + lane];
        cr = lur * kr - lui * ki + sr; ci = lur * ki + lui * kr + si; }
    kr = cr; ki = ci;
    { float sre[16], sim[16];
#pragma unroll
      for (int s = 0; s < 16; ++s) { sre[s] = ldg<float>(seb + s * 512, vl); sim[s] = ldg<float>(seb + s * 512 + 256, vl); }
      float sr = cr, si = ci;
#pragma unroll
      for (int s = 0; s < 16; ++s) { Tb[s * 128 + lane] = f2bf(sr); Tb[s * 128 + 64 + lane] = f2bf(si);
          const float nr = l8r * sr - l8i * si + sre[s], ni = l8r * si + l8i * sr + sim[s]; sr = nr; si = ni; } }
    asm volatile("" ::: "memory");
    const bf16x8 T0 = *(const LAS bf16x8*)(Tb + ln * 128 + 8 * q), T1 = *(const LAS bf16x8*)(Tb + ln * 128 + 32 + 8 * q), T2 = *(const LAS bf16x8*)(Tb + ln * 128 + 64 + 8 * q), T3 = *(const LAS bf16x8*)(Tb + ln * 128 + 96 + 8 * q);
    { LAS bf16_t* yw = yst + (ln * 8) * YST_LD + g * 16 + 4 * q; const char* fb = FTg; const char* yq = ylb;
#pragma unroll 1
      for (int th = 0; th < 4; ++th) { bf16x8 ff[2][4]; u32x2 yl[2];
#pragma unroll
          for (int j = 0; j < 2; ++j) { yl[j] = ldg<u32x2>(yq + (size_t)j * D * 2, vy);
#pragma unroll
              for (int ks = 0; ks < 4; ++ks) ff[j][ks] = ldg<bf16x8>(fb + j * 4096 + ks * 64, vo128); }
#pragma unroll
          for (int j = 0; j < 2; ++j) {
              f32x4 acc; acc[0] = __uint_as_float(yl[j].x << 16); acc[1] = __uint_as_float(yl[j].x & 0xffff0000u); acc[2] = __uint_as_float(yl[j].y << 16); acc[3] = __uint_as_float(yl[j].y & 0xffff0000u);
              acc = mfma16(ff[j][0], T0, acc); acc = mfma16(ff[j][1], T1, acc); acc = mfma16(ff[j][2], T2, acc); acc = mfma16(ff[j][3], T3, acc);
              u32x2 w; w.x = cvt_pk_bf16(gelu_fast(acc[0]), gelu_fast(acc[1])); w.y = cvt_pk_bf16(gelu_fast(acc[2]), gelu_fast(acc[3]));
              *(LAS u32x2*)(yw + j * YST_LD) = w; }
          fb += 8192; yq += (size_t)2 * D * 2; yw += 2 * YST_LD; } }
    asm volatile("s_waitcnt lgkmcnt(0)" ::: "memory");
}
constexpr int S5_PSG = 133120;
__device__ __forceinline__ void s5_glu(int unit, int wave, int lane, const bf16_t* WGLU, const float* glu_b, const float* mo_gc, bf16_t* Y, LAS unsigned char* lds) {
    const int ln = lane & 15, q = lane >> 4; LAS bf16_t* yst = (LAS bf16_t*)(lds + S5_YST); LAS float* PSg = (LAS float*)(lds + S5_PSG);
    bf16x8 wf[2][8];
    { const char* wb = (const char*)(WGLU + (size_t)(32 * wave) * 256); const unsigned vw = (unsigned)(ln * 256 + 8 * q) * 2u;
#pragma unroll
      for (int j = 0; j < 2; ++j)
#pragma unroll
          for (int ks = 0; ks < 8; ++ks) wf[j][ks] = ldg<bf16x8>(wb + j * 8192 + ks * 64, vw); }
    const f32x4 gb0 = *(const f32x4*)(glu_b + 32 * wave + 4 * q), gb1 = *(const f32x4*)(glu_b + 32 * wave + 16 + 4 * q);
    LAS bf16_t* op = (LAS bf16_t*)(lds + wave * S5_WSCR) + ln * 32 + 4 * q;
    { const LAS bf16_t* yrow = yst + ln * YST_LD; LAS float* psw = PSg + ln * 8 + wave; LAS bf16_t* ow = op;
#pragma unroll 2
      for (int tt = 0; tt < 8; ++tt) {
        f32x4 a0 = (f32x4){0.f, 0.f, 0.f, 0.f}, a1 = (f32x4){0.f, 0.f, 0.f, 0.f};
#pragma unroll
        for (int ks = 0; ks < 8; ++ks) { const bf16x8 yf = *(const LAS bf16x8*)(yrow + 32 * ks + 8 * q); a0 = mfma16(wf[0][ks], yf, a0); a1 = mfma16(wf[1][ks], yf, a1); }
        const u32x2 y0 = *(const LAS u32x2*)(yrow + 32 * wave + 4 * q), y1 = *(const LAS u32x2*)(yrow + 32 * wave + 16 + 4 * q);
        float o[8];
        o[0] = __uint_as_float(y0.x << 16) * sigmoid_fast(a0[0] + gb0[0]); o[1] = __uint_as_float(y0.x & 0xffff0000u) * sigmoid_fast(a0[1] + gb0[1]); o[2] = __uint_as_float(y0.y << 16) * sigmoid_fast(a0[2] + gb0[2]); o[3] = __uint_as_float(y0.y & 0xffff0000u) * sigmoid_fast(a0[3] + gb0[3]);
        o[4] = __uint_as_float(y1.x << 16) * sigmoid_fast(a1[0] + gb1[0]); o[5] = __uint_as_float(y1.x & 0xffff0000u) * sigmoid_fast(a1[1] + gb1[1]); o[6] = __uint_as_float(y1.y << 16) * sigmoid_fast(a1[2] + gb1[2]); o[7] = __uint_as_float(y1.y & 0xffff0000u) * sigmoid_fast(a1[3] + gb1[3]);
        float ss = ((o[0] * o[0] + o[1] * o[1]) + (o[2] * o[2] + o[3] * o[3])) + ((o[4] * o[4] + o[5] * o[5]) + (o[6] * o[6] + o[7] * o[7]));
        ss = add_x16_x32(ss);
        if (q == 0) *psw = ss;
        u32x2 w; w.x = cvt_pk_bf16(o[0], o[1]); w.y = cvt_pk_bf16(o[2], o[3]); *(LAS u32x2*)(ow) = w; w.x = cvt_pk_bf16(o[4], o[5]); w.y = cvt_pk_bf16(o[6], o[7]); *(LAS u32x2*)(ow + 16) = w;
        yrow += 16 * YST_LD; psw += 16 * 8; ow += 16 * 32; } }
    asm volatile("s_waitcnt lgkmcnt(0)" ::: "memory");
    __syncthreads();
    const f32x4 g0 = *(const f32x4*)(mo_gc + 32 * wave + 4 * q), g1 = *(const f32x4*)(mo_gc + 32 * wave + 16 + 4 * q);
    { char* yb = (char*)(Y + (size_t)(unit * 128) * D + AW + BW + 32 * wave); const unsigned vy = (unsigned)(ln * D + 4 * q) * 2u; const LAS f32x4* pp = (const LAS f32x4*)(PSg + ln * 8); const LAS bf16_t* ow = op;
#pragma unroll 2
      for (int tt = 0; tt < 8; ++tt) { const f32x4 p0 = pp[0], p1 = pp[1];
        const float rs = __builtin_amdgcn_rsqf((((p0[0] + p0[1]) + (p0[2] + p0[3])) + ((p1[0] + p1[1]) + (p1[2] + p1[3]))) * (1.0f / CW) + EPS);
        const u32x2 a = *(const LAS u32x2*)(ow), b = *(const LAS u32x2*)(ow + 16); u32x2 w;
        w.x = cvt_pk_bf16(__uint_as_float(a.x << 16) * rs * g0[0], __uint_as_float(a.x & 0xffff0000u) * rs * g0[1]); w.y = cvt_pk_bf16(__uint_as_float(a.y << 16) * rs * g0[2], __uint_as_float(a.y & 0xffff0000u) * rs * g0[3]);
        *(u32x2*)(yb + vy) = w;
        w.x = cvt_pk_bf16(__uint_as_float(b.x << 16) * rs * g1[0], __uint_as_float(b.x & 0xffff0000u) * rs * g1[1]); w.y = cvt_pk_bf16(__uint_as_float(b.y << 16) * rs * g1[2], __uint_as_float(b.y & 0xffff0000u) * rs * g1[3]);
        *(u32x2*)(yb + 32 + vy) = w;
        yb += (size_t)16 * D * 2; pp += 16 * 2; ow += 16 * 32; } }
}

constexpr int XC_LD = 392;
constexpr int RG_XC = 0, RG_PS = 100352, RG_CAR = 112640, RG_RSB = 114176, RG_PT = 114688, RG_HC = 116224;
template <int CTRL> __device__ __forceinline__ float dppf(float old, float v) { return __int_as_float(__builtin_amdgcn_update_dpp(__float_as_int(old), __float_as_int(v), CTRL, 0xf, 0xf, false)); }
__device__ __forceinline__ void bf8_to_f32(const u32x4 o, float (&v)[8]) {
    v[0] = __uint_as_float(o.x << 16); v[1] = __uint_as_float(o.x & 0xffff0000u); v[2] = __uint_as_float(o.y << 16); v[3] = __uint_as_float(o.y & 0xffff0000u);
    v[4] = __uint_as_float(o.z << 16); v[5] = __uint_as_float(o.z & 0xffff0000u); v[6] = __uint_as_float(o.w << 16); v[7] = __uint_as_float(o.w & 0xffff0000u);
}
__device__ __forceinline__ float bcast15(float v) { return __int_as_float(__builtin_amdgcn_ds_swizzle(__float_as_int(v), 0x1F0)); }
template <int PASS>
__device__ __forceinline__ void rglru_unit(int unit, bool first, float& cprev, int tid, int wave, int lane, const bf16_t* Z, bf16_t* Y, const bf16_t* WRG, const bf16_t* WIG,
                                           const float* conv_w, const float* conv_b, const float* rg_b, const float* ig_b, const float* lam, const float* mo_gb,
                                           float* SUMA, float* SUMH, float* SUMA2, float* SUMH2, bf16_t* HL, bf16_t* PP, LAS unsigned char* lds) {
    LAS bf16_t* xcl = (LAS bf16_t*)(lds + RG_XC); LAS float* PS = (LAS float*)(lds + RG_PS); LAS float* CAR = (LAS float*)(lds + RG_CAR); LAS float* RSB = (LAS float*)(lds + RG_RSB); LAS float* PT = (LAS float*)(lds + RG_PT); LAS float* HC = (LAS float*)(lds + RG_HC);
    const int t0 = unit * 128; const int ln = lane & 15, q = lane >> 4;
    if (tid < 384) {
        const int c0 = (tid % 48) * 8, tg = tid / 48; const int tb = t0 + tg * 16, s0 = tb % SEQ;
        float w0[8], w1[8], w2[8], w3[8], bb[8];
#pragma unroll
        for (int hh = 0; hh < 2; ++hh) { const f32x4 a0 = *(const f32x4*)(conv_w + 0 * BW + c0 + 4 * hh), a1 = *(const f32x4*)(conv_w + 1 * BW + c0 + 4 * hh), a2 = *(const f32x4*)(conv_w + 2 * BW + c0 + 4 * hh), a3 = *(const f32x4*)(conv_w + 3 * BW + c0 + 4 * hh), a4 = *(const f32x4*)(conv_b + c0 + 4 * hh);
#pragma unroll
            for (int j = 0; j < 4; ++j) { w0[4 * hh + j] = a0[j]; w1[4 * hh + j] = a1[j]; w2[4 * hh + j] = a2[j]; w3[4 * hh + j] = a3[j]; bb[4 * hh + j] = a4[j]; } }
        float xm1[8], xm2[8], xm3[8];
        const bf16_t* zp = Z + (size_t)tb * INC + ZX + c0;
        { const u32x4 z4 = {0u, 0u, 0u, 0u}; const u32x4 o1 = s0 >= 1 ? *(const u32x4*)(zp - INC) : z4, o2 = s0 >= 2 ? *(const u32x4*)(zp - 2 * INC) : z4, o3 = s0 >= 3 ? *(const u32x4*)(zp - 3 * INC) : z4;
          bf8_to_f32(o1, xm1); bf8_to_f32(o2, xm2); bf8_to_f32(o3, xm3); }
        LAS bf16_t* xw = xcl + (tg * 16) * XC_LD + c0;
#pragma unroll 4
        for (int i = 0; i < 16; ++i) { float x0[8]; bf8_to_f32(*(const u32x4*)(zp), x0); float v[8];
#pragma unroll
            for (int j = 0; j < 8; ++j) { v[j] = bb[j] + w3[j] * x0[j] + w2[j] * xm1[j] + w1[j] * xm2[j] + w0[j] * xm3[j]; xm3[j] = xm2[j]; xm2[j] = xm1[j]; xm1[j] = x0[j]; }
            u32x4 w; w.x = cvt_pk_bf16(v[0], v[1]); w.y = cvt_pk_bf16(v[2], v[3]); w.z = cvt_pk_bf16(v[4], v[5]); w.w = cvt_pk_bf16(v[6], v[7]);
            *(LAS u32x4*)(xw) = w; zp += INC; xw += XC_LD; }
        if (PASS == 2) { const int c = tid; float h;
            if (first) { const int pr = unit >> 1, p0 = pr - (pr % (UPB128 / 2)); h = 0.f; const float* pa = SUMA2 + (size_t)p0 * BW + c; const float* ph = SUMH2 + (size_t)p0 * BW + c;
#pragma unroll 8
                for (int j = p0; j < pr; ++j) { h = fmaf(*pa, h, *ph); pa += BW; ph += BW; } }
            else h = fmaf(SUMA[(size_t)(unit - 1) * BW + c], cprev, SUMH[(size_t)(unit - 1) * BW + c]);
            cprev = h; CAR[c] = h; }
    }
    __syncthreads();
#pragma unroll 1
    for (int ci = 0; ci < 3; ++ci) {
        const int combo = wave + 8 * ci, h = combo >> 2, jt = combo & 3, cb = h * 64 + jt * 16;
        const bf16_t* wr = WRG + ((size_t)(h * 64 + jt * 16 + ln)) * 64 + 8 * q; const bf16_t* wi = WIG + ((size_t)(h * 64 + jt * 16 + ln)) * 64 + 8 * q;
        const bf16x8 RG0 = *(const bf16x8*)(wr), RG1 = *(const bf16x8*)(wr + 32), IG0 = *(const bf16x8*)(wi), IG1 = *(const bf16x8*)(wi + 32);
        const f32x4 rgb4 = *(const f32x4*)(rg_b + cb + 4 * q), igb4 = *(const f32x4*)(ig_b + cb + 4 * q), lam4 = *(const f32x4*)(lam + cb + 4 * q);
        float spc[4], car[4], ptot[4];
#pragma unroll
        for (int r = 0; r < 4; ++r) { spc[r] = -8.0f * 1.4426950408889634f * log1pf(expf(-lam4[r])); car[r] = PASS == 2 ? CAR[cb + 4 * q + r] : (first ? 0.f : HC[cb + 4 * q + r]); ptot[r] = (PASS == 1 && !first) ? PT[cb + 4 * q + r] : 1.f; }
        const LAS bf16_t* xb = xcl + ln * XC_LD + h * 64 + 8 * q; const LAS bf16_t* xv = xcl + ln * XC_LD + cb + 4 * q;
        const bf16_t* zg = Z + (size_t)(t0 + ln) * INC + ZG + cb + 4 * q; bf16_t* yo = Y + (size_t)(t0 + ln) * D + AW + cb + 4 * q; LAS float* psw = PS + ln * 24 + combo;
        bf16_t* hlo = HL + (size_t)(t0 + ln) * BW + cb + 4 * q; bf16_t* ppo = PP + (size_t)(t0 + ln) * BW + cb + 4 * q;
#pragma unroll 1
        for (int tt = 0; tt < 8; ++tt) {
            const bf16x8 B0 = *(const LAS bf16x8*)(xb), B1 = *(const LAS bf16x8*)(xb + 32);
            f32x4 ar = (f32x4){0.f, 0.f, 0.f, 0.f}, ai = (f32x4){0.f, 0.f, 0.f, 0.f};
            ar = mfma16(RG0, B0, ar); ar = mfma16(RG1, B1, ar); ai = mfma16(IG0, B0, ai); ai = mfma16(IG1, B1, ai);
            const u32x2 xq = *(const LAS u32x2*)(xv); float xc4[4] = {__uint_as_float(xq.x << 16), __uint_as_float(xq.x & 0xffff0000u), __uint_as_float(xq.y << 16), __uint_as_float(xq.y & 0xffff0000u)};
            float hv[4], pv[4];
#pragma unroll
            for (int r = 0; r < 4; ++r) {
                const float rr = sigmoid_fast(ar[r] + rgb4[r]), ii = sigmoid_fast(ai[r] + igb4[r]);
                float A = __builtin_amdgcn_exp2f(spc[r] * rr);
                float Bv = __builtin_amdgcn_sqrtf(fmaxf(1.0f - A * A, 0.f)) * (ii * xc4[r]);
                if (ln == 0) Bv = fmaf(A, car[r], Bv);
                { const float As = dppf<0x111>(1.0f, A), Bs = dppf<0x111>(0.0f, Bv); Bv = fmaf(A, Bs, Bv); A *= As; }
                { const float As = dppf<0x112>(1.0f, A), Bs = dppf<0x112>(0.0f, Bv); Bv = fmaf(A, Bs, Bv); A *= As; }
                { const float As = dppf<0x114>(1.0f, A), Bs = dppf<0x114>(0.0f, Bv); Bv = fmaf(A, Bs, Bv); A *= As; }
                { const float As = dppf<0x118>(1.0f, A), Bs = dppf<0x118>(0.0f, Bv); Bv = fmaf(A, Bs, Bv); A *= As; }
                hv[r] = Bv; car[r] = bcast15(Bv);
                if (PASS == 1) { pv[r] = ptot[r] * A; ptot[r] *= bcast15(A); }
            }
            if (PASS == 1) { u32x2 w; w.x = cvt_pk_bf16(hv[0], hv[1]); w.y = cvt_pk_bf16(hv[2], hv[3]); *(u32x2*)(hlo) = w; w.x = cvt_pk_bf16(pv[0], pv[1]); w.y = cvt_pk_bf16(pv[2], pv[3]); *(u32x2*)(ppo) = w; hlo += 16 * BW; ppo += 16 * BW; }
            if (PASS == 2) { const u32x2 gq = *(const u32x2*)(zg);
                const float y0 = hv[0] * __uint_as_float(gq.x << 16), y1 = hv[1] * __uint_as_float(gq.x & 0xffff0000u), y2 = hv[2] * __uint_as_float(gq.y << 16), y3 = hv[3] * __uint_as_float(gq.y & 0xffff0000u);
                u32x2 w; w.x = cvt_pk_bf16(y0, y1); w.y = cvt_pk_bf16(y2, y3); *(u32x2*)(yo) = w;
                float ss = (y0 * y0 + y1 * y1) + (y2 * y2 + y3 * y3); ss += __shfl_xor(ss, 16); ss += __shfl_xor(ss, 32);
                if (q == 0) *psw = ss; }
            xb += 16 * XC_LD; xv += 16 * XC_LD; zg += 16 * INC; yo += 16 * D; psw += 16 * 24;
        }
        if (PASS == 1 && ln == 0) {
            float* da = first ? SUMA + (size_t)unit * BW : SUMA2 + (size_t)(unit >> 1) * BW; float* dh = first ? SUMH + (size_t)unit * BW : SUMH2 + (size_t)(unit >> 1) * BW;
#pragma unroll
            for (int r = 0; r < 4; ++r) { da[cb + 4 * q + r] = ptot[r]; dh[cb + 4 * q + r] = car[r]; if (first) { PT[cb + 4 * q + r] = ptot[r]; HC[cb + 4 * q + r] = car[r]; } } }
    }
    if (PASS == 2) {
        asm volatile("s_waitcnt vmcnt(0)" ::: "memory");
        __syncthreads();
        if (tid < 128) { float s = 0.f;
#pragma unroll
            for (int k = 0; k < 24; ++k) s += PS[tid * 24 + k];
            RSB[tid] = __builtin_amdgcn_rsqf(s * (1.0f / BW) + EPS); }
        __syncthreads();
#pragma unroll 2
        for (int k = 0; k < 12; ++k) { const int idx = tid + 512 * k, tl = idx / 48, c0 = (idx % 48) * 8; const float rs = RSB[tl];
            bf16_t* yp = Y + (size_t)(t0 + tl) * D + AW + c0; float v[8]; bf8_to_f32(*(const u32x4*)(yp), v);
            const f32x4 g0 = *(const f32x4*)(mo_gb + c0), g1 = *(const f32x4*)(mo_gb + c0 + 4);
            u32x4 w; w.x = cvt_pk_bf16(v[0] * rs * g0[0], v[1] * rs * g0[1]); w.y = cvt_pk_bf16(v[2] * rs * g0[2], v[3] * rs * g0[3]); w.z = cvt_pk_bf16(v[4] * rs * g1[0], v[5] * rs * g1[1]); w.w = cvt_pk_bf16(v[6] * rs * g1[2], v[7] * rs * g1[3]);
            *(u32x4*)(yp) = w; }
    }
    __syncthreads();
}

__device__ __forceinline__ void rglru_fix_pair(int pr, int tid, int wave, int lane, const bf16_t* Z, bf16_t* Y, const bf16_t* HL, const bf16_t* PP, const float* SUMA2, const float* SUMH2, const float* mo_gb, LAS unsigned char* lds) {
    LAS float* CAR = (LAS float*)(lds + RG_CAR);
    if (tid < 384) { const int c = tid, p0 = pr - (pr % (UPB128 / 2)); float h = 0.f; const float* pa = SUMA2 + (size_t)p0 * BW + c; const float* ph = SUMH2 + (size_t)p0 * BW + c;
#pragma unroll 8
        for (int j = p0; j < pr; ++j) { h = fmaf(*pa, h, *ph); pa += BW; ph += BW; }
        CAR[c] = h; }
    __syncthreads();
    {
        const bool act = lane < 48; const int c0 = act ? lane * 8 : 0; float hin[8]; const f32x4 g0 = *(const f32x4*)(mo_gb + c0), g1 = *(const f32x4*)(mo_gb + c0 + 4);
#pragma unroll
        for (int e = 0; e < 8; ++e) hin[e] = CAR[c0 + e];
#pragma unroll 2
        for (int i = 0; i < 32; ++i) { const size_t t = (size_t)pr * 256 + wave * 32 + i;
            float hl[8], pp[8], gg[8], y[8]; bf8_to_f32(*(const u32x4*)(HL + t * BW + c0), hl); bf8_to_f32(*(const u32x4*)(PP + t * BW + c0), pp); bf8_to_f32(*(const u32x4*)(Z + t * INC + ZG + c0), gg);
            float ss = 0.f;
#pragma unroll
            for (int e = 0; e < 8; ++e) { y[e] = fmaf(pp[e], hin[e], hl[e]) * gg[e]; ss += y[e] * y[e]; }
            ss = wave_sum(act ? ss : 0.f);
            const float rs = __builtin_amdgcn_rsqf(ss * (1.0f / BW) + EPS);
            u32x4 w; w.x = cvt_pk_bf16(y[0] * rs * g0[0], y[1] * rs * g0[1]); w.y = cvt_pk_bf16(y[2] * rs * g0[2], y[3] * rs * g0[3]); w.z = cvt_pk_bf16(y[4] * rs * g1[0], y[5] * rs * g1[1]); w.w = cvt_pk_bf16(y[6] * rs * g1[2], y[7] * rs * g1[3]);
            if (act) *(u32x4*)(Y + t * D + AW + c0) = w; }
    }
    __syncthreads();
}

constexpr int VT_LD = 136;
__device__ __forceinline__ void mixa_unit(int unit, int tid, int wave, int lane, const bf16_t* Z, bf16_t* Y, const bf16_t* WSP, const float* a_sb, const float* vg, const float* mo_ga, LAS unsigned char* lds) {
    LAS bf16_t* vT = (LAS bf16_t*)lds; const int t0 = unit * 128; const int ln = lane & 15, q = lane >> 4;
    { const int j = tid >> 2, part = tid & 3; const bf16_t* zp = Z + (size_t)(t0 + j) * INC + ZV + part * 96;
      u32x4 raw[12]; float ss = 0.f;
#pragma unroll
      for (int k = 0; k < 12; ++k) { raw[k] = *(const u32x4*)(zp + 8 * k); float v[8]; bf8_to_f32(raw[k], v);
#pragma unroll
          for (int e = 0; e < 8; ++e) ss += v[e] * v[e]; }
      ss += x_xor1(ss); ss += x_xor2(ss);
      const float rs = __builtin_amdgcn_rsqf(ss * (1.0f / AW) + EPS);
      LAS bf16_t* vw = vT + (part * 96) * VT_LD + j; const float* gp = vg + part * 96;
#pragma unroll
      for (int k = 0; k < 12; ++k) { float v[8]; bf8_to_f32(raw[k], v); const f32x4 g0 = *(const f32x4*)(gp + 8 * k), g1 = *(const f32x4*)(gp + 8 * k + 4);
#pragma unroll
          for (int e = 0; e < 8; ++e) vw[(8 * k + e) * VT_LD] = f2bf(v[e] * rs * (e < 4 ? g0[e] : g1[e - 4])); } }
    __syncthreads();
    const bool full = wave >= 4;
    float ss = 0.f;
    const int tl = 16 * wave + ln;
    const char* ub = (const char*)(Z + (size_t)t0 * INC + ZU); const unsigned vu = (unsigned)(tl * INC + 4 * q) * 2u;
    const char* wb = (const char*)WSP; const unsigned vw = (unsigned)(tl * 128 + 8 * q) * 2u;
    char* yb = (char*)(Y + (size_t)t0 * D); const unsigned vy = (unsigned)(tl * D + 4 * q) * 2u;
    const bf16x8 z8 = {0, 0, 0, 0, 0, 0, 0, 0};
    bf16x8 Wn0 = ldg<bf16x8>(wb, vw), Wn1 = ldg<bf16x8>(wb + 64, vw), Wn2 = z8, Wn3 = z8;
    if (full) { Wn2 = ldg<bf16x8>(wb + 128, vw); Wn3 = ldg<bf16x8>(wb + 192, vw); }
    u32x2 un0 = ldg<u32x2>(ub, vu), un1 = ldg<u32x2>(ub + 32, vu), un2 = ldg<u32x2>(ub + 64, vu), un3 = ldg<u32x2>(ub + 96, vu); float bn = a_sb[tl];
    const LAS bf16_t* ap = vT + ln * VT_LD + 8 * q;
#pragma unroll 1
    for (int h = 0; h < 6; ++h) {
        const bf16x8 W0 = Wn0, W1 = Wn1, W2 = Wn2, W3 = Wn3; const u32x2 uc[4] = {un0, un1, un2, un3}; const float b = bn;
        if (h < 5) { wb += 128 * 128 * 2; ub += 128; Wn0 = ldg<bf16x8>(wb, vw); Wn1 = ldg<bf16x8>(wb + 64, vw); if (full) { Wn2 = ldg<bf16x8>(wb + 128, vw); Wn3 = ldg<bf16x8>(wb + 192, vw); }
            un0 = ldg<u32x2>(ub, vu); un1 = ldg<u32x2>(ub + 32, vu); un2 = ldg<u32x2>(ub + 64, vu); un3 = ldg<u32x2>(ub + 96, vu); bn = a_sb[(h + 1) * 128 + tl]; }
#pragma unroll
        for (int dt = 0; dt < 4; ++dt) { f32x4 acc = (f32x4){0.f, 0.f, 0.f, 0.f};
            const bf16x8 a0 = *(const LAS bf16x8*)(ap + 16 * dt * VT_LD), a1 = *(const LAS bf16x8*)(ap + 16 * dt * VT_LD + 32), a2 = *(const LAS bf16x8*)(ap + 16 * dt * VT_LD + 64), a3 = *(const LAS bf16x8*)(ap + 16 * dt * VT_LD + 96);
            acc = mfma16(a0, W0, acc); acc = mfma16(a1, W1, acc); acc = mfma16(a2, W2, acc); acc = mfma16(a3, W3, acc);
            const u32x2 u2 = uc[dt];
            const float v0 = __uint_as_float(u2.x << 16) * (acc[0] + b), v1 = __uint_as_float(u2.x & 0xffff0000u) * (acc[1] + b), v2 = __uint_as_float(u2.y << 16) * (acc[2] + b), v3 = __uint_as_float(u2.y & 0xffff0000u) * (acc[3] + b);
            ss += (v0 * v0 + v1 * v1) + (v2 * v2 + v3 * v3);
            u32x2 pk; pk.x = cvt_pk_bf16(v0, v1); pk.y = cvt_pk_bf16(v2, v3); *(u32x2*)(yb + (h * 64 + 16 * dt) * 2 + vy) = pk; }
        ap += 64 * VT_LD;
    }
    ss = add_x16_x32(ss);
    const float rs = __builtin_amdgcn_rsqf(ss * (1.0f / AW) + EPS);
    asm volatile("s_waitcnt vmcnt(0)" ::: "memory");
    { const char* gb = (const char*)mo_ga; const unsigned vg4 = (unsigned)(4 * q) * 4u;
#pragma unroll 1
      for (int kb = 0; kb < 3; ++kb) { u32x2 pk[8];
#pragma unroll
          for (int k = 0; k < 8; ++k) pk[k] = ldg<u32x2>(yb + k * 32, vy);
#pragma unroll
          for (int k = 0; k < 8; ++k) { const f32x4 gg = ldg<f32x4>(gb + k * 64, vg4);
              u32x2 w; w.x = cvt_pk_bf16(__uint_as_float(pk[k].x << 16) * rs * gg[0], __uint_as_float(pk[k].x & 0xffff0000u) * rs * gg[1]); w.y = cvt_pk_bf16(__uint_as_float(pk[k].y << 16) * rs * gg[2], __uint_as_float(pk[k].y & 0xffff0000u) * rs * gg[3]);
              *(u32x2*)(yb + k * 32 + vy) = w; }
          yb += 256; gb += 512; } }
    __syncthreads();
}

__device__ __forceinline__ void router_unit(int unit, int wave, int lane, const bf16_t* HB, const float* SSQ, const bf16_t* WRT, const float* rgb, const float* reb,
                                            int* CLS, float* G2, LAS unsigned char* lds, LAS int* hist) {
    const int ln = lane & 15, q = lane >> 4; const int t0 = unit * UT + wave * 32;
    LAS float* LG = (LAS float*)(lds + wave * 8192);
    f32x4 acc[2][3];
#pragma unroll
    for (int tt = 0; tt < 2; ++tt)
#pragma unroll
        for (int j = 0; j < 3; ++j) acc[tt][j] = (f32x4){0.f, 0.f, 0.f, 0.f};
    const bf16_t* hp0 = HB + (size_t)(t0 + ln) * D + 8 * q; const bf16_t* hp1 = hp0 + (size_t)16 * D; const bf16_t* wp = WRT + (size_t)ln * D + 8 * q;
#pragma unroll 4
    for (int ks = 0; ks < 32; ++ks) {
        const bf16x8 b0 = *(const bf16x8*)(hp0), b1 = *(const bf16x8*)(hp1);
        const bf16x8 a0 = *(const bf16x8*)(wp), a1 = *(const bf16x8*)(wp + 16 * D), a2 = *(const bf16x8*)(wp + 32 * D);
        acc[0][0] = mfma16(a0, b0, acc[0][0]); acc[0][1] = mfma16(a1, b0, acc[0][1]); acc[0][2] = mfma16(a2, b0, acc[0][2]);
        acc[1][0] = mfma16(a0, b1, acc[1][0]); acc[1][1] = mfma16(a1, b1, acc[1][1]); acc[1][2] = mfma16(a2, b1, acc[1][2]);
        hp0 += 32; hp1 += 32; wp += 32; }
#pragma unroll
    for (int tt = 0; tt < 2; ++tt)
#pragma unroll
        for (int j = 0; j < 3; ++j) *(LAS f32x4*)(LG + (16 * tt + ln) * 48 + 16 * j + 4 * q) = acc[tt][j];
    asm volatile("s_waitcnt lgkmcnt(0)" ::: "memory");
    if (lane < 32) { const int t = t0 + lane; const LAS float* lg = LG + lane * 48;
        const f32x4* sp = (const f32x4*)(SSQ + (size_t)t * 16); const f32x4 s0 = sp[0], s1 = sp[1], s2 = sp[2], s3 = sp[3];
        const float sq = ((s0[0] + s0[1]) + (s0[2] + s0[3])) + ((s1[0] + s1[1]) + (s1[2] + s1[3])) + ((s2[0] + s2[1]) + (s2[2] + s2[3])) + ((s3[0] + s3[1]) + (s3[2] + s3[3]));
        const float r = rsqrtf(sq * (1.0f / D) + EPS);
        float gl[4];
#pragma unroll
        for (int j = 0; j < 4; ++j) gl[j] = r * (lg[j] + lg[16 + j]) + rgb[j];
        int gs = 0; float gm = gl[0];
#pragma unroll
        for (int j = 1; j < 4; ++j) if (gl[j] > gm) { gm = gl[j]; gs = j; }
        float den = 0.f;
#pragma unroll
        for (int j = 0; j < 4; ++j) den += expf(gl[j] - gm);
        const float gwt = 1.0f / den;
        float el[4];
#pragma unroll
        for (int j = 0; j < 4; ++j) { float v;
            if (gs < 3) v = lg[4 + 4 * gs + j] + lg[16 + 4 + 4 * gs + j]; else v = lg[32 + j] + lg[36 + j];
            el[j] = r * v + reb[gs * 4 + j]; }
        int i0 = 0; float v0 = el[0];
#pragma unroll
        for (int j = 1; j < 4; ++j) if (el[j] > v0) { v0 = el[j]; i0 = j; }
        int i1 = 0; float v1 = -3.0e38f;
#pragma unroll
        for (int j = 0; j < 4; ++j) if (j != i0 && el[j] > v1) { v1 = el[j]; i1 = j; }
        const float e1 = expf(v1 - v0); const float w0 = gwt / (1.0f + e1), w1 = gwt * e1 / (1.0f + e1);
        const int lo = i0 < i1 ? i0 : i1, hi = i0 < i1 ? i1 : i0; const int cls = gs * 6 + pair_idx(lo, hi);
        CLS[t] = cls; G2[(size_t)t * 2 + 0] = i0 < i1 ? w0 : w1; G2[(size_t)t * 2 + 1] = i0 < i1 ? w1 : w0;
        __hip_atomic_fetch_add(hist + cls, 1, __ATOMIC_RELAXED, __HIP_MEMORY_SCOPE_WORKGROUP); }
}

__device__ __forceinline__ void tr_item8(const float* W, int ldw, int k0, int scol0, unsigned char* WT, int ldo, int drow0, int dk0, LAS float* scr, int lane) {
#pragma unroll 8
    for (int i = 0; i < 32; ++i) { const int kk = 2 * i + (lane >> 5); scr[kk * 33 + (lane & 31)] = W[(size_t)(k0 + kk) * ldw + scol0 + (lane & 31)] * pg8::FS_W; }
    asm volatile("s_waitcnt lgkmcnt(0)" ::: "memory");
    const int c = lane & 7;
#pragma unroll
    for (int j = 0; j < 4; ++j) { const int n = (lane >> 3) + 8 * j; const LAS float* s = scr + (8 * c) * 33 + n;
        u32x2 o; o.x = pk_fp8x4(s[0 * 33], s[1 * 33], s[2 * 33], s[3 * 33]); o.y = pk_fp8x4(s[4 * 33], s[5 * 33], s[6 * 33], s[7 * 33]);
        *(u32x2*)(WT + (size_t)(drow0 + n) * ldo + dk0 + 8 * c) = o; }
    asm volatile("s_waitcnt lgkmcnt(0)" ::: "memory");
}
struct Args { const float* in[34]; float* out; unsigned char* ws; };

__global__ void __launch_bounds__(512, 2) mega_fwd(Args a) {
    extern __shared__ __attribute__((aligned(16))) unsigned char lds_raw[];
    LAS unsigned char* lds = (LAS unsigned char*)lds_raw;
    volatile LAS unsigned* LW = (volatile LAS unsigned*)(lds + LDSCTL_OFF);
    volatile LAS int* LWI = (volatile LAS int*)(lds + LDSCTL_OFF);
    const int G = gridDim.x, bid0 = blockIdx.x; const int wave_s0 = __builtin_amdgcn_readfirstlane(threadIdx.x >> 6);
#define PHASE_IDS() int wv_ = wave_s0, bd_ = bid0; asm volatile("" : "+s"(wv_), "+s"(bd_)); const int wave_s = wv_, bid = bd_;     \
    const int lane = fresh_lane(), wave = wave_s, tid = wave * 64 + lane; const int gw = bid * 8 + wave, NGW = G * 8; \
    const size_t gt = (size_t)bid * 512 + tid, NGT = (size_t)G * 512; (void)lane; (void)wave; (void)gw; (void)NGW; (void)gt; (void)NGT
#define WSB() ({ unsigned char* _w = a.ws; asm volatile("" : "+s"(_w)); _w; })
#define INP(i) ({ int _k = (i); asm volatile("" : "+s"(_k)); a.in[_k]; })
    for (int u = threadIdx.x; u < (LDS_BYTES - LDSCTL_OFF) / 4; u += 512) LW[u] = 0u;
    __syncthreads();
    XcdBarrier bar = xcd_barrier_post((unsigned*)(a.ws + WS_CTL) + CW_BAR, LW + LW_BAR);

    {
        PHASE_IDS(); unsigned char* ws = WSB(); bf16_t* WIN = (bf16_t*)(ws + WS_WIN); bf16_t* WOUT = (bf16_t*)(ws + WS_WOUT); bf16_t* WGU = (bf16_t*)(ws + WS_WGU); bf16_t* WD2 = (bf16_t*)(ws + WS_WD2);
        bf16_t* HB = (bf16_t*)(ws + WS_HB); float* SSQ = (float*)(ws + WS_SSQ);
        LAS float* scr = (LAS float*)(lds + wave * 16384);
        constexpr int I_IN = 16 * 56, I_OUT = 16 * 32, I_GU = 2 * 16 * 256, I_D2 = 48 * 256, I_GLU = 32, I_RG = 24, I_L = I_IN + I_OUT + I_GU + I_D2 + I_GLU + I_RG;
        for (int it = gw; it < 2 * I_L; it += NGW) {
            const int l = it / I_L; int r = it % I_L;
            if (r < I_IN) { const int kb = r / 56, nb = r % 56, j0 = nb * 32; const int sc = j0 < 768 ? j0 : (j0 < 1152 ? j0 + 384 : (j0 < 1536 ? j0 - 384 : j0));
                tr_item(INP(2) + (size_t)l * D * INC, INC, kb * 64, sc, INP(1) + (size_t)l * D, WIN + (size_t)l * INC * D, D, j0, kb * 64, scr, lane); continue; }
            r -= I_IN;
            if (r < I_OUT) { const int kb = r / 32, nb = r % 32; tr_item(INP(24) + (size_t)l * D * D, D, kb * 64, nb * 32, nullptr, WOUT + (size_t)l * D * D, D, nb * 32, kb * 64, scr, lane); continue; }
            r -= I_OUT;
            if (r < I_GU) { const int which = r / (16 * 256), e = (r / 256) % 16, q = r % 256, kb = q / 16, nb = q % 16, n0 = nb * 32;
                const float* src = INP(30 + which) + ((size_t)l * NE + e) * D * DE;
                tr_item8(src, DE, kb * 64, n0, (unsigned char*)WGU + ((size_t)l * NE + e) * 1024 * 1024, 1024, (n0 / 128) * 256 + which * 128 + (n0 % 128), kb * 64, scr, lane); continue; }
            r -= I_GU;
            if (r >= I_D2 + I_GLU) { r -= I_D2 + I_GLU; const int gate = r / 12, h = (r / 2) % 6, nb = r & 1;
                tr_item(INP(gate ? 10 : 8) + ((size_t)l * 6 + h) * 64 * 64, 64, 0, nb * 32, nullptr, (bf16_t*)(ws + WS_WRG) + (((size_t)l * 2 + gate) * 6 + h) * 64 * 64, 64, nb * 32, 0, scr, lane); continue; }
            if (r >= I_D2) { r -= I_D2; const int kb = r / 8, nb = r % 8; tr_item(INP(21) + (size_t)l * CW * CW, CW, kb * 64, nb * 32, nullptr, (bf16_t*)(ws + WS_WGLU) + (size_t)l * CW * CW, CW, nb * 32, kb * 64, scr, lane); continue; }
            { const int ch = r / 256, cls = ch >> 1, half = ch & 1, q = r % 256, kb = q / 32, nb = q % 32; const int g = cls / 6, pi = cls % 6, e = g * 4 + (half ? pair_hi(pi) : pair_lo(pi));
                tr_item8(INP(32) + ((size_t)l * NE + e) * DE * D, D, kb * 64, nb * 32, (unsigned char*)WD2 + ((size_t)l * NCLS + cls) * 1024 * 1024, 1024, nb * 32, half * 512 + kb * 64, scr, lane); }
        }
        { const float* s_are = INP(13); const float* s_aim = INP(14); const float* s_ldt = INP(15); const float* s_bre = INP(16); const float* s_bim = INP(17); const float* s_cre = INP(18); const float* s_cim = INP(19); const float* s_d = INP(20);
          for (size_t e = gt; e < (size_t)2 * CG * 36928; e += NGT) { const int l = (int)(e / (CG * 36928)), g = (int)((e / 36928) % CG), el = (int)(e % 36928);
              s5_table_elem(g, el, s_are + (size_t)l * CG * CS, s_aim + (size_t)l * CG * CS, s_ldt + (size_t)l * CG, s_bre + (size_t)l * CG * CS * CGD, s_bim + (size_t)l * CG * CS * CGD,
                            s_cre + (size_t)l * CG * CGD * CS, s_cim + (size_t)l * CG * CGD * CS, s_d + (size_t)l * CW, ws + WS_S5 + (size_t)l * S5_L_STRIDE); } }
        { const float* sw = INP(4); bf16_t* wsp = (bf16_t*)(ws + WS_WSP); for (size_t e = gt; e < (size_t)2 * 6 * 128 * 128; e += NGT) wsp[e] = f2bf(sw[e]); }
        { const float* fg = INP(25); const float* rgw = INP(26); const float* rew = INP(28); bf16_t* wrt = (bf16_t*)(ws + WS_WRT);
          for (size_t e = gt; e < (size_t)2 * 48 * D; e += NGT) { const int l = (int)(e / (48 * D)), n = (int)((e / D) % 48), k = (int)(e % D);
              int j = -1, lo = 0; if (n < 16) j = n; else if (n < 32) { j = n - 16; lo = 1; } else if (n < 36) j = 16 + (n - 32); else if (n < 40) { j = 16 + (n - 36); lo = 1; }
              float v = 0.f;
              if (j >= 0) { const float w = fg[(size_t)l * D + k] * (j < 4 ? rgw[((size_t)l * D + k) * 4 + j] : rew[(((size_t)l * 4 + ((j - 4) >> 2)) * D + k) * 4 + ((j - 4) & 3)]);
                  const float hi = bf2f(f2bf(w)); v = lo ? (w - hi) : w; }
              wrt[e] = f2bf(v); } }
        const float* xin = INP(0);
        for (int t = gw; t < T; t += NGW) {
            const f32x4* xr = (const f32x4*)(xin + (size_t)t * D) + lane; f32x4 v[4]; float s = 0.f;
#pragma unroll
            for (int j = 0; j < 4; ++j) { v[j] = xr[64 * j]; s += (v[j][0] * v[j][0] + v[j][1] * v[j][1]) + (v[j][2] * v[j][2] + v[j][3] * v[j][3]); }
            s = wave_sum(s);
            u32x2* o8 = (u32x2*)(HB + (size_t)t * D) + lane;
#pragma unroll
            for (int j = 0; j < 4; ++j) { u32x2 w; w.x = cvt_pk_bf16(v[j][0], v[j][1]); w.y = cvt_pk_bf16(v[j][2], v[j][3]); o8[64 * j] = w; }
            if (lane < 16) SSQ[(size_t)t * 16 + lane] = lane == 0 ? s : 0.f;
        }
    }
    xcd_barrier(bar);

    for (int l = 0; l < DEPTH; ++l) {
        { PHASE_IDS(); unsigned char* ws = WSB(); bf16_t* WIN = (bf16_t*)(ws + WS_WIN); bf16_t* HB = (bf16_t*)(ws + WS_HB); float* SSQ = (float*)(ws + WS_SSQ); bf16_t* Z = (bf16_t*)(ws + WS_Z);
          pg8::StaticOrder<T, INC> S; S.init(HB, WIN + (size_t)l * INC * D, G, bid);
          pg8::EpiZ E{Z, SSQ};
          pg8::gemm_phase<pg8::EpiZ, pg8::StaticOrder<T, INC>, true, true>(lds, wave_s, S, E); }
        xcd_barrier(bar);

        {
            PHASE_IDS(); unsigned char* ws = WSB(); const bf16_t* Z = (const bf16_t*)(ws + WS_Z);
            const float* conv_w = INP(6) + (size_t)l * 4 * BW; const float* conv_b = INP(7) + (size_t)l * BW; const float* rg_b = INP(9) + (size_t)l * BW;
            const float* ig_b = INP(11) + (size_t)l * BW; const float* lam = INP(12) + (size_t)l * BW;
            __syncthreads();
            { const bf16_t* WRG = (const bf16_t*)(ws + WS_WRG) + ((size_t)l * 2 + 0) * 6 * 4096; const bf16_t* WIG = (const bf16_t*)(ws + WS_WRG) + ((size_t)l * 2 + 1) * 6 * 4096;
              for (int pr = bid; pr < NU128 / 2; pr += G) { float cp = 0.f;
                  rglru_unit<1>(2 * pr, true, cp, tid, wave, lane, Z, nullptr, WRG, WIG, conv_w, conv_b, rg_b, ig_b, lam, nullptr, (float*)(ws + WS_SUMA), (float*)(ws + WS_SUMH), (float*)(ws + WS_SUMA2), (float*)(ws + WS_SUMH2), (bf16_t*)(ws + WS_HL), (bf16_t*)(ws + WS_PP), lds);
                  rglru_unit<1>(2 * pr + 1, false, cp, tid, wave, lane, Z, nullptr, WRG, WIG, conv_w, conv_b, rg_b, ig_b, lam, nullptr, (float*)(ws + WS_SUMA), (float*)(ws + WS_SUMH), (float*)(ws + WS_SUMA2), (float*)(ws + WS_SUMH2), (bf16_t*)(ws + WS_HL), (bf16_t*)(ws + WS_PP), lds); } }
            for (int pr = bid; pr < NU128 / 2; pr += G) { float k0r = 0.f, k0i = 0.f, k1r = 0.f, k1i = 0.f; const unsigned char* tab = ws + WS_S5 + (size_t)l * S5_L_STRIDE;
#pragma unroll 1
                for (int ui = 0; ui < 2; ++ui) { s5_group<1>(2 * pr + ui, 2 * wave, ui == 0, k0r, k0i, wave, lane, Z, (bf16_t*)(ws + WS_Y), tab, (float*)(ws + WS_SEND), (float*)(ws + WS_SEND2), (float*)(ws + WS_SE), lds);
                                                 s5_group<1>(2 * pr + ui, 2 * wave + 1, ui == 0, k1r, k1i, wave, lane, Z, (bf16_t*)(ws + WS_Y), tab, (float*)(ws + WS_SEND), (float*)(ws + WS_SEND2), (float*)(ws + WS_SE), lds); } }
            __syncthreads();
            { const bf16_t* WSP = (const bf16_t*)(ws + WS_WSP) + (size_t)l * 6 * 128 * 128; const float* a_sb = INP(5) + (size_t)l * 6 * 128; const float* vg = INP(3) + (size_t)l * AW; const float* mo_ga = INP(23) + (size_t)l * D;
              for (int u = bid; u < NU128; u += G) mixa_unit(u, tid, wave, lane, Z, (bf16_t*)(ws + WS_Y), WSP, a_sb, vg, mo_ga, lds); }
        }
        xcd_barrier(bar);

        {
            PHASE_IDS(); unsigned char* ws = WSB(); const bf16_t* Z = (const bf16_t*)(ws + WS_Z); bf16_t* Y = (bf16_t*)(ws + WS_Y);
            const float* a_v_norm_g = INP(3) + (size_t)l * AW; const float* a_sw = INP(4) + (size_t)l * 6 * 128 * 128; const float* a_sb = INP(5) + (size_t)l * 6 * 128;
        }

        { PHASE_IDS(); unsigned char* ws = WSB(); const bf16_t* Z = (const bf16_t*)(ws + WS_Z); bf16_t* Y = (bf16_t*)(ws + WS_Y);
          { const float* mo_gb = INP(23) + (size_t)l * D + AW;
            __syncthreads();
            for (int pr = bid; pr < NU128 / 2; pr += G) rglru_fix_pair(pr, tid, wave, lane, Z, Y, (const bf16_t*)(ws + WS_HL), (const bf16_t*)(ws + WS_PP), (const float*)(ws + WS_SUMA2), (const float*)(ws + WS_SUMH2), mo_gb, lds); }
          { const bf16_t* WGLU = (const bf16_t*)(ws + WS_WGLU) + (size_t)l * CW * CW; const float* glu_b = INP(22) + (size_t)l * CW; const float* mo_gc = INP(23) + (size_t)l * D + AW + BW;
            for (int pr = bid; pr < NU128 / 2; pr += G) { float k0r = 0.f, k0i = 0.f, k1r = 0.f, k1i = 0.f; const unsigned char* tab = ws + WS_S5 + (size_t)l * S5_L_STRIDE;
#pragma unroll 1
                for (int ui = 0; ui < 2; ++ui) { const int u = 2 * pr + ui; __syncthreads();
                    s5_group<2>(u, 2 * wave, ui == 0, k0r, k0i, wave, lane, Z, Y, tab, (float*)(ws + WS_SEND), (float*)(ws + WS_SEND2), (float*)(ws + WS_SE), lds);
                    s5_group<2>(u, 2 * wave + 1, ui == 0, k1r, k1i, wave, lane, Z, Y, tab, (float*)(ws + WS_SEND), (float*)(ws + WS_SEND2), (float*)(ws + WS_SE), lds);
                    __syncthreads(); s5_glu(u, wave, lane, WGLU, glu_b, mo_gc, Y, lds); } } } }
        xcd_barrier(bar);

        { PHASE_IDS(); unsigned char* ws = WSB(); bf16_t* WOUT = (bf16_t*)(ws + WS_WOUT); bf16_t* HB = (bf16_t*)(ws + WS_HB); float* SSQ = (float*)(ws + WS_SSQ); bf16_t* Y = (bf16_t*)(ws + WS_Y);
          pg8::StaticOrder<T, D> S; S.init(Y, WOUT + (size_t)l * D * D, G, bid);
          pg8::EpiRes<false> E{HB, SSQ, nullptr};
          pg8::gemm_phase<pg8::EpiRes<false>, pg8::StaticOrder<T, D>, true, true>(lds, wave_s, S, E); }
        xcd_barrier(bar);

        { PHASE_IDS(); unsigned char* ws = WSB(); const bf16_t* HB = (const bf16_t*)(ws + WS_HB); const float* SSQ = (const float*)(ws + WS_SSQ); int* CLS = (int*)(ws + WS_CLS); float* G2 = (float*)(ws + WS_G2); int* HIST = (int*)(ws + WS_HIST);
          const float* rgb = INP(27) + (size_t)l * 4; const float* reb = INP(29) + (size_t)l * 16;
        for (int u = bid; u < NU; u += G) {
            router_unit(u, wave, lane, HB, SSQ, (const bf16_t*)(ws + WS_WRT) + (size_t)l * 48 * D, rgb, reb, CLS, G2, lds, (LAS int*)(lds + LDSCTL_OFF) + LW_HIST);
            __syncthreads();
            if (tid < 32) { HIST[u * 32 + tid] = tid < NCLS ? LWI[LW_HIST + tid] : 0; LWI[LW_HIST + tid] = 0; }
            __syncthreads();
        } }
        xcd_barrier(bar);

        { PHASE_IDS(); unsigned char* ws = WSB(); const bf16_t* HB = (const bf16_t*)(ws + WS_HB); const float* SSQ = (const float*)(ws + WS_SSQ); const int* CLS = (const int*)(ws + WS_CLS); const float* G2 = (const float*)(ws + WS_G2); const int* HIST = (const int*)(ws + WS_HIST);
          int* CTOT = (int*)(ws + WS_CTOT); int* ROWTOK = (int*)(ws + WS_ROWTOK); float* ROWG = (float*)(ws + WS_ROWG); bf16_t* HBS = (bf16_t*)(ws + WS_HBS); const float* ffn_g = INP(25) + (size_t)l * D;
        for (int u = bid; u < NU; u += G) {
            { const int c = tid & 31, part = tid >> 5; int tot = 0, pre = 0;
_Pragma("unroll 16")
              for (int k = part * 16; k < part * 16 + 16; ++k) { const int v = HIST[k * 32 + c]; tot += v; pre += k < u ? v : 0; }
              ((volatile LAS int*)lds)[tid] = tot; ((volatile LAS int*)lds)[512 + tid] = pre; }
            __syncthreads();
            if (tid < NCLS) { int tot = 0, pre = 0;
_Pragma("unroll")
                for (int k = 0; k < 16; ++k) { tot += ((volatile LAS int*)lds)[k * 32 + tid]; pre += ((volatile LAS int*)lds)[512 + k * 32 + tid]; } LWI[LW_TOT + tid] = tot; LWI[LW_BASE + tid] = pre; }
            __syncthreads();
            if (tid == 0) { int ps = 0;
_Pragma("unroll 1")
                for (int c = 0; c < NCLS; ++c) { const int tot = LWI[LW_TOT + c]; LWI[LW_BASE + c] += ps; LWI[LW_TST + c] = ps; ps += ((tot + 255) >> 8) << 8; if (bid == 0) CTOT[c] = tot; } LWI[LW_TST + NCLS] = ps; }
            if (tid < UT) LWI[LW_CLS + tid] = CLS[u * UT + tid];
            __syncthreads();
            if (tid < UT) { const int cls = LWI[LW_CLS + tid]; int rank = 0;
_Pragma("unroll 1")
                for (int i = 0; i < tid; ++i) rank += LWI[LW_CLS + i] == cls ? 1 : 0;
                const int dest = LWI[LW_BASE + cls] + rank; LWI[LW_DEST + tid] = dest; const int t = u * UT + tid;
                ROWTOK[dest] = t; ROWG[(size_t)dest * 2 + 0] = G2[(size_t)t * 2 + 0]; ROWG[(size_t)dest * 2 + 1] = G2[(size_t)t * 2 + 1]; }
            __syncthreads();
            for (int i = 0; i < 32; ++i) { const int tl = wave * 32 + i, t = u * UT + tl, dest = LWI[LW_DEST + tl];
                float sq = lane < 16 ? SSQ[(size_t)t * 16 + lane] : 0.f; sq = wave_sum(sq); const float r = rsqrtf(sq * (1.0f / D) + EPS);
                { const float r4 = r * pg8::FS_H; u32x4 w;
#pragma unroll
                  for (int hh = 0; hh < 2; ++hh) { const int d0 = lane * 16 + hh * 8; const u32x4 o = *(const u32x4*)(HB + (size_t)t * D + d0);
                    const f32x4 g0 = *(const f32x4*)(ffn_g + d0), g1 = *(const f32x4*)(ffn_g + d0 + 4);
                    const unsigned lo = pk_fp8x4(__uint_as_float(o.x << 16) * r4 * g0[0], __uint_as_float(o.x & 0xffff0000u) * r4 * g0[1], __uint_as_float(o.y << 16) * r4 * g0[2], __uint_as_float(o.y & 0xffff0000u) * r4 * g0[3]);
                    const unsigned hi = pk_fp8x4(__uint_as_float(o.z << 16) * r4 * g1[0], __uint_as_float(o.z & 0xffff0000u) * r4 * g1[1], __uint_as_float(o.w << 16) * r4 * g1[2], __uint_as_float(o.w & 0xffff0000u) * r4 * g1[3]);
                    if (hh == 0) { w.x = lo; w.y = hi; } else { w.z = lo; w.w = hi; } }
                  *(u32x4*)((unsigned char*)HBS + (size_t)dest * D + lane * 16) = w; } }
            if (u == bid)
_Pragma("unroll 1")
            for (int c = bid; c < NCLS; c += G) { const int tot = LWI[LW_TOT + c], r0 = LWI[LW_TST + c] + tot, r1 = LWI[LW_TST + c + 1];
                unsigned zz = 0u; asm volatile("" : "+v"(zz));
                for (int r = r0 + wave; r < r1; r += 8) { if (lane == 0) { ROWTOK[r] = -1; ROWG[(size_t)r * 2] = __uint_as_float(zz); ROWG[(size_t)r * 2 + 1] = __uint_as_float(zz); }
                    *(u32x4*)((unsigned char*)HBS + (size_t)r * D + lane * 16) = (u32x4){zz, zz, zz, zz}; } }
            __syncthreads();
        } }
        xcd_barrier(bar);

        { PHASE_IDS(); unsigned char* ws = WSB(); const int* CTOT = (const int*)(ws + WS_CTOT); bf16_t* HBS = (bf16_t*)(ws + WS_HBS); bf16_t* WGU = (bf16_t*)(ws + WS_WGU); bf16_t* ACT = (bf16_t*)(ws + WS_ACT); const float* ROWG = (const float*)(ws + WS_ROWG);
        if (tid == 0) { int ps = 0;
_Pragma("unroll 1")
            for (int c = 0; c < NCLS; ++c) { LWI[LW_TST + c] = ps; ps += (CTOT[c] + 255) >> 8; } LWI[LW_TST + NCLS] = ps; }
        __syncthreads();
        if (tid < 32) { const int ntile = LWI[LW_TST + NCLS]; const long L = (long)tid * G + bid; int e = -1;
            if (L < (long)ntile * 8) { const int mt = (int)(L / 8), pn = (int)(L % 8); int cls = 0;
_Pragma("unroll 1")
                for (int k = 1; k < NCLS; ++k) cls += (LWI[LW_TST + k] <= mt) ? 1 : 0;
                e = (cls << 24) | (pn << 16) | mt; }
            LWI[LW_UTAB + tid] = e; e = -1;
            if (L < (long)ntile * 4) { const int mt = (int)(L / 4), pn = (int)(L % 4); int cls = 0;
_Pragma("unroll 1")
                for (int k = 1; k < NCLS; ++k) cls += (LWI[LW_TST + k] <= mt) ? 1 : 0;
                e = (cls << 24) | (pn << 16) | mt; }
            LWI[LW_DTAB + tid] = e; }
        __syncthreads();
        { pg8::MoeOrder<8, true, 1024> S{LWI + LW_UTAB, l, (const char*)HBS, (const char*)WGU};
          pg8::EpiUp E{(unsigned char*)ACT, ROWG};
          pg8::gemm_phase<pg8::EpiUp, pg8::MoeOrder<8, true, 1024>, true, true, 512, true>(lds, wave_s, S, E); } }
        xcd_barrier(bar);

        { PHASE_IDS(); unsigned char* ws = WSB(); bf16_t* ACT = (bf16_t*)(ws + WS_ACT); bf16_t* WD2 = (bf16_t*)(ws + WS_WD2); bf16_t* HB = (bf16_t*)(ws + WS_HB); float* SSQ = (float*)(ws + WS_SSQ); const int* ROWTOK = (const int*)(ws + WS_ROWTOK);
          pg8::MoeOrder<4, false, 1024> S{LWI + LW_DTAB, l, (const char*)ACT, (const char*)WD2};
          pg8::EpiRes<true> E{HB, SSQ, ROWTOK};
          pg8::gemm_phase<pg8::EpiRes<true>, pg8::MoeOrder<4, false, 1024>, true, true, 512, true>(lds, wave_s, S, E); }
        xcd_barrier(bar);
    }

    { PHASE_IDS(); unsigned char* ws = WSB(); const bf16_t* HB = (const bf16_t*)(ws + WS_HB); const float* SSQ = (const float*)(ws + WS_SSQ); const float* fg = INP(33); float* outp = a.out;
    for (int t = gw; t < T; t += NGW) {
        float sq = lane < 16 ? SSQ[(size_t)t * 16 + lane] : 0.f; sq = wave_sum(sq); const float r = rsqrtf(sq * (1.0f / D) + EPS);
#pragma unroll
        for (int hh = 0; hh < 2; ++hh) { const int d0 = hh * 512 + lane * 8; const u32x4 o = *(const u32x4*)(HB + (size_t)t * D + d0);
            const f32x4 g0 = *(const f32x4*)(fg + d0), g1 = *(const f32x4*)(fg + d0 + 4);
            f32x4 w0, w1; w0[0] = __uint_as_float(o.x << 16) * r * g0[0]; w0[1] = __uint_as_float(o.x & 0xffff0000u) * r * g0[1]; w0[2] = __uint_as_float(o.y << 16) * r * g0[2]; w0[3] = __uint_as_float(o.y & 0xffff0000u) * r * g0[3];
            w1[0] = __uint_as_float(o.z << 16) * r * g1[0]; w1[1] = __uint_as_float(o.z & 0xffff0000u) * r * g1[1]; w1[2] = __uint_as_float(o.w << 16) * r * g1[2]; w1[3] = __uint_as_float(o.w & 0xffff0000u) * r * g1[3];
            *(f32x4*)(outp + (size_t)t * D + d0) = w0; *(f32x4*)(outp + (size_t)t * D + d0 + 4) = w1; }
    } }
}

extern "C" void kernel_launch(void* const* d_in, const int* in_sizes, int n_in, void* d_out, int out_size, void* d_ws, size_t ws_size, hipStream_t stream) {
    static int grid = 0;
    if (grid == 0) {
        if (n_in != 34 || in_sizes[0] != T * D || out_size != T * D || ws_size < WS_END) { fprintf(stderr, "kernel_launch: unexpected shapes (n_in %d, ws %zu)\n", n_in, ws_size); grid = -1; return; }
        int dev = 0, cus = 0, per_cu = 0;
        if (hipGetDevice(&dev) != hipSuccess || hipDeviceGetAttribute(&cus, hipDeviceAttributeMultiprocessorCount, dev) != hipSuccess) { grid = -1; return; }
        if (hipFuncSetAttribute((const void*)mega_fwd, hipFuncAttributeMaxDynamicSharedMemorySize, LDS_BYTES) != hipSuccess) { fprintf(stderr, "kernel_launch: hipFuncSetAttribute failed\n"); grid = -1; return; }
        if (hipOccupancyMaxActiveBlocksPerMultiprocessor(&per_cu, (const void*)mega_fwd, 512, LDS_BYTES) != hipSuccess || per_cu < 1) { fprintf(stderr, "kernel_launch: occupancy query says %d\n", per_cu); }
        (void)hipGetLastError();
        grid = cus;
    }
    if (grid < 0) return;
    (void)hipMemsetAsync((char*)d_ws + WS_CTL, 0, CTL_ZERO_BYTES, stream);
    Args a{};
    for (int i = 0; i < 34; ++i) a.in[i] = (const float*)d_in[i];
    a.out = (float*)d_out; a.ws = (unsigned char*)d_ws;
    hipLaunchKernelGGL(mega_fwd, dim3(grid), dim3(512), LDS_BYTES, stream, a);
}
```

```cpp
#include <hip/hip_runtime.h>
#include <cstdio>
#include <cstdint>

#define LAS __attribute__((address_space(3)))
typedef unsigned short bf16_t;
typedef short bf16x8 __attribute__((ext_vector_type(8)));
typedef float f32x4 __attribute__((ext_vector_type(4)));
typedef float f32x2 __attribute__((ext_vector_type(2)));
typedef unsigned u32x4 __attribute__((ext_vector_type(4)));
typedef unsigned u32x2 __attribute__((ext_vector_type(2)));
typedef int i32x4 __attribute__((ext_vector_type(4)));
typedef int i32x8 __attribute__((ext_vector_type(8)));

constexpr int D = 1024, BATCH = 8, SEQ = 8192, T = BATCH * SEQ, DEPTH = 2;
constexpr int AW = 384, BW = 384, CW = 256, HD = 64, ABLK = 128, CHUNK = 64;
constexpr int INC = 1792;
constexpr int ZU = 0, ZV = 384, ZG = 768, ZX = 1152, ZC = 1536, ZGELU_END = 1152;
constexpr int CG = 16, CGD = 16, CS = 64;
constexpr int NE = 16, DE = 512, NCLS = 24;
constexpr float EPS = 1e-6f;
constexpr int UT = 256;
constexpr int NU = T / UT;
constexpr int MAXROWS = T + NCLS * 256;

constexpr size_t MiB = 1u << 20;
constexpr size_t WS_CTL = 0, CTL_ZERO_BYTES = 1 * MiB;
constexpr size_t WS_WIN = 2 * MiB;
constexpr size_t WS_WOUT = 10 * MiB;
constexpr size_t WS_WGLU = 14 * MiB;
constexpr size_t WS_WRG = 15 * MiB;
constexpr size_t WS_WSP = 15 * MiB + 256 * 1024;
constexpr size_t WS_WRT = 15 * MiB + 768 * 1024;
constexpr size_t WS_WGU = 16 * MiB;
constexpr size_t WS_WD8 = 48 * MiB;
constexpr size_t WS_WD2 = 80 * MiB;
constexpr size_t WS_SSQ = 176 * MiB;
constexpr size_t WS_RS = 180 * MiB;
constexpr size_t WS_CLS = WS_RS + 256 * 1024;
constexpr size_t WS_G2 = WS_CLS + 256 * 1024;
constexpr size_t WS_HIST = 181 * MiB;
constexpr size_t WS_CTOT = WS_HIST + 64 * 1024;
constexpr size_t WS_ROWTOK = WS_HIST + 256 * 1024;
constexpr size_t WS_ROWG = 182 * MiB;
constexpr size_t WS_SUMA = 183 * MiB;
constexpr size_t WS_SUMH = 191 * MiB;
constexpr size_t WS_S5 = 184 * MiB;
constexpr size_t WS_SEND = 187 * MiB;
constexpr size_t WS_HB = 192 * MiB;
constexpr size_t WS_Z = 320 * MiB;
constexpr size_t WS_HBS = WS_Z;
constexpr size_t WS_Y = 544 * MiB;
constexpr size_t WS_ACT = 672 * MiB;
constexpr size_t WS_HL = 672 * MiB;
constexpr size_t WS_PP = 736 * MiB;
constexpr size_t WS_SE = 800 * MiB;
constexpr size_t WS_AV = 672 * MiB;
constexpr size_t WS_BV = 768 * MiB;
constexpr size_t WS_SEND2 = 864 * MiB;
constexpr size_t WS_SUMA2 = 866 * MiB;
constexpr size_t WS_SUMH2 = 867 * MiB;
constexpr size_t WS_END = 868 * MiB;
constexpr int CW_BAR = 4096;

constexpr int RING_BYTES = 131072;
constexpr int LDSCTL_OFF = 143360;
constexpr int LDS_BYTES = 147456;
constexpr int LW_BAR = 8, LW_TST = 64, LW_HIST = 96, LW_TOT = 128, LW_BASE = 160, LW_CLS = 256  , LW_DEST = 512  , LW_UTAB = 768  , LW_DTAB = 800  ;

__device__ __forceinline__ float bf2f(bf16_t v) { return __uint_as_float(((unsigned)v) << 16); }
__device__ __forceinline__ unsigned cvt_pk_bf16(float lo, float hi) { unsigned r; asm volatile("v_cvt_pk_bf16_f32 %0, %1, %2" : "=v"(r) : "v"(lo), "v"(hi)); return r; }
__device__ __forceinline__ bf16_t f2bf(float v) { return (bf16_t)(cvt_pk_bf16(v, 0.f) & 0xffffu); }
__device__ __forceinline__ unsigned pk_fp8x4(float a, float b, float c, float d) {
    a = fminf(fmaxf(a, -448.f), 448.f); b = fminf(fmaxf(b, -448.f), 448.f); c = fminf(fmaxf(c, -448.f), 448.f); d = fminf(fmaxf(d, -448.f), 448.f);
    int r = __builtin_amdgcn_cvt_pk_fp8_f32(a, b, 0, false); r = __builtin_amdgcn_cvt_pk_fp8_f32(c, d, r, true); return (unsigned)r; }
__device__ __forceinline__ int fresh_lane() { unsigned z = 0u; asm volatile("" : "+s"(z)); return (int)__builtin_amdgcn_mbcnt_hi(~0u, __builtin_amdgcn_mbcnt_lo(~0u, z)); }
__device__ __forceinline__ float x_xor1(float v) { return __int_as_float(__builtin_amdgcn_update_dpp(0, __float_as_int(v), 0xB1, 0xf, 0xf, true)); }
__device__ __forceinline__ float x_xor2(float v) { return __int_as_float(__builtin_amdgcn_update_dpp(0, __float_as_int(v), 0x4E, 0xf, 0xf, true)); }
__device__ __forceinline__ float x_hmir(float v) { return __int_as_float(__builtin_amdgcn_update_dpp(0, __float_as_int(v), 0x141, 0xf, 0xf, true)); }
__device__ __forceinline__ float x_mir(float v) { return __int_as_float(__builtin_amdgcn_update_dpp(0, __float_as_int(v), 0x140, 0xf, 0xf, true)); }
__device__ __forceinline__ float x_xor16(float v) { return __int_as_float(__builtin_amdgcn_ds_swizzle(__float_as_int(v), 0x401F)); }
__device__ __forceinline__ float add_xor32(float v) { const auto r = __builtin_amdgcn_permlane32_swap(__float_as_uint(v), __float_as_uint(v), false, false); return __uint_as_float(r[0]) + __uint_as_float(r[1]); }
__device__ __forceinline__ float add_x16_x32(float v) { v += x_xor16(v); return add_xor32(v); }
__device__ __forceinline__ float wave_sum(float v) { v += x_xor1(v); v += x_xor2(v); v += x_hmir(v); v += x_mir(v); v += x_xor16(v); return add_xor32(v); }
__device__ __forceinline__ float gelu_fast(float x) {
    const float u2 = 1.5957691216057308f * (x + 0.044715f * x * x * x);
    const float e = __builtin_amdgcn_exp2f(-1.4426950408889634f * u2);
    return x * __builtin_amdgcn_rcpf(1.0f + e);
}
__device__ __forceinline__ float sigmoid_fast(float x) { return __builtin_amdgcn_rcpf(1.0f + __builtin_amdgcn_exp2f(-1.4426950408889634f * x)); }
__device__ __forceinline__ float sigmoid_f(float x) { return 1.0f / (1.0f + expf(-x)); }
__device__ __forceinline__ int pair_lo(int pi) { return pi < 3 ? 0 : (pi < 5 ? 1 : 2); }
__device__ __forceinline__ int pair_hi(int pi) { return pi < 3 ? pi + 1 : (pi < 5 ? pi - 1 : 3); }
__device__ __forceinline__ int pair_idx(int lo, int hi) { return lo == 0 ? hi - 1 : (lo == 1 ? hi + 1 : 5); }

#define XB_TMO      128
#define XB_XCNT(j)  (256  + 64 * (j))
#define XB_XSUB(j)  (1280 + 64 * (j))
#define XB_XGEN(j)  (2304 + 64 * (j))
#define XB_TOP      3328
#define XB_TOPGEN   3392
#define XCD_BAR_WORDS 3456
#define XB_SPIN_CAP (1u << 18)
__device__ __forceinline__ unsigned xb_ld(unsigned* p)              { return __hip_atomic_load(p, __ATOMIC_RELAXED, __HIP_MEMORY_SCOPE_AGENT); }
__device__ __forceinline__ unsigned xb_add(unsigned* p, unsigned v) { return __hip_atomic_fetch_add(p, v, __ATOMIC_RELAXED, __HIP_MEMORY_SCOPE_AGENT); }
__device__ __forceinline__ unsigned xb_xcc_id() { return (unsigned)__builtin_amdgcn_s_getreg((3 << 11) | 20) & 0xFu; }
#define XB_SPIN(cond, bar) do { unsigned _sp = 0; while (cond) { __builtin_amdgcn_s_sleep(1); \
    if ((++_sp & 255u) == 0u) { if (xb_ld(&(bar)[XB_TMO])) break; if (_sp > XB_SPIN_CAP) { atomicAdd(&(bar)[XB_TMO], 1u); break; } } } } while (0)
struct XcdBarrier { unsigned* bar; unsigned x; volatile LAS unsigned* st; };
__device__ __forceinline__ XcdBarrier xcd_barrier_post(unsigned* bar, volatile LAS unsigned* st) {
    XcdBarrier b; b.bar = bar; b.x = xb_xcc_id(); b.st = st;
    if (threadIdx.x == 0) (void)xb_add(&bar[XB_XCNT(b.x)], 1u);
    return b;
}
__device__ __forceinline__ void xcd_barrier_complete(unsigned* bar, unsigned x, unsigned& nloc, unsigned& nx) {
    const unsigned G = gridDim.x * gridDim.y * gridDim.z;
    unsigned sum, cnt, mine, sp = 0u;
    for (;;) {
        sum = 0u; cnt = 0u; mine = 0u;
#pragma unroll
        for (unsigned j = 0; j < 16; ++j) { const unsigned c = xb_ld(&bar[XB_XCNT(j)]); sum += c; cnt += (c > 0u) ? 1u : 0u; mine = (j == x) ? c : mine; }
        if (sum == G) break;
        __builtin_amdgcn_s_sleep(1);
        if ((++sp & 255u) == 0u) { if (xb_ld(&bar[XB_TMO])) break; if (sp > XB_SPIN_CAP) { atomicAdd(&bar[XB_TMO], 1u); break; } }
    }
    nloc = mine > 0u ? mine : 1u; nx = cnt > 0u ? cnt : 1u;
}
__device__ __forceinline__ void xcd_barrier(const XcdBarrier& b) {
    asm volatile("s_waitcnt vmcnt(0)" ::: "memory");
    __syncthreads();
    if (threadIdx.x == 0) {
        unsigned* bar = b.bar; asm volatile("" : "+s"(bar));
        __builtin_amdgcn_s_waitcnt(0);
        unsigned bx0 = b.x; asm volatile("" : "+s"(bx0));
        unsigned nloc = b.st[0], nx = b.st[1];
        if (nloc == 0u) { xcd_barrier_complete(bar, bx0, nloc, nx); b.st[0] = nloc; b.st[1] = nx; }
        unsigned bx = b.x; asm volatile("" : "+s"(bx));
        const unsigned old = xb_add(&bar[XB_XSUB(bx)], 1u);
        const unsigned gen = old / nloc;
        if (old + 1u == (gen + 1u) * nloc) {
            __builtin_amdgcn_fence(__ATOMIC_RELEASE, "agent");
            asm volatile("s_waitcnt vmcnt(0)" ::: "memory");
            const unsigned og = xb_add(&bar[XB_TOP], 1u);
            const unsigned tg = og / nx;
            if (og + 1u == (tg + 1u) * nx) xb_add(&bar[XB_TOPGEN], 1u);
            else XB_SPIN(xb_ld(&bar[XB_TOPGEN]) == tg, bar);
            __builtin_amdgcn_fence(__ATOMIC_ACQUIRE, "agent");
            xb_add(&bar[XB_XGEN(bx)], 1u);
            asm volatile("s_waitcnt vmcnt(0)" ::: "memory");
        } else {
            XB_SPIN(xb_ld(&bar[XB_XGEN(bx)]) == gen, bar);
            __builtin_amdgcn_fence(__ATOMIC_ACQUIRE, "agent");
            asm volatile("s_waitcnt vmcnt(0)" ::: "memory");
        }
    }
    __syncthreads();
}

namespace pg8 {
#define PG8_LAS __attribute__((address_space(3)))
constexpr int BM = 256, BK = 64, HALF = 128, HTB = HALF * BK * 2, STAGE_BYTES = 8 * HTB, NXCD = 8, WGM = 8;
__host__ __device__ __forceinline__ int lds_byte(int r, int c) { const int st = (r >> 4) * 2 + (c >> 5), rr = r & 15, cc = c & 31, ob = rr * 64 + cc * 2; return st * 1024 + (ob ^ (((ob >> 9) & 1) << 5)); }
__host__ __device__ __forceinline__ void stage_rc(int b, int& R, int& C) { const int st = b / 1024, sb = b % 1024, swz = sb ^ (((sb >> 9) & 1) << 5); R = (st >> 1) * 16 + swz / 64; C = (st & 1) * 32 + (swz % 64) / 2; }
__host__ __device__ __forceinline__ int perm32(int rho) { const int n = rho >> 4, i = rho & 15; return 8 * (i >> 2) + 4 * n + (i & 3); }
struct Unit { int pm, pn; const char* A; const char* B; };

template <int M_, int N_> struct StaticOrder {
    static constexpr int nM = M_ / BM, nN = N_ / BM, nwg = nM * nN; static constexpr size_t tstep = (size_t)BM * 1024 * 2;
    int G, c; const char* A; const char* Bt;
    __device__ void init(const void* A_, const void* Bt_, int G_, int c_) { G = G_; c = c_; A = (const char*)A_; Bt = (const char*)Bt_; }
    __device__ bool next(int i, Unit& u) const {
        const long L = (long)i * G + c; if (L >= nwg) return false;
        int wgid = (int)L; { constexpr int q = nwg / NXCD, r = nwg % NXCD; const int xcd = wgid % NXCD, off = wgid / NXCD; wgid = (xcd < r ? xcd * (q + 1) : r * (q + 1) + (xcd - r) * q) + off; }
        constexpr int nig = WGM * nN; const int gid = wgid / nig, fm = gid * WGM, gsz = (nM - fm) < WGM ? (nM - fm) : WGM;
        u.pm = fm + ((wgid % nig) % gsz); u.pn = (wgid % nig) / gsz; u.A = A + (size_t)u.pm * tstep; u.B = Bt + (size_t)u.pn * tstep; return true;
    }
    __device__ __forceinline__ void a_ready(const Unit&) const {}
    __device__ __forceinline__ void done(const Unit&) const {}
};
template <class Epi, class Sched, bool ALIGN_EPI = false, bool SP2 = false, int KB = 1024, bool FP8 = false>
__device__ __forceinline__ void gemm_phase(PG8_LAS unsigned char* lds, const int wave_s, const Sched& S, const Epi& E) { const int Kdim = 0;
    const int lane = fresh_lane(), wid = wave_s, tid = wid * 64 + lane, wr = wid >> 2, wc = wid & 3, fr = lane & 15, fq = lane >> 4;
    constexpr int K = KB, nt = K / BK; (void)Kdim;
    unsigned voffA, voffB;
    { int R, C; stage_rc(tid * 16, R, C); const int Rb = Epi::PERM ? ((R & ~31) + perm32(R & 31)) : R; voffA = (unsigned)(R * K + C) * 2u; voffB = (unsigned)(Rb * K + C) * 2u; }
    constexpr size_t kstep = (size_t)(BK * 2);
    constexpr size_t hstep = (size_t)HALF * K * 2;
    constexpr size_t tstep = 2 * hstep; (void)tstep;
    const unsigned ldsw = (unsigned)wid * 1024u; const unsigned ldsb = (unsigned)(size_t)lds + ldsw;
    const int aoff = lds_byte(wr * 64 + fr, fq * 8), boff = lds_byte(wc * 32 + fr, fq * 8);
#define PG8_SA(b, h) (((b) * 2 + (h)) * HTB)
#define PG8_SB(b, h) ((4 + (b) * 2 + (h)) * HTB)
#define PG8_STAGE(bufoff, gbase, voff) do { _Pragma("unroll") for (int _i = 0; _i < 2; ++_i) { unsigned _keep; \
        asm volatile("s_mov_b32 %0, m0\n\ts_mov_b32 m0, %3\n\ts_nop 0\n\tglobal_load_lds_dwordx4 %1, %2\n\ts_mov_b32 m0, %0" : "=&s"(_keep) \
            : "v"(voff), "s"((const char*)(gbase) + (size_t)_i * (64 * K * 2)), "s"(ldsb + (unsigned)((bufoff) + _i * 8192)) : "memory"); } } while (0)
#define PG8_LDA(dst, b, h) do { if constexpr (FP8) { _Pragma("unroll") for (int m = 0; m < 4; ++m) { const i32x4 _lo = *(const PG8_LAS i32x4*)(lds + PG8_SA(b, h) + aoff + m * 2048), _hi = *(const PG8_LAS i32x4*)(lds + PG8_SA(b, h) + aoff + m * 2048 + 1024); \
            dst##8[m] = __builtin_shufflevector(_lo, _hi, 0, 1, 2, 3, 4, 5, 6, 7); } } \
        else { _Pragma("unroll") for (int m = 0; m < 4; ++m) _Pragma("unroll") for (int k = 0; k < 2; ++k) dst[m][k] = *(const PG8_LAS bf16x8*)(lds + PG8_SA(b, h) + aoff + m * 2048 + k * 1024); } } while (0)
#define PG8_LDB(dst, b, h) do { if constexpr (FP8) { _Pragma("unroll") for (int n = 0; n < 2; ++n) { const i32x4 _lo = *(const PG8_LAS i32x4*)(lds + PG8_SB(b, h) + boff + n * 2048), _hi = *(const PG8_LAS i32x4*)(lds + PG8_SB(b, h) + boff + n * 2048 + 1024); \
            dst##8[n] = __builtin_shufflevector(_lo, _hi, 0, 1, 2, 3, 4, 5, 6, 7); } } \
        else { _Pragma("unroll") for (int n = 0; n < 2; ++n) _Pragma("unroll") for (int k = 0; k < 2; ++k) dst[n][k] = *(const PG8_LAS bf16x8*)(lds + PG8_SB(b, h) + boff + n * 2048 + k * 1024); } } while (0)
#define PG8_MMA(ai, bj, At, Bt) do { __builtin_amdgcn_s_setprio(1); \
        if constexpr (FP8) { _Pragma("unroll") for (int m = 0; m < 4; ++m) _Pragma("unroll") for (int n = 0; n < 2; ++n) \
            acc[ai][bj][m][n] = __builtin_amdgcn_mfma_scale_f32_16x16x128_f8f6f4(Bt##8[n], At##8[m], acc[ai][bj][m][n], 0, 0, 0, Epi::SCALE_W, 0, Epi::SCALE_A); } \
        else { _Pragma("unroll") for (int m = 0; m < 4; ++m) _Pragma("unroll") for (int n = 0; n < 2; ++n) _Pragma("unroll") for (int k = 0; k < 2; ++k) \
            acc[ai][bj][m][n] = __builtin_amdgcn_mfma_f32_16x16x32_bf16(Bt[n][k], At[m][k], acc[ai][bj][m][n], 0, 0, 0); } \
        __builtin_amdgcn_s_setprio(0); } while (0)
#define PG8_WAIT_V(n) asm volatile("s_waitcnt vmcnt(" #n ")" ::: "memory")
#define PG8_WAIT_L(n) asm volatile("s_waitcnt lgkmcnt(" #n ")" ::: "memory")
#define PG8_BAR __builtin_amdgcn_s_barrier()
#define PG8_SCHED __builtin_amdgcn_sched_barrier(0)
    Unit cur, nxt; int ui = 0;
    if (!S.next(0, cur)) return;
    f32x4 acc[2][2][4][2];
#pragma unroll
    for (int a = 0; a < 2; ++a)
#pragma unroll
        for (int b = 0; b < 2; ++b)
#pragma unroll
            for (int m = 0; m < 4; ++m)
#pragma unroll
                for (int n = 0; n < 2; ++n) acc[a][b][m][n] = (f32x4){0.f, 0.f, 0.f, 0.f};
    bf16x8 At[4][2], B0[2][2], B1[2][2]; i32x8 At8[4], B08[2], B18[2]; (void)At; (void)B0; (void)B1; (void)At8; (void)B08; (void)B18;
    const char* cA = cur.A; const char* cB = cur.B;
    S.a_ready(cur);
    if constexpr (SP2) {
        PG8_STAGE(PG8_SB(0, 0), cB, voffB); PG8_STAGE(PG8_SB(0, 1), cB + hstep, voffB); PG8_STAGE(PG8_SA(0, 0), cA, voffA); PG8_STAGE(PG8_SA(0, 1), cA + hstep, voffA);
        if (wr == 1) PG8_BAR;
        PG8_WAIT_V(2); PG8_BAR;
        PG8_STAGE(PG8_SB(1, 0), cB + kstep, voffB); PG8_STAGE(PG8_SA(1, 0), cA + kstep, voffA); PG8_STAGE(PG8_SB(1, 1), cB + hstep + kstep, voffB);
        PG8_WAIT_V(6); PG8_BAR;
    } else {
        PG8_STAGE(PG8_SB(0, 0), cB, voffB); PG8_STAGE(PG8_SA(0, 0), cA, voffA); PG8_STAGE(PG8_SB(0, 1), cB + hstep, voffB); PG8_STAGE(PG8_SA(0, 1), cA + hstep, voffA);
        if (wr == 1) PG8_BAR;
        PG8_WAIT_V(4); PG8_BAR;
        PG8_STAGE(PG8_SB(1, 0), cB + kstep, voffB); PG8_STAGE(PG8_SA(1, 0), cA + kstep, voffA); PG8_STAGE(PG8_SB(1, 1), cB + hstep + kstep, voffB);
        PG8_WAIT_V(6); PG8_BAR;
    }
    for (;;) {
        const bool has_next = S.next(ui + 1, nxt);
        const char* nA = has_next ? nxt.A : cA; const char* nB = has_next ? nxt.B : cB;
_Pragma("unroll 1")
        for (int t = 0; t < nt; t += 2) {
            const bool last = (t == nt - 2);
            const char* a1 = cA + (size_t)(t + 1) * kstep;
            const char* a2 = last ? nA : cA + (size_t)(t + 2) * kstep; const char* b2 = last ? nB : cB + (size_t)(t + 2) * kstep;
            const char* a3 = a2 + kstep; const char* b3 = b2 + kstep;
            if (last && has_next) S.a_ready(nxt);
            if constexpr (SP2) {
            PG8_LDB(B0, 0, 0); PG8_LDB(B1, 0, 1); PG8_SCHED; PG8_LDA(At, 0, 0); PG8_STAGE(PG8_SA(1, 1), a1 + hstep, voffA);
            PG8_WAIT_V(8); PG8_WAIT_L(0); PG8_BAR; PG8_MMA(0, 0, At, B0); PG8_MMA(0, 1, At, B1); PG8_BAR; PG8_SCHED;
            PG8_LDA(At, 0, 1); PG8_STAGE(PG8_SB(0, 0), b2, voffB); PG8_STAGE(PG8_SB(0, 1), b2 + hstep, voffB); PG8_STAGE(PG8_SA(0, 0), a2, voffA);
            PG8_WAIT_V(8); PG8_WAIT_L(0); PG8_BAR; PG8_MMA(1, 0, At, B0); PG8_MMA(1, 1, At, B1); PG8_BAR; PG8_SCHED;
            PG8_LDB(B0, 1, 0); PG8_LDB(B1, 1, 1); PG8_SCHED; PG8_LDA(At, 1, 0); PG8_STAGE(PG8_SA(0, 1), a2 + hstep, voffA);
            PG8_WAIT_V(8); PG8_WAIT_L(0); PG8_BAR; PG8_MMA(0, 0, At, B0); PG8_MMA(0, 1, At, B1); PG8_BAR; PG8_SCHED;
            PG8_LDA(At, 1, 1); PG8_STAGE(PG8_SB(1, 0), b3, voffB); PG8_STAGE(PG8_SB(1, 1), b3 + hstep, voffB); PG8_STAGE(PG8_SA(1, 0), a3, voffA);
            PG8_WAIT_V(8); PG8_WAIT_L(0); PG8_BAR; PG8_MMA(1, 0, At, B0); PG8_MMA(1, 1, At, B1); PG8_BAR; PG8_SCHED;
            } else {
            PG8_LDB(B0, 0, 0); PG8_SCHED; PG8_LDA(At, 0, 0); PG8_STAGE(PG8_SA(1, 1), a1 + hstep, voffA);
            PG8_WAIT_L(8); PG8_BAR; PG8_WAIT_L(0); PG8_MMA(0, 0, At, B0); PG8_BAR; PG8_SCHED;
            PG8_LDB(B1, 0, 1); PG8_STAGE(PG8_SB(0, 0), b2, voffB);
            PG8_BAR; PG8_WAIT_L(0); PG8_MMA(0, 1, At, B1); PG8_BAR;
            PG8_LDA(At, 0, 1); PG8_STAGE(PG8_SA(0, 0), a2, voffA);
            PG8_BAR; PG8_WAIT_L(0); PG8_MMA(1, 0, At, B0); PG8_BAR; PG8_SCHED;
            PG8_STAGE(PG8_SB(0, 1), b2 + hstep, voffB);
            PG8_WAIT_V(6); PG8_BAR; PG8_MMA(1, 1, At, B1); PG8_BAR;
            PG8_LDB(B0, 1, 0); PG8_SCHED; PG8_LDA(At, 1, 0); PG8_STAGE(PG8_SA(0, 1), a2 + hstep, voffA);
            PG8_WAIT_L(8); PG8_BAR; PG8_WAIT_L(0); PG8_MMA(0, 0, At, B0); PG8_BAR; PG8_SCHED;
            PG8_LDB(B1, 1, 1); PG8_STAGE(PG8_SB(1, 0), b3, voffB);
            PG8_BAR; PG8_WAIT_L(0); PG8_MMA(0, 1, At, B1); PG8_BAR;
            PG8_LDA(At, 1, 1); PG8_STAGE(PG8_SA(1, 0), a3, voffA);
            PG8_BAR; PG8_WAIT_L(0); PG8_MMA(1, 0, At, B0); PG8_BAR; PG8_SCHED;
            PG8_STAGE(PG8_SB(1, 1), b3 + hstep, voffB);
            PG8_WAIT_V(6); PG8_BAR; PG8_MMA(1, 1, At, B1); PG8_BAR;
            }
        }
        if constexpr (ALIGN_EPI) { if (wr == 0) PG8_BAR; }
        if constexpr (!Epi::AFTER_DRAIN) { E(acc, cur, wr, wc, fr, fq); S.done(cur); }
        if (!has_next) break;
#pragma unroll
        for (int a = 0; a < 2; ++a)
#pragma unroll
            for (int b = 0; b < 2; ++b)
#pragma unroll
                for (int m = 0; m < 4; ++m)
#pragma unroll
                    for (int n = 0; n < 2; ++n) acc[a][b][m][n] = (f32x4){0.f, 0.f, 0.f, 0.f};
        cur = nxt; cA = nA; cB = nB; ++ui;
        if constexpr (ALIGN_EPI) { if (wr == 1) PG8_BAR; }
    }
    PG8_WAIT_V(0);
    if constexpr (!ALIGN_EPI) { if (wr == 0) PG8_BAR; }
    PG8_BAR;
    if constexpr (Epi::AFTER_DRAIN) { E.fused(acc, cur, wr, wc, fr, fq, lds, wid, lane); S.done(cur); }
#undef PG8_SA
#undef PG8_SB
#undef PG8_STAGE
#undef PG8_LDA
#undef PG8_LDB
#undef PG8_MMA
#undef PG8_WAIT_V
#undef PG8_WAIT_L
#undef PG8_BAR
#undef PG8_SCHED
}

template <int NP, bool UP, int ROWB> struct MoeOrder {
    const volatile LAS int* tab; int layer; const char* A; const char* W;
    __device__ bool next(int i, Unit& u) const {
        const int e = tab[i]; if (e < 0) return false;
        const int mt = e & 0xffff, pn = (e >> 16) & 0xff, cls = e >> 24;
        u.pm = mt; u.pn = pn; u.A = A + (size_t)mt * ((size_t)BM * ROWB);
        if (UP) { const int g = cls / 6, pi = cls % 6, s = pn >> 2, ex = g * 4 + (s ? pair_hi(pi) : pair_lo(pi));
            u.B = W + ((size_t)(layer * NE + ex) * 1024 + (size_t)(pn & 3) * 256) * ROWB; }
        else u.B = W + ((size_t)(layer * NCLS + cls) * 1024 + (size_t)pn * 256) * ROWB;
        return true;
    }
    __device__ __forceinline__ void a_ready(const Unit&) const {}
    __device__ __forceinline__ void done(const Unit&) const {}
};

struct EpiZ {
    static constexpr bool PERM = true, AFTER_DRAIN = false;
    bf16_t* Z; const float* ssq;
    __device__ __forceinline__ void operator()(const f32x4 (&acc)[2][2][4][2], const Unit& u, int wr, int wc, int fr, int fq) const {
        { const int ln_ = fresh_lane(); fr = ln_ & 15; fq = ln_ >> 4; }
        const int row0 = u.pm * BM + wr * 64 + fr, col0 = u.pn * BM + wc * 32 + 8 * fq;
        float rr[2][4];
#pragma unroll
        for (int ai = 0; ai < 2; ++ai) {
            f32x4 sp[4];
#pragma unroll
            for (int m = 0; m < 4; ++m) sp[m] = *(const f32x4*)(ssq + (size_t)(row0 + ai * HALF + m * 16) * 16 + 4 * fq);
#pragma unroll
            for (int m = 0; m < 4; ++m) { float t = (sp[m][0] + sp[m][1]) + (sp[m][2] + sp[m][3]); t = add_x16_x32(t); rr[ai][m] = __builtin_amdgcn_rsqf(t * (1.0f / D) + EPS); }
        }
#pragma unroll
        for (int ai = 0; ai < 2; ++ai)
#pragma unroll
            for (int m = 0; m < 4; ++m) { const int row = row0 + ai * HALF + m * 16; const float r = rr[ai][m];
                bf16_t* rowp = Z + (size_t)row * INC + col0;
#pragma unroll
                for (int bj = 0; bj < 2; ++bj) { f32x4 v0 = acc[ai][bj][m][0] * r, v1 = acc[ai][bj][m][1] * r;
                    u32x4 w; w.x = cvt_pk_bf16(v0[0], v0[1]); w.y = cvt_pk_bf16(v0[2], v0[3]); w.z = cvt_pk_bf16(v1[0], v1[1]); w.w = cvt_pk_bf16(v1[2], v1[3]);
                    *(u32x4*)(rowp + bj * HALF) = w; } }
    }
};
template <bool SCATTER> struct EpiRes {
    static constexpr bool PERM = true, AFTER_DRAIN = false; static constexpr int SCALE_W = 0x7b7b7b7b, SCALE_A = 0x7b7b7b7b;
    bf16_t* H; float* ssq; const int* rowtok;
    __device__ __forceinline__ void operator()(const f32x4 (&acc)[2][2][4][2], const Unit& u, int wr, int wc, int fr, int fq) const {
        { const int ln_ = fresh_lane(); fr = ln_ & 15; fq = ln_ >> 4; }
        const int row0 = u.pm * BM + wr * 64 + fr, col0 = u.pn * BM + wc * 32 + 8 * fq;
        int tokv[2][4];
#pragma unroll
        for (int ai = 0; ai < 2; ++ai)
#pragma unroll
            for (int m = 0; m < 4; ++m) { const int row = row0 + ai * HALF + m * 16; tokv[ai][m] = SCATTER ? rowtok[row] : row; }
#pragma unroll
        for (int ai = 0; ai < 2; ++ai) {
            u32x4 o[4][2];
#pragma unroll
            for (int m = 0; m < 4; ++m) { const int tok = tokv[ai][m]; const bf16_t* rowp = H + (size_t)(tok < 0 ? 0 : tok) * D + col0; o[m][0] = *(const u32x4*)(rowp); o[m][1] = *(const u32x4*)(rowp + HALF); }
#pragma unroll
            for (int m = 0; m < 4; ++m) { const int tok = tokv[ai][m]; float s = 0.f; bf16_t* rowp = H + (size_t)(tok < 0 ? 0 : tok) * D + col0;
#pragma unroll
                for (int bj = 0; bj < 2; ++bj) { const u32x4 oo = o[m][bj];
                    f32x4 v0 = acc[ai][bj][m][0], v1 = acc[ai][bj][m][1];
                    v0[0] += __uint_as_float(oo.x << 16); v0[1] += __uint_as_float(oo.x & 0xffff0000u); v0[2] += __uint_as_float(oo.y << 16); v0[3] += __uint_as_float(oo.y & 0xffff0000u);
                    v1[0] += __uint_as_float(oo.z << 16); v1[1] += __uint_as_float(oo.z & 0xffff0000u); v1[2] += __uint_as_float(oo.w << 16); v1[3] += __uint_as_float(oo.w & 0xffff0000u);
                    s += (v0[0] * v0[0] + v0[1] * v0[1]) + (v0[2] * v0[2] + v0[3] * v0[3]) + (v1[0] * v1[0] + v1[1] * v1[1]) + (v1[2] * v1[2] + v1[3] * v1[3]);
                    u32x4 w; w.x = cvt_pk_bf16(v0[0], v0[1]); w.y = cvt_pk_bf16(v0[2], v0[3]); w.z = cvt_pk_bf16(v1[0], v1[1]); w.w = cvt_pk_bf16(v1[2], v1[3]);
                    if (tok >= 0) *(u32x4*)(rowp + bj * HALF) = w; }
                s = add_x16_x32(s);
                if (fq == 0 && tok >= 0) ssq[(size_t)tok * 16 + u.pn * 4 + wc] = s; }
            asm volatile("" ::: "memory"); }
    }
};
constexpr int SC_W = 0x7b7b7b7b, SC_H = 0x7b7b7b7b, SC_ACT = 0x7b7b7b7b;
constexpr float FS_W = 16.f, FS_H = 16.f, FS_ACT = 16.f;
struct EpiUp {
    static constexpr bool PERM = true, AFTER_DRAIN = false; static constexpr int SCALE_W = SC_W, SCALE_A = SC_H;
    unsigned char* ACT; const float* rowg;
    __device__ __forceinline__ void operator()(const f32x4 (&acc)[2][2][4][2], const Unit& u, int wr, int wc, int fr, int fq) const {
        { const int ln_ = fresh_lane(); fr = ln_ & 15; fq = ln_ >> 4; }
        const int row0 = u.pm * BM + wr * 64 + fr, s = u.pn >> 2, col0 = s * 512 + (u.pn & 3) * 128 + wc * 32 + 8 * fq;
        float gt[2][4];
#pragma unroll
        for (int ai = 0; ai < 2; ++ai)
#pragma unroll
            for (int m = 0; m < 4; ++m) gt[ai][m] = rowg[(size_t)(row0 + ai * HALF + m * 16) * 2 + s];
#pragma unroll
        for (int ai = 0; ai < 2; ++ai)
#pragma unroll
            for (int m = 0; m < 4; ++m) { const int row = row0 + ai * HALF + m * 16; const float g1 = gt[ai][m];
                float o[8];
#pragma unroll
                for (int n = 0; n < 2; ++n)
#pragma unroll
                    for (int j = 0; j < 4; ++j) { const float g = acc[ai][0][m][n][j], up = acc[ai][1][m][n][j]; o[n * 4 + j] = g * sigmoid_fast(g) * up * g1; }
                u32x2 w; w.x = pk_fp8x4(o[0] * FS_ACT, o[1] * FS_ACT, o[2] * FS_ACT, o[3] * FS_ACT); w.y = pk_fp8x4(o[4] * FS_ACT, o[5] * FS_ACT, o[6] * FS_ACT, o[7] * FS_ACT);
                *(u32x2*)(ACT + (size_t)row * 1024 + col0) = w; }
    }
};
}

__device__ __forceinline__ void tr_item(const float* W, int ldw, int k0, int scol0, const float* gk, bf16_t* WT, int ldo, int drow0, int dk0, LAS float* scr, int lane) {
#pragma unroll 8
    for (int i = 0; i < 32; ++i) { const int kk = 2 * i + (lane >> 5); float v = W[(size_t)(k0 + kk) * ldw + scol0 + (lane & 31)]; if (gk) v *= gk[k0 + kk]; scr[kk * 33 + (lane & 31)] = v; }
    asm volatile("s_waitcnt lgkmcnt(0)" ::: "memory");
    const int c = lane & 7;
#pragma unroll
    for (int j = 0; j < 4; ++j) { const int n = (lane >> 3) + 8 * j; const LAS float* s = scr + (8 * c) * 33 + n;
        u32x4 o; o.x = cvt_pk_bf16(s[0 * 33], s[1 * 33]); o.y = cvt_pk_bf16(s[2 * 33], s[3 * 33]); o.z = cvt_pk_bf16(s[4 * 33], s[5 * 33]); o.w = cvt_pk_bf16(s[6 * 33], s[7 * 33]);
        *(u32x4*)(WT + (size_t)(drow0 + n) * ldo + dk0 + 8 * c) = o; }
    asm volatile("s_waitcnt lgkmcnt(0)" ::: "memory");
}

constexpr size_t S5_L_STRIDE = 1310720, S5_KT = 0, S5_ET = 131072, S5_FT = 655360, S5_LAMP = 1179648;
constexpr int S5_WSCR = 8192, S5_YST = 65536, YST_LD = 264;
constexpr int NU128 = T / 128, UPB128 = SEQ / 128;
__device__ __forceinline__ f32x4 mfma16(bf16x8 a, bf16x8 b, f32x4 c) { return __builtin_amdgcn_mfma_f32_16x16x32_bf16(a, b, c, 0, 0, 0); }

__device__ __forceinline__ void s5_kt_pair(int g, int c, int cp, const float* a_re, const float* a_im, const float* log_dt, const float* b_re, const float* b_im,
                                           const float* c_re, const float* c_im, const float* dvec, unsigned char* tab) {
    const float dt = __expf(log_dt[g]); float km[8];
#pragma unroll
    for (int d = 0; d < 8; ++d) km[d] = 0.f;
#pragma unroll 2
    for (int p = 0; p < CS; ++p) { const float lr = a_re[g * CS + p], li = a_im[g * CS + p], zr = lr * dt, zi = li * dt;
        const float sh = __sinf(0.5f * zi), cz = __cosf(zi), sz = __sinf(zi), ez = __expf(zr); const float nr = expm1f(zr) * cz - 2.0f * sh * sh, ni = ez * sz, den = lr * lr + li * li;
        const float cr = (nr * lr + ni * li) / den, ci = (ni * lr - nr * li) / den;
        const float br = b_re[((size_t)g * CS + p) * CGD + cp], bi = b_im[((size_t)g * CS + p) * CGD + cp]; const float bbr = cr * br - ci * bi, bbi = cr * bi + ci * br;
        const float cre = c_re[((size_t)g * CGD + c) * CS + p], cim = c_im[((size_t)g * CGD + c) * CS + p];
        float vr = cre * bbr - cim * bbi, vi = cre * bbi + cim * bbr;
        const float lbr = ez * cz, lbi = ez * sz;
#pragma unroll
        for (int d = 0; d < 8; ++d) { km[d] += vr; const float t = vr * lbr - vi * lbi; vi = vr * lbi + vi * lbr; vr = t; } }
    if (c == cp) km[0] += dvec[g * CGD + c];
    bf16_t* kt = (bf16_t*)(tab + S5_KT) + (size_t)g * 4096;
#pragma unroll
    for (int dd = 0; dd < 8; ++dd) { kt[(dd * 16 + c) * 32 + cp] = f2bf(km[dd]); kt[(dd * 16 + c) * 32 + 16 + cp] = dd >= 1 ? f2bf(km[dd - 1]) : (bf16_t)0; }
}
__device__ __forceinline__ void s5_et_task(int g, int ri, int p, int cp, const float* a_re, const float* a_im, const float* log_dt, const float* b_re, const float* b_im, unsigned char* tab) {
    const float dt = __expf(log_dt[g]); const float lr = a_re[g * CS + p], li = a_im[g * CS + p], zr = lr * dt, zi = li * dt;
    const float sh = __sinf(0.5f * zi), cz = __cosf(zi), sz = __sinf(zi), ez = __expf(zr); const float nr = expm1f(zr) * cz - 2.0f * sh * sh, ni = ez * sz, den = lr * lr + li * li;
    const float cr = (nr * lr + ni * li) / den, ci = (ni * lr - nr * li) / den;
    const float br = b_re[((size_t)g * CS + p) * CGD + cp], bi = b_im[((size_t)g * CS + p) * CGD + cp]; float vr = cr * br - ci * bi, vi = cr * bi + ci * br;
    const float lbr = ez * cz, lbi = ez * sz; bf16_t* et = (bf16_t*)(tab + S5_ET) + (size_t)g * 16384 + (size_t)(ri * 64 + p) * 128 + cp;
#pragma unroll
    for (int sp = 7; sp >= 0; --sp) { et[sp * 16] = f2bf(ri ? vi : vr); const float t = vr * lbr - vi * lbi; vi = vr * lbi + vi * lbr; vr = t; }
}
__device__ __forceinline__ void s5_ft_task(int g, int c, int ri, int p, const float* a_re, const float* a_im, const float* log_dt, const float* c_re, const float* c_im, unsigned char* tab) {
    const float dt = __expf(log_dt[g]); const float lr = a_re[g * CS + p], li = a_im[g * CS + p], zr = lr * dt, zi = li * dt; const float ez = __expf(zr), lbr = ez * __cosf(zi), lbi = ez * __sinf(zi);
    const float cre = c_re[((size_t)g * CGD + c) * CS + p], cim = c_im[((size_t)g * CGD + c) * CS + p]; float vr = cre * lbr - cim * lbi, vi = cre * lbi + cim * lbr;
    bf16_t* ft = (bf16_t*)(tab + S5_FT) + (size_t)g * 16384 + (size_t)c * 128 + ri * 64 + p;
#pragma unroll
    for (int tp = 0; tp < 8; ++tp) { ft[(size_t)tp * 16 * 128] = f2bf(ri ? -vi : vr); const float t = vr * lbr - vi * lbi; vi = vr * lbi + vi * lbr; vr = t; }
}
__device__ __forceinline__ void s5_table_elem(int g, int e, const float* a_re, const float* a_im, const float* log_dt, const float* b_re, const float* b_im,
                                              const float* c_re, const float* c_im, const float* dvec, unsigned char* tab) {
    const float dt = __expf(log_dt[g]);
    if (e < 4096) {
        const int dd = e >> 9, c = (e >> 5) & 15, ee = (e >> 4) & 1, cp = e & 15, d = dd - ee; float s = 0.f;
        if (d >= 0) {
            for (int p = 0; p < CS; ++p) { const float lr = a_re[g * CS + p], li = a_im[g * CS + p], zr = lr * dt, zi = li * dt;
                const float sh = __sinf(0.5f * zi); const float nr = expm1f(zr) * __cosf(zi) - 2.0f * sh * sh, ni = __expf(zr) * __sinf(zi), den = lr * lr + li * li;
                const float cr = (nr * lr + ni * li) / den, ci = (ni * lr - nr * li) / den;
                const float br = b_re[((size_t)g * CS + p) * CGD + cp], bi = b_im[((size_t)g * CS + p) * CGD + cp]; const float bbr = cr * br - ci * bi, bbi = cr * bi + ci * br;
                const float mag = __expf(zr * (float)d), pr = mag * __cosf(zi * (float)d), pi = mag * __sinf(zi * (float)d);
                const float vr = pr * bbr - pi * bbi, vi = pr * bbi + pi * bbr;
                s += c_re[((size_t)g * CGD + c) * CS + p] * vr - c_im[((size_t)g * CGD + c) * CS + p] * vi; }
            if (d == 0 && c == cp) s += dvec[g * CGD + c];
        }
        ((bf16_t*)(tab + S5_KT))[(size_t)g * 4096 + e] = f2bf(s); return;
    }
    e -= 4096;
    if (e < 16384) {
        const int n = e >> 7, k = e & 127, ri = n >> 6, p = n & 63, sp = k >> 4, cp = k & 15;
        const float lr = a_re[g * CS + p], li = a_im[g * CS + p], zr = lr * dt, zi = li * dt;
        const float sh = __sinf(0.5f * zi); const float nr = expm1f(zr) * __cosf(zi) - 2.0f * sh * sh, ni = __expf(zr) * __sinf(zi), den = lr * lr + li * li;
        const float cr = (nr * lr + ni * li) / den, ci = (ni * lr - nr * li) / den;
        const float br = b_re[((size_t)g * CS + p) * CGD + cp], bi = b_im[((size_t)g * CS + p) * CGD + cp]; const float bbr = cr * br - ci * bi, bbi = cr * bi + ci * br;
        const float d = (float)(7 - sp); const float mag = __expf(zr * d), pr = mag * __cosf(zi * d), pi = mag * __sinf(zi * d);
        ((bf16_t*)(tab + S5_ET))[(size_t)g * 16384 + e] = f2bf(ri ? (pr * bbi + pi * bbr) : (pr * bbr - pi * bbi)); return;
    }
    e -= 16384;
    if (e < 16384) {
        const int n = e >> 7, k = e & 127, tp = n >> 4, c = n & 15, ri = k >> 6, p = k & 63;
        const float lr = a_re[g * CS + p], li = a_im[g * CS + p], zr = lr * dt, zi = li * dt;
        const float d = (float)(tp + 1); const float mag = __expf(zr * d), pr = mag * __cosf(zi * d), pi = mag * __sinf(zi * d);
        const float cre = c_re[((size_t)g * CGD + c) * CS + p], cim = c_im[((size_t)g * CGD + c) * CS + p];
        ((bf16_t*)(tab + S5_FT))[(size_t)g * 16384 + e] = f2bf(ri ? -(cre * pi + cim * pr) : (cre * pr - cim * pi)); return;
    }
    e -= 16384;
    { const int p = e; const float lr = a_re[g * CS + p], li = a_im[g * CS + p], zr = lr * dt, zi = li * dt; float* o = (float*)(tab + S5_LAMP) + ((size_t)g * CS + p) * 8;
      float mag = expf(zr); o[0] = mag * cosf(zi); o[1] = mag * sinf(zi);
      mag = expf(zr * 8.f); o[2] = mag * cosf(zi * 8.f); o[3] = mag * sinf(zi * 8.f);
      mag = expf(zr * 128.f); o[4] = mag * cosf(zi * 128.f); o[5] = mag * sinf(zi * 128.f); o[6] = 0.f; o[7] = 0.f; }
}

template <class TT> __device__ __forceinline__ TT ldg(const void* ubase, unsigned voff) { return *(const TT*)((const char*)ubase + voff); }
template <int PASS>
__device__ __forceinline__ void s5_group(int unit, int g, bool first, float& kr, float& ki, int wave, int lane, const bf16_t* Z, bf16_t* Y, const unsigned char* tab, float* SEND, float* SEND2, float* SE, LAS unsigned char* lds) {
    const int ln = lane & 15, q = lane >> 4; const int t0 = unit * 128;
    const char* KTg = (const char*)(tab + S5_KT) + (size_t)g * 8192; const char* ETg = (const char*)(tab + S5_ET) + (size_t)g * 32768; const char* FTg = (const char*)(tab + S5_FT) + (size_t)g * 32768;
    const float* LAMPg = (const float*)(tab + S5_LAMP) + (size_t)g * CS * 8;
    const unsigned vo128 = (unsigned)(ln * 128 + 8 * q) * 2u;
    const unsigned vo32 = (unsigned)(ln * 32 + 8 * q) * 2u;
    LAS float* Sb = (LAS float*)(lds + wave * S5_WSCR); LAS bf16_t* Tb = (LAS bf16_t*)(lds + wave * S5_WSCR); LAS bf16_t* yst = (LAS bf16_t*)(lds + S5_YST);
    char* seb = (char*)(SE + ((size_t)unit * CG + g) * 16 * 128); const unsigned vl = (unsigned)lane * 4u;
    char* ylb = (char*)(Y + (size_t)t0 * D + AW + BW + g * 16); const unsigned vy = (unsigned)((ln * 8) * D + 4 * q) * 2u;
    const float lur = LAMPg[lane * 8 + 4], lui = LAMPg[lane * 8 + 5], l8r = LAMPg[lane * 8 + 2], l8i = LAMPg[lane * 8 + 3];
    float cr = 0.f, ci = 0.f;
    if (PASS == 1) {
        if (!first) { cr = kr; ci = ki; }
        bf16x8 X0, X1, X2, X3;
        { const char* zb = (const char*)(Z + (size_t)t0 * INC + ZC + g * 16); const unsigned vz = (unsigned)((ln * 8 + (q >> 1)) * INC + 8 * (q & 1)) * 2u;
          X0 = ldg<bf16x8>(zb, vz); X1 = ldg<bf16x8>(zb + 2 * INC * 2, vz); X2 = ldg<bf16x8>(zb + 4 * INC * 2, vz); X3 = ldg<bf16x8>(zb + 6 * INC * 2, vz); }
        { LAS float* sw = Sb + (4 * q) * 128 + ln; const char* eb = ETg;
#pragma unroll 1
          for (int jh = 0; jh < 2; ++jh) { bf16x8 ef[4][4];
#pragma unroll
            for (int j = 0; j < 4; ++j)
#pragma unroll
              for (int ks = 0; ks < 4; ++ks) ef[j][ks] = ldg<bf16x8>(eb + j * 4096 + ks * 64, vo128);
#pragma unroll
            for (int j = 0; j < 4; ++j) { f32x4 se = (f32x4){0.f, 0.f, 0.f, 0.f};
              se = mfma16(X0, ef[j][0], se); se = mfma16(X1, ef[j][1], se); se = mfma16(X2, ef[j][2], se); se = mfma16(X3, ef[j][3], se);
              LAS float* s2 = sw + 16 * j; s2[0] = se[0]; s2[128] = se[1]; s2[256] = se[2]; s2[384] = se[3]; }
            eb += 16384; sw += 64; } }
        asm volatile("" ::: "memory");
        { const char* kb = KTg; char* yq = ylb;
#pragma unroll 1
          for (int th = 0; th < 4; ++th) {
              const bf16x8 ka = ldg<bf16x8>(kb, vo32), kc = ldg<bf16x8>(kb + 1024, vo32);
              f32x4 acc0 = (f32x4){0.f, 0.f, 0.f, 0.f}, acc1 = (f32x4){0.f, 0.f, 0.f, 0.f};
              acc0 = mfma16(ka, X0, acc0); acc1 = mfma16(kc, X0, acc1);
              if (th >= 1) { acc0 = mfma16(ldg<bf16x8>(kb - 2048, vo32), X1, acc0); acc1 = mfma16(ldg<bf16x8>(kb - 1024, vo32), X1, acc1); }
              if (th >= 2) { acc0 = mfma16(ldg<bf16x8>(kb - 4096, vo32), X2, acc0); acc1 = mfma16(ldg<bf16x8>(kb - 3072, vo32), X2, acc1); }
              if (th >= 3) { acc0 = mfma16(ldg<bf16x8>(kb - 6144, vo32), X3, acc0); acc1 = mfma16(ldg<bf16x8>(kb - 5120, vo32), X3, acc1); }
              u32x2 w; w.x = cvt_pk_bf16(acc0[0], acc0[1]); w.y = cvt_pk_bf16(acc0[2], acc0[3]); *(u32x2*)(yq + vy) = w;
              w.x = cvt_pk_bf16(acc1[0], acc1[1]); w.y = cvt_pk_bf16(acc1[2], acc1[3]); *(u32x2*)(yq + (size_t)D * 2 + vy) = w;
              kb += 2048; yq += (size_t)2 * D * 2; } }
        asm volatile("" ::: "memory");
        float sr = cr, si = ci;
#pragma unroll
        for (int s = 0; s < 16; ++s) { const float er = Sb[s * 128 + lane], ei = Sb[s * 128 + 64 + lane];
            *(float*)(seb + s * 512 + vl) = er; *(float*)(seb + s * 512 + 256 + vl) = ei;
            const float nr = l8r * sr - l8i * si + er, ni = l8r * si + l8i * sr + ei; sr = nr; si = ni; }
        kr = sr; ki = si;
        float* dst = first ? SEND + (((size_t)unit * CG + g) * 2) * CS + lane : SEND2 + (((size_t)(unit >> 1) * CG + g) * 2) * CS + lane;
        dst[0] = sr; dst[CS] = si; asm volatile("" ::: "memory"); return;
    }
    if (first) { const int pr = unit >> 1, p0 = pr - (pr % (UPB128 / 2)); const float l2r = lur * lur - lui * lui, l2i = 2.0f * lur * lui;
        const char* sb = (const char*)(SEND2 + (((size_t)p0 * CG + g) * 2) * CS);
#pragma unroll 8
        for (int j = p0; j < pr; ++j) { const float sr = ldg<float>(sb, vl), si = ldg<float>(sb + CS * 4, vl); sb += (size_t)CG * 2 * CS * 4;
            const float nr = l2r * cr - l2i * ci + sr, ni = l2r * ci + l2i * cr + si; cr = nr; ci = ni; } }
    else { const float sr = SEND[(((size_t)(unit - 1) * CG + g) * 2 + 0) * CS + lane], si = SEND[(((size_t)(unit - 1) * CG + g) * 2 + 1) * CS + lane];
        cr = lur * kr - lui * ki + sr; ci = lur * ki + lui * kr + si; }
    kr = cr; ki = ci;
    { float sre[16], sim[16];
#pragma unroll
      for (int s = 0; s < 16; ++s) { sre[s] = ldg<float>(seb + s * 512, vl); sim[s] = ldg<float>(seb + s * 512 + 256, vl); }
      float sr = cr, si = ci;
#pragma unroll
      for (int s = 0; s < 16; ++s) { Tb[s * 128 + lane] = f2bf(sr); Tb[s * 128 + 64 + lane] = f2bf(si);
          const float nr = l8r * sr - l8i * si + sre[s], ni = l8r * si + l8i * sr + sim[s]; sr = nr; si = ni; } }
    asm volatile("" ::: "memory");
    const bf16x8 T0 = *(const LAS bf16x8*)(Tb + ln * 128 + 8 * q), T1 = *(const LAS bf16x8*)(Tb + ln * 128 + 32 + 8 * q), T2 = *(const LAS bf16x8*)(Tb + ln * 128 + 64 + 8 * q), T3 = *(const LAS bf16x8*)(Tb + ln * 128 + 96 + 8 * q);
    { LAS bf16_t* yw = yst + (ln * 8) * YST_LD + g * 16 + 4 * q; const char* fb = FTg; const char* yq = ylb;
#pragma unroll 1
      for (int th = 0; th < 4; ++th) { bf16x8 ff[2][4]; u32x2 yl[2];
#pragma unroll
          for (int j = 0; j < 2; ++j) { yl[j] = ldg<u32x2>(yq + (size_t)j * D * 2, vy);
#pragma unroll
              for (int ks = 0; ks < 4; ++ks) ff[j][ks] = ldg<bf16x8>(fb + j * 4096 + ks * 64, vo128); }
#pragma unroll
          for (int j = 0; j < 2; ++j) {
              f32x4 acc; acc[0] = __uint_as_float(yl[j].x << 16); acc[1] = __uint_as_float(yl[j].x & 0xffff0000u); acc[2] = __uint_as_float(yl[j].y << 16); acc[3] = __uint_as_float(yl[j].y & 0xffff0000u);
              acc = mfma16(ff[j][0], T0, acc); acc = mfma16(ff[j][1], T1, acc); acc = mfma16(ff[j][2], T2, acc); acc = mfma16(ff[j][3], T3, acc);
              u32x2 w; w.x = cvt_pk_bf16(gelu_fast(acc[0]), gelu_fast(acc[1])); w.y = cvt_pk_bf16(gelu_fast(acc[2]), gelu_fast(acc[3]));
              *(LAS u32x2*)(yw + j * YST_LD) = w; }
          fb += 8192; yq += (size_t)2 * D * 2; yw += 2 * YST_LD; } }
    asm volatile("s_waitcnt lgkmcnt(0)" ::: "memory");
}
constexpr int S5_PSG = 133120;
__device__ __forceinline__ void s5_glu(int unit, int wave, int lane, const bf16_t* WGLU, const float* glu_b, const float* mo_gc, bf16_t* Y, LAS unsigned char* lds) {
    const int ln = lane & 15, q = lane >> 4; LAS bf16_t* yst = (LAS bf16_t*)(lds + S5_YST); LAS float* PSg = (LAS float*)(lds + S5_PSG);
    bf16x8 wf[2][8];
    { const char* wb = (const char*)(WGLU + (size_t)(32 * wave) * 256); const unsigned vw = (unsigned)(ln * 256 + 8 * q) * 2u;
#pragma unroll
      for (int j = 0; j < 2; ++j)
#pragma unroll
          for (int ks = 0; ks < 8; ++ks) wf[j][ks] = ldg<bf16x8>(wb + j * 8192 + ks * 64, vw); }
    const f32x4 gb0 = *(const f32x4*)(glu_b + 32 * wave + 4 * q), gb1 = *(const f32x4*)(glu_b + 32 * wave + 16 + 4 * q);
    LAS bf16_t* op = (LAS bf16_t*)(lds + wave * S5_WSCR) + ln * 32 + 4 * q;
    { const LAS bf16_t* yrow = yst + ln * YST_LD; LAS float* psw = PSg + ln * 8 + wave; LAS bf16_t* ow = op;
#pragma unroll 2
      for (int tt = 0; tt < 8; ++tt) {
        f32x4 a0 = (f32x4){0.f, 0.f, 0.f, 0.f}, a1 = (f32x4){0.f, 0.f, 0.f, 0.f};
#pragma unroll
        for (int ks = 0; ks < 8; ++ks) { const bf16x8 yf = *(const LAS bf16x8*)(yrow + 32 * ks + 8 * q); a0 = mfma16(wf[0][ks], yf, a0); a1 = mfma16(wf[1][ks], yf, a1); }
        const u32x2 y0 = *(const LAS u32x2*)(yrow + 32 * wave + 4 * q), y1 = *(const LAS u32x2*)(yrow + 32 * wave + 16 + 4 * q);
        float o[8];
        o[0] = __uint_as_float(y0.x << 16) * sigmoid_fast(a0[0] + gb0[0]); o[1] = __uint_as_float(y0.x & 0xffff0000u) * sigmoid_fast(a0[1] + gb0[1]); o[2] = __uint_as_float(y0.y << 16) * sigmoid_fast(a0[2] + gb0[2]); o[3] = __uint_as_float(y0.y & 0xffff0000u) * sigmoid_fast(a0[3] + gb0[3]);
        o[4] = __uint_as_float(y1.x << 16) * sigmoid_fast(a1[0] + gb1[0]); o[5] = __uint_as_float(y1.x & 0xffff0000u) * sigmoid_fast(a1[1] + gb1[1]); o[6] = __uint_as_float(y1.y << 16) * sigmoid_fast(a1[2] + gb1[2]); o[7] = __uint_as_float(y1.y & 0xffff0000u) * sigmoid_fast(a1[3] + gb1[3]);
        float ss = ((o[0] * o[0] + o[1] * o[1]) + (o[2] * o[2] + o[3] * o[3])) + ((o[4] * o[4] + o[5] * o[5]) + (o[6] * o[6] + o[7] * o[7]));
        ss = add_x16_x32(ss);
        if (q == 0) *psw = ss;
        u32x2 w; w.x = cvt_pk_bf16(o[0], o[1]); w.y = cvt_pk_bf16(o[2], o[3]); *(LAS u32x2*)(ow) = w; w.x = cvt_pk_bf16(o[4], o[5]); w.y = cvt_pk_bf16(o[6], o[7]); *(LAS u32x2*)(ow + 16) = w;
        yrow += 16 * YST_LD; psw += 16 * 8; ow += 16 * 32; } }
    asm volatile("s_waitcnt lgkmcnt(0)" ::: "memory");
    __syncthreads();
    const f32x4 g0 = *(const f32x4*)(mo_gc + 32 * wave + 4 * q), g1 = *(const f32x4*)(mo_gc + 32 * wave + 16 + 4 * q);
    { char* yb = (char*)(Y + (size_t)(unit * 128) * D + AW + BW + 32 * wave); const unsigned vy = (unsigned)(ln * D + 4 * q) * 2u; const LAS f32x4* pp = (const LAS f32x4*)(PSg + ln * 8); const LAS bf16_t* ow = op;
#pragma unroll 2
      for (int tt = 0; tt < 8; ++tt) { const f32x4 p0 = pp[0], p1 = pp[1];
        const float rs = __builtin_amdgcn_rsqf((((p0[0] + p0[1]) + (p0[2] + p0[3])) + ((p1[0] + p1[1]) + (p1[2] + p1[3]))) * (1.0f / CW) + EPS);
        const u32x2 a = *(const LAS u32x2*)(ow), b = *(const LAS u32x2*)(ow + 16); u32x2 w;
        w.x = cvt_pk_bf16(__uint_as_float(a.x << 16) * rs * g0[0], __uint_as_float(a.x & 0xffff0000u) * rs * g0[1]); w.y = cvt_pk_bf16(__uint_as_float(a.y << 16) * rs * g0[2], __uint_as_float(a.y & 0xffff0000u) * rs * g0[3]);
        *(u32x2*)(yb + vy) = w;
        w.x = cvt_pk_bf16(__uint_as_float(b.x << 16) * rs * g1[0], __uint_as_float(b.x & 0xffff0000u) * rs * g1[1]); w.y = cvt_pk_bf16(__uint_as_float(b.y << 16) * rs * g1[2], __uint_as_float(b.y & 0xffff0000u) * rs * g1[3]);
        *(u32x2*)(yb + 32 + vy) = w;
        yb += (size_t)16 * D * 2; pp += 16 * 2; ow += 16 * 32; } }
}

constexpr int XC_LD = 392;
constexpr int RG_XC = 0, RG_PS = 100352, RG_CAR = 112640, RG_RSB = 114176, RG_PT = 114688, RG_HC = 116224;
template <int CTRL> __device__ __forceinline__ float dppf(float old, float v) { return __int_as_float(__builtin_amdgcn_update_dpp(__float_as_int(old), __float_as_int(v), CTRL, 0xf, 0xf, false)); }
__device__ __forceinline__ void bf8_to_f32(const u32x4 o, float (&v)[8]) {
    v[0] = __uint_as_float(o.x << 16); v[1] = __uint_as_float(o.x & 0xffff0000u); v[2] = __uint_as_float(o.y << 16); v[3] = __uint_as_float(o.y & 0xffff0000u);
    v[4] = __uint_as_float(o.z << 16); v[5] = __uint_as_float(o.z & 0xffff0000u); v[6] = __uint_as_float(o.w << 16); v[7] = __uint_as_float(o.w & 0xffff0000u);
}
__device__ __forceinline__ float bcast15(float v) { return __int_as_float(__builtin_amdgcn_ds_swizzle(__float_as_int(v), 0x1F0)); }
template <int PASS>
__device__ __forceinline__ void rglru_unit(int unit, bool first, float& cprev, int tid, int wave, int lane, const bf16_t* Z, bf16_t* Y, const bf16_t* WRG, const bf16_t* WIG,
                                           const float* conv_w, const float* conv_b, const float* rg_b, const float* ig_b, const float* lam, const float* mo_gb,
                                           float* SUMA, float* SUMH, float* SUMA2, float* SUMH2, bf16_t* HL, bf16_t* PP, LAS unsigned char* lds) {
    LAS bf16_t* xcl = (LAS bf16_t*)(lds + RG_XC); LAS float* PS = (LAS float*)(lds + RG_PS); LAS float* CAR = (LAS float*)(lds + RG_CAR); LAS float* RSB = (LAS float*)(lds + RG_RSB); LAS float* PT = (LAS float*)(lds + RG_PT); LAS float* HC = (LAS float*)(lds + RG_HC);
    const int t0 = unit * 128; const int ln = lane & 15, q = lane >> 4;
    if (tid < 384) {
        const int c0 = (tid % 48) * 8, tg = tid / 48; const int tb = t0 + tg * 16, s0 = tb % SEQ;
        float w0[8], w1[8], w2[8], w3[8], bb[8];
#pragma unroll
        for (int hh = 0; hh < 2; ++hh) { const f32x4 a0 = *(const f32x4*)(conv_w + 0 * BW + c0 + 4 * hh), a1 = *(const f32x4*)(conv_w + 1 * BW + c0 + 4 * hh), a2 = *(const f32x4*)(conv_w + 2 * BW + c0 + 4 * hh), a3 = *(const f32x4*)(conv_w + 3 * BW + c0 + 4 * hh), a4 = *(const f32x4*)(conv_b + c0 + 4 * hh);
#pragma unroll
            for (int j = 0; j < 4; ++j) { w0[4 * hh + j] = a0[j]; w1[4 * hh + j] = a1[j]; w2[4 * hh + j] = a2[j]; w3[4 * hh + j] = a3[j]; bb[4 * hh + j] = a4[j]; } }
        float xm1[8], xm2[8], xm3[8];
        const bf16_t* zp = Z + (size_t)tb * INC + ZX + c0;
        { const u32x4 z4 = {0u, 0u, 0u, 0u}; const u32x4 o1 = s0 >= 1 ? *(const u32x4*)(zp - INC) : z4, o2 = s0 >= 2 ? *(const u32x4*)(zp - 2 * INC) : z4, o3 = s0 >= 3 ? *(const u32x4*)(zp - 3 * INC) : z4;
          bf8_to_f32(o1, xm1); bf8_to_f32(o2, xm2); bf8_to_f32(o3, xm3); }
        LAS bf16_t* xw = xcl + (tg * 16) * XC_LD + c0;
#pragma unroll 4
        for (int i = 0; i < 16; ++i) { float x0[8]; bf8_to_f32(*(const u32x4*)(zp), x0); float v[8];
#pragma unroll
            for (int j = 0; j < 8; ++j) { v[j] = bb[j] + w3[j] * x0[j] + w2[j] * xm1[j] + w1[j] * xm2[j] + w0[j] * xm3[j]; xm3[j] = xm2[j]; xm2[j] = xm1[j]; xm1[j] = x0[j]; }
            u32x4 w; w.x = cvt_pk_bf16(v[0], v[1]); w.y = cvt_pk_bf16(v[2], v[3]); w.z = cvt_pk_bf16(v[4], v[5]); w.w = cvt_pk_bf16(v[6], v[7]);
            *(LAS u32x4*)(xw) = w; zp += INC; xw += XC_LD; }
        if (PASS == 2) { const int c = tid; float h;
            if (first) { const int pr = unit >> 1, p0 = pr - (pr % (UPB128 / 2)); h = 0.f; const float* pa = SUMA2 + (size_t)p0 * BW + c; const float* ph = SUMH2 + (size_t)p0 * BW + c;
#pragma unroll 8
                for (int j = p0; j < pr; ++j) { h = fmaf(*pa, h, *ph); pa += BW; ph += BW; } }
            else h = fmaf(SUMA[(size_t)(unit - 1) * BW + c], cprev, SUMH[(size_t)(unit - 1) * BW + c]);
            cprev = h; CAR[c] = h; }
    }
    __syncthreads();
#pragma unroll 1
    for (int ci = 0; ci < 3; ++ci) {
        const int combo = wave + 8 * ci, h = combo >> 2, jt = combo & 3, cb = h * 64 + jt * 16;
        const bf16_t* wr = WRG + ((size_t)(h * 64 + jt * 16 + ln)) * 64 + 8 * q; const bf16_t* wi = WIG + ((size_t)(h * 64 + jt * 16 + ln)) * 64 + 8 * q;
        const bf16x8 RG0 = *(const bf16x8*)(wr), RG1 = *(const bf16x8*)(wr + 32), IG0 = *(const bf16x8*)(wi), IG1 = *(const bf16x8*)(wi + 32);
        const f32x4 rgb4 = *(const f32x4*)(rg_b + cb + 4 * q), igb4 = *(const f32x4*)(ig_b + cb + 4 * q), lam4 = *(const f32x4*)(lam + cb + 4 * q);
        float spc[4], car[4], ptot[4];
#pragma unroll
        for (int r = 0; r < 4; ++r) { spc[r] = -8.0f * 1.4426950408889634f * log1pf(expf(-lam4[r])); car[r] = PASS == 2 ? CAR[cb + 4 * q + r] : (first ? 0.f : HC[cb + 4 * q + r]); ptot[r] = (PASS == 1 && !first) ? PT[cb + 4 * q + r] : 1.f; }
        const LAS bf16_t* xb = xcl + ln * XC_LD + h * 64 + 8 * q; const LAS bf16_t* xv = xcl + ln * XC_LD + cb + 4 * q;
        const bf16_t* zg = Z + (size_t)(t0 + ln) * INC + ZG + cb + 4 * q; bf16_t* yo = Y + (size_t)(t0 + ln) * D + AW + cb + 4 * q; LAS float* psw = PS + ln * 24 + combo;
        bf16_t* hlo = HL + (size_t)(t0 + ln) * BW + cb + 4 * q; bf16_t* ppo = PP + (size_t)(t0 + ln) * BW + cb + 4 * q;
#pragma unroll 1
        for (int tt = 0; tt < 8; ++tt) {
            const bf16x8 B0 = *(const LAS bf16x8*)(xb), B1 = *(const LAS bf16x8*)(xb + 32);
            f32x4 ar = (f32x4){0.f, 0.f, 0.f, 0.f}, ai = (f32x4){0.f, 0.f, 0.f, 0.f};
            ar = mfma16(RG0, B0, ar); ar = mfma16(RG1, B1, ar); ai = mfma16(IG0, B0, ai); ai = mfma16(IG1, B1, ai);
            const u32x2 xq = *(const LAS u32x2*)(xv); float xc4[4] = {__uint_as_float(xq.x << 16), __uint_as_float(xq.x & 0xffff0000u), __uint_as_float(xq.y << 16), __uint_as_float(xq.y & 0xffff0000u)};
            float hv[4], pv[4];
#pragma unroll
            for (int r = 0; r < 4; ++r) {
                const float rr = sigmoid_fast(ar[r] + rgb4[r]), ii = sigmoid_fast(ai[r] + igb4[r]);
                float A = __builtin_amdgcn_exp2f(spc[r] * rr);
                float Bv = __builtin_amdgcn_sqrtf(fmaxf(1.0f - A * A, 0.f)) * (ii * xc4[r]);
                if (ln == 0) Bv = fmaf(A, car[r], Bv);
                { const float As = dppf<0x111>(1.0f, A), Bs = dppf<0x111>(0.0f, Bv); Bv = fmaf(A, Bs, Bv); A *= As; }
                { const float As = dppf<0x112>(1.0f, A), Bs = dppf<0x112>(0.0f, Bv); Bv = fmaf(A, Bs, Bv); A *= As; }
                { const float As = dppf<0x114>(1.0f, A), Bs = dppf<0x114>(0.0f, Bv); Bv = fmaf(A, Bs, Bv); A *= As; }
                { const float As = dppf<0x118>(1.0f, A), Bs = dppf<0x118>(0.0f, Bv); Bv = fmaf(A, Bs, Bv); A *= As; }
                hv[r] = Bv; car[r] = bcast15(Bv);
                if (PASS == 1) { pv[r] = ptot[r] * A; ptot[r] *= bcast15(A); }
            }
            if (PASS == 1) { u32x2 w; w.x = cvt_pk_bf16(hv[0], hv[1]); w.y = cvt_pk_bf16(hv[2], hv[3]); *(u32x2*)(hlo) = w; w.x = cvt_pk_bf16(pv[0], pv[1]); w.y = cvt_pk_bf16(pv[2], pv[3]); *(u32x2*)(ppo) = w; hlo += 16 * BW; ppo += 16 * BW; }
            if (PASS == 2) { const u32x2 gq = *(const u32x2*)(zg);
                const float y0 = hv[0] * __uint_as_float(gq.x << 16), y1 = hv[1] * __uint_as_float(gq.x & 0xffff0000u), y2 = hv[2] * __uint_as_float(gq.y << 16), y3 = hv[3] * __uint_as_float(gq.y & 0xffff0000u);
                u32x2 w; w.x = cvt_pk_bf16(y0, y1); w.y = cvt_pk_bf16(y2, y3); *(u32x2*)(yo) = w;
                float ss = (y0 * y0 + y1 * y1) + (y2 * y2 + y3 * y3); ss += __shfl_xor(ss, 16); ss += __shfl_xor(ss, 32);
                if (q == 0) *psw = ss; }
            xb += 16 * XC_LD; xv += 16 * XC_LD; zg += 16 * INC; yo += 16 * D; psw += 16 * 24;
        }
        if (PASS == 1 && ln == 0) {
            float* da = first ? SUMA + (size_t)unit * BW : SUMA2 + (size_t)(unit >> 1) * BW; float* dh = first ? SUMH + (size_t)unit * BW : SUMH2 + (size_t)(unit >> 1) * BW;
#pragma unroll
            for (int r = 0; r < 4; ++r) { da[cb + 4 * q + r] = ptot[r]; dh[cb + 4 * q + r] = car[r]; if (first) { PT[cb + 4 * q + r] = ptot[r]; HC[cb + 4 * q + r] = car[r]; } } }
    }
    if (PASS == 2) {
        asm volatile("s_waitcnt vmcnt(0)" ::: "memory");
        __syncthreads();
        if (tid < 128) { float s = 0.f;
#pragma unroll
            for (int k = 0; k < 24; ++k) s += PS[tid * 24 + k];
            RSB[tid] = __builtin_amdgcn_rsqf(s * (1.0f / BW) + EPS); }
        __syncthreads();
#pragma unroll 2
        for (int k = 0; k < 12; ++k) { const int idx = tid + 512 * k, tl = idx / 48, c0 = (idx % 48) * 8; const float rs = RSB[tl];
            bf16_t* yp = Y + (size_t)(t0 + tl) * D + AW + c0; float v[8]; bf8_to_f32(*(const u32x4*)(yp), v);
            const f32x4 g0 = *(const f32x4*)(mo_gb + c0), g1 = *(const f32x4*)(mo_gb + c0 + 4);
            u32x4 w; w.x = cvt_pk_bf16(v[0] * rs * g0[0], v[1] * rs * g0[1]); w.y = cvt_pk_bf16(v[2] * rs * g0[2], v[3] * rs * g0[3]); w.z = cvt_pk_bf16(v[4] * rs * g1[0], v[5] * rs * g1[1]); w.w = cvt_pk_bf16(v[6] * rs * g1[2], v[7] * rs * g1[3]);
            *(u32x4*)(yp) = w; }
    }
    __syncthreads();
}

__device__ __forceinline__ void rglru_fix_pair(int pr, int tid, int wave, int lane, const bf16_t* Z, bf16_t* Y, const bf16_t* HL, const bf16_t* PP, const float* SUMA2, const float* SUMH2, const float* mo_gb, LAS unsigned char* lds) {
    LAS float* CAR = (LAS float*)(lds + RG_CAR);
    if (tid < 384) { const int c = tid, p0 = pr - (pr % (UPB128 / 2)); float h = 0.f; const float* pa = SUMA2 + (size_t)p0 * BW + c; const float* ph = SUMH2 + (size_t)p0 * BW + c;
#pragma unroll 8
        for (int j = p0; j < pr; ++j) { h = fmaf(*pa, h, *ph); pa += BW; ph += BW; }
        CAR[c] = h; }
    __syncthreads();
    {
        const bool act = lane < 48; const int c0 = act ? lane * 8 : 0; float hin[8]; const f32x4 g0 = *(const f32x4*)(mo_gb + c0), g1 = *(const f32x4*)(mo_gb + c0 + 4);
#pragma unroll
        for (int e = 0; e < 8; ++e) hin[e] = CAR[c0 + e];
#pragma unroll 2
        for (int i = 0; i < 32; ++i) { const size_t t = (size_t)pr * 256 + wave * 32 + i;
            float hl[8], pp[8], gg[8], y[8]; bf8_to_f32(*(const u32x4*)(HL + t * BW + c0), hl); bf8_to_f32(*(const u32x4*)(PP + t * BW + c0), pp); bf8_to_f32(*(const u32x4*)(Z + t * INC + ZG + c0), gg);
            float ss = 0.f;
#pragma unroll
            for (int e = 0; e < 8; ++e) { y[e] = fmaf(pp[e], hin[e], hl[e]) * gelu_fast(gg[e]); ss += y[e] * y[e]; }
            ss = wave_sum(act ? ss : 0.f);
            const float rs = __builtin_amdgcn_rsqf(ss * (1.0f / BW) + EPS);
            u32x4 w; w.x = cvt_pk_bf16(y[0] * rs * g0[0], y[1] * rs * g0[1]); w.y = cvt_pk_bf16(y[2] * rs * g0[2], y[3] * rs * g0[3]); w.z = cvt_pk_bf16(y[4] * rs * g1[0], y[5] * rs * g1[1]); w.w = cvt_pk_bf16(y[6] * rs * g1[2], y[7] * rs * g1[3]);
            if (act) *(u32x4*)(Y + t * D + AW + c0) = w; }
    }
    __syncthreads();
}

constexpr int VT_LD = 136;
__device__ __forceinline__ void mixa_unit(int unit, int tid, int wave, int lane, const bf16_t* Z, bf16_t* Y, const bf16_t* WSP, const float* a_sb, const float* vg, const float* mo_ga, LAS unsigned char* lds) {
    LAS bf16_t* vT = (LAS bf16_t*)lds; const int t0 = unit * 128; const int ln = lane & 15, q = lane >> 4;
    { const int j = tid >> 2, part = tid & 3; const bf16_t* zp = Z + (size_t)(t0 + j) * INC + ZV + part * 96;
      u32x4 raw[12]; float ss = 0.f;
#pragma unroll
      for (int k = 0; k < 12; ++k) { const u32x4 rw = *(const u32x4*)(zp + 8 * k); float v[8]; bf8_to_f32(rw, v);
#pragma unroll
          for (int e = 0; e < 8; ++e) { v[e] = gelu_fast(v[e]); ss += v[e] * v[e]; }
          raw[k].x = cvt_pk_bf16(v[0], v[1]); raw[k].y = cvt_pk_bf16(v[2], v[3]); raw[k].z = cvt_pk_bf16(v[4], v[5]); raw[k].w = cvt_pk_bf16(v[6], v[7]); }
      ss += x_xor1(ss); ss += x_xor2(ss);
      const float rs = __builtin_amdgcn_rsqf(ss * (1.0f / AW) + EPS);
      LAS bf16_t* vw = vT + (part * 96) * VT_LD + j; const float* gp = vg + part * 96;
#pragma unroll
      for (int k = 0; k < 12; ++k) { float v[8]; bf8_to_f32(raw[k], v); const f32x4 g0 = *(const f32x4*)(gp + 8 * k), g1 = *(const f32x4*)(gp + 8 * k + 4);
#pragma unroll
          for (int e = 0; e < 8; ++e) vw[(8 * k + e) * VT_LD] = f2bf(v[e] * rs * (e < 4 ? g0[e] : g1[e - 4])); } }
    __syncthreads();
    const bool full = wave >= 4;
    float ss = 0.f;
    const int tl = 16 * wave + ln;
    const char* ub = (const char*)(Z + (size_t)t0 * INC + ZU); const unsigned vu = (unsigned)(tl * INC + 4 * q) * 2u;
    const char* wb = (const char*)WSP; const unsigned vw = (unsigned)(tl * 128 + 8 * q) * 2u;
    char* yb = (char*)(Y + (size_t)t0 * D); const unsigned vy = (unsigned)(tl * D + 4 * q) * 2u;
    const bf16x8 z8 = {0, 0, 0, 0, 0, 0, 0, 0};
    bf16x8 Wn0 = ldg<bf16x8>(wb, vw), Wn1 = ldg<bf16x8>(wb + 64, vw), Wn2 = z8, Wn3 = z8;
    if (full) { Wn2 = ldg<bf16x8>(wb + 128, vw); Wn3 = ldg<bf16x8>(wb + 192, vw); }
    u32x2 un0 = ldg<u32x2>(ub, vu), un1 = ldg<u32x2>(ub + 32, vu), un2 = ldg<u32x2>(ub + 64, vu), un3 = ldg<u32x2>(ub + 96, vu); float bn = a_sb[tl];
    const LAS bf16_t* ap = vT + ln * VT_LD + 8 * q;
#pragma unroll 1
    for (int h = 0; h < 6; ++h) {
        const bf16x8 W0 = Wn0, W1 = Wn1, W2 = Wn2, W3 = Wn3; const u32x2 uc[4] = {un0, un1, un2, un3}; const float b = bn;
        if (h < 5) { wb += 128 * 128 * 2; ub += 128; Wn0 = ldg<bf16x8>(wb, vw); Wn1 = ldg<bf16x8>(wb + 64, vw); if (full) { Wn2 = ldg<bf16x8>(wb + 128, vw); Wn3 = ldg<bf16x8>(wb + 192, vw); }
            un0 = ldg<u32x2>(ub, vu); un1 = ldg<u32x2>(ub + 32, vu); un2 = ldg<u32x2>(ub + 64, vu); un3 = ldg<u32x2>(ub + 96, vu); bn = a_sb[(h + 1) * 128 + tl]; }
#pragma unroll
        for (int dt = 0; dt < 4; ++dt) { f32x4 acc = (f32x4){0.f, 0.f, 0.f, 0.f};
            const bf16x8 a0 = *(const LAS bf16x8*)(ap + 16 * dt * VT_LD), a1 = *(const LAS bf16x8*)(ap + 16 * dt * VT_LD + 32), a2 = *(const LAS bf16x8*)(ap + 16 * dt * VT_LD + 64), a3 = *(const LAS bf16x8*)(ap + 16 * dt * VT_LD + 96);
            acc = mfma16(a0, W0, acc); acc = mfma16(a1, W1, acc); acc = mfma16(a2, W2, acc); acc = mfma16(a3, W3, acc);
            const u32x2 u2 = uc[dt];
            const float v0 = gelu_fast(__uint_as_float(u2.x << 16)) * (acc[0] + b), v1 = gelu_fast(__uint_as_float(u2.x & 0xffff0000u)) * (acc[1] + b), v2 = gelu_fast(__uint_as_float(u2.y << 16)) * (acc[2] + b), v3 = gelu_fast(__uint_as_float(u2.y & 0xffff0000u)) * (acc[3] + b);
            ss += (v0 * v0 + v1 * v1) + (v2 * v2 + v3 * v3);
            u32x2 pk; pk.x = cvt_pk_bf16(v0, v1); pk.y = cvt_pk_bf16(v2, v3); *(u32x2*)(yb + (h * 64 + 16 * dt) * 2 + vy) = pk; }
        ap += 64 * VT_LD;
    }
    ss = add_x16_x32(ss);
    const float rs = __builtin_amdgcn_rsqf(ss * (1.0f / AW) + EPS);
    asm volatile("s_waitcnt vmcnt(0)" ::: "memory");
    { const char* gb = (const char*)mo_ga; const unsigned vg4 = (unsigned)(4 * q) * 4u;
#pragma unroll 1
      for (int kb = 0; kb < 3; ++kb) { u32x2 pk[8];
#pragma unroll
          for (int k = 0; k < 8; ++k) pk[k] = ldg<u32x2>(yb + k * 32, vy);
#pragma unroll
          for (int k = 0; k < 8; ++k) { const f32x4 gg = ldg<f32x4>(gb + k * 64, vg4);
              u32x2 w; w.x = cvt_pk_bf16(__uint_as_float(pk[k].x << 16) * rs * gg[0], __uint_as_float(pk[k].x & 0xffff0000u) * rs * gg[1]); w.y = cvt_pk_bf16(__uint_as_float(pk[k].y << 16) * rs * gg[2], __uint_as_float(pk[k].y & 0xffff0000u) * rs * gg[3]);
              *(u32x2*)(yb + k * 32 + vy) = w; }
          yb += 256; gb += 512; } }
    __syncthreads();
}

__device__ __forceinline__ void router_unit(int unit, int wave, int lane, const bf16_t* HB, const float* SSQ, const bf16_t* WRT, const float* rgb, const float* reb,
                                            int* CLS, float* G2, LAS unsigned char* lds, LAS int* hist) {
    const int ln = lane & 15, q = lane >> 4; const int t0 = unit * UT + wave * 32;
    LAS float* LG = (LAS float*)(lds + wave * 8192);
    f32x4 acc[2][3];
#pragma unroll
    for (int tt = 0; tt < 2; ++tt)
#pragma unroll
        for (int j = 0; j < 3; ++j) acc[tt][j] = (f32x4){0.f, 0.f, 0.f, 0.f};
    const bf16_t* hp0 = HB + (size_t)(t0 + ln) * D + 8 * q; const bf16_t* hp1 = hp0 + (size_t)16 * D; const bf16_t* wp = WRT + (size_t)ln * D + 8 * q;
#pragma unroll 4
    for (int ks = 0; ks < 32; ++ks) {
        const bf16x8 b0 = *(const bf16x8*)(hp0), b1 = *(const bf16x8*)(hp1);
        const bf16x8 a0 = *(const bf16x8*)(wp), a1 = *(const bf16x8*)(wp + 16 * D), a2 = *(const bf16x8*)(wp + 32 * D);
        acc[0][0] = mfma16(a0, b0, acc[0][0]); acc[0][1] = mfma16(a1, b0, acc[0][1]); acc[0][2] = mfma16(a2, b0, acc[0][2]);
        acc[1][0] = mfma16(a0, b1, acc[1][0]); acc[1][1] = mfma16(a1, b1, acc[1][1]); acc[1][2] = mfma16(a2, b1, acc[1][2]);
        hp0 += 32; hp1 += 32; wp += 32; }
#pragma unroll
    for (int tt = 0; tt < 2; ++tt)
#pragma unroll
        for (int j = 0; j < 3; ++j) *(LAS f32x4*)(LG + (16 * tt + ln) * 48 + 16 * j + 4 * q) = acc[tt][j];
    asm volatile("s_waitcnt lgkmcnt(0)" ::: "memory");
    if (lane < 32) { const int t = t0 + lane; const LAS float* lg = LG + lane * 48;
        const f32x4* sp = (const f32x4*)(SSQ + (size_t)t * 16); const f32x4 s0 = sp[0], s1 = sp[1], s2 = sp[2], s3 = sp[3];
        const float sq = ((s0[0] + s0[1]) + (s0[2] + s0[3])) + ((s1[0] + s1[1]) + (s1[2] + s1[3])) + ((s2[0] + s2[1]) + (s2[2] + s2[3])) + ((s3[0] + s3[1]) + (s3[2] + s3[3]));
        const float r = rsqrtf(sq * (1.0f / D) + EPS);
        float gl[4];
#pragma unroll
        for (int j = 0; j < 4; ++j) gl[j] = r * (lg[j] + lg[16 + j]) + rgb[j];
        int gs = 0; float gm = gl[0];
#pragma unroll
        for (int j = 1; j < 4; ++j) if (gl[j] > gm) { gm = gl[j]; gs = j; }
        float den = 0.f;
#pragma unroll
        for (int j = 0; j < 4; ++j) den += expf(gl[j] - gm);
        const float gwt = 1.0f / den;
        float el[4];
#pragma unroll
        for (int j = 0; j < 4; ++j) { float v;
            if (gs < 3) v = lg[4 + 4 * gs + j] + lg[16 + 4 + 4 * gs + j]; else v = lg[32 + j] + lg[36 + j];
            el[j] = r * v + reb[gs * 4 + j]; }
        int i0 = 0; float v0 = el[0];
#pragma unroll
        for (int j = 1; j < 4; ++j) if (el[j] > v0) { v0 = el[j]; i0 = j; }
        int i1 = 0; float v1 = -3.0e38f;
#pragma unroll
        for (int j = 0; j < 4; ++j) if (j != i0 && el[j] > v1) { v1 = el[j]; i1 = j; }
        const float e1 = expf(v1 - v0); const float w0 = gwt / (1.0f + e1), w1 = gwt * e1 / (1.0f + e1);
        const int lo = i0 < i1 ? i0 : i1, hi = i0 < i1 ? i1 : i0; const int cls = gs * 6 + pair_idx(lo, hi);
        CLS[t] = cls; G2[(size_t)t * 2 + 0] = i0 < i1 ? w0 : w1; G2[(size_t)t * 2 + 1] = i0 < i1 ? w1 : w0;
        __hip_atomic_fetch_add(hist + cls, 1, __ATOMIC_RELAXED, __HIP_MEMORY_SCOPE_WORKGROUP); }
}

__device__ __forceinline__ void tr_item8(const float* W, int ldw, int k0, int scol0, unsigned char* WT, int ldo, int drow0, int dk0, LAS float* scr, int lane) {
#pragma unroll 8
    for (int i = 0; i < 32; ++i) { const int kk = 2 * i + (lane >> 5); scr[kk * 33 + (lane & 31)] = W[(size_t)(k0 + kk) * ldw + scol0 + (lane & 31)] * pg8::FS_W; }
    asm volatile("s_waitcnt lgkmcnt(0)" ::: "memory");
    const int c = lane & 7;
#pragma unroll
    for (int j = 0; j < 4; ++j) { const int n = (lane >> 3) + 8 * j; const LAS float* s = scr + (8 * c) * 33 + n;
        u32x2 o; o.x = pk_fp8x4(s[0 * 33], s[1 * 33], s[2 * 33], s[3 * 33]); o.y = pk_fp8x4(s[4 * 33], s[5 * 33], s[6 * 33], s[7 * 33]);
        *(u32x2*)(WT + (size_t)(drow0 + n) * ldo + dk0 + 8 * c) = o; }
    asm volatile("s_waitcnt lgkmcnt(0)" ::: "memory");
}
struct TrP { const float* src; const float* gk; unsigned char* dst; int ldw, ldo, fp8; };
__device__ __forceinline__ void tr_load(const TrP& P, int lane, float (&v)[32]) {
#pragma unroll
    for (int i = 0; i < 32; ++i) { const int kk = 2 * i + (lane >> 5); float x = P.src[(size_t)kk * P.ldw + (lane & 31)]; if (P.gk) x *= P.gk[kk]; v[i] = x; }
}
__device__ __forceinline__ void tr_store(const TrP& P, int lane, const float (&v)[32], LAS float* scr) {
    const float sc = P.fp8 ? pg8::FS_W : 1.0f;
#pragma unroll
    for (int i = 0; i < 32; ++i) scr[(2 * i + (lane >> 5)) * 33 + (lane & 31)] = v[i] * sc;
    asm volatile("s_waitcnt lgkmcnt(0)" ::: "memory");
    const int c = lane & 7;
#pragma unroll
    for (int j = 0; j < 4; ++j) { const int n = (lane >> 3) + 8 * j; const LAS float* s = scr + (8 * c) * 33 + n;
        if (P.fp8) { u32x2 o; o.x = pk_fp8x4(s[0 * 33], s[1 * 33], s[2 * 33], s[3 * 33]); o.y = pk_fp8x4(s[4 * 33], s[5 * 33], s[6 * 33], s[7 * 33]); *(u32x2*)(P.dst + (size_t)n * P.ldo + 8 * c) = o; }
        else { u32x4 o; o.x = cvt_pk_bf16(s[0 * 33], s[1 * 33]); o.y = cvt_pk_bf16(s[2 * 33], s[3 * 33]); o.z = cvt_pk_bf16(s[4 * 33], s[5 * 33]); o.w = cvt_pk_bf16(s[6 * 33], s[7 * 33]); *(u32x4*)(P.dst + (size_t)n * P.ldo + 16 * c) = o; } }
    asm volatile("s_waitcnt lgkmcnt(0)" ::: "memory");
}
struct Args { const float* in[34]; float* out; unsigned char* ws; };

__global__ void __launch_bounds__(512, 2) mega_fwd(Args a) {
    extern __shared__ __attribute__((aligned(16))) unsigned char lds_raw[];
    LAS unsigned char* lds = (LAS unsigned char*)lds_raw;
    volatile LAS unsigned* LW = (volatile LAS unsigned*)(lds + LDSCTL_OFF);
    volatile LAS int* LWI = (volatile LAS int*)(lds + LDSCTL_OFF);
    const int G = gridDim.x, bid0 = blockIdx.x; const int wave_s0 = __builtin_amdgcn_readfirstlane(threadIdx.x >> 6);
#define PHASE_IDS() int wv_ = wave_s0, bd_ = bid0; asm volatile("" : "+s"(wv_), "+s"(bd_)); const int wave_s = wv_, bid = bd_;     \
    const int lane = fresh_lane(), wave = wave_s, tid = wave * 64 + lane; const int gw = bid * 8 + wave, NGW = G * 8; \
    const size_t gt = (size_t)bid * 512 + tid, NGT = (size_t)G * 512; (void)lane; (void)wave; (void)gw; (void)NGW; (void)gt; (void)NGT
#define WSB() ({ unsigned char* _w = a.ws; asm volatile("" : "+s"(_w)); _w; })
#define INP(i) ({ int _k = (i); asm volatile("" : "+s"(_k)); a.in[_k]; })
    for (int u = threadIdx.x; u < (LDS_BYTES - LDSCTL_OFF) / 4; u += 512) LW[u] = 0u;
    __syncthreads();
    XcdBarrier bar = xcd_barrier_post((unsigned*)(a.ws + WS_CTL) + CW_BAR, LW + LW_BAR);

    {
        PHASE_IDS(); unsigned char* ws = WSB(); bf16_t* WIN = (bf16_t*)(ws + WS_WIN); bf16_t* WOUT = (bf16_t*)(ws + WS_WOUT); bf16_t* WGU = (bf16_t*)(ws + WS_WGU); bf16_t* WD2 = (bf16_t*)(ws + WS_WD2);
        bf16_t* HB = (bf16_t*)(ws + WS_HB); float* SSQ = (float*)(ws + WS_SSQ);
        LAS float* scr = (LAS float*)(lds + wave * 16384);
        constexpr int I_IN = 16 * 56, I_OUT = 16 * 32, I_GU = 2 * 16 * 256, I_D8 = 16 * 256, I_GLU = 32, I_RG = 24, I_L = I_IN + I_OUT + I_GU + I_D8 + I_GLU + I_RG;
        const float* i_win = INP(2); const float* i_g = INP(1); const float* i_wout = INP(24); const float* i_wg = INP(30); const float* i_wu = INP(31); const float* i_wd = INP(32);
        const float* i_glu = INP(21); const float* i_rg = INP(8); const float* i_ig = INP(10);
#define TR_DECODE(P, it) do { const int l = (it) / I_L; int r = (it) % I_L; P.gk = nullptr; P.fp8 = 0; \
            if (r < I_IN) { const int kb = r / 56, nb = r % 56, j0 = nb * 32; const int sc = j0 < 768 ? j0 : (j0 < 1152 ? j0 + 384 : (j0 < 1536 ? j0 - 384 : j0));     \
                P.src = i_win + (size_t)l * D * INC + (size_t)kb * 64 * INC + sc; P.ldw = INC; P.gk = i_g + (size_t)l * D + kb * 64; P.dst = (unsigned char*)(WIN + (size_t)l * INC * D + (size_t)j0 * D + kb * 64); P.ldo = D * 2; } \
            else if ((r -= I_IN) < I_OUT) { const int kb = r / 32, nb = r % 32; P.src = i_wout + (size_t)l * D * D + (size_t)kb * 64 * D + nb * 32; P.ldw = D; P.dst = (unsigned char*)(WOUT + (size_t)l * D * D + (size_t)nb * 32 * D + kb * 64); P.ldo = D * 2; } \
            else if ((r -= I_OUT) < I_GU) { const int which = r / (16 * 256), e = (r / 256) % 16, q = r % 256, kb = q / 16, nb = q % 16, n0 = nb * 32;     \
                P.src = (which ? i_wu : i_wg) + ((size_t)l * NE + e) * D * DE + (size_t)kb * 64 * DE + n0; P.ldw = DE; P.fp8 = 1; \
                P.dst = (unsigned char*)WGU + ((size_t)l * NE + e) * 1024 * 1024 + (size_t)((n0 / 128) * 256 + which * 128 + (n0 % 128)) * 1024 + kb * 64; P.ldo = 1024; } \
            else if ((r -= I_GU) < I_D8) { const int e = r / 256, q = r % 256, kb = q / 32, nb = q % 32;        \
                P.src = i_wd + ((size_t)l * NE + e) * DE * D + (size_t)kb * 64 * D + nb * 32; P.ldw = D; P.fp8 = 1; P.dst = ws + WS_WD8 + ((size_t)l * NE + e) * 1024 * 512 + (size_t)nb * 32 * 512 + kb * 64; P.ldo = 512; } \
            else if ((r -= I_D8) < I_GLU) { const int kb = r / 8, nb = r % 8; P.src = i_glu + (size_t)l * CW * CW + (size_t)kb * 64 * CW + nb * 32; P.ldw = CW; P.dst = (unsigned char*)((bf16_t*)(ws + WS_WGLU) + (size_t)l * CW * CW + (size_t)nb * 32 * CW + kb * 64); P.ldo = CW * 2; } \
            else { r -= I_GLU; const int gate = r / 12, h = (r / 2) % 6, nb = r & 1; \
                P.src = (gate ? i_ig : i_rg) + ((size_t)l * 6 + h) * 64 * 64 + nb * 32; P.ldw = 64; P.dst = (unsigned char*)((bf16_t*)(ws + WS_WRG) + (((size_t)l * 2 + gate) * 6 + h) * 64 * 64 + (size_t)nb * 32 * 64); P.ldo = 64 * 2; } } while (0)
        { TrP Pa, Pb; float va[32], vb[32]; int it = gw;
          if (it < 2 * I_L) { TR_DECODE(Pa, it); tr_load(Pa, lane, va); }
#pragma unroll 1
          while (it < 2 * I_L) {
              const int it1 = it + NGW; if (it1 < 2 * I_L) { TR_DECODE(Pb, it1); tr_load(Pb, lane, vb); }
              tr_store(Pa, lane, va, scr);
              if (it1 >= 2 * I_L) break;
              const int it2 = it1 + NGW; if (it2 < 2 * I_L) { TR_DECODE(Pa, it2); tr_load(Pa, lane, va); }
              tr_store(Pb, lane, vb, scr);
              it = it2; } }
#undef TR_DECODE
        { const float* s_are = INP(13); const float* s_aim = INP(14); const float* s_ldt = INP(15); const float* s_bre = INP(16); const float* s_bim = INP(17); const float* s_cre = INP(18); const float* s_cim = INP(19); const float* s_d = INP(20);
          for (size_t e = gt; e < (size_t)2 * CG * 256; e += NGT) { const int l = (int)(e / (CG * 256)), g = (int)((e / 256) % CG), c = (int)((e >> 4) & 15), cp = (int)(e & 15);
              s5_kt_pair(g, c, cp, s_are + (size_t)l * CG * CS, s_aim + (size_t)l * CG * CS, s_ldt + (size_t)l * CG, s_bre + (size_t)l * CG * CS * CGD, s_bim + (size_t)l * CG * CS * CGD,
                         s_cre + (size_t)l * CG * CGD * CS, s_cim + (size_t)l * CG * CGD * CS, s_d + (size_t)l * CW, ws + WS_S5 + (size_t)l * S5_L_STRIDE); }
          for (size_t e = gt; e < (size_t)2 * CG * 2048; e += NGT) { const int l = (int)(e / (CG * 2048)), g = (int)((e / 2048) % CG), r = (int)(e & 2047);
              s5_et_task(g, r >> 10, (r >> 4) & 63, r & 15, s_are + (size_t)l * CG * CS, s_aim + (size_t)l * CG * CS, s_ldt + (size_t)l * CG, s_bre + (size_t)l * CG * CS * CGD, s_bim + (size_t)l * CG * CS * CGD, ws + WS_S5 + (size_t)l * S5_L_STRIDE);
              s5_ft_task(g, r >> 7, (r >> 6) & 1, r & 63, s_are + (size_t)l * CG * CS, s_aim + (size_t)l * CG * CS, s_ldt + (size_t)l * CG, s_cre + (size_t)l * CG * CGD * CS, s_cim + (size_t)l * CG * CGD * CS, ws + WS_S5 + (size_t)l * S5_L_STRIDE); }
          for (size_t e = gt; e < (size_t)2 * CG * 64; e += NGT) { const int l = (int)(e / (CG * 64)), g = (int)((e / 64) % CG), el = 4096 + 32768 + (int)(e % 64);
              s5_table_elem(g, el, s_are + (size_t)l * CG * CS, s_aim + (size_t)l * CG * CS, s_ldt + (size_t)l * CG, s_bre + (size_t)l * CG * CS * CGD, s_bim + (size_t)l * CG * CS * CGD,
                            s_cre + (size_t)l * CG * CGD * CS, s_cim + (size_t)l * CG * CGD * CS, s_d + (size_t)l * CW, ws + WS_S5 + (size_t)l * S5_L_STRIDE); } }
        { const float* sw = INP(4); bf16_t* wsp = (bf16_t*)(ws + WS_WSP); for (size_t e = gt; e < (size_t)2 * 6 * 128 * 128; e += NGT) wsp[e] = f2bf(sw[e]); }
        { const float* fg = INP(25); const float* rgw = INP(26); const float* rew = INP(28); bf16_t* wrt = (bf16_t*)(ws + WS_WRT);
          for (size_t e = gt; e < (size_t)2 * 48 * D; e += NGT) { const int l = (int)(e / (48 * D)), n = (int)((e / D) % 48), k = (int)(e % D);
              int j = -1, lo = 0; if (n < 16) j = n; else if (n < 32) { j = n - 16; lo = 1; } else if (n < 36) j = 16 + (n - 32); else if (n < 40) { j = 16 + (n - 36); lo = 1; }
              float v = 0.f;
              if (j >= 0) { const float w = fg[(size_t)l * D + k] * (j < 4 ? rgw[((size_t)l * D + k) * 4 + j] : rew[(((size_t)l * 4 + ((j - 4) >> 2)) * D + k) * 4 + ((j - 4) & 3)]);
                  const float hi = bf2f(f2bf(w)); v = lo ? (w - hi) : w; }
              wrt[e] = f2bf(v); } }
        const float* xin = INP(0);
#pragma unroll 1
        for (int t = gw * 2; t < T; t += NGW * 2) {
            const f32x4* xr = (const f32x4*)(xin + (size_t)t * D) + lane; f32x4 v[2][4]; float s0 = 0.f, s1 = 0.f;
#pragma unroll
            for (int j = 0; j < 4; ++j) { v[0][j] = xr[64 * j]; v[1][j] = xr[256 + 64 * j]; }
#pragma unroll
            for (int j = 0; j < 4; ++j) { s0 += (v[0][j][0] * v[0][j][0] + v[0][j][1] * v[0][j][1]) + (v[0][j][2] * v[0][j][2] + v[0][j][3] * v[0][j][3]); s1 += (v[1][j][0] * v[1][j][0] + v[1][j][1] * v[1][j][1]) + (v[1][j][2] * v[1][j][2] + v[1][j][3] * v[1][j][3]); }
            u32x2* o8 = (u32x2*)(HB + (size_t)t * D) + lane;
#pragma unroll
            for (int j = 0; j < 4; ++j) { u32x2 w; w.x = cvt_pk_bf16(v[0][j][0], v[0][j][1]); w.y = cvt_pk_bf16(v[0][j][2], v[0][j][3]); o8[64 * j] = w; w.x = cvt_pk_bf16(v[1][j][0], v[1][j][1]); w.y = cvt_pk_bf16(v[1][j][2], v[1][j][3]); o8[256 + 64 * j] = w; }
            s0 = wave_sum(s0); s1 = wave_sum(s1);
            if (lane < 32) SSQ[(size_t)t * 16 + lane] = lane == 0 ? s0 : (lane == 16 ? s1 : 0.f);
        }
    }
    xcd_barrier(bar);

    for (int l = 0; l < DEPTH; ++l) {
        { PHASE_IDS(); unsigned char* ws = WSB(); bf16_t* WIN = (bf16_t*)(ws + WS_WIN); bf16_t* HB = (bf16_t*)(ws + WS_HB); float* SSQ = (float*)(ws + WS_SSQ); bf16_t* Z = (bf16_t*)(ws + WS_Z);
          pg8::StaticOrder<T, INC> S; S.init(HB, WIN + (size_t)l * INC * D, G, bid);
          pg8::EpiZ E{Z, SSQ};
          pg8::gemm_phase<pg8::EpiZ, pg8::StaticOrder<T, INC>, true, true>(lds, wave_s, S, E); }
        xcd_barrier(bar);

        {
            PHASE_IDS(); unsigned char* ws = WSB(); const bf16_t* Z = (const bf16_t*)(ws + WS_Z);
            const float* conv_w = INP(6) + (size_t)l * 4 * BW; const float* conv_b = INP(7) + (size_t)l * BW; const float* rg_b = INP(9) + (size_t)l * BW;
            const float* ig_b = INP(11) + (size_t)l * BW; const float* lam = INP(12) + (size_t)l * BW;
            __syncthreads();
            { const bf16_t* WRG = (const bf16_t*)(ws + WS_WRG) + ((size_t)l * 2 + 0) * 6 * 4096; const bf16_t* WIG = (const bf16_t*)(ws + WS_WRG) + ((size_t)l * 2 + 1) * 6 * 4096;
              for (int pr = bid; pr < NU128 / 2; pr += G) { float cp = 0.f;
                  rglru_unit<1>(2 * pr, true, cp, tid, wave, lane, Z, nullptr, WRG, WIG, conv_w, conv_b, rg_b, ig_b, lam, nullptr, (float*)(ws + WS_SUMA), (float*)(ws + WS_SUMH), (float*)(ws + WS_SUMA2), (float*)(ws + WS_SUMH2), (bf16_t*)(ws + WS_HL), (bf16_t*)(ws + WS_PP), lds);
                  rglru_unit<1>(2 * pr + 1, false, cp, tid, wave, lane, Z, nullptr, WRG, WIG, conv_w, conv_b, rg_b, ig_b, lam, nullptr, (float*)(ws + WS_SUMA), (float*)(ws + WS_SUMH), (float*)(ws + WS_SUMA2), (float*)(ws + WS_SUMH2), (bf16_t*)(ws + WS_HL), (bf16_t*)(ws + WS_PP), lds); } }
            for (int pr = bid; pr < NU128 / 2; pr += G) { float k0r = 0.f, k0i = 0.f, k1r = 0.f, k1i = 0.f; const unsigned char* tab = ws + WS_S5 + (size_t)l * S5_L_STRIDE;
#pragma unroll 1
                for (int ui = 0; ui < 2; ++ui) { s5_group<1>(2 * pr + ui, 2 * wave, ui == 0, k0r, k0i, wave, lane, Z, (bf16_t*)(ws + WS_Y), tab, (float*)(ws + WS_SEND), (float*)(ws + WS_SEND2), (float*)(ws + WS_SE), lds);
                                                 s5_group<1>(2 * pr + ui, 2 * wave + 1, ui == 0, k1r, k1i, wave, lane, Z, (bf16_t*)(ws + WS_Y), tab, (float*)(ws + WS_SEND), (float*)(ws + WS_SEND2), (float*)(ws + WS_SE), lds); } }
            __syncthreads();
            { const bf16_t* WSP = (const bf16_t*)(ws + WS_WSP) + (size_t)l * 6 * 128 * 128; const float* a_sb = INP(5) + (size_t)l * 6 * 128; const float* vg = INP(3) + (size_t)l * AW; const float* mo_ga = INP(23) + (size_t)l * D;
              for (int u = bid; u < NU128; u += G) mixa_unit(u, tid, wave, lane, Z, (bf16_t*)(ws + WS_Y), WSP, a_sb, vg, mo_ga, lds); }
        }
        xcd_barrier(bar);

        {
            PHASE_IDS(); unsigned char* ws = WSB(); const bf16_t* Z = (const bf16_t*)(ws + WS_Z); bf16_t* Y = (bf16_t*)(ws + WS_Y);
            const float* a_v_norm_g = INP(3) + (size_t)l * AW; const float* a_sw = INP(4) + (size_t)l * 6 * 128 * 128; const float* a_sb = INP(5) + (size_t)l * 6 * 128;
        }

        { PHASE_IDS(); unsigned char* ws = WSB(); const bf16_t* Z = (const bf16_t*)(ws + WS_Z); bf16_t* Y = (bf16_t*)(ws + WS_Y);
          { const float* mo_gb = INP(23) + (size_t)l * D + AW;
            __syncthreads();
            for (int pr = bid; pr < NU128 / 2; pr += G) rglru_fix_pair(pr, tid, wave, lane, Z, Y, (const bf16_t*)(ws + WS_HL), (const bf16_t*)(ws + WS_PP), (const float*)(ws + WS_SUMA2), (const float*)(ws + WS_SUMH2), mo_gb, lds); }
          { const bf16_t* WGLU = (const bf16_t*)(ws + WS_WGLU) + (size_t)l * CW * CW; const float* glu_b = INP(22) + (size_t)l * CW; const float* mo_gc = INP(23) + (size_t)l * D + AW + BW;
            for (int pr = bid; pr < NU128 / 2; pr += G) { float k0r = 0.f, k0i = 0.f, k1r = 0.f, k1i = 0.f; const unsigned char* tab = ws + WS_S5 + (size_t)l * S5_L_STRIDE;
#pragma unroll 1
                for (int ui = 0; ui < 2; ++ui) { const int u = 2 * pr + ui; __syncthreads();
                    s5_group<2>(u, 2 * wave, ui == 0, k0r, k0i, wave, lane, Z, Y, tab, (float*)(ws + WS_SEND), (float*)(ws + WS_SEND2), (float*)(ws + WS_SE), lds);
                    s5_group<2>(u, 2 * wave + 1, ui == 0, k1r, k1i, wave, lane, Z, Y, tab, (float*)(ws + WS_SEND), (float*)(ws + WS_SEND2), (float*)(ws + WS_SE), lds);
                    __syncthreads(); s5_glu(u, wave, lane, WGLU, glu_b, mo_gc, Y, lds); } } } }
        xcd_barrier(bar);

        { PHASE_IDS(); unsigned char* ws = WSB(); bf16_t* WOUT = (bf16_t*)(ws + WS_WOUT); bf16_t* HB = (bf16_t*)(ws + WS_HB); float* SSQ = (float*)(ws + WS_SSQ); bf16_t* Y = (bf16_t*)(ws + WS_Y);
          pg8::StaticOrder<T, D> S; S.init(Y, WOUT + (size_t)l * D * D, G, bid);
          pg8::EpiRes<false> E{HB, SSQ, nullptr};
          pg8::gemm_phase<pg8::EpiRes<false>, pg8::StaticOrder<T, D>, true, true>(lds, wave_s, S, E); }
        xcd_barrier(bar);

        { PHASE_IDS(); unsigned char* ws = WSB(); const bf16_t* HB = (const bf16_t*)(ws + WS_HB); const float* SSQ = (const float*)(ws + WS_SSQ); int* CLS = (int*)(ws + WS_CLS); float* G2 = (float*)(ws + WS_G2); int* HIST = (int*)(ws + WS_HIST);
          const float* rgb = INP(27) + (size_t)l * 4; const float* reb = INP(29) + (size_t)l * 16;
        if (l == 0) {
            for (int rr = gw; rr < 2 * NCLS * 2 * 1024 / 2; rr += NGW) { const int row = 2 * rr + (lane >> 5), n = row & 1023, half = (row >> 10) & 1, cls = (row >> 11) % NCLS, ll = row / (2048 * NCLS);
                const int g = cls / 6, pi = cls % 6, e = g * 4 + (half ? pair_hi(pi) : pair_lo(pi));
                const u32x4 v = *(const u32x4*)(ws + WS_WD8 + ((size_t)ll * NE + e) * 1024 * 512 + (size_t)n * 512 + (lane & 31) * 16);
                *(u32x4*)(ws + WS_WD2 + ((size_t)ll * NCLS + cls) * 1024 * 1024 + (size_t)n * 1024 + half * 512 + (lane & 31) * 16) = v; } }
        for (int u = bid; u < NU; u += G) {
            router_unit(u, wave, lane, HB, SSQ, (const bf16_t*)(ws + WS_WRT) + (size_t)l * 48 * D, rgb, reb, CLS, G2, lds, (LAS int*)(lds + LDSCTL_OFF) + LW_HIST);
            __syncthreads();
            if (tid < 32) { HIST[u * 32 + tid] = tid < NCLS ? LWI[LW_HIST + tid] : 0; LWI[LW_HIST + tid] = 0; }
            __syncthreads();
        } }
        xcd_barrier(bar);

        { PHASE_IDS(); unsigned char* ws = WSB(); const bf16_t* HB = (const bf16_t*)(ws + WS_HB); const float* SSQ = (const float*)(ws + WS_SSQ); const int* CLS = (const int*)(ws + WS_CLS); const float* G2 = (const float*)(ws + WS_G2); const int* HIST = (const int*)(ws + WS_HIST);
          int* CTOT = (int*)(ws + WS_CTOT); int* ROWTOK = (int*)(ws + WS_ROWTOK); float* ROWG = (float*)(ws + WS_ROWG); bf16_t* HBS = (bf16_t*)(ws + WS_HBS); const float* ffn_g = INP(25) + (size_t)l * D;
        for (int u = bid; u < NU; u += G) {
            { const int c = tid & 31, part = tid >> 5; int tot = 0, pre = 0;
_Pragma("unroll 16")
              for (int k = part * 16; k < part * 16 + 16; ++k) { const int v = HIST[k * 32 + c]; tot += v; pre += k < u ? v : 0; }
              ((volatile LAS int*)lds)[tid] = tot; ((volatile LAS int*)lds)[512 + tid] = pre; }
            __syncthreads();
            if (tid < NCLS) { int tot = 0, pre = 0;
_Pragma("unroll")
                for (int k = 0; k < 16; ++k) { tot += ((volatile LAS int*)lds)[k * 32 + tid]; pre += ((volatile LAS int*)lds)[512 + k * 32 + tid]; } LWI[LW_TOT + tid] = tot; LWI[LW_BASE + tid] = pre; }
            __syncthreads();
            if (tid == 0) { int ps = 0;
_Pragma("unroll 1")
                for (int c = 0; c < NCLS; ++c) { const int tot = LWI[LW_TOT + c]; LWI[LW_BASE + c] += ps; LWI[LW_TST + c] = ps; ps += ((tot + 255) >> 8) << 8; if (bid == 0) CTOT[c] = tot; } LWI[LW_TST + NCLS] = ps; }
            if (tid < UT) LWI[LW_CLS + tid] = CLS[u * UT + tid];
            __syncthreads();
            if (tid < UT) { const int cls = LWI[LW_CLS + tid]; int rank = 0;
_Pragma("unroll 1")
                for (int i = 0; i < tid; ++i) rank += LWI[LW_CLS + i] == cls ? 1 : 0;
                const int dest = LWI[LW_BASE + cls] + rank; LWI[LW_DEST + tid] = dest; const int t = u * UT + tid;
                ROWTOK[dest] = t; ROWG[(size_t)dest * 2 + 0] = G2[(size_t)t * 2 + 0]; ROWG[(size_t)dest * 2 + 1] = G2[(size_t)t * 2 + 1]; }
            __syncthreads();
            { f32x4 gq[4];
#pragma unroll
              for (int j = 0; j < 4; ++j) gq[j] = *(const f32x4*)(ffn_g + lane * 16 + 4 * j);
#pragma unroll 1
              for (int i = 0; i < 32; i += 4) {
                  const int tl0 = wave * 32 + i, t0r = u * UT + tl0;
                  float sq = SSQ[(size_t)t0r * 16 + lane]; sq += x_xor1(sq); sq += x_xor2(sq); sq += x_hmir(sq); sq += x_mir(sq);
                  u32x4 o[4][2]; int dst[4];
#pragma unroll
                  for (int j = 0; j < 4; ++j) { o[j][0] = *(const u32x4*)(HB + (size_t)(t0r + j) * D + lane * 16); o[j][1] = *(const u32x4*)(HB + (size_t)(t0r + j) * D + lane * 16 + 8); dst[j] = LWI[LW_DEST + tl0 + j]; }
#pragma unroll
                  for (int j = 0; j < 4; ++j) { const float r4 = rsqrtf(__builtin_amdgcn_readlane(sq, 16 * j) * (1.0f / D) + EPS) * pg8::FS_H; u32x4 w;
#pragma unroll
                      for (int hh = 0; hh < 2; ++hh) { const u32x4 oo = o[j][hh]; const f32x4 g0 = gq[2 * hh], g1 = gq[2 * hh + 1];
                          const unsigned lo = pk_fp8x4(__uint_as_float(oo.x << 16) * r4 * g0[0], __uint_as_float(oo.x & 0xffff0000u) * r4 * g0[1], __uint_as_float(oo.y << 16) * r4 * g0[2], __uint_as_float(oo.y & 0xffff0000u) * r4 * g0[3]);
                          const unsigned hi = pk_fp8x4(__uint_as_float(oo.z << 16) * r4 * g1[0], __uint_as_float(oo.z & 0xffff0000u) * r4 * g1[1], __uint_as_float(oo.w << 16) * r4 * g1[2], __uint_as_float(oo.w & 0xffff0000u) * r4 * g1[3]);
                          if (hh == 0) { w.x = lo; w.y = hi; } else { w.z = lo; w.w = hi; } }
                      *(u32x4*)((unsigned char*)HBS + (size_t)dst[j] * D + lane * 16) = w; } } }
            if (u == bid)
_Pragma("unroll 1")
            for (int c = bid; c < NCLS; c += G) { const int tot = LWI[LW_TOT + c], r0 = LWI[LW_TST + c] + tot, r1 = LWI[LW_TST + c + 1];
                unsigned zz = 0u; asm volatile("" : "+v"(zz));
                for (int r = r0 + wave; r < r1; r += 8) { if (lane == 0) { ROWTOK[r] = -1; ROWG[(size_t)r * 2] = __uint_as_float(zz); ROWG[(size_t)r * 2 + 1] = __uint_as_float(zz); }
                    *(u32x4*)((unsigned char*)HBS + (size_t)r * D + lane * 16) = (u32x4){zz, zz, zz, zz}; } }
            __syncthreads();
        } }
        xcd_barrier(bar);

        { PHASE_IDS(); unsigned char* ws = WSB(); const int* CTOT = (const int*)(ws + WS_CTOT); bf16_t* HBS = (bf16_t*)(ws + WS_HBS); bf16_t* WGU = (bf16_t*)(ws + WS_WGU); bf16_t* ACT = (bf16_t*)(ws + WS_ACT); const float* ROWG = (const float*)(ws + WS_ROWG);
        if (tid == 0) { int ps = 0;
_Pragma("unroll 1")
            for (int c = 0; c < NCLS; ++c) { LWI[LW_TST + c] = ps; ps += (CTOT[c] + 255) >> 8; } LWI[LW_TST + NCLS] = ps; }
        __syncthreads();
        if (tid < 32) { const int ntile = LWI[LW_TST + NCLS]; const long L = (long)tid * G + bid; int e = -1;
            if (L < (long)ntile * 8) { const int mt = (int)(L / 8), pn = (int)(L % 8); int cls = 0;
_Pragma("unroll 1")
                for (int k = 1; k < NCLS; ++k) cls += (LWI[LW_TST + k] <= mt) ? 1 : 0;
                e = (cls << 24) | (pn << 16) | mt; }
            LWI[LW_UTAB + tid] = e; e = -1;
            if (L < (long)ntile * 4) { const int mt = (int)(L / 4), pn = (int)(L % 4); int cls = 0;
_Pragma("unroll 1")
                for (int k = 1; k < NCLS; ++k) cls += (LWI[LW_TST + k] <= mt) ? 1 : 0;
                e = (cls << 24) | (pn << 16) | mt; }
            LWI[LW_DTAB + tid] = e; }
        __syncthreads();
        { pg8::MoeOrder<8, true, 1024> S{LWI + LW_UTAB, l, (const char*)HBS, (const char*)WGU};
          pg8::EpiUp E{(unsigned char*)ACT, ROWG};
          pg8::gemm_phase<pg8::EpiUp, pg8::MoeOrder<8, true, 1024>, true, true, 512, true>(lds, wave_s, S, E); } }
        xcd_barrier(bar);

        { PHASE_IDS(); unsigned char* ws = WSB(); bf16_t* ACT = (bf16_t*)(ws + WS_ACT); bf16_t* WD2 = (bf16_t*)(ws + WS_WD2); bf16_t* HB = (bf16_t*)(ws + WS_HB); float* SSQ = (float*)(ws + WS_SSQ); const int* ROWTOK = (const int*)(ws + WS_ROWTOK);
          pg8::MoeOrder<4, false, 1024> S{LWI + LW_DTAB, l, (const char*)ACT, (const char*)WD2};
          pg8::EpiRes<true> E{HB, SSQ, ROWTOK};
          pg8::gemm_phase<pg8::EpiRes<true>, pg8::MoeOrder<4, false, 1024>, true, true, 512, true>(lds, wave_s, S, E); }
        xcd_barrier(bar);
    }

    { PHASE_IDS(); unsigned char* ws = WSB(); const bf16_t* HB = (const bf16_t*)(ws + WS_HB); const float* SSQ = (const float*)(ws + WS_SSQ); const float* fg = INP(33); float* outp = a.out;
    { f32x4 gq[4];
#pragma unroll
      for (int j = 0; j < 4; ++j) gq[j] = *(const f32x4*)(fg + lane * 16 + 4 * j);
#pragma unroll 1
      for (int t0r = gw * 4; t0r < T; t0r += NGW * 4) {
          float sq = SSQ[(size_t)t0r * 16 + lane]; sq += x_xor1(sq); sq += x_xor2(sq); sq += x_hmir(sq); sq += x_mir(sq);
          u32x4 o[4][2];
#pragma unroll
          for (int j = 0; j < 4; ++j) { o[j][0] = *(const u32x4*)(HB + (size_t)(t0r + j) * D + lane * 16); o[j][1] = *(const u32x4*)(HB + (size_t)(t0r + j) * D + lane * 16 + 8); }
#pragma unroll
          for (int j = 0; j < 4; ++j) { const float r = rsqrtf(__builtin_amdgcn_readlane(sq, 16 * j) * (1.0f / D) + EPS); float* orow = outp + (size_t)(t0r + j) * D + lane * 16;
#pragma unroll
              for (int hh = 0; hh < 2; ++hh) { const u32x4 oo = o[j][hh]; const f32x4 g0 = gq[2 * hh], g1 = gq[2 * hh + 1]; f32x4 w0, w1;
                  w0[0] = __uint_as_float(oo.x << 16) * r * g0[0]; w0[1] = __uint_as_float(oo.x & 0xffff0000u) * r * g0[1]; w0[2] = __uint_as_float(oo.y << 16) * r * g0[2]; w0[3] = __uint_as_float(oo.y & 0xffff0000u) * r * g0[3];
                  w1[0] = __uint_as_float(oo.z << 16) * r * g1[0]; w1[1] = __uint_as_float(oo.z & 0xffff0000u) * r * g1[1]; w1[2] = __uint_as_float(oo.w << 16) * r * g1[2]; w1[3] = __uint_as_float(oo.w & 0xffff0000u) * r * g1[3];
                  *(f32x4*)(orow + 8 * hh) = w0; *(f32x4*)(orow + 8 * hh + 4) = w1; } } } }
}
}

extern "C" void kernel_launch(void* const* d_in, const int* in_sizes, int n_in, void* d_out, int out_size, void* d_ws, size_t ws_size, hipStream_t stream) {
    static int grid = 0;
    if (grid == 0) {
        if (n_in != 34 || in_sizes[0] != T * D || out_size != T * D || ws_size < WS_END) { fprintf(stderr, "kernel_launch: unexpected shapes (n_in %d, ws %zu)\n", n_in, ws_size); grid = -1; return; }
        int dev = 0, cus = 0, per_cu = 0;
        if (hipGetDevice(&dev) != hipSuccess || hipDeviceGetAttribute(&cus, hipDeviceAttributeMultiprocessorCount, dev) != hipSuccess) { grid = -1; return; }
        if (hipFuncSetAttribute((const void*)mega_fwd, hipFuncAttributeMaxDynamicSharedMemorySize, LDS_BYTES) != hipSuccess) { fprintf(stderr, "kernel_launch: hipFuncSetAttribute failed\n"); grid = -1; return; }
        if (hipOccupancyMaxActiveBlocksPerMultiprocessor(&per_cu, (const void*)mega_fwd, 512, LDS_BYTES) != hipSuccess || per_cu < 1) { fprintf(stderr, "kernel_launch: occupancy query says %d\n", per_cu); }
        (void)hipGetLastError();
        grid = cus;
    }
    if (grid < 0) return;
    (void)hipMemsetAsync((char*)d_ws + WS_CTL, 0, CTL_ZERO_BYTES, stream);
    Args a{};
    for (int i = 0; i < 34; ++i) a.in[i] = (const float*)d_in[i];
    a.out = (float*)d_out; a.ws = (unsigned char*)d_ws;
    hipLaunchKernelGGL(mega_fwd, dim3(grid), dim3(512), LDS_BYTES, stream, a);
}
```

```cpp
#include <hip/hip_runtime.h>
#include <cstdio>
#include <cstdint>

#define LAS __attribute__((address_space(3)))
typedef unsigned short bf16_t;
typedef short bf16x8 __attribute__((ext_vector_type(8)));
typedef float f32x4 __attribute__((ext_vector_type(4)));
typedef float f32x2 __attribute__((ext_vector_type(2)));
typedef unsigned u32x4 __attribute__((ext_vector_type(4)));
typedef unsigned u32x2 __attribute__((ext_vector_type(2)));
typedef int i32x4 __attribute__((ext_vector_type(4)));
typedef int i32x8 __attribute__((ext_vector_type(8)));

constexpr int D = 1024, BATCH = 8, SEQ = 8192, T = BATCH * SEQ, DEPTH = 2;
constexpr int AW = 384, BW = 384, CW = 256, HD = 64, ABLK = 128, CHUNK = 64;
constexpr int INC = 1792;
constexpr int ZU = 0, ZV = 384, ZG = 768, ZX = 1152, ZC = 1536, ZGELU_END = 1152;
constexpr int CG = 16, CGD = 16, CS = 64;
constexpr int NE = 16, DE = 512, NCLS = 24;
constexpr float EPS = 1e-6f;
constexpr int UT = 256;
constexpr int NU = T / UT;
constexpr int MAXROWS = T + NCLS * 256;

constexpr size_t MiB = 1u << 20;
constexpr size_t WS_CTL = 0, CTL_ZERO_BYTES = 1 * MiB;
constexpr size_t WS_WIN = 2 * MiB;
constexpr size_t WS_WOUT = 10 * MiB;
constexpr size_t WS_WGLU = 14 * MiB;
constexpr size_t WS_WRG = 15 * MiB;
constexpr size_t WS_WSP = 15 * MiB + 256 * 1024;
constexpr size_t WS_WRT = 15 * MiB + 768 * 1024;
constexpr size_t WS_WGU = 16 * MiB;
constexpr size_t WS_WD8 = 48 * MiB;
constexpr size_t WS_WD2 = 80 * MiB;
constexpr size_t WS_SSQ = 176 * MiB;
constexpr size_t WS_RS = 180 * MiB;
constexpr size_t WS_CLS = WS_RS + 256 * 1024;
constexpr size_t WS_G2 = WS_CLS + 256 * 1024;
constexpr size_t WS_HIST = 181 * MiB;
constexpr size_t WS_CTOT = WS_HIST + 64 * 1024;
constexpr size_t WS_ROWTOK = WS_HIST + 256 * 1024;
constexpr size_t WS_ROWG = 182 * MiB;
constexpr size_t WS_SUMA = 183 * MiB;
constexpr size_t WS_SUMH = 191 * MiB;
constexpr size_t WS_S5 = 184 * MiB;
constexpr size_t WS_SEND = 187 * MiB;
constexpr size_t WS_HB = 192 * MiB;
constexpr size_t WS_Z = 320 * MiB;
constexpr size_t WS_HBS = WS_Z;
constexpr size_t WS_Y = 544 * MiB;
constexpr size_t WS_ACT = 672 * MiB;
constexpr size_t WS_HL = 672 * MiB;
constexpr size_t WS_PP = 736 * MiB;
constexpr size_t WS_SE = 800 * MiB;
constexpr size_t WS_AV = 672 * MiB;
constexpr size_t WS_BV = 768 * MiB;
constexpr size_t WS_SEND2 = 864 * MiB;
constexpr size_t WS_SUMA2 = 866 * MiB;
constexpr size_t WS_SUMH2 = 867 * MiB;
constexpr size_t WS_END = 868 * MiB;
constexpr int CW_BAR = 4096;

constexpr int RING_BYTES = 131072;
constexpr int LDSCTL_OFF = 143360;
constexpr int LDS_BYTES = 147456;
constexpr int LW_BAR = 8, LW_TST = 64, LW_HIST = 96, LW_TOT = 128, LW_BASE = 160, LW_CLS = 256  , LW_DEST = 512  , LW_UTAB = 768  , LW_DTAB = 800  ;

__device__ __forceinline__ float bf2f(bf16_t v) { return __uint_as_float(((unsigned)v) << 16); }
__device__ __forceinline__ unsigned cvt_pk_bf16(float lo, float hi) { unsigned r; asm volatile("v_cvt_pk_bf16_f32 %0, %1, %2" : "=v"(r) : "v"(lo), "v"(hi)); return r; }
__device__ __forceinline__ bf16_t f2bf(float v) { return (bf16_t)(cvt_pk_bf16(v, 0.f) & 0xffffu); }
__device__ __forceinline__ unsigned pk_fp8x4(float a, float b, float c, float d) {
    a = fminf(fmaxf(a, -448.f), 448.f); b = fminf(fmaxf(b, -448.f), 448.f); c = fminf(fmaxf(c, -448.f), 448.f); d = fminf(fmaxf(d, -448.f), 448.f);
    int r = __builtin_amdgcn_cvt_pk_fp8_f32(a, b, 0, false); r = __builtin_amdgcn_cvt_pk_fp8_f32(c, d, r, true); return (unsigned)r; }
__device__ __forceinline__ int fresh_lane() { unsigned z = 0u; asm volatile("" : "+s"(z)); return (int)__builtin_amdgcn_mbcnt_hi(~0u, __builtin_amdgcn_mbcnt_lo(~0u, z)); }
__device__ __forceinline__ float x_xor1(float v) { return __int_as_float(__builtin_amdgcn_update_dpp(0, __float_as_int(v), 0xB1, 0xf, 0xf, true)); }
__device__ __forceinline__ float x_xor2(float v) { return __int_as_float(__builtin_amdgcn_update_dpp(0, __float_as_int(v), 0x4E, 0xf, 0xf, true)); }
__device__ __forceinline__ float x_hmir(float v) { return __int_as_float(__builtin_amdgcn_update_dpp(0, __float_as_int(v), 0x141, 0xf, 0xf, true)); }
__device__ __forceinline__ float x_mir(float v) { return __int_as_float(__builtin_amdgcn_update_dpp(0, __float_as_int(v), 0x140, 0xf, 0xf, true)); }
__device__ __forceinline__ float x_xor16(float v) { return __int_as_float(__builtin_amdgcn_ds_swizzle(__float_as_int(v), 0x401F)); }
__device__ __forceinline__ float add_xor32(float v) { const auto r = __builtin_amdgcn_permlane32_swap(__float_as_uint(v), __float_as_uint(v), false, false); return __uint_as_float(r[0]) + __uint_as_float(r[1]); }
__device__ __forceinline__ float add_x16_x32(float v) { v += x_xor16(v); return add_xor32(v); }
__device__ __forceinline__ float wave_sum(float v) { v += x_xor1(v); v += x_xor2(v); v += x_hmir(v); v += x_mir(v); v += x_xor16(v); return add_xor32(v); }
__device__ __forceinline__ float gelu_fast(float x) {
    const float u2 = 1.5957691216057308f * (x + 0.044715f * x * x * x);
    const float e = __builtin_amdgcn_exp2f(-1.4426950408889634f * u2);
    return x * __builtin_amdgcn_rcpf(1.0f + e);
}
__device__ __forceinline__ float sigmoid_fast(float x) { return __builtin_amdgcn_rcpf(1.0f + __builtin_amdgcn_exp2f(-1.4426950408889634f * x)); }
__device__ __forceinline__ float sigmoid_f(float x) { return 1.0f / (1.0f + expf(-x)); }
__device__ __forceinline__ int pair_lo(int pi) { return pi < 3 ? 0 : (pi < 5 ? 1 : 2); }
__device__ __forceinline__ int pair_hi(int pi) { return pi < 3 ? pi + 1 : (pi < 5 ? pi - 1 : 3); }
__device__ __forceinline__ int pair_idx(int lo, int hi) { return lo == 0 ? hi - 1 : (lo == 1 ? hi + 1 : 5); }

#define XB_TMO      128
#define XB_XCNT(j)  (256  + 64 * (j))
#define XB_XSUB(j)  (1280 + 64 * (j))
#define XB_XGEN(j)  (2304 + 64 * (j))
#define XB_TOP      3328
#define XB_TOPGEN   3392
#define XCD_BAR_WORDS 3456
#define XB_SPIN_CAP (1u << 18)
__device__ __forceinline__ unsigned xb_ld(unsigned* p)              { return __hip_atomic_load(p, __ATOMIC_RELAXED, __HIP_MEMORY_SCOPE_AGENT); }
__device__ __forceinline__ unsigned xb_add(unsigned* p, unsigned v) { return __hip_atomic_fetch_add(p, v, __ATOMIC_RELAXED, __HIP_MEMORY_SCOPE_AGENT); }
__device__ __forceinline__ unsigned xb_xcc_id() { return (unsigned)__builtin_amdgcn_s_getreg((3 << 11) | 20) & 0xFu; }
#define XB_SPIN(cond, bar) do { unsigned _sp = 0; while (cond) { __builtin_amdgcn_s_sleep(1); \
    if ((++_sp & 255u) == 0u) { if (xb_ld(&(bar)[XB_TMO])) break; if (_sp > XB_SPIN_CAP) { atomicAdd(&(bar)[XB_TMO], 1u); break; } } } } while (0)
struct XcdBarrier { unsigned* bar; unsigned x; volatile LAS unsigned* st; };
__device__ __forceinline__ XcdBarrier xcd_barrier_post(unsigned* bar, volatile LAS unsigned* st) {
    XcdBarrier b; b.bar = bar; b.x = xb_xcc_id(); b.st = st;
    if (threadIdx.x == 0) (void)xb_add(&bar[XB_XCNT(b.x)], 1u);
    return b;
}
__device__ __forceinline__ void xcd_barrier_complete(unsigned* bar, unsigned x, unsigned& nloc, unsigned& nx) {
    const unsigned G = gridDim.x * gridDim.y * gridDim.z;
    unsigned sum, cnt, mine, sp = 0u;
    for (;;) {
        sum = 0u; cnt = 0u; mine = 0u;
#pragma unroll
        for (unsigned j = 0; j < 16; ++j) { const unsigned c = xb_ld(&bar[XB_XCNT(j)]); sum += c; cnt += (c > 0u) ? 1u : 0u; mine = (j == x) ? c : mine; }
        if (sum == G) break;
        __builtin_amdgcn_s_sleep(1);
        if ((++sp & 255u) == 0u) { if (xb_ld(&bar[XB_TMO])) break; if (sp > XB_SPIN_CAP) { atomicAdd(&bar[XB_TMO], 1u); break; } }
    }
    nloc = mine > 0u ? mine : 1u; nx = cnt > 0u ? cnt : 1u;
}
__device__ __forceinline__ void xcd_barrier(const XcdBarrier& b) {
    asm volatile("s_waitcnt vmcnt(0)" ::: "memory");
    __syncthreads();
    if (threadIdx.x == 0) {
        unsigned* bar = b.bar; asm volatile("" : "+s"(bar));
        __builtin_amdgcn_s_waitcnt(0);
        unsigned bx0 = b.x; asm volatile("" : "+s"(bx0));
        unsigned nloc = b.st[0], nx = b.st[1];
        if (nloc == 0u) { xcd_barrier_complete(bar, bx0, nloc, nx); b.st[0] = nloc; b.st[1] = nx; }
        unsigned bx = b.x; asm volatile("" : "+s"(bx));
        const unsigned old = xb_add(&bar[XB_XSUB(bx)], 1u);
        const unsigned gen = old / nloc;
        if (old + 1u == (gen + 1u) * nloc) {
            __builtin_amdgcn_fence(__ATOMIC_RELEASE, "agent");
            asm volatile("s_waitcnt vmcnt(0)" ::: "memory");
            const unsigned og = xb_add(&bar[XB_TOP], 1u);
            const unsigned tg = og / nx;
            if (og + 1u == (tg + 1u) * nx) xb_add(&bar[XB_TOPGEN], 1u);
            else XB_SPIN(xb_ld(&bar[XB_TOPGEN]) == tg, bar);
            __builtin_amdgcn_fence(__ATOMIC_ACQUIRE, "agent");
            xb_add(&bar[XB_XGEN(bx)], 1u);
            asm volatile("s_waitcnt vmcnt(0)" ::: "memory");
        } else {
            XB_SPIN(xb_ld(&bar[XB_XGEN(bx)]) == gen, bar);
            __builtin_amdgcn_fence(__ATOMIC_ACQUIRE, "agent");
            asm volatile("s_waitcnt vmcnt(0)" ::: "memory");
        }
    }
    __syncthreads();
}

namespace pg8 {
#define PG8_LAS __attribute__((address_space(3)))
constexpr int BM = 256, BK = 64, HALF = 128, HTB = HALF * BK * 2, STAGE_BYTES = 8 * HTB, NXCD = 8, WGM = 8;
__host__ __device__ __forceinline__ int lds_byte(int r, int c) { const int st = (r >> 4) * 2 + (c >> 5), rr = r & 15, cc = c & 31, ob = rr * 64 + cc * 2; return st * 1024 + (ob ^ (((ob >> 9) & 1) << 5)); }
__host__ __device__ __forceinline__ void stage_rc(int b, int& R, int& C) { const int st = b / 1024, sb = b % 1024, swz = sb ^ (((sb >> 9) & 1) << 5); R = (st >> 1) * 16 + swz / 64; C = (st & 1) * 32 + (swz % 64) / 2; }
__host__ __device__ __forceinline__ int perm32(int rho) { const int n = rho >> 4, i = rho & 15; return 8 * (i >> 2) + 4 * n + (i & 3); }
struct Unit { int pm, pn; const char* A; const char* B; };

template <int M_, int N_> struct StaticOrder {
    static constexpr int nM = M_ / BM, nN = N_ / BM, nwg = nM * nN; static constexpr size_t tstep = (size_t)BM * 1024 * 2;
    int G, c; const char* A; const char* Bt;
    __device__ void init(const void* A_, const void* Bt_, int G_, int c_) { G = G_; c = c_; A = (const char*)A_; Bt = (const char*)Bt_; }
    __device__ bool next(int i, Unit& u) const {
        const long L = (long)i * G + c; if (L >= nwg) return false;
        int wgid = (int)L; { constexpr int q = nwg / NXCD, r = nwg % NXCD; const int xcd = wgid % NXCD, off = wgid / NXCD; wgid = (xcd < r ? xcd * (q + 1) : r * (q + 1) + (xcd - r) * q) + off; }
        constexpr int nig = WGM * nN; const int gid = wgid / nig, fm = gid * WGM, gsz = (nM - fm) < WGM ? (nM - fm) : WGM;
        u.pm = fm + ((wgid % nig) % gsz); u.pn = (wgid % nig) / gsz; u.A = A + (size_t)u.pm * tstep; u.B = Bt + (size_t)u.pn * tstep; return true;
    }
    __device__ __forceinline__ void a_ready(const Unit&) const {}
    __device__ __forceinline__ void done(const Unit&) const {}
};
template <class Epi, class Sched, bool ALIGN_EPI = false, bool SP2 = false, int KB = 1024, bool FP8 = false>
__device__ __forceinline__ void gemm_phase(PG8_LAS unsigned char* lds, const int wave_s, const Sched& S, const Epi& E) { const int Kdim = 0;
    const int lane = fresh_lane(), wid = wave_s, tid = wid * 64 + lane, wr = wid >> 2, wc = wid & 3, fr = lane & 15, fq = lane >> 4;
    constexpr int K = KB, nt = K / BK; (void)Kdim;
    unsigned voffA, voffB;
    { int R, C; stage_rc(tid * 16, R, C); const int Rb = Epi::PERM ? ((R & ~31) + perm32(R & 31)) : R; voffA = (unsigned)(R * K + C) * 2u; voffB = (unsigned)(Rb * K + C) * 2u; }
    constexpr size_t kstep = (size_t)(BK * 2);
    constexpr size_t hstep = (size_t)HALF * K * 2;
    constexpr size_t tstep = 2 * hstep; (void)tstep;
    const unsigned ldsw = (unsigned)wid * 1024u; const unsigned ldsb = (unsigned)(size_t)lds + ldsw;
    const int aoff = lds_byte(wr * 64 + fr, fq * 8), boff = lds_byte(wc * 32 + fr, fq * 8);
#define PG8_SA(b, h) (((b) * 2 + (h)) * HTB)
#define PG8_SB(b, h) ((4 + (b) * 2 + (h)) * HTB)
#define PG8_STAGE(bufoff, gbase, voff) do { _Pragma("unroll") for (int _i = 0; _i < 2; ++_i) { unsigned _keep; \
        asm volatile("s_mov_b32 %0, m0\n\ts_mov_b32 m0, %3\n\ts_nop 0\n\tglobal_load_lds_dwordx4 %1, %2\n\ts_mov_b32 m0, %0" : "=&s"(_keep) \
            : "v"(voff), "s"((const char*)(gbase) + (size_t)_i * (64 * K * 2)), "s"(ldsb + (unsigned)((bufoff) + _i * 8192)) : "memory"); } } while (0)
#define PG8_LDA(dst, b, h) do { if constexpr (FP8) { _Pragma("unroll") for (int m = 0; m < 4; ++m) { const i32x4 _lo = *(const PG8_LAS i32x4*)(lds + PG8_SA(b, h) + aoff + m * 2048), _hi = *(const PG8_LAS i32x4*)(lds + PG8_SA(b, h) + aoff + m * 2048 + 1024); \
            dst##8[m] = __builtin_shufflevector(_lo, _hi, 0, 1, 2, 3, 4, 5, 6, 7); } } \
        else { _Pragma("unroll") for (int m = 0; m < 4; ++m) _Pragma("unroll") for (int k = 0; k < 2; ++k) dst[m][k] = *(const PG8_LAS bf16x8*)(lds + PG8_SA(b, h) + aoff + m * 2048 + k * 1024); } } while (0)
#define PG8_LDB(dst, b, h) do { if constexpr (FP8) { _Pragma("unroll") for (int n = 0; n < 2; ++n) { const i32x4 _lo = *(const PG8_LAS i32x4*)(lds + PG8_SB(b, h) + boff + n * 2048), _hi = *(const PG8_LAS i32x4*)(lds + PG8_SB(b, h) + boff + n * 2048 + 1024); \
            dst##8[n] = __builtin_shufflevector(_lo, _hi, 0, 1, 2, 3, 4, 5, 6, 7); } } \
        else { _Pragma("unroll") for (int n = 0; n < 2; ++n) _Pragma("unroll") for (int k = 0; k < 2; ++k) dst[n][k] = *(const PG8_LAS bf16x8*)(lds + PG8_SB(b, h) + boff + n * 2048 + k * 1024); } } while (0)
#define PG8_MMA(ai, bj, At, Bt) do { __builtin_amdgcn_s_setprio(1); \
        if constexpr (FP8) { _Pragma("unroll") for (int m = 0; m < 4; ++m) _Pragma("unroll") for (int n = 0; n < 2; ++n) \
            acc[ai][bj][m][n] = __builtin_amdgcn_mfma_scale_f32_16x16x128_f8f6f4(Bt##8[n], At##8[m], acc[ai][bj][m][n], 0, 0, 0, Epi::SCALE_W, 0, Epi::SCALE_A); } \
        else { _Pragma("unroll") for (int m = 0; m < 4; ++m) _Pragma("unroll") for (int n = 0; n < 2; ++n) _Pragma("unroll") for (int k = 0; k < 2; ++k) \
            acc[ai][bj][m][n] = __builtin_amdgcn_mfma_f32_16x16x32_bf16(Bt[n][k], At[m][k], acc[ai][bj][m][n], 0, 0, 0); } \
        __builtin_amdgcn_s_setprio(0); } while (0)
#define PG8_WAIT_V(n) asm volatile("s_waitcnt vmcnt(" #n ")" ::: "memory")
#define PG8_WAIT_L(n) asm volatile("s_waitcnt lgkmcnt(" #n ")" ::: "memory")
#define PG8_BAR __builtin_amdgcn_s_barrier()
#define PG8_SCHED __builtin_amdgcn_sched_barrier(0)
    Unit cur, nxt; int ui = 0;
    if (!S.next(0, cur)) return;
    f32x4 acc[2][2][4][2];
#pragma unroll
    for (int a = 0; a < 2; ++a)
#pragma unroll
        for (int b = 0; b < 2; ++b)
#pragma unroll
            for (int m = 0; m < 4; ++m)
#pragma unroll
                for (int n = 0; n < 2; ++n) acc[a][b][m][n] = (f32x4){0.f, 0.f, 0.f, 0.f};
    bf16x8 At[4][2], B0[2][2], B1[2][2]; i32x8 At8[4], B08[2], B18[2]; (void)At; (void)B0; (void)B1; (void)At8; (void)B08; (void)B18;
    const char* cA = cur.A; const char* cB = cur.B;
    S.a_ready(cur);
    if constexpr (SP2) {
        PG8_STAGE(PG8_SB(0, 0), cB, voffB); PG8_STAGE(PG8_SB(0, 1), cB + hstep, voffB); PG8_STAGE(PG8_SA(0, 0), cA, voffA); PG8_STAGE(PG8_SA(0, 1), cA + hstep, voffA);
        if (wr == 1) PG8_BAR;
        PG8_WAIT_V(2); PG8_BAR;
        PG8_STAGE(PG8_SB(1, 0), cB + kstep, voffB); PG8_STAGE(PG8_SA(1, 0), cA + kstep, voffA); PG8_STAGE(PG8_SB(1, 1), cB + hstep + kstep, voffB);
        PG8_WAIT_V(6); PG8_BAR;
    } else {
        PG8_STAGE(PG8_SB(0, 0), cB, voffB); PG8_STAGE(PG8_SA(0, 0), cA, voffA); PG8_STAGE(PG8_SB(0, 1), cB + hstep, voffB); PG8_STAGE(PG8_SA(0, 1), cA + hstep, voffA);
        if (wr == 1) PG8_BAR;
        PG8_WAIT_V(4); PG8_BAR;
        PG8_STAGE(PG8_SB(1, 0), cB + kstep, voffB); PG8_STAGE(PG8_SA(1, 0), cA + kstep, voffA); PG8_STAGE(PG8_SB(1, 1), cB + hstep + kstep, voffB);
        PG8_WAIT_V(6); PG8_BAR;
    }
    for (;;) {
        const bool has_next = S.next(ui + 1, nxt);
        const char* nA = has_next ? nxt.A : cA; const char* nB = has_next ? nxt.B : cB;
_Pragma("unroll 1")
        for (int t = 0; t < nt; t += 2) {
            const bool last = (t == nt - 2);
            const char* a1 = cA + (size_t)(t + 1) * kstep;
            const char* a2 = last ? nA : cA + (size_t)(t + 2) * kstep; const char* b2 = last ? nB : cB + (size_t)(t + 2) * kstep;
            const char* a3 = a2 + kstep; const char* b3 = b2 + kstep;
            if (last && has_next) S.a_ready(nxt);
            if constexpr (SP2) {
            PG8_LDB(B0, 0, 0); PG8_LDB(B1, 0, 1); PG8_SCHED; PG8_LDA(At, 0, 0); PG8_STAGE(PG8_SA(1, 1), a1 + hstep, voffA);
            PG8_WAIT_V(8); PG8_WAIT_L(0); PG8_BAR; PG8_MMA(0, 0, At, B0); PG8_MMA(0, 1, At, B1); PG8_BAR; PG8_SCHED;
            PG8_LDA(At, 0, 1); PG8_STAGE(PG8_SB(0, 0), b2, voffB); PG8_STAGE(PG8_SB(0, 1), b2 + hstep, voffB); PG8_STAGE(PG8_SA(0, 0), a2, voffA);
            PG8_WAIT_V(8); PG8_WAIT_L(0); PG8_BAR; PG8_MMA(1, 0, At, B0); PG8_MMA(1, 1, At, B1); PG8_BAR; PG8_SCHED;
            PG8_LDB(B0, 1, 0); PG8_LDB(B1, 1, 1); PG8_SCHED; PG8_LDA(At, 1, 0); PG8_STAGE(PG8_SA(0, 1), a2 + hstep, voffA);
            PG8_WAIT_V(8); PG8_WAIT_L(0); PG8_BAR; PG8_MMA(0, 0, At, B0); PG8_MMA(0, 1, At, B1); PG8_BAR; PG8_SCHED;
            PG8_LDA(At, 1, 1); PG8_STAGE(PG8_SB(1, 0), b3, voffB); PG8_STAGE(PG8_SB(1, 1), b3 + hstep, voffB); PG8_STAGE(PG8_SA(1, 0), a3, voffA);
            PG8_WAIT_V(8); PG8_WAIT_L(0); PG8_BAR; PG8_MMA(1, 0, At, B0); PG8_MMA(1, 1, At, B1); PG8_BAR; PG8_SCHED;
            } else {
            PG8_LDB(B0, 0, 0); PG8_SCHED; PG8_LDA(At, 0, 0); PG8_STAGE(PG8_SA(1, 1), a1 + hstep, voffA);
            PG8_WAIT_L(8); PG8_BAR; PG8_WAIT_L(0); PG8_MMA(0, 0, At, B0); PG8_BAR; PG8_SCHED;
            PG8_LDB(B1, 0, 1); PG8_STAGE(PG8_SB(0, 0), b2, voffB);
            PG8_BAR; PG8_WAIT_L(0); PG8_MMA(0, 1, At, B1); PG8_BAR;
            PG8_LDA(At, 0, 1); PG8_STAGE(PG8_SA(0, 0), a2, voffA);
            PG8_BAR; PG8_WAIT_L(0); PG8_MMA(1, 0, At, B0); PG8_BAR; PG8_SCHED;
            PG8_STAGE(PG8_SB(0, 1), b2 + hstep, voffB);
            PG8_WAIT_V(6); PG8_BAR; PG8_MMA(1, 1, At, B1); PG8_BAR;
            PG8_LDB(B0, 1, 0); PG8_SCHED; PG8_LDA(At, 1, 0); PG8_STAGE(PG8_SA(0, 1), a2 + hstep, voffA);
            PG8_WAIT_L(8); PG8_BAR; PG8_WAIT_L(0); PG8_MMA(0, 0, At, B0); PG8_BAR; PG8_SCHED;
            PG8_LDB(B1, 1, 1); PG8_STAGE(PG8_SB(1, 0), b3, voffB);
            PG8_BAR; PG8_WAIT_L(0); PG8_MMA(0, 1, At, B1); PG8_BAR;
            PG8_LDA(At, 1, 1); PG8_STAGE(PG8_SA(1, 0), a3, voffA);
            PG8_BAR; PG8_WAIT_L(0); PG8_MMA(1, 0, At, B0); PG8_BAR; PG8_SCHED;
            PG8_STAGE(PG8_SB(1, 1), b3 + hstep, voffB);
            PG8_WAIT_V(6); PG8_BAR; PG8_MMA(1, 1, At, B1); PG8_BAR;
            }
        }
        if constexpr (ALIGN_EPI) { if (wr == 0) PG8_BAR; }
        if constexpr (!Epi::AFTER_DRAIN) { E(acc, cur, wr, wc, fr, fq); S.done(cur); }
        if (!has_next) break;
#pragma unroll
        for (int a = 0; a < 2; ++a)
#pragma unroll
            for (int b = 0; b < 2; ++b)
#pragma unroll
                for (int m = 0; m < 4; ++m)
#pragma unroll
                    for (int n = 0; n < 2; ++n) acc[a][b][m][n] = (f32x4){0.f, 0.f, 0.f, 0.f};
        cur = nxt; cA = nA; cB = nB; ++ui;
        if constexpr (ALIGN_EPI) { if (wr == 1) PG8_BAR; }
    }
    PG8_WAIT_V(0);
    if constexpr (!ALIGN_EPI) { if (wr == 0) PG8_BAR; }
    PG8_BAR;
    if constexpr (Epi::AFTER_DRAIN) { E.fused(acc, cur, wr, wc, fr, fq, lds, wid, lane); S.done(cur); }
#undef PG8_SA
#undef PG8_SB
#undef PG8_STAGE
#undef PG8_LDA
#undef PG8_LDB
#undef PG8_MMA
#undef PG8_WAIT_V
#undef PG8_WAIT_L
#undef PG8_BAR
#undef PG8_SCHED
}

template <int NP, bool UP, int ROWB> struct MoeOrder {
    const volatile LAS int* tab; int layer; const char* A; const char* W;
    __device__ bool next(int i, Unit& u) const {
        const int e = tab[i]; if (e < 0) return false;
        const int mt = e & 0xffff, pn = (e >> 16) & 0xff, cls = e >> 24;
        u.pm = mt; u.pn = pn; u.A = A + (size_t)mt * ((size_t)BM * ROWB);
        if (UP) { const int g = cls / 6, pi = cls % 6, s = pn >> 2, ex = g * 4 + (s ? pair_hi(pi) : pair_lo(pi));
            u.B = W + ((size_t)(layer * NE + ex) * 1024 + (size_t)(pn & 3) * 256) * ROWB; }
        else u.B = W + ((size_t)(layer * NCLS + cls) * 1024 + (size_t)pn * 256) * ROWB;
        return true;
    }
    __device__ __forceinline__ void a_ready(const Unit&) const {}
    __device__ __forceinline__ void done(const Unit&) const {}
};

struct EpiZ {
    static constexpr bool PERM = true, AFTER_DRAIN = false;
    bf16_t* Z; const float* ssq;
    __device__ __forceinline__ void operator()(const f32x4 (&acc)[2][2][4][2], const Unit& u, int wr, int wc, int fr, int fq) const {
        { const int ln_ = fresh_lane(); fr = ln_ & 15; fq = ln_ >> 4; }
        const int row0 = u.pm * BM + wr * 64 + fr, col0 = u.pn * BM + wc * 32 + 8 * fq;
        float rr[2][4];
#pragma unroll
        for (int ai = 0; ai < 2; ++ai) {
            f32x4 sp[4];
#pragma unroll
            for (int m = 0; m < 4; ++m) sp[m] = *(const f32x4*)(ssq + (size_t)(row0 + ai * HALF + m * 16) * 16 + 4 * fq);
#pragma unroll
            for (int m = 0; m < 4; ++m) { float t = (sp[m][0] + sp[m][1]) + (sp[m][2] + sp[m][3]); t = add_x16_x32(t); rr[ai][m] = __builtin_amdgcn_rsqf(t * (1.0f / D) + EPS); }
        }
#pragma unroll
        for (int ai = 0; ai < 2; ++ai)
#pragma unroll
            for (int m = 0; m < 4; ++m) { const int row = row0 + ai * HALF + m * 16; const float r = rr[ai][m];
                bf16_t* rowp = Z + (size_t)row * INC + col0;
#pragma unroll
                for (int bj = 0; bj < 2; ++bj) { f32x4 v0 = acc[ai][bj][m][0] * r, v1 = acc[ai][bj][m][1] * r;
                    u32x4 w; w.x = cvt_pk_bf16(v0[0], v0[1]); w.y = cvt_pk_bf16(v0[2], v0[3]); w.z = cvt_pk_bf16(v1[0], v1[1]); w.w = cvt_pk_bf16(v1[2], v1[3]);
                    *(u32x4*)(rowp + bj * HALF) = w; } }
    }
};
template <bool SCATTER> struct EpiRes {
    static constexpr bool PERM = true, AFTER_DRAIN = false; static constexpr int SCALE_W = 0x7b7b7b7b, SCALE_A = 0x7b7b7b7b;
    bf16_t* H; float* ssq; const int* rowtok;
    __device__ __forceinline__ void operator()(const f32x4 (&acc)[2][2][4][2], const Unit& u, int wr, int wc, int fr, int fq) const {
        { const int ln_ = fresh_lane(); fr = ln_ & 15; fq = ln_ >> 4; }
        const int row0 = u.pm * BM + wr * 64 + fr, col0 = u.pn * BM + wc * 32 + 8 * fq;
        int tokv[2][4];
#pragma unroll
        for (int ai = 0; ai < 2; ++ai)
#pragma unroll
            for (int m = 0; m < 4; ++m) { const int row = row0 + ai * HALF + m * 16; tokv[ai][m] = SCATTER ? rowtok[row] : row; }
#pragma unroll
        for (int ai = 0; ai < 2; ++ai) {
            u32x4 o[4][2];
#pragma unroll
            for (int m = 0; m < 4; ++m) { const int tok = tokv[ai][m]; const bf16_t* rowp = H + (size_t)(tok < 0 ? 0 : tok) * D + col0; o[m][0] = *(const u32x4*)(rowp); o[m][1] = *(const u32x4*)(rowp + HALF); }
#pragma unroll
            for (int m = 0; m < 4; ++m) { const int tok = tokv[ai][m]; float s = 0.f; bf16_t* rowp = H + (size_t)(tok < 0 ? 0 : tok) * D + col0;
#pragma unroll
                for (int bj = 0; bj < 2; ++bj) { const u32x4 oo = o[m][bj];
                    f32x4 v0 = acc[ai][bj][m][0], v1 = acc[ai][bj][m][1];
                    v0[0] += __uint_as_float(oo.x << 16); v0[1] += __uint_as_float(oo.x & 0xffff0000u); v0[2] += __uint_as_float(oo.y << 16); v0[3] += __uint_as_float(oo.y & 0xffff0000u);
                    v1[0] += __uint_as_float(oo.z << 16); v1[1] += __uint_as_float(oo.z & 0xffff0000u); v1[2] += __uint_as_float(oo.w << 16); v1[3] += __uint_as_float(oo.w & 0xffff0000u);
                    s += (v0[0] * v0[0] + v0[1] * v0[1]) + (v0[2] * v0[2] + v0[3] * v0[3]) + (v1[0] * v1[0] + v1[1] * v1[1]) + (v1[2] * v1[2] + v1[3] * v1[3]);
                    u32x4 w; w.x = cvt_pk_bf16(v0[0], v0[1]); w.y = cvt_pk_bf16(v0[2], v0[3]); w.z = cvt_pk_bf16(v1[0], v1[1]); w.w = cvt_pk_bf16(v1[2], v1[3]);
                    if (tok >= 0) *(u32x4*)(rowp + bj * HALF) = w; }
                s = add_x16_x32(s);
                if (fq == 0 && tok >= 0) ssq[(size_t)tok * 16 + u.pn * 4 + wc] = s; }
            asm volatile("" ::: "memory"); }
    }
};
constexpr int SC_W = 0x7b7b7b7b, SC_H = 0x7b7b7b7b, SC_ACT = 0x7b7b7b7b;
constexpr float FS_W = 16.f, FS_H = 16.f, FS_ACT = 16.f;
struct EpiUp {
    static constexpr bool PERM = true, AFTER_DRAIN = false; static constexpr int SCALE_W = SC_W, SCALE_A = SC_H;
    unsigned char* ACT; const float* rowg;
    __device__ __forceinline__ void operator()(const f32x4 (&acc)[2][2][4][2], const Unit& u, int wr, int wc, int fr, int fq) const {
        { const int ln_ = fresh_lane(); fr = ln_ & 15; fq = ln_ >> 4; }
        const int row0 = u.pm * BM + wr * 64 + fr, s = u.pn >> 2, col0 = s * 512 + (u.pn & 3) * 128 + wc * 32 + 8 * fq;
        float gt[2][4];
#pragma unroll
        for (int ai = 0; ai < 2; ++ai)
#pragma unroll
            for (int m = 0; m < 4; ++m) gt[ai][m] = rowg[(size_t)(row0 + ai * HALF + m * 16) * 2 + s];
#pragma unroll
        for (int ai = 0; ai < 2; ++ai)
#pragma unroll
            for (int m = 0; m < 4; ++m) { const int row = row0 + ai * HALF + m * 16; const float g1 = gt[ai][m];
                float o[8];
#pragma unroll
                for (int n = 0; n < 2; ++n)
#pragma unroll
                    for (int j = 0; j < 4; ++j) { const float g = acc[ai][0][m][n][j], up = acc[ai][1][m][n][j]; o[n * 4 + j] = g * sigmoid_fast(g) * up * g1; }
                u32x2 w; w.x = pk_fp8x4(o[0] * FS_ACT, o[1] * FS_ACT, o[2] * FS_ACT, o[3] * FS_ACT); w.y = pk_fp8x4(o[4] * FS_ACT, o[5] * FS_ACT, o[6] * FS_ACT, o[7] * FS_ACT);
                *(u32x2*)(ACT + (size_t)row * 1024 + col0) = w; }
    }
};
}

__device__ __forceinline__ void tr_item(const float* W, int ldw, int k0, int scol0, const float* gk, bf16_t* WT, int ldo, int drow0, int dk0, LAS float* scr, int lane) {
#pragma unroll 8
    for (int i = 0; i < 32; ++i) { const int kk = 2 * i + (lane >> 5); float v = W[(size_t)(k0 + kk) * ldw + scol0 + (lane & 31)]; if (gk) v *= gk[k0 + kk]; scr[kk * 33 + (lane & 31)] = v; }
    asm volatile("s_waitcnt lgkmcnt(0)" ::: "memory");
    const int c = lane & 7;
#pragma unroll
    for (int j = 0; j < 4; ++j) { const int n = (lane >> 3) + 8 * j; const LAS float* s = scr + (8 * c) * 33 + n;
        u32x4 o; o.x = cvt_pk_bf16(s[0 * 33], s[1 * 33]); o.y = cvt_pk_bf16(s[2 * 33], s[3 * 33]); o.z = cvt_pk_bf16(s[4 * 33], s[5 * 33]); o.w = cvt_pk_bf16(s[6 * 33], s[7 * 33]);
        *(u32x4*)(WT + (size_t)(drow0 + n) * ldo + dk0 + 8 * c) = o; }
    asm volatile("s_waitcnt lgkmcnt(0)" ::: "memory");
}

constexpr size_t S5_L_STRIDE = 1310720, S5_KT = 0, S5_ET = 131072, S5_FT = 655360, S5_LAMP = 1179648;
constexpr int S5_WSCR = 8192, S5_YST = 65536, YST_LD = 264;
constexpr int NU128 = T / 128, UPB128 = SEQ / 128;
__device__ __forceinline__ f32x4 mfma16(bf16x8 a, bf16x8 b, f32x4 c) { return __builtin_amdgcn_mfma_f32_16x16x32_bf16(a, b, c, 0, 0, 0); }

__device__ __forceinline__ void s5_kt_pair(int g, int c, int cp, const float* a_re, const float* a_im, const float* log_dt, const float* b_re, const float* b_im,
                                           const float* c_re, const float* c_im, const float* dvec, unsigned char* tab) {
    const float dt = __expf(log_dt[g]); float km[8];
#pragma unroll
    for (int d = 0; d < 8; ++d) km[d] = 0.f;
#pragma unroll 2
    for (int p = 0; p < CS; ++p) { const float lr = a_re[g * CS + p], li = a_im[g * CS + p], zr = lr * dt, zi = li * dt;
        const float sh = __sinf(0.5f * zi), cz = __cosf(zi), sz = __sinf(zi), ez = __expf(zr); const float nr = expm1f(zr) * cz - 2.0f * sh * sh, ni = ez * sz, den = lr * lr + li * li;
        const float cr = (nr * lr + ni * li) / den, ci = (ni * lr - nr * li) / den;
        const float br = b_re[((size_t)g * CS + p) * CGD + cp], bi = b_im[((size_t)g * CS + p) * CGD + cp]; const float bbr = cr * br - ci * bi, bbi = cr * bi + ci * br;
        const float cre = c_re[((size_t)g * CGD + c) * CS + p], cim = c_im[((size_t)g * CGD + c) * CS + p];
        float vr = cre * bbr - cim * bbi, vi = cre * bbi + cim * bbr;
        const float lbr = ez * cz, lbi = ez * sz;
#pragma unroll
        for (int d = 0; d < 8; ++d) { km[d] += vr; const float t = vr * lbr - vi * lbi; vi = vr * lbi + vi * lbr; vr = t; } }
    if (c == cp) km[0] += dvec[g * CGD + c];
    bf16_t* kt = (bf16_t*)(tab + S5_KT) + (size_t)g * 4096;
#pragma unroll
    for (int dd = 0; dd < 8; ++dd) { kt[(dd * 16 + c) * 32 + cp] = f2bf(km[dd]); kt[(dd * 16 + c) * 32 + 16 + cp] = dd >= 1 ? f2bf(km[dd - 1]) : (bf16_t)0; }
}
__device__ __forceinline__ void s5_et_task(int g, int ri, int p, int cp, const float* a_re, const float* a_im, const float* log_dt, const float* b_re, const float* b_im, unsigned char* tab) {
    const float dt = __expf(log_dt[g]); const float lr = a_re[g * CS + p], li = a_im[g * CS + p], zr = lr * dt, zi = li * dt;
    const float sh = __sinf(0.5f * zi), cz = __cosf(zi), sz = __sinf(zi), ez = __expf(zr); const float nr = expm1f(zr) * cz - 2.0f * sh * sh, ni = ez * sz, den = lr * lr + li * li;
    const float cr = (nr * lr + ni * li) / den, ci = (ni * lr - nr * li) / den;
    const float br = b_re[((size_t)g * CS + p) * CGD + cp], bi = b_im[((size_t)g * CS + p) * CGD + cp]; float vr = cr * br - ci * bi, vi = cr * bi + ci * br;
    const float lbr = ez * cz, lbi = ez * sz; bf16_t* et = (bf16_t*)(tab + S5_ET) + (size_t)g * 16384 + (size_t)(ri * 64 + p) * 128 + cp;
#pragma unroll
    for (int sp = 7; sp >= 0; --sp) { et[sp * 16] = f2bf(ri ? vi : vr); const float t = vr * lbr - vi * lbi; vi = vr * lbi + vi * lbr; vr = t; }
}
__device__ __forceinline__ void s5_ft_task(int g, int c, int ri, int p, const float* a_re, const float* a_im, const float* log_dt, const float* c_re, const float* c_im, unsigned char* tab) {
    const float dt = __expf(log_dt[g]); const float lr = a_re[g * CS + p], li = a_im[g * CS + p], zr = lr * dt, zi = li * dt; const float ez = __expf(zr), lbr = ez * __cosf(zi), lbi = ez * __sinf(zi);
    const float cre = c_re[((size_t)g * CGD + c) * CS + p], cim = c_im[((size_t)g * CGD + c) * CS + p]; float vr = cre * lbr - cim * lbi, vi = cre * lbi + cim * lbr;
    bf16_t* ft = (bf16_t*)(tab + S5_FT) + (size_t)g * 16384 + (size_t)c * 128 + ri * 64 + p;
#pragma unroll
    for (int tp = 0; tp < 8; ++tp) { ft[(size_t)tp * 16 * 128] = f2bf(ri ? -vi : vr); const float t = vr * lbr - vi * lbi; vi = vr * lbi + vi * lbr; vr = t; }
}
__device__ __forceinline__ void s5_table_elem(int g, int e, const float* a_re, const float* a_im, const float* log_dt, const float* b_re, const float* b_im,
                                              const float* c_re, const float* c_im, const float* dvec, unsigned char* tab) {
    const float dt = __expf(log_dt[g]);
    if (e < 4096) {
        const int dd = e >> 9, c = (e >> 5) & 15, ee = (e >> 4) & 1, cp = e & 15, d = dd - ee; float s = 0.f;
        if (d >= 0) {
            for (int p = 0; p < CS; ++p) { const float lr = a_re[g * CS + p], li = a_im[g * CS + p], zr = lr * dt, zi = li * dt;
                const float sh = __sinf(0.5f * zi); const float nr = expm1f(zr) * __cosf(zi) - 2.0f * sh * sh, ni = __expf(zr) * __sinf(zi), den = lr * lr + li * li;
                const float cr = (nr * lr + ni * li) / den, ci = (ni * lr - nr * li) / den;
                const float br = b_re[((size_t)g * CS + p) * CGD + cp], bi = b_im[((size_t)g * CS + p) * CGD + cp]; const float bbr = cr * br - ci * bi, bbi = cr * bi + ci * br;
                const float mag = __expf(zr * (float)d), pr = mag * __cosf(zi * (float)d), pi = mag * __sinf(zi * (float)d);
                const float vr = pr * bbr - pi * bbi, vi = pr * bbi + pi * bbr;
                s += c_re[((size_t)g * CGD + c) * CS + p] * vr - c_im[((size_t)g * CGD + c) * CS + p] * vi; }
            if (d == 0 && c == cp) s += dvec[g * CGD + c];
        }
        ((bf16_t*)(tab + S5_KT))[(size_t)g * 4096 + e] = f2bf(s); return;
    }
    e -= 4096;
    if (e < 16384) {
        const int n = e >> 7, k = e & 127, ri = n >> 6, p = n & 63, sp = k >> 4, cp = k & 15;
        const float lr = a_re[g * CS + p], li = a_im[g * CS + p], zr = lr * dt, zi = li * dt;
        const float sh = __sinf(0.5f * zi); const float nr = expm1f(zr) * __cosf(zi) - 2.0f * sh * sh, ni = __expf(zr) * __sinf(zi), den = lr * lr + li * li;
        const float cr = (nr * lr + ni * li) / den, ci = (ni * lr - nr * li) / den;
        const float br = b_re[((size_t)g * CS + p) * CGD + cp], bi = b_im[((size_t)g * CS + p) * CGD + cp]; const float bbr = cr * br - ci * bi, bbi = cr * bi + ci * br;
        const float d = (float)(7 - sp); const float mag = __expf(zr * d), pr = mag * __cosf(zi * d), pi = mag * __sinf(zi * d);
        ((bf16_t*)(tab + S5_ET))[(size_t)g * 16384 + e] = f2bf(ri ? (pr * bbi + pi * bbr) : (pr * bbr - pi * bbi)); return;
    }
    e -= 16384;
    if (e < 16384) {
        const int n = e >> 7, k = e & 127, tp = n >> 4, c = n & 15, ri = k >> 6, p = k & 63;
        const float lr = a_re[g * CS + p], li = a_im[g * CS + p], zr = lr * dt, zi = li * dt;
        const float d = (float)(tp + 1); const float mag = __expf(zr * d), pr = mag * __cosf(zi * d), pi = mag * __sinf(zi * d);
        const float cre = c_re[((size_t)g * CGD + c) * CS + p], cim = c_im[((size_t)g * CGD + c) * CS + p];
        ((bf16_t*)(tab + S5_FT))[(size_t)g * 16384 + e] = f2bf(ri ? -(cre * pi + cim * pr) : (cre * pr - cim * pi)); return;
    }
    e -= 16384;
    { const int p = e; const float lr = a_re[g * CS + p], li = a_im[g * CS + p], zr = lr * dt, zi = li * dt; float* o = (float*)(tab + S5_LAMP) + ((size_t)g * CS + p) * 8;
      float mag = expf(zr); o[0] = mag * cosf(zi); o[1] = mag * sinf(zi);
      mag = expf(zr * 8.f); o[2] = mag * cosf(zi * 8.f); o[3] = mag * sinf(zi * 8.f);
      mag = expf(zr * 128.f); o[4] = mag * cosf(zi * 128.f); o[5] = mag * sinf(zi * 128.f); o[6] = 0.f; o[7] = 0.f; }
}

template <class TT> __device__ __forceinline__ TT ldg(const void* ubase, unsigned voff) { return *(const TT*)((const char*)ubase + voff); }
template <int PASS>
__device__ __forceinline__ void s5_group(int unit, int g, bool first, float& kr, float& ki, int wave, int lane, const bf16_t* Z, bf16_t* Y, const unsigned char* tab, float* SEND, float* SEND2, float* SE, LAS unsigned char* lds) {
    const int ln = lane & 15, q = lane >> 4; const int t0 = unit * 128;
    const char* KTg = (const char*)(tab + S5_KT) + (size_t)g * 8192; const char* ETg = (const char*)(tab + S5_ET) + (size_t)g * 32768; const char* FTg = (const char*)(tab + S5_FT) + (size_t)g * 32768;
    const float* LAMPg = (const float*)(tab + S5_LAMP) + (size_t)g * CS * 8;
    const unsigned vo128 = (unsigned)(ln * 128 + 8 * q) * 2u;
    const unsigned vo32 = (unsigned)(ln * 32 + 8 * q) * 2u;
    LAS float* Sb = (LAS float*)(lds + wave * S5_WSCR); LAS bf16_t* Tb = (LAS bf16_t*)(lds + wave * S5_WSCR); LAS bf16_t* yst = (LAS bf16_t*)(lds + S5_YST);
    char* seb = (char*)(SE + ((size_t)unit * CG + g) * 16 * 128); const unsigned vl = (unsigned)lane * 4u;
    char* ylb = (char*)(Y + (size_t)t0 * D + AW + BW + g * 16); const unsigned vy = (unsigned)((ln * 8) * D + 4 * q) * 2u;
    const float lur = LAMPg[lane * 8 + 4], lui = LAMPg[lane * 8 + 5], l8r = LAMPg[lane * 8 + 2], l8i = LAMPg[lane * 8 + 3];
    float cr = 0.f, ci = 0.f;
    if (PASS == 1) {
        if (!first) { cr = kr; ci = ki; }
        bf16x8 X0, X1, X2, X3;
        { const char* zb = (const char*)(Z + (size_t)t0 * INC + ZC + g * 16); const unsigned vz = (unsigned)((ln * 8 + (q >> 1)) * INC + 8 * (q & 1)) * 2u;
          X0 = ldg<bf16x8>(zb, vz); X1 = ldg<bf16x8>(zb + 2 * INC * 2, vz); X2 = ldg<bf16x8>(zb + 4 * INC * 2, vz); X3 = ldg<bf16x8>(zb + 6 * INC * 2, vz); }
        { LAS float* sw = Sb + (4 * q) * 128 + ln; const char* eb = ETg;
#pragma unroll 1
          for (int jh = 0; jh < 2; ++jh) { bf16x8 ef[4][4];
#pragma unroll
            for (int j = 0; j < 4; ++j)
#pragma unroll
              for (int ks = 0; ks < 4; ++ks) ef[j][ks] = ldg<bf16x8>(eb + j * 4096 + ks * 64, vo128);
#pragma unroll
            for (int j = 0; j < 4; ++j) { f32x4 se = (f32x4){0.f, 0.f, 0.f, 0.f};
              se = mfma16(X0, ef[j][0], se); se = mfma16(X1, ef[j][1], se); se = mfma16(X2, ef[j][2], se); se = mfma16(X3, ef[j][3], se);
              LAS float* s2 = sw + 16 * j; s2[0] = se[0]; s2[128] = se[1]; s2[256] = se[2]; s2[384] = se[3]; }
            eb += 16384; sw += 64; } }
        asm volatile("" ::: "memory");
        { const char* kb = KTg; char* yq = ylb;
#pragma unroll 1
          for (int th = 0; th < 4; ++th) {
              const bf16x8 ka = ldg<bf16x8>(kb, vo32), kc = ldg<bf16x8>(kb + 1024, vo32);
              f32x4 acc0 = (f32x4){0.f, 0.f, 0.f, 0.f}, acc1 = (f32x4){0.f, 0.f, 0.f, 0.f};
              acc0 = mfma16(ka, X0, acc0); acc1 = mfma16(kc, X0, acc1);
              if (th >= 1) { acc0 = mfma16(ldg<bf16x8>(kb - 2048, vo32), X1, acc0); acc1 = mfma16(ldg<bf16x8>(kb - 1024, vo32), X1, acc1); }
              if (th >= 2) { acc0 = mfma16(ldg<bf16x8>(kb - 4096, vo32), X2, acc0); acc1 = mfma16(ldg<bf16x8>(kb - 3072, vo32), X2, acc1); }
              if (th >= 3) { acc0 = mfma16(ldg<bf16x8>(kb - 6144, vo32), X3, acc0); acc1 = mfma16(ldg<bf16x8>(kb - 5120, vo32), X3, acc1); }
              u32x2 w; w.x = cvt_pk_bf16(acc0[0], acc0[1]); w.y = cvt_pk_bf16(acc0[2], acc0[3]); *(u32x2*)(yq + vy) = w;
              w.x = cvt_pk_bf16(acc1[0], acc1[1]); w.y = cvt_pk_bf16(acc1[2], acc1[3]); *(u32x2*)(yq + (size_t)D * 2 + vy) = w;
              kb += 2048; yq += (size_t)2 * D * 2; } }
        asm volatile("" ::: "memory");
        float sr = cr, si = ci;
#pragma unroll
        for (int s = 0; s < 16; ++s) { const float er = Sb[s * 128 + lane], ei = Sb[s * 128 + 64 + lane];
            *(float*)(seb + s * 512 + vl) = er; *(float*)(seb + s * 512 + 256 + vl) = ei;
            const float nr = l8r * sr - l8i * si + er, ni = l8r * si + l8i * sr + ei; sr = nr; si = ni; }
        kr = sr; ki = si;
        float* dst = first ? SEND + (((size_t)unit * CG + g) * 2) * CS + lane : SEND2 + (((size_t)(unit >> 1) * CG + g) * 2) * CS + lane;
        dst[0] = sr; dst[CS] = si; asm volatile("" ::: "memory"); return;
    }
    if (first) { const int pr = unit >> 1, p0 = pr - (pr % (UPB128 / 2)); const float l2r = lur * lur - lui * lui, l2i = 2.0f * lur * lui;
        const char* sb = (const char*)(SEND2 + (((size_t)p0 * CG + g) * 2) * CS);
#pragma unroll 8
        for (int j = p0; j < pr; ++j) { const float sr = ldg<float>(sb, vl), si = ldg<float>(sb + CS * 4, vl); sb += (size_t)CG * 2 * CS * 4;
            const float nr = l2r * cr - l2i * ci + sr, ni = l2r * ci + l2i * cr + si; cr = nr; ci = ni; } }
    else { const float sr = SEND[(((size_t)(unit - 1) * CG + g) * 2 + 0) * CS + lane], si = SEND[(((size_t)(unit - 1) * CG + g) * 2 + 1) * CS + lane];
        cr = lur * kr - lui * ki + sr; ci = lur * ki + lui * kr + si; }
    kr = cr; ki = ci;
    { float sre[16], sim[16];
#pragma unroll
      for (int s = 0; s < 16; ++s) { sre[s] = ldg<float>(seb + s * 512, vl); sim[s] = ldg<float>(seb + s * 512 + 256, vl); }
      float sr = cr, si = ci;
#pragma unroll
      for (int s = 0; s < 16; ++s) { Tb[s * 128 + lane] = f2bf(sr); Tb[s * 128 + 64 + lane] = f2bf(si);
          const float nr = l8r * sr - l8i * si + sre[s], ni = l8r * si + l8i * sr + sim[s]; sr = nr; si = ni; } }
    asm volatile("" ::: "memory");
    const bf16x8 T0 = *(const LAS bf16x8*)(Tb + ln * 128 + 8 * q), T1 = *(const LAS bf16x8*)(Tb + ln * 128 + 32 + 8 * q), T2 = *(const LAS bf16x8*)(Tb + ln * 128 + 64 + 8 * q), T3 = *(const LAS bf16x8*)(Tb + ln * 128 + 96 + 8 * q);
    { LAS bf16_t* yw = yst + (ln * 8) * YST_LD + g * 16 + 4 * q; const char* fb = FTg; const char* yq = ylb;
#pragma unroll 1
      for (int th = 0; th < 4; ++th) { bf16x8 ff[2][4]; u32x2 yl[2];
#pragma unroll
          for (int j = 0; j < 2; ++j) { yl[j] = ldg<u32x2>(yq + (size_t)j * D * 2, vy);
#pragma unroll
              for (int ks = 0; ks < 4; ++ks) ff[j][ks] = ldg<bf16x8>(fb + j * 4096 + ks * 64, vo128); }
#pragma unroll
          for (int j = 0; j < 2; ++j) {
              f32x4 acc; acc[0] = __uint_as_float(yl[j].x << 16); acc[1] = __uint_as_float(yl[j].x & 0xffff0000u); acc[2] = __uint_as_float(yl[j].y << 16); acc[3] = __uint_as_float(yl[j].y & 0xffff0000u);
              acc = mfma16(ff[j][0], T0, acc); acc = mfma16(ff[j][1], T1, acc); acc = mfma16(ff[j][2], T2, acc); acc = mfma16(ff[j][3], T3, acc);
              u32x2 w; w.x = cvt_pk_bf16(gelu_fast(acc[0]), gelu_fast(acc[1])); w.y = cvt_pk_bf16(gelu_fast(acc[2]), gelu_fast(acc[3]));
              *(LAS u32x2*)(yw + j * YST_LD) = w; }
          fb += 8192; yq += (size_t)2 * D * 2; yw += 2 * YST_LD; } }
    asm volatile("s_waitcnt lgkmcnt(0)" ::: "memory");
}
__device__ __forceinline__ void s5_pair1(int pr, int g, int wave, int lane, const bf16_t* Z, bf16_t* Y, const unsigned char* tab, float* SEND, float* SEND2, float* SE, LAS unsigned char* lds) {
    const int ln = lane & 15, q = lane >> 4; const int t0 = pr * 256;
    const char* KTg = (const char*)(tab + S5_KT) + (size_t)g * 8192; const char* ETg = (const char*)(tab + S5_ET) + (size_t)g * 32768;
    const float* LAMPg = (const float*)(tab + S5_LAMP) + (size_t)g * CS * 8;
    const unsigned vo128 = (unsigned)(ln * 128 + 8 * q) * 2u, vo32 = (unsigned)(ln * 32 + 8 * q) * 2u, vl = (unsigned)lane * 4u;
    LAS float* SbA = (LAS float*)(lds + wave * 16384); LAS float* SbB = SbA + 2048;
    bf16x8 XA0, XA1, XA2, XA3, XB0, XB1, XB2, XB3;
    { const char* zb = (const char*)(Z + (size_t)t0 * INC + ZC + g * 16); const unsigned vz = (unsigned)((ln * 8 + (q >> 1)) * INC + 8 * (q & 1)) * 2u;
      XA0 = ldg<bf16x8>(zb, vz); XA1 = ldg<bf16x8>(zb + 2 * INC * 2, vz); XA2 = ldg<bf16x8>(zb + 4 * INC * 2, vz); XA3 = ldg<bf16x8>(zb + 6 * INC * 2, vz);
      const char* zc = zb + (size_t)128 * INC * 2;
      XB0 = ldg<bf16x8>(zc, vz); XB1 = ldg<bf16x8>(zc + 2 * INC * 2, vz); XB2 = ldg<bf16x8>(zc + 4 * INC * 2, vz); XB3 = ldg<bf16x8>(zc + 6 * INC * 2, vz); }
    { LAS float* sw = SbA + (4 * q) * 128 + ln; const char* eb = ETg;
#pragma unroll 1
      for (int jh = 0; jh < 2; ++jh) { bf16x8 ef[4][4];
#pragma unroll
        for (int j = 0; j < 4; ++j)
#pragma unroll
          for (int ks = 0; ks < 4; ++ks) ef[j][ks] = ldg<bf16x8>(eb + j * 4096 + ks * 64, vo128);
#pragma unroll
        for (int j = 0; j < 4; ++j) { f32x4 sa = (f32x4){0.f, 0.f, 0.f, 0.f}, sb = (f32x4){0.f, 0.f, 0.f, 0.f};
          sa = mfma16(XA0, ef[j][0], sa); sb = mfma16(XB0, ef[j][0], sb); sa = mfma16(XA1, ef[j][1], sa); sb = mfma16(XB1, ef[j][1], sb);
          sa = mfma16(XA2, ef[j][2], sa); sb = mfma16(XB2, ef[j][2], sb); sa = mfma16(XA3, ef[j][3], sa); sb = mfma16(XB3, ef[j][3], sb);
          LAS float* s2 = sw + 16 * j; s2[0] = sa[0]; s2[128] = sa[1]; s2[256] = sa[2]; s2[384] = sa[3]; s2[2048] = sb[0]; s2[2048 + 128] = sb[1]; s2[2048 + 256] = sb[2]; s2[2048 + 384] = sb[3]; }
        eb += 16384; sw += 64; } }
    asm volatile("" ::: "memory");
    { const char* kb = KTg; char* yq = (char*)(Y + (size_t)t0 * D + AW + BW + g * 16); const unsigned vy = (unsigned)((ln * 8) * D + 4 * q) * 2u;
#pragma unroll 1
      for (int th = 0; th < 4; ++th) {
          const bf16x8 ka = ldg<bf16x8>(kb, vo32), kc = ldg<bf16x8>(kb + 1024, vo32);
          f32x4 a0 = (f32x4){0.f, 0.f, 0.f, 0.f}, a1 = a0, b0 = a0, b1 = a0;
          a0 = mfma16(ka, XA0, a0); a1 = mfma16(kc, XA0, a1); b0 = mfma16(ka, XB0, b0); b1 = mfma16(kc, XB0, b1);
          if (th >= 1) { const bf16x8 k0 = ldg<bf16x8>(kb - 2048, vo32), k1 = ldg<bf16x8>(kb - 1024, vo32); a0 = mfma16(k0, XA1, a0); a1 = mfma16(k1, XA1, a1); b0 = mfma16(k0, XB1, b0); b1 = mfma16(k1, XB1, b1); }
          if (th >= 2) { const bf16x8 k0 = ldg<bf16x8>(kb - 4096, vo32), k1 = ldg<bf16x8>(kb - 3072, vo32); a0 = mfma16(k0, XA2, a0); a1 = mfma16(k1, XA2, a1); b0 = mfma16(k0, XB2, b0); b1 = mfma16(k1, XB2, b1); }
          if (th >= 3) { const bf16x8 k0 = ldg<bf16x8>(kb - 6144, vo32), k1 = ldg<bf16x8>(kb - 5120, vo32); a0 = mfma16(k0, XA3, a0); a1 = mfma16(k1, XA3, a1); b0 = mfma16(k0, XB3, b0); b1 = mfma16(k1, XB3, b1); }
          u32x2 w; w.x = cvt_pk_bf16(a0[0], a0[1]); w.y = cvt_pk_bf16(a0[2], a0[3]); *(u32x2*)(yq + vy) = w;
          w.x = cvt_pk_bf16(a1[0], a1[1]); w.y = cvt_pk_bf16(a1[2], a1[3]); *(u32x2*)(yq + (size_t)D * 2 + vy) = w;
          w.x = cvt_pk_bf16(b0[0], b0[1]); w.y = cvt_pk_bf16(b0[2], b0[3]); *(u32x2*)(yq + (size_t)128 * D * 2 + vy) = w;
          w.x = cvt_pk_bf16(b1[0], b1[1]); w.y = cvt_pk_bf16(b1[2], b1[3]); *(u32x2*)(yq + (size_t)129 * D * 2 + vy) = w;
          kb += 2048; yq += (size_t)2 * D * 2; } }
    asm volatile("" ::: "memory");
    const float l8r = LAMPg[lane * 8 + 2], l8i = LAMPg[lane * 8 + 3];
    float sr = 0.f, si = 0.f;
    { char* seb = (char*)(SE + ((size_t)(2 * pr) * CG + g) * 16 * 128);
#pragma unroll
      for (int s = 0; s < 16; ++s) { const float er = SbA[s * 128 + lane], ei = SbA[s * 128 + 64 + lane];
          *(float*)(seb + s * 512 + vl) = er; *(float*)(seb + s * 512 + 256 + vl) = ei;
          const float nr = l8r * sr - l8i * si + er, ni = l8r * si + l8i * sr + ei; sr = nr; si = ni; }
      float* dst = SEND + (((size_t)(2 * pr) * CG + g) * 2) * CS + lane; dst[0] = sr; dst[CS] = si; }
    { char* seb = (char*)(SE + ((size_t)(2 * pr + 1) * CG + g) * 16 * 128);
#pragma unroll
      for (int s = 0; s < 16; ++s) { const float er = SbB[s * 128 + lane], ei = SbB[s * 128 + 64 + lane];
          *(float*)(seb + s * 512 + vl) = er; *(float*)(seb + s * 512 + 256 + vl) = ei;
          const float nr = l8r * sr - l8i * si + er, ni = l8r * si + l8i * sr + ei; sr = nr; si = ni; }
      float* dst = SEND2 + (((size_t)pr * CG + g) * 2) * CS + lane; dst[0] = sr; dst[CS] = si; }
    asm volatile("s_waitcnt lgkmcnt(0)" ::: "memory");
}
constexpr int S5_PSG = 133120;
__device__ __forceinline__ void s5_glu(int unit, int wave, int lane, const bf16_t* WGLU, const float* glu_b, const float* mo_gc, bf16_t* Y, LAS unsigned char* lds) {
    const int ln = lane & 15, q = lane >> 4; LAS bf16_t* yst = (LAS bf16_t*)(lds + S5_YST); LAS float* PSg = (LAS float*)(lds + S5_PSG);
    bf16x8 wf[2][8];
    { const char* wb = (const char*)(WGLU + (size_t)(32 * wave) * 256); const unsigned vw = (unsigned)(ln * 256 + 8 * q) * 2u;
#pragma unroll
      for (int j = 0; j < 2; ++j)
#pragma unroll
          for (int ks = 0; ks < 8; ++ks) wf[j][ks] = ldg<bf16x8>(wb + j * 8192 + ks * 64, vw); }
    const f32x4 gb0 = *(const f32x4*)(glu_b + 32 * wave + 4 * q), gb1 = *(const f32x4*)(glu_b + 32 * wave + 16 + 4 * q);
    LAS bf16_t* op = (LAS bf16_t*)(lds + wave * S5_WSCR) + ln * 32 + 4 * q;
    { const LAS bf16_t* yrow = yst + ln * YST_LD; LAS float* psw = PSg + ln * 8 + wave; LAS bf16_t* ow = op;
#pragma unroll 2
      for (int tt = 0; tt < 8; ++tt) {
        f32x4 a0 = (f32x4){0.f, 0.f, 0.f, 0.f}, a1 = (f32x4){0.f, 0.f, 0.f, 0.f};
#pragma unroll
        for (int ks = 0; ks < 8; ++ks) { const bf16x8 yf = *(const LAS bf16x8*)(yrow + 32 * ks + 8 * q); a0 = mfma16(wf[0][ks], yf, a0); a1 = mfma16(wf[1][ks], yf, a1); }
        const u32x2 y0 = *(const LAS u32x2*)(yrow + 32 * wave + 4 * q), y1 = *(const LAS u32x2*)(yrow + 32 * wave + 16 + 4 * q);
        float o[8];
        o[0] = __uint_as_float(y0.x << 16) * sigmoid_fast(a0[0] + gb0[0]); o[1] = __uint_as_float(y0.x & 0xffff0000u) * sigmoid_fast(a0[1] + gb0[1]); o[2] = __uint_as_float(y0.y << 16) * sigmoid_fast(a0[2] + gb0[2]); o[3] = __uint_as_float(y0.y & 0xffff0000u) * sigmoid_fast(a0[3] + gb0[3]);
        o[4] = __uint_as_float(y1.x << 16) * sigmoid_fast(a1[0] + gb1[0]); o[5] = __uint_as_float(y1.x & 0xffff0000u) * sigmoid_fast(a1[1] + gb1[1]); o[6] = __uint_as_float(y1.y << 16) * sigmoid_fast(a1[2] + gb1[2]); o[7] = __uint_as_float(y1.y & 0xffff0000u) * sigmoid_fast(a1[3] + gb1[3]);
        float ss = ((o[0] * o[0] + o[1] * o[1]) + (o[2] * o[2] + o[3] * o[3])) + ((o[4] * o[4] + o[5] * o[5]) + (o[6] * o[6] + o[7] * o[7]));
        ss = add_x16_x32(ss);
        if (q == 0) *psw = ss;
        u32x2 w; w.x = cvt_pk_bf16(o[0], o[1]); w.y = cvt_pk_bf16(o[2], o[3]); *(LAS u32x2*)(ow) = w; w.x = cvt_pk_bf16(o[4], o[5]); w.y = cvt_pk_bf16(o[6], o[7]); *(LAS u32x2*)(ow + 16) = w;
        yrow += 16 * YST_LD; psw += 16 * 8; ow += 16 * 32; } }
    asm volatile("s_waitcnt lgkmcnt(0)" ::: "memory");
    __syncthreads();
    const f32x4 g0 = *(const f32x4*)(mo_gc + 32 * wave + 4 * q), g1 = *(const f32x4*)(mo_gc + 32 * wave + 16 + 4 * q);
    { char* yb = (char*)(Y + (size_t)(unit * 128) * D + AW + BW + 32 * wave); const unsigned vy = (unsigned)(ln * D + 4 * q) * 2u; const LAS f32x4* pp = (const LAS f32x4*)(PSg + ln * 8); const LAS bf16_t* ow = op;
#pragma unroll 2
      for (int tt = 0; tt < 8; ++tt) { const f32x4 p0 = pp[0], p1 = pp[1];
        const float rs = __builtin_amdgcn_rsqf((((p0[0] + p0[1]) + (p0[2] + p0[3])) + ((p1[0] + p1[1]) + (p1[2] + p1[3]))) * (1.0f / CW) + EPS);
        const u32x2 a = *(const LAS u32x2*)(ow), b = *(const LAS u32x2*)(ow + 16); u32x2 w;
        w.x = cvt_pk_bf16(__uint_as_float(a.x << 16) * rs * g0[0], __uint_as_float(a.x & 0xffff0000u) * rs * g0[1]); w.y = cvt_pk_bf16(__uint_as_float(a.y << 16) * rs * g0[2], __uint_as_float(a.y & 0xffff0000u) * rs * g0[3]);
        *(u32x2*)(yb + vy) = w;
        w.x = cvt_pk_bf16(__uint_as_float(b.x << 16) * rs * g1[0], __uint_as_float(b.x & 0xffff0000u) * rs * g1[1]); w.y = cvt_pk_bf16(__uint_as_float(b.y << 16) * rs * g1[2], __uint_as_float(b.y & 0xffff0000u) * rs * g1[3]);
        *(u32x2*)(yb + 32 + vy) = w;
        yb += (size_t)16 * D * 2; pp += 16 * 2; ow += 16 * 32; } }
}

constexpr int XC_LD = 392;
constexpr int RG_XC = 0, RG_PS = 100352, RG_CAR = 112640, RG_RSB = 114176, RG_PT = 114688, RG_HC = 116224;
template <int CTRL> __device__ __forceinline__ float dppf(float old, float v) { return __int_as_float(__builtin_amdgcn_update_dpp(__float_as_int(old), __float_as_int(v), CTRL, 0xf, 0xf, false)); }
__device__ __forceinline__ void bf8_to_f32(const u32x4 o, float (&v)[8]) {
    v[0] = __uint_as_float(o.x << 16); v[1] = __uint_as_float(o.x & 0xffff0000u); v[2] = __uint_as_float(o.y << 16); v[3] = __uint_as_float(o.y & 0xffff0000u);
    v[4] = __uint_as_float(o.z << 16); v[5] = __uint_as_float(o.z & 0xffff0000u); v[6] = __uint_as_float(o.w << 16); v[7] = __uint_as_float(o.w & 0xffff0000u);
}
__device__ __forceinline__ float bcast15(float v) { return __int_as_float(__builtin_amdgcn_ds_swizzle(__float_as_int(v), 0x1F0)); }
template <int PASS>
__device__ __forceinline__ void rglru_unit(int unit, bool first, float& cprev, int tid, int wave, int lane, const bf16_t* Z, bf16_t* Y, const bf16_t* WRG, const bf16_t* WIG,
                                           const float* conv_w, const float* conv_b, const float* rg_b, const float* ig_b, const float* lam, const float* mo_gb,
                                           float* SUMA, float* SUMH, float* SUMA2, float* SUMH2, bf16_t* HL, bf16_t* PP, LAS unsigned char* lds) {
    LAS bf16_t* xcl = (LAS bf16_t*)(lds + RG_XC); LAS float* PS = (LAS float*)(lds + RG_PS); LAS float* CAR = (LAS float*)(lds + RG_CAR); LAS float* RSB = (LAS float*)(lds + RG_RSB); LAS float* PT = (LAS float*)(lds + RG_PT); LAS float* HC = (LAS float*)(lds + RG_HC);
    const int t0 = unit * 128; const int ln = lane & 15, q = lane >> 4;
    if (tid < 384) {
        const int c0 = (tid % 48) * 8, tg = tid / 48; const int tb = t0 + tg * 16, s0 = tb % SEQ;
        float w0[8], w1[8], w2[8], w3[8], bb[8];
#pragma unroll
        for (int hh = 0; hh < 2; ++hh) { const f32x4 a0 = *(const f32x4*)(conv_w + 0 * BW + c0 + 4 * hh), a1 = *(const f32x4*)(conv_w + 1 * BW + c0 + 4 * hh), a2 = *(const f32x4*)(conv_w + 2 * BW + c0 + 4 * hh), a3 = *(const f32x4*)(conv_w + 3 * BW + c0 + 4 * hh), a4 = *(const f32x4*)(conv_b + c0 + 4 * hh);
#pragma unroll
            for (int j = 0; j < 4; ++j) { w0[4 * hh + j] = a0[j]; w1[4 * hh + j] = a1[j]; w2[4 * hh + j] = a2[j]; w3[4 * hh + j] = a3[j]; bb[4 * hh + j] = a4[j]; } }
        float xm1[8], xm2[8], xm3[8];
        const bf16_t* zp = Z + (size_t)tb * INC + ZX + c0;
        { const u32x4 z4 = {0u, 0u, 0u, 0u}; const u32x4 o1 = s0 >= 1 ? *(const u32x4*)(zp - INC) : z4, o2 = s0 >= 2 ? *(const u32x4*)(zp - 2 * INC) : z4, o3 = s0 >= 3 ? *(const u32x4*)(zp - 3 * INC) : z4;
          bf8_to_f32(o1, xm1); bf8_to_f32(o2, xm2); bf8_to_f32(o3, xm3); }
        LAS bf16_t* xw = xcl + (tg * 16) * XC_LD + c0;
#pragma unroll 4
        for (int i = 0; i < 16; ++i) { float x0[8]; bf8_to_f32(*(const u32x4*)(zp), x0); float v[8];
#pragma unroll
            for (int j = 0; j < 8; ++j) { v[j] = bb[j] + w3[j] * x0[j] + w2[j] * xm1[j] + w1[j] * xm2[j] + w0[j] * xm3[j]; xm3[j] = xm2[j]; xm2[j] = xm1[j]; xm1[j] = x0[j]; }
            u32x4 w; w.x = cvt_pk_bf16(v[0], v[1]); w.y = cvt_pk_bf16(v[2], v[3]); w.z = cvt_pk_bf16(v[4], v[5]); w.w = cvt_pk_bf16(v[6], v[7]);
            *(LAS u32x4*)(xw) = w; zp += INC; xw += XC_LD; }
        if (PASS == 2) { const int c = tid; float h;
            if (first) { const int pr = unit >> 1, p0 = pr - (pr % (UPB128 / 2)); h = 0.f; const float* pa = SUMA2 + (size_t)p0 * BW + c; const float* ph = SUMH2 + (size_t)p0 * BW + c;
#pragma unroll 8
                for (int j = p0; j < pr; ++j) { h = fmaf(*pa, h, *ph); pa += BW; ph += BW; } }
            else h = fmaf(SUMA[(size_t)(unit - 1) * BW + c], cprev, SUMH[(size_t)(unit - 1) * BW + c]);
            cprev = h; CAR[c] = h; }
    }
    __syncthreads();
#pragma unroll 1
    for (int ci = 0; ci < 3; ++ci) {
        const int combo = wave + 8 * ci, h = combo >> 2, jt = combo & 3, cb = h * 64 + jt * 16;
        const bf16_t* wr = WRG + ((size_t)(h * 64 + jt * 16 + ln)) * 64 + 8 * q; const bf16_t* wi = WIG + ((size_t)(h * 64 + jt * 16 + ln)) * 64 + 8 * q;
        const bf16x8 RG0 = *(const bf16x8*)(wr), RG1 = *(const bf16x8*)(wr + 32), IG0 = *(const bf16x8*)(wi), IG1 = *(const bf16x8*)(wi + 32);
        const f32x4 rgb4 = *(const f32x4*)(rg_b + cb + 4 * q), igb4 = *(const f32x4*)(ig_b + cb + 4 * q), lam4 = *(const f32x4*)(lam + cb + 4 * q);
        float spc[4], car[4], ptot[4];
#pragma unroll
        for (int r = 0; r < 4; ++r) { spc[r] = -8.0f * 1.4426950408889634f * log1pf(expf(-lam4[r])); car[r] = PASS == 2 ? CAR[cb + 4 * q + r] : (first ? 0.f : HC[cb + 4 * q + r]); ptot[r] = (PASS == 1 && !first) ? PT[cb + 4 * q + r] : 1.f; }
        const LAS bf16_t* xb = xcl + ln * XC_LD + h * 64 + 8 * q; const LAS bf16_t* xv = xcl + ln * XC_LD + cb + 4 * q;
        const bf16_t* zg = Z + (size_t)(t0 + ln) * INC + ZG + cb + 4 * q; bf16_t* yo = Y + (size_t)(t0 + ln) * D + AW + cb + 4 * q; LAS float* psw = PS + ln * 24 + combo;
        bf16_t* hlo = HL + (size_t)(t0 + ln) * BW + cb + 4 * q; bf16_t* ppo = PP + (size_t)(t0 + ln) * BW + cb + 4 * q;
#pragma unroll 1
        for (int tt = 0; tt < 8; ++tt) {
            const bf16x8 B0 = *(const LAS bf16x8*)(xb), B1 = *(const LAS bf16x8*)(xb + 32);
            f32x4 ar = (f32x4){0.f, 0.f, 0.f, 0.f}, ai = (f32x4){0.f, 0.f, 0.f, 0.f};
            ar = mfma16(RG0, B0, ar); ar = mfma16(RG1, B1, ar); ai = mfma16(IG0, B0, ai); ai = mfma16(IG1, B1, ai);
            const u32x2 xq = *(const LAS u32x2*)(xv); float xc4[4] = {__uint_as_float(xq.x << 16), __uint_as_float(xq.x & 0xffff0000u), __uint_as_float(xq.y << 16), __uint_as_float(xq.y & 0xffff0000u)};
            float hv[4], pv[4];
#pragma unroll
            for (int r = 0; r < 4; ++r) {
                const float rr = sigmoid_fast(ar[r] + rgb4[r]), ii = sigmoid_fast(ai[r] + igb4[r]);
                float A = __builtin_amdgcn_exp2f(spc[r] * rr);
                float Bv = __builtin_amdgcn_sqrtf(fmaxf(1.0f - A * A, 0.f)) * (ii * xc4[r]);
                if (ln == 0) Bv = fmaf(A, car[r], Bv);
                { const float As = dppf<0x111>(1.0f, A), Bs = dppf<0x111>(0.0f, Bv); Bv = fmaf(A, Bs, Bv); A *= As; }
                { const float As = dppf<0x112>(1.0f, A), Bs = dppf<0x112>(0.0f, Bv); Bv = fmaf(A, Bs, Bv); A *= As; }
                { const float As = dppf<0x114>(1.0f, A), Bs = dppf<0x114>(0.0f, Bv); Bv = fmaf(A, Bs, Bv); A *= As; }
                { const float As = dppf<0x118>(1.0f, A), Bs = dppf<0x118>(0.0f, Bv); Bv = fmaf(A, Bs, Bv); A *= As; }
                hv[r] = Bv; car[r] = bcast15(Bv);
                if (PASS == 1) { pv[r] = ptot[r] * A; ptot[r] *= bcast15(A); }
            }
            if (PASS == 1) { u32x2 w; w.x = cvt_pk_bf16(hv[0], hv[1]); w.y = cvt_pk_bf16(hv[2], hv[3]); *(u32x2*)(hlo) = w; w.x = cvt_pk_bf16(pv[0], pv[1]); w.y = cvt_pk_bf16(pv[2], pv[3]); *(u32x2*)(ppo) = w; hlo += 16 * BW; ppo += 16 * BW; }
            if (PASS == 2) { const u32x2 gq = *(const u32x2*)(zg);
                const float y0 = hv[0] * __uint_as_float(gq.x << 16), y1 = hv[1] * __uint_as_float(gq.x & 0xffff0000u), y2 = hv[2] * __uint_as_float(gq.y << 16), y3 = hv[3] * __uint_as_float(gq.y & 0xffff0000u);
                u32x2 w; w.x = cvt_pk_bf16(y0, y1); w.y = cvt_pk_bf16(y2, y3); *(u32x2*)(yo) = w;
                float ss = (y0 * y0 + y1 * y1) + (y2 * y2 + y3 * y3); ss += __shfl_xor(ss, 16); ss += __shfl_xor(ss, 32);
                if (q == 0) *psw = ss; }
            xb += 16 * XC_LD; xv += 16 * XC_LD; zg += 16 * INC; yo += 16 * D; psw += 16 * 24;
        }
        if (PASS == 1 && ln == 0) {
            float* da = first ? SUMA + (size_t)unit * BW : SUMA2 + (size_t)(unit >> 1) * BW; float* dh = first ? SUMH + (size_t)unit * BW : SUMH2 + (size_t)(unit >> 1) * BW;
#pragma unroll
            for (int r = 0; r < 4; ++r) { da[cb + 4 * q + r] = ptot[r]; dh[cb + 4 * q + r] = car[r]; if (first) { PT[cb + 4 * q + r] = ptot[r]; HC[cb + 4 * q + r] = car[r]; } } }
    }
    if (PASS == 2) {
        asm volatile("s_waitcnt vmcnt(0)" ::: "memory");
        __syncthreads();
        if (tid < 128) { float s = 0.f;
#pragma unroll
            for (int k = 0; k < 24; ++k) s += PS[tid * 24 + k];
            RSB[tid] = __builtin_amdgcn_rsqf(s * (1.0f / BW) + EPS); }
        __syncthreads();
#pragma unroll 2
        for (int k = 0; k < 12; ++k) { const int idx = tid + 512 * k, tl = idx / 48, c0 = (idx % 48) * 8; const float rs = RSB[tl];
            bf16_t* yp = Y + (size_t)(t0 + tl) * D + AW + c0; float v[8]; bf8_to_f32(*(const u32x4*)(yp), v);
            const f32x4 g0 = *(const f32x4*)(mo_gb + c0), g1 = *(const f32x4*)(mo_gb + c0 + 4);
            u32x4 w; w.x = cvt_pk_bf16(v[0] * rs * g0[0], v[1] * rs * g0[1]); w.y = cvt_pk_bf16(v[2] * rs * g0[2], v[3] * rs * g0[3]); w.z = cvt_pk_bf16(v[4] * rs * g1[0], v[5] * rs * g1[1]); w.w = cvt_pk_bf16(v[6] * rs * g1[2], v[7] * rs * g1[3]);
            *(u32x4*)(yp) = w; }
    }
    __syncthreads();
}

__device__ __forceinline__ void rglru_fix_pair(int pr, int tid, int wave, int lane, const bf16_t* Z, bf16_t* Y, const bf16_t* HL, const bf16_t* PP, const float* SUMA2, const float* SUMH2, const float* mo_gb, LAS unsigned char* lds) {
    LAS float* CAR = (LAS float*)(lds + RG_CAR);
    if (tid < 384) { const int c = tid, p0 = pr - (pr % (UPB128 / 2)); float h = 0.f; const float* pa = SUMA2 + (size_t)p0 * BW + c; const float* ph = SUMH2 + (size_t)p0 * BW + c;
#pragma unroll 8
        for (int j = p0; j < pr; ++j) { h = fmaf(*pa, h, *ph); pa += BW; ph += BW; }
        CAR[c] = h; }
    __syncthreads();
    {
        const bool act = lane < 48; const int c0 = act ? lane * 8 : 0; float hin[8]; const f32x4 g0 = *(const f32x4*)(mo_gb + c0), g1 = *(const f32x4*)(mo_gb + c0 + 4);
#pragma unroll
        for (int e = 0; e < 8; ++e) hin[e] = CAR[c0 + e];
#pragma unroll 2
        for (int i = 0; i < 32; ++i) { const size_t t = (size_t)pr * 256 + wave * 32 + i;
            float hl[8], pp[8], gg[8], y[8]; bf8_to_f32(*(const u32x4*)(HL + t * BW + c0), hl); bf8_to_f32(*(const u32x4*)(PP + t * BW + c0), pp); bf8_to_f32(*(const u32x4*)(Z + t * INC + ZG + c0), gg);
            float ss = 0.f;
#pragma unroll
            for (int e = 0; e < 8; ++e) { y[e] = fmaf(pp[e], hin[e], hl[e]) * gelu_fast(gg[e]); ss += y[e] * y[e]; }
            ss = wave_sum(act ? ss : 0.f);
            const float rs = __builtin_amdgcn_rsqf(ss * (1.0f / BW) + EPS);
            u32x4 w; w.x = cvt_pk_bf16(y[0] * rs * g0[0], y[1] * rs * g0[1]); w.y = cvt_pk_bf16(y[2] * rs * g0[2], y[3] * rs * g0[3]); w.z = cvt_pk_bf16(y[4] * rs * g1[0], y[5] * rs * g1[1]); w.w = cvt_pk_bf16(y[6] * rs * g1[2], y[7] * rs * g1[3]);
            if (act) *(u32x4*)(Y + t * D + AW + c0) = w; }
    }
    __syncthreads();
}

constexpr int VT_LD = 136;
__device__ __forceinline__ void mixa_unit(int unit, int tid, int wave, int lane, const bf16_t* Z, bf16_t* Y, const bf16_t* WSP, const float* a_sb, const float* vg, const float* mo_ga, LAS unsigned char* lds) {
    LAS bf16_t* vT = (LAS bf16_t*)lds; const int t0 = unit * 128; const int ln = lane & 15, q = lane >> 4;
    { const int j = tid >> 2, part = tid & 3; const bf16_t* zp = Z + (size_t)(t0 + j) * INC + ZV + part * 96;
      u32x4 raw[12]; float ss = 0.f;
#pragma unroll
      for (int k = 0; k < 12; ++k) { const u32x4 rw = *(const u32x4*)(zp + 8 * k); float v[8]; bf8_to_f32(rw, v);
#pragma unroll
          for (int e = 0; e < 8; ++e) { v[e] = gelu_fast(v[e]); ss += v[e] * v[e]; }
          raw[k].x = cvt_pk_bf16(v[0], v[1]); raw[k].y = cvt_pk_bf16(v[2], v[3]); raw[k].z = cvt_pk_bf16(v[4], v[5]); raw[k].w = cvt_pk_bf16(v[6], v[7]); }
      ss += x_xor1(ss); ss += x_xor2(ss);
      const float rs = __builtin_amdgcn_rsqf(ss * (1.0f / AW) + EPS);
      LAS bf16_t* vw = vT + (part * 96) * VT_LD + j; const float* gp = vg + part * 96;
#pragma unroll
      for (int k = 0; k < 12; ++k) { float v[8]; bf8_to_f32(raw[k], v); const f32x4 g0 = *(const f32x4*)(gp + 8 * k), g1 = *(const f32x4*)(gp + 8 * k + 4);
#pragma unroll
          for (int e = 0; e < 8; ++e) vw[(8 * k + e) * VT_LD] = f2bf(v[e] * rs * (e < 4 ? g0[e] : g1[e - 4])); } }
    __syncthreads();
    const bool full = wave >= 4;
    float ss = 0.f;
    const int tl = 16 * wave + ln;
    const char* ub = (const char*)(Z + (size_t)t0 * INC + ZU); const unsigned vu = (unsigned)(tl * INC + 4 * q) * 2u;
    const char* wb = (const char*)WSP; const unsigned vw = (unsigned)(tl * 128 + 8 * q) * 2u;
    char* yb = (char*)(Y + (size_t)t0 * D); const unsigned vy = (unsigned)(tl * D + 4 * q) * 2u;
    const bf16x8 z8 = {0, 0, 0, 0, 0, 0, 0, 0};
    bf16x8 Wn0 = ldg<bf16x8>(wb, vw), Wn1 = ldg<bf16x8>(wb + 64, vw), Wn2 = z8, Wn3 = z8;
    if (full) { Wn2 = ldg<bf16x8>(wb + 128, vw); Wn3 = ldg<bf16x8>(wb + 192, vw); }
    u32x2 un0 = ldg<u32x2>(ub, vu), un1 = ldg<u32x2>(ub + 32, vu), un2 = ldg<u32x2>(ub + 64, vu), un3 = ldg<u32x2>(ub + 96, vu); float bn = a_sb[tl];
    const LAS bf16_t* ap = vT + ln * VT_LD + 8 * q;
#pragma unroll 1
    for (int h = 0; h < 6; ++h) {
        const bf16x8 W0 = Wn0, W1 = Wn1, W2 = Wn2, W3 = Wn3; const u32x2 uc[4] = {un0, un1, un2, un3}; const float b = bn;
        if (h < 5) { wb += 128 * 128 * 2; ub += 128; Wn0 = ldg<bf16x8>(wb, vw); Wn1 = ldg<bf16x8>(wb + 64, vw); if (full) { Wn2 = ldg<bf16x8>(wb + 128, vw); Wn3 = ldg<bf16x8>(wb + 192, vw); }
            un0 = ldg<u32x2>(ub, vu); un1 = ldg<u32x2>(ub + 32, vu); un2 = ldg<u32x2>(ub + 64, vu); un3 = ldg<u32x2>(ub + 96, vu); bn = a_sb[(h + 1) * 128 + tl]; }
#pragma unroll
        for (int dt = 0; dt < 4; ++dt) { f32x4 acc = (f32x4){0.f, 0.f, 0.f, 0.f};
            const bf16x8 a0 = *(const LAS bf16x8*)(ap + 16 * dt * VT_LD), a1 = *(const LAS bf16x8*)(ap + 16 * dt * VT_LD + 32), a2 = *(const LAS bf16x8*)(ap + 16 * dt * VT_LD + 64), a3 = *(const LAS bf16x8*)(ap + 16 * dt * VT_LD + 96);
            acc = mfma16(a0, W0, acc); acc = mfma16(a1, W1, acc); acc = mfma16(a2, W2, acc); acc = mfma16(a3, W3, acc);
            const u32x2 u2 = uc[dt];
            const float v0 = gelu_fast(__uint_as_float(u2.x << 16)) * (acc[0] + b), v1 = gelu_fast(__uint_as_float(u2.x & 0xffff0000u)) * (acc[1] + b), v2 = gelu_fast(__uint_as_float(u2.y << 16)) * (acc[2] + b), v3 = gelu_fast(__uint_as_float(u2.y & 0xffff0000u)) * (acc[3] + b);
            ss += (v0 * v0 + v1 * v1) + (v2 * v2 + v3 * v3);
            u32x2 pk; pk.x = cvt_pk_bf16(v0, v1); pk.y = cvt_pk_bf16(v2, v3); *(u32x2*)(yb + (h * 64 + 16 * dt) * 2 + vy) = pk; }
        ap += 64 * VT_LD;
    }
    ss = add_x16_x32(ss);
    const float rs = __builtin_amdgcn_rsqf(ss * (1.0f / AW) + EPS);
    asm volatile("s_waitcnt vmcnt(0)" ::: "memory");
    { const char* gb = (const char*)mo_ga; const unsigned vg4 = (unsigned)(4 * q) * 4u;
#pragma unroll 1
      for (int kb = 0; kb < 3; ++kb) { u32x2 pk[8];
#pragma unroll
          for (int k = 0; k < 8; ++k) pk[k] = ldg<u32x2>(yb + k * 32, vy);
#pragma unroll
          for (int k = 0; k < 8; ++k) { const f32x4 gg = ldg<f32x4>(gb + k * 64, vg4);
              u32x2 w; w.x = cvt_pk_bf16(__uint_as_float(pk[k].x << 16) * rs * gg[0], __uint_as_float(pk[k].x & 0xffff0000u) * rs * gg[1]); w.y = cvt_pk_bf16(__uint_as_float(pk[k].y << 16) * rs * gg[2], __uint_as_float(pk[k].y & 0xffff0000u) * rs * gg[3]);
              *(u32x2*)(yb + k * 32 + vy) = w; }
          yb += 256; gb += 512; } }
    __syncthreads();
}

__device__ __forceinline__ void router_unit(int unit, int wave, int lane, const bf16_t* HB, const float* SSQ, const bf16_t* WRT, const float* rgb, const float* reb,
                                            int* CLS, float* G2, LAS unsigned char* lds, LAS int* hist) {
    const int ln = lane & 15, q = lane >> 4; const int t0 = unit * UT + wave * 32;
    LAS float* LG = (LAS float*)(lds + wave * 8192);
    f32x4 acc[2][3];
#pragma unroll
    for (int tt = 0; tt < 2; ++tt)
#pragma unroll
        for (int j = 0; j < 3; ++j) acc[tt][j] = (f32x4){0.f, 0.f, 0.f, 0.f};
    const bf16_t* hp0 = HB + (size_t)(t0 + ln) * D + 8 * q; const bf16_t* hp1 = hp0 + (size_t)16 * D; const bf16_t* wp = WRT + (size_t)ln * D + 8 * q;
#pragma unroll 4
    for (int ks = 0; ks < 32; ++ks) {
        const bf16x8 b0 = *(const bf16x8*)(hp0), b1 = *(const bf16x8*)(hp1);
        const bf16x8 a0 = *(const bf16x8*)(wp), a1 = *(const bf16x8*)(wp + 16 * D), a2 = *(const bf16x8*)(wp + 32 * D);
        acc[0][0] = mfma16(a0, b0, acc[0][0]); acc[0][1] = mfma16(a1, b0, acc[0][1]); acc[0][2] = mfma16(a2, b0, acc[0][2]);
        acc[1][0] = mfma16(a0, b1, acc[1][0]); acc[1][1] = mfma16(a1, b1, acc[1][1]); acc[1][2] = mfma16(a2, b1, acc[1][2]);
        hp0 += 32; hp1 += 32; wp += 32; }
#pragma unroll
    for (int tt = 0; tt < 2; ++tt)
#pragma unroll
        for (int j = 0; j < 3; ++j) *(LAS f32x4*)(LG + (16 * tt + ln) * 48 + 16 * j + 4 * q) = acc[tt][j];
    asm volatile("s_waitcnt lgkmcnt(0)" ::: "memory");
    if (lane < 32) { const int t = t0 + lane; const LAS float* lg = LG + lane * 48;
        const f32x4* sp = (const f32x4*)(SSQ + (size_t)t * 16); const f32x4 s0 = sp[0], s1 = sp[1], s2 = sp[2], s3 = sp[3];
        const float sq = ((s0[0] + s0[1]) + (s0[2] + s0[3])) + ((s1[0] + s1[1]) + (s1[2] + s1[3])) + ((s2[0] + s2[1]) + (s2[2] + s2[3])) + ((s3[0] + s3[1]) + (s3[2] + s3[3]));
        const float r = rsqrtf(sq * (1.0f / D) + EPS);
        float gl[4];
#pragma unroll
        for (int j = 0; j < 4; ++j) gl[j] = r * (lg[j] + lg[16 + j]) + rgb[j];
        int gs = 0; float gm = gl[0];
#pragma unroll
        for (int j = 1; j < 4; ++j) if (gl[j] > gm) { gm = gl[j]; gs = j; }
        float den = 0.f;
#pragma unroll
        for (int j = 0; j < 4; ++j) den += expf(gl[j] - gm);
        const float gwt = 1.0f / den;
        float el[4];
#pragma unroll
        for (int j = 0; j < 4; ++j) { float v;
            if (gs < 3) v = lg[4 + 4 * gs + j] + lg[16 + 4 + 4 * gs + j]; else v = lg[32 + j] + lg[36 + j];
            el[j] = r * v + reb[gs * 4 + j]; }
        int i0 = 0; float v0 = el[0];
#pragma unroll
        for (int j = 1; j < 4; ++j) if (el[j] > v0) { v0 = el[j]; i0 = j; }
        int i1 = 0; float v1 = -3.0e38f;
#pragma unroll
        for (int j = 0; j < 4; ++j) if (j != i0 && el[j] > v1) { v1 = el[j]; i1 = j; }
        const float e1 = expf(v1 - v0); const float w0 = gwt / (1.0f + e1), w1 = gwt * e1 / (1.0f + e1);
        const int lo = i0 < i1 ? i0 : i1, hi = i0 < i1 ? i1 : i0; const int cls = gs * 6 + pair_idx(lo, hi);
        CLS[t] = cls; G2[(size_t)t * 2 + 0] = i0 < i1 ? w0 : w1; G2[(size_t)t * 2 + 1] = i0 < i1 ? w1 : w0;
        __hip_atomic_fetch_add(hist + cls, 1, __ATOMIC_RELAXED, __HIP_MEMORY_SCOPE_WORKGROUP); }
}

__device__ __forceinline__ void tr_item8(const float* W, int ldw, int k0, int scol0, unsigned char* WT, int ldo, int drow0, int dk0, LAS float* scr, int lane) {
#pragma unroll 8
    for (int i = 0; i < 32; ++i) { const int kk = 2 * i + (lane >> 5); scr[kk * 33 + (lane & 31)] = W[(size_t)(k0 + kk) * ldw + scol0 + (lane & 31)] * pg8::FS_W; }
    asm volatile("s_waitcnt lgkmcnt(0)" ::: "memory");
    const int c = lane & 7;
#pragma unroll
    for (int j = 0; j < 4; ++j) { const int n = (lane >> 3) + 8 * j; const LAS float* s = scr + (8 * c) * 33 + n;
        u32x2 o; o.x = pk_fp8x4(s[0 * 33], s[1 * 33], s[2 * 33], s[3 * 33]); o.y = pk_fp8x4(s[4 * 33], s[5 * 33], s[6 * 33], s[7 * 33]);
        *(u32x2*)(WT + (size_t)(drow0 + n) * ldo + dk0 + 8 * c) = o; }
    asm volatile("s_waitcnt lgkmcnt(0)" ::: "memory");
}
struct TrP { const float* src; const float* gk; unsigned char* dst; int ldw, ldo, fp8; };
__device__ __forceinline__ void tr_load(const TrP& P, int lane, float (&v)[32]) {
#pragma unroll
    for (int i = 0; i < 32; ++i) { const int kk = 2 * i + (lane >> 5); float x = P.src[(size_t)kk * P.ldw + (lane & 31)]; if (P.gk) x *= P.gk[kk]; v[i] = x; }
}
__device__ __forceinline__ void tr_store(const TrP& P, int lane, const float (&v)[32], LAS float* scr) {
    const float sc = P.fp8 ? pg8::FS_W : 1.0f;
#pragma unroll
    for (int i = 0; i < 32; ++i) scr[(2 * i + (lane >> 5)) * 33 + (lane & 31)] = v[i] * sc;
    asm volatile("s_waitcnt lgkmcnt(0)" ::: "memory");
    const int c = lane & 7;
#pragma unroll
    for (int j = 0; j < 4; ++j) { const int n = (lane >> 3) + 8 * j; const LAS float* s = scr + (8 * c) * 33 + n;
        if (P.fp8) { u32x2 o; o.x = pk_fp8x4(s[0 * 33], s[1 * 33], s[2 * 33], s[3 * 33]); o.y = pk_fp8x4(s[4 * 33], s[5 * 33], s[6 * 33], s[7 * 33]); *(u32x2*)(P.dst + (size_t)n * P.ldo + 8 * c) = o; }
        else { u32x4 o; o.x = cvt_pk_bf16(s[0 * 33], s[1 * 33]); o.y = cvt_pk_bf16(s[2 * 33], s[3 * 33]); o.z = cvt_pk_bf16(s[4 * 33], s[5 * 33]); o.w = cvt_pk_bf16(s[6 * 33], s[7 * 33]); *(u32x4*)(P.dst + (size_t)n * P.ldo + 16 * c) = o; } }
    asm volatile("s_waitcnt lgkmcnt(0)" ::: "memory");
}
struct Args { const float* in[34]; float* out; unsigned char* ws; };

__global__ void __launch_bounds__(512, 2) mega_fwd(Args a) {
    extern __shared__ __attribute__((aligned(16))) unsigned char lds_raw[];
    LAS unsigned char* lds = (LAS unsigned char*)lds_raw;
    volatile LAS unsigned* LW = (volatile LAS unsigned*)(lds + LDSCTL_OFF);
    volatile LAS int* LWI = (volatile LAS int*)(lds + LDSCTL_OFF);
    const int G = gridDim.x, bid0 = blockIdx.x; const int wave_s0 = __builtin_amdgcn_readfirstlane(threadIdx.x >> 6);
#define PHASE_IDS() int wv_ = wave_s0, bd_ = bid0; asm volatile("" : "+s"(wv_), "+s"(bd_)); const int wave_s = wv_, bid = bd_;     \
    const int lane = fresh_lane(), wave = wave_s, tid = wave * 64 + lane; const int gw = bid * 8 + wave, NGW = G * 8; \
    const size_t gt = (size_t)bid * 512 + tid, NGT = (size_t)G * 512; (void)lane; (void)wave; (void)gw; (void)NGW; (void)gt; (void)NGT
#define WSB() ({ unsigned char* _w = a.ws; asm volatile("" : "+s"(_w)); _w; })
#define INP(i) ({ int _k = (i); asm volatile("" : "+s"(_k)); a.in[_k]; })
    for (int u = threadIdx.x; u < (LDS_BYTES - LDSCTL_OFF) / 4; u += 512) LW[u] = 0u;
    __syncthreads();
    XcdBarrier bar = xcd_barrier_post((unsigned*)(a.ws + WS_CTL) + CW_BAR, LW + LW_BAR);

    {
        PHASE_IDS(); unsigned char* ws = WSB(); bf16_t* WIN = (bf16_t*)(ws + WS_WIN); bf16_t* WOUT = (bf16_t*)(ws + WS_WOUT); bf16_t* WGU = (bf16_t*)(ws + WS_WGU); bf16_t* WD2 = (bf16_t*)(ws + WS_WD2);
        bf16_t* HB = (bf16_t*)(ws + WS_HB); float* SSQ = (float*)(ws + WS_SSQ);
        LAS float* scr = (LAS float*)(lds + wave * 16384);
        constexpr int I_IN = 16 * 56, I_OUT = 16 * 32, I_GU = 2 * 16 * 256, I_D8 = 16 * 256, I_GLU = 32, I_RG = 24, I_L = I_IN + I_OUT + I_GU + I_D8 + I_GLU + I_RG;
        const float* i_win = INP(2); const float* i_g = INP(1); const float* i_wout = INP(24); const float* i_wg = INP(30); const float* i_wu = INP(31); const float* i_wd = INP(32);
        const float* i_glu = INP(21); const float* i_rg = INP(8); const float* i_ig = INP(10);
#define TR_DECODE(P, it) do { const int l = (it) / I_L; int r = (it) % I_L; P.gk = nullptr; P.fp8 = 0; \
            if (r < I_IN) { const int kb = r / 56, nb = r % 56, j0 = nb * 32; const int sc = j0 < 768 ? j0 : (j0 < 1152 ? j0 + 384 : (j0 < 1536 ? j0 - 384 : j0));     \
                P.src = i_win + (size_t)l * D * INC + (size_t)kb * 64 * INC + sc; P.ldw = INC; P.gk = i_g + (size_t)l * D + kb * 64; P.dst = (unsigned char*)(WIN + (size_t)l * INC * D + (size_t)j0 * D + kb * 64); P.ldo = D * 2; } \
            else if ((r -= I_IN) < I_OUT) { const int kb = r / 32, nb = r % 32; P.src = i_wout + (size_t)l * D * D + (size_t)kb * 64 * D + nb * 32; P.ldw = D; P.dst = (unsigned char*)(WOUT + (size_t)l * D * D + (size_t)nb * 32 * D + kb * 64); P.ldo = D * 2; } \
            else if ((r -= I_OUT) < I_GU) { const int which = r / (16 * 256), e = (r / 256) % 16, q = r % 256, kb = q / 16, nb = q % 16, n0 = nb * 32;     \
                P.src = (which ? i_wu : i_wg) + ((size_t)l * NE + e) * D * DE + (size_t)kb * 64 * DE + n0; P.ldw = DE; P.fp8 = 1; \
                P.dst = (unsigned char*)WGU + ((size_t)l * NE + e) * 1024 * 1024 + (size_t)((n0 / 128) * 256 + which * 128 + (n0 % 128)) * 1024 + kb * 64; P.ldo = 1024; } \
            else if ((r -= I_GU) < I_D8) { const int e = r / 256, q = r % 256, kb = q / 32, nb = q % 32;        \
                P.src = i_wd + ((size_t)l * NE + e) * DE * D + (size_t)kb * 64 * D + nb * 32; P.ldw = D; P.fp8 = 1; P.dst = ws + WS_WD8 + ((size_t)l * NE + e) * 1024 * 512 + (size_t)nb * 32 * 512 + kb * 64; P.ldo = 512; } \
            else if ((r -= I_D8) < I_GLU) { const int kb = r / 8, nb = r % 8; P.src = i_glu + (size_t)l * CW * CW + (size_t)kb * 64 * CW + nb * 32; P.ldw = CW; P.dst = (unsigned char*)((bf16_t*)(ws + WS_WGLU) + (size_t)l * CW * CW + (size_t)nb * 32 * CW + kb * 64); P.ldo = CW * 2; } \
            else { r -= I_GLU; const int gate = r / 12, h = (r / 2) % 6, nb = r & 1; \
                P.src = (gate ? i_ig : i_rg) + ((size_t)l * 6 + h) * 64 * 64 + nb * 32; P.ldw = 64; P.dst = (unsigned char*)((bf16_t*)(ws + WS_WRG) + (((size_t)l * 2 + gate) * 6 + h) * 64 * 64 + (size_t)nb * 32 * 64); P.ldo = 64 * 2; } } while (0)
        { TrP Pa, Pb; float va[32], vb[32]; int it = gw;
          if (it < 2 * I_L) { TR_DECODE(Pa, it); tr_load(Pa, lane, va); }
#pragma unroll 1
          while (it < 2 * I_L) {
              const int it1 = it + NGW; if (it1 < 2 * I_L) { TR_DECODE(Pb, it1); tr_load(Pb, lane, vb); }
              tr_store(Pa, lane, va, scr);
              if (it1 >= 2 * I_L) break;
              const int it2 = it1 + NGW; if (it2 < 2 * I_L) { TR_DECODE(Pa, it2); tr_load(Pa, lane, va); }
              tr_store(Pb, lane, vb, scr);
              it = it2; } }
#undef TR_DECODE
        { const float* s_are = INP(13); const float* s_aim = INP(14); const float* s_ldt = INP(15); const float* s_bre = INP(16); const float* s_bim = INP(17); const float* s_cre = INP(18); const float* s_cim = INP(19); const float* s_d = INP(20);
          for (size_t e = gt; e < (size_t)2 * CG * 256; e += NGT) { const int l = (int)(e / (CG * 256)), g = (int)((e / 256) % CG), c = (int)((e >> 4) & 15), cp = (int)(e & 15);
              s5_kt_pair(g, c, cp, s_are + (size_t)l * CG * CS, s_aim + (size_t)l * CG * CS, s_ldt + (size_t)l * CG, s_bre + (size_t)l * CG * CS * CGD, s_bim + (size_t)l * CG * CS * CGD,
                         s_cre + (size_t)l * CG * CGD * CS, s_cim + (size_t)l * CG * CGD * CS, s_d + (size_t)l * CW, ws + WS_S5 + (size_t)l * S5_L_STRIDE); }
          for (size_t e = gt; e < (size_t)2 * CG * 2048; e += NGT) { const int l = (int)(e / (CG * 2048)), g = (int)((e / 2048) % CG), r = (int)(e & 2047);
              s5_et_task(g, r >> 10, (r >> 4) & 63, r & 15, s_are + (size_t)l * CG * CS, s_aim + (size_t)l * CG * CS, s_ldt + (size_t)l * CG, s_bre + (size_t)l * CG * CS * CGD, s_bim + (size_t)l * CG * CS * CGD, ws + WS_S5 + (size_t)l * S5_L_STRIDE);
              s5_ft_task(g, r >> 7, (r >> 6) & 1, r & 63, s_are + (size_t)l * CG * CS, s_aim + (size_t)l * CG * CS, s_ldt + (size_t)l * CG, s_cre + (size_t)l * CG * CGD * CS, s_cim + (size_t)l * CG * CGD * CS, ws + WS_S5 + (size_t)l * S5_L_STRIDE); }
          for (size_t e = gt; e < (size_t)2 * CG * 64; e += NGT) { const int l = (int)(e / (CG * 64)), g = (int)((e / 64) % CG), el = 4096 + 32768 + (int)(e % 64);
              s5_table_elem(g, el, s_are + (size_t)l * CG * CS, s_aim + (size_t)l * CG * CS, s_ldt + (size_t)l * CG, s_bre + (size_t)l * CG * CS * CGD, s_bim + (size_t)l * CG * CS * CGD,
                            s_cre + (size_t)l * CG * CGD * CS, s_cim + (size_t)l * CG * CGD * CS, s_d + (size_t)l * CW, ws + WS_S5 + (size_t)l * S5_L_STRIDE); } }
        { const float* sw = INP(4); bf16_t* wsp = (bf16_t*)(ws + WS_WSP); for (size_t e = gt; e < (size_t)2 * 6 * 128 * 128; e += NGT) wsp[e] = f2bf(sw[e]); }
        { const float* fg = INP(25); const float* rgw = INP(26); const float* rew = INP(28); bf16_t* wrt = (bf16_t*)(ws + WS_WRT);
          for (size_t e = gt; e < (size_t)2 * 48 * D; e += NGT) { const int l = (int)(e / (48 * D)), n = (int)((e / D) % 48), k = (int)(e % D);
              int j = -1, lo = 0; if (n < 16) j = n; else if (n < 32) { j = n - 16; lo = 1; } else if (n < 36) j = 16 + (n - 32); else if (n < 40) { j = 16 + (n - 36); lo = 1; }
              float v = 0.f;
              if (j >= 0) { const float w = fg[(size_t)l * D + k] * (j < 4 ? rgw[((size_t)l * D + k) * 4 + j] : rew[(((size_t)l * 4 + ((j - 4) >> 2)) * D + k) * 4 + ((j - 4) & 3)]);
                  const float hi = bf2f(f2bf(w)); v = lo ? (w - hi) : w; }
              wrt[e] = f2bf(v); } }
        const float* xin = INP(0);
#pragma unroll 1
        for (int t = gw * 2; t < T; t += NGW * 2) {
            const f32x4* xr = (const f32x4*)(xin + (size_t)t * D) + lane; f32x4 v[2][4]; float s0 = 0.f, s1 = 0.f;
#pragma unroll
            for (int j = 0; j < 4; ++j) { v[0][j] = xr[64 * j]; v[1][j] = xr[256 + 64 * j]; }
#pragma unroll
            for (int j = 0; j < 4; ++j) { s0 += (v[0][j][0] * v[0][j][0] + v[0][j][1] * v[0][j][1]) + (v[0][j][2] * v[0][j][2] + v[0][j][3] * v[0][j][3]); s1 += (v[1][j][0] * v[1][j][0] + v[1][j][1] * v[1][j][1]) + (v[1][j][2] * v[1][j][2] + v[1][j][3] * v[1][j][3]); }
            u32x2* o8 = (u32x2*)(HB + (size_t)t * D) + lane;
#pragma unroll
            for (int j = 0; j < 4; ++j) { u32x2 w; w.x = cvt_pk_bf16(v[0][j][0], v[0][j][1]); w.y = cvt_pk_bf16(v[0][j][2], v[0][j][3]); o8[64 * j] = w; w.x = cvt_pk_bf16(v[1][j][0], v[1][j][1]); w.y = cvt_pk_bf16(v[1][j][2], v[1][j][3]); o8[256 + 64 * j] = w; }
            s0 = wave_sum(s0); s1 = wave_sum(s1);
            if (lane < 32) SSQ[(size_t)t * 16 + lane] = lane == 0 ? s0 : (lane == 16 ? s1 : 0.f);
        }
    }
    xcd_barrier(bar);

    for (int l = 0; l < DEPTH; ++l) {
        { PHASE_IDS(); unsigned char* ws = WSB(); bf16_t* WIN = (bf16_t*)(ws + WS_WIN); bf16_t* HB = (bf16_t*)(ws + WS_HB); float* SSQ = (float*)(ws + WS_SSQ); bf16_t* Z = (bf16_t*)(ws + WS_Z);
          pg8::StaticOrder<T, INC> S; S.init(HB, WIN + (size_t)l * INC * D, G, bid);
          pg8::EpiZ E{Z, SSQ};
          pg8::gemm_phase<pg8::EpiZ, pg8::StaticOrder<T, INC>, true, true>(lds, wave_s, S, E); }
        xcd_barrier(bar);

        {
            PHASE_IDS(); unsigned char* ws = WSB(); const bf16_t* Z = (const bf16_t*)(ws + WS_Z);
            const float* conv_w = INP(6) + (size_t)l * 4 * BW; const float* conv_b = INP(7) + (size_t)l * BW; const float* rg_b = INP(9) + (size_t)l * BW;
            const float* ig_b = INP(11) + (size_t)l * BW; const float* lam = INP(12) + (size_t)l * BW;
            __syncthreads();
            { const bf16_t* WRG = (const bf16_t*)(ws + WS_WRG) + ((size_t)l * 2 + 0) * 6 * 4096; const bf16_t* WIG = (const bf16_t*)(ws + WS_WRG) + ((size_t)l * 2 + 1) * 6 * 4096;
              for (int pr = bid; pr < NU128 / 2; pr += G) { float cp = 0.f;
                  rglru_unit<1>(2 * pr, true, cp, tid, wave, lane, Z, nullptr, WRG, WIG, conv_w, conv_b, rg_b, ig_b, lam, nullptr, (float*)(ws + WS_SUMA), (float*)(ws + WS_SUMH), (float*)(ws + WS_SUMA2), (float*)(ws + WS_SUMH2), (bf16_t*)(ws + WS_HL), (bf16_t*)(ws + WS_PP), lds);
                  rglru_unit<1>(2 * pr + 1, false, cp, tid, wave, lane, Z, nullptr, WRG, WIG, conv_w, conv_b, rg_b, ig_b, lam, nullptr, (float*)(ws + WS_SUMA), (float*)(ws + WS_SUMH), (float*)(ws + WS_SUMA2), (float*)(ws + WS_SUMH2), (bf16_t*)(ws + WS_HL), (bf16_t*)(ws + WS_PP), lds); } }
            for (int pr = bid; pr < NU128 / 2; pr += G) { const unsigned char* tab = ws + WS_S5 + (size_t)l * S5_L_STRIDE;
                s5_pair1(pr, 2 * wave, wave, lane, Z, (bf16_t*)(ws + WS_Y), tab, (float*)(ws + WS_SEND), (float*)(ws + WS_SEND2), (float*)(ws + WS_SE), lds);
                s5_pair1(pr, 2 * wave + 1, wave, lane, Z, (bf16_t*)(ws + WS_Y), tab, (float*)(ws + WS_SEND), (float*)(ws + WS_SEND2), (float*)(ws + WS_SE), lds); }
            __syncthreads();
            { const bf16_t* WSP = (const bf16_t*)(ws + WS_WSP) + (size_t)l * 6 * 128 * 128; const float* a_sb = INP(5) + (size_t)l * 6 * 128; const float* vg = INP(3) + (size_t)l * AW; const float* mo_ga = INP(23) + (size_t)l * D;
              for (int u = bid; u < NU128; u += G) mixa_unit(u, tid, wave, lane, Z, (bf16_t*)(ws + WS_Y), WSP, a_sb, vg, mo_ga, lds); }
        }
        xcd_barrier(bar);

        {
            PHASE_IDS(); unsigned char* ws = WSB(); const bf16_t* Z = (const bf16_t*)(ws + WS_Z); bf16_t* Y = (bf16_t*)(ws + WS_Y);
            const float* a_v_norm_g = INP(3) + (size_t)l * AW; const float* a_sw = INP(4) + (size_t)l * 6 * 128 * 128; const float* a_sb = INP(5) + (size_t)l * 6 * 128;
        }

        { PHASE_IDS(); unsigned char* ws = WSB(); const bf16_t* Z = (const bf16_t*)(ws + WS_Z); bf16_t* Y = (bf16_t*)(ws + WS_Y);
          { const float* mo_gb = INP(23) + (size_t)l * D + AW;
            __syncthreads();
            for (int pr = bid; pr < NU128 / 2; pr += G) rglru_fix_pair(pr, tid, wave, lane, Z, Y, (const bf16_t*)(ws + WS_HL), (const bf16_t*)(ws + WS_PP), (const float*)(ws + WS_SUMA2), (const float*)(ws + WS_SUMH2), mo_gb, lds); }
          { const bf16_t* WGLU = (const bf16_t*)(ws + WS_WGLU) + (size_t)l * CW * CW; const float* glu_b = INP(22) + (size_t)l * CW; const float* mo_gc = INP(23) + (size_t)l * D + AW + BW;
            for (int pr = bid; pr < NU128 / 2; pr += G) { float k0r = 0.f, k0i = 0.f, k1r = 0.f, k1i = 0.f; const unsigned char* tab = ws + WS_S5 + (size_t)l * S5_L_STRIDE;
#pragma unroll 1
                for (int ui = 0; ui < 2; ++ui) { const int u = 2 * pr + ui; __syncthreads();
                    s5_group<2>(u, 2 * wave, ui == 0, k0r, k0i, wave, lane, Z, Y, tab, (float*)(ws + WS_SEND), (float*)(ws + WS_SEND2), (float*)(ws + WS_SE), lds);
                    s5_group<2>(u, 2 * wave + 1, ui == 0, k1r, k1i, wave, lane, Z, Y, tab, (float*)(ws + WS_SEND), (float*)(ws + WS_SEND2), (float*)(ws + WS_SE), lds);
                    __syncthreads(); s5_glu(u, wave, lane, WGLU, glu_b, mo_gc, Y, lds); } } } }
        xcd_barrier(bar);

        { PHASE_IDS(); unsigned char* ws = WSB(); bf16_t* WOUT = (bf16_t*)(ws + WS_WOUT); bf16_t* HB = (bf16_t*)(ws + WS_HB); float* SSQ = (float*)(ws + WS_SSQ); bf16_t* Y = (bf16_t*)(ws + WS_Y);
          pg8::StaticOrder<T, D> S; S.init(Y, WOUT + (size_t)l * D * D, G, bid);
          pg8::EpiRes<false> E{HB, SSQ, nullptr};
          pg8::gemm_phase<pg8::EpiRes<false>, pg8::StaticOrder<T, D>, true, true>(lds, wave_s, S, E); }
        xcd_barrier(bar);

        { PHASE_IDS(); unsigned char* ws = WSB(); const bf16_t* HB = (const bf16_t*)(ws + WS_HB); const float* SSQ = (const float*)(ws + WS_SSQ); int* CLS = (int*)(ws + WS_CLS); float* G2 = (float*)(ws + WS_G2); int* HIST = (int*)(ws + WS_HIST);
          const float* rgb = INP(27) + (size_t)l * 4; const float* reb = INP(29) + (size_t)l * 16;
        if (l == 0) {
            for (int rr = gw; rr < 2 * NCLS * 2 * 1024 / 2; rr += NGW) { const int row = 2 * rr + (lane >> 5), n = row & 1023, half = (row >> 10) & 1, cls = (row >> 11) % NCLS, ll = row / (2048 * NCLS);
                const int g = cls / 6, pi = cls % 6, e = g * 4 + (half ? pair_hi(pi) : pair_lo(pi));
                const u32x4 v = *(const u32x4*)(ws + WS_WD8 + ((size_t)ll * NE + e) * 1024 * 512 + (size_t)n * 512 + (lane & 31) * 16);
                *(u32x4*)(ws + WS_WD2 + ((size_t)ll * NCLS + cls) * 1024 * 1024 + (size_t)n * 1024 + half * 512 + (lane & 31) * 16) = v; } }
        for (int u = bid; u < NU; u += G) {
            router_unit(u, wave, lane, HB, SSQ, (const bf16_t*)(ws + WS_WRT) + (size_t)l * 48 * D, rgb, reb, CLS, G2, lds, (LAS int*)(lds + LDSCTL_OFF) + LW_HIST);
            __syncthreads();
            if (tid < 32) { HIST[u * 32 + tid] = tid < NCLS ? LWI[LW_HIST + tid] : 0; LWI[LW_HIST + tid] = 0; }
            __syncthreads();
        } }
        xcd_barrier(bar);

        { PHASE_IDS(); unsigned char* ws = WSB(); const bf16_t* HB = (const bf16_t*)(ws + WS_HB); const float* SSQ = (const float*)(ws + WS_SSQ); const int* CLS = (const int*)(ws + WS_CLS); const float* G2 = (const float*)(ws + WS_G2); const int* HIST = (const int*)(ws + WS_HIST);
          int* CTOT = (int*)(ws + WS_CTOT); int* ROWTOK = (int*)(ws + WS_ROWTOK); float* ROWG = (float*)(ws + WS_ROWG); bf16_t* HBS = (bf16_t*)(ws + WS_HBS); const float* ffn_g = INP(25) + (size_t)l * D;
        for (int u = bid; u < NU; u += G) {
            { const int c = tid & 31, part = tid >> 5; int tot = 0, pre = 0;
_Pragma("unroll 16")
              for (int k = part * 16; k < part * 16 + 16; ++k) { const int v = HIST[k * 32 + c]; tot += v; pre += k < u ? v : 0; }
              ((volatile LAS int*)lds)[tid] = tot; ((volatile LAS int*)lds)[512 + tid] = pre; }
            __syncthreads();
            if (tid < NCLS) { int tot = 0, pre = 0;
_Pragma("unroll")
                for (int k = 0; k < 16; ++k) { tot += ((volatile LAS int*)lds)[k * 32 + tid]; pre += ((volatile LAS int*)lds)[512 + k * 32 + tid]; } LWI[LW_TOT + tid] = tot; LWI[LW_BASE + tid] = pre; }
            __syncthreads();
            if (tid == 0) { int ps = 0;
_Pragma("unroll 1")
                for (int c = 0; c < NCLS; ++c) { const int tot = LWI[LW_TOT + c]; LWI[LW_BASE + c] += ps; LWI[LW_TST + c] = ps; ps += ((tot + 255) >> 8) << 8; if (bid == 0) CTOT[c] = tot; } LWI[LW_TST + NCLS] = ps; }
            if (tid < UT) LWI[LW_CLS + tid] = CLS[u * UT + tid];
            __syncthreads();
            if (tid < UT) { const int cls = LWI[LW_CLS + tid]; int rank = 0;
_Pragma("unroll 1")
                for (int i = 0; i < tid; ++i) rank += LWI[LW_CLS + i] == cls ? 1 : 0;
                const int dest = LWI[LW_BASE + cls] + rank; LWI[LW_DEST + tid] = dest; const int t = u * UT + tid;
                ROWTOK[dest] = t; ROWG[(size_t)dest * 2 + 0] = G2[(size_t)t * 2 + 0]; ROWG[(size_t)dest * 2 + 1] = G2[(size_t)t * 2 + 1]; }
            __syncthreads();
            { f32x4 gq[4];
#pragma unroll
              for (int j = 0; j < 4; ++j) gq[j] = *(const f32x4*)(ffn_g + lane * 16 + 4 * j);
#pragma unroll 1
              for (int i = 0; i < 32; i += 4) {
                  const int tl0 = wave * 32 + i, t0r = u * UT + tl0;
                  float sq = SSQ[(size_t)t0r * 16 + lane]; sq += x_xor1(sq); sq += x_xor2(sq); sq += x_hmir(sq); sq += x_mir(sq);
                  u32x4 o[4][2]; int dst[4];
#pragma unroll
                  for (int j = 0; j < 4; ++j) { o[j][0] = *(const u32x4*)(HB + (size_t)(t0r + j) * D + lane * 16); o[j][1] = *(const u32x4*)(HB + (size_t)(t0r + j) * D + lane * 16 + 8); dst[j] = LWI[LW_DEST + tl0 + j]; }
#pragma unroll
                  for (int j = 0; j < 4; ++j) { const float r4 = rsqrtf(__builtin_amdgcn_readlane(sq, 16 * j) * (1.0f / D) + EPS) * pg8::FS_H; u32x4 w;
#pragma unroll
                      for (int hh = 0; hh < 2; ++hh) { const u32x4 oo = o[j][hh]; const f32x4 g0 = gq[2 * hh], g1 = gq[2 * hh + 1];
                          const unsigned lo = pk_fp8x4(__uint_as_float(oo.x << 16) * r4 * g0[0], __uint_as_float(oo.x & 0xffff0000u) * r4 * g0[1], __uint_as_float(oo.y << 16) * r4 * g0[2], __uint_as_float(oo.y & 0xffff0000u) * r4 * g0[3]);
                          const unsigned hi = pk_fp8x4(__uint_as_float(oo.z << 16) * r4 * g1[0], __uint_as_float(oo.z & 0xffff0000u) * r4 * g1[1], __uint_as_float(oo.w << 16) * r4 * g1[2], __uint_as_float(oo.w & 0xffff0000u) * r4 * g1[3]);
                          if (hh == 0) { w.x = lo; w.y = hi; } else { w.z = lo; w.w = hi; } }
                      *(u32x4*)((unsigned char*)HBS + (size_t)dst[j] * D + lane * 16) = w; } } }
            if (u == bid)
_Pragma("unroll 1")
            for (int c = bid; c < NCLS; c += G) { const int tot = LWI[LW_TOT + c], r0 = LWI[LW_TST + c] + tot, r1 = LWI[LW_TST + c + 1];
                unsigned zz = 0u; asm volatile("" : "+v"(zz));
                for (int r = r0 + wave; r < r1; r += 8) { if (lane == 0) { ROWTOK[r] = -1; ROWG[(size_t)r * 2] = __uint_as_float(zz); ROWG[(size_t)r * 2 + 1] = __uint_as_float(zz); }
                    *(u32x4*)((unsigned char*)HBS + (size_t)r * D + lane * 16) = (u32x4){zz, zz, zz, zz}; } }
            __syncthreads();
        } }
        xcd_barrier(bar);

        { PHASE_IDS(); unsigned char* ws = WSB(); const int* CTOT = (const int*)(ws + WS_CTOT); bf16_t* HBS = (bf16_t*)(ws + WS_HBS); bf16_t* WGU = (bf16_t*)(ws + WS_WGU); bf16_t* ACT = (bf16_t*)(ws + WS_ACT); const float* ROWG = (const float*)(ws + WS_ROWG);
        if (tid == 0) { int ps = 0;
_Pragma("unroll 1")
            for (int c = 0; c < NCLS; ++c) { LWI[LW_TST + c] = ps; ps += (CTOT[c] + 255) >> 8; } LWI[LW_TST + NCLS] = ps; }
        __syncthreads();
        if (tid < 32) { const int ntile = LWI[LW_TST + NCLS]; const long L = (long)tid * G + bid; int e = -1;
            if (L < (long)ntile * 8) { const int mt = (int)(L / 8), pn = (int)(L % 8); int cls = 0;
_Pragma("unroll 1")
                for (int k = 1; k < NCLS; ++k) cls += (LWI[LW_TST + k] <= mt) ? 1 : 0;
                e = (cls << 24) | (pn << 16) | mt; }
            LWI[LW_UTAB + tid] = e; e = -1;
            if (L < (long)ntile * 4) { const int mt = (int)(L / 4), pn = (int)(L % 4); int cls = 0;
_Pragma("unroll 1")
                for (int k = 1; k < NCLS; ++k) cls += (LWI[LW_TST + k] <= mt) ? 1 : 0;
                e = (cls << 24) | (pn << 16) | mt; }
            LWI[LW_DTAB + tid] = e; }
        __syncthreads();
        { pg8::MoeOrder<8, true, 1024> S{LWI + LW_UTAB, l, (const char*)HBS, (const char*)WGU};
          pg8::EpiUp E{(unsigned char*)ACT, ROWG};
          pg8::gemm_phase<pg8::EpiUp, pg8::MoeOrder<8, true, 1024>, true, true, 512, true>(lds, wave_s, S, E); } }
        xcd_barrier(bar);

        { PHASE_IDS(); unsigned char* ws = WSB(); bf16_t* ACT = (bf16_t*)(ws + WS_ACT); bf16_t* WD2 = (bf16_t*)(ws + WS_WD2); bf16_t* HB = (bf16_t*)(ws + WS_HB); float* SSQ = (float*)(ws + WS_SSQ); const int* ROWTOK = (const int*)(ws + WS_ROWTOK);
          pg8::MoeOrder<4, false, 1024> S{LWI + LW_DTAB, l, (const char*)ACT, (const char*)WD2};
          pg8::EpiRes<true> E{HB, SSQ, ROWTOK};
          pg8::gemm_phase<pg8::EpiRes<true>, pg8::MoeOrder<4, false, 1024>, true, true, 512, true>(lds, wave_s, S, E); }
        xcd_barrier(bar);
    }

    { PHASE_IDS(); unsigned char* ws = WSB(); const bf16_t* HB = (const bf16_t*)(ws + WS_HB); const float* SSQ = (const float*)(ws + WS_SSQ); const float* fg = INP(33); float* outp = a.out;
    { f32x4 gq[4];
#pragma unroll
      for (int j = 0; j < 4; ++j) gq[j] = *(const f32x4*)(fg + lane * 16 + 4 * j);
#pragma unroll 1
      for (int t0r = gw * 4; t0r < T; t0r += NGW * 4) {
          float sq = SSQ[(size_t)t0r * 16 + lane]; sq += x_xor1(sq); sq += x_xor2(sq); sq += x_hmir(sq); sq += x_mir(sq);
          u32x4 o[4][2];
#pragma unroll
          for (int j = 0; j < 4; ++j) { o[j][0] = *(const u32x4*)(HB + (size_t)(t0r + j) * D + lane * 16); o[j][1] = *(const u32x4*)(HB + (size_t)(t0r + j) * D + lane * 16 + 8); }
#pragma unroll
          for (int j = 0; j < 4; ++j) { const float r = rsqrtf(__builtin_amdgcn_readlane(sq, 16 * j) * (1.0f / D) + EPS); float* orow = outp + (size_t)(t0r + j) * D + lane * 16;
#pragma unroll
              for (int hh = 0; hh < 2; ++hh) { const u32x4 oo = o[j][hh]; const f32x4 g0 = gq[2 * hh], g1 = gq[2 * hh + 1]; f32x4 w0, w1;
                  w0[0] = __uint_as_float(oo.x << 16) * r * g0[0]; w0[1] = __uint_as_float(oo.x & 0xffff0000u) * r * g0[1]; w0[2] = __uint_as_float(oo.y << 16) * r * g0[2]; w0[3] = __uint_as_float(oo.y & 0xffff0000u) * r * g0[3];
                  w1[0] = __uint_as_float(oo.z << 16) * r * g1[0]; w1[1] = __uint_as_float(oo.z & 0xffff0000u) * r * g1[1]; w1[2] = __uint_as_float(oo.w << 16) * r * g1[2]; w1[3] = __uint_as_float(oo.w & 0xffff0000u) * r * g1[3];
                  *(f32x4*)(orow + 8 * hh) = w0; *(f32x4*)(orow + 8 * hh + 4) = w1; } } } }
}
}

extern "C" void kernel_launch(void* const* d_in, const int* in_sizes, int n_in, void* d_out, int out_size, void* d_ws, size_t ws_size, hipStream_t stream) {
    static int grid = 0;
    if (grid == 0) {
        if (n_in != 34 || in_sizes[0] != T * D || out_size != T * D || ws_size < WS_END) { fprintf(stderr, "kernel_launch: unexpected shapes (n_in %d, ws %zu)\n", n_in, ws_size); grid = -1; return; }
        int dev = 0, cus = 0, per_cu = 0;
        if (hipGetDevice(&dev) != hipSuccess || hipDeviceGetAttribute(&cus, hipDeviceAttributeMultiprocessorCount, dev) != hipSuccess) { grid = -1; return; }
        if (hipFuncSetAttribute((const void*)mega_fwd, hipFuncAttributeMaxDynamicSharedMemorySize, LDS_BYTES) != hipSuccess) { fprintf(stderr, "kernel_launch: hipFuncSetAttribute failed\n"); grid = -1; return; }
        if (hipOccupancyMaxActiveBlocksPerMultiprocessor(&per_cu, (const void*)mega_fwd, 512, LDS_BYTES) != hipSuccess || per_cu < 1) { fprintf(stderr, "kernel_launch: occupancy query says %d\n", per_cu); }
        (void)hipGetLastError();
        grid = cus;
    }
    if (grid < 0) return;
    (void)hipMemsetAsync((char*)d_ws + WS_CTL, 0, CTL_ZERO_BYTES, stream);
    Args a{};
    for (int i = 0; i < 34; ++i) a.in[i] = (const float*)d_in[i];
    a.out = (float*)d_out; a.ws = (unsigned char*)d_ws;
    hipLaunchKernelGGL(mega_fwd, dim3(grid), dim3(512), LDS_BYTES, stream, a);
}
```

```cpp
#include <hip/hip_runtime.h>
#include <cstdio>
#include <cstdint>

#define LAS __attribute__((address_space(3)))
typedef unsigned short bf16_t;
typedef short bf16x8 __attribute__((ext_vector_type(8)));
typedef float f32x4 __attribute__((ext_vector_type(4)));
typedef float f32x2 __attribute__((ext_vector_type(2)));
typedef unsigned u32x4 __attribute__((ext_vector_type(4)));
typedef unsigned u32x2 __attribute__((ext_vector_type(2)));
typedef int i32x4 __attribute__((ext_vector_type(4)));
typedef int i32x8 __attribute__((ext_vector_type(8)));

constexpr int D = 1024, BATCH = 8, SEQ = 8192, T = BATCH * SEQ, DEPTH = 2;
constexpr int AW = 384, BW = 384, CW = 256, HD = 64, ABLK = 128, CHUNK = 64;
constexpr int INC = 1792;
constexpr int ZU = 0, ZV = 384, ZG = 768, ZX = 1152, ZC = 1536, ZGELU_END = 1152;
constexpr int CG = 16, CGD = 16, CS = 64;
constexpr int NE = 16, DE = 512, NCLS = 24;
constexpr float EPS = 1e-6f;
constexpr int UT = 256;
constexpr int NU = T / UT;
constexpr int MAXROWS = T + NCLS * 256;

constexpr size_t MiB = 1u << 20;
constexpr size_t WS_CTL = 0, CTL_ZERO_BYTES = 1 * MiB;
constexpr size_t WS_WIN = 2 * MiB;
constexpr size_t WS_WOUT = 10 * MiB;
constexpr size_t WS_WGLU = 14 * MiB;
constexpr size_t WS_WRG = 15 * MiB;
constexpr size_t WS_WSP = 15 * MiB + 256 * 1024;
constexpr size_t WS_WRT = 15 * MiB + 768 * 1024;
constexpr size_t WS_WGU = 16 * MiB;
constexpr size_t WS_WD8 = 48 * MiB;
constexpr size_t WS_WD2 = 80 * MiB;
constexpr size_t WS_SSQ = 176 * MiB;
constexpr size_t WS_RS = 180 * MiB;
constexpr size_t WS_CLS = WS_RS + 256 * 1024;
constexpr size_t WS_G2 = WS_CLS + 256 * 1024;
constexpr size_t WS_HIST = 181 * MiB;
constexpr size_t WS_CTOT = WS_HIST + 64 * 1024;
constexpr size_t WS_ROWTOK = WS_HIST + 256 * 1024;
constexpr size_t WS_ROWG = 182 * MiB;
constexpr size_t WS_SUMA = 183 * MiB;
constexpr size_t WS_SUMH = 191 * MiB;
constexpr size_t WS_S5 = 184 * MiB;
constexpr size_t WS_SEND = 187 * MiB;
constexpr size_t WS_HB = 192 * MiB;
constexpr size_t WS_Z = 320 * MiB;
constexpr size_t WS_HBS = WS_Z;
constexpr size_t WS_Y = 544 * MiB;
constexpr size_t WS_ACT = 672 * MiB;
constexpr size_t WS_HL = 672 * MiB;
constexpr size_t WS_PP = 736 * MiB;
constexpr size_t WS_SE = 800 * MiB;
constexpr size_t WS_AV = 672 * MiB;
constexpr size_t WS_BV = 768 * MiB;
constexpr size_t WS_SEND2 = 864 * MiB;
constexpr size_t WS_SUMA2 = 866 * MiB;
constexpr size_t WS_SUMH2 = 867 * MiB;
constexpr size_t WS_END = 868 * MiB;
constexpr int CW_BAR = 4096;

constexpr int RING_BYTES = 131072;
constexpr int LDSCTL_OFF = 143360;
constexpr int LDS_BYTES = 147456;
constexpr int LW_BAR = 8, LW_TST = 64, LW_HIST = 96, LW_TOT = 128, LW_BASE = 160, LW_CLS = 256  , LW_DEST = 512  , LW_UTAB = 768  , LW_DTAB = 800  ;

__device__ __forceinline__ float bf2f(bf16_t v) { return __uint_as_float(((unsigned)v) << 16); }
__device__ __forceinline__ unsigned cvt_pk_bf16(float lo, float hi) { unsigned r; asm volatile("v_cvt_pk_bf16_f32 %0, %1, %2" : "=v"(r) : "v"(lo), "v"(hi)); return r; }
__device__ __forceinline__ bf16_t f2bf(float v) { return (bf16_t)(cvt_pk_bf16(v, 0.f) & 0xffffu); }
__device__ __forceinline__ unsigned pk_fp8x4(float a, float b, float c, float d) {
    a = fminf(fmaxf(a, -448.f), 448.f); b = fminf(fmaxf(b, -448.f), 448.f); c = fminf(fmaxf(c, -448.f), 448.f); d = fminf(fmaxf(d, -448.f), 448.f);
    int r = __builtin_amdgcn_cvt_pk_fp8_f32(a, b, 0, false); r = __builtin_amdgcn_cvt_pk_fp8_f32(c, d, r, true); return (unsigned)r; }
__device__ __forceinline__ int fresh_lane() { unsigned z = 0u; asm volatile("" : "+s"(z)); return (int)__builtin_amdgcn_mbcnt_hi(~0u, __builtin_amdgcn_mbcnt_lo(~0u, z)); }
__device__ __forceinline__ float x_xor1(float v) { return __int_as_float(__builtin_amdgcn_update_dpp(0, __float_as_int(v), 0xB1, 0xf, 0xf, true)); }
__device__ __forceinline__ float x_xor2(float v) { return __int_as_float(__builtin_amdgcn_update_dpp(0, __float_as_int(v), 0x4E, 0xf, 0xf, true)); }
__device__ __forceinline__ float x_hmir(float v) { return __int_as_float(__builtin_amdgcn_update_dpp(0, __float_as_int(v), 0x141, 0xf, 0xf, true)); }
__device__ __forceinline__ float x_mir(float v) { return __int_as_float(__builtin_amdgcn_update_dpp(0, __float_as_int(v), 0x140, 0xf, 0xf, true)); }
__device__ __forceinline__ float x_xor16(float v) { return __int_as_float(__builtin_amdgcn_ds_swizzle(__float_as_int(v), 0x401F)); }
__device__ __forceinline__ float add_xor32(float v) { const auto r = __builtin_amdgcn_permlane32_swap(__float_as_uint(v), __float_as_uint(v), false, false); return __uint_as_float(r[0]) + __uint_as_float(r[1]); }
__device__ __forceinline__ float add_x16_x32(float v) { v += x_xor16(v); return add_xor32(v); }
__device__ __forceinline__ float wave_sum(float v) { v += x_xor1(v); v += x_xor2(v); v += x_hmir(v); v += x_mir(v); v += x_xor16(v); return add_xor32(v); }
__device__ __forceinline__ float gelu_fast(float x) {
    const float u2 = 1.5957691216057308f * (x + 0.044715f * x * x * x);
    const float e = __builtin_amdgcn_exp2f(-1.4426950408889634f * u2);
    return x * __builtin_amdgcn_rcpf(1.0f + e);
}
__device__ __forceinline__ float sigmoid_fast(float x) { return __builtin_amdgcn_rcpf(1.0f + __builtin_amdgcn_exp2f(-1.4426950408889634f * x)); }
__device__ __forceinline__ float sigmoid_f(float x) { return 1.0f / (1.0f + expf(-x)); }
__device__ __forceinline__ int pair_lo(int pi) { return pi < 3 ? 0 : (pi < 5 ? 1 : 2); }
__device__ __forceinline__ int pair_hi(int pi) { return pi < 3 ? pi + 1 : (pi < 5 ? pi - 1 : 3); }
__device__ __forceinline__ int pair_idx(int lo, int hi) { return lo == 0 ? hi - 1 : (lo == 1 ? hi + 1 : 5); }

#define XB_TMO      128
#define XB_XCNT(j)  (256  + 64 * (j))
#define XB_XSUB(j)  (1280 + 64 * (j))
#define XB_XGEN(j)  (2304 + 64 * (j))
#define XB_TOP      3328
#define XB_TOPGEN   3392
#define XCD_BAR_WORDS 3456
#define XB_SPIN_CAP (1u << 18)
__device__ __forceinline__ unsigned xb_ld(unsigned* p)              { return __hip_atomic_load(p, __ATOMIC_RELAXED, __HIP_MEMORY_SCOPE_AGENT); }
__device__ __forceinline__ unsigned xb_add(unsigned* p, unsigned v) { return __hip_atomic_fetch_add(p, v, __ATOMIC_RELAXED, __HIP_MEMORY_SCOPE_AGENT); }
__device__ __forceinline__ unsigned xb_xcc_id() { return (unsigned)__builtin_amdgcn_s_getreg((3 << 11) | 20) & 0xFu; }
#define XB_SPIN(cond, bar) do { unsigned _sp = 0; while (cond) { __builtin_amdgcn_s_sleep(1); \
    if ((++_sp & 255u) == 0u) { if (xb_ld(&(bar)[XB_TMO])) break; if (_sp > XB_SPIN_CAP) { atomicAdd(&(bar)[XB_TMO], 1u); break; } } } } while (0)
struct XcdBarrier { unsigned* bar; unsigned x; volatile LAS unsigned* st; };
__device__ __forceinline__ XcdBarrier xcd_barrier_post(unsigned* bar, volatile LAS unsigned* st) {
    XcdBarrier b; b.bar = bar; b.x = xb_xcc_id(); b.st = st;
    if (threadIdx.x == 0) (void)xb_add(&bar[XB_XCNT(b.x)], 1u);
    return b;
}
__device__ __forceinline__ void xcd_barrier_complete(unsigned* bar, unsigned x, unsigned& nloc, unsigned& nx) {
    const unsigned G = gridDim.x * gridDim.y * gridDim.z;
    unsigned sum, cnt, mine, sp = 0u;
    for (;;) {
        sum = 0u; cnt = 0u; mine = 0u;
#pragma unroll
        for (unsigned j = 0; j < 16; ++j) { const unsigned c = xb_ld(&bar[XB_XCNT(j)]); sum += c; cnt += (c > 0u) ? 1u : 0u; mine = (j == x) ? c : mine; }
        if (sum == G) break;
        __builtin_amdgcn_s_sleep(1);
        if ((++sp & 255u) == 0u) { if (xb_ld(&bar[XB_TMO])) break; if (sp > XB_SPIN_CAP) { atomicAdd(&bar[XB_TMO], 1u); break; } }
    }
    nloc = mine > 0u ? mine : 1u; nx = cnt > 0u ? cnt : 1u;
}
__device__ __forceinline__ void xcd_barrier(const XcdBarrier& b) {
    asm volatile("s_waitcnt vmcnt(0)" ::: "memory");
    __syncthreads();
    if (threadIdx.x == 0) {
        unsigned* bar = b.bar; asm volatile("" : "+s"(bar));
        __builtin_amdgcn_s_waitcnt(0);
        unsigned bx0 = b.x; asm volatile("" : "+s"(bx0));
        unsigned nloc = b.st[0], nx = b.st[1];
        if (nloc == 0u) { xcd_barrier_complete(bar, bx0, nloc, nx); b.st[0] = nloc; b.st[1] = nx; }
        unsigned bx = b.x; asm volatile("" : "+s"(bx));
        const unsigned old = xb_add(&bar[XB_XSUB(bx)], 1u);
        const unsigned gen = old / nloc;
        if (old + 1u == (gen + 1u) * nloc) {
            __builtin_amdgcn_fence(__ATOMIC_RELEASE, "agent");
            asm volatile("s_waitcnt vmcnt(0)" ::: "memory");
            const unsigned og = xb_add(&bar[XB_TOP], 1u);
            const unsigned tg = og / nx;
            if (og + 1u == (tg + 1u) * nx) xb_add(&bar[XB_TOPGEN], 1u);
            else XB_SPIN(xb_ld(&bar[XB_TOPGEN]) == tg, bar);
            __builtin_amdgcn_fence(__ATOMIC_ACQUIRE, "agent");
            xb_add(&bar[XB_XGEN(bx)], 1u);
            asm volatile("s_waitcnt vmcnt(0)" ::: "memory");
        } else {
            XB_SPIN(xb_ld(&bar[XB_XGEN(bx)]) == gen, bar);
            __builtin_amdgcn_fence(__ATOMIC_ACQUIRE, "agent");
            asm volatile("s_waitcnt vmcnt(0)" ::: "memory");
        }
    }
    __syncthreads();
}

namespace pg8 {
#define PG8_LAS __attribute__((address_space(3)))
constexpr int BM = 256, BK = 64, HALF = 128, HTB = HALF * BK * 2, STAGE_BYTES = 8 * HTB, NXCD = 8, WGM = 4;
__host__ __device__ __forceinline__ int lds_byte(int r, int c) { const int st = (r >> 4) * 2 + (c >> 5), rr = r & 15, cc = c & 31, ob = rr * 64 + cc * 2; return st * 1024 + (ob ^ (((ob >> 9) & 1) << 5)); }
__host__ __device__ __forceinline__ void stage_rc(int b, int& R, int& C) { const int st = b / 1024, sb = b % 1024, swz = sb ^ (((sb >> 9) & 1) << 5); R = (st >> 1) * 16 + swz / 64; C = (st & 1) * 32 + (swz % 64) / 2; }
__host__ __device__ __forceinline__ int perm32(int rho) { const int n = rho >> 4, i = rho & 15; return 8 * (i >> 2) + 4 * n + (i & 3); }
struct Unit { int pm, pn; const char* A; const char* B; };

template <int M_, int NN> struct PanelOrder {
    static constexpr int nM = M_ / BM; static constexpr size_t tstep = (size_t)BM * 1024 * 2;
    int G, c; const char* A; const char* Bt;
    __device__ void init(const void* A_, const void* Bt_, int G_, int c_) { G = G_; c = c_; A = (const char*)A_; Bt = (const char*)Bt_; }
    __device__ bool next(int i, Unit& u) const { const int pm = c + (i / NN) * G; if (pm >= nM) return false; u.pm = pm; u.pn = i % NN; u.A = A + (size_t)pm * tstep; u.B = Bt + (size_t)u.pn * tstep; return true; }
    __device__ __forceinline__ void a_ready(const Unit&) const {}
    __device__ __forceinline__ void done(const Unit&) const {}
};
template <int M_, int N_> struct StaticOrder {
    static constexpr int nM = M_ / BM, nN = N_ / BM, nwg = nM * nN; static constexpr size_t tstep = (size_t)BM * 1024 * 2;
    int G, c; const char* A; const char* Bt;
    __device__ void init(const void* A_, const void* Bt_, int G_, int c_) { G = G_; c = c_; A = (const char*)A_; Bt = (const char*)Bt_; }
    __device__ bool next(int i, Unit& u) const {
        const long L = (long)i * G + c; if (L >= nwg) return false;
        int wgid = (int)L; { constexpr int q = nwg / NXCD, r = nwg % NXCD; const int xcd = wgid % NXCD, off = wgid / NXCD; wgid = (xcd < r ? xcd * (q + 1) : r * (q + 1) + (xcd - r) * q) + off; }
        constexpr int nig = WGM * nN; const int gid = wgid / nig, fm = gid * WGM, gsz = (nM - fm) < WGM ? (nM - fm) : WGM;
        u.pm = fm + ((wgid % nig) % gsz); u.pn = (wgid % nig) / gsz; u.A = A + (size_t)u.pm * tstep; u.B = Bt + (size_t)u.pn * tstep; return true;
    }
    __device__ __forceinline__ void a_ready(const Unit&) const {}
    __device__ __forceinline__ void done(const Unit&) const {}
};
template <class Epi, class Sched, bool ALIGN_EPI = false, bool SP2 = false, int KB = 1024, bool FP8 = false>
__device__ __forceinline__ void gemm_phase(PG8_LAS unsigned char* lds, const int wave_s, const Sched& S, const Epi& E) { const int Kdim = 0;
    const int lane = fresh_lane(), wid = wave_s, tid = wid * 64 + lane, wr = wid >> 2, wc = wid & 3, fr = lane & 15, fq = lane >> 4;
    constexpr int K = KB, nt = K / BK; (void)Kdim;
    unsigned voffA, voffB;
    { int R, C; stage_rc(tid * 16, R, C); const int Rb = Epi::PERM ? ((R & ~31) + perm32(R & 31)) : R; voffA = (unsigned)(R * K + C) * 2u; voffB = (unsigned)(Rb * K + C) * 2u; }
    constexpr size_t kstep = (size_t)(BK * 2);
    constexpr size_t hstep = (size_t)HALF * K * 2;
    constexpr size_t tstep = 2 * hstep; (void)tstep;
    const unsigned ldsw = (unsigned)wid * 1024u; const unsigned ldsb = (unsigned)(size_t)lds + ldsw;
    const int aoff = lds_byte(wr * 64 + fr, fq * 8), boff = lds_byte(wc * 32 + fr, fq * 8);
#define PG8_SA(b, h) (((b) * 2 + (h)) * HTB)
#define PG8_SB(b, h) ((4 + (b) * 2 + (h)) * HTB)
#define PG8_STAGE(bufoff, gbase, voff) do { _Pragma("unroll") for (int _i = 0; _i < 2; ++_i) { unsigned _keep; \
        asm volatile("s_mov_b32 %0, m0\n\ts_mov_b32 m0, %3\n\ts_nop 0\n\tglobal_load_lds_dwordx4 %1, %2\n\ts_mov_b32 m0, %0" : "=&s"(_keep) \
            : "v"(voff), "s"((const char*)(gbase) + (size_t)_i * (64 * K * 2)), "s"(ldsb + (unsigned)((bufoff) + _i * 8192)) : "memory"); } } while (0)
#define PG8_LDA(dst, b, h) do { if constexpr (FP8) { _Pragma("unroll") for (int m = 0; m < 4; ++m) { const i32x4 _lo = *(const PG8_LAS i32x4*)(lds + PG8_SA(b, h) + aoff + m * 2048), _hi = *(const PG8_LAS i32x4*)(lds + PG8_SA(b, h) + aoff + m * 2048 + 1024); \
            dst##8[m] = __builtin_shufflevector(_lo, _hi, 0, 1, 2, 3, 4, 5, 6, 7); } } \
        else { _Pragma("unroll") for (int m = 0; m < 4; ++m) _Pragma("unroll") for (int k = 0; k < 2; ++k) dst[m][k] = *(const PG8_LAS bf16x8*)(lds + PG8_SA(b, h) + aoff + m * 2048 + k * 1024); } } while (0)
#define PG8_LDB(dst, b, h) do { if constexpr (FP8) { _Pragma("unroll") for (int n = 0; n < 2; ++n) { const i32x4 _lo = *(const PG8_LAS i32x4*)(lds + PG8_SB(b, h) + boff + n * 2048), _hi = *(const PG8_LAS i32x4*)(lds + PG8_SB(b, h) + boff + n * 2048 + 1024); \
            dst##8[n] = __builtin_shufflevector(_lo, _hi, 0, 1, 2, 3, 4, 5, 6, 7); } } \
        else { _Pragma("unroll") for (int n = 0; n < 2; ++n) _Pragma("unroll") for (int k = 0; k < 2; ++k) dst[n][k] = *(const PG8_LAS bf16x8*)(lds + PG8_SB(b, h) + boff + n * 2048 + k * 1024); } } while (0)
#define PG8_MMA(ai, bj, At, Bt) do { __builtin_amdgcn_s_setprio(1); \
        if constexpr (FP8) { _Pragma("unroll") for (int m = 0; m < 4; ++m) _Pragma("unroll") for (int n = 0; n < 2; ++n) \
            acc[ai][bj][m][n] = __builtin_amdgcn_mfma_scale_f32_16x16x128_f8f6f4(Bt##8[n], At##8[m], acc[ai][bj][m][n], 0, 0, 0, Epi::SCALE_W, 0, Epi::SCALE_A); } \
        else { _Pragma("unroll") for (int m = 0; m < 4; ++m) _Pragma("unroll") for (int n = 0; n < 2; ++n) _Pragma("unroll") for (int k = 0; k < 2; ++k) \
            acc[ai][bj][m][n] = __builtin_amdgcn_mfma_f32_16x16x32_bf16(Bt[n][k], At[m][k], acc[ai][bj][m][n], 0, 0, 0); } \
        __builtin_amdgcn_s_setprio(0); } while (0)
#define PG8_WAIT_V(n) asm volatile("s_waitcnt vmcnt(" #n ")" ::: "memory")
#define PG8_WAIT_L(n) asm volatile("s_waitcnt lgkmcnt(" #n ")" ::: "memory")
#define PG8_BAR __builtin_amdgcn_s_barrier()
#define PG8_SCHED __builtin_amdgcn_sched_barrier(0)
    Unit cur, nxt; int ui = 0;
    if (!S.next(0, cur)) return;
    f32x4 acc[2][2][4][2];
#pragma unroll
    for (int a = 0; a < 2; ++a)
#pragma unroll
        for (int b = 0; b < 2; ++b)
#pragma unroll
            for (int m = 0; m < 4; ++m)
#pragma unroll
                for (int n = 0; n < 2; ++n) acc[a][b][m][n] = (f32x4){0.f, 0.f, 0.f, 0.f};
    bf16x8 At[4][2], B0[2][2], B1[2][2]; i32x8 At8[4], B08[2], B18[2]; (void)At; (void)B0; (void)B1; (void)At8; (void)B08; (void)B18;
    const char* cA = cur.A; const char* cB = cur.B;
    S.a_ready(cur);
    if constexpr (SP2) {
        PG8_STAGE(PG8_SB(0, 0), cB, voffB); PG8_STAGE(PG8_SB(0, 1), cB + hstep, voffB); PG8_STAGE(PG8_SA(0, 0), cA, voffA); PG8_STAGE(PG8_SA(0, 1), cA + hstep, voffA);
        if (wr == 1) PG8_BAR;
        PG8_WAIT_V(2); PG8_BAR;
        PG8_STAGE(PG8_SB(1, 0), cB + kstep, voffB); PG8_STAGE(PG8_SA(1, 0), cA + kstep, voffA); PG8_STAGE(PG8_SB(1, 1), cB + hstep + kstep, voffB);
        PG8_WAIT_V(6); PG8_BAR;
    } else {
        PG8_STAGE(PG8_SB(0, 0), cB, voffB); PG8_STAGE(PG8_SA(0, 0), cA, voffA); PG8_STAGE(PG8_SB(0, 1), cB + hstep, voffB); PG8_STAGE(PG8_SA(0, 1), cA + hstep, voffA);
        if (wr == 1) PG8_BAR;
        PG8_WAIT_V(4); PG8_BAR;
        PG8_STAGE(PG8_SB(1, 0), cB + kstep, voffB); PG8_STAGE(PG8_SA(1, 0), cA + kstep, voffA); PG8_STAGE(PG8_SB(1, 1), cB + hstep + kstep, voffB);
        PG8_WAIT_V(6); PG8_BAR;
    }
    for (;;) {
        const bool has_next = S.next(ui + 1, nxt);
        const char* nA = has_next ? nxt.A : cA; const char* nB = has_next ? nxt.B : cB;
_Pragma("unroll 1")
        for (int t = 0; t < nt; t += 2) {
            const bool last = (t == nt - 2);
            const char* a1 = cA + (size_t)(t + 1) * kstep;
            const char* a2 = last ? nA : cA + (size_t)(t + 2) * kstep; const char* b2 = last ? nB : cB + (size_t)(t + 2) * kstep;
            const char* a3 = a2 + kstep; const char* b3 = b2 + kstep;
            if (last && has_next) S.a_ready(nxt);
            if constexpr (SP2) {
            PG8_LDB(B0, 0, 0); PG8_LDB(B1, 0, 1); PG8_SCHED; PG8_LDA(At, 0, 0); PG8_STAGE(PG8_SA(1, 1), a1 + hstep, voffA);
            PG8_WAIT_V(8); PG8_WAIT_L(0); PG8_BAR; PG8_MMA(0, 0, At, B0); PG8_MMA(0, 1, At, B1); PG8_BAR; PG8_SCHED;
            PG8_LDA(At, 0, 1); PG8_STAGE(PG8_SB(0, 0), b2, voffB); PG8_STAGE(PG8_SB(0, 1), b2 + hstep, voffB); PG8_STAGE(PG8_SA(0, 0), a2, voffA);
            PG8_WAIT_V(8); PG8_WAIT_L(0); PG8_BAR; PG8_MMA(1, 0, At, B0); PG8_MMA(1, 1, At, B1); PG8_BAR; PG8_SCHED;
            PG8_LDB(B0, 1, 0); PG8_LDB(B1, 1, 1); PG8_SCHED; PG8_LDA(At, 1, 0); PG8_STAGE(PG8_SA(0, 1), a2 + hstep, voffA);
            PG8_WAIT_V(8); PG8_WAIT_L(0); PG8_BAR; PG8_MMA(0, 0, At, B0); PG8_MMA(0, 1, At, B1); PG8_BAR; PG8_SCHED;
            PG8_LDA(At, 1, 1); PG8_STAGE(PG8_SB(1, 0), b3, voffB); PG8_STAGE(PG8_SB(1, 1), b3 + hstep, voffB); PG8_STAGE(PG8_SA(1, 0), a3, voffA);
            PG8_WAIT_V(8); PG8_WAIT_L(0); PG8_BAR; PG8_MMA(1, 0, At, B0); PG8_MMA(1, 1, At, B1); PG8_BAR; PG8_SCHED;
            } else {
            PG8_LDB(B0, 0, 0); PG8_SCHED; PG8_LDA(At, 0, 0); PG8_STAGE(PG8_SA(1, 1), a1 + hstep, voffA);
            PG8_WAIT_L(8); PG8_BAR; PG8_WAIT_L(0); PG8_MMA(0, 0, At, B0); PG8_BAR; PG8_SCHED;
            PG8_LDB(B1, 0, 1); PG8_STAGE(PG8_SB(0, 0), b2, voffB);
            PG8_BAR; PG8_WAIT_L(0); PG8_MMA(0, 1, At, B1); PG8_BAR;
            PG8_LDA(At, 0, 1); PG8_STAGE(PG8_SA(0, 0), a2, voffA);
            PG8_BAR; PG8_WAIT_L(0); PG8_MMA(1, 0, At, B0); PG8_BAR; PG8_SCHED;
            PG8_STAGE(PG8_SB(0, 1), b2 + hstep, voffB);
            PG8_WAIT_V(6); PG8_BAR; PG8_MMA(1, 1, At, B1); PG8_BAR;
            PG8_LDB(B0, 1, 0); PG8_SCHED; PG8_LDA(At, 1, 0); PG8_STAGE(PG8_SA(0, 1), a2 + hstep, voffA);
            PG8_WAIT_L(8); PG8_BAR; PG8_WAIT_L(0); PG8_MMA(0, 0, At, B0); PG8_BAR; PG8_SCHED;
            PG8_LDB(B1, 1, 1); PG8_STAGE(PG8_SB(1, 0), b3, voffB);
            PG8_BAR; PG8_WAIT_L(0); PG8_MMA(0, 1, At, B1); PG8_BAR;
            PG8_LDA(At, 1, 1); PG8_STAGE(PG8_SA(1, 0), a3, voffA);
            PG8_BAR; PG8_WAIT_L(0); PG8_MMA(1, 0, At, B0); PG8_BAR; PG8_SCHED;
            PG8_STAGE(PG8_SB(1, 1), b3 + hstep, voffB);
            PG8_WAIT_V(6); PG8_BAR; PG8_MMA(1, 1, At, B1); PG8_BAR;
            }
        }
        if constexpr (ALIGN_EPI) { if (wr == 0) PG8_BAR; }
        if constexpr (!Epi::AFTER_DRAIN) { E(acc, cur, wr, wc, fr, fq); S.done(cur); }
        if (!has_next) break;
#pragma unroll
        for (int a = 0; a < 2; ++a)
#pragma unroll
            for (int b = 0; b < 2; ++b)
#pragma unroll
                for (int m = 0; m < 4; ++m)
#pragma unroll
                    for (int n = 0; n < 2; ++n) acc[a][b][m][n] = (f32x4){0.f, 0.f, 0.f, 0.f};
        cur = nxt; cA = nA; cB = nB; ++ui;
        if constexpr (ALIGN_EPI) { if (wr == 1) PG8_BAR; }
    }
    PG8_WAIT_V(0);
    if constexpr (!ALIGN_EPI) { if (wr == 0) PG8_BAR; }
    PG8_BAR;
    if constexpr (Epi::AFTER_DRAIN) { E.fused(acc, cur, wr, wc, fr, fq, lds, wid, lane); S.done(cur); }
#undef PG8_SA
#undef PG8_SB
#undef PG8_STAGE
#undef PG8_LDA
#undef PG8_LDB
#undef PG8_MMA
#undef PG8_WAIT_V
#undef PG8_WAIT_L
#undef PG8_BAR
#undef PG8_SCHED
}

template <int NP, bool UP, int ROWB> struct MoeOrder {
    const volatile LAS int* tab; int layer; const char* A; const char* W;
    __device__ bool next(int i, Unit& u) const {
        const int e = tab[i]; if (e < 0) return false;
        const int mt = e & 0xffff, pn = (e >> 16) & 0xff, cls = e >> 24;
        u.pm = mt; u.pn = pn; u.A = A + (size_t)mt * ((size_t)BM * ROWB);
        if (UP) { const int g = cls / 6, pi = cls % 6, s = pn >> 2, ex = g * 4 + (s ? pair_hi(pi) : pair_lo(pi));
            u.B = W + ((size_t)(layer * NE + ex) * 1024 + (size_t)(pn & 3) * 256) * ROWB; }
        else u.B = W + ((size_t)(layer * NCLS + cls) * 1024 + (size_t)pn * 256) * ROWB;
        return true;
    }
    __device__ __forceinline__ void a_ready(const Unit&) const {}
    __device__ __forceinline__ void done(const Unit&) const {}
};

struct EpiZ {
    static constexpr bool PERM = true, AFTER_DRAIN = false;
    bf16_t* Z; const float* ssq;
    __device__ __forceinline__ void operator()(const f32x4 (&acc)[2][2][4][2], const Unit& u, int wr, int wc, int fr, int fq) const {
        { const int ln_ = fresh_lane(); fr = ln_ & 15; fq = ln_ >> 4; }
        const int row0 = u.pm * BM + wr * 64 + fr, col0 = u.pn * BM + wc * 32 + 8 * fq;
        float rr[2][4];
#pragma unroll
        for (int ai = 0; ai < 2; ++ai) {
            f32x4 sp[4];
#pragma unroll
            for (int m = 0; m < 4; ++m) sp[m] = *(const f32x4*)(ssq + (size_t)(row0 + ai * HALF + m * 16) * 16 + 4 * fq);
#pragma unroll
            for (int m = 0; m < 4; ++m) { float t = (sp[m][0] + sp[m][1]) + (sp[m][2] + sp[m][3]); t = add_x16_x32(t); rr[ai][m] = __builtin_amdgcn_rsqf(t * (1.0f / D) + EPS); }
        }
#pragma unroll
        for (int ai = 0; ai < 2; ++ai)
#pragma unroll
            for (int m = 0; m < 4; ++m) { const int row = row0 + ai * HALF + m * 16; const float r = rr[ai][m];
                bf16_t* rowp = Z + (size_t)row * INC + col0;
#pragma unroll
                for (int bj = 0; bj < 2; ++bj) { f32x4 v0 = acc[ai][bj][m][0] * r, v1 = acc[ai][bj][m][1] * r;
                    u32x4 w; w.x = cvt_pk_bf16(v0[0], v0[1]); w.y = cvt_pk_bf16(v0[2], v0[3]); w.z = cvt_pk_bf16(v1[0], v1[1]); w.w = cvt_pk_bf16(v1[2], v1[3]);
                    *(u32x4*)(rowp + bj * HALF) = w; } }
    }
};
template <bool SCATTER> struct EpiRes {
    static constexpr bool PERM = true, AFTER_DRAIN = false; static constexpr int SCALE_W = 0x7b7b7b7b, SCALE_A = 0x7b7b7b7b;
    bf16_t* H; float* ssq; const int* rowtok;
    __device__ __forceinline__ void operator()(const f32x4 (&acc)[2][2][4][2], const Unit& u, int wr, int wc, int fr, int fq) const {
        { const int ln_ = fresh_lane(); fr = ln_ & 15; fq = ln_ >> 4; }
        const int row0 = u.pm * BM + wr * 64 + fr, col0 = u.pn * BM + wc * 32 + 8 * fq;
        int tokv[2][4];
#pragma unroll
        for (int ai = 0; ai < 2; ++ai)
#pragma unroll
            for (int m = 0; m < 4; ++m) { const int row = row0 + ai * HALF + m * 16; tokv[ai][m] = SCATTER ? rowtok[row] : row; }
#pragma unroll
        for (int ai = 0; ai < 2; ++ai) {
            u32x4 o[4][2];
#pragma unroll
            for (int m = 0; m < 4; ++m) { const int tok = tokv[ai][m]; const bf16_t* rowp = H + (size_t)(tok < 0 ? 0 : tok) * D + col0; o[m][0] = *(const u32x4*)(rowp); o[m][1] = *(const u32x4*)(rowp + HALF); }
#pragma unroll
            for (int m = 0; m < 4; ++m) { const int tok = tokv[ai][m]; float s = 0.f; bf16_t* rowp = H + (size_t)(tok < 0 ? 0 : tok) * D + col0;
#pragma unroll
                for (int bj = 0; bj < 2; ++bj) { const u32x4 oo = o[m][bj];
                    f32x4 v0 = acc[ai][bj][m][0], v1 = acc[ai][bj][m][1];
                    v0[0] += __uint_as_float(oo.x << 16); v0[1] += __uint_as_float(oo.x & 0xffff0000u); v0[2] += __uint_as_float(oo.y << 16); v0[3] += __uint_as_float(oo.y & 0xffff0000u);
                    v1[0] += __uint_as_float(oo.z << 16); v1[1] += __uint_as_float(oo.z & 0xffff0000u); v1[2] += __uint_as_float(oo.w << 16); v1[3] += __uint_as_float(oo.w & 0xffff0000u);
                    s += (v0[0] * v0[0] + v0[1] * v0[1]) + (v0[2] * v0[2] + v0[3] * v0[3]) + (v1[0] * v1[0] + v1[1] * v1[1]) + (v1[2] * v1[2] + v1[3] * v1[3]);
                    u32x4 w; w.x = cvt_pk_bf16(v0[0], v0[1]); w.y = cvt_pk_bf16(v0[2], v0[3]); w.z = cvt_pk_bf16(v1[0], v1[1]); w.w = cvt_pk_bf16(v1[2], v1[3]);
                    if (tok >= 0) *(u32x4*)(rowp + bj * HALF) = w; }
                s = add_x16_x32(s);
                if (fq == 0 && tok >= 0) ssq[(size_t)tok * 16 + u.pn * 4 + wc] = s; }
            asm volatile("" ::: "memory"); }
    }
};
constexpr int SC_W = 0x7b7b7b7b, SC_H = 0x7b7b7b7b, SC_ACT = 0x7b7b7b7b;
constexpr float FS_W = 16.f, FS_H = 16.f, FS_ACT = 16.f;
struct EpiUp {
    static constexpr bool PERM = true, AFTER_DRAIN = false; static constexpr int SCALE_W = SC_W, SCALE_A = SC_H;
    unsigned char* ACT; const float* rowg;
    __device__ __forceinline__ void operator()(const f32x4 (&acc)[2][2][4][2], const Unit& u, int wr, int wc, int fr, int fq) const {
        { const int ln_ = fresh_lane(); fr = ln_ & 15; fq = ln_ >> 4; }
        const int row0 = u.pm * BM + wr * 64 + fr, s = u.pn >> 2, col0 = s * 512 + (u.pn & 3) * 128 + wc * 32 + 8 * fq;
        float gt[2][4];
#pragma unroll
        for (int ai = 0; ai < 2; ++ai)
#pragma unroll
            for (int m = 0; m < 4; ++m) gt[ai][m] = rowg[(size_t)(row0 + ai * HALF + m * 16) * 2 + s];
#pragma unroll
        for (int ai = 0; ai < 2; ++ai)
#pragma unroll
            for (int m = 0; m < 4; ++m) { const int row = row0 + ai * HALF + m * 16; const float g1 = gt[ai][m];
                float o[8];
#pragma unroll
                for (int n = 0; n < 2; ++n)
#pragma unroll
                    for (int j = 0; j < 4; ++j) { const float g = acc[ai][0][m][n][j], up = acc[ai][1][m][n][j]; o[n * 4 + j] = g * sigmoid_fast(g) * up * g1; }
                u32x2 w; w.x = pk_fp8x4(o[0] * FS_ACT, o[1] * FS_ACT, o[2] * FS_ACT, o[3] * FS_ACT); w.y = pk_fp8x4(o[4] * FS_ACT, o[5] * FS_ACT, o[6] * FS_ACT, o[7] * FS_ACT);
                *(u32x2*)(ACT + (size_t)row * 1024 + col0) = w; }
    }
};
}

__device__ __forceinline__ void tr_item(const float* W, int ldw, int k0, int scol0, const float* gk, bf16_t* WT, int ldo, int drow0, int dk0, LAS float* scr, int lane) {
#pragma unroll 8
    for (int i = 0; i < 32; ++i) { const int kk = 2 * i + (lane >> 5); float v = W[(size_t)(k0 + kk) * ldw + scol0 + (lane & 31)]; if (gk) v *= gk[k0 + kk]; scr[kk * 33 + (lane & 31)] = v; }
    asm volatile("s_waitcnt lgkmcnt(0)" ::: "memory");
    const int c = lane & 7;
#pragma unroll
    for (int j = 0; j < 4; ++j) { const int n = (lane >> 3) + 8 * j; const LAS float* s = scr + (8 * c) * 33 + n;
        u32x4 o; o.x = cvt_pk_bf16(s[0 * 33], s[1 * 33]); o.y = cvt_pk_bf16(s[2 * 33], s[3 * 33]); o.z = cvt_pk_bf16(s[4 * 33], s[5 * 33]); o.w = cvt_pk_bf16(s[6 * 33], s[7 * 33]);
        *(u32x4*)(WT + (size_t)(drow0 + n) * ldo + dk0 + 8 * c) = o; }
    asm volatile("s_waitcnt lgkmcnt(0)" ::: "memory");
}

constexpr size_t S5_L_STRIDE = 1310720, S5_KT = 0, S5_ET = 131072, S5_FT = 655360, S5_LAMP = 1179648;
constexpr int S5_WSCR = 8192, S5_YST = 65536, YST_LD = 264;
constexpr int NU128 = T / 128, UPB128 = SEQ / 128;
__device__ __forceinline__ f32x4 mfma16(bf16x8 a, bf16x8 b, f32x4 c) { return __builtin_amdgcn_mfma_f32_16x16x32_bf16(a, b, c, 0, 0, 0); }

__device__ __forceinline__ void s5_kt_pair(int g, int c, int cp, const float* a_re, const float* a_im, const float* log_dt, const float* b_re, const float* b_im,
                                           const float* c_re, const float* c_im, const float* dvec, unsigned char* tab) {
    const float dt = __expf(log_dt[g]); float km[8];
#pragma unroll
    for (int d = 0; d < 8; ++d) km[d] = 0.f;
#pragma unroll 2
    for (int p = 0; p < CS; ++p) { const float lr = a_re[g * CS + p], li = a_im[g * CS + p], zr = lr * dt, zi = li * dt;
        const float sh = __sinf(0.5f * zi), cz = __cosf(zi), sz = __sinf(zi), ez = __expf(zr); const float nr = expm1f(zr) * cz - 2.0f * sh * sh, ni = ez * sz, den = lr * lr + li * li;
        const float cr = (nr * lr + ni * li) / den, ci = (ni * lr - nr * li) / den;
        const float br = b_re[((size_t)g * CS + p) * CGD + cp], bi = b_im[((size_t)g * CS + p) * CGD + cp]; const float bbr = cr * br - ci * bi, bbi = cr * bi + ci * br;
        const float cre = c_re[((size_t)g * CGD + c) * CS + p], cim = c_im[((size_t)g * CGD + c) * CS + p];
        float vr = cre * bbr - cim * bbi, vi = cre * bbi + cim * bbr;
        const float lbr = ez * cz, lbi = ez * sz;
#pragma unroll
        for (int d = 0; d < 8; ++d) { km[d] += vr; const float t = vr * lbr - vi * lbi; vi = vr * lbi + vi * lbr; vr = t; } }
    if (c == cp) km[0] += dvec[g * CGD + c];
    bf16_t* kt = (bf16_t*)(tab + S5_KT) + (size_t)g * 4096;
#pragma unroll
    for (int dd = 0; dd < 8; ++dd) { kt[(dd * 16 + c) * 32 + cp] = f2bf(km[dd]); kt[(dd * 16 + c) * 32 + 16 + cp] = dd >= 1 ? f2bf(km[dd - 1]) : (bf16_t)0; }
}
__device__ __forceinline__ void s5_et_task(int g, int ri, int p, int cp, const float* a_re, const float* a_im, const float* log_dt, const float* b_re, const float* b_im, unsigned char* tab) {
    const float dt = __expf(log_dt[g]); const float lr = a_re[g * CS + p], li = a_im[g * CS + p], zr = lr * dt, zi = li * dt;
    const float sh = __sinf(0.5f * zi), cz = __cosf(zi), sz = __sinf(zi), ez = __expf(zr); const float nr = expm1f(zr) * cz - 2.0f * sh * sh, ni = ez * sz, den = lr * lr + li * li;
    const float cr = (nr * lr + ni * li) / den, ci = (ni * lr - nr * li) / den;
    const float br = b_re[((size_t)g * CS + p) * CGD + cp], bi = b_im[((size_t)g * CS + p) * CGD + cp]; float vr = cr * br - ci * bi, vi = cr * bi + ci * br;
    const float lbr = ez * cz, lbi = ez * sz; bf16_t* et = (bf16_t*)(tab + S5_ET) + (size_t)g * 16384 + (size_t)(ri * 64 + p) * 128 + cp;
#pragma unroll
    for (int sp = 7; sp >= 0; --sp) { et[sp * 16] = f2bf(ri ? vi : vr); const float t = vr * lbr - vi * lbi; vi = vr * lbi + vi * lbr; vr = t; }
}
__device__ __forceinline__ void s5_ft_task(int g, int c, int ri, int p, const float* a_re, const float* a_im, const float* log_dt, const float* c_re, const float* c_im, unsigned char* tab) {
    const float dt = __expf(log_dt[g]); const float lr = a_re[g * CS + p], li = a_im[g * CS + p], zr = lr * dt, zi = li * dt; const float ez = __expf(zr), lbr = ez * __cosf(zi), lbi = ez * __sinf(zi);
    const float cre = c_re[((size_t)g * CGD + c) * CS + p], cim = c_im[((size_t)g * CGD + c) * CS + p]; float vr = cre * lbr - cim * lbi, vi = cre * lbi + cim * lbr;
    bf16_t* ft = (bf16_t*)(tab + S5_FT) + (size_t)g * 16384 + (size_t)c * 128 + ri * 64 + p;
#pragma unroll
    for (int tp = 0; tp < 8; ++tp) { ft[(size_t)tp * 16 * 128] = f2bf(ri ? -vi : vr); const float t = vr * lbr - vi * lbi; vi = vr * lbi + vi * lbr; vr = t; }
}
__device__ __forceinline__ void s5_table_elem(int g, int e, const float* a_re, const float* a_im, const float* log_dt, const float* b_re, const float* b_im,
                                              const float* c_re, const float* c_im, const float* dvec, unsigned char* tab) {
    const float dt = __expf(log_dt[g]);
    if (e < 4096) {
        const int dd = e >> 9, c = (e >> 5) & 15, ee = (e >> 4) & 1, cp = e & 15, d = dd - ee; float s = 0.f;
        if (d >= 0) {
            for (int p = 0; p < CS; ++p) { const float lr = a_re[g * CS + p], li = a_im[g * CS + p], zr = lr * dt, zi = li * dt;
                const float sh = __sinf(0.5f * zi); const float nr = expm1f(zr) * __cosf(zi) - 2.0f * sh * sh, ni = __expf(zr) * __sinf(zi), den = lr * lr + li * li;
                const float cr = (nr * lr + ni * li) / den, ci = (ni * lr - nr * li) / den;
                const float br = b_re[((size_t)g * CS + p) * CGD + cp], bi = b_im[((size_t)g * CS + p) * CGD + cp]; const float bbr = cr * br - ci * bi, bbi = cr * bi + ci * br;
                const float mag = __expf(zr * (float)d), pr = mag * __cosf(zi * (float)d), pi = mag * __sinf(zi * (float)d);
                const float vr = pr * bbr - pi * bbi, vi = pr * bbi + pi * bbr;
                s += c_re[((size_t)g * CGD + c) * CS + p] * vr - c_im[((size_t)g * CGD + c) * CS + p] * vi; }
            if (d == 0 && c == cp) s += dvec[g * CGD + c];
        }
        ((bf16_t*)(tab + S5_KT))[(size_t)g * 4096 + e] = f2bf(s); return;
    }
    e -= 4096;
    if (e < 16384) {
        const int n = e >> 7, k = e & 127, ri = n >> 6, p = n & 63, sp = k >> 4, cp = k & 15;
        const float lr = a_re[g * CS + p], li = a_im[g * CS + p], zr = lr * dt, zi = li * dt;
        const float sh = __sinf(0.5f * zi); const float nr = expm1f(zr) * __cosf(zi) - 2.0f * sh * sh, ni = __expf(zr) * __sinf(zi), den = lr * lr + li * li;
        const float cr = (nr * lr + ni * li) / den, ci = (ni * lr - nr * li) / den;
        const float br = b_re[((size_t)g * CS + p) * CGD + cp], bi = b_im[((size_t)g * CS + p) * CGD + cp]; const float bbr = cr * br - ci * bi, bbi = cr * bi + ci * br;
        const float d = (float)(7 - sp); const float mag = __expf(zr * d), pr = mag * __cosf(zi * d), pi = mag * __sinf(zi * d);
        ((bf16_t*)(tab + S5_ET))[(size_t)g * 16384 + e] = f2bf(ri ? (pr * bbi + pi * bbr) : (pr * bbr - pi * bbi)); return;
    }
    e -= 16384;
    if (e < 16384) {
        const int n = e >> 7, k = e & 127, tp = n >> 4, c = n & 15, ri = k >> 6, p = k & 63;
        const float lr = a_re[g * CS + p], li = a_im[g * CS + p], zr = lr * dt, zi = li * dt;
        const float d = (float)(tp + 1); const float mag = __expf(zr * d), pr = mag * __cosf(zi * d), pi = mag * __sinf(zi * d);
        const float cre = c_re[((size_t)g * CGD + c) * CS + p], cim = c_im[((size_t)g * CGD + c) * CS + p];
        ((bf16_t*)(tab + S5_FT))[(size_t)g * 16384 + e] = f2bf(ri ? -(cre * pi + cim * pr) : (cre * pr - cim * pi)); return;
    }
    e -= 16384;
    { const int p = e; const float lr = a_re[g * CS + p], li = a_im[g * CS + p], zr = lr * dt, zi = li * dt; float* o = (float*)(tab + S5_LAMP) + ((size_t)g * CS + p) * 8;
      float mag = expf(zr); o[0] = mag * cosf(zi); o[1] = mag * sinf(zi);
      mag = expf(zr * 8.f); o[2] = mag * cosf(zi * 8.f); o[3] = mag * sinf(zi * 8.f);
      mag = expf(zr * 128.f); o[4] = mag * cosf(zi * 128.f); o[5] = mag * sinf(zi * 128.f); o[6] = 0.f; o[7] = 0.f; }
}

template <class TT> __device__ __forceinline__ TT ldg(const void* ubase, unsigned voff) { return *(const TT*)((const char*)ubase + voff); }
template <int PASS>
__device__ __forceinline__ void s5_group(int unit, int g, bool first, float& kr, float& ki, int wave, int lane, const bf16_t* Z, bf16_t* Y, const unsigned char* tab, float* SEND, float* SEND2, float* SE, LAS unsigned char* lds) {
    const int ln = lane & 15, q = lane >> 4; const int t0 = unit * 128;
    const char* KTg = (const char*)(tab + S5_KT) + (size_t)g * 8192; const char* ETg = (const char*)(tab + S5_ET) + (size_t)g * 32768; const char* FTg = (const char*)(tab + S5_FT) + (size_t)g * 32768;
    const float* LAMPg = (const float*)(tab + S5_LAMP) + (size_t)g * CS * 8;
    const unsigned vo128 = (unsigned)(ln * 128 + 8 * q) * 2u;
    const unsigned vo32 = (unsigned)(ln * 32 + 8 * q) * 2u;
    LAS float* Sb = (LAS float*)(lds + wave * S5_WSCR); LAS bf16_t* Tb = (LAS bf16_t*)(lds + wave * S5_WSCR); LAS bf16_t* yst = (LAS bf16_t*)(lds + S5_YST);
    char* seb = (char*)(SE + ((size_t)unit * CG + g) * 16 * 128); const unsigned vl = (unsigned)lane * 4u;
    char* ylb = (char*)(Y + (size_t)t0 * D + AW + BW + g * 16); const unsigned vy = (unsigned)((ln * 8) * D + 4 * q) * 2u;
    const float lur = LAMPg[lane * 8 + 4], lui = LAMPg[lane * 8 + 5], l8r = LAMPg[lane * 8 + 2], l8i = LAMPg[lane * 8 + 3];
    float cr = 0.f, ci = 0.f;
    if (PASS == 1) {
        if (!first) { cr = kr; ci = ki; }
        bf16x8 X0, X1, X2, X3;
        { const char* zb = (const char*)(Z + (size_t)t0 * INC + ZC + g * 16); const unsigned vz = (unsigned)((ln * 8 + (q >> 1)) * INC + 8 * (q & 1)) * 2u;
          X0 = ldg<bf16x8>(zb, vz); X1 = ldg<bf16x8>(zb + 2 * INC * 2, vz); X2 = ldg<bf16x8>(zb + 4 * INC * 2, vz); X3 = ldg<bf16x8>(zb + 6 * INC * 2, vz); }
        { LAS float* sw = Sb + (4 * q) * 128 + ln; const char* eb = ETg;
#pragma unroll 1
          for (int jh = 0; jh < 2; ++jh) { bf16x8 ef[4][4];
#pragma unroll
            for (int j = 0; j < 4; ++j)
#pragma unroll
              for (int ks = 0; ks < 4; ++ks) ef[j][ks] = ldg<bf16x8>(eb + j * 4096 + ks * 64, vo128);
#pragma unroll
            for (int j = 0; j < 4; ++j) { f32x4 se = (f32x4){0.f, 0.f, 0.f, 0.f};
              se = mfma16(X0, ef[j][0], se); se = mfma16(X1, ef[j][1], se); se = mfma16(X2, ef[j][2], se); se = mfma16(X3, ef[j][3], se);
              LAS float* s2 = sw + 16 * j; s2[0] = se[0]; s2[128] = se[1]; s2[256] = se[2]; s2[384] = se[3]; }
            eb += 16384; sw += 64; } }
        asm volatile("" ::: "memory");
        { const char* kb = KTg; char* yq = ylb;
#pragma unroll 1
          for (int th = 0; th < 4; ++th) {
              const bf16x8 ka = ldg<bf16x8>(kb, vo32), kc = ldg<bf16x8>(kb + 1024, vo32);
              f32x4 acc0 = (f32x4){0.f, 0.f, 0.f, 0.f}, acc1 = (f32x4){0.f, 0.f, 0.f, 0.f};
              acc0 = mfma16(ka, X0, acc0); acc1 = mfma16(kc, X0, acc1);
              if (th >= 1) { acc0 = mfma16(ldg<bf16x8>(kb - 2048, vo32), X1, acc0); acc1 = mfma16(ldg<bf16x8>(kb - 1024, vo32), X1, acc1); }
              if (th >= 2) { acc0 = mfma16(ldg<bf16x8>(kb - 4096, vo32), X2, acc0); acc1 = mfma16(ldg<bf16x8>(kb - 3072, vo32), X2, acc1); }
              if (th >= 3) { acc0 = mfma16(ldg<bf16x8>(kb - 6144, vo32), X3, acc0); acc1 = mfma16(ldg<bf16x8>(kb - 5120, vo32), X3, acc1); }
              u32x2 w; w.x = cvt_pk_bf16(acc0[0], acc0[1]); w.y = cvt_pk_bf16(acc0[2], acc0[3]); *(u32x2*)(yq + vy) = w;
              w.x = cvt_pk_bf16(acc1[0], acc1[1]); w.y = cvt_pk_bf16(acc1[2], acc1[3]); *(u32x2*)(yq + (size_t)D * 2 + vy) = w;
              kb += 2048; yq += (size_t)2 * D * 2; } }
        asm volatile("" ::: "memory");
        float sr = cr, si = ci;
#pragma unroll
        for (int s = 0; s < 16; ++s) { const float er = Sb[s * 128 + lane], ei = Sb[s * 128 + 64 + lane];
            *(float*)(seb + s * 512 + vl) = er; *(float*)(seb + s * 512 + 256 + vl) = ei;
            const float nr = l8r * sr - l8i * si + er, ni = l8r * si + l8i * sr + ei; sr = nr; si = ni; }
        kr = sr; ki = si;
        float* dst = first ? SEND + (((size_t)unit * CG + g) * 2) * CS + lane : SEND2 + (((size_t)(unit >> 1) * CG + g) * 2) * CS + lane;
        dst[0] = sr; dst[CS] = si; asm volatile("" ::: "memory"); return;
    }
    if (first) { const int pr = unit >> 1, p0 = pr - (pr % (UPB128 / 2)); const float l2r = lur * lur - lui * lui, l2i = 2.0f * lur * lui;
        const char* sb = (const char*)(SEND2 + (((size_t)p0 * CG + g) * 2) * CS);
#pragma unroll 8
        for (int j = p0; j < pr; ++j) { const float sr = ldg<float>(sb, vl), si = ldg<float>(sb + CS * 4, vl); sb += (size_t)CG * 2 * CS * 4;
            const float nr = l2r * cr - l2i * ci + sr, ni = l2r * ci + l2i * cr + si; cr = nr; ci = ni; } }
    else { const float sr = SEND[(((size_t)(unit - 1) * CG + g) * 2 + 0) * CS + lane], si = SEND[(((size_t)(unit - 1) * CG + g) * 2 + 1) * CS + lane];
        cr = lur * kr - lui * ki + sr; ci = lur * ki + lui * kr + si; }
    kr = cr; ki = ci;
    { float sre[16], sim[16];
#pragma unroll
      for (int s = 0; s < 16; ++s) { sre[s] = ldg<float>(seb + s * 512, vl); sim[s] = ldg<float>(seb + s * 512 + 256, vl); }
      float sr = cr, si = ci;
#pragma unroll
      for (int s = 0; s < 16; ++s) { Tb[s * 128 + lane] = f2bf(sr); Tb[s * 128 + 64 + lane] = f2bf(si);
          const float nr = l8r * sr - l8i * si + sre[s], ni = l8r * si + l8i * sr + sim[s]; sr = nr; si = ni; } }
    asm volatile("" ::: "memory");
    const bf16x8 T0 = *(const LAS bf16x8*)(Tb + ln * 128 + 8 * q), T1 = *(const LAS bf16x8*)(Tb + ln * 128 + 32 + 8 * q), T2 = *(const LAS bf16x8*)(Tb + ln * 128 + 64 + 8 * q), T3 = *(const LAS bf16x8*)(Tb + ln * 128 + 96 + 8 * q);
    { LAS bf16_t* yw = yst + (ln * 8) * YST_LD + g * 16 + 4 * q; const char* fb = FTg; const char* yq = ylb;
#pragma unroll 1
      for (int th = 0; th < 4; ++th) { bf16x8 ff[2][4]; u32x2 yl[2];
#pragma unroll
          for (int j = 0; j < 2; ++j) { yl[j] = ldg<u32x2>(yq + (size_t)j * D * 2, vy);
#pragma unroll
              for (int ks = 0; ks < 4; ++ks) ff[j][ks] = ldg<bf16x8>(fb + j * 4096 + ks * 64, vo128); }
#pragma unroll
          for (int j = 0; j < 2; ++j) {
              f32x4 acc; acc[0] = __uint_as_float(yl[j].x << 16); acc[1] = __uint_as_float(yl[j].x & 0xffff0000u); acc[2] = __uint_as_float(yl[j].y << 16); acc[3] = __uint_as_float(yl[j].y & 0xffff0000u);
              acc = mfma16(ff[j][0], T0, acc); acc = mfma16(ff[j][1], T1, acc); acc = mfma16(ff[j][2], T2, acc); acc = mfma16(ff[j][3], T3, acc);
              u32x2 w; w.x = cvt_pk_bf16(gelu_fast(acc[0]), gelu_fast(acc[1])); w.y = cvt_pk_bf16(gelu_fast(acc[2]), gelu_fast(acc[3]));
              *(LAS u32x2*)(yw + j * YST_LD) = w; }
          fb += 8192; yq += (size_t)2 * D * 2; yw += 2 * YST_LD; } }
    asm volatile("s_waitcnt lgkmcnt(0)" ::: "memory");
}
__device__ __forceinline__ void s5_pair1(int pr, int g, int wave, int lane, const bf16_t* Z, bf16_t* Y, const unsigned char* tab, float* SEND, float* SEND2, float* SE, LAS unsigned char* lds) {
    const int ln = lane & 15, q = lane >> 4; const int t0 = pr * 256;
    const char* KTg = (const char*)(tab + S5_KT) + (size_t)g * 8192; const char* ETg = (const char*)(tab + S5_ET) + (size_t)g * 32768;
    const float* LAMPg = (const float*)(tab + S5_LAMP) + (size_t)g * CS * 8;
    const unsigned vo128 = (unsigned)(ln * 128 + 8 * q) * 2u, vo32 = (unsigned)(ln * 32 + 8 * q) * 2u, vl = (unsigned)lane * 4u;
    LAS float* SbA = (LAS float*)(lds + wave * 16384); LAS float* SbB = SbA + 2048;
    bf16x8 XA0, XA1, XA2, XA3, XB0, XB1, XB2, XB3;
    { const char* zb = (const char*)(Z + (size_t)t0 * INC + ZC + g * 16); const unsigned vz = (unsigned)((ln * 8 + (q >> 1)) * INC + 8 * (q & 1)) * 2u;
      XA0 = ldg<bf16x8>(zb, vz); XA1 = ldg<bf16x8>(zb + 2 * INC * 2, vz); XA2 = ldg<bf16x8>(zb + 4 * INC * 2, vz); XA3 = ldg<bf16x8>(zb + 6 * INC * 2, vz);
      const char* zc = zb + (size_t)128 * INC * 2;
      XB0 = ldg<bf16x8>(zc, vz); XB1 = ldg<bf16x8>(zc + 2 * INC * 2, vz); XB2 = ldg<bf16x8>(zc + 4 * INC * 2, vz); XB3 = ldg<bf16x8>(zc + 6 * INC * 2, vz); }
    { LAS float* sw = SbA + (4 * q) * 128 + ln; const char* eb = ETg;
#pragma unroll 1
      for (int jh = 0; jh < 2; ++jh) { bf16x8 ef[4][4];
#pragma unroll
        for (int j = 0; j < 4; ++j)
#pragma unroll
          for (int ks = 0; ks < 4; ++ks) ef[j][ks] = ldg<bf16x8>(eb + j * 4096 + ks * 64, vo128);
#pragma unroll
        for (int j = 0; j < 4; ++j) { f32x4 sa = (f32x4){0.f, 0.f, 0.f, 0.f}, sb = (f32x4){0.f, 0.f, 0.f, 0.f};
          sa = mfma16(XA0, ef[j][0], sa); sb = mfma16(XB0, ef[j][0], sb); sa = mfma16(XA1, ef[j][1], sa); sb = mfma16(XB1, ef[j][1], sb);
          sa = mfma16(XA2, ef[j][2], sa); sb = mfma16(XB2, ef[j][2], sb); sa = mfma16(XA3, ef[j][3], sa); sb = mfma16(XB3, ef[j][3], sb);
          LAS float* s2 = sw + 16 * j; s2[0] = sa[0]; s2[128] = sa[1]; s2[256] = sa[2]; s2[384] = sa[3]; s2[2048] = sb[0]; s2[2048 + 128] = sb[1]; s2[2048 + 256] = sb[2]; s2[2048 + 384] = sb[3]; }
        eb += 16384; sw += 64; } }
    asm volatile("" ::: "memory");
    { const char* kb = KTg; char* yq = (char*)(Y + (size_t)t0 * D + AW + BW + g * 16); const unsigned vy = (unsigned)((ln * 8) * D + 4 * q) * 2u;
#pragma unroll 1
      for (int th = 0; th < 4; ++th) {
          const bf16x8 ka = ldg<bf16x8>(kb, vo32), kc = ldg<bf16x8>(kb + 1024, vo32);
          f32x4 a0 = (f32x4){0.f, 0.f, 0.f, 0.f}, a1 = a0, b0 = a0, b1 = a0;
          a0 = mfma16(ka, XA0, a0); a1 = mfma16(kc, XA0, a1); b0 = mfma16(ka, XB0, b0); b1 = mfma16(kc, XB0, b1);
          if (th >= 1) { const bf16x8 k0 = ldg<bf16x8>(kb - 2048, vo32), k1 = ldg<bf16x8>(kb - 1024, vo32); a0 = mfma16(k0, XA1, a0); a1 = mfma16(k1, XA1, a1); b0 = mfma16(k0, XB1, b0); b1 = mfma16(k1, XB1, b1); }
          if (th >= 2) { const bf16x8 k0 = ldg<bf16x8>(kb - 4096, vo32), k1 = ldg<bf16x8>(kb - 3072, vo32); a0 = mfma16(k0, XA2, a0); a1 = mfma16(k1, XA2, a1); b0 = mfma16(k0, XB2, b0); b1 = mfma16(k1, XB2, b1); }
          if (th >= 3) { const bf16x8 k0 = ldg<bf16x8>(kb - 6144, vo32), k1 = ldg<bf16x8>(kb - 5120, vo32); a0 = mfma16(k0, XA3, a0); a1 = mfma16(k1, XA3, a1); b0 = mfma16(k0, XB3, b0); b1 = mfma16(k1, XB3, b1); }
          u32x2 w; w.x = cvt_pk_bf16(a0[0], a0[1]); w.y = cvt_pk_bf16(a0[2], a0[3]); *(u32x2*)(yq + vy) = w;
          w.x = cvt_pk_bf16(a1[0], a1[1]); w.y = cvt_pk_bf16(a1[2], a1[3]); *(u32x2*)(yq + (size_t)D * 2 + vy) = w;
          w.x = cvt_pk_bf16(b0[0], b0[1]); w.y = cvt_pk_bf16(b0[2], b0[3]); *(u32x2*)(yq + (size_t)128 * D * 2 + vy) = w;
          w.x = cvt_pk_bf16(b1[0], b1[1]); w.y = cvt_pk_bf16(b1[2], b1[3]); *(u32x2*)(yq + (size_t)129 * D * 2 + vy) = w;
          kb += 2048; yq += (size_t)2 * D * 2; } }
    asm volatile("" ::: "memory");
    const float l8r = LAMPg[lane * 8 + 2], l8i = LAMPg[lane * 8 + 3];
    float sr = 0.f, si = 0.f;
    { char* seb = (char*)(SE + ((size_t)(2 * pr) * CG + g) * 16 * 128);
#pragma unroll
      for (int s = 0; s < 16; ++s) { const float er = SbA[s * 128 + lane], ei = SbA[s * 128 + 64 + lane];
          *(float*)(seb + s * 512 + vl) = er; *(float*)(seb + s * 512 + 256 + vl) = ei;
          const float nr = l8r * sr - l8i * si + er, ni = l8r * si + l8i * sr + ei; sr = nr; si = ni; }
      float* dst = SEND + (((size_t)(2 * pr) * CG + g) * 2) * CS + lane; dst[0] = sr; dst[CS] = si; }
    { char* seb = (char*)(SE + ((size_t)(2 * pr + 1) * CG + g) * 16 * 128);
#pragma unroll
      for (int s = 0; s < 16; ++s) { const float er = SbB[s * 128 + lane], ei = SbB[s * 128 + 64 + lane];
          *(float*)(seb + s * 512 + vl) = er; *(float*)(seb + s * 512 + 256 + vl) = ei;
          const float nr = l8r * sr - l8i * si + er, ni = l8r * si + l8i * sr + ei; sr = nr; si = ni; }
      float* dst = SEND2 + (((size_t)pr * CG + g) * 2) * CS + lane; dst[0] = sr; dst[CS] = si; }
    asm volatile("s_waitcnt lgkmcnt(0)" ::: "memory");
}
constexpr int S5_PSG = 133120;
__device__ __forceinline__ void s5_glu(int unit, int wave, int lane, const bf16_t* WGLU, const float* glu_b, const float* mo_gc, bf16_t* Y, LAS unsigned char* lds) {
    const int ln = lane & 15, q = lane >> 4; LAS bf16_t* yst = (LAS bf16_t*)(lds + S5_YST); LAS float* PSg = (LAS float*)(lds + S5_PSG);
    bf16x8 wf[2][8];
    { const char* wb = (const char*)(WGLU + (size_t)(32 * wave) * 256); const unsigned vw = (unsigned)(ln * 256 + 8 * q) * 2u;
#pragma unroll
      for (int j = 0; j < 2; ++j)
#pragma unroll
          for (int ks = 0; ks < 8; ++ks) wf[j][ks] = ldg<bf16x8>(wb + j * 8192 + ks * 64, vw); }
    const f32x4 gb0 = *(const f32x4*)(glu_b + 32 * wave + 4 * q), gb1 = *(const f32x4*)(glu_b + 32 * wave + 16 + 4 * q);
    LAS bf16_t* op = (LAS bf16_t*)(lds + wave * S5_WSCR) + ln * 32 + 4 * q;
    { const LAS bf16_t* yrow = yst + ln * YST_LD; LAS float* psw = PSg + ln * 8 + wave; LAS bf16_t* ow = op;
#pragma unroll 2
      for (int tt = 0; tt < 8; ++tt) {
        f32x4 a0 = (f32x4){0.f, 0.f, 0.f, 0.f}, a1 = (f32x4){0.f, 0.f, 0.f, 0.f};
#pragma unroll
        for (int ks = 0; ks < 8; ++ks) { const bf16x8 yf = *(const LAS bf16x8*)(yrow + 32 * ks + 8 * q); a0 = mfma16(wf[0][ks], yf, a0); a1 = mfma16(wf[1][ks], yf, a1); }
        const u32x2 y0 = *(const LAS u32x2*)(yrow + 32 * wave + 4 * q), y1 = *(const LAS u32x2*)(yrow + 32 * wave + 16 + 4 * q);
        float o[8];
        o[0] = __uint_as_float(y0.x << 16) * sigmoid_fast(a0[0] + gb0[0]); o[1] = __uint_as_float(y0.x & 0xffff0000u) * sigmoid_fast(a0[1] + gb0[1]); o[2] = __uint_as_float(y0.y << 16) * sigmoid_fast(a0[2] + gb0[2]); o[3] = __uint_as_float(y0.y & 0xffff0000u) * sigmoid_fast(a0[3] + gb0[3]);
        o[4] = __uint_as_float(y1.x << 16) * sigmoid_fast(a1[0] + gb1[0]); o[5] = __uint_as_float(y1.x & 0xffff0000u) * sigmoid_fast(a1[1] + gb1[1]); o[6] = __uint_as_float(y1.y << 16) * sigmoid_fast(a1[2] + gb1[2]); o[7] = __uint_as_float(y1.y & 0xffff0000u) * sigmoid_fast(a1[3] + gb1[3]);
        float ss = ((o[0] * o[0] + o[1] * o[1]) + (o[2] * o[2] + o[3] * o[3])) + ((o[4] * o[4] + o[5] * o[5]) + (o[6] * o[6] + o[7] * o[7]));
        ss = add_x16_x32(ss);
        if (q == 0) *psw = ss;
        u32x2 w; w.x = cvt_pk_bf16(o[0], o[1]); w.y = cvt_pk_bf16(o[2], o[3]); *(LAS u32x2*)(ow) = w; w.x = cvt_pk_bf16(o[4], o[5]); w.y = cvt_pk_bf16(o[6], o[7]); *(LAS u32x2*)(ow + 16) = w;
        yrow += 16 * YST_LD; psw += 16 * 8; ow += 16 * 32; } }
    asm volatile("s_waitcnt lgkmcnt(0)" ::: "memory");
    __syncthreads();
    const f32x4 g0 = *(const f32x4*)(mo_gc + 32 * wave + 4 * q), g1 = *(const f32x4*)(mo_gc + 32 * wave + 16 + 4 * q);
    { char* yb = (char*)(Y + (size_t)(unit * 128) * D + AW + BW + 32 * wave); const unsigned vy = (unsigned)(ln * D + 4 * q) * 2u; const LAS f32x4* pp = (const LAS f32x4*)(PSg + ln * 8); const LAS bf16_t* ow = op;
#pragma unroll 2
      for (int tt = 0; tt < 8; ++tt) { const f32x4 p0 = pp[0], p1 = pp[1];
        const float rs = __builtin_amdgcn_rsqf((((p0[0] + p0[1]) + (p0[2] + p0[3])) + ((p1[0] + p1[1]) + (p1[2] + p1[3]))) * (1.0f / CW) + EPS);
        const u32x2 a = *(const LAS u32x2*)(ow), b = *(const LAS u32x2*)(ow + 16); u32x2 w;
        w.x = cvt_pk_bf16(__uint_as_float(a.x << 16) * rs * g0[0], __uint_as_float(a.x & 0xffff0000u) * rs * g0[1]); w.y = cvt_pk_bf16(__uint_as_float(a.y << 16) * rs * g0[2], __uint_as_float(a.y & 0xffff0000u) * rs * g0[3]);
        *(u32x2*)(yb + vy) = w;
        w.x = cvt_pk_bf16(__uint_as_float(b.x << 16) * rs * g1[0], __uint_as_float(b.x & 0xffff0000u) * rs * g1[1]); w.y = cvt_pk_bf16(__uint_as_float(b.y << 16) * rs * g1[2], __uint_as_float(b.y & 0xffff0000u) * rs * g1[3]);
        *(u32x2*)(yb + 32 + vy) = w;
        yb += (size_t)16 * D * 2; pp += 16 * 2; ow += 16 * 32; } }
}

constexpr int XC_LD = 392;
constexpr int RG_XC = 0, RG_PS = 100352, RG_CAR = 112640, RG_RSB = 114176, RG_PT = 114688, RG_HC = 116224;
template <int CTRL> __device__ __forceinline__ float dppf(float old, float v) { return __int_as_float(__builtin_amdgcn_update_dpp(__float_as_int(old), __float_as_int(v), CTRL, 0xf, 0xf, false)); }
__device__ __forceinline__ void bf8_to_f32(const u32x4 o, float (&v)[8]) {
    v[0] = __uint_as_float(o.x << 16); v[1] = __uint_as_float(o.x & 0xffff0000u); v[2] = __uint_as_float(o.y << 16); v[3] = __uint_as_float(o.y & 0xffff0000u);
    v[4] = __uint_as_float(o.z << 16); v[5] = __uint_as_float(o.z & 0xffff0000u); v[6] = __uint_as_float(o.w << 16); v[7] = __uint_as_float(o.w & 0xffff0000u);
}
__device__ __forceinline__ float bcast15(float v) { return __int_as_float(__builtin_amdgcn_ds_swizzle(__float_as_int(v), 0x1F0)); }
template <int PASS>
__device__ __forceinline__ void rglru_unit(int unit, bool first, float& cprev, int tid, int wave, int lane, const bf16_t* Z, bf16_t* Y, const bf16_t* WRG, const bf16_t* WIG,
                                           const float* conv_w, const float* conv_b, const float* rg_b, const float* ig_b, const float* lam, const float* mo_gb,
                                           float* SUMA, float* SUMH, float* SUMA2, float* SUMH2, bf16_t* HL, bf16_t* PP, LAS unsigned char* lds) {
    LAS bf16_t* xcl = (LAS bf16_t*)(lds + RG_XC); LAS float* PS = (LAS float*)(lds + RG_PS); LAS float* CAR = (LAS float*)(lds + RG_CAR); LAS float* RSB = (LAS float*)(lds + RG_RSB); LAS float* PT = (LAS float*)(lds + RG_PT); LAS float* HC = (LAS float*)(lds + RG_HC);
    const int t0 = unit * 128; const int ln = lane & 15, q = lane >> 4;
    if (tid < 384) {
        const int c0 = (tid % 48) * 8, tg = tid / 48; const int tb = t0 + tg * 16, s0 = tb % SEQ;
        float w0[8], w1[8], w2[8], w3[8], bb[8];
#pragma unroll
        for (int hh = 0; hh < 2; ++hh) { const f32x4 a0 = *(const f32x4*)(conv_w + 0 * BW + c0 + 4 * hh), a1 = *(const f32x4*)(conv_w + 1 * BW + c0 + 4 * hh), a2 = *(const f32x4*)(conv_w + 2 * BW + c0 + 4 * hh), a3 = *(const f32x4*)(conv_w + 3 * BW + c0 + 4 * hh), a4 = *(const f32x4*)(conv_b + c0 + 4 * hh);
#pragma unroll
            for (int j = 0; j < 4; ++j) { w0[4 * hh + j] = a0[j]; w1[4 * hh + j] = a1[j]; w2[4 * hh + j] = a2[j]; w3[4 * hh + j] = a3[j]; bb[4 * hh + j] = a4[j]; } }
        float xm1[8], xm2[8], xm3[8];
        const bf16_t* zp = Z + (size_t)tb * INC + ZX + c0;
        { const u32x4 z4 = {0u, 0u, 0u, 0u}; const u32x4 o1 = s0 >= 1 ? *(const u32x4*)(zp - INC) : z4, o2 = s0 >= 2 ? *(const u32x4*)(zp - 2 * INC) : z4, o3 = s0 >= 3 ? *(const u32x4*)(zp - 3 * INC) : z4;
          bf8_to_f32(o1, xm1); bf8_to_f32(o2, xm2); bf8_to_f32(o3, xm3); }
        LAS bf16_t* xw = xcl + (tg * 16) * XC_LD + c0;
#pragma unroll 4
        for (int i = 0; i < 16; ++i) { float x0[8]; bf8_to_f32(*(const u32x4*)(zp), x0); float v[8];
#pragma unroll
            for (int j = 0; j < 8; ++j) { v[j] = bb[j] + w3[j] * x0[j] + w2[j] * xm1[j] + w1[j] * xm2[j] + w0[j] * xm3[j]; xm3[j] = xm2[j]; xm2[j] = xm1[j]; xm1[j] = x0[j]; }
            u32x4 w; w.x = cvt_pk_bf16(v[0], v[1]); w.y = cvt_pk_bf16(v[2], v[3]); w.z = cvt_pk_bf16(v[4], v[5]); w.w = cvt_pk_bf16(v[6], v[7]);
            *(LAS u32x4*)(xw) = w; zp += INC; xw += XC_LD; }
        if (PASS == 2) { const int c = tid; float h;
            if (first) { const int pr = unit >> 1, p0 = pr - (pr % (UPB128 / 2)); h = 0.f; const float* pa = SUMA2 + (size_t)p0 * BW + c; const float* ph = SUMH2 + (size_t)p0 * BW + c;
#pragma unroll 8
                for (int j = p0; j < pr; ++j) { h = fmaf(*pa, h, *ph); pa += BW; ph += BW; } }
            else h = fmaf(SUMA[(size_t)(unit - 1) * BW + c], cprev, SUMH[(size_t)(unit - 1) * BW + c]);
            cprev = h; CAR[c] = h; }
    }
    __syncthreads();
#pragma unroll 1
    for (int ci = 0; ci < 3; ++ci) {
        const int combo = wave + 8 * ci, h = combo >> 2, jt = combo & 3, cb = h * 64 + jt * 16;
        const bf16_t* wr = WRG + ((size_t)(h * 64 + jt * 16 + ln)) * 64 + 8 * q; const bf16_t* wi = WIG + ((size_t)(h * 64 + jt * 16 + ln)) * 64 + 8 * q;
        const bf16x8 RG0 = *(const bf16x8*)(wr), RG1 = *(const bf16x8*)(wr + 32), IG0 = *(const bf16x8*)(wi), IG1 = *(const bf16x8*)(wi + 32);
        const f32x4 rgb4 = *(const f32x4*)(rg_b + cb + 4 * q), igb4 = *(const f32x4*)(ig_b + cb + 4 * q), lam4 = *(const f32x4*)(lam + cb + 4 * q);
        float spc[4], car[4], ptot[4];
#pragma unroll
        for (int r = 0; r < 4; ++r) { spc[r] = -8.0f * 1.4426950408889634f * log1pf(expf(-lam4[r])); car[r] = PASS == 2 ? CAR[cb + 4 * q + r] : (first ? 0.f : HC[cb + 4 * q + r]); ptot[r] = (PASS == 1 && !first) ? PT[cb + 4 * q + r] : 1.f; }
        const LAS bf16_t* xb = xcl + ln * XC_LD + h * 64 + 8 * q; const LAS bf16_t* xv = xcl + ln * XC_LD + cb + 4 * q;
        const bf16_t* zg = Z + (size_t)(t0 + ln) * INC + ZG + cb + 4 * q; bf16_t* yo = Y + (size_t)(t0 + ln) * D + AW + cb + 4 * q; LAS float* psw = PS + ln * 24 + combo;
        bf16_t* hlo = HL + (size_t)(t0 + ln) * BW + cb + 4 * q; bf16_t* ppo = PP + (size_t)(t0 + ln) * BW + cb + 4 * q;
#pragma unroll 1
        for (int tt = 0; tt < 8; ++tt) {
            const bf16x8 B0 = *(const LAS bf16x8*)(xb), B1 = *(const LAS bf16x8*)(xb + 32);
            f32x4 ar = (f32x4){0.f, 0.f, 0.f, 0.f}, ai = (f32x4){0.f, 0.f, 0.f, 0.f};
            ar = mfma16(RG0, B0, ar); ar = mfma16(RG1, B1, ar); ai = mfma16(IG0, B0, ai); ai = mfma16(IG1, B1, ai);
            const u32x2 xq = *(const LAS u32x2*)(xv); float xc4[4] = {__uint_as_float(xq.x << 16), __uint_as_float(xq.x & 0xffff0000u), __uint_as_float(xq.y << 16), __uint_as_float(xq.y & 0xffff0000u)};
            float hv[4], pv[4];
#pragma unroll
            for (int r = 0; r < 4; ++r) {
                const float rr = sigmoid_fast(ar[r] + rgb4[r]), ii = sigmoid_fast(ai[r] + igb4[r]);
                float A = __builtin_amdgcn_exp2f(spc[r] * rr);
                float Bv = __builtin_amdgcn_sqrtf(fmaxf(1.0f - A * A, 0.f)) * (ii * xc4[r]);
                if (ln == 0) Bv = fmaf(A, car[r], Bv);
                { const float As = dppf<0x111>(1.0f, A), Bs = dppf<0x111>(0.0f, Bv); Bv = fmaf(A, Bs, Bv); A *= As; }
                { const float As = dppf<0x112>(1.0f, A), Bs = dppf<0x112>(0.0f, Bv); Bv = fmaf(A, Bs, Bv); A *= As; }
                { const float As = dppf<0x114>(1.0f, A), Bs = dppf<0x114>(0.0f, Bv); Bv = fmaf(A, Bs, Bv); A *= As; }
                { const float As = dppf<0x118>(1.0f, A), Bs = dppf<0x118>(0.0f, Bv); Bv = fmaf(A, Bs, Bv); A *= As; }
                hv[r] = Bv; car[r] = bcast15(Bv);
                if (PASS == 1) { pv[r] = ptot[r] * A; ptot[r] *= bcast15(A); }
            }
            if (PASS == 1) { u32x2 w; w.x = cvt_pk_bf16(hv[0], hv[1]); w.y = cvt_pk_bf16(hv[2], hv[3]); *(u32x2*)(hlo) = w; w.x = cvt_pk_bf16(pv[0], pv[1]); w.y = cvt_pk_bf16(pv[2], pv[3]); *(u32x2*)(ppo) = w; hlo += 16 * BW; ppo += 16 * BW; }
            if (PASS == 2) { const u32x2 gq = *(const u32x2*)(zg);
                const float y0 = hv[0] * __uint_as_float(gq.x << 16), y1 = hv[1] * __uint_as_float(gq.x & 0xffff0000u), y2 = hv[2] * __uint_as_float(gq.y << 16), y3 = hv[3] * __uint_as_float(gq.y & 0xffff0000u);
                u32x2 w; w.x = cvt_pk_bf16(y0, y1); w.y = cvt_pk_bf16(y2, y3); *(u32x2*)(yo) = w;
                float ss = (y0 * y0 + y1 * y1) + (y2 * y2 + y3 * y3); ss += __shfl_xor(ss, 16); ss += __shfl_xor(ss, 32);
                if (q == 0) *psw = ss; }
            xb += 16 * XC_LD; xv += 16 * XC_LD; zg += 16 * INC; yo += 16 * D; psw += 16 * 24;
        }
        if (PASS == 1 && ln == 0) {
            float* da = first ? SUMA + (size_t)unit * BW : SUMA2 + (size_t)(unit >> 1) * BW; float* dh = first ? SUMH + (size_t)unit * BW : SUMH2 + (size_t)(unit >> 1) * BW;
#pragma unroll
            for (int r = 0; r < 4; ++r) { da[cb + 4 * q + r] = ptot[r]; dh[cb + 4 * q + r] = car[r]; if (first) { PT[cb + 4 * q + r] = ptot[r]; HC[cb + 4 * q + r] = car[r]; } } }
    }
    if (PASS == 2) {
        asm volatile("s_waitcnt vmcnt(0)" ::: "memory");
        __syncthreads();
        if (tid < 128) { float s = 0.f;
#pragma unroll
            for (int k = 0; k < 24; ++k) s += PS[tid * 24 + k];
            RSB[tid] = __builtin_amdgcn_rsqf(s * (1.0f / BW) + EPS); }
        __syncthreads();
#pragma unroll 2
        for (int k = 0; k < 12; ++k) { const int idx = tid + 512 * k, tl = idx / 48, c0 = (idx % 48) * 8; const float rs = RSB[tl];
            bf16_t* yp = Y + (size_t)(t0 + tl) * D + AW + c0; float v[8]; bf8_to_f32(*(const u32x4*)(yp), v);
            const f32x4 g0 = *(const f32x4*)(mo_gb + c0), g1 = *(const f32x4*)(mo_gb + c0 + 4);
            u32x4 w; w.x = cvt_pk_bf16(v[0] * rs * g0[0], v[1] * rs * g0[1]); w.y = cvt_pk_bf16(v[2] * rs * g0[2], v[3] * rs * g0[3]); w.z = cvt_pk_bf16(v[4] * rs * g1[0], v[5] * rs * g1[1]); w.w = cvt_pk_bf16(v[6] * rs * g1[2], v[7] * rs * g1[3]);
            *(u32x4*)(yp) = w; }
    }
    __syncthreads();
}

__device__ __forceinline__ void rglru_fix_pair(int pr, int tid, int wave, int lane, const bf16_t* Z, bf16_t* Y, const bf16_t* HL, const bf16_t* PP, const float* SUMA2, const float* SUMH2, const float* mo_gb, LAS unsigned char* lds) {
    LAS float* CAR = (LAS float*)(lds + RG_CAR);
    if (tid < 384) { const int c = tid, p0 = pr - (pr % (UPB128 / 2)); float h = 0.f; const float* pa = SUMA2 + (size_t)p0 * BW + c; const float* ph = SUMH2 + (size_t)p0 * BW + c;
#pragma unroll 8
        for (int j = p0; j < pr; ++j) { h = fmaf(*pa, h, *ph); pa += BW; ph += BW; }
        CAR[c] = h; }
    __syncthreads();
    {
        const bool act = lane < 48; const int c0 = act ? lane * 8 : 0; float hin[8]; const f32x4 g0 = *(const f32x4*)(mo_gb + c0), g1 = *(const f32x4*)(mo_gb + c0 + 4);
#pragma unroll
        for (int e = 0; e < 8; ++e) hin[e] = CAR[c0 + e];
#pragma unroll 2
        for (int i = 0; i < 32; ++i) { const size_t t = (size_t)pr * 256 + wave * 32 + i;
            float hl[8], pp[8], gg[8], y[8]; bf8_to_f32(*(const u32x4*)(HL + t * BW + c0), hl); bf8_to_f32(*(const u32x4*)(PP + t * BW + c0), pp); bf8_to_f32(*(const u32x4*)(Z + t * INC + ZG + c0), gg);
            float ss = 0.f;
#pragma unroll
            for (int e = 0; e < 8; ++e) { y[e] = fmaf(pp[e], hin[e], hl[e]) * gelu_fast(gg[e]); ss += y[e] * y[e]; }
            ss = wave_sum(act ? ss : 0.f);
            const float rs = __builtin_amdgcn_rsqf(ss * (1.0f / BW) + EPS);
            u32x4 w; w.x = cvt_pk_bf16(y[0] * rs * g0[0], y[1] * rs * g0[1]); w.y = cvt_pk_bf16(y[2] * rs * g0[2], y[3] * rs * g0[3]); w.z = cvt_pk_bf16(y[4] * rs * g1[0], y[5] * rs * g1[1]); w.w = cvt_pk_bf16(y[6] * rs * g1[2], y[7] * rs * g1[3]);
            if (act) *(u32x4*)(Y + t * D + AW + c0) = w; }
    }
    __syncthreads();
}

constexpr int VT_LD = 136;
__device__ __forceinline__ void mixa_unit(int unit, int tid, int wave, int lane, const bf16_t* Z, bf16_t* Y, const bf16_t* WSP, const float* a_sb, const float* vg, const float* mo_ga, LAS unsigned char* lds) {
    LAS bf16_t* vT = (LAS bf16_t*)lds; const int t0 = unit * 128; const int ln = lane & 15, q = lane >> 4;
    { const int j = tid >> 2, part = tid & 3; const bf16_t* zp = Z + (size_t)(t0 + j) * INC + ZV + part * 96;
      u32x4 raw[12]; float ss = 0.f;
#pragma unroll
      for (int k = 0; k < 12; ++k) { const u32x4 rw = *(const u32x4*)(zp + 8 * k); float v[8]; bf8_to_f32(rw, v);
#pragma unroll
          for (int e = 0; e < 8; ++e) { v[e] = gelu_fast(v[e]); ss += v[e] * v[e]; }
          raw[k].x = cvt_pk_bf16(v[0], v[1]); raw[k].y = cvt_pk_bf16(v[2], v[3]); raw[k].z = cvt_pk_bf16(v[4], v[5]); raw[k].w = cvt_pk_bf16(v[6], v[7]); }
      ss += x_xor1(ss); ss += x_xor2(ss);
      const float rs = __builtin_amdgcn_rsqf(ss * (1.0f / AW) + EPS);
      LAS bf16_t* vw = vT + (part * 96) * VT_LD + j; const float* gp = vg + part * 96;
#pragma unroll
      for (int k = 0; k < 12; ++k) { float v[8]; bf8_to_f32(raw[k], v); const f32x4 g0 = *(const f32x4*)(gp + 8 * k), g1 = *(const f32x4*)(gp + 8 * k + 4);
#pragma unroll
          for (int e = 0; e < 8; ++e) vw[(8 * k + e) * VT_LD] = f2bf(v[e] * rs * (e < 4 ? g0[e] : g1[e - 4])); } }
    __syncthreads();
    const bool full = wave >= 4;
    float ss = 0.f;
    const int tl = 16 * wave + ln;
    const char* ub = (const char*)(Z + (size_t)t0 * INC + ZU); const unsigned vu = (unsigned)(tl * INC + 4 * q) * 2u;
    const char* wb = (const char*)WSP; const unsigned vw = (unsigned)(tl * 128 + 8 * q) * 2u;
    char* yb = (char*)(Y + (size_t)t0 * D); const unsigned vy = (unsigned)(tl * D + 4 * q) * 2u;
    const bf16x8 z8 = {0, 0, 0, 0, 0, 0, 0, 0};
    bf16x8 Wn0 = ldg<bf16x8>(wb, vw), Wn1 = ldg<bf16x8>(wb + 64, vw), Wn2 = z8, Wn3 = z8;
    if (full) { Wn2 = ldg<bf16x8>(wb + 128, vw); Wn3 = ldg<bf16x8>(wb + 192, vw); }
    u32x2 un0 = ldg<u32x2>(ub, vu), un1 = ldg<u32x2>(ub + 32, vu), un2 = ldg<u32x2>(ub + 64, vu), un3 = ldg<u32x2>(ub + 96, vu); float bn = a_sb[tl];
    const LAS bf16_t* ap = vT + ln * VT_LD + 8 * q;
#pragma unroll 1
    for (int h = 0; h < 6; ++h) {
        const bf16x8 W0 = Wn0, W1 = Wn1, W2 = Wn2, W3 = Wn3; const u32x2 uc[4] = {un0, un1, un2, un3}; const float b = bn;
        if (h < 5) { wb += 128 * 128 * 2; ub += 128; Wn0 = ldg<bf16x8>(wb, vw); Wn1 = ldg<bf16x8>(wb + 64, vw); if (full) { Wn2 = ldg<bf16x8>(wb + 128, vw); Wn3 = ldg<bf16x8>(wb + 192, vw); }
            un0 = ldg<u32x2>(ub, vu); un1 = ldg<u32x2>(ub + 32, vu); un2 = ldg<u32x2>(ub + 64, vu); un3 = ldg<u32x2>(ub + 96, vu); bn = a_sb[(h + 1) * 128 + tl]; }
#pragma unroll
        for (int dt = 0; dt < 4; ++dt) { f32x4 acc = (f32x4){0.f, 0.f, 0.f, 0.f};
            const bf16x8 a0 = *(const LAS bf16x8*)(ap + 16 * dt * VT_LD), a1 = *(const LAS bf16x8*)(ap + 16 * dt * VT_LD + 32), a2 = *(const LAS bf16x8*)(ap + 16 * dt * VT_LD + 64), a3 = *(const LAS bf16x8*)(ap + 16 * dt * VT_LD + 96);
            acc = mfma16(a0, W0, acc); acc = mfma16(a1, W1, acc); acc = mfma16(a2, W2, acc); acc = mfma16(a3, W3, acc);
            const u32x2 u2 = uc[dt];
            const float v0 = gelu_fast(__uint_as_float(u2.x << 16)) * (acc[0] + b), v1 = gelu_fast(__uint_as_float(u2.x & 0xffff0000u)) * (acc[1] + b), v2 = gelu_fast(__uint_as_float(u2.y << 16)) * (acc[2] + b), v3 = gelu_fast(__uint_as_float(u2.y & 0xffff0000u)) * (acc[3] + b);
            ss += (v0 * v0 + v1 * v1) + (v2 * v2 + v3 * v3);
            u32x2 pk; pk.x = cvt_pk_bf16(v0, v1); pk.y = cvt_pk_bf16(v2, v3); *(u32x2*)(yb + (h * 64 + 16 * dt) * 2 + vy) = pk; }
        ap += 64 * VT_LD;
    }
    ss = add_x16_x32(ss);
    const float rs = __builtin_amdgcn_rsqf(ss * (1.0f / AW) + EPS);
    asm volatile("s_waitcnt vmcnt(0)" ::: "memory");
    { const char* gb = (const char*)mo_ga; const unsigned vg4 = (unsigned)(4 * q) * 4u;
#pragma unroll 1
      for (int kb = 0; kb < 3; ++kb) { u32x2 pk[8];
#pragma unroll
          for (int k = 0; k < 8; ++k) pk[k] = ldg<u32x2>(yb + k * 32, vy);
#pragma unroll
          for (int k = 0; k < 8; ++k) { const f32x4 gg = ldg<f32x4>(gb + k * 64, vg4);
              u32x2 w; w.x = cvt_pk_bf16(__uint_as_float(pk[k].x << 16) * rs * gg[0], __uint_as_float(pk[k].x & 0xffff0000u) * rs * gg[1]); w.y = cvt_pk_bf16(__uint_as_float(pk[k].y << 16) * rs * gg[2], __uint_as_float(pk[k].y & 0xffff0000u) * rs * gg[3]);
              *(u32x2*)(yb + k * 32 + vy) = w; }
          yb += 256; gb += 512; } }
    __syncthreads();
}

__device__ __forceinline__ void router_unit(int unit, int wave, int lane, const bf16_t* HB, const float* SSQ, const bf16_t* WRT, const float* rgb, const float* reb,
                                            int* CLS, float* G2, LAS unsigned char* lds, LAS int* hist) {
    const int ln = lane & 15, q = lane >> 4; const int t0 = unit * UT + wave * 32;
    LAS float* LG = (LAS float*)(lds + wave * 8192);
    f32x4 acc[2][3];
#pragma unroll
    for (int tt = 0; tt < 2; ++tt)
#pragma unroll
        for (int j = 0; j < 3; ++j) acc[tt][j] = (f32x4){0.f, 0.f, 0.f, 0.f};
    const bf16_t* hp0 = HB + (size_t)(t0 + ln) * D + 8 * q; const bf16_t* hp1 = hp0 + (size_t)16 * D; const bf16_t* wp = WRT + (size_t)ln * D + 8 * q;
#pragma unroll 4
    for (int ks = 0; ks < 32; ++ks) {
        const bf16x8 b0 = *(const bf16x8*)(hp0), b1 = *(const bf16x8*)(hp1);
        const bf16x8 a0 = *(const bf16x8*)(wp), a1 = *(const bf16x8*)(wp + 16 * D), a2 = *(const bf16x8*)(wp + 32 * D);
        acc[0][0] = mfma16(a0, b0, acc[0][0]); acc[0][1] = mfma16(a1, b0, acc[0][1]); acc[0][2] = mfma16(a2, b0, acc[0][2]);
        acc[1][0] = mfma16(a0, b1, acc[1][0]); acc[1][1] = mfma16(a1, b1, acc[1][1]); acc[1][2] = mfma16(a2, b1, acc[1][2]);
        hp0 += 32; hp1 += 32; wp += 32; }
#pragma unroll
    for (int tt = 0; tt < 2; ++tt)
#pragma unroll
        for (int j = 0; j < 3; ++j) *(LAS f32x4*)(LG + (16 * tt + ln) * 48 + 16 * j + 4 * q) = acc[tt][j];
    asm volatile("s_waitcnt lgkmcnt(0)" ::: "memory");
    if (lane < 32) { const int t = t0 + lane; const LAS float* lg = LG + lane * 48;
        const f32x4* sp = (const f32x4*)(SSQ + (size_t)t * 16); const f32x4 s0 = sp[0], s1 = sp[1], s2 = sp[2], s3 = sp[3];
        const float sq = ((s0[0] + s0[1]) + (s0[2] + s0[3])) + ((s1[0] + s1[1]) + (s1[2] + s1[3])) + ((s2[0] + s2[1]) + (s2[2] + s2[3])) + ((s3[0] + s3[1]) + (s3[2] + s3[3]));
        const float r = rsqrtf(sq * (1.0f / D) + EPS);
        float gl[4];
#pragma unroll
        for (int j = 0; j < 4; ++j) gl[j] = r * (lg[j] + lg[16 + j]) + rgb[j];
        int gs = 0; float gm = gl[0];
#pragma unroll
        for (int j = 1; j < 4; ++j) if (gl[j] > gm) { gm = gl[j]; gs = j; }
        float den = 0.f;
#pragma unroll
        for (int j = 0; j < 4; ++j) den += expf(gl[j] - gm);
        const float gwt = 1.0f / den;
        float el[4];
#pragma unroll
        for (int j = 0; j < 4; ++j) { float v;
            if (gs < 3) v = lg[4 + 4 * gs + j] + lg[16 + 4 + 4 * gs + j]; else v = lg[32 + j] + lg[36 + j];
            el[j] = r * v + reb[gs * 4 + j]; }
        int i0 = 0; float v0 = el[0];
#pragma unroll
        for (int j = 1; j < 4; ++j) if (el[j] > v0) { v0 = el[j]; i0 = j; }
        int i1 = 0; float v1 = -3.0e38f;
#pragma unroll
        for (int j = 0; j < 4; ++j) if (j != i0 && el[j] > v1) { v1 = el[j]; i1 = j; }
        const float e1 = expf(v1 - v0); const float w0 = gwt / (1.0f + e1), w1 = gwt * e1 / (1.0f + e1);
        const int lo = i0 < i1 ? i0 : i1, hi = i0 < i1 ? i1 : i0; const int cls = gs * 6 + pair_idx(lo, hi);
        CLS[t] = cls; G2[(size_t)t * 2 + 0] = i0 < i1 ? w0 : w1; G2[(size_t)t * 2 + 1] = i0 < i1 ? w1 : w0;
        __hip_atomic_fetch_add(hist + cls, 1, __ATOMIC_RELAXED, __HIP_MEMORY_SCOPE_WORKGROUP); }
}

__device__ __forceinline__ void tr_item8(const float* W, int ldw, int k0, int scol0, unsigned char* WT, int ldo, int drow0, int dk0, LAS float* scr, int lane) {
#pragma unroll 8
    for (int i = 0; i < 32; ++i) { const int kk = 2 * i + (lane >> 5); scr[kk * 33 + (lane & 31)] = W[(size_t)(k0 + kk) * ldw + scol0 + (lane & 31)] * pg8::FS_W; }
    asm volatile("s_waitcnt lgkmcnt(0)" ::: "memory");
    const int c = lane & 7;
#pragma unroll
    for (int j = 0; j < 4; ++j) { const int n = (lane >> 3) + 8 * j; const LAS float* s = scr + (8 * c) * 33 + n;
        u32x2 o; o.x = pk_fp8x4(s[0 * 33], s[1 * 33], s[2 * 33], s[3 * 33]); o.y = pk_fp8x4(s[4 * 33], s[5 * 33], s[6 * 33], s[7 * 33]);
        *(u32x2*)(WT + (size_t)(drow0 + n) * ldo + dk0 + 8 * c) = o; }
    asm volatile("s_waitcnt lgkmcnt(0)" ::: "memory");
}
struct TrP { const float* src; const float* gk; unsigned char* dst; int ldw, ldo, fp8; };
__device__ __forceinline__ void tr_load(const TrP& P, int lane, float (&v)[32]) {
#pragma unroll
    for (int i = 0; i < 32; ++i) { const int kk = 2 * i + (lane >> 5); float x = P.src[(size_t)kk * P.ldw + (lane & 31)]; if (P.gk) x *= P.gk[kk]; v[i] = x; }
}
__device__ __forceinline__ void tr_store(const TrP& P, int lane, const float (&v)[32], LAS float* scr) {
    const float sc = P.fp8 ? pg8::FS_W : 1.0f;
#pragma unroll
    for (int i = 0; i < 32; ++i) scr[(2 * i + (lane >> 5)) * 33 + (lane & 31)] = v[i] * sc;
    asm volatile("s_waitcnt lgkmcnt(0)" ::: "memory");
    const int c = lane & 7;
#pragma unroll
    for (int j = 0; j < 4; ++j) { const int n = (lane >> 3) + 8 * j; const LAS float* s = scr + (8 * c) * 33 + n;
        if (P.fp8) { u32x2 o; o.x = pk_fp8x4(s[0 * 33], s[1 * 33], s[2 * 33], s[3 * 33]); o.y = pk_fp8x4(s[4 * 33], s[5 * 33], s[6 * 33], s[7 * 33]); *(u32x2*)(P.dst + (size_t)n * P.ldo + 8 * c) = o; }
        else { u32x4 o; o.x = cvt_pk_bf16(s[0 * 33], s[1 * 33]); o.y = cvt_pk_bf16(s[2 * 33], s[3 * 33]); o.z = cvt_pk_bf16(s[4 * 33], s[5 * 33]); o.w = cvt_pk_bf16(s[6 * 33], s[7 * 33]); *(u32x4*)(P.dst + (size_t)n * P.ldo + 16 * c) = o; } }
    asm volatile("s_waitcnt lgkmcnt(0)" ::: "memory");
}
struct Args { const float* in[34]; float* out; unsigned char* ws; };

__global__ void __launch_bounds__(512, 2) mega_fwd(Args a) {
    extern __shared__ __attribute__((aligned(16))) unsigned char lds_raw[];
    LAS unsigned char* lds = (LAS unsigned char*)lds_raw;
    volatile LAS unsigned* LW = (volatile LAS unsigned*)(lds + LDSCTL_OFF);
    volatile LAS int* LWI = (volatile LAS int*)(lds + LDSCTL_OFF);
    const int G = gridDim.x, bid0 = blockIdx.x; const int wave_s0 = __builtin_amdgcn_readfirstlane(threadIdx.x >> 6);
#define PHASE_IDS() int wv_ = wave_s0, bd_ = bid0; asm volatile("" : "+s"(wv_), "+s"(bd_)); const int wave_s = wv_, bid = bd_;     \
    const int lane = fresh_lane(), wave = wave_s, tid = wave * 64 + lane; const int gw = bid * 8 + wave, NGW = G * 8; \
    const size_t gt = (size_t)bid * 512 + tid, NGT = (size_t)G * 512; (void)lane; (void)wave; (void)gw; (void)NGW; (void)gt; (void)NGT
#define WSB() ({ unsigned char* _w = a.ws; asm volatile("" : "+s"(_w)); _w; })
#define INP(i) ({ int _k = (i); asm volatile("" : "+s"(_k)); a.in[_k]; })
    for (int u = threadIdx.x; u < (LDS_BYTES - LDSCTL_OFF) / 4; u += 512) LW[u] = 0u;
    __syncthreads();
    XcdBarrier bar = xcd_barrier_post((unsigned*)(a.ws + WS_CTL) + CW_BAR, LW + LW_BAR);

    {
        PHASE_IDS(); unsigned char* ws = WSB(); bf16_t* WIN = (bf16_t*)(ws + WS_WIN); bf16_t* WOUT = (bf16_t*)(ws + WS_WOUT); bf16_t* WGU = (bf16_t*)(ws + WS_WGU); bf16_t* WD2 = (bf16_t*)(ws + WS_WD2);
        bf16_t* HB = (bf16_t*)(ws + WS_HB); float* SSQ = (float*)(ws + WS_SSQ);
        LAS float* scr = (LAS float*)(lds + wave * 16384);
        constexpr int I_IN = 16 * 56, I_OUT = 16 * 32, I_GU = 2 * 16 * 256, I_D8 = 16 * 256, I_GLU = 32, I_RG = 24, I_L = I_IN + I_OUT + I_GU + I_D8 + I_GLU + I_RG;
        const float* i_win = INP(2); const float* i_g = INP(1); const float* i_wout = INP(24); const float* i_wg = INP(30); const float* i_wu = INP(31); const float* i_wd = INP(32);
        const float* i_glu = INP(21); const float* i_rg = INP(8); const float* i_ig = INP(10);
#define TR_DECODE(P, it) do { const int l = (it) / I_L; int r = (it) % I_L; P.gk = nullptr; P.fp8 = 0; \
            if (r < I_IN) { const int kb = r / 56, nb = r % 56, j0 = nb * 32; const int sc = j0 < 768 ? j0 : (j0 < 1152 ? j0 + 384 : (j0 < 1536 ? j0 - 384 : j0));     \
                P.src = i_win + (size_t)l * D * INC + (size_t)kb * 64 * INC + sc; P.ldw = INC; P.gk = i_g + (size_t)l * D + kb * 64; P.dst = (unsigned char*)(WIN + (size_t)l * INC * D + (size_t)j0 * D + kb * 64); P.ldo = D * 2; } \
            else if ((r -= I_IN) < I_OUT) { const int kb = r / 32, nb = r % 32; P.src = i_wout + (size_t)l * D * D + (size_t)kb * 64 * D + nb * 32; P.ldw = D; P.dst = (unsigned char*)(WOUT + (size_t)l * D * D + (size_t)nb * 32 * D + kb * 64); P.ldo = D * 2; } \
            else if ((r -= I_OUT) < I_GU) { const int which = r / (16 * 256), e = (r / 256) % 16, q = r % 256, kb = q / 16, nb = q % 16, n0 = nb * 32;     \
                P.src = (which ? i_wu : i_wg) + ((size_t)l * NE + e) * D * DE + (size_t)kb * 64 * DE + n0; P.ldw = DE; P.fp8 = 1; \
                P.dst = (unsigned char*)WGU + ((size_t)l * NE + e) * 1024 * 1024 + (size_t)((n0 / 128) * 256 + which * 128 + (n0 % 128)) * 1024 + kb * 64; P.ldo = 1024; } \
            else if ((r -= I_GU) < I_D8) { const int e = r / 256, q = r % 256, kb = q / 32, nb = q % 32;        \
                P.src = i_wd + ((size_t)l * NE + e) * DE * D + (size_t)kb * 64 * D + nb * 32; P.ldw = D; P.fp8 = 1; P.dst = ws + WS_WD8 + ((size_t)l * NE + e) * 1024 * 512 + (size_t)nb * 32 * 512 + kb * 64; P.ldo = 512; } \
            else if ((r -= I_D8) < I_GLU) { const int kb = r / 8, nb = r % 8; P.src = i_glu + (size_t)l * CW * CW + (size_t)kb * 64 * CW + nb * 32; P.ldw = CW; P.dst = (unsigned char*)((bf16_t*)(ws + WS_WGLU) + (size_t)l * CW * CW + (size_t)nb * 32 * CW + kb * 64); P.ldo = CW * 2; } \
            else { r -= I_GLU; const int gate = r / 12, h = (r / 2) % 6, nb = r & 1; \
                P.src = (gate ? i_ig : i_rg) + ((size_t)l * 6 + h) * 64 * 64 + nb * 32; P.ldw = 64; P.dst = (unsigned char*)((bf16_t*)(ws + WS_WRG) + (((size_t)l * 2 + gate) * 6 + h) * 64 * 64 + (size_t)nb * 32 * 64); P.ldo = 64 * 2; } } while (0)
        { TrP Pa, Pb; float va[32], vb[32]; int it = gw;
          if (it < 2 * I_L) { TR_DECODE(Pa, it); tr_load(Pa, lane, va); }
#pragma unroll 1
          while (it < 2 * I_L) {
              const int it1 = it + NGW; if (it1 < 2 * I_L) { TR_DECODE(Pb, it1); tr_load(Pb, lane, vb); }
              tr_store(Pa, lane, va, scr);
              if (it1 >= 2 * I_L) break;
              const int it2 = it1 + NGW; if (it2 < 2 * I_L) { TR_DECODE(Pa, it2); tr_load(Pa, lane, va); }
              tr_store(Pb, lane, vb, scr);
              it = it2; } }
#undef TR_DECODE
        { const float* s_are = INP(13); const float* s_aim = INP(14); const float* s_ldt = INP(15); const float* s_bre = INP(16); const float* s_bim = INP(17); const float* s_cre = INP(18); const float* s_cim = INP(19); const float* s_d = INP(20);
          for (size_t e = gt; e < (size_t)2 * CG * 256; e += NGT) { const int l = (int)(e / (CG * 256)), g = (int)((e / 256) % CG), c = (int)((e >> 4) & 15), cp = (int)(e & 15);
              s5_kt_pair(g, c, cp, s_are + (size_t)l * CG * CS, s_aim + (size_t)l * CG * CS, s_ldt + (size_t)l * CG, s_bre + (size_t)l * CG * CS * CGD, s_bim + (size_t)l * CG * CS * CGD,
                         s_cre + (size_t)l * CG * CGD * CS, s_cim + (size_t)l * CG * CGD * CS, s_d + (size_t)l * CW, ws + WS_S5 + (size_t)l * S5_L_STRIDE); }
          for (size_t e = gt; e < (size_t)2 * CG * 2048; e += NGT) { const int l = (int)(e / (CG * 2048)), g = (int)((e / 2048) % CG), r = (int)(e & 2047);
              s5_et_task(g, r >> 10, (r >> 4) & 63, r & 15, s_are + (size_t)l * CG * CS, s_aim + (size_t)l * CG * CS, s_ldt + (size_t)l * CG, s_bre + (size_t)l * CG * CS * CGD, s_bim + (size_t)l * CG * CS * CGD, ws + WS_S5 + (size_t)l * S5_L_STRIDE);
              s5_ft_task(g, r >> 7, (r >> 6) & 1, r & 63, s_are + (size_t)l * CG * CS, s_aim + (size_t)l * CG * CS, s_ldt + (size_t)l * CG, s_cre + (size_t)l * CG * CGD * CS, s_cim + (size_t)l * CG * CGD * CS, ws + WS_S5 + (size_t)l * S5_L_STRIDE); }
          for (size_t e = gt; e < (size_t)2 * CG * 64; e += NGT) { const int l = (int)(e / (CG * 64)), g = (int)((e / 64) % CG), el = 4096 + 32768 + (int)(e % 64);
              s5_table_elem(g, el, s_are + (size_t)l * CG * CS, s_aim + (size_t)l * CG * CS, s_ldt + (size_t)l * CG, s_bre + (size_t)l * CG * CS * CGD, s_bim + (size_t)l * CG * CS * CGD,
                            s_cre + (size_t)l * CG * CGD * CS, s_cim + (size_t)l * CG * CGD * CS, s_d + (size_t)l * CW, ws + WS_S5 + (size_t)l * S5_L_STRIDE); } }
        { const float* sw = INP(4); bf16_t* wsp = (bf16_t*)(ws + WS_WSP); for (size_t e = gt; e < (size_t)2 * 6 * 128 * 128; e += NGT) wsp[e] = f2bf(sw[e]); }
        { const float* fg = INP(25); const float* rgw = INP(26); const float* rew = INP(28); bf16_t* wrt = (bf16_t*)(ws + WS_WRT);
          for (size_t e = gt; e < (size_t)2 * 48 * D; e += NGT) { const int l = (int)(e / (48 * D)), n = (int)((e / D) % 48), k = (int)(e % D);
              int j = -1, lo = 0; if (n < 16) j = n; else if (n < 32) { j = n - 16; lo = 1; } else if (n < 36) j = 16 + (n - 32); else if (n < 40) { j = 16 + (n - 36); lo = 1; }
              float v = 0.f;
              if (j >= 0) { const float w = fg[(size_t)l * D + k] * (j < 4 ? rgw[((size_t)l * D + k) * 4 + j] : rew[(((size_t)l * 4 + ((j - 4) >> 2)) * D + k) * 4 + ((j - 4) & 3)]);
                  const float hi = bf2f(f2bf(w)); v = lo ? (w - hi) : w; }
              wrt[e] = f2bf(v); } }
        const float* xin = INP(0);
#pragma unroll 1
        for (int t = gw * 2; t < T; t += NGW * 2) {
            const f32x4* xr = (const f32x4*)(xin + (size_t)t * D) + lane; f32x4 v[2][4]; float s0 = 0.f, s1 = 0.f;
#pragma unroll
            for (int j = 0; j < 4; ++j) { v[0][j] = xr[64 * j]; v[1][j] = xr[256 + 64 * j]; }
#pragma unroll
            for (int j = 0; j < 4; ++j) { s0 += (v[0][j][0] * v[0][j][0] + v[0][j][1] * v[0][j][1]) + (v[0][j][2] * v[0][j][2] + v[0][j][3] * v[0][j][3]); s1 += (v[1][j][0] * v[1][j][0] + v[1][j][1] * v[1][j][1]) + (v[1][j][2] * v[1][j][2] + v[1][j][3] * v[1][j][3]); }
            u32x2* o8 = (u32x2*)(HB + (size_t)t * D) + lane;
#pragma unroll
            for (int j = 0; j < 4; ++j) { u32x2 w; w.x = cvt_pk_bf16(v[0][j][0], v[0][j][1]); w.y = cvt_pk_bf16(v[0][j][2], v[0][j][3]); o8[64 * j] = w; w.x = cvt_pk_bf16(v[1][j][0], v[1][j][1]); w.y = cvt_pk_bf16(v[1][j][2], v[1][j][3]); o8[256 + 64 * j] = w; }
            s0 = wave_sum(s0); s1 = wave_sum(s1);
            if (lane < 32) SSQ[(size_t)t * 16 + lane] = lane == 0 ? s0 : (lane == 16 ? s1 : 0.f);
        }
    }
    xcd_barrier(bar);

    for (int l = 0; l < DEPTH; ++l) {
        { PHASE_IDS(); unsigned char* ws = WSB(); bf16_t* WIN = (bf16_t*)(ws + WS_WIN); bf16_t* HB = (bf16_t*)(ws + WS_HB); float* SSQ = (float*)(ws + WS_SSQ); bf16_t* Z = (bf16_t*)(ws + WS_Z);
          pg8::StaticOrder<T, INC> S; S.init(HB, WIN + (size_t)l * INC * D, G, bid);
          pg8::EpiZ E{Z, SSQ};
          pg8::gemm_phase<pg8::EpiZ, pg8::StaticOrder<T, INC>, true, true>(lds, wave_s, S, E); }
        xcd_barrier(bar);

        {
            PHASE_IDS(); unsigned char* ws = WSB(); const bf16_t* Z = (const bf16_t*)(ws + WS_Z);
            const float* conv_w = INP(6) + (size_t)l * 4 * BW; const float* conv_b = INP(7) + (size_t)l * BW; const float* rg_b = INP(9) + (size_t)l * BW;
            const float* ig_b = INP(11) + (size_t)l * BW; const float* lam = INP(12) + (size_t)l * BW;
            __syncthreads();
            { const bf16_t* WRG = (const bf16_t*)(ws + WS_WRG) + ((size_t)l * 2 + 0) * 6 * 4096; const bf16_t* WIG = (const bf16_t*)(ws + WS_WRG) + ((size_t)l * 2 + 1) * 6 * 4096;
              for (int pr = bid; pr < NU128 / 2; pr += G) { float cp = 0.f;
                  rglru_unit<1>(2 * pr, true, cp, tid, wave, lane, Z, nullptr, WRG, WIG, conv_w, conv_b, rg_b, ig_b, lam, nullptr, (float*)(ws + WS_SUMA), (float*)(ws + WS_SUMH), (float*)(ws + WS_SUMA2), (float*)(ws + WS_SUMH2), (bf16_t*)(ws + WS_HL), (bf16_t*)(ws + WS_PP), lds);
                  rglru_unit<1>(2 * pr + 1, false, cp, tid, wave, lane, Z, nullptr, WRG, WIG, conv_w, conv_b, rg_b, ig_b, lam, nullptr, (float*)(ws + WS_SUMA), (float*)(ws + WS_SUMH), (float*)(ws + WS_SUMA2), (float*)(ws + WS_SUMH2), (bf16_t*)(ws + WS_HL), (bf16_t*)(ws + WS_PP), lds); } }
            for (int pr = bid; pr < NU128 / 2; pr += G) { const unsigned char* tab = ws + WS_S5 + (size_t)l * S5_L_STRIDE;
                s5_pair1(pr, 2 * wave, wave, lane, Z, (bf16_t*)(ws + WS_Y), tab, (float*)(ws + WS_SEND), (float*)(ws + WS_SEND2), (float*)(ws + WS_SE), lds);
                s5_pair1(pr, 2 * wave + 1, wave, lane, Z, (bf16_t*)(ws + WS_Y), tab, (float*)(ws + WS_SEND), (float*)(ws + WS_SEND2), (float*)(ws + WS_SE), lds); }
            __syncthreads();
            { const bf16_t* WSP = (const bf16_t*)(ws + WS_WSP) + (size_t)l * 6 * 128 * 128; const float* a_sb = INP(5) + (size_t)l * 6 * 128; const float* vg = INP(3) + (size_t)l * AW; const float* mo_ga = INP(23) + (size_t)l * D;
              for (int u = bid; u < NU128; u += G) mixa_unit(u, tid, wave, lane, Z, (bf16_t*)(ws + WS_Y), WSP, a_sb, vg, mo_ga, lds); }
        }
        xcd_barrier(bar);

        {
            PHASE_IDS(); unsigned char* ws = WSB(); const bf16_t* Z = (const bf16_t*)(ws + WS_Z); bf16_t* Y = (bf16_t*)(ws + WS_Y);
            const float* a_v_norm_g = INP(3) + (size_t)l * AW; const float* a_sw = INP(4) + (size_t)l * 6 * 128 * 128; const float* a_sb = INP(5) + (size_t)l * 6 * 128;
        }

        { PHASE_IDS(); unsigned char* ws = WSB(); const bf16_t* Z = (const bf16_t*)(ws + WS_Z); bf16_t* Y = (bf16_t*)(ws + WS_Y);
          { const float* mo_gb = INP(23) + (size_t)l * D + AW;
            __syncthreads();
            for (int pr = bid; pr < NU128 / 2; pr += G) rglru_fix_pair(pr, tid, wave, lane, Z, Y, (const bf16_t*)(ws + WS_HL), (const bf16_t*)(ws + WS_PP), (const float*)(ws + WS_SUMA2), (const float*)(ws + WS_SUMH2), mo_gb, lds); }
          { const bf16_t* WGLU = (const bf16_t*)(ws + WS_WGLU) + (size_t)l * CW * CW; const float* glu_b = INP(22) + (size_t)l * CW; const float* mo_gc = INP(23) + (size_t)l * D + AW + BW;
            for (int pr = bid; pr < NU128 / 2; pr += G) { float k0r = 0.f, k0i = 0.f, k1r = 0.f, k1i = 0.f; const unsigned char* tab = ws + WS_S5 + (size_t)l * S5_L_STRIDE;
#pragma unroll 1
                for (int ui = 0; ui < 2; ++ui) { const int u = 2 * pr + ui; __syncthreads();
                    s5_group<2>(u, 2 * wave, ui == 0, k0r, k0i, wave, lane, Z, Y, tab, (float*)(ws + WS_SEND), (float*)(ws + WS_SEND2), (float*)(ws + WS_SE), lds);
                    s5_group<2>(u, 2 * wave + 1, ui == 0, k1r, k1i, wave, lane, Z, Y, tab, (float*)(ws + WS_SEND), (float*)(ws + WS_SEND2), (float*)(ws + WS_SE), lds);
                    __syncthreads(); s5_glu(u, wave, lane, WGLU, glu_b, mo_gc, Y, lds); } } } }
        asm volatile("s_waitcnt vmcnt(0)" ::: "memory"); __syncthreads();
        if (wave_s0 == 0) { __builtin_amdgcn_fence(__ATOMIC_ACQUIRE, "agent"); asm volatile("s_waitcnt vmcnt(0)" ::: "memory"); }
        __syncthreads();

        { PHASE_IDS(); unsigned char* ws = WSB(); bf16_t* WOUT = (bf16_t*)(ws + WS_WOUT); bf16_t* HB = (bf16_t*)(ws + WS_HB); float* SSQ = (float*)(ws + WS_SSQ); bf16_t* Y = (bf16_t*)(ws + WS_Y);
          pg8::PanelOrder<T, 4> S; S.init(Y, WOUT + (size_t)l * D * D, G, bid);
          pg8::EpiRes<false> E{HB, SSQ, nullptr};
          pg8::gemm_phase<pg8::EpiRes<false>, pg8::PanelOrder<T, 4>, true, true>(lds, wave_s, S, E); }
        asm volatile("s_waitcnt vmcnt(0)" ::: "memory"); __syncthreads();
        if (wave_s0 == 0) { __builtin_amdgcn_fence(__ATOMIC_ACQUIRE, "agent"); asm volatile("s_waitcnt vmcnt(0)" ::: "memory"); }
        __syncthreads();

        { PHASE_IDS(); unsigned char* ws = WSB(); const bf16_t* HB = (const bf16_t*)(ws + WS_HB); const float* SSQ = (const float*)(ws + WS_SSQ); int* CLS = (int*)(ws + WS_CLS); float* G2 = (float*)(ws + WS_G2); int* HIST = (int*)(ws + WS_HIST);
          const float* rgb = INP(27) + (size_t)l * 4; const float* reb = INP(29) + (size_t)l * 16;
        if (l == 0) {
            for (int rr = gw; rr < 2 * NCLS * 2 * 1024 / 2; rr += NGW) { const int row = 2 * rr + (lane >> 5), n = row & 1023, half = (row >> 10) & 1, cls = (row >> 11) % NCLS, ll = row / (2048 * NCLS);
                const int g = cls / 6, pi = cls % 6, e = g * 4 + (half ? pair_hi(pi) : pair_lo(pi));
                const u32x4 v = *(const u32x4*)(ws + WS_WD8 + ((size_t)ll * NE + e) * 1024 * 512 + (size_t)n * 512 + (lane & 31) * 16);
                *(u32x4*)(ws + WS_WD2 + ((size_t)ll * NCLS + cls) * 1024 * 1024 + (size_t)n * 1024 + half * 512 + (lane & 31) * 16) = v; } }
        for (int u = bid; u < NU; u += G) {
            router_unit(u, wave, lane, HB, SSQ, (const bf16_t*)(ws + WS_WRT) + (size_t)l * 48 * D, rgb, reb, CLS, G2, lds, (LAS int*)(lds + LDSCTL_OFF) + LW_HIST);
            __syncthreads();
            if (tid < 32) { HIST[u * 32 + tid] = tid < NCLS ? LWI[LW_HIST + tid] : 0; LWI[LW_HIST + tid] = 0; }
            __syncthreads();
        } }
        xcd_barrier(bar);

        { PHASE_IDS(); unsigned char* ws = WSB(); const bf16_t* HB = (const bf16_t*)(ws + WS_HB); const float* SSQ = (const float*)(ws + WS_SSQ); const int* CLS = (const int*)(ws + WS_CLS); const float* G2 = (const float*)(ws + WS_G2); const int* HIST = (const int*)(ws + WS_HIST);
          int* CTOT = (int*)(ws + WS_CTOT); int* ROWTOK = (int*)(ws + WS_ROWTOK); float* ROWG = (float*)(ws + WS_ROWG); bf16_t* HBS = (bf16_t*)(ws + WS_HBS); const float* ffn_g = INP(25) + (size_t)l * D;
        for (int u = bid; u < NU; u += G) {
            { const int c = tid & 31, part = tid >> 5; int tot = 0, pre = 0;
_Pragma("unroll 16")
              for (int k = part * 16; k < part * 16 + 16; ++k) { const int v = HIST[k * 32 + c]; tot += v; pre += k < u ? v : 0; }
              ((volatile LAS int*)lds)[tid] = tot; ((volatile LAS int*)lds)[512 + tid] = pre; }
            __syncthreads();
            if (tid < NCLS) { int tot = 0, pre = 0;
_Pragma("unroll")
                for (int k = 0; k < 16; ++k) { tot += ((volatile LAS int*)lds)[k * 32 + tid]; pre += ((volatile LAS int*)lds)[512 + k * 32 + tid]; } LWI[LW_TOT + tid] = tot; LWI[LW_BASE + tid] = pre; }
            __syncthreads();
            if (tid == 0) { int ps = 0;
_Pragma("unroll 1")
                for (int c = 0; c < NCLS; ++c) { const int tot = LWI[LW_TOT + c]; LWI[LW_BASE + c] += ps; LWI[LW_TST + c] = ps; ps += ((tot + 255) >> 8) << 8; if (bid == 0) CTOT[c] = tot; } LWI[LW_TST + NCLS] = ps; }
            if (tid < UT) LWI[LW_CLS + tid] = CLS[u * UT + tid];
            __syncthreads();
            if (tid < UT) { const int cls = LWI[LW_CLS + tid]; int rank = 0;
_Pragma("unroll 1")
                for (int i = 0; i < tid; ++i) rank += LWI[LW_CLS + i] == cls ? 1 : 0;
                const int dest = LWI[LW_BASE + cls] + rank; LWI[LW_DEST + tid] = dest; const int t = u * UT + tid;
                ROWTOK[dest] = t; ROWG[(size_t)dest * 2 + 0] = G2[(size_t)t * 2 + 0]; ROWG[(size_t)dest * 2 + 1] = G2[(size_t)t * 2 + 1]; }
            __syncthreads();
            { f32x4 gq[4];
#pragma unroll
              for (int j = 0; j < 4; ++j) gq[j] = *(const f32x4*)(ffn_g + lane * 16 + 4 * j);
#pragma unroll 1
              for (int i = 0; i < 32; i += 4) {
                  const int tl0 = wave * 32 + i, t0r = u * UT + tl0;
                  float sq = SSQ[(size_t)t0r * 16 + lane]; sq += x_xor1(sq); sq += x_xor2(sq); sq += x_hmir(sq); sq += x_mir(sq);
                  u32x4 o[4][2]; int dst[4];
#pragma unroll
                  for (int j = 0; j < 4; ++j) { o[j][0] = *(const u32x4*)(HB + (size_t)(t0r + j) * D + lane * 16); o[j][1] = *(const u32x4*)(HB + (size_t)(t0r + j) * D + lane * 16 + 8); dst[j] = LWI[LW_DEST + tl0 + j]; }
#pragma unroll
                  for (int j = 0; j < 4; ++j) { const float r4 = rsqrtf(__builtin_amdgcn_readlane(sq, 16 * j) * (1.0f / D) + EPS) * pg8::FS_H; u32x4 w;
#pragma unroll
                      for (int hh = 0; hh < 2; ++hh) { const u32x4 oo = o[j][hh]; const f32x4 g0 = gq[2 * hh], g1 = gq[2 * hh + 1];
                          const unsigned lo = pk_fp8x4(__uint_as_float(oo.x << 16) * r4 * g0[0], __uint_as_float(oo.x & 0xffff0000u) * r4 * g0[1], __uint_as_float(oo.y << 16) * r4 * g0[2], __uint_as_float(oo.y & 0xffff0000u) * r4 * g0[3]);
                          const unsigned hi = pk_fp8x4(__uint_as_float(oo.z << 16) * r4 * g1[0], __uint_as_float(oo.z & 0xffff0000u) * r4 * g1[1], __uint_as_float(oo.w << 16) * r4 * g1[2], __uint_as_float(oo.w & 0xffff0000u) * r4 * g1[3]);
                          if (hh == 0) { w.x = lo; w.y = hi; } else { w.z = lo; w.w = hi; } }
                      *(u32x4*)((unsigned char*)HBS + (size_t)dst[j] * D + lane * 16) = w; } } }
            if (u == bid)
_Pragma("unroll 1")
            for (int c = bid; c < NCLS; c += G) { const int tot = LWI[LW_TOT + c], r0 = LWI[LW_TST + c] + tot, r1 = LWI[LW_TST + c + 1];
                unsigned zz = 0u; asm volatile("" : "+v"(zz));
                for (int r = r0 + wave; r < r1; r += 8) { if (lane == 0) { ROWTOK[r] = -1; ROWG[(size_t)r * 2] = __uint_as_float(zz); ROWG[(size_t)r * 2 + 1] = __uint_as_float(zz); }
                    *(u32x4*)((unsigned char*)HBS + (size_t)r * D + lane * 16) = (u32x4){zz, zz, zz, zz}; } }
            __syncthreads();
        } }
        xcd_barrier(bar);

        { PHASE_IDS(); unsigned char* ws = WSB(); const int* CTOT = (const int*)(ws + WS_CTOT); bf16_t* HBS = (bf16_t*)(ws + WS_HBS); bf16_t* WGU = (bf16_t*)(ws + WS_WGU); bf16_t* ACT = (bf16_t*)(ws + WS_ACT); const float* ROWG = (const float*)(ws + WS_ROWG);
        if (tid == 0) { int ps = 0;
_Pragma("unroll 1")
            for (int c = 0; c < NCLS; ++c) { LWI[LW_TST + c] = ps; ps += (CTOT[c] + 255) >> 8; } LWI[LW_TST + NCLS] = ps; }
        __syncthreads();
        if (tid < 32) { const int ntile = LWI[LW_TST + NCLS]; const long L = (long)tid * G + bid; int e = -1;
            if (L < (long)ntile * 8) { const int nwg = ntile * 8, qq = nwg / 8, rr = nwg % 8, xcd = (int)(L % 8), off = (int)(L / 8); const int Lr = (xcd < rr ? xcd * (qq + 1) : rr * (qq + 1) + (xcd - rr) * qq) + off;
                const int mt = Lr / 8, pn = Lr % 8; int cls = 0;
_Pragma("unroll 1")
                for (int k = 1; k < NCLS; ++k) cls += (LWI[LW_TST + k] <= mt) ? 1 : 0;
                e = (cls << 24) | (pn << 16) | mt; }
            LWI[LW_UTAB + tid] = e; e = -1;
            if (L < (long)ntile * 4) { const int nwg = ntile * 4, qq = nwg / 8, rr = nwg % 8, xcd = (int)(L % 8), off = (int)(L / 8); const int Lr = (xcd < rr ? xcd * (qq + 1) : rr * (qq + 1) + (xcd - rr) * qq) + off;
                const int mt = Lr / 4, pn = Lr % 4; int cls = 0;
_Pragma("unroll 1")
                for (int k = 1; k < NCLS; ++k) cls += (LWI[LW_TST + k] <= mt) ? 1 : 0;
                e = (cls << 24) | (pn << 16) | mt; }
            LWI[LW_DTAB + tid] = e; }
        __syncthreads();
        { pg8::MoeOrder<8, true, 1024> S{LWI + LW_UTAB, l, (const char*)HBS, (const char*)WGU};
          pg8::EpiUp E{(unsigned char*)ACT, ROWG};
          pg8::gemm_phase<pg8::EpiUp, pg8::MoeOrder<8, true, 1024>, true, true, 512, true>(lds, wave_s, S, E); } }
        xcd_barrier(bar);

        { PHASE_IDS(); unsigned char* ws = WSB(); bf16_t* ACT = (bf16_t*)(ws + WS_ACT); bf16_t* WD2 = (bf16_t*)(ws + WS_WD2); bf16_t* HB = (bf16_t*)(ws + WS_HB); float* SSQ = (float*)(ws + WS_SSQ); const int* ROWTOK = (const int*)(ws + WS_ROWTOK);
          pg8::MoeOrder<4, false, 1024> S{LWI + LW_DTAB, l, (const char*)ACT, (const char*)WD2};
          pg8::EpiRes<true> E{HB, SSQ, ROWTOK};
          pg8::gemm_phase<pg8::EpiRes<true>, pg8::MoeOrder<4, false, 1024>, true, true, 512, true>(lds, wave_s, S, E); }
        xcd_barrier(bar);
    }

    { PHASE_IDS(); unsigned char* ws = WSB(); const bf16_t* HB = (const bf16_t*)(ws + WS_HB); const float* SSQ = (const float*)(ws + WS_SSQ); const float* fg = INP(33); float* outp = a.out;
    { f32x4 gq[4];
#pragma unroll
      for (int j = 0; j < 4; ++j) gq[j] = *(const f32x4*)(fg + lane * 16 + 4 * j);
#pragma unroll 1
      for (int t0r = gw * 4; t0r < T; t0r += NGW * 4) {
          float sq = SSQ[(size_t)t0r * 16 + lane]; sq += x_xor1(sq); sq += x_xor2(sq); sq += x_hmir(sq); sq += x_mir(sq);
          u32x4 o[4][2];
#pragma unroll
          for (int j = 0; j < 4; ++j) { o[j][0] = *(const u32x4*)(HB + (size_t)(t0r + j) * D + lane * 16); o[j][1] = *(const u32x4*)(HB + (size_t)(t0r + j) * D + lane * 16 + 8); }
#pragma unroll
          for (int j = 0; j < 4; ++j) { const float r = rsqrtf(__builtin_amdgcn_readlane(sq, 16 * j) * (1.0f / D) + EPS); float* orow = outp + (size_t)(t0r + j) * D + lane * 16;
#pragma unroll
              for (int hh = 0; hh < 2; ++hh) { const u32x4 oo = o[j][hh]; const f32x4 g0 = gq[2 * hh], g1 = gq[2 * hh + 1]; f32x4 w0, w1;
                  w0[0] = __uint_as_float(oo.x << 16) * r * g0[0]; w0[1] = __uint_as_float(oo.x & 0xffff0000u) * r * g0[1]; w0[2] = __uint_as_float(oo.y << 16) * r * g0[2]; w0[3] = __uint_as_float(oo.y & 0xffff0000u) * r * g0[3];
                  w1[0] = __uint_as_float(oo.z << 16) * r * g1[0]; w1[1] = __uint_as_float(oo.z & 0xffff0000u) * r * g1[1]; w1[2] = __uint_as_float(oo.w << 16) * r * g1[2]; w1[3] = __uint_as_float(oo.w & 0xffff0000u) * r * g1[3];
                  *(f32x4*)(orow + 8 * hh) = w0; *(f32x4*)(orow + 8 * hh + 4) = w1; } } } }
}
}

extern "C" void kernel_launch(void* const* d_in, const int* in_sizes, int n_in, void* d_out, int out_size, void* d_ws, size_t ws_size, hipStream_t stream) {
    static int grid = 0;
    if (grid == 0) {
        if (n_in != 34 || in_sizes[0] != T * D || out_size != T * D || ws_size < WS_END) { fprintf(stderr, "kernel_launch: unexpected shapes (n_in %d, ws %zu)\n", n_in, ws_size); grid = -1; return; }
        int dev = 0, cus = 0, per_cu = 0;
        if (hipGetDevice(&dev) != hipSuccess || hipDeviceGetAttribute(&cus, hipDeviceAttributeMultiprocessorCount, dev) != hipSuccess) { grid = -1; return; }
        if (hipFuncSetAttribute((const void*)mega_fwd, hipFuncAttributeMaxDynamicSharedMemorySize, LDS_BYTES) != hipSuccess) { fprintf(stderr, "kernel_launch: hipFuncSetAttribute failed\n"); grid = -1; return; }
        if (hipOccupancyMaxActiveBlocksPerMultiprocessor(&per_cu, (const void*)mega_fwd, 512, LDS_BYTES) != hipSuccess || per_cu < 1) { fprintf(stderr, "kernel_launch: occupancy query says %d\n", per_cu); }
        (void)hipGetLastError();
        grid = cus;
    }
    if (grid < 0) return;
    (void)hipMemsetAsync((char*)d_ws + WS_CTL, 0, CTL_ZERO_BYTES, stream);
    Args a{};
    for (int i = 0; i < 34; ++i) a.in[i] = (const float*)d_in[i];
    a.out = (float*)d_out; a.ws = (unsigned char*)d_ws;
    hipLaunchKernelGGL(mega_fwd, dim3(grid), dim3(512), LDS_BYTES, stream, a);
}
```

```cpp
#include <hip/hip_runtime.h>
#include <cstdio>
#include <cstdint>

#define LAS __attribute__((address_space(3)))
typedef unsigned short bf16_t;
typedef short bf16x8 __attribute__((ext_vector_type(8)));
typedef float f32x4 __attribute__((ext_vector_type(4)));
typedef float f32x2 __attribute__((ext_vector_type(2)));
typedef unsigned u32x4 __attribute__((ext_vector_type(4)));
typedef unsigned u32x2 __attribute__((ext_vector_type(2)));
typedef int i32x4 __attribute__((ext_vector_type(4)));
typedef int i32x8 __attribute__((ext_vector_type(8)));

constexpr int D = 1024, BATCH = 8, SEQ = 8192, T = BATCH * SEQ, DEPTH = 2;
constexpr int AW = 384, BW = 384, CW = 256, HD = 64, ABLK = 128, CHUNK = 64;
constexpr int INC = 1792;
constexpr int ZU = 0, ZV = 384, ZG = 768, ZX = 1152, ZC = 1536, ZGELU_END = 1152;
constexpr int CG = 16, CGD = 16, CS = 64;
constexpr int NE = 16, DE = 512, NCLS = 24;
constexpr float EPS = 1e-6f;
constexpr int UT = 256;
constexpr int NU = T / UT;
constexpr int MAXROWS = T + NCLS * 256;

constexpr size_t MiB = 1u << 20;
constexpr size_t WS_CTL = 0, CTL_ZERO_BYTES = 1 * MiB;
constexpr size_t WS_WIN = 2 * MiB;
constexpr size_t WS_WOUT = 10 * MiB;
constexpr size_t WS_WGLU = 14 * MiB;
constexpr size_t WS_WRG = 15 * MiB;
constexpr size_t WS_WSP = 15 * MiB + 256 * 1024;
constexpr size_t WS_WRT = 15 * MiB + 768 * 1024;
constexpr size_t WS_WGU = 16 * MiB;
constexpr size_t WS_WD8 = 48 * MiB;
constexpr size_t WS_WD2 = 80 * MiB;
constexpr size_t WS_SSQ = 176 * MiB;
constexpr size_t WS_RS = 180 * MiB;
constexpr size_t WS_CLS = WS_RS + 256 * 1024;
constexpr size_t WS_G2 = WS_CLS + 256 * 1024;
constexpr size_t WS_HIST = 181 * MiB;
constexpr size_t WS_CTOT = WS_HIST + 64 * 1024;
constexpr size_t WS_ROWTOK = WS_HIST + 256 * 1024;
constexpr size_t WS_ROWG = 182 * MiB;
constexpr size_t WS_SUMA = 183 * MiB;
constexpr size_t WS_SUMH = 191 * MiB;
constexpr size_t WS_S5 = 184 * MiB;
constexpr size_t WS_SEND = 187 * MiB;
constexpr size_t WS_HB = 192 * MiB;
constexpr size_t WS_Z = 320 * MiB;
constexpr size_t WS_HBS = WS_Z;
constexpr size_t WS_Y = 544 * MiB;
constexpr size_t WS_ACT = 672 * MiB;
constexpr size_t WS_HL = 672 * MiB;
constexpr size_t WS_PP = 736 * MiB;
constexpr size_t WS_SE = 800 * MiB;
constexpr size_t WS_AV = 672 * MiB;
constexpr size_t WS_BV = 768 * MiB;
constexpr size_t WS_SEND2 = 864 * MiB;
constexpr size_t WS_SUMA2 = 866 * MiB;
constexpr size_t WS_SUMH2 = 867 * MiB;
constexpr size_t WS_END = 868 * MiB;
constexpr int CW_BAR = 4096;

constexpr int RING_BYTES = 131072;
constexpr int LDSCTL_OFF = 143360;
constexpr int LDS_BYTES = 147456;
constexpr int LW_BAR = 8, LW_TST = 64, LW_HIST = 96, LW_TOT = 128, LW_BASE = 160, LW_CLS = 256  , LW_DEST = 512  , LW_UTAB = 768  , LW_DTAB = 800  ;

__device__ __forceinline__ float bf2f(bf16_t v) { return __uint_as_float(((unsigned)v) << 16); }
__device__ __forceinline__ unsigned cvt_pk_bf16(float lo, float hi) { unsigned r; asm volatile("v_cvt_pk_bf16_f32 %0, %1, %2" : "=v"(r) : "v"(lo), "v"(hi)); return r; }
__device__ __forceinline__ bf16_t f2bf(float v) { return (bf16_t)(cvt_pk_bf16(v, 0.f) & 0xffffu); }
__device__ __forceinline__ unsigned pk_fp8x4(float a, float b, float c, float d) {
    a = fminf(fmaxf(a, -448.f), 448.f); b = fminf(fmaxf(b, -448.f), 448.f); c = fminf(fmaxf(c, -448.f), 448.f); d = fminf(fmaxf(d, -448.f), 448.f);
    int r = __builtin_amdgcn_cvt_pk_fp8_f32(a, b, 0, false); r = __builtin_amdgcn_cvt_pk_fp8_f32(c, d, r, true); return (unsigned)r; }
__device__ __forceinline__ int fresh_lane() { unsigned z = 0u; asm volatile("" : "+s"(z)); return (int)__builtin_amdgcn_mbcnt_hi(~0u, __builtin_amdgcn_mbcnt_lo(~0u, z)); }
__device__ __forceinline__ float x_xor1(float v) { return __int_as_float(__builtin_amdgcn_update_dpp(0, __float_as_int(v), 0xB1, 0xf, 0xf, true)); }
__device__ __forceinline__ float x_xor2(float v) { return __int_as_float(__builtin_amdgcn_update_dpp(0, __float_as_int(v), 0x4E, 0xf, 0xf, true)); }
__device__ __forceinline__ float x_hmir(float v) { return __int_as_float(__builtin_amdgcn_update_dpp(0, __float_as_int(v), 0x141, 0xf, 0xf, true)); }
__device__ __forceinline__ float x_mir(float v) { return __int_as_float(__builtin_amdgcn_update_dpp(0, __float_as_int(v), 0x140, 0xf, 0xf, true)); }
__device__ __forceinline__ float x_xor16(float v) { return __int_as_float(__builtin_amdgcn_ds_swizzle(__float_as_int(v), 0x401F)); }
__device__ __forceinline__ float add_xor32(float v) { const auto r = __builtin_amdgcn_permlane32_swap(__float_as_uint(v), __float_as_uint(v), false, false); return __uint_as_float(r[0]) + __uint_as_float(r[1]); }
__device__ __forceinline__ float add_x16_x32(float v) { v += x_xor16(v); return add_xor32(v); }
__device__ __forceinline__ float wave_sum(float v) { v += x_xor1(v); v += x_xor2(v); v += x_hmir(v); v += x_mir(v); v += x_xor16(v); return add_xor32(v); }
__device__ __forceinline__ float gelu_fast(float x) {
    const float u2 = 1.5957691216057308f * (x + 0.044715f * x * x * x);
    const float e = __builtin_amdgcn_exp2f(-1.4426950408889634f * u2);
    return x * __builtin_amdgcn_rcpf(1.0f + e);
}
__device__ __forceinline__ float sigmoid_fast(float x) { return __builtin_amdgcn_rcpf(1.0f + __builtin_amdgcn_exp2f(-1.4426950408889634f * x)); }
__device__ __forceinline__ float sigmoid_f(float x) { return 1.0f / (1.0f + expf(-x)); }
__device__ __forceinline__ int pair_lo(int pi) { return pi < 3 ? 0 : (pi < 5 ? 1 : 2); }
__device__ __forceinline__ int pair_hi(int pi) { return pi < 3 ? pi + 1 : (pi < 5 ? pi - 1 : 3); }
__device__ __forceinline__ int pair_idx(int lo, int hi) { return lo == 0 ? hi - 1 : (lo == 1 ? hi + 1 : 5); }

#define XB_TMO      128
#define XB_XCNT(j)  (256  + 64 * (j))
#define XB_XSUB(j)  (1280 + 64 * (j))
#define XB_XGEN(j)  (2304 + 64 * (j))
#define XB_TOP      3328
#define XB_TOPGEN   3392
#define XCD_BAR_WORDS 3456
#define XB_SPIN_CAP (1u << 18)
__device__ __forceinline__ unsigned xb_ld(unsigned* p)              { return __hip_atomic_load(p, __ATOMIC_RELAXED, __HIP_MEMORY_SCOPE_AGENT); }
__device__ __forceinline__ unsigned xb_add(unsigned* p, unsigned v) { return __hip_atomic_fetch_add(p, v, __ATOMIC_RELAXED, __HIP_MEMORY_SCOPE_AGENT); }
__device__ __forceinline__ unsigned xb_xcc_id() { return (unsigned)__builtin_amdgcn_s_getreg((3 << 11) | 20) & 0xFu; }
#define XB_SPIN(cond, bar) do { unsigned _sp = 0; while (cond) { __builtin_amdgcn_s_sleep(1); \
    if ((++_sp & 255u) == 0u) { if (xb_ld(&(bar)[XB_TMO])) break; if (_sp > XB_SPIN_CAP) { atomicAdd(&(bar)[XB_TMO], 1u); break; } } } } while (0)
struct XcdBarrier { unsigned* bar; unsigned x; volatile LAS unsigned* st; };
__device__ __forceinline__ XcdBarrier xcd_barrier_post(unsigned* bar, volatile LAS unsigned* st) {
    XcdBarrier b; b.bar = bar; b.x = xb_xcc_id(); b.st = st;
    if (threadIdx.x == 0) (void)xb_add(&bar[XB_XCNT(b.x)], 1u);
    return b;
}
__device__ __forceinline__ void xcd_barrier_complete(unsigned* bar, unsigned x, unsigned& nloc, unsigned& nx) {
    const unsigned G = gridDim.x * gridDim.y * gridDim.z;
    unsigned sum, cnt, mine, sp = 0u;
    for (;;) {
        sum = 0u; cnt = 0u; mine = 0u;
#pragma unroll
        for (unsigned j = 0; j < 16; ++j) { const unsigned c = xb_ld(&bar[XB_XCNT(j)]); sum += c; cnt += (c > 0u) ? 1u : 0u; mine = (j == x) ? c : mine; }
        if (sum == G) break;
        __builtin_amdgcn_s_sleep(1);
        if ((++sp & 255u) == 0u) { if (xb_ld(&bar[XB_TMO])) break; if (sp > XB_SPIN_CAP) { atomicAdd(&bar[XB_TMO], 1u); break; } }
    }
    nloc = mine > 0u ? mine : 1u; nx = cnt > 0u ? cnt : 1u;
}
__device__ __forceinline__ void xcd_barrier(const XcdBarrier& b) {
    asm volatile("s_waitcnt vmcnt(0)" ::: "memory");
    __syncthreads();
    if (threadIdx.x == 0) {
        unsigned* bar = b.bar; asm volatile("" : "+s"(bar));
        __builtin_amdgcn_s_waitcnt(0);
        unsigned bx0 = b.x; asm volatile("" : "+s"(bx0));
        unsigned nloc = b.st[0], nx = b.st[1];
        if (nloc == 0u) { xcd_barrier_complete(bar, bx0, nloc, nx); b.st[0] = nloc; b.st[1] = nx; }
        unsigned bx = b.x; asm volatile("" : "+s"(bx));
        const unsigned old = xb_add(&bar[XB_XSUB(bx)], 1u);
        const unsigned gen = old / nloc;
        if (old + 1u == (gen + 1u) * nloc) {
            __builtin_amdgcn_fence(__ATOMIC_RELEASE, "agent");
            asm volatile("s_waitcnt vmcnt(0)" ::: "memory");
            const unsigned og = xb_add(&bar[XB_TOP], 1u);
            const unsigned tg = og / nx;
            if (og + 1u == (tg + 1u) * nx) xb_add(&bar[XB_TOPGEN], 1u);
            else XB_SPIN(xb_ld(&bar[XB_TOPGEN]) == tg, bar);
            __builtin_amdgcn_fence(__ATOMIC_ACQUIRE, "agent");
            xb_add(&bar[XB_XGEN(bx)], 1u);
            asm volatile("s_waitcnt vmcnt(0)" ::: "memory");
        } else {
            XB_SPIN(xb_ld(&bar[XB_XGEN(bx)]) == gen, bar);
            __builtin_amdgcn_fence(__ATOMIC_ACQUIRE, "agent");
            asm volatile("s_waitcnt vmcnt(0)" ::: "memory");
        }
    }
    __syncthreads();
}

namespace pg8 {
#define PG8_LAS __attribute__((address_space(3)))
constexpr int BM = 256, BK = 64, HALF = 128, HTB = HALF * BK * 2, STAGE_BYTES = 8 * HTB, NXCD = 8, WGM = 4;
__host__ __device__ __forceinline__ int lds_byte(int r, int c) { const int st = (r >> 4) * 2 + (c >> 5), rr = r & 15, cc = c & 31, ob = rr * 64 + cc * 2; return st * 1024 + (ob ^ (((ob >> 9) & 1) << 5)); }
__host__ __device__ __forceinline__ void stage_rc(int b, int& R, int& C) { const int st = b / 1024, sb = b % 1024, swz = sb ^ (((sb >> 9) & 1) << 5); R = (st >> 1) * 16 + swz / 64; C = (st & 1) * 32 + (swz % 64) / 2; }
__host__ __device__ __forceinline__ int perm32(int rho) { const int n = rho >> 4, i = rho & 15; return 8 * (i >> 2) + 4 * n + (i & 3); }
struct Unit { int pm, pn; const char* A; const char* B; };

template <int M_, int NN> struct PanelOrder {
    static constexpr int nM = M_ / BM; static constexpr size_t tstep = (size_t)BM * 1024 * 2;
    int G, c; const char* A; const char* Bt;
    __device__ void init(const void* A_, const void* Bt_, int G_, int c_) { G = G_; c = c_; A = (const char*)A_; Bt = (const char*)Bt_; }
    __device__ bool next(int i, Unit& u) const { const int pm = c + (i / NN) * G; if (pm >= nM) return false; u.pm = pm; u.pn = i % NN; u.A = A + (size_t)pm * tstep; u.B = Bt + (size_t)u.pn * tstep; return true; }
    __device__ __forceinline__ void a_ready(const Unit&) const {}
    __device__ __forceinline__ void done(const Unit&) const {}
};
template <int M_, int N_> struct StaticOrder {
    static constexpr int nM = M_ / BM, nN = N_ / BM, nwg = nM * nN; static constexpr size_t tstep = (size_t)BM * 1024 * 2;
    int G, c; const char* A; const char* Bt;
    __device__ void init(const void* A_, const void* Bt_, int G_, int c_) { G = G_; c = c_; A = (const char*)A_; Bt = (const char*)Bt_; }
    __device__ bool next(int i, Unit& u) const {
        const long L = (long)i * G + c; if (L >= nwg) return false;
        int wgid = (int)L; { constexpr int q = nwg / NXCD, r = nwg % NXCD; const int xcd = wgid % NXCD, off = wgid / NXCD; wgid = (xcd < r ? xcd * (q + 1) : r * (q + 1) + (xcd - r) * q) + off; }
        constexpr int nig = WGM * nN; const int gid = wgid / nig, fm = gid * WGM, gsz = (nM - fm) < WGM ? (nM - fm) : WGM;
        u.pm = fm + ((wgid % nig) % gsz); u.pn = (wgid % nig) / gsz; u.A = A + (size_t)u.pm * tstep; u.B = Bt + (size_t)u.pn * tstep; return true;
    }
    __device__ __forceinline__ void a_ready(const Unit&) const {}
    __device__ __forceinline__ void done(const Unit&) const {}
};
template <class Epi, class Sched, bool ALIGN_EPI = false, bool SP2 = false, int KB = 1024, bool FP8 = false>
__device__ __forceinline__ void gemm_phase(PG8_LAS unsigned char* lds, const int wave_s, const Sched& S, const Epi& E) { const int Kdim = 0;
    const int lane = fresh_lane(), wid = wave_s, tid = wid * 64 + lane, wr = wid >> 2, wc = wid & 3, fr = lane & 15, fq = lane >> 4;
    constexpr int K = KB, nt = K / BK; (void)Kdim;
    unsigned voffA, voffB;
    { int R, C; stage_rc(tid * 16, R, C); const int Rb = Epi::PERM ? ((R & ~31) + perm32(R & 31)) : R; voffA = (unsigned)(R * K + C) * 2u; voffB = (unsigned)(Rb * K + C) * 2u; }
    constexpr size_t kstep = (size_t)(BK * 2);
    constexpr size_t hstep = (size_t)HALF * K * 2;
    constexpr size_t tstep = 2 * hstep; (void)tstep;
    const unsigned ldsw = (unsigned)wid * 1024u; const unsigned ldsb = (unsigned)(size_t)lds + ldsw;
    const int aoff = lds_byte(wr * 64 + fr, fq * 8), boff = lds_byte(wc * 32 + fr, fq * 8);
#define PG8_SA(b, h) (((b) * 2 + (h)) * HTB)
#define PG8_SB(b, h) ((4 + (b) * 2 + (h)) * HTB)
#define PG8_STAGE(bufoff, gbase, voff) do { _Pragma("unroll") for (int _i = 0; _i < 2; ++_i) { unsigned _keep; \
        asm volatile("s_mov_b32 %0, m0\n\ts_mov_b32 m0, %3\n\ts_nop 0\n\tglobal_load_lds_dwordx4 %1, %2\n\ts_mov_b32 m0, %0" : "=&s"(_keep) \
            : "v"(voff), "s"((const char*)(gbase) + (size_t)_i * (64 * K * 2)), "s"(ldsb + (unsigned)((bufoff) + _i * 8192)) : "memory"); } } while (0)
#define PG8_LDA(dst, b, h) do { if constexpr (FP8) { _Pragma("unroll") for (int m = 0; m < 4; ++m) { const i32x4 _lo = *(const PG8_LAS i32x4*)(lds + PG8_SA(b, h) + aoff + m * 2048), _hi = *(const PG8_LAS i32x4*)(lds + PG8_SA(b, h) + aoff + m * 2048 + 1024); \
            dst##8[m] = __builtin_shufflevector(_lo, _hi, 0, 1, 2, 3, 4, 5, 6, 7); } } \
        else { _Pragma("unroll") for (int m = 0; m < 4; ++m) _Pragma("unroll") for (int k = 0; k < 2; ++k) dst[m][k] = *(const PG8_LAS bf16x8*)(lds + PG8_SA(b, h) + aoff + m * 2048 + k * 1024); } } while (0)
#define PG8_LDB(dst, b, h) do { if constexpr (FP8) { _Pragma("unroll") for (int n = 0; n < 2; ++n) { const i32x4 _lo = *(const PG8_LAS i32x4*)(lds + PG8_SB(b, h) + boff + n * 2048), _hi = *(const PG8_LAS i32x4*)(lds + PG8_SB(b, h) + boff + n * 2048 + 1024); \
            dst##8[n] = __builtin_shufflevector(_lo, _hi, 0, 1, 2, 3, 4, 5, 6, 7); } } \
        else { _Pragma("unroll") for (int n = 0; n < 2; ++n) _Pragma("unroll") for (int k = 0; k < 2; ++k) dst[n][k] = *(const PG8_LAS bf16x8*)(lds + PG8_SB(b, h) + boff + n * 2048 + k * 1024); } } while (0)
#define PG8_MMA(ai, bj, At, Bt) do { __builtin_amdgcn_s_setprio(1); \
        if constexpr (FP8) { _Pragma("unroll") for (int m = 0; m < 4; ++m) _Pragma("unroll") for (int n = 0; n < 2; ++n) \
            acc[ai][bj][m][n] = __builtin_amdgcn_mfma_scale_f32_16x16x128_f8f6f4(Bt##8[n], At##8[m], acc[ai][bj][m][n], 0, 0, 0, Epi::SCALE_W, 0, Epi::SCALE_A); } \
        else { _Pragma("unroll") for (int m = 0; m < 4; ++m) _Pragma("unroll") for (int n = 0; n < 2; ++n) _Pragma("unroll") for (int k = 0; k < 2; ++k) \
            acc[ai][bj][m][n] = __builtin_amdgcn_mfma_f32_16x16x32_bf16(Bt[n][k], At[m][k], acc[ai][bj][m][n], 0, 0, 0); } \
        __builtin_amdgcn_s_setprio(0); } while (0)
#define PG8_WAIT_V(n) asm volatile("s_waitcnt vmcnt(" #n ")" ::: "memory")
#define PG8_WAIT_L(n) asm volatile("s_waitcnt lgkmcnt(" #n ")" ::: "memory")
#define PG8_BAR __builtin_amdgcn_s_barrier()
#define PG8_SCHED __builtin_amdgcn_sched_barrier(0)
    Unit cur, nxt; int ui = 0;
    if (!S.next(0, cur)) return;
    f32x4 acc[2][2][4][2];
#pragma unroll
    for (int a = 0; a < 2; ++a)
#pragma unroll
        for (int b = 0; b < 2; ++b)
#pragma unroll
            for (int m = 0; m < 4; ++m)
#pragma unroll
                for (int n = 0; n < 2; ++n) acc[a][b][m][n] = (f32x4){0.f, 0.f, 0.f, 0.f};
    bf16x8 At[4][2], B0[2][2], B1[2][2]; i32x8 At8[4], B08[2], B18[2]; (void)At; (void)B0; (void)B1; (void)At8; (void)B08; (void)B18;
    const char* cA = cur.A; const char* cB = cur.B;
    S.a_ready(cur);
    if constexpr (SP2) {
        PG8_STAGE(PG8_SB(0, 0), cB, voffB); PG8_STAGE(PG8_SB(0, 1), cB + hstep, voffB); PG8_STAGE(PG8_SA(0, 0), cA, voffA); PG8_STAGE(PG8_SA(0, 1), cA + hstep, voffA);
        if (wr == 1) PG8_BAR;
        PG8_WAIT_V(2); PG8_BAR;
        PG8_STAGE(PG8_SB(1, 0), cB + kstep, voffB); PG8_STAGE(PG8_SA(1, 0), cA + kstep, voffA); PG8_STAGE(PG8_SB(1, 1), cB + hstep + kstep, voffB);
        PG8_WAIT_V(6); PG8_BAR;
    } else {
        PG8_STAGE(PG8_SB(0, 0), cB, voffB); PG8_STAGE(PG8_SA(0, 0), cA, voffA); PG8_STAGE(PG8_SB(0, 1), cB + hstep, voffB); PG8_STAGE(PG8_SA(0, 1), cA + hstep, voffA);
        if (wr == 1) PG8_BAR;
        PG8_WAIT_V(4); PG8_BAR;
        PG8_STAGE(PG8_SB(1, 0), cB + kstep, voffB); PG8_STAGE(PG8_SA(1, 0), cA + kstep, voffA); PG8_STAGE(PG8_SB(1, 1), cB + hstep + kstep, voffB);
        PG8_WAIT_V(6); PG8_BAR;
    }
    for (;;) {
        const bool has_next = S.next(ui + 1, nxt);
        const char* nA = has_next ? nxt.A : cA; const char* nB = has_next ? nxt.B : cB;
_Pragma("unroll 1")
        for (int t = 0; t < nt; t += 2) {
            const bool last = (t == nt - 2);
            const char* a1 = cA + (size_t)(t + 1) * kstep;
            const char* a2 = last ? nA : cA + (size_t)(t + 2) * kstep; const char* b2 = last ? nB : cB + (size_t)(t + 2) * kstep;
            const char* a3 = a2 + kstep; const char* b3 = b2 + kstep;
            if (last && has_next) S.a_ready(nxt);
            if constexpr (SP2) {
            PG8_LDB(B0, 0, 0); PG8_LDB(B1, 0, 1); PG8_SCHED; PG8_LDA(At, 0, 0); PG8_STAGE(PG8_SA(1, 1), a1 + hstep, voffA);
            PG8_WAIT_V(8); PG8_WAIT_L(0); PG8_BAR; PG8_MMA(0, 0, At, B0); PG8_MMA(0, 1, At, B1); PG8_BAR; PG8_SCHED;
            PG8_LDA(At, 0, 1); PG8_STAGE(PG8_SB(0, 0), b2, voffB); PG8_STAGE(PG8_SB(0, 1), b2 + hstep, voffB); PG8_STAGE(PG8_SA(0, 0), a2, voffA);
            PG8_WAIT_V(8); PG8_WAIT_L(0); PG8_BAR; PG8_MMA(1, 0, At, B0); PG8_MMA(1, 1, At, B1); PG8_BAR; PG8_SCHED;
            PG8_LDB(B0, 1, 0); PG8_LDB(B1, 1, 1); PG8_SCHED; PG8_LDA(At, 1, 0); PG8_STAGE(PG8_SA(0, 1), a2 + hstep, voffA);
            PG8_WAIT_V(8); PG8_WAIT_L(0); PG8_BAR; PG8_MMA(0, 0, At, B0); PG8_MMA(0, 1, At, B1); PG8_BAR; PG8_SCHED;
            PG8_LDA(At, 1, 1); PG8_STAGE(PG8_SB(1, 0), b3, voffB); PG8_STAGE(PG8_SB(1, 1), b3 + hstep, voffB); PG8_STAGE(PG8_SA(1, 0), a3, voffA);
            PG8_WAIT_V(8); PG8_WAIT_L(0); PG8_BAR; PG8_MMA(1, 0, At, B0); PG8_MMA(1, 1, At, B1); PG8_BAR; PG8_SCHED;
            } else {
            PG8_LDB(B0, 0, 0); PG8_SCHED; PG8_LDA(At, 0, 0); PG8_STAGE(PG8_SA(1, 1), a1 + hstep, voffA);
            PG8_WAIT_L(8); PG8_BAR; PG8_WAIT_L(0); PG8_MMA(0, 0, At, B0); PG8_BAR; PG8_SCHED;
            PG8_LDB(B1, 0, 1); PG8_STAGE(PG8_SB(0, 0), b2, voffB);
            PG8_BAR; PG8_WAIT_L(0); PG8_MMA(0, 1, At, B1); PG8_BAR;
            PG8_LDA(At, 0, 1); PG8_STAGE(PG8_SA(0, 0), a2, voffA);
            PG8_BAR; PG8_WAIT_L(0); PG8_MMA(1, 0, At, B0); PG8_BAR; PG8_SCHED;
            PG8_STAGE(PG8_SB(0, 1), b2 + hstep, voffB);
            PG8_WAIT_V(6); PG8_BAR; PG8_MMA(1, 1, At, B1); PG8_BAR;
            PG8_LDB(B0, 1, 0); PG8_SCHED; PG8_LDA(At, 1, 0); PG8_STAGE(PG8_SA(0, 1), a2 + hstep, voffA);
            PG8_WAIT_L(8); PG8_BAR; PG8_WAIT_L(0); PG8_MMA(0, 0, At, B0); PG8_BAR; PG8_SCHED;
            PG8_LDB(B1, 1, 1); PG8_STAGE(PG8_SB(1, 0), b3, voffB);
            PG8_BAR; PG8_WAIT_L(0); PG8_MMA(0, 1, At, B1); PG8_BAR;
            PG8_LDA(At, 1, 1); PG8_STAGE(PG8_SA(1, 0), a3, voffA);
            PG8_BAR; PG8_WAIT_L(0); PG8_MMA(1, 0, At, B0); PG8_BAR; PG8_SCHED;
            PG8_STAGE(PG8_SB(1, 1), b3 + hstep, voffB);
            PG8_WAIT_V(6); PG8_BAR; PG8_MMA(1, 1, At, B1); PG8_BAR;
            }
        }
        if constexpr (ALIGN_EPI) { if (wr == 0) PG8_BAR; }
        if constexpr (!Epi::AFTER_DRAIN) { E(acc, cur, wr, wc, fr, fq); S.done(cur); }
        if (!has_next) break;
#pragma unroll
        for (int a = 0; a < 2; ++a)
#pragma unroll
            for (int b = 0; b < 2; ++b)
#pragma unroll
                for (int m = 0; m < 4; ++m)
#pragma unroll
                    for (int n = 0; n < 2; ++n) acc[a][b][m][n] = (f32x4){0.f, 0.f, 0.f, 0.f};
        cur = nxt; cA = nA; cB = nB; ++ui;
        if constexpr (ALIGN_EPI) { if (wr == 1) PG8_BAR; }
    }
    PG8_WAIT_V(0);
    if constexpr (!ALIGN_EPI) { if (wr == 0) PG8_BAR; }
    PG8_BAR;
    if constexpr (Epi::AFTER_DRAIN) { E.fused(acc, cur, wr, wc, fr, fq, lds, wid, lane); S.done(cur); }
#undef PG8_SA
#undef PG8_SB
#undef PG8_STAGE
#undef PG8_LDA
#undef PG8_LDB
#undef PG8_MMA
#undef PG8_WAIT_V
#undef PG8_WAIT_L
#undef PG8_BAR
#undef PG8_SCHED
}

template <int NP, bool UP, int ROWB> struct MoeOrder {
    const volatile LAS int* tab; int layer; const char* A; const char* W;
    __device__ bool next(int i, Unit& u) const {
        const int e = tab[i]; if (e < 0) return false;
        const int mt = e & 0xffff, pn = (e >> 16) & 0xff, cls = e >> 24;
        u.pm = mt; u.pn = pn; u.A = A + (size_t)mt * ((size_t)BM * ROWB);
        if (UP) { const int g = cls / 6, pi = cls % 6, s = pn >> 2, ex = g * 4 + (s ? pair_hi(pi) : pair_lo(pi));
            u.B = W + ((size_t)(layer * NE + ex) * 1024 + (size_t)(pn & 3) * 256) * ROWB; }
        else u.B = W + ((size_t)(layer * NCLS + cls) * 1024 + (size_t)pn * 256) * ROWB;
        return true;
    }
    __device__ __forceinline__ void a_ready(const Unit&) const {}
    __device__ __forceinline__ void done(const Unit&) const {}
};

struct EpiZ {
    static constexpr bool PERM = true, AFTER_DRAIN = false;
    bf16_t* Z; const float* ssq;
    __device__ __forceinline__ void operator()(const f32x4 (&acc)[2][2][4][2], const Unit& u, int wr, int wc, int fr, int fq) const {
        { const int ln_ = fresh_lane(); fr = ln_ & 15; fq = ln_ >> 4; }
        const int row0 = u.pm * BM + wr * 64 + fr, col0 = u.pn * BM + wc * 32 + 8 * fq;
        float rr[2][4];
#pragma unroll
        for (int ai = 0; ai < 2; ++ai) {
            f32x4 sp[4];
#pragma unroll
            for (int m = 0; m < 4; ++m) sp[m] = *(const f32x4*)(ssq + (size_t)(row0 + ai * HALF + m * 16) * 16 + 4 * fq);
#pragma unroll
            for (int m = 0; m < 4; ++m) { float t = (sp[m][0] + sp[m][1]) + (sp[m][2] + sp[m][3]); t = add_x16_x32(t); rr[ai][m] = __builtin_amdgcn_rsqf(t * (1.0f / D) + EPS); }
        }
#pragma unroll
        for (int ai = 0; ai < 2; ++ai)
#pragma unroll
            for (int m = 0; m < 4; ++m) { const int row = row0 + ai * HALF + m * 16; const float r = rr[ai][m];
                bf16_t* rowp = Z + (size_t)row * INC + col0;
#pragma unroll
                for (int bj = 0; bj < 2; ++bj) { f32x4 v0 = acc[ai][bj][m][0] * r, v1 = acc[ai][bj][m][1] * r;
                    u32x4 w; w.x = cvt_pk_bf16(v0[0], v0[1]); w.y = cvt_pk_bf16(v0[2], v0[3]); w.z = cvt_pk_bf16(v1[0], v1[1]); w.w = cvt_pk_bf16(v1[2], v1[3]);
                    *(u32x4*)(rowp + bj * HALF) = w; } }
    }
};
template <bool SCATTER> struct EpiRes {
    static constexpr bool PERM = true, AFTER_DRAIN = false; static constexpr int SCALE_W = 0x7b7b7b7b, SCALE_A = 0x7b7b7b7b;
    bf16_t* H; float* ssq; const int* rowtok;
    __device__ __forceinline__ void operator()(const f32x4 (&acc)[2][2][4][2], const Unit& u, int wr, int wc, int fr, int fq) const {
        { const int ln_ = fresh_lane(); fr = ln_ & 15; fq = ln_ >> 4; }
        const int row0 = u.pm * BM + wr * 64 + fr, col0 = u.pn * BM + wc * 32 + 8 * fq;
        int tokv[2][4];
#pragma unroll
        for (int ai = 0; ai < 2; ++ai)
#pragma unroll
            for (int m = 0; m < 4; ++m) { const int row = row0 + ai * HALF + m * 16; tokv[ai][m] = SCATTER ? rowtok[row] : row; }
#pragma unroll
        for (int ai = 0; ai < 2; ++ai) {
            u32x4 o[4][2];
#pragma unroll
            for (int m = 0; m < 4; ++m) { const int tok = tokv[ai][m]; const bf16_t* rowp = H + (size_t)(tok < 0 ? 0 : tok) * D + col0; o[m][0] = *(const u32x4*)(rowp); o[m][1] = *(const u32x4*)(rowp + HALF); }
#pragma unroll
            for (int m = 0; m < 4; ++m) { const int tok = tokv[ai][m]; float s = 0.f; bf16_t* rowp = H + (size_t)(tok < 0 ? 0 : tok) * D + col0;
#pragma unroll
                for (int bj = 0; bj < 2; ++bj) { const u32x4 oo = o[m][bj];
                    f32x4 v0 = acc[ai][bj][m][0], v1 = acc[ai][bj][m][1];
                    v0[0] += __uint_as_float(oo.x << 16); v0[1] += __uint_as_float(oo.x & 0xffff0000u); v0[2] += __uint_as_float(oo.y << 16); v0[3] += __uint_as_float(oo.y & 0xffff0000u);
                    v1[0] += __uint_as_float(oo.z << 16); v1[1] += __uint_as_float(oo.z & 0xffff0000u); v1[2] += __uint_as_float(oo.w << 16); v1[3] += __uint_as_float(oo.w & 0xffff0000u);
                    s += (v0[0] * v0[0] + v0[1] * v0[1]) + (v0[2] * v0[2] + v0[3] * v0[3]) + (v1[0] * v1[0] + v1[1] * v1[1]) + (v1[2] * v1[2] + v1[3] * v1[3]);
                    u32x4 w; w.x = cvt_pk_bf16(v0[0], v0[1]); w.y = cvt_pk_bf16(v0[2], v0[3]); w.z = cvt_pk_bf16(v1[0], v1[1]); w.w = cvt_pk_bf16(v1[2], v1[3]);
                    if (tok >= 0) *(u32x4*)(rowp + bj * HALF) = w; }
                s = add_x16_x32(s);
                if (fq == 0 && tok >= 0) ssq[(size_t)tok * 16 + u.pn * 4 + wc] = s; }
            asm volatile("" ::: "memory"); }
    }
};
constexpr int SC_W = 0x7b7b7b7b, SC_H = 0x7b7b7b7b, SC_ACT = 0x7b7b7b7b;
constexpr float FS_W = 16.f, FS_H = 16.f, FS_ACT = 16.f;
struct EpiUp {
    static constexpr bool PERM = true, AFTER_DRAIN = false; static constexpr int SCALE_W = SC_W, SCALE_A = SC_H;
    unsigned char* ACT; const float* rowg;
    __device__ __forceinline__ void operator()(const f32x4 (&acc)[2][2][4][2], const Unit& u, int wr, int wc, int fr, int fq) const {
        { const int ln_ = fresh_lane(); fr = ln_ & 15; fq = ln_ >> 4; }
        const int row0 = u.pm * BM + wr * 64 + fr, s = u.pn >> 2, col0 = s * 512 + (u.pn & 3) * 128 + wc * 32 + 8 * fq;
        float gt[2][4];
#pragma unroll
        for (int ai = 0; ai < 2; ++ai)
#pragma unroll
            for (int m = 0; m < 4; ++m) gt[ai][m] = rowg[(size_t)(row0 + ai * HALF + m * 16) * 2 + s];
#pragma unroll
        for (int ai = 0; ai < 2; ++ai)
#pragma unroll
            for (int m = 0; m < 4; ++m) { const int row = row0 + ai * HALF + m * 16; const float g1 = gt[ai][m];
                float o[8];
#pragma unroll
                for (int n = 0; n < 2; ++n)
#pragma unroll
                    for (int j = 0; j < 4; ++j) { const float g = acc[ai][0][m][n][j], up = acc[ai][1][m][n][j]; o[n * 4 + j] = g * sigmoid_fast(g) * up * g1; }
                u32x2 w; w.x = pk_fp8x4(o[0] * FS_ACT, o[1] * FS_ACT, o[2] * FS_ACT, o[3] * FS_ACT); w.y = pk_fp8x4(o[4] * FS_ACT, o[5] * FS_ACT, o[6] * FS_ACT, o[7] * FS_ACT);
                *(u32x2*)(ACT + (size_t)row * 1024 + col0) = w; }
    }
};
}

__device__ __forceinline__ void tr_item(const float* W, int ldw, int k0, int scol0, const float* gk, bf16_t* WT, int ldo, int drow0, int dk0, LAS float* scr, int lane) {
#pragma unroll 8
    for (int i = 0; i < 32; ++i) { const int kk = 2 * i + (lane >> 5); float v = W[(size_t)(k0 + kk) * ldw + scol0 + (lane & 31)]; if (gk) v *= gk[k0 + kk]; scr[kk * 33 + (lane & 31)] = v; }
    asm volatile("s_waitcnt lgkmcnt(0)" ::: "memory");
    const int c = lane & 7;
#pragma unroll
    for (int j = 0; j < 4; ++j) { const int n = (lane >> 3) + 8 * j; const LAS float* s = scr + (8 * c) * 33 + n;
        u32x4 o; o.x = cvt_pk_bf16(s[0 * 33], s[1 * 33]); o.y = cvt_pk_bf16(s[2 * 33], s[3 * 33]); o.z = cvt_pk_bf16(s[4 * 33], s[5 * 33]); o.w = cvt_pk_bf16(s[6 * 33], s[7 * 33]);
        *(u32x4*)(WT + (size_t)(drow0 + n) * ldo + dk0 + 8 * c) = o; }
    asm volatile("s_waitcnt lgkmcnt(0)" ::: "memory");
}

constexpr size_t S5_L_STRIDE = 1310720, S5_KT = 0, S5_ET = 131072, S5_FT = 655360, S5_LAMP = 1179648;
constexpr int S5_WSCR = 8192, S5_YST = 65536, YST_LD = 264;
constexpr int NU128 = T / 128, UPB128 = SEQ / 128;
__device__ __forceinline__ f32x4 mfma16(bf16x8 a, bf16x8 b, f32x4 c) { return __builtin_amdgcn_mfma_f32_16x16x32_bf16(a, b, c, 0, 0, 0); }

__device__ __forceinline__ void s5_kt_pair(int g, int c, int cp, const float* a_re, const float* a_im, const float* log_dt, const float* b_re, const float* b_im,
                                           const float* c_re, const float* c_im, const float* dvec, unsigned char* tab) {
    const float dt = __expf(log_dt[g]); float km[8];
#pragma unroll
    for (int d = 0; d < 8; ++d) km[d] = 0.f;
#pragma unroll 2
    for (int p = 0; p < CS; ++p) { const float lr = a_re[g * CS + p], li = a_im[g * CS + p], zr = lr * dt, zi = li * dt;
        const float sh = __sinf(0.5f * zi), cz = __cosf(zi), sz = __sinf(zi), ez = __expf(zr); const float nr = expm1f(zr) * cz - 2.0f * sh * sh, ni = ez * sz, den = lr * lr + li * li;
        const float cr = (nr * lr + ni * li) / den, ci = (ni * lr - nr * li) / den;
        const float br = b_re[((size_t)g * CS + p) * CGD + cp], bi = b_im[((size_t)g * CS + p) * CGD + cp]; const float bbr = cr * br - ci * bi, bbi = cr * bi + ci * br;
        const float cre = c_re[((size_t)g * CGD + c) * CS + p], cim = c_im[((size_t)g * CGD + c) * CS + p];
        float vr = cre * bbr - cim * bbi, vi = cre * bbi + cim * bbr;
        const float lbr = ez * cz, lbi = ez * sz;
#pragma unroll
        for (int d = 0; d < 8; ++d) { km[d] += vr; const float t = vr * lbr - vi * lbi; vi = vr * lbi + vi * lbr; vr = t; } }
    if (c == cp) km[0] += dvec[g * CGD + c];
    bf16_t* kt = (bf16_t*)(tab + S5_KT) + (size_t)g * 4096;
#pragma unroll
    for (int dd = 0; dd < 8; ++dd) { kt[(dd * 16 + c) * 32 + cp] = f2bf(km[dd]); kt[(dd * 16 + c) * 32 + 16 + cp] = dd >= 1 ? f2bf(km[dd - 1]) : (bf16_t)0; }
}
__device__ __forceinline__ void s5_et_task(int g, int ri, int p, int cp, const float* a_re, const float* a_im, const float* log_dt, const float* b_re, const float* b_im, unsigned char* tab) {
    const float dt = __expf(log_dt[g]); const float lr = a_re[g * CS + p], li = a_im[g * CS + p], zr = lr * dt, zi = li * dt;
    const float sh = __sinf(0.5f * zi), cz = __cosf(zi), sz = __sinf(zi), ez = __expf(zr); const float nr = expm1f(zr) * cz - 2.0f * sh * sh, ni = ez * sz, den = lr * lr + li * li;
    const float cr = (nr * lr + ni * li) / den, ci = (ni * lr - nr * li) / den;
    const float br = b_re[((size_t)g * CS + p) * CGD + cp], bi = b_im[((size_t)g * CS + p) * CGD + cp]; float vr = cr * br - ci * bi, vi = cr * bi + ci * br;
    const float lbr = ez * cz, lbi = ez * sz; bf16_t* et = (bf16_t*)(tab + S5_ET) + (size_t)g * 16384 + (size_t)(ri * 64 + p) * 128 + cp;
#pragma unroll
    for (int sp = 7; sp >= 0; --sp) { et[sp * 16] = f2bf(ri ? vi : vr); const float t = vr * lbr - vi * lbi; vi = vr * lbi + vi * lbr; vr = t; }
}
__device__ __forceinline__ void s5_ft_task(int g, int c, int ri, int p, const float* a_re, const float* a_im, const float* log_dt, const float* c_re, const float* c_im, unsigned char* tab) {
    const float dt = __expf(log_dt[g]); const float lr = a_re[g * CS + p], li = a_im[g * CS + p], zr = lr * dt, zi = li * dt; const float ez = __expf(zr), lbr = ez * __cosf(zi), lbi = ez * __sinf(zi);
    const float cre = c_re[((size_t)g * CGD + c) * CS + p], cim = c_im[((size_t)g * CGD + c) * CS + p]; float vr = cre * lbr - cim * lbi, vi = cre * lbi + cim * lbr;
    bf16_t* ft = (bf16_t*)(tab + S5_FT) + (size_t)g * 16384 + (size_t)c * 128 + ri * 64 + p;
#pragma unroll
    for (int tp = 0; tp < 8; ++tp) { ft[(size_t)tp * 16 * 128] = f2bf(ri ? -vi : vr); const float t = vr * lbr - vi * lbi; vi = vr * lbi + vi * lbr; vr = t; }
}
__device__ __forceinline__ void s5_table_elem(int g, int e, const float* a_re, const float* a_im, const float* log_dt, const float* b_re, const float* b_im,
                                              const float* c_re, const float* c_im, const float* dvec, unsigned char* tab) {
    const float dt = __expf(log_dt[g]);
    if (e < 4096) {
        const int dd = e >> 9, c = (e >> 5) & 15, ee = (e >> 4) & 1, cp = e & 15, d = dd - ee; float s = 0.f;
        if (d >= 0) {
            for (int p = 0; p < CS; ++p) { const float lr = a_re[g * CS + p], li = a_im[g * CS + p], zr = lr * dt, zi = li * dt;
                const float sh = __sinf(0.5f * zi); const float nr = expm1f(zr) * __cosf(zi) - 2.0f * sh * sh, ni = __expf(zr) * __sinf(zi), den = lr * lr + li * li;
                const float cr = (nr * lr + ni * li) / den, ci = (ni * lr - nr * li) / den;
                const float br = b_re[((size_t)g * CS + p) * CGD + cp], bi = b_im[((size_t)g * CS + p) * CGD + cp]; const float bbr = cr * br - ci * bi, bbi = cr * bi + ci * br;
                const float mag = __expf(zr * (float)d), pr = mag * __cosf(zi * (float)d), pi = mag * __sinf(zi * (float)d);
                const float vr = pr * bbr - pi * bbi, vi = pr * bbi + pi * bbr;
                s += c_re[((size_t)g * CGD + c) * CS + p] * vr - c_im[((size_t)g * CGD + c) * CS + p] * vi; }
            if (d == 0 && c == cp) s += dvec[g * CGD + c];
        }
        ((bf16_t*)(tab + S5_KT))[(size_t)g * 4096 + e] = f2bf(s); return;
    }
    e -= 4096;
    if (e < 16384) {
        const int n = e >> 7, k = e & 127, ri = n >> 6, p = n & 63, sp = k >> 4, cp = k & 15;
        const float lr = a_re[g * CS + p], li = a_im[g * CS + p], zr = lr * dt, zi = li * dt;
        const float sh = __sinf(0.5f * zi); const float nr = expm1f(zr) * __cosf(zi) - 2.0f * sh * sh, ni = __expf(zr) * __sinf(zi), den = lr * lr + li * li;
        const float cr = (nr * lr + ni * li) / den, ci = (ni * lr - nr * li) / den;
        const float br = b_re[((size_t)g * CS + p) * CGD + cp], bi = b_im[((size_t)g * CS + p) * CGD + cp]; const float bbr = cr * br - ci * bi, bbi = cr * bi + ci * br;
        const float d = (float)(7 - sp); const float mag = __expf(zr * d), pr = mag * __cosf(zi * d), pi = mag * __sinf(zi * d);
        ((bf16_t*)(tab + S5_ET))[(size_t)g * 16384 + e] = f2bf(ri ? (pr * bbi + pi * bbr) : (pr * bbr - pi * bbi)); return;
    }
    e -= 16384;
    if (e < 16384) {
        const int n = e >> 7, k = e & 127, tp = n >> 4, c = n & 15, ri = k >> 6, p = k & 63;
        const float lr = a_re[g * CS + p], li = a_im[g * CS + p], zr = lr * dt, zi = li * dt;
        const float d = (float)(tp + 1); const float mag = __expf(zr * d), pr = mag * __cosf(zi * d), pi = mag * __sinf(zi * d);
        const float cre = c_re[((size_t)g * CGD + c) * CS + p], cim = c_im[((size_t)g * CGD + c) * CS + p];
        ((bf16_t*)(tab + S5_FT))[(size_t)g * 16384 + e] = f2bf(ri ? -(cre * pi + cim * pr) : (cre * pr - cim * pi)); return;
    }
    e -= 16384;
    { const int p = e; const float lr = a_re[g * CS + p], li = a_im[g * CS + p], zr = lr * dt, zi = li * dt; float* o = (float*)(tab + S5_LAMP) + ((size_t)g * CS + p) * 8;
      float mag = expf(zr); o[0] = mag * cosf(zi); o[1] = mag * sinf(zi);
      mag = expf(zr * 8.f); o[2] = mag * cosf(zi * 8.f); o[3] = mag * sinf(zi * 8.f);
      mag = expf(zr * 128.f); o[4] = mag * cosf(zi * 128.f); o[5] = mag * sinf(zi * 128.f); o[6] = 0.f; o[7] = 0.f; }
}

template <class TT> __device__ __forceinline__ TT ldg(const void* ubase, unsigned voff) { return *(const TT*)((const char*)ubase + voff); }
template <int PASS>
__device__ __forceinline__ void s5_group(int unit, int g, bool first, float& kr, float& ki, int wave, int lane, const bf16_t* Z, bf16_t* Y, const unsigned char* tab, float* SEND, float* SEND2, float* SE, LAS unsigned char* lds) {
    const int ln = lane & 15, q = lane >> 4; const int t0 = unit * 128;
    const char* KTg = (const char*)(tab + S5_KT) + (size_t)g * 8192; const char* ETg = (const char*)(tab + S5_ET) + (size_t)g * 32768; const char* FTg = (const char*)(tab + S5_FT) + (size_t)g * 32768;
    const float* LAMPg = (const float*)(tab + S5_LAMP) + (size_t)g * CS * 8;
    const unsigned vo128 = (unsigned)(ln * 128 + 8 * q) * 2u;
    const unsigned vo32 = (unsigned)(ln * 32 + 8 * q) * 2u;
    LAS float* Sb = (LAS float*)(lds + wave * S5_WSCR); LAS bf16_t* Tb = (LAS bf16_t*)(lds + wave * S5_WSCR); LAS bf16_t* yst = (LAS bf16_t*)(lds + S5_YST);
    char* seb = (char*)(SE + ((size_t)unit * CG + g) * 16 * 128); const unsigned vl = (unsigned)lane * 4u;
    char* ylb = (char*)(Y + (size_t)t0 * D + AW + BW + g * 16); const unsigned vy = (unsigned)((ln * 8) * D + 4 * q) * 2u;
    const float lur = LAMPg[lane * 8 + 4], lui = LAMPg[lane * 8 + 5], l8r = LAMPg[lane * 8 + 2], l8i = LAMPg[lane * 8 + 3];
    float cr = 0.f, ci = 0.f;
    if (PASS == 1) {
        if (!first) { cr = kr; ci = ki; }
        bf16x8 X0, X1, X2, X3;
        { const char* zb = (const char*)(Z + (size_t)t0 * INC + ZC + g * 16); const unsigned vz = (unsigned)((ln * 8 + (q >> 1)) * INC + 8 * (q & 1)) * 2u;
          X0 = ldg<bf16x8>(zb, vz); X1 = ldg<bf16x8>(zb + 2 * INC * 2, vz); X2 = ldg<bf16x8>(zb + 4 * INC * 2, vz); X3 = ldg<bf16x8>(zb + 6 * INC * 2, vz); }
        { LAS float* sw = Sb + (4 * q) * 128 + ln; const char* eb = ETg;
#pragma unroll 1
          for (int jh = 0; jh < 2; ++jh) { bf16x8 ef[4][4];
#pragma unroll
            for (int j = 0; j < 4; ++j)
#pragma unroll
              for (int ks = 0; ks < 4; ++ks) ef[j][ks] = ldg<bf16x8>(eb + j * 4096 + ks * 64, vo128);
#pragma unroll
            for (int j = 0; j < 4; ++j) { f32x4 se = (f32x4){0.f, 0.f, 0.f, 0.f};
              se = mfma16(X0, ef[j][0], se); se = mfma16(X1, ef[j][1], se); se = mfma16(X2, ef[j][2], se); se = mfma16(X3, ef[j][3], se);
              LAS float* s2 = sw + 16 * j; s2[0] = se[0]; s2[128] = se[1]; s2[256] = se[2]; s2[384] = se[3]; }
            eb += 16384; sw += 64; } }
        asm volatile("" ::: "memory");
        { const char* kb = KTg; char* yq = ylb;
#pragma unroll 1
          for (int th = 0; th < 4; ++th) {
              const bf16x8 ka = ldg<bf16x8>(kb, vo32), kc = ldg<bf16x8>(kb + 1024, vo32);
              f32x4 acc0 = (f32x4){0.f, 0.f, 0.f, 0.f}, acc1 = (f32x4){0.f, 0.f, 0.f, 0.f};
              acc0 = mfma16(ka, X0, acc0); acc1 = mfma16(kc, X0, acc1);
              if (th >= 1) { acc0 = mfma16(ldg<bf16x8>(kb - 2048, vo32), X1, acc0); acc1 = mfma16(ldg<bf16x8>(kb - 1024, vo32), X1, acc1); }
              if (th >= 2) { acc0 = mfma16(ldg<bf16x8>(kb - 4096, vo32), X2, acc0); acc1 = mfma16(ldg<bf16x8>(kb - 3072, vo32), X2, acc1); }
              if (th >= 3) { acc0 = mfma16(ldg<bf16x8>(kb - 6144, vo32), X3, acc0); acc1 = mfma16(ldg<bf16x8>(kb - 5120, vo32), X3, acc1); }
              u32x2 w; w.x = cvt_pk_bf16(acc0[0], acc0[1]); w.y = cvt_pk_bf16(acc0[2], acc0[3]); *(u32x2*)(yq + vy) = w;
              w.x = cvt_pk_bf16(acc1[0], acc1[1]); w.y = cvt_pk_bf16(acc1[2], acc1[3]); *(u32x2*)(yq + (size_t)D * 2 + vy) = w;
              kb += 2048; yq += (size_t)2 * D * 2; } }
        asm volatile("" ::: "memory");
        float sr = cr, si = ci;
#pragma unroll
        for (int s = 0; s < 16; ++s) { const float er = Sb[s * 128 + lane], ei = Sb[s * 128 + 64 + lane];
            *(float*)(seb + s * 512 + vl) = er; *(float*)(seb + s * 512 + 256 + vl) = ei;
            const float nr = l8r * sr - l8i * si + er, ni = l8r * si + l8i * sr + ei; sr = nr; si = ni; }
        kr = sr; ki = si;
        float* dst = first ? SEND + (((size_t)unit * CG + g) * 2) * CS + lane : SEND2 + (((size_t)(unit >> 1) * CG + g) * 2) * CS + lane;
        dst[0] = sr; dst[CS] = si; asm volatile("" ::: "memory"); return;
    }
    if (first) { const int pr = unit >> 1, p0 = pr - (pr % (UPB128 / 2)); const float l2r = lur * lur - lui * lui, l2i = 2.0f * lur * lui;
        const char* sb = (const char*)(SEND2 + (((size_t)p0 * CG + g) * 2) * CS);
#pragma unroll 8
        for (int j = p0; j < pr; ++j) { const float sr = ldg<float>(sb, vl), si = ldg<float>(sb + CS * 4, vl); sb += (size_t)CG * 2 * CS * 4;
            const float nr = l2r * cr - l2i * ci + sr, ni = l2r * ci + l2i * cr + si; cr = nr; ci = ni; } }
    else { const float sr = SEND[(((size_t)(unit - 1) * CG + g) * 2 + 0) * CS + lane], si = SEND[(((size_t)(unit - 1) * CG + g) * 2 + 1) * CS + lane];
        cr = lur * kr - lui * ki + sr; ci = lur * ki + lui * kr + si; }
    kr = cr; ki = ci;
    { float sre[16], sim[16];
#pragma unroll
      for (int s = 0; s < 16; ++s) { sre[s] = ldg<float>(seb + s * 512, vl); sim[s] = ldg<float>(seb + s * 512 + 256, vl); }
      float sr = cr, si = ci;
#pragma unroll
      for (int s = 0; s < 16; ++s) { Tb[s * 128 + lane] = f2bf(sr); Tb[s * 128 + 64 + lane] = f2bf(si);
          const float nr = l8r * sr - l8i * si + sre[s], ni = l8r * si + l8i * sr + sim[s]; sr = nr; si = ni; } }
    asm volatile("" ::: "memory");
    const bf16x8 T0 = *(const LAS bf16x8*)(Tb + ln * 128 + 8 * q), T1 = *(const LAS bf16x8*)(Tb + ln * 128 + 32 + 8 * q), T2 = *(const LAS bf16x8*)(Tb + ln * 128 + 64 + 8 * q), T3 = *(const LAS bf16x8*)(Tb + ln * 128 + 96 + 8 * q);
    { LAS bf16_t* yw = yst + (ln * 8) * YST_LD + g * 16 + 4 * q; const char* fb = FTg; const char* yq = ylb;
#pragma unroll 2
      for (int th = 0; th < 4; ++th) { bf16x8 ff[2][4]; u32x2 yl[2];
#pragma unroll
          for (int j = 0; j < 2; ++j) { yl[j] = ldg<u32x2>(yq + (size_t)j * D * 2, vy);
#pragma unroll
              for (int ks = 0; ks < 4; ++ks) ff[j][ks] = ldg<bf16x8>(fb + j * 4096 + ks * 64, vo128); }
#pragma unroll
          for (int j = 0; j < 2; ++j) {
              f32x4 acc; acc[0] = __uint_as_float(yl[j].x << 16); acc[1] = __uint_as_float(yl[j].x & 0xffff0000u); acc[2] = __uint_as_float(yl[j].y << 16); acc[3] = __uint_as_float(yl[j].y & 0xffff0000u);
              acc = mfma16(ff[j][0], T0, acc); acc = mfma16(ff[j][1], T1, acc); acc = mfma16(ff[j][2], T2, acc); acc = mfma16(ff[j][3], T3, acc);
              u32x2 w; w.x = cvt_pk_bf16(gelu_fast(acc[0]), gelu_fast(acc[1])); w.y = cvt_pk_bf16(gelu_fast(acc[2]), gelu_fast(acc[3]));
              *(LAS u32x2*)(yw + j * YST_LD) = w; }
          fb += 8192; yq += (size_t)2 * D * 2; yw += 2 * YST_LD; } }
    asm volatile("s_waitcnt lgkmcnt(0)" ::: "memory");
}
__device__ __forceinline__ void s5_pair1(int pr, int g, int wave, int lane, const bf16_t* Z, bf16_t* Y, const unsigned char* tab, float* SEND, float* SEND2, float* SE, LAS unsigned char* lds) {
    const int ln = lane & 15, q = lane >> 4; const int t0 = pr * 256;
    const char* KTg = (const char*)(tab + S5_KT) + (size_t)g * 8192; const char* ETg = (const char*)(tab + S5_ET) + (size_t)g * 32768;
    const float* LAMPg = (const float*)(tab + S5_LAMP) + (size_t)g * CS * 8;
    const unsigned vo128 = (unsigned)(ln * 128 + 8 * q) * 2u, vo32 = (unsigned)(ln * 32 + 8 * q) * 2u, vl = (unsigned)lane * 4u;
    LAS float* SbA = (LAS float*)(lds + wave * 16384); LAS float* SbB = SbA + 2048;
    bf16x8 XA0, XA1, XA2, XA3, XB0, XB1, XB2, XB3;
    { const char* zb = (const char*)(Z + (size_t)t0 * INC + ZC + g * 16); const unsigned vz = (unsigned)((ln * 8 + (q >> 1)) * INC + 8 * (q & 1)) * 2u;
      XA0 = ldg<bf16x8>(zb, vz); XA1 = ldg<bf16x8>(zb + 2 * INC * 2, vz); XA2 = ldg<bf16x8>(zb + 4 * INC * 2, vz); XA3 = ldg<bf16x8>(zb + 6 * INC * 2, vz);
      const char* zc = zb + (size_t)128 * INC * 2;
      XB0 = ldg<bf16x8>(zc, vz); XB1 = ldg<bf16x8>(zc + 2 * INC * 2, vz); XB2 = ldg<bf16x8>(zc + 4 * INC * 2, vz); XB3 = ldg<bf16x8>(zc + 6 * INC * 2, vz); }
    { LAS float* sw = SbA + (4 * q) * 128 + ln; const char* eb = ETg;
#pragma unroll
      for (int jh = 0; jh < 2; ++jh) { bf16x8 ef[4][4];
#pragma unroll
        for (int j = 0; j < 4; ++j)
#pragma unroll
          for (int ks = 0; ks < 4; ++ks) ef[j][ks] = ldg<bf16x8>(eb + j * 4096 + ks * 64, vo128);
#pragma unroll
        for (int j = 0; j < 4; ++j) { f32x4 sa = (f32x4){0.f, 0.f, 0.f, 0.f}, sb = (f32x4){0.f, 0.f, 0.f, 0.f};
          sa = mfma16(XA0, ef[j][0], sa); sb = mfma16(XB0, ef[j][0], sb); sa = mfma16(XA1, ef[j][1], sa); sb = mfma16(XB1, ef[j][1], sb);
          sa = mfma16(XA2, ef[j][2], sa); sb = mfma16(XB2, ef[j][2], sb); sa = mfma16(XA3, ef[j][3], sa); sb = mfma16(XB3, ef[j][3], sb);
          LAS float* s2 = sw + 16 * j; s2[0] = sa[0]; s2[128] = sa[1]; s2[256] = sa[2]; s2[384] = sa[3]; s2[2048] = sb[0]; s2[2048 + 128] = sb[1]; s2[2048 + 256] = sb[2]; s2[2048 + 384] = sb[3]; }
        eb += 16384; sw += 64; } }
    asm volatile("" ::: "memory");
    { const char* kb = KTg; char* yq = (char*)(Y + (size_t)t0 * D + AW + BW + g * 16); const unsigned vy = (unsigned)((ln * 8) * D + 4 * q) * 2u;
#pragma unroll 1
      for (int th = 0; th < 4; ++th) {
          const bf16x8 ka = ldg<bf16x8>(kb, vo32), kc = ldg<bf16x8>(kb + 1024, vo32);
          f32x4 a0 = (f32x4){0.f, 0.f, 0.f, 0.f}, a1 = a0, b0 = a0, b1 = a0;
          a0 = mfma16(ka, XA0, a0); a1 = mfma16(kc, XA0, a1); b0 = mfma16(ka, XB0, b0); b1 = mfma16(kc, XB0, b1);
          if (th >= 1) { const bf16x8 k0 = ldg<bf16x8>(kb - 2048, vo32), k1 = ldg<bf16x8>(kb - 1024, vo32); a0 = mfma16(k0, XA1, a0); a1 = mfma16(k1, XA1, a1); b0 = mfma16(k0, XB1, b0); b1 = mfma16(k1, XB1, b1); }
          if (th >= 2) { const bf16x8 k0 = ldg<bf16x8>(kb - 4096, vo32), k1 = ldg<bf16x8>(kb - 3072, vo32); a0 = mfma16(k0, XA2, a0); a1 = mfma16(k1, XA2, a1); b0 = mfma16(k0, XB2, b0); b1 = mfma16(k1, XB2, b1); }
          if (th >= 3) { const bf16x8 k0 = ldg<bf16x8>(kb - 6144, vo32), k1 = ldg<bf16x8>(kb - 5120, vo32); a0 = mfma16(k0, XA3, a0); a1 = mfma16(k1, XA3, a1); b0 = mfma16(k0, XB3, b0); b1 = mfma16(k1, XB3, b1); }
          u32x2 w; w.x = cvt_pk_bf16(a0[0], a0[1]); w.y = cvt_pk_bf16(a0[2], a0[3]); *(u32x2*)(yq + vy) = w;
          w.x = cvt_pk_bf16(a1[0], a1[1]); w.y = cvt_pk_bf16(a1[2], a1[3]); *(u32x2*)(yq + (size_t)D * 2 + vy) = w;
          w.x = cvt_pk_bf16(b0[0], b0[1]); w.y = cvt_pk_bf16(b0[2], b0[3]); *(u32x2*)(yq + (size_t)128 * D * 2 + vy) = w;
          w.x = cvt_pk_bf16(b1[0], b1[1]); w.y = cvt_pk_bf16(b1[2], b1[3]); *(u32x2*)(yq + (size_t)129 * D * 2 + vy) = w;
          kb += 2048; yq += (size_t)2 * D * 2; } }
    asm volatile("" ::: "memory");
    const float l8r = LAMPg[lane * 8 + 2], l8i = LAMPg[lane * 8 + 3];
    float sr = 0.f, si = 0.f;
    { char* seb = (char*)(SE + ((size_t)(2 * pr) * CG + g) * 16 * 128);
#pragma unroll
      for (int s = 0; s < 16; ++s) { const float er = SbA[s * 128 + lane], ei = SbA[s * 128 + 64 + lane];
          *(float*)(seb + s * 512 + vl) = er; *(float*)(seb + s * 512 + 256 + vl) = ei;
          const float nr = l8r * sr - l8i * si + er, ni = l8r * si + l8i * sr + ei; sr = nr; si = ni; }
      float* dst = SEND + (((size_t)(2 * pr) * CG + g) * 2) * CS + lane; dst[0] = sr; dst[CS] = si; }
    { char* seb = (char*)(SE + ((size_t)(2 * pr + 1) * CG + g) * 16 * 128);
#pragma unroll
      for (int s = 0; s < 16; ++s) { const float er = SbB[s * 128 + lane], ei = SbB[s * 128 + 64 + lane];
          *(float*)(seb + s * 512 + vl) = er; *(float*)(seb + s * 512 + 256 + vl) = ei;
          const float nr = l8r * sr - l8i * si + er, ni = l8r * si + l8i * sr + ei; sr = nr; si = ni; }
      float* dst = SEND2 + (((size_t)pr * CG + g) * 2) * CS + lane; dst[0] = sr; dst[CS] = si; }
    asm volatile("s_waitcnt lgkmcnt(0)" ::: "memory");
}
constexpr int S5_PSG = 133120;
__device__ __forceinline__ void s5_glu(int unit, int wave, int lane, const bf16_t* WGLU, const float* glu_b, const float* mo_gc, bf16_t* Y, LAS unsigned char* lds) {
    const int ln = lane & 15, q = lane >> 4; LAS bf16_t* yst = (LAS bf16_t*)(lds + S5_YST); LAS float* PSg = (LAS float*)(lds + S5_PSG);
    bf16x8 wf[2][8];
    { const char* wb = (const char*)(WGLU + (size_t)(32 * wave) * 256); const unsigned vw = (unsigned)(ln * 256 + 8 * q) * 2u;
#pragma unroll
      for (int j = 0; j < 2; ++j)
#pragma unroll
          for (int ks = 0; ks < 8; ++ks) wf[j][ks] = ldg<bf16x8>(wb + j * 8192 + ks * 64, vw); }
    const f32x4 gb0 = *(const f32x4*)(glu_b + 32 * wave + 4 * q), gb1 = *(const f32x4*)(glu_b + 32 * wave + 16 + 4 * q);
    LAS bf16_t* op = (LAS bf16_t*)(lds + wave * S5_WSCR) + ln * 32 + 4 * q;
    { const LAS bf16_t* yrow = yst + ln * YST_LD; LAS float* psw = PSg + ln * 8 + wave; LAS bf16_t* ow = op;
#pragma unroll 4
      for (int tt = 0; tt < 8; ++tt) {
        f32x4 a0 = (f32x4){0.f, 0.f, 0.f, 0.f}, a1 = (f32x4){0.f, 0.f, 0.f, 0.f};
#pragma unroll
        for (int ks = 0; ks < 8; ++ks) { const bf16x8 yf = *(const LAS bf16x8*)(yrow + 32 * ks + 8 * q); a0 = mfma16(wf[0][ks], yf, a0); a1 = mfma16(wf[1][ks], yf, a1); }
        const u32x2 y0 = *(const LAS u32x2*)(yrow + 32 * wave + 4 * q), y1 = *(const LAS u32x2*)(yrow + 32 * wave + 16 + 4 * q);
        float o[8];
        o[0] = __uint_as_float(y0.x << 16) * sigmoid_fast(a0[0] + gb0[0]); o[1] = __uint_as_float(y0.x & 0xffff0000u) * sigmoid_fast(a0[1] + gb0[1]); o[2] = __uint_as_float(y0.y << 16) * sigmoid_fast(a0[2] + gb0[2]); o[3] = __uint_as_float(y0.y & 0xffff0000u) * sigmoid_fast(a0[3] + gb0[3]);
        o[4] = __uint_as_float(y1.x << 16) * sigmoid_fast(a1[0] + gb1[0]); o[5] = __uint_as_float(y1.x & 0xffff0000u) * sigmoid_fast(a1[1] + gb1[1]); o[6] = __uint_as_float(y1.y << 16) * sigmoid_fast(a1[2] + gb1[2]); o[7] = __uint_as_float(y1.y & 0xffff0000u) * sigmoid_fast(a1[3] + gb1[3]);
        float ss = ((o[0] * o[0] + o[1] * o[1]) + (o[2] * o[2] + o[3] * o[3])) + ((o[4] * o[4] + o[5] * o[5]) + (o[6] * o[6] + o[7] * o[7]));
        ss = add_x16_x32(ss);
        if (q == 0) *psw = ss;
        u32x2 w; w.x = cvt_pk_bf16(o[0], o[1]); w.y = cvt_pk_bf16(o[2], o[3]); *(LAS u32x2*)(ow) = w; w.x = cvt_pk_bf16(o[4], o[5]); w.y = cvt_pk_bf16(o[6], o[7]); *(LAS u32x2*)(ow + 16) = w;
        yrow += 16 * YST_LD; psw += 16 * 8; ow += 16 * 32; } }
    asm volatile("s_waitcnt lgkmcnt(0)" ::: "memory");
    __syncthreads();
    const f32x4 g0 = *(const f32x4*)(mo_gc + 32 * wave + 4 * q), g1 = *(const f32x4*)(mo_gc + 32 * wave + 16 + 4 * q);
    { char* yb = (char*)(Y + (size_t)(unit * 128) * D + AW + BW + 32 * wave); const unsigned vy = (unsigned)(ln * D + 4 * q) * 2u; const LAS f32x4* pp = (const LAS f32x4*)(PSg + ln * 8); const LAS bf16_t* ow = op;
#pragma unroll 2
      for (int tt = 0; tt < 8; ++tt) { const f32x4 p0 = pp[0], p1 = pp[1];
        const float rs = __builtin_amdgcn_rsqf((((p0[0] + p0[1]) + (p0[2] + p0[3])) + ((p1[0] + p1[1]) + (p1[2] + p1[3]))) * (1.0f / CW) + EPS);
        const u32x2 a = *(const LAS u32x2*)(ow), b = *(const LAS u32x2*)(ow + 16); u32x2 w;
        w.x = cvt_pk_bf16(__uint_as_float(a.x << 16) * rs * g0[0], __uint_as_float(a.x & 0xffff0000u) * rs * g0[1]); w.y = cvt_pk_bf16(__uint_as_float(a.y << 16) * rs * g0[2], __uint_as_float(a.y & 0xffff0000u) * rs * g0[3]);
        *(u32x2*)(yb + vy) = w;
        w.x = cvt_pk_bf16(__uint_as_float(b.x << 16) * rs * g1[0], __uint_as_float(b.x & 0xffff0000u) * rs * g1[1]); w.y = cvt_pk_bf16(__uint_as_float(b.y << 16) * rs * g1[2], __uint_as_float(b.y & 0xffff0000u) * rs * g1[3]);
        *(u32x2*)(yb + 32 + vy) = w;
        yb += (size_t)16 * D * 2; pp += 16 * 2; ow += 16 * 32; } }
}

constexpr int XC_LD = 392;
constexpr int RG_XC = 0, RG_PS = 100352, RG_CAR = 112640, RG_RSB = 114176, RG_PT = 114688, RG_HC = 116224;
template <int CTRL> __device__ __forceinline__ float dpp0(float v) { return __int_as_float(__builtin_amdgcn_update_dpp(0, __float_as_int(v), CTRL, 0xf, 0xf, true)); }
template <int CTRL> __device__ __forceinline__ float dppf(float old, float v) { return __int_as_float(__builtin_amdgcn_update_dpp(__float_as_int(old), __float_as_int(v), CTRL, 0xf, 0xf, false)); }
__device__ __forceinline__ void bf8_to_f32(const u32x4 o, float (&v)[8]) {
    v[0] = __uint_as_float(o.x << 16); v[1] = __uint_as_float(o.x & 0xffff0000u); v[2] = __uint_as_float(o.y << 16); v[3] = __uint_as_float(o.y & 0xffff0000u);
    v[4] = __uint_as_float(o.z << 16); v[5] = __uint_as_float(o.z & 0xffff0000u); v[6] = __uint_as_float(o.w << 16); v[7] = __uint_as_float(o.w & 0xffff0000u);
}
__device__ __forceinline__ float bcast15(float v) { return __int_as_float(__builtin_amdgcn_ds_swizzle(__float_as_int(v), 0x1F0)); }
template <int PASS>
__device__ __forceinline__ void rglru_unit(int unit, bool first, float& cprev, int tid, int wave, int lane, const bf16_t* Z, bf16_t* Y, const bf16_t* WRG, const bf16_t* WIG,
                                           const float* conv_w, const float* conv_b, const float* rg_b, const float* ig_b, const float* lam, const float* mo_gb,
                                           float* SUMA, float* SUMH, float* SUMA2, float* SUMH2, bf16_t* HL, bf16_t* PP, LAS unsigned char* lds) {
    LAS bf16_t* xcl = (LAS bf16_t*)(lds + RG_XC); LAS float* PS = (LAS float*)(lds + RG_PS); LAS float* CAR = (LAS float*)(lds + RG_CAR); LAS float* RSB = (LAS float*)(lds + RG_RSB); LAS float* PT = (LAS float*)(lds + RG_PT); LAS float* HC = (LAS float*)(lds + RG_HC);
    const int t0 = unit * 128; const int ln = lane & 15, q = lane >> 4;
    if (tid < 384) {
        const int c0 = (tid % 48) * 8, tg = tid / 48; const int tb = t0 + tg * 16, s0 = tb % SEQ;
        float w0[8], w1[8], w2[8], w3[8], bb[8];
#pragma unroll
        for (int hh = 0; hh < 2; ++hh) { const f32x4 a0 = *(const f32x4*)(conv_w + 0 * BW + c0 + 4 * hh), a1 = *(const f32x4*)(conv_w + 1 * BW + c0 + 4 * hh), a2 = *(const f32x4*)(conv_w + 2 * BW + c0 + 4 * hh), a3 = *(const f32x4*)(conv_w + 3 * BW + c0 + 4 * hh), a4 = *(const f32x4*)(conv_b + c0 + 4 * hh);
#pragma unroll
            for (int j = 0; j < 4; ++j) { w0[4 * hh + j] = a0[j]; w1[4 * hh + j] = a1[j]; w2[4 * hh + j] = a2[j]; w3[4 * hh + j] = a3[j]; bb[4 * hh + j] = a4[j]; } }
        float xm1[8], xm2[8], xm3[8];
        const bf16_t* zp = Z + (size_t)tb * INC + ZX + c0;
        { const u32x4 z4 = {0u, 0u, 0u, 0u}; const u32x4 o1 = s0 >= 1 ? *(const u32x4*)(zp - INC) : z4, o2 = s0 >= 2 ? *(const u32x4*)(zp - 2 * INC) : z4, o3 = s0 >= 3 ? *(const u32x4*)(zp - 3 * INC) : z4;
          bf8_to_f32(o1, xm1); bf8_to_f32(o2, xm2); bf8_to_f32(o3, xm3); }
        LAS bf16_t* xw = xcl + (tg * 16) * XC_LD + c0;
#pragma unroll 4
        for (int i = 0; i < 16; ++i) { float x0[8]; bf8_to_f32(*(const u32x4*)(zp), x0); float v[8];
#pragma unroll
            for (int j = 0; j < 8; ++j) { v[j] = bb[j] + w3[j] * x0[j] + w2[j] * xm1[j] + w1[j] * xm2[j] + w0[j] * xm3[j]; xm3[j] = xm2[j]; xm2[j] = xm1[j]; xm1[j] = x0[j]; }
            u32x4 w; w.x = cvt_pk_bf16(v[0], v[1]); w.y = cvt_pk_bf16(v[2], v[3]); w.z = cvt_pk_bf16(v[4], v[5]); w.w = cvt_pk_bf16(v[6], v[7]);
            *(LAS u32x4*)(xw) = w; zp += INC; xw += XC_LD; }
        if (PASS == 2) { const int c = tid; float h;
            if (first) { const int pr = unit >> 1, p0 = pr - (pr % (UPB128 / 2)); h = 0.f; const float* pa = SUMA2 + (size_t)p0 * BW + c; const float* ph = SUMH2 + (size_t)p0 * BW + c;
#pragma unroll 8
                for (int j = p0; j < pr; ++j) { h = fmaf(*pa, h, *ph); pa += BW; ph += BW; } }
            else h = fmaf(SUMA[(size_t)(unit - 1) * BW + c], cprev, SUMH[(size_t)(unit - 1) * BW + c]);
            cprev = h; CAR[c] = h; }
    }
    __syncthreads();
#pragma unroll 1
    for (int ci = 0; ci < 3; ++ci) {
        const int combo = wave + 8 * ci, h = combo >> 2, jt = combo & 3, cb = h * 64 + jt * 16;
        const bf16_t* wr = WRG + ((size_t)(h * 64 + jt * 16 + ln)) * 64 + 8 * q; const bf16_t* wi = WIG + ((size_t)(h * 64 + jt * 16 + ln)) * 64 + 8 * q;
        const bf16x8 RG0 = *(const bf16x8*)(wr), RG1 = *(const bf16x8*)(wr + 32), IG0 = *(const bf16x8*)(wi), IG1 = *(const bf16x8*)(wi + 32);
        const f32x4 rgb4 = *(const f32x4*)(rg_b + cb + 4 * q), igb4 = *(const f32x4*)(ig_b + cb + 4 * q), lam4 = *(const f32x4*)(lam + cb + 4 * q);
        const float m1 = ln < 1 ? 1.f : 0.f, m2 = ln < 2 ? 1.f : 0.f, m4 = ln < 4 ? 1.f : 0.f, m8 = ln < 8 ? 1.f : 0.f;
        float spc[4], car[4], ptot[4];
#pragma unroll
        for (int r = 0; r < 4; ++r) { spc[r] = -8.0f * 1.4426950408889634f * log1pf(expf(-lam4[r])); car[r] = PASS == 2 ? CAR[cb + 4 * q + r] : (first ? 0.f : HC[cb + 4 * q + r]); ptot[r] = (PASS == 1 && !first) ? PT[cb + 4 * q + r] : 1.f; }
        const LAS bf16_t* xb = xcl + ln * XC_LD + h * 64 + 8 * q; const LAS bf16_t* xv = xcl + ln * XC_LD + cb + 4 * q;
        const bf16_t* zg = Z + (size_t)(t0 + ln) * INC + ZG + cb + 4 * q; bf16_t* yo = Y + (size_t)(t0 + ln) * D + AW + cb + 4 * q; LAS float* psw = PS + ln * 24 + combo;
        bf16_t* hlo = HL + (size_t)(t0 + ln) * BW + cb + 4 * q; bf16_t* ppo = PP + (size_t)(t0 + ln) * BW + cb + 4 * q;
#pragma unroll 1
        for (int tt = 0; tt < 8; ++tt) {
            const bf16x8 B0 = *(const LAS bf16x8*)(xb), B1 = *(const LAS bf16x8*)(xb + 32);
            f32x4 ar = (f32x4){0.f, 0.f, 0.f, 0.f}, ai = (f32x4){0.f, 0.f, 0.f, 0.f};
            ar = mfma16(RG0, B0, ar); ar = mfma16(RG1, B1, ar); ai = mfma16(IG0, B0, ai); ai = mfma16(IG1, B1, ai);
            const u32x2 xq = *(const LAS u32x2*)(xv); float xc4[4] = {__uint_as_float(xq.x << 16), __uint_as_float(xq.x & 0xffff0000u), __uint_as_float(xq.y << 16), __uint_as_float(xq.y & 0xffff0000u)};
            float hv[4], pv[4];
#pragma unroll
            for (int r = 0; r < 4; ++r) {
                const float rr = sigmoid_fast(ar[r] + rgb4[r]), ii = sigmoid_fast(ai[r] + igb4[r]);
                float A = __builtin_amdgcn_exp2f(spc[r] * rr);
                float Bv = __builtin_amdgcn_sqrtf(fmaxf(1.0f - A * A, 0.f)) * (ii * xc4[r]);
                if (ln == 0) { Bv = fmaf(A, car[r], Bv); A *= ptot[r]; }
                { const float As = dpp0<0x111>(A) + m1, Bs = dpp0<0x111>(Bv); Bv = fmaf(A, Bs, Bv); A *= As; }
                { const float As = dpp0<0x112>(A) + m2, Bs = dpp0<0x112>(Bv); Bv = fmaf(A, Bs, Bv); A *= As; }
                { const float As = dpp0<0x114>(A) + m4, Bs = dpp0<0x114>(Bv); Bv = fmaf(A, Bs, Bv); A *= As; }
                { const float As = dpp0<0x118>(A) + m8, Bs = dpp0<0x118>(Bv); Bv = fmaf(A, Bs, Bv); A *= As; }
                hv[r] = Bv; pv[r] = A; car[r] = dppf<0x121>(Bv, Bv); ptot[r] = dppf<0x121>(A, A);
            }
            if (PASS == 1) { u32x2 w; w.x = cvt_pk_bf16(hv[0], hv[1]); w.y = cvt_pk_bf16(hv[2], hv[3]); *(u32x2*)(hlo) = w; w.x = cvt_pk_bf16(pv[0], pv[1]); w.y = cvt_pk_bf16(pv[2], pv[3]); *(u32x2*)(ppo) = w; hlo += 16 * BW; ppo += 16 * BW; }
            if (PASS == 2) { const u32x2 gq = *(const u32x2*)(zg);
                const float y0 = hv[0] * __uint_as_float(gq.x << 16), y1 = hv[1] * __uint_as_float(gq.x & 0xffff0000u), y2 = hv[2] * __uint_as_float(gq.y << 16), y3 = hv[3] * __uint_as_float(gq.y & 0xffff0000u);
                u32x2 w; w.x = cvt_pk_bf16(y0, y1); w.y = cvt_pk_bf16(y2, y3); *(u32x2*)(yo) = w;
                float ss = (y0 * y0 + y1 * y1) + (y2 * y2 + y3 * y3); ss += __shfl_xor(ss, 16); ss += __shfl_xor(ss, 32);
                if (q == 0) *psw = ss; }
            xb += 16 * XC_LD; xv += 16 * XC_LD; zg += 16 * INC; yo += 16 * D; psw += 16 * 24;
        }
        if (PASS == 1 && ln == 0) {
            float* da = first ? SUMA + (size_t)unit * BW : SUMA2 + (size_t)(unit >> 1) * BW; float* dh = first ? SUMH + (size_t)unit * BW : SUMH2 + (size_t)(unit >> 1) * BW;
#pragma unroll
            for (int r = 0; r < 4; ++r) { da[cb + 4 * q + r] = ptot[r]; dh[cb + 4 * q + r] = car[r]; if (first) { PT[cb + 4 * q + r] = ptot[r]; HC[cb + 4 * q + r] = car[r]; } } }
    }
    if (PASS == 2) {
        asm volatile("s_waitcnt vmcnt(0)" ::: "memory");
        __syncthreads();
        if (tid < 128) { float s = 0.f;
#pragma unroll
            for (int k = 0; k < 24; ++k) s += PS[tid * 24 + k];
            RSB[tid] = __builtin_amdgcn_rsqf(s * (1.0f / BW) + EPS); }
        __syncthreads();
#pragma unroll 2
        for (int k = 0; k < 12; ++k) { const int idx = tid + 512 * k, tl = idx / 48, c0 = (idx % 48) * 8; const float rs = RSB[tl];
            bf16_t* yp = Y + (size_t)(t0 + tl) * D + AW + c0; float v[8]; bf8_to_f32(*(const u32x4*)(yp), v);
            const f32x4 g0 = *(const f32x4*)(mo_gb + c0), g1 = *(const f32x4*)(mo_gb + c0 + 4);
            u32x4 w; w.x = cvt_pk_bf16(v[0] * rs * g0[0], v[1] * rs * g0[1]); w.y = cvt_pk_bf16(v[2] * rs * g0[2], v[3] * rs * g0[3]); w.z = cvt_pk_bf16(v[4] * rs * g1[0], v[5] * rs * g1[1]); w.w = cvt_pk_bf16(v[6] * rs * g1[2], v[7] * rs * g1[3]);
            *(u32x4*)(yp) = w; }
    }
    __syncthreads();
}

__device__ __forceinline__ void rglru_fix_pair(int pr, int tid, int wave, int lane, const bf16_t* Z, bf16_t* Y, const bf16_t* HL, const bf16_t* PP, const float* SUMA2, const float* SUMH2, const float* mo_gb, LAS unsigned char* lds) {
    LAS float* CAR = (LAS float*)(lds + RG_CAR);
    if (tid < 384) { const int c = tid, p0 = pr - (pr % (UPB128 / 2)); float h = 0.f; const float* pa = SUMA2 + (size_t)p0 * BW + c; const float* ph = SUMH2 + (size_t)p0 * BW + c;
#pragma unroll 8
        for (int j = p0; j < pr; ++j) { h = fmaf(*pa, h, *ph); pa += BW; ph += BW; }
        CAR[c] = h; }
    __syncthreads();
    {
        const bool act = lane < 48; const int c0 = act ? lane * 8 : 0; float hin[8]; const f32x4 g0 = *(const f32x4*)(mo_gb + c0), g1 = *(const f32x4*)(mo_gb + c0 + 4);
#pragma unroll
        for (int e = 0; e < 8; ++e) hin[e] = CAR[c0 + e];
#pragma unroll 2
        for (int i = 0; i < 32; ++i) { const size_t t = (size_t)pr * 256 + wave * 32 + i;
            float hl[8], pp[8], gg[8], y[8]; bf8_to_f32(*(const u32x4*)(HL + t * BW + c0), hl); bf8_to_f32(*(const u32x4*)(PP + t * BW + c0), pp); bf8_to_f32(*(const u32x4*)(Z + t * INC + ZG + c0), gg);
            float ss = 0.f;
#pragma unroll
            for (int e = 0; e < 8; ++e) { y[e] = fmaf(pp[e], hin[e], hl[e]) * gelu_fast(gg[e]); ss += y[e] * y[e]; }
            ss = wave_sum(act ? ss : 0.f);
            const float rs = __builtin_amdgcn_rsqf(ss * (1.0f / BW) + EPS);
            u32x4 w; w.x = cvt_pk_bf16(y[0] * rs * g0[0], y[1] * rs * g0[1]); w.y = cvt_pk_bf16(y[2] * rs * g0[2], y[3] * rs * g0[3]); w.z = cvt_pk_bf16(y[4] * rs * g1[0], y[5] * rs * g1[1]); w.w = cvt_pk_bf16(y[6] * rs * g1[2], y[7] * rs * g1[3]);
            if (act) *(u32x4*)(Y + t * D + AW + c0) = w; }
    }
    __syncthreads();
}

constexpr int VT_LD = 136;
__device__ __forceinline__ void mixa_unit(int unit, int tid, int wave, int lane, const bf16_t* Z, bf16_t* Y, const bf16_t* WSP, const float* a_sb, const float* vg, const float* mo_ga, LAS unsigned char* lds) {
    LAS bf16_t* vT = (LAS bf16_t*)lds; const int t0 = unit * 128; const int ln = lane & 15, q = lane >> 4;
    { const int j = tid >> 2, part = tid & 3; const bf16_t* zp = Z + (size_t)(t0 + j) * INC + ZV + part * 96;
      u32x4 raw[12]; float ss = 0.f;
#pragma unroll
      for (int k = 0; k < 12; ++k) { const u32x4 rw = *(const u32x4*)(zp + 8 * k); float v[8]; bf8_to_f32(rw, v);
#pragma unroll
          for (int e = 0; e < 8; ++e) { v[e] = gelu_fast(v[e]); ss += v[e] * v[e]; }
          raw[k].x = cvt_pk_bf16(v[0], v[1]); raw[k].y = cvt_pk_bf16(v[2], v[3]); raw[k].z = cvt_pk_bf16(v[4], v[5]); raw[k].w = cvt_pk_bf16(v[6], v[7]); }
      ss += x_xor1(ss); ss += x_xor2(ss);
      const float rs = __builtin_amdgcn_rsqf(ss * (1.0f / AW) + EPS);
      LAS bf16_t* vw = vT + (part * 96) * VT_LD + j; const float* gp = vg + part * 96;
#pragma unroll
      for (int k = 0; k < 12; ++k) { float v[8]; bf8_to_f32(raw[k], v); const f32x4 g0 = *(const f32x4*)(gp + 8 * k), g1 = *(const f32x4*)(gp + 8 * k + 4);
#pragma unroll
          for (int e = 0; e < 8; ++e) vw[(8 * k + e) * VT_LD] = f2bf(v[e] * rs * (e < 4 ? g0[e] : g1[e - 4])); } }
    __syncthreads();
    const bool full = wave >= 4;
    float ss = 0.f;
    const int tl = 16 * wave + ln;
    const char* ub = (const char*)(Z + (size_t)t0 * INC + ZU); const unsigned vu = (unsigned)(tl * INC + 4 * q) * 2u;
    const char* wb = (const char*)WSP; const unsigned vw = (unsigned)(tl * 128 + 8 * q) * 2u;
    char* yb = (char*)(Y + (size_t)t0 * D); const unsigned vy = (unsigned)(tl * D + 4 * q) * 2u;
    const bf16x8 z8 = {0, 0, 0, 0, 0, 0, 0, 0};
    bf16x8 Wn0 = ldg<bf16x8>(wb, vw), Wn1 = ldg<bf16x8>(wb + 64, vw), Wn2 = z8, Wn3 = z8;
    if (full) { Wn2 = ldg<bf16x8>(wb + 128, vw); Wn3 = ldg<bf16x8>(wb + 192, vw); }
    u32x2 un0 = ldg<u32x2>(ub, vu), un1 = ldg<u32x2>(ub + 32, vu), un2 = ldg<u32x2>(ub + 64, vu), un3 = ldg<u32x2>(ub + 96, vu); float bn = a_sb[tl];
    const LAS bf16_t* ap = vT + ln * VT_LD + 8 * q;
    u32x2 val[24];
#pragma unroll
    for (int h = 0; h < 6; ++h) {
        const bf16x8 W0 = Wn0, W1 = Wn1, W2 = Wn2, W3 = Wn3; const u32x2 uc[4] = {un0, un1, un2, un3}; const float b = bn;
        if (h < 5) { const char* wq = wb + (size_t)(h + 1) * 128 * 128 * 2; const char* uq2 = ub + (h + 1) * 128;
            Wn0 = ldg<bf16x8>(wq, vw); Wn1 = ldg<bf16x8>(wq + 64, vw); if (full) { Wn2 = ldg<bf16x8>(wq + 128, vw); Wn3 = ldg<bf16x8>(wq + 192, vw); }
            un0 = ldg<u32x2>(uq2, vu); un1 = ldg<u32x2>(uq2 + 32, vu); un2 = ldg<u32x2>(uq2 + 64, vu); un3 = ldg<u32x2>(uq2 + 96, vu); bn = a_sb[(h + 1) * 128 + tl]; }
        asm volatile("" ::: "memory");
#pragma unroll
        for (int dt = 0; dt < 4; ++dt) { f32x4 acc = (f32x4){0.f, 0.f, 0.f, 0.f};
            const LAS bf16_t* aq = ap + (h * 64 + 16 * dt) * VT_LD;
            const bf16x8 a0 = *(const LAS bf16x8*)(aq), a1 = *(const LAS bf16x8*)(aq + 32), a2 = *(const LAS bf16x8*)(aq + 64), a3 = *(const LAS bf16x8*)(aq + 96);
            acc = mfma16(a0, W0, acc); acc = mfma16(a1, W1, acc); acc = mfma16(a2, W2, acc); acc = mfma16(a3, W3, acc);
            const u32x2 u2 = uc[dt];
            const float v0 = gelu_fast(__uint_as_float(u2.x << 16)) * (acc[0] + b), v1 = gelu_fast(__uint_as_float(u2.x & 0xffff0000u)) * (acc[1] + b), v2 = gelu_fast(__uint_as_float(u2.y << 16)) * (acc[2] + b), v3 = gelu_fast(__uint_as_float(u2.y & 0xffff0000u)) * (acc[3] + b);
            ss += (v0 * v0 + v1 * v1) + (v2 * v2 + v3 * v3);
            u32x2 pk; pk.x = cvt_pk_bf16(v0, v1); pk.y = cvt_pk_bf16(v2, v3); val[h * 4 + dt] = pk; }
    }
    ss = add_x16_x32(ss);
    const float rs = __builtin_amdgcn_rsqf(ss * (1.0f / AW) + EPS);
    { const char* gb = (const char*)mo_ga; const unsigned vg4 = (unsigned)(4 * q) * 4u;
#pragma unroll
      for (int k = 0; k < 24; ++k) { const f32x4 gg = ldg<f32x4>(gb + k * 64, vg4); const u32x2 pk = val[k];
          u32x2 w; w.x = cvt_pk_bf16(__uint_as_float(pk.x << 16) * rs * gg[0], __uint_as_float(pk.x & 0xffff0000u) * rs * gg[1]); w.y = cvt_pk_bf16(__uint_as_float(pk.y << 16) * rs * gg[2], __uint_as_float(pk.y & 0xffff0000u) * rs * gg[3]);
          *(u32x2*)(yb + k * 32 + vy) = w; } }
    __syncthreads();
}

__device__ __forceinline__ void router_unit(int unit, int wave, int lane, const bf16_t* HB, const float* SSQ, const bf16_t* WRT, const float* rgb, const float* reb,
                                            int* CLS, float* G2, LAS unsigned char* lds, LAS int* hist) {
    const int ln = lane & 15, q = lane >> 4; const int t0 = unit * UT + wave * 32;
    LAS float* LG = (LAS float*)(lds + wave * 8192);
    f32x4 acc[2][3];
#pragma unroll
    for (int tt = 0; tt < 2; ++tt)
#pragma unroll
        for (int j = 0; j < 3; ++j) acc[tt][j] = (f32x4){0.f, 0.f, 0.f, 0.f};
    const bf16_t* hp0 = HB + (size_t)(t0 + ln) * D + 8 * q; const bf16_t* hp1 = hp0 + (size_t)16 * D; const bf16_t* wp = WRT + (size_t)ln * D + 8 * q;
#pragma unroll 4
    for (int ks = 0; ks < 32; ++ks) {
        const bf16x8 b0 = *(const bf16x8*)(hp0), b1 = *(const bf16x8*)(hp1);
        const bf16x8 a0 = *(const bf16x8*)(wp), a1 = *(const bf16x8*)(wp + 16 * D), a2 = *(const bf16x8*)(wp + 32 * D);
        acc[0][0] = mfma16(a0, b0, acc[0][0]); acc[0][1] = mfma16(a1, b0, acc[0][1]); acc[0][2] = mfma16(a2, b0, acc[0][2]);
        acc[1][0] = mfma16(a0, b1, acc[1][0]); acc[1][1] = mfma16(a1, b1, acc[1][1]); acc[1][2] = mfma16(a2, b1, acc[1][2]);
        hp0 += 32; hp1 += 32; wp += 32; }
#pragma unroll
    for (int tt = 0; tt < 2; ++tt)
#pragma unroll
        for (int j = 0; j < 3; ++j) *(LAS f32x4*)(LG + (16 * tt + ln) * 48 + 16 * j + 4 * q) = acc[tt][j];
    asm volatile("s_waitcnt lgkmcnt(0)" ::: "memory");
    if (lane < 32) { const int t = t0 + lane; const LAS float* lg = LG + lane * 48;
        const f32x4* sp = (const f32x4*)(SSQ + (size_t)t * 16); const f32x4 s0 = sp[0], s1 = sp[1], s2 = sp[2], s3 = sp[3];
        const float sq = ((s0[0] + s0[1]) + (s0[2] + s0[3])) + ((s1[0] + s1[1]) + (s1[2] + s1[3])) + ((s2[0] + s2[1]) + (s2[2] + s2[3])) + ((s3[0] + s3[1]) + (s3[2] + s3[3]));
        const float r = rsqrtf(sq * (1.0f / D) + EPS);
        float gl[4];
#pragma unroll
        for (int j = 0; j < 4; ++j) gl[j] = r * (lg[j] + lg[16 + j]) + rgb[j];
        int gs = 0; float gm = gl[0];
#pragma unroll
        for (int j = 1; j < 4; ++j) if (gl[j] > gm) { gm = gl[j]; gs = j; }
        float den = 0.f;
#pragma unroll
        for (int j = 0; j < 4; ++j) den += expf(gl[j] - gm);
        const float gwt = 1.0f / den;
        float el[4];
#pragma unroll
        for (int j = 0; j < 4; ++j) { float v;
            if (gs < 3) v = lg[4 + 4 * gs + j] + lg[16 + 4 + 4 * gs + j]; else v = lg[32 + j] + lg[36 + j];
            el[j] = r * v + reb[gs * 4 + j]; }
        int i0 = 0; float v0 = el[0];
#pragma unroll
        for (int j = 1; j < 4; ++j) if (el[j] > v0) { v0 = el[j]; i0 = j; }
        int i1 = 0; float v1 = -3.0e38f;
#pragma unroll
        for (int j = 0; j < 4; ++j) if (j != i0 && el[j] > v1) { v1 = el[j]; i1 = j; }
        const float e1 = expf(v1 - v0); const float w0 = gwt / (1.0f + e1), w1 = gwt * e1 / (1.0f + e1);
        const int lo = i0 < i1 ? i0 : i1, hi = i0 < i1 ? i1 : i0; const int cls = gs * 6 + pair_idx(lo, hi);
        CLS[t] = cls; G2[(size_t)t * 2 + 0] = i0 < i1 ? w0 : w1; G2[(size_t)t * 2 + 1] = i0 < i1 ? w1 : w0;
        __hip_atomic_fetch_add(hist + cls, 1, __ATOMIC_RELAXED, __HIP_MEMORY_SCOPE_WORKGROUP); }
}

__device__ __forceinline__ void tr_item8(const float* W, int ldw, int k0, int scol0, unsigned char* WT, int ldo, int drow0, int dk0, LAS float* scr, int lane) {
#pragma unroll 8
    for (int i = 0; i < 32; ++i) { const int kk = 2 * i + (lane >> 5); scr[kk * 33 + (lane & 31)] = W[(size_t)(k0 + kk) * ldw + scol0 + (lane & 31)] * pg8::FS_W; }
    asm volatile("s_waitcnt lgkmcnt(0)" ::: "memory");
    const int c = lane & 7;
#pragma unroll
    for (int j = 0; j < 4; ++j) { const int n = (lane >> 3) + 8 * j; const LAS float* s = scr + (8 * c) * 33 + n;
        u32x2 o; o.x = pk_fp8x4(s[0 * 33], s[1 * 33], s[2 * 33], s[3 * 33]); o.y = pk_fp8x4(s[4 * 33], s[5 * 33], s[6 * 33], s[7 * 33]);
        *(u32x2*)(WT + (size_t)(drow0 + n) * ldo + dk0 + 8 * c) = o; }
    asm volatile("s_waitcnt lgkmcnt(0)" ::: "memory");
}
struct TrP { const float* src; const float* gk; unsigned char* dst; int ldw, ldo, fp8; };
__device__ __forceinline__ void tr_load(const TrP& P, int lane, float (&v)[32]) {
#pragma unroll
    for (int i = 0; i < 32; ++i) { const int kk = 2 * i + (lane >> 5); float x = P.src[(size_t)kk * P.ldw + (lane & 31)]; if (P.gk) x *= P.gk[kk]; v[i] = x; }
}
__device__ __forceinline__ void tr_store(const TrP& P, int lane, const float (&v)[32], LAS float* scr) {
    const float sc = P.fp8 ? pg8::FS_W : 1.0f;
#pragma unroll
    for (int i = 0; i < 32; ++i) scr[(2 * i + (lane >> 5)) * 33 + (lane & 31)] = v[i] * sc;
    asm volatile("s_waitcnt lgkmcnt(0)" ::: "memory");
    const int c = lane & 7;
#pragma unroll
    for (int j = 0; j < 4; ++j) { const int n = (lane >> 3) + 8 * j; const LAS float* s = scr + (8 * c) * 33 + n;
        if (P.fp8) { u32x2 o; o.x = pk_fp8x4(s[0 * 33], s[1 * 33], s[2 * 33], s[3 * 33]); o.y = pk_fp8x4(s[4 * 33], s[5 * 33], s[6 * 33], s[7 * 33]); *(u32x2*)(P.dst + (size_t)n * P.ldo + 8 * c) = o; }
        else { u32x4 o; o.x = cvt_pk_bf16(s[0 * 33], s[1 * 33]); o.y = cvt_pk_bf16(s[2 * 33], s[3 * 33]); o.z = cvt_pk_bf16(s[4 * 33], s[5 * 33]); o.w = cvt_pk_bf16(s[6 * 33], s[7 * 33]); *(u32x4*)(P.dst + (size_t)n * P.ldo + 16 * c) = o; } }
    asm volatile("s_waitcnt lgkmcnt(0)" ::: "memory");
}
struct Args { const float* in[34]; float* out; unsigned char* ws; };

__global__ void __launch_bounds__(512, 2) mega_fwd(Args a) {
    extern __shared__ __attribute__((aligned(16))) unsigned char lds_raw[];
    LAS unsigned char* lds = (LAS unsigned char*)lds_raw;
    volatile LAS unsigned* LW = (volatile LAS unsigned*)(lds + LDSCTL_OFF);
    volatile LAS int* LWI = (volatile LAS int*)(lds + LDSCTL_OFF);
    const int G = gridDim.x, bid0 = blockIdx.x; const int wave_s0 = __builtin_amdgcn_readfirstlane(threadIdx.x >> 6);
#define PHASE_IDS() int wv_ = wave_s0, bd_ = bid0; asm volatile("" : "+s"(wv_), "+s"(bd_)); const int wave_s = wv_, bid = bd_;     \
    const int lane = fresh_lane(), wave = wave_s, tid = wave * 64 + lane; const int gw = bid * 8 + wave, NGW = G * 8; \
    const size_t gt = (size_t)bid * 512 + tid, NGT = (size_t)G * 512; (void)lane; (void)wave; (void)gw; (void)NGW; (void)gt; (void)NGT
#define WSB() ({ unsigned char* _w = a.ws; asm volatile("" : "+s"(_w)); _w; })
#define INP(i) ({ int _k = (i); asm volatile("" : "+s"(_k)); a.in[_k]; })
    for (int u = threadIdx.x; u < (LDS_BYTES - LDSCTL_OFF) / 4; u += 512) LW[u] = 0u;
    __syncthreads();
    XcdBarrier bar = xcd_barrier_post((unsigned*)(a.ws + WS_CTL) + CW_BAR, LW + LW_BAR);

    {
        PHASE_IDS(); unsigned char* ws = WSB(); bf16_t* WIN = (bf16_t*)(ws + WS_WIN); bf16_t* WOUT = (bf16_t*)(ws + WS_WOUT); bf16_t* WGU = (bf16_t*)(ws + WS_WGU); bf16_t* WD2 = (bf16_t*)(ws + WS_WD2);
        bf16_t* HB = (bf16_t*)(ws + WS_HB); float* SSQ = (float*)(ws + WS_SSQ);
        LAS float* scr = (LAS float*)(lds + wave * 16384);
        constexpr int I_IN = 16 * 56, I_OUT = 16 * 32, I_GU = 2 * 16 * 256, I_D8 = 16 * 256, I_GLU = 32, I_RG = 24, I_L = I_IN + I_OUT + I_GU + I_D8 + I_GLU + I_RG;
        const float* i_win = INP(2); const float* i_g = INP(1); const float* i_wout = INP(24); const float* i_wg = INP(30); const float* i_wu = INP(31); const float* i_wd = INP(32);
        const float* i_glu = INP(21); const float* i_rg = INP(8); const float* i_ig = INP(10);
#define TR_DECODE(P, it) do { const int l = (it) / I_L; int r = (it) % I_L; P.gk = nullptr; P.fp8 = 0; \
            if (r < I_IN) { const int kb = r / 56, nb = r % 56, j0 = nb * 32; const int sc = j0 < 768 ? j0 : (j0 < 1152 ? j0 + 384 : (j0 < 1536 ? j0 - 384 : j0));     \
                P.src = i_win + (size_t)l * D * INC + (size_t)kb * 64 * INC + sc; P.ldw = INC; P.gk = i_g + (size_t)l * D + kb * 64; P.dst = (unsigned char*)(WIN + (size_t)l * INC * D + (size_t)j0 * D + kb * 64); P.ldo = D * 2; } \
            else if ((r -= I_IN) < I_OUT) { const int kb = r / 32, nb = r % 32; P.src = i_wout + (size_t)l * D * D + (size_t)kb * 64 * D + nb * 32; P.ldw = D; P.dst = (unsigned char*)(WOUT + (size_t)l * D * D + (size_t)nb * 32 * D + kb * 64); P.ldo = D * 2; } \
            else if ((r -= I_OUT) < I_GU) { const int which = r / (16 * 256), e = (r / 256) % 16, q = r % 256, kb = q / 16, nb = q % 16, n0 = nb * 32;     \
                P.src = (which ? i_wu : i_wg) + ((size_t)l * NE + e) * D * DE + (size_t)kb * 64 * DE + n0; P.ldw = DE; P.fp8 = 1; \
                P.dst = (unsigned char*)WGU + ((size_t)l * NE + e) * 1024 * 1024 + (size_t)((n0 / 128) * 256 + which * 128 + (n0 % 128)) * 1024 + kb * 64; P.ldo = 1024; } \
            else if ((r -= I_GU) < I_D8) { const int e = r / 256, q = r % 256, kb = q / 32, nb = q % 32;        \
                P.src = i_wd + ((size_t)l * NE + e) * DE * D + (size_t)kb * 64 * D + nb * 32; P.ldw = D; P.fp8 = 1; P.dst = ws + WS_WD8 + ((size_t)l * NE + e) * 1024 * 512 + (size_t)nb * 32 * 512 + kb * 64; P.ldo = 512; } \
            else if ((r -= I_D8) < I_GLU) { const int kb = r / 8, nb = r % 8; P.src = i_glu + (size_t)l * CW * CW + (size_t)kb * 64 * CW + nb * 32; P.ldw = CW; P.dst = (unsigned char*)((bf16_t*)(ws + WS_WGLU) + (size_t)l * CW * CW + (size_t)nb * 32 * CW + kb * 64); P.ldo = CW * 2; } \
            else { r -= I_GLU; const int gate = r / 12, h = (r / 2) % 6, nb = r & 1; \
                P.src = (gate ? i_ig : i_rg) + ((size_t)l * 6 + h) * 64 * 64 + nb * 32; P.ldw = 64; P.dst = (unsigned char*)((bf16_t*)(ws + WS_WRG) + (((size_t)l * 2 + gate) * 6 + h) * 64 * 64 + (size_t)nb * 32 * 64); P.ldo = 64 * 2; } } while (0)
        { TrP Pa, Pb; float va[32], vb[32]; int it = gw;
          if (it < 2 * I_L) { TR_DECODE(Pa, it); tr_load(Pa, lane, va); }
#pragma unroll 1
          while (it < 2 * I_L) {
              const int it1 = it + NGW; if (it1 < 2 * I_L) { TR_DECODE(Pb, it1); tr_load(Pb, lane, vb); }
              tr_store(Pa, lane, va, scr);
              if (it1 >= 2 * I_L) break;
              const int it2 = it1 + NGW; if (it2 < 2 * I_L) { TR_DECODE(Pa, it2); tr_load(Pa, lane, va); }
              tr_store(Pb, lane, vb, scr);
              it = it2; } }
#undef TR_DECODE
        { const float* s_are = INP(13); const float* s_aim = INP(14); const float* s_ldt = INP(15); const float* s_bre = INP(16); const float* s_bim = INP(17); const float* s_cre = INP(18); const float* s_cim = INP(19); const float* s_d = INP(20);
          for (size_t e = gt; e < (size_t)2 * CG * 256; e += NGT) { const int l = (int)(e / (CG * 256)), g = (int)((e / 256) % CG), c = (int)((e >> 4) & 15), cp = (int)(e & 15);
              s5_kt_pair(g, c, cp, s_are + (size_t)l * CG * CS, s_aim + (size_t)l * CG * CS, s_ldt + (size_t)l * CG, s_bre + (size_t)l * CG * CS * CGD, s_bim + (size_t)l * CG * CS * CGD,
                         s_cre + (size_t)l * CG * CGD * CS, s_cim + (size_t)l * CG * CGD * CS, s_d + (size_t)l * CW, ws + WS_S5 + (size_t)l * S5_L_STRIDE); }
          for (size_t e = gt; e < (size_t)2 * CG * 2048; e += NGT) { const int l = (int)(e / (CG * 2048)), g = (int)((e / 2048) % CG), r = (int)(e & 2047);
              s5_et_task(g, r >> 10, (r >> 4) & 63, r & 15, s_are + (size_t)l * CG * CS, s_aim + (size_t)l * CG * CS, s_ldt + (size_t)l * CG, s_bre + (size_t)l * CG * CS * CGD, s_bim + (size_t)l * CG * CS * CGD, ws + WS_S5 + (size_t)l * S5_L_STRIDE);
              s5_ft_task(g, r >> 7, (r >> 6) & 1, r & 63, s_are + (size_t)l * CG * CS, s_aim + (size_t)l * CG * CS, s_ldt + (size_t)l * CG, s_cre + (size_t)l * CG * CGD * CS, s_cim + (size_t)l * CG * CGD * CS, ws + WS_S5 + (size_t)l * S5_L_STRIDE); }
          for (size_t e = gt; e < (size_t)2 * CG * 64; e += NGT) { const int l = (int)(e / (CG * 64)), g = (int)((e / 64) % CG), el = 4096 + 32768 + (int)(e % 64);
              s5_table_elem(g, el, s_are + (size_t)l * CG * CS, s_aim + (size_t)l * CG * CS, s_ldt + (size_t)l * CG, s_bre + (size_t)l * CG * CS * CGD, s_bim + (size_t)l * CG * CS * CGD,
                            s_cre + (size_t)l * CG * CGD * CS, s_cim + (size_t)l * CG * CGD * CS, s_d + (size_t)l * CW, ws + WS_S5 + (size_t)l * S5_L_STRIDE); } }
        { const float* sw = INP(4); bf16_t* wsp = (bf16_t*)(ws + WS_WSP); for (size_t e = gt; e < (size_t)2 * 6 * 128 * 128; e += NGT) wsp[e] = f2bf(sw[e]); }
        { const float* fg = INP(25); const float* rgw = INP(26); const float* rew = INP(28); bf16_t* wrt = (bf16_t*)(ws + WS_WRT);
          for (size_t e = gt; e < (size_t)2 * 48 * D; e += NGT) { const int l = (int)(e / (48 * D)), n = (int)((e / D) % 48), k = (int)(e % D);
              int j = -1, lo = 0; if (n < 16) j = n; else if (n < 32) { j = n - 16; lo = 1; } else if (n < 36) j = 16 + (n - 32); else if (n < 40) { j = 16 + (n - 36); lo = 1; }
              float v = 0.f;
              if (j >= 0) { const float w = fg[(size_t)l * D + k] * (j < 4 ? rgw[((size_t)l * D + k) * 4 + j] : rew[(((size_t)l * 4 + ((j - 4) >> 2)) * D + k) * 4 + ((j - 4) & 3)]);
                  const float hi = bf2f(f2bf(w)); v = lo ? (w - hi) : w; }
              wrt[e] = f2bf(v); } }
        const float* xin = INP(0);
#pragma unroll 1
        for (int t = gw * 2; t < T; t += NGW * 2) {
            const f32x4* xr = (const f32x4*)(xin + (size_t)t * D) + lane; f32x4 v[2][4]; float s0 = 0.f, s1 = 0.f;
#pragma unroll
            for (int j = 0; j < 4; ++j) { v[0][j] = xr[64 * j]; v[1][j] = xr[256 + 64 * j]; }
#pragma unroll
            for (int j = 0; j < 4; ++j) { s0 += (v[0][j][0] * v[0][j][0] + v[0][j][1] * v[0][j][1]) + (v[0][j][2] * v[0][j][2] + v[0][j][3] * v[0][j][3]); s1 += (v[1][j][0] * v[1][j][0] + v[1][j][1] * v[1][j][1]) + (v[1][j][2] * v[1][j][2] + v[1][j][3] * v[1][j][3]); }
            u32x2* o8 = (u32x2*)(HB + (size_t)t * D) + lane;
#pragma unroll
            for (int j = 0; j < 4; ++j) { u32x2 w; w.x = cvt_pk_bf16(v[0][j][0], v[0][j][1]); w.y = cvt_pk_bf16(v[0][j][2], v[0][j][3]); o8[64 * j] = w; w.x = cvt_pk_bf16(v[1][j][0], v[1][j][1]); w.y = cvt_pk_bf16(v[1][j][2], v[1][j][3]); o8[256 + 64 * j] = w; }
            s0 = wave_sum(s0); s1 = wave_sum(s1);
            if (lane < 32) SSQ[(size_t)t * 16 + lane] = lane == 0 ? s0 : (lane == 16 ? s1 : 0.f);
        }
    }
    xcd_barrier(bar);

    for (int l = 0; l < DEPTH; ++l) {
        { PHASE_IDS(); unsigned char* ws = WSB(); bf16_t* WIN = (bf16_t*)(ws + WS_WIN); bf16_t* HB = (bf16_t*)(ws + WS_HB); float* SSQ = (float*)(ws + WS_SSQ); bf16_t* Z = (bf16_t*)(ws + WS_Z);
          pg8::StaticOrder<T, INC> S; S.init(HB, WIN + (size_t)l * INC * D, G, bid);
          pg8::EpiZ E{Z, SSQ};
          pg8::gemm_phase<pg8::EpiZ, pg8::StaticOrder<T, INC>, true, true>(lds, wave_s, S, E); }
        xcd_barrier(bar);

        {
            PHASE_IDS(); unsigned char* ws = WSB(); const bf16_t* Z = (const bf16_t*)(ws + WS_Z);
            const float* conv_w = INP(6) + (size_t)l * 4 * BW; const float* conv_b = INP(7) + (size_t)l * BW; const float* rg_b = INP(9) + (size_t)l * BW;
            const float* ig_b = INP(11) + (size_t)l * BW; const float* lam = INP(12) + (size_t)l * BW;
            __syncthreads();
            { const bf16_t* WRG = (const bf16_t*)(ws + WS_WRG) + ((size_t)l * 2 + 0) * 6 * 4096; const bf16_t* WIG = (const bf16_t*)(ws + WS_WRG) + ((size_t)l * 2 + 1) * 6 * 4096;
              for (int pr = bid; pr < NU128 / 2; pr += G) { float cp = 0.f;
                  rglru_unit<1>(2 * pr, true, cp, tid, wave, lane, Z, nullptr, WRG, WIG, conv_w, conv_b, rg_b, ig_b, lam, nullptr, (float*)(ws + WS_SUMA), (float*)(ws + WS_SUMH), (float*)(ws + WS_SUMA2), (float*)(ws + WS_SUMH2), (bf16_t*)(ws + WS_HL), (bf16_t*)(ws + WS_PP), lds);
                  rglru_unit<1>(2 * pr + 1, false, cp, tid, wave, lane, Z, nullptr, WRG, WIG, conv_w, conv_b, rg_b, ig_b, lam, nullptr, (float*)(ws + WS_SUMA), (float*)(ws + WS_SUMH), (float*)(ws + WS_SUMA2), (float*)(ws + WS_SUMH2), (bf16_t*)(ws + WS_HL), (bf16_t*)(ws + WS_PP), lds); } }
            for (int pr = bid; pr < NU128 / 2; pr += G) { const unsigned char* tab = ws + WS_S5 + (size_t)l * S5_L_STRIDE;
                s5_pair1(pr, 2 * wave, wave, lane, Z, (bf16_t*)(ws + WS_Y), tab, (float*)(ws + WS_SEND), (float*)(ws + WS_SEND2), (float*)(ws + WS_SE), lds);
                s5_pair1(pr, 2 * wave + 1, wave, lane, Z, (bf16_t*)(ws + WS_Y), tab, (float*)(ws + WS_SEND), (float*)(ws + WS_SEND2), (float*)(ws + WS_SE), lds); }
            __syncthreads();
            { const bf16_t* WSP = (const bf16_t*)(ws + WS_WSP) + (size_t)l * 6 * 128 * 128; const float* a_sb = INP(5) + (size_t)l * 6 * 128; const float* vg = INP(3) + (size_t)l * AW; const float* mo_ga = INP(23) + (size_t)l * D;
              for (int u = bid; u < NU128; u += G) mixa_unit(u, tid, wave, lane, Z, (bf16_t*)(ws + WS_Y), WSP, a_sb, vg, mo_ga, lds); }
        }
        xcd_barrier(bar);

        {
            PHASE_IDS(); unsigned char* ws = WSB(); const bf16_t* Z = (const bf16_t*)(ws + WS_Z); bf16_t* Y = (bf16_t*)(ws + WS_Y);
            const float* a_v_norm_g = INP(3) + (size_t)l * AW; const float* a_sw = INP(4) + (size_t)l * 6 * 128 * 128; const float* a_sb = INP(5) + (size_t)l * 6 * 128;
        }

        { PHASE_IDS(); unsigned char* ws = WSB(); const bf16_t* Z = (const bf16_t*)(ws + WS_Z); bf16_t* Y = (bf16_t*)(ws + WS_Y);
          { const float* mo_gb = INP(23) + (size_t)l * D + AW;
            __syncthreads();
            for (int pr = bid; pr < NU128 / 2; pr += G) rglru_fix_pair(pr, tid, wave, lane, Z, Y, (const bf16_t*)(ws + WS_HL), (const bf16_t*)(ws + WS_PP), (const float*)(ws + WS_SUMA2), (const float*)(ws + WS_SUMH2), mo_gb, lds); }
          { const bf16_t* WGLU = (const bf16_t*)(ws + WS_WGLU) + (size_t)l * CW * CW; const float* glu_b = INP(22) + (size_t)l * CW; const float* mo_gc = INP(23) + (size_t)l * D + AW + BW;
            for (int pr = bid; pr < NU128 / 2; pr += G) { float k0r = 0.f, k0i = 0.f, k1r = 0.f, k1i = 0.f; const unsigned char* tab = ws + WS_S5 + (size_t)l * S5_L_STRIDE;
#pragma unroll 1
                for (int ui = 0; ui < 2; ++ui) { const int u = 2 * pr + ui; __syncthreads();
                    s5_group<2>(u, 2 * wave, ui == 0, k0r, k0i, wave, lane, Z, Y, tab, (float*)(ws + WS_SEND), (float*)(ws + WS_SEND2), (float*)(ws + WS_SE), lds);
                    s5_group<2>(u, 2 * wave + 1, ui == 0, k1r, k1i, wave, lane, Z, Y, tab, (float*)(ws + WS_SEND), (float*)(ws + WS_SEND2), (float*)(ws + WS_SE), lds);
                    __syncthreads(); s5_glu(u, wave, lane, WGLU, glu_b, mo_gc, Y, lds); } } } }
        asm volatile("s_waitcnt vmcnt(0)" ::: "memory"); __syncthreads();
        if (wave_s0 == 0) { __builtin_amdgcn_fence(__ATOMIC_ACQUIRE, "agent"); asm volatile("s_waitcnt vmcnt(0)" ::: "memory"); }
        __syncthreads();

        { PHASE_IDS(); unsigned char* ws = WSB(); bf16_t* WOUT = (bf16_t*)(ws + WS_WOUT); bf16_t* HB = (bf16_t*)(ws + WS_HB); float* SSQ = (float*)(ws + WS_SSQ); bf16_t* Y = (bf16_t*)(ws + WS_Y);
          pg8::PanelOrder<T, 4> S; S.init(Y, WOUT + (size_t)l * D * D, G, bid);
          pg8::EpiRes<false> E{HB, SSQ, nullptr};
          pg8::gemm_phase<pg8::EpiRes<false>, pg8::PanelOrder<T, 4>, true, true>(lds, wave_s, S, E); }
        asm volatile("s_waitcnt vmcnt(0)" ::: "memory"); __syncthreads();
        if (wave_s0 == 0) { __builtin_amdgcn_fence(__ATOMIC_ACQUIRE, "agent"); asm volatile("s_waitcnt vmcnt(0)" ::: "memory"); }
        __syncthreads();

        { PHASE_IDS(); unsigned char* ws = WSB(); const bf16_t* HB = (const bf16_t*)(ws + WS_HB); const float* SSQ = (const float*)(ws + WS_SSQ); int* CLS = (int*)(ws + WS_CLS); float* G2 = (float*)(ws + WS_G2); int* HIST = (int*)(ws + WS_HIST);
          const float* rgb = INP(27) + (size_t)l * 4; const float* reb = INP(29) + (size_t)l * 16;
        if (l == 0) {
            for (int rr = gw; rr < 2 * NCLS * 2 * 1024 / 2; rr += NGW) { const int row = 2 * rr + (lane >> 5), n = row & 1023, half = (row >> 10) & 1, cls = (row >> 11) % NCLS, ll = row / (2048 * NCLS);
                const int g = cls / 6, pi = cls % 6, e = g * 4 + (half ? pair_hi(pi) : pair_lo(pi));
                const u32x4 v = *(const u32x4*)(ws + WS_WD8 + ((size_t)ll * NE + e) * 1024 * 512 + (size_t)n * 512 + (lane & 31) * 16);
                *(u32x4*)(ws + WS_WD2 + ((size_t)ll * NCLS + cls) * 1024 * 1024 + (size_t)n * 1024 + half * 512 + (lane & 31) * 16) = v; } }
        for (int u = bid; u < NU; u += G) {
            router_unit(u, wave, lane, HB, SSQ, (const bf16_t*)(ws + WS_WRT) + (size_t)l * 48 * D, rgb, reb, CLS, G2, lds, (LAS int*)(lds + LDSCTL_OFF) + LW_HIST);
            __syncthreads();
            if (tid < 32) { HIST[u * 32 + tid] = tid < NCLS ? LWI[LW_HIST + tid] : 0; LWI[LW_HIST + tid] = 0; }
            __syncthreads();
        } }
        xcd_barrier(bar);

        { PHASE_IDS(); unsigned char* ws = WSB(); const bf16_t* HB = (const bf16_t*)(ws + WS_HB); const float* SSQ = (const float*)(ws + WS_SSQ); const int* CLS = (const int*)(ws + WS_CLS); const float* G2 = (const float*)(ws + WS_G2); const int* HIST = (const int*)(ws + WS_HIST);
          int* CTOT = (int*)(ws + WS_CTOT); int* ROWTOK = (int*)(ws + WS_ROWTOK); float* ROWG = (float*)(ws + WS_ROWG); bf16_t* HBS = (bf16_t*)(ws + WS_HBS); const float* ffn_g = INP(25) + (size_t)l * D;
        for (int u = bid; u < NU; u += G) {
            { const int c = tid & 31, part = tid >> 5; int tot = 0, pre = 0;
_Pragma("unroll 16")
              for (int k = part * 16; k < part * 16 + 16; ++k) { const int v = HIST[k * 32 + c]; tot += v; pre += k < u ? v : 0; }
              ((volatile LAS int*)lds)[tid] = tot; ((volatile LAS int*)lds)[512 + tid] = pre; }
            __syncthreads();
            if (tid < NCLS) { int tot = 0, pre = 0;
_Pragma("unroll")
                for (int k = 0; k < 16; ++k) { tot += ((volatile LAS int*)lds)[k * 32 + tid]; pre += ((volatile LAS int*)lds)[512 + k * 32 + tid]; } LWI[LW_TOT + tid] = tot; LWI[LW_BASE + tid] = pre; }
            __syncthreads();
            if (tid == 0) { int ps = 0;
_Pragma("unroll 1")
                for (int c = 0; c < NCLS; ++c) { const int tot = LWI[LW_TOT + c]; LWI[LW_BASE + c] += ps; LWI[LW_TST + c] = ps; ps += ((tot + 255) >> 8) << 8; if (bid == 0) CTOT[c] = tot; } LWI[LW_TST + NCLS] = ps; }
            if (tid < UT) LWI[LW_CLS + tid] = CLS[u * UT + tid];
            __syncthreads();
            if (tid < UT) { const int cls = LWI[LW_CLS + tid]; int rank = 0;
_Pragma("unroll 1")
                for (int i = 0; i < tid; ++i) rank += LWI[LW_CLS + i] == cls ? 1 : 0;
                const int dest = LWI[LW_BASE + cls] + rank; LWI[LW_DEST + tid] = dest; const int t = u * UT + tid;
                ROWTOK[dest] = t; ROWG[(size_t)dest * 2 + 0] = G2[(size_t)t * 2 + 0]; ROWG[(size_t)dest * 2 + 1] = G2[(size_t)t * 2 + 1]; }
            __syncthreads();
            { f32x4 gq[4];
#pragma unroll
              for (int j = 0; j < 4; ++j) gq[j] = *(const f32x4*)(ffn_g + lane * 16 + 4 * j);
#pragma unroll 1
              for (int i = 0; i < 32; i += 4) {
                  const int tl0 = wave * 32 + i, t0r = u * UT + tl0;
                  float sq = SSQ[(size_t)t0r * 16 + lane]; sq += x_xor1(sq); sq += x_xor2(sq); sq += x_hmir(sq); sq += x_mir(sq);
                  u32x4 o[4][2]; int dst[4];
#pragma unroll
                  for (int j = 0; j < 4; ++j) { o[j][0] = *(const u32x4*)(HB + (size_t)(t0r + j) * D + lane * 16); o[j][1] = *(const u32x4*)(HB + (size_t)(t0r + j) * D + lane * 16 + 8); dst[j] = LWI[LW_DEST + tl0 + j]; }
#pragma unroll
                  for (int j = 0; j < 4; ++j) { const float r4 = rsqrtf(__builtin_amdgcn_readlane(sq, 16 * j) * (1.0f / D) + EPS) * pg8::FS_H; u32x4 w;
#pragma unroll
                      for (int hh = 0; hh < 2; ++hh) { const u32x4 oo = o[j][hh]; const f32x4 g0 = gq[2 * hh], g1 = gq[2 * hh + 1];
                          const unsigned lo = pk_fp8x4(__uint_as_float(oo.x << 16) * r4 * g0[0], __uint_as_float(oo.x & 0xffff0000u) * r4 * g0[1], __uint_as_float(oo.y << 16) * r4 * g0[2], __uint_as_float(oo.y & 0xffff0000u) * r4 * g0[3]);
                          const unsigned hi = pk_fp8x4(__uint_as_float(oo.z << 16) * r4 * g1[0], __uint_as_float(oo.z & 0xffff0000u) * r4 * g1[1], __uint_as_float(oo.w << 16) * r4 * g1[2], __uint_as_float(oo.w & 0xffff0000u) * r4 * g1[3]);
                          if (hh == 0) { w.x = lo; w.y = hi; } else { w.z = lo; w.w = hi; } }
                      *(u32x4*)((unsigned char*)HBS + (size_t)dst[j] * D + lane * 16) = w; } } }
            if (u == bid)
_Pragma("unroll 1")
            for (int c = bid; c < NCLS; c += G) { const int tot = LWI[LW_TOT + c], r0 = LWI[LW_TST + c] + tot, r1 = LWI[LW_TST + c + 1];
                unsigned zz = 0u; asm volatile("" : "+v"(zz));
                for (int r = r0 + wave; r < r1; r += 8) { if (lane == 0) { ROWTOK[r] = -1; ROWG[(size_t)r * 2] = __uint_as_float(zz); ROWG[(size_t)r * 2 + 1] = __uint_as_float(zz); }
                    *(u32x4*)((unsigned char*)HBS + (size_t)r * D + lane * 16) = (u32x4){zz, zz, zz, zz}; } }
            __syncthreads();
        } }
        xcd_barrier(bar);

        { PHASE_IDS(); unsigned char* ws = WSB(); const int* CTOT = (const int*)(ws + WS_CTOT); bf16_t* HBS = (bf16_t*)(ws + WS_HBS); bf16_t* WGU = (bf16_t*)(ws + WS_WGU); bf16_t* ACT = (bf16_t*)(ws + WS_ACT); const float* ROWG = (const float*)(ws + WS_ROWG);
        if (tid == 0) { int ps = 0;
_Pragma("unroll 1")
            for (int c = 0; c < NCLS; ++c) { LWI[LW_TST + c] = ps; ps += (CTOT[c] + 255) >> 8; } LWI[LW_TST + NCLS] = ps; }
        __syncthreads();
        if (tid < 32) { const int ntile = LWI[LW_TST + NCLS]; const long L = (long)tid * G + bid; int e = -1;
            if (L < (long)ntile * 8) { const int nwg = ntile * 8, qq = nwg / 8, rr = nwg % 8, xcd = (int)(L % 8), off = (int)(L / 8); const int Lr = (xcd < rr ? xcd * (qq + 1) : rr * (qq + 1) + (xcd - rr) * qq) + off;
                const int mt = Lr / 8, pn = Lr % 8; int cls = 0;
_Pragma("unroll 1")
                for (int k = 1; k < NCLS; ++k) cls += (LWI[LW_TST + k] <= mt) ? 1 : 0;
                e = (cls << 24) | (pn << 16) | mt; }
            LWI[LW_UTAB + tid] = e; e = -1;
            if (L < (long)ntile * 4) { const int nwg = ntile * 4, qq = nwg / 8, rr = nwg % 8, xcd = (int)(L % 8), off = (int)(L / 8); const int Lr = (xcd < rr ? xcd * (qq + 1) : rr * (qq + 1) + (xcd - rr) * qq) + off;
                const int mt = Lr / 4, pn = Lr % 4; int cls = 0;
_Pragma("unroll 1")
                for (int k = 1; k < NCLS; ++k) cls += (LWI[LW_TST + k] <= mt) ? 1 : 0;
                e = (cls << 24) | (pn << 16) | mt; }
            LWI[LW_DTAB + tid] = e; }
        __syncthreads();
        { pg8::MoeOrder<8, true, 1024> S{LWI + LW_UTAB, l, (const char*)HBS, (const char*)WGU};
          pg8::EpiUp E{(unsigned char*)ACT, ROWG};
          pg8::gemm_phase<pg8::EpiUp, pg8::MoeOrder<8, true, 1024>, true, true, 512, true>(lds, wave_s, S, E); } }
        xcd_barrier(bar);

        { PHASE_IDS(); unsigned char* ws = WSB(); bf16_t* ACT = (bf16_t*)(ws + WS_ACT); bf16_t* WD2 = (bf16_t*)(ws + WS_WD2); bf16_t* HB = (bf16_t*)(ws + WS_HB); float* SSQ = (float*)(ws + WS_SSQ); const int* ROWTOK = (const int*)(ws + WS_ROWTOK);
          pg8::MoeOrder<4, false, 1024> S{LWI + LW_DTAB, l, (const char*)ACT, (const char*)WD2};
          pg8::EpiRes<true> E{HB, SSQ, ROWTOK};
          pg8::gemm_phase<pg8::EpiRes<true>, pg8::MoeOrder<4, false, 1024>, true, true, 512, true>(lds, wave_s, S, E); }
        xcd_barrier(bar);
    }

    { PHASE_IDS(); unsigned char* ws = WSB(); const bf16_t* HB = (const bf16_t*)(ws + WS_HB); const float* SSQ = (const float*)(ws + WS_SSQ); const float* fg = INP(33); float* outp = a.out;
    { f32x4 gq[4];
#pragma unroll
      for (int j = 0; j < 4; ++j) gq[j] = *(const f32x4*)(fg + lane * 16 + 4 * j);
#pragma unroll 1
      for (int t0r = gw * 4; t0r < T; t0r += NGW * 4) {
          float sq = SSQ[(size_t)t0r * 16 + lane]; sq += x_xor1(sq); sq += x_xor2(sq); sq += x_hmir(sq); sq += x_mir(sq);
          u32x4 o[4][2];
#pragma unroll
          for (int j = 0; j < 4; ++j) { o[j][0] = *(const u32x4*)(HB + (size_t)(t0r + j) * D + lane * 16); o[j][1] = *(const u32x4*)(HB + (size_t)(t0r + j) * D + lane * 16 + 8); }
#pragma unroll
          for (int j = 0; j < 4; ++j) { const float r = rsqrtf(__builtin_amdgcn_readlane(sq, 16 * j) * (1.0f / D) + EPS); float* orow = outp + (size_t)(t0r + j) * D + lane * 16;
#pragma unroll
              for (int hh = 0; hh < 2; ++hh) { const u32x4 oo = o[j][hh]; const f32x4 g0 = gq[2 * hh], g1 = gq[2 * hh + 1]; f32x4 w0, w1;
                  w0[0] = __uint_as_float(oo.x << 16) * r * g0[0]; w0[1] = __uint_as_float(oo.x & 0xffff0000u) * r * g0[1]; w0[2] = __uint_as_float(oo.y << 16) * r * g0[2]; w0[3] = __uint_as_float(oo.y & 0xffff0000u) * r * g0[3];
                  w1[0] = __uint_as_float(oo.z << 16) * r * g1[0]; w1[1] = __uint_as_float(oo.z & 0xffff0000u) * r * g1[1]; w1[2] = __uint_as_float(oo.w << 16) * r * g1[2]; w1[3] = __uint_as_float(oo.w & 0xffff0000u) * r * g1[3];
                  *(f32x4*)(orow + 8 * hh) = w0; *(f32x4*)(orow + 8 * hh + 4) = w1; } } } }
}
}

extern "C" void kernel_launch(void* const* d_in, const int* in_sizes, int n_in, void* d_out, int out_size, void* d_ws, size_t ws_size, hipStream_t stream) {
    static int grid = 0;
    if (grid == 0) {
        if (n_in != 34 || in_sizes[0] != T * D || out_size != T * D || ws_size < WS_END) { fprintf(stderr, "kernel_launch: unexpected shapes (n_in %d, ws %zu)\n", n_in, ws_size); grid = -1; return; }
        int dev = 0, cus = 0, per_cu = 0;
        if (hipGetDevice(&dev) != hipSuccess || hipDeviceGetAttribute(&cus, hipDeviceAttributeMultiprocessorCount, dev) != hipSuccess) { grid = -1; return; }
        if (hipFuncSetAttribute((const void*)mega_fwd, hipFuncAttributeMaxDynamicSharedMemorySize, LDS_BYTES) != hipSuccess) { fprintf(stderr, "kernel_launch: hipFuncSetAttribute failed\n"); grid = -1; return; }
        if (hipOccupancyMaxActiveBlocksPerMultiprocessor(&per_cu, (const void*)mega_fwd, 512, LDS_BYTES) != hipSuccess || per_cu < 1) { fprintf(stderr, "kernel_launch: occupancy query says %d\n", per_cu); }
        (void)hipGetLastError();
        grid = cus;
    }
    if (grid < 0) return;
    (void)hipMemsetAsync((char*)d_ws + WS_CTL, 0, CTL_ZERO_BYTES, stream);
    Args a{};
    for (int i = 0; i < 34; ++i) a.in[i] = (const float*)d_in[i];
    a.out = (float*)d_out; a.ws = (unsigned char*)d_ws;
    hipLaunchKernelGGL(mega_fwd, dim3(grid), dim3(512), LDS_BYTES, stream, a);
}
```

```cpp
#include <hip/hip_runtime.h>
#include <cstdio>
#include <cstdint>

#define LAS __attribute__((address_space(3)))
typedef unsigned short bf16_t;
typedef short bf16x8 __attribute__((ext_vector_type(8)));
typedef float f32x4 __attribute__((ext_vector_type(4)));
typedef float f32x2 __attribute__((ext_vector_type(2)));
typedef unsigned u32x4 __attribute__((ext_vector_type(4)));
typedef unsigned u32x2 __attribute__((ext_vector_type(2)));
typedef int i32x4 __attribute__((ext_vector_type(4)));
typedef int i32x8 __attribute__((ext_vector_type(8)));

constexpr int D = 1024, BATCH = 8, SEQ = 8192, T = BATCH * SEQ, DEPTH = 2;
constexpr int AW = 384, BW = 384, CW = 256, HD = 64, ABLK = 128, CHUNK = 64;
constexpr int INC = 1792;
constexpr int ZU = 0, ZV = 384, ZG = 768, ZX = 1152, ZC = 1536, ZGELU_END = 1152;
constexpr int CG = 16, CGD = 16, CS = 64;
constexpr int NE = 16, DE = 512, NCLS = 24;
constexpr float EPS = 1e-6f;
constexpr int UT = 256;
constexpr int NU = T / UT;
constexpr int MAXROWS = T + NCLS * 256;

constexpr size_t MiB = 1u << 20;
constexpr size_t WS_CTL = 0, CTL_ZERO_BYTES = 1 * MiB;
constexpr size_t WS_WIN = 2 * MiB;
constexpr size_t WS_WOUT = 10 * MiB;
constexpr size_t WS_WGLU = 14 * MiB;
constexpr size_t WS_WRG = 15 * MiB;
constexpr size_t WS_WSP = 15 * MiB + 256 * 1024;
constexpr size_t WS_WRT = 15 * MiB + 768 * 1024;
constexpr size_t WS_WGU = 16 * MiB;
constexpr size_t WS_WD8 = 48 * MiB;
constexpr size_t WS_WD2 = 80 * MiB;
constexpr size_t WS_SSQ = 176 * MiB;
constexpr size_t WS_RS = 180 * MiB;
constexpr size_t WS_CLS = WS_RS + 256 * 1024;
constexpr size_t WS_G2 = WS_CLS + 256 * 1024;
constexpr size_t WS_HIST = 181 * MiB;
constexpr size_t WS_CTOT = WS_HIST + 64 * 1024;
constexpr size_t WS_ROWTOK = WS_HIST + 256 * 1024;
constexpr size_t WS_ROWG = 182 * MiB;
constexpr size_t WS_SUMA = 183 * MiB;
constexpr size_t WS_SUMH = 191 * MiB;
constexpr size_t WS_S5 = 184 * MiB;
constexpr size_t WS_SEND = 187 * MiB;
constexpr size_t WS_HB = 192 * MiB;
constexpr size_t WS_Z = 320 * MiB;
constexpr size_t WS_HBS = WS_Z;
constexpr size_t WS_Y = 544 * MiB;
constexpr size_t WS_ACT = 672 * MiB;
constexpr size_t WS_HL = 672 * MiB;
constexpr size_t WS_PP = 736 * MiB;
constexpr size_t WS_SE = 800 * MiB;
constexpr size_t WS_AV = 672 * MiB;
constexpr size_t WS_BV = 768 * MiB;
constexpr size_t WS_SEND2 = 864 * MiB;
constexpr size_t WS_SUMA2 = 866 * MiB;
constexpr size_t WS_SUMH2 = 867 * MiB;
constexpr size_t WS_END = 868 * MiB;
constexpr int CW_BAR = 4096;

constexpr int RING_BYTES = 131072;
constexpr int LDSCTL_OFF = 143360;
constexpr int LDS_PF = 147456;
constexpr int LDS_BYTES = 163840;
constexpr int LW_BAR = 8, LW_TST = 64, LW_HIST = 96, LW_TOT = 128, LW_BASE = 160, LW_CLS = 256  , LW_DEST = 512  , LW_UTAB = 768  , LW_DTAB = 800  ;

__device__ __forceinline__ float bf2f(bf16_t v) { return __uint_as_float(((unsigned)v) << 16); }
__device__ __forceinline__ unsigned cvt_pk_bf16(float lo, float hi) { unsigned r; asm volatile("v_cvt_pk_bf16_f32 %0, %1, %2" : "=v"(r) : "v"(lo), "v"(hi)); return r; }
__device__ __forceinline__ bf16_t f2bf(float v) { return (bf16_t)(cvt_pk_bf16(v, 0.f) & 0xffffu); }
__device__ __forceinline__ unsigned pk_fp8x4(float a, float b, float c, float d) {
    a = fminf(fmaxf(a, -448.f), 448.f); b = fminf(fmaxf(b, -448.f), 448.f); c = fminf(fmaxf(c, -448.f), 448.f); d = fminf(fmaxf(d, -448.f), 448.f);
    int r = __builtin_amdgcn_cvt_pk_fp8_f32(a, b, 0, false); r = __builtin_amdgcn_cvt_pk_fp8_f32(c, d, r, true); return (unsigned)r; }
__device__ __forceinline__ int fresh_lane() { unsigned z = 0u; asm volatile("" : "+s"(z)); return (int)__builtin_amdgcn_mbcnt_hi(~0u, __builtin_amdgcn_mbcnt_lo(~0u, z)); }
__device__ __forceinline__ float x_xor1(float v) { return __int_as_float(__builtin_amdgcn_update_dpp(0, __float_as_int(v), 0xB1, 0xf, 0xf, true)); }
__device__ __forceinline__ float x_xor2(float v) { return __int_as_float(__builtin_amdgcn_update_dpp(0, __float_as_int(v), 0x4E, 0xf, 0xf, true)); }
__device__ __forceinline__ float x_hmir(float v) { return __int_as_float(__builtin_amdgcn_update_dpp(0, __float_as_int(v), 0x141, 0xf, 0xf, true)); }
__device__ __forceinline__ float x_mir(float v) { return __int_as_float(__builtin_amdgcn_update_dpp(0, __float_as_int(v), 0x140, 0xf, 0xf, true)); }
__device__ __forceinline__ float x_xor16(float v) { return __int_as_float(__builtin_amdgcn_ds_swizzle(__float_as_int(v), 0x401F)); }
__device__ __forceinline__ float add_xor32(float v) { const auto r = __builtin_amdgcn_permlane32_swap(__float_as_uint(v), __float_as_uint(v), false, false); return __uint_as_float(r[0]) + __uint_as_float(r[1]); }
__device__ __forceinline__ float add_x16_x32(float v) { v += x_xor16(v); return add_xor32(v); }
__device__ __forceinline__ float wave_sum(float v) { v += x_xor1(v); v += x_xor2(v); v += x_hmir(v); v += x_mir(v); v += x_xor16(v); return add_xor32(v); }
__device__ __forceinline__ float gelu_fast(float x) {
    const float u2 = 1.5957691216057308f * (x + 0.044715f * x * x * x);
    const float e = __builtin_amdgcn_exp2f(-1.4426950408889634f * u2);
    return x * __builtin_amdgcn_rcpf(1.0f + e);
}
__device__ __forceinline__ float sigmoid_fast(float x) { return __builtin_amdgcn_rcpf(1.0f + __builtin_amdgcn_exp2f(-1.4426950408889634f * x)); }
__device__ __forceinline__ float sigmoid_f(float x) { return 1.0f / (1.0f + expf(-x)); }
__device__ __forceinline__ int pair_lo(int pi) { return pi < 3 ? 0 : (pi < 5 ? 1 : 2); }
__device__ __forceinline__ int pair_hi(int pi) { return pi < 3 ? pi + 1 : (pi < 5 ? pi - 1 : 3); }
__device__ __forceinline__ int pair_idx(int lo, int hi) { return lo == 0 ? hi - 1 : (lo == 1 ? hi + 1 : 5); }

#define XB_TMO      128
#define XB_XCNT(j)  (256  + 64 * (j))
#define XB_XSUB(j)  (1280 + 64 * (j))
#define XB_XGEN(j)  (2304 + 64 * (j))
#define XB_TOP      3328
#define XB_TOPGEN   3392
#define XCD_BAR_WORDS 3456
#define XB_SPIN_CAP (1u << 18)
__device__ __forceinline__ unsigned xb_ld(unsigned* p)              { return __hip_atomic_load(p, __ATOMIC_RELAXED, __HIP_MEMORY_SCOPE_AGENT); }
__device__ __forceinline__ unsigned xb_add(unsigned* p, unsigned v) { return __hip_atomic_fetch_add(p, v, __ATOMIC_RELAXED, __HIP_MEMORY_SCOPE_AGENT); }
__device__ __forceinline__ unsigned xb_xcc_id() { return (unsigned)__builtin_amdgcn_s_getreg((3 << 11) | 20) & 0xFu; }
#define XB_SPIN(cond, bar) do { unsigned _sp = 0; while (cond) { __builtin_amdgcn_s_sleep(1); \
    if ((++_sp & 255u) == 0u) { if (xb_ld(&(bar)[XB_TMO])) break; if (_sp > XB_SPIN_CAP) { atomicAdd(&(bar)[XB_TMO], 1u); break; } } } } while (0)
struct XcdBarrier { unsigned* bar; unsigned x; volatile LAS unsigned* st; };
__device__ __forceinline__ XcdBarrier xcd_barrier_post(unsigned* bar, volatile LAS unsigned* st) {
    XcdBarrier b; b.bar = bar; b.x = xb_xcc_id(); b.st = st;
    if (threadIdx.x == 0) (void)xb_add(&bar[XB_XCNT(b.x)], 1u);
    return b;
}
__device__ __forceinline__ void xcd_barrier_complete(unsigned* bar, unsigned x, unsigned& nloc, unsigned& nx) {
    const unsigned G = gridDim.x * gridDim.y * gridDim.z;
    unsigned sum, cnt, mine, sp = 0u;
    for (;;) {
        sum = 0u; cnt = 0u; mine = 0u;
#pragma unroll
        for (unsigned j = 0; j < 16; ++j) { const unsigned c = xb_ld(&bar[XB_XCNT(j)]); sum += c; cnt += (c > 0u) ? 1u : 0u; mine = (j == x) ? c : mine; }
        if (sum == G) break;
        __builtin_amdgcn_s_sleep(1);
        if ((++sp & 255u) == 0u) { if (xb_ld(&bar[XB_TMO])) break; if (sp > XB_SPIN_CAP) { atomicAdd(&bar[XB_TMO], 1u); break; } }
    }
    nloc = mine > 0u ? mine : 1u; nx = cnt > 0u ? cnt : 1u;
}
__device__ __forceinline__ void xcd_barrier(const XcdBarrier& b) {
    asm volatile("s_waitcnt vmcnt(0)" ::: "memory");
    __syncthreads();
    if (threadIdx.x == 0) {
        unsigned* bar = b.bar; asm volatile("" : "+s"(bar));
        __builtin_amdgcn_s_waitcnt(0);
        unsigned bx0 = b.x; asm volatile("" : "+s"(bx0));
        unsigned nloc = b.st[0], nx = b.st[1];
        if (nloc == 0u) { xcd_barrier_complete(bar, bx0, nloc, nx); b.st[0] = nloc; b.st[1] = nx; }
        unsigned bx = b.x; asm volatile("" : "+s"(bx));
        const unsigned old = xb_add(&bar[XB_XSUB(bx)], 1u);
        const unsigned gen = old / nloc;
        if (old + 1u == (gen + 1u) * nloc) {
            __builtin_amdgcn_fence(__ATOMIC_RELEASE, "agent");
            asm volatile("s_waitcnt vmcnt(0)" ::: "memory");
            const unsigned og = xb_add(&bar[XB_TOP], 1u);
            const unsigned tg = og / nx;
            if (og + 1u == (tg + 1u) * nx) xb_add(&bar[XB_TOPGEN], 1u);
            else XB_SPIN(xb_ld(&bar[XB_TOPGEN]) == tg, bar);
            __builtin_amdgcn_fence(__ATOMIC_ACQUIRE, "agent");
            xb_add(&bar[XB_XGEN(bx)], 1u);
            asm volatile("s_waitcnt vmcnt(0)" ::: "memory");
        } else {
            XB_SPIN(xb_ld(&bar[XB_XGEN(bx)]) == gen, bar);
            __builtin_amdgcn_fence(__ATOMIC_ACQUIRE, "agent");
            asm volatile("s_waitcnt vmcnt(0)" ::: "memory");
        }
    }
    __syncthreads();
}

namespace pg8 {
#define PG8_LAS __attribute__((address_space(3)))
constexpr int BM = 256, BK = 64, HALF = 128, HTB = HALF * BK * 2, STAGE_BYTES = 8 * HTB, NXCD = 8, WGM = 4;
__host__ __device__ __forceinline__ int lds_byte(int r, int c) { const int st = (r >> 4) * 2 + (c >> 5), rr = r & 15, cc = c & 31, ob = rr * 64 + cc * 2; return st * 1024 + (ob ^ (((ob >> 9) & 1) << 5)); }
__host__ __device__ __forceinline__ void stage_rc(int b, int& R, int& C) { const int st = b / 1024, sb = b % 1024, swz = sb ^ (((sb >> 9) & 1) << 5); R = (st >> 1) * 16 + swz / 64; C = (st & 1) * 32 + (swz % 64) / 2; }
__host__ __device__ __forceinline__ int perm32(int rho) { const int n = rho >> 4, i = rho & 15; return 8 * (i >> 2) + 4 * n + (i & 3); }
struct Unit { int pm, pn; const char* A; const char* B; };

template <int M_, int NN> struct PanelOrder {
    static constexpr int nM = M_ / BM; static constexpr size_t tstep = (size_t)BM * 1024 * 2;
    int G, c; const char* A; const char* Bt;
    __device__ void init(const void* A_, const void* Bt_, int G_, int c_) { G = G_; c = c_; A = (const char*)A_; Bt = (const char*)Bt_; }
    __device__ bool next(int i, Unit& u) const { const int pm = c + (i / NN) * G; if (pm >= nM) return false; u.pm = pm; u.pn = i % NN; u.A = A + (size_t)pm * tstep; u.B = Bt + (size_t)u.pn * tstep; return true; }
    __device__ __forceinline__ void a_ready(const Unit&) const {}
    __device__ __forceinline__ void done(const Unit&) const {}
};
template <int M_, int N_> struct StaticOrder {
    static constexpr int nM = M_ / BM, nN = N_ / BM, nwg = nM * nN; static constexpr size_t tstep = (size_t)BM * 1024 * 2;
    int G, c; const char* A; const char* Bt;
    __device__ void init(const void* A_, const void* Bt_, int G_, int c_) { G = G_; c = c_; A = (const char*)A_; Bt = (const char*)Bt_; }
    __device__ bool next(int i, Unit& u) const {
        const long L = (long)i * G + c; if (L >= nwg) return false;
        int wgid = (int)L; { constexpr int q = nwg / NXCD, r = nwg % NXCD; const int xcd = wgid % NXCD, off = wgid / NXCD; wgid = (xcd < r ? xcd * (q + 1) : r * (q + 1) + (xcd - r) * q) + off; }
        constexpr int nig = WGM * nN; const int gid = wgid / nig, fm = gid * WGM, gsz = (nM - fm) < WGM ? (nM - fm) : WGM;
        u.pm = fm + ((wgid % nig) % gsz); u.pn = (wgid % nig) / gsz; u.A = A + (size_t)u.pm * tstep; u.B = Bt + (size_t)u.pn * tstep; return true;
    }
    __device__ __forceinline__ void a_ready(const Unit&) const {}
    __device__ __forceinline__ void done(const Unit&) const {}
};
template <class Epi, class Sched, bool ALIGN_EPI = false, bool SP2 = false, int KB = 1024, bool FP8 = false>
__device__ __forceinline__ void gemm_phase(PG8_LAS unsigned char* lds, const int wave_s, const Sched& S, const Epi& E) { const int Kdim = 0;
    const int lane = fresh_lane(), wid = wave_s, tid = wid * 64 + lane, wr = wid >> 2, wc = wid & 3, fr = lane & 15, fq = lane >> 4;
    constexpr int K = KB, nt = K / BK; (void)Kdim;
    unsigned voffA, voffB;
    { int R, C; stage_rc(tid * 16, R, C); const int Rb = Epi::PERM ? ((R & ~31) + perm32(R & 31)) : R; voffA = (unsigned)(R * K + C) * 2u; voffB = (unsigned)(Rb * K + C) * 2u; }
    constexpr size_t kstep = (size_t)(BK * 2);
    constexpr size_t hstep = (size_t)HALF * K * 2;
    constexpr size_t tstep = 2 * hstep; (void)tstep;
    const unsigned ldsw = (unsigned)wid * 1024u; const unsigned ldsb = (unsigned)(size_t)lds + ldsw;
    const int aoff = lds_byte(wr * 64 + fr, fq * 8), boff = lds_byte(wc * 32 + fr, fq * 8);
#define PG8_SA(b, h) (((b) * 2 + (h)) * HTB)
#define PG8_SB(b, h) ((4 + (b) * 2 + (h)) * HTB)
#define PG8_STAGE(bufoff, gbase, voff) do { _Pragma("unroll") for (int _i = 0; _i < 2; ++_i) { unsigned _keep; \
        asm volatile("s_mov_b32 %0, m0\n\ts_mov_b32 m0, %3\n\ts_nop 0\n\tglobal_load_lds_dwordx4 %1, %2\n\ts_mov_b32 m0, %0" : "=&s"(_keep) \
            : "v"(voff), "s"((const char*)(gbase) + (size_t)_i * (64 * K * 2)), "s"(ldsb + (unsigned)((bufoff) + _i * 8192)) : "memory"); } } while (0)
#define PG8_LDA(dst, b, h) do { if constexpr (FP8) { _Pragma("unroll") for (int m = 0; m < 4; ++m) { const i32x4 _lo = *(const PG8_LAS i32x4*)(lds + PG8_SA(b, h) + aoff + m * 2048), _hi = *(const PG8_LAS i32x4*)(lds + PG8_SA(b, h) + aoff + m * 2048 + 1024); \
            dst##8[m] = __builtin_shufflevector(_lo, _hi, 0, 1, 2, 3, 4, 5, 6, 7); } } \
        else { _Pragma("unroll") for (int m = 0; m < 4; ++m) _Pragma("unroll") for (int k = 0; k < 2; ++k) dst[m][k] = *(const PG8_LAS bf16x8*)(lds + PG8_SA(b, h) + aoff + m * 2048 + k * 1024); } } while (0)
#define PG8_LDB(dst, b, h) do { if constexpr (FP8) { _Pragma("unroll") for (int n = 0; n < 2; ++n) { const i32x4 _lo = *(const PG8_LAS i32x4*)(lds + PG8_SB(b, h) + boff + n * 2048), _hi = *(const PG8_LAS i32x4*)(lds + PG8_SB(b, h) + boff + n * 2048 + 1024); \
            dst##8[n] = __builtin_shufflevector(_lo, _hi, 0, 1, 2, 3, 4, 5, 6, 7); } } \
        else { _Pragma("unroll") for (int n = 0; n < 2; ++n) _Pragma("unroll") for (int k = 0; k < 2; ++k) dst[n][k] = *(const PG8_LAS bf16x8*)(lds + PG8_SB(b, h) + boff + n * 2048 + k * 1024); } } while (0)
#define PG8_MMA(ai, bj, At, Bt) do { __builtin_amdgcn_s_setprio(1); \
        if constexpr (FP8) { _Pragma("unroll") for (int m = 0; m < 4; ++m) _Pragma("unroll") for (int n = 0; n < 2; ++n) \
            acc[ai][bj][m][n] = __builtin_amdgcn_mfma_scale_f32_16x16x128_f8f6f4(Bt##8[n], At##8[m], acc[ai][bj][m][n], 0, 0, 0, Epi::SCALE_W, 0, Epi::SCALE_A); } \
        else { _Pragma("unroll") for (int m = 0; m < 4; ++m) _Pragma("unroll") for (int n = 0; n < 2; ++n) _Pragma("unroll") for (int k = 0; k < 2; ++k) \
            acc[ai][bj][m][n] = __builtin_amdgcn_mfma_f32_16x16x32_bf16(Bt[n][k], At[m][k], acc[ai][bj][m][n], 0, 0, 0); } \
        __builtin_amdgcn_s_setprio(0); } while (0)
#define PG8_WAIT_V(n) asm volatile("s_waitcnt vmcnt(" #n ")" ::: "memory")
#define PG8_WAIT_L(n) asm volatile("s_waitcnt lgkmcnt(" #n ")" ::: "memory")
#define PG8_BAR __builtin_amdgcn_s_barrier()
#define PG8_SCHED __builtin_amdgcn_sched_barrier(0)
    Unit cur, nxt; int ui = 0;
    if (!S.next(0, cur)) return;
    f32x4 acc[2][2][4][2];
#pragma unroll
    for (int a = 0; a < 2; ++a)
#pragma unroll
        for (int b = 0; b < 2; ++b)
#pragma unroll
            for (int m = 0; m < 4; ++m)
#pragma unroll
                for (int n = 0; n < 2; ++n) acc[a][b][m][n] = (f32x4){0.f, 0.f, 0.f, 0.f};
    bf16x8 At[4][2], B0[2][2], B1[2][2]; i32x8 At8[4], B08[2], B18[2]; (void)At; (void)B0; (void)B1; (void)At8; (void)B08; (void)B18;
    const char* cA = cur.A; const char* cB = cur.B;
    S.a_ready(cur);
    if constexpr (SP2) {
        PG8_STAGE(PG8_SB(0, 0), cB, voffB); PG8_STAGE(PG8_SB(0, 1), cB + hstep, voffB); PG8_STAGE(PG8_SA(0, 0), cA, voffA); PG8_STAGE(PG8_SA(0, 1), cA + hstep, voffA);
        if (wr == 1) PG8_BAR;
        PG8_WAIT_V(2); PG8_BAR;
        PG8_STAGE(PG8_SB(1, 0), cB + kstep, voffB); PG8_STAGE(PG8_SA(1, 0), cA + kstep, voffA); PG8_STAGE(PG8_SB(1, 1), cB + hstep + kstep, voffB);
        PG8_WAIT_V(6); PG8_BAR;
    } else {
        PG8_STAGE(PG8_SB(0, 0), cB, voffB); PG8_STAGE(PG8_SA(0, 0), cA, voffA); PG8_STAGE(PG8_SB(0, 1), cB + hstep, voffB); PG8_STAGE(PG8_SA(0, 1), cA + hstep, voffA);
        if (wr == 1) PG8_BAR;
        PG8_WAIT_V(4); PG8_BAR;
        PG8_STAGE(PG8_SB(1, 0), cB + kstep, voffB); PG8_STAGE(PG8_SA(1, 0), cA + kstep, voffA); PG8_STAGE(PG8_SB(1, 1), cB + hstep + kstep, voffB);
        PG8_WAIT_V(6); PG8_BAR;
    }
    for (;;) {
        const bool has_next = S.next(ui + 1, nxt);
        const char* nA = has_next ? nxt.A : cA; const char* nB = has_next ? nxt.B : cB;
_Pragma("unroll 1")
        for (int t = 0; t < nt; t += 2) {
            const bool last = (t == nt - 2);
            const char* a1 = cA + (size_t)(t + 1) * kstep;
            const char* a2 = last ? nA : cA + (size_t)(t + 2) * kstep; const char* b2 = last ? nB : cB + (size_t)(t + 2) * kstep;
            const char* a3 = a2 + kstep; const char* b3 = b2 + kstep;
            if (last && has_next) S.a_ready(nxt);
            if constexpr (Epi::PF) { if (t == 2) E.prefetch(cur, (unsigned)(size_t)lds + (unsigned)LDS_PF, wid); }
            if constexpr (SP2) {
            PG8_LDB(B0, 0, 0); PG8_LDB(B1, 0, 1); PG8_SCHED; PG8_LDA(At, 0, 0); PG8_STAGE(PG8_SA(1, 1), a1 + hstep, voffA);
            PG8_WAIT_V(8); PG8_WAIT_L(0); PG8_BAR; PG8_MMA(0, 0, At, B0); PG8_MMA(0, 1, At, B1); PG8_BAR; PG8_SCHED;
            PG8_LDA(At, 0, 1); PG8_STAGE(PG8_SB(0, 0), b2, voffB); PG8_STAGE(PG8_SB(0, 1), b2 + hstep, voffB); PG8_STAGE(PG8_SA(0, 0), a2, voffA);
            PG8_WAIT_V(8); PG8_WAIT_L(0); PG8_BAR; PG8_MMA(1, 0, At, B0); PG8_MMA(1, 1, At, B1); PG8_BAR; PG8_SCHED;
            PG8_LDB(B0, 1, 0); PG8_LDB(B1, 1, 1); PG8_SCHED; PG8_LDA(At, 1, 0); PG8_STAGE(PG8_SA(0, 1), a2 + hstep, voffA);
            PG8_WAIT_V(8); PG8_WAIT_L(0); PG8_BAR; PG8_MMA(0, 0, At, B0); PG8_MMA(0, 1, At, B1); PG8_BAR; PG8_SCHED;
            PG8_LDA(At, 1, 1); PG8_STAGE(PG8_SB(1, 0), b3, voffB); PG8_STAGE(PG8_SB(1, 1), b3 + hstep, voffB); PG8_STAGE(PG8_SA(1, 0), a3, voffA);
            PG8_WAIT_V(8); PG8_WAIT_L(0); PG8_BAR; PG8_MMA(1, 0, At, B0); PG8_MMA(1, 1, At, B1); PG8_BAR; PG8_SCHED;
            } else {
            PG8_LDB(B0, 0, 0); PG8_SCHED; PG8_LDA(At, 0, 0); PG8_STAGE(PG8_SA(1, 1), a1 + hstep, voffA);
            PG8_WAIT_L(8); PG8_BAR; PG8_WAIT_L(0); PG8_MMA(0, 0, At, B0); PG8_BAR; PG8_SCHED;
            PG8_LDB(B1, 0, 1); PG8_STAGE(PG8_SB(0, 0), b2, voffB);
            PG8_BAR; PG8_WAIT_L(0); PG8_MMA(0, 1, At, B1); PG8_BAR;
            PG8_LDA(At, 0, 1); PG8_STAGE(PG8_SA(0, 0), a2, voffA);
            PG8_BAR; PG8_WAIT_L(0); PG8_MMA(1, 0, At, B0); PG8_BAR; PG8_SCHED;
            PG8_STAGE(PG8_SB(0, 1), b2 + hstep, voffB);
            PG8_WAIT_V(6); PG8_BAR; PG8_MMA(1, 1, At, B1); PG8_BAR;
            PG8_LDB(B0, 1, 0); PG8_SCHED; PG8_LDA(At, 1, 0); PG8_STAGE(PG8_SA(0, 1), a2 + hstep, voffA);
            PG8_WAIT_L(8); PG8_BAR; PG8_WAIT_L(0); PG8_MMA(0, 0, At, B0); PG8_BAR; PG8_SCHED;
            PG8_LDB(B1, 1, 1); PG8_STAGE(PG8_SB(1, 0), b3, voffB);
            PG8_BAR; PG8_WAIT_L(0); PG8_MMA(0, 1, At, B1); PG8_BAR;
            PG8_LDA(At, 1, 1); PG8_STAGE(PG8_SA(1, 0), a3, voffA);
            PG8_BAR; PG8_WAIT_L(0); PG8_MMA(1, 0, At, B0); PG8_BAR; PG8_SCHED;
            PG8_STAGE(PG8_SB(1, 1), b3 + hstep, voffB);
            PG8_WAIT_V(6); PG8_BAR; PG8_MMA(1, 1, At, B1); PG8_BAR;
            }
        }
        if constexpr (ALIGN_EPI) { if (wr == 0) PG8_BAR; }
        if constexpr (!Epi::AFTER_DRAIN) { E(acc, cur, wr, wc, fr, fq); S.done(cur); }
        if (!has_next) break;
#pragma unroll
        for (int a = 0; a < 2; ++a)
#pragma unroll
            for (int b = 0; b < 2; ++b)
#pragma unroll
                for (int m = 0; m < 4; ++m)
#pragma unroll
                    for (int n = 0; n < 2; ++n) acc[a][b][m][n] = (f32x4){0.f, 0.f, 0.f, 0.f};
        cur = nxt; cA = nA; cB = nB; ++ui;
        if constexpr (ALIGN_EPI) { if (wr == 1) PG8_BAR; }
    }
    PG8_WAIT_V(0);
    if constexpr (!ALIGN_EPI) { if (wr == 0) PG8_BAR; }
    PG8_BAR;
    if constexpr (Epi::AFTER_DRAIN) { E.fused(acc, cur, wr, wc, fr, fq, lds, wid, lane); S.done(cur); }
#undef PG8_SA
#undef PG8_SB
#undef PG8_STAGE
#undef PG8_LDA
#undef PG8_LDB
#undef PG8_MMA
#undef PG8_WAIT_V
#undef PG8_WAIT_L
#undef PG8_BAR
#undef PG8_SCHED
}

template <int NP, bool UP, int ROWB> struct MoeOrder {
    const volatile LAS int* tab; int layer; const char* A; const char* W;
    __device__ bool next(int i, Unit& u) const {
        const int e = tab[i]; if (e < 0) return false;
        const int mt = e & 0xffff, pn = (e >> 16) & 0xff, cls = e >> 24;
        u.pm = mt; u.pn = pn; u.A = A + (size_t)mt * ((size_t)BM * ROWB);
        if (UP) { const int g = cls / 6, pi = cls % 6, s = pn >> 2, ex = g * 4 + (s ? pair_hi(pi) : pair_lo(pi));
            u.B = W + ((size_t)(layer * NE + ex) * 1024 + (size_t)(pn & 3) * 256) * ROWB; }
        else u.B = W + ((size_t)(layer * NCLS + cls) * 1024 + (size_t)pn * 256) * ROWB;
        return true;
    }
    __device__ __forceinline__ void a_ready(const Unit&) const {}
    __device__ __forceinline__ void done(const Unit&) const {}
};

struct EpiZ {
    static constexpr bool PERM = true, AFTER_DRAIN = false, PF = true;
    bf16_t* Z; const float* ssq; const PG8_LAS unsigned char* pf;
    __device__ __forceinline__ void prefetch(const Unit& u, unsigned lds_addr, int wid) const {
        const char* g = (const char*)(ssq + (size_t)u.pm * BM * 16) + wid * 1024; const unsigned vo = (unsigned)fresh_lane() * 16u;
#pragma unroll
        for (int i = 0; i < 2; ++i) { unsigned keep;
            asm volatile("s_mov_b32 %0, m0\n\ts_mov_b32 m0, %3\n\ts_nop 0\n\tglobal_load_lds_dwordx4 %1, %2\n\ts_mov_b32 m0, %0" : "=&s"(keep) : "v"(vo), "s"(g + i * 8192), "s"(lds_addr + (unsigned)(wid * 1024 + i * 8192)) : "memory"); } }
    __device__ __forceinline__ void operator()(const f32x4 (&acc)[2][2][4][2], const Unit& u, int wr, int wc, int fr, int fq) const {
        { const int ln_ = fresh_lane(); fr = ln_ & 15; fq = ln_ >> 4; }
        const int row0 = u.pm * BM + wr * 64 + fr, col0 = u.pn * BM + wc * 32 + 8 * fq;
        float rr[2][4];
#pragma unroll
        for (int ai = 0; ai < 2; ++ai) {
            f32x4 sp[4];
#pragma unroll
            for (int m = 0; m < 4; ++m) sp[m] = *(const PG8_LAS f32x4*)(pf + (ai * HALF + wr * 64 + m * 16 + fr) * 64 + 16 * fq);
#pragma unroll
            for (int m = 0; m < 4; ++m) { float t = (sp[m][0] + sp[m][1]) + (sp[m][2] + sp[m][3]); t = add_x16_x32(t); rr[ai][m] = __builtin_amdgcn_rsqf(t * (1.0f / D) + EPS); }
        }
#pragma unroll
        for (int ai = 0; ai < 2; ++ai)
#pragma unroll
            for (int m = 0; m < 4; ++m) { const int row = row0 + ai * HALF + m * 16; const float r = rr[ai][m];
                bf16_t* rowp = Z + (size_t)row * INC + col0;
#pragma unroll
                for (int bj = 0; bj < 2; ++bj) { f32x4 v0 = acc[ai][bj][m][0] * r, v1 = acc[ai][bj][m][1] * r;
                    u32x4 w; w.x = cvt_pk_bf16(v0[0], v0[1]); w.y = cvt_pk_bf16(v0[2], v0[3]); w.z = cvt_pk_bf16(v1[0], v1[1]); w.w = cvt_pk_bf16(v1[2], v1[3]);
                    *(u32x4*)(rowp + bj * HALF) = w; } }
    }
};
template <bool SCATTER> struct EpiRes {
    static constexpr bool PERM = true, AFTER_DRAIN = false, PF = SCATTER; static constexpr int SCALE_W = 0x7b7b7b7b, SCALE_A = 0x7b7b7b7b;
    bf16_t* H; float* ssq; const int* rowtok; const PG8_LAS unsigned char* pf;
    __device__ __forceinline__ void prefetch(const Unit& u, unsigned lds_addr, int wid) const {
        if (wid < 4) { const char* g = (const char*)(rowtok + (size_t)u.pm * BM) + wid * 256; const unsigned vo = (unsigned)fresh_lane() * 4u; unsigned keep;
            asm volatile("s_mov_b32 %0, m0\n\ts_mov_b32 m0, %3\n\ts_nop 0\n\tglobal_load_lds_dword %1, %2\n\ts_mov_b32 m0, %0" : "=&s"(keep) : "v"(vo), "s"(g), "s"(lds_addr + (unsigned)(wid * 256)) : "memory"); } }
    __device__ __forceinline__ void operator()(const f32x4 (&acc)[2][2][4][2], const Unit& u, int wr, int wc, int fr, int fq) const {
        { const int ln_ = fresh_lane(); fr = ln_ & 15; fq = ln_ >> 4; }
        const int row0 = u.pm * BM + wr * 64 + fr, col0 = u.pn * BM + wc * 32 + 8 * fq;
        int tokv[2][4];
#pragma unroll
        for (int ai = 0; ai < 2; ++ai)
#pragma unroll
            for (int m = 0; m < 4; ++m) { const int row = row0 + ai * HALF + m * 16; tokv[ai][m] = SCATTER ? *(const PG8_LAS int*)(pf + (ai * HALF + wr * 64 + m * 16 + fr) * 4) : row; }
#pragma unroll
        for (int ai = 0; ai < 2; ++ai) {
            u32x4 o[4][2];
#pragma unroll
            for (int m = 0; m < 4; ++m) { const int tok = tokv[ai][m]; const bf16_t* rowp = H + (size_t)(tok < 0 ? 0 : tok) * D + col0; o[m][0] = *(const u32x4*)(rowp); o[m][1] = *(const u32x4*)(rowp + HALF); }
#pragma unroll
            for (int m = 0; m < 4; ++m) { const int tok = tokv[ai][m]; float s = 0.f; bf16_t* rowp = H + (size_t)(tok < 0 ? 0 : tok) * D + col0;
#pragma unroll
                for (int bj = 0; bj < 2; ++bj) { const u32x4 oo = o[m][bj];
                    f32x4 v0 = acc[ai][bj][m][0], v1 = acc[ai][bj][m][1];
                    v0[0] += __uint_as_float(oo.x << 16); v0[1] += __uint_as_float(oo.x & 0xffff0000u); v0[2] += __uint_as_float(oo.y << 16); v0[3] += __uint_as_float(oo.y & 0xffff0000u);
                    v1[0] += __uint_as_float(oo.z << 16); v1[1] += __uint_as_float(oo.z & 0xffff0000u); v1[2] += __uint_as_float(oo.w << 16); v1[3] += __uint_as_float(oo.w & 0xffff0000u);
                    s += (v0[0] * v0[0] + v0[1] * v0[1]) + (v0[2] * v0[2] + v0[3] * v0[3]) + (v1[0] * v1[0] + v1[1] * v1[1]) + (v1[2] * v1[2] + v1[3] * v1[3]);
                    u32x4 w; w.x = cvt_pk_bf16(v0[0], v0[1]); w.y = cvt_pk_bf16(v0[2], v0[3]); w.z = cvt_pk_bf16(v1[0], v1[1]); w.w = cvt_pk_bf16(v1[2], v1[3]);
                    if (tok >= 0) *(u32x4*)(rowp + bj * HALF) = w; }
                s = add_x16_x32(s);
                if (fq == 0 && tok >= 0) ssq[(size_t)tok * 16 + u.pn * 4 + wc] = s; }
            asm volatile("" ::: "memory"); }
    }
};
constexpr int SC_W = 0x7b7b7b7b, SC_H = 0x7b7b7b7b, SC_ACT = 0x7b7b7b7b;
constexpr float FS_W = 16.f, FS_H = 16.f, FS_ACT = 16.f;
struct EpiUp {
    static constexpr bool PERM = true, AFTER_DRAIN = false, PF = true; static constexpr int SCALE_W = SC_W, SCALE_A = SC_H;
    unsigned char* ACT; const float* rowg; const PG8_LAS unsigned char* pf;
    __device__ __forceinline__ void prefetch(const Unit& u, unsigned lds_addr, int wid) const {
        const char* g = (const char*)(rowg + (size_t)u.pm * BM * 2) + wid * 256; const unsigned vo = (unsigned)fresh_lane() * 4u; unsigned keep;
        asm volatile("s_mov_b32 %0, m0\n\ts_mov_b32 m0, %3\n\ts_nop 0\n\tglobal_load_lds_dword %1, %2\n\ts_mov_b32 m0, %0" : "=&s"(keep) : "v"(vo), "s"(g), "s"(lds_addr + (unsigned)(wid * 256)) : "memory"); }
    __device__ __forceinline__ void operator()(const f32x4 (&acc)[2][2][4][2], const Unit& u, int wr, int wc, int fr, int fq) const {
        { const int ln_ = fresh_lane(); fr = ln_ & 15; fq = ln_ >> 4; }
        const int row0 = u.pm * BM + wr * 64 + fr, s = u.pn >> 2, col0 = s * 512 + (u.pn & 3) * 128 + wc * 32 + 8 * fq;
        float gt[2][4];
#pragma unroll
        for (int ai = 0; ai < 2; ++ai)
#pragma unroll
            for (int m = 0; m < 4; ++m) gt[ai][m] = *(const PG8_LAS float*)(pf + ((ai * HALF + wr * 64 + m * 16 + fr) * 2 + s) * 4);
#pragma unroll
        for (int ai = 0; ai < 2; ++ai)
#pragma unroll
            for (int m = 0; m < 4; ++m) { const int row = row0 + ai * HALF + m * 16; const float g1 = gt[ai][m];
                float o[8];
#pragma unroll
                for (int n = 0; n < 2; ++n)
#pragma unroll
                    for (int j = 0; j < 4; ++j) { const float g = acc[ai][0][m][n][j], up = acc[ai][1][m][n][j]; o[n * 4 + j] = g * sigmoid_fast(g) * up * g1; }
                u32x2 w; w.x = pk_fp8x4(o[0] * FS_ACT, o[1] * FS_ACT, o[2] * FS_ACT, o[3] * FS_ACT); w.y = pk_fp8x4(o[4] * FS_ACT, o[5] * FS_ACT, o[6] * FS_ACT, o[7] * FS_ACT);
                *(u32x2*)(ACT + (size_t)row * 1024 + col0) = w; }
    }
};
}

__device__ __forceinline__ void tr_item(const float* W, int ldw, int k0, int scol0, const float* gk, bf16_t* WT, int ldo, int drow0, int dk0, LAS float* scr, int lane) {
#pragma unroll 8
    for (int i = 0; i < 32; ++i) { const int kk = 2 * i + (lane >> 5); float v = W[(size_t)(k0 + kk) * ldw + scol0 + (lane & 31)]; if (gk) v *= gk[k0 + kk]; scr[kk * 33 + (lane & 31)] = v; }
    asm volatile("s_waitcnt lgkmcnt(0)" ::: "memory");
    const int c = lane & 7;
#pragma unroll
    for (int j = 0; j < 4; ++j) { const int n = (lane >> 3) + 8 * j; const LAS float* s = scr + (8 * c) * 33 + n;
        u32x4 o; o.x = cvt_pk_bf16(s[0 * 33], s[1 * 33]); o.y = cvt_pk_bf16(s[2 * 33], s[3 * 33]); o.z = cvt_pk_bf16(s[4 * 33], s[5 * 33]); o.w = cvt_pk_bf16(s[6 * 33], s[7 * 33]);
        *(u32x4*)(WT + (size_t)(drow0 + n) * ldo + dk0 + 8 * c) = o; }
    asm volatile("s_waitcnt lgkmcnt(0)" ::: "memory");
}

constexpr size_t S5_L_STRIDE = 1310720, S5_KT = 0, S5_ET = 131072, S5_FT = 655360, S5_LAMP = 1179648;
constexpr int S5_WSCR = 8192, S5_YST = 65536, YST_LD = 264;
constexpr int NU128 = T / 128, UPB128 = SEQ / 128;
__device__ __forceinline__ f32x4 mfma16(bf16x8 a, bf16x8 b, f32x4 c) { return __builtin_amdgcn_mfma_f32_16x16x32_bf16(a, b, c, 0, 0, 0); }

__device__ __forceinline__ void s5_kt_pair(int g, int c, int cp, const float* a_re, const float* a_im, const float* log_dt, const float* b_re, const float* b_im,
                                           const float* c_re, const float* c_im, const float* dvec, unsigned char* tab) {
    const float dt = __expf(log_dt[g]); float km[8];
#pragma unroll
    for (int d = 0; d < 8; ++d) km[d] = 0.f;
#pragma unroll 2
    for (int p = 0; p < CS; ++p) { const float lr = a_re[g * CS + p], li = a_im[g * CS + p], zr = lr * dt, zi = li * dt;
        const float sh = __sinf(0.5f * zi), cz = __cosf(zi), sz = __sinf(zi), ez = __expf(zr); const float nr = expm1f(zr) * cz - 2.0f * sh * sh, ni = ez * sz, den = lr * lr + li * li;
        const float cr = (nr * lr + ni * li) / den, ci = (ni * lr - nr * li) / den;
        const float br = b_re[((size_t)g * CS + p) * CGD + cp], bi = b_im[((size_t)g * CS + p) * CGD + cp]; const float bbr = cr * br - ci * bi, bbi = cr * bi + ci * br;
        const float cre = c_re[((size_t)g * CGD + c) * CS + p], cim = c_im[((size_t)g * CGD + c) * CS + p];
        float vr = cre * bbr - cim * bbi, vi = cre * bbi + cim * bbr;
        const float lbr = ez * cz, lbi = ez * sz;
#pragma unroll
        for (int d = 0; d < 8; ++d) { km[d] += vr; const float t = vr * lbr - vi * lbi; vi = vr * lbi + vi * lbr; vr = t; } }
    if (c == cp) km[0] += dvec[g * CGD + c];
    bf16_t* kt = (bf16_t*)(tab + S5_KT) + (size_t)g * 4096;
#pragma unroll
    for (int dd = 0; dd < 8; ++dd) { kt[(dd * 16 + c) * 32 + cp] = f2bf(km[dd]); kt[(dd * 16 + c) * 32 + 16 + cp] = dd >= 1 ? f2bf(km[dd - 1]) : (bf16_t)0; }
}
__device__ __forceinline__ void s5_et_task(int g, int ri, int p, int cp, const float* a_re, const float* a_im, const float* log_dt, const float* b_re, const float* b_im, unsigned char* tab) {
    const float dt = __expf(log_dt[g]); const float lr = a_re[g * CS + p], li = a_im[g * CS + p], zr = lr * dt, zi = li * dt;
    const float sh = __sinf(0.5f * zi), cz = __cosf(zi), sz = __sinf(zi), ez = __expf(zr); const float nr = expm1f(zr) * cz - 2.0f * sh * sh, ni = ez * sz, den = lr * lr + li * li;
    const float cr = (nr * lr + ni * li) / den, ci = (ni * lr - nr * li) / den;
    const float br = b_re[((size_t)g * CS + p) * CGD + cp], bi = b_im[((size_t)g * CS + p) * CGD + cp]; float vr = cr * br - ci * bi, vi = cr * bi + ci * br;
    const float lbr = ez * cz, lbi = ez * sz; bf16_t* et = (bf16_t*)(tab + S5_ET) + (size_t)g * 16384 + (size_t)(ri * 64 + p) * 128 + cp;
#pragma unroll
    for (int sp = 7; sp >= 0; --sp) { et[sp * 16] = f2bf(ri ? vi : vr); const float t = vr * lbr - vi * lbi; vi = vr * lbi + vi * lbr; vr = t; }
}
__device__ __forceinline__ void s5_ft_task(int g, int c, int ri, int p, const float* a_re, const float* a_im, const float* log_dt, const float* c_re, const float* c_im, unsigned char* tab) {
    const float dt = __expf(log_dt[g]); const float lr = a_re[g * CS + p], li = a_im[g * CS + p], zr = lr * dt, zi = li * dt; const float ez = __expf(zr), lbr = ez * __cosf(zi), lbi = ez * __sinf(zi);
    const float cre = c_re[((size_t)g * CGD + c) * CS + p], cim = c_im[((size_t)g * CGD + c) * CS + p]; float vr = cre * lbr - cim * lbi, vi = cre * lbi + cim * lbr;
    bf16_t* ft = (bf16_t*)(tab + S5_FT) + (size_t)g * 16384 + (size_t)c * 128 + ri * 64 + p;
#pragma unroll
    for (int tp = 0; tp < 8; ++tp) { ft[(size_t)tp * 16 * 128] = f2bf(ri ? -vi : vr); const float t = vr * lbr - vi * lbi; vi = vr * lbi + vi * lbr; vr = t; }
}
__device__ __forceinline__ void s5_table_elem(int g, int e, const float* a_re, const float* a_im, const float* log_dt, const float* b_re, const float* b_im,
                                              const float* c_re, const float* c_im, const float* dvec, unsigned char* tab) {
    const float dt = __expf(log_dt[g]);
    if (e < 4096) {
        const int dd = e >> 9, c = (e >> 5) & 15, ee = (e >> 4) & 1, cp = e & 15, d = dd - ee; float s = 0.f;
        if (d >= 0) {
            for (int p = 0; p < CS; ++p) { const float lr = a_re[g * CS + p], li = a_im[g * CS + p], zr = lr * dt, zi = li * dt;
                const float sh = __sinf(0.5f * zi); const float nr = expm1f(zr) * __cosf(zi) - 2.0f * sh * sh, ni = __expf(zr) * __sinf(zi), den = lr * lr + li * li;
                const float cr = (nr * lr + ni * li) / den, ci = (ni * lr - nr * li) / den;
                const float br = b_re[((size_t)g * CS + p) * CGD + cp], bi = b_im[((size_t)g * CS + p) * CGD + cp]; const float bbr = cr * br - ci * bi, bbi = cr * bi + ci * br;
                const float mag = __expf(zr * (float)d), pr = mag * __cosf(zi * (float)d), pi = mag * __sinf(zi * (float)d);
                const float vr = pr * bbr - pi * bbi, vi = pr * bbi + pi * bbr;
                s += c_re[((size_t)g * CGD + c) * CS + p] * vr - c_im[((size_t)g * CGD + c) * CS + p] * vi; }
            if (d == 0 && c == cp) s += dvec[g * CGD + c];
        }
        ((bf16_t*)(tab + S5_KT))[(size_t)g * 4096 + e] = f2bf(s); return;
    }
    e -= 4096;
    if (e < 16384) {
        const int n = e >> 7, k = e & 127, ri = n >> 6, p = n & 63, sp = k >> 4, cp = k & 15;
        const float lr = a_re[g * CS + p], li = a_im[g * CS + p], zr = lr * dt, zi = li * dt;
        const float sh = __sinf(0.5f * zi); const float nr = expm1f(zr) * __cosf(zi) - 2.0f * sh * sh, ni = __expf(zr) * __sinf(zi), den = lr * lr + li * li;
        const float cr = (nr * lr + ni * li) / den, ci = (ni * lr - nr * li) / den;
        const float br = b_re[((size_t)g * CS + p) * CGD + cp], bi = b_im[((size_t)g * CS + p) * CGD + cp]; const float bbr = cr * br - ci * bi, bbi = cr * bi + ci * br;
        const float d = (float)(7 - sp); const float mag = __expf(zr * d), pr = mag * __cosf(zi * d), pi = mag * __sinf(zi * d);
        ((bf16_t*)(tab + S5_ET))[(size_t)g * 16384 + e] = f2bf(ri ? (pr * bbi + pi * bbr) : (pr * bbr - pi * bbi)); return;
    }
    e -= 16384;
    if (e < 16384) {
        const int n = e >> 7, k = e & 127, tp = n >> 4, c = n & 15, ri = k >> 6, p = k & 63;
        const float lr = a_re[g * CS + p], li = a_im[g * CS + p], zr = lr * dt, zi = li * dt;
        const float d = (float)(tp + 1); const float mag = __expf(zr * d), pr = mag * __cosf(zi * d), pi = mag * __sinf(zi * d);
        const float cre = c_re[((size_t)g * CGD + c) * CS + p], cim = c_im[((size_t)g * CGD + c) * CS + p];
        ((bf16_t*)(tab + S5_FT))[(size_t)g * 16384 + e] = f2bf(ri ? -(cre * pi + cim * pr) : (cre * pr - cim * pi)); return;
    }
    e -= 16384;
    { const int p = e; const float lr = a_re[g * CS + p], li = a_im[g * CS + p], zr = lr * dt, zi = li * dt; float* o = (float*)(tab + S5_LAMP) + ((size_t)g * CS + p) * 8;
      float mag = expf(zr); o[0] = mag * cosf(zi); o[1] = mag * sinf(zi);
      mag = expf(zr * 8.f); o[2] = mag * cosf(zi * 8.f); o[3] = mag * sinf(zi * 8.f);
      mag = expf(zr * 128.f); o[4] = mag * cosf(zi * 128.f); o[5] = mag * sinf(zi * 128.f); o[6] = 0.f; o[7] = 0.f; }
}

template <class TT> __device__ __forceinline__ TT ldg(const void* ubase, unsigned voff) { return *(const TT*)((const char*)ubase + voff); }
template <int PASS>
__device__ __forceinline__ void s5_group(int unit, int g, bool first, float& kr, float& ki, int wave, int lane, const bf16_t* Z, bf16_t* Y, const unsigned char* tab, float* SEND, float* SEND2, float* SE, LAS unsigned char* lds) {
    const int ln = lane & 15, q = lane >> 4; const int t0 = unit * 128;
    const char* KTg = (const char*)(tab + S5_KT) + (size_t)g * 8192; const char* ETg = (const char*)(tab + S5_ET) + (size_t)g * 32768; const char* FTg = (const char*)(tab + S5_FT) + (size_t)g * 32768;
    const float* LAMPg = (const float*)(tab + S5_LAMP) + (size_t)g * CS * 8;
    const unsigned vo128 = (unsigned)(ln * 128 + 8 * q) * 2u;
    const unsigned vo32 = (unsigned)(ln * 32 + 8 * q) * 2u;
    LAS float* Sb = (LAS float*)(lds + wave * S5_WSCR); LAS bf16_t* Tb = (LAS bf16_t*)(lds + wave * S5_WSCR); LAS bf16_t* yst = (LAS bf16_t*)(lds + S5_YST);
    char* seb = (char*)(SE + ((size_t)unit * CG + g) * 16 * 128); const unsigned vl = (unsigned)lane * 4u;
    char* ylb = (char*)(Y + (size_t)t0 * D + AW + BW + g * 16); const unsigned vy = (unsigned)((ln * 8) * D + 4 * q) * 2u;
    const float lur = LAMPg[lane * 8 + 4], lui = LAMPg[lane * 8 + 5], l8r = LAMPg[lane * 8 + 2], l8i = LAMPg[lane * 8 + 3];
    float cr = 0.f, ci = 0.f;
    if (PASS == 1) {
        if (!first) { cr = kr; ci = ki; }
        bf16x8 X0, X1, X2, X3;
        { const char* zb = (const char*)(Z + (size_t)t0 * INC + ZC + g * 16); const unsigned vz = (unsigned)((ln * 8 + (q >> 1)) * INC + 8 * (q & 1)) * 2u;
          X0 = ldg<bf16x8>(zb, vz); X1 = ldg<bf16x8>(zb + 2 * INC * 2, vz); X2 = ldg<bf16x8>(zb + 4 * INC * 2, vz); X3 = ldg<bf16x8>(zb + 6 * INC * 2, vz); }
        { LAS float* sw = Sb + (4 * q) * 128 + ln; const char* eb = ETg;
#pragma unroll 1
          for (int jh = 0; jh < 2; ++jh) { bf16x8 ef[4][4];
#pragma unroll
            for (int j = 0; j < 4; ++j)
#pragma unroll
              for (int ks = 0; ks < 4; ++ks) ef[j][ks] = ldg<bf16x8>(eb + j * 4096 + ks * 64, vo128);
#pragma unroll
            for (int j = 0; j < 4; ++j) { f32x4 se = (f32x4){0.f, 0.f, 0.f, 0.f};
              se = mfma16(X0, ef[j][0], se); se = mfma16(X1, ef[j][1], se); se = mfma16(X2, ef[j][2], se); se = mfma16(X3, ef[j][3], se);
              LAS float* s2 = sw + 16 * j; s2[0] = se[0]; s2[128] = se[1]; s2[256] = se[2]; s2[384] = se[3]; }
            eb += 16384; sw += 64; } }
        asm volatile("" ::: "memory");
        { const char* kb = KTg; char* yq = ylb;
#pragma unroll 1
          for (int th = 0; th < 4; ++th) {
              const bf16x8 ka = ldg<bf16x8>(kb, vo32), kc = ldg<bf16x8>(kb + 1024, vo32);
              f32x4 acc0 = (f32x4){0.f, 0.f, 0.f, 0.f}, acc1 = (f32x4){0.f, 0.f, 0.f, 0.f};
              acc0 = mfma16(ka, X0, acc0); acc1 = mfma16(kc, X0, acc1);
              if (th >= 1) { acc0 = mfma16(ldg<bf16x8>(kb - 2048, vo32), X1, acc0); acc1 = mfma16(ldg<bf16x8>(kb - 1024, vo32), X1, acc1); }
              if (th >= 2) { acc0 = mfma16(ldg<bf16x8>(kb - 4096, vo32), X2, acc0); acc1 = mfma16(ldg<bf16x8>(kb - 3072, vo32), X2, acc1); }
              if (th >= 3) { acc0 = mfma16(ldg<bf16x8>(kb - 6144, vo32), X3, acc0); acc1 = mfma16(ldg<bf16x8>(kb - 5120, vo32), X3, acc1); }
              u32x2 w; w.x = cvt_pk_bf16(acc0[0], acc0[1]); w.y = cvt_pk_bf16(acc0[2], acc0[3]); *(u32x2*)(yq + vy) = w;
              w.x = cvt_pk_bf16(acc1[0], acc1[1]); w.y = cvt_pk_bf16(acc1[2], acc1[3]); *(u32x2*)(yq + (size_t)D * 2 + vy) = w;
              kb += 2048; yq += (size_t)2 * D * 2; } }
        asm volatile("" ::: "memory");
        float sr = cr, si = ci;
#pragma unroll
        for (int s = 0; s < 16; ++s) { const float er = Sb[s * 128 + lane], ei = Sb[s * 128 + 64 + lane];
            *(float*)(seb + s * 512 + vl) = er; *(float*)(seb + s * 512 + 256 + vl) = ei;
            const float nr = l8r * sr - l8i * si + er, ni = l8r * si + l8i * sr + ei; sr = nr; si = ni; }
        kr = sr; ki = si;
        float* dst = first ? SEND + (((size_t)unit * CG + g) * 2) * CS + lane : SEND2 + (((size_t)(unit >> 1) * CG + g) * 2) * CS + lane;
        dst[0] = sr; dst[CS] = si; asm volatile("" ::: "memory"); return;
    }
    if (first) { const int pr = unit >> 1, p0 = pr - (pr % (UPB128 / 2)); const float l2r = lur * lur - lui * lui, l2i = 2.0f * lur * lui;
        const char* sb = (const char*)(SEND2 + (((size_t)p0 * CG + g) * 2) * CS);
#pragma unroll 8
        for (int j = p0; j < pr; ++j) { const float sr = ldg<float>(sb, vl), si = ldg<float>(sb + CS * 4, vl); sb += (size_t)CG * 2 * CS * 4;
            const float nr = l2r * cr - l2i * ci + sr, ni = l2r * ci + l2i * cr + si; cr = nr; ci = ni; } }
    else { const float sr = SEND[(((size_t)(unit - 1) * CG + g) * 2 + 0) * CS + lane], si = SEND[(((size_t)(unit - 1) * CG + g) * 2 + 1) * CS + lane];
        cr = lur * kr - lui * ki + sr; ci = lur * ki + lui * kr + si; }
    kr = cr; ki = ci;
    { float sre[16], sim[16];
#pragma unroll
      for (int s = 0; s < 16; ++s) { sre[s] = ldg<float>(seb + s * 512, vl); sim[s] = ldg<float>(seb + s * 512 + 256, vl); }
      float sr = cr, si = ci;
#pragma unroll
      for (int s = 0; s < 16; ++s) { Tb[s * 128 + lane] = f2bf(sr); Tb[s * 128 + 64 + lane] = f2bf(si);
          const float nr = l8r * sr - l8i * si + sre[s], ni = l8r * si + l8i * sr + sim[s]; sr = nr; si = ni; } }
    asm volatile("" ::: "memory");
    const bf16x8 T0 = *(const LAS bf16x8*)(Tb + ln * 128 + 8 * q), T1 = *(const LAS bf16x8*)(Tb + ln * 128 + 32 + 8 * q), T2 = *(const LAS bf16x8*)(Tb + ln * 128 + 64 + 8 * q), T3 = *(const LAS bf16x8*)(Tb + ln * 128 + 96 + 8 * q);
    { LAS bf16_t* yw = yst + (ln * 8) * YST_LD + g * 16 + 4 * q; const char* fb = FTg; const char* yq = ylb;
#pragma unroll 2
      for (int th = 0; th < 4; ++th) { bf16x8 ff[2][4]; u32x2 yl[2];
#pragma unroll
          for (int j = 0; j < 2; ++j) { yl[j] = ldg<u32x2>(yq + (size_t)j * D * 2, vy);
#pragma unroll
              for (int ks = 0; ks < 4; ++ks) ff[j][ks] = ldg<bf16x8>(fb + j * 4096 + ks * 64, vo128); }
#pragma unroll
          for (int j = 0; j < 2; ++j) {
              f32x4 acc; acc[0] = __uint_as_float(yl[j].x << 16); acc[1] = __uint_as_float(yl[j].x & 0xffff0000u); acc[2] = __uint_as_float(yl[j].y << 16); acc[3] = __uint_as_float(yl[j].y & 0xffff0000u);
              acc = mfma16(ff[j][0], T0, acc); acc = mfma16(ff[j][1], T1, acc); acc = mfma16(ff[j][2], T2, acc); acc = mfma16(ff[j][3], T3, acc);
              u32x2 w; w.x = cvt_pk_bf16(gelu_fast(acc[0]), gelu_fast(acc[1])); w.y = cvt_pk_bf16(gelu_fast(acc[2]), gelu_fast(acc[3]));
              *(LAS u32x2*)(yw + j * YST_LD) = w; }
          fb += 8192; yq += (size_t)2 * D * 2; yw += 2 * YST_LD; } }
    asm volatile("s_waitcnt lgkmcnt(0)" ::: "memory");
}
__device__ __forceinline__ void s5_pair1(int pr, int g, int wave, int lane, const bf16_t* Z, bf16_t* Y, const unsigned char* tab, float* SEND, float* SEND2, float* SE, LAS unsigned char* lds) {
    const int ln = lane & 15, q = lane >> 4; const int t0 = pr * 256;
    const char* KTg = (const char*)(tab + S5_KT) + (size_t)g * 8192; const char* ETg = (const char*)(tab + S5_ET) + (size_t)g * 32768;
    const float* LAMPg = (const float*)(tab + S5_LAMP) + (size_t)g * CS * 8;
    const unsigned vo128 = (unsigned)(ln * 128 + 8 * q) * 2u, vo32 = (unsigned)(ln * 32 + 8 * q) * 2u, vl = (unsigned)lane * 4u;
    LAS float* SbA = (LAS float*)(lds + wave * 16384); LAS float* SbB = SbA + 2048;
    bf16x8 XA0, XA1, XA2, XA3, XB0, XB1, XB2, XB3;
    { const char* zb = (const char*)(Z + (size_t)t0 * INC + ZC + g * 16); const unsigned vz = (unsigned)((ln * 8 + (q >> 1)) * INC + 8 * (q & 1)) * 2u;
      XA0 = ldg<bf16x8>(zb, vz); XA1 = ldg<bf16x8>(zb + 2 * INC * 2, vz); XA2 = ldg<bf16x8>(zb + 4 * INC * 2, vz); XA3 = ldg<bf16x8>(zb + 6 * INC * 2, vz);
      const char* zc = zb + (size_t)128 * INC * 2;
      XB0 = ldg<bf16x8>(zc, vz); XB1 = ldg<bf16x8>(zc + 2 * INC * 2, vz); XB2 = ldg<bf16x8>(zc + 4 * INC * 2, vz); XB3 = ldg<bf16x8>(zc + 6 * INC * 2, vz); }
    { LAS float* sw = SbA + (4 * q) * 128 + ln; const char* eb = ETg;
#pragma unroll
      for (int jh = 0; jh < 2; ++jh) { bf16x8 ef[4][4];
#pragma unroll
        for (int j = 0; j < 4; ++j)
#pragma unroll
          for (int ks = 0; ks < 4; ++ks) ef[j][ks] = ldg<bf16x8>(eb + j * 4096 + ks * 64, vo128);
#pragma unroll
        for (int j = 0; j < 4; ++j) { f32x4 sa = (f32x4){0.f, 0.f, 0.f, 0.f}, sb = (f32x4){0.f, 0.f, 0.f, 0.f};
          sa = mfma16(XA0, ef[j][0], sa); sb = mfma16(XB0, ef[j][0], sb); sa = mfma16(XA1, ef[j][1], sa); sb = mfma16(XB1, ef[j][1], sb);
          sa = mfma16(XA2, ef[j][2], sa); sb = mfma16(XB2, ef[j][2], sb); sa = mfma16(XA3, ef[j][3], sa); sb = mfma16(XB3, ef[j][3], sb);
          LAS float* s2 = sw + 16 * j; s2[0] = sa[0]; s2[128] = sa[1]; s2[256] = sa[2]; s2[384] = sa[3]; s2[2048] = sb[0]; s2[2048 + 128] = sb[1]; s2[2048 + 256] = sb[2]; s2[2048 + 384] = sb[3]; }
        eb += 16384; sw += 64; } }
    asm volatile("" ::: "memory");
    { const char* kb = KTg; char* yq = (char*)(Y + (size_t)t0 * D + AW + BW + g * 16); const unsigned vy = (unsigned)((ln * 8) * D + 4 * q) * 2u;
#pragma unroll 1
      for (int th = 0; th < 4; ++th) {
          const bf16x8 ka = ldg<bf16x8>(kb, vo32), kc = ldg<bf16x8>(kb + 1024, vo32);
          f32x4 a0 = (f32x4){0.f, 0.f, 0.f, 0.f}, a1 = a0, b0 = a0, b1 = a0;
          a0 = mfma16(ka, XA0, a0); a1 = mfma16(kc, XA0, a1); b0 = mfma16(ka, XB0, b0); b1 = mfma16(kc, XB0, b1);
          if (th >= 1) { const bf16x8 k0 = ldg<bf16x8>(kb - 2048, vo32), k1 = ldg<bf16x8>(kb - 1024, vo32); a0 = mfma16(k0, XA1, a0); a1 = mfma16(k1, XA1, a1); b0 = mfma16(k0, XB1, b0); b1 = mfma16(k1, XB1, b1); }
          if (th >= 2) { const bf16x8 k0 = ldg<bf16x8>(kb - 4096, vo32), k1 = ldg<bf16x8>(kb - 3072, vo32); a0 = mfma16(k0, XA2, a0); a1 = mfma16(k1, XA2, a1); b0 = mfma16(k0, XB2, b0); b1 = mfma16(k1, XB2, b1); }
          if (th >= 3) { const bf16x8 k0 = ldg<bf16x8>(kb - 6144, vo32), k1 = ldg<bf16x8>(kb - 5120, vo32); a0 = mfma16(k0, XA3, a0); a1 = mfma16(k1, XA3, a1); b0 = mfma16(k0, XB3, b0); b1 = mfma16(k1, XB3, b1); }
          u32x2 w; w.x = cvt_pk_bf16(a0[0], a0[1]); w.y = cvt_pk_bf16(a0[2], a0[3]); *(u32x2*)(yq + vy) = w;
          w.x = cvt_pk_bf16(a1[0], a1[1]); w.y = cvt_pk_bf16(a1[2], a1[3]); *(u32x2*)(yq + (size_t)D * 2 + vy) = w;
          w.x = cvt_pk_bf16(b0[0], b0[1]); w.y = cvt_pk_bf16(b0[2], b0[3]); *(u32x2*)(yq + (size_t)128 * D * 2 + vy) = w;
          w.x = cvt_pk_bf16(b1[0], b1[1]); w.y = cvt_pk_bf16(b1[2], b1[3]); *(u32x2*)(yq + (size_t)129 * D * 2 + vy) = w;
          kb += 2048; yq += (size_t)2 * D * 2; } }
    asm volatile("" ::: "memory");
    const float l8r = LAMPg[lane * 8 + 2], l8i = LAMPg[lane * 8 + 3];
    float sr = 0.f, si = 0.f;
    { char* seb = (char*)(SE + ((size_t)(2 * pr) * CG + g) * 16 * 128);
#pragma unroll
      for (int s = 0; s < 16; ++s) { const float er = SbA[s * 128 + lane], ei = SbA[s * 128 + 64 + lane];
          *(float*)(seb + s * 512 + vl) = er; *(float*)(seb + s * 512 + 256 + vl) = ei;
          const float nr = l8r * sr - l8i * si + er, ni = l8r * si + l8i * sr + ei; sr = nr; si = ni; }
      float* dst = SEND + (((size_t)(2 * pr) * CG + g) * 2) * CS + lane; dst[0] = sr; dst[CS] = si; }
    { char* seb = (char*)(SE + ((size_t)(2 * pr + 1) * CG + g) * 16 * 128);
#pragma unroll
      for (int s = 0; s < 16; ++s) { const float er = SbB[s * 128 + lane], ei = SbB[s * 128 + 64 + lane];
          *(float*)(seb + s * 512 + vl) = er; *(float*)(seb + s * 512 + 256 + vl) = ei;
          const float nr = l8r * sr - l8i * si + er, ni = l8r * si + l8i * sr + ei; sr = nr; si = ni; }
      float* dst = SEND2 + (((size_t)pr * CG + g) * 2) * CS + lane; dst[0] = sr; dst[CS] = si; }
    asm volatile("s_waitcnt lgkmcnt(0)" ::: "memory");
}
constexpr int S5_PSG = 133120;
__device__ __forceinline__ void s5_glu(int unit, int wave, int lane, const bf16_t* WGLU, const float* glu_b, const float* mo_gc, bf16_t* Y, LAS unsigned char* lds) {
    const int ln = lane & 15, q = lane >> 4; LAS bf16_t* yst = (LAS bf16_t*)(lds + S5_YST); LAS float* PSg = (LAS float*)(lds + S5_PSG);
    bf16x8 wf[2][8];
    { const char* wb = (const char*)(WGLU + (size_t)(32 * wave) * 256); const unsigned vw = (unsigned)(ln * 256 + 8 * q) * 2u;
#pragma unroll
      for (int j = 0; j < 2; ++j)
#pragma unroll
          for (int ks = 0; ks < 8; ++ks) wf[j][ks] = ldg<bf16x8>(wb + j * 8192 + ks * 64, vw); }
    const f32x4 gb0 = *(const f32x4*)(glu_b + 32 * wave + 4 * q), gb1 = *(const f32x4*)(glu_b + 32 * wave + 16 + 4 * q);
    LAS bf16_t* op = (LAS bf16_t*)(lds + wave * S5_WSCR) + ln * 32 + 4 * q;
    { const LAS bf16_t* yrow = yst + ln * YST_LD; LAS float* psw = PSg + ln * 8 + wave; LAS bf16_t* ow = op;
#pragma unroll 4
      for (int tt = 0; tt < 8; ++tt) {
        f32x4 a0 = (f32x4){0.f, 0.f, 0.f, 0.f}, a1 = (f32x4){0.f, 0.f, 0.f, 0.f};
#pragma unroll
        for (int ks = 0; ks < 8; ++ks) { const bf16x8 yf = *(const LAS bf16x8*)(yrow + 32 * ks + 8 * q); a0 = mfma16(wf[0][ks], yf, a0); a1 = mfma16(wf[1][ks], yf, a1); }
        const u32x2 y0 = *(const LAS u32x2*)(yrow + 32 * wave + 4 * q), y1 = *(const LAS u32x2*)(yrow + 32 * wave + 16 + 4 * q);
        float o[8];
        o[0] = __uint_as_float(y0.x << 16) * sigmoid_fast(a0[0] + gb0[0]); o[1] = __uint_as_float(y0.x & 0xffff0000u) * sigmoid_fast(a0[1] + gb0[1]); o[2] = __uint_as_float(y0.y << 16) * sigmoid_fast(a0[2] + gb0[2]); o[3] = __uint_as_float(y0.y & 0xffff0000u) * sigmoid_fast(a0[3] + gb0[3]);
        o[4] = __uint_as_float(y1.x << 16) * sigmoid_fast(a1[0] + gb1[0]); o[5] = __uint_as_float(y1.x & 0xffff0000u) * sigmoid_fast(a1[1] + gb1[1]); o[6] = __uint_as_float(y1.y << 16) * sigmoid_fast(a1[2] + gb1[2]); o[7] = __uint_as_float(y1.y & 0xffff0000u) * sigmoid_fast(a1[3] + gb1[3]);
        float ss = ((o[0] * o[0] + o[1] * o[1]) + (o[2] * o[2] + o[3] * o[3])) + ((o[4] * o[4] + o[5] * o[5]) + (o[6] * o[6] + o[7] * o[7]));
        ss = add_x16_x32(ss);
        if (q == 0) *psw = ss;
        u32x2 w; w.x = cvt_pk_bf16(o[0], o[1]); w.y = cvt_pk_bf16(o[2], o[3]); *(LAS u32x2*)(ow) = w; w.x = cvt_pk_bf16(o[4], o[5]); w.y = cvt_pk_bf16(o[6], o[7]); *(LAS u32x2*)(ow + 16) = w;
        yrow += 16 * YST_LD; psw += 16 * 8; ow += 16 * 32; } }
    asm volatile("s_waitcnt lgkmcnt(0)" ::: "memory");
    __syncthreads();
    const f32x4 g0 = *(const f32x4*)(mo_gc + 32 * wave + 4 * q), g1 = *(const f32x4*)(mo_gc + 32 * wave + 16 + 4 * q);
    { char* yb = (char*)(Y + (size_t)(unit * 128) * D + AW + BW + 32 * wave); const unsigned vy = (unsigned)(ln * D + 4 * q) * 2u; const LAS f32x4* pp = (const LAS f32x4*)(PSg + ln * 8); const LAS bf16_t* ow = op;
#pragma unroll 2
      for (int tt = 0; tt < 8; ++tt) { const f32x4 p0 = pp[0], p1 = pp[1];
        const float rs = __builtin_amdgcn_rsqf((((p0[0] + p0[1]) + (p0[2] + p0[3])) + ((p1[0] + p1[1]) + (p1[2] + p1[3]))) * (1.0f / CW) + EPS);
        const u32x2 a = *(const LAS u32x2*)(ow), b = *(const LAS u32x2*)(ow + 16); u32x2 w;
        w.x = cvt_pk_bf16(__uint_as_float(a.x << 16) * rs * g0[0], __uint_as_float(a.x & 0xffff0000u) * rs * g0[1]); w.y = cvt_pk_bf16(__uint_as_float(a.y << 16) * rs * g0[2], __uint_as_float(a.y & 0xffff0000u) * rs * g0[3]);
        *(u32x2*)(yb + vy) = w;
        w.x = cvt_pk_bf16(__uint_as_float(b.x << 16) * rs * g1[0], __uint_as_float(b.x & 0xffff0000u) * rs * g1[1]); w.y = cvt_pk_bf16(__uint_as_float(b.y << 16) * rs * g1[2], __uint_as_float(b.y & 0xffff0000u) * rs * g1[3]);
        *(u32x2*)(yb + 32 + vy) = w;
        yb += (size_t)16 * D * 2; pp += 16 * 2; ow += 16 * 32; } }
}

constexpr int XC_LD = 392;
constexpr int RG_XC = 0, RG_PS = 100352, RG_CAR = 112640, RG_RSB = 114176, RG_PT = 114688, RG_HC = 116224;
template <int CTRL> __device__ __forceinline__ float dpp0(float v) { return __int_as_float(__builtin_amdgcn_update_dpp(0, __float_as_int(v), CTRL, 0xf, 0xf, true)); }
template <int CTRL> __device__ __forceinline__ float dppf(float old, float v) { return __int_as_float(__builtin_amdgcn_update_dpp(__float_as_int(old), __float_as_int(v), CTRL, 0xf, 0xf, false)); }
__device__ __forceinline__ void bf8_to_f32(const u32x4 o, float (&v)[8]) {
    v[0] = __uint_as_float(o.x << 16); v[1] = __uint_as_float(o.x & 0xffff0000u); v[2] = __uint_as_float(o.y << 16); v[3] = __uint_as_float(o.y & 0xffff0000u);
    v[4] = __uint_as_float(o.z << 16); v[5] = __uint_as_float(o.z & 0xffff0000u); v[6] = __uint_as_float(o.w << 16); v[7] = __uint_as_float(o.w & 0xffff0000u);
}
__device__ __forceinline__ float bcast15(float v) { return __int_as_float(__builtin_amdgcn_ds_swizzle(__float_as_int(v), 0x1F0)); }
template <int PASS>
__device__ __forceinline__ void rglru_unit(int unit, bool first, float& cprev, int tid, int wave, int lane, const bf16_t* Z, bf16_t* Y, const bf16_t* WRG, const bf16_t* WIG,
                                           const float* conv_w, const float* conv_b, const float* rg_b, const float* ig_b, const float* lam, const float* mo_gb,
                                           float* SUMA, float* SUMH, float* SUMA2, float* SUMH2, bf16_t* HL, bf16_t* PP, LAS unsigned char* lds) {
    LAS bf16_t* xcl = (LAS bf16_t*)(lds + RG_XC); LAS float* PS = (LAS float*)(lds + RG_PS); LAS float* CAR = (LAS float*)(lds + RG_CAR); LAS float* RSB = (LAS float*)(lds + RG_RSB); LAS float* PT = (LAS float*)(lds + RG_PT); LAS float* HC = (LAS float*)(lds + RG_HC);
    const int t0 = unit * 128; const int ln = lane & 15, q = lane >> 4;
    if (tid < 384) {
        const int c0 = (tid % 48) * 8, tg = tid / 48; const int tb = t0 + tg * 16, s0 = tb % SEQ;
        float w0[8], w1[8], w2[8], w3[8], bb[8];
#pragma unroll
        for (int hh = 0; hh < 2; ++hh) { const f32x4 a0 = *(const f32x4*)(conv_w + 0 * BW + c0 + 4 * hh), a1 = *(const f32x4*)(conv_w + 1 * BW + c0 + 4 * hh), a2 = *(const f32x4*)(conv_w + 2 * BW + c0 + 4 * hh), a3 = *(const f32x4*)(conv_w + 3 * BW + c0 + 4 * hh), a4 = *(const f32x4*)(conv_b + c0 + 4 * hh);
#pragma unroll
            for (int j = 0; j < 4; ++j) { w0[4 * hh + j] = a0[j]; w1[4 * hh + j] = a1[j]; w2[4 * hh + j] = a2[j]; w3[4 * hh + j] = a3[j]; bb[4 * hh + j] = a4[j]; } }
        float xm1[8], xm2[8], xm3[8];
        const bf16_t* zp = Z + (size_t)tb * INC + ZX + c0;
        { const u32x4 z4 = {0u, 0u, 0u, 0u}; const u32x4 o1 = s0 >= 1 ? *(const u32x4*)(zp - INC) : z4, o2 = s0 >= 2 ? *(const u32x4*)(zp - 2 * INC) : z4, o3 = s0 >= 3 ? *(const u32x4*)(zp - 3 * INC) : z4;
          bf8_to_f32(o1, xm1); bf8_to_f32(o2, xm2); bf8_to_f32(o3, xm3); }
        LAS bf16_t* xw = xcl + (tg * 16) * XC_LD + c0;
#pragma unroll 4
        for (int i = 0; i < 16; ++i) { float x0[8]; bf8_to_f32(*(const u32x4*)(zp), x0); float v[8];
#pragma unroll
            for (int j = 0; j < 8; ++j) { v[j] = bb[j] + w3[j] * x0[j] + w2[j] * xm1[j] + w1[j] * xm2[j] + w0[j] * xm3[j]; xm3[j] = xm2[j]; xm2[j] = xm1[j]; xm1[j] = x0[j]; }
            u32x4 w; w.x = cvt_pk_bf16(v[0], v[1]); w.y = cvt_pk_bf16(v[2], v[3]); w.z = cvt_pk_bf16(v[4], v[5]); w.w = cvt_pk_bf16(v[6], v[7]);
            *(LAS u32x4*)(xw) = w; zp += INC; xw += XC_LD; }
        if (PASS == 2) { const int c = tid; float h;
            if (first) { const int pr = unit >> 1, p0 = pr - (pr % (UPB128 / 2)); h = 0.f; const float* pa = SUMA2 + (size_t)p0 * BW + c; const float* ph = SUMH2 + (size_t)p0 * BW + c;
#pragma unroll 8
                for (int j = p0; j < pr; ++j) { h = fmaf(*pa, h, *ph); pa += BW; ph += BW; } }
            else h = fmaf(SUMA[(size_t)(unit - 1) * BW + c], cprev, SUMH[(size_t)(unit - 1) * BW + c]);
            cprev = h; CAR[c] = h; }
    }
    __syncthreads();
#pragma unroll 1
    for (int ci = 0; ci < 3; ++ci) {
        const int combo = wave + 8 * ci, h = combo >> 2, jt = combo & 3, cb = h * 64 + jt * 16;
        const bf16_t* wr = WRG + ((size_t)(h * 64 + jt * 16 + ln)) * 64 + 8 * q; const bf16_t* wi = WIG + ((size_t)(h * 64 + jt * 16 + ln)) * 64 + 8 * q;
        const bf16x8 RG0 = *(const bf16x8*)(wr), RG1 = *(const bf16x8*)(wr + 32), IG0 = *(const bf16x8*)(wi), IG1 = *(const bf16x8*)(wi + 32);
        const f32x4 rgb4 = *(const f32x4*)(rg_b + cb + 4 * q), igb4 = *(const f32x4*)(ig_b + cb + 4 * q), lam4 = *(const f32x4*)(lam + cb + 4 * q);
        const float m1 = ln < 1 ? 1.f : 0.f, m2 = ln < 2 ? 1.f : 0.f, m4 = ln < 4 ? 1.f : 0.f, m8 = ln < 8 ? 1.f : 0.f;
        float spc[4], car[4], ptot[4];
#pragma unroll
        for (int r = 0; r < 4; ++r) { spc[r] = -8.0f * 1.4426950408889634f * log1pf(expf(-lam4[r])); car[r] = PASS == 2 ? CAR[cb + 4 * q + r] : (first ? 0.f : HC[cb + 4 * q + r]); ptot[r] = (PASS == 1 && !first) ? PT[cb + 4 * q + r] : 1.f; }
        const LAS bf16_t* xb = xcl + ln * XC_LD + h * 64 + 8 * q; const LAS bf16_t* xv = xcl + ln * XC_LD + cb + 4 * q;
        const bf16_t* zg = Z + (size_t)(t0 + ln) * INC + ZG + cb + 4 * q; bf16_t* yo = Y + (size_t)(t0 + ln) * D + AW + cb + 4 * q; LAS float* psw = PS + ln * 24 + combo;
        bf16_t* hlo = HL + (size_t)(t0 + ln) * BW + cb + 4 * q; bf16_t* ppo = PP + (size_t)(t0 + ln) * BW + cb + 4 * q;
#pragma unroll 1
        for (int tt = 0; tt < 8; ++tt) {
            const bf16x8 B0 = *(const LAS bf16x8*)(xb), B1 = *(const LAS bf16x8*)(xb + 32);
            f32x4 ar = (f32x4){0.f, 0.f, 0.f, 0.f}, ai = (f32x4){0.f, 0.f, 0.f, 0.f};
            ar = mfma16(RG0, B0, ar); ar = mfma16(RG1, B1, ar); ai = mfma16(IG0, B0, ai); ai = mfma16(IG1, B1, ai);
            const u32x2 xq = *(const LAS u32x2*)(xv); float xc4[4] = {__uint_as_float(xq.x << 16), __uint_as_float(xq.x & 0xffff0000u), __uint_as_float(xq.y << 16), __uint_as_float(xq.y & 0xffff0000u)};
            float hv[4], pv[4];
#pragma unroll
            for (int r = 0; r < 4; ++r) {
                const float rr = sigmoid_fast(ar[r] + rgb4[r]), ii = sigmoid_fast(ai[r] + igb4[r]);
                float A = __builtin_amdgcn_exp2f(spc[r] * rr);
                float Bv = __builtin_amdgcn_sqrtf(fmaxf(1.0f - A * A, 0.f)) * (ii * xc4[r]);
                if (ln == 0) { Bv = fmaf(A, car[r], Bv); A *= ptot[r]; }
                { const float As = dpp0<0x111>(A) + m1, Bs = dpp0<0x111>(Bv); Bv = fmaf(A, Bs, Bv); A *= As; }
                { const float As = dpp0<0x112>(A) + m2, Bs = dpp0<0x112>(Bv); Bv = fmaf(A, Bs, Bv); A *= As; }
                { const float As = dpp0<0x114>(A) + m4, Bs = dpp0<0x114>(Bv); Bv = fmaf(A, Bs, Bv); A *= As; }
                { const float As = dpp0<0x118>(A) + m8, Bs = dpp0<0x118>(Bv); Bv = fmaf(A, Bs, Bv); A *= As; }
                hv[r] = Bv; pv[r] = A; car[r] = dppf<0x121>(Bv, Bv); ptot[r] = dppf<0x121>(A, A);
            }
            if (PASS == 1) { u32x2 w; w.x = cvt_pk_bf16(hv[0], hv[1]); w.y = cvt_pk_bf16(hv[2], hv[3]); *(u32x2*)(hlo) = w; w.x = cvt_pk_bf16(pv[0], pv[1]); w.y = cvt_pk_bf16(pv[2], pv[3]); *(u32x2*)(ppo) = w; hlo += 16 * BW; ppo += 16 * BW; }
            if (PASS == 2) { const u32x2 gq = *(const u32x2*)(zg);
                const float y0 = hv[0] * __uint_as_float(gq.x << 16), y1 = hv[1] * __uint_as_float(gq.x & 0xffff0000u), y2 = hv[2] * __uint_as_float(gq.y << 16), y3 = hv[3] * __uint_as_float(gq.y & 0xffff0000u);
                u32x2 w; w.x = cvt_pk_bf16(y0, y1); w.y = cvt_pk_bf16(y2, y3); *(u32x2*)(yo) = w;
                float ss = (y0 * y0 + y1 * y1) + (y2 * y2 + y3 * y3); ss += __shfl_xor(ss, 16); ss += __shfl_xor(ss, 32);
                if (q == 0) *psw = ss; }
            xb += 16 * XC_LD; xv += 16 * XC_LD; zg += 16 * INC; yo += 16 * D; psw += 16 * 24;
        }
        if (PASS == 1 && ln == 0) {
            float* da = first ? SUMA + (size_t)unit * BW : SUMA2 + (size_t)(unit >> 1) * BW; float* dh = first ? SUMH + (size_t)unit * BW : SUMH2 + (size_t)(unit >> 1) * BW;
#pragma unroll
            for (int r = 0; r < 4; ++r) { da[cb + 4 * q + r] = ptot[r]; dh[cb + 4 * q + r] = car[r]; if (first) { PT[cb + 4 * q + r] = ptot[r]; HC[cb + 4 * q + r] = car[r]; } } }
    }
    if (PASS == 2) {
        asm volatile("s_waitcnt vmcnt(0)" ::: "memory");
        __syncthreads();
        if (tid < 128) { float s = 0.f;
#pragma unroll
            for (int k = 0; k < 24; ++k) s += PS[tid * 24 + k];
            RSB[tid] = __builtin_amdgcn_rsqf(s * (1.0f / BW) + EPS); }
        __syncthreads();
#pragma unroll 2
        for (int k = 0; k < 12; ++k) { const int idx = tid + 512 * k, tl = idx / 48, c0 = (idx % 48) * 8; const float rs = RSB[tl];
            bf16_t* yp = Y + (size_t)(t0 + tl) * D + AW + c0; float v[8]; bf8_to_f32(*(const u32x4*)(yp), v);
            const f32x4 g0 = *(const f32x4*)(mo_gb + c0), g1 = *(const f32x4*)(mo_gb + c0 + 4);
            u32x4 w; w.x = cvt_pk_bf16(v[0] * rs * g0[0], v[1] * rs * g0[1]); w.y = cvt_pk_bf16(v[2] * rs * g0[2], v[3] * rs * g0[3]); w.z = cvt_pk_bf16(v[4] * rs * g1[0], v[5] * rs * g1[1]); w.w = cvt_pk_bf16(v[6] * rs * g1[2], v[7] * rs * g1[3]);
            *(u32x4*)(yp) = w; }
    }
    __syncthreads();
}

__device__ __forceinline__ void rglru_fix_pair(int pr, int tid, int wave, int lane, const bf16_t* Z, bf16_t* Y, const bf16_t* HL, const bf16_t* PP, const float* SUMA2, const float* SUMH2, const float* mo_gb, LAS unsigned char* lds) {
    LAS float* CAR = (LAS float*)(lds + RG_CAR);
    if (tid < 384) { const int c = tid, p0 = pr - (pr % (UPB128 / 2)); float h = 0.f; const float* pa = SUMA2 + (size_t)p0 * BW + c; const float* ph = SUMH2 + (size_t)p0 * BW + c;
#pragma unroll 8
        for (int j = p0; j < pr; ++j) { h = fmaf(*pa, h, *ph); pa += BW; ph += BW; }
        CAR[c] = h; }
    __syncthreads();
    {
        const bool act = lane < 48; const int c0 = act ? lane * 8 : 0; float hin[8]; const f32x4 g0 = *(const f32x4*)(mo_gb + c0), g1 = *(const f32x4*)(mo_gb + c0 + 4);
#pragma unroll
        for (int e = 0; e < 8; ++e) hin[e] = CAR[c0 + e];
#pragma unroll 2
        for (int i = 0; i < 32; ++i) { const size_t t = (size_t)pr * 256 + wave * 32 + i;
            float hl[8], pp[8], gg[8], y[8]; bf8_to_f32(*(const u32x4*)(HL + t * BW + c0), hl); bf8_to_f32(*(const u32x4*)(PP + t * BW + c0), pp); bf8_to_f32(*(const u32x4*)(Z + t * INC + ZG + c0), gg);
            float ss = 0.f;
#pragma unroll
            for (int e = 0; e < 8; ++e) { y[e] = fmaf(pp[e], hin[e], hl[e]) * gelu_fast(gg[e]); ss += y[e] * y[e]; }
            ss = wave_sum(act ? ss : 0.f);
            const float rs = __builtin_amdgcn_rsqf(ss * (1.0f / BW) + EPS);
            u32x4 w; w.x = cvt_pk_bf16(y[0] * rs * g0[0], y[1] * rs * g0[1]); w.y = cvt_pk_bf16(y[2] * rs * g0[2], y[3] * rs * g0[3]); w.z = cvt_pk_bf16(y[4] * rs * g1[0], y[5] * rs * g1[1]); w.w = cvt_pk_bf16(y[6] * rs * g1[2], y[7] * rs * g1[3]);
            if (act) *(u32x4*)(Y + t * D + AW + c0) = w; }
    }
    __syncthreads();
}

constexpr int VT_LD = 136;
__device__ __forceinline__ void mixa_unit(int unit, int tid, int wave, int lane, const bf16_t* Z, bf16_t* Y, const bf16_t* WSP, const float* a_sb, const float* vg, const float* mo_ga, LAS unsigned char* lds) {
    LAS bf16_t* vT = (LAS bf16_t*)lds; const int t0 = unit * 128; const int ln = lane & 15, q = lane >> 4;
    { const int j = tid >> 2, part = tid & 3; const bf16_t* zp = Z + (size_t)(t0 + j) * INC + ZV + part * 96;
      u32x4 raw[12]; float ss = 0.f;
#pragma unroll
      for (int k = 0; k < 12; ++k) { const u32x4 rw = *(const u32x4*)(zp + 8 * k); float v[8]; bf8_to_f32(rw, v);
#pragma unroll
          for (int e = 0; e < 8; ++e) { v[e] = gelu_fast(v[e]); ss += v[e] * v[e]; }
          raw[k].x = cvt_pk_bf16(v[0], v[1]); raw[k].y = cvt_pk_bf16(v[2], v[3]); raw[k].z = cvt_pk_bf16(v[4], v[5]); raw[k].w = cvt_pk_bf16(v[6], v[7]); }
      ss += x_xor1(ss); ss += x_xor2(ss);
      const float rs = __builtin_amdgcn_rsqf(ss * (1.0f / AW) + EPS);
      LAS bf16_t* vw = vT + (part * 96) * VT_LD + j; const float* gp = vg + part * 96;
#pragma unroll
      for (int k = 0; k < 12; ++k) { float v[8]; bf8_to_f32(raw[k], v); const f32x4 g0 = *(const f32x4*)(gp + 8 * k), g1 = *(const f32x4*)(gp + 8 * k + 4);
#pragma unroll
          for (int e = 0; e < 8; ++e) vw[(8 * k + e) * VT_LD] = f2bf(v[e] * rs * (e < 4 ? g0[e] : g1[e - 4])); } }
    __syncthreads();
    const bool full = wave >= 4;
    float ss = 0.f;
    const int tl = 16 * wave + ln;
    const char* ub = (const char*)(Z + (size_t)t0 * INC + ZU); const unsigned vu = (unsigned)(tl * INC + 4 * q) * 2u;
    const char* wb = (const char*)WSP; const unsigned vw = (unsigned)(tl * 128 + 8 * q) * 2u;
    char* yb = (char*)(Y + (size_t)t0 * D); const unsigned vy = (unsigned)(tl * D + 4 * q) * 2u;
    const bf16x8 z8 = {0, 0, 0, 0, 0, 0, 0, 0};
    bf16x8 Wn0 = ldg<bf16x8>(wb, vw), Wn1 = ldg<bf16x8>(wb + 64, vw), Wn2 = z8, Wn3 = z8;
    if (full) { Wn2 = ldg<bf16x8>(wb + 128, vw); Wn3 = ldg<bf16x8>(wb + 192, vw); }
    u32x2 un0 = ldg<u32x2>(ub, vu), un1 = ldg<u32x2>(ub + 32, vu), un2 = ldg<u32x2>(ub + 64, vu), un3 = ldg<u32x2>(ub + 96, vu); float bn = a_sb[tl];
    const LAS bf16_t* ap = vT + ln * VT_LD + 8 * q;
    u32x2 val[24];
#pragma unroll
    for (int h = 0; h < 6; ++h) {
        const bf16x8 W0 = Wn0, W1 = Wn1, W2 = Wn2, W3 = Wn3; const u32x2 uc[4] = {un0, un1, un2, un3}; const float b = bn;
        if (h < 5) { const char* wq = wb + (size_t)(h + 1) * 128 * 128 * 2; const char* uq2 = ub + (h + 1) * 128;
            Wn0 = ldg<bf16x8>(wq, vw); Wn1 = ldg<bf16x8>(wq + 64, vw); if (full) { Wn2 = ldg<bf16x8>(wq + 128, vw); Wn3 = ldg<bf16x8>(wq + 192, vw); }
            un0 = ldg<u32x2>(uq2, vu); un1 = ldg<u32x2>(uq2 + 32, vu); un2 = ldg<u32x2>(uq2 + 64, vu); un3 = ldg<u32x2>(uq2 + 96, vu); bn = a_sb[(h + 1) * 128 + tl]; }
        asm volatile("" ::: "memory");
#pragma unroll
        for (int dt = 0; dt < 4; ++dt) { f32x4 acc = (f32x4){0.f, 0.f, 0.f, 0.f};
            const LAS bf16_t* aq = ap + (h * 64 + 16 * dt) * VT_LD;
            const bf16x8 a0 = *(const LAS bf16x8*)(aq), a1 = *(const LAS bf16x8*)(aq + 32), a2 = *(const LAS bf16x8*)(aq + 64), a3 = *(const LAS bf16x8*)(aq + 96);
            acc = mfma16(a0, W0, acc); acc = mfma16(a1, W1, acc); acc = mfma16(a2, W2, acc); acc = mfma16(a3, W3, acc);
            const u32x2 u2 = uc[dt];
            const float v0 = gelu_fast(__uint_as_float(u2.x << 16)) * (acc[0] + b), v1 = gelu_fast(__uint_as_float(u2.x & 0xffff0000u)) * (acc[1] + b), v2 = gelu_fast(__uint_as_float(u2.y << 16)) * (acc[2] + b), v3 = gelu_fast(__uint_as_float(u2.y & 0xffff0000u)) * (acc[3] + b);
            ss += (v0 * v0 + v1 * v1) + (v2 * v2 + v3 * v3);
            u32x2 pk; pk.x = cvt_pk_bf16(v0, v1); pk.y = cvt_pk_bf16(v2, v3); val[h * 4 + dt] = pk; }
    }
    ss = add_x16_x32(ss);
    const float rs = __builtin_amdgcn_rsqf(ss * (1.0f / AW) + EPS);
    { const char* gb = (const char*)mo_ga; const unsigned vg4 = (unsigned)(4 * q) * 4u;
#pragma unroll
      for (int k = 0; k < 24; ++k) { const f32x4 gg = ldg<f32x4>(gb + k * 64, vg4); const u32x2 pk = val[k];
          u32x2 w; w.x = cvt_pk_bf16(__uint_as_float(pk.x << 16) * rs * gg[0], __uint_as_float(pk.x & 0xffff0000u) * rs * gg[1]); w.y = cvt_pk_bf16(__uint_as_float(pk.y << 16) * rs * gg[2], __uint_as_float(pk.y & 0xffff0000u) * rs * gg[3]);
          *(u32x2*)(yb + k * 32 + vy) = w; } }
    __syncthreads();
}

__device__ __forceinline__ void router_unit(int unit, int wave, int lane, const bf16_t* HB, const float* SSQ, const bf16_t* WRT, const float* rgb, const float* reb,
                                            int* CLS, float* G2, LAS unsigned char* lds, LAS int* hist) {
    const int ln = lane & 15, q = lane >> 4; const int t0 = unit * UT + wave * 32;
    LAS float* LG = (LAS float*)(lds + wave * 8192);
    f32x4 acc[2][3];
#pragma unroll
    for (int tt = 0; tt < 2; ++tt)
#pragma unroll
        for (int j = 0; j < 3; ++j) acc[tt][j] = (f32x4){0.f, 0.f, 0.f, 0.f};
    const bf16_t* hp0 = HB + (size_t)(t0 + ln) * D + 8 * q; const bf16_t* hp1 = hp0 + (size_t)16 * D; const bf16_t* wp = WRT + (size_t)ln * D + 8 * q;
#pragma unroll 4
    for (int ks = 0; ks < 32; ++ks) {
        const bf16x8 b0 = *(const bf16x8*)(hp0), b1 = *(const bf16x8*)(hp1);
        const bf16x8 a0 = *(const bf16x8*)(wp), a1 = *(const bf16x8*)(wp + 16 * D), a2 = *(const bf16x8*)(wp + 32 * D);
        acc[0][0] = mfma16(a0, b0, acc[0][0]); acc[0][1] = mfma16(a1, b0, acc[0][1]); acc[0][2] = mfma16(a2, b0, acc[0][2]);
        acc[1][0] = mfma16(a0, b1, acc[1][0]); acc[1][1] = mfma16(a1, b1, acc[1][1]); acc[1][2] = mfma16(a2, b1, acc[1][2]);
        hp0 += 32; hp1 += 32; wp += 32; }
#pragma unroll
    for (int tt = 0; tt < 2; ++tt)
#pragma unroll
        for (int j = 0; j < 3; ++j) *(LAS f32x4*)(LG + (16 * tt + ln) * 48 + 16 * j + 4 * q) = acc[tt][j];
    asm volatile("s_waitcnt lgkmcnt(0)" ::: "memory");
    if (lane < 32) { const int t = t0 + lane; const LAS float* lg = LG + lane * 48;
        const f32x4* sp = (const f32x4*)(SSQ + (size_t)t * 16); const f32x4 s0 = sp[0], s1 = sp[1], s2 = sp[2], s3 = sp[3];
        const float sq = ((s0[0] + s0[1]) + (s0[2] + s0[3])) + ((s1[0] + s1[1]) + (s1[2] + s1[3])) + ((s2[0] + s2[1]) + (s2[2] + s2[3])) + ((s3[0] + s3[1]) + (s3[2] + s3[3]));
        const float r = rsqrtf(sq * (1.0f / D) + EPS);
        float gl[4];
#pragma unroll
        for (int j = 0; j < 4; ++j) gl[j] = r * (lg[j] + lg[16 + j]) + rgb[j];
        int gs = 0; float gm = gl[0];
#pragma unroll
        for (int j = 1; j < 4; ++j) if (gl[j] > gm) { gm = gl[j]; gs = j; }
        float den = 0.f;
#pragma unroll
        for (int j = 0; j < 4; ++j) den += expf(gl[j] - gm);
        const float gwt = 1.0f / den;
        float el[4];
#pragma unroll
        for (int j = 0; j < 4; ++j) { float v;
            if (gs < 3) v = lg[4 + 4 * gs + j] + lg[16 + 4 + 4 * gs + j]; else v = lg[32 + j] + lg[36 + j];
            el[j] = r * v + reb[gs * 4 + j]; }
        int i0 = 0; float v0 = el[0];
#pragma unroll
        for (int j = 1; j < 4; ++j) if (el[j] > v0) { v0 = el[j]; i0 = j; }
        int i1 = 0; float v1 = -3.0e38f;
#pragma unroll
        for (int j = 0; j < 4; ++j) if (j != i0 && el[j] > v1) { v1 = el[j]; i1 = j; }
        const float e1 = expf(v1 - v0); const float w0 = gwt / (1.0f + e1), w1 = gwt * e1 / (1.0f + e1);
        const int lo = i0 < i1 ? i0 : i1, hi = i0 < i1 ? i1 : i0; const int cls = gs * 6 + pair_idx(lo, hi);
        CLS[t] = cls; G2[(size_t)t * 2 + 0] = i0 < i1 ? w0 : w1; G2[(size_t)t * 2 + 1] = i0 < i1 ? w1 : w0;
        __hip_atomic_fetch_add(hist + cls, 1, __ATOMIC_RELAXED, __HIP_MEMORY_SCOPE_WORKGROUP); }
}

__device__ __forceinline__ void tr_item8(const float* W, int ldw, int k0, int scol0, unsigned char* WT, int ldo, int drow0, int dk0, LAS float* scr, int lane) {
#pragma unroll 8
    for (int i = 0; i < 32; ++i) { const int kk = 2 * i + (lane >> 5); scr[kk * 33 + (lane & 31)] = W[(size_t)(k0 + kk) * ldw + scol0 + (lane & 31)] * pg8::FS_W; }
    asm volatile("s_waitcnt lgkmcnt(0)" ::: "memory");
    const int c = lane & 7;
#pragma unroll
    for (int j = 0; j < 4; ++j) { const int n = (lane >> 3) + 8 * j; const LAS float* s = scr + (8 * c) * 33 + n;
        u32x2 o; o.x = pk_fp8x4(s[0 * 33], s[1 * 33], s[2 * 33], s[3 * 33]); o.y = pk_fp8x4(s[4 * 33], s[5 * 33], s[6 * 33], s[7 * 33]);
        *(u32x2*)(WT + (size_t)(drow0 + n) * ldo + dk0 + 8 * c) = o; }
    asm volatile("s_waitcnt lgkmcnt(0)" ::: "memory");
}
struct TrP { const float* src; const float* gk; unsigned char* dst; int ldw, ldo, fp8; };
__device__ __forceinline__ void tr_load(const TrP& P, int lane, float (&v)[32]) {
#pragma unroll
    for (int i = 0; i < 32; ++i) { const int kk = 2 * i + (lane >> 5); float x = P.src[(size_t)kk * P.ldw + (lane & 31)]; if (P.gk) x *= P.gk[kk]; v[i] = x; }
}
__device__ __forceinline__ void tr_store(const TrP& P, int lane, const float (&v)[32], LAS float* scr) {
    const float sc = P.fp8 ? pg8::FS_W : 1.0f;
#pragma unroll
    for (int i = 0; i < 32; ++i) scr[(2 * i + (lane >> 5)) * 33 + (lane & 31)] = v[i] * sc;
    asm volatile("s_waitcnt lgkmcnt(0)" ::: "memory");
    const int c = lane & 7;
#pragma unroll
    for (int j = 0; j < 4; ++j) { const int n = (lane >> 3) + 8 * j; const LAS float* s = scr + (8 * c) * 33 + n;
        if (P.fp8) { u32x2 o; o.x = pk_fp8x4(s[0 * 33], s[1 * 33], s[2 * 33], s[3 * 33]); o.y = pk_fp8x4(s[4 * 33], s[5 * 33], s[6 * 33], s[7 * 33]); *(u32x2*)(P.dst + (size_t)n * P.ldo + 8 * c) = o; }
        else { u32x4 o; o.x = cvt_pk_bf16(s[0 * 33], s[1 * 33]); o.y = cvt_pk_bf16(s[2 * 33], s[3 * 33]); o.z = cvt_pk_bf16(s[4 * 33], s[5 * 33]); o.w = cvt_pk_bf16(s[6 * 33], s[7 * 33]); *(u32x4*)(P.dst + (size_t)n * P.ldo + 16 * c) = o; } }
    asm volatile("s_waitcnt lgkmcnt(0)" ::: "memory");
}
struct Args { const float* in[34]; float* out; unsigned char* ws; };

__global__ void __launch_bounds__(512, 2) mega_fwd(Args a) {
    extern __shared__ __attribute__((aligned(16))) unsigned char lds_raw[];
    LAS unsigned char* lds = (LAS unsigned char*)lds_raw;
    volatile LAS unsigned* LW = (volatile LAS unsigned*)(lds + LDSCTL_OFF);
    volatile LAS int* LWI = (volatile LAS int*)(lds + LDSCTL_OFF);
    const int G = gridDim.x, bid0 = blockIdx.x; const int wave_s0 = __builtin_amdgcn_readfirstlane(threadIdx.x >> 6);
#define PHASE_IDS() int wv_ = wave_s0, bd_ = bid0; asm volatile("" : "+s"(wv_), "+s"(bd_)); const int wave_s = wv_, bid = bd_;     \
    const int lane = fresh_lane(), wave = wave_s, tid = wave * 64 + lane; const int gw = bid * 8 + wave, NGW = G * 8; \
    const size_t gt = (size_t)bid * 512 + tid, NGT = (size_t)G * 512; (void)lane; (void)wave; (void)gw; (void)NGW; (void)gt; (void)NGT
#define WSB() ({ unsigned char* _w = a.ws; asm volatile("" : "+s"(_w)); _w; })
#define INP(i) ({ int _k = (i); asm volatile("" : "+s"(_k)); a.in[_k]; })
    for (int u = threadIdx.x; u < (LDS_PF - LDSCTL_OFF) / 4; u += 512) LW[u] = 0u;
    __syncthreads();
    XcdBarrier bar = xcd_barrier_post((unsigned*)(a.ws + WS_CTL) + CW_BAR, LW + LW_BAR);

    {
        PHASE_IDS(); unsigned char* ws = WSB(); bf16_t* WIN = (bf16_t*)(ws + WS_WIN); bf16_t* WOUT = (bf16_t*)(ws + WS_WOUT); bf16_t* WGU = (bf16_t*)(ws + WS_WGU); bf16_t* WD2 = (bf16_t*)(ws + WS_WD2);
        bf16_t* HB = (bf16_t*)(ws + WS_HB); float* SSQ = (float*)(ws + WS_SSQ);
        LAS float* scr = (LAS float*)(lds + wave * 16384);
        constexpr int I_IN = 16 * 56, I_OUT = 16 * 32, I_GU = 2 * 16 * 256, I_D8 = 16 * 256, I_GLU = 32, I_RG = 24, I_L = I_IN + I_OUT + I_GU + I_D8 + I_GLU + I_RG;
        const float* i_win = INP(2); const float* i_g = INP(1); const float* i_wout = INP(24); const float* i_wg = INP(30); const float* i_wu = INP(31); const float* i_wd = INP(32);
        const float* i_glu = INP(21); const float* i_rg = INP(8); const float* i_ig = INP(10);
#define TR_DECODE(P, it) do { const int l = (it) / I_L; int r = (it) % I_L; P.gk = nullptr; P.fp8 = 0; \
            if (r < I_IN) { const int kb = r / 56, nb = r % 56, j0 = nb * 32; const int sc = j0 < 768 ? j0 : (j0 < 1152 ? j0 + 384 : (j0 < 1536 ? j0 - 384 : j0));     \
                P.src = i_win + (size_t)l * D * INC + (size_t)kb * 64 * INC + sc; P.ldw = INC; P.gk = i_g + (size_t)l * D + kb * 64; P.dst = (unsigned char*)(WIN + (size_t)l * INC * D + (size_t)j0 * D + kb * 64); P.ldo = D * 2; } \
            else if ((r -= I_IN) < I_OUT) { const int kb = r / 32, nb = r % 32; P.src = i_wout + (size_t)l * D * D + (size_t)kb * 64 * D + nb * 32; P.ldw = D; P.dst = (unsigned char*)(WOUT + (size_t)l * D * D + (size_t)nb * 32 * D + kb * 64); P.ldo = D * 2; } \
            else if ((r -= I_OUT) < I_GU) { const int which = r / (16 * 256), e = (r / 256) % 16, q = r % 256, kb = q / 16, nb = q % 16, n0 = nb * 32;     \
                P.src = (which ? i_wu : i_wg) + ((size_t)l * NE + e) * D * DE + (size_t)kb * 64 * DE + n0; P.ldw = DE; P.fp8 = 1; \
                P.dst = (unsigned char*)WGU + ((size_t)l * NE + e) * 1024 * 1024 + (size_t)((n0 / 128) * 256 + which * 128 + (n0 % 128)) * 1024 + kb * 64; P.ldo = 1024; } \
            else if ((r -= I_GU) < I_D8) { const int e = r / 256, q = r % 256, kb = q / 32, nb = q % 32;        \
                P.src = i_wd + ((size_t)l * NE + e) * DE * D + (size_t)kb * 64 * D + nb * 32; P.ldw = D; P.fp8 = 1; P.dst = ws + WS_WD8 + ((size_t)l * NE + e) * 1024 * 512 + (size_t)nb * 32 * 512 + kb * 64; P.ldo = 512; } \
            else if ((r -= I_D8) < I_GLU) { const int kb = r / 8, nb = r % 8; P.src = i_glu + (size_t)l * CW * CW + (size_t)kb * 64 * CW + nb * 32; P.ldw = CW; P.dst = (unsigned char*)((bf16_t*)(ws + WS_WGLU) + (size_t)l * CW * CW + (size_t)nb * 32 * CW + kb * 64); P.ldo = CW * 2; } \
            else { r -= I_GLU; const int gate = r / 12, h = (r / 2) % 6, nb = r & 1; \
                P.src = (gate ? i_ig : i_rg) + ((size_t)l * 6 + h) * 64 * 64 + nb * 32; P.ldw = 64; P.dst = (unsigned char*)((bf16_t*)(ws + WS_WRG) + (((size_t)l * 2 + gate) * 6 + h) * 64 * 64 + (size_t)nb * 32 * 64); P.ldo = 64 * 2; } } while (0)
        { TrP Pa, Pb; float va[32], vb[32]; int it = gw;
          if (it < 2 * I_L) { TR_DECODE(Pa, it); tr_load(Pa, lane, va); }
#pragma unroll 1
          while (it < 2 * I_L) {
              const int it1 = it + NGW; if (it1 < 2 * I_L) { TR_DECODE(Pb, it1); tr_load(Pb, lane, vb); }
              tr_store(Pa, lane, va, scr);
              if (it1 >= 2 * I_L) break;
              const int it2 = it1 + NGW; if (it2 < 2 * I_L) { TR_DECODE(Pa, it2); tr_load(Pa, lane, va); }
              tr_store(Pb, lane, vb, scr);
              it = it2; } }
#undef TR_DECODE
        { const float* s_are = INP(13); const float* s_aim = INP(14); const float* s_ldt = INP(15); const float* s_bre = INP(16); const float* s_bim = INP(17); const float* s_cre = INP(18); const float* s_cim = INP(19); const float* s_d = INP(20);
          for (size_t e = gt; e < (size_t)2 * CG * 256; e += NGT) { const int l = (int)(e / (CG * 256)), g = (int)((e / 256) % CG), c = (int)((e >> 4) & 15), cp = (int)(e & 15);
              s5_kt_pair(g, c, cp, s_are + (size_t)l * CG * CS, s_aim + (size_t)l * CG * CS, s_ldt + (size_t)l * CG, s_bre + (size_t)l * CG * CS * CGD, s_bim + (size_t)l * CG * CS * CGD,
                         s_cre + (size_t)l * CG * CGD * CS, s_cim + (size_t)l * CG * CGD * CS, s_d + (size_t)l * CW, ws + WS_S5 + (size_t)l * S5_L_STRIDE); }
          for (size_t e = gt; e < (size_t)2 * CG * 2048; e += NGT) { const int l = (int)(e / (CG * 2048)), g = (int)((e / 2048) % CG), r = (int)(e & 2047);
              s5_et_task(g, r >> 10, (r >> 4) & 63, r & 15, s_are + (size_t)l * CG * CS, s_aim + (size_t)l * CG * CS, s_ldt + (size_t)l * CG, s_bre + (size_t)l * CG * CS * CGD, s_bim + (size_t)l * CG * CS * CGD, ws + WS_S5 + (size_t)l * S5_L_STRIDE);
              s5_ft_task(g, r >> 7, (r >> 6) & 1, r & 63, s_are + (size_t)l * CG * CS, s_aim + (size_t)l * CG * CS, s_ldt + (size_t)l * CG, s_cre + (size_t)l * CG * CGD * CS, s_cim + (size_t)l * CG * CGD * CS, ws + WS_S5 + (size_t)l * S5_L_STRIDE); }
          for (size_t e = gt; e < (size_t)2 * CG * 64; e += NGT) { const int l = (int)(e / (CG * 64)), g = (int)((e / 64) % CG), el = 4096 + 32768 + (int)(e % 64);
              s5_table_elem(g, el, s_are + (size_t)l * CG * CS, s_aim + (size_t)l * CG * CS, s_ldt + (size_t)l * CG, s_bre + (size_t)l * CG * CS * CGD, s_bim + (size_t)l * CG * CS * CGD,
                            s_cre + (size_t)l * CG * CGD * CS, s_cim + (size_t)l * CG * CGD * CS, s_d + (size_t)l * CW, ws + WS_S5 + (size_t)l * S5_L_STRIDE); } }
        { const float* sw = INP(4); bf16_t* wsp = (bf16_t*)(ws + WS_WSP); for (size_t e = gt; e < (size_t)2 * 6 * 128 * 128; e += NGT) wsp[e] = f2bf(sw[e]); }
        { const float* fg = INP(25); const float* rgw = INP(26); const float* rew = INP(28); bf16_t* wrt = (bf16_t*)(ws + WS_WRT);
          for (size_t e = gt; e < (size_t)2 * 48 * D; e += NGT) { const int l = (int)(e / (48 * D)), n = (int)((e / D) % 48), k = (int)(e % D);
              int j = -1, lo = 0; if (n < 16) j = n; else if (n < 32) { j = n - 16; lo = 1; } else if (n < 36) j = 16 + (n - 32); else if (n < 40) { j = 16 + (n - 36); lo = 1; }
              float v = 0.f;
              if (j >= 0) { const float w = fg[(size_t)l * D + k] * (j < 4 ? rgw[((size_t)l * D + k) * 4 + j] : rew[(((size_t)l * 4 + ((j - 4) >> 2)) * D + k) * 4 + ((j - 4) & 3)]);
                  const float hi = bf2f(f2bf(w)); v = lo ? (w - hi) : w; }
              wrt[e] = f2bf(v); } }
        const float* xin = INP(0);
#pragma unroll 1
        for (int t = gw * 2; t < T; t += NGW * 2) {
            const f32x4* xr = (const f32x4*)(xin + (size_t)t * D) + lane; f32x4 v[2][4]; float s0 = 0.f, s1 = 0.f;
#pragma unroll
            for (int j = 0; j < 4; ++j) { v[0][j] = xr[64 * j]; v[1][j] = xr[256 + 64 * j]; }
#pragma unroll
            for (int j = 0; j < 4; ++j) { s0 += (v[0][j][0] * v[0][j][0] + v[0][j][1] * v[0][j][1]) + (v[0][j][2] * v[0][j][2] + v[0][j][3] * v[0][j][3]); s1 += (v[1][j][0] * v[1][j][0] + v[1][j][1] * v[1][j][1]) + (v[1][j][2] * v[1][j][2] + v[1][j][3] * v[1][j][3]); }
            u32x2* o8 = (u32x2*)(HB + (size_t)t * D) + lane;
#pragma unroll
            for (int j = 0; j < 4; ++j) { u32x2 w; w.x = cvt_pk_bf16(v[0][j][0], v[0][j][1]); w.y = cvt_pk_bf16(v[0][j][2], v[0][j][3]); o8[64 * j] = w; w.x = cvt_pk_bf16(v[1][j][0], v[1][j][1]); w.y = cvt_pk_bf16(v[1][j][2], v[1][j][3]); o8[256 + 64 * j] = w; }
            s0 = wave_sum(s0); s1 = wave_sum(s1);
            if (lane < 32) SSQ[(size_t)t * 16 + lane] = lane == 0 ? s0 : (lane == 16 ? s1 : 0.f);
        }
    }
    xcd_barrier(bar);

    for (int l = 0; l < DEPTH; ++l) {
        { PHASE_IDS(); unsigned char* ws = WSB(); bf16_t* WIN = (bf16_t*)(ws + WS_WIN); bf16_t* HB = (bf16_t*)(ws + WS_HB); float* SSQ = (float*)(ws + WS_SSQ); bf16_t* Z = (bf16_t*)(ws + WS_Z);
          pg8::StaticOrder<T, INC> S; S.init(HB, WIN + (size_t)l * INC * D, G, bid);
          pg8::EpiZ E{Z, SSQ, lds + LDS_PF};
          pg8::gemm_phase<pg8::EpiZ, pg8::StaticOrder<T, INC>, true, true>(lds, wave_s, S, E); }
        xcd_barrier(bar);

        {
            PHASE_IDS(); unsigned char* ws = WSB(); const bf16_t* Z = (const bf16_t*)(ws + WS_Z);
            const float* conv_w = INP(6) + (size_t)l * 4 * BW; const float* conv_b = INP(7) + (size_t)l * BW; const float* rg_b = INP(9) + (size_t)l * BW;
            const float* ig_b = INP(11) + (size_t)l * BW; const float* lam = INP(12) + (size_t)l * BW;
            __syncthreads();
            { const bf16_t* WRG = (const bf16_t*)(ws + WS_WRG) + ((size_t)l * 2 + 0) * 6 * 4096; const bf16_t* WIG = (const bf16_t*)(ws + WS_WRG) + ((size_t)l * 2 + 1) * 6 * 4096;
              for (int pr = bid; pr < NU128 / 2; pr += G) { float cp = 0.f;
                  rglru_unit<1>(2 * pr, true, cp, tid, wave, lane, Z, nullptr, WRG, WIG, conv_w, conv_b, rg_b, ig_b, lam, nullptr, (float*)(ws + WS_SUMA), (float*)(ws + WS_SUMH), (float*)(ws + WS_SUMA2), (float*)(ws + WS_SUMH2), (bf16_t*)(ws + WS_HL), (bf16_t*)(ws + WS_PP), lds);
                  rglru_unit<1>(2 * pr + 1, false, cp, tid, wave, lane, Z, nullptr, WRG, WIG, conv_w, conv_b, rg_b, ig_b, lam, nullptr, (float*)(ws + WS_SUMA), (float*)(ws + WS_SUMH), (float*)(ws + WS_SUMA2), (float*)(ws + WS_SUMH2), (bf16_t*)(ws + WS_HL), (bf16_t*)(ws + WS_PP), lds); } }
            for (int pr = bid; pr < NU128 / 2; pr += G) { const unsigned char* tab = ws + WS_S5 + (size_t)l * S5_L_STRIDE;
                s5_pair1(pr, 2 * wave, wave, lane, Z, (bf16_t*)(ws + WS_Y), tab, (float*)(ws + WS_SEND), (float*)(ws + WS_SEND2), (float*)(ws + WS_SE), lds);
                s5_pair1(pr, 2 * wave + 1, wave, lane, Z, (bf16_t*)(ws + WS_Y), tab, (float*)(ws + WS_SEND), (float*)(ws + WS_SEND2), (float*)(ws + WS_SE), lds); }
            __syncthreads();
            { const bf16_t* WSP = (const bf16_t*)(ws + WS_WSP) + (size_t)l * 6 * 128 * 128; const float* a_sb = INP(5) + (size_t)l * 6 * 128; const float* vg = INP(3) + (size_t)l * AW; const float* mo_ga = INP(23) + (size_t)l * D;
              for (int u = bid; u < NU128; u += G) mixa_unit(u, tid, wave, lane, Z, (bf16_t*)(ws + WS_Y), WSP, a_sb, vg, mo_ga, lds); }
        }
        xcd_barrier(bar);

        {
            PHASE_IDS(); unsigned char* ws = WSB(); const bf16_t* Z = (const bf16_t*)(ws + WS_Z); bf16_t* Y = (bf16_t*)(ws + WS_Y);
            const float* a_v_norm_g = INP(3) + (size_t)l * AW; const float* a_sw = INP(4) + (size_t)l * 6 * 128 * 128; const float* a_sb = INP(5) + (size_t)l * 6 * 128;
        }

        { PHASE_IDS(); unsigned char* ws = WSB(); const bf16_t* Z = (const bf16_t*)(ws + WS_Z); bf16_t* Y = (bf16_t*)(ws + WS_Y);
          { const float* mo_gb = INP(23) + (size_t)l * D + AW;
            __syncthreads();
            for (int pr = bid; pr < NU128 / 2; pr += G) rglru_fix_pair(pr, tid, wave, lane, Z, Y, (const bf16_t*)(ws + WS_HL), (const bf16_t*)(ws + WS_PP), (const float*)(ws + WS_SUMA2), (const float*)(ws + WS_SUMH2), mo_gb, lds); }
          { const bf16_t* WGLU = (const bf16_t*)(ws + WS_WGLU) + (size_t)l * CW * CW; const float* glu_b = INP(22) + (size_t)l * CW; const float* mo_gc = INP(23) + (size_t)l * D + AW + BW;
            for (int pr = bid; pr < NU128 / 2; pr += G) { float k0r = 0.f, k0i = 0.f, k1r = 0.f, k1i = 0.f; const unsigned char* tab = ws + WS_S5 + (size_t)l * S5_L_STRIDE;
#pragma unroll 1
                for (int ui = 0; ui < 2; ++ui) { const int u = 2 * pr + ui; __syncthreads();
                    s5_group<2>(u, 2 * wave, ui == 0, k0r, k0i, wave, lane, Z, Y, tab, (float*)(ws + WS_SEND), (float*)(ws + WS_SEND2), (float*)(ws + WS_SE), lds);
                    s5_group<2>(u, 2 * wave + 1, ui == 0, k1r, k1i, wave, lane, Z, Y, tab, (float*)(ws + WS_SEND), (float*)(ws + WS_SEND2), (float*)(ws + WS_SE), lds);
                    __syncthreads(); s5_glu(u, wave, lane, WGLU, glu_b, mo_gc, Y, lds); } } } }
        asm volatile("s_waitcnt vmcnt(0)" ::: "memory"); __syncthreads();
        if (wave_s0 == 0) { __builtin_amdgcn_fence(__ATOMIC_ACQUIRE, "agent"); asm volatile("s_waitcnt vmcnt(0)" ::: "memory"); }
        __syncthreads();

        { PHASE_IDS(); unsigned char* ws = WSB(); bf16_t* WOUT = (bf16_t*)(ws + WS_WOUT); bf16_t* HB = (bf16_t*)(ws + WS_HB); float* SSQ = (float*)(ws + WS_SSQ); bf16_t* Y = (bf16_t*)(ws + WS_Y);
          pg8::PanelOrder<T, 4> S; S.init(Y, WOUT + (size_t)l * D * D, G, bid);
          pg8::EpiRes<false> E{HB, SSQ, nullptr, lds + LDS_PF};
          pg8::gemm_phase<pg8::EpiRes<false>, pg8::PanelOrder<T, 4>, true, true>(lds, wave_s, S, E); }
        asm volatile("s_waitcnt vmcnt(0)" ::: "memory"); __syncthreads();
        if (wave_s0 == 0) { __builtin_amdgcn_fence(__ATOMIC_ACQUIRE, "agent"); asm volatile("s_waitcnt vmcnt(0)" ::: "memory"); }
        __syncthreads();

        { PHASE_IDS(); unsigned char* ws = WSB(); const bf16_t* HB = (const bf16_t*)(ws + WS_HB); const float* SSQ = (const float*)(ws + WS_SSQ); int* CLS = (int*)(ws + WS_CLS); float* G2 = (float*)(ws + WS_G2); int* HIST = (int*)(ws + WS_HIST);
          const float* rgb = INP(27) + (size_t)l * 4; const float* reb = INP(29) + (size_t)l * 16;
        if (l == 0) {
            for (int rr = gw; rr < 2 * NCLS * 2 * 1024 / 2; rr += NGW) { const int row = 2 * rr + (lane >> 5), n = row & 1023, half = (row >> 10) & 1, cls = (row >> 11) % NCLS, ll = row / (2048 * NCLS);
                const int g = cls / 6, pi = cls % 6, e = g * 4 + (half ? pair_hi(pi) : pair_lo(pi));
                const u32x4 v = *(const u32x4*)(ws + WS_WD8 + ((size_t)ll * NE + e) * 1024 * 512 + (size_t)n * 512 + (lane & 31) * 16);
                *(u32x4*)(ws + WS_WD2 + ((size_t)ll * NCLS + cls) * 1024 * 1024 + (size_t)n * 1024 + half * 512 + (lane & 31) * 16) = v; } }
        for (int u = bid; u < NU; u += G) {
            router_unit(u, wave, lane, HB, SSQ, (const bf16_t*)(ws + WS_WRT) + (size_t)l * 48 * D, rgb, reb, CLS, G2, lds, (LAS int*)(lds + LDSCTL_OFF) + LW_HIST);
            __syncthreads();
            if (tid < 32) { HIST[u * 32 + tid] = tid < NCLS ? LWI[LW_HIST + tid] : 0; LWI[LW_HIST + tid] = 0; }
            __syncthreads();
        } }
        xcd_barrier(bar);

        { PHASE_IDS(); unsigned char* ws = WSB(); const bf16_t* HB = (const bf16_t*)(ws + WS_HB); const float* SSQ = (const float*)(ws + WS_SSQ); const int* CLS = (const int*)(ws + WS_CLS); const float* G2 = (const float*)(ws + WS_G2); const int* HIST = (const int*)(ws + WS_HIST);
          int* CTOT = (int*)(ws + WS_CTOT); int* ROWTOK = (int*)(ws + WS_ROWTOK); float* ROWG = (float*)(ws + WS_ROWG); bf16_t* HBS = (bf16_t*)(ws + WS_HBS); const float* ffn_g = INP(25) + (size_t)l * D;
        for (int u = bid; u < NU; u += G) {
            { const int c = tid & 31, part = tid >> 5; int tot = 0, pre = 0;
_Pragma("unroll 16")
              for (int k = part * 16; k < part * 16 + 16; ++k) { const int v = HIST[k * 32 + c]; tot += v; pre += k < u ? v : 0; }
              ((volatile LAS int*)lds)[tid] = tot; ((volatile LAS int*)lds)[512 + tid] = pre; }
            __syncthreads();
            if (tid < NCLS) { int tot = 0, pre = 0;
_Pragma("unroll")
                for (int k = 0; k < 16; ++k) { tot += ((volatile LAS int*)lds)[k * 32 + tid]; pre += ((volatile LAS int*)lds)[512 + k * 32 + tid]; } LWI[LW_TOT + tid] = tot; LWI[LW_BASE + tid] = pre; }
            __syncthreads();
            if (tid == 0) { int ps = 0;
_Pragma("unroll 1")
                for (int c = 0; c < NCLS; ++c) { const int tot = LWI[LW_TOT + c]; LWI[LW_BASE + c] += ps; LWI[LW_TST + c] = ps; ps += ((tot + 255) >> 8) << 8; if (bid == 0) CTOT[c] = tot; } LWI[LW_TST + NCLS] = ps; }
            if (tid < UT) LWI[LW_CLS + tid] = CLS[u * UT + tid];
            __syncthreads();
            if (tid < UT) { const int cls = LWI[LW_CLS + tid]; int rank = 0;
_Pragma("unroll 1")
                for (int i = 0; i < tid; ++i) rank += LWI[LW_CLS + i] == cls ? 1 : 0;
                const int dest = LWI[LW_BASE + cls] + rank; LWI[LW_DEST + tid] = dest; const int t = u * UT + tid;
                ROWTOK[dest] = t; ROWG[(size_t)dest * 2 + 0] = G2[(size_t)t * 2 + 0]; ROWG[(size_t)dest * 2 + 1] = G2[(size_t)t * 2 + 1]; }
            __syncthreads();
            { f32x4 gq[4];
#pragma unroll
              for (int j = 0; j < 4; ++j) gq[j] = *(const f32x4*)(ffn_g + lane * 16 + 4 * j);
#pragma unroll 1
              for (int i = 0; i < 32; i += 4) {
                  const int tl0 = wave * 32 + i, t0r = u * UT + tl0;
                  float sq = SSQ[(size_t)t0r * 16 + lane]; sq += x_xor1(sq); sq += x_xor2(sq); sq += x_hmir(sq); sq += x_mir(sq);
                  u32x4 o[4][2]; int dst[4];
#pragma unroll
                  for (int j = 0; j < 4; ++j) { o[j][0] = *(const u32x4*)(HB + (size_t)(t0r + j) * D + lane * 16); o[j][1] = *(const u32x4*)(HB + (size_t)(t0r + j) * D + lane * 16 + 8); dst[j] = LWI[LW_DEST + tl0 + j]; }
#pragma unroll
                  for (int j = 0; j < 4; ++j) { const float r4 = rsqrtf(__builtin_amdgcn_readlane(sq, 16 * j) * (1.0f / D) + EPS) * pg8::FS_H; u32x4 w;
#pragma unroll
                      for (int hh = 0; hh < 2; ++hh) { const u32x4 oo = o[j][hh]; const f32x4 g0 = gq[2 * hh], g1 = gq[2 * hh + 1];
                          const unsigned lo = pk_fp8x4(__uint_as_float(oo.x << 16) * r4 * g0[0], __uint_as_float(oo.x & 0xffff0000u) * r4 * g0[1], __uint_as_float(oo.y << 16) * r4 * g0[2], __uint_as_float(oo.y & 0xffff0000u) * r4 * g0[3]);
                          const unsigned hi = pk_fp8x4(__uint_as_float(oo.z << 16) * r4 * g1[0], __uint_as_float(oo.z & 0xffff0000u) * r4 * g1[1], __uint_as_float(oo.w << 16) * r4 * g1[2], __uint_as_float(oo.w & 0xffff0000u) * r4 * g1[3]);
                          if (hh == 0) { w.x = lo; w.y = hi; } else { w.z = lo; w.w = hi; } }
                      *(u32x4*)((unsigned char*)HBS + (size_t)dst[j] * D + lane * 16) = w; } } }
            if (u == bid)
_Pragma("unroll 1")
            for (int c = bid; c < NCLS; c += G) { const int tot = LWI[LW_TOT + c], r0 = LWI[LW_TST + c] + tot, r1 = LWI[LW_TST + c + 1];
                unsigned zz = 0u; asm volatile("" : "+v"(zz));
                for (int r = r0 + wave; r < r1; r += 8) { if (lane == 0) { ROWTOK[r] = -1; ROWG[(size_t)r * 2] = __uint_as_float(zz); ROWG[(size_t)r * 2 + 1] = __uint_as_float(zz); }
                    *(u32x4*)((unsigned char*)HBS + (size_t)r * D + lane * 16) = (u32x4){zz, zz, zz, zz}; } }
            __syncthreads();
        } }
        xcd_barrier(bar);

        { PHASE_IDS(); unsigned char* ws = WSB(); const int* CTOT = (const int*)(ws + WS_CTOT); bf16_t* HBS = (bf16_t*)(ws + WS_HBS); bf16_t* WGU = (bf16_t*)(ws + WS_WGU); bf16_t* ACT = (bf16_t*)(ws + WS_ACT); const float* ROWG = (const float*)(ws + WS_ROWG);
        if (tid == 0) { int ps = 0;
_Pragma("unroll 1")
            for (int c = 0; c < NCLS; ++c) { LWI[LW_TST + c] = ps; ps += (CTOT[c] + 255) >> 8; } LWI[LW_TST + NCLS] = ps; }
        __syncthreads();
        if (tid < 32) { const int ntile = LWI[LW_TST + NCLS]; const long L = (long)tid * G + bid; int e = -1;
            if (L < (long)ntile * 8) { const int nwg = ntile * 8, qq = nwg / 8, rr = nwg % 8, xcd = (int)(L % 8), off = (int)(L / 8); const int Lr = (xcd < rr ? xcd * (qq + 1) : rr * (qq + 1) + (xcd - rr) * qq) + off;
                const int mt = Lr / 8, pn = Lr % 8; int cls = 0;
_Pragma("unroll 1")
                for (int k = 1; k < NCLS; ++k) cls += (LWI[LW_TST + k] <= mt) ? 1 : 0;
                e = (cls << 24) | (pn << 16) | mt; }
            LWI[LW_UTAB + tid] = e; e = -1;
            if (L < (long)ntile * 4) { const int nwg = ntile * 4, qq = nwg / 8, rr = nwg % 8, xcd = (int)(L % 8), off = (int)(L / 8); const int Lr = (xcd < rr ? xcd * (qq + 1) : rr * (qq + 1) + (xcd - rr) * qq) + off;
                const int mt = Lr / 4, pn = Lr % 4; int cls = 0;
_Pragma("unroll 1")
                for (int k = 1; k < NCLS; ++k) cls += (LWI[LW_TST + k] <= mt) ? 1 : 0;
                e = (cls << 24) | (pn << 16) | mt; }
            LWI[LW_DTAB + tid] = e; }
        __syncthreads();
        { pg8::MoeOrder<8, true, 1024> S{LWI + LW_UTAB, l, (const char*)HBS, (const char*)WGU};
          pg8::EpiUp E{(unsigned char*)ACT, ROWG, lds + LDS_PF};
          pg8::gemm_phase<pg8::EpiUp, pg8::MoeOrder<8, true, 1024>, true, true, 512, true>(lds, wave_s, S, E); } }
        xcd_barrier(bar);

        { PHASE_IDS(); unsigned char* ws = WSB(); bf16_t* ACT = (bf16_t*)(ws + WS_ACT); bf16_t* WD2 = (bf16_t*)(ws + WS_WD2); bf16_t* HB = (bf16_t*)(ws + WS_HB); float* SSQ = (float*)(ws + WS_SSQ); const int* ROWTOK = (const int*)(ws + WS_ROWTOK);
          pg8::MoeOrder<4, false, 1024> S{LWI + LW_DTAB, l, (const char*)ACT, (const char*)WD2};
          pg8::EpiRes<true> E{HB, SSQ, ROWTOK, lds + LDS_PF};
          pg8::gemm_phase<pg8::EpiRes<true>, pg8::MoeOrder<4, false, 1024>, true, true, 512, true>(lds, wave_s, S, E); }
        xcd_barrier(bar);
    }

    { PHASE_IDS(); unsigned char* ws = WSB(); const bf16_t* HB = (const bf16_t*)(ws + WS_HB); const float* SSQ = (const float*)(ws + WS_SSQ); const float* fg = INP(33); float* outp = a.out;
    { f32x4 gq[4];
#pragma unroll
      for (int j = 0; j < 4; ++j) gq[j] = *(const f32x4*)(fg + lane * 16 + 4 * j);
#pragma unroll 1
      for (int t0r = gw * 4; t0r < T; t0r += NGW * 4) {
          float sq = SSQ[(size_t)t0r * 16 + lane]; sq += x_xor1(sq); sq += x_xor2(sq); sq += x_hmir(sq); sq += x_mir(sq);
          u32x4 o[4][2];
#pragma unroll
          for (int j = 0; j < 4; ++j) { o[j][0] = *(const u32x4*)(HB + (size_t)(t0r + j) * D + lane * 16); o[j][1] = *(const u32x4*)(HB + (size_t)(t0r + j) * D + lane * 16 + 8); }
#pragma unroll
          for (int j = 0; j < 4; ++j) { const float r = rsqrtf(__builtin_amdgcn_readlane(sq, 16 * j) * (1.0f / D) + EPS); float* orow = outp + (size_t)(t0r + j) * D + lane * 16;
#pragma unroll
              for (int hh = 0; hh < 2; ++hh) { const u32x4 oo = o[j][hh]; const f32x4 g0 = gq[2 * hh], g1 = gq[2 * hh + 1]; f32x4 w0, w1;
                  w0[0] = __uint_as_float(oo.x << 16) * r * g0[0]; w0[1] = __uint_as_float(oo.x & 0xffff0000u) * r * g0[1]; w0[2] = __uint_as_float(oo.y << 16) * r * g0[2]; w0[3] = __uint_as_float(oo.y & 0xffff0000u) * r * g0[3];
                  w1[0] = __uint_as_float(oo.z << 16) * r * g1[0]; w1[1] = __uint_as_float(oo.z & 0xffff0000u) * r * g1[1]; w1[2] = __uint_as_float(oo.w << 16) * r * g1[2]; w1[3] = __uint_as_float(oo.w & 0xffff0000u) * r * g1[3];
                  *(f32x4*)(orow + 8 * hh) = w0; *(f32x4*)(orow + 8 * hh + 4) = w1; } } } }
}
}

extern "C" void kernel_launch(void* const* d_in, const int* in_sizes, int n_in, void* d_out, int out_size, void* d_ws, size_t ws_size, hipStream_t stream) {
    static int grid = 0;
    if (grid == 0) {
        if (n_in != 34 || in_sizes[0] != T * D || out_size != T * D || ws_size < WS_END) { fprintf(stderr, "kernel_launch: unexpected shapes (n_in %d, ws %zu)\n", n_in, ws_size); grid = -1; return; }
        int dev = 0, cus = 0, per_cu = 0;
        if (hipGetDevice(&dev) != hipSuccess || hipDeviceGetAttribute(&cus, hipDeviceAttributeMultiprocessorCount, dev) != hipSuccess) { grid = -1; return; }
        if (hipFuncSetAttribute((const void*)mega_fwd, hipFuncAttributeMaxDynamicSharedMemorySize, LDS_BYTES) != hipSuccess) { fprintf(stderr, "kernel_launch: hipFuncSetAttribute failed\n"); grid = -1; return; }
        if (hipOccupancyMaxActiveBlocksPerMultiprocessor(&per_cu, (const void*)mega_fwd, 512, LDS_BYTES) != hipSuccess || per_cu < 1) { fprintf(stderr, "kernel_launch: occupancy query says %d\n", per_cu); }
        (void)hipGetLastError();
        grid = cus;
    }
    if (grid < 0) return;
    (void)hipMemsetAsync((char*)d_ws + WS_CTL, 0, CTL_ZERO_BYTES, stream);
    Args a{};
    for (int i = 0; i < 34; ++i) a.in[i] = (const float*)d_in[i];
    a.out = (float*)d_out; a.ws = (unsigned char*)d_ws;
    hipLaunchKernelGGL(mega_fwd, dim3(grid), dim3(512), LDS_BYTES, stream, a);
}
```

```cpp
#include <hip/hip_runtime.h>
#include <cstdio>
#include <cstdint>

#define LAS __attribute__((address_space(3)))
typedef unsigned short bf16_t;
typedef short bf16x8 __attribute__((ext_vector_type(8)));
typedef float f32x4 __attribute__((ext_vector_type(4)));
typedef float f32x2 __attribute__((ext_vector_type(2)));
typedef unsigned u32x4 __attribute__((ext_vector_type(4)));
typedef unsigned u32x2 __attribute__((ext_vector_type(2)));
typedef int i32x4 __attribute__((ext_vector_type(4)));
typedef int i32x8 __attribute__((ext_vector_type(8)));

constexpr int D = 1024, BATCH = 8, SEQ = 8192, T = BATCH * SEQ, DEPTH = 2;
constexpr int AW = 384, BW = 384, CW = 256, HD = 64, ABLK = 128, CHUNK = 64;
constexpr int INC = 1792;
constexpr int ZU = 0, ZV = 384, ZG = 768, ZX = 1152, ZC = 1536, ZGELU_END = 1152;
constexpr int CG = 16, CGD = 16, CS = 64;
constexpr int NE = 16, DE = 512, NCLS = 24;
constexpr float EPS = 1e-6f;
constexpr int UT = 256;
constexpr int NU = T / UT;
constexpr int MAXROWS = T + NCLS * 256;

constexpr size_t MiB = 1u << 20;
constexpr size_t WS_CTL = 0, CTL_ZERO_BYTES = 1 * MiB;
constexpr size_t WS_WIN = 2 * MiB;
constexpr size_t WS_WOUT = 10 * MiB;
constexpr size_t WS_WGLU = 14 * MiB;
constexpr size_t WS_WRG = 15 * MiB;
constexpr size_t WS_WSP = 15 * MiB + 256 * 1024;
constexpr size_t WS_WRT = 15 * MiB + 768 * 1024;
constexpr size_t WS_WGU = 16 * MiB;
constexpr size_t WS_WD8 = 48 * MiB;
constexpr size_t WS_WD2 = 80 * MiB;
constexpr size_t WS_SSQ = 176 * MiB;
constexpr size_t WS_RS = 180 * MiB;
constexpr size_t WS_CLS = WS_RS + 256 * 1024;
constexpr size_t WS_G2 = WS_CLS + 256 * 1024;
constexpr size_t WS_HIST = 181 * MiB;
constexpr size_t WS_CTOT = WS_HIST + 64 * 1024;
constexpr size_t WS_ROWTOK = WS_HIST + 256 * 1024;
constexpr size_t WS_ROWG = 182 * MiB;
constexpr size_t WS_SUMA = 183 * MiB;
constexpr size_t WS_SUMH = 191 * MiB;
constexpr size_t WS_S5 = 184 * MiB;
constexpr size_t WS_SEND = 187 * MiB;
constexpr size_t WS_HB = 192 * MiB;
constexpr size_t WS_Z = 320 * MiB;
constexpr size_t WS_HBS = WS_Z;
constexpr size_t WS_Y = 544 * MiB;
constexpr size_t WS_ACT = 672 * MiB;
constexpr size_t WS_HL = 672 * MiB;
constexpr size_t WS_PP = 736 * MiB;
constexpr size_t WS_SE = 800 * MiB;
constexpr size_t WS_AV = 672 * MiB;
constexpr size_t WS_BV = 768 * MiB;
constexpr size_t WS_SEND2 = 864 * MiB;
constexpr size_t WS_SUMA2 = 866 * MiB;
constexpr size_t WS_SUMH2 = 867 * MiB;
constexpr size_t WS_END = 868 * MiB;
constexpr int CW_BAR = 4096;

constexpr int RING_BYTES = 131072;
constexpr int LDSCTL_OFF = 143360;
constexpr int LDS_PF = 147456;
constexpr int LDS_BYTES = 163840;
constexpr int LW_BAR = 8, LW_TST = 64, LW_HIST = 96, LW_TOT = 128, LW_BASE = 160, LW_CLS = 256  , LW_DEST = 512  , LW_UTAB = 768  , LW_DTAB = 800  ;

__device__ __forceinline__ float bf2f(bf16_t v) { return __uint_as_float(((unsigned)v) << 16); }
__device__ __forceinline__ unsigned cvt_pk_bf16(float lo, float hi) { unsigned r; asm volatile("v_cvt_pk_bf16_f32 %0, %1, %2" : "=v"(r) : "v"(lo), "v"(hi)); return r; }
__device__ __forceinline__ bf16_t f2bf(float v) { return (bf16_t)(cvt_pk_bf16(v, 0.f) & 0xffffu); }
__device__ __forceinline__ unsigned pk_fp8x4(float a, float b, float c, float d) {
    a = fminf(fmaxf(a, -448.f), 448.f); b = fminf(fmaxf(b, -448.f), 448.f); c = fminf(fmaxf(c, -448.f), 448.f); d = fminf(fmaxf(d, -448.f), 448.f);
    int r = __builtin_amdgcn_cvt_pk_fp8_f32(a, b, 0, false); r = __builtin_amdgcn_cvt_pk_fp8_f32(c, d, r, true); return (unsigned)r; }
__device__ __forceinline__ int fresh_lane() { unsigned z = 0u; asm volatile("" : "+s"(z)); return (int)__builtin_amdgcn_mbcnt_hi(~0u, __builtin_amdgcn_mbcnt_lo(~0u, z)); }
__device__ __forceinline__ float x_xor1(float v) { return __int_as_float(__builtin_amdgcn_update_dpp(0, __float_as_int(v), 0xB1, 0xf, 0xf, true)); }
__device__ __forceinline__ float x_xor2(float v) { return __int_as_float(__builtin_amdgcn_update_dpp(0, __float_as_int(v), 0x4E, 0xf, 0xf, true)); }
__device__ __forceinline__ float x_hmir(float v) { return __int_as_float(__builtin_amdgcn_update_dpp(0, __float_as_int(v), 0x141, 0xf, 0xf, true)); }
__device__ __forceinline__ float x_mir(float v) { return __int_as_float(__builtin_amdgcn_update_dpp(0, __float_as_int(v), 0x140, 0xf, 0xf, true)); }
__device__ __forceinline__ float x_xor16(float v) { return __int_as_float(__builtin_amdgcn_ds_swizzle(__float_as_int(v), 0x401F)); }
__device__ __forceinline__ float add_xor32(float v) { const auto r = __builtin_amdgcn_permlane32_swap(__float_as_uint(v), __float_as_uint(v), false, false); return __uint_as_float(r[0]) + __uint_as_float(r[1]); }
__device__ __forceinline__ float add_x16_x32(float v) { v += x_xor16(v); return add_xor32(v); }
__device__ __forceinline__ float wave_sum(float v) { v += x_xor1(v); v += x_xor2(v); v += x_hmir(v); v += x_mir(v); v += x_xor16(v); return add_xor32(v); }
__device__ __forceinline__ float gelu_fast(float x) {
    const float u2 = 1.5957691216057308f * (x + 0.044715f * x * x * x);
    const float e = __builtin_amdgcn_exp2f(-1.4426950408889634f * u2);
    return x * __builtin_amdgcn_rcpf(1.0f + e);
}
__device__ __forceinline__ float sigmoid_fast(float x) { return __builtin_amdgcn_rcpf(1.0f + __builtin_amdgcn_exp2f(-1.4426950408889634f * x)); }
__device__ __forceinline__ float sigmoid_f(float x) { return 1.0f / (1.0f + expf(-x)); }
__device__ __forceinline__ int pair_lo(int pi) { return pi < 3 ? 0 : (pi < 5 ? 1 : 2); }
__device__ __forceinline__ int pair_hi(int pi) { return pi < 3 ? pi + 1 : (pi < 5 ? pi - 1 : 3); }
__device__ __forceinline__ int pair_idx(int lo, int hi) { return lo == 0 ? hi - 1 : (lo == 1 ? hi + 1 : 5); }

#define XB_TMO      128
#define XB_XCNT(j)  (256  + 64 * (j))
#define XB_XSUB(j)  (1280 + 64 * (j))
#define XB_XGEN(j)  (2304 + 64 * (j))
#define XB_TOP      3328
#define XB_TOPGEN   3392
#define XCD_BAR_WORDS 3456
#define XB_SPIN_CAP (1u << 18)
__device__ __forceinline__ unsigned xb_ld(unsigned* p)              { return __hip_atomic_load(p, __ATOMIC_RELAXED, __HIP_MEMORY_SCOPE_AGENT); }
__device__ __forceinline__ unsigned xb_add(unsigned* p, unsigned v) { return __hip_atomic_fetch_add(p, v, __ATOMIC_RELAXED, __HIP_MEMORY_SCOPE_AGENT); }
__device__ __forceinline__ unsigned xb_xcc_id() { return (unsigned)__builtin_amdgcn_s_getreg((3 << 11) | 20) & 0xFu; }
#define XB_SPIN(cond, bar) do { unsigned _sp = 0; while (cond) { __builtin_amdgcn_s_sleep(1); \
    if ((++_sp & 255u) == 0u) { if (xb_ld(&(bar)[XB_TMO])) break; if (_sp > XB_SPIN_CAP) { atomicAdd(&(bar)[XB_TMO], 1u); break; } } } } while (0)
struct XcdBarrier { unsigned* bar; unsigned x; volatile LAS unsigned* st; };
__device__ __forceinline__ XcdBarrier xcd_barrier_post(unsigned* bar, volatile LAS unsigned* st) {
    XcdBarrier b; b.bar = bar; b.x = xb_xcc_id(); b.st = st;
    if (threadIdx.x == 0) (void)xb_add(&bar[XB_XCNT(b.x)], 1u);
    return b;
}
__device__ __forceinline__ void xcd_barrier_complete(unsigned* bar, unsigned x, unsigned& nloc, unsigned& nx) {
    const unsigned G = gridDim.x * gridDim.y * gridDim.z;
    unsigned sum, cnt, mine, sp = 0u;
    for (;;) {
        sum = 0u; cnt = 0u; mine = 0u;
#pragma unroll
        for (unsigned j = 0; j < 16; ++j) { const unsigned c = xb_ld(&bar[XB_XCNT(j)]); sum += c; cnt += (c > 0u) ? 1u : 0u; mine = (j == x) ? c : mine; }
        if (sum == G) break;
        __builtin_amdgcn_s_sleep(1);
        if ((++sp & 255u) == 0u) { if (xb_ld(&bar[XB_TMO])) break; if (sp > XB_SPIN_CAP) { atomicAdd(&bar[XB_TMO], 1u); break; } }
    }
    nloc = mine > 0u ? mine : 1u; nx = cnt > 0u ? cnt : 1u;
}
__device__ __forceinline__ void xcd_barrier(const XcdBarrier& b) {
    asm volatile("s_waitcnt vmcnt(0)" ::: "memory");
    __syncthreads();
    if (threadIdx.x == 0) {
        unsigned* bar = b.bar; asm volatile("" : "+s"(bar));
        __builtin_amdgcn_s_waitcnt(0);
        unsigned bx0 = b.x; asm volatile("" : "+s"(bx0));
        unsigned nloc = b.st[0], nx = b.st[1];
        if (nloc == 0u) { xcd_barrier_complete(bar, bx0, nloc, nx); b.st[0] = nloc; b.st[1] = nx; }
        unsigned bx = b.x; asm volatile("" : "+s"(bx));
        const unsigned old = xb_add(&bar[XB_XSUB(bx)], 1u);
        const unsigned gen = old / nloc;
        if (old + 1u == (gen + 1u) * nloc) {
            __builtin_amdgcn_fence(__ATOMIC_RELEASE, "agent");
            asm volatile("s_waitcnt vmcnt(0)" ::: "memory");
            const unsigned og = xb_add(&bar[XB_TOP], 1u);
            const unsigned tg = og / nx;
            if (og + 1u == (tg + 1u) * nx) xb_add(&bar[XB_TOPGEN], 1u);
            else XB_SPIN(xb_ld(&bar[XB_TOPGEN]) == tg, bar);
            __builtin_amdgcn_fence(__ATOMIC_ACQUIRE, "agent");
            xb_add(&bar[XB_XGEN(bx)], 1u);
            asm volatile("s_waitcnt vmcnt(0)" ::: "memory");
        } else {
            XB_SPIN(xb_ld(&bar[XB_XGEN(bx)]) == gen, bar);
            __builtin_amdgcn_fence(__ATOMIC_ACQUIRE, "agent");
            asm volatile("s_waitcnt vmcnt(0)" ::: "memory");
        }
    }
    __syncthreads();
}

namespace pg8 {
#define PG8_LAS __attribute__((address_space(3)))
constexpr int BM = 256, BK = 64, HALF = 128, HTB = HALF * BK * 2, STAGE_BYTES = 8 * HTB, NXCD = 8, WGM = 4;
__host__ __device__ __forceinline__ int lds_byte(int r, int c) { const int st = (r >> 4) * 2 + (c >> 5), rr = r & 15, cc = c & 31, ob = rr * 64 + cc * 2; return st * 1024 + (ob ^ (((ob >> 9) & 1) << 5)); }
__host__ __device__ __forceinline__ void stage_rc(int b, int& R, int& C) { const int st = b / 1024, sb = b % 1024, swz = sb ^ (((sb >> 9) & 1) << 5); R = (st >> 1) * 16 + swz / 64; C = (st & 1) * 32 + (swz % 64) / 2; }
__host__ __device__ __forceinline__ int perm32(int rho) { const int n = rho >> 4, i = rho & 15; return 8 * (i >> 2) + 4 * n + (i & 3); }
struct Unit { int pm, pn; const char* A; const char* B; };

template <int M_, int NN> struct PanelOrder {
    static constexpr int nM = M_ / BM; static constexpr size_t tstep = (size_t)BM * 1024 * 2;
    int G, c; const char* A; const char* Bt;
    __device__ void init(const void* A_, const void* Bt_, int G_, int c_) { G = G_; c = c_; A = (const char*)A_; Bt = (const char*)Bt_; }
    __device__ bool next(int i, Unit& u) const { const int pm = c + (i / NN) * G; if (pm >= nM) return false; u.pm = pm; u.pn = i % NN; u.A = A + (size_t)pm * tstep; u.B = Bt + (size_t)u.pn * tstep; return true; }
    __device__ __forceinline__ void a_ready(const Unit&) const {}
    __device__ __forceinline__ void done(const Unit&) const {}
};
template <int M_, int N_> struct StaticOrder {
    static constexpr int nM = M_ / BM, nN = N_ / BM, nwg = nM * nN; static constexpr size_t tstep = (size_t)BM * 1024 * 2;
    int G, c; const char* A; const char* Bt;
    __device__ void init(const void* A_, const void* Bt_, int G_, int c_) { G = G_; c = c_; A = (const char*)A_; Bt = (const char*)Bt_; }
    __device__ bool next(int i, Unit& u) const {
        const long L = (long)i * G + c; if (L >= nwg) return false;
        int wgid = (int)L; { constexpr int q = nwg / NXCD, r = nwg % NXCD; const int xcd = wgid % NXCD, off = wgid / NXCD; wgid = (xcd < r ? xcd * (q + 1) : r * (q + 1) + (xcd - r) * q) + off; }
        constexpr int nig = WGM * nN; const int gid = wgid / nig, fm = gid * WGM, gsz = (nM - fm) < WGM ? (nM - fm) : WGM;
        u.pm = fm + ((wgid % nig) % gsz); u.pn = (wgid % nig) / gsz; u.A = A + (size_t)u.pm * tstep; u.B = Bt + (size_t)u.pn * tstep; return true;
    }
    __device__ __forceinline__ void a_ready(const Unit&) const {}
    __device__ __forceinline__ void done(const Unit&) const {}
};
template <class Epi, class Sched, bool ALIGN_EPI = false, bool SP2 = false, int KB = 1024, bool FP8 = false>
__device__ __forceinline__ void gemm_phase(PG8_LAS unsigned char* lds, const int wave_s, const Sched& S, const Epi& E) { const int Kdim = 0;
    const int lane = fresh_lane(), wid = wave_s, tid = wid * 64 + lane, wr = wid >> 2, wc = wid & 3, fr = lane & 15, fq = lane >> 4;
    constexpr int K = KB, nt = K / BK; (void)Kdim;
    unsigned voffA, voffB;
    { int R, C; stage_rc(tid * 16, R, C); const int Rb = Epi::PERM ? ((R & ~31) + perm32(R & 31)) : R; voffA = (unsigned)(R * K + C) * 2u; voffB = (unsigned)(Rb * K + C) * 2u; }
    constexpr size_t kstep = (size_t)(BK * 2);
    constexpr size_t hstep = (size_t)HALF * K * 2;
    constexpr size_t tstep = 2 * hstep; (void)tstep;
    const unsigned ldsw = (unsigned)wid * 1024u; const unsigned ldsb = (unsigned)(size_t)lds + ldsw;
    const int aoff = lds_byte(wr * 64 + fr, fq * 8), boff = lds_byte(wc * 32 + fr, fq * 8);
#define PG8_SA(b, h) (((b) * 2 + (h)) * HTB)
#define PG8_SB(b, h) ((4 + (b) * 2 + (h)) * HTB)
#define PG8_STAGE(bufoff, gbase, voff) do { _Pragma("unroll") for (int _i = 0; _i < 2; ++_i) { unsigned _keep; \
        asm volatile("s_mov_b32 %0, m0\n\ts_mov_b32 m0, %3\n\ts_nop 0\n\tglobal_load_lds_dwordx4 %1, %2\n\ts_mov_b32 m0, %0" : "=&s"(_keep) \
            : "v"(voff), "s"((const char*)(gbase) + (size_t)_i * (64 * K * 2)), "s"(ldsb + (unsigned)((bufoff) + _i * 8192)) : "memory"); } } while (0)
#define PG8_LDA(dst, b, h) do { if constexpr (FP8) { _Pragma("unroll") for (int m = 0; m < 4; ++m) { const i32x4 _lo = *(const PG8_LAS i32x4*)(lds + PG8_SA(b, h) + aoff + m * 2048), _hi = *(const PG8_LAS i32x4*)(lds + PG8_SA(b, h) + aoff + m * 2048 + 1024); \
            dst##8[m] = __builtin_shufflevector(_lo, _hi, 0, 1, 2, 3, 4, 5, 6, 7); } } \
        else { _Pragma("unroll") for (int m = 0; m < 4; ++m) _Pragma("unroll") for (int k = 0; k < 2; ++k) dst[m][k] = *(const PG8_LAS bf16x8*)(lds + PG8_SA(b, h) + aoff + m * 2048 + k * 1024); } } while (0)
#define PG8_LDB(dst, b, h) do { if constexpr (FP8) { _Pragma("unroll") for (int n = 0; n < 2; ++n) { const i32x4 _lo = *(const PG8_LAS i32x4*)(lds + PG8_SB(b, h) + boff + n * 2048), _hi = *(const PG8_LAS i32x4*)(lds + PG8_SB(b, h) + boff + n * 2048 + 1024); \
            dst##8[n] = __builtin_shufflevector(_lo, _hi, 0, 1, 2, 3, 4, 5, 6, 7); } } \
        else { _Pragma("unroll") for (int n = 0; n < 2; ++n) _Pragma("unroll") for (int k = 0; k < 2; ++k) dst[n][k] = *(const PG8_LAS bf16x8*)(lds + PG8_SB(b, h) + boff + n * 2048 + k * 1024); } } while (0)
#define PG8_MMA(ai, bj, At, Bt) do { __builtin_amdgcn_s_setprio(1); \
        if constexpr (FP8) { _Pragma("unroll") for (int m = 0; m < 4; ++m) _Pragma("unroll") for (int n = 0; n < 2; ++n) \
            acc[ai][bj][m][n] = __builtin_amdgcn_mfma_scale_f32_16x16x128_f8f6f4(Bt##8[n], At##8[m], acc[ai][bj][m][n], 0, 0, 0, Epi::SCALE_W, 0, Epi::SCALE_A); } \
        else { _Pragma("unroll") for (int m = 0; m < 4; ++m) _Pragma("unroll") for (int n = 0; n < 2; ++n) _Pragma("unroll") for (int k = 0; k < 2; ++k) \
            acc[ai][bj][m][n] = __builtin_amdgcn_mfma_f32_16x16x32_bf16(Bt[n][k], At[m][k], acc[ai][bj][m][n], 0, 0, 0); } \
        __builtin_amdgcn_s_setprio(0); } while (0)
#define PG8_WAIT_V(n) asm volatile("s_waitcnt vmcnt(" #n ")" ::: "memory")
#define PG8_WAIT_L(n) asm volatile("s_waitcnt lgkmcnt(" #n ")" ::: "memory")
#define PG8_BAR __builtin_amdgcn_s_barrier()
#define PG8_SCHED __builtin_amdgcn_sched_barrier(0)
    Unit cur, nxt; int ui = 0;
    if (!S.next(0, cur)) return;
    f32x4 acc[2][2][4][2];
#pragma unroll
    for (int a = 0; a < 2; ++a)
#pragma unroll
        for (int b = 0; b < 2; ++b)
#pragma unroll
            for (int m = 0; m < 4; ++m)
#pragma unroll
                for (int n = 0; n < 2; ++n) acc[a][b][m][n] = (f32x4){0.f, 0.f, 0.f, 0.f};
    bf16x8 At[4][2], B0[2][2], B1[2][2]; i32x8 At8[4], B08[2], B18[2]; (void)At; (void)B0; (void)B1; (void)At8; (void)B08; (void)B18;
    const char* cA = cur.A; const char* cB = cur.B;
    S.a_ready(cur);
    if constexpr (SP2) {
        PG8_STAGE(PG8_SB(0, 0), cB, voffB); PG8_STAGE(PG8_SB(0, 1), cB + hstep, voffB); PG8_STAGE(PG8_SA(0, 0), cA, voffA); PG8_STAGE(PG8_SA(0, 1), cA + hstep, voffA);
        if (wr == 1) PG8_BAR;
        PG8_WAIT_V(2); PG8_BAR;
        PG8_STAGE(PG8_SB(1, 0), cB + kstep, voffB); PG8_STAGE(PG8_SA(1, 0), cA + kstep, voffA); PG8_STAGE(PG8_SB(1, 1), cB + hstep + kstep, voffB);
        PG8_WAIT_V(6); PG8_BAR;
    } else {
        PG8_STAGE(PG8_SB(0, 0), cB, voffB); PG8_STAGE(PG8_SA(0, 0), cA, voffA); PG8_STAGE(PG8_SB(0, 1), cB + hstep, voffB); PG8_STAGE(PG8_SA(0, 1), cA + hstep, voffA);
        if (wr == 1) PG8_BAR;
        PG8_WAIT_V(4); PG8_BAR;
        PG8_STAGE(PG8_SB(1, 0), cB + kstep, voffB); PG8_STAGE(PG8_SA(1, 0), cA + kstep, voffA); PG8_STAGE(PG8_SB(1, 1), cB + hstep + kstep, voffB);
        PG8_WAIT_V(6); PG8_BAR;
    }
    for (;;) {
        const bool has_next = S.next(ui + 1, nxt);
        const char* nA = has_next ? nxt.A : cA; const char* nB = has_next ? nxt.B : cB;
_Pragma("unroll 1")
        for (int t = 0; t < nt; t += 2) {
            const bool last = (t == nt - 2);
            const char* a1 = cA + (size_t)(t + 1) * kstep;
            const char* a2 = last ? nA : cA + (size_t)(t + 2) * kstep; const char* b2 = last ? nB : cB + (size_t)(t + 2) * kstep;
            const char* a3 = a2 + kstep; const char* b3 = b2 + kstep;
            if (last && has_next) S.a_ready(nxt);
            if constexpr (Epi::PF) { if (t == 2) E.prefetch(cur, (unsigned)(size_t)lds + (unsigned)LDS_PF, wid); }
            if constexpr (SP2) {
            PG8_LDB(B0, 0, 0); PG8_LDB(B1, 0, 1); PG8_SCHED; PG8_LDA(At, 0, 0); PG8_STAGE(PG8_SA(1, 1), a1 + hstep, voffA);
            PG8_WAIT_V(8); PG8_WAIT_L(0); PG8_BAR; PG8_MMA(0, 0, At, B0); PG8_MMA(0, 1, At, B1); PG8_BAR; PG8_SCHED;
            PG8_LDA(At, 0, 1); PG8_STAGE(PG8_SB(0, 0), b2, voffB); PG8_STAGE(PG8_SB(0, 1), b2 + hstep, voffB); PG8_STAGE(PG8_SA(0, 0), a2, voffA);
            PG8_WAIT_V(8); PG8_WAIT_L(0); PG8_BAR; PG8_MMA(1, 0, At, B0); PG8_MMA(1, 1, At, B1); PG8_BAR; PG8_SCHED;
            PG8_LDB(B0, 1, 0); PG8_LDB(B1, 1, 1); PG8_SCHED; PG8_LDA(At, 1, 0); PG8_STAGE(PG8_SA(0, 1), a2 + hstep, voffA);
            PG8_WAIT_V(8); PG8_WAIT_L(0); PG8_BAR; PG8_MMA(0, 0, At, B0); PG8_MMA(0, 1, At, B1); PG8_BAR; PG8_SCHED;
            PG8_LDA(At, 1, 1); PG8_STAGE(PG8_SB(1, 0), b3, voffB); PG8_STAGE(PG8_SB(1, 1), b3 + hstep, voffB); PG8_STAGE(PG8_SA(1, 0), a3, voffA);
            PG8_WAIT_V(8); PG8_WAIT_L(0); PG8_BAR; PG8_MMA(1, 0, At, B0); PG8_MMA(1, 1, At, B1); PG8_BAR; PG8_SCHED;
            } else {
            PG8_LDB(B0, 0, 0); PG8_SCHED; PG8_LDA(At, 0, 0); PG8_STAGE(PG8_SA(1, 1), a1 + hstep, voffA);
            PG8_WAIT_L(8); PG8_BAR; PG8_WAIT_L(0); PG8_MMA(0, 0, At, B0); PG8_BAR; PG8_SCHED;
            PG8_LDB(B1, 0, 1); PG8_STAGE(PG8_SB(0, 0), b2, voffB);
            PG8_BAR; PG8_WAIT_L(0); PG8_MMA(0, 1, At, B1); PG8_BAR;
            PG8_LDA(At, 0, 1); PG8_STAGE(PG8_SA(0, 0), a2, voffA);
            PG8_BAR; PG8_WAIT_L(0); PG8_MMA(1, 0, At, B0); PG8_BAR; PG8_SCHED;
            PG8_STAGE(PG8_SB(0, 1), b2 + hstep, voffB);
            PG8_WAIT_V(6); PG8_BAR; PG8_MMA(1, 1, At, B1); PG8_BAR;
            PG8_LDB(B0, 1, 0); PG8_SCHED; PG8_LDA(At, 1, 0); PG8_STAGE(PG8_SA(0, 1), a2 + hstep, voffA);
            PG8_WAIT_L(8); PG8_BAR; PG8_WAIT_L(0); PG8_MMA(0, 0, At, B0); PG8_BAR; PG8_SCHED;
            PG8_LDB(B1, 1, 1); PG8_STAGE(PG8_SB(1, 0), b3, voffB);
            PG8_BAR; PG8_WAIT_L(0); PG8_MMA(0, 1, At, B1); PG8_BAR;
            PG8_LDA(At, 1, 1); PG8_STAGE(PG8_SA(1, 0), a3, voffA);
            PG8_BAR; PG8_WAIT_L(0); PG8_MMA(1, 0, At, B0); PG8_BAR; PG8_SCHED;
            PG8_STAGE(PG8_SB(1, 1), b3 + hstep, voffB);
            PG8_WAIT_V(6); PG8_BAR; PG8_MMA(1, 1, At, B1); PG8_BAR;
            }
        }
        if constexpr (ALIGN_EPI) { if (wr == 0) PG8_BAR; }
        if constexpr (!Epi::AFTER_DRAIN) { E(acc, cur, wr, wc, fr, fq); S.done(cur); }
        if (!has_next) break;
#pragma unroll
        for (int a = 0; a < 2; ++a)
#pragma unroll
            for (int b = 0; b < 2; ++b)
#pragma unroll
                for (int m = 0; m < 4; ++m)
#pragma unroll
                    for (int n = 0; n < 2; ++n) acc[a][b][m][n] = (f32x4){0.f, 0.f, 0.f, 0.f};
        cur = nxt; cA = nA; cB = nB; ++ui;
        if constexpr (ALIGN_EPI) { if (wr == 1) PG8_BAR; }
    }
    PG8_WAIT_V(0);
    if constexpr (!ALIGN_EPI) { if (wr == 0) PG8_BAR; }
    PG8_BAR;
    if constexpr (Epi::AFTER_DRAIN) { E.fused(acc, cur, wr, wc, fr, fq, lds, wid, lane); S.done(cur); }
#undef PG8_SA
#undef PG8_SB
#undef PG8_STAGE
#undef PG8_LDA
#undef PG8_LDB
#undef PG8_MMA
#undef PG8_WAIT_V
#undef PG8_WAIT_L
#undef PG8_BAR
#undef PG8_SCHED
}

template <int NP, bool UP, int ROWB> struct MoeOrder {
    const volatile LAS int* tab; int layer; const char* A; const char* W;
    __device__ bool next(int i, Unit& u) const {
        const int e = tab[i]; if (e < 0) return false;
        const int mt = e & 0xffff, pn = (e >> 16) & 0xff, cls = e >> 24;
        u.pm = mt; u.pn = pn; u.A = A + (size_t)mt * ((size_t)BM * ROWB);
        if (UP) { const int g = cls / 6, pi = cls % 6, s = pn >> 2, ex = g * 4 + (s ? pair_hi(pi) : pair_lo(pi));
            u.B = W + ((size_t)(layer * NE + ex) * 1024 + (size_t)(pn & 3) * 256) * ROWB; }
        else u.B = W + ((size_t)(layer * NCLS + cls) * 1024 + (size_t)pn * 256) * ROWB;
        return true;
    }
    __device__ __forceinline__ void a_ready(const Unit&) const {}
    __device__ __forceinline__ void done(const Unit&) const {}
};

struct EpiZ {
    static constexpr bool PERM = true, AFTER_DRAIN = false, PF = true;
    bf16_t* Z; const float* ssq; const PG8_LAS unsigned char* pf;
    __device__ __forceinline__ void prefetch(const Unit& u, unsigned lds_addr, int wid) const {
        const char* g = (const char*)(ssq + (size_t)u.pm * BM * 16) + wid * 1024; const unsigned vo = (unsigned)fresh_lane() * 16u;
#pragma unroll
        for (int i = 0; i < 2; ++i) { unsigned keep;
            asm volatile("s_mov_b32 %0, m0\n\ts_mov_b32 m0, %3\n\ts_nop 0\n\tglobal_load_lds_dwordx4 %1, %2\n\ts_mov_b32 m0, %0" : "=&s"(keep) : "v"(vo), "s"(g + i * 8192), "s"(lds_addr + (unsigned)(wid * 1024 + i * 8192)) : "memory"); } }
    __device__ __forceinline__ void operator()(const f32x4 (&acc)[2][2][4][2], const Unit& u, int wr, int wc, int fr, int fq) const {
        { const int ln_ = fresh_lane(); fr = ln_ & 15; fq = ln_ >> 4; }
        const int row0 = u.pm * BM + wr * 64 + fr, col0 = u.pn * BM + wc * 32 + 8 * fq;
        float rr[2][4];
#pragma unroll
        for (int ai = 0; ai < 2; ++ai) {
            f32x4 sp[4];
#pragma unroll
            for (int m = 0; m < 4; ++m) sp[m] = *(const PG8_LAS f32x4*)(pf + (ai * HALF + wr * 64 + m * 16 + fr) * 64 + 16 * fq);
#pragma unroll
            for (int m = 0; m < 4; ++m) { float t = (sp[m][0] + sp[m][1]) + (sp[m][2] + sp[m][3]); t = add_x16_x32(t); rr[ai][m] = __builtin_amdgcn_rsqf(t * (1.0f / D) + EPS); }
        }
#pragma unroll
        for (int ai = 0; ai < 2; ++ai)
#pragma unroll
            for (int m = 0; m < 4; ++m) { const int row = row0 + ai * HALF + m * 16; const float r = rr[ai][m];
                bf16_t* rowp = Z + (size_t)row * INC + col0;
#pragma unroll
                for (int bj = 0; bj < 2; ++bj) { f32x4 v0 = acc[ai][bj][m][0] * r, v1 = acc[ai][bj][m][1] * r;
                    u32x4 w; w.x = cvt_pk_bf16(v0[0], v0[1]); w.y = cvt_pk_bf16(v0[2], v0[3]); w.z = cvt_pk_bf16(v1[0], v1[1]); w.w = cvt_pk_bf16(v1[2], v1[3]);
                    *(u32x4*)(rowp + bj * HALF) = w; } }
    }
};
template <bool SCATTER> struct EpiRes {
    static constexpr bool PERM = true, AFTER_DRAIN = false, PF = SCATTER; static constexpr int SCALE_W = 0x7b7b7b7b, SCALE_A = 0x7b7b7b7b;
    bf16_t* H; float* ssq; const int* rowtok; const PG8_LAS unsigned char* pf;
    __device__ __forceinline__ void prefetch(const Unit& u, unsigned lds_addr, int wid) const {
        if (wid < 4) { const char* g = (const char*)(rowtok + (size_t)u.pm * BM) + wid * 256; const unsigned vo = (unsigned)fresh_lane() * 4u; unsigned keep;
            asm volatile("s_mov_b32 %0, m0\n\ts_mov_b32 m0, %3\n\ts_nop 0\n\tglobal_load_lds_dword %1, %2\n\ts_mov_b32 m0, %0" : "=&s"(keep) : "v"(vo), "s"(g), "s"(lds_addr + (unsigned)(wid * 256)) : "memory"); } }
    __device__ __forceinline__ void operator()(const f32x4 (&acc)[2][2][4][2], const Unit& u, int wr, int wc, int fr, int fq) const {
        { const int ln_ = fresh_lane(); fr = ln_ & 15; fq = ln_ >> 4; }
        const int row0 = u.pm * BM + wr * 64 + fr, col0 = u.pn * BM + wc * 32 + 8 * fq;
        int tokv[2][4];
#pragma unroll
        for (int ai = 0; ai < 2; ++ai)
#pragma unroll
            for (int m = 0; m < 4; ++m) { const int row = row0 + ai * HALF + m * 16; tokv[ai][m] = SCATTER ? *(const PG8_LAS int*)(pf + (ai * HALF + wr * 64 + m * 16 + fr) * 4) : row; }
#pragma unroll
        for (int ai = 0; ai < 2; ++ai) {
            u32x4 o[4][2];
#pragma unroll
            for (int m = 0; m < 4; ++m) { const int tok = tokv[ai][m]; const bf16_t* rowp = H + (size_t)(tok < 0 ? 0 : tok) * D + col0; o[m][0] = *(const u32x4*)(rowp); o[m][1] = *(const u32x4*)(rowp + HALF); }
#pragma unroll
            for (int m = 0; m < 4; ++m) { const int tok = tokv[ai][m]; float s = 0.f; bf16_t* rowp = H + (size_t)(tok < 0 ? 0 : tok) * D + col0;
#pragma unroll
                for (int bj = 0; bj < 2; ++bj) { const u32x4 oo = o[m][bj];
                    f32x4 v0 = acc[ai][bj][m][0], v1 = acc[ai][bj][m][1];
                    v0[0] += __uint_as_float(oo.x << 16); v0[1] += __uint_as_float(oo.x & 0xffff0000u); v0[2] += __uint_as_float(oo.y << 16); v0[3] += __uint_as_float(oo.y & 0xffff0000u);
                    v1[0] += __uint_as_float(oo.z << 16); v1[1] += __uint_as_float(oo.z & 0xffff0000u); v1[2] += __uint_as_float(oo.w << 16); v1[3] += __uint_as_float(oo.w & 0xffff0000u);
                    s += (v0[0] * v0[0] + v0[1] * v0[1]) + (v0[2] * v0[2] + v0[3] * v0[3]) + (v1[0] * v1[0] + v1[1] * v1[1]) + (v1[2] * v1[2] + v1[3] * v1[3]);
                    u32x4 w; w.x = cvt_pk_bf16(v0[0], v0[1]); w.y = cvt_pk_bf16(v0[2], v0[3]); w.z = cvt_pk_bf16(v1[0], v1[1]); w.w = cvt_pk_bf16(v1[2], v1[3]);
                    if (tok >= 0) *(u32x4*)(rowp + bj * HALF) = w; }
                s = add_x16_x32(s);
                if (fq == 0 && tok >= 0) ssq[(size_t)tok * 16 + u.pn * 4 + wc] = s; }
            asm volatile("" ::: "memory"); }
    }
};
constexpr int SC_W = 0x7b7b7b7b, SC_H = 0x7b7b7b7b, SC_ACT = 0x7b7b7b7b;
constexpr float FS_W = 16.f, FS_H = 16.f, FS_ACT = 16.f;
struct EpiUp {
    static constexpr bool PERM = true, AFTER_DRAIN = false, PF = true; static constexpr int SCALE_W = SC_W, SCALE_A = SC_H;
    unsigned char* ACT; const float* rowg; const PG8_LAS unsigned char* pf;
    __device__ __forceinline__ void prefetch(const Unit& u, unsigned lds_addr, int wid) const {
        const char* g = (const char*)(rowg + (size_t)u.pm * BM * 2) + wid * 256; const unsigned vo = (unsigned)fresh_lane() * 4u; unsigned keep;
        asm volatile("s_mov_b32 %0, m0\n\ts_mov_b32 m0, %3\n\ts_nop 0\n\tglobal_load_lds_dword %1, %2\n\ts_mov_b32 m0, %0" : "=&s"(keep) : "v"(vo), "s"(g), "s"(lds_addr + (unsigned)(wid * 256)) : "memory"); }
    __device__ __forceinline__ void operator()(const f32x4 (&acc)[2][2][4][2], const Unit& u, int wr, int wc, int fr, int fq) const {
        { const int ln_ = fresh_lane(); fr = ln_ & 15; fq = ln_ >> 4; }
        const int row0 = u.pm * BM + wr * 64 + fr, s = u.pn >> 2, col0 = s * 512 + (u.pn & 3) * 128 + wc * 32 + 8 * fq;
        float gt[2][4];
#pragma unroll
        for (int ai = 0; ai < 2; ++ai)
#pragma unroll
            for (int m = 0; m < 4; ++m) gt[ai][m] = *(const PG8_LAS float*)(pf + ((ai * HALF + wr * 64 + m * 16 + fr) * 2 + s) * 4);
#pragma unroll
        for (int ai = 0; ai < 2; ++ai)
#pragma unroll
            for (int m = 0; m < 4; ++m) { const int row = row0 + ai * HALF + m * 16; const float g1 = gt[ai][m];
                float o[8];
#pragma unroll
                for (int n = 0; n < 2; ++n)
#pragma unroll
                    for (int j = 0; j < 4; ++j) { const float g = acc[ai][0][m][n][j], up = acc[ai][1][m][n][j]; o[n * 4 + j] = g * sigmoid_fast(g) * up * g1; }
                u32x2 w; w.x = pk_fp8x4(o[0] * FS_ACT, o[1] * FS_ACT, o[2] * FS_ACT, o[3] * FS_ACT); w.y = pk_fp8x4(o[4] * FS_ACT, o[5] * FS_ACT, o[6] * FS_ACT, o[7] * FS_ACT);
                *(u32x2*)(ACT + (size_t)row * 1024 + col0) = w; }
    }
};
}

__device__ __forceinline__ void tr_item(const float* W, int ldw, int k0, int scol0, const float* gk, bf16_t* WT, int ldo, int drow0, int dk0, LAS float* scr, int lane) {
#pragma unroll 8
    for (int i = 0; i < 32; ++i) { const int kk = 2 * i + (lane >> 5); float v = W[(size_t)(k0 + kk) * ldw + scol0 + (lane & 31)]; if (gk) v *= gk[k0 + kk]; scr[kk * 33 + (lane & 31)] = v; }
    asm volatile("s_waitcnt lgkmcnt(0)" ::: "memory");
    const int c = lane & 7;
#pragma unroll
    for (int j = 0; j < 4; ++j) { const int n = (lane >> 3) + 8 * j; const LAS float* s = scr + (8 * c) * 33 + n;
        u32x4 o; o.x = cvt_pk_bf16(s[0 * 33], s[1 * 33]); o.y = cvt_pk_bf16(s[2 * 33], s[3 * 33]); o.z = cvt_pk_bf16(s[4 * 33], s[5 * 33]); o.w = cvt_pk_bf16(s[6 * 33], s[7 * 33]);
        *(u32x4*)(WT + (size_t)(drow0 + n) * ldo + dk0 + 8 * c) = o; }
    asm volatile("s_waitcnt lgkmcnt(0)" ::: "memory");
}

constexpr size_t S5_L_STRIDE = 1310720, S5_KT = 0, S5_ET = 131072, S5_FT = 655360, S5_LAMP = 1179648;
constexpr int S5_WSCR = 8192, S5_YST = 65536, YST_LD = 264;
constexpr int NU128 = T / 128, UPB128 = SEQ / 128;
__device__ __forceinline__ f32x4 mfma16(bf16x8 a, bf16x8 b, f32x4 c) { return __builtin_amdgcn_mfma_f32_16x16x32_bf16(a, b, c, 0, 0, 0); }

__device__ __forceinline__ void s5_kt_pair(int g, int c, int cp, const float* a_re, const float* a_im, const float* log_dt, const float* b_re, const float* b_im,
                                           const float* c_re, const float* c_im, const float* dvec, unsigned char* tab) {
    const float dt = __expf(log_dt[g]); float km[8];
#pragma unroll
    for (int d = 0; d < 8; ++d) km[d] = 0.f;
#pragma unroll 2
    for (int p = 0; p < CS; ++p) { const float lr = a_re[g * CS + p], li = a_im[g * CS + p], zr = lr * dt, zi = li * dt;
        const float sh = __sinf(0.5f * zi), cz = __cosf(zi), sz = __sinf(zi), ez = __expf(zr); const float nr = expm1f(zr) * cz - 2.0f * sh * sh, ni = ez * sz, den = lr * lr + li * li;
        const float cr = (nr * lr + ni * li) / den, ci = (ni * lr - nr * li) / den;
        const float br = b_re[((size_t)g * CS + p) * CGD + cp], bi = b_im[((size_t)g * CS + p) * CGD + cp]; const float bbr = cr * br - ci * bi, bbi = cr * bi + ci * br;
        const float cre = c_re[((size_t)g * CGD + c) * CS + p], cim = c_im[((size_t)g * CGD + c) * CS + p];
        float vr = cre * bbr - cim * bbi, vi = cre * bbi + cim * bbr;
        const float lbr = ez * cz, lbi = ez * sz;
#pragma unroll
        for (int d = 0; d < 8; ++d) { km[d] += vr; const float t = vr * lbr - vi * lbi; vi = vr * lbi + vi * lbr; vr = t; } }
    if (c == cp) km[0] += dvec[g * CGD + c];
    bf16_t* kt = (bf16_t*)(tab + S5_KT) + (size_t)g * 4096;
#pragma unroll
    for (int dd = 0; dd < 8; ++dd) { kt[(dd * 16 + c) * 32 + cp] = f2bf(km[dd]); kt[(dd * 16 + c) * 32 + 16 + cp] = dd >= 1 ? f2bf(km[dd - 1]) : (bf16_t)0; }
}
__device__ __forceinline__ void s5_et_task(int g, int ri, int p, int cp, const float* a_re, const float* a_im, const float* log_dt, const float* b_re, const float* b_im, unsigned char* tab) {
    const float dt = __expf(log_dt[g]); const float lr = a_re[g * CS + p], li = a_im[g * CS + p], zr = lr * dt, zi = li * dt;
    const float sh = __sinf(0.5f * zi), cz = __cosf(zi), sz = __sinf(zi), ez = __expf(zr); const float nr = expm1f(zr) * cz - 2.0f * sh * sh, ni = ez * sz, den = lr * lr + li * li;
    const float cr = (nr * lr + ni * li) / den, ci = (ni * lr - nr * li) / den;
    const float br = b_re[((size_t)g * CS + p) * CGD + cp], bi = b_im[((size_t)g * CS + p) * CGD + cp]; float vr = cr * br - ci * bi, vi = cr * bi + ci * br;
    const float lbr = ez * cz, lbi = ez * sz; bf16_t* et = (bf16_t*)(tab + S5_ET) + (size_t)g * 16384 + (size_t)(ri * 64 + p) * 128 + cp;
#pragma unroll
    for (int sp = 7; sp >= 0; --sp) { et[sp * 16] = f2bf(ri ? vi : vr); const float t = vr * lbr - vi * lbi; vi = vr * lbi + vi * lbr; vr = t; }
}
__device__ __forceinline__ void s5_ft_task(int g, int c, int ri, int p, const float* a_re, const float* a_im, const float* log_dt, const float* c_re, const float* c_im, unsigned char* tab) {
    const float dt = __expf(log_dt[g]); const float lr = a_re[g * CS + p], li = a_im[g * CS + p], zr = lr * dt, zi = li * dt; const float ez = __expf(zr), lbr = ez * __cosf(zi), lbi = ez * __sinf(zi);
    const float cre = c_re[((size_t)g * CGD + c) * CS + p], cim = c_im[((size_t)g * CGD + c) * CS + p]; float vr = cre * lbr - cim * lbi, vi = cre * lbi + cim * lbr;
    bf16_t* ft = (bf16_t*)(tab + S5_FT) + (size_t)g * 16384 + (size_t)c * 128 + ri * 64 + p;
#pragma unroll
    for (int tp = 0; tp < 8; ++tp) { ft[(size_t)tp * 16 * 128] = f2bf(ri ? -vi : vr); const float t = vr * lbr - vi * lbi; vi = vr * lbi + vi * lbr; vr = t; }
}
__device__ __forceinline__ void s5_table_elem(int g, int e, const float* a_re, const float* a_im, const float* log_dt, const float* b_re, const float* b_im,
                                              const float* c_re, const float* c_im, const float* dvec, unsigned char* tab) {
    const float dt = __expf(log_dt[g]);
    if (e < 4096) {
        const int dd = e >> 9, c = (e >> 5) & 15, ee = (e >> 4) & 1, cp = e & 15, d = dd - ee; float s = 0.f;
        if (d >= 0) {
            for (int p = 0; p < CS; ++p) { const float lr = a_re[g * CS + p], li = a_im[g * CS + p], zr = lr * dt, zi = li * dt;
                const float sh = __sinf(0.5f * zi); const float nr = expm1f(zr) * __cosf(zi) - 2.0f * sh * sh, ni = __expf(zr) * __sinf(zi), den = lr * lr + li * li;
                const float cr = (nr * lr + ni * li) / den, ci = (ni * lr - nr * li) / den;
                const float br = b_re[((size_t)g * CS + p) * CGD + cp], bi = b_im[((size_t)g * CS + p) * CGD + cp]; const float bbr = cr * br - ci * bi, bbi = cr * bi + ci * br;
                const float mag = __expf(zr * (float)d), pr = mag * __cosf(zi * (float)d), pi = mag * __sinf(zi * (float)d);
                const float vr = pr * bbr - pi * bbi, vi = pr * bbi + pi * bbr;
                s += c_re[((size_t)g * CGD + c) * CS + p] * vr - c_im[((size_t)g * CGD + c) * CS + p] * vi; }
            if (d == 0 && c == cp) s += dvec[g * CGD + c];
        }
        ((bf16_t*)(tab + S5_KT))[(size_t)g * 4096 + e] = f2bf(s); return;
    }
    e -= 4096;
    if (e < 16384) {
        const int n = e >> 7, k = e & 127, ri = n >> 6, p = n & 63, sp = k >> 4, cp = k & 15;
        const float lr = a_re[g * CS + p], li = a_im[g * CS + p], zr = lr * dt, zi = li * dt;
        const float sh = __sinf(0.5f * zi); const float nr = expm1f(zr) * __cosf(zi) - 2.0f * sh * sh, ni = __expf(zr) * __sinf(zi), den = lr * lr + li * li;
        const float cr = (nr * lr + ni * li) / den, ci = (ni * lr - nr * li) / den;
        const float br = b_re[((size_t)g * CS + p) * CGD + cp], bi = b_im[((size_t)g * CS + p) * CGD + cp]; const float bbr = cr * br - ci * bi, bbi = cr * bi + ci * br;
        const float d = (float)(7 - sp); const float mag = __expf(zr * d), pr = mag * __cosf(zi * d), pi = mag * __sinf(zi * d);
        ((bf16_t*)(tab + S5_ET))[(size_t)g * 16384 + e] = f2bf(ri ? (pr * bbi + pi * bbr) : (pr * bbr - pi * bbi)); return;
    }
    e -= 16384;
    if (e < 16384) {
        const int n = e >> 7, k = e & 127, tp = n >> 4, c = n & 15, ri = k >> 6, p = k & 63;
        const float lr = a_re[g * CS + p], li = a_im[g * CS + p], zr = lr * dt, zi = li * dt;
        const float d = (float)(tp + 1); const float mag = __expf(zr * d), pr = mag * __cosf(zi * d), pi = mag * __sinf(zi * d);
        const float cre = c_re[((size_t)g * CGD + c) * CS + p], cim = c_im[((size_t)g * CGD + c) * CS + p];
        ((bf16_t*)(tab + S5_FT))[(size_t)g * 16384 + e] = f2bf(ri ? -(cre * pi + cim * pr) : (cre * pr - cim * pi)); return;
    }
    e -= 16384;
    { const int p = e; const float lr = a_re[g * CS + p], li = a_im[g * CS + p], zr = lr * dt, zi = li * dt; float* o = (float*)(tab + S5_LAMP) + ((size_t)g * CS + p) * 8;
      float mag = expf(zr); o[0] = mag * cosf(zi); o[1] = mag * sinf(zi);
      mag = expf(zr * 8.f); o[2] = mag * cosf(zi * 8.f); o[3] = mag * sinf(zi * 8.f);
      mag = expf(zr * 128.f); o[4] = mag * cosf(zi * 128.f); o[5] = mag * sinf(zi * 128.f); o[6] = 0.f; o[7] = 0.f; }
}

template <class TT> __device__ __forceinline__ TT ldg(const void* ubase, unsigned voff) { return *(const TT*)((const char*)ubase + voff); }
template <int PASS>
__device__ __forceinline__ void s5_group(int unit, int g, bool first, float& kr, float& ki, int wave, int lane, const bf16_t* Z, bf16_t* Y, const unsigned char* tab, float* SEND, float* SEND2, float* SE, LAS unsigned char* lds) {
    const int ln = lane & 15, q = lane >> 4; const int t0 = unit * 128;
    const char* KTg = (const char*)(tab + S5_KT) + (size_t)g * 8192; const char* ETg = (const char*)(tab + S5_ET) + (size_t)g * 32768; const char* FTg = (const char*)(tab + S5_FT) + (size_t)g * 32768;
    const float* LAMPg = (const float*)(tab + S5_LAMP) + (size_t)g * CS * 8;
    const unsigned vo128 = (unsigned)(ln * 128 + 8 * q) * 2u;
    const unsigned vo32 = (unsigned)(ln * 32 + 8 * q) * 2u;
    LAS float* Sb = (LAS float*)(lds + wave * S5_WSCR); LAS bf16_t* Tb = (LAS bf16_t*)(lds + wave * S5_WSCR); LAS bf16_t* yst = (LAS bf16_t*)(lds + S5_YST);
    char* seb = (char*)(SE + ((size_t)unit * CG + g) * 16 * 128); const unsigned vl = (unsigned)lane * 4u;
    char* ylb = (char*)(Y + (size_t)t0 * D + AW + BW + g * 16); const unsigned vy = (unsigned)((ln * 8) * D + 4 * q) * 2u;
    const float lur = LAMPg[lane * 8 + 4], lui = LAMPg[lane * 8 + 5], l8r = LAMPg[lane * 8 + 2], l8i = LAMPg[lane * 8 + 3];
    float cr = 0.f, ci = 0.f;
    if (PASS == 1) {
        if (!first) { cr = kr; ci = ki; }
        bf16x8 X0, X1, X2, X3;
        { const char* zb = (const char*)(Z + (size_t)t0 * INC + ZC + g * 16); const unsigned vz = (unsigned)((ln * 8 + (q >> 1)) * INC + 8 * (q & 1)) * 2u;
          X0 = ldg<bf16x8>(zb, vz); X1 = ldg<bf16x8>(zb + 2 * INC * 2, vz); X2 = ldg<bf16x8>(zb + 4 * INC * 2, vz); X3 = ldg<bf16x8>(zb + 6 * INC * 2, vz); }
        { LAS float* sw = Sb + (4 * q) * 128 + ln; const char* eb = ETg;
#pragma unroll 1
          for (int jh = 0; jh < 2; ++jh) { bf16x8 ef[4][4];
#pragma unroll
            for (int j = 0; j < 4; ++j)
#pragma unroll
              for (int ks = 0; ks < 4; ++ks) ef[j][ks] = ldg<bf16x8>(eb + j * 4096 + ks * 64, vo128);
#pragma unroll
            for (int j = 0; j < 4; ++j) { f32x4 se = (f32x4){0.f, 0.f, 0.f, 0.f};
              se = mfma16(X0, ef[j][0], se); se = mfma16(X1, ef[j][1], se); se = mfma16(X2, ef[j][2], se); se = mfma16(X3, ef[j][3], se);
              LAS float* s2 = sw + 16 * j; s2[0] = se[0]; s2[128] = se[1]; s2[256] = se[2]; s2[384] = se[3]; }
            eb += 16384; sw += 64; } }
        asm volatile("" ::: "memory");
        { const char* kb = KTg; char* yq = ylb;
#pragma unroll 1
          for (int th = 0; th < 4; ++th) {
              const bf16x8 ka = ldg<bf16x8>(kb, vo32), kc = ldg<bf16x8>(kb + 1024, vo32);
              f32x4 acc0 = (f32x4){0.f, 0.f, 0.f, 0.f}, acc1 = (f32x4){0.f, 0.f, 0.f, 0.f};
              acc0 = mfma16(ka, X0, acc0); acc1 = mfma16(kc, X0, acc1);
              if (th >= 1) { acc0 = mfma16(ldg<bf16x8>(kb - 2048, vo32), X1, acc0); acc1 = mfma16(ldg<bf16x8>(kb - 1024, vo32), X1, acc1); }
              if (th >= 2) { acc0 = mfma16(ldg<bf16x8>(kb - 4096, vo32), X2, acc0); acc1 = mfma16(ldg<bf16x8>(kb - 3072, vo32), X2, acc1); }
              if (th >= 3) { acc0 = mfma16(ldg<bf16x8>(kb - 6144, vo32), X3, acc0); acc1 = mfma16(ldg<bf16x8>(kb - 5120, vo32), X3, acc1); }
              u32x2 w; w.x = cvt_pk_bf16(acc0[0], acc0[1]); w.y = cvt_pk_bf16(acc0[2], acc0[3]); *(u32x2*)(yq + vy) = w;
              w.x = cvt_pk_bf16(acc1[0], acc1[1]); w.y = cvt_pk_bf16(acc1[2], acc1[3]); *(u32x2*)(yq + (size_t)D * 2 + vy) = w;
              kb += 2048; yq += (size_t)2 * D * 2; } }
        asm volatile("" ::: "memory");
        float sr = cr, si = ci;
#pragma unroll
        for (int s = 0; s < 16; ++s) { const float er = Sb[s * 128 + lane], ei = Sb[s * 128 + 64 + lane];
            *(float*)(seb + s * 512 + vl) = er; *(float*)(seb + s * 512 + 256 + vl) = ei;
            const float nr = l8r * sr - l8i * si + er, ni = l8r * si + l8i * sr + ei; sr = nr; si = ni; }
        kr = sr; ki = si;
        float* dst = first ? SEND + (((size_t)unit * CG + g) * 2) * CS + lane : SEND2 + (((size_t)(unit >> 1) * CG + g) * 2) * CS + lane;
        dst[0] = sr; dst[CS] = si; asm volatile("" ::: "memory"); return;
    }
    if (first) { const int pr = unit >> 1, p0 = pr - (pr % (UPB128 / 2)); const float l2r = lur * lur - lui * lui, l2i = 2.0f * lur * lui;
        const char* sb = (const char*)(SEND2 + (((size_t)p0 * CG + g) * 2) * CS);
#pragma unroll 8
        for (int j = p0; j < pr; ++j) { const float sr = ldg<float>(sb, vl), si = ldg<float>(sb + CS * 4, vl); sb += (size_t)CG * 2 * CS * 4;
            const float nr = l2r * cr - l2i * ci + sr, ni = l2r * ci + l2i * cr + si; cr = nr; ci = ni; } }
    else { const float sr = SEND[(((size_t)(unit - 1) * CG + g) * 2 + 0) * CS + lane], si = SEND[(((size_t)(unit - 1) * CG + g) * 2 + 1) * CS + lane];
        cr = lur * kr - lui * ki + sr; ci = lur * ki + lui * kr + si; }
    kr = cr; ki = ci;
    { float sre[16], sim[16];
#pragma unroll
      for (int s = 0; s < 16; ++s) { sre[s] = ldg<float>(seb + s * 512, vl); sim[s] = ldg<float>(seb + s * 512 + 256, vl); }
      float sr = cr, si = ci;
#pragma unroll
      for (int s = 0; s < 16; ++s) { Tb[s * 128 + lane] = f2bf(sr); Tb[s * 128 + 64 + lane] = f2bf(si);
          const float nr = l8r * sr - l8i * si + sre[s], ni = l8r * si + l8i * sr + sim[s]; sr = nr; si = ni; } }
    asm volatile("" ::: "memory");
    const bf16x8 T0 = *(const LAS bf16x8*)(Tb + ln * 128 + 8 * q), T1 = *(const LAS bf16x8*)(Tb + ln * 128 + 32 + 8 * q), T2 = *(const LAS bf16x8*)(Tb + ln * 128 + 64 + 8 * q), T3 = *(const LAS bf16x8*)(Tb + ln * 128 + 96 + 8 * q);
    { LAS bf16_t* yw = yst + (ln * 8) * YST_LD + g * 16 + 4 * q; const char* fb = FTg; const char* yq = ylb;
#pragma unroll 2
      for (int th = 0; th < 4; ++th) { bf16x8 ff[2][4]; u32x2 yl[2];
#pragma unroll
          for (int j = 0; j < 2; ++j) { yl[j] = ldg<u32x2>(yq + (size_t)j * D * 2, vy);
#pragma unroll
              for (int ks = 0; ks < 4; ++ks) ff[j][ks] = ldg<bf16x8>(fb + j * 4096 + ks * 64, vo128); }
#pragma unroll
          for (int j = 0; j < 2; ++j) {
              f32x4 acc; acc[0] = __uint_as_float(yl[j].x << 16); acc[1] = __uint_as_float(yl[j].x & 0xffff0000u); acc[2] = __uint_as_float(yl[j].y << 16); acc[3] = __uint_as_float(yl[j].y & 0xffff0000u);
              acc = mfma16(ff[j][0], T0, acc); acc = mfma16(ff[j][1], T1, acc); acc = mfma16(ff[j][2], T2, acc); acc = mfma16(ff[j][3], T3, acc);
              u32x2 w; w.x = cvt_pk_bf16(gelu_fast(acc[0]), gelu_fast(acc[1])); w.y = cvt_pk_bf16(gelu_fast(acc[2]), gelu_fast(acc[3]));
              *(LAS u32x2*)(yw + j * YST_LD) = w; }
          fb += 8192; yq += (size_t)2 * D * 2; yw += 2 * YST_LD; } }
    asm volatile("s_waitcnt lgkmcnt(0)" ::: "memory");
}
__device__ __forceinline__ void s5_pair1(int pr, int g, int wave, int lane, const bf16_t* Z, bf16_t* Y, const unsigned char* tab, float* SEND, float* SEND2, float* SE, LAS unsigned char* lds) {
    const int ln = lane & 15, q = lane >> 4; const int t0 = pr * 256;
    const char* KTg = (const char*)(tab + S5_KT) + (size_t)g * 8192; const char* ETg = (const char*)(tab + S5_ET) + (size_t)g * 32768;
    const float* LAMPg = (const float*)(tab + S5_LAMP) + (size_t)g * CS * 8;
    const unsigned vo128 = (unsigned)(ln * 128 + 8 * q) * 2u, vo32 = (unsigned)(ln * 32 + 8 * q) * 2u, vl = (unsigned)lane * 4u;
    LAS float* SbA = (LAS float*)(lds + wave * 16384); LAS float* SbB = SbA + 2048;
    bf16x8 XA0, XA1, XA2, XA3, XB0, XB1, XB2, XB3;
    { const char* zb = (const char*)(Z + (size_t)t0 * INC + ZC + g * 16); const unsigned vz = (unsigned)((ln * 8 + (q >> 1)) * INC + 8 * (q & 1)) * 2u;
      XA0 = ldg<bf16x8>(zb, vz); XA1 = ldg<bf16x8>(zb + 2 * INC * 2, vz); XA2 = ldg<bf16x8>(zb + 4 * INC * 2, vz); XA3 = ldg<bf16x8>(zb + 6 * INC * 2, vz);
      const char* zc = zb + (size_t)128 * INC * 2;
      XB0 = ldg<bf16x8>(zc, vz); XB1 = ldg<bf16x8>(zc + 2 * INC * 2, vz); XB2 = ldg<bf16x8>(zc + 4 * INC * 2, vz); XB3 = ldg<bf16x8>(zc + 6 * INC * 2, vz); }
    { LAS float* sw = SbA + (4 * q) * 128 + ln; const char* eb = ETg;
#pragma unroll
      for (int jh = 0; jh < 2; ++jh) { bf16x8 ef[4][4];
#pragma unroll
        for (int j = 0; j < 4; ++j)
#pragma unroll
          for (int ks = 0; ks < 4; ++ks) ef[j][ks] = ldg<bf16x8>(eb + j * 4096 + ks * 64, vo128);
#pragma unroll
        for (int j = 0; j < 4; ++j) { f32x4 sa = (f32x4){0.f, 0.f, 0.f, 0.f}, sb = (f32x4){0.f, 0.f, 0.f, 0.f};
          sa = mfma16(XA0, ef[j][0], sa); sb = mfma16(XB0, ef[j][0], sb); sa = mfma16(XA1, ef[j][1], sa); sb = mfma16(XB1, ef[j][1], sb);
          sa = mfma16(XA2, ef[j][2], sa); sb = mfma16(XB2, ef[j][2], sb); sa = mfma16(XA3, ef[j][3], sa); sb = mfma16(XB3, ef[j][3], sb);
          LAS float* s2 = sw + 16 * j; s2[0] = sa[0]; s2[128] = sa[1]; s2[256] = sa[2]; s2[384] = sa[3]; s2[2048] = sb[0]; s2[2048 + 128] = sb[1]; s2[2048 + 256] = sb[2]; s2[2048 + 384] = sb[3]; }
        eb += 16384; sw += 64; } }
    asm volatile("" ::: "memory");
    { const char* kb = KTg; char* yq = (char*)(Y + (size_t)t0 * D + AW + BW + g * 16); const unsigned vy = (unsigned)((ln * 8) * D + 4 * q) * 2u;
#pragma unroll 1
      for (int th = 0; th < 4; ++th) {
          const bf16x8 ka = ldg<bf16x8>(kb, vo32), kc = ldg<bf16x8>(kb + 1024, vo32);
          f32x4 a0 = (f32x4){0.f, 0.f, 0.f, 0.f}, a1 = a0, b0 = a0, b1 = a0;
          a0 = mfma16(ka, XA0, a0); a1 = mfma16(kc, XA0, a1); b0 = mfma16(ka, XB0, b0); b1 = mfma16(kc, XB0, b1);
          if (th >= 1) { const bf16x8 k0 = ldg<bf16x8>(kb - 2048, vo32), k1 = ldg<bf16x8>(kb - 1024, vo32); a0 = mfma16(k0, XA1, a0); a1 = mfma16(k1, XA1, a1); b0 = mfma16(k0, XB1, b0); b1 = mfma16(k1, XB1, b1); }
          if (th >= 2) { const bf16x8 k0 = ldg<bf16x8>(kb - 4096, vo32), k1 = ldg<bf16x8>(kb - 3072, vo32); a0 = mfma16(k0, XA2, a0); a1 = mfma16(k1, XA2, a1); b0 = mfma16(k0, XB2, b0); b1 = mfma16(k1, XB2, b1); }
          if (th >= 3) { const bf16x8 k0 = ldg<bf16x8>(kb - 6144, vo32), k1 = ldg<bf16x8>(kb - 5120, vo32); a0 = mfma16(k0, XA3, a0); a1 = mfma16(k1, XA3, a1); b0 = mfma16(k0, XB3, b0); b1 = mfma16(k1, XB3, b1); }
          u32x2 w; w.x = cvt_pk_bf16(a0[0], a0[1]); w.y = cvt_pk_bf16(a0[2], a0[3]); *(u32x2*)(yq + vy) = w;
          w.x = cvt_pk_bf16(a1[0], a1[1]); w.y = cvt_pk_bf16(a1[2], a1[3]); *(u32x2*)(yq + (size_t)D * 2 + vy) = w;
          w.x = cvt_pk_bf16(b0[0], b0[1]); w.y = cvt_pk_bf16(b0[2], b0[3]); *(u32x2*)(yq + (size_t)128 * D * 2 + vy) = w;
          w.x = cvt_pk_bf16(b1[0], b1[1]); w.y = cvt_pk_bf16(b1[2], b1[3]); *(u32x2*)(yq + (size_t)129 * D * 2 + vy) = w;
          kb += 2048; yq += (size_t)2 * D * 2; } }
    asm volatile("" ::: "memory");
    const float l8r = LAMPg[lane * 8 + 2], l8i = LAMPg[lane * 8 + 3];
    float sr = 0.f, si = 0.f;
    { char* seb = (char*)(SE + ((size_t)(2 * pr) * CG + g) * 16 * 128);
#pragma unroll
      for (int s = 0; s < 16; ++s) { const float er = SbA[s * 128 + lane], ei = SbA[s * 128 + 64 + lane];
          *(float*)(seb + s * 512 + vl) = er; *(float*)(seb + s * 512 + 256 + vl) = ei;
          const float nr = l8r * sr - l8i * si + er, ni = l8r * si + l8i * sr + ei; sr = nr; si = ni; }
      float* dst = SEND + (((size_t)(2 * pr) * CG + g) * 2) * CS + lane; dst[0] = sr; dst[CS] = si; }
    { char* seb = (char*)(SE + ((size_t)(2 * pr + 1) * CG + g) * 16 * 128);
#pragma unroll
      for (int s = 0; s < 16; ++s) { const float er = SbB[s * 128 + lane], ei = SbB[s * 128 + 64 + lane];
          *(float*)(seb + s * 512 + vl) = er; *(float*)(seb + s * 512 + 256 + vl) = ei;
          const float nr = l8r * sr - l8i * si + er, ni = l8r * si + l8i * sr + ei; sr = nr; si = ni; }
      float* dst = SEND2 + (((size_t)pr * CG + g) * 2) * CS + lane; dst[0] = sr; dst[CS] = si; }
    asm volatile("s_waitcnt lgkmcnt(0)" ::: "memory");
}
constexpr int S5_PSG = 133120;
__device__ __forceinline__ void s5_glu(int unit, int wave, int lane, const bf16_t* WGLU, const float* glu_b, const float* mo_gc, bf16_t* Y, LAS unsigned char* lds) {
    const int ln = lane & 15, q = lane >> 4; LAS bf16_t* yst = (LAS bf16_t*)(lds + S5_YST); LAS float* PSg = (LAS float*)(lds + S5_PSG);
    bf16x8 wf[2][8];
    { const char* wb = (const char*)(WGLU + (size_t)(32 * wave) * 256); const unsigned vw = (unsigned)(ln * 256 + 8 * q) * 2u;
#pragma unroll
      for (int j = 0; j < 2; ++j)
#pragma unroll
          for (int ks = 0; ks < 8; ++ks) wf[j][ks] = ldg<bf16x8>(wb + j * 8192 + ks * 64, vw); }
    const f32x4 gb0 = *(const f32x4*)(glu_b + 32 * wave + 4 * q), gb1 = *(const f32x4*)(glu_b + 32 * wave + 16 + 4 * q);
    LAS bf16_t* op = (LAS bf16_t*)(lds + wave * S5_WSCR) + ln * 32 + 4 * q;
    { const LAS bf16_t* yrow = yst + ln * YST_LD; LAS float* psw = PSg + ln * 8 + wave; LAS bf16_t* ow = op;
#pragma unroll 4
      for (int tt = 0; tt < 8; ++tt) {
        f32x4 a0 = (f32x4){0.f, 0.f, 0.f, 0.f}, a1 = (f32x4){0.f, 0.f, 0.f, 0.f};
#pragma unroll
        for (int ks = 0; ks < 8; ++ks) { const bf16x8 yf = *(const LAS bf16x8*)(yrow + 32 * ks + 8 * q); a0 = mfma16(wf[0][ks], yf, a0); a1 = mfma16(wf[1][ks], yf, a1); }
        const u32x2 y0 = *(const LAS u32x2*)(yrow + 32 * wave + 4 * q), y1 = *(const LAS u32x2*)(yrow + 32 * wave + 16 + 4 * q);
        float o[8];
        o[0] = __uint_as_float(y0.x << 16) * sigmoid_fast(a0[0] + gb0[0]); o[1] = __uint_as_float(y0.x & 0xffff0000u) * sigmoid_fast(a0[1] + gb0[1]); o[2] = __uint_as_float(y0.y << 16) * sigmoid_fast(a0[2] + gb0[2]); o[3] = __uint_as_float(y0.y & 0xffff0000u) * sigmoid_fast(a0[3] + gb0[3]);
        o[4] = __uint_as_float(y1.x << 16) * sigmoid_fast(a1[0] + gb1[0]); o[5] = __uint_as_float(y1.x & 0xffff0000u) * sigmoid_fast(a1[1] + gb1[1]); o[6] = __uint_as_float(y1.y << 16) * sigmoid_fast(a1[2] + gb1[2]); o[7] = __uint_as_float(y1.y & 0xffff0000u) * sigmoid_fast(a1[3] + gb1[3]);
        float ss = ((o[0] * o[0] + o[1] * o[1]) + (o[2] * o[2] + o[3] * o[3])) + ((o[4] * o[4] + o[5] * o[5]) + (o[6] * o[6] + o[7] * o[7]));
        ss = add_x16_x32(ss);
        if (q == 0) *psw = ss;
        u32x2 w; w.x = cvt_pk_bf16(o[0], o[1]); w.y = cvt_pk_bf16(o[2], o[3]); *(LAS u32x2*)(ow) = w; w.x = cvt_pk_bf16(o[4], o[5]); w.y = cvt_pk_bf16(o[6], o[7]); *(LAS u32x2*)(ow + 16) = w;
        yrow += 16 * YST_LD; psw += 16 * 8; ow += 16 * 32; } }
    asm volatile("s_waitcnt lgkmcnt(0)" ::: "memory");
    __syncthreads();
    const f32x4 g0 = *(const f32x4*)(mo_gc + 32 * wave + 4 * q), g1 = *(const f32x4*)(mo_gc + 32 * wave + 16 + 4 * q);
    { char* yb = (char*)(Y + (size_t)(unit * 128) * D + AW + BW + 32 * wave); const unsigned vy = (unsigned)(ln * D + 4 * q) * 2u; const LAS f32x4* pp = (const LAS f32x4*)(PSg + ln * 8); const LAS bf16_t* ow = op;
#pragma unroll 2
      for (int tt = 0; tt < 8; ++tt) { const f32x4 p0 = pp[0], p1 = pp[1];
        const float rs = __builtin_amdgcn_rsqf((((p0[0] + p0[1]) + (p0[2] + p0[3])) + ((p1[0] + p1[1]) + (p1[2] + p1[3]))) * (1.0f / CW) + EPS);
        const u32x2 a = *(const LAS u32x2*)(ow), b = *(const LAS u32x2*)(ow + 16); u32x2 w;
        w.x = cvt_pk_bf16(__uint_as_float(a.x << 16) * rs * g0[0], __uint_as_float(a.x & 0xffff0000u) * rs * g0[1]); w.y = cvt_pk_bf16(__uint_as_float(a.y << 16) * rs * g0[2], __uint_as_float(a.y & 0xffff0000u) * rs * g0[3]);
        *(u32x2*)(yb + vy) = w;
        w.x = cvt_pk_bf16(__uint_as_float(b.x << 16) * rs * g1[0], __uint_as_float(b.x & 0xffff0000u) * rs * g1[1]); w.y = cvt_pk_bf16(__uint_as_float(b.y << 16) * rs * g1[2], __uint_as_float(b.y & 0xffff0000u) * rs * g1[3]);
        *(u32x2*)(yb + 32 + vy) = w;
        yb += (size_t)16 * D * 2; pp += 16 * 2; ow += 16 * 32; } }
}

constexpr int XC_LD = 392;
constexpr int RG_XC = 0, RG_PS = 100352, RG_CAR = 112640, RG_RSB = 114176, RG_PT = 114688, RG_HC = 116224;
template <int CTRL> __device__ __forceinline__ float dpp0(float v) { return __int_as_float(__builtin_amdgcn_update_dpp(0, __float_as_int(v), CTRL, 0xf, 0xf, true)); }
template <int CTRL> __device__ __forceinline__ float dppf(float old, float v) { return __int_as_float(__builtin_amdgcn_update_dpp(__float_as_int(old), __float_as_int(v), CTRL, 0xf, 0xf, false)); }
__device__ __forceinline__ void bf8_to_f32(const u32x4 o, float (&v)[8]) {
    v[0] = __uint_as_float(o.x << 16); v[1] = __uint_as_float(o.x & 0xffff0000u); v[2] = __uint_as_float(o.y << 16); v[3] = __uint_as_float(o.y & 0xffff0000u);
    v[4] = __uint_as_float(o.z << 16); v[5] = __uint_as_float(o.z & 0xffff0000u); v[6] = __uint_as_float(o.w << 16); v[7] = __uint_as_float(o.w & 0xffff0000u);
}
__device__ __forceinline__ float bcast15(float v) { return __int_as_float(__builtin_amdgcn_ds_swizzle(__float_as_int(v), 0x1F0)); }
template <int PASS>
__device__ __forceinline__ void rglru_unit(int unit, bool first, float& cprev, int tid, int wave, int lane, const bf16_t* Z, bf16_t* Y, const bf16_t* WRG, const bf16_t* WIG,
                                           const float* conv_w, const float* conv_b, const float* rg_b, const float* ig_b, const float* lam, const float* mo_gb,
                                           float* SUMA, float* SUMH, float* SUMA2, float* SUMH2, bf16_t* HL, bf16_t* PP, LAS unsigned char* lds) {
    LAS bf16_t* xcl = (LAS bf16_t*)(lds + RG_XC); LAS float* PS = (LAS float*)(lds + RG_PS); LAS float* CAR = (LAS float*)(lds + RG_CAR); LAS float* RSB = (LAS float*)(lds + RG_RSB); LAS float* PT = (LAS float*)(lds + RG_PT); LAS float* HC = (LAS float*)(lds + RG_HC);
    const int t0 = unit * 128; const int ln = lane & 15, q = lane >> 4;
    if (tid < 384) {
        const int c0 = (tid % 48) * 8, tg = tid / 48; const int tb = t0 + tg * 16, s0 = tb % SEQ;
        float w0[8], w1[8], w2[8], w3[8], bb[8];
#pragma unroll
        for (int hh = 0; hh < 2; ++hh) { const f32x4 a0 = *(const f32x4*)(conv_w + 0 * BW + c0 + 4 * hh), a1 = *(const f32x4*)(conv_w + 1 * BW + c0 + 4 * hh), a2 = *(const f32x4*)(conv_w + 2 * BW + c0 + 4 * hh), a3 = *(const f32x4*)(conv_w + 3 * BW + c0 + 4 * hh), a4 = *(const f32x4*)(conv_b + c0 + 4 * hh);
#pragma unroll
            for (int j = 0; j < 4; ++j) { w0[4 * hh + j] = a0[j]; w1[4 * hh + j] = a1[j]; w2[4 * hh + j] = a2[j]; w3[4 * hh + j] = a3[j]; bb[4 * hh + j] = a4[j]; } }
        float xm1[8], xm2[8], xm3[8];
        const bf16_t* zp = Z + (size_t)tb * INC + ZX + c0;
        { const u32x4 z4 = {0u, 0u, 0u, 0u}; const u32x4 o1 = s0 >= 1 ? *(const u32x4*)(zp - INC) : z4, o2 = s0 >= 2 ? *(const u32x4*)(zp - 2 * INC) : z4, o3 = s0 >= 3 ? *(const u32x4*)(zp - 3 * INC) : z4;
          bf8_to_f32(o1, xm1); bf8_to_f32(o2, xm2); bf8_to_f32(o3, xm3); }
        LAS bf16_t* xw = xcl + (tg * 16) * XC_LD + c0;
#pragma unroll 4
        for (int i = 0; i < 16; ++i) { float x0[8]; bf8_to_f32(*(const u32x4*)(zp), x0); float v[8];
#pragma unroll
            for (int j = 0; j < 8; ++j) { v[j] = bb[j] + w3[j] * x0[j] + w2[j] * xm1[j] + w1[j] * xm2[j] + w0[j] * xm3[j]; xm3[j] = xm2[j]; xm2[j] = xm1[j]; xm1[j] = x0[j]; }
            u32x4 w; w.x = cvt_pk_bf16(v[0], v[1]); w.y = cvt_pk_bf16(v[2], v[3]); w.z = cvt_pk_bf16(v[4], v[5]); w.w = cvt_pk_bf16(v[6], v[7]);
            *(LAS u32x4*)(xw) = w; zp += INC; xw += XC_LD; }
        if (PASS == 2) { const int c = tid; float h;
            if (first) { const int pr = unit >> 1, p0 = pr - (pr % (UPB128 / 2)); h = 0.f; const float* pa = SUMA2 + (size_t)p0 * BW + c; const float* ph = SUMH2 + (size_t)p0 * BW + c;
#pragma unroll 8
                for (int j = p0; j < pr; ++j) { h = fmaf(*pa, h, *ph); pa += BW; ph += BW; } }
            else h = fmaf(SUMA[(size_t)(unit - 1) * BW + c], cprev, SUMH[(size_t)(unit - 1) * BW + c]);
            cprev = h; CAR[c] = h; }
    }
    __syncthreads();
#pragma unroll 1
    for (int ci = 0; ci < 3; ++ci) {
        const int combo = wave + 8 * ci, h = combo >> 2, jt = combo & 3, cb = h * 64 + jt * 16;
        const bf16_t* wr = WRG + ((size_t)(h * 64 + jt * 16 + ln)) * 64 + 8 * q; const bf16_t* wi = WIG + ((size_t)(h * 64 + jt * 16 + ln)) * 64 + 8 * q;
        const bf16x8 RG0 = *(const bf16x8*)(wr), RG1 = *(const bf16x8*)(wr + 32), IG0 = *(const bf16x8*)(wi), IG1 = *(const bf16x8*)(wi + 32);
        const f32x4 rgb4 = *(const f32x4*)(rg_b + cb + 4 * q), igb4 = *(const f32x4*)(ig_b + cb + 4 * q), lam4 = *(const f32x4*)(lam + cb + 4 * q);
        const float m1 = ln < 1 ? 1.f : 0.f, m2 = ln < 2 ? 1.f : 0.f, m4 = ln < 4 ? 1.f : 0.f, m8 = ln < 8 ? 1.f : 0.f;
        float spc[4], car[4], ptot[4];
#pragma unroll
        for (int r = 0; r < 4; ++r) { spc[r] = -8.0f * 1.4426950408889634f * log1pf(expf(-lam4[r])); car[r] = PASS == 2 ? CAR[cb + 4 * q + r] : (first ? 0.f : HC[cb + 4 * q + r]); ptot[r] = (PASS == 1 && !first) ? PT[cb + 4 * q + r] : 1.f; }
        const LAS bf16_t* xb = xcl + ln * XC_LD + h * 64 + 8 * q; const LAS bf16_t* xv = xcl + ln * XC_LD + cb + 4 * q;
        const bf16_t* zg = Z + (size_t)(t0 + ln) * INC + ZG + cb + 4 * q; bf16_t* yo = Y + (size_t)(t0 + ln) * D + AW + cb + 4 * q; LAS float* psw = PS + ln * 24 + combo;
        bf16_t* hlo = HL + (size_t)(t0 + ln) * BW + cb + 4 * q; bf16_t* ppo = PP + (size_t)(t0 + ln) * BW + cb + 4 * q;
#pragma unroll 1
        for (int tt = 0; tt < 8; ++tt) {
            const bf16x8 B0 = *(const LAS bf16x8*)(xb), B1 = *(const LAS bf16x8*)(xb + 32);
            f32x4 ar = (f32x4){0.f, 0.f, 0.f, 0.f}, ai = (f32x4){0.f, 0.f, 0.f, 0.f};
            ar = mfma16(RG0, B0, ar); ar = mfma16(RG1, B1, ar); ai = mfma16(IG0, B0, ai); ai = mfma16(IG1, B1, ai);
            const u32x2 xq = *(const LAS u32x2*)(xv); float xc4[4] = {__uint_as_float(xq.x << 16), __uint_as_float(xq.x & 0xffff0000u), __uint_as_float(xq.y << 16), __uint_as_float(xq.y & 0xffff0000u)};
            float hv[4], pv[4];
#pragma unroll
            for (int r = 0; r < 4; ++r) {
                const float rr = sigmoid_fast(ar[r] + rgb4[r]), ii = sigmoid_fast(ai[r] + igb4[r]);
                float A = __builtin_amdgcn_exp2f(spc[r] * rr);
                float Bv = __builtin_amdgcn_sqrtf(fmaxf(1.0f - A * A, 0.f)) * (ii * xc4[r]);
                if (ln == 0) { Bv = fmaf(A, car[r], Bv); A *= ptot[r]; }
                { const float As = dpp0<0x111>(A) + m1, Bs = dpp0<0x111>(Bv); Bv = fmaf(A, Bs, Bv); A *= As; }
                { const float As = dpp0<0x112>(A) + m2, Bs = dpp0<0x112>(Bv); Bv = fmaf(A, Bs, Bv); A *= As; }
                { const float As = dpp0<0x114>(A) + m4, Bs = dpp0<0x114>(Bv); Bv = fmaf(A, Bs, Bv); A *= As; }
                { const float As = dpp0<0x118>(A) + m8, Bs = dpp0<0x118>(Bv); Bv = fmaf(A, Bs, Bv); A *= As; }
                hv[r] = Bv; pv[r] = A; car[r] = dppf<0x121>(Bv, Bv); ptot[r] = dppf<0x121>(A, A);
            }
            if (PASS == 1) { u32x2 w; w.x = cvt_pk_bf16(hv[0], hv[1]); w.y = cvt_pk_bf16(hv[2], hv[3]); *(u32x2*)(hlo) = w; w.x = cvt_pk_bf16(pv[0], pv[1]); w.y = cvt_pk_bf16(pv[2], pv[3]); *(u32x2*)(ppo) = w; hlo += 16 * BW; ppo += 16 * BW; }
            if (PASS == 2) { const u32x2 gq = *(const u32x2*)(zg);
                const float y0 = hv[0] * __uint_as_float(gq.x << 16), y1 = hv[1] * __uint_as_float(gq.x & 0xffff0000u), y2 = hv[2] * __uint_as_float(gq.y << 16), y3 = hv[3] * __uint_as_float(gq.y & 0xffff0000u);
                u32x2 w; w.x = cvt_pk_bf16(y0, y1); w.y = cvt_pk_bf16(y2, y3); *(u32x2*)(yo) = w;
                float ss = (y0 * y0 + y1 * y1) + (y2 * y2 + y3 * y3); ss += __shfl_xor(ss, 16); ss += __shfl_xor(ss, 32);
                if (q == 0) *psw = ss; }
            xb += 16 * XC_LD; xv += 16 * XC_LD; zg += 16 * INC; yo += 16 * D; psw += 16 * 24;
        }
        if (PASS == 1 && ln == 0) {
            float* da = first ? SUMA + (size_t)unit * BW : SUMA2 + (size_t)(unit >> 1) * BW; float* dh = first ? SUMH + (size_t)unit * BW : SUMH2 + (size_t)(unit >> 1) * BW;
#pragma unroll
            for (int r = 0; r < 4; ++r) { da[cb + 4 * q + r] = ptot[r]; dh[cb + 4 * q + r] = car[r]; if (first) { PT[cb + 4 * q + r] = ptot[r]; HC[cb + 4 * q + r] = car[r]; } } }
    }
    if (PASS == 2) {
        asm volatile("s_waitcnt vmcnt(0)" ::: "memory");
        __syncthreads();
        if (tid < 128) { float s = 0.f;
#pragma unroll
            for (int k = 0; k < 24; ++k) s += PS[tid * 24 + k];
            RSB[tid] = __builtin_amdgcn_rsqf(s * (1.0f / BW) + EPS); }
        __syncthreads();
#pragma unroll 2
        for (int k = 0; k < 12; ++k) { const int idx = tid + 512 * k, tl = idx / 48, c0 = (idx % 48) * 8; const float rs = RSB[tl];
            bf16_t* yp = Y + (size_t)(t0 + tl) * D + AW + c0; float v[8]; bf8_to_f32(*(const u32x4*)(yp), v);
            const f32x4 g0 = *(const f32x4*)(mo_gb + c0), g1 = *(const f32x4*)(mo_gb + c0 + 4);
            u32x4 w; w.x = cvt_pk_bf16(v[0] * rs * g0[0], v[1] * rs * g0[1]); w.y = cvt_pk_bf16(v[2] * rs * g0[2], v[3] * rs * g0[3]); w.z = cvt_pk_bf16(v[4] * rs * g1[0], v[5] * rs * g1[1]); w.w = cvt_pk_bf16(v[6] * rs * g1[2], v[7] * rs * g1[3]);
            *(u32x4*)(yp) = w; }
    }
    __syncthreads();
}

__device__ __forceinline__ void rglru_fix_pair(int pr, int tid, int wave, int lane, const bf16_t* Z, bf16_t* Y, const bf16_t* HL, const bf16_t* PP, const float* SUMA2, const float* SUMH2, const float* mo_gb, LAS unsigned char* lds) {
    LAS float* CAR = (LAS float*)(lds + RG_CAR);
    if (tid < 384) { const int c = tid, p0 = pr - (pr % (UPB128 / 2)); float h = 0.f; const float* pa = SUMA2 + (size_t)p0 * BW + c; const float* ph = SUMH2 + (size_t)p0 * BW + c;
#pragma unroll 8
        for (int j = p0; j < pr; ++j) { h = fmaf(*pa, h, *ph); pa += BW; ph += BW; }
        CAR[c] = h; }
    __syncthreads();
    {
        const bool act = lane < 48; const int c0 = act ? lane * 8 : 0; float hin[8]; const f32x4 g0 = *(const f32x4*)(mo_gb + c0), g1 = *(const f32x4*)(mo_gb + c0 + 4);
#pragma unroll
        for (int e = 0; e < 8; ++e) hin[e] = CAR[c0 + e];
#pragma unroll 2
        for (int i = 0; i < 32; ++i) { const size_t t = (size_t)pr * 256 + wave * 32 + i;
            float hl[8], pp[8], gg[8], y[8]; bf8_to_f32(*(const u32x4*)(HL + t * BW + c0), hl); bf8_to_f32(*(const u32x4*)(PP + t * BW + c0), pp); bf8_to_f32(*(const u32x4*)(Z + t * INC + ZG + c0), gg);
            float ss = 0.f;
#pragma unroll
            for (int e = 0; e < 8; ++e) { y[e] = fmaf(pp[e], hin[e], hl[e]) * gelu_fast(gg[e]); ss += y[e] * y[e]; }
            ss = wave_sum(act ? ss : 0.f);
            const float rs = __builtin_amdgcn_rsqf(ss * (1.0f / BW) + EPS);
            u32x4 w; w.x = cvt_pk_bf16(y[0] * rs * g0[0], y[1] * rs * g0[1]); w.y = cvt_pk_bf16(y[2] * rs * g0[2], y[3] * rs * g0[3]); w.z = cvt_pk_bf16(y[4] * rs * g1[0], y[5] * rs * g1[1]); w.w = cvt_pk_bf16(y[6] * rs * g1[2], y[7] * rs * g1[3]);
            if (act) *(u32x4*)(Y + t * D + AW + c0) = w; }
    }
    __syncthreads();
}

constexpr int VT_LD = 136;
__device__ __forceinline__ void mixa_unit(int unit, int tid, int wave, int lane, const bf16_t* Z, bf16_t* Y, const bf16_t* WSP, const float* a_sb, const float* vg, const float* mo_ga, LAS unsigned char* lds) {
    LAS bf16_t* vT = (LAS bf16_t*)lds; const int t0 = unit * 128; const int ln = lane & 15, q = lane >> 4;
    { const int j = tid >> 2, part = tid & 3; const bf16_t* zp = Z + (size_t)(t0 + j) * INC + ZV + part * 96;
      u32x4 raw[12]; float ss = 0.f;
#pragma unroll
      for (int k = 0; k < 12; ++k) { const u32x4 rw = *(const u32x4*)(zp + 8 * k); float v[8]; bf8_to_f32(rw, v);
#pragma unroll
          for (int e = 0; e < 8; ++e) { v[e] = gelu_fast(v[e]); ss += v[e] * v[e]; }
          raw[k].x = cvt_pk_bf16(v[0], v[1]); raw[k].y = cvt_pk_bf16(v[2], v[3]); raw[k].z = cvt_pk_bf16(v[4], v[5]); raw[k].w = cvt_pk_bf16(v[6], v[7]); }
      ss += x_xor1(ss); ss += x_xor2(ss);
      const float rs = __builtin_amdgcn_rsqf(ss * (1.0f / AW) + EPS);
      LAS bf16_t* vw = vT + (part * 96) * VT_LD + j; const float* gp = vg + part * 96;
#pragma unroll
      for (int k = 0; k < 12; ++k) { float v[8]; bf8_to_f32(raw[k], v); const f32x4 g0 = *(const f32x4*)(gp + 8 * k), g1 = *(const f32x4*)(gp + 8 * k + 4);
#pragma unroll
          for (int e = 0; e < 8; ++e) vw[(8 * k + e) * VT_LD] = f2bf(v[e] * rs * (e < 4 ? g0[e] : g1[e - 4])); } }
    __syncthreads();
    const bool full = wave >= 4;
    float ss = 0.f;
    const int tl = 16 * wave + ln;
    const char* ub = (const char*)(Z + (size_t)t0 * INC + ZU); const unsigned vu = (unsigned)(tl * INC + 4 * q) * 2u;
    const char* wb = (const char*)WSP; const unsigned vw = (unsigned)(tl * 128 + 8 * q) * 2u;
    char* yb = (char*)(Y + (size_t)t0 * D); const unsigned vy = (unsigned)(tl * D + 4 * q) * 2u;
    const bf16x8 z8 = {0, 0, 0, 0, 0, 0, 0, 0};
    bf16x8 Wn0 = ldg<bf16x8>(wb, vw), Wn1 = ldg<bf16x8>(wb + 64, vw), Wn2 = z8, Wn3 = z8;
    if (full) { Wn2 = ldg<bf16x8>(wb + 128, vw); Wn3 = ldg<bf16x8>(wb + 192, vw); }
    u32x2 un0 = ldg<u32x2>(ub, vu), un1 = ldg<u32x2>(ub + 32, vu), un2 = ldg<u32x2>(ub + 64, vu), un3 = ldg<u32x2>(ub + 96, vu); float bn = a_sb[tl];
    const LAS bf16_t* ap = vT + ln * VT_LD + 8 * q;
    u32x2 val[24];
#pragma unroll
    for (int h = 0; h < 6; ++h) {
        const bf16x8 W0 = Wn0, W1 = Wn1, W2 = Wn2, W3 = Wn3; const u32x2 uc[4] = {un0, un1, un2, un3}; const float b = bn;
        if (h < 5) { const char* wq = wb + (size_t)(h + 1) * 128 * 128 * 2; const char* uq2 = ub + (h + 1) * 128;
            Wn0 = ldg<bf16x8>(wq, vw); Wn1 = ldg<bf16x8>(wq + 64, vw); if (full) { Wn2 = ldg<bf16x8>(wq + 128, vw); Wn3 = ldg<bf16x8>(wq + 192, vw); }
            un0 = ldg<u32x2>(uq2, vu); un1 = ldg<u32x2>(uq2 + 32, vu); un2 = ldg<u32x2>(uq2 + 64, vu); un3 = ldg<u32x2>(uq2 + 96, vu); bn = a_sb[(h + 1) * 128 + tl]; }
        asm volatile("" ::: "memory");
#pragma unroll
        for (int dt = 0; dt < 4; ++dt) { f32x4 acc = (f32x4){0.f, 0.f, 0.f, 0.f};
            const LAS bf16_t* aq = ap + (h * 64 + 16 * dt) * VT_LD;
            const bf16x8 a0 = *(const LAS bf16x8*)(aq), a1 = *(const LAS bf16x8*)(aq + 32), a2 = *(const LAS bf16x8*)(aq + 64), a3 = *(const LAS bf16x8*)(aq + 96);
            acc = mfma16(a0, W0, acc); acc = mfma16(a1, W1, acc); acc = mfma16(a2, W2, acc); acc = mfma16(a3, W3, acc);
            const u32x2 u2 = uc[dt];
            const float v0 = gelu_fast(__uint_as_float(u2.x << 16)) * (acc[0] + b), v1 = gelu_fast(__uint_as_float(u2.x & 0xffff0000u)) * (acc[1] + b), v2 = gelu_fast(__uint_as_float(u2.y << 16)) * (acc[2] + b), v3 = gelu_fast(__uint_as_float(u2.y & 0xffff0000u)) * (acc[3] + b);
            ss += (v0 * v0 + v1 * v1) + (v2 * v2 + v3 * v3);
            u32x2 pk; pk.x = cvt_pk_bf16(v0, v1); pk.y = cvt_pk_bf16(v2, v3); val[h * 4 + dt] = pk; }
    }
    ss = add_x16_x32(ss);
    const float rs = __builtin_amdgcn_rsqf(ss * (1.0f / AW) + EPS);
    { const char* gb = (const char*)mo_ga; const unsigned vg4 = (unsigned)(4 * q) * 4u;
#pragma unroll
      for (int k = 0; k < 24; ++k) { const f32x4 gg = ldg<f32x4>(gb + k * 64, vg4); const u32x2 pk = val[k];
          u32x2 w; w.x = cvt_pk_bf16(__uint_as_float(pk.x << 16) * rs * gg[0], __uint_as_float(pk.x & 0xffff0000u) * rs * gg[1]); w.y = cvt_pk_bf16(__uint_as_float(pk.y << 16) * rs * gg[2], __uint_as_float(pk.y & 0xffff0000u) * rs * gg[3]);
          *(u32x2*)(yb + k * 32 + vy) = w; } }
    __syncthreads();
}

__device__ __forceinline__ void router_unit(int unit, int wave, int lane, const bf16_t* HB, const float* SSQ, const bf16_t* WRT, const float* rgb, const float* reb,
                                            int* CLS, float* G2, LAS unsigned char* lds, LAS int* hist) {
    const int ln = lane & 15, q = lane >> 4; const int t0 = unit * UT + wave * 32;
    LAS float* LG = (LAS float*)(lds + wave * 8192);
    f32x4 acc[2][3];
#pragma unroll
    for (int tt = 0; tt < 2; ++tt)
#pragma unroll
        for (int j = 0; j < 3; ++j) acc[tt][j] = (f32x4){0.f, 0.f, 0.f, 0.f};
    const bf16_t* hp0 = HB + (size_t)(t0 + ln) * D + 8 * q; const bf16_t* hp1 = hp0 + (size_t)16 * D; const bf16_t* wp = WRT + (size_t)ln * D + 8 * q;
#pragma unroll 4
    for (int ks = 0; ks < 32; ++ks) {
        const bf16x8 b0 = *(const bf16x8*)(hp0), b1 = *(const bf16x8*)(hp1);
        const bf16x8 a0 = *(const bf16x8*)(wp), a1 = *(const bf16x8*)(wp + 16 * D), a2 = *(const bf16x8*)(wp + 32 * D);
        acc[0][0] = mfma16(a0, b0, acc[0][0]); acc[0][1] = mfma16(a1, b0, acc[0][1]); acc[0][2] = mfma16(a2, b0, acc[0][2]);
        acc[1][0] = mfma16(a0, b1, acc[1][0]); acc[1][1] = mfma16(a1, b1, acc[1][1]); acc[1][2] = mfma16(a2, b1, acc[1][2]);
        hp0 += 32; hp1 += 32; wp += 32; }
#pragma unroll
    for (int tt = 0; tt < 2; ++tt)
#pragma unroll
        for (int j = 0; j < 3; ++j) *(LAS f32x4*)(LG + (16 * tt + ln) * 48 + 16 * j + 4 * q) = acc[tt][j];
    asm volatile("s_waitcnt lgkmcnt(0)" ::: "memory");
    if (lane < 32) { const int t = t0 + lane; const LAS float* lg = LG + lane * 48;
        const f32x4* sp = (const f32x4*)(SSQ + (size_t)t * 16); const f32x4 s0 = sp[0], s1 = sp[1], s2 = sp[2], s3 = sp[3];
        const float sq = ((s0[0] + s0[1]) + (s0[2] + s0[3])) + ((s1[0] + s1[1]) + (s1[2] + s1[3])) + ((s2[0] + s2[1]) + (s2[2] + s2[3])) + ((s3[0] + s3[1]) + (s3[2] + s3[3]));
        const float r = rsqrtf(sq * (1.0f / D) + EPS);
        float gl[4];
#pragma unroll
        for (int j = 0; j < 4; ++j) gl[j] = r * (lg[j] + lg[16 + j]) + rgb[j];
        int gs = 0; float gm = gl[0];
#pragma unroll
        for (int j = 1; j < 4; ++j) if (gl[j] > gm) { gm = gl[j]; gs = j; }
        float den = 0.f;
#pragma unroll
        for (int j = 0; j < 4; ++j) den += expf(gl[j] - gm);
        const float gwt = 1.0f / den;
        float el[4];
#pragma unroll
        for (int j = 0; j < 4; ++j) { float v;
            if (gs < 3) v = lg[4 + 4 * gs + j] + lg[16 + 4 + 4 * gs + j]; else v = lg[32 + j] + lg[36 + j];
            el[j] = r * v + reb[gs * 4 + j]; }
        int i0 = 0; float v0 = el[0];
#pragma unroll
        for (int j = 1; j < 4; ++j) if (el[j] > v0) { v0 = el[j]; i0 = j; }
        int i1 = 0; float v1 = -3.0e38f;
#pragma unroll
        for (int j = 0; j < 4; ++j) if (j != i0 && el[j] > v1) { v1 = el[j]; i1 = j; }
        const float e1 = expf(v1 - v0); const float w0 = gwt / (1.0f + e1), w1 = gwt * e1 / (1.0f + e1);
        const int lo = i0 < i1 ? i0 : i1, hi = i0 < i1 ? i1 : i0; const int cls = gs * 6 + pair_idx(lo, hi);
        CLS[t] = cls; G2[(size_t)t * 2 + 0] = i0 < i1 ? w0 : w1; G2[(size_t)t * 2 + 1] = i0 < i1 ? w1 : w0;
        __hip_atomic_fetch_add(hist + cls, 1, __ATOMIC_RELAXED, __HIP_MEMORY_SCOPE_WORKGROUP); }
}

__device__ __forceinline__ void tr_item8(const float* W, int ldw, int k0, int scol0, unsigned char* WT, int ldo, int drow0, int dk0, LAS float* scr, int lane) {
#pragma unroll 8
    for (int i = 0; i < 32; ++i) { const int kk = 2 * i + (lane >> 5); scr[kk * 33 + (lane & 31)] = W[(size_t)(k0 + kk) * ldw + scol0 + (lane & 31)] * pg8::FS_W; }
    asm volatile("s_waitcnt lgkmcnt(0)" ::: "memory");
    const int c = lane & 7;
#pragma unroll
    for (int j = 0; j < 4; ++j) { const int n = (lane >> 3) + 8 * j; const LAS float* s = scr + (8 * c) * 33 + n;
        u32x2 o; o.x = pk_fp8x4(s[0 * 33], s[1 * 33], s[2 * 33], s[3 * 33]); o.y = pk_fp8x4(s[4 * 33], s[5 * 33], s[6 * 33], s[7 * 33]);
        *(u32x2*)(WT + (size_t)(drow0 + n) * ldo + dk0 + 8 * c) = o; }
    asm volatile("s_waitcnt lgkmcnt(0)" ::: "memory");
}
struct TrP { const float* src; const float* gk; unsigned char* dst; int ldw, ldo, fp8; };
__device__ __forceinline__ void tr_load(const TrP& P, int lane, float (&v)[32]) {
#pragma unroll
    for (int i = 0; i < 32; ++i) { const int kk = 2 * i + (lane >> 5); float x = P.src[(size_t)kk * P.ldw + (lane & 31)]; if (P.gk) x *= P.gk[kk]; v[i] = x; }
}
__device__ __forceinline__ void tr_store(const TrP& P, int lane, const float (&v)[32], LAS float* scr) {
    const float sc = P.fp8 ? pg8::FS_W : 1.0f;
#pragma unroll
    for (int i = 0; i < 32; ++i) scr[(2 * i + (lane >> 5)) * 33 + (lane & 31)] = v[i] * sc;
    asm volatile("s_waitcnt lgkmcnt(0)" ::: "memory");
    const int c = lane & 7;
#pragma unroll
    for (int j = 0; j < 4; ++j) { const int n = (lane >> 3) + 8 * j; const LAS float* s = scr + (8 * c) * 33 + n;
        if (P.fp8) { u32x2 o; o.x = pk_fp8x4(s[0 * 33], s[1 * 33], s[2 * 33], s[3 * 33]); o.y = pk_fp8x4(s[4 * 33], s[5 * 33], s[6 * 33], s[7 * 33]); *(u32x2*)(P.dst + (size_t)n * P.ldo + 8 * c) = o; }
        else { u32x4 o; o.x = cvt_pk_bf16(s[0 * 33], s[1 * 33]); o.y = cvt_pk_bf16(s[2 * 33], s[3 * 33]); o.z = cvt_pk_bf16(s[4 * 33], s[5 * 33]); o.w = cvt_pk_bf16(s[6 * 33], s[7 * 33]); *(u32x4*)(P.dst + (size_t)n * P.ldo + 16 * c) = o; } }
    asm volatile("s_waitcnt lgkmcnt(0)" ::: "memory");
}
struct Args { const float* in[34]; float* out; unsigned char* ws; };

__global__ void __launch_bounds__(512, 2) mega_fwd(Args a) {
    extern __shared__ __attribute__((aligned(16))) unsigned char lds_raw[];
    LAS unsigned char* lds = (LAS unsigned char*)lds_raw;
    volatile LAS unsigned* LW = (volatile LAS unsigned*)(lds + LDSCTL_OFF);
    volatile LAS int* LWI = (volatile LAS int*)(lds + LDSCTL_OFF);
    const int G = gridDim.x, bid0 = blockIdx.x; const int wave_s0 = __builtin_amdgcn_readfirstlane(threadIdx.x >> 6);
#define PHASE_IDS() int wv_ = wave_s0, bd_ = bid0; asm volatile("" : "+s"(wv_), "+s"(bd_)); const int wave_s = wv_, bid = bd_;     \
    const int lane = fresh_lane(), wave = wave_s, tid = wave * 64 + lane; const int gw = bid * 8 + wave, NGW = G * 8; \
    const size_t gt = (size_t)bid * 512 + tid, NGT = (size_t)G * 512; (void)lane; (void)wave; (void)gw; (void)NGW; (void)gt; (void)NGT
#define WSB() ({ unsigned char* _w = a.ws; asm volatile("" : "+s"(_w)); _w; })
#define INP(i) ({ int _k = (i); asm volatile("" : "+s"(_k)); a.in[_k]; })
    for (int u = threadIdx.x; u < (LDS_PF - LDSCTL_OFF) / 4; u += 512) LW[u] = 0u;
    __syncthreads();
    XcdBarrier bar = xcd_barrier_post((unsigned*)(a.ws + WS_CTL) + CW_BAR, LW + LW_BAR);

    {
        PHASE_IDS(); unsigned char* ws = WSB(); bf16_t* WIN = (bf16_t*)(ws + WS_WIN); bf16_t* WOUT = (bf16_t*)(ws + WS_WOUT); bf16_t* WGU = (bf16_t*)(ws + WS_WGU); bf16_t* WD2 = (bf16_t*)(ws + WS_WD2);
        bf16_t* HB = (bf16_t*)(ws + WS_HB); float* SSQ = (float*)(ws + WS_SSQ);
        LAS float* scr = (LAS float*)(lds + wave * 16384);
        constexpr int I_IN = 16 * 56, I_OUT = 16 * 32, I_GU = 2 * 16 * 256, I_D8 = 16 * 256, I_GLU = 32, I_RG = 24, I_L = I_IN + I_OUT + I_GU + I_D8 + I_GLU + I_RG;
        const float* i_win = INP(2); const float* i_g = INP(1); const float* i_wout = INP(24); const float* i_wg = INP(30); const float* i_wu = INP(31); const float* i_wd = INP(32);
        const float* i_glu = INP(21); const float* i_rg = INP(8); const float* i_ig = INP(10);
#define TR_DECODE(P, it) do { const int l = (it) / I_L; int r = (it) % I_L; P.gk = nullptr; P.fp8 = 0; \
            if (r < I_IN) { const int kb = r / 56, nb = r % 56, j0 = nb * 32; const int sc = j0 < 768 ? j0 : (j0 < 1152 ? j0 + 384 : (j0 < 1536 ? j0 - 384 : j0));     \
                P.src = i_win + (size_t)l * D * INC + (size_t)kb * 64 * INC + sc; P.ldw = INC; P.gk = i_g + (size_t)l * D + kb * 64; P.dst = (unsigned char*)(WIN + (size_t)l * INC * D + (size_t)j0 * D + kb * 64); P.ldo = D * 2; } \
            else if ((r -= I_IN) < I_OUT) { const int kb = r / 32, nb = r % 32; P.src = i_wout + (size_t)l * D * D + (size_t)kb * 64 * D + nb * 32; P.ldw = D; P.dst = (unsigned char*)(WOUT + (size_t)l * D * D + (size_t)nb * 32 * D + kb * 64); P.ldo = D * 2; } \
            else if ((r -= I_OUT) < I_GU) { const int which = r / (16 * 256), e = (r / 256) % 16, q = r % 256, kb = q / 16, nb = q % 16, n0 = nb * 32;     \
                P.src = (which ? i_wu : i_wg) + ((size_t)l * NE + e) * D * DE + (size_t)kb * 64 * DE + n0; P.ldw = DE; P.fp8 = 1; \
                P.dst = (unsigned char*)WGU + ((size_t)l * NE + e) * 1024 * 1024 + (size_t)((n0 / 128) * 256 + which * 128 + (n0 % 128)) * 1024 + kb * 64; P.ldo = 1024; } \
            else if ((r -= I_GU) < I_D8) { const int e = r / 256, q = r % 256, kb = q / 32, nb = q % 32;        \
                P.src = i_wd + ((size_t)l * NE + e) * DE * D + (size_t)kb * 64 * D + nb * 32; P.ldw = D; P.fp8 = 1; P.dst = ws + WS_WD8 + ((size_t)l * NE + e) * 1024 * 512 + (size_t)nb * 32 * 512 + kb * 64; P.ldo = 512; } \
            else if ((r -= I_D8) < I_GLU) { const int kb = r / 8, nb = r % 8; P.src = i_glu + (size_t)l * CW * CW + (size_t)kb * 64 * CW + nb * 32; P.ldw = CW; P.dst = (unsigned char*)((bf16_t*)(ws + WS_WGLU) + (size_t)l * CW * CW + (size_t)nb * 32 * CW + kb * 64); P.ldo = CW * 2; } \
            else { r -= I_GLU; const int gate = r / 12, h = (r / 2) % 6, nb = r & 1; \
                P.src = (gate ? i_ig : i_rg) + ((size_t)l * 6 + h) * 64 * 64 + nb * 32; P.ldw = 64; P.dst = (unsigned char*)((bf16_t*)(ws + WS_WRG) + (((size_t)l * 2 + gate) * 6 + h) * 64 * 64 + (size_t)nb * 32 * 64); P.ldo = 64 * 2; } } while (0)
        { TrP Pa, Pb; float va[32], vb[32]; int it = gw;
          if (it < 2 * I_L) { TR_DECODE(Pa, it); tr_load(Pa, lane, va); }
#pragma unroll 1
          while (it < 2 * I_L) {
              const int it1 = it + NGW; if (it1 < 2 * I_L) { TR_DECODE(Pb, it1); tr_load(Pb, lane, vb); }
              tr_store(Pa, lane, va, scr);
              if (it1 >= 2 * I_L) break;
              const int it2 = it1 + NGW; if (it2 < 2 * I_L) { TR_DECODE(Pa, it2); tr_load(Pa, lane, va); }
              tr_store(Pb, lane, vb, scr);
              it = it2; } }
#undef TR_DECODE
        { const float* s_are = INP(13); const float* s_aim = INP(14); const float* s_ldt = INP(15); const float* s_bre = INP(16); const float* s_bim = INP(17); const float* s_cre = INP(18); const float* s_cim = INP(19); const float* s_d = INP(20);
          for (size_t e = gt; e < (size_t)2 * CG * 256; e += NGT) { const int l = (int)(e / (CG * 256)), g = (int)((e / 256) % CG), c = (int)((e >> 4) & 15), cp = (int)(e & 15);
              s5_kt_pair(g, c, cp, s_are + (size_t)l * CG * CS, s_aim + (size_t)l * CG * CS, s_ldt + (size_t)l * CG, s_bre + (size_t)l * CG * CS * CGD, s_bim + (size_t)l * CG * CS * CGD,
                         s_cre + (size_t)l * CG * CGD * CS, s_cim + (size_t)l * CG * CGD * CS, s_d + (size_t)l * CW, ws + WS_S5 + (size_t)l * S5_L_STRIDE); }
          for (size_t e = gt; e < (size_t)2 * CG * 2048; e += NGT) { const int l = (int)(e / (CG * 2048)), g = (int)((e / 2048) % CG), r = (int)(e & 2047);
              s5_et_task(g, r >> 10, (r >> 4) & 63, r & 15, s_are + (size_t)l * CG * CS, s_aim + (size_t)l * CG * CS, s_ldt + (size_t)l * CG, s_bre + (size_t)l * CG * CS * CGD, s_bim + (size_t)l * CG * CS * CGD, ws + WS_S5 + (size_t)l * S5_L_STRIDE);
              s5_ft_task(g, r >> 7, (r >> 6) & 1, r & 63, s_are + (size_t)l * CG * CS, s_aim + (size_t)l * CG * CS, s_ldt + (size_t)l * CG, s_cre + (size_t)l * CG * CGD * CS, s_cim + (size_t)l * CG * CGD * CS, ws + WS_S5 + (size_t)l * S5_L_STRIDE); }
          for (size_t e = gt; e < (size_t)2 * CG * 64; e += NGT) { const int l = (int)(e / (CG * 64)), g = (int)((e / 64) % CG), el = 4096 + 32768 + (int)(e % 64);
              s5_table_elem(g, el, s_are + (size_t)l * CG * CS, s_aim + (size_t)l * CG * CS, s_ldt + (size_t)l * CG, s_bre + (size_t)l * CG * CS * CGD, s_bim + (size_t)l * CG * CS * CGD,
                            s_cre + (size_t)l * CG * CGD * CS, s_cim + (size_t)l * CG * CGD * CS, s_d + (size_t)l * CW, ws + WS_S5 + (size_t)l * S5_L_STRIDE); } }
        { const float* sw = INP(4); bf16_t* wsp = (bf16_t*)(ws + WS_WSP); for (size_t e = gt; e < (size_t)2 * 6 * 128 * 128; e += NGT) wsp[e] = f2bf(sw[e]); }
        { const float* fg = INP(25); const float* rgw = INP(26); const float* rew = INP(28); bf16_t* wrt = (bf16_t*)(ws + WS_WRT);
          for (size_t e = gt; e < (size_t)2 * 48 * D; e += NGT) { const int l = (int)(e / (48 * D)), n = (int)((e / D) % 48), k = (int)(e % D);
              int j = -1, lo = 0; if (n < 16) j = n; else if (n < 32) { j = n - 16; lo = 1; } else if (n < 36) j = 16 + (n - 32); else if (n < 40) { j = 16 + (n - 36); lo = 1; }
              float v = 0.f;
              if (j >= 0) { const float w = fg[(size_t)l * D + k] * (j < 4 ? rgw[((size_t)l * D + k) * 4 + j] : rew[(((size_t)l * 4 + ((j - 4) >> 2)) * D + k) * 4 + ((j - 4) & 3)]);
                  const float hi = bf2f(f2bf(w)); v = lo ? (w - hi) : w; }
              wrt[e] = f2bf(v); } }
        const float* xin = INP(0);
#pragma unroll 1
        for (int t = gw * 2; t < T; t += NGW * 2) {
            const f32x4* xr = (const f32x4*)(xin + (size_t)t * D) + lane; f32x4 v[2][4]; float s0 = 0.f, s1 = 0.f;
#pragma unroll
            for (int j = 0; j < 4; ++j) { v[0][j] = xr[64 * j]; v[1][j] = xr[256 + 64 * j]; }
#pragma unroll
            for (int j = 0; j < 4; ++j) { s0 += (v[0][j][0] * v[0][j][0] + v[0][j][1] * v[0][j][1]) + (v[0][j][2] * v[0][j][2] + v[0][j][3] * v[0][j][3]); s1 += (v[1][j][0] * v[1][j][0] + v[1][j][1] * v[1][j][1]) + (v[1][j][2] * v[1][j][2] + v[1][j][3] * v[1][j][3]); }
            u32x2* o8 = (u32x2*)(HB + (size_t)t * D) + lane;
#pragma unroll
            for (int j = 0; j < 4; ++j) { u32x2 w; w.x = cvt_pk_bf16(v[0][j][0], v[0][j][1]); w.y = cvt_pk_bf16(v[0][j][2], v[0][j][3]); o8[64 * j] = w; w.x = cvt_pk_bf16(v[1][j][0], v[1][j][1]); w.y = cvt_pk_bf16(v[1][j][2], v[1][j][3]); o8[256 + 64 * j] = w; }
            s0 = wave_sum(s0); s1 = wave_sum(s1);
            if (lane < 32) SSQ[(size_t)t * 16 + lane] = lane == 0 ? s0 : (lane == 16 ? s1 : 0.f);
        }
    }
    xcd_barrier(bar);

    for (int l = 0; l < DEPTH; ++l) {
        { PHASE_IDS(); unsigned char* ws = WSB(); bf16_t* WIN = (bf16_t*)(ws + WS_WIN); bf16_t* HB = (bf16_t*)(ws + WS_HB); float* SSQ = (float*)(ws + WS_SSQ); bf16_t* Z = (bf16_t*)(ws + WS_Z);
          pg8::StaticOrder<T, INC> S; S.init(HB, WIN + (size_t)l * INC * D, G, bid);
          pg8::EpiZ E{Z, SSQ, lds + LDS_PF};
          pg8::gemm_phase<pg8::EpiZ, pg8::StaticOrder<T, INC>, true, true>(lds, wave_s, S, E); }
        xcd_barrier(bar);

        {
            PHASE_IDS(); unsigned char* ws = WSB(); const bf16_t* Z = (const bf16_t*)(ws + WS_Z);
            const float* conv_w = INP(6) + (size_t)l * 4 * BW; const float* conv_b = INP(7) + (size_t)l * BW; const float* rg_b = INP(9) + (size_t)l * BW;
            const float* ig_b = INP(11) + (size_t)l * BW; const float* lam = INP(12) + (size_t)l * BW;
            __syncthreads();
            { const bf16_t* WRG = (const bf16_t*)(ws + WS_WRG) + ((size_t)l * 2 + 0) * 6 * 4096; const bf16_t* WIG = (const bf16_t*)(ws + WS_WRG) + ((size_t)l * 2 + 1) * 6 * 4096;
              for (int pr = bid; pr < NU128 / 2; pr += G) { float cp = 0.f;
                  rglru_unit<1>(2 * pr, true, cp, tid, wave, lane, Z, nullptr, WRG, WIG, conv_w, conv_b, rg_b, ig_b, lam, nullptr, (float*)(ws + WS_SUMA), (float*)(ws + WS_SUMH), (float*)(ws + WS_SUMA2), (float*)(ws + WS_SUMH2), (bf16_t*)(ws + WS_HL), (bf16_t*)(ws + WS_PP), lds);
                  rglru_unit<1>(2 * pr + 1, false, cp, tid, wave, lane, Z, nullptr, WRG, WIG, conv_w, conv_b, rg_b, ig_b, lam, nullptr, (float*)(ws + WS_SUMA), (float*)(ws + WS_SUMH), (float*)(ws + WS_SUMA2), (float*)(ws + WS_SUMH2), (bf16_t*)(ws + WS_HL), (bf16_t*)(ws + WS_PP), lds); } }
            for (int pr = bid; pr < NU128 / 2; pr += G) { const unsigned char* tab = ws + WS_S5 + (size_t)l * S5_L_STRIDE;
                s5_pair1(pr, 2 * wave, wave, lane, Z, (bf16_t*)(ws + WS_Y), tab, (float*)(ws + WS_SEND), (float*)(ws + WS_SEND2), (float*)(ws + WS_SE), lds);
                s5_pair1(pr, 2 * wave + 1, wave, lane, Z, (bf16_t*)(ws + WS_Y), tab, (float*)(ws + WS_SEND), (float*)(ws + WS_SEND2), (float*)(ws + WS_SE), lds); }
            __syncthreads();
            { const bf16_t* WSP = (const bf16_t*)(ws + WS_WSP) + (size_t)l * 6 * 128 * 128; const float* a_sb = INP(5) + (size_t)l * 6 * 128; const float* vg = INP(3) + (size_t)l * AW; const float* mo_ga = INP(23) + (size_t)l * D;
              for (int u = bid; u < NU128; u += G) mixa_unit(u, tid, wave, lane, Z, (bf16_t*)(ws + WS_Y), WSP, a_sb, vg, mo_ga, lds); }
        }
        xcd_barrier(bar);

        {
            PHASE_IDS(); unsigned char* ws = WSB(); const bf16_t* Z = (const bf16_t*)(ws + WS_Z); bf16_t* Y = (bf16_t*)(ws + WS_Y);
            const float* a_v_norm_g = INP(3) + (size_t)l * AW; const float* a_sw = INP(4) + (size_t)l * 6 * 128 * 128; const float* a_sb = INP(5) + (size_t)l * 6 * 128;
        }

        { PHASE_IDS(); unsigned char* ws = WSB(); const bf16_t* Z = (const bf16_t*)(ws + WS_Z); bf16_t* Y = (bf16_t*)(ws + WS_Y);
          { const float* mo_gb = INP(23) + (size_t)l * D + AW;
            __syncthreads();
            for (int pr = bid; pr < NU128 / 2; pr += G) rglru_fix_pair(pr, tid, wave, lane, Z, Y, (const bf16_t*)(ws + WS_HL), (const bf16_t*)(ws + WS_PP), (const float*)(ws + WS_SUMA2), (const float*)(ws + WS_SUMH2), mo_gb, lds); }
          { const bf16_t* WGLU = (const bf16_t*)(ws + WS_WGLU) + (size_t)l * CW * CW; const float* glu_b = INP(22) + (size_t)l * CW; const float* mo_gc = INP(23) + (size_t)l * D + AW + BW;
            for (int pr = bid; pr < NU128 / 2; pr += G) { float k0r = 0.f, k0i = 0.f, k1r = 0.f, k1i = 0.f; const unsigned char* tab = ws + WS_S5 + (size_t)l * S5_L_STRIDE;
#pragma unroll 1
                for (int ui = 0; ui < 2; ++ui) { const int u = 2 * pr + ui; __syncthreads();
                    s5_group<2>(u, 2 * wave, ui == 0, k0r, k0i, wave, lane, Z, Y, tab, (float*)(ws + WS_SEND), (float*)(ws + WS_SEND2), (float*)(ws + WS_SE), lds);
                    s5_group<2>(u, 2 * wave + 1, ui == 0, k1r, k1i, wave, lane, Z, Y, tab, (float*)(ws + WS_SEND), (float*)(ws + WS_SEND2), (float*)(ws + WS_SE), lds);
                    __syncthreads(); s5_glu(u, wave, lane, WGLU, glu_b, mo_gc, Y, lds); } } } }
        asm volatile("s_waitcnt vmcnt(0)" ::: "memory"); __syncthreads();
        if (wave_s0 == 0) { __builtin_amdgcn_fence(__ATOMIC_ACQUIRE, "agent"); asm volatile("s_waitcnt vmcnt(0)" ::: "memory"); }
        __syncthreads();

        { PHASE_IDS(); unsigned char* ws = WSB(); bf16_t* WOUT = (bf16_t*)(ws + WS_WOUT); bf16_t* HB = (bf16_t*)(ws + WS_HB); float* SSQ = (float*)(ws + WS_SSQ); bf16_t* Y = (bf16_t*)(ws + WS_Y);
          pg8::PanelOrder<T, 4> S; S.init(Y, WOUT + (size_t)l * D * D, G, bid);
          pg8::EpiRes<false> E{HB, SSQ, nullptr, lds + LDS_PF};
          pg8::gemm_phase<pg8::EpiRes<false>, pg8::PanelOrder<T, 4>, true, true>(lds, wave_s, S, E); }
        asm volatile("s_waitcnt vmcnt(0)" ::: "memory"); __syncthreads();
        if (wave_s0 == 0) { __builtin_amdgcn_fence(__ATOMIC_ACQUIRE, "agent"); asm volatile("s_waitcnt vmcnt(0)" ::: "memory"); }
        __syncthreads();

        { PHASE_IDS(); unsigned char* ws = WSB(); const bf16_t* HB = (const bf16_t*)(ws + WS_HB); const float* SSQ = (const float*)(ws + WS_SSQ); int* CLS = (int*)(ws + WS_CLS); float* G2 = (float*)(ws + WS_G2); int* HIST = (int*)(ws + WS_HIST);
          const float* rgb = INP(27) + (size_t)l * 4; const float* reb = INP(29) + (size_t)l * 16;
        if (l == 0) {
            for (int rr = gw; rr < 2 * NCLS * 2 * 1024 / 2; rr += NGW) { const int row = 2 * rr + (lane >> 5), n = row & 1023, half = (row >> 10) & 1, cls = (row >> 11) % NCLS, ll = row / (2048 * NCLS);
                const int g = cls / 6, pi = cls % 6, e = g * 4 + (half ? pair_hi(pi) : pair_lo(pi));
                const u32x4 v = *(const u32x4*)(ws + WS_WD8 + ((size_t)ll * NE + e) * 1024 * 512 + (size_t)n * 512 + (lane & 31) * 16);
                *(u32x4*)(ws + WS_WD2 + ((size_t)ll * NCLS + cls) * 1024 * 1024 + (size_t)n * 1024 + half * 512 + (lane & 31) * 16) = v; } }
        for (int u = bid; u < NU; u += G) {
            router_unit(u, wave, lane, HB, SSQ, (const bf16_t*)(ws + WS_WRT) + (size_t)l * 48 * D, rgb, reb, CLS, G2, lds, (LAS int*)(lds + LDSCTL_OFF) + LW_HIST);
            __syncthreads();
            if (tid < 32) { HIST[u * 32 + tid] = tid < NCLS ? LWI[LW_HIST + tid] : 0; LWI[LW_HIST + tid] = 0; }
            __syncthreads();
        } }
        xcd_barrier(bar);

        { PHASE_IDS(); unsigned char* ws = WSB(); const bf16_t* HB = (const bf16_t*)(ws + WS_HB); const float* SSQ = (const float*)(ws + WS_SSQ); const int* CLS = (const int*)(ws + WS_CLS); const float* G2 = (const float*)(ws + WS_G2); const int* HIST = (const int*)(ws + WS_HIST);
          int* CTOT = (int*)(ws + WS_CTOT); int* ROWTOK = (int*)(ws + WS_ROWTOK); float* ROWG = (float*)(ws + WS_ROWG); bf16_t* HBS = (bf16_t*)(ws + WS_HBS); const float* ffn_g = INP(25) + (size_t)l * D;
        for (int u = bid; u < NU; u += G) {
            { const int c = tid & 31, part = tid >> 5; int tot = 0, pre = 0;
_Pragma("unroll 16")
              for (int k = part * 16; k < part * 16 + 16; ++k) { const int v = HIST[k * 32 + c]; tot += v; pre += k < u ? v : 0; }
              ((volatile LAS int*)lds)[tid] = tot; ((volatile LAS int*)lds)[512 + tid] = pre; }
            __syncthreads();
            if (tid < NCLS) { int tot = 0, pre = 0;
_Pragma("unroll")
                for (int k = 0; k < 16; ++k) { tot += ((volatile LAS int*)lds)[k * 32 + tid]; pre += ((volatile LAS int*)lds)[512 + k * 32 + tid]; } LWI[LW_TOT + tid] = tot; LWI[LW_BASE + tid] = pre; }
            __syncthreads();
            if (tid == 0) { int ps = 0;
_Pragma("unroll 1")
                for (int c = 0; c < NCLS; ++c) { const int tot = LWI[LW_TOT + c]; LWI[LW_BASE + c] += ps; LWI[LW_TST + c] = ps; ps += ((tot + 255) >> 8) << 8; if (bid == 0) CTOT[c] = tot; } LWI[LW_TST + NCLS] = ps; }
            if (tid < UT) LWI[LW_CLS + tid] = CLS[u * UT + tid];
            __syncthreads();
            if (tid < UT) { const int cls = LWI[LW_CLS + tid]; int rank = 0;
_Pragma("unroll 1")
                for (int i = 0; i < tid; ++i) rank += LWI[LW_CLS + i] == cls ? 1 : 0;
                const int dest = LWI[LW_BASE + cls] + rank; LWI[LW_DEST + tid] = dest; const int t = u * UT + tid;
                ROWTOK[dest] = t; ROWG[(size_t)dest * 2 + 0] = G2[(size_t)t * 2 + 0]; ROWG[(size_t)dest * 2 + 1] = G2[(size_t)t * 2 + 1]; }
            __syncthreads();
            { f32x4 gq[4];
#pragma unroll
              for (int j = 0; j < 4; ++j) gq[j] = *(const f32x4*)(ffn_g + lane * 16 + 4 * j);
#pragma unroll 1
              for (int i = 0; i < 32; i += 4) {
                  const int tl0 = wave * 32 + i, t0r = u * UT + tl0;
                  float sq = SSQ[(size_t)t0r * 16 + lane]; sq += x_xor1(sq); sq += x_xor2(sq); sq += x_hmir(sq); sq += x_mir(sq);
                  u32x4 o[4][2]; int dst[4];
#pragma unroll
                  for (int j = 0; j < 4; ++j) { o[j][0] = *(const u32x4*)(HB + (size_t)(t0r + j) * D + lane * 16); o[j][1] = *(const u32x4*)(HB + (size_t)(t0r + j) * D + lane * 16 + 8); dst[j] = LWI[LW_DEST + tl0 + j]; }
#pragma unroll
                  for (int j = 0; j < 4; ++j) { const float r4 = rsqrtf(__builtin_amdgcn_readlane(sq, 16 * j) * (1.0f / D) + EPS) * pg8::FS_H; u32x4 w;
#pragma unroll
                      for (int hh = 0; hh < 2; ++hh) { const u32x4 oo = o[j][hh]; const f32x4 g0 = gq[2 * hh], g1 = gq[2 * hh + 1];
                          const unsigned lo = pk_fp8x4(__uint_as_float(oo.x << 16) * r4 * g0[0], __uint_as_float(oo.x & 0xffff0000u) * r4 * g0[1], __uint_as_float(oo.y << 16) * r4 * g0[2], __uint_as_float(oo.y & 0xffff0000u) * r4 * g0[3]);
                          const unsigned hi = pk_fp8x4(__uint_as_float(oo.z << 16) * r4 * g1[0], __uint_as_float(oo.z & 0xffff0000u) * r4 * g1[1], __uint_as_float(oo.w << 16) * r4 * g1[2], __uint_as_float(oo.w & 0xffff0000u) * r4 * g1[3]);
                          if (hh == 0) { w.x = lo; w.y = hi; } else { w.z = lo; w.w = hi; } }
                      *(u32x4*)((unsigned char*)HBS + (size_t)dst[j] * D + lane * 16) = w; } } }
            if (u == bid)
_Pragma("unroll 1")
            for (int c = bid; c < NCLS; c += G) { const int tot = LWI[LW_TOT + c], r0 = LWI[LW_TST + c] + tot, r1 = LWI[LW_TST + c + 1];
                unsigned zz = 0u; asm volatile("" : "+v"(zz));
                for (int r = r0 + wave; r < r1; r += 8) { if (lane == 0) { ROWTOK[r] = -1; ROWG[(size_t)r * 2] = __uint_as_float(zz); ROWG[(size_t)r * 2 + 1] = __uint_as_float(zz); }
                    *(u32x4*)((unsigned char*)HBS + (size_t)r * D + lane * 16) = (u32x4){zz, zz, zz, zz}; } }
            __syncthreads();
        } }
        xcd_barrier(bar);

        { PHASE_IDS(); unsigned char* ws = WSB(); const int* CTOT = (const int*)(ws + WS_CTOT); bf16_t* HBS = (bf16_t*)(ws + WS_HBS); bf16_t* WGU = (bf16_t*)(ws + WS_WGU); bf16_t* ACT = (bf16_t*)(ws + WS_ACT); const float* ROWG = (const float*)(ws + WS_ROWG);
        if (tid == 0) { int ps = 0;
_Pragma("unroll 1")
            for (int c = 0; c < NCLS; ++c) { LWI[LW_TST + c] = ps; ps += (CTOT[c] + 255) >> 8; } LWI[LW_TST + NCLS] = ps; }
        __syncthreads();
        if (tid < 32) { const int ntile = LWI[LW_TST + NCLS]; const long L = (long)tid * G + bid; int e = -1;
            if (L < (long)ntile * 8) { const int nwg = ntile * 8, qq = nwg / 8, rr = nwg % 8, xcd = (int)(L % 8), off = (int)(L / 8); const int Lr = (xcd < rr ? xcd * (qq + 1) : rr * (qq + 1) + (xcd - rr) * qq) + off;
                const int mt = Lr / 8, pn = Lr % 8; int cls = 0;
_Pragma("unroll 1")
                for (int k = 1; k < NCLS; ++k) cls += (LWI[LW_TST + k] <= mt) ? 1 : 0;
                e = (cls << 24) | (pn << 16) | mt; }
            LWI[LW_UTAB + tid] = e; e = -1;
            if (L < (long)ntile * 4) { const int nwg = ntile * 4, qq = nwg / 8, rr = nwg % 8, xcd = (int)(L % 8), off = (int)(L / 8); const int Lr = (xcd < rr ? xcd * (qq + 1) : rr * (qq + 1) + (xcd - rr) * qq) + off;
                const int mt = Lr / 4, pn = Lr % 4; int cls = 0;
_Pragma("unroll 1")
                for (int k = 1; k < NCLS; ++k) cls += (LWI[LW_TST + k] <= mt) ? 1 : 0;
                e = (cls << 24) | (pn << 16) | mt; }
            LWI[LW_DTAB + tid] = e; }
        __syncthreads();
        { pg8::MoeOrder<8, true, 1024> S{LWI + LW_UTAB, l, (const char*)HBS, (const char*)WGU};
          pg8::EpiUp E{(unsigned char*)ACT, ROWG, lds + LDS_PF};
          pg8::gemm_phase<pg8::EpiUp, pg8::MoeOrder<8, true, 1024>, true, true, 512, true>(lds, wave_s, S, E); } }
        xcd_barrier(bar);

        { PHASE_IDS(); unsigned char* ws = WSB(); bf16_t* ACT = (bf16_t*)(ws + WS_ACT); bf16_t* WD2 = (bf16_t*)(ws + WS_WD2); bf16_t* HB = (bf16_t*)(ws + WS_HB); float* SSQ = (float*)(ws + WS_SSQ); const int* ROWTOK = (const int*)(ws + WS_ROWTOK);
          pg8::MoeOrder<4, false, 1024> S{LWI + LW_DTAB, l, (const char*)ACT, (const char*)WD2};
          pg8::EpiRes<true> E{HB, SSQ, ROWTOK, lds + LDS_PF};
          pg8::gemm_phase<pg8::EpiRes<true>, pg8::MoeOrder<4, false, 1024>, true, true, 512, true>(lds, wave_s, S, E); }
        xcd_barrier(bar);
    }

    { PHASE_IDS(); unsigned char* ws = WSB(); const bf16_t* HB = (const bf16_t*)(ws + WS_HB); const float* SSQ = (const float*)(ws + WS_SSQ); const float* fg = INP(33); float* outp = a.out;
    { f32x4 gq[4];
#pragma unroll
      for (int q = 0; q < 4; ++q) gq[q] = *(const f32x4*)(fg + 256 * q + 4 * lane);
#pragma unroll 1
      for (int t0r = gw * 4; t0r < T; t0r += NGW * 4) {
          float sq = SSQ[(size_t)t0r * 16 + lane]; sq += x_xor1(sq); sq += x_xor2(sq); sq += x_hmir(sq); sq += x_mir(sq);
          u32x2 o[4][4];
#pragma unroll
          for (int j = 0; j < 4; ++j)
#pragma unroll
              for (int q = 0; q < 4; ++q) o[j][q] = *(const u32x2*)(HB + (size_t)(t0r + j) * D + 256 * q + 4 * lane);
#pragma unroll
          for (int j = 0; j < 4; ++j) { const float r = rsqrtf(__builtin_amdgcn_readlane(sq, 16 * j) * (1.0f / D) + EPS); float* orow = outp + (size_t)(t0r + j) * D + 4 * lane;
#pragma unroll
              for (int q = 0; q < 4; ++q) { const u32x2 oo = o[j][q]; const f32x4 g0 = gq[q]; f32x4 w0;
                  w0[0] = __uint_as_float(oo.x << 16) * r * g0[0]; w0[1] = __uint_as_float(oo.x & 0xffff0000u) * r * g0[1]; w0[2] = __uint_as_float(oo.y << 16) * r * g0[2]; w0[3] = __uint_as_float(oo.y & 0xffff0000u) * r * g0[3];
                  *(f32x4*)(orow + 256 * q) = w0; } } } }
}
}

extern "C" void kernel_launch(void* const* d_in, const int* in_sizes, int n_in, void* d_out, int out_size, void* d_ws, size_t ws_size, hipStream_t stream) {
    static int grid = 0;
    if (grid == 0) {
        if (n_in != 34 || in_sizes[0] != T * D || out_size != T * D || ws_size < WS_END) { fprintf(stderr, "kernel_launch: unexpected shapes (n_in %d, ws %zu)\n", n_in, ws_size); grid = -1; return; }
        int dev = 0, cus = 0, per_cu = 0;
        if (hipGetDevice(&dev) != hipSuccess || hipDeviceGetAttribute(&cus, hipDeviceAttributeMultiprocessorCount, dev) != hipSuccess) { grid = -1; return; }
        if (hipFuncSetAttribute((const void*)mega_fwd, hipFuncAttributeMaxDynamicSharedMemorySize, LDS_BYTES) != hipSuccess) { fprintf(stderr, "kernel_launch: hipFuncSetAttribute failed\n"); grid = -1; return; }
        if (hipOccupancyMaxActiveBlocksPerMultiprocessor(&per_cu, (const void*)mega_fwd, 512, LDS_BYTES) != hipSuccess || per_cu < 1) { fprintf(stderr, "kernel_launch: occupancy query says %d\n", per_cu); }
        (void)hipGetLastError();
        grid = cus;
    }
    if (grid < 0) return;
    (void)hipMemsetAsync((char*)d_ws + WS_CTL, 0, CTL_ZERO_BYTES, stream);
    Args a{};
    for (int i = 0; i < 34; ++i) a.in[i] = (const float*)d_in[i];
    a.out = (float*)d_out; a.ws = (unsigned char*)d_ws;
    hipLaunchKernelGGL(mega_fwd, dim3(grid), dim3(512), LDS_BYTES, stream, a);
}
```

```cpp
#include <hip/hip_runtime.h>
#include <cstdio>
#include <cstdint>

#define LAS __attribute__((address_space(3)))
typedef unsigned short bf16_t;
typedef short bf16x8 __attribute__((ext_vector_type(8)));
typedef float f32x4 __attribute__((ext_vector_type(4)));
typedef float f32x2 __attribute__((ext_vector_type(2)));
typedef unsigned u32x4 __attribute__((ext_vector_type(4)));
typedef unsigned u32x2 __attribute__((ext_vector_type(2)));
typedef int i32x4 __attribute__((ext_vector_type(4)));
typedef int i32x8 __attribute__((ext_vector_type(8)));

constexpr int D = 1024, BATCH = 8, SEQ = 8192, T = BATCH * SEQ, DEPTH = 2;
constexpr int AW = 384, BW = 384, CW = 256, HD = 64, ABLK = 128, CHUNK = 64;
constexpr int INC = 1792;
constexpr int ZU = 0, ZV = 384, ZG = 768, ZX = 1152, ZC = 1536, ZGELU_END = 1152;
constexpr int CG = 16, CGD = 16, CS = 64;
constexpr int NE = 16, DE = 512, NCLS = 24;
constexpr float EPS = 1e-6f;
constexpr int UT = 256;
constexpr int NU = T / UT;
constexpr int MAXROWS = T + NCLS * 256;

constexpr size_t MiB = 1u << 20;
constexpr size_t WS_CTL = 0, CTL_ZERO_BYTES = 1 * MiB;
constexpr size_t WS_WIN = 2 * MiB;
constexpr size_t WS_WOUT = 10 * MiB;
constexpr size_t WS_WGLU = 14 * MiB;
constexpr size_t WS_WRG = 15 * MiB;
constexpr size_t WS_WSP = 15 * MiB + 256 * 1024;
constexpr size_t WS_WRT = 15 * MiB + 768 * 1024;
constexpr size_t WS_WGU = 16 * MiB;
constexpr size_t WS_WD8 = 48 * MiB;
constexpr size_t WS_WD2 = 80 * MiB;
constexpr size_t WS_SSQ = 176 * MiB;
constexpr size_t WS_RS = 180 * MiB;
constexpr size_t WS_CLS = WS_RS + 256 * 1024;
constexpr size_t WS_G2 = WS_CLS + 256 * 1024;
constexpr size_t WS_HIST = 181 * MiB;
constexpr size_t WS_CTOT = WS_HIST + 64 * 1024;
constexpr size_t WS_ROWTOK = WS_HIST + 256 * 1024;
constexpr size_t WS_ROWG = 182 * MiB;
constexpr size_t WS_SUMA = 183 * MiB;
constexpr size_t WS_SUMH = 191 * MiB;
constexpr size_t WS_S5 = 184 * MiB;
constexpr size_t WS_SEND = 187 * MiB;
constexpr size_t WS_HB = 192 * MiB;
constexpr size_t WS_Z = 320 * MiB;
constexpr size_t WS_HBS = WS_Z;
constexpr size_t WS_Y = 544 * MiB;
constexpr size_t WS_ACT = 672 * MiB;
constexpr size_t WS_HL = 672 * MiB;
constexpr size_t WS_PP = 736 * MiB;
constexpr size_t WS_SE = 800 * MiB;
constexpr size_t WS_AV = 672 * MiB;
constexpr size_t WS_BV = 768 * MiB;
constexpr size_t WS_SEND2 = 864 * MiB;
constexpr size_t WS_SUMA2 = 866 * MiB;
constexpr size_t WS_SUMH2 = 867 * MiB;
constexpr size_t WS_END = 868 * MiB;
constexpr int CW_BAR = 4096;

constexpr int RING_BYTES = 131072;
constexpr int LDSCTL_OFF = 143360;
constexpr int LDS_PF = 147456;
constexpr int LDS_BYTES = 163840;
constexpr int LW_BAR = 8, LW_TST = 64, LW_HIST = 96, LW_TOT = 128, LW_BASE = 160, LW_CLS = 256  , LW_DEST = 512  , LW_UTAB = 768  , LW_DTAB = 800  ;

__device__ __forceinline__ float bf2f(bf16_t v) { return __uint_as_float(((unsigned)v) << 16); }
__device__ __forceinline__ unsigned cvt_pk_bf16(float lo, float hi) { unsigned r; asm volatile("v_cvt_pk_bf16_f32 %0, %1, %2" : "=v"(r) : "v"(lo), "v"(hi)); return r; }
__device__ __forceinline__ bf16_t f2bf(float v) { return (bf16_t)(cvt_pk_bf16(v, 0.f) & 0xffffu); }
__device__ __forceinline__ unsigned pk_fp8x4(float a, float b, float c, float d) {
    a = fminf(fmaxf(a, -448.f), 448.f); b = fminf(fmaxf(b, -448.f), 448.f); c = fminf(fmaxf(c, -448.f), 448.f); d = fminf(fmaxf(d, -448.f), 448.f);
    int r = __builtin_amdgcn_cvt_pk_fp8_f32(a, b, 0, false); r = __builtin_amdgcn_cvt_pk_fp8_f32(c, d, r, true); return (unsigned)r; }
__device__ __forceinline__ int fresh_lane() { unsigned z = 0u; asm volatile("" : "+s"(z)); return (int)__builtin_amdgcn_mbcnt_hi(~0u, __builtin_amdgcn_mbcnt_lo(~0u, z)); }
__device__ __forceinline__ float x_xor1(float v) { return __int_as_float(__builtin_amdgcn_update_dpp(0, __float_as_int(v), 0xB1, 0xf, 0xf, true)); }
__device__ __forceinline__ float x_xor2(float v) { return __int_as_float(__builtin_amdgcn_update_dpp(0, __float_as_int(v), 0x4E, 0xf, 0xf, true)); }
__device__ __forceinline__ float x_hmir(float v) { return __int_as_float(__builtin_amdgcn_update_dpp(0, __float_as_int(v), 0x141, 0xf, 0xf, true)); }
__device__ __forceinline__ float x_mir(float v) { return __int_as_float(__builtin_amdgcn_update_dpp(0, __float_as_int(v), 0x140, 0xf, 0xf, true)); }
__device__ __forceinline__ float x_xor16(float v) { return __int_as_float(__builtin_amdgcn_ds_swizzle(__float_as_int(v), 0x401F)); }
__device__ __forceinline__ float add_xor32(float v) { const auto r = __builtin_amdgcn_permlane32_swap(__float_as_uint(v), __float_as_uint(v), false, false); return __uint_as_float(r[0]) + __uint_as_float(r[1]); }
__device__ __forceinline__ float add_x16_x32(float v) { v += x_xor16(v); return add_xor32(v); }
__device__ __forceinline__ float wave_sum(float v) { v += x_xor1(v); v += x_xor2(v); v += x_hmir(v); v += x_mir(v); v += x_xor16(v); return add_xor32(v); }
__device__ __forceinline__ float gelu_fast(float x) {
    const float u2 = 1.5957691216057308f * (x + 0.044715f * x * x * x);
    const float e = __builtin_amdgcn_exp2f(-1.4426950408889634f * u2);
    return x * __builtin_amdgcn_rcpf(1.0f + e);
}
__device__ __forceinline__ float sigmoid_fast(float x) { return __builtin_amdgcn_rcpf(1.0f + __builtin_amdgcn_exp2f(-1.4426950408889634f * x)); }
__device__ __forceinline__ float sigmoid_f(float x) { return 1.0f / (1.0f + expf(-x)); }
__device__ __forceinline__ int pair_lo(int pi) { return pi < 3 ? 0 : (pi < 5 ? 1 : 2); }
__device__ __forceinline__ int pair_hi(int pi) { return pi < 3 ? pi + 1 : (pi < 5 ? pi - 1 : 3); }
__device__ __forceinline__ int pair_idx(int lo, int hi) { return lo == 0 ? hi - 1 : (lo == 1 ? hi + 1 : 5); }

#define XB_TMO      128
#define XB_XCNT(j)  (256  + 64 * (j))
#define XB_XSUB(j)  (1280 + 64 * (j))
#define XB_XGEN(j)  (2304 + 64 * (j))
#define XB_TOP      3328
#define XB_TOPGEN   3392
#define XCD_BAR_WORDS 3456
#define XB_SPIN_CAP (1u << 18)
__device__ __forceinline__ unsigned xb_ld(unsigned* p)              { return __hip_atomic_load(p, __ATOMIC_RELAXED, __HIP_MEMORY_SCOPE_AGENT); }
__device__ __forceinline__ unsigned xb_add(unsigned* p, unsigned v) { return __hip_atomic_fetch_add(p, v, __ATOMIC_RELAXED, __HIP_MEMORY_SCOPE_AGENT); }
__device__ __forceinline__ unsigned xb_xcc_id() { return (unsigned)__builtin_amdgcn_s_getreg((3 << 11) | 20) & 0xFu; }
#define XB_SPIN(cond, bar) do { unsigned _sp = 0; while (cond) { __builtin_amdgcn_s_sleep(1); \
    if ((++_sp & 255u) == 0u) { if (xb_ld(&(bar)[XB_TMO])) break; if (_sp > XB_SPIN_CAP) { atomicAdd(&(bar)[XB_TMO], 1u); break; } } } } while (0)
struct XcdBarrier { unsigned* bar; unsigned x; volatile LAS unsigned* st; };
__device__ __forceinline__ XcdBarrier xcd_barrier_post(unsigned* bar, volatile LAS unsigned* st) {
    XcdBarrier b; b.bar = bar; b.x = xb_xcc_id(); b.st = st;
    if (threadIdx.x == 0) (void)xb_add(&bar[XB_XCNT(b.x)], 1u);
    return b;
}
__device__ __forceinline__ void xcd_barrier_complete(unsigned* bar, unsigned x, unsigned& nloc, unsigned& nx) {
    const unsigned G = gridDim.x * gridDim.y * gridDim.z;
    unsigned sum, cnt, mine, sp = 0u;
    for (;;) {
        sum = 0u; cnt = 0u; mine = 0u;
#pragma unroll
        for (unsigned j = 0; j < 16; ++j) { const unsigned c = xb_ld(&bar[XB_XCNT(j)]); sum += c; cnt += (c > 0u) ? 1u : 0u; mine = (j == x) ? c : mine; }
        if (sum == G) break;
        __builtin_amdgcn_s_sleep(1);
        if ((++sp & 255u) == 0u) { if (xb_ld(&bar[XB_TMO])) break; if (sp > XB_SPIN_CAP) { atomicAdd(&bar[XB_TMO], 1u); break; } }
    }
    nloc = mine > 0u ? mine : 1u; nx = cnt > 0u ? cnt : 1u;
}
__device__ __forceinline__ void xcd_barrier(const XcdBarrier& b) {
    asm volatile("s_waitcnt vmcnt(0)" ::: "memory");
    __syncthreads();
    if (threadIdx.x == 0) {
        unsigned* bar = b.bar; asm volatile("" : "+s"(bar));
        __builtin_amdgcn_s_waitcnt(0);
        unsigned bx0 = b.x; asm volatile("" : "+s"(bx0));
        unsigned nloc = b.st[0], nx = b.st[1];
        if (nloc == 0u) { xcd_barrier_complete(bar, bx0, nloc, nx); b.st[0] = nloc; b.st[1] = nx; }
        unsigned bx = b.x; asm volatile("" : "+s"(bx));
        const unsigned old = xb_add(&bar[XB_XSUB(bx)], 1u);
        const unsigned gen = old / nloc;
        if (old + 1u == (gen + 1u) * nloc) {
            __builtin_amdgcn_fence(__ATOMIC_RELEASE, "agent");
            asm volatile("s_waitcnt vmcnt(0)" ::: "memory");
            const unsigned og = xb_add(&bar[XB_TOP], 1u);
            const unsigned tg = og / nx;
            if (og + 1u == (tg + 1u) * nx) xb_add(&bar[XB_TOPGEN], 1u);
            else XB_SPIN(xb_ld(&bar[XB_TOPGEN]) == tg, bar);
            __builtin_amdgcn_fence(__ATOMIC_ACQUIRE, "agent");
            xb_add(&bar[XB_XGEN(bx)], 1u);
            asm volatile("s_waitcnt vmcnt(0)" ::: "memory");
        } else {
            XB_SPIN(xb_ld(&bar[XB_XGEN(bx)]) == gen, bar);
            __builtin_amdgcn_fence(__ATOMIC_ACQUIRE, "agent");
            asm volatile("s_waitcnt vmcnt(0)" ::: "memory");
        }
    }
    __syncthreads();
}

namespace pg8 {
#define PG8_LAS __attribute__((address_space(3)))
constexpr int BM = 256, BK = 64, HALF = 128, HTB = HALF * BK * 2, STAGE_BYTES = 8 * HTB, NXCD = 8, WGM = 4;
__host__ __device__ __forceinline__ int lds_byte(int r, int c) { const int st = (r >> 4) * 2 + (c >> 5), rr = r & 15, cc = c & 31, ob = rr * 64 + cc * 2; return st * 1024 + (ob ^ (((ob >> 9) & 1) << 5)); }
__host__ __device__ __forceinline__ void stage_rc(int b, int& R, int& C) { const int st = b / 1024, sb = b % 1024, swz = sb ^ (((sb >> 9) & 1) << 5); R = (st >> 1) * 16 + swz / 64; C = (st & 1) * 32 + (swz % 64) / 2; }
__host__ __device__ __forceinline__ int perm32(int rho) { const int n = rho >> 4, i = rho & 15; return 8 * (i >> 2) + 4 * n + (i & 3); }
struct Unit { int pm, pn; const char* A; const char* B; };

template <int M_, int NN> struct PanelOrder {
    static constexpr int nM = M_ / BM; static constexpr size_t tstep = (size_t)BM * 1024 * 2;
    int G, c; const char* A; const char* Bt;
    __device__ void init(const void* A_, const void* Bt_, int G_, int c_) { G = G_; c = c_; A = (const char*)A_; Bt = (const char*)Bt_; }
    __device__ bool next(int i, Unit& u) const { const int pm = c + (i / NN) * G; if (pm >= nM) return false; u.pm = pm; u.pn = i % NN; u.A = A + (size_t)pm * tstep; u.B = Bt + (size_t)u.pn * tstep; return true; }
    __device__ __forceinline__ void a_ready(const Unit&) const {}
    __device__ __forceinline__ void done(const Unit&) const {}
};
template <int M_, int N_> struct StaticOrder {
    static constexpr int nM = M_ / BM, nN = N_ / BM, nwg = nM * nN; static constexpr size_t tstep = (size_t)BM * 1024 * 2;
    int G, c; const char* A; const char* Bt;
    __device__ void init(const void* A_, const void* Bt_, int G_, int c_) { G = G_; c = c_; A = (const char*)A_; Bt = (const char*)Bt_; }
    __device__ bool next(int i, Unit& u) const {
        const long L = (long)i * G + c; if (L >= nwg) return false;
        int wgid = (int)L; { constexpr int q = nwg / NXCD, r = nwg % NXCD; const int xcd = wgid % NXCD, off = wgid / NXCD; wgid = (xcd < r ? xcd * (q + 1) : r * (q + 1) + (xcd - r) * q) + off; }
        constexpr int nig = WGM * nN; const int gid = wgid / nig, fm = gid * WGM, gsz = (nM - fm) < WGM ? (nM - fm) : WGM;
        u.pm = fm + ((wgid % nig) % gsz); u.pn = (wgid % nig) / gsz; u.A = A + (size_t)u.pm * tstep; u.B = Bt + (size_t)u.pn * tstep; return true;
    }
    __device__ __forceinline__ void a_ready(const Unit&) const {}
    __device__ __forceinline__ void done(const Unit&) const {}
};
template <class Epi, class Sched, bool ALIGN_EPI = false, bool SP2 = false, int KB = 1024, bool FP8 = false>
__device__ __forceinline__ void gemm_phase(PG8_LAS unsigned char* lds, const int wave_s, const Sched& S, const Epi& E) { const int Kdim = 0;
    const int lane = fresh_lane(), wid = wave_s, tid = wid * 64 + lane, wr = wid >> 2, wc = wid & 3, fr = lane & 15, fq = lane >> 4;
    constexpr int K = KB, nt = K / BK; (void)Kdim;
    unsigned voffA, voffB;
    { int R, C; stage_rc(tid * 16, R, C); const int Rb = Epi::PERM ? ((R & ~31) + perm32(R & 31)) : R; voffA = (unsigned)(R * K + C) * 2u; voffB = (unsigned)(Rb * K + C) * 2u; }
    constexpr size_t kstep = (size_t)(BK * 2);
    constexpr size_t hstep = (size_t)HALF * K * 2;
    constexpr size_t tstep = 2 * hstep; (void)tstep;
    const unsigned ldsw = (unsigned)wid * 1024u; const unsigned ldsb = (unsigned)(size_t)lds + ldsw;
    const int aoff = lds_byte(wr * 64 + fr, fq * 8), boff = lds_byte(wc * 32 + fr, fq * 8);
#define PG8_SA(b, h) (((b) * 2 + (h)) * HTB)
#define PG8_SB(b, h) ((4 + (b) * 2 + (h)) * HTB)
#define PG8_STAGE(bufoff, gbase, voff) do { _Pragma("unroll") for (int _i = 0; _i < 2; ++_i) { unsigned _keep; \
        asm volatile("s_mov_b32 %0, m0\n\ts_mov_b32 m0, %3\n\ts_nop 0\n\tglobal_load_lds_dwordx4 %1, %2\n\ts_mov_b32 m0, %0" : "=&s"(_keep) \
            : "v"(voff), "s"((const char*)(gbase) + (size_t)_i * (64 * K * 2)), "s"(ldsb + (unsigned)((bufoff) + _i * 8192)) : "memory"); } } while (0)
#define PG8_LDA(dst, b, h) do { if constexpr (FP8) { _Pragma("unroll") for (int m = 0; m < 4; ++m) { const i32x4 _lo = *(const PG8_LAS i32x4*)(lds + PG8_SA(b, h) + aoff + m * 2048), _hi = *(const PG8_LAS i32x4*)(lds + PG8_SA(b, h) + aoff + m * 2048 + 1024); \
            dst##8[m] = __builtin_shufflevector(_lo, _hi, 0, 1, 2, 3, 4, 5, 6, 7); } } \
        else { _Pragma("unroll") for (int m = 0; m < 4; ++m) _Pragma("unroll") for (int k = 0; k < 2; ++k) dst[m][k] = *(const PG8_LAS bf16x8*)(lds + PG8_SA(b, h) + aoff + m * 2048 + k * 1024); } } while (0)
#define PG8_LDB(dst, b, h) do { if constexpr (FP8) { _Pragma("unroll") for (int n = 0; n < 2; ++n) { const i32x4 _lo = *(const PG8_LAS i32x4*)(lds + PG8_SB(b, h) + boff + n * 2048), _hi = *(const PG8_LAS i32x4*)(lds + PG8_SB(b, h) + boff + n * 2048 + 1024); \
            dst##8[n] = __builtin_shufflevector(_lo, _hi, 0, 1, 2, 3, 4, 5, 6, 7); } } \
        else { _Pragma("unroll") for (int n = 0; n < 2; ++n) _Pragma("unroll") for (int k = 0; k < 2; ++k) dst[n][k] = *(const PG8_LAS bf16x8*)(lds + PG8_SB(b, h) + boff + n * 2048 + k * 1024); } } while (0)
#define PG8_MMA(ai, bj, At, Bt) do { __builtin_amdgcn_s_setprio(1); \
        if constexpr (FP8) { _Pragma("unroll") for (int m = 0; m < 4; ++m) _Pragma("unroll") for (int n = 0; n < 2; ++n) \
            acc[ai][bj][m][n] = __builtin_amdgcn_mfma_scale_f32_16x16x128_f8f6f4(Bt##8[n], At##8[m], acc[ai][bj][m][n], 0, 0, 0, Epi::SCALE_W, 0, Epi::SCALE_A); } \
        else { _Pragma("unroll") for (int m = 0; m < 4; ++m) _Pragma("unroll") for (int n = 0; n < 2; ++n) _Pragma("unroll") for (int k = 0; k < 2; ++k) \
            acc[ai][bj][m][n] = __builtin_amdgcn_mfma_f32_16x16x32_bf16(Bt[n][k], At[m][k], acc[ai][bj][m][n], 0, 0, 0); } \
        __builtin_amdgcn_s_setprio(0); } while (0)
#define PG8_WAIT_V(n) asm volatile("s_waitcnt vmcnt(" #n ")" ::: "memory")
#define PG8_WAIT_L(n) asm volatile("s_waitcnt lgkmcnt(" #n ")" ::: "memory")
#define PG8_BAR __builtin_amdgcn_s_barrier()
#define PG8_SCHED __builtin_amdgcn_sched_barrier(0)
    Unit cur, nxt; int ui = 0;
    if (!S.next(0, cur)) return;
    f32x4 acc[2][2][4][2];
#pragma unroll
    for (int a = 0; a < 2; ++a)
#pragma unroll
        for (int b = 0; b < 2; ++b)
#pragma unroll
            for (int m = 0; m < 4; ++m)
#pragma unroll
                for (int n = 0; n < 2; ++n) acc[a][b][m][n] = (f32x4){0.f, 0.f, 0.f, 0.f};
    bf16x8 At[4][2], B0[2][2], B1[2][2]; i32x8 At8[4], B08[2], B18[2]; (void)At; (void)B0; (void)B1; (void)At8; (void)B08; (void)B18;
    const char* cA = cur.A; const char* cB = cur.B;
    S.a_ready(cur);
    if constexpr (SP2) {
        PG8_STAGE(PG8_SB(0, 0), cB, voffB); PG8_STAGE(PG8_SB(0, 1), cB + hstep, voffB); PG8_STAGE(PG8_SA(0, 0), cA, voffA); PG8_STAGE(PG8_SA(0, 1), cA + hstep, voffA);
        if (wr == 1) PG8_BAR;
        PG8_WAIT_V(2); PG8_BAR;
        PG8_STAGE(PG8_SB(1, 0), cB + kstep, voffB); PG8_STAGE(PG8_SA(1, 0), cA + kstep, voffA); PG8_STAGE(PG8_SB(1, 1), cB + hstep + kstep, voffB);
        PG8_WAIT_V(6); PG8_BAR;
    } else {
        PG8_STAGE(PG8_SB(0, 0), cB, voffB); PG8_STAGE(PG8_SA(0, 0), cA, voffA); PG8_STAGE(PG8_SB(0, 1), cB + hstep, voffB); PG8_STAGE(PG8_SA(0, 1), cA + hstep, voffA);
        if (wr == 1) PG8_BAR;
        PG8_WAIT_V(4); PG8_BAR;
        PG8_STAGE(PG8_SB(1, 0), cB + kstep, voffB); PG8_STAGE(PG8_SA(1, 0), cA + kstep, voffA); PG8_STAGE(PG8_SB(1, 1), cB + hstep + kstep, voffB);
        PG8_WAIT_V(6); PG8_BAR;
    }
    for (;;) {
        const bool has_next = S.next(ui + 1, nxt);
        const char* nA = has_next ? nxt.A : cA; const char* nB = has_next ? nxt.B : cB;
_Pragma("unroll 1")
        for (int t = 0; t < nt; t += 2) {
            const bool last = (t == nt - 2);
            const char* a1 = cA + (size_t)(t + 1) * kstep;
            const char* a2 = last ? nA : cA + (size_t)(t + 2) * kstep; const char* b2 = last ? nB : cB + (size_t)(t + 2) * kstep;
            const char* a3 = a2 + kstep; const char* b3 = b2 + kstep;
            if (last && has_next) S.a_ready(nxt);
            if constexpr (Epi::PF) { if (t == 2) E.prefetch(cur, (unsigned)(size_t)lds + (unsigned)LDS_PF, wid); }
            if constexpr (SP2) {
            PG8_LDB(B0, 0, 0); PG8_LDB(B1, 0, 1); PG8_SCHED; PG8_LDA(At, 0, 0); PG8_STAGE(PG8_SA(1, 1), a1 + hstep, voffA);
            PG8_WAIT_V(8); PG8_WAIT_L(0); PG8_BAR; PG8_MMA(0, 0, At, B0); PG8_MMA(0, 1, At, B1); PG8_BAR; PG8_SCHED;
            PG8_LDA(At, 0, 1); PG8_STAGE(PG8_SB(0, 0), b2, voffB); PG8_STAGE(PG8_SB(0, 1), b2 + hstep, voffB); PG8_STAGE(PG8_SA(0, 0), a2, voffA);
            PG8_WAIT_V(8); PG8_WAIT_L(0); PG8_BAR; PG8_MMA(1, 0, At, B0); PG8_MMA(1, 1, At, B1); PG8_BAR; PG8_SCHED;
            PG8_LDB(B0, 1, 0); PG8_LDB(B1, 1, 1); PG8_SCHED; PG8_LDA(At, 1, 0); PG8_STAGE(PG8_SA(0, 1), a2 + hstep, voffA);
            PG8_WAIT_V(8); PG8_WAIT_L(0); PG8_BAR; PG8_MMA(0, 0, At, B0); PG8_MMA(0, 1, At, B1); PG8_BAR; PG8_SCHED;
            PG8_LDA(At, 1, 1); PG8_STAGE(PG8_SB(1, 0), b3, voffB); PG8_STAGE(PG8_SB(1, 1), b3 + hstep, voffB); PG8_STAGE(PG8_SA(1, 0), a3, voffA);
            PG8_WAIT_V(8); PG8_WAIT_L(0); PG8_BAR; PG8_MMA(1, 0, At, B0); PG8_MMA(1, 1, At, B1); PG8_BAR; PG8_SCHED;
            } else {
            PG8_LDB(B0, 0, 0); PG8_SCHED; PG8_LDA(At, 0, 0); PG8_STAGE(PG8_SA(1, 1), a1 + hstep, voffA);
            PG8_WAIT_L(8); PG8_BAR; PG8_WAIT_L(0); PG8_MMA(0, 0, At, B0); PG8_BAR; PG8_SCHED;
            PG8_LDB(B1, 0, 1); PG8_STAGE(PG8_SB(0, 0), b2, voffB);
            PG8_BAR; PG8_WAIT_L(0); PG8_MMA(0, 1, At, B1); PG8_BAR;
            PG8_LDA(At, 0, 1); PG8_STAGE(PG8_SA(0, 0), a2, voffA);
            PG8_BAR; PG8_WAIT_L(0); PG8_MMA(1, 0, At, B0); PG8_BAR; PG8_SCHED;
            PG8_STAGE(PG8_SB(0, 1), b2 + hstep, voffB);
            PG8_WAIT_V(6); PG8_BAR; PG8_MMA(1, 1, At, B1); PG8_BAR;
            PG8_LDB(B0, 1, 0); PG8_SCHED; PG8_LDA(At, 1, 0); PG8_STAGE(PG8_SA(0, 1), a2 + hstep, voffA);
            PG8_WAIT_L(8); PG8_BAR; PG8_WAIT_L(0); PG8_MMA(0, 0, At, B0); PG8_BAR; PG8_SCHED;
            PG8_LDB(B1, 1, 1); PG8_STAGE(PG8_SB(1, 0), b3, voffB);
            PG8_BAR; PG8_WAIT_L(0); PG8_MMA(0, 1, At, B1); PG8_BAR;
            PG8_LDA(At, 1, 1); PG8_STAGE(PG8_SA(1, 0), a3, voffA);
            PG8_BAR; PG8_WAIT_L(0); PG8_MMA(1, 0, At, B0); PG8_BAR; PG8_SCHED;
            PG8_STAGE(PG8_SB(1, 1), b3 + hstep, voffB);
            PG8_WAIT_V(6); PG8_BAR; PG8_MMA(1, 1, At, B1); PG8_BAR;
            }
        }
        if constexpr (ALIGN_EPI) { if (wr == 0) PG8_BAR; }
        if constexpr (!Epi::AFTER_DRAIN) { E(acc, cur, wr, wc, fr, fq); S.done(cur); }
        if (!has_next) break;
#pragma unroll
        for (int a = 0; a < 2; ++a)
#pragma unroll
            for (int b = 0; b < 2; ++b)
#pragma unroll
                for (int m = 0; m < 4; ++m)
#pragma unroll
                    for (int n = 0; n < 2; ++n) acc[a][b][m][n] = (f32x4){0.f, 0.f, 0.f, 0.f};
        cur = nxt; cA = nA; cB = nB; ++ui;
        if constexpr (ALIGN_EPI) { if (wr == 1) PG8_BAR; }
    }
    PG8_WAIT_V(0);
    if constexpr (!ALIGN_EPI) { if (wr == 0) PG8_BAR; }
    PG8_BAR;
    if constexpr (Epi::AFTER_DRAIN) { E.fused(acc, cur, wr, wc, fr, fq, lds, wid, lane); S.done(cur); }
#undef PG8_SA
#undef PG8_SB
#undef PG8_STAGE
#undef PG8_LDA
#undef PG8_LDB
#undef PG8_MMA
#undef PG8_WAIT_V
#undef PG8_WAIT_L
#undef PG8_BAR
#undef PG8_SCHED
}

template <int NP, bool UP, int ROWB> struct MoeOrder {
    const volatile LAS int* tab; int layer; const char* A; const char* W;
    __device__ bool next(int i, Unit& u) const {
        const int e = tab[i]; if (e < 0) return false;
        const int mt = e & 0xffff, pn = (e >> 16) & 0xff, cls = e >> 24;
        u.pm = mt; u.pn = pn; u.A = A + (size_t)mt * ((size_t)BM * ROWB);
        if (UP) { const int g = cls / 6, pi = cls % 6, s = pn >> 2, ex = g * 4 + (s ? pair_hi(pi) : pair_lo(pi));
            u.B = W + ((size_t)(layer * NE + ex) * 1024 + (size_t)(pn & 3) * 256) * ROWB; }
        else u.B = W + ((size_t)(layer * NCLS + cls) * 1024 + (size_t)pn * 256) * ROWB;
        return true;
    }
    __device__ __forceinline__ void a_ready(const Unit&) const {}
    __device__ __forceinline__ void done(const Unit&) const {}
};

struct EpiZ {
    static constexpr bool PERM = true, AFTER_DRAIN = false, PF = true;
    bf16_t* Z; const float* ssq; const PG8_LAS unsigned char* pf;
    __device__ __forceinline__ void prefetch(const Unit& u, unsigned lds_addr, int wid) const {
        const char* g = (const char*)(ssq + (size_t)u.pm * BM * 16) + wid * 1024; const unsigned vo = (unsigned)fresh_lane() * 16u;
#pragma unroll
        for (int i = 0; i < 2; ++i) { unsigned keep;
            asm volatile("s_mov_b32 %0, m0\n\ts_mov_b32 m0, %3\n\ts_nop 0\n\tglobal_load_lds_dwordx4 %1, %2\n\ts_mov_b32 m0, %0" : "=&s"(keep) : "v"(vo), "s"(g + i * 8192), "s"(lds_addr + (unsigned)(wid * 1024 + i * 8192)) : "memory"); } }
    __device__ __forceinline__ void operator()(const f32x4 (&acc)[2][2][4][2], const Unit& u, int wr, int wc, int fr, int fq) const {
        { const int ln_ = fresh_lane(); fr = ln_ & 15; fq = ln_ >> 4; }
        const int row0 = u.pm * BM + wr * 64 + fr, col0 = u.pn * BM + wc * 32 + 8 * fq;
        float rr[2][4];
#pragma unroll
        for (int ai = 0; ai < 2; ++ai) {
            f32x4 sp[4];
#pragma unroll
            for (int m = 0; m < 4; ++m) sp[m] = *(const PG8_LAS f32x4*)(pf + (ai * HALF + wr * 64 + m * 16 + fr) * 64 + 16 * fq);
#pragma unroll
            for (int m = 0; m < 4; ++m) { float t = (sp[m][0] + sp[m][1]) + (sp[m][2] + sp[m][3]); t = add_x16_x32(t); rr[ai][m] = __builtin_amdgcn_rsqf(t * (1.0f / D) + EPS); }
        }
#pragma unroll
        for (int ai = 0; ai < 2; ++ai)
#pragma unroll
            for (int m = 0; m < 4; ++m) { const int row = row0 + ai * HALF + m * 16; const float r = rr[ai][m];
                bf16_t* rowp = Z + (size_t)row * INC + col0;
#pragma unroll
                for (int bj = 0; bj < 2; ++bj) { f32x4 v0 = acc[ai][bj][m][0] * r, v1 = acc[ai][bj][m][1] * r;
                    u32x4 w; w.x = cvt_pk_bf16(v0[0], v0[1]); w.y = cvt_pk_bf16(v0[2], v0[3]); w.z = cvt_pk_bf16(v1[0], v1[1]); w.w = cvt_pk_bf16(v1[2], v1[3]);
                    *(u32x4*)(rowp + bj * HALF) = w; } }
    }
};
template <bool SCATTER> struct EpiRes {
    static constexpr bool PERM = true, AFTER_DRAIN = false, PF = SCATTER; static constexpr int SCALE_W = 0x7b7b7b7b, SCALE_A = 0x7b7b7b7b;
    bf16_t* H; float* ssq; const int* rowtok; const PG8_LAS unsigned char* pf;
    __device__ __forceinline__ void prefetch(const Unit& u, unsigned lds_addr, int wid) const {
        if (wid < 4) { const char* g = (const char*)(rowtok + (size_t)u.pm * BM) + wid * 256; const unsigned vo = (unsigned)fresh_lane() * 4u; unsigned keep;
            asm volatile("s_mov_b32 %0, m0\n\ts_mov_b32 m0, %3\n\ts_nop 0\n\tglobal_load_lds_dword %1, %2\n\ts_mov_b32 m0, %0" : "=&s"(keep) : "v"(vo), "s"(g), "s"(lds_addr + (unsigned)(wid * 256)) : "memory"); } }
    __device__ __forceinline__ void operator()(const f32x4 (&acc)[2][2][4][2], const Unit& u, int wr, int wc, int fr, int fq) const {
        { const int ln_ = fresh_lane(); fr = ln_ & 15; fq = ln_ >> 4; }
        const int row0 = u.pm * BM + wr * 64 + fr, col0 = u.pn * BM + wc * 32 + 8 * fq;
        int tokv[2][4];
#pragma unroll
        for (int ai = 0; ai < 2; ++ai)
#pragma unroll
            for (int m = 0; m < 4; ++m) { const int row = row0 + ai * HALF + m * 16; tokv[ai][m] = SCATTER ? *(const PG8_LAS int*)(pf + (ai * HALF + wr * 64 + m * 16 + fr) * 4) : row; }
#pragma unroll
        for (int ai = 0; ai < 2; ++ai) {
            u32x4 o[4][2];
#pragma unroll
            for (int m = 0; m < 4; ++m) { const int tok = tokv[ai][m]; const bf16_t* rowp = H + (size_t)(tok < 0 ? 0 : tok) * D + col0; o[m][0] = *(const u32x4*)(rowp); o[m][1] = *(const u32x4*)(rowp + HALF); }
#pragma unroll
            for (int m = 0; m < 4; ++m) { const int tok = tokv[ai][m]; float s = 0.f; bf16_t* rowp = H + (size_t)(tok < 0 ? 0 : tok) * D + col0;
#pragma unroll
                for (int bj = 0; bj < 2; ++bj) { const u32x4 oo = o[m][bj];
                    f32x4 v0 = acc[ai][bj][m][0], v1 = acc[ai][bj][m][1];
                    v0[0] += __uint_as_float(oo.x << 16); v0[1] += __uint_as_float(oo.x & 0xffff0000u); v0[2] += __uint_as_float(oo.y << 16); v0[3] += __uint_as_float(oo.y & 0xffff0000u);
                    v1[0] += __uint_as_float(oo.z << 16); v1[1] += __uint_as_float(oo.z & 0xffff0000u); v1[2] += __uint_as_float(oo.w << 16); v1[3] += __uint_as_float(oo.w & 0xffff0000u);
                    s += (v0[0] * v0[0] + v0[1] * v0[1]) + (v0[2] * v0[2] + v0[3] * v0[3]) + (v1[0] * v1[0] + v1[1] * v1[1]) + (v1[2] * v1[2] + v1[3] * v1[3]);
                    u32x4 w; w.x = cvt_pk_bf16(v0[0], v0[1]); w.y = cvt_pk_bf16(v0[2], v0[3]); w.z = cvt_pk_bf16(v1[0], v1[1]); w.w = cvt_pk_bf16(v1[2], v1[3]);
                    if (tok >= 0) *(u32x4*)(rowp + bj * HALF) = w; }
                s = add_x16_x32(s);
                if (fq == 0 && tok >= 0) ssq[(size_t)tok * 16 + u.pn * 4 + wc] = s; }
            asm volatile("" ::: "memory"); }
    }
};
constexpr int SC_W = 0x7b7b7b7b, SC_H = 0x7b7b7b7b, SC_ACT = 0x7b7b7b7b;
constexpr float FS_W = 16.f, FS_H = 16.f, FS_ACT = 16.f;
struct EpiUp {
    static constexpr bool PERM = true, AFTER_DRAIN = false, PF = true; static constexpr int SCALE_W = SC_W, SCALE_A = SC_H;
    unsigned char* ACT; const float* rowg; const PG8_LAS unsigned char* pf;
    __device__ __forceinline__ void prefetch(const Unit& u, unsigned lds_addr, int wid) const {
        const char* g = (const char*)(rowg + (size_t)u.pm * BM * 2) + wid * 256; const unsigned vo = (unsigned)fresh_lane() * 4u; unsigned keep;
        asm volatile("s_mov_b32 %0, m0\n\ts_mov_b32 m0, %3\n\ts_nop 0\n\tglobal_load_lds_dword %1, %2\n\ts_mov_b32 m0, %0" : "=&s"(keep) : "v"(vo), "s"(g), "s"(lds_addr + (unsigned)(wid * 256)) : "memory"); }
    __device__ __forceinline__ void operator()(const f32x4 (&acc)[2][2][4][2], const Unit& u, int wr, int wc, int fr, int fq) const {
        { const int ln_ = fresh_lane(); fr = ln_ & 15; fq = ln_ >> 4; }
        const int row0 = u.pm * BM + wr * 64 + fr, s = u.pn >> 2, col0 = s * 512 + (u.pn & 3) * 128 + wc * 32 + 8 * fq;
        float gt[2][4];
#pragma unroll
        for (int ai = 0; ai < 2; ++ai)
#pragma unroll
            for (int m = 0; m < 4; ++m) gt[ai][m] = *(const PG8_LAS float*)(pf + ((ai * HALF + wr * 64 + m * 16 + fr) * 2 + s) * 4);
#pragma unroll
        for (int ai = 0; ai < 2; ++ai)
#pragma unroll
            for (int m = 0; m < 4; ++m) { const int row = row0 + ai * HALF + m * 16; const float g1 = gt[ai][m];
                float o[8];
#pragma unroll
                for (int n = 0; n < 2; ++n)
#pragma unroll
                    for (int j = 0; j < 4; ++j) { const float g = acc[ai][0][m][n][j], up = acc[ai][1][m][n][j]; o[n * 4 + j] = g * sigmoid_fast(g) * up * g1; }
                u32x2 w; w.x = pk_fp8x4(o[0] * FS_ACT, o[1] * FS_ACT, o[2] * FS_ACT, o[3] * FS_ACT); w.y = pk_fp8x4(o[4] * FS_ACT, o[5] * FS_ACT, o[6] * FS_ACT, o[7] * FS_ACT);
                *(u32x2*)(ACT + (size_t)row * 1024 + col0) = w; }
    }
};
}

__device__ __forceinline__ void tr_item(const float* W, int ldw, int k0, int scol0, const float* gk, bf16_t* WT, int ldo, int drow0, int dk0, LAS float* scr, int lane) {
#pragma unroll 8
    for (int i = 0; i < 32; ++i) { const int kk = 2 * i + (lane >> 5); float v = W[(size_t)(k0 + kk) * ldw + scol0 + (lane & 31)]; if (gk) v *= gk[k0 + kk]; scr[kk * 33 + (lane & 31)] = v; }
    asm volatile("s_waitcnt lgkmcnt(0)" ::: "memory");
    const int c = lane & 7;
#pragma unroll
    for (int j = 0; j < 4; ++j) { const int n = (lane >> 3) + 8 * j; const LAS float* s = scr + (8 * c) * 33 + n;
        u32x4 o; o.x = cvt_pk_bf16(s[0 * 33], s[1 * 33]); o.y = cvt_pk_bf16(s[2 * 33], s[3 * 33]); o.z = cvt_pk_bf16(s[4 * 33], s[5 * 33]); o.w = cvt_pk_bf16(s[6 * 33], s[7 * 33]);
        *(u32x4*)(WT + (size_t)(drow0 + n) * ldo + dk0 + 8 * c) = o; }
    asm volatile("s_waitcnt lgkmcnt(0)" ::: "memory");
}

constexpr size_t S5_L_STRIDE = 1310720, S5_KT = 0, S5_ET = 131072, S5_FT = 655360, S5_LAMP = 1179648;
constexpr int S5_WSCR = 8192, S5_YST = 65536, YST_LD = 264;
constexpr int NU128 = T / 128, UPB128 = SEQ / 128;
__device__ __forceinline__ f32x4 mfma16(bf16x8 a, bf16x8 b, f32x4 c) { return __builtin_amdgcn_mfma_f32_16x16x32_bf16(a, b, c, 0, 0, 0); }

__device__ __forceinline__ void s5_kt_pair(int g, int c, int cp, const float* a_re, const float* a_im, const float* log_dt, const float* b_re, const float* b_im,
                                           const float* c_re, const float* c_im, const float* dvec, unsigned char* tab) {
    const float dt = __expf(log_dt[g]); float km[8];
#pragma unroll
    for (int d = 0; d < 8; ++d) km[d] = 0.f;
#pragma unroll 2
    for (int p = 0; p < CS; ++p) { const float lr = a_re[g * CS + p], li = a_im[g * CS + p], zr = lr * dt, zi = li * dt;
        const float sh = __sinf(0.5f * zi), cz = __cosf(zi), sz = __sinf(zi), ez = __expf(zr); const float nr = expm1f(zr) * cz - 2.0f * sh * sh, ni = ez * sz, den = lr * lr + li * li;
        const float cr = (nr * lr + ni * li) / den, ci = (ni * lr - nr * li) / den;
        const float br = b_re[((size_t)g * CS + p) * CGD + cp], bi = b_im[((size_t)g * CS + p) * CGD + cp]; const float bbr = cr * br - ci * bi, bbi = cr * bi + ci * br;
        const float cre = c_re[((size_t)g * CGD + c) * CS + p], cim = c_im[((size_t)g * CGD + c) * CS + p];
        float vr = cre * bbr - cim * bbi, vi = cre * bbi + cim * bbr;
        const float lbr = ez * cz, lbi = ez * sz;
#pragma unroll
        for (int d = 0; d < 8; ++d) { km[d] += vr; const float t = vr * lbr - vi * lbi; vi = vr * lbi + vi * lbr; vr = t; } }
    if (c == cp) km[0] += dvec[g * CGD + c];
    bf16_t* kt = (bf16_t*)(tab + S5_KT) + (size_t)g * 4096;
#pragma unroll
    for (int dd = 0; dd < 8; ++dd) { kt[(dd * 16 + c) * 32 + cp] = f2bf(km[dd]); kt[(dd * 16 + c) * 32 + 16 + cp] = dd >= 1 ? f2bf(km[dd - 1]) : (bf16_t)0; }
}
__device__ __forceinline__ void s5_et_task(int g, int ri, int p, int cp, const float* a_re, const float* a_im, const float* log_dt, const float* b_re, const float* b_im, unsigned char* tab) {
    const float dt = __expf(log_dt[g]); const float lr = a_re[g * CS + p], li = a_im[g * CS + p], zr = lr * dt, zi = li * dt;
    const float sh = __sinf(0.5f * zi), cz = __cosf(zi), sz = __sinf(zi), ez = __expf(zr); const float nr = expm1f(zr) * cz - 2.0f * sh * sh, ni = ez * sz, den = lr * lr + li * li;
    const float cr = (nr * lr + ni * li) / den, ci = (ni * lr - nr * li) / den;
    const float br = b_re[((size_t)g * CS + p) * CGD + cp], bi = b_im[((size_t)g * CS + p) * CGD + cp]; float vr = cr * br - ci * bi, vi = cr * bi + ci * br;
    const float lbr = ez * cz, lbi = ez * sz; bf16_t* et = (bf16_t*)(tab + S5_ET) + (size_t)g * 16384 + (size_t)(ri * 64 + p) * 128 + cp;
#pragma unroll
    for (int sp = 7; sp >= 0; --sp) { et[sp * 16] = f2bf(ri ? vi : vr); const float t = vr * lbr - vi * lbi; vi = vr * lbi + vi * lbr; vr = t; }
}
__device__ __forceinline__ void s5_ft_task(int g, int c, int ri, int p, const float* a_re, const float* a_im, const float* log_dt, const float* c_re, const float* c_im, unsigned char* tab) {
    const float dt = __expf(log_dt[g]); const float lr = a_re[g * CS + p], li = a_im[g * CS + p], zr = lr * dt, zi = li * dt; const float ez = __expf(zr), lbr = ez * __cosf(zi), lbi = ez * __sinf(zi);
    const float cre = c_re[((size_t)g * CGD + c) * CS + p], cim = c_im[((size_t)g * CGD + c) * CS + p]; float vr = cre * lbr - cim * lbi, vi = cre * lbi + cim * lbr;
    bf16_t* ft = (bf16_t*)(tab + S5_FT) + (size_t)g * 16384 + (size_t)c * 128 + ri * 64 + p;
#pragma unroll
    for (int tp = 0; tp < 8; ++tp) { ft[(size_t)tp * 16 * 128] = f2bf(ri ? -vi : vr); const float t = vr * lbr - vi * lbi; vi = vr * lbi + vi * lbr; vr = t; }
}
__device__ __forceinline__ void s5_table_elem(int g, int e, const float* a_re, const float* a_im, const float* log_dt, const float* b_re, const float* b_im,
                                              const float* c_re, const float* c_im, const float* dvec, unsigned char* tab) {
    const float dt = __expf(log_dt[g]);
    if (e < 4096) {
        const int dd = e >> 9, c = (e >> 5) & 15, ee = (e >> 4) & 1, cp = e & 15, d = dd - ee; float s = 0.f;
        if (d >= 0) {
            for (int p = 0; p < CS; ++p) { const float lr = a_re[g * CS + p], li = a_im[g * CS + p], zr = lr * dt, zi = li * dt;
                const float sh = __sinf(0.5f * zi); const float nr = expm1f(zr) * __cosf(zi) - 2.0f * sh * sh, ni = __expf(zr) * __sinf(zi), den = lr * lr + li * li;
                const float cr = (nr * lr + ni * li) / den, ci = (ni * lr - nr * li) / den;
                const float br = b_re[((size_t)g * CS + p) * CGD + cp], bi = b_im[((size_t)g * CS + p) * CGD + cp]; const float bbr = cr * br - ci * bi, bbi = cr * bi + ci * br;
                const float mag = __expf(zr * (float)d), pr = mag * __cosf(zi * (float)d), pi = mag * __sinf(zi * (float)d);
                const float vr = pr * bbr - pi * bbi, vi = pr * bbi + pi * bbr;
                s += c_re[((size_t)g * CGD + c) * CS + p] * vr - c_im[((size_t)g * CGD + c) * CS + p] * vi; }
            if (d == 0 && c == cp) s += dvec[g * CGD + c];
        }
        ((bf16_t*)(tab + S5_KT))[(size_t)g * 4096 + e] = f2bf(s); return;
    }
    e -= 4096;
    if (e < 16384) {
        const int n = e >> 7, k = e & 127, ri = n >> 6, p = n & 63, sp = k >> 4, cp = k & 15;
        const float lr = a_re[g * CS + p], li = a_im[g * CS + p], zr = lr * dt, zi = li * dt;
        const float sh = __sinf(0.5f * zi); const float nr = expm1f(zr) * __cosf(zi) - 2.0f * sh * sh, ni = __expf(zr) * __sinf(zi), den = lr * lr + li * li;
        const float cr = (nr * lr + ni * li) / den, ci = (ni * lr - nr * li) / den;
        const float br = b_re[((size_t)g * CS + p) * CGD + cp], bi = b_im[((size_t)g * CS + p) * CGD + cp]; const float bbr = cr * br - ci * bi, bbi = cr * bi + ci * br;
        const float d = (float)(7 - sp); const float mag = __expf(zr * d), pr = mag * __cosf(zi * d), pi = mag * __sinf(zi * d);
        ((bf16_t*)(tab + S5_ET))[(size_t)g * 16384 + e] = f2bf(ri ? (pr * bbi + pi * bbr) : (pr * bbr - pi * bbi)); return;
    }
    e -= 16384;
    if (e < 16384) {
        const int n = e >> 7, k = e & 127, tp = n >> 4, c = n & 15, ri = k >> 6, p = k & 63;
        const float lr = a_re[g * CS + p], li = a_im[g * CS + p], zr = lr * dt, zi = li * dt;
        const float d = (float)(tp + 1); const float mag = __expf(zr * d), pr = mag * __cosf(zi * d), pi = mag * __sinf(zi * d);
        const float cre = c_re[((size_t)g * CGD + c) * CS + p], cim = c_im[((size_t)g * CGD + c) * CS + p];
        ((bf16_t*)(tab + S5_FT))[(size_t)g * 16384 + e] = f2bf(ri ? -(cre * pi + cim * pr) : (cre * pr - cim * pi)); return;
    }
    e -= 16384;
    { const int p = e; const float lr = a_re[g * CS + p], li = a_im[g * CS + p], zr = lr * dt, zi = li * dt; float* o = (float*)(tab + S5_LAMP) + ((size_t)g * CS + p) * 8;
      float mag = expf(zr); o[0] = mag * cosf(zi); o[1] = mag * sinf(zi);
      mag = expf(zr * 8.f); o[2] = mag * cosf(zi * 8.f); o[3] = mag * sinf(zi * 8.f);
      mag = expf(zr * 128.f); o[4] = mag * cosf(zi * 128.f); o[5] = mag * sinf(zi * 128.f); o[6] = 0.f; o[7] = 0.f; }
}

template <class TT> __device__ __forceinline__ TT ldg(const void* ubase, unsigned voff) { return *(const TT*)((const char*)ubase + voff); }
template <int PASS>
__device__ __forceinline__ void s5_group(int unit, int g, bool first, float& kr, float& ki, int wave, int lane, const bf16_t* Z, bf16_t* Y, const unsigned char* tab, float* SEND, float* SEND2, float* SE, LAS unsigned char* lds) {
    const int ln = lane & 15, q = lane >> 4; const int t0 = unit * 128;
    const char* KTg = (const char*)(tab + S5_KT) + (size_t)g * 8192; const char* ETg = (const char*)(tab + S5_ET) + (size_t)g * 32768; const char* FTg = (const char*)(tab + S5_FT) + (size_t)g * 32768;
    const float* LAMPg = (const float*)(tab + S5_LAMP) + (size_t)g * CS * 8;
    const unsigned vo128 = (unsigned)(ln * 128 + 8 * q) * 2u;
    const unsigned vo32 = (unsigned)(ln * 32 + 8 * q) * 2u;
    LAS float* Sb = (LAS float*)(lds + wave * S5_WSCR); LAS bf16_t* Tb = (LAS bf16_t*)(lds + wave * S5_WSCR); LAS bf16_t* yst = (LAS bf16_t*)(lds + S5_YST);
    char* seb = (char*)(SE + ((size_t)unit * CG + g) * 16 * 128); const unsigned vl = (unsigned)lane * 4u;
    char* ylb = (char*)(Y + (size_t)t0 * D + AW + BW + g * 16); const unsigned vy = (unsigned)((ln * 8) * D + 4 * q) * 2u;
    const float lur = LAMPg[lane * 8 + 4], lui = LAMPg[lane * 8 + 5], l8r = LAMPg[lane * 8 + 2], l8i = LAMPg[lane * 8 + 3];
    float cr = 0.f, ci = 0.f;
    if (PASS == 1) {
        if (!first) { cr = kr; ci = ki; }
        bf16x8 X0, X1, X2, X3;
        { const char* zb = (const char*)(Z + (size_t)t0 * INC + ZC + g * 16); const unsigned vz = (unsigned)((ln * 8 + (q >> 1)) * INC + 8 * (q & 1)) * 2u;
          X0 = ldg<bf16x8>(zb, vz); X1 = ldg<bf16x8>(zb + 2 * INC * 2, vz); X2 = ldg<bf16x8>(zb + 4 * INC * 2, vz); X3 = ldg<bf16x8>(zb + 6 * INC * 2, vz); }
        { LAS float* sw = Sb + (4 * q) * 128 + ln; const char* eb = ETg;
#pragma unroll 1
          for (int jh = 0; jh < 2; ++jh) { bf16x8 ef[4][4];
#pragma unroll
            for (int j = 0; j < 4; ++j)
#pragma unroll
              for (int ks = 0; ks < 4; ++ks) ef[j][ks] = ldg<bf16x8>(eb + j * 4096 + ks * 64, vo128);
#pragma unroll
            for (int j = 0; j < 4; ++j) { f32x4 se = (f32x4){0.f, 0.f, 0.f, 0.f};
              se = mfma16(X0, ef[j][0], se); se = mfma16(X1, ef[j][1], se); se = mfma16(X2, ef[j][2], se); se = mfma16(X3, ef[j][3], se);
              LAS float* s2 = sw + 16 * j; s2[0] = se[0]; s2[128] = se[1]; s2[256] = se[2]; s2[384] = se[3]; }
            eb += 16384; sw += 64; } }
        asm volatile("" ::: "memory");
        { const char* kb = KTg; char* yq = ylb;
#pragma unroll 1
          for (int th = 0; th < 4; ++th) {
              const bf16x8 ka = ldg<bf16x8>(kb, vo32), kc = ldg<bf16x8>(kb + 1024, vo32);
              f32x4 acc0 = (f32x4){0.f, 0.f, 0.f, 0.f}, acc1 = (f32x4){0.f, 0.f, 0.f, 0.f};
              acc0 = mfma16(ka, X0, acc0); acc1 = mfma16(kc, X0, acc1);
              if (th >= 1) { acc0 = mfma16(ldg<bf16x8>(kb - 2048, vo32), X1, acc0); acc1 = mfma16(ldg<bf16x8>(kb - 1024, vo32), X1, acc1); }
              if (th >= 2) { acc0 = mfma16(ldg<bf16x8>(kb - 4096, vo32), X2, acc0); acc1 = mfma16(ldg<bf16x8>(kb - 3072, vo32), X2, acc1); }
              if (th >= 3) { acc0 = mfma16(ldg<bf16x8>(kb - 6144, vo32), X3, acc0); acc1 = mfma16(ldg<bf16x8>(kb - 5120, vo32), X3, acc1); }
              u32x2 w; w.x = cvt_pk_bf16(acc0[0], acc0[1]); w.y = cvt_pk_bf16(acc0[2], acc0[3]); *(u32x2*)(yq + vy) = w;
              w.x = cvt_pk_bf16(acc1[0], acc1[1]); w.y = cvt_pk_bf16(acc1[2], acc1[3]); *(u32x2*)(yq + (size_t)D * 2 + vy) = w;
              kb += 2048; yq += (size_t)2 * D * 2; } }
        asm volatile("" ::: "memory");
        float sr = cr, si = ci;
#pragma unroll
        for (int s = 0; s < 16; ++s) { const float er = Sb[s * 128 + lane], ei = Sb[s * 128 + 64 + lane];
            *(float*)(seb + s * 512 + vl) = er; *(float*)(seb + s * 512 + 256 + vl) = ei;
            const float nr = l8r * sr - l8i * si + er, ni = l8r * si + l8i * sr + ei; sr = nr; si = ni; }
        kr = sr; ki = si;
        float* dst = first ? SEND + (((size_t)unit * CG + g) * 2) * CS + lane : SEND2 + (((size_t)(unit >> 1) * CG + g) * 2) * CS + lane;
        dst[0] = sr; dst[CS] = si; asm volatile("" ::: "memory"); return;
    }
    if (first) { const int pr = unit >> 1, p0 = pr - (pr % (UPB128 / 2)); const float l2r = lur * lur - lui * lui, l2i = 2.0f * lur * lui;
        const char* sb = (const char*)(SEND2 + (((size_t)p0 * CG + g) * 2) * CS);
#pragma unroll 8
        for (int j = p0; j < pr; ++j) { const float sr = ldg<float>(sb, vl), si = ldg<float>(sb + CS * 4, vl); sb += (size_t)CG * 2 * CS * 4;
            const float nr = l2r * cr - l2i * ci + sr, ni = l2r * ci + l2i * cr + si; cr = nr; ci = ni; } }
    else { const float sr = SEND[(((size_t)(unit - 1) * CG + g) * 2 + 0) * CS + lane], si = SEND[(((size_t)(unit - 1) * CG + g) * 2 + 1) * CS + lane];
        cr = lur * kr - lui * ki + sr; ci = lur * ki + lui * kr + si; }
    kr = cr; ki = ci;
    { float sre[16], sim[16];
#pragma unroll
      for (int s = 0; s < 16; ++s) { sre[s] = ldg<float>(seb + s * 512, vl); sim[s] = ldg<float>(seb + s * 512 + 256, vl); }
      float sr = cr, si = ci;
#pragma unroll
      for (int s = 0; s < 16; ++s) { Tb[s * 128 + lane] = f2bf(sr); Tb[s * 128 + 64 + lane] = f2bf(si);
          const float nr = l8r * sr - l8i * si + sre[s], ni = l8r * si + l8i * sr + sim[s]; sr = nr; si = ni; } }
    asm volatile("" ::: "memory");
    const bf16x8 T0 = *(const LAS bf16x8*)(Tb + ln * 128 + 8 * q), T1 = *(const LAS bf16x8*)(Tb + ln * 128 + 32 + 8 * q), T2 = *(const LAS bf16x8*)(Tb + ln * 128 + 64 + 8 * q), T3 = *(const LAS bf16x8*)(Tb + ln * 128 + 96 + 8 * q);
    { LAS bf16_t* yw = yst + (ln * 8) * YST_LD + g * 16 + 4 * q; const char* fb = FTg; const char* yq = ylb;
#pragma unroll 2
      for (int th = 0; th < 4; ++th) { bf16x8 ff[2][4]; u32x2 yl[2];
#pragma unroll
          for (int j = 0; j < 2; ++j) { yl[j] = ldg<u32x2>(yq + (size_t)j * D * 2, vy);
#pragma unroll
              for (int ks = 0; ks < 4; ++ks) ff[j][ks] = ldg<bf16x8>(fb + j * 4096 + ks * 64, vo128); }
#pragma unroll
          for (int j = 0; j < 2; ++j) {
              f32x4 acc; acc[0] = __uint_as_float(yl[j].x << 16); acc[1] = __uint_as_float(yl[j].x & 0xffff0000u); acc[2] = __uint_as_float(yl[j].y << 16); acc[3] = __uint_as_float(yl[j].y & 0xffff0000u);
              acc = mfma16(ff[j][0], T0, acc); acc = mfma16(ff[j][1], T1, acc); acc = mfma16(ff[j][2], T2, acc); acc = mfma16(ff[j][3], T3, acc);
              u32x2 w; w.x = cvt_pk_bf16(gelu_fast(acc[0]), gelu_fast(acc[1])); w.y = cvt_pk_bf16(gelu_fast(acc[2]), gelu_fast(acc[3]));
              *(LAS u32x2*)(yw + j * YST_LD) = w; }
          fb += 8192; yq += (size_t)2 * D * 2; yw += 2 * YST_LD; } }
    asm volatile("s_waitcnt lgkmcnt(0)" ::: "memory");
}
__device__ __forceinline__ void s5_pair1(int pr, int g, int wave, int lane, const bf16_t* Z, bf16_t* Y, const unsigned char* tab, float* SEND, float* SEND2, float* SE, LAS unsigned char* lds) {
    const int ln = lane & 15, q = lane >> 4; const int t0 = pr * 256;
    const char* KTg = (const char*)(tab + S5_KT) + (size_t)g * 8192; const char* ETg = (const char*)(tab + S5_ET) + (size_t)g * 32768;
    const float* LAMPg = (const float*)(tab + S5_LAMP) + (size_t)g * CS * 8;
    const unsigned vo128 = (unsigned)(ln * 128 + 8 * q) * 2u, vo32 = (unsigned)(ln * 32 + 8 * q) * 2u, vl = (unsigned)lane * 4u;
    LAS float* SbA = (LAS float*)(lds + wave * 16384); LAS float* SbB = SbA + 2048;
    bf16x8 XA0, XA1, XA2, XA3, XB0, XB1, XB2, XB3;
    { const char* zb = (const char*)(Z + (size_t)t0 * INC + ZC + g * 16); const unsigned vz = (unsigned)((ln * 8 + (q >> 1)) * INC + 8 * (q & 1)) * 2u;
      XA0 = ldg<bf16x8>(zb, vz); XA1 = ldg<bf16x8>(zb + 2 * INC * 2, vz); XA2 = ldg<bf16x8>(zb + 4 * INC * 2, vz); XA3 = ldg<bf16x8>(zb + 6 * INC * 2, vz);
      const char* zc = zb + (size_t)128 * INC * 2;
      XB0 = ldg<bf16x8>(zc, vz); XB1 = ldg<bf16x8>(zc + 2 * INC * 2, vz); XB2 = ldg<bf16x8>(zc + 4 * INC * 2, vz); XB3 = ldg<bf16x8>(zc + 6 * INC * 2, vz); }
    { LAS float* sw = SbA + (4 * q) * 128 + ln; const char* eb = ETg;
#pragma unroll
      for (int jh = 0; jh < 2; ++jh) { bf16x8 ef[4][4];
#pragma unroll
        for (int j = 0; j < 4; ++j)
#pragma unroll
          for (int ks = 0; ks < 4; ++ks) ef[j][ks] = ldg<bf16x8>(eb + j * 4096 + ks * 64, vo128);
#pragma unroll
        for (int j = 0; j < 4; ++j) { f32x4 sa = (f32x4){0.f, 0.f, 0.f, 0.f}, sb = (f32x4){0.f, 0.f, 0.f, 0.f};
          sa = mfma16(XA0, ef[j][0], sa); sb = mfma16(XB0, ef[j][0], sb); sa = mfma16(XA1, ef[j][1], sa); sb = mfma16(XB1, ef[j][1], sb);
          sa = mfma16(XA2, ef[j][2], sa); sb = mfma16(XB2, ef[j][2], sb); sa = mfma16(XA3, ef[j][3], sa); sb = mfma16(XB3, ef[j][3], sb);
          LAS float* s2 = sw + 16 * j; s2[0] = sa[0]; s2[128] = sa[1]; s2[256] = sa[2]; s2[384] = sa[3]; s2[2048] = sb[0]; s2[2048 + 128] = sb[1]; s2[2048 + 256] = sb[2]; s2[2048 + 384] = sb[3]; }
        eb += 16384; sw += 64; } }
    asm volatile("" ::: "memory");
    { const char* kb = KTg; char* yq = (char*)(Y + (size_t)t0 * D + AW + BW + g * 16); const unsigned vy = (unsigned)((ln * 8) * D + 4 * q) * 2u;
#pragma unroll 1
      for (int th = 0; th < 4; ++th) {
          const bf16x8 ka = ldg<bf16x8>(kb, vo32), kc = ldg<bf16x8>(kb + 1024, vo32);
          f32x4 a0 = (f32x4){0.f, 0.f, 0.f, 0.f}, a1 = a0, b0 = a0, b1 = a0;
          a0 = mfma16(ka, XA0, a0); a1 = mfma16(kc, XA0, a1); b0 = mfma16(ka, XB0, b0); b1 = mfma16(kc, XB0, b1);
          if (th >= 1) { const bf16x8 k0 = ldg<bf16x8>(kb - 2048, vo32), k1 = ldg<bf16x8>(kb - 1024, vo32); a0 = mfma16(k0, XA1, a0); a1 = mfma16(k1, XA1, a1); b0 = mfma16(k0, XB1, b0); b1 = mfma16(k1, XB1, b1); }
          if (th >= 2) { const bf16x8 k0 = ldg<bf16x8>(kb - 4096, vo32), k1 = ldg<bf16x8>(kb - 3072, vo32); a0 = mfma16(k0, XA2, a0); a1 = mfma16(k1, XA2, a1); b0 = mfma16(k0, XB2, b0); b1 = mfma16(k1, XB2, b1); }
          if (th >= 3) { const bf16x8 k0 = ldg<bf16x8>(kb - 6144, vo32), k1 = ldg<bf16x8>(kb - 5120, vo32); a0 = mfma16(k0, XA3, a0); a1 = mfma16(k1, XA3, a1); b0 = mfma16(k0, XB3, b0); b1 = mfma16(k1, XB3, b1); }
          u32x2 w; w.x = cvt_pk_bf16(a0[0], a0[1]); w.y = cvt_pk_bf16(a0[2], a0[3]); *(u32x2*)(yq + vy) = w;
          w.x = cvt_pk_bf16(a1[0], a1[1]); w.y = cvt_pk_bf16(a1[2], a1[3]); *(u32x2*)(yq + (size_t)D * 2 + vy) = w;
          w.x = cvt_pk_bf16(b0[0], b0[1]); w.y = cvt_pk_bf16(b0[2], b0[3]); *(u32x2*)(yq + (size_t)128 * D * 2 + vy) = w;
          w.x = cvt_pk_bf16(b1[0], b1[1]); w.y = cvt_pk_bf16(b1[2], b1[3]); *(u32x2*)(yq + (size_t)129 * D * 2 + vy) = w;
          kb += 2048; yq += (size_t)2 * D * 2; } }
    asm volatile("" ::: "memory");
    const float l8r = LAMPg[lane * 8 + 2], l8i = LAMPg[lane * 8 + 3];
    float sr = 0.f, si = 0.f;
    { char* seb = (char*)(SE + ((size_t)(2 * pr) * CG + g) * 16 * 128);
#pragma unroll
      for (int s = 0; s < 16; ++s) { const float er = SbA[s * 128 + lane], ei = SbA[s * 128 + 64 + lane];
          *(float*)(seb + s * 512 + vl) = er; *(float*)(seb + s * 512 + 256 + vl) = ei;
          const float nr = l8r * sr - l8i * si + er, ni = l8r * si + l8i * sr + ei; sr = nr; si = ni; }
      float* dst = SEND + (((size_t)(2 * pr) * CG + g) * 2) * CS + lane; dst[0] = sr; dst[CS] = si; }
    { char* seb = (char*)(SE + ((size_t)(2 * pr + 1) * CG + g) * 16 * 128);
#pragma unroll
      for (int s = 0; s < 16; ++s) { const float er = SbB[s * 128 + lane], ei = SbB[s * 128 + 64 + lane];
          *(float*)(seb + s * 512 + vl) = er; *(float*)(seb + s * 512 + 256 + vl) = ei;
          const float nr = l8r * sr - l8i * si + er, ni = l8r * si + l8i * sr + ei; sr = nr; si = ni; }
      float* dst = SEND2 + (((size_t)pr * CG + g) * 2) * CS + lane; dst[0] = sr; dst[CS] = si; }
    asm volatile("s_waitcnt lgkmcnt(0)" ::: "memory");
}
constexpr int S5_PSG = 133120;
__device__ __forceinline__ void s5_glu(int unit, int wave, int lane, const bf16_t* WGLU, const float* glu_b, const float* mo_gc, bf16_t* Y, LAS unsigned char* lds) {
    const int ln = lane & 15, q = lane >> 4; LAS bf16_t* yst = (LAS bf16_t*)(lds + S5_YST); LAS float* PSg = (LAS float*)(lds + S5_PSG);
    bf16x8 wf[2][8];
    { const char* wb = (const char*)(WGLU + (size_t)(32 * wave) * 256); const unsigned vw = (unsigned)(ln * 256 + 8 * q) * 2u;
#pragma unroll
      for (int j = 0; j < 2; ++j)
#pragma unroll
          for (int ks = 0; ks < 8; ++ks) wf[j][ks] = ldg<bf16x8>(wb + j * 8192 + ks * 64, vw); }
    const f32x4 gb0 = *(const f32x4*)(glu_b + 32 * wave + 4 * q), gb1 = *(const f32x4*)(glu_b + 32 * wave + 16 + 4 * q);
    LAS bf16_t* op = (LAS bf16_t*)(lds + wave * S5_WSCR) + ln * 32 + 4 * q;
    { const LAS bf16_t* yrow = yst + ln * YST_LD; LAS float* psw = PSg + ln * 8 + wave; LAS bf16_t* ow = op;
#pragma unroll 4
      for (int tt = 0; tt < 8; ++tt) {
        f32x4 a0 = (f32x4){0.f, 0.f, 0.f, 0.f}, a1 = (f32x4){0.f, 0.f, 0.f, 0.f};
#pragma unroll
        for (int ks = 0; ks < 8; ++ks) { const bf16x8 yf = *(const LAS bf16x8*)(yrow + 32 * ks + 8 * q); a0 = mfma16(wf[0][ks], yf, a0); a1 = mfma16(wf[1][ks], yf, a1); }
        const u32x2 y0 = *(const LAS u32x2*)(yrow + 32 * wave + 4 * q), y1 = *(const LAS u32x2*)(yrow + 32 * wave + 16 + 4 * q);
        float o[8];
        o[0] = __uint_as_float(y0.x << 16) * sigmoid_fast(a0[0] + gb0[0]); o[1] = __uint_as_float(y0.x & 0xffff0000u) * sigmoid_fast(a0[1] + gb0[1]); o[2] = __uint_as_float(y0.y << 16) * sigmoid_fast(a0[2] + gb0[2]); o[3] = __uint_as_float(y0.y & 0xffff0000u) * sigmoid_fast(a0[3] + gb0[3]);
        o[4] = __uint_as_float(y1.x << 16) * sigmoid_fast(a1[0] + gb1[0]); o[5] = __uint_as_float(y1.x & 0xffff0000u) * sigmoid_fast(a1[1] + gb1[1]); o[6] = __uint_as_float(y1.y << 16) * sigmoid_fast(a1[2] + gb1[2]); o[7] = __uint_as_float(y1.y & 0xffff0000u) * sigmoid_fast(a1[3] + gb1[3]);
        float ss = ((o[0] * o[0] + o[1] * o[1]) + (o[2] * o[2] + o[3] * o[3])) + ((o[4] * o[4] + o[5] * o[5]) + (o[6] * o[6] + o[7] * o[7]));
        ss = add_x16_x32(ss);
        if (q == 0) *psw = ss;
        u32x2 w; w.x = cvt_pk_bf16(o[0], o[1]); w.y = cvt_pk_bf16(o[2], o[3]); *(LAS u32x2*)(ow) = w; w.x = cvt_pk_bf16(o[4], o[5]); w.y = cvt_pk_bf16(o[6], o[7]); *(LAS u32x2*)(ow + 16) = w;
        yrow += 16 * YST_LD; psw += 16 * 8; ow += 16 * 32; } }
    asm volatile("s_waitcnt lgkmcnt(0)" ::: "memory");
    __syncthreads();
    const f32x4 g0 = *(const f32x4*)(mo_gc + 32 * wave + 4 * q), g1 = *(const f32x4*)(mo_gc + 32 * wave + 16 + 4 * q);
    { char* yb = (char*)(Y + (size_t)(unit * 128) * D + AW + BW + 32 * wave); const unsigned vy = (unsigned)(ln * D + 4 * q) * 2u; const LAS f32x4* pp = (const LAS f32x4*)(PSg + ln * 8); const LAS bf16_t* ow = op;
#pragma unroll 2
      for (int tt = 0; tt < 8; ++tt) { const f32x4 p0 = pp[0], p1 = pp[1];
        const float rs = __builtin_amdgcn_rsqf((((p0[0] + p0[1]) + (p0[2] + p0[3])) + ((p1[0] + p1[1]) + (p1[2] + p1[3]))) * (1.0f / CW) + EPS);
        const u32x2 a = *(const LAS u32x2*)(ow), b = *(const LAS u32x2*)(ow + 16); u32x2 w;
        w.x = cvt_pk_bf16(__uint_as_float(a.x << 16) * rs * g0[0], __uint_as_float(a.x & 0xffff0000u) * rs * g0[1]); w.y = cvt_pk_bf16(__uint_as_float(a.y << 16) * rs * g0[2], __uint_as_float(a.y & 0xffff0000u) * rs * g0[3]);
        *(u32x2*)(yb + vy) = w;
        w.x = cvt_pk_bf16(__uint_as_float(b.x << 16) * rs * g1[0], __uint_as_float(b.x & 0xffff0000u) * rs * g1[1]); w.y = cvt_pk_bf16(__uint_as_float(b.y << 16) * rs * g1[2], __uint_as_float(b.y & 0xffff0000u) * rs * g1[3]);
        *(u32x2*)(yb + 32 + vy) = w;
        yb += (size_t)16 * D * 2; pp += 16 * 2; ow += 16 * 32; } }
}

constexpr int XC_LD = 392;
constexpr int RG_XC = 0, RG_PS = 100352, RG_CAR = 112640, RG_RSB = 114176, RG_PT = 114688, RG_HC = 116224;
template <int CTRL> __device__ __forceinline__ float dpp0(float v) { return __int_as_float(__builtin_amdgcn_update_dpp(0, __float_as_int(v), CTRL, 0xf, 0xf, true)); }
template <int CTRL> __device__ __forceinline__ float dppf(float old, float v) { return __int_as_float(__builtin_amdgcn_update_dpp(__float_as_int(old), __float_as_int(v), CTRL, 0xf, 0xf, false)); }
__device__ __forceinline__ void bf8_to_f32(const u32x4 o, float (&v)[8]) {
    v[0] = __uint_as_float(o.x << 16); v[1] = __uint_as_float(o.x & 0xffff0000u); v[2] = __uint_as_float(o.y << 16); v[3] = __uint_as_float(o.y & 0xffff0000u);
    v[4] = __uint_as_float(o.z << 16); v[5] = __uint_as_float(o.z & 0xffff0000u); v[6] = __uint_as_float(o.w << 16); v[7] = __uint_as_float(o.w & 0xffff0000u);
}
__device__ __forceinline__ float bcast15(float v) { return __int_as_float(__builtin_amdgcn_ds_swizzle(__float_as_int(v), 0x1F0)); }
template <int PASS>
__device__ __forceinline__ void rglru_unit(int unit, bool first, float& cprev, int tid, int wave, int lane, const bf16_t* Z, bf16_t* Y, const bf16_t* WRG, const bf16_t* WIG,
                                           const float* conv_w, const float* conv_b, const float* rg_b, const float* ig_b, const float* lam, const float* mo_gb,
                                           float* SUMA, float* SUMH, float* SUMA2, float* SUMH2, bf16_t* HL, bf16_t* PP, LAS unsigned char* lds) {
    LAS bf16_t* xcl = (LAS bf16_t*)(lds + RG_XC); LAS float* PS = (LAS float*)(lds + RG_PS); LAS float* CAR = (LAS float*)(lds + RG_CAR); LAS float* RSB = (LAS float*)(lds + RG_RSB); LAS float* PT = (LAS float*)(lds + RG_PT); LAS float* HC = (LAS float*)(lds + RG_HC);
    const int t0 = unit * 128; const int ln = lane & 15, q = lane >> 4;
    if (tid < 384) {
        const int c0 = (tid % 48) * 8, tg = tid / 48; const int tb = t0 + tg * 16, s0 = tb % SEQ;
        float w0[8], w1[8], w2[8], w3[8], bb[8];
#pragma unroll
        for (int hh = 0; hh < 2; ++hh) { const f32x4 a0 = *(const f32x4*)(conv_w + 0 * BW + c0 + 4 * hh), a1 = *(const f32x4*)(conv_w + 1 * BW + c0 + 4 * hh), a2 = *(const f32x4*)(conv_w + 2 * BW + c0 + 4 * hh), a3 = *(const f32x4*)(conv_w + 3 * BW + c0 + 4 * hh), a4 = *(const f32x4*)(conv_b + c0 + 4 * hh);
#pragma unroll
            for (int j = 0; j < 4; ++j) { w0[4 * hh + j] = a0[j]; w1[4 * hh + j] = a1[j]; w2[4 * hh + j] = a2[j]; w3[4 * hh + j] = a3[j]; bb[4 * hh + j] = a4[j]; } }
        float xm1[8], xm2[8], xm3[8];
        const bf16_t* zp = Z + (size_t)tb * INC + ZX + c0;
        { const u32x4 z4 = {0u, 0u, 0u, 0u}; const u32x4 o1 = s0 >= 1 ? *(const u32x4*)(zp - INC) : z4, o2 = s0 >= 2 ? *(const u32x4*)(zp - 2 * INC) : z4, o3 = s0 >= 3 ? *(const u32x4*)(zp - 3 * INC) : z4;
          bf8_to_f32(o1, xm1); bf8_to_f32(o2, xm2); bf8_to_f32(o3, xm3); }
        LAS bf16_t* xw = xcl + (tg * 16) * XC_LD + c0;
#pragma unroll 4
        for (int i = 0; i < 16; ++i) { float x0[8]; bf8_to_f32(*(const u32x4*)(zp), x0); float v[8];
#pragma unroll
            for (int j = 0; j < 8; ++j) { v[j] = bb[j] + w3[j] * x0[j] + w2[j] * xm1[j] + w1[j] * xm2[j] + w0[j] * xm3[j]; xm3[j] = xm2[j]; xm2[j] = xm1[j]; xm1[j] = x0[j]; }
            u32x4 w; w.x = cvt_pk_bf16(v[0], v[1]); w.y = cvt_pk_bf16(v[2], v[3]); w.z = cvt_pk_bf16(v[4], v[5]); w.w = cvt_pk_bf16(v[6], v[7]);
            *(LAS u32x4*)(xw) = w; zp += INC; xw += XC_LD; }
        if (PASS == 2) { const int c = tid; float h;
            if (first) { const int pr = unit >> 1, p0 = pr - (pr % (UPB128 / 2)); h = 0.f; const float* pa = SUMA2 + (size_t)p0 * BW + c; const float* ph = SUMH2 + (size_t)p0 * BW + c;
#pragma unroll 8
                for (int j = p0; j < pr; ++j) { h = fmaf(*pa, h, *ph); pa += BW; ph += BW; } }
            else h = fmaf(SUMA[(size_t)(unit - 1) * BW + c], cprev, SUMH[(size_t)(unit - 1) * BW + c]);
            cprev = h; CAR[c] = h; }
    }
    __syncthreads();
#pragma unroll 1
    for (int ci = 0; ci < 3; ++ci) {
        const int combo = wave + 8 * ci, h = combo >> 2, jt = combo & 3, cb = h * 64 + jt * 16;
        const bf16_t* wr = WRG + ((size_t)(h * 64 + jt * 16 + ln)) * 64 + 8 * q; const bf16_t* wi = WIG + ((size_t)(h * 64 + jt * 16 + ln)) * 64 + 8 * q;
        const bf16x8 RG0 = *(const bf16x8*)(wr), RG1 = *(const bf16x8*)(wr + 32), IG0 = *(const bf16x8*)(wi), IG1 = *(const bf16x8*)(wi + 32);
        const f32x4 rgb4 = *(const f32x4*)(rg_b + cb + 4 * q), igb4 = *(const f32x4*)(ig_b + cb + 4 * q), lam4 = *(const f32x4*)(lam + cb + 4 * q);
        const float m1 = ln < 1 ? 1.f : 0.f, m2 = ln < 2 ? 1.f : 0.f, m4 = ln < 4 ? 1.f : 0.f, m8 = ln < 8 ? 1.f : 0.f;
        float spc[4], car[4], ptot[4];
#pragma unroll
        for (int r = 0; r < 4; ++r) { spc[r] = -8.0f * 1.4426950408889634f * log1pf(expf(-lam4[r])); car[r] = PASS == 2 ? CAR[cb + 4 * q + r] : (first ? 0.f : HC[cb + 4 * q + r]); ptot[r] = (PASS == 1 && !first) ? PT[cb + 4 * q + r] : 1.f; }
        const LAS bf16_t* xb = xcl + ln * XC_LD + h * 64 + 8 * q; const LAS bf16_t* xv = xcl + ln * XC_LD + cb + 4 * q;
        const bf16_t* zg = Z + (size_t)(t0 + ln) * INC + ZG + cb + 4 * q; bf16_t* yo = Y + (size_t)(t0 + ln) * D + AW + cb + 4 * q; LAS float* psw = PS + ln * 24 + combo;
        bf16_t* hlo = HL + (size_t)(t0 + ln) * BW + cb + 4 * q; bf16_t* ppo = PP + (size_t)(t0 + ln) * BW + cb + 4 * q;
#pragma unroll 1
        for (int tt = 0; tt < 8; ++tt) {
            const bf16x8 B0 = *(const LAS bf16x8*)(xb), B1 = *(const LAS bf16x8*)(xb + 32);
            f32x4 ar = (f32x4){0.f, 0.f, 0.f, 0.f}, ai = (f32x4){0.f, 0.f, 0.f, 0.f};
            ar = mfma16(RG0, B0, ar); ar = mfma16(RG1, B1, ar); ai = mfma16(IG0, B0, ai); ai = mfma16(IG1, B1, ai);
            const u32x2 xq = *(const LAS u32x2*)(xv); float xc4[4] = {__uint_as_float(xq.x << 16), __uint_as_float(xq.x & 0xffff0000u), __uint_as_float(xq.y << 16), __uint_as_float(xq.y & 0xffff0000u)};
            float hv[4], pv[4];
#pragma unroll
            for (int r = 0; r < 4; ++r) {
                const float rr = sigmoid_fast(ar[r] + rgb4[r]), ii = sigmoid_fast(ai[r] + igb4[r]);
                float A = __builtin_amdgcn_exp2f(spc[r] * rr);
                float Bv = __builtin_amdgcn_sqrtf(fmaxf(1.0f - A * A, 0.f)) * (ii * xc4[r]);
                if (ln == 0) { Bv = fmaf(A, car[r], Bv); A *= ptot[r]; }
                { const float As = dpp0<0x111>(A) + m1, Bs = dpp0<0x111>(Bv); Bv = fmaf(A, Bs, Bv); A *= As; }
                { const float As = dpp0<0x112>(A) + m2, Bs = dpp0<0x112>(Bv); Bv = fmaf(A, Bs, Bv); A *= As; }
                { const float As = dpp0<0x114>(A) + m4, Bs = dpp0<0x114>(Bv); Bv = fmaf(A, Bs, Bv); A *= As; }
                { const float As = dpp0<0x118>(A) + m8, Bs = dpp0<0x118>(Bv); Bv = fmaf(A, Bs, Bv); A *= As; }
                hv[r] = Bv; pv[r] = A; car[r] = dppf<0x121>(Bv, Bv); ptot[r] = dppf<0x121>(A, A);
            }
            if (PASS == 1) { u32x2 w; w.x = cvt_pk_bf16(hv[0], hv[1]); w.y = cvt_pk_bf16(hv[2], hv[3]); *(u32x2*)(hlo) = w; w.x = cvt_pk_bf16(pv[0], pv[1]); w.y = cvt_pk_bf16(pv[2], pv[3]); *(u32x2*)(ppo) = w; hlo += 16 * BW; ppo += 16 * BW; }
            if (PASS == 2) { const u32x2 gq = *(const u32x2*)(zg);
                const float y0 = hv[0] * __uint_as_float(gq.x << 16), y1 = hv[1] * __uint_as_float(gq.x & 0xffff0000u), y2 = hv[2] * __uint_as_float(gq.y << 16), y3 = hv[3] * __uint_as_float(gq.y & 0xffff0000u);
                u32x2 w; w.x = cvt_pk_bf16(y0, y1); w.y = cvt_pk_bf16(y2, y3); *(u32x2*)(yo) = w;
                float ss = (y0 * y0 + y1 * y1) + (y2 * y2 + y3 * y3); ss += __shfl_xor(ss, 16); ss += __shfl_xor(ss, 32);
                if (q == 0) *psw = ss; }
            xb += 16 * XC_LD; xv += 16 * XC_LD; zg += 16 * INC; yo += 16 * D; psw += 16 * 24;
        }
        if (PASS == 1 && ln == 0) {
            float* da = first ? SUMA + (size_t)unit * BW : SUMA2 + (size_t)(unit >> 1) * BW; float* dh = first ? SUMH + (size_t)unit * BW : SUMH2 + (size_t)(unit >> 1) * BW;
#pragma unroll
            for (int r = 0; r < 4; ++r) { da[cb + 4 * q + r] = ptot[r]; dh[cb + 4 * q + r] = car[r]; if (first) { PT[cb + 4 * q + r] = ptot[r]; HC[cb + 4 * q + r] = car[r]; } } }
    }
    if (PASS == 2) {
        asm volatile("s_waitcnt vmcnt(0)" ::: "memory");
        __syncthreads();
        if (tid < 128) { float s = 0.f;
#pragma unroll
            for (int k = 0; k < 24; ++k) s += PS[tid * 24 + k];
            RSB[tid] = __builtin_amdgcn_rsqf(s * (1.0f / BW) + EPS); }
        __syncthreads();
#pragma unroll 2
        for (int k = 0; k < 12; ++k) { const int idx = tid + 512 * k, tl = idx / 48, c0 = (idx % 48) * 8; const float rs = RSB[tl];
            bf16_t* yp = Y + (size_t)(t0 + tl) * D + AW + c0; float v[8]; bf8_to_f32(*(const u32x4*)(yp), v);
            const f32x4 g0 = *(const f32x4*)(mo_gb + c0), g1 = *(const f32x4*)(mo_gb + c0 + 4);
            u32x4 w; w.x = cvt_pk_bf16(v[0] * rs * g0[0], v[1] * rs * g0[1]); w.y = cvt_pk_bf16(v[2] * rs * g0[2], v[3] * rs * g0[3]); w.z = cvt_pk_bf16(v[4] * rs * g1[0], v[5] * rs * g1[1]); w.w = cvt_pk_bf16(v[6] * rs * g1[2], v[7] * rs * g1[3]);
            *(u32x4*)(yp) = w; }
    }
    __syncthreads();
}

__device__ __forceinline__ void rglru_fix_pair(int pr, int tid, int wave, int lane, const bf16_t* Z, bf16_t* Y, const bf16_t* HL, const bf16_t* PP, const float* SUMA2, const float* SUMH2, const float* mo_gb, LAS unsigned char* lds) {
    LAS float* CAR = (LAS float*)(lds + RG_CAR);
    if (tid < 384) { const int c = tid, p0 = pr - (pr % (UPB128 / 2)); float h = 0.f; const float* pa = SUMA2 + (size_t)p0 * BW + c; const float* ph = SUMH2 + (size_t)p0 * BW + c;
#pragma unroll 8
        for (int j = p0; j < pr; ++j) { h = fmaf(*pa, h, *ph); pa += BW; ph += BW; }
        CAR[c] = h; }
    __syncthreads();
    {
        typedef unsigned u32x3 __attribute__((ext_vector_type(3)));
        const int c0 = lane * 6; float hin[6], gch[6];
#pragma unroll
        for (int e = 0; e < 6; ++e) { hin[e] = CAR[c0 + e]; gch[e] = mo_gb[c0 + e]; }
#pragma unroll 2
        for (int i = 0; i < 32; ++i) { const size_t t = (size_t)pr * 256 + wave * 32 + i;
            const u32x3 h3 = *(const u32x3*)(HL + t * BW + c0), p3 = *(const u32x3*)(PP + t * BW + c0), g3 = *(const u32x3*)(Z + t * INC + ZG + c0);
            float y[6]; float ss = 0.f;
#pragma unroll
            for (int e = 0; e < 3; ++e) { const unsigned hh = h3[e], pq = p3[e], gq = g3[e];
                y[2 * e] = fmaf(__uint_as_float(pq << 16), hin[2 * e], __uint_as_float(hh << 16)) * gelu_fast(__uint_as_float(gq << 16));
                y[2 * e + 1] = fmaf(__uint_as_float(pq & 0xffff0000u), hin[2 * e + 1], __uint_as_float(hh & 0xffff0000u)) * gelu_fast(__uint_as_float(gq & 0xffff0000u));
                ss += y[2 * e] * y[2 * e] + y[2 * e + 1] * y[2 * e + 1]; }
            ss = wave_sum(ss);
            const float rs = __builtin_amdgcn_rsqf(ss * (1.0f / BW) + EPS);
            u32x3 w; w.x = cvt_pk_bf16(y[0] * rs * gch[0], y[1] * rs * gch[1]); w.y = cvt_pk_bf16(y[2] * rs * gch[2], y[3] * rs * gch[3]); w.z = cvt_pk_bf16(y[4] * rs * gch[4], y[5] * rs * gch[5]);
            *(u32x3*)(Y + t * D + AW + c0) = w; }
    }
    __syncthreads();
}

constexpr int VT_LD = 136;
__device__ __forceinline__ void mixa_unit(int unit, int tid, int wave, int lane, const bf16_t* Z, bf16_t* Y, const bf16_t* WSP, const float* a_sb, const float* vg, const float* mo_ga, LAS unsigned char* lds) {
    LAS bf16_t* vT = (LAS bf16_t*)lds; const int t0 = unit * 128; const int ln = lane & 15, q = lane >> 4;
    { const int j = tid >> 2, part = tid & 3; const bf16_t* zp = Z + (size_t)(t0 + j) * INC + ZV + part * 96;
      u32x4 raw[12]; float ss = 0.f;
#pragma unroll
      for (int k = 0; k < 12; ++k) { const u32x4 rw = *(const u32x4*)(zp + 8 * k); float v[8]; bf8_to_f32(rw, v);
#pragma unroll
          for (int e = 0; e < 8; ++e) { v[e] = gelu_fast(v[e]); ss += v[e] * v[e]; }
          raw[k].x = cvt_pk_bf16(v[0], v[1]); raw[k].y = cvt_pk_bf16(v[2], v[3]); raw[k].z = cvt_pk_bf16(v[4], v[5]); raw[k].w = cvt_pk_bf16(v[6], v[7]); }
      ss += x_xor1(ss); ss += x_xor2(ss);
      const float rs = __builtin_amdgcn_rsqf(ss * (1.0f / AW) + EPS);
      LAS bf16_t* vw = vT + (part * 96) * VT_LD + j; const float* gp = vg + part * 96;
#pragma unroll
      for (int k = 0; k < 12; ++k) { float v[8]; bf8_to_f32(raw[k], v); const f32x4 g0 = *(const f32x4*)(gp + 8 * k), g1 = *(const f32x4*)(gp + 8 * k + 4);
#pragma unroll
          for (int e = 0; e < 8; ++e) vw[(8 * k + e) * VT_LD] = f2bf(v[e] * rs * (e < 4 ? g0[e] : g1[e - 4])); } }
    __syncthreads();
    const bool full = wave >= 4;
    float ss = 0.f;
    const int tl = 16 * wave + ln;
    const char* ub = (const char*)(Z + (size_t)t0 * INC + ZU); const unsigned vu = (unsigned)(tl * INC + 4 * q) * 2u;
    const char* wb = (const char*)WSP; const unsigned vw = (unsigned)(tl * 128 + 8 * q) * 2u;
    char* yb = (char*)(Y + (size_t)t0 * D); const unsigned vy = (unsigned)(tl * D + 4 * q) * 2u;
    const bf16x8 z8 = {0, 0, 0, 0, 0, 0, 0, 0};
    bf16x8 Wn0 = ldg<bf16x8>(wb, vw), Wn1 = ldg<bf16x8>(wb + 64, vw), Wn2 = z8, Wn3 = z8;
    if (full) { Wn2 = ldg<bf16x8>(wb + 128, vw); Wn3 = ldg<bf16x8>(wb + 192, vw); }
    u32x2 un0 = ldg<u32x2>(ub, vu), un1 = ldg<u32x2>(ub + 32, vu), un2 = ldg<u32x2>(ub + 64, vu), un3 = ldg<u32x2>(ub + 96, vu); float bn = a_sb[tl];
    const LAS bf16_t* ap = vT + ln * VT_LD + 8 * q;
    u32x2 val[24];
#pragma unroll
    for (int h = 0; h < 6; ++h) {
        const bf16x8 W0 = Wn0, W1 = Wn1, W2 = Wn2, W3 = Wn3; const u32x2 uc[4] = {un0, un1, un2, un3}; const float b = bn;
        if (h < 5) { const char* wq = wb + (size_t)(h + 1) * 128 * 128 * 2; const char* uq2 = ub + (h + 1) * 128;
            Wn0 = ldg<bf16x8>(wq, vw); Wn1 = ldg<bf16x8>(wq + 64, vw); if (full) { Wn2 = ldg<bf16x8>(wq + 128, vw); Wn3 = ldg<bf16x8>(wq + 192, vw); }
            un0 = ldg<u32x2>(uq2, vu); un1 = ldg<u32x2>(uq2 + 32, vu); un2 = ldg<u32x2>(uq2 + 64, vu); un3 = ldg<u32x2>(uq2 + 96, vu); bn = a_sb[(h + 1) * 128 + tl]; }
        asm volatile("" ::: "memory");
#pragma unroll
        for (int dt = 0; dt < 4; ++dt) { f32x4 acc = (f32x4){0.f, 0.f, 0.f, 0.f};
            const LAS bf16_t* aq = ap + (h * 64 + 16 * dt) * VT_LD;
            const bf16x8 a0 = *(const LAS bf16x8*)(aq), a1 = *(const LAS bf16x8*)(aq + 32), a2 = *(const LAS bf16x8*)(aq + 64), a3 = *(const LAS bf16x8*)(aq + 96);
            acc = mfma16(a0, W0, acc); acc = mfma16(a1, W1, acc); acc = mfma16(a2, W2, acc); acc = mfma16(a3, W3, acc);
            const u32x2 u2 = uc[dt];
            const float v0 = gelu_fast(__uint_as_float(u2.x << 16)) * (acc[0] + b), v1 = gelu_fast(__uint_as_float(u2.x & 0xffff0000u)) * (acc[1] + b), v2 = gelu_fast(__uint_as_float(u2.y << 16)) * (acc[2] + b), v3 = gelu_fast(__uint_as_float(u2.y & 0xffff0000u)) * (acc[3] + b);
            ss += (v0 * v0 + v1 * v1) + (v2 * v2 + v3 * v3);
            u32x2 pk; pk.x = cvt_pk_bf16(v0, v1); pk.y = cvt_pk_bf16(v2, v3); val[h * 4 + dt] = pk; }
    }
    ss = add_x16_x32(ss);
    const float rs = __builtin_amdgcn_rsqf(ss * (1.0f / AW) + EPS);
    { const char* gb = (const char*)mo_ga; const unsigned vg4 = (unsigned)(4 * q) * 4u;
#pragma unroll
      for (int k = 0; k < 24; ++k) { const f32x4 gg = ldg<f32x4>(gb + k * 64, vg4); const u32x2 pk = val[k];
          u32x2 w; w.x = cvt_pk_bf16(__uint_as_float(pk.x << 16) * rs * gg[0], __uint_as_float(pk.x & 0xffff0000u) * rs * gg[1]); w.y = cvt_pk_bf16(__uint_as_float(pk.y << 16) * rs * gg[2], __uint_as_float(pk.y & 0xffff0000u) * rs * gg[3]);
          *(u32x2*)(yb + k * 32 + vy) = w; } }
    __syncthreads();
}

__device__ __forceinline__ void router_unit(int unit, int wave, int lane, const bf16_t* HB, const float* SSQ, const bf16_t* WRT, const float* rgb, const float* reb,
                                            int* CLS, float* G2, LAS unsigned char* lds, LAS int* hist) {
    const int ln = lane & 15, q = lane >> 4; const int t0 = unit * UT + wave * 32;
    LAS float* LG = (LAS float*)(lds + wave * 8192);
    f32x4 acc[2][3];
#pragma unroll
    for (int tt = 0; tt < 2; ++tt)
#pragma unroll
        for (int j = 0; j < 3; ++j) acc[tt][j] = (f32x4){0.f, 0.f, 0.f, 0.f};
    const bf16_t* hp0 = HB + (size_t)(t0 + ln) * D + 8 * q; const bf16_t* hp1 = hp0 + (size_t)16 * D; const bf16_t* wp = WRT + (size_t)ln * D + 8 * q;
#pragma unroll 4
    for (int ks = 0; ks < 32; ++ks) {
        const bf16x8 b0 = *(const bf16x8*)(hp0), b1 = *(const bf16x8*)(hp1);
        const bf16x8 a0 = *(const bf16x8*)(wp), a1 = *(const bf16x8*)(wp + 16 * D), a2 = *(const bf16x8*)(wp + 32 * D);
        acc[0][0] = mfma16(a0, b0, acc[0][0]); acc[0][1] = mfma16(a1, b0, acc[0][1]); acc[0][2] = mfma16(a2, b0, acc[0][2]);
        acc[1][0] = mfma16(a0, b1, acc[1][0]); acc[1][1] = mfma16(a1, b1, acc[1][1]); acc[1][2] = mfma16(a2, b1, acc[1][2]);
        hp0 += 32; hp1 += 32; wp += 32; }
#pragma unroll
    for (int tt = 0; tt < 2; ++tt)
#pragma unroll
        for (int j = 0; j < 3; ++j) *(LAS f32x4*)(LG + (16 * tt + ln) * 48 + 16 * j + 4 * q) = acc[tt][j];
    asm volatile("s_waitcnt lgkmcnt(0)" ::: "memory");
    if (lane < 32) { const int t = t0 + lane; const LAS float* lg = LG + lane * 48;
        const f32x4* sp = (const f32x4*)(SSQ + (size_t)t * 16); const f32x4 s0 = sp[0], s1 = sp[1], s2 = sp[2], s3 = sp[3];
        const float sq = ((s0[0] + s0[1]) + (s0[2] + s0[3])) + ((s1[0] + s1[1]) + (s1[2] + s1[3])) + ((s2[0] + s2[1]) + (s2[2] + s2[3])) + ((s3[0] + s3[1]) + (s3[2] + s3[3]));
        const float r = rsqrtf(sq * (1.0f / D) + EPS);
        float gl[4];
#pragma unroll
        for (int j = 0; j < 4; ++j) gl[j] = r * (lg[j] + lg[16 + j]) + rgb[j];
        int gs = 0; float gm = gl[0];
#pragma unroll
        for (int j = 1; j < 4; ++j) if (gl[j] > gm) { gm = gl[j]; gs = j; }
        float den = 0.f;
#pragma unroll
        for (int j = 0; j < 4; ++j) den += expf(gl[j] - gm);
        const float gwt = 1.0f / den;
        float el[4];
#pragma unroll
        for (int j = 0; j < 4; ++j) { float v;
            if (gs < 3) v = lg[4 + 4 * gs + j] + lg[16 + 4 + 4 * gs + j]; else v = lg[32 + j] + lg[36 + j];
            el[j] = r * v + reb[gs * 4 + j]; }
        int i0 = 0; float v0 = el[0];
#pragma unroll
        for (int j = 1; j < 4; ++j) if (el[j] > v0) { v0 = el[j]; i0 = j; }
        int i1 = 0; float v1 = -3.0e38f;
#pragma unroll
        for (int j = 0; j < 4; ++j) if (j != i0 && el[j] > v1) { v1 = el[j]; i1 = j; }
        const float e1 = expf(v1 - v0); const float w0 = gwt / (1.0f + e1), w1 = gwt * e1 / (1.0f + e1);
        const int lo = i0 < i1 ? i0 : i1, hi = i0 < i1 ? i1 : i0; const int cls = gs * 6 + pair_idx(lo, hi);
        CLS[t] = cls; G2[(size_t)t * 2 + 0] = i0 < i1 ? w0 : w1; G2[(size_t)t * 2 + 1] = i0 < i1 ? w1 : w0;
        __hip_atomic_fetch_add(hist + cls, 1, __ATOMIC_RELAXED, __HIP_MEMORY_SCOPE_WORKGROUP); }
}

__device__ __forceinline__ void tr_item8(const float* W, int ldw, int k0, int scol0, unsigned char* WT, int ldo, int drow0, int dk0, LAS float* scr, int lane) {
#pragma unroll 8
    for (int i = 0; i < 32; ++i) { const int kk = 2 * i + (lane >> 5); scr[kk * 33 + (lane & 31)] = W[(size_t)(k0 + kk) * ldw + scol0 + (lane & 31)] * pg8::FS_W; }
    asm volatile("s_waitcnt lgkmcnt(0)" ::: "memory");
    const int c = lane & 7;
#pragma unroll
    for (int j = 0; j < 4; ++j) { const int n = (lane >> 3) + 8 * j; const LAS float* s = scr + (8 * c) * 33 + n;
        u32x2 o; o.x = pk_fp8x4(s[0 * 33], s[1 * 33], s[2 * 33], s[3 * 33]); o.y = pk_fp8x4(s[4 * 33], s[5 * 33], s[6 * 33], s[7 * 33]);
        *(u32x2*)(WT + (size_t)(drow0 + n) * ldo + dk0 + 8 * c) = o; }
    asm volatile("s_waitcnt lgkmcnt(0)" ::: "memory");
}
struct TrP { const float* src; const float* gk; unsigned char* dst; int ldw, ldo, fp8; };
__device__ __forceinline__ void tr_load(const TrP& P, int lane, float (&v)[32]) {
#pragma unroll
    for (int i = 0; i < 32; ++i) { const int kk = 2 * i + (lane >> 5); float x = P.src[(size_t)kk * P.ldw + (lane & 31)]; if (P.gk) x *= P.gk[kk]; v[i] = x; }
}
__device__ __forceinline__ void tr_store(const TrP& P, int lane, const float (&v)[32], LAS float* scr) {
    const float sc = P.fp8 ? pg8::FS_W : 1.0f;
#pragma unroll
    for (int i = 0; i < 32; ++i) scr[(2 * i + (lane >> 5)) * 33 + (lane & 31)] = v[i] * sc;
    asm volatile("s_waitcnt lgkmcnt(0)" ::: "memory");
    const int c = lane & 7;
#pragma unroll
    for (int j = 0; j < 4; ++j) { const int n = (lane >> 3) + 8 * j; const LAS float* s = scr + (8 * c) * 33 + n;
        if (P.fp8) { u32x2 o; o.x = pk_fp8x4(s[0 * 33], s[1 * 33], s[2 * 33], s[3 * 33]); o.y = pk_fp8x4(s[4 * 33], s[5 * 33], s[6 * 33], s[7 * 33]); *(u32x2*)(P.dst + (size_t)n * P.ldo + 8 * c) = o; }
        else { u32x4 o; o.x = cvt_pk_bf16(s[0 * 33], s[1 * 33]); o.y = cvt_pk_bf16(s[2 * 33], s[3 * 33]); o.z = cvt_pk_bf16(s[4 * 33], s[5 * 33]); o.w = cvt_pk_bf16(s[6 * 33], s[7 * 33]); *(u32x4*)(P.dst + (size_t)n * P.ldo + 16 * c) = o; } }
    asm volatile("s_waitcnt lgkmcnt(0)" ::: "memory");
}
struct Args { const float* in[34]; float* out; unsigned char* ws; };

__global__ void __launch_bounds__(512, 2) mega_fwd(Args a) {
    extern __shared__ __attribute__((aligned(16))) unsigned char lds_raw[];
    LAS unsigned char* lds = (LAS unsigned char*)lds_raw;
    volatile LAS unsigned* LW = (volatile LAS unsigned*)(lds + LDSCTL_OFF);
    volatile LAS int* LWI = (volatile LAS int*)(lds + LDSCTL_OFF);
    const int G = gridDim.x, bid0 = blockIdx.x; const int wave_s0 = __builtin_amdgcn_readfirstlane(threadIdx.x >> 6);
#define PHASE_IDS() int wv_ = wave_s0, bd_ = bid0; asm volatile("" : "+s"(wv_), "+s"(bd_)); const int wave_s = wv_, bid = bd_;     \
    const int lane = fresh_lane(), wave = wave_s, tid = wave * 64 + lane; const int gw = bid * 8 + wave, NGW = G * 8; \
    const size_t gt = (size_t)bid * 512 + tid, NGT = (size_t)G * 512; (void)lane; (void)wave; (void)gw; (void)NGW; (void)gt; (void)NGT
#define WSB() ({ unsigned char* _w = a.ws; asm volatile("" : "+s"(_w)); _w; })
#define INP(i) ({ int _k = (i); asm volatile("" : "+s"(_k)); a.in[_k]; })
    for (int u = threadIdx.x; u < (LDS_PF - LDSCTL_OFF) / 4; u += 512) LW[u] = 0u;
    __syncthreads();
    XcdBarrier bar = xcd_barrier_post((unsigned*)(a.ws + WS_CTL) + CW_BAR, LW + LW_BAR);

    {
        PHASE_IDS(); unsigned char* ws = WSB(); bf16_t* WIN = (bf16_t*)(ws + WS_WIN); bf16_t* WOUT = (bf16_t*)(ws + WS_WOUT); bf16_t* WGU = (bf16_t*)(ws + WS_WGU); bf16_t* WD2 = (bf16_t*)(ws + WS_WD2);
        bf16_t* HB = (bf16_t*)(ws + WS_HB); float* SSQ = (float*)(ws + WS_SSQ);
        LAS float* scr = (LAS float*)(lds + wave * 16384);
        constexpr int I_IN = 16 * 56, I_OUT = 16 * 32, I_GU = 2 * 16 * 256, I_D8 = 16 * 256, I_GLU = 32, I_RG = 24, I_L = I_IN + I_OUT + I_GU + I_D8 + I_GLU + I_RG;
        const float* i_win = INP(2); const float* i_g = INP(1); const float* i_wout = INP(24); const float* i_wg = INP(30); const float* i_wu = INP(31); const float* i_wd = INP(32);
        const float* i_glu = INP(21); const float* i_rg = INP(8); const float* i_ig = INP(10);
#define TR_DECODE(P, it) do { const int l = (it) / I_L; int r = (it) % I_L; P.gk = nullptr; P.fp8 = 0; \
            if (r < I_IN) { const int kb = r / 56, nb = r % 56, j0 = nb * 32; const int sc = j0 < 768 ? j0 : (j0 < 1152 ? j0 + 384 : (j0 < 1536 ? j0 - 384 : j0));     \
                P.src = i_win + (size_t)l * D * INC + (size_t)kb * 64 * INC + sc; P.ldw = INC; P.gk = i_g + (size_t)l * D + kb * 64; P.dst = (unsigned char*)(WIN + (size_t)l * INC * D + (size_t)j0 * D + kb * 64); P.ldo = D * 2; } \
            else if ((r -= I_IN) < I_OUT) { const int kb = r / 32, nb = r % 32; P.src = i_wout + (size_t)l * D * D + (size_t)kb * 64 * D + nb * 32; P.ldw = D; P.dst = (unsigned char*)(WOUT + (size_t)l * D * D + (size_t)nb * 32 * D + kb * 64); P.ldo = D * 2; } \
            else if ((r -= I_OUT) < I_GU) { const int which = r / (16 * 256), e = (r / 256) % 16, q = r % 256, kb = q / 16, nb = q % 16, n0 = nb * 32;     \
                P.src = (which ? i_wu : i_wg) + ((size_t)l * NE + e) * D * DE + (size_t)kb * 64 * DE + n0; P.ldw = DE; P.fp8 = 1; \
                P.dst = (unsigned char*)WGU + ((size_t)l * NE + e) * 1024 * 1024 + (size_t)((n0 / 128) * 256 + which * 128 + (n0 % 128)) * 1024 + kb * 64; P.ldo = 1024; } \
            else if ((r -= I_GU) < I_D8) { const int e = r / 256, q = r % 256, kb = q / 32, nb = q % 32;        \
                P.src = i_wd + ((size_t)l * NE + e) * DE * D + (size_t)kb * 64 * D + nb * 32; P.ldw = D; P.fp8 = 1; P.dst = ws + WS_WD8 + ((size_t)l * NE + e) * 1024 * 512 + (size_t)nb * 32 * 512 + kb * 64; P.ldo = 512; } \
            else if ((r -= I_D8) < I_GLU) { const int kb = r / 8, nb = r % 8; P.src = i_glu + (size_t)l * CW * CW + (size_t)kb * 64 * CW + nb * 32; P.ldw = CW; P.dst = (unsigned char*)((bf16_t*)(ws + WS_WGLU) + (size_t)l * CW * CW + (size_t)nb * 32 * CW + kb * 64); P.ldo = CW * 2; } \
            else { r -= I_GLU; const int gate = r / 12, h = (r / 2) % 6, nb = r & 1; \
                P.src = (gate ? i_ig : i_rg) + ((size_t)l * 6 + h) * 64 * 64 + nb * 32; P.ldw = 64; P.dst = (unsigned char*)((bf16_t*)(ws + WS_WRG) + (((size_t)l * 2 + gate) * 6 + h) * 64 * 64 + (size_t)nb * 32 * 64); P.ldo = 64 * 2; } } while (0)
        { TrP Pa, Pb; float va[32], vb[32]; int it = gw;
          if (it < 2 * I_L) { TR_DECODE(Pa, it); tr_load(Pa, lane, va); }
#pragma unroll 1
          while (it < 2 * I_L) {
              const int it1 = it + NGW; if (it1 < 2 * I_L) { TR_DECODE(Pb, it1); tr_load(Pb, lane, vb); }
              tr_store(Pa, lane, va, scr);
              if (it1 >= 2 * I_L) break;
              const int it2 = it1 + NGW; if (it2 < 2 * I_L) { TR_DECODE(Pa, it2); tr_load(Pa, lane, va); }
              tr_store(Pb, lane, vb, scr);
              it = it2; } }
#undef TR_DECODE
        { const float* s_are = INP(13); const float* s_aim = INP(14); const float* s_ldt = INP(15); const float* s_bre = INP(16); const float* s_bim = INP(17); const float* s_cre = INP(18); const float* s_cim = INP(19); const float* s_d = INP(20);
          for (size_t e = gt; e < (size_t)2 * CG * 256; e += NGT) { const int l = (int)(e / (CG * 256)), g = (int)((e / 256) % CG), c = (int)((e >> 4) & 15), cp = (int)(e & 15);
              s5_kt_pair(g, c, cp, s_are + (size_t)l * CG * CS, s_aim + (size_t)l * CG * CS, s_ldt + (size_t)l * CG, s_bre + (size_t)l * CG * CS * CGD, s_bim + (size_t)l * CG * CS * CGD,
                         s_cre + (size_t)l * CG * CGD * CS, s_cim + (size_t)l * CG * CGD * CS, s_d + (size_t)l * CW, ws + WS_S5 + (size_t)l * S5_L_STRIDE); }
          for (size_t e = gt; e < (size_t)2 * CG * 2048; e += NGT) { const int l = (int)(e / (CG * 2048)), g = (int)((e / 2048) % CG), r = (int)(e & 2047);
              s5_et_task(g, r >> 10, (r >> 4) & 63, r & 15, s_are + (size_t)l * CG * CS, s_aim + (size_t)l * CG * CS, s_ldt + (size_t)l * CG, s_bre + (size_t)l * CG * CS * CGD, s_bim + (size_t)l * CG * CS * CGD, ws + WS_S5 + (size_t)l * S5_L_STRIDE);
              s5_ft_task(g, r >> 7, (r >> 6) & 1, r & 63, s_are + (size_t)l * CG * CS, s_aim + (size_t)l * CG * CS, s_ldt + (size_t)l * CG, s_cre + (size_t)l * CG * CGD * CS, s_cim + (size_t)l * CG * CGD * CS, ws + WS_S5 + (size_t)l * S5_L_STRIDE); }
          for (size_t e = gt; e < (size_t)2 * CG * 64; e += NGT) { const int l = (int)(e / (CG * 64)), g = (int)((e / 64) % CG), el = 4096 + 32768 + (int)(e % 64);
              s5_table_elem(g, el, s_are + (size_t)l * CG * CS, s_aim + (size_t)l * CG * CS, s_ldt + (size_t)l * CG, s_bre + (size_t)l * CG * CS * CGD, s_bim + (size_t)l * CG * CS * CGD,
                            s_cre + (size_t)l * CG * CGD * CS, s_cim + (size_t)l * CG * CGD * CS, s_d + (size_t)l * CW, ws + WS_S5 + (size_t)l * S5_L_STRIDE); } }
        { const float* sw = INP(4); bf16_t* wsp = (bf16_t*)(ws + WS_WSP); for (size_t e = gt; e < (size_t)2 * 6 * 128 * 128; e += NGT) wsp[e] = f2bf(sw[e]); }
        { const float* fg = INP(25); const float* rgw = INP(26); const float* rew = INP(28); bf16_t* wrt = (bf16_t*)(ws + WS_WRT);
          for (size_t e = gt; e < (size_t)2 * 48 * D; e += NGT) { const int l = (int)(e / (48 * D)), n = (int)((e / D) % 48), k = (int)(e % D);
              int j = -1, lo = 0; if (n < 16) j = n; else if (n < 32) { j = n - 16; lo = 1; } else if (n < 36) j = 16 + (n - 32); else if (n < 40) { j = 16 + (n - 36); lo = 1; }
              float v = 0.f;
              if (j >= 0) { const float w = fg[(size_t)l * D + k] * (j < 4 ? rgw[((size_t)l * D + k) * 4 + j] : rew[(((size_t)l * 4 + ((j - 4) >> 2)) * D + k) * 4 + ((j - 4) & 3)]);
                  const float hi = bf2f(f2bf(w)); v = lo ? (w - hi) : w; }
              wrt[e] = f2bf(v); } }
        const float* xin = INP(0);
#pragma unroll 1
        for (int t = gw * 2; t < T; t += NGW * 2) {
            const f32x4* xr = (const f32x4*)(xin + (size_t)t * D) + lane; f32x4 v[2][4]; float s0 = 0.f, s1 = 0.f;
#pragma unroll
            for (int j = 0; j < 4; ++j) { v[0][j] = xr[64 * j]; v[1][j] = xr[256 + 64 * j]; }
#pragma unroll
            for (int j = 0; j < 4; ++j) { s0 += (v[0][j][0] * v[0][j][0] + v[0][j][1] * v[0][j][1]) + (v[0][j][2] * v[0][j][2] + v[0][j][3] * v[0][j][3]); s1 += (v[1][j][0] * v[1][j][0] + v[1][j][1] * v[1][j][1]) + (v[1][j][2] * v[1][j][2] + v[1][j][3] * v[1][j][3]); }
            u32x2* o8 = (u32x2*)(HB + (size_t)t * D) + lane;
#pragma unroll
            for (int j = 0; j < 4; ++j) { u32x2 w; w.x = cvt_pk_bf16(v[0][j][0], v[0][j][1]); w.y = cvt_pk_bf16(v[0][j][2], v[0][j][3]); o8[64 * j] = w; w.x = cvt_pk_bf16(v[1][j][0], v[1][j][1]); w.y = cvt_pk_bf16(v[1][j][2], v[1][j][3]); o8[256 + 64 * j] = w; }
            s0 = wave_sum(s0); s1 = wave_sum(s1);
            if (lane < 32) SSQ[(size_t)t * 16 + lane] = lane == 0 ? s0 : (lane == 16 ? s1 : 0.f);
        }
    }
    xcd_barrier(bar);

    for (int l = 0; l < DEPTH; ++l) {
        { PHASE_IDS(); unsigned char* ws = WSB(); bf16_t* WIN = (bf16_t*)(ws + WS_WIN); bf16_t* HB = (bf16_t*)(ws + WS_HB); float* SSQ = (float*)(ws + WS_SSQ); bf16_t* Z = (bf16_t*)(ws + WS_Z);
          pg8::StaticOrder<T, INC> S; S.init(HB, WIN + (size_t)l * INC * D, G, bid);
          pg8::EpiZ E{Z, SSQ, lds + LDS_PF};
          pg8::gemm_phase<pg8::EpiZ, pg8::StaticOrder<T, INC>, true, true>(lds, wave_s, S, E); }
        xcd_barrier(bar);

        {
            PHASE_IDS(); unsigned char* ws = WSB(); const bf16_t* Z = (const bf16_t*)(ws + WS_Z);
            const float* conv_w = INP(6) + (size_t)l * 4 * BW; const float* conv_b = INP(7) + (size_t)l * BW; const float* rg_b = INP(9) + (size_t)l * BW;
            const float* ig_b = INP(11) + (size_t)l * BW; const float* lam = INP(12) + (size_t)l * BW;
            __syncthreads();
            { const bf16_t* WRG = (const bf16_t*)(ws + WS_WRG) + ((size_t)l * 2 + 0) * 6 * 4096; const bf16_t* WIG = (const bf16_t*)(ws + WS_WRG) + ((size_t)l * 2 + 1) * 6 * 4096;
              for (int pr = bid; pr < NU128 / 2; pr += G) { float cp = 0.f;
                  rglru_unit<1>(2 * pr, true, cp, tid, wave, lane, Z, nullptr, WRG, WIG, conv_w, conv_b, rg_b, ig_b, lam, nullptr, (float*)(ws + WS_SUMA), (float*)(ws + WS_SUMH), (float*)(ws + WS_SUMA2), (float*)(ws + WS_SUMH2), (bf16_t*)(ws + WS_HL), (bf16_t*)(ws + WS_PP), lds);
                  rglru_unit<1>(2 * pr + 1, false, cp, tid, wave, lane, Z, nullptr, WRG, WIG, conv_w, conv_b, rg_b, ig_b, lam, nullptr, (float*)(ws + WS_SUMA), (float*)(ws + WS_SUMH), (float*)(ws + WS_SUMA2), (float*)(ws + WS_SUMH2), (bf16_t*)(ws + WS_HL), (bf16_t*)(ws + WS_PP), lds); } }
            for (int pr = bid; pr < NU128 / 2; pr += G) { const unsigned char* tab = ws + WS_S5 + (size_t)l * S5_L_STRIDE;
                s5_pair1(pr, 2 * wave, wave, lane, Z, (bf16_t*)(ws + WS_Y), tab, (float*)(ws + WS_SEND), (float*)(ws + WS_SEND2), (float*)(ws + WS_SE), lds);
                s5_pair1(pr, 2 * wave + 1, wave, lane, Z, (bf16_t*)(ws + WS_Y), tab, (float*)(ws + WS_SEND), (float*)(ws + WS_SEND2), (float*)(ws + WS_SE), lds); }
            __syncthreads();
            { const bf16_t* WSP = (const bf16_t*)(ws + WS_WSP) + (size_t)l * 6 * 128 * 128; const float* a_sb = INP(5) + (size_t)l * 6 * 128; const float* vg = INP(3) + (size_t)l * AW; const float* mo_ga = INP(23) + (size_t)l * D;
              for (int u = bid; u < NU128; u += G) mixa_unit(u, tid, wave, lane, Z, (bf16_t*)(ws + WS_Y), WSP, a_sb, vg, mo_ga, lds); }
        }
        xcd_barrier(bar);

        {
            PHASE_IDS(); unsigned char* ws = WSB(); const bf16_t* Z = (const bf16_t*)(ws + WS_Z); bf16_t* Y = (bf16_t*)(ws + WS_Y);
            const float* a_v_norm_g = INP(3) + (size_t)l * AW; const float* a_sw = INP(4) + (size_t)l * 6 * 128 * 128; const float* a_sb = INP(5) + (size_t)l * 6 * 128;
        }

        { PHASE_IDS(); unsigned char* ws = WSB(); const bf16_t* Z = (const bf16_t*)(ws + WS_Z); bf16_t* Y = (bf16_t*)(ws + WS_Y);
          { const float* mo_gb = INP(23) + (size_t)l * D + AW;
            __syncthreads();
            for (int pr = bid; pr < NU128 / 2; pr += G) rglru_fix_pair(pr, tid, wave, lane, Z, Y, (const bf16_t*)(ws + WS_HL), (const bf16_t*)(ws + WS_PP), (const float*)(ws + WS_SUMA2), (const float*)(ws + WS_SUMH2), mo_gb, lds); }
          { const bf16_t* WGLU = (const bf16_t*)(ws + WS_WGLU) + (size_t)l * CW * CW; const float* glu_b = INP(22) + (size_t)l * CW; const float* mo_gc = INP(23) + (size_t)l * D + AW + BW;
            for (int pr = bid; pr < NU128 / 2; pr += G) { float k0r = 0.f, k0i = 0.f, k1r = 0.f, k1i = 0.f; const unsigned char* tab = ws + WS_S5 + (size_t)l * S5_L_STRIDE;
#pragma unroll 1
                for (int ui = 0; ui < 2; ++ui) { const int u = 2 * pr + ui; __syncthreads();
                    s5_group<2>(u, 2 * wave, ui == 0, k0r, k0i, wave, lane, Z, Y, tab, (float*)(ws + WS_SEND), (float*)(ws + WS_SEND2), (float*)(ws + WS_SE), lds);
                    s5_group<2>(u, 2 * wave + 1, ui == 0, k1r, k1i, wave, lane, Z, Y, tab, (float*)(ws + WS_SEND), (float*)(ws + WS_SEND2), (float*)(ws + WS_SE), lds);
                    __syncthreads(); s5_glu(u, wave, lane, WGLU, glu_b, mo_gc, Y, lds); } } } }
        asm volatile("s_waitcnt vmcnt(0)" ::: "memory"); __syncthreads();
        if (wave_s0 == 0) { __builtin_amdgcn_fence(__ATOMIC_ACQUIRE, "agent"); asm volatile("s_waitcnt vmcnt(0)" ::: "memory"); }
        __syncthreads();

        { PHASE_IDS(); unsigned char* ws = WSB(); bf16_t* WOUT = (bf16_t*)(ws + WS_WOUT); bf16_t* HB = (bf16_t*)(ws + WS_HB); float* SSQ = (float*)(ws + WS_SSQ); bf16_t* Y = (bf16_t*)(ws + WS_Y);
          pg8::PanelOrder<T, 4> S; S.init(Y, WOUT + (size_t)l * D * D, G, bid);
          pg8::EpiRes<false> E{HB, SSQ, nullptr, lds + LDS_PF};
          pg8::gemm_phase<pg8::EpiRes<false>, pg8::PanelOrder<T, 4>, true, true>(lds, wave_s, S, E); }
        asm volatile("s_waitcnt vmcnt(0)" ::: "memory"); __syncthreads();
        if (wave_s0 == 0) { __builtin_amdgcn_fence(__ATOMIC_ACQUIRE, "agent"); asm volatile("s_waitcnt vmcnt(0)" ::: "memory"); }
        __syncthreads();

        { PHASE_IDS(); unsigned char* ws = WSB(); const bf16_t* HB = (const bf16_t*)(ws + WS_HB); const float* SSQ = (const float*)(ws + WS_SSQ); int* CLS = (int*)(ws + WS_CLS); float* G2 = (float*)(ws + WS_G2); int* HIST = (int*)(ws + WS_HIST);
          const float* rgb = INP(27) + (size_t)l * 4; const float* reb = INP(29) + (size_t)l * 16;
        if (l == 0) {
            for (int rr = gw; rr < 2 * NCLS * 2 * 1024 / 2; rr += NGW) { const int row = 2 * rr + (lane >> 5), n = row & 1023, half = (row >> 10) & 1, cls = (row >> 11) % NCLS, ll = row / (2048 * NCLS);
                const int g = cls / 6, pi = cls % 6, e = g * 4 + (half ? pair_hi(pi) : pair_lo(pi));
                const u32x4 v = *(const u32x4*)(ws + WS_WD8 + ((size_t)ll * NE + e) * 1024 * 512 + (size_t)n * 512 + (lane & 31) * 16);
                *(u32x4*)(ws + WS_WD2 + ((size_t)ll * NCLS + cls) * 1024 * 1024 + (size_t)n * 1024 + half * 512 + (lane & 31) * 16) = v; } }
        for (int u = bid; u < NU; u += G) {
            router_unit(u, wave, lane, HB, SSQ, (const bf16_t*)(ws + WS_WRT) + (size_t)l * 48 * D, rgb, reb, CLS, G2, lds, (LAS int*)(lds + LDSCTL_OFF) + LW_HIST);
            __syncthreads();
            if (tid < 32) { HIST[u * 32 + tid] = tid < NCLS ? LWI[LW_HIST + tid] : 0; LWI[LW_HIST + tid] = 0; }
            __syncthreads();
        } }
        xcd_barrier(bar);

        { PHASE_IDS(); unsigned char* ws = WSB(); const bf16_t* HB = (const bf16_t*)(ws + WS_HB); const float* SSQ = (const float*)(ws + WS_SSQ); const int* CLS = (const int*)(ws + WS_CLS); const float* G2 = (const float*)(ws + WS_G2); const int* HIST = (const int*)(ws + WS_HIST);
          int* CTOT = (int*)(ws + WS_CTOT); int* ROWTOK = (int*)(ws + WS_ROWTOK); float* ROWG = (float*)(ws + WS_ROWG); bf16_t* HBS = (bf16_t*)(ws + WS_HBS); const float* ffn_g = INP(25) + (size_t)l * D;
        for (int u = bid; u < NU; u += G) {
            { const int c = tid & 31, part = tid >> 5; int tot = 0, pre = 0;
_Pragma("unroll 16")
              for (int k = part * 16; k < part * 16 + 16; ++k) { const int v = HIST[k * 32 + c]; tot += v; pre += k < u ? v : 0; }
              ((volatile LAS int*)lds)[tid] = tot; ((volatile LAS int*)lds)[512 + tid] = pre; }
            __syncthreads();
            if (tid < NCLS) { int tot = 0, pre = 0;
_Pragma("unroll")
                for (int k = 0; k < 16; ++k) { tot += ((volatile LAS int*)lds)[k * 32 + tid]; pre += ((volatile LAS int*)lds)[512 + k * 32 + tid]; } LWI[LW_TOT + tid] = tot; LWI[LW_BASE + tid] = pre; }
            __syncthreads();
            if (tid == 0) { int ps = 0;
_Pragma("unroll 1")
                for (int c = 0; c < NCLS; ++c) { const int tot = LWI[LW_TOT + c]; LWI[LW_BASE + c] += ps; LWI[LW_TST + c] = ps; ps += ((tot + 255) >> 8) << 8; if (bid == 0) CTOT[c] = tot; } LWI[LW_TST + NCLS] = ps; }
            if (tid < UT) LWI[LW_CLS + tid] = CLS[u * UT + tid];
            __syncthreads();
            if (tid < UT) { const int cls = LWI[LW_CLS + tid]; int rank = 0;
_Pragma("unroll 1")
                for (int i = 0; i < tid; ++i) rank += LWI[LW_CLS + i] == cls ? 1 : 0;
                const int dest = LWI[LW_BASE + cls] + rank; LWI[LW_DEST + tid] = dest; const int t = u * UT + tid;
                ROWTOK[dest] = t; ROWG[(size_t)dest * 2 + 0] = G2[(size_t)t * 2 + 0]; ROWG[(size_t)dest * 2 + 1] = G2[(size_t)t * 2 + 1]; }
            __syncthreads();
            { f32x4 gq[4];
#pragma unroll
              for (int j = 0; j < 4; ++j) gq[j] = *(const f32x4*)(ffn_g + (j >> 1) * 512 + lane * 8 + 4 * (j & 1));
#pragma unroll 1
              for (int i = 0; i < 32; i += 4) {
                  const int tl0 = wave * 32 + i, t0r = u * UT + tl0;
                  float sq = SSQ[(size_t)t0r * 16 + lane]; sq += x_xor1(sq); sq += x_xor2(sq); sq += x_hmir(sq); sq += x_mir(sq);
                  u32x4 o[4][2]; int dst[4];
#pragma unroll
                  for (int j = 0; j < 4; ++j) { o[j][0] = *(const u32x4*)(HB + (size_t)(t0r + j) * D + lane * 8); o[j][1] = *(const u32x4*)(HB + (size_t)(t0r + j) * D + 512 + lane * 8); dst[j] = LWI[LW_DEST + tl0 + j]; }
#pragma unroll
                  for (int j = 0; j < 4; ++j) { const float r4 = rsqrtf(__builtin_amdgcn_readlane(sq, 16 * j) * (1.0f / D) + EPS) * pg8::FS_H; u32x4 w;
#pragma unroll
                      for (int hh = 0; hh < 2; ++hh) { const u32x4 oo = o[j][hh]; const f32x4 g0 = gq[2 * hh], g1 = gq[2 * hh + 1];
                          const unsigned lo = pk_fp8x4(__uint_as_float(oo.x << 16) * r4 * g0[0], __uint_as_float(oo.x & 0xffff0000u) * r4 * g0[1], __uint_as_float(oo.y << 16) * r4 * g0[2], __uint_as_float(oo.y & 0xffff0000u) * r4 * g0[3]);
                          const unsigned hi = pk_fp8x4(__uint_as_float(oo.z << 16) * r4 * g1[0], __uint_as_float(oo.z & 0xffff0000u) * r4 * g1[1], __uint_as_float(oo.w << 16) * r4 * g1[2], __uint_as_float(oo.w & 0xffff0000u) * r4 * g1[3]);
                          if (hh == 0) { w.x = lo; w.y = hi; } else { w.z = lo; w.w = hi; } }
                      *(u32x2*)((unsigned char*)HBS + (size_t)dst[j] * D + lane * 8) = (u32x2){w.x, w.y}; *(u32x2*)((unsigned char*)HBS + (size_t)dst[j] * D + 512 + lane * 8) = (u32x2){w.z, w.w}; } } }
            if (u == bid)
_Pragma("unroll 1")
            for (int c = bid; c < NCLS; c += G) { const int tot = LWI[LW_TOT + c], r0 = LWI[LW_TST + c] + tot, r1 = LWI[LW_TST + c + 1];
                unsigned zz = 0u; asm volatile("" : "+v"(zz));
                for (int r = r0 + wave; r < r1; r += 8) { if (lane == 0) { ROWTOK[r] = -1; ROWG[(size_t)r * 2] = __uint_as_float(zz); ROWG[(size_t)r * 2 + 1] = __uint_as_float(zz); }
                    *(u32x4*)((unsigned char*)HBS + (size_t)r * D + lane * 16) = (u32x4){zz, zz, zz, zz}; } }
            __syncthreads();
        } }
        xcd_barrier(bar);

        { PHASE_IDS(); unsigned char* ws = WSB(); const int* CTOT = (const int*)(ws + WS_CTOT); bf16_t* HBS = (bf16_t*)(ws + WS_HBS); bf16_t* WGU = (bf16_t*)(ws + WS_WGU); bf16_t* ACT = (bf16_t*)(ws + WS_ACT); const float* ROWG = (const float*)(ws + WS_ROWG);
        if (tid == 0) { int ps = 0;
_Pragma("unroll 1")
            for (int c = 0; c < NCLS; ++c) { LWI[LW_TST + c] = ps; ps += (CTOT[c] + 255) >> 8; } LWI[LW_TST + NCLS] = ps; }
        __syncthreads();
        if (tid < 32) { const int ntile = LWI[LW_TST + NCLS]; const long L = (long)tid * G + bid; int e = -1;
            if (L < (long)ntile * 8) { const int nwg = ntile * 8, qq = nwg / 8, rr = nwg % 8, xcd = (int)(L % 8), off = (int)(L / 8); const int Lr = (xcd < rr ? xcd * (qq + 1) : rr * (qq + 1) + (xcd - rr) * qq) + off;
                const int mt = Lr / 8, pn = Lr % 8; int cls = 0;
_Pragma("unroll 1")
                for (int k = 1; k < NCLS; ++k) cls += (LWI[LW_TST + k] <= mt) ? 1 : 0;
                e = (cls << 24) | (pn << 16) | mt; }
            LWI[LW_UTAB + tid] = e; e = -1;
            if (L < (long)ntile * 4) { const int nwg = ntile * 4, qq = nwg / 8, rr = nwg % 8, xcd = (int)(L % 8), off = (int)(L / 8); const int Lr = (xcd < rr ? xcd * (qq + 1) : rr * (qq + 1) + (xcd - rr) * qq) + off;
                const int mt = Lr / 4, pn = Lr % 4; int cls = 0;
_Pragma("unroll 1")
                for (int k = 1; k < NCLS; ++k) cls += (LWI[LW_TST + k] <= mt) ? 1 : 0;
                e = (cls << 24) | (pn << 16) | mt; }
            LWI[LW_DTAB + tid] = e; }
        __syncthreads();
        { pg8::MoeOrder<8, true, 1024> S{LWI + LW_UTAB, l, (const char*)HBS, (const char*)WGU};
          pg8::EpiUp E{(unsigned char*)ACT, ROWG, lds + LDS_PF};
          pg8::gemm_phase<pg8::EpiUp, pg8::MoeOrder<8, true, 1024>, true, true, 512, true>(lds, wave_s, S, E); } }
        xcd_barrier(bar);

        { PHASE_IDS(); unsigned char* ws = WSB(); bf16_t* ACT = (bf16_t*)(ws + WS_ACT); bf16_t* WD2 = (bf16_t*)(ws + WS_WD2); bf16_t* HB = (bf16_t*)(ws + WS_HB); float* SSQ = (float*)(ws + WS_SSQ); const int* ROWTOK = (const int*)(ws + WS_ROWTOK);
          pg8::MoeOrder<4, false, 1024> S{LWI + LW_DTAB, l, (const char*)ACT, (const char*)WD2};
          pg8::EpiRes<true> E{HB, SSQ, ROWTOK, lds + LDS_PF};
          pg8::gemm_phase<pg8::EpiRes<true>, pg8::MoeOrder<4, false, 1024>, true, true, 512, true>(lds, wave_s, S, E); }
        xcd_barrier(bar);
    }

    { PHASE_IDS(); unsigned char* ws = WSB(); const bf16_t* HB = (const bf16_t*)(ws + WS_HB); const float* SSQ = (const float*)(ws + WS_SSQ); const float* fg = INP(33); float* outp = a.out;
    { f32x4 gq[4];
#pragma unroll
      for (int q = 0; q < 4; ++q) gq[q] = *(const f32x4*)(fg + 256 * q + 4 * lane);
#pragma unroll 1
      for (int t0r = gw * 4; t0r < T; t0r += NGW * 4) {
          float sq = SSQ[(size_t)t0r * 16 + lane]; sq += x_xor1(sq); sq += x_xor2(sq); sq += x_hmir(sq); sq += x_mir(sq);
          u32x2 o[4][4];
#pragma unroll
          for (int j = 0; j < 4; ++j)
#pragma unroll
              for (int q = 0; q < 4; ++q) o[j][q] = *(const u32x2*)(HB + (size_t)(t0r + j) * D + 256 * q + 4 * lane);
#pragma unroll
          for (int j = 0; j < 4; ++j) { const float r = rsqrtf(__builtin_amdgcn_readlane(sq, 16 * j) * (1.0f / D) + EPS); float* orow = outp + (size_t)(t0r + j) * D + 4 * lane;
#pragma unroll
              for (int q = 0; q < 4; ++q) { const u32x2 oo = o[j][q]; const f32x4 g0 = gq[q]; f32x4 w0;
                  w0[0] = __uint_as_float(oo.x << 16) * r * g0[0]; w0[1] = __uint_as_float(oo.x & 0xffff0000u) * r * g0[1]; w0[2] = __uint_as_float(oo.y << 16) * r * g0[2]; w0[3] = __uint_as_float(oo.y & 0xffff0000u) * r * g0[3];
                  *(f32x4*)(orow + 256 * q) = w0; } } } }
}
}

extern "C" void kernel_launch(void* const* d_in, const int* in_sizes, int n_in, void* d_out, int out_size, void* d_ws, size_t ws_size, hipStream_t stream) {
    static int grid = 0;
    if (grid == 0) {
        if (n_in != 34 || in_sizes[0] != T * D || out_size != T * D || ws_size < WS_END) { fprintf(stderr, "kernel_launch: unexpected shapes (n_in %d, ws %zu)\n", n_in, ws_size); grid = -1; return; }
        int dev = 0, cus = 0, per_cu = 0;
        if (hipGetDevice(&dev) != hipSuccess || hipDeviceGetAttribute(&cus, hipDeviceAttributeMultiprocessorCount, dev) != hipSuccess) { grid = -1; return; }
        if (hipFuncSetAttribute((const void*)mega_fwd, hipFuncAttributeMaxDynamicSharedMemorySize, LDS_BYTES) != hipSuccess) { fprintf(stderr, "kernel_launch: hipFuncSetAttribute failed\n"); grid = -1; return; }
        if (hipOccupancyMaxActiveBlocksPerMultiprocessor(&per_cu, (const void*)mega_fwd, 512, LDS_BYTES) != hipSuccess || per_cu < 1) { fprintf(stderr, "kernel_launch: occupancy query says %d\n", per_cu); }
        (void)hipGetLastError();
        grid = cus;
    }
    if (grid < 0) return;
    (void)hipMemsetAsync((char*)d_ws + WS_CTL, 0, CTL_ZERO_BYTES, stream);
    Args a{};
    for (int i = 0; i < 34; ++i) a.in[i] = (const float*)d_in[i];
    a.out = (float*)d_out; a.ws = (unsigned char*)d_ws;
    hipLaunchKernelGGL(mega_fwd, dim3(grid), dim3(512), LDS_BYTES, stream, a);
}
```

```cpp
#include <hip/hip_runtime.h>
#include <cstdio>
#include <cstdint>

#define LAS __attribute__((address_space(3)))
typedef unsigned short bf16_t;
typedef short bf16x8 __attribute__((ext_vector_type(8)));
typedef float f32x4 __attribute__((ext_vector_type(4)));
typedef float f32x2 __attribute__((ext_vector_type(2)));
typedef unsigned u32x4 __attribute__((ext_vector_type(4)));
typedef unsigned u32x2 __attribute__((ext_vector_type(2)));
typedef int i32x4 __attribute__((ext_vector_type(4)));
typedef int i32x8 __attribute__((ext_vector_type(8)));

constexpr int D = 1024, BATCH = 8, SEQ = 8192, T = BATCH * SEQ, DEPTH = 2;
constexpr int AW = 384, BW = 384, CW = 256, HD = 64, ABLK = 128, CHUNK = 64;
constexpr int INC = 1792;
constexpr int ZU = 0, ZV = 384, ZG = 768, ZX = 1152, ZC = 1536, ZGELU_END = 1152;
constexpr int CG = 16, CGD = 16, CS = 64;
constexpr int NE = 16, DE = 512, NCLS = 24;
constexpr float EPS = 1e-6f;
constexpr int UT = 256;
constexpr int NU = T / UT;
constexpr int MAXROWS = T + NCLS * 256;

constexpr size_t MiB = 1u << 20;
constexpr size_t WS_CTL = 0, CTL_ZERO_BYTES = 1 * MiB;
constexpr size_t WS_WIN = 2 * MiB;
constexpr size_t WS_WOUT = 10 * MiB;
constexpr size_t WS_WGLU = 14 * MiB;
constexpr size_t WS_WRG = 15 * MiB;
constexpr size_t WS_WSP = 15 * MiB + 256 * 1024;
constexpr size_t WS_WRT = 15 * MiB + 768 * 1024;
constexpr size_t WS_WGU = 16 * MiB;
constexpr size_t WS_WD8 = 48 * MiB;
constexpr size_t WS_WD2 = 80 * MiB;
constexpr size_t WS_SSQ = 176 * MiB;
constexpr size_t WS_RS = 180 * MiB;
constexpr size_t WS_CLS = WS_RS + 256 * 1024;
constexpr size_t WS_G2 = WS_CLS + 256 * 1024;
constexpr size_t WS_HIST = 181 * MiB;
constexpr size_t WS_CTOT = WS_HIST + 64 * 1024;
constexpr size_t WS_ROWTOK = WS_HIST + 256 * 1024;
constexpr size_t WS_ROWG = 182 * MiB;
constexpr size_t WS_SUMA = 183 * MiB;
constexpr size_t WS_SUMH = 191 * MiB;
constexpr size_t WS_S5 = 184 * MiB;
constexpr size_t WS_SEND = 187 * MiB;
constexpr size_t WS_HB = 192 * MiB;
constexpr size_t WS_Z = 320 * MiB;
constexpr size_t WS_HBS = WS_Z;
constexpr size_t WS_Y = 544 * MiB;
constexpr size_t WS_ACT = 672 * MiB;
constexpr size_t WS_HL = 672 * MiB;
constexpr size_t WS_PP = 736 * MiB;
constexpr size_t WS_SE = 800 * MiB;
constexpr size_t WS_AV = 672 * MiB;
constexpr size_t WS_BV = 768 * MiB;
constexpr size_t WS_SEND2 = 864 * MiB;
constexpr size_t WS_SUMA2 = 866 * MiB;
constexpr size_t WS_SUMH2 = 867 * MiB;
constexpr size_t WS_END = 868 * MiB;
constexpr int CW_BAR = 4096;

constexpr int RING_BYTES = 131072;
constexpr int LDSCTL_OFF = 143360;
constexpr int LDS_PF = 147456;
constexpr int LDS_BYTES = 163840;
constexpr int LW_BAR = 8, LW_TST = 64, LW_HIST = 96, LW_TOT = 128, LW_BASE = 160, LW_CLS = 256  , LW_DEST = 512  , LW_UTAB = 768  , LW_DTAB = 800  ;

__device__ __forceinline__ float bf2f(bf16_t v) { return __uint_as_float(((unsigned)v) << 16); }
__device__ __forceinline__ unsigned cvt_pk_bf16(float lo, float hi) { unsigned r; asm volatile("v_cvt_pk_bf16_f32 %0, %1, %2" : "=v"(r) : "v"(lo), "v"(hi)); return r; }
__device__ __forceinline__ bf16_t f2bf(float v) { return (bf16_t)(cvt_pk_bf16(v, 0.f) & 0xffffu); }
__device__ __forceinline__ unsigned pk_fp8x4(float a, float b, float c, float d) {
    a = fminf(fmaxf(a, -448.f), 448.f); b = fminf(fmaxf(b, -448.f), 448.f); c = fminf(fmaxf(c, -448.f), 448.f); d = fminf(fmaxf(d, -448.f), 448.f);
    int r = __builtin_amdgcn_cvt_pk_fp8_f32(a, b, 0, false); r = __builtin_amdgcn_cvt_pk_fp8_f32(c, d, r, true); return (unsigned)r; }
__device__ __forceinline__ int fresh_lane() { unsigned z = 0u; asm volatile("" : "+s"(z)); return (int)__builtin_amdgcn_mbcnt_hi(~0u, __builtin_amdgcn_mbcnt_lo(~0u, z)); }
__device__ __forceinline__ float x_xor1(float v) { return __int_as_float(__builtin_amdgcn_update_dpp(0, __float_as_int(v), 0xB1, 0xf, 0xf, true)); }
__device__ __forceinline__ float x_xor2(float v) { return __int_as_float(__builtin_amdgcn_update_dpp(0, __float_as_int(v), 0x4E, 0xf, 0xf, true)); }
__device__ __forceinline__ float x_hmir(float v) { return __int_as_float(__builtin_amdgcn_update_dpp(0, __float_as_int(v), 0x141, 0xf, 0xf, true)); }
__device__ __forceinline__ float x_mir(float v) { return __int_as_float(__builtin_amdgcn_update_dpp(0, __float_as_int(v), 0x140, 0xf, 0xf, true)); }
__device__ __forceinline__ float x_xor16(float v) { return __int_as_float(__builtin_amdgcn_ds_swizzle(__float_as_int(v), 0x401F)); }
__device__ __forceinline__ float add_xor32(float v) { const auto r = __builtin_amdgcn_permlane32_swap(__float_as_uint(v), __float_as_uint(v), false, false); return __uint_as_float(r[0]) + __uint_as_float(r[1]); }
__device__ __forceinline__ float add_x16_x32(float v) { v += x_xor16(v); return add_xor32(v); }
__device__ __forceinline__ float wave_sum(float v) { v += x_xor1(v); v += x_xor2(v); v += x_hmir(v); v += x_mir(v); v += x_xor16(v); return add_xor32(v); }
__device__ __forceinline__ float gelu_fast(float x) {
    const float u2 = 1.5957691216057308f * (x + 0.044715f * x * x * x);
    const float e = __builtin_amdgcn_exp2f(-1.4426950408889634f * u2);
    return x * __builtin_amdgcn_rcpf(1.0f + e);
}
__device__ __forceinline__ float sigmoid_fast(float x) { return __builtin_amdgcn_rcpf(1.0f + __builtin_amdgcn_exp2f(-1.4426950408889634f * x)); }
__device__ __forceinline__ float sigmoid_f(float x) { return 1.0f / (1.0f + expf(-x)); }
__device__ __forceinline__ int pair_lo(int pi) { return pi < 3 ? 0 : (pi < 5 ? 1 : 2); }
__device__ __forceinline__ int pair_hi(int pi) { return pi < 3 ? pi + 1 : (pi < 5 ? pi - 1 : 3); }
__device__ __forceinline__ int pair_idx(int lo, int hi) { return lo == 0 ? hi - 1 : (lo == 1 ? hi + 1 : 5); }

#define XB_TMO      128
#define XB_XCNT(j)  (256  + 64 * (j))
#define XB_XSUB(j)  (1280 + 64 * (j))
#define XB_XGEN(j)  (2304 + 64 * (j))
#define XB_TOP      3328
#define XB_TOPGEN   3392
#define XCD_BAR_WORDS 3456
#define XB_SPIN_CAP (1u << 18)
__device__ __forceinline__ unsigned xb_ld(unsigned* p)              { return __hip_atomic_load(p, __ATOMIC_RELAXED, __HIP_MEMORY_SCOPE_AGENT); }
__device__ __forceinline__ unsigned xb_add(unsigned* p, unsigned v) { return __hip_atomic_fetch_add(p, v, __ATOMIC_RELAXED, __HIP_MEMORY_SCOPE_AGENT); }
__device__ __forceinline__ unsigned xb_xcc_id() { return (unsigned)__builtin_amdgcn_s_getreg((3 << 11) | 20) & 0xFu; }
#define XB_SPIN(cond, bar) do { unsigned _sp = 0; while (cond) { __builtin_amdgcn_s_sleep(1); \
    if ((++_sp & 255u) == 0u) { if (xb_ld(&(bar)[XB_TMO])) break; if (_sp > XB_SPIN_CAP) { atomicAdd(&(bar)[XB_TMO], 1u); break; } } } } while (0)
struct XcdBarrier { unsigned* bar; unsigned x; volatile LAS unsigned* st; };
__device__ __forceinline__ XcdBarrier xcd_barrier_post(unsigned* bar, volatile LAS unsigned* st) {
    XcdBarrier b; b.bar = bar; b.x = xb_xcc_id(); b.st = st;
    if (threadIdx.x == 0) (void)xb_add(&bar[XB_XCNT(b.x)], 1u);
    return b;
}
__device__ __forceinline__ void xcd_barrier_complete(unsigned* bar, unsigned x, unsigned& nloc, unsigned& nx) {
    const unsigned G = gridDim.x * gridDim.y * gridDim.z;
    unsigned sum, cnt, mine, sp = 0u;
    for (;;) {
        sum = 0u; cnt = 0u; mine = 0u;
#pragma unroll
        for (unsigned j = 0; j < 16; ++j) { const unsigned c = xb_ld(&bar[XB_XCNT(j)]); sum += c; cnt += (c > 0u) ? 1u : 0u; mine = (j == x) ? c : mine; }
        if (sum == G) break;
        __builtin_amdgcn_s_sleep(1);
        if ((++sp & 255u) == 0u) { if (xb_ld(&bar[XB_TMO])) break; if (sp > XB_SPIN_CAP) { atomicAdd(&bar[XB_TMO], 1u); break; } }
    }
    nloc = mine > 0u ? mine : 1u; nx = cnt > 0u ? cnt : 1u;
}
__device__ __forceinline__ void xcd_barrier(const XcdBarrier& b) {
    asm volatile("s_waitcnt vmcnt(0)" ::: "memory");
    __syncthreads();
    if (threadIdx.x == 0) {
        unsigned* bar = b.bar; asm volatile("" : "+s"(bar));
        __builtin_amdgcn_s_waitcnt(0);
        unsigned bx0 = b.x; asm volatile("" : "+s"(bx0));
        unsigned nloc = b.st[0], nx = b.st[1];
        if (nloc == 0u) { xcd_barrier_complete(bar, bx0, nloc, nx); b.st[0] = nloc; b.st[1] = nx; }
        unsigned bx = b.x; asm volatile("" : "+s"(bx));
        const unsigned old = xb_add(&bar[XB_XSUB(bx)], 1u);
        const unsigned gen = old / nloc;
        if (old + 1u == (gen + 1u) * nloc) {
            __builtin_amdgcn_fence(__ATOMIC_RELEASE, "agent");
            asm volatile("s_waitcnt vmcnt(0)" ::: "memory");
            const unsigned og = xb_add(&bar[XB_TOP], 1u);
            const unsigned tg = og / nx;
            if (og + 1u == (tg + 1u) * nx) xb_add(&bar[XB_TOPGEN], 1u);
            else XB_SPIN(xb_ld(&bar[XB_TOPGEN]) == tg, bar);
            __builtin_amdgcn_fence(__ATOMIC_ACQUIRE, "agent");
            xb_add(&bar[XB_XGEN(bx)], 1u);
            asm volatile("s_waitcnt vmcnt(0)" ::: "memory");
        } else {
            XB_SPIN(xb_ld(&bar[XB_XGEN(bx)]) == gen, bar);
            __builtin_amdgcn_fence(__ATOMIC_ACQUIRE, "agent");
            asm volatile("s_waitcnt vmcnt(0)" ::: "memory");
        }
    }
    __syncthreads();
}

namespace pg8 {
#define PG8_LAS __attribute__((address_space(3)))
constexpr int BM = 256, BK = 64, HALF = 128, HTB = HALF * BK * 2, STAGE_BYTES = 8 * HTB, NXCD = 8, WGM = 4;
__host__ __device__ __forceinline__ int lds_byte(int r, int c) { const int st = (r >> 4) * 2 + (c >> 5), rr = r & 15, cc = c & 31, ob = rr * 64 + cc * 2; return st * 1024 + (ob ^ (((ob >> 9) & 1) << 5)); }
__host__ __device__ __forceinline__ void stage_rc(int b, int& R, int& C) { const int st = b / 1024, sb = b % 1024, swz = sb ^ (((sb >> 9) & 1) << 5); R = (st >> 1) * 16 + swz / 64; C = (st & 1) * 32 + (swz % 64) / 2; }
__host__ __device__ __forceinline__ int perm32(int rho) { const int n = rho >> 4, i = rho & 15; return 8 * (i >> 2) + 4 * n + (i & 3); }
struct Unit { int pm, pn; const char* A; const char* B; };

template <int M_, int NN> struct PanelOrder {
    static constexpr int nM = M_ / BM; static constexpr size_t tstep = (size_t)BM * 1024 * 2;
    int G, c; const char* A; const char* Bt;
    __device__ void init(const void* A_, const void* Bt_, int G_, int c_) { G = G_; c = c_; A = (const char*)A_; Bt = (const char*)Bt_; }
    __device__ bool next(int i, Unit& u) const { const int pm = c + (i / NN) * G; if (pm >= nM) return false; u.pm = pm; u.pn = i % NN; u.A = A + (size_t)pm * tstep; u.B = Bt + (size_t)u.pn * tstep; return true; }
    __device__ __forceinline__ void a_ready(const Unit&) const {}
    __device__ __forceinline__ void done(const Unit&) const {}
};
template <int M_, int N_> struct StaticOrder {
    static constexpr int nM = M_ / BM, nN = N_ / BM, nwg = nM * nN; static constexpr size_t tstep = (size_t)BM * 1024 * 2;
    int G, c; const char* A; const char* Bt;
    __device__ void init(const void* A_, const void* Bt_, int G_, int c_) { G = G_; c = c_; A = (const char*)A_; Bt = (const char*)Bt_; }
    __device__ bool next(int i, Unit& u) const {
        const long L = (long)i * G + c; if (L >= nwg) return false;
        int wgid = (int)L; { constexpr int q = nwg / NXCD, r = nwg % NXCD; const int xcd = wgid % NXCD, off = wgid / NXCD; wgid = (xcd < r ? xcd * (q + 1) : r * (q + 1) + (xcd - r) * q) + off; }
        constexpr int nig = WGM * nN; const int gid = wgid / nig, fm = gid * WGM, gsz = (nM - fm) < WGM ? (nM - fm) : WGM;
        u.pm = fm + ((wgid % nig) % gsz); u.pn = (wgid % nig) / gsz; u.A = A + (size_t)u.pm * tstep; u.B = Bt + (size_t)u.pn * tstep; return true;
    }
    __device__ __forceinline__ void a_ready(const Unit&) const {}
    __device__ __forceinline__ void done(const Unit&) const {}
};
template <class Epi, class Sched, bool ALIGN_EPI = false, bool SP2 = false, int KB = 1024, bool FP8 = false>
__device__ __forceinline__ void gemm_phase(PG8_LAS unsigned char* lds, const int wave_s, const Sched& S, const Epi& E) { const int Kdim = 0;
    const int lane = fresh_lane(), wid = wave_s, tid = wid * 64 + lane, wr = wid >> 2, wc = wid & 3, fr = lane & 15, fq = lane >> 4;
    constexpr int K = KB, nt = K / BK; (void)Kdim;
    unsigned voffA, voffB;
    { int R, C; stage_rc(tid * 16, R, C); const int Rb = Epi::PERM ? ((R & ~31) + perm32(R & 31)) : R; voffA = (unsigned)(R * K + C) * 2u; voffB = (unsigned)(Rb * K + C) * 2u; }
    constexpr size_t kstep = (size_t)(BK * 2);
    constexpr size_t hstep = (size_t)HALF * K * 2;
    constexpr size_t tstep = 2 * hstep; (void)tstep;
    const unsigned ldsw = (unsigned)wid * 1024u; const unsigned ldsb = (unsigned)(size_t)lds + ldsw;
    const int aoff = lds_byte(wr * 64 + fr, fq * 8), boff = lds_byte(wc * 32 + fr, fq * 8);
#define PG8_SA(b, h) (((b) * 2 + (h)) * HTB)
#define PG8_SB(b, h) ((4 + (b) * 2 + (h)) * HTB)
#define PG8_STAGE(bufoff, gbase, voff) do { _Pragma("unroll") for (int _i = 0; _i < 2; ++_i) { unsigned _keep; \
        asm volatile("s_mov_b32 %0, m0\n\ts_mov_b32 m0, %3\n\ts_nop 0\n\tglobal_load_lds_dwordx4 %1, %2\n\ts_mov_b32 m0, %0" : "=&s"(_keep) \
            : "v"(voff), "s"((const char*)(gbase) + (size_t)_i * (64 * K * 2)), "s"(ldsb + (unsigned)((bufoff) + _i * 8192)) : "memory"); } } while (0)
#define PG8_LDA(dst, b, h) do { if constexpr (FP8) { _Pragma("unroll") for (int m = 0; m < 4; ++m) { const i32x4 _lo = *(const PG8_LAS i32x4*)(lds + PG8_SA(b, h) + aoff + m * 2048), _hi = *(const PG8_LAS i32x4*)(lds + PG8_SA(b, h) + aoff + m * 2048 + 1024); \
            dst##8[m] = __builtin_shufflevector(_lo, _hi, 0, 1, 2, 3, 4, 5, 6, 7); } } \
        else { _Pragma("unroll") for (int m = 0; m < 4; ++m) _Pragma("unroll") for (int k = 0; k < 2; ++k) dst[m][k] = *(const PG8_LAS bf16x8*)(lds + PG8_SA(b, h) + aoff + m * 2048 + k * 1024); } } while (0)
#define PG8_LDB(dst, b, h) do { if constexpr (FP8) { _Pragma("unroll") for (int n = 0; n < 2; ++n) { const i32x4 _lo = *(const PG8_LAS i32x4*)(lds + PG8_SB(b, h) + boff + n * 2048), _hi = *(const PG8_LAS i32x4*)(lds + PG8_SB(b, h) + boff + n * 2048 + 1024); \
            dst##8[n] = __builtin_shufflevector(_lo, _hi, 0, 1, 2, 3, 4, 5, 6, 7); } } \
        else { _Pragma("unroll") for (int n = 0; n < 2; ++n) _Pragma("unroll") for (int k = 0; k < 2; ++k) dst[n][k] = *(const PG8_LAS bf16x8*)(lds + PG8_SB(b, h) + boff + n * 2048 + k * 1024); } } while (0)
#define PG8_MMA(ai, bj, At, Bt) do { __builtin_amdgcn_s_setprio(1); \
        if constexpr (FP8) { _Pragma("unroll") for (int m = 0; m < 4; ++m) _Pragma("unroll") for (int n = 0; n < 2; ++n) \
            acc[ai][bj][m][n] = __builtin_amdgcn_mfma_scale_f32_16x16x128_f8f6f4(Bt##8[n], At##8[m], acc[ai][bj][m][n], 0, 0, 0, Epi::SCALE_W, 0, Epi::SCALE_A); } \
        else { _Pragma("unroll") for (int m = 0; m < 4; ++m) _Pragma("unroll") for (int n = 0; n < 2; ++n) _Pragma("unroll") for (int k = 0; k < 2; ++k) \
            acc[ai][bj][m][n] = __builtin_amdgcn_mfma_f32_16x16x32_bf16(Bt[n][k], At[m][k], acc[ai][bj][m][n], 0, 0, 0); } \
        __builtin_amdgcn_s_setprio(0); } while (0)
#define PG8_WAIT_V(n) asm volatile("s_waitcnt vmcnt(" #n ")" ::: "memory")
#define PG8_WAIT_L(n) asm volatile("s_waitcnt lgkmcnt(" #n ")" ::: "memory")
#define PG8_BAR __builtin_amdgcn_s_barrier()
#define PG8_SCHED __builtin_amdgcn_sched_barrier(0)
    Unit cur, nxt; int ui = 0;
    if (!S.next(0, cur)) return;
    f32x4 acc[2][2][4][2];
#pragma unroll
    for (int a = 0; a < 2; ++a)
#pragma unroll
        for (int b = 0; b < 2; ++b)
#pragma unroll
            for (int m = 0; m < 4; ++m)
#pragma unroll
                for (int n = 0; n < 2; ++n) acc[a][b][m][n] = (f32x4){0.f, 0.f, 0.f, 0.f};
    bf16x8 At[4][2], B0[2][2], B1[2][2]; i32x8 At8[4], B08[2], B18[2]; (void)At; (void)B0; (void)B1; (void)At8; (void)B08; (void)B18;
    const char* cA = cur.A; const char* cB = cur.B;
    S.a_ready(cur);
    if constexpr (SP2) {
        PG8_STAGE(PG8_SB(0, 0), cB, voffB); PG8_STAGE(PG8_SB(0, 1), cB + hstep, voffB); PG8_STAGE(PG8_SA(0, 0), cA, voffA); PG8_STAGE(PG8_SA(0, 1), cA + hstep, voffA);
        if (wr == 1) PG8_BAR;
        PG8_WAIT_V(2); PG8_BAR;
        PG8_STAGE(PG8_SB(1, 0), cB + kstep, voffB); PG8_STAGE(PG8_SA(1, 0), cA + kstep, voffA); PG8_STAGE(PG8_SB(1, 1), cB + hstep + kstep, voffB);
        PG8_WAIT_V(6); PG8_BAR;
    } else {
        PG8_STAGE(PG8_SB(0, 0), cB, voffB); PG8_STAGE(PG8_SA(0, 0), cA, voffA); PG8_STAGE(PG8_SB(0, 1), cB + hstep, voffB); PG8_STAGE(PG8_SA(0, 1), cA + hstep, voffA);
        if (wr == 1) PG8_BAR;
        PG8_WAIT_V(4); PG8_BAR;
        PG8_STAGE(PG8_SB(1, 0), cB + kstep, voffB); PG8_STAGE(PG8_SA(1, 0), cA + kstep, voffA); PG8_STAGE(PG8_SB(1, 1), cB + hstep + kstep, voffB);
        PG8_WAIT_V(6); PG8_BAR;
    }
    for (;;) {
        const bool has_next = S.next(ui + 1, nxt);
        const char* nA = has_next ? nxt.A : cA; const char* nB = has_next ? nxt.B : cB;
_Pragma("unroll 1")
        for (int t = 0; t < nt; t += 2) {
            const bool last = (t == nt - 2);
            const char* a1 = cA + (size_t)(t + 1) * kstep;
            const char* a2 = last ? nA : cA + (size_t)(t + 2) * kstep; const char* b2 = last ? nB : cB + (size_t)(t + 2) * kstep;
            const char* a3 = a2 + kstep; const char* b3 = b2 + kstep;
            if (last && has_next) S.a_ready(nxt);
            if constexpr (Epi::PF) { if (t == 2) E.prefetch(cur, (unsigned)(size_t)lds + (unsigned)LDS_PF, wid); }
            if constexpr (SP2) {
            PG8_LDB(B0, 0, 0); PG8_LDB(B1, 0, 1); PG8_SCHED; PG8_LDA(At, 0, 0); PG8_STAGE(PG8_SA(1, 1), a1 + hstep, voffA);
            PG8_WAIT_V(8); PG8_WAIT_L(0); PG8_BAR; PG8_MMA(0, 0, At, B0); PG8_MMA(0, 1, At, B1); PG8_BAR; PG8_SCHED;
            PG8_LDA(At, 0, 1); PG8_STAGE(PG8_SB(0, 0), b2, voffB); PG8_STAGE(PG8_SB(0, 1), b2 + hstep, voffB); PG8_STAGE(PG8_SA(0, 0), a2, voffA);
            PG8_WAIT_V(8); PG8_WAIT_L(0); PG8_BAR; PG8_MMA(1, 0, At, B0); PG8_MMA(1, 1, At, B1); PG8_BAR; PG8_SCHED;
            PG8_LDB(B0, 1, 0); PG8_LDB(B1, 1, 1); PG8_SCHED; PG8_LDA(At, 1, 0); PG8_STAGE(PG8_SA(0, 1), a2 + hstep, voffA);
            PG8_WAIT_V(8); PG8_WAIT_L(0); PG8_BAR; PG8_MMA(0, 0, At, B0); PG8_MMA(0, 1, At, B1); PG8_BAR; PG8_SCHED;
            PG8_LDA(At, 1, 1); PG8_STAGE(PG8_SB(1, 0), b3, voffB); PG8_STAGE(PG8_SB(1, 1), b3 + hstep, voffB); PG8_STAGE(PG8_SA(1, 0), a3, voffA);
            PG8_WAIT_V(8); PG8_WAIT_L(0); PG8_BAR; PG8_MMA(1, 0, At, B0); PG8_MMA(1, 1, At, B1); PG8_BAR; PG8_SCHED;
            } else {
            PG8_LDB(B0, 0, 0); PG8_SCHED; PG8_LDA(At, 0, 0); PG8_STAGE(PG8_SA(1, 1), a1 + hstep, voffA);
            PG8_WAIT_L(8); PG8_BAR; PG8_WAIT_L(0); PG8_MMA(0, 0, At, B0); PG8_BAR; PG8_SCHED;
            PG8_LDB(B1, 0, 1); PG8_STAGE(PG8_SB(0, 0), b2, voffB);
            PG8_BAR; PG8_WAIT_L(0); PG8_MMA(0, 1, At, B1); PG8_BAR;
            PG8_LDA(At, 0, 1); PG8_STAGE(PG8_SA(0, 0), a2, voffA);
            PG8_BAR; PG8_WAIT_L(0); PG8_MMA(1, 0, At, B0); PG8_BAR; PG8_SCHED;
            PG8_STAGE(PG8_SB(0, 1), b2 + hstep, voffB);
            PG8_WAIT_V(6); PG8_BAR; PG8_MMA(1, 1, At, B1); PG8_BAR;
            PG8_LDB(B0, 1, 0); PG8_SCHED; PG8_LDA(At, 1, 0); PG8_STAGE(PG8_SA(0, 1), a2 + hstep, voffA);
            PG8_WAIT_L(8); PG8_BAR; PG8_WAIT_L(0); PG8_MMA(0, 0, At, B0); PG8_BAR; PG8_SCHED;
            PG8_LDB(B1, 1, 1); PG8_STAGE(PG8_SB(1, 0), b3, voffB);
            PG8_BAR; PG8_WAIT_L(0); PG8_MMA(0, 1, At, B1); PG8_BAR;
            PG8_LDA(At, 1, 1); PG8_STAGE(PG8_SA(1, 0), a3, voffA);
            PG8_BAR; PG8_WAIT_L(0); PG8_MMA(1, 0, At, B0); PG8_BAR; PG8_SCHED;
            PG8_STAGE(PG8_SB(1, 1), b3 + hstep, voffB);
            PG8_WAIT_V(6); PG8_BAR; PG8_MMA(1, 1, At, B1); PG8_BAR;
            }
        }
        if constexpr (ALIGN_EPI) { if (wr == 0) PG8_BAR; }
        if constexpr (!Epi::AFTER_DRAIN) { E(acc, cur, wr, wc, fr, fq); S.done(cur); }
        if (!has_next) break;
#pragma unroll
        for (int a = 0; a < 2; ++a)
#pragma unroll
            for (int b = 0; b < 2; ++b)
#pragma unroll
                for (int m = 0; m < 4; ++m)
#pragma unroll
                    for (int n = 0; n < 2; ++n) acc[a][b][m][n] = (f32x4){0.f, 0.f, 0.f, 0.f};
        cur = nxt; cA = nA; cB = nB; ++ui;
        if constexpr (ALIGN_EPI) { if (wr == 1) PG8_BAR; }
    }
    PG8_WAIT_V(0);
    if constexpr (!ALIGN_EPI) { if (wr == 0) PG8_BAR; }
    PG8_BAR;
    if constexpr (Epi::AFTER_DRAIN) { E.fused(acc, cur, wr, wc, fr, fq, lds, wid, lane); S.done(cur); }
#undef PG8_SA
#undef PG8_SB
#undef PG8_STAGE
#undef PG8_LDA
#undef PG8_LDB
#undef PG8_MMA
#undef PG8_WAIT_V
#undef PG8_WAIT_L
#undef PG8_BAR
#undef PG8_SCHED
}

template <int NP, bool UP, int ROWB> struct MoeOrder {
    const volatile LAS int* tab; int layer; const char* A; const char* W;
    __device__ bool next(int i, Unit& u) const {
        const int e = tab[i]; if (e < 0) return false;
        const int mt = e & 0xffff, pn = (e >> 16) & 0xff, cls = e >> 24;
        u.pm = mt; u.pn = pn; u.A = A + (size_t)mt * ((size_t)BM * ROWB);
        if (UP) { const int g = cls / 6, pi = cls % 6, s = pn >> 2, ex = g * 4 + (s ? pair_hi(pi) : pair_lo(pi));
            u.B = W + ((size_t)(layer * NE + ex) * 1024 + (size_t)(pn & 3) * 256) * ROWB; }
        else u.B = W + ((size_t)(layer * NCLS + cls) * 1024 + (size_t)pn * 256) * ROWB;
        return true;
    }
    __device__ __forceinline__ void a_ready(const Unit&) const {}
    __device__ __forceinline__ void done(const Unit&) const {}
};

struct EpiZ {
    static constexpr bool PERM = true, AFTER_DRAIN = false, PF = true;
    bf16_t* Z; const float* ssq; const PG8_LAS unsigned char* pf;
    __device__ __forceinline__ void prefetch(const Unit& u, unsigned lds_addr, int wid) const {
        const char* g = (const char*)(ssq + (size_t)u.pm * BM * 16) + wid * 1024; const unsigned vo = (unsigned)fresh_lane() * 16u;
#pragma unroll
        for (int i = 0; i < 2; ++i) { unsigned keep;
            asm volatile("s_mov_b32 %0, m0\n\ts_mov_b32 m0, %3\n\ts_nop 0\n\tglobal_load_lds_dwordx4 %1, %2\n\ts_mov_b32 m0, %0" : "=&s"(keep) : "v"(vo), "s"(g + i * 8192), "s"(lds_addr + (unsigned)(wid * 1024 + i * 8192)) : "memory"); } }
    __device__ __forceinline__ void operator()(const f32x4 (&acc)[2][2][4][2], const Unit& u, int wr, int wc, int fr, int fq) const {
        { const int ln_ = fresh_lane(); fr = ln_ & 15; fq = ln_ >> 4; }
        const int row0 = u.pm * BM + wr * 64 + fr, col0 = u.pn * BM + wc * 32 + 8 * fq;
        float rr[2][4];
#pragma unroll
        for (int ai = 0; ai < 2; ++ai) {
            f32x4 sp[4];
#pragma unroll
            for (int m = 0; m < 4; ++m) sp[m] = *(const PG8_LAS f32x4*)(pf + (ai * HALF + wr * 64 + m * 16 + fr) * 64 + 16 * fq);
#pragma unroll
            for (int m = 0; m < 4; ++m) { float t = (sp[m][0] + sp[m][1]) + (sp[m][2] + sp[m][3]); t = add_x16_x32(t); rr[ai][m] = __builtin_amdgcn_rsqf(t * (1.0f / D) + EPS); }
        }
#pragma unroll
        for (int ai = 0; ai < 2; ++ai)
#pragma unroll
            for (int m = 0; m < 4; ++m) { const int row = row0 + ai * HALF + m * 16; const float r = rr[ai][m];
                bf16_t* rowp = Z + (size_t)row * INC + col0;
#pragma unroll
                for (int bj = 0; bj < 2; ++bj) { f32x4 v0 = acc[ai][bj][m][0] * r, v1 = acc[ai][bj][m][1] * r;
                    u32x4 w; w.x = cvt_pk_bf16(v0[0], v0[1]); w.y = cvt_pk_bf16(v0[2], v0[3]); w.z = cvt_pk_bf16(v1[0], v1[1]); w.w = cvt_pk_bf16(v1[2], v1[3]);
                    *(u32x4*)(rowp + bj * HALF) = w; } }
    }
};
template <bool SCATTER> struct EpiRes {
    static constexpr bool PERM = true, AFTER_DRAIN = false, PF = SCATTER; static constexpr int SCALE_W = 0x7b7b7b7b, SCALE_A = 0x7b7b7b7b;
    bf16_t* H; float* ssq; const int* rowtok; const PG8_LAS unsigned char* pf;
    __device__ __forceinline__ void prefetch(const Unit& u, unsigned lds_addr, int wid) const {
        if (wid < 4) { const char* g = (const char*)(rowtok + (size_t)u.pm * BM) + wid * 256; const unsigned vo = (unsigned)fresh_lane() * 4u; unsigned keep;
            asm volatile("s_mov_b32 %0, m0\n\ts_mov_b32 m0, %3\n\ts_nop 0\n\tglobal_load_lds_dword %1, %2\n\ts_mov_b32 m0, %0" : "=&s"(keep) : "v"(vo), "s"(g), "s"(lds_addr + (unsigned)(wid * 256)) : "memory"); } }
    __device__ __forceinline__ void operator()(const f32x4 (&acc)[2][2][4][2], const Unit& u, int wr, int wc, int fr, int fq) const {
        { const int ln_ = fresh_lane(); fr = ln_ & 15; fq = ln_ >> 4; }
        const int row0 = u.pm * BM + wr * 64 + fr, col0 = u.pn * BM + wc * 32 + 8 * fq;
        int tokv[2][4];
#pragma unroll
        for (int ai = 0; ai < 2; ++ai)
#pragma unroll
            for (int m = 0; m < 4; ++m) { const int row = row0 + ai * HALF + m * 16; tokv[ai][m] = SCATTER ? *(const PG8_LAS int*)(pf + (ai * HALF + wr * 64 + m * 16 + fr) * 4) : row; }
#pragma unroll
        for (int ai = 0; ai < 2; ++ai) {
            u32x4 o[4][2];
#pragma unroll
            for (int m = 0; m < 4; ++m) { const int tok = tokv[ai][m]; const bf16_t* rowp = H + (size_t)(tok < 0 ? 0 : tok) * D + col0; o[m][0] = *(const u32x4*)(rowp); o[m][1] = *(const u32x4*)(rowp + HALF); }
#pragma unroll
            for (int m = 0; m < 4; ++m) { const int tok = tokv[ai][m]; float s = 0.f; bf16_t* rowp = H + (size_t)(tok < 0 ? 0 : tok) * D + col0;
#pragma unroll
                for (int bj = 0; bj < 2; ++bj) { const u32x4 oo = o[m][bj];
                    f32x4 v0 = acc[ai][bj][m][0], v1 = acc[ai][bj][m][1];
                    v0[0] += __uint_as_float(oo.x << 16); v0[1] += __uint_as_float(oo.x & 0xffff0000u); v0[2] += __uint_as_float(oo.y << 16); v0[3] += __uint_as_float(oo.y & 0xffff0000u);
                    v1[0] += __uint_as_float(oo.z << 16); v1[1] += __uint_as_float(oo.z & 0xffff0000u); v1[2] += __uint_as_float(oo.w << 16); v1[3] += __uint_as_float(oo.w & 0xffff0000u);
                    s += (v0[0] * v0[0] + v0[1] * v0[1]) + (v0[2] * v0[2] + v0[3] * v0[3]) + (v1[0] * v1[0] + v1[1] * v1[1]) + (v1[2] * v1[2] + v1[3] * v1[3]);
                    u32x4 w; w.x = cvt_pk_bf16(v0[0], v0[1]); w.y = cvt_pk_bf16(v0[2], v0[3]); w.z = cvt_pk_bf16(v1[0], v1[1]); w.w = cvt_pk_bf16(v1[2], v1[3]);
                    if (tok >= 0) *(u32x4*)(rowp + bj * HALF) = w; }
                s = add_x16_x32(s);
                if (fq == 0 && tok >= 0) ssq[(size_t)tok * 16 + u.pn * 4 + wc] = s; }
            asm volatile("" ::: "memory"); }
    }
};
constexpr int SC_W = 0x7b7b7b7b, SC_H = 0x7b7b7b7b, SC_ACT = 0x7b7b7b7b;
constexpr float FS_W = 16.f, FS_H = 16.f, FS_ACT = 16.f;
struct EpiUp {
    static constexpr bool PERM = true, AFTER_DRAIN = false, PF = true; static constexpr int SCALE_W = SC_W, SCALE_A = SC_H;
    unsigned char* ACT; const float* rowg; const PG8_LAS unsigned char* pf;
    __device__ __forceinline__ void prefetch(const Unit& u, unsigned lds_addr, int wid) const {
        const char* g = (const char*)(rowg + (size_t)u.pm * BM * 2) + wid * 256; const unsigned vo = (unsigned)fresh_lane() * 4u; unsigned keep;
        asm volatile("s_mov_b32 %0, m0\n\ts_mov_b32 m0, %3\n\ts_nop 0\n\tglobal_load_lds_dword %1, %2\n\ts_mov_b32 m0, %0" : "=&s"(keep) : "v"(vo), "s"(g), "s"(lds_addr + (unsigned)(wid * 256)) : "memory"); }
    __device__ __forceinline__ void operator()(const f32x4 (&acc)[2][2][4][2], const Unit& u, int wr, int wc, int fr, int fq) const {
        { const int ln_ = fresh_lane(); fr = ln_ & 15; fq = ln_ >> 4; }
        const int row0 = u.pm * BM + wr * 64 + fr, s = u.pn >> 2, col0 = s * 512 + (u.pn & 3) * 128 + wc * 32 + 8 * fq;
        float gt[2][4];
#pragma unroll
        for (int ai = 0; ai < 2; ++ai)
#pragma unroll
            for (int m = 0; m < 4; ++m) gt[ai][m] = *(const PG8_LAS float*)(pf + ((ai * HALF + wr * 64 + m * 16 + fr) * 2 + s) * 4);
#pragma unroll
        for (int ai = 0; ai < 2; ++ai)
#pragma unroll
            for (int m = 0; m < 4; ++m) { const int row = row0 + ai * HALF + m * 16; const float g1 = gt[ai][m];
                float o[8];
#pragma unroll
                for (int n = 0; n < 2; ++n)
#pragma unroll
                    for (int j = 0; j < 4; ++j) { const float g = acc[ai][0][m][n][j], up = acc[ai][1][m][n][j]; o[n * 4 + j] = g * sigmoid_fast(g) * up * g1; }
                u32x2 w; w.x = pk_fp8x4(o[0] * FS_ACT, o[1] * FS_ACT, o[2] * FS_ACT, o[3] * FS_ACT); w.y = pk_fp8x4(o[4] * FS_ACT, o[5] * FS_ACT, o[6] * FS_ACT, o[7] * FS_ACT);
                *(u32x2*)(ACT + (size_t)row * 1024 + col0) = w; }
    }
};
}

__device__ __forceinline__ void tr_item(const float* W, int ldw, int k0, int scol0, const float* gk, bf16_t* WT, int ldo, int drow0, int dk0, LAS float* scr, int lane) {
#pragma unroll 8
    for (int i = 0; i < 32; ++i) { const int kk = 2 * i + (lane >> 5); float v = W[(size_t)(k0 + kk) * ldw + scol0 + (lane & 31)]; if (gk) v *= gk[k0 + kk]; scr[kk * 33 + (lane & 31)] = v; }
    asm volatile("s_waitcnt lgkmcnt(0)" ::: "memory");
    const int c = lane & 7;
#pragma unroll
    for (int j = 0; j < 4; ++j) { const int n = (lane >> 3) + 8 * j; const LAS float* s = scr + (8 * c) * 33 + n;
        u32x4 o; o.x = cvt_pk_bf16(s[0 * 33], s[1 * 33]); o.y = cvt_pk_bf16(s[2 * 33], s[3 * 33]); o.z = cvt_pk_bf16(s[4 * 33], s[5 * 33]); o.w = cvt_pk_bf16(s[6 * 33], s[7 * 33]);
        *(u32x4*)(WT + (size_t)(drow0 + n) * ldo + dk0 + 8 * c) = o; }
    asm volatile("s_waitcnt lgkmcnt(0)" ::: "memory");
}

constexpr size_t S5_L_STRIDE = 1310720, S5_KT = 0, S5_ET = 131072, S5_FT = 655360, S5_LAMP = 1179648;
constexpr int S5_WSCR = 8192, S5_YST = 65536, YST_LD = 264;
constexpr int NU128 = T / 128, UPB128 = SEQ / 128;
__device__ __forceinline__ f32x4 mfma16(bf16x8 a, bf16x8 b, f32x4 c) { return __builtin_amdgcn_mfma_f32_16x16x32_bf16(a, b, c, 0, 0, 0); }

__device__ __forceinline__ void s5_kt_pair(int g, int c, int cp, const float* a_re, const float* a_im, const float* log_dt, const float* b_re, const float* b_im,
                                           const float* c_re, const float* c_im, const float* dvec, unsigned char* tab) {
    const float dt = __expf(log_dt[g]); float km[8];
#pragma unroll
    for (int d = 0; d < 8; ++d) km[d] = 0.f;
#pragma unroll 2
    for (int p = 0; p < CS; ++p) { const float lr = a_re[g * CS + p], li = a_im[g * CS + p], zr = lr * dt, zi = li * dt;
        const float sh = __sinf(0.5f * zi), cz = __cosf(zi), sz = __sinf(zi), ez = __expf(zr); const float nr = expm1f(zr) * cz - 2.0f * sh * sh, ni = ez * sz, den = lr * lr + li * li;
        const float cr = (nr * lr + ni * li) / den, ci = (ni * lr - nr * li) / den;
        const float br = b_re[((size_t)g * CS + p) * CGD + cp], bi = b_im[((size_t)g * CS + p) * CGD + cp]; const float bbr = cr * br - ci * bi, bbi = cr * bi + ci * br;
        const float cre = c_re[((size_t)g * CGD + c) * CS + p], cim = c_im[((size_t)g * CGD + c) * CS + p];
        float vr = cre * bbr - cim * bbi, vi = cre * bbi + cim * bbr;
        const float lbr = ez * cz, lbi = ez * sz;
#pragma unroll
        for (int d = 0; d < 8; ++d) { km[d] += vr; const float t = vr * lbr - vi * lbi; vi = vr * lbi + vi * lbr; vr = t; } }
    if (c == cp) km[0] += dvec[g * CGD + c];
    bf16_t* kt = (bf16_t*)(tab + S5_KT) + (size_t)g * 4096;
#pragma unroll
    for (int dd = 0; dd < 8; ++dd) { kt[(dd * 16 + c) * 32 + cp] = f2bf(km[dd]); kt[(dd * 16 + c) * 32 + 16 + cp] = dd >= 1 ? f2bf(km[dd - 1]) : (bf16_t)0; }
}
__device__ __forceinline__ void s5_et_task(int g, int ri, int p, int cp, const float* a_re, const float* a_im, const float* log_dt, const float* b_re, const float* b_im, unsigned char* tab) {
    const float dt = __expf(log_dt[g]); const float lr = a_re[g * CS + p], li = a_im[g * CS + p], zr = lr * dt, zi = li * dt;
    const float sh = __sinf(0.5f * zi), cz = __cosf(zi), sz = __sinf(zi), ez = __expf(zr); const float nr = expm1f(zr) * cz - 2.0f * sh * sh, ni = ez * sz, den = lr * lr + li * li;
    const float cr = (nr * lr + ni * li) / den, ci = (ni * lr - nr * li) / den;
    const float br = b_re[((size_t)g * CS + p) * CGD + cp], bi = b_im[((size_t)g * CS + p) * CGD + cp]; float vr = cr * br - ci * bi, vi = cr * bi + ci * br;
    const float lbr = ez * cz, lbi = ez * sz; bf16_t* et = (bf16_t*)(tab + S5_ET) + (size_t)g * 16384 + (size_t)(ri * 64 + p) * 128 + cp;
#pragma unroll
    for (int sp = 7; sp >= 0; --sp) { et[sp * 16] = f2bf(ri ? vi : vr); const float t = vr * lbr - vi * lbi; vi = vr * lbi + vi * lbr; vr = t; }
}
__device__ __forceinline__ void s5_ft_task(int g, int c, int ri, int p, const float* a_re, const float* a_im, const float* log_dt, const float* c_re, const float* c_im, unsigned char* tab) {
    const float dt = __expf(log_dt[g]); const float lr = a_re[g * CS + p], li = a_im[g * CS + p], zr = lr * dt, zi = li * dt; const float ez = __expf(zr), lbr = ez * __cosf(zi), lbi = ez * __sinf(zi);
    const float cre = c_re[((size_t)g * CGD + c) * CS + p], cim = c_im[((size_t)g * CGD + c) * CS + p]; float vr = cre * lbr - cim * lbi, vi = cre * lbi + cim * lbr;
    bf16_t* ft = (bf16_t*)(tab + S5_FT) + (size_t)g * 16384 + (size_t)c * 128 + ri * 64 + p;
#pragma unroll
    for (int tp = 0; tp < 8; ++tp) { ft[(size_t)tp * 16 * 128] = f2bf(ri ? -vi : vr); const float t = vr * lbr - vi * lbi; vi = vr * lbi + vi * lbr; vr = t; }
}
__device__ __forceinline__ void s5_table_elem(int g, int e, const float* a_re, const float* a_im, const float* log_dt, const float* b_re, const float* b_im,
                                              const float* c_re, const float* c_im, const float* dvec, unsigned char* tab) {
    const float dt = __expf(log_dt[g]);
    if (e < 4096) {
        const int dd = e >> 9, c = (e >> 5) & 15, ee = (e >> 4) & 1, cp = e & 15, d = dd - ee; float s = 0.f;
        if (d >= 0) {
            for (int p = 0; p < CS; ++p) { const float lr = a_re[g * CS + p], li = a_im[g * CS + p], zr = lr * dt, zi = li * dt;
                const float sh = __sinf(0.5f * zi); const float nr = expm1f(zr) * __cosf(zi) - 2.0f * sh * sh, ni = __expf(zr) * __sinf(zi), den = lr * lr + li * li;
                const float cr = (nr * lr + ni * li) / den, ci = (ni * lr - nr * li) / den;
                const float br = b_re[((size_t)g * CS + p) * CGD + cp], bi = b_im[((size_t)g * CS + p) * CGD + cp]; const float bbr = cr * br - ci * bi, bbi = cr * bi + ci * br;
                const float mag = __expf(zr * (float)d), pr = mag * __cosf(zi * (float)d), pi = mag * __sinf(zi * (float)d);
                const float vr = pr * bbr - pi * bbi, vi = pr * bbi + pi * bbr;
                s += c_re[((size_t)g * CGD + c) * CS + p] * vr - c_im[((size_t)g * CGD + c) * CS + p] * vi; }
            if (d == 0 && c == cp) s += dvec[g * CGD + c];
        }
        ((bf16_t*)(tab + S5_KT))[(size_t)g * 4096 + e] = f2bf(s); return;
    }
    e -= 4096;
    if (e < 16384) {
        const int n = e >> 7, k = e & 127, ri = n >> 6, p = n & 63, sp = k >> 4, cp = k & 15;
        const float lr = a_re[g * CS + p], li = a_im[g * CS + p], zr = lr * dt, zi = li * dt;
        const float sh = __sinf(0.5f * zi); const float nr = expm1f(zr) * __cosf(zi) - 2.0f * sh * sh, ni = __expf(zr) * __sinf(zi), den = lr * lr + li * li;
        const float cr = (nr * lr + ni * li) / den, ci = (ni * lr - nr * li) / den;
        const float br = b_re[((size_t)g * CS + p) * CGD + cp], bi = b_im[((size_t)g * CS + p) * CGD + cp]; const float bbr = cr * br - ci * bi, bbi = cr * bi + ci * br;
        const float d = (float)(7 - sp); const float mag = __expf(zr * d), pr = mag * __cosf(zi * d), pi = mag * __sinf(zi * d);
        ((bf16_t*)(tab + S5_ET))[(size_t)g * 16384 + e] = f2bf(ri ? (pr * bbi + pi * bbr) : (pr * bbr - pi * bbi)); return;
    }
    e -= 16384;
    if (e < 16384) {
        const int n = e >> 7, k = e & 127, tp = n >> 4, c = n & 15, ri = k >> 6, p = k & 63;
        const float lr = a_re[g * CS + p], li = a_im[g * CS + p], zr = lr * dt, zi = li * dt;
        const float d = (float)(tp + 1); const float mag = __expf(zr * d), pr = mag * __cosf(zi * d), pi = mag * __sinf(zi * d);
        const float cre = c_re[((size_t)g * CGD + c) * CS + p], cim = c_im[((size_t)g * CGD + c) * CS + p];
        ((bf16_t*)(tab + S5_FT))[(size_t)g * 16384 + e] = f2bf(ri ? -(cre * pi + cim * pr) : (cre * pr - cim * pi)); return;
    }
    e -= 16384;
    { const int p = e; const float lr = a_re[g * CS + p], li = a_im[g * CS + p], zr = lr * dt, zi = li * dt; float* o = (float*)(tab + S5_LAMP) + ((size_t)g * CS + p) * 8;
      float mag = expf(zr); o[0] = mag * cosf(zi); o[1] = mag * sinf(zi);
      mag = expf(zr * 8.f); o[2] = mag * cosf(zi * 8.f); o[3] = mag * sinf(zi * 8.f);
      mag = expf(zr * 128.f); o[4] = mag * cosf(zi * 128.f); o[5] = mag * sinf(zi * 128.f); o[6] = 0.f; o[7] = 0.f; }
}

template <class TT> __device__ __forceinline__ TT ldg(const void* ubase, unsigned voff) { return *(const TT*)((const char*)ubase + voff); }
template <int PASS>
__device__ __forceinline__ void s5_group(int unit, int g, bool first, float& kr, float& ki, int wave, int lane, const bf16_t* Z, bf16_t* Y, const unsigned char* tab, float* SEND, float* SEND2, float* SE, LAS unsigned char* lds) {
    const int ln = lane & 15, q = lane >> 4; const int t0 = unit * 128;
    const char* KTg = (const char*)(tab + S5_KT) + (size_t)g * 8192; const char* ETg = (const char*)(tab + S5_ET) + (size_t)g * 32768; const char* FTg = (const char*)(tab + S5_FT) + (size_t)g * 32768;
    const float* LAMPg = (const float*)(tab + S5_LAMP) + (size_t)g * CS * 8;
    const unsigned vo128 = (unsigned)(ln * 128 + 8 * q) * 2u;
    const unsigned vo32 = (unsigned)(ln * 32 + 8 * q) * 2u;
    LAS float* Sb = (LAS float*)(lds + wave * S5_WSCR); LAS bf16_t* Tb = (LAS bf16_t*)(lds + wave * S5_WSCR); LAS bf16_t* yst = (LAS bf16_t*)(lds + S5_YST);
    char* seb = (char*)(SE + ((size_t)unit * CG + g) * 16 * 128); const unsigned vl = (unsigned)lane * 4u;
    char* ylb = (char*)(Y + (size_t)t0 * D + AW + BW + g * 16); const unsigned vy = (unsigned)((ln * 8) * D + 4 * q) * 2u;
    const float lur = LAMPg[lane * 8 + 4], lui = LAMPg[lane * 8 + 5], l8r = LAMPg[lane * 8 + 2], l8i = LAMPg[lane * 8 + 3];
    float cr = 0.f, ci = 0.f;
    if (PASS == 1) {
        if (!first) { cr = kr; ci = ki; }
        bf16x8 X0, X1, X2, X3;
        { const char* zb = (const char*)(Z + (size_t)t0 * INC + ZC + g * 16); const unsigned vz = (unsigned)((ln * 8 + (q >> 1)) * INC + 8 * (q & 1)) * 2u;
          X0 = ldg<bf16x8>(zb, vz); X1 = ldg<bf16x8>(zb + 2 * INC * 2, vz); X2 = ldg<bf16x8>(zb + 4 * INC * 2, vz); X3 = ldg<bf16x8>(zb + 6 * INC * 2, vz); }
        { LAS float* sw = Sb + (4 * q) * 128 + ln; const char* eb = ETg;
#pragma unroll 1
          for (int jh = 0; jh < 2; ++jh) { bf16x8 ef[4][4];
#pragma unroll
            for (int j = 0; j < 4; ++j)
#pragma unroll
              for (int ks = 0; ks < 4; ++ks) ef[j][ks] = ldg<bf16x8>(eb + j * 4096 + ks * 64, vo128);
#pragma unroll
            for (int j = 0; j < 4; ++j) { f32x4 se = (f32x4){0.f, 0.f, 0.f, 0.f};
              se = mfma16(X0, ef[j][0], se); se = mfma16(X1, ef[j][1], se); se = mfma16(X2, ef[j][2], se); se = mfma16(X3, ef[j][3], se);
              LAS float* s2 = sw + 16 * j; s2[0] = se[0]; s2[128] = se[1]; s2[256] = se[2]; s2[384] = se[3]; }
            eb += 16384; sw += 64; } }
        asm volatile("" ::: "memory");
        { const char* kb = KTg; char* yq = ylb;
#pragma unroll 1
          for (int th = 0; th < 4; ++th) {
              const bf16x8 ka = ldg<bf16x8>(kb, vo32), kc = ldg<bf16x8>(kb + 1024, vo32);
              f32x4 acc0 = (f32x4){0.f, 0.f, 0.f, 0.f}, acc1 = (f32x4){0.f, 0.f, 0.f, 0.f};
              acc0 = mfma16(ka, X0, acc0); acc1 = mfma16(kc, X0, acc1);
              if (th >= 1) { acc0 = mfma16(ldg<bf16x8>(kb - 2048, vo32), X1, acc0); acc1 = mfma16(ldg<bf16x8>(kb - 1024, vo32), X1, acc1); }
              if (th >= 2) { acc0 = mfma16(ldg<bf16x8>(kb - 4096, vo32), X2, acc0); acc1 = mfma16(ldg<bf16x8>(kb - 3072, vo32), X2, acc1); }
              if (th >= 3) { acc0 = mfma16(ldg<bf16x8>(kb - 6144, vo32), X3, acc0); acc1 = mfma16(ldg<bf16x8>(kb - 5120, vo32), X3, acc1); }
              u32x2 w; w.x = cvt_pk_bf16(acc0[0], acc0[1]); w.y = cvt_pk_bf16(acc0[2], acc0[3]); *(u32x2*)(yq + vy) = w;
              w.x = cvt_pk_bf16(acc1[0], acc1[1]); w.y = cvt_pk_bf16(acc1[2], acc1[3]); *(u32x2*)(yq + (size_t)D * 2 + vy) = w;
              kb += 2048; yq += (size_t)2 * D * 2; } }
        asm volatile("" ::: "memory");
        float sr = cr, si = ci;
#pragma unroll
        for (int s = 0; s < 16; ++s) { const float er = Sb[s * 128 + lane], ei = Sb[s * 128 + 64 + lane];
            *(float*)(seb + s * 512 + vl) = er; *(float*)(seb + s * 512 + 256 + vl) = ei;
            const float nr = l8r * sr - l8i * si + er, ni = l8r * si + l8i * sr + ei; sr = nr; si = ni; }
        kr = sr; ki = si;
        float* dst = first ? SEND + (((size_t)unit * CG + g) * 2) * CS + lane : SEND2 + (((size_t)(unit >> 1) * CG + g) * 2) * CS + lane;
        dst[0] = sr; dst[CS] = si; asm volatile("" ::: "memory"); return;
    }
    if (first) { const int pr = unit >> 1, p0 = pr - (pr % (UPB128 / 2)); const float l2r = lur * lur - lui * lui, l2i = 2.0f * lur * lui;
        const char* sb = (const char*)(SEND2 + (((size_t)p0 * CG + g) * 2) * CS);
#pragma unroll 8
        for (int j = p0; j < pr; ++j) { const float sr = ldg<float>(sb, vl), si = ldg<float>(sb + CS * 4, vl); sb += (size_t)CG * 2 * CS * 4;
            const float nr = l2r * cr - l2i * ci + sr, ni = l2r * ci + l2i * cr + si; cr = nr; ci = ni; } }
    else { const float sr = SEND[(((size_t)(unit - 1) * CG + g) * 2 + 0) * CS + lane], si = SEND[(((size_t)(unit - 1) * CG + g) * 2 + 1) * CS + lane];
        cr = lur * kr - lui * ki + sr; ci = lur * ki + lui * kr + si; }
    kr = cr; ki = ci;
    { float sre[16], sim[16];
#pragma unroll
      for (int s = 0; s < 16; ++s) { sre[s] = ldg<float>(seb + s * 512, vl); sim[s] = ldg<float>(seb + s * 512 + 256, vl); }
      float sr = cr, si = ci;
#pragma unroll
      for (int s = 0; s < 16; ++s) { Tb[s * 128 + lane] = f2bf(sr); Tb[s * 128 + 64 + lane] = f2bf(si);
          const float nr = l8r * sr - l8i * si + sre[s], ni = l8r * si + l8i * sr + sim[s]; sr = nr; si = ni; } }
    asm volatile("" ::: "memory");
    const bf16x8 T0 = *(const LAS bf16x8*)(Tb + ln * 128 + 8 * q), T1 = *(const LAS bf16x8*)(Tb + ln * 128 + 32 + 8 * q), T2 = *(const LAS bf16x8*)(Tb + ln * 128 + 64 + 8 * q), T3 = *(const LAS bf16x8*)(Tb + ln * 128 + 96 + 8 * q);
    { LAS bf16_t* yw = yst + (ln * 8) * YST_LD + g * 16 + 4 * q; const char* fb = FTg; const char* yq = ylb;
#pragma unroll 2
      for (int th = 0; th < 4; ++th) { bf16x8 ff[2][4]; u32x2 yl[2];
#pragma unroll
          for (int j = 0; j < 2; ++j) { yl[j] = ldg<u32x2>(yq + (size_t)j * D * 2, vy);
#pragma unroll
              for (int ks = 0; ks < 4; ++ks) ff[j][ks] = ldg<bf16x8>(fb + j * 4096 + ks * 64, vo128); }
#pragma unroll
          for (int j = 0; j < 2; ++j) {
              f32x4 acc; acc[0] = __uint_as_float(yl[j].x << 16); acc[1] = __uint_as_float(yl[j].x & 0xffff0000u); acc[2] = __uint_as_float(yl[j].y << 16); acc[3] = __uint_as_float(yl[j].y & 0xffff0000u);
              acc = mfma16(ff[j][0], T0, acc); acc = mfma16(ff[j][1], T1, acc); acc = mfma16(ff[j][2], T2, acc); acc = mfma16(ff[j][3], T3, acc);
              u32x2 w; w.x = cvt_pk_bf16(gelu_fast(acc[0]), gelu_fast(acc[1])); w.y = cvt_pk_bf16(gelu_fast(acc[2]), gelu_fast(acc[3]));
              *(LAS u32x2*)(yw + j * YST_LD) = w; }
          fb += 8192; yq += (size_t)2 * D * 2; yw += 2 * YST_LD; } }
    asm volatile("s_waitcnt lgkmcnt(0)" ::: "memory");
}
__device__ __forceinline__ void s5_pair1(int pr, int g, int wave, int lane, const bf16_t* Z, bf16_t* Y, const unsigned char* tab, float* SEND, float* SEND2, float* SE, LAS unsigned char* lds) {
    const int ln = lane & 15, q = lane >> 4; const int t0 = pr * 256;
    const char* KTg = (const char*)(tab + S5_KT) + (size_t)g * 8192; const char* ETg = (const char*)(tab + S5_ET) + (size_t)g * 32768;
    const float* LAMPg = (const float*)(tab + S5_LAMP) + (size_t)g * CS * 8;
    const unsigned vo128 = (unsigned)(ln * 128 + 8 * q) * 2u, vo32 = (unsigned)(ln * 32 + 8 * q) * 2u, vl = (unsigned)lane * 4u;
    LAS float* SbA = (LAS float*)(lds + wave * 16384); LAS float* SbB = SbA + 2048;
    bf16x8 XA0, XA1, XA2, XA3, XB0, XB1, XB2, XB3;
    { const char* zb = (const char*)(Z + (size_t)t0 * INC + ZC + g * 16); const unsigned vz = (unsigned)((ln * 8 + (q >> 1)) * INC + 8 * (q & 1)) * 2u;
      XA0 = ldg<bf16x8>(zb, vz); XA1 = ldg<bf16x8>(zb + 2 * INC * 2, vz); XA2 = ldg<bf16x8>(zb + 4 * INC * 2, vz); XA3 = ldg<bf16x8>(zb + 6 * INC * 2, vz);
      const char* zc = zb + (size_t)128 * INC * 2;
      XB0 = ldg<bf16x8>(zc, vz); XB1 = ldg<bf16x8>(zc + 2 * INC * 2, vz); XB2 = ldg<bf16x8>(zc + 4 * INC * 2, vz); XB3 = ldg<bf16x8>(zc + 6 * INC * 2, vz); }
    { LAS float* sw = SbA + (4 * q) * 128 + ln; const char* eb = ETg;
#pragma unroll
      for (int jh = 0; jh < 2; ++jh) { bf16x8 ef[4][4];
#pragma unroll
        for (int j = 0; j < 4; ++j)
#pragma unroll
          for (int ks = 0; ks < 4; ++ks) ef[j][ks] = ldg<bf16x8>(eb + j * 4096 + ks * 64, vo128);
#pragma unroll
        for (int j = 0; j < 4; ++j) { f32x4 sa = (f32x4){0.f, 0.f, 0.f, 0.f}, sb = (f32x4){0.f, 0.f, 0.f, 0.f};
          sa = mfma16(XA0, ef[j][0], sa); sb = mfma16(XB0, ef[j][0], sb); sa = mfma16(XA1, ef[j][1], sa); sb = mfma16(XB1, ef[j][1], sb);
          sa = mfma16(XA2, ef[j][2], sa); sb = mfma16(XB2, ef[j][2], sb); sa = mfma16(XA3, ef[j][3], sa); sb = mfma16(XB3, ef[j][3], sb);
          LAS float* s2 = sw + 16 * j; s2[0] = sa[0]; s2[128] = sa[1]; s2[256] = sa[2]; s2[384] = sa[3]; s2[2048] = sb[0]; s2[2048 + 128] = sb[1]; s2[2048 + 256] = sb[2]; s2[2048 + 384] = sb[3]; }
        eb += 16384; sw += 64; } }
    asm volatile("" ::: "memory");
    { const char* kb = KTg; char* yq = (char*)(Y + (size_t)t0 * D + AW + BW + g * 16); const unsigned vy = (unsigned)((ln * 8) * D + 4 * q) * 2u;
#pragma unroll 1
      for (int th = 0; th < 4; ++th) {
          const bf16x8 ka = ldg<bf16x8>(kb, vo32), kc = ldg<bf16x8>(kb + 1024, vo32);
          f32x4 a0 = (f32x4){0.f, 0.f, 0.f, 0.f}, a1 = a0, b0 = a0, b1 = a0;
          a0 = mfma16(ka, XA0, a0); a1 = mfma16(kc, XA0, a1); b0 = mfma16(ka, XB0, b0); b1 = mfma16(kc, XB0, b1);
          if (th >= 1) { const bf16x8 k0 = ldg<bf16x8>(kb - 2048, vo32), k1 = ldg<bf16x8>(kb - 1024, vo32); a0 = mfma16(k0, XA1, a0); a1 = mfma16(k1, XA1, a1); b0 = mfma16(k0, XB1, b0); b1 = mfma16(k1, XB1, b1); }
          if (th >= 2) { const bf16x8 k0 = ldg<bf16x8>(kb - 4096, vo32), k1 = ldg<bf16x8>(kb - 3072, vo32); a0 = mfma16(k0, XA2, a0); a1 = mfma16(k1, XA2, a1); b0 = mfma16(k0, XB2, b0); b1 = mfma16(k1, XB2, b1); }
          if (th >= 3) { const bf16x8 k0 = ldg<bf16x8>(kb - 6144, vo32), k1 = ldg<bf16x8>(kb - 5120, vo32); a0 = mfma16(k0, XA3, a0); a1 = mfma16(k1, XA3, a1); b0 = mfma16(k0, XB3, b0); b1 = mfma16(k1, XB3, b1); }
          u32x2 w; w.x = cvt_pk_bf16(a0[0], a0[1]); w.y = cvt_pk_bf16(a0[2], a0[3]); *(u32x2*)(yq + vy) = w;
          w.x = cvt_pk_bf16(a1[0], a1[1]); w.y = cvt_pk_bf16(a1[2], a1[3]); *(u32x2*)(yq + (size_t)D * 2 + vy) = w;
          w.x = cvt_pk_bf16(b0[0], b0[1]); w.y = cvt_pk_bf16(b0[2], b0[3]); *(u32x2*)(yq + (size_t)128 * D * 2 + vy) = w;
          w.x = cvt_pk_bf16(b1[0], b1[1]); w.y = cvt_pk_bf16(b1[2], b1[3]); *(u32x2*)(yq + (size_t)129 * D * 2 + vy) = w;
          kb += 2048; yq += (size_t)2 * D * 2; } }
    asm volatile("" ::: "memory");
    const float l8r = LAMPg[lane * 8 + 2], l8i = LAMPg[lane * 8 + 3];
    float sr = 0.f, si = 0.f;
    { char* seb = (char*)(SE + ((size_t)(2 * pr) * CG + g) * 16 * 128);
#pragma unroll
      for (int s = 0; s < 16; ++s) { const float er = SbA[s * 128 + lane], ei = SbA[s * 128 + 64 + lane];
          *(float*)(seb + s * 512 + vl) = er; *(float*)(seb + s * 512 + 256 + vl) = ei;
          const float nr = l8r * sr - l8i * si + er, ni = l8r * si + l8i * sr + ei; sr = nr; si = ni; }
      float* dst = SEND + (((size_t)(2 * pr) * CG + g) * 2) * CS + lane; dst[0] = sr; dst[CS] = si; }
    { char* seb = (char*)(SE + ((size_t)(2 * pr + 1) * CG + g) * 16 * 128);
#pragma unroll
      for (int s = 0; s < 16; ++s) { const float er = SbB[s * 128 + lane], ei = SbB[s * 128 + 64 + lane];
          *(float*)(seb + s * 512 + vl) = er; *(float*)(seb + s * 512 + 256 + vl) = ei;
          const float nr = l8r * sr - l8i * si + er, ni = l8r * si + l8i * sr + ei; sr = nr; si = ni; }
      float* dst = SEND2 + (((size_t)pr * CG + g) * 2) * CS + lane; dst[0] = sr; dst[CS] = si; }
    asm volatile("s_waitcnt lgkmcnt(0)" ::: "memory");
}
constexpr int S5_PSG = 133120;
__device__ __forceinline__ void s5_glu(int unit, int wave, int lane, const bf16_t* WGLU, const float* glu_b, const float* mo_gc, bf16_t* Y, LAS unsigned char* lds) {
    const int ln = lane & 15, q = lane >> 4; LAS bf16_t* yst = (LAS bf16_t*)(lds + S5_YST); LAS float* PSg = (LAS float*)(lds + S5_PSG);
    bf16x8 wf[2][8];
    { const char* wb = (const char*)(WGLU + (size_t)(32 * wave) * 256); const unsigned vw = (unsigned)(ln * 256 + 8 * q) * 2u;
#pragma unroll
      for (int j = 0; j < 2; ++j)
#pragma unroll
          for (int ks = 0; ks < 8; ++ks) wf[j][ks] = ldg<bf16x8>(wb + j * 8192 + ks * 64, vw); }
    const f32x4 gb0 = *(const f32x4*)(glu_b + 32 * wave + 4 * q), gb1 = *(const f32x4*)(glu_b + 32 * wave + 16 + 4 * q);
    LAS bf16_t* op = (LAS bf16_t*)(lds + wave * S5_WSCR) + ln * 32 + 4 * q;
    { const LAS bf16_t* yrow = yst + ln * YST_LD; LAS float* psw = PSg + ln * 8 + wave; LAS bf16_t* ow = op;
#pragma unroll 4
      for (int tt = 0; tt < 8; ++tt) {
        f32x4 a0 = (f32x4){0.f, 0.f, 0.f, 0.f}, a1 = (f32x4){0.f, 0.f, 0.f, 0.f};
#pragma unroll
        for (int ks = 0; ks < 8; ++ks) { const bf16x8 yf = *(const LAS bf16x8*)(yrow + 32 * ks + 8 * q); a0 = mfma16(wf[0][ks], yf, a0); a1 = mfma16(wf[1][ks], yf, a1); }
        const u32x2 y0 = *(const LAS u32x2*)(yrow + 32 * wave + 4 * q), y1 = *(const LAS u32x2*)(yrow + 32 * wave + 16 + 4 * q);
        float o[8];
        o[0] = __uint_as_float(y0.x << 16) * sigmoid_fast(a0[0] + gb0[0]); o[1] = __uint_as_float(y0.x & 0xffff0000u) * sigmoid_fast(a0[1] + gb0[1]); o[2] = __uint_as_float(y0.y << 16) * sigmoid_fast(a0[2] + gb0[2]); o[3] = __uint_as_float(y0.y & 0xffff0000u) * sigmoid_fast(a0[3] + gb0[3]);
        o[4] = __uint_as_float(y1.x << 16) * sigmoid_fast(a1[0] + gb1[0]); o[5] = __uint_as_float(y1.x & 0xffff0000u) * sigmoid_fast(a1[1] + gb1[1]); o[6] = __uint_as_float(y1.y << 16) * sigmoid_fast(a1[2] + gb1[2]); o[7] = __uint_as_float(y1.y & 0xffff0000u) * sigmoid_fast(a1[3] + gb1[3]);
        float ss = ((o[0] * o[0] + o[1] * o[1]) + (o[2] * o[2] + o[3] * o[3])) + ((o[4] * o[4] + o[5] * o[5]) + (o[6] * o[6] + o[7] * o[7]));
        ss = add_x16_x32(ss);
        if (q == 0) *psw = ss;
        u32x2 w; w.x = cvt_pk_bf16(o[0], o[1]); w.y = cvt_pk_bf16(o[2], o[3]); *(LAS u32x2*)(ow) = w; w.x = cvt_pk_bf16(o[4], o[5]); w.y = cvt_pk_bf16(o[6], o[7]); *(LAS u32x2*)(ow + 16) = w;
        yrow += 16 * YST_LD; psw += 16 * 8; ow += 16 * 32; } }
    asm volatile("s_waitcnt lgkmcnt(0)" ::: "memory");
    __syncthreads();
    { const int p = lane & 31, rsel = lane >> 5; const f32x4 g0 = *(const f32x4*)(mo_gc + 8 * p), g1 = *(const f32x4*)(mo_gc + 8 * p + 4);
      const LAS unsigned char* src = lds + (p >> 2) * S5_WSCR + (p & 3) * 16; bf16_t* yb = Y + (size_t)(unit * 128) * D + AW + BW + 8 * p;
#pragma unroll 4
      for (int it = 0; it < 8; ++it) { const int row = 16 * wave + 2 * it + rsel; const LAS f32x4* pp = (const LAS f32x4*)(PSg + row * 8); const f32x4 p0 = pp[0], p1 = pp[1];
        const float rs = __builtin_amdgcn_rsqf((((p0[0] + p0[1]) + (p0[2] + p0[3])) + ((p1[0] + p1[1]) + (p1[2] + p1[3]))) * (1.0f / CW) + EPS);
        const u32x4 a = *(const LAS u32x4*)(src + row * 64); u32x4 w;
        w.x = cvt_pk_bf16(__uint_as_float(a.x << 16) * rs * g0[0], __uint_as_float(a.x & 0xffff0000u) * rs * g0[1]); w.y = cvt_pk_bf16(__uint_as_float(a.y << 16) * rs * g0[2], __uint_as_float(a.y & 0xffff0000u) * rs * g0[3]);
        w.z = cvt_pk_bf16(__uint_as_float(a.z << 16) * rs * g1[0], __uint_as_float(a.z & 0xffff0000u) * rs * g1[1]); w.w = cvt_pk_bf16(__uint_as_float(a.w << 16) * rs * g1[2], __uint_as_float(a.w & 0xffff0000u) * rs * g1[3]);
        *(u32x4*)(yb + (size_t)row * D) = w; } }
}

constexpr int XC_LD = 392;
constexpr int RG_XC = 0, RG_PS = 100352, RG_CAR = 112640, RG_RSB = 114176, RG_PT = 114688, RG_HC = 116224;
template <int CTRL> __device__ __forceinline__ float dpp0(float v) { return __int_as_float(__builtin_amdgcn_update_dpp(0, __float_as_int(v), CTRL, 0xf, 0xf, true)); }
template <int CTRL> __device__ __forceinline__ float dppf(float old, float v) { return __int_as_float(__builtin_amdgcn_update_dpp(__float_as_int(old), __float_as_int(v), CTRL, 0xf, 0xf, false)); }
__device__ __forceinline__ void bf8_to_f32(const u32x4 o, float (&v)[8]) {
    v[0] = __uint_as_float(o.x << 16); v[1] = __uint_as_float(o.x & 0xffff0000u); v[2] = __uint_as_float(o.y << 16); v[3] = __uint_as_float(o.y & 0xffff0000u);
    v[4] = __uint_as_float(o.z << 16); v[5] = __uint_as_float(o.z & 0xffff0000u); v[6] = __uint_as_float(o.w << 16); v[7] = __uint_as_float(o.w & 0xffff0000u);
}
__device__ __forceinline__ float bcast15(float v) { return __int_as_float(__builtin_amdgcn_ds_swizzle(__float_as_int(v), 0x1F0)); }
template <int PASS>
__device__ __forceinline__ void rglru_unit(int unit, bool first, float& cprev, int tid, int wave, int lane, const bf16_t* Z, bf16_t* Y, const bf16_t* WRG, const bf16_t* WIG,
                                           const float* conv_w, const float* conv_b, const float* rg_b, const float* ig_b, const float* lam, const float* mo_gb,
                                           float* SUMA, float* SUMH, float* SUMA2, float* SUMH2, bf16_t* HL, bf16_t* PP, LAS unsigned char* lds) {
    LAS bf16_t* xcl = (LAS bf16_t*)(lds + RG_XC); LAS float* PS = (LAS float*)(lds + RG_PS); LAS float* CAR = (LAS float*)(lds + RG_CAR); LAS float* RSB = (LAS float*)(lds + RG_RSB); LAS float* PT = (LAS float*)(lds + RG_PT); LAS float* HC = (LAS float*)(lds + RG_HC);
    const int t0 = unit * 128; const int ln = lane & 15, q = lane >> 4;
    if (tid < 384) {
        const int c0 = (tid % 48) * 8, tg = tid / 48; const int tb = t0 + tg * 16, s0 = tb % SEQ;
        float w0[8], w1[8], w2[8], w3[8], bb[8];
#pragma unroll
        for (int hh = 0; hh < 2; ++hh) { const f32x4 a0 = *(const f32x4*)(conv_w + 0 * BW + c0 + 4 * hh), a1 = *(const f32x4*)(conv_w + 1 * BW + c0 + 4 * hh), a2 = *(const f32x4*)(conv_w + 2 * BW + c0 + 4 * hh), a3 = *(const f32x4*)(conv_w + 3 * BW + c0 + 4 * hh), a4 = *(const f32x4*)(conv_b + c0 + 4 * hh);
#pragma unroll
            for (int j = 0; j < 4; ++j) { w0[4 * hh + j] = a0[j]; w1[4 * hh + j] = a1[j]; w2[4 * hh + j] = a2[j]; w3[4 * hh + j] = a3[j]; bb[4 * hh + j] = a4[j]; } }
        float xm1[8], xm2[8], xm3[8];
        const bf16_t* zp = Z + (size_t)tb * INC + ZX + c0;
        { const u32x4 z4 = {0u, 0u, 0u, 0u}; const u32x4 o1 = s0 >= 1 ? *(const u32x4*)(zp - INC) : z4, o2 = s0 >= 2 ? *(const u32x4*)(zp - 2 * INC) : z4, o3 = s0 >= 3 ? *(const u32x4*)(zp - 3 * INC) : z4;
          bf8_to_f32(o1, xm1); bf8_to_f32(o2, xm2); bf8_to_f32(o3, xm3); }
        LAS bf16_t* xw = xcl + (tg * 16) * XC_LD + c0;
#pragma unroll 4
        for (int i = 0; i < 16; ++i) { float x0[8]; bf8_to_f32(*(const u32x4*)(zp), x0); float v[8];
#pragma unroll
            for (int j = 0; j < 8; ++j) { v[j] = bb[j] + w3[j] * x0[j] + w2[j] * xm1[j] + w1[j] * xm2[j] + w0[j] * xm3[j]; xm3[j] = xm2[j]; xm2[j] = xm1[j]; xm1[j] = x0[j]; }
            u32x4 w; w.x = cvt_pk_bf16(v[0], v[1]); w.y = cvt_pk_bf16(v[2], v[3]); w.z = cvt_pk_bf16(v[4], v[5]); w.w = cvt_pk_bf16(v[6], v[7]);
            *(LAS u32x4*)(xw) = w; zp += INC; xw += XC_LD; }
        if (PASS == 2) { const int c = tid; float h;
            if (first) { const int pr = unit >> 1, p0 = pr - (pr % (UPB128 / 2)); h = 0.f; const float* pa = SUMA2 + (size_t)p0 * BW + c; const float* ph = SUMH2 + (size_t)p0 * BW + c;
#pragma unroll 8
                for (int j = p0; j < pr; ++j) { h = fmaf(*pa, h, *ph); pa += BW; ph += BW; } }
            else h = fmaf(SUMA[(size_t)(unit - 1) * BW + c], cprev, SUMH[(size_t)(unit - 1) * BW + c]);
            cprev = h; CAR[c] = h; }
    }
    __syncthreads();
#pragma unroll 1
    for (int ci = 0; ci < 3; ++ci) {
        const int combo = wave + 8 * ci, h = combo >> 2, jt = combo & 3, cb = h * 64 + jt * 16;
        const bf16_t* wr = WRG + ((size_t)(h * 64 + jt * 16 + ln)) * 64 + 8 * q; const bf16_t* wi = WIG + ((size_t)(h * 64 + jt * 16 + ln)) * 64 + 8 * q;
        const bf16x8 RG0 = *(const bf16x8*)(wr), RG1 = *(const bf16x8*)(wr + 32), IG0 = *(const bf16x8*)(wi), IG1 = *(const bf16x8*)(wi + 32);
        const f32x4 rgb4 = *(const f32x4*)(rg_b + cb + 4 * q), igb4 = *(const f32x4*)(ig_b + cb + 4 * q), lam4 = *(const f32x4*)(lam + cb + 4 * q);
        const float m1 = ln < 1 ? 1.f : 0.f, m2 = ln < 2 ? 1.f : 0.f, m4 = ln < 4 ? 1.f : 0.f, m8 = ln < 8 ? 1.f : 0.f;
        float spc[4], car[4], ptot[4];
#pragma unroll
        for (int r = 0; r < 4; ++r) { spc[r] = -8.0f * 1.4426950408889634f * log1pf(expf(-lam4[r])); car[r] = PASS == 2 ? CAR[cb + 4 * q + r] : (first ? 0.f : HC[cb + 4 * q + r]); ptot[r] = (PASS == 1 && !first) ? PT[cb + 4 * q + r] : 1.f; }
        const LAS bf16_t* xb = xcl + ln * XC_LD + h * 64 + 8 * q; const LAS bf16_t* xv = xcl + ln * XC_LD + cb + 4 * q;
        const bf16_t* zg = Z + (size_t)(t0 + ln) * INC + ZG + cb + 4 * q; bf16_t* yo = Y + (size_t)(t0 + ln) * D + AW + cb + 4 * q; LAS float* psw = PS + ln * 24 + combo;
        bf16_t* hlo = HL + (size_t)(t0 + ln) * BW + cb + 4 * q; bf16_t* ppo = PP + (size_t)(t0 + ln) * BW + cb + 4 * q;
#pragma unroll 1
        for (int tt = 0; tt < 8; ++tt) {
            const bf16x8 B0 = *(const LAS bf16x8*)(xb), B1 = *(const LAS bf16x8*)(xb + 32);
            f32x4 ar = (f32x4){0.f, 0.f, 0.f, 0.f}, ai = (f32x4){0.f, 0.f, 0.f, 0.f};
            ar = mfma16(RG0, B0, ar); ar = mfma16(RG1, B1, ar); ai = mfma16(IG0, B0, ai); ai = mfma16(IG1, B1, ai);
            const u32x2 xq = *(const LAS u32x2*)(xv); float xc4[4] = {__uint_as_float(xq.x << 16), __uint_as_float(xq.x & 0xffff0000u), __uint_as_float(xq.y << 16), __uint_as_float(xq.y & 0xffff0000u)};
            float hv[4], pv[4];
#pragma unroll
            for (int r = 0; r < 4; ++r) {
                const float rr = sigmoid_fast(ar[r] + rgb4[r]), ii = sigmoid_fast(ai[r] + igb4[r]);
                float A = __builtin_amdgcn_exp2f(spc[r] * rr);
                float Bv = __builtin_amdgcn_sqrtf(fmaxf(1.0f - A * A, 0.f)) * (ii * xc4[r]);
                if (ln == 0) { Bv = fmaf(A, car[r], Bv); A *= ptot[r]; }
                { const float As = dpp0<0x111>(A) + m1, Bs = dpp0<0x111>(Bv); Bv = fmaf(A, Bs, Bv); A *= As; }
                { const float As = dpp0<0x112>(A) + m2, Bs = dpp0<0x112>(Bv); Bv = fmaf(A, Bs, Bv); A *= As; }
                { const float As = dpp0<0x114>(A) + m4, Bs = dpp0<0x114>(Bv); Bv = fmaf(A, Bs, Bv); A *= As; }
                { const float As = dpp0<0x118>(A) + m8, Bs = dpp0<0x118>(Bv); Bv = fmaf(A, Bs, Bv); A *= As; }
                hv[r] = Bv; pv[r] = A; car[r] = dppf<0x121>(Bv, Bv); ptot[r] = dppf<0x121>(A, A);
            }
            if (PASS == 1) { u32x2 w; w.x = cvt_pk_bf16(hv[0], hv[1]); w.y = cvt_pk_bf16(hv[2], hv[3]); *(u32x2*)(hlo) = w; w.x = cvt_pk_bf16(pv[0], pv[1]); w.y = cvt_pk_bf16(pv[2], pv[3]); *(u32x2*)(ppo) = w; hlo += 16 * BW; ppo += 16 * BW; }
            if (PASS == 2) { const u32x2 gq = *(const u32x2*)(zg);
                const float y0 = hv[0] * __uint_as_float(gq.x << 16), y1 = hv[1] * __uint_as_float(gq.x & 0xffff0000u), y2 = hv[2] * __uint_as_float(gq.y << 16), y3 = hv[3] * __uint_as_float(gq.y & 0xffff0000u);
                u32x2 w; w.x = cvt_pk_bf16(y0, y1); w.y = cvt_pk_bf16(y2, y3); *(u32x2*)(yo) = w;
                float ss = (y0 * y0 + y1 * y1) + (y2 * y2 + y3 * y3); ss += __shfl_xor(ss, 16); ss += __shfl_xor(ss, 32);
                if (q == 0) *psw = ss; }
            xb += 16 * XC_LD; xv += 16 * XC_LD; zg += 16 * INC; yo += 16 * D; psw += 16 * 24;
        }
        if (PASS == 1 && ln == 0) {
            float* da = first ? SUMA + (size_t)unit * BW : SUMA2 + (size_t)(unit >> 1) * BW; float* dh = first ? SUMH + (size_t)unit * BW : SUMH2 + (size_t)(unit >> 1) * BW;
#pragma unroll
            for (int r = 0; r < 4; ++r) { da[cb + 4 * q + r] = ptot[r]; dh[cb + 4 * q + r] = car[r]; if (first) { PT[cb + 4 * q + r] = ptot[r]; HC[cb + 4 * q + r] = car[r]; } } }
    }
    if (PASS == 2) {
        asm volatile("s_waitcnt vmcnt(0)" ::: "memory");
        __syncthreads();
        if (tid < 128) { float s = 0.f;
#pragma unroll
            for (int k = 0; k < 24; ++k) s += PS[tid * 24 + k];
            RSB[tid] = __builtin_amdgcn_rsqf(s * (1.0f / BW) + EPS); }
        __syncthreads();
#pragma unroll 2
        for (int k = 0; k < 12; ++k) { const int idx = tid + 512 * k, tl = idx / 48, c0 = (idx % 48) * 8; const float rs = RSB[tl];
            bf16_t* yp = Y + (size_t)(t0 + tl) * D + AW + c0; float v[8]; bf8_to_f32(*(const u32x4*)(yp), v);
            const f32x4 g0 = *(const f32x4*)(mo_gb + c0), g1 = *(const f32x4*)(mo_gb + c0 + 4);
            u32x4 w; w.x = cvt_pk_bf16(v[0] * rs * g0[0], v[1] * rs * g0[1]); w.y = cvt_pk_bf16(v[2] * rs * g0[2], v[3] * rs * g0[3]); w.z = cvt_pk_bf16(v[4] * rs * g1[0], v[5] * rs * g1[1]); w.w = cvt_pk_bf16(v[6] * rs * g1[2], v[7] * rs * g1[3]);
            *(u32x4*)(yp) = w; }
    }
    __syncthreads();
}

__device__ __forceinline__ void rglru_fix_pair(int pr, int tid, int wave, int lane, const bf16_t* Z, bf16_t* Y, const bf16_t* HL, const bf16_t* PP, const float* SUMA2, const float* SUMH2, const float* mo_gb, LAS unsigned char* lds) {
    LAS float* CAR = (LAS float*)(lds + RG_CAR);
    if (tid < 384) { const int c = tid, p0 = pr - (pr % (UPB128 / 2)); float h = 0.f; const float* pa = SUMA2 + (size_t)p0 * BW + c; const float* ph = SUMH2 + (size_t)p0 * BW + c;
#pragma unroll 8
        for (int j = p0; j < pr; ++j) { h = fmaf(*pa, h, *ph); pa += BW; ph += BW; }
        CAR[c] = h; }
    __syncthreads();
    {
        typedef unsigned u32x3 __attribute__((ext_vector_type(3)));
        const int c0 = lane * 6; float hin[6], gch[6];
#pragma unroll
        for (int e = 0; e < 6; ++e) { hin[e] = CAR[c0 + e]; gch[e] = mo_gb[c0 + e]; }
#pragma unroll 2
        for (int i = 0; i < 32; ++i) { const size_t t = (size_t)pr * 256 + wave * 32 + i;
            const u32x3 h3 = *(const u32x3*)(HL + t * BW + c0), p3 = *(const u32x3*)(PP + t * BW + c0), g3 = *(const u32x3*)(Z + t * INC + ZG + c0);
            float y[6]; float ss = 0.f;
#pragma unroll
            for (int e = 0; e < 3; ++e) { const unsigned hh = h3[e], pq = p3[e], gq = g3[e];
                y[2 * e] = fmaf(__uint_as_float(pq << 16), hin[2 * e], __uint_as_float(hh << 16)) * gelu_fast(__uint_as_float(gq << 16));
                y[2 * e + 1] = fmaf(__uint_as_float(pq & 0xffff0000u), hin[2 * e + 1], __uint_as_float(hh & 0xffff0000u)) * gelu_fast(__uint_as_float(gq & 0xffff0000u));
                ss += y[2 * e] * y[2 * e] + y[2 * e + 1] * y[2 * e + 1]; }
            ss = wave_sum(ss);
            const float rs = __builtin_amdgcn_rsqf(ss * (1.0f / BW) + EPS);
            u32x3 w; w.x = cvt_pk_bf16(y[0] * rs * gch[0], y[1] * rs * gch[1]); w.y = cvt_pk_bf16(y[2] * rs * gch[2], y[3] * rs * gch[3]); w.z = cvt_pk_bf16(y[4] * rs * gch[4], y[5] * rs * gch[5]);
            *(u32x3*)(Y + t * D + AW + c0) = w; }
    }
    __syncthreads();
}

constexpr int VT_LD = 136;
__device__ __forceinline__ void mixa_unit(int unit, int tid, int wave, int lane, const bf16_t* Z, bf16_t* Y, const bf16_t* WSP, const float* a_sb, const float* vg, const float* mo_ga, LAS unsigned char* lds) {
    LAS bf16_t* vT = (LAS bf16_t*)lds; const int t0 = unit * 128; const int ln = lane & 15, q = lane >> 4;
    { const int j = tid >> 2, part = tid & 3; const bf16_t* zp = Z + (size_t)(t0 + j) * INC + ZV + part * 8;
      u32x4 raw[12]; float ss = 0.f;
#pragma unroll
      for (int k = 0; k < 12; ++k) { const u32x4 rw = *(const u32x4*)(zp + 32 * k); float v[8]; bf8_to_f32(rw, v);
#pragma unroll
          for (int e = 0; e < 8; ++e) { v[e] = gelu_fast(v[e]); ss += v[e] * v[e]; }
          raw[k].x = cvt_pk_bf16(v[0], v[1]); raw[k].y = cvt_pk_bf16(v[2], v[3]); raw[k].z = cvt_pk_bf16(v[4], v[5]); raw[k].w = cvt_pk_bf16(v[6], v[7]); }
      ss += x_xor1(ss); ss += x_xor2(ss);
      const float rs = __builtin_amdgcn_rsqf(ss * (1.0f / AW) + EPS);
      LAS bf16_t* vw = vT + (part * 8) * VT_LD + j; const float* gp = vg + part * 8;
#pragma unroll
      for (int k = 0; k < 12; ++k) { float v[8]; bf8_to_f32(raw[k], v); const f32x4 g0 = *(const f32x4*)(gp + 32 * k), g1 = *(const f32x4*)(gp + 32 * k + 4);
#pragma unroll
          for (int e = 0; e < 8; ++e) vw[(32 * k + e) * VT_LD] = f2bf(v[e] * rs * (e < 4 ? g0[e] : g1[e - 4])); } }
    __syncthreads();
    const bool full = wave >= 4;
    float ss = 0.f;
    const int tl = 16 * wave + ln;
    const char* ub = (const char*)(Z + (size_t)t0 * INC + ZU); const unsigned vu = (unsigned)(tl * INC + 4 * q) * 2u;
    const char* wb = (const char*)WSP; const unsigned vw = (unsigned)(tl * 128 + 8 * q) * 2u;
    const bf16x8 z8 = {0, 0, 0, 0, 0, 0, 0, 0};
    bf16x8 Wn0 = ldg<bf16x8>(wb, vw), Wn1 = ldg<bf16x8>(wb + 64, vw), Wn2 = z8, Wn3 = z8;
    if (full) { Wn2 = ldg<bf16x8>(wb + 128, vw); Wn3 = ldg<bf16x8>(wb + 192, vw); }
    u32x2 un0 = ldg<u32x2>(ub, vu), un1 = ldg<u32x2>(ub + 32, vu), un2 = ldg<u32x2>(ub + 64, vu), un3 = ldg<u32x2>(ub + 96, vu); float bn = a_sb[tl];
    const LAS bf16_t* ap = vT + ln * VT_LD + 8 * q;
    u32x2 val[24];
#pragma unroll
    for (int h = 0; h < 6; ++h) {
        const bf16x8 W0 = Wn0, W1 = Wn1, W2 = Wn2, W3 = Wn3; const u32x2 uc[4] = {un0, un1, un2, un3}; const float b = bn;
        if (h < 5) { const char* wq = wb + (size_t)(h + 1) * 128 * 128 * 2; const char* uq2 = ub + (h + 1) * 128;
            Wn0 = ldg<bf16x8>(wq, vw); Wn1 = ldg<bf16x8>(wq + 64, vw); if (full) { Wn2 = ldg<bf16x8>(wq + 128, vw); Wn3 = ldg<bf16x8>(wq + 192, vw); }
            un0 = ldg<u32x2>(uq2, vu); un1 = ldg<u32x2>(uq2 + 32, vu); un2 = ldg<u32x2>(uq2 + 64, vu); un3 = ldg<u32x2>(uq2 + 96, vu); bn = a_sb[(h + 1) * 128 + tl]; }
        asm volatile("" ::: "memory");
#pragma unroll
        for (int dt = 0; dt < 4; ++dt) { f32x4 acc = (f32x4){0.f, 0.f, 0.f, 0.f};
            const LAS bf16_t* aq = ap + (h * 64 + 16 * dt) * VT_LD;
            const bf16x8 a0 = *(const LAS bf16x8*)(aq), a1 = *(const LAS bf16x8*)(aq + 32), a2 = *(const LAS bf16x8*)(aq + 64), a3 = *(const LAS bf16x8*)(aq + 96);
            acc = mfma16(a0, W0, acc); acc = mfma16(a1, W1, acc); acc = mfma16(a2, W2, acc); acc = mfma16(a3, W3, acc);
            const u32x2 u2 = uc[dt];
            const float v0 = gelu_fast(__uint_as_float(u2.x << 16)) * (acc[0] + b), v1 = gelu_fast(__uint_as_float(u2.x & 0xffff0000u)) * (acc[1] + b), v2 = gelu_fast(__uint_as_float(u2.y << 16)) * (acc[2] + b), v3 = gelu_fast(__uint_as_float(u2.y & 0xffff0000u)) * (acc[3] + b);
            ss += (v0 * v0 + v1 * v1) + (v2 * v2 + v3 * v3);
            u32x2 pk; pk.x = cvt_pk_bf16(v0, v1); pk.y = cvt_pk_bf16(v2, v3); val[h * 4 + dt] = pk; }
    }
    ss = add_x16_x32(ss);
    const float rs = __builtin_amdgcn_rsqf(ss * (1.0f / AW) + EPS);
    __syncthreads();
    { LAS unsigned char* scr = lds + wave * (16 * 784);
      const char* gb = (const char*)mo_ga; const unsigned vg4 = (unsigned)(4 * q) * 4u; LAS unsigned char* sw = scr + ln * 784 + q * 8;
#pragma unroll
      for (int k = 0; k < 24; ++k) { const f32x4 gg = ldg<f32x4>(gb + k * 64, vg4); const u32x2 pk = val[k];
          u32x2 w; w.x = cvt_pk_bf16(__uint_as_float(pk.x << 16) * rs * gg[0], __uint_as_float(pk.x & 0xffff0000u) * rs * gg[1]); w.y = cvt_pk_bf16(__uint_as_float(pk.y << 16) * rs * gg[2], __uint_as_float(pk.y & 0xffff0000u) * rs * gg[3]);
          *(LAS u32x2*)(sw + k * 32) = w; }
      asm volatile("s_waitcnt lgkmcnt(0)" ::: "memory");
      bf16_t* yr = Y + (size_t)(t0 + 16 * wave) * D;
      { int row = lane >= 48 ? 1 : 0, cp = lane >= 48 ? lane - 48 : lane;
#pragma unroll 2
        for (int i = 0; i < 12; ++i) { const unsigned so = (unsigned)(row * 784 + cp * 16), go = (unsigned)(row * D + cp * 8) * 2u;
            const u32x4 v = *(const LAS u32x4*)(scr + so); *(u32x4*)((char*)yr + go) = v;
            cp += 16; row += 1; if (cp >= 48) { cp -= 48; row += 1; } } } }
    __syncthreads();
}

__device__ __forceinline__ void router_unit(int unit, int wave, int lane, const bf16_t* HB, const float* SSQ, const bf16_t* WRT, const float* rgb, const float* reb,
                                            int* CLS, float* G2, LAS unsigned char* lds, LAS int* hist) {
    const int ln = lane & 15, q = lane >> 4; const int t0 = unit * UT + wave * 32;
    LAS float* LG = (LAS float*)(lds + wave * 8192);
    f32x4 acc[2][3];
#pragma unroll
    for (int tt = 0; tt < 2; ++tt)
#pragma unroll
        for (int j = 0; j < 3; ++j) acc[tt][j] = (f32x4){0.f, 0.f, 0.f, 0.f};
    const bf16_t* hp0 = HB + (size_t)(t0 + ln) * D + 8 * q; const bf16_t* hp1 = hp0 + (size_t)16 * D; const bf16_t* wp = WRT + (size_t)ln * D + 8 * q;
#pragma unroll 4
    for (int ks = 0; ks < 32; ++ks) {
        const bf16x8 b0 = *(const bf16x8*)(hp0), b1 = *(const bf16x8*)(hp1);
        const bf16x8 a0 = *(const bf16x8*)(wp), a1 = *(const bf16x8*)(wp + 16 * D), a2 = *(const bf16x8*)(wp + 32 * D);
        acc[0][0] = mfma16(a0, b0, acc[0][0]); acc[0][1] = mfma16(a1, b0, acc[0][1]); acc[0][2] = mfma16(a2, b0, acc[0][2]);
        acc[1][0] = mfma16(a0, b1, acc[1][0]); acc[1][1] = mfma16(a1, b1, acc[1][1]); acc[1][2] = mfma16(a2, b1, acc[1][2]);
        hp0 += 32; hp1 += 32; wp += 32; }
#pragma unroll
    for (int tt = 0; tt < 2; ++tt)
#pragma unroll
        for (int j = 0; j < 3; ++j) *(LAS f32x4*)(LG + (16 * tt + ln) * 48 + 16 * j + 4 * q) = acc[tt][j];
    asm volatile("s_waitcnt lgkmcnt(0)" ::: "memory");
    if (lane < 32) { const int t = t0 + lane; const LAS float* lg = LG + lane * 48;
        const f32x4* sp = (const f32x4*)(SSQ + (size_t)t * 16); const f32x4 s0 = sp[0], s1 = sp[1], s2 = sp[2], s3 = sp[3];
        const float sq = ((s0[0] + s0[1]) + (s0[2] + s0[3])) + ((s1[0] + s1[1]) + (s1[2] + s1[3])) + ((s2[0] + s2[1]) + (s2[2] + s2[3])) + ((s3[0] + s3[1]) + (s3[2] + s3[3]));
        const float r = rsqrtf(sq * (1.0f / D) + EPS);
        float gl[4];
#pragma unroll
        for (int j = 0; j < 4; ++j) gl[j] = r * (lg[j] + lg[16 + j]) + rgb[j];
        int gs = 0; float gm = gl[0];
#pragma unroll
        for (int j = 1; j < 4; ++j) if (gl[j] > gm) { gm = gl[j]; gs = j; }
        float den = 0.f;
#pragma unroll
        for (int j = 0; j < 4; ++j) den += expf(gl[j] - gm);
        const float gwt = 1.0f / den;
        float el[4];
#pragma unroll
        for (int j = 0; j < 4; ++j) { float v;
            if (gs < 3) v = lg[4 + 4 * gs + j] + lg[16 + 4 + 4 * gs + j]; else v = lg[32 + j] + lg[36 + j];
            el[j] = r * v + reb[gs * 4 + j]; }
        int i0 = 0; float v0 = el[0];
#pragma unroll
        for (int j = 1; j < 4; ++j) if (el[j] > v0) { v0 = el[j]; i0 = j; }
        int i1 = 0; float v1 = -3.0e38f;
#pragma unroll
        for (int j = 0; j < 4; ++j) if (j != i0 && el[j] > v1) { v1 = el[j]; i1 = j; }
        const float e1 = expf(v1 - v0); const float w0 = gwt / (1.0f + e1), w1 = gwt * e1 / (1.0f + e1);
        const int lo = i0 < i1 ? i0 : i1, hi = i0 < i1 ? i1 : i0; const int cls = gs * 6 + pair_idx(lo, hi);
        CLS[t] = cls; G2[(size_t)t * 2 + 0] = i0 < i1 ? w0 : w1; G2[(size_t)t * 2 + 1] = i0 < i1 ? w1 : w0;
        __hip_atomic_fetch_add(hist + cls, 1, __ATOMIC_RELAXED, __HIP_MEMORY_SCOPE_WORKGROUP); }
}

__device__ __forceinline__ void tr_item8(const float* W, int ldw, int k0, int scol0, unsigned char* WT, int ldo, int drow0, int dk0, LAS float* scr, int lane) {
#pragma unroll 8
    for (int i = 0; i < 32; ++i) { const int kk = 2 * i + (lane >> 5); scr[kk * 33 + (lane & 31)] = W[(size_t)(k0 + kk) * ldw + scol0 + (lane & 31)] * pg8::FS_W; }
    asm volatile("s_waitcnt lgkmcnt(0)" ::: "memory");
    const int c = lane & 7;
#pragma unroll
    for (int j = 0; j < 4; ++j) { const int n = (lane >> 3) + 8 * j; const LAS float* s = scr + (8 * c) * 33 + n;
        u32x2 o; o.x = pk_fp8x4(s[0 * 33], s[1 * 33], s[2 * 33], s[3 * 33]); o.y = pk_fp8x4(s[4 * 33], s[5 * 33], s[6 * 33], s[7 * 33]);
        *(u32x2*)(WT + (size_t)(drow0 + n) * ldo + dk0 + 8 * c) = o; }
    asm volatile("s_waitcnt lgkmcnt(0)" ::: "memory");
}
struct TrP { const float* src; const float* gk; unsigned char* dst; int ldw, ldo, fp8; };
__device__ __forceinline__ void tr_load(const TrP& P, int lane, float (&v)[32]) {
#pragma unroll
    for (int i = 0; i < 32; ++i) { const int kk = 2 * i + (lane >> 5); float x = P.src[(size_t)kk * P.ldw + (lane & 31)]; if (P.gk) x *= P.gk[kk]; v[i] = x; }
}
__device__ __forceinline__ void tr_store(const TrP& P, int lane, const float (&v)[32], LAS float* scr) {
    const float sc = P.fp8 ? pg8::FS_W : 1.0f;
#pragma unroll
    for (int i = 0; i < 32; ++i) scr[(2 * i + (lane >> 5)) * 33 + (lane & 31)] = v[i] * sc;
    asm volatile("s_waitcnt lgkmcnt(0)" ::: "memory");
    const int c = lane & 7;
#pragma unroll
    for (int j = 0; j < 4; ++j) { const int n = (lane >> 3) + 8 * j; const LAS float* s = scr + (8 * c) * 33 + n;
        if (P.fp8) { u32x2 o; o.x = pk_fp8x4(s[0 * 33], s[1 * 33], s[2 * 33], s[3 * 33]); o.y = pk_fp8x4(s[4 * 33], s[5 * 33], s[6 * 33], s[7 * 33]); *(u32x2*)(P.dst + (size_t)n * P.ldo + 8 * c) = o; }
        else { u32x4 o; o.x = cvt_pk_bf16(s[0 * 33], s[1 * 33]); o.y = cvt_pk_bf16(s[2 * 33], s[3 * 33]); o.z = cvt_pk_bf16(s[4 * 33], s[5 * 33]); o.w = cvt_pk_bf16(s[6 * 33], s[7 * 33]); *(u32x4*)(P.dst + (size_t)n * P.ldo + 16 * c) = o; } }
    asm volatile("s_waitcnt lgkmcnt(0)" ::: "memory");
}
struct Args { const float* in[34]; float* out; unsigned char* ws; };

__global__ void __launch_bounds__(512, 2) mega_fwd(Args a) {
    extern __shared__ __attribute__((aligned(16))) unsigned char lds_raw[];
    LAS unsigned char* lds = (LAS unsigned char*)lds_raw;
    volatile LAS unsigned* LW = (volatile LAS unsigned*)(lds + LDSCTL_OFF);
    volatile LAS int* LWI = (volatile LAS int*)(lds + LDSCTL_OFF);
    const int G = gridDim.x, bid0 = blockIdx.x; const int wave_s0 = __builtin_amdgcn_readfirstlane(threadIdx.x >> 6);
#define PHASE_IDS() int wv_ = wave_s0, bd_ = bid0; asm volatile("" : "+s"(wv_), "+s"(bd_)); const int wave_s = wv_, bid = bd_;     \
    const int lane = fresh_lane(), wave = wave_s, tid = wave * 64 + lane; const int gw = bid * 8 + wave, NGW = G * 8; \
    const size_t gt = (size_t)bid * 512 + tid, NGT = (size_t)G * 512; (void)lane; (void)wave; (void)gw; (void)NGW; (void)gt; (void)NGT
#define WSB() ({ unsigned char* _w = a.ws; asm volatile("" : "+s"(_w)); _w; })
#define INP(i) ({ int _k = (i); asm volatile("" : "+s"(_k)); a.in[_k]; })
    for (int u = threadIdx.x; u < (LDS_PF - LDSCTL_OFF) / 4; u += 512) LW[u] = 0u;
    __syncthreads();
    XcdBarrier bar = xcd_barrier_post((unsigned*)(a.ws + WS_CTL) + CW_BAR, LW + LW_BAR);

    {
        PHASE_IDS(); unsigned char* ws = WSB(); bf16_t* WIN = (bf16_t*)(ws + WS_WIN); bf16_t* WOUT = (bf16_t*)(ws + WS_WOUT); bf16_t* WGU = (bf16_t*)(ws + WS_WGU); bf16_t* WD2 = (bf16_t*)(ws + WS_WD2);
        bf16_t* HB = (bf16_t*)(ws + WS_HB); float* SSQ = (float*)(ws + WS_SSQ);
        LAS float* scr = (LAS float*)(lds + wave * 16384);
        constexpr int I_IN = 16 * 56, I_OUT = 16 * 32, I_GU = 2 * 16 * 256, I_D8 = 16 * 256, I_GLU = 32, I_RG = 24, I_L = I_IN + I_OUT + I_GU + I_D8 + I_GLU + I_RG;
        const float* i_win = INP(2); const float* i_g = INP(1); const float* i_wout = INP(24); const float* i_wg = INP(30); const float* i_wu = INP(31); const float* i_wd = INP(32);
        const float* i_glu = INP(21); const float* i_rg = INP(8); const float* i_ig = INP(10);
#define TR_DECODE(P, it) do { const int l = (it) / I_L; int r = (it) % I_L; P.gk = nullptr; P.fp8 = 0; \
            if (r < I_IN) { const int kb = r / 56, nb = r % 56, j0 = nb * 32; const int sc = j0 < 768 ? j0 : (j0 < 1152 ? j0 + 384 : (j0 < 1536 ? j0 - 384 : j0));     \
                P.src = i_win + (size_t)l * D * INC + (size_t)kb * 64 * INC + sc; P.ldw = INC; P.gk = i_g + (size_t)l * D + kb * 64; P.dst = (unsigned char*)(WIN + (size_t)l * INC * D + (size_t)j0 * D + kb * 64); P.ldo = D * 2; } \
            else if ((r -= I_IN) < I_OUT) { const int kb = r / 32, nb = r % 32; P.src = i_wout + (size_t)l * D * D + (size_t)kb * 64 * D + nb * 32; P.ldw = D; P.dst = (unsigned char*)(WOUT + (size_t)l * D * D + (size_t)nb * 32 * D + kb * 64); P.ldo = D * 2; } \
            else if ((r -= I_OUT) < I_GU) { const int which = r / (16 * 256), e = (r / 256) % 16, q = r % 256, kb = q / 16, nb = q % 16, n0 = nb * 32;     \
                P.src = (which ? i_wu : i_wg) + ((size_t)l * NE + e) * D * DE + (size_t)kb * 64 * DE + n0; P.ldw = DE; P.fp8 = 1; \
                P.dst = (unsigned char*)WGU + ((size_t)l * NE + e) * 1024 * 1024 + (size_t)((n0 / 128) * 256 + which * 128 + (n0 % 128)) * 1024 + kb * 64; P.ldo = 1024; } \
            else if ((r -= I_GU) < I_D8) { const int e = r / 256, q = r % 256, kb = q / 32, nb = q % 32;        \
                P.src = i_wd + ((size_t)l * NE + e) * DE * D + (size_t)kb * 64 * D + nb * 32; P.ldw = D; P.fp8 = 1; P.dst = ws + WS_WD8 + ((size_t)l * NE + e) * 1024 * 512 + (size_t)nb * 32 * 512 + kb * 64; P.ldo = 512; } \
            else if ((r -= I_D8) < I_GLU) { const int kb = r / 8, nb = r % 8; P.src = i_glu + (size_t)l * CW * CW + (size_t)kb * 64 * CW + nb * 32; P.ldw = CW; P.dst = (unsigned char*)((bf16_t*)(ws + WS_WGLU) + (size_t)l * CW * CW + (size_t)nb * 32 * CW + kb * 64); P.ldo = CW * 2; } \
            else { r -= I_GLU; const int gate = r / 12, h = (r / 2) % 6, nb = r & 1; \
                P.src = (gate ? i_ig : i_rg) + ((size_t)l * 6 + h) * 64 * 64 + nb * 32; P.ldw = 64; P.dst = (unsigned char*)((bf16_t*)(ws + WS_WRG) + (((size_t)l * 2 + gate) * 6 + h) * 64 * 64 + (size_t)nb * 32 * 64); P.ldo = 64 * 2; } } while (0)
        { TrP Pa, Pb; float va[32], vb[32]; int it = gw;
          if (it < 2 * I_L) { TR_DECODE(Pa, it); tr_load(Pa, lane, va); }
#pragma unroll 1
          while (it < 2 * I_L) {
              const int it1 = it + NGW; if (it1 < 2 * I_L) { TR_DECODE(Pb, it1); tr_load(Pb, lane, vb); }
              tr_store(Pa, lane, va, scr);
              if (it1 >= 2 * I_L) break;
              const int it2 = it1 + NGW; if (it2 < 2 * I_L) { TR_DECODE(Pa, it2); tr_load(Pa, lane, va); }
              tr_store(Pb, lane, vb, scr);
              it = it2; } }
#undef TR_DECODE
        { const float* s_are = INP(13); const float* s_aim = INP(14); const float* s_ldt = INP(15); const float* s_bre = INP(16); const float* s_bim = INP(17); const float* s_cre = INP(18); const float* s_cim = INP(19); const float* s_d = INP(20);
          for (size_t e = gt; e < (size_t)2 * CG * 256; e += NGT) { const int l = (int)(e / (CG * 256)), g = (int)((e / 256) % CG), c = (int)((e >> 4) & 15), cp = (int)(e & 15);
              s5_kt_pair(g, c, cp, s_are + (size_t)l * CG * CS, s_aim + (size_t)l * CG * CS, s_ldt + (size_t)l * CG, s_bre + (size_t)l * CG * CS * CGD, s_bim + (size_t)l * CG * CS * CGD,
                         s_cre + (size_t)l * CG * CGD * CS, s_cim + (size_t)l * CG * CGD * CS, s_d + (size_t)l * CW, ws + WS_S5 + (size_t)l * S5_L_STRIDE); }
          for (size_t e = gt; e < (size_t)2 * CG * 2048; e += NGT) { const int l = (int)(e / (CG * 2048)), g = (int)((e / 2048) % CG), r = (int)(e & 2047);
              s5_et_task(g, r >> 10, (r >> 4) & 63, r & 15, s_are + (size_t)l * CG * CS, s_aim + (size_t)l * CG * CS, s_ldt + (size_t)l * CG, s_bre + (size_t)l * CG * CS * CGD, s_bim + (size_t)l * CG * CS * CGD, ws + WS_S5 + (size_t)l * S5_L_STRIDE);
              s5_ft_task(g, r >> 7, (r >> 6) & 1, r & 63, s_are + (size_t)l * CG * CS, s_aim + (size_t)l * CG * CS, s_ldt + (size_t)l * CG, s_cre + (size_t)l * CG * CGD * CS, s_cim + (size_t)l * CG * CGD * CS, ws + WS_S5 + (size_t)l * S5_L_STRIDE); }
          for (size_t e = gt; e < (size_t)2 * CG * 64; e += NGT) { const int l = (int)(e / (CG * 64)), g = (int)((e / 64) % CG), el = 4096 + 32768 + (int)(e % 64);
              s5_table_elem(g, el, s_are + (size_t)l * CG * CS, s_aim + (size_t)l * CG * CS, s_ldt + (size_t)l * CG, s_bre + (size_t)l * CG * CS * CGD, s_bim + (size_t)l * CG * CS * CGD,
                            s_cre + (size_t)l * CG * CGD * CS, s_cim + (size_t)l * CG * CGD * CS, s_d + (size_t)l * CW, ws + WS_S5 + (size_t)l * S5_L_STRIDE); } }
        { const float* sw = INP(4); bf16_t* wsp = (bf16_t*)(ws + WS_WSP); for (size_t e = gt; e < (size_t)2 * 6 * 128 * 128; e += NGT) wsp[e] = f2bf(sw[e]); }
        { const float* fg = INP(25); const float* rgw = INP(26); const float* rew = INP(28); bf16_t* wrt = (bf16_t*)(ws + WS_WRT);
          for (size_t e = gt; e < (size_t)2 * 48 * D; e += NGT) { const int l = (int)(e / (48 * D)), n = (int)((e / D) % 48), k = (int)(e % D);
              int j = -1, lo = 0; if (n < 16) j = n; else if (n < 32) { j = n - 16; lo = 1; } else if (n < 36) j = 16 + (n - 32); else if (n < 40) { j = 16 + (n - 36); lo = 1; }
              float v = 0.f;
              if (j >= 0) { const float w = fg[(size_t)l * D + k] * (j < 4 ? rgw[((size_t)l * D + k) * 4 + j] : rew[(((size_t)l * 4 + ((j - 4) >> 2)) * D + k) * 4 + ((j - 4) & 3)]);
                  const float hi = bf2f(f2bf(w)); v = lo ? (w - hi) : w; }
              wrt[e] = f2bf(v); } }
        const float* xin = INP(0);
#pragma unroll 1
        for (int t = gw * 2; t < T; t += NGW * 2) {
            const f32x4* xr = (const f32x4*)(xin + (size_t)t * D) + lane; f32x4 v[2][4]; float s0 = 0.f, s1 = 0.f;
#pragma unroll
            for (int j = 0; j < 4; ++j) { v[0][j] = xr[64 * j]; v[1][j] = xr[256 + 64 * j]; }
#pragma unroll
            for (int j = 0; j < 4; ++j) { s0 += (v[0][j][0] * v[0][j][0] + v[0][j][1] * v[0][j][1]) + (v[0][j][2] * v[0][j][2] + v[0][j][3] * v[0][j][3]); s1 += (v[1][j][0] * v[1][j][0] + v[1][j][1] * v[1][j][1]) + (v[1][j][2] * v[1][j][2] + v[1][j][3] * v[1][j][3]); }
            u32x2* o8 = (u32x2*)(HB + (size_t)t * D) + lane;
#pragma unroll
            for (int j = 0; j < 4; ++j) { u32x2 w; w.x = cvt_pk_bf16(v[0][j][0], v[0][j][1]); w.y = cvt_pk_bf16(v[0][j][2], v[0][j][3]); o8[64 * j] = w; w.x = cvt_pk_bf16(v[1][j][0], v[1][j][1]); w.y = cvt_pk_bf16(v[1][j][2], v[1][j][3]); o8[256 + 64 * j] = w; }
            s0 = wave_sum(s0); s1 = wave_sum(s1);
            if (lane < 32) SSQ[(size_t)t * 16 + lane] = lane == 0 ? s0 : (lane == 16 ? s1 : 0.f);
        }
    }
    xcd_barrier(bar);

    for (int l = 0; l < DEPTH; ++l) {
        { PHASE_IDS(); unsigned char* ws = WSB(); bf16_t* WIN = (bf16_t*)(ws + WS_WIN); bf16_t* HB = (bf16_t*)(ws + WS_HB); float* SSQ = (float*)(ws + WS_SSQ); bf16_t* Z = (bf16_t*)(ws + WS_Z);
          pg8::StaticOrder<T, INC> S; S.init(HB, WIN + (size_t)l * INC * D, G, bid);
          pg8::EpiZ E{Z, SSQ, lds + LDS_PF};
          pg8::gemm_phase<pg8::EpiZ, pg8::StaticOrder<T, INC>, true, true>(lds, wave_s, S, E); }
        xcd_barrier(bar);

        {
            PHASE_IDS(); unsigned char* ws = WSB(); const bf16_t* Z = (const bf16_t*)(ws + WS_Z);
            const float* conv_w = INP(6) + (size_t)l * 4 * BW; const float* conv_b = INP(7) + (size_t)l * BW; const float* rg_b = INP(9) + (size_t)l * BW;
            const float* ig_b = INP(11) + (size_t)l * BW; const float* lam = INP(12) + (size_t)l * BW;
            __syncthreads();
            { const bf16_t* WRG = (const bf16_t*)(ws + WS_WRG) + ((size_t)l * 2 + 0) * 6 * 4096; const bf16_t* WIG = (const bf16_t*)(ws + WS_WRG) + ((size_t)l * 2 + 1) * 6 * 4096;
              for (int pr = bid; pr < NU128 / 2; pr += G) { float cp = 0.f;
                  rglru_unit<1>(2 * pr, true, cp, tid, wave, lane, Z, nullptr, WRG, WIG, conv_w, conv_b, rg_b, ig_b, lam, nullptr, (float*)(ws + WS_SUMA), (float*)(ws + WS_SUMH), (float*)(ws + WS_SUMA2), (float*)(ws + WS_SUMH2), (bf16_t*)(ws + WS_HL), (bf16_t*)(ws + WS_PP), lds);
                  rglru_unit<1>(2 * pr + 1, false, cp, tid, wave, lane, Z, nullptr, WRG, WIG, conv_w, conv_b, rg_b, ig_b, lam, nullptr, (float*)(ws + WS_SUMA), (float*)(ws + WS_SUMH), (float*)(ws + WS_SUMA2), (float*)(ws + WS_SUMH2), (bf16_t*)(ws + WS_HL), (bf16_t*)(ws + WS_PP), lds); } }
            for (int pr = bid; pr < NU128 / 2; pr += G) { const unsigned char* tab = ws + WS_S5 + (size_t)l * S5_L_STRIDE;
                s5_pair1(pr, 2 * wave, wave, lane, Z, (bf16_t*)(ws + WS_Y), tab, (float*)(ws + WS_SEND), (float*)(ws + WS_SEND2), (float*)(ws + WS_SE), lds);
                s5_pair1(pr, 2 * wave + 1, wave, lane, Z, (bf16_t*)(ws + WS_Y), tab, (float*)(ws + WS_SEND), (float*)(ws + WS_SEND2), (float*)(ws + WS_SE), lds); }
            __syncthreads();
            { const bf16_t* WSP = (const bf16_t*)(ws + WS_WSP) + (size_t)l * 6 * 128 * 128; const float* a_sb = INP(5) + (size_t)l * 6 * 128; const float* vg = INP(3) + (size_t)l * AW; const float* mo_ga = INP(23) + (size_t)l * D;
              for (int u = bid; u < NU128; u += G) mixa_unit(u, tid, wave, lane, Z, (bf16_t*)(ws + WS_Y), WSP, a_sb, vg, mo_ga, lds); }
        }
        xcd_barrier(bar);

        {
            PHASE_IDS(); unsigned char* ws = WSB(); const bf16_t* Z = (const bf16_t*)(ws + WS_Z); bf16_t* Y = (bf16_t*)(ws + WS_Y);
            const float* a_v_norm_g = INP(3) + (size_t)l * AW; const float* a_sw = INP(4) + (size_t)l * 6 * 128 * 128; const float* a_sb = INP(5) + (size_t)l * 6 * 128;
        }

        { PHASE_IDS(); unsigned char* ws = WSB(); const bf16_t* Z = (const bf16_t*)(ws + WS_Z); bf16_t* Y = (bf16_t*)(ws + WS_Y);
          { const float* mo_gb = INP(23) + (size_t)l * D + AW;
            __syncthreads();
            for (int pr = bid; pr < NU128 / 2; pr += G) rglru_fix_pair(pr, tid, wave, lane, Z, Y, (const bf16_t*)(ws + WS_HL), (const bf16_t*)(ws + WS_PP), (const float*)(ws + WS_SUMA2), (const float*)(ws + WS_SUMH2), mo_gb, lds); }
          { const bf16_t* WGLU = (const bf16_t*)(ws + WS_WGLU) + (size_t)l * CW * CW; const float* glu_b = INP(22) + (size_t)l * CW; const float* mo_gc = INP(23) + (size_t)l * D + AW + BW;
            for (int pr = bid; pr < NU128 / 2; pr += G) { float k0r = 0.f, k0i = 0.f, k1r = 0.f, k1i = 0.f; const unsigned char* tab = ws + WS_S5 + (size_t)l * S5_L_STRIDE;
#pragma unroll 1
                for (int ui = 0; ui < 2; ++ui) { const int u = 2 * pr + ui; __syncthreads();
                    s5_group<2>(u, 2 * wave, ui == 0, k0r, k0i, wave, lane, Z, Y, tab, (float*)(ws + WS_SEND), (float*)(ws + WS_SEND2), (float*)(ws + WS_SE), lds);
                    s5_group<2>(u, 2 * wave + 1, ui == 0, k1r, k1i, wave, lane, Z, Y, tab, (float*)(ws + WS_SEND), (float*)(ws + WS_SEND2), (float*)(ws + WS_SE), lds);
                    __syncthreads(); s5_glu(u, wave, lane, WGLU, glu_b, mo_gc, Y, lds); } } } }
        asm volatile("s_waitcnt vmcnt(0)" ::: "memory"); __syncthreads();
        if (wave_s0 == 0) { __builtin_amdgcn_fence(__ATOMIC_ACQUIRE, "agent"); asm volatile("s_waitcnt vmcnt(0)" ::: "memory"); }
        __syncthreads();

        { PHASE_IDS(); unsigned char* ws = WSB(); bf16_t* WOUT = (bf16_t*)(ws + WS_WOUT); bf16_t* HB = (bf16_t*)(ws + WS_HB); float* SSQ = (float*)(ws + WS_SSQ); bf16_t* Y = (bf16_t*)(ws + WS_Y);
          pg8::PanelOrder<T, 4> S; S.init(Y, WOUT + (size_t)l * D * D, G, bid);
          pg8::EpiRes<false> E{HB, SSQ, nullptr, lds + LDS_PF};
          pg8::gemm_phase<pg8::EpiRes<false>, pg8::PanelOrder<T, 4>, true, true>(lds, wave_s, S, E); }
        asm volatile("s_waitcnt vmcnt(0)" ::: "memory"); __syncthreads();
        if (wave_s0 == 0) { __builtin_amdgcn_fence(__ATOMIC_ACQUIRE, "agent"); asm volatile("s_waitcnt vmcnt(0)" ::: "memory"); }
        __syncthreads();

        { PHASE_IDS(); unsigned char* ws = WSB(); const bf16_t* HB = (const bf16_t*)(ws + WS_HB); const float* SSQ = (const float*)(ws + WS_SSQ); int* CLS = (int*)(ws + WS_CLS); float* G2 = (float*)(ws + WS_G2); int* HIST = (int*)(ws + WS_HIST);
          const float* rgb = INP(27) + (size_t)l * 4; const float* reb = INP(29) + (size_t)l * 16;
        if (l == 0) {
            for (int rr = gw; rr < 2 * NCLS * 2 * 1024 / 2; rr += NGW) { const int row = 2 * rr + (lane >> 5), n = row & 1023, half = (row >> 10) & 1, cls = (row >> 11) % NCLS, ll = row / (2048 * NCLS);
                const int g = cls / 6, pi = cls % 6, e = g * 4 + (half ? pair_hi(pi) : pair_lo(pi));
                const u32x4 v = *(const u32x4*)(ws + WS_WD8 + ((size_t)ll * NE + e) * 1024 * 512 + (size_t)n * 512 + (lane & 31) * 16);
                *(u32x4*)(ws + WS_WD2 + ((size_t)ll * NCLS + cls) * 1024 * 1024 + (size_t)n * 1024 + half * 512 + (lane & 31) * 16) = v; } }
        for (int u = bid; u < NU; u += G) {
            router_unit(u, wave, lane, HB, SSQ, (const bf16_t*)(ws + WS_WRT) + (size_t)l * 48 * D, rgb, reb, CLS, G2, lds, (LAS int*)(lds + LDSCTL_OFF) + LW_HIST);
            __syncthreads();
            if (tid < 32) { HIST[u * 32 + tid] = tid < NCLS ? LWI[LW_HIST + tid] : 0; LWI[LW_HIST + tid] = 0; }
            __syncthreads();
        } }
        xcd_barrier(bar);

        { PHASE_IDS(); unsigned char* ws = WSB(); const bf16_t* HB = (const bf16_t*)(ws + WS_HB); const float* SSQ = (const float*)(ws + WS_SSQ); const int* CLS = (const int*)(ws + WS_CLS); const float* G2 = (const float*)(ws + WS_G2); const int* HIST = (const int*)(ws + WS_HIST);
          int* CTOT = (int*)(ws + WS_CTOT); int* ROWTOK = (int*)(ws + WS_ROWTOK); float* ROWG = (float*)(ws + WS_ROWG); bf16_t* HBS = (bf16_t*)(ws + WS_HBS); const float* ffn_g = INP(25) + (size_t)l * D;
        for (int u = bid; u < NU; u += G) {
            { const int c = tid & 31, part = tid >> 5; int tot = 0, pre = 0;
_Pragma("unroll 16")
              for (int k = part * 16; k < part * 16 + 16; ++k) { const int v = HIST[k * 32 + c]; tot += v; pre += k < u ? v : 0; }
              ((volatile LAS int*)lds)[tid] = tot; ((volatile LAS int*)lds)[512 + tid] = pre; }
            __syncthreads();
            if (tid < NCLS) { int tot = 0, pre = 0;
_Pragma("unroll")
                for (int k = 0; k < 16; ++k) { tot += ((volatile LAS int*)lds)[k * 32 + tid]; pre += ((volatile LAS int*)lds)[512 + k * 32 + tid]; } LWI[LW_TOT + tid] = tot; LWI[LW_BASE + tid] = pre; }
            __syncthreads();
            if (tid == 0) { int ps = 0;
_Pragma("unroll 1")
                for (int c = 0; c < NCLS; ++c) { const int tot = LWI[LW_TOT + c]; LWI[LW_BASE + c] += ps; LWI[LW_TST + c] = ps; ps += ((tot + 255) >> 8) << 8; if (bid == 0) CTOT[c] = tot; } LWI[LW_TST + NCLS] = ps; }
            if (tid < UT) LWI[LW_CLS + tid] = CLS[u * UT + tid];
            __syncthreads();
            if (tid < UT) { const int cls = LWI[LW_CLS + tid]; int rank = 0;
_Pragma("unroll 1")
                for (int i = 0; i < tid; ++i) rank += LWI[LW_CLS + i] == cls ? 1 : 0;
                const int dest = LWI[LW_BASE + cls] + rank; LWI[LW_DEST + tid] = dest; const int t = u * UT + tid;
                ROWTOK[dest] = t; ROWG[(size_t)dest * 2 + 0] = G2[(size_t)t * 2 + 0]; ROWG[(size_t)dest * 2 + 1] = G2[(size_t)t * 2 + 1]; }
            __syncthreads();
            { f32x4 gq[4];
#pragma unroll
              for (int j = 0; j < 4; ++j) gq[j] = *(const f32x4*)(ffn_g + (j >> 1) * 512 + lane * 8 + 4 * (j & 1));
#pragma unroll 1
              for (int i = 0; i < 32; i += 4) {
                  const int tl0 = wave * 32 + i, t0r = u * UT + tl0;
                  float sq = SSQ[(size_t)t0r * 16 + lane]; sq += x_xor1(sq); sq += x_xor2(sq); sq += x_hmir(sq); sq += x_mir(sq);
                  u32x4 o[4][2]; int dst[4];
#pragma unroll
                  for (int j = 0; j < 4; ++j) { o[j][0] = *(const u32x4*)(HB + (size_t)(t0r + j) * D + lane * 8); o[j][1] = *(const u32x4*)(HB + (size_t)(t0r + j) * D + 512 + lane * 8); dst[j] = LWI[LW_DEST + tl0 + j]; }
#pragma unroll
                  for (int j = 0; j < 4; ++j) { const float r4 = rsqrtf(__builtin_amdgcn_readlane(sq, 16 * j) * (1.0f / D) + EPS) * pg8::FS_H; u32x4 w;
#pragma unroll
                      for (int hh = 0; hh < 2; ++hh) { const u32x4 oo = o[j][hh]; const f32x4 g0 = gq[2 * hh], g1 = gq[2 * hh + 1];
                          const unsigned lo = pk_fp8x4(__uint_as_float(oo.x << 16) * r4 * g0[0], __uint_as_float(oo.x & 0xffff0000u) * r4 * g0[1], __uint_as_float(oo.y << 16) * r4 * g0[2], __uint_as_float(oo.y & 0xffff0000u) * r4 * g0[3]);
                          const unsigned hi = pk_fp8x4(__uint_as_float(oo.z << 16) * r4 * g1[0], __uint_as_float(oo.z & 0xffff0000u) * r4 * g1[1], __uint_as_float(oo.w << 16) * r4 * g1[2], __uint_as_float(oo.w & 0xffff0000u) * r4 * g1[3]);
                          if (hh == 0) { w.x = lo; w.y = hi; } else { w.z = lo; w.w = hi; } }
                      *(u32x2*)((unsigned char*)HBS + (size_t)dst[j] * D + lane * 8) = (u32x2){w.x, w.y}; *(u32x2*)((unsigned char*)HBS + (size_t)dst[j] * D + 512 + lane * 8) = (u32x2){w.z, w.w}; } } }
            if (u == bid)
_Pragma("unroll 1")
            for (int c = bid; c < NCLS; c += G) { const int tot = LWI[LW_TOT + c], r0 = LWI[LW_TST + c] + tot, r1 = LWI[LW_TST + c + 1];
                unsigned zz = 0u; asm volatile("" : "+v"(zz));
                for (int r = r0 + wave; r < r1; r += 8) { if (lane == 0) { ROWTOK[r] = -1; ROWG[(size_t)r * 2] = __uint_as_float(zz); ROWG[(size_t)r * 2 + 1] = __uint_as_float(zz); }
                    *(u32x4*)((unsigned char*)HBS + (size_t)r * D + lane * 16) = (u32x4){zz, zz, zz, zz}; } }
            __syncthreads();
        } }
        xcd_barrier(bar);

        { PHASE_IDS(); unsigned char* ws = WSB(); const int* CTOT = (const int*)(ws + WS_CTOT); bf16_t* HBS = (bf16_t*)(ws + WS_HBS); bf16_t* WGU = (bf16_t*)(ws + WS_WGU); bf16_t* ACT = (bf16_t*)(ws + WS_ACT); const float* ROWG = (const float*)(ws + WS_ROWG);
        if (tid == 0) { int ps = 0;
_Pragma("unroll 1")
            for (int c = 0; c < NCLS; ++c) { LWI[LW_TST + c] = ps; ps += (CTOT[c] + 255) >> 8; } LWI[LW_TST + NCLS] = ps; }
        __syncthreads();
        if (tid < 32) { const int ntile = LWI[LW_TST + NCLS]; const long L = (long)tid * G + bid; int e = -1;
            if (L < (long)ntile * 8) { const int nwg = ntile * 8, qq = nwg / 8, rr = nwg % 8, xcd = (int)(L % 8), off = (int)(L / 8); const int Lr = (xcd < rr ? xcd * (qq + 1) : rr * (qq + 1) + (xcd - rr) * qq) + off;
                const int mt = Lr / 8, pn = Lr % 8; int cls = 0;
_Pragma("unroll 1")
                for (int k = 1; k < NCLS; ++k) cls += (LWI[LW_TST + k] <= mt) ? 1 : 0;
                e = (cls << 24) | (pn << 16) | mt; }
            LWI[LW_UTAB + tid] = e; e = -1;
            if (L < (long)ntile * 4) { const int nwg = ntile * 4, qq = nwg / 8, rr = nwg % 8, xcd = (int)(L % 8), off = (int)(L / 8); const int Lr = (xcd < rr ? xcd * (qq + 1) : rr * (qq + 1) + (xcd - rr) * qq) + off;
                const int mt = Lr / 4, pn = Lr % 4; int cls = 0;
_Pragma("unroll 1")
                for (int k = 1; k < NCLS; ++k) cls += (LWI[LW_TST + k] <= mt) ? 1 : 0;
                e = (cls << 24) | (pn << 16) | mt; }
            LWI[LW_DTAB + tid] = e; }
        __syncthreads();
        { pg8::MoeOrder<8, true, 1024> S{LWI + LW_UTAB, l, (const char*)HBS, (const char*)WGU};
          pg8::EpiUp E{(unsigned char*)ACT, ROWG, lds + LDS_PF};
          pg8::gemm_phase<pg8::EpiUp, pg8::MoeOrder<8, true, 1024>, true, true, 512, true>(lds, wave_s, S, E); } }
        xcd_barrier(bar);

        { PHASE_IDS(); unsigned char* ws = WSB(); bf16_t* ACT = (bf16_t*)(ws + WS_ACT); bf16_t* WD2 = (bf16_t*)(ws + WS_WD2); bf16_t* HB = (bf16_t*)(ws + WS_HB); float* SSQ = (float*)(ws + WS_SSQ); const int* ROWTOK = (const int*)(ws + WS_ROWTOK);
          pg8::MoeOrder<4, false, 1024> S{LWI + LW_DTAB, l, (const char*)ACT, (const char*)WD2};
          pg8::EpiRes<true> E{HB, SSQ, ROWTOK, lds + LDS_PF};
          pg8::gemm_phase<pg8::EpiRes<true>, pg8::MoeOrder<4, false, 1024>, true, true, 512, true>(lds, wave_s, S, E); }
        xcd_barrier(bar);
    }

    { PHASE_IDS(); unsigned char* ws = WSB(); const bf16_t* HB = (const bf16_t*)(ws + WS_HB); const float* SSQ = (const float*)(ws + WS_SSQ); const float* fg = INP(33); float* outp = a.out;
    { f32x4 gq[4];
#pragma unroll
      for (int q = 0; q < 4; ++q) gq[q] = *(const f32x4*)(fg + 256 * q + 4 * lane);
#pragma unroll 1
      for (int t0r = gw * 4; t0r < T; t0r += NGW * 4) {
          float sq = SSQ[(size_t)t0r * 16 + lane]; sq += x_xor1(sq); sq += x_xor2(sq); sq += x_hmir(sq); sq += x_mir(sq);
          u32x2 o[4][4];
#pragma unroll
          for (int j = 0; j < 4; ++j)
#pragma unroll
              for (int q = 0; q < 4; ++q) o[j][q] = *(const u32x2*)(HB + (size_t)(t0r + j) * D + 256 * q + 4 * lane);
#pragma unroll
          for (int j = 0; j < 4; ++j) { const float r = rsqrtf(__builtin_amdgcn_readlane(sq, 16 * j) * (1.0f / D) + EPS); float* orow = outp + (size_t)(t0r + j) * D + 4 * lane;
#pragma unroll
              for (int q = 0; q < 4; ++q) { const u32x2 oo = o[j][q]; const f32x4 g0 = gq[q]; f32x4 w0;
                  w0[0] = __uint_as_float(oo.x << 16) * r * g0[0]; w0[1] = __uint_as_float(oo.x & 0xffff0000u) * r * g0[1]; w0[2] = __uint_as_float(oo.y << 16) * r * g0[2]; w0[3] = __uint_as_float(oo.y & 0xffff0000u) * r * g0[3];
                  *(f32x4*)(orow + 256 * q) = w0; } } } }
}
}

extern "C" void kernel_launch(void* const* d_in, const int* in_sizes, int n_in, void* d_out, int out_size, void* d_ws, size_t ws_size, hipStream_t stream) {
    static int grid = 0;
    if (grid == 0) {
        if (n_in != 34 || in_sizes[0] != T * D || out_size != T * D || ws_size < WS_END) { fprintf(stderr, "kernel_launch: unexpected shapes (n_in %d, ws %zu)\n", n_in, ws_size); grid = -1; return; }
        int dev = 0, cus = 0, per_cu = 0;
        if (hipGetDevice(&dev) != hipSuccess || hipDeviceGetAttribute(&cus, hipDeviceAttributeMultiprocessorCount, dev) != hipSuccess) { grid = -1; return; }
        if (hipFuncSetAttribute((const void*)mega_fwd, hipFuncAttributeMaxDynamicSharedMemorySize, LDS_BYTES) != hipSuccess) { fprintf(stderr, "kernel_launch: hipFuncSetAttribute failed\n"); grid = -1; return; }
        if (hipOccupancyMaxActiveBlocksPerMultiprocessor(&per_cu, (const void*)mega_fwd, 512, LDS_BYTES) != hipSuccess || per_cu < 1) { fprintf(stderr, "kernel_launch: occupancy query says %d\n", per_cu); }
        (void)hipGetLastError();
        grid = cus;
    }
    if (grid < 0) return;
    (void)hipMemsetAsync((char*)d_ws + WS_CTL, 0, CTL_ZERO_BYTES, stream);
    Args a{};
    for (int i = 0; i < 34; ++i) a.in[i] = (const float*)d_in[i];
    a.out = (float*)d_out; a.ws = (unsigned char*)d_ws;
    hipLaunchKernelGGL(mega_fwd, dim3(grid), dim3(512), LDS_BYTES, stream, a);
}
```

```cpp
#include <hip/hip_runtime.h>
#include <cstdio>
#include <cstdint>

#define LAS __attribute__((address_space(3)))
typedef unsigned short bf16_t;
typedef short bf16x8 __attribute__((ext_vector_type(8)));
typedef float f32x4 __attribute__((ext_vector_type(4)));
typedef float f32x2 __attribute__((ext_vector_type(2)));
typedef unsigned u32x4 __attribute__((ext_vector_type(4)));
typedef unsigned u32x2 __attribute__((ext_vector_type(2)));
typedef int i32x4 __attribute__((ext_vector_type(4)));
typedef int i32x8 __attribute__((ext_vector_type(8)));

constexpr int D = 1024, BATCH = 8, SEQ = 8192, T = BATCH * SEQ, DEPTH = 2;
constexpr int AW = 384, BW = 384, CW = 256, HD = 64, ABLK = 128, CHUNK = 64;
constexpr int INC = 1792;
constexpr int ZU = 0, ZV = 384, ZG = 768, ZX = 1152, ZC = 1536, ZGELU_END = 1152;
constexpr int CG = 16, CGD = 16, CS = 64;
constexpr int NE = 16, DE = 512, NCLS = 24;
constexpr float EPS = 1e-6f;
constexpr int UT = 256;
constexpr int NU = T / UT;
constexpr int MAXROWS = T + NCLS * 256;

constexpr size_t MiB = 1u << 20;
constexpr size_t WS_CTL = 0, CTL_ZERO_BYTES = 1 * MiB;
constexpr size_t WS_WIN = 2 * MiB;
constexpr size_t WS_WOUT = 10 * MiB;
constexpr size_t WS_WGLU = 14 * MiB;
constexpr size_t WS_WRG = 15 * MiB;
constexpr size_t WS_WSP = 15 * MiB + 256 * 1024;
constexpr size_t WS_WRT = 15 * MiB + 768 * 1024;
constexpr size_t WS_WGU = 16 * MiB;
constexpr size_t WS_WD8 = 48 * MiB;
constexpr size_t WS_WD2 = 80 * MiB;
constexpr size_t WS_SSQ = 176 * MiB;
constexpr size_t WS_RS = 180 * MiB;
constexpr size_t WS_CLS = WS_RS + 256 * 1024;
constexpr size_t WS_G2 = WS_CLS + 256 * 1024;
constexpr size_t WS_HIST = 181 * MiB;
constexpr size_t WS_CTOT = WS_HIST + 64 * 1024;
constexpr size_t WS_ROWTOK = WS_HIST + 256 * 1024;
constexpr size_t WS_ROWG = 182 * MiB;
constexpr size_t WS_SUMA = 183 * MiB;
constexpr size_t WS_SUMH = 191 * MiB;
constexpr size_t WS_S5 = 184 * MiB;
constexpr size_t WS_SEND = 187 * MiB;
constexpr size_t WS_HB = 192 * MiB;
constexpr size_t WS_Z = 320 * MiB;
constexpr size_t WS_HBS = WS_Z;
constexpr size_t WS_Y = 544 * MiB;
constexpr size_t WS_ACT = 672 * MiB;
constexpr size_t WS_HL = 672 * MiB;
constexpr size_t WS_PP = 736 * MiB;
constexpr size_t WS_SE = 800 * MiB;
constexpr size_t WS_AV = 672 * MiB;
constexpr size_t WS_BV = 768 * MiB;
constexpr size_t WS_SEND2 = 864 * MiB;
constexpr size_t WS_SUMA2 = 866 * MiB;
constexpr size_t WS_SUMH2 = 867 * MiB;
constexpr size_t WS_END = 868 * MiB;
constexpr int CW_BAR = 4096;

constexpr int RING_BYTES = 131072;
constexpr int LDSCTL_OFF = 143360;
constexpr int LDS_PF = 147456;
constexpr int LDS_BYTES = 163840;
constexpr int LW_BAR = 8, LW_TST = 64, LW_HIST = 96, LW_TOT = 128, LW_BASE = 160, LW_CLS = 256  , LW_DEST = 512  , LW_UTAB = 768  , LW_DTAB = 800  ;

__device__ __forceinline__ float bf2f(bf16_t v) { return __uint_as_float(((unsigned)v) << 16); }
__device__ __forceinline__ unsigned cvt_pk_bf16(float lo, float hi) { unsigned r; asm volatile("v_cvt_pk_bf16_f32 %0, %1, %2" : "=v"(r) : "v"(lo), "v"(hi)); return r; }
__device__ __forceinline__ bf16_t f2bf(float v) { return (bf16_t)(cvt_pk_bf16(v, 0.f) & 0xffffu); }
__device__ __forceinline__ unsigned pk_fp8x4(float a, float b, float c, float d) {
    a = fminf(fmaxf(a, -448.f), 448.f); b = fminf(fmaxf(b, -448.f), 448.f); c = fminf(fmaxf(c, -448.f), 448.f); d = fminf(fmaxf(d, -448.f), 448.f);
    int r = __builtin_amdgcn_cvt_pk_fp8_f32(a, b, 0, false); r = __builtin_amdgcn_cvt_pk_fp8_f32(c, d, r, true); return (unsigned)r; }
__device__ __forceinline__ int fresh_lane() { unsigned z = 0u; asm volatile("" : "+s"(z)); return (int)__builtin_amdgcn_mbcnt_hi(~0u, __builtin_amdgcn_mbcnt_lo(~0u, z)); }
__device__ __forceinline__ float x_xor1(float v) { return __int_as_float(__builtin_amdgcn_update_dpp(0, __float_as_int(v), 0xB1, 0xf, 0xf, true)); }
__device__ __forceinline__ float x_xor2(float v) { return __int_as_float(__builtin_amdgcn_update_dpp(0, __float_as_int(v), 0x4E, 0xf, 0xf, true)); }
__device__ __forceinline__ float x_hmir(float v) { return __int_as_float(__builtin_amdgcn_update_dpp(0, __float_as_int(v), 0x141, 0xf, 0xf, true)); }
__device__ __forceinline__ float x_mir(float v) { return __int_as_float(__builtin_amdgcn_update_dpp(0, __float_as_int(v), 0x140, 0xf, 0xf, true)); }
__device__ __forceinline__ float x_xor16(float v) { return __int_as_float(__builtin_amdgcn_ds_swizzle(__float_as_int(v), 0x401F)); }
__device__ __forceinline__ float add_xor32(float v) { const auto r = __builtin_amdgcn_permlane32_swap(__float_as_uint(v), __float_as_uint(v), false, false); return __uint_as_float(r[0]) + __uint_as_float(r[1]); }
__device__ __forceinline__ float add_x16_x32(float v) { v += x_xor16(v); return add_xor32(v); }
__device__ __forceinline__ float wave_sum(float v) { v += x_xor1(v); v += x_xor2(v); v += x_hmir(v); v += x_mir(v); v += x_xor16(v); return add_xor32(v); }
__device__ __forceinline__ float gelu_fast(float x) {
    const float u2 = 1.5957691216057308f * (x + 0.044715f * x * x * x);
    const float e = __builtin_amdgcn_exp2f(-1.4426950408889634f * u2);
    return x * __builtin_amdgcn_rcpf(1.0f + e);
}
__device__ __forceinline__ float sigmoid_fast(float x) { return __builtin_amdgcn_rcpf(1.0f + __builtin_amdgcn_exp2f(-1.4426950408889634f * x)); }
__device__ __forceinline__ float sigmoid_f(float x) { return 1.0f / (1.0f + expf(-x)); }
__device__ __forceinline__ int pair_lo(int pi) { return pi < 3 ? 0 : (pi < 5 ? 1 : 2); }
__device__ __forceinline__ int pair_hi(int pi) { return pi < 3 ? pi + 1 : (pi < 5 ? pi - 1 : 3); }
__device__ __forceinline__ int pair_idx(int lo, int hi) { return lo == 0 ? hi - 1 : (lo == 1 ? hi + 1 : 5); }

#define XB_TMO      128
#define XB_XCNT(j)  (256  + 64 * (j))
#define XB_XSUB(j)  (1280 + 64 * (j))
#define XB_XGEN(j)  (2304 + 64 * (j))
#define XB_TOP      3328
#define XB_TOPGEN   3392
#define XCD_BAR_WORDS 3456
#define XB_SPIN_CAP (1u << 18)
__device__ __forceinline__ unsigned xb_ld(unsigned* p)              { return __hip_atomic_load(p, __ATOMIC_RELAXED, __HIP_MEMORY_SCOPE_AGENT); }
__device__ __forceinline__ unsigned xb_add(unsigned* p, unsigned v) { return __hip_atomic_fetch_add(p, v, __ATOMIC_RELAXED, __HIP_MEMORY_SCOPE_AGENT); }
__device__ __forceinline__ unsigned xb_xcc_id() { return (unsigned)__builtin_amdgcn_s_getreg((3 << 11) | 20) & 0xFu; }
#define XB_SPIN(cond, bar) do { unsigned _sp = 0; while (cond) { __builtin_amdgcn_s_sleep(1); \
    if ((++_sp & 255u) == 0u) { if (xb_ld(&(bar)[XB_TMO])) break; if (_sp > XB_SPIN_CAP) { atomicAdd(&(bar)[XB_TMO], 1u); break; } } } } while (0)
struct XcdBarrier { unsigned* bar; unsigned x; volatile LAS unsigned* st; };
__device__ __forceinline__ XcdBarrier xcd_barrier_post(unsigned* bar, volatile LAS unsigned* st) {
    XcdBarrier b; b.bar = bar; b.x = xb_xcc_id(); b.st = st;
    if (threadIdx.x == 0) (void)xb_add(&bar[XB_XCNT(b.x)], 1u);
    return b;
}
__device__ __forceinline__ void xcd_barrier_complete(unsigned* bar, unsigned x, unsigned& nloc, unsigned& nx) {
    const unsigned G = gridDim.x * gridDim.y * gridDim.z;
    unsigned sum, cnt, mine, sp = 0u;
    for (;;) {
        sum = 0u; cnt = 0u; mine = 0u;
#pragma unroll
        for (unsigned j = 0; j < 16; ++j) { const unsigned c = xb_ld(&bar[XB_XCNT(j)]); sum += c; cnt += (c > 0u) ? 1u : 0u; mine = (j == x) ? c : mine; }
        if (sum == G) break;
        __builtin_amdgcn_s_sleep(1);
        if ((++sp & 255u) == 0u) { if (xb_ld(&bar[XB_TMO])) break; if (sp > XB_SPIN_CAP) { atomicAdd(&bar[XB_TMO], 1u); break; } }
    }
    nloc = mine > 0u ? mine : 1u; nx = cnt > 0u ? cnt : 1u;
}
__device__ __forceinline__ void xcd_barrier(const XcdBarrier& b) {
    asm volatile("s_waitcnt vmcnt(0)" ::: "memory");
    __syncthreads();
    if (threadIdx.x == 0) {
        unsigned* bar = b.bar; asm volatile("" : "+s"(bar));
        __builtin_amdgcn_s_waitcnt(0);
        unsigned bx0 = b.x; asm volatile("" : "+s"(bx0));
        unsigned nloc = b.st[0], nx = b.st[1];
        if (nloc == 0u) { xcd_barrier_complete(bar, bx0, nloc, nx); b.st[0] = nloc; b.st[1] = nx; }
        unsigned bx = b.x; asm volatile("" : "+s"(bx));
        const unsigned old = xb_add(&bar[XB_XSUB(bx)], 1u);
        const unsigned gen = old / nloc;
        if (old + 1u == (gen + 1u) * nloc) {
            __builtin_amdgcn_fence(__ATOMIC_RELEASE, "agent");
            asm volatile("s_waitcnt vmcnt(0)" ::: "memory");
            const unsigned og = xb_add(&bar[XB_TOP], 1u);
            const unsigned tg = og / nx;
            if (og + 1u == (tg + 1u) * nx) xb_add(&bar[XB_TOPGEN], 1u);
            else XB_SPIN(xb_ld(&bar[XB_TOPGEN]) == tg, bar);
            __builtin_amdgcn_fence(__ATOMIC_ACQUIRE, "agent");
            xb_add(&bar[XB_XGEN(bx)], 1u);
            asm volatile("s_waitcnt vmcnt(0)" ::: "memory");
        } else {
            XB_SPIN(xb_ld(&bar[XB_XGEN(bx)]) == gen, bar);
            __builtin_amdgcn_fence(__ATOMIC_ACQUIRE, "agent");
            asm volatile("s_waitcnt vmcnt(0)" ::: "memory");
        }
    }
    __syncthreads();
}

namespace pg8 {
#define PG8_LAS __attribute__((address_space(3)))
constexpr int BM = 256, BK = 64, HALF = 128, HTB = HALF * BK * 2, STAGE_BYTES = 8 * HTB, NXCD = 8, WGM = 4;
__host__ __device__ __forceinline__ int lds_byte(int r, int c) { const int st = (r >> 4) * 2 + (c >> 5), rr = r & 15, cc = c & 31, ob = rr * 64 + cc * 2; return st * 1024 + (ob ^ (((ob >> 9) & 1) << 5)); }
__host__ __device__ __forceinline__ void stage_rc(int b, int& R, int& C) { const int st = b / 1024, sb = b % 1024, swz = sb ^ (((sb >> 9) & 1) << 5); R = (st >> 1) * 16 + swz / 64; C = (st & 1) * 32 + (swz % 64) / 2; }
__host__ __device__ __forceinline__ int perm32(int rho) { const int n = rho >> 4, i = rho & 15; return 8 * (i >> 2) + 4 * n + (i & 3); }
struct Unit { int pm, pn; const char* A; const char* B; };

template <int M_, int NN> struct PanelOrder {
    static constexpr int nM = M_ / BM; static constexpr size_t tstep = (size_t)BM * 1024 * 2;
    int G, c; const char* A; const char* Bt;
    __device__ void init(const void* A_, const void* Bt_, int G_, int c_) { G = G_; c = c_; A = (const char*)A_; Bt = (const char*)Bt_; }
    __device__ bool next(int i, Unit& u) const { const int pm = c + (i / NN) * G; if (pm >= nM) return false; u.pm = pm; u.pn = i % NN; u.A = A + (size_t)pm * tstep; u.B = Bt + (size_t)u.pn * tstep; return true; }
    __device__ __forceinline__ void a_ready(const Unit&) const {}
    __device__ __forceinline__ void done(const Unit&) const {}
};
template <int M_, int N_> struct StaticOrder {
    static constexpr int nM = M_ / BM, nN = N_ / BM, nwg = nM * nN; static constexpr size_t tstep = (size_t)BM * 1024 * 2;
    int G, c; const char* A; const char* Bt;
    __device__ void init(const void* A_, const void* Bt_, int G_, int c_) { G = G_; c = c_; A = (const char*)A_; Bt = (const char*)Bt_; }
    __device__ bool next(int i, Unit& u) const {
        const long L = (long)i * G + c; if (L >= nwg) return false;
        int wgid = (int)L; { constexpr int q = nwg / NXCD, r = nwg % NXCD; const int xcd = wgid % NXCD, off = wgid / NXCD; wgid = (xcd < r ? xcd * (q + 1) : r * (q + 1) + (xcd - r) * q) + off; }
        constexpr int nig = WGM * nN; const int gid = wgid / nig, fm = gid * WGM, gsz = (nM - fm) < WGM ? (nM - fm) : WGM;
        u.pm = fm + ((wgid % nig) % gsz); u.pn = (wgid % nig) / gsz; u.A = A + (size_t)u.pm * tstep; u.B = Bt + (size_t)u.pn * tstep; return true;
    }
    __device__ __forceinline__ void a_ready(const Unit&) const {}
    __device__ __forceinline__ void done(const Unit&) const {}
};
template <class Epi, class Sched, bool ALIGN_EPI = false, bool SP2 = false, int KB = 1024, bool FP8 = false>
__device__ __forceinline__ void gemm_phase(PG8_LAS unsigned char* lds, const int wave_s, const Sched& S, const Epi& E) { const int Kdim = 0;
    const int lane = fresh_lane(), wid = wave_s, tid = wid * 64 + lane, wr = wid >> 2, wc = wid & 3, fr = lane & 15, fq = lane >> 4;
    constexpr int K = KB, nt = K / BK; (void)Kdim;
    unsigned voffA, voffB;
    { int R, C; stage_rc(tid * 16, R, C); const int Rb = Epi::PERM ? ((R & ~31) + perm32(R & 31)) : R; voffA = (unsigned)(R * K + C) * 2u; voffB = (unsigned)(Rb * K + C) * 2u; }
    constexpr size_t kstep = (size_t)(BK * 2);
    constexpr size_t hstep = (size_t)HALF * K * 2;
    constexpr size_t tstep = 2 * hstep; (void)tstep;
    const unsigned ldsw = (unsigned)wid * 1024u; const unsigned ldsb = (unsigned)(size_t)lds + ldsw;
    const int aoff = lds_byte(wr * 64 + fr, fq * 8), boff = lds_byte(wc * 32 + fr, fq * 8);
#define PG8_SA(b, h) (((b) * 2 + (h)) * HTB)
#define PG8_SB(b, h) ((4 + (b) * 2 + (h)) * HTB)
#define PG8_STAGE(bufoff, gbase, voff) do { _Pragma("unroll") for (int _i = 0; _i < 2; ++_i) { unsigned _keep; \
        asm volatile("s_mov_b32 %0, m0\n\ts_mov_b32 m0, %3\n\ts_nop 0\n\tglobal_load_lds_dwordx4 %1, %2\n\ts_mov_b32 m0, %0" : "=&s"(_keep) \
            : "v"(voff), "s"((const char*)(gbase) + (size_t)_i * (64 * K * 2)), "s"(ldsb + (unsigned)((bufoff) + _i * 8192)) : "memory"); } } while (0)
#define PG8_LDA(dst, b, h) do { if constexpr (FP8) { _Pragma("unroll") for (int m = 0; m < 4; ++m) { const i32x4 _lo = *(const PG8_LAS i32x4*)(lds + PG8_SA(b, h) + aoff + m * 2048), _hi = *(const PG8_LAS i32x4*)(lds + PG8_SA(b, h) + aoff + m * 2048 + 1024); \
            dst##8[m] = __builtin_shufflevector(_lo, _hi, 0, 1, 2, 3, 4, 5, 6, 7); } } \
        else { _Pragma("unroll") for (int m = 0; m < 4; ++m) _Pragma("unroll") for (int k = 0; k < 2; ++k) dst[m][k] = *(const PG8_LAS bf16x8*)(lds + PG8_SA(b, h) + aoff + m * 2048 + k * 1024); } } while (0)
#define PG8_LDB(dst, b, h) do { if constexpr (FP8) { _Pragma("unroll") for (int n = 0; n < 2; ++n) { const i32x4 _lo = *(const PG8_LAS i32x4*)(lds + PG8_SB(b, h) + boff + n * 2048), _hi = *(const PG8_LAS i32x4*)(lds + PG8_SB(b, h) + boff + n * 2048 + 1024); \
            dst##8[n] = __builtin_shufflevector(_lo, _hi, 0, 1, 2, 3, 4, 5, 6, 7); } } \
        else { _Pragma("unroll") for (int n = 0; n < 2; ++n) _Pragma("unroll") for (int k = 0; k < 2; ++k) dst[n][k] = *(const PG8_LAS bf16x8*)(lds + PG8_SB(b, h) + boff + n * 2048 + k * 1024); } } while (0)
#define PG8_MMA(ai, bj, At, Bt) do { __builtin_amdgcn_s_setprio(1); \
        if constexpr (FP8) { _Pragma("unroll") for (int m = 0; m < 4; ++m) _Pragma("unroll") for (int n = 0; n < 2; ++n) \
            acc[ai][bj][m][n] = __builtin_amdgcn_mfma_scale_f32_16x16x128_f8f6f4(Bt##8[n], At##8[m], acc[ai][bj][m][n], 0, 0, 0, Epi::SCALE_W, 0, Epi::SCALE_A); } \
        else { _Pragma("unroll") for (int m = 0; m < 4; ++m) _Pragma("unroll") for (int n = 0; n < 2; ++n) _Pragma("unroll") for (int k = 0; k < 2; ++k) \
            acc[ai][bj][m][n] = __builtin_amdgcn_mfma_f32_16x16x32_bf16(Bt[n][k], At[m][k], acc[ai][bj][m][n], 0, 0, 0); } \
        __builtin_amdgcn_s_setprio(0); } while (0)
#define PG8_WAIT_V(n) asm volatile("s_waitcnt vmcnt(" #n ")" ::: "memory")
#define PG8_WAIT_L(n) asm volatile("s_waitcnt lgkmcnt(" #n ")" ::: "memory")
#define PG8_BAR __builtin_amdgcn_s_barrier()
#define PG8_SCHED __builtin_amdgcn_sched_barrier(0)
    Unit cur, nxt; int ui = 0;
    if (!S.next(0, cur)) return;
    f32x4 acc[2][2][4][2];
#pragma unroll
    for (int a = 0; a < 2; ++a)
#pragma unroll
        for (int b = 0; b < 2; ++b)
#pragma unroll
            for (int m = 0; m < 4; ++m)
#pragma unroll
                for (int n = 0; n < 2; ++n) acc[a][b][m][n] = (f32x4){0.f, 0.f, 0.f, 0.f};
    bf16x8 At[4][2], B0[2][2], B1[2][2]; i32x8 At8[4], B08[2], B18[2]; (void)At; (void)B0; (void)B1; (void)At8; (void)B08; (void)B18;
    const char* cA = cur.A; const char* cB = cur.B;
    S.a_ready(cur);
    if constexpr (SP2) {
        PG8_STAGE(PG8_SB(0, 0), cB, voffB); PG8_STAGE(PG8_SB(0, 1), cB + hstep, voffB); PG8_STAGE(PG8_SA(0, 0), cA, voffA); PG8_STAGE(PG8_SA(0, 1), cA + hstep, voffA);
        if (wr == 1) PG8_BAR;
        PG8_WAIT_V(2); PG8_BAR;
        PG8_STAGE(PG8_SB(1, 0), cB + kstep, voffB); PG8_STAGE(PG8_SA(1, 0), cA + kstep, voffA); PG8_STAGE(PG8_SB(1, 1), cB + hstep + kstep, voffB);
        PG8_WAIT_V(6); PG8_BAR;
    } else {
        PG8_STAGE(PG8_SB(0, 0), cB, voffB); PG8_STAGE(PG8_SA(0, 0), cA, voffA); PG8_STAGE(PG8_SB(0, 1), cB + hstep, voffB); PG8_STAGE(PG8_SA(0, 1), cA + hstep, voffA);
        if (wr == 1) PG8_BAR;
        PG8_WAIT_V(4); PG8_BAR;
        PG8_STAGE(PG8_SB(1, 0), cB + kstep, voffB); PG8_STAGE(PG8_SA(1, 0), cA + kstep, voffA); PG8_STAGE(PG8_SB(1, 1), cB + hstep + kstep, voffB);
        PG8_WAIT_V(6); PG8_BAR;
    }
    for (;;) {
        const bool has_next = S.next(ui + 1, nxt);
        const char* nA = has_next ? nxt.A : cA; const char* nB = has_next ? nxt.B : cB;
_Pragma("unroll 1")
        for (int t = 0; t < nt; t += 2) {
            const bool last = (t == nt - 2);
            const char* a1 = cA + (size_t)(t + 1) * kstep;
            const char* a2 = last ? nA : cA + (size_t)(t + 2) * kstep; const char* b2 = last ? nB : cB + (size_t)(t + 2) * kstep;
            const char* a3 = a2 + kstep; const char* b3 = b2 + kstep;
            if (last && has_next) S.a_ready(nxt);
            if constexpr (Epi::PF) { if (t == 2) E.prefetch(cur, (unsigned)(size_t)lds + (unsigned)LDS_PF, wid); }
            if constexpr (SP2) {
            PG8_LDB(B0, 0, 0); PG8_LDB(B1, 0, 1); PG8_SCHED; PG8_LDA(At, 0, 0); PG8_STAGE(PG8_SA(1, 1), a1 + hstep, voffA);
            PG8_WAIT_V(8); PG8_WAIT_L(0); PG8_BAR; PG8_MMA(0, 0, At, B0); PG8_MMA(0, 1, At, B1); PG8_BAR; PG8_SCHED;
            PG8_LDA(At, 0, 1); PG8_STAGE(PG8_SB(0, 0), b2, voffB); PG8_STAGE(PG8_SB(0, 1), b2 + hstep, voffB); PG8_STAGE(PG8_SA(0, 0), a2, voffA);
            PG8_WAIT_V(8); PG8_WAIT_L(0); PG8_BAR; PG8_MMA(1, 0, At, B0); PG8_MMA(1, 1, At, B1); PG8_BAR; PG8_SCHED;
            PG8_LDB(B0, 1, 0); PG8_LDB(B1, 1, 1); PG8_SCHED; PG8_LDA(At, 1, 0); PG8_STAGE(PG8_SA(0, 1), a2 + hstep, voffA);
            PG8_WAIT_V(8); PG8_WAIT_L(0); PG8_BAR; PG8_MMA(0, 0, At, B0); PG8_MMA(0, 1, At, B1); PG8_BAR; PG8_SCHED;
            PG8_LDA(At, 1, 1); PG8_STAGE(PG8_SB(1, 0), b3, voffB); PG8_STAGE(PG8_SB(1, 1), b3 + hstep, voffB); PG8_STAGE(PG8_SA(1, 0), a3, voffA);
            PG8_WAIT_V(8); PG8_WAIT_L(0); PG8_BAR; PG8_MMA(1, 0, At, B0); PG8_MMA(1, 1, At, B1); PG8_BAR; PG8_SCHED;
            } else {
            PG8_LDB(B0, 0, 0); PG8_SCHED; PG8_LDA(At, 0, 0); PG8_STAGE(PG8_SA(1, 1), a1 + hstep, voffA);
            PG8_WAIT_L(8); PG8_BAR; PG8_WAIT_L(0); PG8_MMA(0, 0, At, B0); PG8_BAR; PG8_SCHED;
            PG8_LDB(B1, 0, 1); PG8_STAGE(PG8_SB(0, 0), b2, voffB);
            PG8_BAR; PG8_WAIT_L(0); PG8_MMA(0, 1, At, B1); PG8_BAR;
            PG8_LDA(At, 0, 1); PG8_STAGE(PG8_SA(0, 0), a2, voffA);
            PG8_BAR; PG8_WAIT_L(0); PG8_MMA(1, 0, At, B0); PG8_BAR; PG8_SCHED;
            PG8_STAGE(PG8_SB(0, 1), b2 + hstep, voffB);
            PG8_WAIT_V(6); PG8_BAR; PG8_MMA(1, 1, At, B1); PG8_BAR;
            PG8_LDB(B0, 1, 0); PG8_SCHED; PG8_LDA(At, 1, 0); PG8_STAGE(PG8_SA(0, 1), a2 + hstep, voffA);
            PG8_WAIT_L(8); PG8_BAR; PG8_WAIT_L(0); PG8_MMA(0, 0, At, B0); PG8_BAR; PG8_SCHED;
            PG8_LDB(B1, 1, 1); PG8_STAGE(PG8_SB(1, 0), b3, voffB);
            PG8_BAR; PG8_WAIT_L(0); PG8_MMA(0, 1, At, B1); PG8_BAR;
            PG8_LDA(At, 1, 1); PG8_STAGE(PG8_SA(1, 0), a3, voffA);
            PG8_BAR; PG8_WAIT_L(0); PG8_MMA(1, 0, At, B0); PG8_BAR; PG8_SCHED;
            PG8_STAGE(PG8_SB(1, 1), b3 + hstep, voffB);
            PG8_WAIT_V(6); PG8_BAR; PG8_MMA(1, 1, At, B1); PG8_BAR;
            }
        }
        if constexpr (ALIGN_EPI) { if (wr == 0) PG8_BAR; }
        if constexpr (!Epi::AFTER_DRAIN) { E(acc, cur, wr, wc, fr, fq); S.done(cur); }
        if (!has_next) break;
#pragma unroll
        for (int a = 0; a < 2; ++a)
#pragma unroll
            for (int b = 0; b < 2; ++b)
#pragma unroll
                for (int m = 0; m < 4; ++m)
#pragma unroll
                    for (int n = 0; n < 2; ++n) acc[a][b][m][n] = (f32x4){0.f, 0.f, 0.f, 0.f};
        cur = nxt; cA = nA; cB = nB; ++ui;
        if constexpr (ALIGN_EPI) { if (wr == 1) PG8_BAR; }
    }
    PG8_WAIT_V(0);
    if constexpr (!ALIGN_EPI) { if (wr == 0) PG8_BAR; }
    PG8_BAR;
    if constexpr (Epi::AFTER_DRAIN) { E.fused(acc, cur, wr, wc, fr, fq, lds, wid, lane); S.done(cur); }
#undef PG8_SA
#undef PG8_SB
#undef PG8_STAGE
#undef PG8_LDA
#undef PG8_LDB
#undef PG8_MMA
#undef PG8_WAIT_V
#undef PG8_WAIT_L
#undef PG8_BAR
#undef PG8_SCHED
}

template <int NP, bool UP, int ROWB> struct MoeOrder {
    const volatile LAS int* tab; int layer; const char* A; const char* W;
    __device__ bool next(int i, Unit& u) const {
        const int e = tab[i]; if (e < 0) return false;
        const int mt = e & 0xffff, pn = (e >> 16) & 0xff, cls = e >> 24;
        u.pm = mt; u.pn = pn; u.A = A + (size_t)mt * ((size_t)BM * ROWB);
        if (UP) { const int g = cls / 6, pi = cls % 6, s = pn >> 2, ex = g * 4 + (s ? pair_hi(pi) : pair_lo(pi));
            u.B = W + ((size_t)(layer * NE + ex) * 1024 + (size_t)(pn & 3) * 256) * ROWB; }
        else u.B = W + ((size_t)(layer * NCLS + cls) * 1024 + (size_t)pn * 256) * ROWB;
        return true;
    }
    __device__ __forceinline__ void a_ready(const Unit&) const {}
    __device__ __forceinline__ void done(const Unit&) const {}
};

struct EpiZ {
    static constexpr bool PERM = true, AFTER_DRAIN = false, PF = true;
    bf16_t* Z; const float* ssq; const PG8_LAS unsigned char* pf;
    __device__ __forceinline__ void prefetch(const Unit& u, unsigned lds_addr, int wid) const {
        const char* g = (const char*)(ssq + (size_t)u.pm * BM * 16) + wid * 1024; const unsigned vo = (unsigned)fresh_lane() * 16u;
#pragma unroll
        for (int i = 0; i < 2; ++i) { unsigned keep;
            asm volatile("s_mov_b32 %0, m0\n\ts_mov_b32 m0, %3\n\ts_nop 0\n\tglobal_load_lds_dwordx4 %1, %2\n\ts_mov_b32 m0, %0" : "=&s"(keep) : "v"(vo), "s"(g + i * 8192), "s"(lds_addr + (unsigned)(wid * 1024 + i * 8192)) : "memory"); } }
    __device__ __forceinline__ void operator()(const f32x4 (&acc)[2][2][4][2], const Unit& u, int wr, int wc, int fr, int fq) const {
        { const int ln_ = fresh_lane(); fr = ln_ & 15; fq = ln_ >> 4; }
        const int row0 = u.pm * BM + wr * 64 + fr, col0 = u.pn * BM + wc * 32 + 8 * fq;
        float rr[2][4];
#pragma unroll
        for (int ai = 0; ai < 2; ++ai) {
            f32x4 sp[4];
#pragma unroll
            for (int m = 0; m < 4; ++m) sp[m] = *(const PG8_LAS f32x4*)(pf + (ai * HALF + wr * 64 + m * 16 + fr) * 64 + 16 * fq);
#pragma unroll
            for (int m = 0; m < 4; ++m) { float t = (sp[m][0] + sp[m][1]) + (sp[m][2] + sp[m][3]); t = add_x16_x32(t); rr[ai][m] = __builtin_amdgcn_rsqf(t * (1.0f / D) + EPS); }
        }
#pragma unroll
        for (int ai = 0; ai < 2; ++ai)
#pragma unroll
            for (int m = 0; m < 4; ++m) { const int row = row0 + ai * HALF + m * 16; const float r = rr[ai][m];
                bf16_t* rowp = Z + (size_t)row * INC + col0;
#pragma unroll
                for (int bj = 0; bj < 2; ++bj) { f32x4 v0 = acc[ai][bj][m][0] * r, v1 = acc[ai][bj][m][1] * r;
                    u32x4 w; w.x = cvt_pk_bf16(v0[0], v0[1]); w.y = cvt_pk_bf16(v0[2], v0[3]); w.z = cvt_pk_bf16(v1[0], v1[1]); w.w = cvt_pk_bf16(v1[2], v1[3]);
                    *(u32x4*)(rowp + bj * HALF) = w; } }
    }
};
template <bool SCATTER> struct EpiRes {
    static constexpr bool PERM = true, AFTER_DRAIN = false, PF = SCATTER; static constexpr int SCALE_W = 0x7b7b7b7b, SCALE_A = 0x7b7b7b7b;
    bf16_t* H; float* ssq; const int* rowtok; const PG8_LAS unsigned char* pf;
    __device__ __forceinline__ void prefetch(const Unit& u, unsigned lds_addr, int wid) const {
        if (wid < 4) { const char* g = (const char*)(rowtok + (size_t)u.pm * BM) + wid * 256; const unsigned vo = (unsigned)fresh_lane() * 4u; unsigned keep;
            asm volatile("s_mov_b32 %0, m0\n\ts_mov_b32 m0, %3\n\ts_nop 0\n\tglobal_load_lds_dword %1, %2\n\ts_mov_b32 m0, %0" : "=&s"(keep) : "v"(vo), "s"(g), "s"(lds_addr + (unsigned)(wid * 256)) : "memory"); } }
    __device__ __forceinline__ void operator()(const f32x4 (&acc)[2][2][4][2], const Unit& u, int wr, int wc, int fr, int fq) const {
        { const int ln_ = fresh_lane(); fr = ln_ & 15; fq = ln_ >> 4; }
        const int row0 = u.pm * BM + wr * 64 + fr, col0 = u.pn * BM + wc * 32 + 8 * fq;
        int tokv[2][4];
#pragma unroll
        for (int ai = 0; ai < 2; ++ai)
#pragma unroll
            for (int m = 0; m < 4; ++m) { const int row = row0 + ai * HALF + m * 16; tokv[ai][m] = SCATTER ? *(const PG8_LAS int*)(pf + (ai * HALF + wr * 64 + m * 16 + fr) * 4) : row; }
#pragma unroll
        for (int ai = 0; ai < 2; ++ai) {
            u32x4 o[4][2];
#pragma unroll
            for (int m = 0; m < 4; ++m) { const int tok = tokv[ai][m]; const bf16_t* rowp = H + (size_t)(tok < 0 ? 0 : tok) * D + col0; o[m][0] = *(const u32x4*)(rowp); o[m][1] = *(const u32x4*)(rowp + HALF); }
#pragma unroll
            for (int m = 0; m < 4; ++m) { const int tok = tokv[ai][m]; float s = 0.f; bf16_t* rowp = H + (size_t)(tok < 0 ? 0 : tok) * D + col0;
#pragma unroll
                for (int bj = 0; bj < 2; ++bj) { const u32x4 oo = o[m][bj];
                    f32x4 v0 = acc[ai][bj][m][0], v1 = acc[ai][bj][m][1];
                    v0[0] += __uint_as_float(oo.x << 16); v0[1] += __uint_as_float(oo.x & 0xffff0000u); v0[2] += __uint_as_float(oo.y << 16); v0[3] += __uint_as_float(oo.y & 0xffff0000u);
                    v1[0] += __uint_as_float(oo.z << 16); v1[1] += __uint_as_float(oo.z & 0xffff0000u); v1[2] += __uint_as_float(oo.w << 16); v1[3] += __uint_as_float(oo.w & 0xffff0000u);
                    s += (v0[0] * v0[0] + v0[1] * v0[1]) + (v0[2] * v0[2] + v0[3] * v0[3]) + (v1[0] * v1[0] + v1[1] * v1[1]) + (v1[2] * v1[2] + v1[3] * v1[3]);
                    u32x4 w; w.x = cvt_pk_bf16(v0[0], v0[1]); w.y = cvt_pk_bf16(v0[2], v0[3]); w.z = cvt_pk_bf16(v1[0], v1[1]); w.w = cvt_pk_bf16(v1[2], v1[3]);
                    if (tok >= 0) *(u32x4*)(rowp + bj * HALF) = w; }
                s = add_x16_x32(s);
                if (fq == 0 && tok >= 0) ssq[(size_t)tok * 16 + u.pn * 4 + wc] = s; }
            asm volatile("" ::: "memory"); }
    }
};
constexpr int SC_W = 0x7b7b7b7b, SC_H = 0x7b7b7b7b, SC_ACT = 0x7b7b7b7b;
constexpr float FS_W = 16.f, FS_H = 16.f, FS_ACT = 16.f;
struct EpiUp {
    static constexpr bool PERM = true, AFTER_DRAIN = false, PF = true; static constexpr int SCALE_W = SC_W, SCALE_A = SC_H;
    unsigned char* ACT; const float* rowg; const PG8_LAS unsigned char* pf;
    __device__ __forceinline__ void prefetch(const Unit& u, unsigned lds_addr, int wid) const {
        const char* g = (const char*)(rowg + (size_t)u.pm * BM * 2) + wid * 256; const unsigned vo = (unsigned)fresh_lane() * 4u; unsigned keep;
        asm volatile("s_mov_b32 %0, m0\n\ts_mov_b32 m0, %3\n\ts_nop 0\n\tglobal_load_lds_dword %1, %2\n\ts_mov_b32 m0, %0" : "=&s"(keep) : "v"(vo), "s"(g), "s"(lds_addr + (unsigned)(wid * 256)) : "memory"); }
    __device__ __forceinline__ void operator()(const f32x4 (&acc)[2][2][4][2], const Unit& u, int wr, int wc, int fr, int fq) const {
        { const int ln_ = fresh_lane(); fr = ln_ & 15; fq = ln_ >> 4; }
        const int row0 = u.pm * BM + wr * 64 + fr, s = u.pn >> 2, col0 = s * 512 + (u.pn & 3) * 128 + wc * 32 + 8 * fq;
        float gt[2][4];
#pragma unroll
        for (int ai = 0; ai < 2; ++ai)
#pragma unroll
            for (int m = 0; m < 4; ++m) gt[ai][m] = *(const PG8_LAS float*)(pf + ((ai * HALF + wr * 64 + m * 16 + fr) * 2 + s) * 4);
#pragma unroll
        for (int ai = 0; ai < 2; ++ai)
#pragma unroll
            for (int m = 0; m < 4; ++m) { const int row = row0 + ai * HALF + m * 16; const float g1 = gt[ai][m];
                float o[8];
#pragma unroll
                for (int n = 0; n < 2; ++n)
#pragma unroll
                    for (int j = 0; j < 4; ++j) { const float g = acc[ai][0][m][n][j], up = acc[ai][1][m][n][j]; o[n * 4 + j] = g * sigmoid_fast(g) * up * g1; }
                u32x2 w; w.x = pk_fp8x4(o[0] * FS_ACT, o[1] * FS_ACT, o[2] * FS_ACT, o[3] * FS_ACT); w.y = pk_fp8x4(o[4] * FS_ACT, o[5] * FS_ACT, o[6] * FS_ACT, o[7] * FS_ACT);
                *(u32x2*)(ACT + (size_t)row * 1024 + col0) = w; }
    }
};
}

__device__ __forceinline__ void tr_item(const float* W, int ldw, int k0, int scol0, const float* gk, bf16_t* WT, int ldo, int drow0, int dk0, LAS float* scr, int lane) {
#pragma unroll 8
    for (int i = 0; i < 32; ++i) { const int kk = 2 * i + (lane >> 5); float v = W[(size_t)(k0 + kk) * ldw + scol0 + (lane & 31)]; if (gk) v *= gk[k0 + kk]; scr[kk * 33 + (lane & 31)] = v; }
    asm volatile("s_waitcnt lgkmcnt(0)" ::: "memory");
    const int c = lane & 7;
#pragma unroll
    for (int j = 0; j < 4; ++j) { const int n = (lane >> 3) + 8 * j; const LAS float* s = scr + (8 * c) * 33 + n;
        u32x4 o; o.x = cvt_pk_bf16(s[0 * 33], s[1 * 33]); o.y = cvt_pk_bf16(s[2 * 33], s[3 * 33]); o.z = cvt_pk_bf16(s[4 * 33], s[5 * 33]); o.w = cvt_pk_bf16(s[6 * 33], s[7 * 33]);
        *(u32x4*)(WT + (size_t)(drow0 + n) * ldo + dk0 + 8 * c) = o; }
    asm volatile("s_waitcnt lgkmcnt(0)" ::: "memory");
}

constexpr size_t S5_L_STRIDE = 1310720, S5_KT = 0, S5_ET = 131072, S5_FT = 655360, S5_LAMP = 1179648;
constexpr int S5_WSCR = 8192, S5_YST = 65536, YST_LD = 264;
constexpr int NU128 = T / 128, UPB128 = SEQ / 128;
__device__ __forceinline__ f32x4 mfma16(bf16x8 a, bf16x8 b, f32x4 c) { return __builtin_amdgcn_mfma_f32_16x16x32_bf16(a, b, c, 0, 0, 0); }

__device__ __forceinline__ void s5_kt_pair(int g, int c, int cp, const float* a_re, const float* a_im, const float* log_dt, const float* b_re, const float* b_im,
                                           const float* c_re, const float* c_im, const float* dvec, unsigned char* tab) {
    const float dt = __expf(log_dt[g]); float km[8];
#pragma unroll
    for (int d = 0; d < 8; ++d) km[d] = 0.f;
#pragma unroll 2
    for (int p = 0; p < CS; ++p) { const float lr = a_re[g * CS + p], li = a_im[g * CS + p], zr = lr * dt, zi = li * dt;
        const float sh = __sinf(0.5f * zi), cz = __cosf(zi), sz = __sinf(zi), ez = __expf(zr); const float nr = expm1f(zr) * cz - 2.0f * sh * sh, ni = ez * sz, den = lr * lr + li * li;
        const float cr = (nr * lr + ni * li) / den, ci = (ni * lr - nr * li) / den;
        const float br = b_re[((size_t)g * CS + p) * CGD + cp], bi = b_im[((size_t)g * CS + p) * CGD + cp]; const float bbr = cr * br - ci * bi, bbi = cr * bi + ci * br;
        const float cre = c_re[((size_t)g * CGD + c) * CS + p], cim = c_im[((size_t)g * CGD + c) * CS + p];
        float vr = cre * bbr - cim * bbi, vi = cre * bbi + cim * bbr;
        const float lbr = ez * cz, lbi = ez * sz;
#pragma unroll
        for (int d = 0; d < 8; ++d) { km[d] += vr; const float t = vr * lbr - vi * lbi; vi = vr * lbi + vi * lbr; vr = t; } }
    if (c == cp) km[0] += dvec[g * CGD + c];
    bf16_t* kt = (bf16_t*)(tab + S5_KT) + (size_t)g * 4096;
#pragma unroll
    for (int dd = 0; dd < 8; ++dd) { kt[(dd * 16 + c) * 32 + cp] = f2bf(km[dd]); kt[(dd * 16 + c) * 32 + 16 + cp] = dd >= 1 ? f2bf(km[dd - 1]) : (bf16_t)0; }
}
__device__ __forceinline__ void s5_et_task(int g, int ri, int p, int cp, const float* a_re, const float* a_im, const float* log_dt, const float* b_re, const float* b_im, unsigned char* tab) {
    const float dt = __expf(log_dt[g]); const float lr = a_re[g * CS + p], li = a_im[g * CS + p], zr = lr * dt, zi = li * dt;
    const float sh = __sinf(0.5f * zi), cz = __cosf(zi), sz = __sinf(zi), ez = __expf(zr); const float nr = expm1f(zr) * cz - 2.0f * sh * sh, ni = ez * sz, den = lr * lr + li * li;
    const float cr = (nr * lr + ni * li) / den, ci = (ni * lr - nr * li) / den;
    const float br = b_re[((size_t)g * CS + p) * CGD + cp], bi = b_im[((size_t)g * CS + p) * CGD + cp]; float vr = cr * br - ci * bi, vi = cr * bi + ci * br;
    const float lbr = ez * cz, lbi = ez * sz; bf16_t* et = (bf16_t*)(tab + S5_ET) + (size_t)g * 16384 + (size_t)(ri * 64 + p) * 128 + cp;
#pragma unroll
    for (int sp = 7; sp >= 0; --sp) { et[sp * 16] = f2bf(ri ? vi : vr); const float t = vr * lbr - vi * lbi; vi = vr * lbi + vi * lbr; vr = t; }
}
__device__ __forceinline__ void s5_ft_task(int g, int c, int ri, int p, const float* a_re, const float* a_im, const float* log_dt, const float* c_re, const float* c_im, unsigned char* tab) {
    const float dt = __expf(log_dt[g]); const float lr = a_re[g * CS + p], li = a_im[g * CS + p], zr = lr * dt, zi = li * dt; const float ez = __expf(zr), lbr = ez * __cosf(zi), lbi = ez * __sinf(zi);
    const float cre = c_re[((size_t)g * CGD + c) * CS + p], cim = c_im[((size_t)g * CGD + c) * CS + p]; float vr = cre * lbr - cim * lbi, vi = cre * lbi + cim * lbr;
    bf16_t* ft = (bf16_t*)(tab + S5_FT) + (size_t)g * 16384 + (size_t)c * 128 + ri * 64 + p;
#pragma unroll
    for (int tp = 0; tp < 8; ++tp) { ft[(size_t)tp * 16 * 128] = f2bf(ri ? -vi : vr); const float t = vr * lbr - vi * lbi; vi = vr * lbi + vi * lbr; vr = t; }
}
__device__ __forceinline__ void s5_table_elem(int g, int e, const float* a_re, const float* a_im, const float* log_dt, const float* b_re, const float* b_im,
                                              const float* c_re, const float* c_im, const float* dvec, unsigned char* tab) {
    const float dt = __expf(log_dt[g]);
    if (e < 4096) {
        const int dd = e >> 9, c = (e >> 5) & 15, ee = (e >> 4) & 1, cp = e & 15, d = dd - ee; float s = 0.f;
        if (d >= 0) {
            for (int p = 0; p < CS; ++p) { const float lr = a_re[g * CS + p], li = a_im[g * CS + p], zr = lr * dt, zi = li * dt;
                const float sh = __sinf(0.5f * zi); const float nr = expm1f(zr) * __cosf(zi) - 2.0f * sh * sh, ni = __expf(zr) * __sinf(zi), den = lr * lr + li * li;
                const float cr = (nr * lr + ni * li) / den, ci = (ni * lr - nr * li) / den;
                const float br = b_re[((size_t)g * CS + p) * CGD + cp], bi = b_im[((size_t)g * CS + p) * CGD + cp]; const float bbr = cr * br - ci * bi, bbi = cr * bi + ci * br;
                const float mag = __expf(zr * (float)d), pr = mag * __cosf(zi * (float)d), pi = mag * __sinf(zi * (float)d);
                const float vr = pr * bbr - pi * bbi, vi = pr * bbi + pi * bbr;
                s += c_re[((size_t)g * CGD + c) * CS + p] * vr - c_im[((size_t)g * CGD + c) * CS + p] * vi; }
            if (d == 0 && c == cp) s += dvec[g * CGD + c];
        }
        ((bf16_t*)(tab + S5_KT))[(size_t)g * 4096 + e] = f2bf(s); return;
    }
    e -= 4096;
    if (e < 16384) {
        const int n = e >> 7, k = e & 127, ri = n >> 6, p = n & 63, sp = k >> 4, cp = k & 15;
        const float lr = a_re[g * CS + p], li = a_im[g * CS + p], zr = lr * dt, zi = li * dt;
        const float sh = __sinf(0.5f * zi); const float nr = expm1f(zr) * __cosf(zi) - 2.0f * sh * sh, ni = __expf(zr) * __sinf(zi), den = lr * lr + li * li;
        const float cr = (nr * lr + ni * li) / den, ci = (ni * lr - nr * li) / den;
        const float br = b_re[((size_t)g * CS + p) * CGD + cp], bi = b_im[((size_t)g * CS + p) * CGD + cp]; const float bbr = cr * br - ci * bi, bbi = cr * bi + ci * br;
        const float d = (float)(7 - sp); const float mag = __expf(zr * d), pr = mag * __cosf(zi * d), pi = mag * __sinf(zi * d);
        ((bf16_t*)(tab + S5_ET))[(size_t)g * 16384 + e] = f2bf(ri ? (pr * bbi + pi * bbr) : (pr * bbr - pi * bbi)); return;
    }
    e -= 16384;
    if (e < 16384) {
        const int n = e >> 7, k = e & 127, tp = n >> 4, c = n & 15, ri = k >> 6, p = k & 63;
        const float lr = a_re[g * CS + p], li = a_im[g * CS + p], zr = lr * dt, zi = li * dt;
        const float d = (float)(tp + 1); const float mag = __expf(zr * d), pr = mag * __cosf(zi * d), pi = mag * __sinf(zi * d);
        const float cre = c_re[((size_t)g * CGD + c) * CS + p], cim = c_im[((size_t)g * CGD + c) * CS + p];
        ((bf16_t*)(tab + S5_FT))[(size_t)g * 16384 + e] = f2bf(ri ? -(cre * pi + cim * pr) : (cre * pr - cim * pi)); return;
    }
    e -= 16384;
    { const int p = e; const float lr = a_re[g * CS + p], li = a_im[g * CS + p], zr = lr * dt, zi = li * dt; float* o = (float*)(tab + S5_LAMP) + ((size_t)g * CS + p) * 8;
      float mag = expf(zr); o[0] = mag * cosf(zi); o[1] = mag * sinf(zi);
      mag = expf(zr * 8.f); o[2] = mag * cosf(zi * 8.f); o[3] = mag * sinf(zi * 8.f);
      mag = expf(zr * 128.f); o[4] = mag * cosf(zi * 128.f); o[5] = mag * sinf(zi * 128.f); o[6] = 0.f; o[7] = 0.f; }
}

template <class TT> __device__ __forceinline__ TT ldg(const void* ubase, unsigned voff) { return *(const TT*)((const char*)ubase + voff); }
template <int PASS>
__device__ __forceinline__ void s5_group(int unit, int g, bool first, float& kr, float& ki, int wave, int lane, const bf16_t* Z, bf16_t* Y, const unsigned char* tab, float* SEND, float* SEND2, float* SE, LAS unsigned char* lds) {
    const int ln = lane & 15, q = lane >> 4; const int t0 = unit * 128;
    const char* KTg = (const char*)(tab + S5_KT) + (size_t)g * 8192; const char* ETg = (const char*)(tab + S5_ET) + (size_t)g * 32768; const char* FTg = (const char*)(tab + S5_FT) + (size_t)g * 32768;
    const float* LAMPg = (const float*)(tab + S5_LAMP) + (size_t)g * CS * 8;
    const unsigned vo128 = (unsigned)(ln * 128 + 8 * q) * 2u;
    const unsigned vo32 = (unsigned)(ln * 32 + 8 * q) * 2u;
    LAS float* Sb = (LAS float*)(lds + wave * S5_WSCR); LAS bf16_t* Tb = (LAS bf16_t*)(lds + wave * S5_WSCR); LAS bf16_t* yst = (LAS bf16_t*)(lds + S5_YST);
    char* seb = (char*)(SE + ((size_t)unit * CG + g) * 16 * 128); const unsigned vl = (unsigned)lane * 4u;
    char* ylb = (char*)(Y + (size_t)t0 * D + AW + BW + g * 16); const unsigned vy = (unsigned)((ln * 8) * D + 4 * q) * 2u;
    const float lur = LAMPg[lane * 8 + 4], lui = LAMPg[lane * 8 + 5], l8r = LAMPg[lane * 8 + 2], l8i = LAMPg[lane * 8 + 3];
    float cr = 0.f, ci = 0.f;
    if (PASS == 1) {
        if (!first) { cr = kr; ci = ki; }
        bf16x8 X0, X1, X2, X3;
        { const char* zb = (const char*)(Z + (size_t)t0 * INC + ZC + g * 16); const unsigned vz = (unsigned)((ln * 8 + (q >> 1)) * INC + 8 * (q & 1)) * 2u;
          X0 = ldg<bf16x8>(zb, vz); X1 = ldg<bf16x8>(zb + 2 * INC * 2, vz); X2 = ldg<bf16x8>(zb + 4 * INC * 2, vz); X3 = ldg<bf16x8>(zb + 6 * INC * 2, vz); }
        { LAS float* sw = Sb + (4 * q) * 128 + ln; const char* eb = ETg;
#pragma unroll 1
          for (int jh = 0; jh < 2; ++jh) { bf16x8 ef[4][4];
#pragma unroll
            for (int j = 0; j < 4; ++j)
#pragma unroll
              for (int ks = 0; ks < 4; ++ks) ef[j][ks] = ldg<bf16x8>(eb + j * 4096 + ks * 64, vo128);
#pragma unroll
            for (int j = 0; j < 4; ++j) { f32x4 se = (f32x4){0.f, 0.f, 0.f, 0.f};
              se = mfma16(X0, ef[j][0], se); se = mfma16(X1, ef[j][1], se); se = mfma16(X2, ef[j][2], se); se = mfma16(X3, ef[j][3], se);
              LAS float* s2 = sw + 16 * j; s2[0] = se[0]; s2[128] = se[1]; s2[256] = se[2]; s2[384] = se[3]; }
            eb += 16384; sw += 64; } }
        asm volatile("" ::: "memory");
        { const char* kb = KTg; char* yq = ylb;
#pragma unroll 1
          for (int th = 0; th < 4; ++th) {
              const bf16x8 ka = ldg<bf16x8>(kb, vo32), kc = ldg<bf16x8>(kb + 1024, vo32);
              f32x4 acc0 = (f32x4){0.f, 0.f, 0.f, 0.f}, acc1 = (f32x4){0.f, 0.f, 0.f, 0.f};
              acc0 = mfma16(ka, X0, acc0); acc1 = mfma16(kc, X0, acc1);
              if (th >= 1) { acc0 = mfma16(ldg<bf16x8>(kb - 2048, vo32), X1, acc0); acc1 = mfma16(ldg<bf16x8>(kb - 1024, vo32), X1, acc1); }
              if (th >= 2) { acc0 = mfma16(ldg<bf16x8>(kb - 4096, vo32), X2, acc0); acc1 = mfma16(ldg<bf16x8>(kb - 3072, vo32), X2, acc1); }
              if (th >= 3) { acc0 = mfma16(ldg<bf16x8>(kb - 6144, vo32), X3, acc0); acc1 = mfma16(ldg<bf16x8>(kb - 5120, vo32), X3, acc1); }
              u32x2 w; w.x = cvt_pk_bf16(acc0[0], acc0[1]); w.y = cvt_pk_bf16(acc0[2], acc0[3]); *(u32x2*)(yq + vy) = w;
              w.x = cvt_pk_bf16(acc1[0], acc1[1]); w.y = cvt_pk_bf16(acc1[2], acc1[3]); *(u32x2*)(yq + (size_t)D * 2 + vy) = w;
              kb += 2048; yq += (size_t)2 * D * 2; } }
        asm volatile("" ::: "memory");
        float sr = cr, si = ci;
#pragma unroll
        for (int s = 0; s < 16; ++s) { const float er = Sb[s * 128 + lane], ei = Sb[s * 128 + 64 + lane];
            *(float*)(seb + s * 512 + vl) = er; *(float*)(seb + s * 512 + 256 + vl) = ei;
            const float nr = l8r * sr - l8i * si + er, ni = l8r * si + l8i * sr + ei; sr = nr; si = ni; }
        kr = sr; ki = si;
        float* dst = first ? SEND + (((size_t)unit * CG + g) * 2) * CS + lane : SEND2 + (((size_t)(unit >> 1) * CG + g) * 2) * CS + lane;
        dst[0] = sr; dst[CS] = si; asm volatile("" ::: "memory"); return;
    }
    if (first) { const int pr = unit >> 1, p0 = pr - (pr % (UPB128 / 2)); const float l2r = lur * lur - lui * lui, l2i = 2.0f * lur * lui;
        const char* sb = (const char*)(SEND2 + (((size_t)p0 * CG + g) * 2) * CS);
#pragma unroll 8
        for (int j = p0; j < pr; ++j) { const float sr = ldg<float>(sb, vl), si = ldg<float>(sb + CS * 4, vl); sb += (size_t)CG * 2 * CS * 4;
            const float nr = l2r * cr - l2i * ci + sr, ni = l2r * ci + l2i * cr + si; cr = nr; ci = ni; } }
    else { const float sr = SEND[(((size_t)(unit - 1) * CG + g) * 2 + 0) * CS + lane], si = SEND[(((size_t)(unit - 1) * CG + g) * 2 + 1) * CS + lane];
        cr = lur * kr - lui * ki + sr; ci = lur * ki + lui * kr + si; }
    kr = cr; ki = ci;
    { float sre[16], sim[16];
#pragma unroll
      for (int s = 0; s < 16; ++s) { sre[s] = ldg<float>(seb + s * 512, vl); sim[s] = ldg<float>(seb + s * 512 + 256, vl); }
      float sr = cr, si = ci;
#pragma unroll
      for (int s = 0; s < 16; ++s) { Tb[s * 128 + lane] = f2bf(sr); Tb[s * 128 + 64 + lane] = f2bf(si);
          const float nr = l8r * sr - l8i * si + sre[s], ni = l8r * si + l8i * sr + sim[s]; sr = nr; si = ni; } }
    asm volatile("" ::: "memory");
    const bf16x8 T0 = *(const LAS bf16x8*)(Tb + ln * 128 + 8 * q), T1 = *(const LAS bf16x8*)(Tb + ln * 128 + 32 + 8 * q), T2 = *(const LAS bf16x8*)(Tb + ln * 128 + 64 + 8 * q), T3 = *(const LAS bf16x8*)(Tb + ln * 128 + 96 + 8 * q);
    { LAS bf16_t* yw = yst + (ln * 8) * YST_LD + g * 16 + 4 * q; const char* fb = FTg; const char* yq = ylb;
#pragma unroll 2
      for (int th = 0; th < 4; ++th) { bf16x8 ff[2][4]; u32x2 yl[2];
#pragma unroll
          for (int j = 0; j < 2; ++j) { yl[j] = ldg<u32x2>(yq + (size_t)j * D * 2, vy);
#pragma unroll
              for (int ks = 0; ks < 4; ++ks) ff[j][ks] = ldg<bf16x8>(fb + j * 4096 + ks * 64, vo128); }
#pragma unroll
          for (int j = 0; j < 2; ++j) {
              f32x4 acc; acc[0] = __uint_as_float(yl[j].x << 16); acc[1] = __uint_as_float(yl[j].x & 0xffff0000u); acc[2] = __uint_as_float(yl[j].y << 16); acc[3] = __uint_as_float(yl[j].y & 0xffff0000u);
              acc = mfma16(ff[j][0], T0, acc); acc = mfma16(ff[j][1], T1, acc); acc = mfma16(ff[j][2], T2, acc); acc = mfma16(ff[j][3], T3, acc);
              u32x2 w; w.x = cvt_pk_bf16(gelu_fast(acc[0]), gelu_fast(acc[1])); w.y = cvt_pk_bf16(gelu_fast(acc[2]), gelu_fast(acc[3]));
              *(LAS u32x2*)(yw + j * YST_LD) = w; }
          fb += 8192; yq += (size_t)2 * D * 2; yw += 2 * YST_LD; } }
    asm volatile("s_waitcnt lgkmcnt(0)" ::: "memory");
}
__device__ __forceinline__ void s5_pair1(int pr, int g, int wave, int lane, const bf16_t* Z, bf16_t* Y, const unsigned char* tab, float* SEND, float* SEND2, float* SE, LAS unsigned char* lds) {
    const int ln = lane & 15, q = lane >> 4; const int t0 = pr * 256;
    const char* KTg = (const char*)(tab + S5_KT) + (size_t)g * 8192; const char* ETg = (const char*)(tab + S5_ET) + (size_t)g * 32768;
    const float* LAMPg = (const float*)(tab + S5_LAMP) + (size_t)g * CS * 8;
    const unsigned vo128 = (unsigned)(ln * 128 + 8 * q) * 2u, vo32 = (unsigned)(ln * 32 + 8 * q) * 2u, vl = (unsigned)lane * 4u;
    LAS float* SbA = (LAS float*)(lds + wave * 16384); LAS float* SbB = SbA + 2048;
    bf16x8 XA0, XA1, XA2, XA3, XB0, XB1, XB2, XB3;
    { const char* zb = (const char*)(Z + (size_t)t0 * INC + ZC + g * 16); const unsigned vz = (unsigned)((ln * 8 + (q >> 1)) * INC + 8 * (q & 1)) * 2u;
      XA0 = ldg<bf16x8>(zb, vz); XA1 = ldg<bf16x8>(zb + 2 * INC * 2, vz); XA2 = ldg<bf16x8>(zb + 4 * INC * 2, vz); XA3 = ldg<bf16x8>(zb + 6 * INC * 2, vz);
      const char* zc = zb + (size_t)128 * INC * 2;
      XB0 = ldg<bf16x8>(zc, vz); XB1 = ldg<bf16x8>(zc + 2 * INC * 2, vz); XB2 = ldg<bf16x8>(zc + 4 * INC * 2, vz); XB3 = ldg<bf16x8>(zc + 6 * INC * 2, vz); }
    { LAS float* sw = SbA + (4 * q) * 128 + ln; const char* eb = ETg;
#pragma unroll
      for (int jh = 0; jh < 2; ++jh) { bf16x8 ef[4][4];
#pragma unroll
        for (int j = 0; j < 4; ++j)
#pragma unroll
          for (int ks = 0; ks < 4; ++ks) ef[j][ks] = ldg<bf16x8>(eb + j * 4096 + ks * 64, vo128);
#pragma unroll
        for (int j = 0; j < 4; ++j) { f32x4 sa = (f32x4){0.f, 0.f, 0.f, 0.f}, sb = (f32x4){0.f, 0.f, 0.f, 0.f};
          sa = mfma16(XA0, ef[j][0], sa); sb = mfma16(XB0, ef[j][0], sb); sa = mfma16(XA1, ef[j][1], sa); sb = mfma16(XB1, ef[j][1], sb);
          sa = mfma16(XA2, ef[j][2], sa); sb = mfma16(XB2, ef[j][2], sb); sa = mfma16(XA3, ef[j][3], sa); sb = mfma16(XB3, ef[j][3], sb);
          LAS float* s2 = sw + 16 * j; s2[0] = sa[0]; s2[128] = sa[1]; s2[256] = sa[2]; s2[384] = sa[3]; s2[2048] = sb[0]; s2[2048 + 128] = sb[1]; s2[2048 + 256] = sb[2]; s2[2048 + 384] = sb[3]; }
        eb += 16384; sw += 64; } }
    asm volatile("" ::: "memory");
    { const char* kb = KTg; char* yq = (char*)(Y + (size_t)t0 * D + AW + BW + g * 16); const unsigned vy = (unsigned)((ln * 8) * D + 4 * q) * 2u;
#pragma unroll 1
      for (int th = 0; th < 4; ++th) {
          const bf16x8 ka = ldg<bf16x8>(kb, vo32), kc = ldg<bf16x8>(kb + 1024, vo32);
          f32x4 a0 = (f32x4){0.f, 0.f, 0.f, 0.f}, a1 = a0, b0 = a0, b1 = a0;
          a0 = mfma16(ka, XA0, a0); a1 = mfma16(kc, XA0, a1); b0 = mfma16(ka, XB0, b0); b1 = mfma16(kc, XB0, b1);
          if (th >= 1) { const bf16x8 k0 = ldg<bf16x8>(kb - 2048, vo32), k1 = ldg<bf16x8>(kb - 1024, vo32); a0 = mfma16(k0, XA1, a0); a1 = mfma16(k1, XA1, a1); b0 = mfma16(k0, XB1, b0); b1 = mfma16(k1, XB1, b1); }
          if (th >= 2) { const bf16x8 k0 = ldg<bf16x8>(kb - 4096, vo32), k1 = ldg<bf16x8>(kb - 3072, vo32); a0 = mfma16(k0, XA2, a0); a1 = mfma16(k1, XA2, a1); b0 = mfma16(k0, XB2, b0); b1 = mfma16(k1, XB2, b1); }
          if (th >= 3) { const bf16x8 k0 = ldg<bf16x8>(kb - 6144, vo32), k1 = ldg<bf16x8>(kb - 5120, vo32); a0 = mfma16(k0, XA3, a0); a1 = mfma16(k1, XA3, a1); b0 = mfma16(k0, XB3, b0); b1 = mfma16(k1, XB3, b1); }
          u32x2 w; w.x = cvt_pk_bf16(a0[0], a0[1]); w.y = cvt_pk_bf16(a0[2], a0[3]); *(u32x2*)(yq + vy) = w;
          w.x = cvt_pk_bf16(a1[0], a1[1]); w.y = cvt_pk_bf16(a1[2], a1[3]); *(u32x2*)(yq + (size_t)D * 2 + vy) = w;
          w.x = cvt_pk_bf16(b0[0], b0[1]); w.y = cvt_pk_bf16(b0[2], b0[3]); *(u32x2*)(yq + (size_t)128 * D * 2 + vy) = w;
          w.x = cvt_pk_bf16(b1[0], b1[1]); w.y = cvt_pk_bf16(b1[2], b1[3]); *(u32x2*)(yq + (size_t)129 * D * 2 + vy) = w;
          kb += 2048; yq += (size_t)2 * D * 2; } }
    asm volatile("" ::: "memory");
    const float l8r = LAMPg[lane * 8 + 2], l8i = LAMPg[lane * 8 + 3];
    float sr = 0.f, si = 0.f;
    { char* seb = (char*)(SE + ((size_t)(2 * pr) * CG + g) * 16 * 128);
#pragma unroll
      for (int s = 0; s < 16; ++s) { const float er = SbA[s * 128 + lane], ei = SbA[s * 128 + 64 + lane];
          *(float*)(seb + s * 512 + vl) = er; *(float*)(seb + s * 512 + 256 + vl) = ei;
          const float nr = l8r * sr - l8i * si + er, ni = l8r * si + l8i * sr + ei; sr = nr; si = ni; }
      float* dst = SEND + (((size_t)(2 * pr) * CG + g) * 2) * CS + lane; dst[0] = sr; dst[CS] = si; }
    { char* seb = (char*)(SE + ((size_t)(2 * pr + 1) * CG + g) * 16 * 128);
#pragma unroll
      for (int s = 0; s < 16; ++s) { const float er = SbB[s * 128 + lane], ei = SbB[s * 128 + 64 + lane];
          *(float*)(seb + s * 512 + vl) = er; *(float*)(seb + s * 512 + 256 + vl) = ei;
          const float nr = l8r * sr - l8i * si + er, ni = l8r * si + l8i * sr + ei; sr = nr; si = ni; }
      float* dst = SEND2 + (((size_t)pr * CG + g) * 2) * CS + lane; dst[0] = sr; dst[CS] = si; }
    asm volatile("s_waitcnt lgkmcnt(0)" ::: "memory");
}
constexpr int S5_PSG = 133120;
__device__ __forceinline__ void s5_glu(int unit, int wave, int lane, const bf16_t* WGLU, const float* glu_b, const float* mo_gc, bf16_t* Y, LAS unsigned char* lds) {
    const int ln = lane & 15, q = lane >> 4; LAS bf16_t* yst = (LAS bf16_t*)(lds + S5_YST); LAS float* PSg = (LAS float*)(lds + S5_PSG);
    bf16x8 wf[2][8];
    { const char* wb = (const char*)(WGLU + (size_t)(32 * wave) * 256); const unsigned vw = (unsigned)(ln * 256 + 8 * q) * 2u;
#pragma unroll
      for (int j = 0; j < 2; ++j)
#pragma unroll
          for (int ks = 0; ks < 8; ++ks) wf[j][ks] = ldg<bf16x8>(wb + j * 8192 + ks * 64, vw); }
    const f32x4 gb0 = *(const f32x4*)(glu_b + 32 * wave + 4 * q), gb1 = *(const f32x4*)(glu_b + 32 * wave + 16 + 4 * q);
    LAS bf16_t* op = (LAS bf16_t*)(lds + wave * S5_WSCR) + ln * 32 + 4 * q;
    { const LAS bf16_t* yrow = yst + ln * YST_LD; LAS float* psw = PSg + ln * 8 + wave; LAS bf16_t* ow = op;
#pragma unroll 4
      for (int tt = 0; tt < 8; ++tt) {
        f32x4 a0 = (f32x4){0.f, 0.f, 0.f, 0.f}, a1 = (f32x4){0.f, 0.f, 0.f, 0.f};
#pragma unroll
        for (int ks = 0; ks < 8; ++ks) { const bf16x8 yf = *(const LAS bf16x8*)(yrow + 32 * ks + 8 * q); a0 = mfma16(wf[0][ks], yf, a0); a1 = mfma16(wf[1][ks], yf, a1); }
        const u32x2 y0 = *(const LAS u32x2*)(yrow + 32 * wave + 4 * q), y1 = *(const LAS u32x2*)(yrow + 32 * wave + 16 + 4 * q);
        float o[8];
        o[0] = __uint_as_float(y0.x << 16) * sigmoid_fast(a0[0] + gb0[0]); o[1] = __uint_as_float(y0.x & 0xffff0000u) * sigmoid_fast(a0[1] + gb0[1]); o[2] = __uint_as_float(y0.y << 16) * sigmoid_fast(a0[2] + gb0[2]); o[3] = __uint_as_float(y0.y & 0xffff0000u) * sigmoid_fast(a0[3] + gb0[3]);
        o[4] = __uint_as_float(y1.x << 16) * sigmoid_fast(a1[0] + gb1[0]); o[5] = __uint_as_float(y1.x & 0xffff0000u) * sigmoid_fast(a1[1] + gb1[1]); o[6] = __uint_as_float(y1.y << 16) * sigmoid_fast(a1[2] + gb1[2]); o[7] = __uint_as_float(y1.y & 0xffff0000u) * sigmoid_fast(a1[3] + gb1[3]);
        float ss = ((o[0] * o[0] + o[1] * o[1]) + (o[2] * o[2] + o[3] * o[3])) + ((o[4] * o[4] + o[5] * o[5]) + (o[6] * o[6] + o[7] * o[7]));
        ss = add_x16_x32(ss);
        if (q == 0) *psw = ss;
        u32x2 w; w.x = cvt_pk_bf16(o[0], o[1]); w.y = cvt_pk_bf16(o[2], o[3]); *(LAS u32x2*)(ow) = w; w.x = cvt_pk_bf16(o[4], o[5]); w.y = cvt_pk_bf16(o[6], o[7]); *(LAS u32x2*)(ow + 16) = w;
        yrow += 16 * YST_LD; psw += 16 * 8; ow += 16 * 32; } }
    asm volatile("s_waitcnt lgkmcnt(0)" ::: "memory");
    __syncthreads();
    { const int p = lane & 31, rsel = lane >> 5; const f32x4 g0 = *(const f32x4*)(mo_gc + 8 * p), g1 = *(const f32x4*)(mo_gc + 8 * p + 4);
      const LAS unsigned char* src = lds + (p >> 2) * S5_WSCR + (p & 3) * 16; bf16_t* yb = Y + (size_t)(unit * 128) * D + AW + BW + 8 * p;
#pragma unroll 4
      for (int it = 0; it < 8; ++it) { const int row = 16 * wave + 2 * it + rsel; const LAS f32x4* pp = (const LAS f32x4*)(PSg + row * 8); const f32x4 p0 = pp[0], p1 = pp[1];
        const float rs = __builtin_amdgcn_rsqf((((p0[0] + p0[1]) + (p0[2] + p0[3])) + ((p1[0] + p1[1]) + (p1[2] + p1[3]))) * (1.0f / CW) + EPS);
        const u32x4 a = *(const LAS u32x4*)(src + row * 64); u32x4 w;
        w.x = cvt_pk_bf16(__uint_as_float(a.x << 16) * rs * g0[0], __uint_as_float(a.x & 0xffff0000u) * rs * g0[1]); w.y = cvt_pk_bf16(__uint_as_float(a.y << 16) * rs * g0[2], __uint_as_float(a.y & 0xffff0000u) * rs * g0[3]);
        w.z = cvt_pk_bf16(__uint_as_float(a.z << 16) * rs * g1[0], __uint_as_float(a.z & 0xffff0000u) * rs * g1[1]); w.w = cvt_pk_bf16(__uint_as_float(a.w << 16) * rs * g1[2], __uint_as_float(a.w & 0xffff0000u) * rs * g1[3]);
        *(u32x4*)(yb + (size_t)row * D) = w; } }
}

constexpr int XC_LD = 392;
constexpr int RG_XC = 0, RG_PS = 100352, RG_CAR = 112640, RG_RSB = 114176, RG_PT = 114688, RG_HC = 116224;
template <int CTRL> __device__ __forceinline__ float dpp0(float v) { return __int_as_float(__builtin_amdgcn_update_dpp(0, __float_as_int(v), CTRL, 0xf, 0xf, true)); }
template <int CTRL> __device__ __forceinline__ float dppf(float old, float v) { return __int_as_float(__builtin_amdgcn_update_dpp(__float_as_int(old), __float_as_int(v), CTRL, 0xf, 0xf, false)); }
__device__ __forceinline__ void bf8_to_f32(const u32x4 o, float (&v)[8]) {
    v[0] = __uint_as_float(o.x << 16); v[1] = __uint_as_float(o.x & 0xffff0000u); v[2] = __uint_as_float(o.y << 16); v[3] = __uint_as_float(o.y & 0xffff0000u);
    v[4] = __uint_as_float(o.z << 16); v[5] = __uint_as_float(o.z & 0xffff0000u); v[6] = __uint_as_float(o.w << 16); v[7] = __uint_as_float(o.w & 0xffff0000u);
}
__device__ __forceinline__ float bcast15(float v) { return __int_as_float(__builtin_amdgcn_ds_swizzle(__float_as_int(v), 0x1F0)); }
template <int PASS>
__device__ __forceinline__ void rglru_unit(int unit, bool first, float& cprev, int tid, int wave, int lane, const bf16_t* Z, bf16_t* Y, const bf16_t* WRG, const bf16_t* WIG,
                                           const float* conv_w, const float* conv_b, const float* rg_b, const float* ig_b, const float* lam, const float* mo_gb,
                                           float* SUMA, float* SUMH, float* SUMA2, float* SUMH2, bf16_t* HL, bf16_t* PP, LAS unsigned char* lds) {
    LAS bf16_t* xcl = (LAS bf16_t*)(lds + RG_XC); LAS float* PS = (LAS float*)(lds + RG_PS); LAS float* CAR = (LAS float*)(lds + RG_CAR); LAS float* RSB = (LAS float*)(lds + RG_RSB); LAS float* PT = (LAS float*)(lds + RG_PT); LAS float* HC = (LAS float*)(lds + RG_HC);
    const int t0 = unit * 128; const int ln = lane & 15, q = lane >> 4;
    if (tid < 384) {
        const int c0 = (tid % 48) * 8, tg = tid / 48; const int tb = t0 + tg * 16, s0 = tb % SEQ;
        float w0[8], w1[8], w2[8], w3[8], bb[8];
#pragma unroll
        for (int hh = 0; hh < 2; ++hh) { const f32x4 a0 = *(const f32x4*)(conv_w + 0 * BW + c0 + 4 * hh), a1 = *(const f32x4*)(conv_w + 1 * BW + c0 + 4 * hh), a2 = *(const f32x4*)(conv_w + 2 * BW + c0 + 4 * hh), a3 = *(const f32x4*)(conv_w + 3 * BW + c0 + 4 * hh), a4 = *(const f32x4*)(conv_b + c0 + 4 * hh);
#pragma unroll
            for (int j = 0; j < 4; ++j) { w0[4 * hh + j] = a0[j]; w1[4 * hh + j] = a1[j]; w2[4 * hh + j] = a2[j]; w3[4 * hh + j] = a3[j]; bb[4 * hh + j] = a4[j]; } }
        float xm1[8], xm2[8], xm3[8];
        const bf16_t* zp = Z + (size_t)tb * INC + ZX + c0;
        { const u32x4 z4 = {0u, 0u, 0u, 0u}; const u32x4 o1 = s0 >= 1 ? *(const u32x4*)(zp - INC) : z4, o2 = s0 >= 2 ? *(const u32x4*)(zp - 2 * INC) : z4, o3 = s0 >= 3 ? *(const u32x4*)(zp - 3 * INC) : z4;
          bf8_to_f32(o1, xm1); bf8_to_f32(o2, xm2); bf8_to_f32(o3, xm3); }
        LAS bf16_t* xw = xcl + (tg * 16) * XC_LD + c0;
#pragma unroll 4
        for (int i = 0; i < 16; ++i) { float x0[8]; bf8_to_f32(*(const u32x4*)(zp), x0); float v[8];
#pragma unroll
            for (int j = 0; j < 8; ++j) { v[j] = bb[j] + w3[j] * x0[j] + w2[j] * xm1[j] + w1[j] * xm2[j] + w0[j] * xm3[j]; xm3[j] = xm2[j]; xm2[j] = xm1[j]; xm1[j] = x0[j]; }
            u32x4 w; w.x = cvt_pk_bf16(v[0], v[1]); w.y = cvt_pk_bf16(v[2], v[3]); w.z = cvt_pk_bf16(v[4], v[5]); w.w = cvt_pk_bf16(v[6], v[7]);
            *(LAS u32x4*)(xw) = w; zp += INC; xw += XC_LD; }
        if (PASS == 2) { const int c = tid; float h;
            if (first) { const int pr = unit >> 1, p0 = pr - (pr % (UPB128 / 2)); h = 0.f; const float* pa = SUMA2 + (size_t)p0 * BW + c; const float* ph = SUMH2 + (size_t)p0 * BW + c;
#pragma unroll 8
                for (int j = p0; j < pr; ++j) { h = fmaf(*pa, h, *ph); pa += BW; ph += BW; } }
            else h = fmaf(SUMA[(size_t)(unit - 1) * BW + c], cprev, SUMH[(size_t)(unit - 1) * BW + c]);
            cprev = h; CAR[c] = h; }
    }
    __syncthreads();
#pragma unroll 1
    for (int ci = 0; ci < 3; ++ci) {
        const int combo = wave + 8 * ci, h = combo >> 2, jt = combo & 3, cb = h * 64 + jt * 16;
        const bf16_t* wr = WRG + ((size_t)(h * 64 + jt * 16 + ln)) * 64 + 8 * q; const bf16_t* wi = WIG + ((size_t)(h * 64 + jt * 16 + ln)) * 64 + 8 * q;
        const bf16x8 RG0 = *(const bf16x8*)(wr), RG1 = *(const bf16x8*)(wr + 32), IG0 = *(const bf16x8*)(wi), IG1 = *(const bf16x8*)(wi + 32);
        const f32x4 rgb4 = *(const f32x4*)(rg_b + cb + 4 * q), igb4 = *(const f32x4*)(ig_b + cb + 4 * q), lam4 = *(const f32x4*)(lam + cb + 4 * q);
        const float m1 = ln < 1 ? 1.f : 0.f, m2 = ln < 2 ? 1.f : 0.f, m4 = ln < 4 ? 1.f : 0.f, m8 = ln < 8 ? 1.f : 0.f;
        float spc[4], car[4], ptot[4];
#pragma unroll
        for (int r = 0; r < 4; ++r) { spc[r] = -8.0f * 1.4426950408889634f * log1pf(expf(-lam4[r])); car[r] = PASS == 2 ? CAR[cb + 4 * q + r] : (first ? 0.f : HC[cb + 4 * q + r]); ptot[r] = (PASS == 1 && !first) ? PT[cb + 4 * q + r] : 1.f; }
        const LAS bf16_t* xb = xcl + ln * XC_LD + h * 64 + 8 * q; const LAS bf16_t* xv = xcl + ln * XC_LD + cb + 4 * q;
        const bf16_t* zg = Z + (size_t)(t0 + ln) * INC + ZG + cb + 4 * q; bf16_t* yo = Y + (size_t)(t0 + ln) * D + AW + cb + 4 * q; LAS float* psw = PS + ln * 24 + combo;
        bf16_t* hlo = HL + (size_t)(t0 + ln) * BW + cb + 4 * q; bf16_t* ppo = PP + (size_t)(t0 + ln) * BW + cb + 4 * q;
#pragma unroll 1
        for (int tt = 0; tt < 8; ++tt) {
            const bf16x8 B0 = *(const LAS bf16x8*)(xb), B1 = *(const LAS bf16x8*)(xb + 32);
            f32x4 ar = (f32x4){0.f, 0.f, 0.f, 0.f}, ai = (f32x4){0.f, 0.f, 0.f, 0.f};
            ar = mfma16(RG0, B0, ar); ar = mfma16(RG1, B1, ar); ai = mfma16(IG0, B0, ai); ai = mfma16(IG1, B1, ai);
            const u32x2 xq = *(const LAS u32x2*)(xv); float xc4[4] = {__uint_as_float(xq.x << 16), __uint_as_float(xq.x & 0xffff0000u), __uint_as_float(xq.y << 16), __uint_as_float(xq.y & 0xffff0000u)};
            float hv[4], pv[4];
#pragma unroll
            for (int r = 0; r < 4; ++r) {
                const float rr = sigmoid_fast(ar[r] + rgb4[r]), ii = sigmoid_fast(ai[r] + igb4[r]);
                float A = __builtin_amdgcn_exp2f(spc[r] * rr);
                float Bv = __builtin_amdgcn_sqrtf(fmaxf(1.0f - A * A, 0.f)) * (ii * xc4[r]);
                if (ln == 0) { Bv = fmaf(A, car[r], Bv); A *= ptot[r]; }
                { const float As = dpp0<0x111>(A) + m1, Bs = dpp0<0x111>(Bv); Bv = fmaf(A, Bs, Bv); A *= As; }
                { const float As = dpp0<0x112>(A) + m2, Bs = dpp0<0x112>(Bv); Bv = fmaf(A, Bs, Bv); A *= As; }
                { const float As = dpp0<0x114>(A) + m4, Bs = dpp0<0x114>(Bv); Bv = fmaf(A, Bs, Bv); A *= As; }
                { const float As = dpp0<0x118>(A) + m8, Bs = dpp0<0x118>(Bv); Bv = fmaf(A, Bs, Bv); A *= As; }
                hv[r] = Bv; pv[r] = A; car[r] = dppf<0x121>(Bv, Bv); ptot[r] = dppf<0x121>(A, A);
            }
            if (PASS == 1) { u32x2 w; w.x = cvt_pk_bf16(hv[0], hv[1]); w.y = cvt_pk_bf16(hv[2], hv[3]); *(u32x2*)(hlo) = w; w.x = cvt_pk_bf16(pv[0], pv[1]); w.y = cvt_pk_bf16(pv[2], pv[3]); *(u32x2*)(ppo) = w; hlo += 16 * BW; ppo += 16 * BW; }
            if (PASS == 2) { const u32x2 gq = *(const u32x2*)(zg);
                const float y0 = hv[0] * __uint_as_float(gq.x << 16), y1 = hv[1] * __uint_as_float(gq.x & 0xffff0000u), y2 = hv[2] * __uint_as_float(gq.y << 16), y3 = hv[3] * __uint_as_float(gq.y & 0xffff0000u);
                u32x2 w; w.x = cvt_pk_bf16(y0, y1); w.y = cvt_pk_bf16(y2, y3); *(u32x2*)(yo) = w;
                float ss = (y0 * y0 + y1 * y1) + (y2 * y2 + y3 * y3); ss += __shfl_xor(ss, 16); ss += __shfl_xor(ss, 32);
                if (q == 0) *psw = ss; }
            xb += 16 * XC_LD; xv += 16 * XC_LD; zg += 16 * INC; yo += 16 * D; psw += 16 * 24;
        }
        if (PASS == 1 && ln == 0) {
            float* da = first ? SUMA + (size_t)unit * BW : SUMA2 + (size_t)(unit >> 1) * BW; float* dh = first ? SUMH + (size_t)unit * BW : SUMH2 + (size_t)(unit >> 1) * BW;
#pragma unroll
            for (int r = 0; r < 4; ++r) { da[cb + 4 * q + r] = ptot[r]; dh[cb + 4 * q + r] = car[r]; if (first) { PT[cb + 4 * q + r] = ptot[r]; HC[cb + 4 * q + r] = car[r]; } } }
    }
    if (PASS == 2) {
        asm volatile("s_waitcnt vmcnt(0)" ::: "memory");
        __syncthreads();
        if (tid < 128) { float s = 0.f;
#pragma unroll
            for (int k = 0; k < 24; ++k) s += PS[tid * 24 + k];
            RSB[tid] = __builtin_amdgcn_rsqf(s * (1.0f / BW) + EPS); }
        __syncthreads();
#pragma unroll 2
        for (int k = 0; k < 12; ++k) { const int idx = tid + 512 * k, tl = idx / 48, c0 = (idx % 48) * 8; const float rs = RSB[tl];
            bf16_t* yp = Y + (size_t)(t0 + tl) * D + AW + c0; float v[8]; bf8_to_f32(*(const u32x4*)(yp), v);
            const f32x4 g0 = *(const f32x4*)(mo_gb + c0), g1 = *(const f32x4*)(mo_gb + c0 + 4);
            u32x4 w; w.x = cvt_pk_bf16(v[0] * rs * g0[0], v[1] * rs * g0[1]); w.y = cvt_pk_bf16(v[2] * rs * g0[2], v[3] * rs * g0[3]); w.z = cvt_pk_bf16(v[4] * rs * g1[0], v[5] * rs * g1[1]); w.w = cvt_pk_bf16(v[6] * rs * g1[2], v[7] * rs * g1[3]);
            *(u32x4*)(yp) = w; }
    }
    __syncthreads();
}

__device__ __forceinline__ void rglru_fix_pair(int pr, int tid, int wave, int lane, const bf16_t* Z, bf16_t* Y, const bf16_t* HL, const bf16_t* PP, const float* SUMA2, const float* SUMH2, const float* mo_gb, LAS unsigned char* lds) {
    LAS float* CAR = (LAS float*)(lds + RG_CAR);
    if (tid < 384) { const int c = tid, p0 = pr - (pr % (UPB128 / 2)); float h = 0.f; const float* pa = SUMA2 + (size_t)p0 * BW + c; const float* ph = SUMH2 + (size_t)p0 * BW + c;
#pragma unroll 8
        for (int j = p0; j < pr; ++j) { h = fmaf(*pa, h, *ph); pa += BW; ph += BW; }
        CAR[c] = h; }
    __syncthreads();
    {
        typedef unsigned u32x3 __attribute__((ext_vector_type(3)));
        const int c0 = lane * 6; float hin[6], gch[6];
#pragma unroll
        for (int e = 0; e < 6; ++e) { hin[e] = CAR[c0 + e]; gch[e] = mo_gb[c0 + e]; }
#pragma unroll 2
        for (int i = 0; i < 32; ++i) { const size_t t = (size_t)pr * 256 + wave * 32 + i;
            const u32x3 h3 = *(const u32x3*)(HL + t * BW + c0), p3 = *(const u32x3*)(PP + t * BW + c0), g3 = *(const u32x3*)(Z + t * INC + ZG + c0);
            float y[6]; float ss = 0.f;
#pragma unroll
            for (int e = 0; e < 3; ++e) { const unsigned hh = h3[e], pq = p3[e], gq = g3[e];
                y[2 * e] = fmaf(__uint_as_float(pq << 16), hin[2 * e], __uint_as_float(hh << 16)) * gelu_fast(__uint_as_float(gq << 16));
                y[2 * e + 1] = fmaf(__uint_as_float(pq & 0xffff0000u), hin[2 * e + 1], __uint_as_float(hh & 0xffff0000u)) * gelu_fast(__uint_as_float(gq & 0xffff0000u));
                ss += y[2 * e] * y[2 * e] + y[2 * e + 1] * y[2 * e + 1]; }
            ss = wave_sum(ss);
            const float rs = __builtin_amdgcn_rsqf(ss * (1.0f / BW) + EPS);
            u32x3 w; w.x = cvt_pk_bf16(y[0] * rs * gch[0], y[1] * rs * gch[1]); w.y = cvt_pk_bf16(y[2] * rs * gch[2], y[3] * rs * gch[3]); w.z = cvt_pk_bf16(y[4] * rs * gch[4], y[5] * rs * gch[5]);
            *(u32x3*)(Y + t * D + AW + c0) = w; }
    }
    __syncthreads();
}

constexpr int VT_LD = 136;
__device__ __forceinline__ void mixa_unit(int unit, int tid, int wave, int lane, const bf16_t* Z, bf16_t* Y, const bf16_t* WSP, const float* a_sb, const float* vg, const float* mo_ga, LAS unsigned char* lds) {
    LAS bf16_t* vT = (LAS bf16_t*)lds; const int t0 = unit * 128; const int ln = lane & 15, q = lane >> 4;
    { const int j = tid >> 2, part = tid & 3; const bf16_t* zp = Z + (size_t)(t0 + j) * INC + ZV + part * 8;
      u32x4 raw[12]; float ss = 0.f;
#pragma unroll
      for (int k = 0; k < 12; ++k) { const u32x4 rw = *(const u32x4*)(zp + 32 * k); float v[8]; bf8_to_f32(rw, v);
#pragma unroll
          for (int e = 0; e < 8; ++e) { v[e] = gelu_fast(v[e]); ss += v[e] * v[e]; }
          raw[k].x = cvt_pk_bf16(v[0], v[1]); raw[k].y = cvt_pk_bf16(v[2], v[3]); raw[k].z = cvt_pk_bf16(v[4], v[5]); raw[k].w = cvt_pk_bf16(v[6], v[7]); }
      ss += x_xor1(ss); ss += x_xor2(ss);
      const float rs = __builtin_amdgcn_rsqf(ss * (1.0f / AW) + EPS);
      LAS bf16_t* vw = vT + (part * 8) * VT_LD + j; const float* gp = vg + part * 8;
#pragma unroll
      for (int k = 0; k < 12; ++k) { float v[8]; bf8_to_f32(raw[k], v); const f32x4 g0 = *(const f32x4*)(gp + 32 * k), g1 = *(const f32x4*)(gp + 32 * k + 4);
#pragma unroll
          for (int e = 0; e < 8; ++e) vw[(32 * k + e) * VT_LD] = f2bf(v[e] * rs * (e < 4 ? g0[e] : g1[e - 4])); } }
    __syncthreads();
    const bool full = wave >= 4;
    float ss = 0.f;
    const int tl = 16 * wave + ln;
    const char* ub = (const char*)(Z + (size_t)t0 * INC + ZU); const unsigned vu = (unsigned)(tl * INC + 4 * q) * 2u;
    const char* wb = (const char*)WSP; const unsigned vw = (unsigned)(tl * 128 + 8 * q) * 2u;
    const bf16x8 z8 = {0, 0, 0, 0, 0, 0, 0, 0};
    bf16x8 Wn0 = ldg<bf16x8>(wb, vw), Wn1 = ldg<bf16x8>(wb + 64, vw), Wn2 = z8, Wn3 = z8;
    if (full) { Wn2 = ldg<bf16x8>(wb + 128, vw); Wn3 = ldg<bf16x8>(wb + 192, vw); }
    u32x2 un0 = ldg<u32x2>(ub, vu), un1 = ldg<u32x2>(ub + 32, vu), un2 = ldg<u32x2>(ub + 64, vu), un3 = ldg<u32x2>(ub + 96, vu); float bn = a_sb[tl];
    const LAS bf16_t* ap = vT + ln * VT_LD + 8 * q;
    u32x2 val[24];
#pragma unroll
    for (int h = 0; h < 6; ++h) {
        const bf16x8 W0 = Wn0, W1 = Wn1, W2 = Wn2, W3 = Wn3; const u32x2 uc[4] = {un0, un1, un2, un3}; const float b = bn;
        if (h < 5) { const char* wq = wb + (size_t)(h + 1) * 128 * 128 * 2; const char* uq2 = ub + (h + 1) * 128;
            Wn0 = ldg<bf16x8>(wq, vw); Wn1 = ldg<bf16x8>(wq + 64, vw); if (full) { Wn2 = ldg<bf16x8>(wq + 128, vw); Wn3 = ldg<bf16x8>(wq + 192, vw); }
            un0 = ldg<u32x2>(uq2, vu); un1 = ldg<u32x2>(uq2 + 32, vu); un2 = ldg<u32x2>(uq2 + 64, vu); un3 = ldg<u32x2>(uq2 + 96, vu); bn = a_sb[(h + 1) * 128 + tl]; }
        asm volatile("" ::: "memory");
#pragma unroll
        for (int dt = 0; dt < 4; ++dt) { f32x4 acc = (f32x4){0.f, 0.f, 0.f, 0.f};
            const LAS bf16_t* aq = ap + (h * 64 + 16 * dt) * VT_LD;
            const bf16x8 a0 = *(const LAS bf16x8*)(aq), a1 = *(const LAS bf16x8*)(aq + 32), a2 = *(const LAS bf16x8*)(aq + 64), a3 = *(const LAS bf16x8*)(aq + 96);
            acc = mfma16(a0, W0, acc); acc = mfma16(a1, W1, acc); acc = mfma16(a2, W2, acc); acc = mfma16(a3, W3, acc);
            const u32x2 u2 = uc[dt];
            const float v0 = gelu_fast(__uint_as_float(u2.x << 16)) * (acc[0] + b), v1 = gelu_fast(__uint_as_float(u2.x & 0xffff0000u)) * (acc[1] + b), v2 = gelu_fast(__uint_as_float(u2.y << 16)) * (acc[2] + b), v3 = gelu_fast(__uint_as_float(u2.y & 0xffff0000u)) * (acc[3] + b);
            ss += (v0 * v0 + v1 * v1) + (v2 * v2 + v3 * v3);
            u32x2 pk; pk.x = cvt_pk_bf16(v0, v1); pk.y = cvt_pk_bf16(v2, v3); val[h * 4 + dt] = pk; }
    }
    ss = add_x16_x32(ss);
    const float rs = __builtin_amdgcn_rsqf(ss * (1.0f / AW) + EPS);
    __syncthreads();
    { LAS unsigned char* scr = lds + wave * (16 * 784);
      const char* gb = (const char*)mo_ga; const unsigned vg4 = (unsigned)(4 * q) * 4u; LAS unsigned char* sw = scr + ln * 784 + q * 8;
#pragma unroll
      for (int k = 0; k < 24; ++k) { const f32x4 gg = ldg<f32x4>(gb + k * 64, vg4); const u32x2 pk = val[k];
          u32x2 w; w.x = cvt_pk_bf16(__uint_as_float(pk.x << 16) * rs * gg[0], __uint_as_float(pk.x & 0xffff0000u) * rs * gg[1]); w.y = cvt_pk_bf16(__uint_as_float(pk.y << 16) * rs * gg[2], __uint_as_float(pk.y & 0xffff0000u) * rs * gg[3]);
          *(LAS u32x2*)(sw + k * 32) = w; }
      asm volatile("s_waitcnt lgkmcnt(0)" ::: "memory");
      bf16_t* yr = Y + (size_t)(t0 + 16 * wave) * D;
      { int row = lane >= 48 ? 1 : 0, cp = lane >= 48 ? lane - 48 : lane;
#pragma unroll 2
        for (int i = 0; i < 12; ++i) { const unsigned so = (unsigned)(row * 784 + cp * 16), go = (unsigned)(row * D + cp * 8) * 2u;
            const u32x4 v = *(const LAS u32x4*)(scr + so); *(u32x4*)((char*)yr + go) = v;
            cp += 16; row += 1; if (cp >= 48) { cp -= 48; row += 1; } } } }
    __syncthreads();
}

__device__ __forceinline__ void router_unit(int unit, int wave, int lane, const bf16_t* HB, const float* SSQ, const bf16_t* WRT, const float* rgb, const float* reb,
                                            int* CLS, float* G2, LAS unsigned char* lds, LAS int* hist) {
    const int ln = lane & 15, q = lane >> 4; const int t0 = unit * UT + wave * 32;
    LAS float* LG = (LAS float*)(lds + wave * 8192);
    f32x4 acc[2][3];
#pragma unroll
    for (int tt = 0; tt < 2; ++tt)
#pragma unroll
        for (int j = 0; j < 3; ++j) acc[tt][j] = (f32x4){0.f, 0.f, 0.f, 0.f};
    const bf16_t* hp0 = HB + (size_t)(t0 + ln) * D + 8 * q; const bf16_t* hp1 = hp0 + (size_t)16 * D; const bf16_t* wp = WRT + (size_t)ln * D + 8 * q;
#pragma unroll 4
    for (int ks = 0; ks < 32; ++ks) {
        const bf16x8 b0 = *(const bf16x8*)(hp0), b1 = *(const bf16x8*)(hp1);
        const bf16x8 a0 = *(const bf16x8*)(wp), a1 = *(const bf16x8*)(wp + 16 * D), a2 = *(const bf16x8*)(wp + 32 * D);
        acc[0][0] = mfma16(a0, b0, acc[0][0]); acc[0][1] = mfma16(a1, b0, acc[0][1]); acc[0][2] = mfma16(a2, b0, acc[0][2]);
        acc[1][0] = mfma16(a0, b1, acc[1][0]); acc[1][1] = mfma16(a1, b1, acc[1][1]); acc[1][2] = mfma16(a2, b1, acc[1][2]);
        hp0 += 32; hp1 += 32; wp += 32; }
#pragma unroll
    for (int tt = 0; tt < 2; ++tt)
#pragma unroll
        for (int j = 0; j < 3; ++j) *(LAS f32x4*)(LG + (16 * tt + ln) * 48 + 16 * j + 4 * q) = acc[tt][j];
    asm volatile("s_waitcnt lgkmcnt(0)" ::: "memory");
    if (lane < 32) { const int t = t0 + lane; const LAS float* lg = LG + lane * 48;
        const f32x4* sp = (const f32x4*)(SSQ + (size_t)t * 16); const f32x4 s0 = sp[0], s1 = sp[1], s2 = sp[2], s3 = sp[3];
        const float sq = ((s0[0] + s0[1]) + (s0[2] + s0[3])) + ((s1[0] + s1[1]) + (s1[2] + s1[3])) + ((s2[0] + s2[1]) + (s2[2] + s2[3])) + ((s3[0] + s3[1]) + (s3[2] + s3[3]));
        const float r = rsqrtf(sq * (1.0f / D) + EPS);
        float gl[4];
#pragma unroll
        for (int j = 0; j < 4; ++j) gl[j] = r * (lg[j] + lg[16 + j]) + rgb[j];
        int gs = 0; float gm = gl[0];
#pragma unroll
        for (int j = 1; j < 4; ++j) if (gl[j] > gm) { gm = gl[j]; gs = j; }
        float den = 0.f;
#pragma unroll
        for (int j = 0; j < 4; ++j) den += expf(gl[j] - gm);
        const float gwt = 1.0f / den;
        float el[4];
#pragma unroll
        for (int j = 0; j < 4; ++j) { float v;
            if (gs < 3) v = lg[4 + 4 * gs + j] + lg[16 + 4 + 4 * gs + j]; else v = lg[32 + j] + lg[36 + j];
            el[j] = r * v + reb[gs * 4 + j]; }
        int i0 = 0; float v0 = el[0];
#pragma unroll
        for (int j = 1; j < 4; ++j) if (el[j] > v0) { v0 = el[j]; i0 = j; }
        int i1 = 0; float v1 = -3.0e38f;
#pragma unroll
        for (int j = 0; j < 4; ++j) if (j != i0 && el[j] > v1) { v1 = el[j]; i1 = j; }
        const float e1 = expf(v1 - v0); const float w0 = gwt / (1.0f + e1), w1 = gwt * e1 / (1.0f + e1);
        const int lo = i0 < i1 ? i0 : i1, hi = i0 < i1 ? i1 : i0; const int cls = gs * 6 + pair_idx(lo, hi);
        CLS[t] = cls; G2[(size_t)t * 2 + 0] = i0 < i1 ? w0 : w1; G2[(size_t)t * 2 + 1] = i0 < i1 ? w1 : w0;
        __hip_atomic_fetch_add(hist + cls, 1, __ATOMIC_RELAXED, __HIP_MEMORY_SCOPE_WORKGROUP); }
}

__device__ __forceinline__ void tr_item8(const float* W, int ldw, int k0, int scol0, unsigned char* WT, int ldo, int drow0, int dk0, LAS float* scr, int lane) {
#pragma unroll 8
    for (int i = 0; i < 32; ++i) { const int kk = 2 * i + (lane >> 5); scr[kk * 33 + (lane & 31)] = W[(size_t)(k0 + kk) * ldw + scol0 + (lane & 31)] * pg8::FS_W; }
    asm volatile("s_waitcnt lgkmcnt(0)" ::: "memory");
    const int c = lane & 7;
#pragma unroll
    for (int j = 0; j < 4; ++j) { const int n = (lane >> 3) + 8 * j; const LAS float* s = scr + (8 * c) * 33 + n;
        u32x2 o; o.x = pk_fp8x4(s[0 * 33], s[1 * 33], s[2 * 33], s[3 * 33]); o.y = pk_fp8x4(s[4 * 33], s[5 * 33], s[6 * 33], s[7 * 33]);
        *(u32x2*)(WT + (size_t)(drow0 + n) * ldo + dk0 + 8 * c) = o; }
    asm volatile("s_waitcnt lgkmcnt(0)" ::: "memory");
}
struct TrP { const float* src; const float* gk; unsigned char* dst; int ldw, ldo, fp8; };
__device__ __forceinline__ void tr_load(const TrP& P, int lane, float (&v)[32]) {
#pragma unroll
    for (int i = 0; i < 32; ++i) { const int kk = 2 * i + (lane >> 5); float x = P.src[(size_t)kk * P.ldw + (lane & 31)]; if (P.gk) x *= P.gk[kk]; v[i] = x; }
}
__device__ __forceinline__ void tr_store(const TrP& P, int lane, const float (&v)[32], LAS float* scr) {
    const float sc = P.fp8 ? pg8::FS_W : 1.0f;
#pragma unroll
    for (int i = 0; i < 32; ++i) scr[(2 * i + (lane >> 5)) * 33 + (lane & 31)] = v[i] * sc;
    asm volatile("s_waitcnt lgkmcnt(0)" ::: "memory");
    const int c = lane & 7;
#pragma unroll
    for (int j = 0; j < 4; ++j) { const int n = (lane >> 3) + 8 * j; const LAS float* s = scr + (8 * c) * 33 + n;
        if (P.fp8) { u32x2 o; o.x = pk_fp8x4(s[0 * 33], s[1 * 33], s[2 * 33], s[3 * 33]); o.y = pk_fp8x4(s[4 * 33], s[5 * 33], s[6 * 33], s[7 * 33]); *(u32x2*)(P.dst + (size_t)n * P.ldo + 8 * c) = o; }
        else { u32x4 o; o.x = cvt_pk_bf16(s[0 * 33], s[1 * 33]); o.y = cvt_pk_bf16(s[2 * 33], s[3 * 33]); o.z = cvt_pk_bf16(s[4 * 33], s[5 * 33]); o.w = cvt_pk_bf16(s[6 * 33], s[7 * 33]); *(u32x4*)(P.dst + (size_t)n * P.ldo + 16 * c) = o; } }
    asm volatile("s_waitcnt lgkmcnt(0)" ::: "memory");
}
struct Args { const float* in[34]; float* out; unsigned char* ws; };

__global__ void __launch_bounds__(512, 2) mega_fwd(Args a) {
    extern __shared__ __attribute__((aligned(16))) unsigned char lds_raw[];
    LAS unsigned char* lds = (LAS unsigned char*)lds_raw;
    volatile LAS unsigned* LW = (volatile LAS unsigned*)(lds + LDSCTL_OFF);
    volatile LAS int* LWI = (volatile LAS int*)(lds + LDSCTL_OFF);
    const int G = gridDim.x, bid0 = blockIdx.x; const int wave_s0 = __builtin_amdgcn_readfirstlane(threadIdx.x >> 6);
#define PHASE_IDS() int wv_ = wave_s0, bd_ = bid0; asm volatile("" : "+s"(wv_), "+s"(bd_)); const int wave_s = wv_, bid = bd_;     \
    const int lane = fresh_lane(), wave = wave_s, tid = wave * 64 + lane; const int gw = bid * 8 + wave, NGW = G * 8; \
    const size_t gt = (size_t)bid * 512 + tid, NGT = (size_t)G * 512; (void)lane; (void)wave; (void)gw; (void)NGW; (void)gt; (void)NGT
#define WSB() ({ unsigned char* _w = a.ws; asm volatile("" : "+s"(_w)); _w; })
#define INP(i) ({ int _k = (i); asm volatile("" : "+s"(_k)); a.in[_k]; })
    for (int u = threadIdx.x; u < (LDS_PF - LDSCTL_OFF) / 4; u += 512) LW[u] = 0u;
    __syncthreads();
    XcdBarrier bar = xcd_barrier_post((unsigned*)(a.ws + WS_CTL) + CW_BAR, LW + LW_BAR);

    {
        PHASE_IDS(); unsigned char* ws = WSB(); bf16_t* WIN = (bf16_t*)(ws + WS_WIN); bf16_t* WOUT = (bf16_t*)(ws + WS_WOUT); bf16_t* WGU = (bf16_t*)(ws + WS_WGU); bf16_t* WD2 = (bf16_t*)(ws + WS_WD2);
        bf16_t* HB = (bf16_t*)(ws + WS_HB); float* SSQ = (float*)(ws + WS_SSQ);
        LAS float* scr = (LAS float*)(lds + wave * 16384);
        constexpr int I_IN = 16 * 56, I_OUT = 16 * 32, I_GU = 2 * 16 * 256, I_D8 = 16 * 256, I_GLU = 32, I_RG = 24, I_L = I_IN + I_OUT + I_GU + I_D8 + I_GLU + I_RG;
        const float* i_win = INP(2); const float* i_g = INP(1); const float* i_wout = INP(24); const float* i_wg = INP(30); const float* i_wu = INP(31); const float* i_wd = INP(32);
        const float* i_glu = INP(21); const float* i_rg = INP(8); const float* i_ig = INP(10);
#define TR_DECODE(P, it) do { const int l = (it) / I_L; int r = (it) % I_L; P.gk = nullptr; P.fp8 = 0; \
            if (r < I_IN) { const int kb = r / 56, nb = r % 56, j0 = nb * 32; const int sc = j0 < 768 ? j0 : (j0 < 1152 ? j0 + 384 : (j0 < 1536 ? j0 - 384 : j0));     \
                P.src = i_win + (size_t)l * D * INC + (size_t)kb * 64 * INC + sc; P.ldw = INC; P.gk = i_g + (size_t)l * D + kb * 64; P.dst = (unsigned char*)(WIN + (size_t)l * INC * D + (size_t)j0 * D + kb * 64); P.ldo = D * 2; } \
            else if ((r -= I_IN) < I_OUT) { const int kb = r / 32, nb = r % 32; P.src = i_wout + (size_t)l * D * D + (size_t)kb * 64 * D + nb * 32; P.ldw = D; P.dst = (unsigned char*)(WOUT + (size_t)l * D * D + (size_t)nb * 32 * D + kb * 64); P.ldo = D * 2; } \
            else if ((r -= I_OUT) < I_GU) { const int which = r / (16 * 256), e = (r / 256) % 16, q = r % 256, kb = q / 16, nb = q % 16, n0 = nb * 32;     \
                P.src = (which ? i_wu : i_wg) + ((size_t)l * NE + e) * D * DE + (size_t)kb * 64 * DE + n0; P.ldw = DE; P.fp8 = 1; \
                P.dst = (unsigned char*)WGU + ((size_t)l * NE + e) * 1024 * 1024 + (size_t)((n0 / 128) * 256 + which * 128 + (n0 % 128)) * 1024 + kb * 64; P.ldo = 1024; } \
            else if ((r -= I_GU) < I_D8) { const int e = r / 256, q = r % 256, kb = q / 32, nb = q % 32;        \
                P.src = i_wd + ((size_t)l * NE + e) * DE * D + (size_t)kb * 64 * D + nb * 32; P.ldw = D; P.fp8 = 1; P.dst = ws + WS_WD8 + ((size_t)l * NE + e) * 1024 * 512 + (size_t)nb * 32 * 512 + kb * 64; P.ldo = 512; } \
            else if ((r -= I_D8) < I_GLU) { const int kb = r / 8, nb = r % 8; P.src = i_glu + (size_t)l * CW * CW + (size_t)kb * 64 * CW + nb * 32; P.ldw = CW; P.dst = (unsigned char*)((bf16_t*)(ws + WS_WGLU) + (size_t)l * CW * CW + (size_t)nb * 32 * CW + kb * 64); P.ldo = CW * 2; } \
            else { r -= I_GLU; const int gate = r / 12, h = (r / 2) % 6, nb = r & 1; \
                P.src = (gate ? i_ig : i_rg) + ((size_t)l * 6 + h) * 64 * 64 + nb * 32; P.ldw = 64; P.dst = (unsigned char*)((bf16_t*)(ws + WS_WRG) + (((size_t)l * 2 + gate) * 6 + h) * 64 * 64 + (size_t)nb * 32 * 64); P.ldo = 64 * 2; } } while (0)
        { TrP Pa, Pb; float va[32], vb[32]; int it = gw;
          if (it < 2 * I_L) { TR_DECODE(Pa, it); tr_load(Pa, lane, va); }
#pragma unroll 1
          while (it < 2 * I_L) {
              const int it1 = it + NGW; if (it1 < 2 * I_L) { TR_DECODE(Pb, it1); tr_load(Pb, lane, vb); }
              tr_store(Pa, lane, va, scr);
              if (it1 >= 2 * I_L) break;
              const int it2 = it1 + NGW; if (it2 < 2 * I_L) { TR_DECODE(Pa, it2); tr_load(Pa, lane, va); }
              tr_store(Pb, lane, vb, scr);
              it = it2; } }
#undef TR_DECODE
        { const float* s_are = INP(13); const float* s_aim = INP(14); const float* s_ldt = INP(15); const float* s_bre = INP(16); const float* s_bim = INP(17); const float* s_cre = INP(18); const float* s_cim = INP(19); const float* s_d = INP(20);
          for (size_t e = gt; e < (size_t)2 * CG * 256; e += NGT) { const int l = (int)(e / (CG * 256)), g = (int)((e / 256) % CG), c = (int)((e >> 4) & 15), cp = (int)(e & 15);
              s5_kt_pair(g, c, cp, s_are + (size_t)l * CG * CS, s_aim + (size_t)l * CG * CS, s_ldt + (size_t)l * CG, s_bre + (size_t)l * CG * CS * CGD, s_bim + (size_t)l * CG * CS * CGD,
                         s_cre + (size_t)l * CG * CGD * CS, s_cim + (size_t)l * CG * CGD * CS, s_d + (size_t)l * CW, ws + WS_S5 + (size_t)l * S5_L_STRIDE); }
          for (size_t e = gt; e < (size_t)2 * CG * 2048; e += NGT) { const int l = (int)(e / (CG * 2048)), g = (int)((e / 2048) % CG), r = (int)(e & 2047);
              s5_et_task(g, r >> 10, (r >> 4) & 63, r & 15, s_are + (size_t)l * CG * CS, s_aim + (size_t)l * CG * CS, s_ldt + (size_t)l * CG, s_bre + (size_t)l * CG * CS * CGD, s_bim + (size_t)l * CG * CS * CGD, ws + WS_S5 + (size_t)l * S5_L_STRIDE);
              s5_ft_task(g, r >> 7, (r >> 6) & 1, r & 63, s_are + (size_t)l * CG * CS, s_aim + (size_t)l * CG * CS, s_ldt + (size_t)l * CG, s_cre + (size_t)l * CG * CGD * CS, s_cim + (size_t)l * CG * CGD * CS, ws + WS_S5 + (size_t)l * S5_L_STRIDE); }
          for (size_t e = gt; e < (size_t)2 * CG * 64; e += NGT) { const int l = (int)(e / (CG * 64)), g = (int)((e / 64) % CG), el = 4096 + 32768 + (int)(e % 64);
              s5_table_elem(g, el, s_are + (size_t)l * CG * CS, s_aim + (size_t)l * CG * CS, s_ldt + (size_t)l * CG, s_bre + (size_t)l * CG * CS * CGD, s_bim + (size_t)l * CG * CS * CGD,
                            s_cre + (size_t)l * CG * CGD * CS, s_cim + (size_t)l * CG * CGD * CS, s_d + (size_t)l * CW, ws + WS_S5 + (size_t)l * S5_L_STRIDE); } }
        { const float* sw = INP(4); bf16_t* wsp = (bf16_t*)(ws + WS_WSP); for (size_t e = gt; e < (size_t)2 * 6 * 128 * 128; e += NGT) wsp[e] = f2bf(sw[e]); }
        { const float* fg = INP(25); const float* rgw = INP(26); const float* rew = INP(28); bf16_t* wrt = (bf16_t*)(ws + WS_WRT);
          for (size_t e = gt; e < (size_t)2 * 48 * D; e += NGT) { const int l = (int)(e / (48 * D)), n = (int)((e / D) % 48), k = (int)(e % D);
              int j = -1, lo = 0; if (n < 16) j = n; else if (n < 32) { j = n - 16; lo = 1; } else if (n < 36) j = 16 + (n - 32); else if (n < 40) { j = 16 + (n - 36); lo = 1; }
              float v = 0.f;
              if (j >= 0) { const float w = fg[(size_t)l * D + k] * (j < 4 ? rgw[((size_t)l * D + k) * 4 + j] : rew[(((size_t)l * 4 + ((j - 4) >> 2)) * D + k) * 4 + ((j - 4) & 3)]);
                  const float hi = bf2f(f2bf(w)); v = lo ? (w - hi) : w; }
              wrt[e] = f2bf(v); } }
        const float* xin = INP(0);
#pragma unroll 1
        for (int t = gw * 2; t < T; t += NGW * 2) {
            const f32x4* xr = (const f32x4*)(xin + (size_t)t * D) + lane; f32x4 v[2][4]; float s0 = 0.f, s1 = 0.f;
#pragma unroll
            for (int j = 0; j < 4; ++j) { v[0][j] = xr[64 * j]; v[1][j] = xr[256 + 64 * j]; }
#pragma unroll
            for (int j = 0; j < 4; ++j) { s0 += (v[0][j][0] * v[0][j][0] + v[0][j][1] * v[0][j][1]) + (v[0][j][2] * v[0][j][2] + v[0][j][3] * v[0][j][3]); s1 += (v[1][j][0] * v[1][j][0] + v[1][j][1] * v[1][j][1]) + (v[1][j][2] * v[1][j][2] + v[1][j][3] * v[1][j][3]); }
            u32x2* o8 = (u32x2*)(HB + (size_t)t * D) + lane;
#pragma unroll
            for (int j = 0; j < 4; ++j) { u32x2 w; w.x = cvt_pk_bf16(v[0][j][0], v[0][j][1]); w.y = cvt_pk_bf16(v[0][j][2], v[0][j][3]); o8[64 * j] = w; w.x = cvt_pk_bf16(v[1][j][0], v[1][j][1]); w.y = cvt_pk_bf16(v[1][j][2], v[1][j][3]); o8[256 + 64 * j] = w; }
            s0 = wave_sum(s0); s1 = wave_sum(s1);
            if (lane < 32) SSQ[(size_t)t * 16 + lane] = lane == 0 ? s0 : (lane == 16 ? s1 : 0.f);
        }
    }
    xcd_barrier(bar);

    for (int l = 0; l < DEPTH; ++l) {
        { PHASE_IDS(); unsigned char* ws = WSB(); bf16_t* WIN = (bf16_t*)(ws + WS_WIN); bf16_t* HB = (bf16_t*)(ws + WS_HB); float* SSQ = (float*)(ws + WS_SSQ); bf16_t* Z = (bf16_t*)(ws + WS_Z);
          pg8::StaticOrder<T, INC> S; S.init(HB, WIN + (size_t)l * INC * D, G, bid);
          pg8::EpiZ E{Z, SSQ, lds + LDS_PF};
          pg8::gemm_phase<pg8::EpiZ, pg8::StaticOrder<T, INC>, true, true>(lds, wave_s, S, E); }
        xcd_barrier(bar);

        {
            PHASE_IDS(); unsigned char* ws = WSB(); const bf16_t* Z = (const bf16_t*)(ws + WS_Z);
            const float* conv_w = INP(6) + (size_t)l * 4 * BW; const float* conv_b = INP(7) + (size_t)l * BW; const float* rg_b = INP(9) + (size_t)l * BW;
            const float* ig_b = INP(11) + (size_t)l * BW; const float* lam = INP(12) + (size_t)l * BW;
            __syncthreads();
            { const bf16_t* WRG = (const bf16_t*)(ws + WS_WRG) + ((size_t)l * 2 + 0) * 6 * 4096; const bf16_t* WIG = (const bf16_t*)(ws + WS_WRG) + ((size_t)l * 2 + 1) * 6 * 4096;
              for (int pr = bid; pr < NU128 / 2; pr += G) { float cp = 0.f;
                  rglru_unit<1>(2 * pr, true, cp, tid, wave, lane, Z, nullptr, WRG, WIG, conv_w, conv_b, rg_b, ig_b, lam, nullptr, (float*)(ws + WS_SUMA), (float*)(ws + WS_SUMH), (float*)(ws + WS_SUMA2), (float*)(ws + WS_SUMH2), (bf16_t*)(ws + WS_HL), (bf16_t*)(ws + WS_PP), lds);
                  rglru_unit<1>(2 * pr + 1, false, cp, tid, wave, lane, Z, nullptr, WRG, WIG, conv_w, conv_b, rg_b, ig_b, lam, nullptr, (float*)(ws + WS_SUMA), (float*)(ws + WS_SUMH), (float*)(ws + WS_SUMA2), (float*)(ws + WS_SUMH2), (bf16_t*)(ws + WS_HL), (bf16_t*)(ws + WS_PP), lds); } }
            for (int pr = bid; pr < NU128 / 2; pr += G) { const unsigned char* tab = ws + WS_S5 + (size_t)l * S5_L_STRIDE;
                s5_pair1(pr, 2 * wave, wave, lane, Z, (bf16_t*)(ws + WS_Y), tab, (float*)(ws + WS_SEND), (float*)(ws + WS_SEND2), (float*)(ws + WS_SE), lds);
                s5_pair1(pr, 2 * wave + 1, wave, lane, Z, (bf16_t*)(ws + WS_Y), tab, (float*)(ws + WS_SEND), (float*)(ws + WS_SEND2), (float*)(ws + WS_SE), lds); }
            __syncthreads();
            { const bf16_t* WSP = (const bf16_t*)(ws + WS_WSP) + (size_t)l * 6 * 128 * 128; const float* a_sb = INP(5) + (size_t)l * 6 * 128; const float* vg = INP(3) + (size_t)l * AW; const float* mo_ga = INP(23) + (size_t)l * D;
              for (int u = bid; u < NU128; u += G) mixa_unit(u, tid, wave, lane, Z, (bf16_t*)(ws + WS_Y), WSP, a_sb, vg, mo_ga, lds); }
        }
        xcd_barrier(bar);

        {
            PHASE_IDS(); unsigned char* ws = WSB(); const bf16_t* Z = (const bf16_t*)(ws + WS_Z); bf16_t* Y = (bf16_t*)(ws + WS_Y);
            const float* a_v_norm_g = INP(3) + (size_t)l * AW; const float* a_sw = INP(4) + (size_t)l * 6 * 128 * 128; const float* a_sb = INP(5) + (size_t)l * 6 * 128;
        }

        { PHASE_IDS(); unsigned char* ws = WSB(); const bf16_t* Z = (const bf16_t*)(ws + WS_Z); bf16_t* Y = (bf16_t*)(ws + WS_Y);
          { const float* mo_gb = INP(23) + (size_t)l * D + AW;
            __syncthreads();
            for (int pr = bid; pr < NU128 / 2; pr += G) rglru_fix_pair(pr, tid, wave, lane, Z, Y, (const bf16_t*)(ws + WS_HL), (const bf16_t*)(ws + WS_PP), (const float*)(ws + WS_SUMA2), (const float*)(ws + WS_SUMH2), mo_gb, lds); }
          { const bf16_t* WGLU = (const bf16_t*)(ws + WS_WGLU) + (size_t)l * CW * CW; const float* glu_b = INP(22) + (size_t)l * CW; const float* mo_gc = INP(23) + (size_t)l * D + AW + BW;
            for (int pr = bid; pr < NU128 / 2; pr += G) { float k0r = 0.f, k0i = 0.f, k1r = 0.f, k1i = 0.f; const unsigned char* tab = ws + WS_S5 + (size_t)l * S5_L_STRIDE;
#pragma unroll 1
                for (int ui = 0; ui < 2; ++ui) { const int u = 2 * pr + ui; __syncthreads();
                    s5_group<2>(u, 2 * wave, ui == 0, k0r, k0i, wave, lane, Z, Y, tab, (float*)(ws + WS_SEND), (float*)(ws + WS_SEND2), (float*)(ws + WS_SE), lds);
                    s5_group<2>(u, 2 * wave + 1, ui == 0, k1r, k1i, wave, lane, Z, Y, tab, (float*)(ws + WS_SEND), (float*)(ws + WS_SEND2), (float*)(ws + WS_SE), lds);
                    __syncthreads(); s5_glu(u, wave, lane, WGLU, glu_b, mo_gc, Y, lds); } } } }
        asm volatile("s_waitcnt vmcnt(0)" ::: "memory"); __syncthreads();
        if (wave_s0 == 0) { __builtin_amdgcn_fence(__ATOMIC_ACQUIRE, "agent"); asm volatile("s_waitcnt vmcnt(0)" ::: "memory"); }
        __syncthreads();

        { PHASE_IDS(); unsigned char* ws = WSB(); bf16_t* WOUT = (bf16_t*)(ws + WS_WOUT); bf16_t* HB = (bf16_t*)(ws + WS_HB); float* SSQ = (float*)(ws + WS_SSQ); bf16_t* Y = (bf16_t*)(ws + WS_Y);
          pg8::PanelOrder<T, 4> S; S.init(Y, WOUT + (size_t)l * D * D, G, bid);
          pg8::EpiRes<false> E{HB, SSQ, nullptr, lds + LDS_PF};
          pg8::gemm_phase<pg8::EpiRes<false>, pg8::PanelOrder<T, 4>, true, true>(lds, wave_s, S, E); }
        asm volatile("s_waitcnt vmcnt(0)" ::: "memory"); __syncthreads();
        if (wave_s0 == 0) { __builtin_amdgcn_fence(__ATOMIC_ACQUIRE, "agent"); asm volatile("s_waitcnt vmcnt(0)" ::: "memory"); }
        __syncthreads();

        { PHASE_IDS(); unsigned char* ws = WSB(); const bf16_t* HB = (const bf16_t*)(ws + WS_HB); const float* SSQ = (const float*)(ws + WS_SSQ); int* CLS = (int*)(ws + WS_CLS); float* G2 = (float*)(ws + WS_G2); int* HIST = (int*)(ws + WS_HIST);
          const float* rgb = INP(27) + (size_t)l * 4; const float* reb = INP(29) + (size_t)l * 16;
        if (l == 0) {
            for (int rr = gw; rr < 2 * NCLS * 2 * 1024 / 2; rr += NGW) { const int row = 2 * rr + (lane >> 5), n = row & 1023, half = (row >> 10) & 1, cls = (row >> 11) % NCLS, ll = row / (2048 * NCLS);
                const int g = cls / 6, pi = cls % 6, e = g * 4 + (half ? pair_hi(pi) : pair_lo(pi));
                const u32x4 v = *(const u32x4*)(ws + WS_WD8 + ((size_t)ll * NE + e) * 1024 * 512 + (size_t)n * 512 + (lane & 31) * 16);
                *(u32x4*)(ws + WS_WD2 + ((size_t)ll * NCLS + cls) * 1024 * 1024 + (size_t)n * 1024 + half * 512 + (lane & 31) * 16) = v; } }
        for (int u = bid; u < NU; u += G) {
            router_unit(u, wave, lane, HB, SSQ, (const bf16_t*)(ws + WS_WRT) + (size_t)l * 48 * D, rgb, reb, CLS, G2, lds, (LAS int*)(lds + LDSCTL_OFF) + LW_HIST);
            __syncthreads();
            if (tid < 32) { HIST[u * 32 + tid] = tid < NCLS ? LWI[LW_HIST + tid] : 0; LWI[LW_HIST + tid] = 0; }
            __syncthreads();
        } }
        xcd_barrier(bar);

        { PHASE_IDS(); unsigned char* ws = WSB(); const bf16_t* HB = (const bf16_t*)(ws + WS_HB); const float* SSQ = (const float*)(ws + WS_SSQ); const int* CLS = (const int*)(ws + WS_CLS); const float* G2 = (const float*)(ws + WS_G2); const int* HIST = (const int*)(ws + WS_HIST);
          int* CTOT = (int*)(ws + WS_CTOT); int* ROWTOK = (int*)(ws + WS_ROWTOK); float* ROWG = (float*)(ws + WS_ROWG); bf16_t* HBS = (bf16_t*)(ws + WS_HBS); const float* ffn_g = INP(25) + (size_t)l * D;
        for (int u = bid; u < NU; u += G) {
            { const int c = tid & 31, part = tid >> 5; int tot = 0, pre = 0;
_Pragma("unroll 16")
              for (int k = part * 16; k < part * 16 + 16; ++k) { const int v = HIST[k * 32 + c]; tot += v; pre += k < u ? v : 0; }
              ((volatile LAS int*)lds)[tid] = tot; ((volatile LAS int*)lds)[512 + tid] = pre; }
            __syncthreads();
            if (tid < NCLS) { int tot = 0, pre = 0;
_Pragma("unroll")
                for (int k = 0; k < 16; ++k) { tot += ((volatile LAS int*)lds)[k * 32 + tid]; pre += ((volatile LAS int*)lds)[512 + k * 32 + tid]; } LWI[LW_TOT + tid] = tot; LWI[LW_BASE + tid] = pre; }
            __syncthreads();
            if (tid == 0) { int ps = 0;
_Pragma("unroll 1")
                for (int c = 0; c < NCLS; ++c) { const int tot = LWI[LW_TOT + c]; LWI[LW_BASE + c] += ps; LWI[LW_TST + c] = ps; ps += ((tot + 255) >> 8) << 8; if (bid == 0) CTOT[c] = tot; } LWI[LW_TST + NCLS] = ps; }
            int mycls = 0, rank = 0;
            if (tid < UT) { mycls = CLS[u * UT + tid];
_Pragma("unroll 4")
                for (int c = 0; c < NCLS; ++c) { const unsigned long long m = __ballot(mycls == c); const int below = __builtin_amdgcn_mbcnt_hi((unsigned)(m >> 32), __builtin_amdgcn_mbcnt_lo((unsigned)m, 0u));
                    if (mycls == c) rank = below; if (lane == 0) ((volatile LAS int*)lds)[1024 + wave * 32 + c] = __popcll(m); } }
            __syncthreads();
            if (tid < UT) { const int cls = mycls;
                for (int w = 0; w < wave; ++w) rank += ((volatile LAS int*)lds)[1024 + w * 32 + cls];
                const int dest = LWI[LW_BASE + cls] + rank; LWI[LW_DEST + tid] = dest; const int t = u * UT + tid;
                ROWTOK[dest] = t; ROWG[(size_t)dest * 2 + 0] = G2[(size_t)t * 2 + 0]; ROWG[(size_t)dest * 2 + 1] = G2[(size_t)t * 2 + 1]; }
            __syncthreads();
            { f32x4 gq[4];
#pragma unroll
              for (int j = 0; j < 4; ++j) gq[j] = *(const f32x4*)(ffn_g + (j >> 1) * 512 + lane * 8 + 4 * (j & 1));
#pragma unroll 1
              for (int i = 0; i < 32; i += 4) {
                  const int tl0 = wave * 32 + i, t0r = u * UT + tl0;
                  float sq = SSQ[(size_t)t0r * 16 + lane]; sq += x_xor1(sq); sq += x_xor2(sq); sq += x_hmir(sq); sq += x_mir(sq);
                  u32x4 o[4][2]; int dst[4];
#pragma unroll
                  for (int j = 0; j < 4; ++j) { o[j][0] = *(const u32x4*)(HB + (size_t)(t0r + j) * D + lane * 8); o[j][1] = *(const u32x4*)(HB + (size_t)(t0r + j) * D + 512 + lane * 8); dst[j] = LWI[LW_DEST + tl0 + j]; }
#pragma unroll
                  for (int j = 0; j < 4; ++j) { const float r4 = rsqrtf(__builtin_amdgcn_readlane(sq, 16 * j) * (1.0f / D) + EPS) * pg8::FS_H; u32x4 w;
#pragma unroll
                      for (int hh = 0; hh < 2; ++hh) { const u32x4 oo = o[j][hh]; const f32x4 g0 = gq[2 * hh], g1 = gq[2 * hh + 1];
                          const unsigned lo = pk_fp8x4(__uint_as_float(oo.x << 16) * r4 * g0[0], __uint_as_float(oo.x & 0xffff0000u) * r4 * g0[1], __uint_as_float(oo.y << 16) * r4 * g0[2], __uint_as_float(oo.y & 0xffff0000u) * r4 * g0[3]);
                          const unsigned hi = pk_fp8x4(__uint_as_float(oo.z << 16) * r4 * g1[0], __uint_as_float(oo.z & 0xffff0000u) * r4 * g1[1], __uint_as_float(oo.w << 16) * r4 * g1[2], __uint_as_float(oo.w & 0xffff0000u) * r4 * g1[3]);
                          if (hh == 0) { w.x = lo; w.y = hi; } else { w.z = lo; w.w = hi; } }
                      *(u32x2*)((unsigned char*)HBS + (size_t)dst[j] * D + lane * 8) = (u32x2){w.x, w.y}; *(u32x2*)((unsigned char*)HBS + (size_t)dst[j] * D + 512 + lane * 8) = (u32x2){w.z, w.w}; } } }
            if (u == bid)
_Pragma("unroll 1")
            for (int c = bid; c < NCLS; c += G) { const int tot = LWI[LW_TOT + c], r0 = LWI[LW_TST + c] + tot, r1 = LWI[LW_TST + c + 1];
                unsigned zz = 0u; asm volatile("" : "+v"(zz));
                for (int r = r0 + wave; r < r1; r += 8) { if (lane == 0) { ROWTOK[r] = -1; ROWG[(size_t)r * 2] = __uint_as_float(zz); ROWG[(size_t)r * 2 + 1] = __uint_as_float(zz); }
                    *(u32x4*)((unsigned char*)HBS + (size_t)r * D + lane * 16) = (u32x4){zz, zz, zz, zz}; } }
            __syncthreads();
        } }
        xcd_barrier(bar);

        { PHASE_IDS(); unsigned char* ws = WSB(); const int* CTOT = (const int*)(ws + WS_CTOT); bf16_t* HBS = (bf16_t*)(ws + WS_HBS); bf16_t* WGU = (bf16_t*)(ws + WS_WGU); bf16_t* ACT = (bf16_t*)(ws + WS_ACT); const float* ROWG = (const float*)(ws + WS_ROWG);
        if (wave == 0) {
            const int vt = lane < NCLS ? (CTOT[lane] + 255) >> 8 : 0; int tst = 0, ntile = 0;
_Pragma("unroll")
            for (int k = 0; k < NCLS; ++k) { const int vk = __builtin_amdgcn_readlane(vt, k); tst += (k < lane) ? vk : 0; ntile += vk; }
            if (lane <= NCLS) LWI[LW_TST + lane] = tst;
            if (lane < 32) { const long L = (long)lane * G + bid; int e = -1;
            int mtu = -1, pnu = 0, mtd = -1, pnd = 0;
            if (L < (long)ntile * 8) { const int nwg = ntile * 8, qq = nwg / 8, rr = nwg % 8, xcd = (int)(L % 8), off = (int)(L / 8); const int Lr = (xcd < rr ? xcd * (qq + 1) : rr * (qq + 1) + (xcd - rr) * qq) + off; mtu = Lr / 8; pnu = Lr % 8; }
            if (L < (long)ntile * 4) { const int nwg = ntile * 4, qq = nwg / 8, rr = nwg % 8, xcd = (int)(L % 8), off = (int)(L / 8); const int Lr = (xcd < rr ? xcd * (qq + 1) : rr * (qq + 1) + (xcd - rr) * qq) + off; mtd = Lr / 4; pnd = Lr % 4; }
            int clsu = 0, clsd = 0;
_Pragma("unroll")
            for (int k = 1; k < NCLS; ++k) { const int sk = __builtin_amdgcn_readlane(tst, k); clsu += (sk <= mtu) ? 1 : 0; clsd += (sk <= mtd) ? 1 : 0; }
            e = mtu >= 0 ? ((clsu << 24) | (pnu << 16) | mtu) : -1; LWI[LW_UTAB + lane] = e;
            e = mtd >= 0 ? ((clsd << 24) | (pnd << 16) | mtd) : -1; LWI[LW_DTAB + lane] = e; } }
        __syncthreads();
        { pg8::MoeOrder<8, true, 1024> S{LWI + LW_UTAB, l, (const char*)HBS, (const char*)WGU};
          pg8::EpiUp E{(unsigned char*)ACT, ROWG, lds + LDS_PF};
          pg8::gemm_phase<pg8::EpiUp, pg8::MoeOrder<8, true, 1024>, true, true, 512, true>(lds, wave_s, S, E); } }
        xcd_barrier(bar);

        { PHASE_IDS(); unsigned char* ws = WSB(); bf16_t* ACT = (bf16_t*)(ws + WS_ACT); bf16_t* WD2 = (bf16_t*)(ws + WS_WD2); bf16_t* HB = (bf16_t*)(ws + WS_HB); float* SSQ = (float*)(ws + WS_SSQ); const int* ROWTOK = (const int*)(ws + WS_ROWTOK);
          pg8::MoeOrder<4, false, 1024> S{LWI + LW_DTAB, l, (const char*)ACT, (const char*)WD2};
          pg8::EpiRes<true> E{HB, SSQ, ROWTOK, lds + LDS_PF};
          pg8::gemm_phase<pg8::EpiRes<true>, pg8::MoeOrder<4, false, 1024>, true, true, 512, true>(lds, wave_s, S, E); }
        xcd_barrier(bar);
    }

    { PHASE_IDS(); unsigned char* ws = WSB(); const bf16_t* HB = (const bf16_t*)(ws + WS_HB); const float* SSQ = (const float*)(ws + WS_SSQ); const float* fg = INP(33); float* outp = a.out;
    { f32x4 gq[4];
#pragma unroll
      for (int q = 0; q < 4; ++q) gq[q] = *(const f32x4*)(fg + 256 * q + 4 * lane);
#pragma unroll 1
      for (int t0r = gw * 4; t0r < T; t0r += NGW * 4) {
          float sq = SSQ[(size_t)t0r * 16 + lane]; sq += x_xor1(sq); sq += x_xor2(sq); sq += x_hmir(sq); sq += x_mir(sq);
          u32x2 o[4][4];
#pragma unroll
          for (int j = 0; j < 4; ++j)
#pragma unroll
              for (int q = 0; q < 4; ++q) o[j][q] = *(const u32x2*)(HB + (size_t)(t0r + j) * D + 256 * q + 4 * lane);
#pragma unroll
          for (int j = 0; j < 4; ++j) { const float r = rsqrtf(__builtin_amdgcn_readlane(sq, 16 * j) * (1.0f / D) + EPS); float* orow = outp + (size_t)(t0r + j) * D + 4 * lane;
#pragma unroll
              for (int q = 0; q < 4; ++q) { const u32x2 oo = o[j][q]; const f32x4 g0 = gq[q]; f32x4 w0;
                  w0[0] = __uint_as_float(oo.x << 16) * r * g0[0]; w0[1] = __uint_as_float(oo.x & 0xffff0000u) * r * g0[1]; w0[2] = __uint_as_float(oo.y << 16) * r * g0[2]; w0[3] = __uint_as_float(oo.y & 0xffff0000u) * r * g0[3];
                  *(f32x4*)(orow + 256 * q) = w0; } } } }
}
}

extern "C" void kernel_launch(void* const* d_in, const int* in_sizes, int n_in, void* d_out, int out_size, void* d_ws, size_t ws_size, hipStream_t stream) {
    static int grid = 0;
    if (grid == 0) {
        if (n_in != 34 || in_sizes[0] != T * D || out_size != T * D || ws_size < WS_END) { fprintf(stderr, "kernel_launch: unexpected shapes (n_in %d, ws %zu)\n", n_in, ws_size); grid = -1; return; }
        int dev = 0, cus = 0, per_cu = 0;
        if (hipGetDevice(&dev) != hipSuccess || hipDeviceGetAttribute(&cus, hipDeviceAttributeMultiprocessorCount, dev) != hipSuccess) { grid = -1; return; }
        if (hipFuncSetAttribute((const void*)mega_fwd, hipFuncAttributeMaxDynamicSharedMemorySize, LDS_BYTES) != hipSuccess) { fprintf(stderr, "kernel_launch: hipFuncSetAttribute failed\n"); grid = -1; return; }
        if (hipOccupancyMaxActiveBlocksPerMultiprocessor(&per_cu, (const void*)mega_fwd, 512, LDS_BYTES) != hipSuccess || per_cu < 1) { fprintf(stderr, "kernel_launch: occupancy query says %d\n", per_cu); }
        (void)hipGetLastError();
        grid = cus;
    }
    if (grid < 0) return;
    (void)hipMemsetAsync((char*)d_ws + WS_CTL, 0, CTL_ZERO_BYTES, stream);
    Args a{};
    for (int i = 0; i < 34; ++i) a.in[i] = (const float*)d_in[i];
    a.out = (float*)d_out; a.ws = (unsigned char*)d_ws;
    hipLaunchKernelGGL(mega_fwd, dim3(grid), dim3(512), LDS_BYTES, stream, a);
}
```

```cpp
#include <hip/hip_runtime.h>
#include <cstdio>
#include <cstdint>

#define LAS __attribute__((address_space(3)))
typedef unsigned short bf16_t;
typedef short bf16x8 __attribute__((ext_vector_type(8)));
typedef float f32x4 __attribute__((ext_vector_type(4)));
typedef float f32x2 __attribute__((ext_vector_type(2)));
typedef unsigned u32x4 __attribute__((ext_vector_type(4)));
typedef unsigned u32x2 __attribute__((ext_vector_type(2)));
typedef int i32x4 __attribute__((ext_vector_type(4)));
typedef int i32x8 __attribute__((ext_vector_type(8)));

constexpr int D = 1024, BATCH = 8, SEQ = 8192, T = BATCH * SEQ, DEPTH = 2;
constexpr int AW = 384, BW = 384, CW = 256, HD = 64, ABLK = 128, CHUNK = 64;
constexpr int INC = 1792;
constexpr int ZU = 0, ZV = 384, ZG = 768, ZX = 1152, ZC = 1536, ZGELU_END = 1152;
constexpr int CG = 16, CGD = 16, CS = 64;
constexpr int NE = 16, DE = 512, NCLS = 24;
constexpr float EPS = 1e-6f;
constexpr int UT = 256;
constexpr int NU = T / UT;
constexpr int MAXROWS = T + NCLS * 256;

constexpr size_t MiB = 1u << 20;
constexpr size_t WS_CTL = 0, CTL_ZERO_BYTES = 1 * MiB;
constexpr size_t WS_WIN = 2 * MiB;
constexpr size_t WS_WOUT = 10 * MiB;
constexpr size_t WS_WGLU = 14 * MiB;
constexpr size_t WS_WRG = 15 * MiB;
constexpr size_t WS_WSP = 15 * MiB + 256 * 1024;
constexpr size_t WS_WRT = 15 * MiB + 768 * 1024;
constexpr size_t WS_WGU = 16 * MiB;
constexpr size_t WS_WD8 = 48 * MiB;
constexpr size_t WS_WD2 = 80 * MiB;
constexpr size_t WS_SSQ = 176 * MiB;
constexpr size_t WS_RS = 180 * MiB;
constexpr size_t WS_CLS = WS_RS + 256 * 1024;
constexpr size_t WS_G2 = WS_CLS + 256 * 1024;
constexpr size_t WS_HIST = 181 * MiB;
constexpr size_t WS_CTOT = WS_HIST + 64 * 1024;
constexpr size_t WS_ROWTOK = WS_HIST + 256 * 1024;
constexpr size_t WS_ROWG = 182 * MiB;
constexpr size_t WS_SUMA = 183 * MiB;
constexpr size_t WS_SUMH = 191 * MiB;
constexpr size_t WS_S5 = 184 * MiB;
constexpr size_t WS_SEND = 187 * MiB;
constexpr size_t WS_HB = 192 * MiB;
constexpr size_t WS_Z = 320 * MiB;
constexpr size_t WS_HBS = WS_Z;
constexpr size_t WS_Y = 544 * MiB;
constexpr size_t WS_ACT = 672 * MiB;
constexpr size_t WS_HL = 672 * MiB;
constexpr size_t WS_PP = 736 * MiB;
constexpr size_t WS_SE = 800 * MiB;
constexpr size_t WS_AV = 672 * MiB;
constexpr size_t WS_BV = 768 * MiB;
constexpr size_t WS_SEND2 = 864 * MiB;
constexpr size_t WS_SUMA2 = 866 * MiB;
constexpr size_t WS_SUMH2 = 867 * MiB;
constexpr size_t WS_END = 868 * MiB;
constexpr int CW_BAR = 4096;

constexpr int RING_BYTES = 131072;
constexpr int LDSCTL_OFF = 143360;
constexpr int LDS_PF = 147456;
constexpr int LDS_BYTES = 163840;
constexpr int LW_BAR = 8, LW_TST = 64, LW_HIST = 96, LW_TOT = 128, LW_BASE = 160, LW_CLS = 256  , LW_DEST = 512  , LW_UTAB = 768  , LW_DTAB = 800  ;

__device__ __forceinline__ float bf2f(bf16_t v) { return __uint_as_float(((unsigned)v) << 16); }
__device__ __forceinline__ unsigned cvt_pk_bf16(float lo, float hi) { unsigned r; asm volatile("v_cvt_pk_bf16_f32 %0, %1, %2" : "=v"(r) : "v"(lo), "v"(hi)); return r; }
__device__ __forceinline__ bf16_t f2bf(float v) { return (bf16_t)(cvt_pk_bf16(v, 0.f) & 0xffffu); }
__device__ __forceinline__ unsigned pk_fp8x4(float a, float b, float c, float d) {
    a = fminf(fmaxf(a, -448.f), 448.f); b = fminf(fmaxf(b, -448.f), 448.f); c = fminf(fmaxf(c, -448.f), 448.f); d = fminf(fmaxf(d, -448.f), 448.f);
    int r = __builtin_amdgcn_cvt_pk_fp8_f32(a, b, 0, false); r = __builtin_amdgcn_cvt_pk_fp8_f32(c, d, r, true); return (unsigned)r; }
__device__ __forceinline__ int fresh_lane() { unsigned z = 0u; asm volatile("" : "+s"(z)); return (int)__builtin_amdgcn_mbcnt_hi(~0u, __builtin_amdgcn_mbcnt_lo(~0u, z)); }
__device__ __forceinline__ float x_xor1(float v) { return __int_as_float(__builtin_amdgcn_update_dpp(0, __float_as_int(v), 0xB1, 0xf, 0xf, true)); }
__device__ __forceinline__ float x_xor2(float v) { return __int_as_float(__builtin_amdgcn_update_dpp(0, __float_as_int(v), 0x4E, 0xf, 0xf, true)); }
__device__ __forceinline__ float x_hmir(float v) { return __int_as_float(__builtin_amdgcn_update_dpp(0, __float_as_int(v), 0x141, 0xf, 0xf, true)); }
__device__ __forceinline__ float x_mir(float v) { return __int_as_float(__builtin_amdgcn_update_dpp(0, __float_as_int(v), 0x140, 0xf, 0xf, true)); }
__device__ __forceinline__ float x_xor16(float v) { return __int_as_float(__builtin_amdgcn_ds_swizzle(__float_as_int(v), 0x401F)); }
__device__ __forceinline__ float add_xor32(float v) { const auto r = __builtin_amdgcn_permlane32_swap(__float_as_uint(v), __float_as_uint(v), false, false); return __uint_as_float(r[0]) + __uint_as_float(r[1]); }
__device__ __forceinline__ float add_x16_x32(float v) { v += x_xor16(v); return add_xor32(v); }
__device__ __forceinline__ float wave_sum(float v) { v += x_xor1(v); v += x_xor2(v); v += x_hmir(v); v += x_mir(v); v += x_xor16(v); return add_xor32(v); }
__device__ __forceinline__ float gelu_fast(float x) {
    const float u2 = 1.5957691216057308f * (x + 0.044715f * x * x * x);
    const float e = __builtin_amdgcn_exp2f(-1.4426950408889634f * u2);
    return x * __builtin_amdgcn_rcpf(1.0f + e);
}
__device__ __forceinline__ float sigmoid_fast(float x) { return __builtin_amdgcn_rcpf(1.0f + __builtin_amdgcn_exp2f(-1.4426950408889634f * x)); }
__device__ __forceinline__ float sigmoid_f(float x) { return 1.0f / (1.0f + expf(-x)); }
__device__ __forceinline__ int pair_lo(int pi) { return pi < 3 ? 0 : (pi < 5 ? 1 : 2); }
__device__ __forceinline__ int pair_hi(int pi) { return pi < 3 ? pi + 1 : (pi < 5 ? pi - 1 : 3); }
__device__ __forceinline__ int pair_idx(int lo, int hi) { return lo == 0 ? hi - 1 : (lo == 1 ? hi + 1 : 5); }

#define XB_TMO      128
#define XB_XCNT(j)  (256  + 64 * (j))
#define XB_XSUB(j)  (1280 + 64 * (j))
#define XB_XGEN(j)  (2304 + 64 * (j))
#define XB_TOP      3328
#define XB_TOPGEN   3392
#define XCD_BAR_WORDS 3456
#define XB_SPIN_CAP (1u << 18)
__device__ __forceinline__ unsigned xb_ld(unsigned* p)              { return __hip_atomic_load(p, __ATOMIC_RELAXED, __HIP_MEMORY_SCOPE_AGENT); }
__device__ __forceinline__ unsigned xb_add(unsigned* p, unsigned v) { return __hip_atomic_fetch_add(p, v, __ATOMIC_RELAXED, __HIP_MEMORY_SCOPE_AGENT); }
__device__ __forceinline__ unsigned xb_xcc_id() { return (unsigned)__builtin_amdgcn_s_getreg((3 << 11) | 20) & 0xFu; }
#define XB_SPIN(cond, bar) do { unsigned _sp = 0; while (cond) { __builtin_amdgcn_s_sleep(1); \
    if ((++_sp & 255u) == 0u) { if (xb_ld(&(bar)[XB_TMO])) break; if (_sp > XB_SPIN_CAP) { atomicAdd(&(bar)[XB_TMO], 1u); break; } } } } while (0)
struct XcdBarrier { unsigned* bar; unsigned x; volatile LAS unsigned* st; };
__device__ __forceinline__ XcdBarrier xcd_barrier_post(unsigned* bar, volatile LAS unsigned* st) {
    XcdBarrier b; b.bar = bar; b.x = xb_xcc_id(); b.st = st;
    if (threadIdx.x == 0) (void)xb_add(&bar[XB_XCNT(b.x)], 1u);
    return b;
}
__device__ __forceinline__ void xcd_barrier_complete(unsigned* bar, unsigned x, unsigned& nloc, unsigned& nx) {
    const unsigned G = gridDim.x * gridDim.y * gridDim.z;
    unsigned sum, cnt, mine, sp = 0u;
    for (;;) {
        sum = 0u; cnt = 0u; mine = 0u;
#pragma unroll
        for (unsigned j = 0; j < 16; ++j) { const unsigned c = xb_ld(&bar[XB_XCNT(j)]); sum += c; cnt += (c > 0u) ? 1u : 0u; mine = (j == x) ? c : mine; }
        if (sum == G) break;
        __builtin_amdgcn_s_sleep(1);
        if ((++sp & 255u) == 0u) { if (xb_ld(&bar[XB_TMO])) break; if (sp > XB_SPIN_CAP) { atomicAdd(&bar[XB_TMO], 1u); break; } }
    }
    nloc = mine > 0u ? mine : 1u; nx = cnt > 0u ? cnt : 1u;
}
__device__ __forceinline__ void xcd_barrier(const XcdBarrier& b) {
    asm volatile("s_waitcnt vmcnt(0)" ::: "memory");
    __syncthreads();
    if (threadIdx.x == 0) {
        unsigned* bar = b.bar; asm volatile("" : "+s"(bar));
        __builtin_amdgcn_s_waitcnt(0);
        unsigned bx0 = b.x; asm volatile("" : "+s"(bx0));
        unsigned nloc = b.st[0], nx = b.st[1];
        if (nloc == 0u) { xcd_barrier_complete(bar, bx0, nloc, nx); b.st[0] = nloc; b.st[1] = nx; }
        unsigned bx = b.x; asm volatile("" : "+s"(bx));
        const unsigned old = xb_add(&bar[XB_XSUB(bx)], 1u);
        const unsigned gen = old / nloc;
        if (old + 1u == (gen + 1u) * nloc) {
            __builtin_amdgcn_fence(__ATOMIC_RELEASE, "agent");
            asm volatile("s_waitcnt vmcnt(0)" ::: "memory");
            const unsigned og = xb_add(&bar[XB_TOP], 1u);
            const unsigned tg = og / nx;
            if (og + 1u == (tg + 1u) * nx) xb_add(&bar[XB_TOPGEN], 1u);
            else XB_SPIN(xb_ld(&bar[XB_TOPGEN]) == tg, bar);
            __builtin_amdgcn_fence(__ATOMIC_ACQUIRE, "agent");
            xb_add(&bar[XB_XGEN(bx)], 1u);
            asm volatile("s_waitcnt vmcnt(0)" ::: "memory");
        } else {
            XB_SPIN(xb_ld(&bar[XB_XGEN(bx)]) == gen, bar);
            __builtin_amdgcn_fence(__ATOMIC_ACQUIRE, "agent");
            asm volatile("s_waitcnt vmcnt(0)" ::: "memory");
        }
    }
    __syncthreads();
}

namespace pg8 {
#define PG8_LAS __attribute__((address_space(3)))
constexpr int BM = 256, BK = 64, HALF = 128, HTB = HALF * BK * 2, STAGE_BYTES = 8 * HTB, NXCD = 8, WGM = 4;
__host__ __device__ __forceinline__ int lds_byte(int r, int c) { const int st = (r >> 4) * 2 + (c >> 5), rr = r & 15, cc = c & 31, ob = rr * 64 + cc * 2; return st * 1024 + (ob ^ (((ob >> 9) & 1) << 5)); }
__host__ __device__ __forceinline__ void stage_rc(int b, int& R, int& C) { const int st = b / 1024, sb = b % 1024, swz = sb ^ (((sb >> 9) & 1) << 5); R = (st >> 1) * 16 + swz / 64; C = (st & 1) * 32 + (swz % 64) / 2; }
__host__ __device__ __forceinline__ int perm32(int rho) { const int n = rho >> 4, i = rho & 15; return 8 * (i >> 2) + 4 * n + (i & 3); }
struct Unit { int pm, pn; const char* A; const char* B; };

template <int M_, int NN> struct PanelOrder {
    static constexpr int nM = M_ / BM; static constexpr size_t tstep = (size_t)BM * 1024 * 2;
    int G, c; const char* A; const char* Bt;
    __device__ void init(const void* A_, const void* Bt_, int G_, int c_) { G = G_; c = c_; A = (const char*)A_; Bt = (const char*)Bt_; }
    __device__ bool next(int i, Unit& u) const { const int pm = c + (i / NN) * G; if (pm >= nM) return false; u.pm = pm; u.pn = i % NN; u.A = A + (size_t)pm * tstep; u.B = Bt + (size_t)u.pn * tstep; return true; }
    __device__ __forceinline__ void a_ready(const Unit&) const {}
    __device__ __forceinline__ void done(const Unit&) const {}
};
template <int M_, int N_> struct StaticOrder {
    static constexpr int nM = M_ / BM, nN = N_ / BM, nwg = nM * nN; static constexpr size_t tstep = (size_t)BM * 1024 * 2;
    int G, c; const char* A; const char* Bt;
    __device__ void init(const void* A_, const void* Bt_, int G_, int c_) { G = G_; c = c_; A = (const char*)A_; Bt = (const char*)Bt_; }
    __device__ bool next(int i, Unit& u) const {
        const long L = (long)i * G + c; if (L >= nwg) return false;
        int wgid = (int)L; { constexpr int q = nwg / NXCD, r = nwg % NXCD; const int xcd = wgid % NXCD, off = wgid / NXCD; wgid = (xcd < r ? xcd * (q + 1) : r * (q + 1) + (xcd - r) * q) + off; }
        constexpr int nig = WGM * nN; const int gid = wgid / nig, fm = gid * WGM, gsz = (nM - fm) < WGM ? (nM - fm) : WGM;
        u.pm = fm + ((wgid % nig) % gsz); u.pn = (wgid % nig) / gsz; u.A = A + (size_t)u.pm * tstep; u.B = Bt + (size_t)u.pn * tstep; return true;
    }
    __device__ __forceinline__ void a_ready(const Unit&) const {}
    __device__ __forceinline__ void done(const Unit&) const {}
};
template <class Epi, class Sched, bool ALIGN_EPI = false, bool SP2 = false, int KB = 1024, bool FP8 = false>
__device__ __forceinline__ void gemm_phase(PG8_LAS unsigned char* lds, const int wave_s, const Sched& S, const Epi& E) { const int Kdim = 0;
    const int lane = fresh_lane(), wid = wave_s, tid = wid * 64 + lane, wr = wid >> 2, wc = wid & 3, fr = lane & 15, fq = lane >> 4;
    constexpr int K = KB, nt = K / BK; (void)Kdim;
    unsigned voffA, voffB;
    { int R, C; stage_rc(tid * 16, R, C); const int Rb = Epi::PERM ? ((R & ~31) + perm32(R & 31)) : R; voffA = (unsigned)(R * K + C) * 2u; voffB = (unsigned)(Rb * K + C) * 2u; }
    constexpr size_t kstep = (size_t)(BK * 2);
    constexpr size_t hstep = (size_t)HALF * K * 2;
    constexpr size_t tstep = 2 * hstep; (void)tstep;
    const unsigned ldsw = (unsigned)wid * 1024u; const unsigned ldsb = (unsigned)(size_t)lds + ldsw;
    const int aoff = lds_byte(wr * 64 + fr, fq * 8), boff = lds_byte(wc * 32 + fr, fq * 8);
#define PG8_SA(b, h) (((b) * 2 + (h)) * HTB)
#define PG8_SB(b, h) ((4 + (b) * 2 + (h)) * HTB)
#define PG8_STAGE(bufoff, gbase, voff) do { _Pragma("unroll") for (int _i = 0; _i < 2; ++_i) { unsigned _keep; \
        asm volatile("s_mov_b32 %0, m0\n\ts_mov_b32 m0, %3\n\ts_nop 0\n\tglobal_load_lds_dwordx4 %1, %2\n\ts_mov_b32 m0, %0" : "=&s"(_keep) \
            : "v"(voff), "s"((const char*)(gbase) + (size_t)_i * (64 * K * 2)), "s"(ldsb + (unsigned)((bufoff) + _i * 8192)) : "memory"); } } while (0)
#define PG8_LDA(dst, b, h) do { if constexpr (FP8) { _Pragma("unroll") for (int m = 0; m < 4; ++m) { const i32x4 _lo = *(const PG8_LAS i32x4*)(lds + PG8_SA(b, h) + aoff + m * 2048), _hi = *(const PG8_LAS i32x4*)(lds + PG8_SA(b, h) + aoff + m * 2048 + 1024); \
            dst##8[m] = __builtin_shufflevector(_lo, _hi, 0, 1, 2, 3, 4, 5, 6, 7); } } \
        else { _Pragma("unroll") for (int m = 0; m < 4; ++m) _Pragma("unroll") for (int k = 0; k < 2; ++k) dst[m][k] = *(const PG8_LAS bf16x8*)(lds + PG8_SA(b, h) + aoff + m * 2048 + k * 1024); } } while (0)
#define PG8_LDB(dst, b, h) do { if constexpr (FP8) { _Pragma("unroll") for (int n = 0; n < 2; ++n) { const i32x4 _lo = *(const PG8_LAS i32x4*)(lds + PG8_SB(b, h) + boff + n * 2048), _hi = *(const PG8_LAS i32x4*)(lds + PG8_SB(b, h) + boff + n * 2048 + 1024); \
            dst##8[n] = __builtin_shufflevector(_lo, _hi, 0, 1, 2, 3, 4, 5, 6, 7); } } \
        else { _Pragma("unroll") for (int n = 0; n < 2; ++n) _Pragma("unroll") for (int k = 0; k < 2; ++k) dst[n][k] = *(const PG8_LAS bf16x8*)(lds + PG8_SB(b, h) + boff + n * 2048 + k * 1024); } } while (0)
#define PG8_MMA(ai, bj, At, Bt) do { __builtin_amdgcn_s_setprio(1); \
        if constexpr (FP8) { _Pragma("unroll") for (int m = 0; m < 4; ++m) _Pragma("unroll") for (int n = 0; n < 2; ++n) \
            acc[ai][bj][m][n] = __builtin_amdgcn_mfma_scale_f32_16x16x128_f8f6f4(Bt##8[n], At##8[m], acc[ai][bj][m][n], 0, 0, 0, Epi::SCALE_W, 0, Epi::SCALE_A); } \
        else { _Pragma("unroll") for (int m = 0; m < 4; ++m) _Pragma("unroll") for (int n = 0; n < 2; ++n) _Pragma("unroll") for (int k = 0; k < 2; ++k) \
            acc[ai][bj][m][n] = __builtin_amdgcn_mfma_f32_16x16x32_bf16(Bt[n][k], At[m][k], acc[ai][bj][m][n], 0, 0, 0); } \
        __builtin_amdgcn_s_setprio(0); } while (0)
#define PG8_WAIT_V(n) asm volatile("s_waitcnt vmcnt(" #n ")" ::: "memory")
#define PG8_WAIT_L(n) asm volatile("s_waitcnt lgkmcnt(" #n ")" ::: "memory")
#define PG8_BAR __builtin_amdgcn_s_barrier()
#define PG8_SCHED __builtin_amdgcn_sched_barrier(0)
    Unit cur, nxt; int ui = 0;
    if (!S.next(0, cur)) return;
    f32x4 acc[2][2][4][2];
#pragma unroll
    for (int a = 0; a < 2; ++a)
#pragma unroll
        for (int b = 0; b < 2; ++b)
#pragma unroll
            for (int m = 0; m < 4; ++m)
#pragma unroll
                for (int n = 0; n < 2; ++n) acc[a][b][m][n] = (f32x4){0.f, 0.f, 0.f, 0.f};
    bf16x8 At[4][2], B0[2][2], B1[2][2]; i32x8 At8[4], B08[2], B18[2]; (void)At; (void)B0; (void)B1; (void)At8; (void)B08; (void)B18;
    const char* cA = cur.A; const char* cB = cur.B;
    S.a_ready(cur);
    if constexpr (SP2) {
        PG8_STAGE(PG8_SB(0, 0), cB, voffB); PG8_STAGE(PG8_SB(0, 1), cB + hstep, voffB); PG8_STAGE(PG8_SA(0, 0), cA, voffA); PG8_STAGE(PG8_SA(0, 1), cA + hstep, voffA);
        if (wr == 1) PG8_BAR;
        PG8_WAIT_V(2); PG8_BAR;
        PG8_STAGE(PG8_SB(1, 0), cB + kstep, voffB); PG8_STAGE(PG8_SA(1, 0), cA + kstep, voffA); PG8_STAGE(PG8_SB(1, 1), cB + hstep + kstep, voffB);
        PG8_WAIT_V(6); PG8_BAR;
    } else {
        PG8_STAGE(PG8_SB(0, 0), cB, voffB); PG8_STAGE(PG8_SA(0, 0), cA, voffA); PG8_STAGE(PG8_SB(0, 1), cB + hstep, voffB); PG8_STAGE(PG8_SA(0, 1), cA + hstep, voffA);
        if (wr == 1) PG8_BAR;
        PG8_WAIT_V(4); PG8_BAR;
        PG8_STAGE(PG8_SB(1, 0), cB + kstep, voffB); PG8_STAGE(PG8_SA(1, 0), cA + kstep, voffA); PG8_STAGE(PG8_SB(1, 1), cB + hstep + kstep, voffB);
        PG8_WAIT_V(6); PG8_BAR;
    }
    for (;;) {
        const bool has_next = S.next(ui + 1, nxt);
        const char* nA = has_next ? nxt.A : cA; const char* nB = has_next ? nxt.B : cB;
_Pragma("unroll 1")
        for (int t = 0; t < nt; t += 2) {
            const bool last = (t == nt - 2);
            const char* a1 = cA + (size_t)(t + 1) * kstep;
            const char* a2 = last ? nA : cA + (size_t)(t + 2) * kstep; const char* b2 = last ? nB : cB + (size_t)(t + 2) * kstep;
            const char* a3 = a2 + kstep; const char* b3 = b2 + kstep;
            if (last && has_next) S.a_ready(nxt);
            if constexpr (Epi::PF) { if (t == 2) E.prefetch(cur, (unsigned)(size_t)lds + (unsigned)LDS_PF, wid); }
            if constexpr (SP2) {
            PG8_LDB(B0, 0, 0); PG8_LDB(B1, 0, 1); PG8_SCHED; PG8_LDA(At, 0, 0); PG8_STAGE(PG8_SA(1, 1), a1 + hstep, voffA);
            PG8_WAIT_V(8); PG8_WAIT_L(0); PG8_BAR; PG8_MMA(0, 0, At, B0); PG8_MMA(0, 1, At, B1); PG8_BAR; PG8_SCHED;
            PG8_LDA(At, 0, 1); PG8_STAGE(PG8_SB(0, 0), b2, voffB); PG8_STAGE(PG8_SB(0, 1), b2 + hstep, voffB); PG8_STAGE(PG8_SA(0, 0), a2, voffA);
            PG8_WAIT_V(8); PG8_WAIT_L(0); PG8_BAR; PG8_MMA(1, 0, At, B0); PG8_MMA(1, 1, At, B1); PG8_BAR; PG8_SCHED;
            PG8_LDB(B0, 1, 0); PG8_LDB(B1, 1, 1); PG8_SCHED; PG8_LDA(At, 1, 0); PG8_STAGE(PG8_SA(0, 1), a2 + hstep, voffA);
            PG8_WAIT_V(8); PG8_WAIT_L(0); PG8_BAR; PG8_MMA(0, 0, At, B0); PG8_MMA(0, 1, At, B1); PG8_BAR; PG8_SCHED;
            PG8_LDA(At, 1, 1); PG8_STAGE(PG8_SB(1, 0), b3, voffB); PG8_STAGE(PG8_SB(1, 1), b3 + hstep, voffB); PG8_STAGE(PG8_SA(1, 0), a3, voffA);
            PG8_WAIT_V(8); PG8_WAIT_L(0); PG8_BAR; PG8_MMA(1, 0, At, B0); PG8_MMA(1, 1, At, B1); PG8_BAR; PG8_SCHED;
            } else {
            PG8_LDB(B0, 0, 0); PG8_SCHED; PG8_LDA(At, 0, 0); PG8_STAGE(PG8_SA(1, 1), a1 + hstep, voffA);
            PG8_WAIT_L(8); PG8_BAR; PG8_WAIT_L(0); PG8_MMA(0, 0, At, B0); PG8_BAR; PG8_SCHED;
            PG8_LDB(B1, 0, 1); PG8_STAGE(PG8_SB(0, 0), b2, voffB);
            PG8_BAR; PG8_WAIT_L(0); PG8_MMA(0, 1, At, B1); PG8_BAR;
            PG8_LDA(At, 0, 1); PG8_STAGE(PG8_SA(0, 0), a2, voffA);
            PG8_BAR; PG8_WAIT_L(0); PG8_MMA(1, 0, At, B0); PG8_BAR; PG8_SCHED;
            PG8_STAGE(PG8_SB(0, 1), b2 + hstep, voffB);
            PG8_WAIT_V(6); PG8_BAR; PG8_MMA(1, 1, At, B1); PG8_BAR;
            PG8_LDB(B0, 1, 0); PG8_SCHED; PG8_LDA(At, 1, 0); PG8_STAGE(PG8_SA(0, 1), a2 + hstep, voffA);
            PG8_WAIT_L(8); PG8_BAR; PG8_WAIT_L(0); PG8_MMA(0, 0, At, B0); PG8_BAR; PG8_SCHED;
            PG8_LDB(B1, 1, 1); PG8_STAGE(PG8_SB(1, 0), b3, voffB);
            PG8_BAR; PG8_WAIT_L(0); PG8_MMA(0, 1, At, B1); PG8_BAR;
            PG8_LDA(At, 1, 1); PG8_STAGE(PG8_SA(1, 0), a3, voffA);
            PG8_BAR; PG8_WAIT_L(0); PG8_MMA(1, 0, At, B0); PG8_BAR; PG8_SCHED;
            PG8_STAGE(PG8_SB(1, 1), b3 + hstep, voffB);
            PG8_WAIT_V(6); PG8_BAR; PG8_MMA(1, 1, At, B1); PG8_BAR;
            }
        }
        if constexpr (ALIGN_EPI) { if (wr == 0) PG8_BAR; }
        if constexpr (!Epi::AFTER_DRAIN) { E(acc, cur, wr, wc, fr, fq); S.done(cur); }
        if (!has_next) break;
#pragma unroll
        for (int a = 0; a < 2; ++a)
#pragma unroll
            for (int b = 0; b < 2; ++b)
#pragma unroll
                for (int m = 0; m < 4; ++m)
#pragma unroll
                    for (int n = 0; n < 2; ++n) acc[a][b][m][n] = (f32x4){0.f, 0.f, 0.f, 0.f};
        cur = nxt; cA = nA; cB = nB; ++ui;
        if constexpr (ALIGN_EPI) { if (wr == 1) PG8_BAR; }
    }
    PG8_WAIT_V(0);
    if constexpr (!ALIGN_EPI) { if (wr == 0) PG8_BAR; }
    PG8_BAR;
    if constexpr (Epi::AFTER_DRAIN) { E.fused(acc, cur, wr, wc, fr, fq, lds, wid, lane); S.done(cur); }
#undef PG8_SA
#undef PG8_SB
#undef PG8_STAGE
#undef PG8_LDA
#undef PG8_LDB
#undef PG8_MMA
#undef PG8_WAIT_V
#undef PG8_WAIT_L
#undef PG8_BAR
#undef PG8_SCHED
}

template <int NP, bool UP, int ROWB> struct MoeOrder {
    const volatile LAS int* tab; int layer; const char* A; const char* W;
    __device__ bool next(int i, Unit& u) const {
        const int e = tab[i]; if (e < 0) return false;
        const int mt = e & 0xffff, pn = (e >> 16) & 0xff, cls = e >> 24;
        u.pm = mt; u.pn = pn; u.A = A + (size_t)mt * ((size_t)BM * ROWB);
        if (UP) { const int g = cls / 6, pi = cls % 6, s = pn >> 2, ex = g * 4 + (s ? pair_hi(pi) : pair_lo(pi));
            u.B = W + ((size_t)(layer * NE + ex) * 1024 + (size_t)(pn & 3) * 256) * ROWB; }
        else u.B = W + ((size_t)(layer * NCLS + cls) * 1024 + (size_t)pn * 256) * ROWB;
        return true;
    }
    __device__ __forceinline__ void a_ready(const Unit&) const {}
    __device__ __forceinline__ void done(const Unit&) const {}
};

struct EpiZ {
    static constexpr bool PERM = true, AFTER_DRAIN = false, PF = true;
    bf16_t* Z; const float* ssq; const PG8_LAS unsigned char* pf;
    __device__ __forceinline__ void prefetch(const Unit& u, unsigned lds_addr, int wid) const {
        const char* g = (const char*)(ssq + (size_t)u.pm * BM * 16) + wid * 1024; const unsigned vo = (unsigned)fresh_lane() * 16u;
#pragma unroll
        for (int i = 0; i < 2; ++i) { unsigned keep;
            asm volatile("s_mov_b32 %0, m0\n\ts_mov_b32 m0, %3\n\ts_nop 0\n\tglobal_load_lds_dwordx4 %1, %2\n\ts_mov_b32 m0, %0" : "=&s"(keep) : "v"(vo), "s"(g + i * 8192), "s"(lds_addr + (unsigned)(wid * 1024 + i * 8192)) : "memory"); } }
    __device__ __forceinline__ void operator()(const f32x4 (&acc)[2][2][4][2], const Unit& u, int wr, int wc, int fr, int fq) const {
        { const int ln_ = fresh_lane(); fr = ln_ & 15; fq = ln_ >> 4; }
        const int row0 = u.pm * BM + wr * 64 + fr, col0 = u.pn * BM + wc * 32 + 8 * fq;
        float rr[2][4];
#pragma unroll
        for (int ai = 0; ai < 2; ++ai) {
            f32x4 sp[4];
#pragma unroll
            for (int m = 0; m < 4; ++m) sp[m] = *(const PG8_LAS f32x4*)(pf + (ai * HALF + wr * 64 + m * 16 + fr) * 64 + 16 * fq);
#pragma unroll
            for (int m = 0; m < 4; ++m) { float t = (sp[m][0] + sp[m][1]) + (sp[m][2] + sp[m][3]); t = add_x16_x32(t); rr[ai][m] = __builtin_amdgcn_rsqf(t * (1.0f / D) + EPS); }
        }
#pragma unroll
        for (int ai = 0; ai < 2; ++ai)
#pragma unroll
            for (int m = 0; m < 4; ++m) { const int row = row0 + ai * HALF + m * 16; const float r = rr[ai][m];
                bf16_t* rowp = Z + (size_t)row * INC + col0;
#pragma unroll
                for (int bj = 0; bj < 2; ++bj) { f32x4 v0 = acc[ai][bj][m][0] * r, v1 = acc[ai][bj][m][1] * r;
                    u32x4 w; w.x = cvt_pk_bf16(v0[0], v0[1]); w.y = cvt_pk_bf16(v0[2], v0[3]); w.z = cvt_pk_bf16(v1[0], v1[1]); w.w = cvt_pk_bf16(v1[2], v1[3]);
                    *(u32x4*)(rowp + bj * HALF) = w; } }
    }
};
template <bool SCATTER> struct EpiRes {
    static constexpr bool PERM = true, AFTER_DRAIN = false, PF = SCATTER; static constexpr int SCALE_W = 0x7b7b7b7b, SCALE_A = 0x7b7b7b7b;
    bf16_t* H; float* ssq; const int* rowtok; const PG8_LAS unsigned char* pf;
    __device__ __forceinline__ void prefetch(const Unit& u, unsigned lds_addr, int wid) const {
        if (wid < 4) { const char* g = (const char*)(rowtok + (size_t)u.pm * BM) + wid * 256; const unsigned vo = (unsigned)fresh_lane() * 4u; unsigned keep;
            asm volatile("s_mov_b32 %0, m0\n\ts_mov_b32 m0, %3\n\ts_nop 0\n\tglobal_load_lds_dword %1, %2\n\ts_mov_b32 m0, %0" : "=&s"(keep) : "v"(vo), "s"(g), "s"(lds_addr + (unsigned)(wid * 256)) : "memory"); } }
    __device__ __forceinline__ void operator()(const f32x4 (&acc)[2][2][4][2], const Unit& u, int wr, int wc, int fr, int fq) const {
        { const int ln_ = fresh_lane(); fr = ln_ & 15; fq = ln_ >> 4; }
        const int row0 = u.pm * BM + wr * 64 + fr, col0 = u.pn * BM + wc * 32 + 8 * fq;
        int tokv[2][4];
#pragma unroll
        for (int ai = 0; ai < 2; ++ai)
#pragma unroll
            for (int m = 0; m < 4; ++m) { const int row = row0 + ai * HALF + m * 16; tokv[ai][m] = SCATTER ? *(const PG8_LAS int*)(pf + (ai * HALF + wr * 64 + m * 16 + fr) * 4) : row; }
#pragma unroll
        for (int ai = 0; ai < 2; ++ai) {
            u32x4 o[4][2];
#pragma unroll
            for (int m = 0; m < 4; ++m) { const int tok = tokv[ai][m]; const bf16_t* rowp = H + (size_t)(tok < 0 ? 0 : tok) * D + col0; o[m][0] = *(const u32x4*)(rowp); o[m][1] = *(const u32x4*)(rowp + HALF); }
#pragma unroll
            for (int m = 0; m < 4; ++m) { const int tok = tokv[ai][m]; float s = 0.f; bf16_t* rowp = H + (size_t)(tok < 0 ? 0 : tok) * D + col0;
#pragma unroll
                for (int bj = 0; bj < 2; ++bj) { const u32x4 oo = o[m][bj];
                    f32x4 v0 = acc[ai][bj][m][0], v1 = acc[ai][bj][m][1];
                    v0[0] += __uint_as_float(oo.x << 16); v0[1] += __uint_as_float(oo.x & 0xffff0000u); v0[2] += __uint_as_float(oo.y << 16); v0[3] += __uint_as_float(oo.y & 0xffff0000u);
                    v1[0] += __uint_as_float(oo.z << 16); v1[1] += __uint_as_float(oo.z & 0xffff0000u); v1[2] += __uint_as_float(oo.w << 16); v1[3] += __uint_as_float(oo.w & 0xffff0000u);
                    s += (v0[0] * v0[0] + v0[1] * v0[1]) + (v0[2] * v0[2] + v0[3] * v0[3]) + (v1[0] * v1[0] + v1[1] * v1[1]) + (v1[2] * v1[2] + v1[3] * v1[3]);
                    u32x4 w; w.x = cvt_pk_bf16(v0[0], v0[1]); w.y = cvt_pk_bf16(v0[2], v0[3]); w.z = cvt_pk_bf16(v1[0], v1[1]); w.w = cvt_pk_bf16(v1[2], v1[3]);
                    if (tok >= 0) *(u32x4*)(rowp + bj * HALF) = w; }
                s = add_x16_x32(s);
                if (fq == 0 && tok >= 0) ssq[(size_t)tok * 16 + u.pn * 4 + wc] = s; }
            asm volatile("" ::: "memory"); }
    }
};
constexpr int SC_W = 0x7b7b7b7b, SC_H = 0x7b7b7b7b, SC_ACT = 0x7b7b7b7b;
constexpr float FS_W = 16.f, FS_H = 16.f, FS_ACT = 16.f;
struct EpiUp {
    static constexpr bool PERM = true, AFTER_DRAIN = false, PF = true; static constexpr int SCALE_W = SC_W, SCALE_A = SC_H;
    unsigned char* ACT; const float* rowg; const PG8_LAS unsigned char* pf;
    __device__ __forceinline__ void prefetch(const Unit& u, unsigned lds_addr, int wid) const {
        const char* g = (const char*)(rowg + (size_t)u.pm * BM * 2) + wid * 256; const unsigned vo = (unsigned)fresh_lane() * 4u; unsigned keep;
        asm volatile("s_mov_b32 %0, m0\n\ts_mov_b32 m0, %3\n\ts_nop 0\n\tglobal_load_lds_dword %1, %2\n\ts_mov_b32 m0, %0" : "=&s"(keep) : "v"(vo), "s"(g), "s"(lds_addr + (unsigned)(wid * 256)) : "memory"); }
    __device__ __forceinline__ void operator()(const f32x4 (&acc)[2][2][4][2], const Unit& u, int wr, int wc, int fr, int fq) const {
        { const int ln_ = fresh_lane(); fr = ln_ & 15; fq = ln_ >> 4; }
        const int row0 = u.pm * BM + wr * 64 + fr, s = u.pn >> 2, col0 = s * 512 + (u.pn & 3) * 128 + wc * 32 + 8 * fq;
        float gt[2][4];
#pragma unroll
        for (int ai = 0; ai < 2; ++ai)
#pragma unroll
            for (int m = 0; m < 4; ++m) gt[ai][m] = *(const PG8_LAS float*)(pf + ((ai * HALF + wr * 64 + m * 16 + fr) * 2 + s) * 4);
#pragma unroll
        for (int ai = 0; ai < 2; ++ai)
#pragma unroll
            for (int m = 0; m < 4; ++m) { const int row = row0 + ai * HALF + m * 16; const float g1 = gt[ai][m];
                float o[8];
#pragma unroll
                for (int n = 0; n < 2; ++n)
#pragma unroll
                    for (int j = 0; j < 4; ++j) { const float g = acc[ai][0][m][n][j], up = acc[ai][1][m][n][j]; o[n * 4 + j] = g * sigmoid_fast(g) * up * g1; }
                u32x2 w; w.x = pk_fp8x4(o[0] * FS_ACT, o[1] * FS_ACT, o[2] * FS_ACT, o[3] * FS_ACT); w.y = pk_fp8x4(o[4] * FS_ACT, o[5] * FS_ACT, o[6] * FS_ACT, o[7] * FS_ACT);
                *(u32x2*)(ACT + (size_t)row * 1024 + col0) = w; }
    }
};
}

__device__ __forceinline__ void tr_item(const float* W, int ldw, int k0, int scol0, const float* gk, bf16_t* WT, int ldo, int drow0, int dk0, LAS float* scr, int lane) {
#pragma unroll 8
    for (int i = 0; i < 32; ++i) { const int kk = 2 * i + (lane >> 5); float v = W[(size_t)(k0 + kk) * ldw + scol0 + (lane & 31)]; if (gk) v *= gk[k0 + kk]; scr[kk * 33 + (lane & 31)] = v; }
    asm volatile("s_waitcnt lgkmcnt(0)" ::: "memory");
    const int c = lane & 7;
#pragma unroll
    for (int j = 0; j < 4; ++j) { const int n = (lane >> 3) + 8 * j; const LAS float* s = scr + (8 * c) * 33 + n;
        u32x4 o; o.x = cvt_pk_bf16(s[0 * 33], s[1 * 33]); o.y = cvt_pk_bf16(s[2 * 33], s[3 * 33]); o.z = cvt_pk_bf16(s[4 * 33], s[5 * 33]); o.w = cvt_pk_bf16(s[6 * 33], s[7 * 33]);
        *(u32x4*)(WT + (size_t)(drow0 + n) * ldo + dk0 + 8 * c) = o; }
    asm volatile("s_waitcnt lgkmcnt(0)" ::: "memory");
}

constexpr size_t S5_L_STRIDE = 1310720, S5_KT = 0, S5_ET = 131072, S5_FT = 655360, S5_LAMP = 1179648;
constexpr int S5_WSCR = 8192, S5_YST = 65536, YST_LD = 264;
constexpr int NU128 = T / 128, UPB128 = SEQ / 128;
__device__ __forceinline__ f32x4 mfma16(bf16x8 a, bf16x8 b, f32x4 c) { return __builtin_amdgcn_mfma_f32_16x16x32_bf16(a, b, c, 0, 0, 0); }

__device__ __forceinline__ void s5_kt_pair(int g, int c, int cp, const float* a_re, const float* a_im, const float* log_dt, const float* b_re, const float* b_im,
                                           const float* c_re, const float* c_im, const float* dvec, unsigned char* tab) {
    const float dt = __expf(log_dt[g]); float km[8];
#pragma unroll
    for (int d = 0; d < 8; ++d) km[d] = 0.f;
#pragma unroll 2
    for (int p = 0; p < CS; ++p) { const float lr = a_re[g * CS + p], li = a_im[g * CS + p], zr = lr * dt, zi = li * dt;
        const float sh = __sinf(0.5f * zi), cz = __cosf(zi), sz = __sinf(zi), ez = __expf(zr); const float nr = expm1f(zr) * cz - 2.0f * sh * sh, ni = ez * sz, den = lr * lr + li * li;
        const float cr = (nr * lr + ni * li) / den, ci = (ni * lr - nr * li) / den;
        const float br = b_re[((size_t)g * CS + p) * CGD + cp], bi = b_im[((size_t)g * CS + p) * CGD + cp]; const float bbr = cr * br - ci * bi, bbi = cr * bi + ci * br;
        const float cre = c_re[((size_t)g * CGD + c) * CS + p], cim = c_im[((size_t)g * CGD + c) * CS + p];
        float vr = cre * bbr - cim * bbi, vi = cre * bbi + cim * bbr;
        const float lbr = ez * cz, lbi = ez * sz;
#pragma unroll
        for (int d = 0; d < 8; ++d) { km[d] += vr; const float t = vr * lbr - vi * lbi; vi = vr * lbi + vi * lbr; vr = t; } }
    if (c == cp) km[0] += dvec[g * CGD + c];
    bf16_t* kt = (bf16_t*)(tab + S5_KT) + (size_t)g * 4096;
#pragma unroll
    for (int dd = 0; dd < 8; ++dd) { kt[(dd * 16 + c) * 32 + cp] = f2bf(km[dd]); kt[(dd * 16 + c) * 32 + 16 + cp] = dd >= 1 ? f2bf(km[dd - 1]) : (bf16_t)0; }
}
__device__ __forceinline__ void s5_et_task(int g, int ri, int p, int cp, const float* a_re, const float* a_im, const float* log_dt, const float* b_re, const float* b_im, unsigned char* tab) {
    const float dt = __expf(log_dt[g]); const float lr = a_re[g * CS + p], li = a_im[g * CS + p], zr = lr * dt, zi = li * dt;
    const float sh = __sinf(0.5f * zi), cz = __cosf(zi), sz = __sinf(zi), ez = __expf(zr); const float nr = expm1f(zr) * cz - 2.0f * sh * sh, ni = ez * sz, den = lr * lr + li * li;
    const float cr = (nr * lr + ni * li) / den, ci = (ni * lr - nr * li) / den;
    const float br = b_re[((size_t)g * CS + p) * CGD + cp], bi = b_im[((size_t)g * CS + p) * CGD + cp]; float vr = cr * br - ci * bi, vi = cr * bi + ci * br;
    const float lbr = ez * cz, lbi = ez * sz; bf16_t* et = (bf16_t*)(tab + S5_ET) + (size_t)g * 16384 + (size_t)(ri * 64 + p) * 128 + cp;
#pragma unroll
    for (int sp = 7; sp >= 0; --sp) { et[sp * 16] = f2bf(ri ? vi : vr); const float t = vr * lbr - vi * lbi; vi = vr * lbi + vi * lbr; vr = t; }
}
__device__ __forceinline__ void s5_ft_task(int g, int c, int ri, int p, const float* a_re, const float* a_im, const float* log_dt, const float* c_re, const float* c_im, unsigned char* tab) {
    const float dt = __expf(log_dt[g]); const float lr = a_re[g * CS + p], li = a_im[g * CS + p], zr = lr * dt, zi = li * dt; const float ez = __expf(zr), lbr = ez * __cosf(zi), lbi = ez * __sinf(zi);
    const float cre = c_re[((size_t)g * CGD + c) * CS + p], cim = c_im[((size_t)g * CGD + c) * CS + p]; float vr = cre * lbr - cim * lbi, vi = cre * lbi + cim * lbr;
    bf16_t* ft = (bf16_t*)(tab + S5_FT) + (size_t)g * 16384 + (size_t)c * 128 + ri * 64 + p;
#pragma unroll
    for (int tp = 0; tp < 8; ++tp) { ft[(size_t)tp * 16 * 128] = f2bf(ri ? -vi : vr); const float t = vr * lbr - vi * lbi; vi = vr * lbi + vi * lbr; vr = t; }
}
__device__ __forceinline__ void s5_table_elem(int g, int e, const float* a_re, const float* a_im, const float* log_dt, const float* b_re, const float* b_im,
                                              const float* c_re, const float* c_im, const float* dvec, unsigned char* tab) {
    const float dt = __expf(log_dt[g]);
    if (e < 4096) {
        const int dd = e >> 9, c = (e >> 5) & 15, ee = (e >> 4) & 1, cp = e & 15, d = dd - ee; float s = 0.f;
        if (d >= 0) {
            for (int p = 0; p < CS; ++p) { const float lr = a_re[g * CS + p], li = a_im[g * CS + p], zr = lr * dt, zi = li * dt;
                const float sh = __sinf(0.5f * zi); const float nr = expm1f(zr) * __cosf(zi) - 2.0f * sh * sh, ni = __expf(zr) * __sinf(zi), den = lr * lr + li * li;
                const float cr = (nr * lr + ni * li) / den, ci = (ni * lr - nr * li) / den;
                const float br = b_re[((size_t)g * CS + p) * CGD + cp], bi = b_im[((size_t)g * CS + p) * CGD + cp]; const float bbr = cr * br - ci * bi, bbi = cr * bi + ci * br;
                const float mag = __expf(zr * (float)d), pr = mag * __cosf(zi * (float)d), pi = mag * __sinf(zi * (float)d);
                const float vr = pr * bbr - pi * bbi, vi = pr * bbi + pi * bbr;
                s += c_re[((size_t)g * CGD + c) * CS + p] * vr - c_im[((size_t)g * CGD + c) * CS + p] * vi; }
            if (d == 0 && c == cp) s += dvec[g * CGD + c];
        }
        ((bf16_t*)(tab + S5_KT))[(size_t)g * 4096 + e] = f2bf(s); return;
    }
    e -= 4096;
    if (e < 16384) {
        const int n = e >> 7, k = e & 127, ri = n >> 6, p = n & 63, sp = k >> 4, cp = k & 15;
        const float lr = a_re[g * CS + p], li = a_im[g * CS + p], zr = lr * dt, zi = li * dt;
        const float sh = __sinf(0.5f * zi); const float nr = expm1f(zr) * __cosf(zi) - 2.0f * sh * sh, ni = __expf(zr) * __sinf(zi), den = lr * lr + li * li;
        const float cr = (nr * lr + ni * li) / den, ci = (ni * lr - nr * li) / den;
        const float br = b_re[((size_t)g * CS + p) * CGD + cp], bi = b_im[((size_t)g * CS + p) * CGD + cp]; const float bbr = cr * br - ci * bi, bbi = cr * bi + ci * br;
        const float d = (float)(7 - sp); const float mag = __expf(zr * d), pr = mag * __cosf(zi * d), pi = mag * __sinf(zi * d);
        ((bf16_t*)(tab + S5_ET))[(size_t)g * 16384 + e] = f2bf(ri ? (pr * bbi + pi * bbr) : (pr * bbr - pi * bbi)); return;
    }
    e -= 16384;
    if (e < 16384) {
        const int n = e >> 7, k = e & 127, tp = n >> 4, c = n & 15, ri = k >> 6, p = k & 63;
        const float lr = a_re[g * CS + p], li = a_im[g * CS + p], zr = lr * dt, zi = li * dt;
        const float d = (float)(tp + 1); const float mag = __expf(zr * d), pr = mag * __cosf(zi * d), pi = mag * __sinf(zi * d);
        const float cre = c_re[((size_t)g * CGD + c) * CS + p], cim = c_im[((size_t)g * CGD + c) * CS + p];
        ((bf16_t*)(tab + S5_FT))[(size_t)g * 16384 + e] = f2bf(ri ? -(cre * pi + cim * pr) : (cre * pr - cim * pi)); return;
    }
    e -= 16384;
    { const int p = e; const float lr = a_re[g * CS + p], li = a_im[g * CS + p], zr = lr * dt, zi = li * dt; float* o = (float*)(tab + S5_LAMP) + ((size_t)g * CS + p) * 8;
      float mag = expf(zr); o[0] = mag * cosf(zi); o[1] = mag * sinf(zi);
      mag = expf(zr * 8.f); o[2] = mag * cosf(zi * 8.f); o[3] = mag * sinf(zi * 8.f);
      mag = expf(zr * 128.f); o[4] = mag * cosf(zi * 128.f); o[5] = mag * sinf(zi * 128.f); o[6] = 0.f; o[7] = 0.f; }
}

template <class TT> __device__ __forceinline__ TT ldg(const void* ubase, unsigned voff) { return *(const TT*)((const char*)ubase + voff); }
template <int PASS>
__device__ __forceinline__ void s5_group(int unit, int g, bool first, float& kr, float& ki, int wave, int lane, const bf16_t* Z, bf16_t* Y, const unsigned char* tab, float* SEND, float* SEND2, float* SE, LAS unsigned char* lds) {
    const int ln = lane & 15, q = lane >> 4; const int t0 = unit * 128;
    const char* KTg = (const char*)(tab + S5_KT) + (size_t)g * 8192; const char* ETg = (const char*)(tab + S5_ET) + (size_t)g * 32768; const char* FTg = (const char*)(tab + S5_FT) + (size_t)g * 32768;
    const float* LAMPg = (const float*)(tab + S5_LAMP) + (size_t)g * CS * 8;
    const unsigned vo128 = (unsigned)(ln * 128 + 8 * q) * 2u;
    const unsigned vo32 = (unsigned)(ln * 32 + 8 * q) * 2u;
    LAS float* Sb = (LAS float*)(lds + wave * S5_WSCR); LAS bf16_t* Tb = (LAS bf16_t*)(lds + wave * S5_WSCR); LAS bf16_t* yst = (LAS bf16_t*)(lds + S5_YST);
    char* seb = (char*)(SE + ((size_t)unit * CG + g) * 16 * 128); const unsigned vl = (unsigned)lane * 4u;
    char* ylb = (char*)(Y + (size_t)t0 * D + AW + BW + g * 16); const unsigned vy = (unsigned)((ln * 8) * D + 4 * q) * 2u;
    const float lur = LAMPg[lane * 8 + 4], lui = LAMPg[lane * 8 + 5], l8r = LAMPg[lane * 8 + 2], l8i = LAMPg[lane * 8 + 3];
    float cr = 0.f, ci = 0.f;
    if (PASS == 1) {
        if (!first) { cr = kr; ci = ki; }
        bf16x8 X0, X1, X2, X3;
        { const char* zb = (const char*)(Z + (size_t)t0 * INC + ZC + g * 16); const unsigned vz = (unsigned)((ln * 8 + (q >> 1)) * INC + 8 * (q & 1)) * 2u;
          X0 = ldg<bf16x8>(zb, vz); X1 = ldg<bf16x8>(zb + 2 * INC * 2, vz); X2 = ldg<bf16x8>(zb + 4 * INC * 2, vz); X3 = ldg<bf16x8>(zb + 6 * INC * 2, vz); }
        { LAS float* sw = Sb + (4 * q) * 128 + ln; const char* eb = ETg;
#pragma unroll 1
          for (int jh = 0; jh < 2; ++jh) { bf16x8 ef[4][4];
#pragma unroll
            for (int j = 0; j < 4; ++j)
#pragma unroll
              for (int ks = 0; ks < 4; ++ks) ef[j][ks] = ldg<bf16x8>(eb + j * 4096 + ks * 64, vo128);
#pragma unroll
            for (int j = 0; j < 4; ++j) { f32x4 se = (f32x4){0.f, 0.f, 0.f, 0.f};
              se = mfma16(X0, ef[j][0], se); se = mfma16(X1, ef[j][1], se); se = mfma16(X2, ef[j][2], se); se = mfma16(X3, ef[j][3], se);
              LAS float* s2 = sw + 16 * j; s2[0] = se[0]; s2[128] = se[1]; s2[256] = se[2]; s2[384] = se[3]; }
            eb += 16384; sw += 64; } }
        asm volatile("" ::: "memory");
        { const char* kb = KTg; char* yq = ylb;
#pragma unroll 1
          for (int th = 0; th < 4; ++th) {
              const bf16x8 ka = ldg<bf16x8>(kb, vo32), kc = ldg<bf16x8>(kb + 1024, vo32);
              f32x4 acc0 = (f32x4){0.f, 0.f, 0.f, 0.f}, acc1 = (f32x4){0.f, 0.f, 0.f, 0.f};
              acc0 = mfma16(ka, X0, acc0); acc1 = mfma16(kc, X0, acc1);
              if (th >= 1) { acc0 = mfma16(ldg<bf16x8>(kb - 2048, vo32), X1, acc0); acc1 = mfma16(ldg<bf16x8>(kb - 1024, vo32), X1, acc1); }
              if (th >= 2) { acc0 = mfma16(ldg<bf16x8>(kb - 4096, vo32), X2, acc0); acc1 = mfma16(ldg<bf16x8>(kb - 3072, vo32), X2, acc1); }
              if (th >= 3) { acc0 = mfma16(ldg<bf16x8>(kb - 6144, vo32), X3, acc0); acc1 = mfma16(ldg<bf16x8>(kb - 5120, vo32), X3, acc1); }
              u32x2 w; w.x = cvt_pk_bf16(acc0[0], acc0[1]); w.y = cvt_pk_bf16(acc0[2], acc0[3]); *(u32x2*)(yq + vy) = w;
              w.x = cvt_pk_bf16(acc1[0], acc1[1]); w.y = cvt_pk_bf16(acc1[2], acc1[3]); *(u32x2*)(yq + (size_t)D * 2 + vy) = w;
              kb += 2048; yq += (size_t)2 * D * 2; } }
        asm volatile("" ::: "memory");
        float sr = cr, si = ci;
#pragma unroll
        for (int s = 0; s < 16; ++s) { const float er = Sb[s * 128 + lane], ei = Sb[s * 128 + 64 + lane];
            *(float*)(seb + s * 512 + vl) = er; *(float*)(seb + s * 512 + 256 + vl) = ei;
            const float nr = l8r * sr - l8i * si + er, ni = l8r * si + l8i * sr + ei; sr = nr; si = ni; }
        kr = sr; ki = si;
        float* dst = first ? SEND + (((size_t)unit * CG + g) * 2) * CS + lane : SEND2 + (((size_t)(unit >> 1) * CG + g) * 2) * CS + lane;
        dst[0] = sr; dst[CS] = si; asm volatile("" ::: "memory"); return;
    }
    if (first) { const int pr = unit >> 1, p0 = pr - (pr % (UPB128 / 2)); const float l2r = lur * lur - lui * lui, l2i = 2.0f * lur * lui;
        const char* sb = (const char*)(SEND2 + (((size_t)p0 * CG + g) * 2) * CS);
#pragma unroll 8
        for (int j = p0; j < pr; ++j) { const float sr = ldg<float>(sb, vl), si = ldg<float>(sb + CS * 4, vl); sb += (size_t)CG * 2 * CS * 4;
            const float nr = l2r * cr - l2i * ci + sr, ni = l2r * ci + l2i * cr + si; cr = nr; ci = ni; } }
    else { const float sr = SEND[(((size_t)(unit - 1) * CG + g) * 2 + 0) * CS + lane], si = SEND[(((size_t)(unit - 1) * CG + g) * 2 + 1) * CS + lane];
        cr = lur * kr - lui * ki + sr; ci = lur * ki + lui * kr + si; }
    kr = cr; ki = ci;
    { float sre[16], sim[16];
#pragma unroll
      for (int s = 0; s < 16; ++s) { sre[s] = ldg<float>(seb + s * 512, vl); sim[s] = ldg<float>(seb + s * 512 + 256, vl); }
      float sr = cr, si = ci;
#pragma unroll
      for (int s = 0; s < 16; ++s) { Tb[s * 128 + lane] = f2bf(sr); Tb[s * 128 + 64 + lane] = f2bf(si);
          const float nr = l8r * sr - l8i * si + sre[s], ni = l8r * si + l8i * sr + sim[s]; sr = nr; si = ni; } }
    asm volatile("" ::: "memory");
    const bf16x8 T0 = *(const LAS bf16x8*)(Tb + ln * 128 + 8 * q), T1 = *(const LAS bf16x8*)(Tb + ln * 128 + 32 + 8 * q), T2 = *(const LAS bf16x8*)(Tb + ln * 128 + 64 + 8 * q), T3 = *(const LAS bf16x8*)(Tb + ln * 128 + 96 + 8 * q);
    { LAS bf16_t* yw = yst + (ln * 8) * YST_LD + g * 16 + 4 * q; const char* fb = FTg; const char* yq = ylb;
#pragma unroll 2
      for (int th = 0; th < 4; ++th) { bf16x8 ff[2][4]; u32x2 yl[2];
#pragma unroll
          for (int j = 0; j < 2; ++j) { yl[j] = ldg<u32x2>(yq + (size_t)j * D * 2, vy);
#pragma unroll
              for (int ks = 0; ks < 4; ++ks) ff[j][ks] = ldg<bf16x8>(fb + j * 4096 + ks * 64, vo128); }
#pragma unroll
          for (int j = 0; j < 2; ++j) {
              f32x4 acc; acc[0] = __uint_as_float(yl[j].x << 16); acc[1] = __uint_as_float(yl[j].x & 0xffff0000u); acc[2] = __uint_as_float(yl[j].y << 16); acc[3] = __uint_as_float(yl[j].y & 0xffff0000u);
              acc = mfma16(ff[j][0], T0, acc); acc = mfma16(ff[j][1], T1, acc); acc = mfma16(ff[j][2], T2, acc); acc = mfma16(ff[j][3], T3, acc);
              u32x2 w; w.x = cvt_pk_bf16(gelu_fast(acc[0]), gelu_fast(acc[1])); w.y = cvt_pk_bf16(gelu_fast(acc[2]), gelu_fast(acc[3]));
              *(LAS u32x2*)(yw + j * YST_LD) = w; }
          fb += 8192; yq += (size_t)2 * D * 2; yw += 2 * YST_LD; } }
    asm volatile("s_waitcnt lgkmcnt(0)" ::: "memory");
}
__device__ __forceinline__ void s5_pair1(int pr, int g, int wave, int lane, const bf16_t* Z, bf16_t* Y, const unsigned char* tab, float* SEND, float* SEND2, float* SE, LAS unsigned char* lds) {
    const int ln = lane & 15, q = lane >> 4; const int t0 = pr * 256;
    const char* KTg = (const char*)(tab + S5_KT) + (size_t)g * 8192; const char* ETg = (const char*)(tab + S5_ET) + (size_t)g * 32768;
    const float* LAMPg = (const float*)(tab + S5_LAMP) + (size_t)g * CS * 8;
    const unsigned vo128 = (unsigned)(ln * 128 + 8 * q) * 2u, vo32 = (unsigned)(ln * 32 + 8 * q) * 2u, vl = (unsigned)lane * 4u;
    LAS float* SbA = (LAS float*)(lds + wave * 16384); LAS float* SbB = SbA + 2048;
    bf16x8 XA0, XA1, XA2, XA3, XB0, XB1, XB2, XB3;
    { const char* zb = (const char*)(Z + (size_t)t0 * INC + ZC + g * 16); const unsigned vz = (unsigned)((ln * 8 + (q >> 1)) * INC + 8 * (q & 1)) * 2u;
      XA0 = ldg<bf16x8>(zb, vz); XA1 = ldg<bf16x8>(zb + 2 * INC * 2, vz); XA2 = ldg<bf16x8>(zb + 4 * INC * 2, vz); XA3 = ldg<bf16x8>(zb + 6 * INC * 2, vz);
      const char* zc = zb + (size_t)128 * INC * 2;
      XB0 = ldg<bf16x8>(zc, vz); XB1 = ldg<bf16x8>(zc + 2 * INC * 2, vz); XB2 = ldg<bf16x8>(zc + 4 * INC * 2, vz); XB3 = ldg<bf16x8>(zc + 6 * INC * 2, vz); }
    { LAS float* sw = SbA + (4 * q) * 128 + ln; const char* eb = ETg;
#pragma unroll
      for (int jh = 0; jh < 2; ++jh) { bf16x8 ef[4][4];
#pragma unroll
        for (int j = 0; j < 4; ++j)
#pragma unroll
          for (int ks = 0; ks < 4; ++ks) ef[j][ks] = ldg<bf16x8>(eb + j * 4096 + ks * 64, vo128);
#pragma unroll
        for (int j = 0; j < 4; ++j) { f32x4 sa = (f32x4){0.f, 0.f, 0.f, 0.f}, sb = (f32x4){0.f, 0.f, 0.f, 0.f};
          sa = mfma16(XA0, ef[j][0], sa); sb = mfma16(XB0, ef[j][0], sb); sa = mfma16(XA1, ef[j][1], sa); sb = mfma16(XB1, ef[j][1], sb);
          sa = mfma16(XA2, ef[j][2], sa); sb = mfma16(XB2, ef[j][2], sb); sa = mfma16(XA3, ef[j][3], sa); sb = mfma16(XB3, ef[j][3], sb);
          LAS float* s2 = sw + 16 * j; s2[0] = sa[0]; s2[128] = sa[1]; s2[256] = sa[2]; s2[384] = sa[3]; s2[2048] = sb[0]; s2[2048 + 128] = sb[1]; s2[2048 + 256] = sb[2]; s2[2048 + 384] = sb[3]; }
        eb += 16384; sw += 64; } }
    asm volatile("" ::: "memory");
    { const char* kb = KTg; char* yq = (char*)(Y + (size_t)t0 * D + AW + BW + g * 16); const unsigned vy = (unsigned)((ln * 8) * D + 4 * q) * 2u;
#pragma unroll 1
      for (int th = 0; th < 4; ++th) {
          const bf16x8 ka = ldg<bf16x8>(kb, vo32), kc = ldg<bf16x8>(kb + 1024, vo32);
          f32x4 a0 = (f32x4){0.f, 0.f, 0.f, 0.f}, a1 = a0, b0 = a0, b1 = a0;
          a0 = mfma16(ka, XA0, a0); a1 = mfma16(kc, XA0, a1); b0 = mfma16(ka, XB0, b0); b1 = mfma16(kc, XB0, b1);
          if (th >= 1) { const bf16x8 k0 = ldg<bf16x8>(kb - 2048, vo32), k1 = ldg<bf16x8>(kb - 1024, vo32); a0 = mfma16(k0, XA1, a0); a1 = mfma16(k1, XA1, a1); b0 = mfma16(k0, XB1, b0); b1 = mfma16(k1, XB1, b1); }
          if (th >= 2) { const bf16x8 k0 = ldg<bf16x8>(kb - 4096, vo32), k1 = ldg<bf16x8>(kb - 3072, vo32); a0 = mfma16(k0, XA2, a0); a1 = mfma16(k1, XA2, a1); b0 = mfma16(k0, XB2, b0); b1 = mfma16(k1, XB2, b1); }
          if (th >= 3) { const bf16x8 k0 = ldg<bf16x8>(kb - 6144, vo32), k1 = ldg<bf16x8>(kb - 5120, vo32); a0 = mfma16(k0, XA3, a0); a1 = mfma16(k1, XA3, a1); b0 = mfma16(k0, XB3, b0); b1 = mfma16(k1, XB3, b1); }
          u32x2 w; w.x = cvt_pk_bf16(a0[0], a0[1]); w.y = cvt_pk_bf16(a0[2], a0[3]); *(u32x2*)(yq + vy) = w;
          w.x = cvt_pk_bf16(a1[0], a1[1]); w.y = cvt_pk_bf16(a1[2], a1[3]); *(u32x2*)(yq + (size_t)D * 2 + vy) = w;
          w.x = cvt_pk_bf16(b0[0], b0[1]); w.y = cvt_pk_bf16(b0[2], b0[3]); *(u32x2*)(yq + (size_t)128 * D * 2 + vy) = w;
          w.x = cvt_pk_bf16(b1[0], b1[1]); w.y = cvt_pk_bf16(b1[2], b1[3]); *(u32x2*)(yq + (size_t)129 * D * 2 + vy) = w;
          kb += 2048; yq += (size_t)2 * D * 2; } }
    asm volatile("" ::: "memory");
    const float l8r = LAMPg[lane * 8 + 2], l8i = LAMPg[lane * 8 + 3];
    float sr = 0.f, si = 0.f;
    { char* seb = (char*)(SE + ((size_t)(2 * pr) * CG + g) * 16 * 128);
#pragma unroll
      for (int s = 0; s < 16; ++s) { const float er = SbA[s * 128 + lane], ei = SbA[s * 128 + 64 + lane];
          *(float*)(seb + s * 512 + vl) = er; *(float*)(seb + s * 512 + 256 + vl) = ei;
          const float nr = l8r * sr - l8i * si + er, ni = l8r * si + l8i * sr + ei; sr = nr; si = ni; }
      float* dst = SEND + (((size_t)(2 * pr) * CG + g) * 2) * CS + lane; dst[0] = sr; dst[CS] = si; }
    { char* seb = (char*)(SE + ((size_t)(2 * pr + 1) * CG + g) * 16 * 128);
#pragma unroll
      for (int s = 0; s < 16; ++s) { const float er = SbB[s * 128 + lane], ei = SbB[s * 128 + 64 + lane];
          *(float*)(seb + s * 512 + vl) = er; *(float*)(seb + s * 512 + 256 + vl) = ei;
          const float nr = l8r * sr - l8i * si + er, ni = l8r * si + l8i * sr + ei; sr = nr; si = ni; }
      float* dst = SEND2 + (((size_t)pr * CG + g) * 2) * CS + lane; dst[0] = sr; dst[CS] = si; }
    asm volatile("s_waitcnt lgkmcnt(0)" ::: "memory");
}
constexpr int S5_PSG = 133120;
__device__ __forceinline__ void s5_glu(int unit, int wave, int lane, const bf16_t* WGLU, const float* glu_b, const float* mo_gc, bf16_t* Y, LAS unsigned char* lds) {
    const int ln = lane & 15, q = lane >> 4; LAS bf16_t* yst = (LAS bf16_t*)(lds + S5_YST); LAS float* PSg = (LAS float*)(lds + S5_PSG);
    bf16x8 wf[2][8];
    { const char* wb = (const char*)(WGLU + (size_t)(32 * wave) * 256); const unsigned vw = (unsigned)(ln * 256 + 8 * q) * 2u;
#pragma unroll
      for (int j = 0; j < 2; ++j)
#pragma unroll
          for (int ks = 0; ks < 8; ++ks) wf[j][ks] = ldg<bf16x8>(wb + j * 8192 + ks * 64, vw); }
    const f32x4 gb0 = *(const f32x4*)(glu_b + 32 * wave + 4 * q), gb1 = *(const f32x4*)(glu_b + 32 * wave + 16 + 4 * q);
    LAS bf16_t* op = (LAS bf16_t*)(lds + wave * S5_WSCR) + ln * 32 + 4 * q;
    { const LAS bf16_t* yrow = yst + ln * YST_LD; LAS float* psw = PSg + ln * 8 + wave; LAS bf16_t* ow = op;
#pragma unroll 4
      for (int tt = 0; tt < 8; ++tt) {
        f32x4 a0 = (f32x4){0.f, 0.f, 0.f, 0.f}, a1 = (f32x4){0.f, 0.f, 0.f, 0.f};
#pragma unroll
        for (int ks = 0; ks < 8; ++ks) { const bf16x8 yf = *(const LAS bf16x8*)(yrow + 32 * ks + 8 * q); a0 = mfma16(wf[0][ks], yf, a0); a1 = mfma16(wf[1][ks], yf, a1); }
        const u32x2 y0 = *(const LAS u32x2*)(yrow + 32 * wave + 4 * q), y1 = *(const LAS u32x2*)(yrow + 32 * wave + 16 + 4 * q);
        float o[8];
        o[0] = __uint_as_float(y0.x << 16) * sigmoid_fast(a0[0] + gb0[0]); o[1] = __uint_as_float(y0.x & 0xffff0000u) * sigmoid_fast(a0[1] + gb0[1]); o[2] = __uint_as_float(y0.y << 16) * sigmoid_fast(a0[2] + gb0[2]); o[3] = __uint_as_float(y0.y & 0xffff0000u) * sigmoid_fast(a0[3] + gb0[3]);
        o[4] = __uint_as_float(y1.x << 16) * sigmoid_fast(a1[0] + gb1[0]); o[5] = __uint_as_float(y1.x & 0xffff0000u) * sigmoid_fast(a1[1] + gb1[1]); o[6] = __uint_as_float(y1.y << 16) * sigmoid_fast(a1[2] + gb1[2]); o[7] = __uint_as_float(y1.y & 0xffff0000u) * sigmoid_fast(a1[3] + gb1[3]);
        float ss = ((o[0] * o[0] + o[1] * o[1]) + (o[2] * o[2] + o[3] * o[3])) + ((o[4] * o[4] + o[5] * o[5]) + (o[6] * o[6] + o[7] * o[7]));
        ss = add_x16_x32(ss);
        if (q == 0) *psw = ss;
        u32x2 w; w.x = cvt_pk_bf16(o[0], o[1]); w.y = cvt_pk_bf16(o[2], o[3]); *(LAS u32x2*)(ow) = w; w.x = cvt_pk_bf16(o[4], o[5]); w.y = cvt_pk_bf16(o[6], o[7]); *(LAS u32x2*)(ow + 16) = w;
        yrow += 16 * YST_LD; psw += 16 * 8; ow += 16 * 32; } }
    asm volatile("s_waitcnt lgkmcnt(0)" ::: "memory");
    __syncthreads();
    { const int p = lane & 31, rsel = lane >> 5; const f32x4 g0 = *(const f32x4*)(mo_gc + 8 * p), g1 = *(const f32x4*)(mo_gc + 8 * p + 4);
      const LAS unsigned char* src = lds + (p >> 2) * S5_WSCR + (p & 3) * 16; bf16_t* yb = Y + (size_t)(unit * 128) * D + AW + BW + 8 * p;
#pragma unroll 4
      for (int it = 0; it < 8; ++it) { const int row = 16 * wave + 2 * it + rsel; const LAS f32x4* pp = (const LAS f32x4*)(PSg + row * 8); const f32x4 p0 = pp[0], p1 = pp[1];
        const float rs = __builtin_amdgcn_rsqf((((p0[0] + p0[1]) + (p0[2] + p0[3])) + ((p1[0] + p1[1]) + (p1[2] + p1[3]))) * (1.0f / CW) + EPS);
        const u32x4 a = *(const LAS u32x4*)(src + row * 64); u32x4 w;
        w.x = cvt_pk_bf16(__uint_as_float(a.x << 16) * rs * g0[0], __uint_as_float(a.x & 0xffff0000u) * rs * g0[1]); w.y = cvt_pk_bf16(__uint_as_float(a.y << 16) * rs * g0[2], __uint_as_float(a.y & 0xffff0000u) * rs * g0[3]);
        w.z = cvt_pk_bf16(__uint_as_float(a.z << 16) * rs * g1[0], __uint_as_float(a.z & 0xffff0000u) * rs * g1[1]); w.w = cvt_pk_bf16(__uint_as_float(a.w << 16) * rs * g1[2], __uint_as_float(a.w & 0xffff0000u) * rs * g1[3]);
        *(u32x4*)(yb + (size_t)row * D) = w; } }
}

constexpr int XC_LD = 392;
constexpr int RG_XC = 0, RG_PS = 100352, RG_CAR = 112640, RG_RSB = 114176, RG_PT = 114688, RG_HC = 116224;
template <int CTRL> __device__ __forceinline__ float dpp0(float v) { return __int_as_float(__builtin_amdgcn_update_dpp(0, __float_as_int(v), CTRL, 0xf, 0xf, true)); }
template <int CTRL> __device__ __forceinline__ float dppf(float old, float v) { return __int_as_float(__builtin_amdgcn_update_dpp(__float_as_int(old), __float_as_int(v), CTRL, 0xf, 0xf, false)); }
__device__ __forceinline__ void bf8_to_f32(const u32x4 o, float (&v)[8]) {
    v[0] = __uint_as_float(o.x << 16); v[1] = __uint_as_float(o.x & 0xffff0000u); v[2] = __uint_as_float(o.y << 16); v[3] = __uint_as_float(o.y & 0xffff0000u);
    v[4] = __uint_as_float(o.z << 16); v[5] = __uint_as_float(o.z & 0xffff0000u); v[6] = __uint_as_float(o.w << 16); v[7] = __uint_as_float(o.w & 0xffff0000u);
}
__device__ __forceinline__ float bcast15(float v) { return __int_as_float(__builtin_amdgcn_ds_swizzle(__float_as_int(v), 0x1F0)); }
template <int PASS>
__device__ __forceinline__ void rglru_unit(int unit, bool first, float& cprev, int tid, int wave, int lane, const bf16_t* Z, bf16_t* Y, const bf16_t* WRG, const bf16_t* WIG,
                                           const float* conv_w, const float* conv_b, const float* rg_b, const float* ig_b, const float* lam, const float* mo_gb,
                                           float* SUMA, float* SUMH, float* SUMA2, float* SUMH2, bf16_t* HL, bf16_t* PP, LAS unsigned char* lds) {
    LAS bf16_t* xcl = (LAS bf16_t*)(lds + RG_XC); LAS float* PS = (LAS float*)(lds + RG_PS); LAS float* CAR = (LAS float*)(lds + RG_CAR); LAS float* RSB = (LAS float*)(lds + RG_RSB); LAS float* PT = (LAS float*)(lds + RG_PT); LAS float* HC = (LAS float*)(lds + RG_HC);
    const int t0 = unit * 128; const int ln = lane & 15, q = lane >> 4;
    if (tid < 384) {
        const int c0 = (tid % 48) * 8, tg = tid / 48; const int tb = t0 + tg * 16, s0 = tb % SEQ;
        float w0[8], w1[8], w2[8], w3[8], bb[8];
#pragma unroll
        for (int hh = 0; hh < 2; ++hh) { const f32x4 a0 = *(const f32x4*)(conv_w + 0 * BW + c0 + 4 * hh), a1 = *(const f32x4*)(conv_w + 1 * BW + c0 + 4 * hh), a2 = *(const f32x4*)(conv_w + 2 * BW + c0 + 4 * hh), a3 = *(const f32x4*)(conv_w + 3 * BW + c0 + 4 * hh), a4 = *(const f32x4*)(conv_b + c0 + 4 * hh);
#pragma unroll
            for (int j = 0; j < 4; ++j) { w0[4 * hh + j] = a0[j]; w1[4 * hh + j] = a1[j]; w2[4 * hh + j] = a2[j]; w3[4 * hh + j] = a3[j]; bb[4 * hh + j] = a4[j]; } }
        float xm1[8], xm2[8], xm3[8];
        const bf16_t* zp = Z + (size_t)tb * INC + ZX + c0;
        { const u32x4 z4 = {0u, 0u, 0u, 0u}; const u32x4 o1 = s0 >= 1 ? *(const u32x4*)(zp - INC) : z4, o2 = s0 >= 2 ? *(const u32x4*)(zp - 2 * INC) : z4, o3 = s0 >= 3 ? *(const u32x4*)(zp - 3 * INC) : z4;
          bf8_to_f32(o1, xm1); bf8_to_f32(o2, xm2); bf8_to_f32(o3, xm3); }
        LAS bf16_t* xw = xcl + (tg * 16) * XC_LD + c0;
#pragma unroll 4
        for (int i = 0; i < 16; ++i) { float x0[8]; bf8_to_f32(*(const u32x4*)(zp), x0); float v[8];
#pragma unroll
            for (int j = 0; j < 8; ++j) { v[j] = bb[j] + w3[j] * x0[j] + w2[j] * xm1[j] + w1[j] * xm2[j] + w0[j] * xm3[j]; xm3[j] = xm2[j]; xm2[j] = xm1[j]; xm1[j] = x0[j]; }
            u32x4 w; w.x = cvt_pk_bf16(v[0], v[1]); w.y = cvt_pk_bf16(v[2], v[3]); w.z = cvt_pk_bf16(v[4], v[5]); w.w = cvt_pk_bf16(v[6], v[7]);
            *(LAS u32x4*)(xw) = w; zp += INC; xw += XC_LD; }
        if (PASS == 2) { const int c = tid; float h;
            if (first) { const int pr = unit >> 1, p0 = pr - (pr % (UPB128 / 2)); h = 0.f; const float* pa = SUMA2 + (size_t)p0 * BW + c; const float* ph = SUMH2 + (size_t)p0 * BW + c;
#pragma unroll 8
                for (int j = p0; j < pr; ++j) { h = fmaf(*pa, h, *ph); pa += BW; ph += BW; } }
            else h = fmaf(SUMA[(size_t)(unit - 1) * BW + c], cprev, SUMH[(size_t)(unit - 1) * BW + c]);
            cprev = h; CAR[c] = h; }
    }
    __syncthreads();
#pragma unroll 1
    for (int ci = 0; ci < 3; ++ci) {
        const int combo = wave + 8 * ci, h = combo >> 2, jt = combo & 3, cb = h * 64 + jt * 16;
        const bf16_t* wr = WRG + ((size_t)(h * 64 + jt * 16 + ln)) * 64 + 8 * q; const bf16_t* wi = WIG + ((size_t)(h * 64 + jt * 16 + ln)) * 64 + 8 * q;
        const bf16x8 RG0 = *(const bf16x8*)(wr), RG1 = *(const bf16x8*)(wr + 32), IG0 = *(const bf16x8*)(wi), IG1 = *(const bf16x8*)(wi + 32);
        const f32x4 rgb4 = *(const f32x4*)(rg_b + cb + 4 * q), igb4 = *(const f32x4*)(ig_b + cb + 4 * q), lam4 = *(const f32x4*)(lam + cb + 4 * q);
        const float m1 = ln < 1 ? 1.f : 0.f, m2 = ln < 2 ? 1.f : 0.f, m4 = ln < 4 ? 1.f : 0.f, m8 = ln < 8 ? 1.f : 0.f;
        float spc[4], car[4], ptot[4];
#pragma unroll
        for (int r = 0; r < 4; ++r) { spc[r] = -8.0f * 1.4426950408889634f * log1pf(expf(-lam4[r])); car[r] = PASS == 2 ? CAR[cb + 4 * q + r] : (first ? 0.f : HC[cb + 4 * q + r]); ptot[r] = (PASS == 1 && !first) ? PT[cb + 4 * q + r] : 1.f; }
        const LAS bf16_t* xb = xcl + ln * XC_LD + h * 64 + 8 * q; const LAS bf16_t* xv = xcl + ln * XC_LD + cb + 4 * q;
        const bf16_t* zg = Z + (size_t)(t0 + ln) * INC + ZG + cb + 4 * q; bf16_t* yo = Y + (size_t)(t0 + ln) * D + AW + cb + 4 * q; LAS float* psw = PS + ln * 24 + combo;
        bf16_t* hlo = HL + (size_t)(t0 + ln) * BW + cb + 4 * q; bf16_t* ppo = PP + (size_t)(t0 + ln) * BW + cb + 4 * q;
#pragma unroll 1
        for (int tt = 0; tt < 8; ++tt) {
            const bf16x8 B0 = *(const LAS bf16x8*)(xb), B1 = *(const LAS bf16x8*)(xb + 32);
            f32x4 ar = (f32x4){0.f, 0.f, 0.f, 0.f}, ai = (f32x4){0.f, 0.f, 0.f, 0.f};
            ar = mfma16(RG0, B0, ar); ar = mfma16(RG1, B1, ar); ai = mfma16(IG0, B0, ai); ai = mfma16(IG1, B1, ai);
            const u32x2 xq = *(const LAS u32x2*)(xv); float xc4[4] = {__uint_as_float(xq.x << 16), __uint_as_float(xq.x & 0xffff0000u), __uint_as_float(xq.y << 16), __uint_as_float(xq.y & 0xffff0000u)};
            float hv[4], pv[4];
#pragma unroll
            for (int r = 0; r < 4; ++r) {
                const float rr = sigmoid_fast(ar[r] + rgb4[r]), ii = sigmoid_fast(ai[r] + igb4[r]);
                float A = __builtin_amdgcn_exp2f(spc[r] * rr);
                float Bv = __builtin_amdgcn_sqrtf(fmaxf(1.0f - A * A, 0.f)) * (ii * xc4[r]);
                if (ln == 0) { Bv = fmaf(A, car[r], Bv); A *= ptot[r]; }
                { const float As = dpp0<0x111>(A) + m1, Bs = dpp0<0x111>(Bv); Bv = fmaf(A, Bs, Bv); A *= As; }
                { const float As = dpp0<0x112>(A) + m2, Bs = dpp0<0x112>(Bv); Bv = fmaf(A, Bs, Bv); A *= As; }
                { const float As = dpp0<0x114>(A) + m4, Bs = dpp0<0x114>(Bv); Bv = fmaf(A, Bs, Bv); A *= As; }
                { const float As = dpp0<0x118>(A) + m8, Bs = dpp0<0x118>(Bv); Bv = fmaf(A, Bs, Bv); A *= As; }
                hv[r] = Bv; pv[r] = A; car[r] = dppf<0x121>(Bv, Bv); ptot[r] = dppf<0x121>(A, A);
            }
            if (PASS == 1) { u32x2 w; w.x = cvt_pk_bf16(hv[0], hv[1]); w.y = cvt_pk_bf16(hv[2], hv[3]); *(u32x2*)(hlo) = w; w.x = cvt_pk_bf16(pv[0], pv[1]); w.y = cvt_pk_bf16(pv[2], pv[3]); *(u32x2*)(ppo) = w; hlo += 16 * BW; ppo += 16 * BW; }
            if (PASS == 2) { const u32x2 gq = *(const u32x2*)(zg);
                const float y0 = hv[0] * __uint_as_float(gq.x << 16), y1 = hv[1] * __uint_as_float(gq.x & 0xffff0000u), y2 = hv[2] * __uint_as_float(gq.y << 16), y3 = hv[3] * __uint_as_float(gq.y & 0xffff0000u);
                u32x2 w; w.x = cvt_pk_bf16(y0, y1); w.y = cvt_pk_bf16(y2, y3); *(u32x2*)(yo) = w;
                float ss = (y0 * y0 + y1 * y1) + (y2 * y2 + y3 * y3); ss += __shfl_xor(ss, 16); ss += __shfl_xor(ss, 32);
                if (q == 0) *psw = ss; }
            xb += 16 * XC_LD; xv += 16 * XC_LD; zg += 16 * INC; yo += 16 * D; psw += 16 * 24;
        }
        if (PASS == 1 && ln == 0) {
            float* da = first ? SUMA + (size_t)unit * BW : SUMA2 + (size_t)(unit >> 1) * BW; float* dh = first ? SUMH + (size_t)unit * BW : SUMH2 + (size_t)(unit >> 1) * BW;
#pragma unroll
            for (int r = 0; r < 4; ++r) { da[cb + 4 * q + r] = ptot[r]; dh[cb + 4 * q + r] = car[r]; if (first) { PT[cb + 4 * q + r] = ptot[r]; HC[cb + 4 * q + r] = car[r]; } } }
    }
    if (PASS == 2) {
        asm volatile("s_waitcnt vmcnt(0)" ::: "memory");
        __syncthreads();
        if (tid < 128) { float s = 0.f;
#pragma unroll
            for (int k = 0; k < 24; ++k) s += PS[tid * 24 + k];
            RSB[tid] = __builtin_amdgcn_rsqf(s * (1.0f / BW) + EPS); }
        __syncthreads();
#pragma unroll 2
        for (int k = 0; k < 12; ++k) { const int idx = tid + 512 * k, tl = idx / 48, c0 = (idx % 48) * 8; const float rs = RSB[tl];
            bf16_t* yp = Y + (size_t)(t0 + tl) * D + AW + c0; float v[8]; bf8_to_f32(*(const u32x4*)(yp), v);
            const f32x4 g0 = *(const f32x4*)(mo_gb + c0), g1 = *(const f32x4*)(mo_gb + c0 + 4);
            u32x4 w; w.x = cvt_pk_bf16(v[0] * rs * g0[0], v[1] * rs * g0[1]); w.y = cvt_pk_bf16(v[2] * rs * g0[2], v[3] * rs * g0[3]); w.z = cvt_pk_bf16(v[4] * rs * g1[0], v[5] * rs * g1[1]); w.w = cvt_pk_bf16(v[6] * rs * g1[2], v[7] * rs * g1[3]);
            *(u32x4*)(yp) = w; }
    }
    __syncthreads();
}

__device__ __forceinline__ void rglru_fix_pair(int pr, int tid, int wave, int lane, const bf16_t* Z, bf16_t* Y, const bf16_t* HL, const bf16_t* PP, const float* SUMA2, const float* SUMH2, const float* mo_gb, LAS unsigned char* lds) {
    LAS float* CAR = (LAS float*)(lds + RG_CAR);
    if (tid < 384) { const int c = tid, p0 = pr - (pr % (UPB128 / 2)); float h = 0.f; const float* pa = SUMA2 + (size_t)p0 * BW + c; const float* ph = SUMH2 + (size_t)p0 * BW + c;
#pragma unroll 8
        for (int j = p0; j < pr; ++j) { h = fmaf(*pa, h, *ph); pa += BW; ph += BW; }
        CAR[c] = h; }
    __syncthreads();
    {
        typedef unsigned u32x3 __attribute__((ext_vector_type(3)));
        const int c0 = lane * 6; float hin[6], gch[6];
#pragma unroll
        for (int e = 0; e < 6; ++e) { hin[e] = CAR[c0 + e]; gch[e] = mo_gb[c0 + e]; }
#pragma unroll 2
        for (int i = 0; i < 32; ++i) { const size_t t = (size_t)pr * 256 + wave * 32 + i;
            const u32x3 h3 = *(const u32x3*)(HL + t * BW + c0), p3 = *(const u32x3*)(PP + t * BW + c0), g3 = *(const u32x3*)(Z + t * INC + ZG + c0);
            float y[6]; float ss = 0.f;
#pragma unroll
            for (int e = 0; e < 3; ++e) { const unsigned hh = h3[e], pq = p3[e], gq = g3[e];
                y[2 * e] = fmaf(__uint_as_float(pq << 16), hin[2 * e], __uint_as_float(hh << 16)) * gelu_fast(__uint_as_float(gq << 16));
                y[2 * e + 1] = fmaf(__uint_as_float(pq & 0xffff0000u), hin[2 * e + 1], __uint_as_float(hh & 0xffff0000u)) * gelu_fast(__uint_as_float(gq & 0xffff0000u));
                ss += y[2 * e] * y[2 * e] + y[2 * e + 1] * y[2 * e + 1]; }
            ss = wave_sum(ss);
            const float rs = __builtin_amdgcn_rsqf(ss * (1.0f / BW) + EPS);
            u32x3 w; w.x = cvt_pk_bf16(y[0] * rs * gch[0], y[1] * rs * gch[1]); w.y = cvt_pk_bf16(y[2] * rs * gch[2], y[3] * rs * gch[3]); w.z = cvt_pk_bf16(y[4] * rs * gch[4], y[5] * rs * gch[5]);
            *(u32x3*)(Y + t * D + AW + c0) = w; }
    }
    __syncthreads();
}

constexpr int VT_LD = 136;
__device__ __forceinline__ void mixa_unit(int unit, int tid, int wave, int lane, const bf16_t* Z, bf16_t* Y, const bf16_t* WSP, const float* a_sb, const float* vg, const float* mo_ga, LAS unsigned char* lds) {
    LAS bf16_t* vT = (LAS bf16_t*)lds; const int t0 = unit * 128; const int ln = lane & 15, q = lane >> 4;
    { const int j = tid >> 2, part = tid & 3; const bf16_t* zp = Z + (size_t)(t0 + j) * INC + ZV + part * 8;
      u32x4 raw[12]; float ss = 0.f;
#pragma unroll
      for (int k = 0; k < 12; ++k) { const u32x4 rw = *(const u32x4*)(zp + 32 * k); float v[8]; bf8_to_f32(rw, v);
#pragma unroll
          for (int e = 0; e < 8; ++e) { v[e] = gelu_fast(v[e]); ss += v[e] * v[e]; }
          raw[k].x = cvt_pk_bf16(v[0], v[1]); raw[k].y = cvt_pk_bf16(v[2], v[3]); raw[k].z = cvt_pk_bf16(v[4], v[5]); raw[k].w = cvt_pk_bf16(v[6], v[7]); }
      ss += x_xor1(ss); ss += x_xor2(ss);
      const float rs = __builtin_amdgcn_rsqf(ss * (1.0f / AW) + EPS);
      LAS bf16_t* vw = vT + (part * 8) * VT_LD + j; const float* gp = vg + part * 8;
#pragma unroll
      for (int k = 0; k < 12; ++k) { float v[8]; bf8_to_f32(raw[k], v); const f32x4 g0 = *(const f32x4*)(gp + 32 * k), g1 = *(const f32x4*)(gp + 32 * k + 4);
#pragma unroll
          for (int e = 0; e < 8; ++e) vw[(32 * k + e) * VT_LD] = f2bf(v[e] * rs * (e < 4 ? g0[e] : g1[e - 4])); } }
    __syncthreads();
    const bool full = wave >= 4;
    float ss = 0.f;
    const int tl = 16 * wave + ln;
    const char* ub = (const char*)(Z + (size_t)t0 * INC + ZU); const unsigned vu = (unsigned)(tl * INC + 4 * q) * 2u;
    const char* wb = (const char*)WSP; const unsigned vw = (unsigned)(tl * 128 + 8 * q) * 2u;
    const bf16x8 z8 = {0, 0, 0, 0, 0, 0, 0, 0};
    bf16x8 Wn0 = ldg<bf16x8>(wb, vw), Wn1 = ldg<bf16x8>(wb + 64, vw), Wn2 = z8, Wn3 = z8;
    if (full) { Wn2 = ldg<bf16x8>(wb + 128, vw); Wn3 = ldg<bf16x8>(wb + 192, vw); }
    u32x2 un0 = ldg<u32x2>(ub, vu), un1 = ldg<u32x2>(ub + 32, vu), un2 = ldg<u32x2>(ub + 64, vu), un3 = ldg<u32x2>(ub + 96, vu); float bn = a_sb[tl];
    const LAS bf16_t* ap = vT + ln * VT_LD + 8 * q;
    u32x2 val[24];
#pragma unroll
    for (int h = 0; h < 6; ++h) {
        const bf16x8 W0 = Wn0, W1 = Wn1, W2 = Wn2, W3 = Wn3; const u32x2 uc[4] = {un0, un1, un2, un3}; const float b = bn;
        if (h < 5) { const char* wq = wb + (size_t)(h + 1) * 128 * 128 * 2; const char* uq2 = ub + (h + 1) * 128;
            Wn0 = ldg<bf16x8>(wq, vw); Wn1 = ldg<bf16x8>(wq + 64, vw); if (full) { Wn2 = ldg<bf16x8>(wq + 128, vw); Wn3 = ldg<bf16x8>(wq + 192, vw); }
            un0 = ldg<u32x2>(uq2, vu); un1 = ldg<u32x2>(uq2 + 32, vu); un2 = ldg<u32x2>(uq2 + 64, vu); un3 = ldg<u32x2>(uq2 + 96, vu); bn = a_sb[(h + 1) * 128 + tl]; }
        asm volatile("" ::: "memory");
#pragma unroll
        for (int dt = 0; dt < 4; ++dt) { f32x4 acc = (f32x4){0.f, 0.f, 0.f, 0.f};
            const LAS bf16_t* aq = ap + (h * 64 + 16 * dt) * VT_LD;
            const bf16x8 a0 = *(const LAS bf16x8*)(aq), a1 = *(const LAS bf16x8*)(aq + 32), a2 = *(const LAS bf16x8*)(aq + 64), a3 = *(const LAS bf16x8*)(aq + 96);
            acc = mfma16(a0, W0, acc); acc = mfma16(a1, W1, acc); acc = mfma16(a2, W2, acc); acc = mfma16(a3, W3, acc);
            const u32x2 u2 = uc[dt];
            const float v0 = gelu_fast(__uint_as_float(u2.x << 16)) * (acc[0] + b), v1 = gelu_fast(__uint_as_float(u2.x & 0xffff0000u)) * (acc[1] + b), v2 = gelu_fast(__uint_as_float(u2.y << 16)) * (acc[2] + b), v3 = gelu_fast(__uint_as_float(u2.y & 0xffff0000u)) * (acc[3] + b);
            ss += (v0 * v0 + v1 * v1) + (v2 * v2 + v3 * v3);
            u32x2 pk; pk.x = cvt_pk_bf16(v0, v1); pk.y = cvt_pk_bf16(v2, v3); val[h * 4 + dt] = pk; }
    }
    ss = add_x16_x32(ss);
    const float rs = __builtin_amdgcn_rsqf(ss * (1.0f / AW) + EPS);
    __syncthreads();
    { LAS unsigned char* scr = lds + wave * (16 * 784);
      const char* gb = (const char*)mo_ga; const unsigned vg4 = (unsigned)(4 * q) * 4u; LAS unsigned char* sw = scr + ln * 784 + q * 8;
#pragma unroll
      for (int k = 0; k < 24; ++k) { const f32x4 gg = ldg<f32x4>(gb + k * 64, vg4); const u32x2 pk = val[k];
          u32x2 w; w.x = cvt_pk_bf16(__uint_as_float(pk.x << 16) * rs * gg[0], __uint_as_float(pk.x & 0xffff0000u) * rs * gg[1]); w.y = cvt_pk_bf16(__uint_as_float(pk.y << 16) * rs * gg[2], __uint_as_float(pk.y & 0xffff0000u) * rs * gg[3]);
          *(LAS u32x2*)(sw + k * 32) = w; }
      asm volatile("s_waitcnt lgkmcnt(0)" ::: "memory");
      bf16_t* yr = Y + (size_t)(t0 + 16 * wave) * D;
      { int row = lane >= 48 ? 1 : 0, cp = lane >= 48 ? lane - 48 : lane;
#pragma unroll 2
        for (int i = 0; i < 12; ++i) { const unsigned so = (unsigned)(row * 784 + cp * 16), go = (unsigned)(row * D + cp * 8) * 2u;
            const u32x4 v = *(const LAS u32x4*)(scr + so); *(u32x4*)((char*)yr + go) = v;
            cp += 16; row += 1; if (cp >= 48) { cp -= 48; row += 1; } } } }
    __syncthreads();
}

__device__ __forceinline__ void router_unit(int unit, int wave, int lane, const bf16_t* HB, const float* SSQ, const bf16_t* WRT, const float* rgb, const float* reb,
                                            int* CLS, float* G2, LAS unsigned char* lds, LAS int* hist) {
    const int ln = lane & 15, q = lane >> 4; const int t0 = unit * UT + wave * 32;
    LAS float* LG = (LAS float*)(lds + wave * 8192);
    f32x4 acc[2][3];
#pragma unroll
    for (int tt = 0; tt < 2; ++tt)
#pragma unroll
        for (int j = 0; j < 3; ++j) acc[tt][j] = (f32x4){0.f, 0.f, 0.f, 0.f};
    const bf16_t* hp0 = HB + (size_t)(t0 + ln) * D + 8 * q; const bf16_t* hp1 = hp0 + (size_t)16 * D; const bf16_t* wp = WRT + (size_t)ln * D + 8 * q;
#pragma unroll 4
    for (int ks = 0; ks < 32; ++ks) {
        const bf16x8 b0 = *(const bf16x8*)(hp0), b1 = *(const bf16x8*)(hp1);
        const bf16x8 a0 = *(const bf16x8*)(wp), a1 = *(const bf16x8*)(wp + 16 * D), a2 = *(const bf16x8*)(wp + 32 * D);
        acc[0][0] = mfma16(a0, b0, acc[0][0]); acc[0][1] = mfma16(a1, b0, acc[0][1]); acc[0][2] = mfma16(a2, b0, acc[0][2]);
        acc[1][0] = mfma16(a0, b1, acc[1][0]); acc[1][1] = mfma16(a1, b1, acc[1][1]); acc[1][2] = mfma16(a2, b1, acc[1][2]);
        hp0 += 32; hp1 += 32; wp += 32; }
#pragma unroll
    for (int tt = 0; tt < 2; ++tt)
#pragma unroll
        for (int j = 0; j < 3; ++j) *(LAS f32x4*)(LG + (16 * tt + ln) * 48 + 16 * j + 4 * q) = acc[tt][j];
    asm volatile("s_waitcnt lgkmcnt(0)" ::: "memory");
    if (lane < 32) { const int t = t0 + lane; const LAS float* lg = LG + lane * 48;
        const f32x4* sp = (const f32x4*)(SSQ + (size_t)t * 16); const f32x4 s0 = sp[0], s1 = sp[1], s2 = sp[2], s3 = sp[3];
        const float sq = ((s0[0] + s0[1]) + (s0[2] + s0[3])) + ((s1[0] + s1[1]) + (s1[2] + s1[3])) + ((s2[0] + s2[1]) + (s2[2] + s2[3])) + ((s3[0] + s3[1]) + (s3[2] + s3[3]));
        const float r = rsqrtf(sq * (1.0f / D) + EPS);
        float gl[4];
#pragma unroll
        for (int j = 0; j < 4; ++j) gl[j] = r * (lg[j] + lg[16 + j]) + rgb[j];
        int gs = 0; float gm = gl[0];
#pragma unroll
        for (int j = 1; j < 4; ++j) if (gl[j] > gm) { gm = gl[j]; gs = j; }
        float den = 0.f;
#pragma unroll
        for (int j = 0; j < 4; ++j) den += expf(gl[j] - gm);
        const float gwt = 1.0f / den;
        float el[4];
#pragma unroll
        for (int j = 0; j < 4; ++j) { float v;
            if (gs < 3) v = lg[4 + 4 * gs + j] + lg[16 + 4 + 4 * gs + j]; else v = lg[32 + j] + lg[36 + j];
            el[j] = r * v + reb[gs * 4 + j]; }
        int i0 = 0; float v0 = el[0];
#pragma unroll
        for (int j = 1; j < 4; ++j) if (el[j] > v0) { v0 = el[j]; i0 = j; }
        int i1 = 0; float v1 = -3.0e38f;
#pragma unroll
        for (int j = 0; j < 4; ++j) if (j != i0 && el[j] > v1) { v1 = el[j]; i1 = j; }
        const float e1 = expf(v1 - v0); const float w0 = gwt / (1.0f + e1), w1 = gwt * e1 / (1.0f + e1);
        const int lo = i0 < i1 ? i0 : i1, hi = i0 < i1 ? i1 : i0; const int cls = gs * 6 + pair_idx(lo, hi);
        CLS[t] = cls; G2[(size_t)t * 2 + 0] = i0 < i1 ? w0 : w1; G2[(size_t)t * 2 + 1] = i0 < i1 ? w1 : w0;
        __hip_atomic_fetch_add(hist + cls, 1, __ATOMIC_RELAXED, __HIP_MEMORY_SCOPE_WORKGROUP); }
}

__device__ __forceinline__ void tr_item8(const float* W, int ldw, int k0, int scol0, unsigned char* WT, int ldo, int drow0, int dk0, LAS float* scr, int lane) {
#pragma unroll 8
    for (int i = 0; i < 32; ++i) { const int kk = 2 * i + (lane >> 5); scr[kk * 33 + (lane & 31)] = W[(size_t)(k0 + kk) * ldw + scol0 + (lane & 31)] * pg8::FS_W; }
    asm volatile("s_waitcnt lgkmcnt(0)" ::: "memory");
    const int c = lane & 7;
#pragma unroll
    for (int j = 0; j < 4; ++j) { const int n = (lane >> 3) + 8 * j; const LAS float* s = scr + (8 * c) * 33 + n;
        u32x2 o; o.x = pk_fp8x4(s[0 * 33], s[1 * 33], s[2 * 33], s[3 * 33]); o.y = pk_fp8x4(s[4 * 33], s[5 * 33], s[6 * 33], s[7 * 33]);
        *(u32x2*)(WT + (size_t)(drow0 + n) * ldo + dk0 + 8 * c) = o; }
    asm volatile("s_waitcnt lgkmcnt(0)" ::: "memory");
}
struct TrP { const float* src; const float* gk; unsigned char* dst; int ldw, ldo, fp8; };
__device__ __forceinline__ void tr_load(const TrP& P, int lane, float (&v)[32]) {
#pragma unroll
    for (int i = 0; i < 8; ++i) { const int kk = 8 * i + (lane >> 3); f32x4 x = *(const f32x4*)(P.src + (size_t)kk * P.ldw + 4 * (lane & 7)); if (P.gk) x *= P.gk[kk]; v[4 * i] = x[0]; v[4 * i + 1] = x[1]; v[4 * i + 2] = x[2]; v[4 * i + 3] = x[3]; }
}
__device__ __forceinline__ void tr_store(const TrP& P, int lane, const float (&v)[32], LAS float* scr) {
    const float sc = P.fp8 ? pg8::FS_W : 1.0f;
#pragma unroll
    for (int i = 0; i < 8; ++i)
#pragma unroll
        for (int e = 0; e < 4; ++e) scr[(8 * i + (lane >> 3)) * 33 + 4 * (lane & 7) + e] = v[4 * i + e] * sc;
    asm volatile("s_waitcnt lgkmcnt(0)" ::: "memory");
    const int c = lane & 7;
#pragma unroll
    for (int j = 0; j < 4; ++j) { const int n = (lane >> 3) + 8 * j; const LAS float* s = scr + (8 * c) * 33 + n;
        if (P.fp8) { u32x2 o; o.x = pk_fp8x4(s[0 * 33], s[1 * 33], s[2 * 33], s[3 * 33]); o.y = pk_fp8x4(s[4 * 33], s[5 * 33], s[6 * 33], s[7 * 33]); *(u32x2*)(P.dst + (size_t)n * P.ldo + 8 * c) = o; }
        else { u32x4 o; o.x = cvt_pk_bf16(s[0 * 33], s[1 * 33]); o.y = cvt_pk_bf16(s[2 * 33], s[3 * 33]); o.z = cvt_pk_bf16(s[4 * 33], s[5 * 33]); o.w = cvt_pk_bf16(s[6 * 33], s[7 * 33]); *(u32x4*)(P.dst + (size_t)n * P.ldo + 16 * c) = o; } }
    asm volatile("s_waitcnt lgkmcnt(0)" ::: "memory");
}
struct Args { const float* in[34]; float* out; unsigned char* ws; };

__global__ void __launch_bounds__(512, 2) mega_fwd(Args a) {
    extern __shared__ __attribute__((aligned(16))) unsigned char lds_raw[];
    LAS unsigned char* lds = (LAS unsigned char*)lds_raw;
    volatile LAS unsigned* LW = (volatile LAS unsigned*)(lds + LDSCTL_OFF);
    volatile LAS int* LWI = (volatile LAS int*)(lds + LDSCTL_OFF);
    const int G = gridDim.x, bid0 = blockIdx.x; const int wave_s0 = __builtin_amdgcn_readfirstlane(threadIdx.x >> 6);
#define PHASE_IDS() int wv_ = wave_s0, bd_ = bid0; asm volatile("" : "+s"(wv_), "+s"(bd_)); const int wave_s = wv_, bid = bd_;     \
    const int lane = fresh_lane(), wave = wave_s, tid = wave * 64 + lane; const int gw = bid * 8 + wave, NGW = G * 8; \
    const size_t gt = (size_t)bid * 512 + tid, NGT = (size_t)G * 512; (void)lane; (void)wave; (void)gw; (void)NGW; (void)gt; (void)NGT
#define WSB() ({ unsigned char* _w = a.ws; asm volatile("" : "+s"(_w)); _w; })
#define INP(i) ({ int _k = (i); asm volatile("" : "+s"(_k)); a.in[_k]; })
    for (int u = threadIdx.x; u < (LDS_PF - LDSCTL_OFF) / 4; u += 512) LW[u] = 0u;
    __syncthreads();
    XcdBarrier bar = xcd_barrier_post((unsigned*)(a.ws + WS_CTL) + CW_BAR, LW + LW_BAR);

    {
        PHASE_IDS(); unsigned char* ws = WSB(); bf16_t* WIN = (bf16_t*)(ws + WS_WIN); bf16_t* WOUT = (bf16_t*)(ws + WS_WOUT); bf16_t* WGU = (bf16_t*)(ws + WS_WGU); bf16_t* WD2 = (bf16_t*)(ws + WS_WD2);
        bf16_t* HB = (bf16_t*)(ws + WS_HB); float* SSQ = (float*)(ws + WS_SSQ);
        LAS float* scr = (LAS float*)(lds + wave * 16384);
        constexpr int I_IN = 16 * 56, I_OUT = 16 * 32, I_GU = 2 * 16 * 256, I_D8 = 16 * 256, I_GLU = 32, I_RG = 24, I_L = I_IN + I_OUT + I_GU + I_D8 + I_GLU + I_RG;
        const float* i_win = INP(2); const float* i_g = INP(1); const float* i_wout = INP(24); const float* i_wg = INP(30); const float* i_wu = INP(31); const float* i_wd = INP(32);
        const float* i_glu = INP(21); const float* i_rg = INP(8); const float* i_ig = INP(10);
#define TR_DECODE(P, it) do { const int l = (it) / I_L; int r = (it) % I_L; P.gk = nullptr; P.fp8 = 0; \
            if (r < I_IN) { const int kb = r / 56, nb = r % 56, j0 = nb * 32; const int sc = j0 < 768 ? j0 : (j0 < 1152 ? j0 + 384 : (j0 < 1536 ? j0 - 384 : j0));     \
                P.src = i_win + (size_t)l * D * INC + (size_t)kb * 64 * INC + sc; P.ldw = INC; P.gk = i_g + (size_t)l * D + kb * 64; P.dst = (unsigned char*)(WIN + (size_t)l * INC * D + (size_t)j0 * D + kb * 64); P.ldo = D * 2; } \
            else if ((r -= I_IN) < I_OUT) { const int kb = r / 32, nb = r % 32; P.src = i_wout + (size_t)l * D * D + (size_t)kb * 64 * D + nb * 32; P.ldw = D; P.dst = (unsigned char*)(WOUT + (size_t)l * D * D + (size_t)nb * 32 * D + kb * 64); P.ldo = D * 2; } \
            else if ((r -= I_OUT) < I_GU) { const int which = r / (16 * 256), e = (r / 256) % 16, q = r % 256, kb = q / 16, nb = q % 16, n0 = nb * 32;     \
                P.src = (which ? i_wu : i_wg) + ((size_t)l * NE + e) * D * DE + (size_t)kb * 64 * DE + n0; P.ldw = DE; P.fp8 = 1; \
                P.dst = (unsigned char*)WGU + ((size_t)l * NE + e) * 1024 * 1024 + (size_t)((n0 / 128) * 256 + which * 128 + (n0 % 128)) * 1024 + kb * 64; P.ldo = 1024; } \
            else if ((r -= I_GU) < I_D8) { const int e = r / 256, q = r % 256, kb = q / 32, nb = q % 32;        \
                P.src = i_wd + ((size_t)l * NE + e) * DE * D + (size_t)kb * 64 * D + nb * 32; P.ldw = D; P.fp8 = 1; P.dst = ws + WS_WD8 + ((size_t)l * NE + e) * 1024 * 512 + (size_t)nb * 32 * 512 + kb * 64; P.ldo = 512; } \
            else if ((r -= I_D8) < I_GLU) { const int kb = r / 8, nb = r % 8; P.src = i_glu + (size_t)l * CW * CW + (size_t)kb * 64 * CW + nb * 32; P.ldw = CW; P.dst = (unsigned char*)((bf16_t*)(ws + WS_WGLU) + (size_t)l * CW * CW + (size_t)nb * 32 * CW + kb * 64); P.ldo = CW * 2; } \
            else { r -= I_GLU; const int gate = r / 12, h = (r / 2) % 6, nb = r & 1; \
                P.src = (gate ? i_ig : i_rg) + ((size_t)l * 6 + h) * 64 * 64 + nb * 32; P.ldw = 64; P.dst = (unsigned char*)((bf16_t*)(ws + WS_WRG) + (((size_t)l * 2 + gate) * 6 + h) * 64 * 64 + (size_t)nb * 32 * 64); P.ldo = 64 * 2; } } while (0)
        { TrP Pa, Pb; float va[32], vb[32]; int it = gw;
          if (it < 2 * I_L) { TR_DECODE(Pa, it); tr_load(Pa, lane, va); }
#pragma unroll 1
          while (it < 2 * I_L) {
              const int it1 = it + NGW; if (it1 < 2 * I_L) { TR_DECODE(Pb, it1); tr_load(Pb, lane, vb); }
              tr_store(Pa, lane, va, scr);
              if (it1 >= 2 * I_L) break;
              const int it2 = it1 + NGW; if (it2 < 2 * I_L) { TR_DECODE(Pa, it2); tr_load(Pa, lane, va); }
              tr_store(Pb, lane, vb, scr);
              it = it2; } }
#undef TR_DECODE
        { const float* s_are = INP(13); const float* s_aim = INP(14); const float* s_ldt = INP(15); const float* s_bre = INP(16); const float* s_bim = INP(17); const float* s_cre = INP(18); const float* s_cim = INP(19); const float* s_d = INP(20);
          for (size_t e = gt; e < (size_t)2 * CG * 256; e += NGT) { const int l = (int)(e / (CG * 256)), g = (int)((e / 256) % CG), c = (int)((e >> 4) & 15), cp = (int)(e & 15);
              s5_kt_pair(g, c, cp, s_are + (size_t)l * CG * CS, s_aim + (size_t)l * CG * CS, s_ldt + (size_t)l * CG, s_bre + (size_t)l * CG * CS * CGD, s_bim + (size_t)l * CG * CS * CGD,
                         s_cre + (size_t)l * CG * CGD * CS, s_cim + (size_t)l * CG * CGD * CS, s_d + (size_t)l * CW, ws + WS_S5 + (size_t)l * S5_L_STRIDE); }
          for (size_t e = gt; e < (size_t)2 * CG * 2048; e += NGT) { const int l = (int)(e / (CG * 2048)), g = (int)((e / 2048) % CG), r = (int)(e & 2047);
              s5_et_task(g, r >> 10, (r >> 4) & 63, r & 15, s_are + (size_t)l * CG * CS, s_aim + (size_t)l * CG * CS, s_ldt + (size_t)l * CG, s_bre + (size_t)l * CG * CS * CGD, s_bim + (size_t)l * CG * CS * CGD, ws + WS_S5 + (size_t)l * S5_L_STRIDE);
              s5_ft_task(g, r >> 7, (r >> 6) & 1, r & 63, s_are + (size_t)l * CG * CS, s_aim + (size_t)l * CG * CS, s_ldt + (size_t)l * CG, s_cre + (size_t)l * CG * CGD * CS, s_cim + (size_t)l * CG * CGD * CS, ws + WS_S5 + (size_t)l * S5_L_STRIDE); }
          for (size_t e = gt; e < (size_t)2 * CG * 64; e += NGT) { const int l = (int)(e / (CG * 64)), g = (int)((e / 64) % CG), el = 4096 + 32768 + (int)(e % 64);
              s5_table_elem(g, el, s_are + (size_t)l * CG * CS, s_aim + (size_t)l * CG * CS, s_ldt + (size_t)l * CG, s_bre + (size_t)l * CG * CS * CGD, s_bim + (size_t)l * CG * CS * CGD,
                            s_cre + (size_t)l * CG * CGD * CS, s_cim + (size_t)l * CG * CGD * CS, s_d + (size_t)l * CW, ws + WS_S5 + (size_t)l * S5_L_STRIDE); } }
        { const float* sw = INP(4); bf16_t* wsp = (bf16_t*)(ws + WS_WSP); for (size_t e = gt; e < (size_t)2 * 6 * 128 * 128; e += NGT) wsp[e] = f2bf(sw[e]); }
        { const float* fg = INP(25); const float* rgw = INP(26); const float* rew = INP(28); bf16_t* wrt = (bf16_t*)(ws + WS_WRT);
          for (size_t e = gt; e < (size_t)2 * 48 * D; e += NGT) { const int l = (int)(e / (48 * D)), n = (int)((e / D) % 48), k = (int)(e % D);
              int j = -1, lo = 0; if (n < 16) j = n; else if (n < 32) { j = n - 16; lo = 1; } else if (n < 36) j = 16 + (n - 32); else if (n < 40) { j = 16 + (n - 36); lo = 1; }
              float v = 0.f;
              if (j >= 0) { const float w = fg[(size_t)l * D + k] * (j < 4 ? rgw[((size_t)l * D + k) * 4 + j] : rew[(((size_t)l * 4 + ((j - 4) >> 2)) * D + k) * 4 + ((j - 4) & 3)]);
                  const float hi = bf2f(f2bf(w)); v = lo ? (w - hi) : w; }
              wrt[e] = f2bf(v); } }
        const float* xin = INP(0);
#pragma unroll 1
        for (int t = gw * 2; t < T; t += NGW * 2) {
            const f32x4* xr = (const f32x4*)(xin + (size_t)t * D) + lane; f32x4 v[2][4]; float s0 = 0.f, s1 = 0.f;
#pragma unroll
            for (int j = 0; j < 4; ++j) { v[0][j] = xr[64 * j]; v[1][j] = xr[256 + 64 * j]; }
#pragma unroll
            for (int j = 0; j < 4; ++j) { s0 += (v[0][j][0] * v[0][j][0] + v[0][j][1] * v[0][j][1]) + (v[0][j][2] * v[0][j][2] + v[0][j][3] * v[0][j][3]); s1 += (v[1][j][0] * v[1][j][0] + v[1][j][1] * v[1][j][1]) + (v[1][j][2] * v[1][j][2] + v[1][j][3] * v[1][j][3]); }
            u32x2* o8 = (u32x2*)(HB + (size_t)t * D) + lane;
#pragma unroll
            for (int j = 0; j < 4; ++j) { u32x2 w; w.x = cvt_pk_bf16(v[0][j][0], v[0][j][1]); w.y = cvt_pk_bf16(v[0][j][2], v[0][j][3]); o8[64 * j] = w; w.x = cvt_pk_bf16(v[1][j][0], v[1][j][1]); w.y = cvt_pk_bf16(v[1][j][2], v[1][j][3]); o8[256 + 64 * j] = w; }
            s0 = wave_sum(s0); s1 = wave_sum(s1);
            if (lane < 32) SSQ[(size_t)t * 16 + lane] = lane == 0 ? s0 : (lane == 16 ? s1 : 0.f);
        }
    }
    xcd_barrier(bar);

    for (int l = 0; l < DEPTH; ++l) {
        { PHASE_IDS(); unsigned char* ws = WSB(); bf16_t* WIN = (bf16_t*)(ws + WS_WIN); bf16_t* HB = (bf16_t*)(ws + WS_HB); float* SSQ = (float*)(ws + WS_SSQ); bf16_t* Z = (bf16_t*)(ws + WS_Z);
          pg8::StaticOrder<T, INC> S; S.init(HB, WIN + (size_t)l * INC * D, G, bid);
          pg8::EpiZ E{Z, SSQ, lds + LDS_PF};
          pg8::gemm_phase<pg8::EpiZ, pg8::StaticOrder<T, INC>, true, true>(lds, wave_s, S, E); }
        xcd_barrier(bar);

        {
            PHASE_IDS(); unsigned char* ws = WSB(); const bf16_t* Z = (const bf16_t*)(ws + WS_Z);
            const float* conv_w = INP(6) + (size_t)l * 4 * BW; const float* conv_b = INP(7) + (size_t)l * BW; const float* rg_b = INP(9) + (size_t)l * BW;
            const float* ig_b = INP(11) + (size_t)l * BW; const float* lam = INP(12) + (size_t)l * BW;
            __syncthreads();
            { const bf16_t* WRG = (const bf16_t*)(ws + WS_WRG) + ((size_t)l * 2 + 0) * 6 * 4096; const bf16_t* WIG = (const bf16_t*)(ws + WS_WRG) + ((size_t)l * 2 + 1) * 6 * 4096;
              for (int pr = bid; pr < NU128 / 2; pr += G) { float cp = 0.f;
                  rglru_unit<1>(2 * pr, true, cp, tid, wave, lane, Z, nullptr, WRG, WIG, conv_w, conv_b, rg_b, ig_b, lam, nullptr, (float*)(ws + WS_SUMA), (float*)(ws + WS_SUMH), (float*)(ws + WS_SUMA2), (float*)(ws + WS_SUMH2), (bf16_t*)(ws + WS_HL), (bf16_t*)(ws + WS_PP), lds);
                  rglru_unit<1>(2 * pr + 1, false, cp, tid, wave, lane, Z, nullptr, WRG, WIG, conv_w, conv_b, rg_b, ig_b, lam, nullptr, (float*)(ws + WS_SUMA), (float*)(ws + WS_SUMH), (float*)(ws + WS_SUMA2), (float*)(ws + WS_SUMH2), (bf16_t*)(ws + WS_HL), (bf16_t*)(ws + WS_PP), lds); } }
            for (int pr = bid; pr < NU128 / 2; pr += G) { const unsigned char* tab = ws + WS_S5 + (size_t)l * S5_L_STRIDE;
                s5_pair1(pr, 2 * wave, wave, lane, Z, (bf16_t*)(ws + WS_Y), tab, (float*)(ws + WS_SEND), (float*)(ws + WS_SEND2), (float*)(ws + WS_SE), lds);
                s5_pair1(pr, 2 * wave + 1, wave, lane, Z, (bf16_t*)(ws + WS_Y), tab, (float*)(ws + WS_SEND), (float*)(ws + WS_SEND2), (float*)(ws + WS_SE), lds); }
            __syncthreads();
            { const bf16_t* WSP = (const bf16_t*)(ws + WS_WSP) + (size_t)l * 6 * 128 * 128; const float* a_sb = INP(5) + (size_t)l * 6 * 128; const float* vg = INP(3) + (size_t)l * AW; const float* mo_ga = INP(23) + (size_t)l * D;
              for (int u = bid; u < NU128; u += G) mixa_unit(u, tid, wave, lane, Z, (bf16_t*)(ws + WS_Y), WSP, a_sb, vg, mo_ga, lds); }
        }
        xcd_barrier(bar);

        {
            PHASE_IDS(); unsigned char* ws = WSB(); const bf16_t* Z = (const bf16_t*)(ws + WS_Z); bf16_t* Y = (bf16_t*)(ws + WS_Y);
            const float* a_v_norm_g = INP(3) + (size_t)l * AW; const float* a_sw = INP(4) + (size_t)l * 6 * 128 * 128; const float* a_sb = INP(5) + (size_t)l * 6 * 128;
        }

        { PHASE_IDS(); unsigned char* ws = WSB(); const bf16_t* Z = (const bf16_t*)(ws + WS_Z); bf16_t* Y = (bf16_t*)(ws + WS_Y);
          { const float* mo_gb = INP(23) + (size_t)l * D + AW;
            __syncthreads();
            for (int pr = bid; pr < NU128 / 2; pr += G) rglru_fix_pair(pr, tid, wave, lane, Z, Y, (const bf16_t*)(ws + WS_HL), (const bf16_t*)(ws + WS_PP), (const float*)(ws + WS_SUMA2), (const float*)(ws + WS_SUMH2), mo_gb, lds); }
          { const bf16_t* WGLU = (const bf16_t*)(ws + WS_WGLU) + (size_t)l * CW * CW; const float* glu_b = INP(22) + (size_t)l * CW; const float* mo_gc = INP(23) + (size_t)l * D + AW + BW;
            for (int pr = bid; pr < NU128 / 2; pr += G) { float k0r = 0.f, k0i = 0.f, k1r = 0.f, k1i = 0.f; const unsigned char* tab = ws + WS_S5 + (size_t)l * S5_L_STRIDE;
#pragma unroll 1
                for (int ui = 0; ui < 2; ++ui) { const int u = 2 * pr + ui; __syncthreads();
                    s5_group<2>(u, 2 * wave, ui == 0, k0r, k0i, wave, lane, Z, Y, tab, (float*)(ws + WS_SEND), (float*)(ws + WS_SEND2), (float*)(ws + WS_SE), lds);
                    s5_group<2>(u, 2 * wave + 1, ui == 0, k1r, k1i, wave, lane, Z, Y, tab, (float*)(ws + WS_SEND), (float*)(ws + WS_SEND2), (float*)(ws + WS_SE), lds);
                    __syncthreads(); s5_glu(u, wave, lane, WGLU, glu_b, mo_gc, Y, lds); } } } }
        asm volatile("s_waitcnt vmcnt(0)" ::: "memory"); __syncthreads();
        if (wave_s0 == 0) { __builtin_amdgcn_fence(__ATOMIC_ACQUIRE, "agent"); asm volatile("s_waitcnt vmcnt(0)" ::: "memory"); }
        __syncthreads();

        { PHASE_IDS(); unsigned char* ws = WSB(); bf16_t* WOUT = (bf16_t*)(ws + WS_WOUT); bf16_t* HB = (bf16_t*)(ws + WS_HB); float* SSQ = (float*)(ws + WS_SSQ); bf16_t* Y = (bf16_t*)(ws + WS_Y);
          pg8::PanelOrder<T, 4> S; S.init(Y, WOUT + (size_t)l * D * D, G, bid);
          pg8::EpiRes<false> E{HB, SSQ, nullptr, lds + LDS_PF};
          pg8::gemm_phase<pg8::EpiRes<false>, pg8::PanelOrder<T, 4>, true, true>(lds, wave_s, S, E); }
        asm volatile("s_waitcnt vmcnt(0)" ::: "memory"); __syncthreads();
        if (wave_s0 == 0) { __builtin_amdgcn_fence(__ATOMIC_ACQUIRE, "agent"); asm volatile("s_waitcnt vmcnt(0)" ::: "memory"); }
        __syncthreads();

        { PHASE_IDS(); unsigned char* ws = WSB(); const bf16_t* HB = (const bf16_t*)(ws + WS_HB); const float* SSQ = (const float*)(ws + WS_SSQ); int* CLS = (int*)(ws + WS_CLS); float* G2 = (float*)(ws + WS_G2); int* HIST = (int*)(ws + WS_HIST);
          const float* rgb = INP(27) + (size_t)l * 4; const float* reb = INP(29) + (size_t)l * 16;
        if (l == 0) {
            for (int rr = gw; rr < 2 * NCLS * 2 * 1024 / 2; rr += NGW) { const int row = 2 * rr + (lane >> 5), n = row & 1023, half = (row >> 10) & 1, cls = (row >> 11) % NCLS, ll = row / (2048 * NCLS);
                const int g = cls / 6, pi = cls % 6, e = g * 4 + (half ? pair_hi(pi) : pair_lo(pi));
                const u32x4 v = *(const u32x4*)(ws + WS_WD8 + ((size_t)ll * NE + e) * 1024 * 512 + (size_t)n * 512 + (lane & 31) * 16);
                *(u32x4*)(ws + WS_WD2 + ((size_t)ll * NCLS + cls) * 1024 * 1024 + (size_t)n * 1024 + half * 512 + (lane & 31) * 16) = v; } }
        for (int u = bid; u < NU; u += G) {
            router_unit(u, wave, lane, HB, SSQ, (const bf16_t*)(ws + WS_WRT) + (size_t)l * 48 * D, rgb, reb, CLS, G2, lds, (LAS int*)(lds + LDSCTL_OFF) + LW_HIST);
            __syncthreads();
            if (tid < 32) { HIST[u * 32 + tid] = tid < NCLS ? LWI[LW_HIST + tid] : 0; LWI[LW_HIST + tid] = 0; }
            __syncthreads();
        } }
        xcd_barrier(bar);

        { PHASE_IDS(); unsigned char* ws = WSB(); const bf16_t* HB = (const bf16_t*)(ws + WS_HB); const float* SSQ = (const float*)(ws + WS_SSQ); const int* CLS = (const int*)(ws + WS_CLS); const float* G2 = (const float*)(ws + WS_G2); const int* HIST = (const int*)(ws + WS_HIST);
          int* CTOT = (int*)(ws + WS_CTOT); int* ROWTOK = (int*)(ws + WS_ROWTOK); float* ROWG = (float*)(ws + WS_ROWG); bf16_t* HBS = (bf16_t*)(ws + WS_HBS); const float* ffn_g = INP(25) + (size_t)l * D;
        for (int u = bid; u < NU; u += G) {
            { const int c = tid & 31, part = tid >> 5; int tot = 0, pre = 0;
_Pragma("unroll 16")
              for (int k = part * 16; k < part * 16 + 16; ++k) { const int v = HIST[k * 32 + c]; tot += v; pre += k < u ? v : 0; }
              ((volatile LAS int*)lds)[tid] = tot; ((volatile LAS int*)lds)[512 + tid] = pre; }
            __syncthreads();
            if (tid < NCLS) { int tot = 0, pre = 0;
_Pragma("unroll")
                for (int k = 0; k < 16; ++k) { tot += ((volatile LAS int*)lds)[k * 32 + tid]; pre += ((volatile LAS int*)lds)[512 + k * 32 + tid]; } LWI[LW_TOT + tid] = tot; LWI[LW_BASE + tid] = pre; }
            __syncthreads();
            if (tid == 0) { int ps = 0;
_Pragma("unroll 1")
                for (int c = 0; c < NCLS; ++c) { const int tot = LWI[LW_TOT + c]; LWI[LW_BASE + c] += ps; LWI[LW_TST + c] = ps; ps += ((tot + 255) >> 8) << 8; if (bid == 0) CTOT[c] = tot; } LWI[LW_TST + NCLS] = ps; }
            int mycls = 0, rank = 0;
            if (tid < UT) { mycls = CLS[u * UT + tid];
_Pragma("unroll 4")
                for (int c = 0; c < NCLS; ++c) { const unsigned long long m = __ballot(mycls == c); const int below = __builtin_amdgcn_mbcnt_hi((unsigned)(m >> 32), __builtin_amdgcn_mbcnt_lo((unsigned)m, 0u));
                    if (mycls == c) rank = below; if (lane == 0) ((volatile LAS int*)lds)[1024 + wave * 32 + c] = __popcll(m); } }
            __syncthreads();
            if (tid < UT) { const int cls = mycls;
                for (int w = 0; w < wave; ++w) rank += ((volatile LAS int*)lds)[1024 + w * 32 + cls];
                const int dest = LWI[LW_BASE + cls] + rank; LWI[LW_DEST + tid] = dest; const int t = u * UT + tid;
                ROWTOK[dest] = t; ROWG[(size_t)dest * 2 + 0] = G2[(size_t)t * 2 + 0]; ROWG[(size_t)dest * 2 + 1] = G2[(size_t)t * 2 + 1]; }
            __syncthreads();
            { f32x4 gq[4];
#pragma unroll
              for (int j = 0; j < 4; ++j) gq[j] = *(const f32x4*)(ffn_g + (j >> 1) * 512 + lane * 8 + 4 * (j & 1));
#pragma unroll 1
              for (int i = 0; i < 32; i += 4) {
                  const int tl0 = wave * 32 + i, t0r = u * UT + tl0;
                  float sq = SSQ[(size_t)t0r * 16 + lane]; sq += x_xor1(sq); sq += x_xor2(sq); sq += x_hmir(sq); sq += x_mir(sq);
                  u32x4 o[4][2]; int dst[4];
#pragma unroll
                  for (int j = 0; j < 4; ++j) { o[j][0] = *(const u32x4*)(HB + (size_t)(t0r + j) * D + lane * 8); o[j][1] = *(const u32x4*)(HB + (size_t)(t0r + j) * D + 512 + lane * 8); dst[j] = LWI[LW_DEST + tl0 + j]; }
#pragma unroll
                  for (int j = 0; j < 4; ++j) { const float r4 = rsqrtf(__builtin_amdgcn_readlane(sq, 16 * j) * (1.0f / D) + EPS) * pg8::FS_H; u32x4 w;
#pragma unroll
                      for (int hh = 0; hh < 2; ++hh) { const u32x4 oo = o[j][hh]; const f32x4 g0 = gq[2 * hh], g1 = gq[2 * hh + 1];
                          const unsigned lo = pk_fp8x4(__uint_as_float(oo.x << 16) * r4 * g0[0], __uint_as_float(oo.x & 0xffff0000u) * r4 * g0[1], __uint_as_float(oo.y << 16) * r4 * g0[2], __uint_as_float(oo.y & 0xffff0000u) * r4 * g0[3]);
                          const unsigned hi = pk_fp8x4(__uint_as_float(oo.z << 16) * r4 * g1[0], __uint_as_float(oo.z & 0xffff0000u) * r4 * g1[1], __uint_as_float(oo.w << 16) * r4 * g1[2], __uint_as_float(oo.w & 0xffff0000u) * r4 * g1[3]);
                          if (hh == 0) { w.x = lo; w.y = hi; } else { w.z = lo; w.w = hi; } }
                      *(u32x2*)((unsigned char*)HBS + (size_t)dst[j] * D + lane * 8) = (u32x2){w.x, w.y}; *(u32x2*)((unsigned char*)HBS + (size_t)dst[j] * D + 512 + lane * 8) = (u32x2){w.z, w.w}; } } }
            if (u == bid)
_Pragma("unroll 1")
            for (int c = bid; c < NCLS; c += G) { const int tot = LWI[LW_TOT + c], r0 = LWI[LW_TST + c] + tot, r1 = LWI[LW_TST + c + 1];
                unsigned zz = 0u; asm volatile("" : "+v"(zz));
                for (int r = r0 + wave; r < r1; r += 8) { if (lane == 0) { ROWTOK[r] = -1; ROWG[(size_t)r * 2] = __uint_as_float(zz); ROWG[(size_t)r * 2 + 1] = __uint_as_float(zz); }
                    *(u32x4*)((unsigned char*)HBS + (size_t)r * D + lane * 16) = (u32x4){zz, zz, zz, zz}; } }
            __syncthreads();
        } }
        xcd_barrier(bar);

        { PHASE_IDS(); unsigned char* ws = WSB(); const int* CTOT = (const int*)(ws + WS_CTOT); bf16_t* HBS = (bf16_t*)(ws + WS_HBS); bf16_t* WGU = (bf16_t*)(ws + WS_WGU); bf16_t* ACT = (bf16_t*)(ws + WS_ACT); const float* ROWG = (const float*)(ws + WS_ROWG);
        if (wave == 0) {
            const int vt = lane < NCLS ? (CTOT[lane] + 255) >> 8 : 0; int tst = 0, ntile = 0;
_Pragma("unroll")
            for (int k = 0; k < NCLS; ++k) { const int vk = __builtin_amdgcn_readlane(vt, k); tst += (k < lane) ? vk : 0; ntile += vk; }
            if (lane <= NCLS) LWI[LW_TST + lane] = tst;
            if (lane < 32) { const long L = (long)lane * G + bid; int e = -1;
            int mtu = -1, pnu = 0, mtd = -1, pnd = 0;
            if (L < (long)ntile * 8) { const int nwg = ntile * 8, qq = nwg / 8, rr = nwg % 8, xcd = (int)(L % 8), off = (int)(L / 8); const int Lr = (xcd < rr ? xcd * (qq + 1) : rr * (qq + 1) + (xcd - rr) * qq) + off; mtu = Lr / 8; pnu = Lr % 8; }
            if (L < (long)ntile * 4) { const int nwg = ntile * 4, qq = nwg / 8, rr = nwg % 8, xcd = (int)(L % 8), off = (int)(L / 8); const int Lr = (xcd < rr ? xcd * (qq + 1) : rr * (qq + 1) + (xcd - rr) * qq) + off; mtd = Lr / 4; pnd = Lr % 4; }
            int clsu = 0, clsd = 0;
_Pragma("unroll")
            for (int k = 1; k < NCLS; ++k) { const int sk = __builtin_amdgcn_readlane(tst, k); clsu += (sk <= mtu) ? 1 : 0; clsd += (sk <= mtd) ? 1 : 0; }
            e = mtu >= 0 ? ((clsu << 24) | (pnu << 16) | mtu) : -1; LWI[LW_UTAB + lane] = e;
            e = mtd >= 0 ? ((clsd << 24) | (pnd << 16) | mtd) : -1; LWI[LW_DTAB + lane] = e; } }
        __syncthreads();
        { pg8::MoeOrder<8, true, 1024> S{LWI + LW_UTAB, l, (const char*)HBS, (const char*)WGU};
          pg8::EpiUp E{(unsigned char*)ACT, ROWG, lds + LDS_PF};
          pg8::gemm_phase<pg8::EpiUp, pg8::MoeOrder<8, true, 1024>, true, true, 512, true>(lds, wave_s, S, E); } }
        xcd_barrier(bar);

        { PHASE_IDS(); unsigned char* ws = WSB(); bf16_t* ACT = (bf16_t*)(ws + WS_ACT); bf16_t* WD2 = (bf16_t*)(ws + WS_WD2); bf16_t* HB = (bf16_t*)(ws + WS_HB); float* SSQ = (float*)(ws + WS_SSQ); const int* ROWTOK = (const int*)(ws + WS_ROWTOK);
          pg8::MoeOrder<4, false, 1024> S{LWI + LW_DTAB, l, (const char*)ACT, (const char*)WD2};
          pg8::EpiRes<true> E{HB, SSQ, ROWTOK, lds + LDS_PF};
          pg8::gemm_phase<pg8::EpiRes<true>, pg8::MoeOrder<4, false, 1024>, true, true, 512, true>(lds, wave_s, S, E); }
        xcd_barrier(bar);
    }

    { PHASE_IDS(); unsigned char* ws = WSB(); const bf16_t* HB = (const bf16_t*)(ws + WS_HB); const float* SSQ = (const float*)(ws + WS_SSQ); const float* fg = INP(33); float* outp = a.out;
    { f32x4 gq[4];
#pragma unroll
      for (int q = 0; q < 4; ++q) gq[q] = *(const f32x4*)(fg + 256 * q + 4 * lane);
#pragma unroll 1
      for (int t0r = gw * 4; t0r < T; t0r += NGW * 4) {
          float sq = SSQ[(size_t)t0r * 16 + lane]; sq += x_xor1(sq); sq += x_xor2(sq); sq += x_hmir(sq); sq += x_mir(sq);
          u32x2 o[4][4];
#pragma unroll
          for (int j = 0; j < 4; ++j)
#pragma unroll
              for (int q = 0; q < 4; ++q) o[j][q] = *(const u32x2*)(HB + (size_t)(t0r + j) * D + 256 * q + 4 * lane);
#pragma unroll
          for (int j = 0; j < 4; ++j) { const float r = rsqrtf(__builtin_amdgcn_readlane(sq, 16 * j) * (1.0f / D) + EPS); float* orow = outp + (size_t)(t0r + j) * D + 4 * lane;
#pragma unroll
              for (int q = 0; q < 4; ++q) { const u32x2 oo = o[j][q]; const f32x4 g0 = gq[q]; f32x4 w0;
                  w0[0] = __uint_as_float(oo.x << 16) * r * g0[0]; w0[1] = __uint_as_float(oo.x & 0xffff0000u) * r * g0[1]; w0[2] = __uint_as_float(oo.y << 16) * r * g0[2]; w0[3] = __uint_as_float(oo.y & 0xffff0000u) * r * g0[3];
                  *(f32x4*)(orow + 256 * q) = w0; } } } }
}
}

extern "C" void kernel_launch(void* const* d_in, const int* in_sizes, int n_in, void* d_out, int out_size, void* d_ws, size_t ws_size, hipStream_t stream) {
    static int grid = 0;
    if (grid == 0) {
        if (n_in != 34 || in_sizes[0] != T * D || out_size != T * D || ws_size < WS_END) { fprintf(stderr, "kernel_launch: unexpected shapes (n_in %d, ws %zu)\n", n_in, ws_size); grid = -1; return; }
        int dev = 0, cus = 0, per_cu = 0;
        if (hipGetDevice(&dev) != hipSuccess || hipDeviceGetAttribute(&cus, hipDeviceAttributeMultiprocessorCount, dev) != hipSuccess) { grid = -1; return; }
        if (hipFuncSetAttribute((const void*)mega_fwd, hipFuncAttributeMaxDynamicSharedMemorySize, LDS_BYTES) != hipSuccess) { fprintf(stderr, "kernel_launch: hipFuncSetAttribute failed\n"); grid = -1; return; }
        if (hipOccupancyMaxActiveBlocksPerMultiprocessor(&per_cu, (const void*)mega_fwd, 512, LDS_BYTES) != hipSuccess || per_cu < 1) { fprintf(stderr, "kernel_launch: occupancy query says %d\n", per_cu); }
        (void)hipGetLastError();
        grid = cus;
    }
    if (grid < 0) return;
    (void)hipMemsetAsync((char*)d_ws + WS_CTL, 0, CTL_ZERO_BYTES, stream);
    Args a{};
    for (int i = 0; i < 34; ++i) a.in[i] = (const float*)d_in[i];
    a.out = (float*)d_out; a.ws = (unsigned char*)d_ws;
    hipLaunchKernelGGL(mega_fwd, dim3(grid), dim3(512), LDS_BYTES, stream, a);
}
```

```cpp
#include <hip/hip_runtime.h>
#include <cstdio>
#include <cstdint>

#define LAS __attribute__((address_space(3)))
typedef unsigned short bf16_t;
typedef short bf16x8 __attribute__((ext_vector_type(8)));
typedef float f32x4 __attribute__((ext_vector_type(4)));
typedef float f32x2 __attribute__((ext_vector_type(2)));
typedef unsigned u32x4 __attribute__((ext_vector_type(4)));
typedef unsigned u32x2 __attribute__((ext_vector_type(2)));
typedef int i32x4 __attribute__((ext_vector_type(4)));
typedef int i32x8 __attribute__((ext_vector_type(8)));

constexpr int D = 1024, BATCH = 8, SEQ = 8192, T = BATCH * SEQ, DEPTH = 2;
constexpr int AW = 384, BW = 384, CW = 256, HD = 64, ABLK = 128, CHUNK = 64;
constexpr int INC = 1792;
constexpr int ZU = 0, ZV = 384, ZG = 768, ZX = 1152, ZC = 1536, ZGELU_END = 1152;
constexpr int CG = 16, CGD = 16, CS = 64;
constexpr int NE = 16, DE = 512, NCLS = 24;
constexpr float EPS = 1e-6f;
constexpr int UT = 256;
constexpr int NU = T / UT;
constexpr int MAXROWS = T + NCLS * 256;

constexpr size_t MiB = 1u << 20;
constexpr size_t WS_CTL = 0, CTL_ZERO_BYTES = 1 * MiB;
constexpr size_t WS_WIN = 2 * MiB;
constexpr size_t WS_WOUT = 10 * MiB;
constexpr size_t WS_WGLU = 14 * MiB;
constexpr size_t WS_WRG = 15 * MiB;
constexpr size_t WS_WSP = 15 * MiB + 256 * 1024;
constexpr size_t WS_WRT = 15 * MiB + 768 * 1024;
constexpr size_t WS_WGU = 16 * MiB;
constexpr size_t WS_WD8 = 48 * MiB;
constexpr size_t WS_WD2 = 80 * MiB;
constexpr size_t WS_SSQ = 176 * MiB;
constexpr size_t WS_RS = 180 * MiB;
constexpr size_t WS_CLS = WS_RS + 256 * 1024;
constexpr size_t WS_G2 = WS_CLS + 256 * 1024;
constexpr size_t WS_HIST = 181 * MiB;
constexpr size_t WS_CTOT = WS_HIST + 64 * 1024;
constexpr size_t WS_ROWTOK = WS_HIST + 256 * 1024;
constexpr size_t WS_ROWG = 182 * MiB;
constexpr size_t WS_SUMA = 183 * MiB;
constexpr size_t WS_SUMH = 191 * MiB;
constexpr size_t WS_S5 = 184 * MiB;
constexpr size_t WS_SEND = 187 * MiB;
constexpr size_t WS_HB = 192 * MiB;
constexpr size_t WS_Z = 320 * MiB;
constexpr size_t WS_HBS = WS_Z;
constexpr size_t WS_Y = 544 * MiB;
constexpr size_t WS_ACT = 672 * MiB;
constexpr size_t WS_HL = 672 * MiB;
constexpr size_t WS_PP = 736 * MiB;
constexpr size_t WS_SE = 800 * MiB;
constexpr size_t WS_AV = 672 * MiB;
constexpr size_t WS_BV = 768 * MiB;
constexpr size_t WS_SEND2 = 864 * MiB;
constexpr size_t WS_SUMA2 = 866 * MiB;
constexpr size_t WS_SUMH2 = 867 * MiB;
constexpr size_t WS_END = 868 * MiB;
constexpr int CW_BAR = 4096;

constexpr int RING_BYTES = 131072;
constexpr int LDSCTL_OFF = 143360;
constexpr int LDS_PF = 147456;
constexpr int LDS_BYTES = 163840;
constexpr int LW_BAR = 8, LW_TST = 64, LW_HIST = 96, LW_TOT = 128, LW_BASE = 160, LW_CLS = 256  , LW_DEST = 512  , LW_UTAB = 768  , LW_DTAB = 800  ;

__device__ __forceinline__ float bf2f(bf16_t v) { return __uint_as_float(((unsigned)v) << 16); }
__device__ __forceinline__ unsigned cvt_pk_bf16(float lo, float hi) { unsigned r; asm volatile("v_cvt_pk_bf16_f32 %0, %1, %2" : "=v"(r) : "v"(lo), "v"(hi)); return r; }
__device__ __forceinline__ bf16_t f2bf(float v) { return (bf16_t)(cvt_pk_bf16(v, 0.f) & 0xffffu); }
__device__ __forceinline__ unsigned pk_fp8x4(float a, float b, float c, float d) {
    a = fminf(fmaxf(a, -448.f), 448.f); b = fminf(fmaxf(b, -448.f), 448.f); c = fminf(fmaxf(c, -448.f), 448.f); d = fminf(fmaxf(d, -448.f), 448.f);
    int r = __builtin_amdgcn_cvt_pk_fp8_f32(a, b, 0, false); r = __builtin_amdgcn_cvt_pk_fp8_f32(c, d, r, true); return (unsigned)r; }
__device__ __forceinline__ int fresh_lane() { unsigned z = 0u; asm volatile("" : "+s"(z)); return (int)__builtin_amdgcn_mbcnt_hi(~0u, __builtin_amdgcn_mbcnt_lo(~0u, z)); }
__device__ __forceinline__ float x_xor1(float v) { return __int_as_float(__builtin_amdgcn_update_dpp(0, __float_as_int(v), 0xB1, 0xf, 0xf, true)); }
__device__ __forceinline__ float x_xor2(float v) { return __int_as_float(__builtin_amdgcn_update_dpp(0, __float_as_int(v), 0x4E, 0xf, 0xf, true)); }
__device__ __forceinline__ float x_hmir(float v) { return __int_as_float(__builtin_amdgcn_update_dpp(0, __float_as_int(v), 0x141, 0xf, 0xf, true)); }
__device__ __forceinline__ float x_mir(float v) { return __int_as_float(__builtin_amdgcn_update_dpp(0, __float_as_int(v), 0x140, 0xf, 0xf, true)); }
__device__ __forceinline__ float x_xor16(float v) { return __int_as_float(__builtin_amdgcn_ds_swizzle(__float_as_int(v), 0x401F)); }
__device__ __forceinline__ float add_xor32(float v) { const auto r = __builtin_amdgcn_permlane32_swap(__float_as_uint(v), __float_as_uint(v), false, false); return __uint_as_float(r[0]) + __uint_as_float(r[1]); }
__device__ __forceinline__ float add_x16_x32(float v) { v += x_xor16(v); return add_xor32(v); }
__device__ __forceinline__ float wave_sum(float v) { v += x_xor1(v); v += x_xor2(v); v += x_hmir(v); v += x_mir(v); v += x_xor16(v); return add_xor32(v); }
__device__ __forceinline__ float gelu_fast(float x) {
    const float u2 = 1.5957691216057308f * (x + 0.044715f * x * x * x);
    const float e = __builtin_amdgcn_exp2f(-1.4426950408889634f * u2);
    return x * __builtin_amdgcn_rcpf(1.0f + e);
}
__device__ __forceinline__ float sigmoid_fast(float x) { return __builtin_amdgcn_rcpf(1.0f + __builtin_amdgcn_exp2f(-1.4426950408889634f * x)); }
__device__ __forceinline__ float sigmoid_f(float x) { return 1.0f / (1.0f + expf(-x)); }
__device__ __forceinline__ int pair_lo(int pi) { return pi < 3 ? 0 : (pi < 5 ? 1 : 2); }
__device__ __forceinline__ int pair_hi(int pi) { return pi < 3 ? pi + 1 : (pi < 5 ? pi - 1 : 3); }
__device__ __forceinline__ int pair_idx(int lo, int hi) { return lo == 0 ? hi - 1 : (lo == 1 ? hi + 1 : 5); }

#define XB_TMO      128
#define XB_XCNT(j)  (256  + 64 * (j))
#define XB_XSUB(j)  (1280 + 64 * (j))
#define XB_XGEN(j)  (2304 + 64 * (j))
#define XB_TOP      3328
#define XB_TOPGEN   3392
#define XCD_BAR_WORDS 3456
#define XB_SPIN_CAP (1u << 18)
__device__ __forceinline__ unsigned xb_ld(unsigned* p)              { return __hip_atomic_load(p, __ATOMIC_RELAXED, __HIP_MEMORY_SCOPE_AGENT); }
__device__ __forceinline__ unsigned xb_add(unsigned* p, unsigned v) { return __hip_atomic_fetch_add(p, v, __ATOMIC_RELAXED, __HIP_MEMORY_SCOPE_AGENT); }
__device__ __forceinline__ unsigned xb_xcc_id() { return (unsigned)__builtin_amdgcn_s_getreg((3 << 11) | 20) & 0xFu; }
#define XB_SPIN(cond, bar) do { unsigned _sp = 0; while (cond) { __builtin_amdgcn_s_sleep(1); \
    if ((++_sp & 255u) == 0u) { if (xb_ld(&(bar)[XB_TMO])) break; if (_sp > XB_SPIN_CAP) { atomicAdd(&(bar)[XB_TMO], 1u); break; } } } } while (0)
struct XcdBarrier { unsigned* bar; unsigned x; volatile LAS unsigned* st; };
__device__ __forceinline__ XcdBarrier xcd_barrier_post(unsigned* bar, volatile LAS unsigned* st) {
    XcdBarrier b; b.bar = bar; b.x = xb_xcc_id(); b.st = st;
    if (threadIdx.x == 0) (void)xb_add(&bar[XB_XCNT(b.x)], 1u);
    return b;
}
__device__ __forceinline__ void xcd_barrier_complete(unsigned* bar, unsigned x, unsigned& nloc, unsigned& nx) {
    const unsigned G = gridDim.x * gridDim.y * gridDim.z;
    unsigned sum, cnt, mine, sp = 0u;
    for (;;) {
        sum = 0u; cnt = 0u; mine = 0u;
#pragma unroll
        for (unsigned j = 0; j < 16; ++j) { const unsigned c = xb_ld(&bar[XB_XCNT(j)]); sum += c; cnt += (c > 0u) ? 1u : 0u; mine = (j == x) ? c : mine; }
        if (sum == G) break;
        __builtin_amdgcn_s_sleep(1);
        if ((++sp & 255u) == 0u) { if (xb_ld(&bar[XB_TMO])) break; if (sp > XB_SPIN_CAP) { atomicAdd(&bar[XB_TMO], 1u); break; } }
    }
    nloc = mine > 0u ? mine : 1u; nx = cnt > 0u ? cnt : 1u;
}
__device__ __forceinline__ void xcd_barrier(const XcdBarrier& b) {
    asm volatile("s_waitcnt vmcnt(0)" ::: "memory");
    __syncthreads();
    if (threadIdx.x == 0) {
        unsigned* bar = b.bar; asm volatile("" : "+s"(bar));
        __builtin_amdgcn_s_waitcnt(0);
        unsigned bx0 = b.x; asm volatile("" : "+s"(bx0));
        unsigned nloc = b.st[0], nx = b.st[1];
        if (nloc == 0u) { xcd_barrier_complete(bar, bx0, nloc, nx); b.st[0] = nloc; b.st[1] = nx; }
        unsigned bx = b.x; asm volatile("" : "+s"(bx));
        const unsigned old = xb_add(&bar[XB_XSUB(bx)], 1u);
        const unsigned gen = old / nloc;
        if (old + 1u == (gen + 1u) * nloc) {
            __builtin_amdgcn_fence(__ATOMIC_RELEASE, "agent");
            asm volatile("s_waitcnt vmcnt(0)" ::: "memory");
            const unsigned og = xb_add(&bar[XB_TOP], 1u);
            const unsigned tg = og / nx;
            if (og + 1u == (tg + 1u) * nx) xb_add(&bar[XB_TOPGEN], 1u);
            else XB_SPIN(xb_ld(&bar[XB_TOPGEN]) == tg, bar);
            __builtin_amdgcn_fence(__ATOMIC_ACQUIRE, "agent");
            xb_add(&bar[XB_XGEN(bx)], 1u);
            asm volatile("s_waitcnt vmcnt(0)" ::: "memory");
        } else {
            XB_SPIN(xb_ld(&bar[XB_XGEN(bx)]) == gen, bar);
            __builtin_amdgcn_fence(__ATOMIC_ACQUIRE, "agent");
            asm volatile("s_waitcnt vmcnt(0)" ::: "memory");
        }
    }
    __syncthreads();
}

namespace pg8 {
#define PG8_LAS __attribute__((address_space(3)))
constexpr int BM = 256, BK = 64, HALF = 128, HTB = HALF * BK * 2, STAGE_BYTES = 8 * HTB, NXCD = 8, WGM = 4;
__host__ __device__ __forceinline__ int lds_byte(int r, int c) { const int st = (r >> 4) * 2 + (c >> 5), rr = r & 15, cc = c & 31, ob = rr * 64 + cc * 2; return st * 1024 + (ob ^ (((ob >> 9) & 1) << 5)); }
__host__ __device__ __forceinline__ void stage_rc(int b, int& R, int& C) { const int st = b / 1024, sb = b % 1024, swz = sb ^ (((sb >> 9) & 1) << 5); R = (st >> 1) * 16 + swz / 64; C = (st & 1) * 32 + (swz % 64) / 2; }
__host__ __device__ __forceinline__ int perm32(int rho) { const int n = rho >> 4, i = rho & 15; return 8 * (i >> 2) + 4 * n + (i & 3); }
struct Unit { int pm, pn; const char* A; const char* B; };

template <int M_, int NN> struct PanelOrder {
    static constexpr int nM = M_ / BM; static constexpr size_t tstep = (size_t)BM * 1024 * 2;
    int G, c; const char* A; const char* Bt;
    __device__ void init(const void* A_, const void* Bt_, int G_, int c_) { G = G_; c = c_; A = (const char*)A_; Bt = (const char*)Bt_; }
    __device__ bool next(int i, Unit& u) const { const int pm = c + (i / NN) * G; if (pm >= nM) return false; u.pm = pm; u.pn = i % NN; u.A = A + (size_t)pm * tstep; u.B = Bt + (size_t)u.pn * tstep; return true; }
    __device__ __forceinline__ void a_ready(const Unit&) const {}
    __device__ __forceinline__ void done(const Unit&) const {}
};
template <int M_, int N_> struct StaticOrder {
    static constexpr int nM = M_ / BM, nN = N_ / BM, nwg = nM * nN; static constexpr size_t tstep = (size_t)BM * 1024 * 2;
    int G, c; const char* A; const char* Bt;
    __device__ void init(const void* A_, const void* Bt_, int G_, int c_) { G = G_; c = c_; A = (const char*)A_; Bt = (const char*)Bt_; }
    __device__ bool next(int i, Unit& u) const {
        const long L = (long)i * G + c; if (L >= nwg) return false;
        int wgid = (int)L; { constexpr int q = nwg / NXCD, r = nwg % NXCD; const int xcd = wgid % NXCD, off = wgid / NXCD; wgid = (xcd < r ? xcd * (q + 1) : r * (q + 1) + (xcd - r) * q) + off; }
        constexpr int nig = WGM * nN; const int gid = wgid / nig, fm = gid * WGM, gsz = (nM - fm) < WGM ? (nM - fm) : WGM;
        u.pm = fm + ((wgid % nig) % gsz); u.pn = (wgid % nig) / gsz; u.A = A + (size_t)u.pm * tstep; u.B = Bt + (size_t)u.pn * tstep; return true;
    }
    __device__ __forceinline__ void a_ready(const Unit&) const {}
    __device__ __forceinline__ void done(const Unit&) const {}
};
template <class Epi, class Sched, bool ALIGN_EPI = false, bool SP2 = false, int KB = 1024, bool FP8 = false>
__device__ __forceinline__ void gemm_phase(PG8_LAS unsigned char* lds, const int wave_s, const Sched& S, const Epi& E) { const int Kdim = 0;
    const int lane = fresh_lane(), wid = wave_s, tid = wid * 64 + lane, wr = wid >> 2, wc = wid & 3, fr = lane & 15, fq = lane >> 4;
    constexpr int K = KB, nt = K / BK; (void)Kdim;
    unsigned voffA, voffB;
    { int R, C; stage_rc(tid * 16, R, C); const int Rb = Epi::PERM ? ((R & ~31) + perm32(R & 31)) : R; voffA = (unsigned)(R * K + C) * 2u; voffB = (unsigned)(Rb * K + C) * 2u; }
    constexpr size_t kstep = (size_t)(BK * 2);
    constexpr size_t hstep = (size_t)HALF * K * 2;
    constexpr size_t tstep = 2 * hstep; (void)tstep;
    const unsigned ldsw = (unsigned)wid * 1024u; const unsigned ldsb = (unsigned)(size_t)lds + ldsw;
    const int aoff = lds_byte(wr * 64 + fr, fq * 8), boff = lds_byte(wc * 32 + fr, fq * 8);
#define PG8_SA(b, h) (((b) * 2 + (h)) * HTB)
#define PG8_SB(b, h) ((4 + (b) * 2 + (h)) * HTB)
#define PG8_STAGE(bufoff, gbase, voff) do { _Pragma("unroll") for (int _i = 0; _i < 2; ++_i) { unsigned _keep; \
        asm volatile("s_mov_b32 %0, m0\n\ts_mov_b32 m0, %3\n\ts_nop 0\n\tglobal_load_lds_dwordx4 %1, %2\n\ts_mov_b32 m0, %0" : "=&s"(_keep) \
            : "v"(voff), "s"((const char*)(gbase) + (size_t)_i * (64 * K * 2)), "s"(ldsb + (unsigned)((bufoff) + _i * 8192)) : "memory"); } } while (0)
#define PG8_LDA(dst, b, h) do { if constexpr (FP8) { _Pragma("unroll") for (int m = 0; m < 4; ++m) { const i32x4 _lo = *(const PG8_LAS i32x4*)(lds + PG8_SA(b, h) + aoff + m * 2048), _hi = *(const PG8_LAS i32x4*)(lds + PG8_SA(b, h) + aoff + m * 2048 + 1024); \
            dst##8[m] = __builtin_shufflevector(_lo, _hi, 0, 1, 2, 3, 4, 5, 6, 7); } } \
        else { _Pragma("unroll") for (int m = 0; m < 4; ++m) _Pragma("unroll") for (int k = 0; k < 2; ++k) dst[m][k] = *(const PG8_LAS bf16x8*)(lds + PG8_SA(b, h) + aoff + m * 2048 + k * 1024); } } while (0)
#define PG8_LDB(dst, b, h) do { if constexpr (FP8) { _Pragma("unroll") for (int n = 0; n < 2; ++n) { const i32x4 _lo = *(const PG8_LAS i32x4*)(lds + PG8_SB(b, h) + boff + n * 2048), _hi = *(const PG8_LAS i32x4*)(lds + PG8_SB(b, h) + boff + n * 2048 + 1024); \
            dst##8[n] = __builtin_shufflevector(_lo, _hi, 0, 1, 2, 3, 4, 5, 6, 7); } } \
        else { _Pragma("unroll") for (int n = 0; n < 2; ++n) _Pragma("unroll") for (int k = 0; k < 2; ++k) dst[n][k] = *(const PG8_LAS bf16x8*)(lds + PG8_SB(b, h) + boff + n * 2048 + k * 1024); } } while (0)
#define PG8_MMA(ai, bj, At, Bt) do { __builtin_amdgcn_s_setprio(1); \
        if constexpr (FP8) { _Pragma("unroll") for (int m = 0; m < 4; ++m) _Pragma("unroll") for (int n = 0; n < 2; ++n) \
            acc[ai][bj][m][n] = __builtin_amdgcn_mfma_scale_f32_16x16x128_f8f6f4(Bt##8[n], At##8[m], acc[ai][bj][m][n], 0, 0, 0, Epi::SCALE_W, 0, Epi::SCALE_A); } \
        else { _Pragma("unroll") for (int m = 0; m < 4; ++m) _Pragma("unroll") for (int n = 0; n < 2; ++n) _Pragma("unroll") for (int k = 0; k < 2; ++k) \
            acc[ai][bj][m][n] = __builtin_amdgcn_mfma_f32_16x16x32_bf16(Bt[n][k], At[m][k], acc[ai][bj][m][n], 0, 0, 0); } \
        __builtin_amdgcn_s_setprio(0); } while (0)
#define PG8_WAIT_V(n) asm volatile("s_waitcnt vmcnt(" #n ")" ::: "memory")
#define PG8_WAIT_L(n) asm volatile("s_waitcnt lgkmcnt(" #n ")" ::: "memory")
#define PG8_BAR __builtin_amdgcn_s_barrier()
#define PG8_SCHED __builtin_amdgcn_sched_barrier(0)
    Unit cur, nxt; int ui = 0;
    if (!S.next(0, cur)) return;
    f32x4 acc[2][2][4][2];
#pragma unroll
    for (int a = 0; a < 2; ++a)
#pragma unroll
        for (int b = 0; b < 2; ++b)
#pragma unroll
            for (int m = 0; m < 4; ++m)
#pragma unroll
                for (int n = 0; n < 2; ++n) acc[a][b][m][n] = (f32x4){0.f, 0.f, 0.f, 0.f};
    bf16x8 At[4][2], B0[2][2], B1[2][2]; i32x8 At8[4], B08[2], B18[2]; (void)At; (void)B0; (void)B1; (void)At8; (void)B08; (void)B18;
    const char* cA = cur.A; const char* cB = cur.B;
    S.a_ready(cur);
    if constexpr (SP2) {
        PG8_STAGE(PG8_SB(0, 0), cB, voffB); PG8_STAGE(PG8_SB(0, 1), cB + hstep, voffB); PG8_STAGE(PG8_SA(0, 0), cA, voffA); PG8_STAGE(PG8_SA(0, 1), cA + hstep, voffA);
        if (wr == 1) PG8_BAR;
        PG8_WAIT_V(2); PG8_BAR;
        PG8_STAGE(PG8_SB(1, 0), cB + kstep, voffB); PG8_STAGE(PG8_SA(1, 0), cA + kstep, voffA); PG8_STAGE(PG8_SB(1, 1), cB + hstep + kstep, voffB);
        PG8_WAIT_V(6); PG8_BAR;
    } else {
        PG8_STAGE(PG8_SB(0, 0), cB, voffB); PG8_STAGE(PG8_SA(0, 0), cA, voffA); PG8_STAGE(PG8_SB(0, 1), cB + hstep, voffB); PG8_STAGE(PG8_SA(0, 1), cA + hstep, voffA);
        if (wr == 1) PG8_BAR;
        PG8_WAIT_V(4); PG8_BAR;
        PG8_STAGE(PG8_SB(1, 0), cB + kstep, voffB); PG8_STAGE(PG8_SA(1, 0), cA + kstep, voffA); PG8_STAGE(PG8_SB(1, 1), cB + hstep + kstep, voffB);
        PG8_WAIT_V(6); PG8_BAR;
    }
    for (;;) {
        const bool has_next = S.next(ui + 1, nxt);
        const char* nA = has_next ? nxt.A : cA; const char* nB = has_next ? nxt.B : cB;
_Pragma("unroll 1")
        for (int t = 0; t < nt; t += 2) {
            const bool last = (t == nt - 2);
            const char* a1 = cA + (size_t)(t + 1) * kstep;
            const char* a2 = last ? nA : cA + (size_t)(t + 2) * kstep; const char* b2 = last ? nB : cB + (size_t)(t + 2) * kstep;
            const char* a3 = a2 + kstep; const char* b3 = b2 + kstep;
            if (last && has_next) S.a_ready(nxt);
            if constexpr (Epi::PF) { if (t == 2) E.prefetch(cur, (unsigned)(size_t)lds + (unsigned)LDS_PF, wid); }
            if constexpr (SP2) {
            PG8_LDB(B0, 0, 0); PG8_LDB(B1, 0, 1); PG8_SCHED; PG8_LDA(At, 0, 0); PG8_STAGE(PG8_SA(1, 1), a1 + hstep, voffA);
            PG8_WAIT_V(8); PG8_WAIT_L(0); PG8_BAR; PG8_MMA(0, 0, At, B0); PG8_MMA(0, 1, At, B1); PG8_BAR; PG8_SCHED;
            PG8_LDA(At, 0, 1); PG8_STAGE(PG8_SB(0, 0), b2, voffB); PG8_STAGE(PG8_SB(0, 1), b2 + hstep, voffB); PG8_STAGE(PG8_SA(0, 0), a2, voffA);
            PG8_WAIT_V(8); PG8_WAIT_L(0); PG8_BAR; PG8_MMA(1, 0, At, B0); PG8_MMA(1, 1, At, B1); PG8_BAR; PG8_SCHED;
            PG8_LDB(B0, 1, 0); PG8_LDB(B1, 1, 1); PG8_SCHED; PG8_LDA(At, 1, 0); PG8_STAGE(PG8_SA(0, 1), a2 + hstep, voffA);
            PG8_WAIT_V(8); PG8_WAIT_L(0); PG8_BAR; PG8_MMA(0, 0, At, B0); PG8_MMA(0, 1, At, B1); PG8_BAR; PG8_SCHED;
            PG8_LDA(At, 1, 1); PG8_STAGE(PG8_SB(1, 0), b3, voffB); PG8_STAGE(PG8_SB(1, 1), b3 + hstep, voffB); PG8_STAGE(PG8_SA(1, 0), a3, voffA);
            PG8_WAIT_V(8); PG8_WAIT_L(0); PG8_BAR; PG8_MMA(1, 0, At, B0); PG8_MMA(1, 1, At, B1); PG8_BAR; PG8_SCHED;
            } else {
            PG8_LDB(B0, 0, 0); PG8_SCHED; PG8_LDA(At, 0, 0); PG8_STAGE(PG8_SA(1, 1), a1 + hstep, voffA);
            PG8_WAIT_L(8); PG8_BAR; PG8_WAIT_L(0); PG8_MMA(0, 0, At, B0); PG8_BAR; PG8_SCHED;
            PG8_LDB(B1, 0, 1); PG8_STAGE(PG8_SB(0, 0), b2, voffB);
            PG8_BAR; PG8_WAIT_L(0); PG8_MMA(0, 1, At, B1); PG8_BAR;
            PG8_LDA(At, 0, 1); PG8_STAGE(PG8_SA(0, 0), a2, voffA);
            PG8_BAR; PG8_WAIT_L(0); PG8_MMA(1, 0, At, B0); PG8_BAR; PG8_SCHED;
            PG8_STAGE(PG8_SB(0, 1), b2 + hstep, voffB);
            PG8_WAIT_V(6); PG8_BAR; PG8_MMA(1, 1, At, B1); PG8_BAR;
            PG8_LDB(B0, 1, 0); PG8_SCHED; PG8_LDA(At, 1, 0); PG8_STAGE(PG8_SA(0, 1), a2 + hstep, voffA);
            PG8_WAIT_L(8); PG8_BAR; PG8_WAIT_L(0); PG8_MMA(0, 0, At, B0); PG8_BAR; PG8_SCHED;
            PG8_LDB(B1, 1, 1); PG8_STAGE(PG8_SB(1, 0), b3, voffB);
            PG8_BAR; PG8_WAIT_L(0); PG8_MMA(0, 1, At, B1); PG8_BAR;
            PG8_LDA(At, 1, 1); PG8_STAGE(PG8_SA(1, 0), a3, voffA);
            PG8_BAR; PG8_WAIT_L(0); PG8_MMA(1, 0, At, B0); PG8_BAR; PG8_SCHED;
            PG8_STAGE(PG8_SB(1, 1), b3 + hstep, voffB);
            PG8_WAIT_V(6); PG8_BAR; PG8_MMA(1, 1, At, B1); PG8_BAR;
            }
        }
        if constexpr (ALIGN_EPI) { if (wr == 0) PG8_BAR; }
        if constexpr (!Epi::AFTER_DRAIN) { E(acc, cur, wr, wc, fr, fq); S.done(cur); }
        if (!has_next) break;
#pragma unroll
        for (int a = 0; a < 2; ++a)
#pragma unroll
            for (int b = 0; b < 2; ++b)
#pragma unroll
                for (int m = 0; m < 4; ++m)
#pragma unroll
                    for (int n = 0; n < 2; ++n) acc[a][b][m][n] = (f32x4){0.f, 0.f, 0.f, 0.f};
        cur = nxt; cA = nA; cB = nB; ++ui;
        if constexpr (ALIGN_EPI) { if (wr == 1) PG8_BAR; }
    }
    PG8_WAIT_V(0);
    if constexpr (!ALIGN_EPI) { if (wr == 0) PG8_BAR; }
    PG8_BAR;
    if constexpr (Epi::AFTER_DRAIN) { E.fused(acc, cur, wr, wc, fr, fq, lds, wid, lane); S.done(cur); }
#undef PG8_SA
#undef PG8_SB
#undef PG8_STAGE
#undef PG8_LDA
#undef PG8_LDB
#undef PG8_MMA
#undef PG8_WAIT_V
#undef PG8_WAIT_L
#undef PG8_BAR
#undef PG8_SCHED
}

template <int NP, bool UP, int ROWB> struct MoeOrder {
    const volatile LAS int* tab; int layer; const char* A; const char* W;
    __device__ bool next(int i, Unit& u) const {
        const int e = tab[i]; if (e < 0) return false;
        const int mt = e & 0xffff, pn = (e >> 16) & 0xff, cls = e >> 24;
        u.pm = mt; u.pn = pn; u.A = A + (size_t)mt * ((size_t)BM * ROWB);
        if (UP) { const int g = cls / 6, pi = cls % 6, s = pn >> 2, ex = g * 4 + (s ? pair_hi(pi) : pair_lo(pi));
            u.B = W + ((size_t)(layer * NE + ex) * 1024 + (size_t)(pn & 3) * 256) * ROWB; }
        else u.B = W + ((size_t)(layer * NCLS + cls) * 1024 + (size_t)pn * 256) * ROWB;
        return true;
    }
    __device__ __forceinline__ void a_ready(const Unit&) const {}
    __device__ __forceinline__ void done(const Unit&) const {}
};

struct EpiZ {
    static constexpr bool PERM = true, AFTER_DRAIN = false, PF = true;
    bf16_t* Z; const float* ssq; const PG8_LAS unsigned char* pf;
    __device__ __forceinline__ void prefetch(const Unit& u, unsigned lds_addr, int wid) const {
        const char* g = (const char*)(ssq + (size_t)u.pm * BM * 16) + wid * 1024; const unsigned vo = (unsigned)fresh_lane() * 16u;
#pragma unroll
        for (int i = 0; i < 2; ++i) { unsigned keep;
            asm volatile("s_mov_b32 %0, m0\n\ts_mov_b32 m0, %3\n\ts_nop 0\n\tglobal_load_lds_dwordx4 %1, %2\n\ts_mov_b32 m0, %0" : "=&s"(keep) : "v"(vo), "s"(g + i * 8192), "s"(lds_addr + (unsigned)(wid * 1024 + i * 8192)) : "memory"); } }
    __device__ __forceinline__ void operator()(const f32x4 (&acc)[2][2][4][2], const Unit& u, int wr, int wc, int fr, int fq) const {
        { const int ln_ = fresh_lane(); fr = ln_ & 15; fq = ln_ >> 4; }
        const int row0 = u.pm * BM + wr * 64 + fr, col0 = u.pn * BM + wc * 32 + 8 * fq;
        float rr[2][4];
#pragma unroll
        for (int ai = 0; ai < 2; ++ai) {
            f32x4 sp[4];
#pragma unroll
            for (int m = 0; m < 4; ++m) sp[m] = *(const PG8_LAS f32x4*)(pf + (ai * HALF + wr * 64 + m * 16 + fr) * 64 + 16 * fq);
#pragma unroll
            for (int m = 0; m < 4; ++m) { float t = (sp[m][0] + sp[m][1]) + (sp[m][2] + sp[m][3]); t = add_x16_x32(t); rr[ai][m] = __builtin_amdgcn_rsqf(t * (1.0f / D) + EPS); }
        }
#pragma unroll
        for (int ai = 0; ai < 2; ++ai)
#pragma unroll
            for (int m = 0; m < 4; ++m) { const int row = row0 + ai * HALF + m * 16; const float r = rr[ai][m];
                bf16_t* rowp = Z + (size_t)row * INC + col0;
#pragma unroll
                for (int bj = 0; bj < 2; ++bj) { f32x4 v0 = acc[ai][bj][m][0] * r, v1 = acc[ai][bj][m][1] * r;
                    u32x4 w; w.x = cvt_pk_bf16(v0[0], v0[1]); w.y = cvt_pk_bf16(v0[2], v0[3]); w.z = cvt_pk_bf16(v1[0], v1[1]); w.w = cvt_pk_bf16(v1[2], v1[3]);
                    *(u32x4*)(rowp + bj * HALF) = w; } }
    }
};
template <bool SCATTER> struct EpiRes {
    static constexpr bool PERM = true, AFTER_DRAIN = false, PF = SCATTER; static constexpr int SCALE_W = 0x7b7b7b7b, SCALE_A = 0x7b7b7b7b;
    bf16_t* H; float* ssq; const int* rowtok; const PG8_LAS unsigned char* pf;
    __device__ __forceinline__ void prefetch(const Unit& u, unsigned lds_addr, int wid) const {
        if (wid < 4) { const char* g = (const char*)(rowtok + (size_t)u.pm * BM) + wid * 256; const unsigned vo = (unsigned)fresh_lane() * 4u; unsigned keep;
            asm volatile("s_mov_b32 %0, m0\n\ts_mov_b32 m0, %3\n\ts_nop 0\n\tglobal_load_lds_dword %1, %2\n\ts_mov_b32 m0, %0" : "=&s"(keep) : "v"(vo), "s"(g), "s"(lds_addr + (unsigned)(wid * 256)) : "memory"); } }
    __device__ __forceinline__ void operator()(const f32x4 (&acc)[2][2][4][2], const Unit& u, int wr, int wc, int fr, int fq) const {
        { const int ln_ = fresh_lane(); fr = ln_ & 15; fq = ln_ >> 4; }
        const int row0 = u.pm * BM + wr * 64 + fr, col0 = u.pn * BM + wc * 32 + 8 * fq;
        int tokv[2][4];
#pragma unroll
        for (int ai = 0; ai < 2; ++ai)
#pragma unroll
            for (int m = 0; m < 4; ++m) { const int row = row0 + ai * HALF + m * 16; tokv[ai][m] = SCATTER ? *(const PG8_LAS int*)(pf + (ai * HALF + wr * 64 + m * 16 + fr) * 4) : row; }
#pragma unroll
        for (int ai = 0; ai < 2; ++ai) {
            u32x4 o[4][2];
#pragma unroll
            for (int m = 0; m < 4; ++m) { const int tok = tokv[ai][m]; const bf16_t* rowp = H + (size_t)(tok < 0 ? 0 : tok) * D + col0; o[m][0] = *(const u32x4*)(rowp); o[m][1] = *(const u32x4*)(rowp + HALF); }
#pragma unroll
            for (int m = 0; m < 4; ++m) { const int tok = tokv[ai][m]; float s = 0.f; bf16_t* rowp = H + (size_t)(tok < 0 ? 0 : tok) * D + col0;
#pragma unroll
                for (int bj = 0; bj < 2; ++bj) { const u32x4 oo = o[m][bj];
                    f32x4 v0 = acc[ai][bj][m][0], v1 = acc[ai][bj][m][1];
                    v0[0] += __uint_as_float(oo.x << 16); v0[1] += __uint_as_float(oo.x & 0xffff0000u); v0[2] += __uint_as_float(oo.y << 16); v0[3] += __uint_as_float(oo.y & 0xffff0000u);
                    v1[0] += __uint_as_float(oo.z << 16); v1[1] += __uint_as_float(oo.z & 0xffff0000u); v1[2] += __uint_as_float(oo.w << 16); v1[3] += __uint_as_float(oo.w & 0xffff0000u);
                    s += (v0[0] * v0[0] + v0[1] * v0[1]) + (v0[2] * v0[2] + v0[3] * v0[3]) + (v1[0] * v1[0] + v1[1] * v1[1]) + (v1[2] * v1[2] + v1[3] * v1[3]);
                    u32x4 w; w.x = cvt_pk_bf16(v0[0], v0[1]); w.y = cvt_pk_bf16(v0[2], v0[3]); w.z = cvt_pk_bf16(v1[0], v1[1]); w.w = cvt_pk_bf16(v1[2], v1[3]);
                    if (tok >= 0) *(u32x4*)(rowp + bj * HALF) = w; }
                s = add_x16_x32(s);
                if (fq == 0 && tok >= 0) ssq[(size_t)tok * 16 + u.pn * 4 + wc] = s; }
            asm volatile("" ::: "memory"); }
    }
};
constexpr int SC_W = 0x7b7b7b7b, SC_H = 0x7b7b7b7b, SC_ACT = 0x7b7b7b7b;
constexpr float FS_W = 16.f, FS_H = 16.f, FS_ACT = 16.f;
struct EpiUp {
    static constexpr bool PERM = true, AFTER_DRAIN = false, PF = true; static constexpr int SCALE_W = SC_W, SCALE_A = SC_H;
    unsigned char* ACT; const float* rowg; const PG8_LAS unsigned char* pf;
    __device__ __forceinline__ void prefetch(const Unit& u, unsigned lds_addr, int wid) const {
        const char* g = (const char*)(rowg + (size_t)u.pm * BM * 2) + wid * 256; const unsigned vo = (unsigned)fresh_lane() * 4u; unsigned keep;
        asm volatile("s_mov_b32 %0, m0\n\ts_mov_b32 m0, %3\n\ts_nop 0\n\tglobal_load_lds_dword %1, %2\n\ts_mov_b32 m0, %0" : "=&s"(keep) : "v"(vo), "s"(g), "s"(lds_addr + (unsigned)(wid * 256)) : "memory"); }
    __device__ __forceinline__ void operator()(const f32x4 (&acc)[2][2][4][2], const Unit& u, int wr, int wc, int fr, int fq) const {
        { const int ln_ = fresh_lane(); fr = ln_ & 15; fq = ln_ >> 4; }
        const int row0 = u.pm * BM + wr * 64 + fr, s = u.pn >> 2, col0 = s * 512 + (u.pn & 3) * 128 + wc * 32 + 8 * fq;
        float gt[2][4];
#pragma unroll
        for (int ai = 0; ai < 2; ++ai)
#pragma unroll
            for (int m = 0; m < 4; ++m) gt[ai][m] = *(const PG8_LAS float*)(pf + ((ai * HALF + wr * 64 + m * 16 + fr) * 2 + s) * 4);
#pragma unroll
        for (int ai = 0; ai < 2; ++ai)
#pragma unroll
            for (int m = 0; m < 4; ++m) { const int row = row0 + ai * HALF + m * 16; const float g1 = gt[ai][m];
                float o[8];
#pragma unroll
                for (int n = 0; n < 2; ++n)
#pragma unroll
                    for (int j = 0; j < 4; ++j) { const float g = acc[ai][0][m][n][j], up = acc[ai][1][m][n][j]; o[n * 4 + j] = g * sigmoid_fast(g) * up * g1; }
                u32x2 w; w.x = pk_fp8x4(o[0] * FS_ACT, o[1] * FS_ACT, o[2] * FS_ACT, o[3] * FS_ACT); w.y = pk_fp8x4(o[4] * FS_ACT, o[5] * FS_ACT, o[6] * FS_ACT, o[7] * FS_ACT);
                *(u32x2*)(ACT + (size_t)row * 1024 + col0) = w; }
    }
};
}

__device__ __forceinline__ void tr_item(const float* W, int ldw, int k0, int scol0, const float* gk, bf16_t* WT, int ldo, int drow0, int dk0, LAS float* scr, int lane) {
#pragma unroll 8
    for (int i = 0; i < 32; ++i) { const int kk = 2 * i + (lane >> 5); float v = W[(size_t)(k0 + kk) * ldw + scol0 + (lane & 31)]; if (gk) v *= gk[k0 + kk]; scr[kk * 33 + (lane & 31)] = v; }
    asm volatile("s_waitcnt lgkmcnt(0)" ::: "memory");
    const int c = lane & 7;
#pragma unroll
    for (int j = 0; j < 4; ++j) { const int n = (lane >> 3) + 8 * j; const LAS float* s = scr + (8 * c) * 33 + n;
        u32x4 o; o.x = cvt_pk_bf16(s[0 * 33], s[1 * 33]); o.y = cvt_pk_bf16(s[2 * 33], s[3 * 33]); o.z = cvt_pk_bf16(s[4 * 33], s[5 * 33]); o.w = cvt_pk_bf16(s[6 * 33], s[7 * 33]);
        *(u32x4*)(WT + (size_t)(drow0 + n) * ldo + dk0 + 8 * c) = o; }
    asm volatile("s_waitcnt lgkmcnt(0)" ::: "memory");
}

constexpr size_t S5_L_STRIDE = 1310720, S5_KT = 0, S5_ET = 131072, S5_FT = 655360, S5_LAMP = 1179648;
constexpr int S5_WSCR = 8192, S5_YST = 65536, YST_LD = 264;
constexpr int NU128 = T / 128, UPB128 = SEQ / 128;
__device__ __forceinline__ f32x4 mfma16(bf16x8 a, bf16x8 b, f32x4 c) { return __builtin_amdgcn_mfma_f32_16x16x32_bf16(a, b, c, 0, 0, 0); }

__device__ __forceinline__ void s5_kt_pair(int g, int c, int cp, const float* a_re, const float* a_im, const float* log_dt, const float* b_re, const float* b_im,
                                           const float* c_re, const float* c_im, const float* dvec, unsigned char* tab) {
    const float dt = __expf(log_dt[g]); float km[8];
#pragma unroll
    for (int d = 0; d < 8; ++d) km[d] = 0.f;
#pragma unroll 2
    for (int p = 0; p < CS; ++p) { const float lr = a_re[g * CS + p], li = a_im[g * CS + p], zr = lr * dt, zi = li * dt;
        const float sh = __sinf(0.5f * zi), cz = __cosf(zi), sz = __sinf(zi), ez = __expf(zr); const float nr = expm1f(zr) * cz - 2.0f * sh * sh, ni = ez * sz, den = lr * lr + li * li;
        const float cr = (nr * lr + ni * li) / den, ci = (ni * lr - nr * li) / den;
        const float br = b_re[((size_t)g * CS + p) * CGD + cp], bi = b_im[((size_t)g * CS + p) * CGD + cp]; const float bbr = cr * br - ci * bi, bbi = cr * bi + ci * br;
        const float cre = c_re[((size_t)g * CGD + c) * CS + p], cim = c_im[((size_t)g * CGD + c) * CS + p];
        float vr = cre * bbr - cim * bbi, vi = cre * bbi + cim * bbr;
        const float lbr = ez * cz, lbi = ez * sz;
#pragma unroll
        for (int d = 0; d < 8; ++d) { km[d] += vr; const float t = vr * lbr - vi * lbi; vi = vr * lbi + vi * lbr; vr = t; } }
    if (c == cp) km[0] += dvec[g * CGD + c];
    bf16_t* kt = (bf16_t*)(tab + S5_KT) + (size_t)g * 4096;
#pragma unroll
    for (int dd = 0; dd < 8; ++dd) { kt[(dd * 16 + c) * 32 + cp] = f2bf(km[dd]); kt[(dd * 16 + c) * 32 + 16 + cp] = dd >= 1 ? f2bf(km[dd - 1]) : (bf16_t)0; }
}
__device__ __forceinline__ void s5_et_task(int g, int ri, int p, int cp, const float* a_re, const float* a_im, const float* log_dt, const float* b_re, const float* b_im, unsigned char* tab) {
    const float dt = __expf(log_dt[g]); const float lr = a_re[g * CS + p], li = a_im[g * CS + p], zr = lr * dt, zi = li * dt;
    const float sh = __sinf(0.5f * zi), cz = __cosf(zi), sz = __sinf(zi), ez = __expf(zr); const float nr = expm1f(zr) * cz - 2.0f * sh * sh, ni = ez * sz, den = lr * lr + li * li;
    const float cr = (nr * lr + ni * li) / den, ci = (ni * lr - nr * li) / den;
    const float br = b_re[((size_t)g * CS + p) * CGD + cp], bi = b_im[((size_t)g * CS + p) * CGD + cp]; float vr = cr * br - ci * bi, vi = cr * bi + ci * br;
    const float lbr = ez * cz, lbi = ez * sz; bf16_t* et = (bf16_t*)(tab + S5_ET) + (size_t)g * 16384 + (size_t)(ri * 64 + p) * 128 + cp;
#pragma unroll
    for (int sp = 7; sp >= 0; --sp) { et[sp * 16] = f2bf(ri ? vi : vr); const float t = vr * lbr - vi * lbi; vi = vr * lbi + vi * lbr; vr = t; }
}
__device__ __forceinline__ void s5_ft_task(int g, int c, int ri, int p, const float* a_re, const float* a_im, const float* log_dt, const float* c_re, const float* c_im, unsigned char* tab) {
    const float dt = __expf(log_dt[g]); const float lr = a_re[g * CS + p], li = a_im[g * CS + p], zr = lr * dt, zi = li * dt; const float ez = __expf(zr), lbr = ez * __cosf(zi), lbi = ez * __sinf(zi);
    const float cre = c_re[((size_t)g * CGD + c) * CS + p], cim = c_im[((size_t)g * CGD + c) * CS + p]; float vr = cre * lbr - cim * lbi, vi = cre * lbi + cim * lbr;
    bf16_t* ft = (bf16_t*)(tab + S5_FT) + (size_t)g * 16384 + (size_t)c * 128 + ri * 64 + p;
#pragma unroll
    for (int tp = 0; tp < 8; ++tp) { ft[(size_t)tp * 16 * 128] = f2bf(ri ? -vi : vr); const float t = vr * lbr - vi * lbi; vi = vr * lbi + vi * lbr; vr = t; }
}
__device__ __forceinline__ void s5_table_elem(int g, int e, const float* a_re, const float* a_im, const float* log_dt, const float* b_re, const float* b_im,
                                              const float* c_re, const float* c_im, const float* dvec, unsigned char* tab) {
    const float dt = __expf(log_dt[g]);
    if (e < 4096) {
        const int dd = e >> 9, c = (e >> 5) & 15, ee = (e >> 4) & 1, cp = e & 15, d = dd - ee; float s = 0.f;
        if (d >= 0) {
            for (int p = 0; p < CS; ++p) { const float lr = a_re[g * CS + p], li = a_im[g * CS + p], zr = lr * dt, zi = li * dt;
                const float sh = __sinf(0.5f * zi); const float nr = expm1f(zr) * __cosf(zi) - 2.0f * sh * sh, ni = __expf(zr) * __sinf(zi), den = lr * lr + li * li;
                const float cr = (nr * lr + ni * li) / den, ci = (ni * lr - nr * li) / den;
                const float br = b_re[((size_t)g * CS + p) * CGD + cp], bi = b_im[((size_t)g * CS + p) * CGD + cp]; const float bbr = cr * br - ci * bi, bbi = cr * bi + ci * br;
                const float mag = __expf(zr * (float)d), pr = mag * __cosf(zi * (float)d), pi = mag * __sinf(zi * (float)d);
                const float vr = pr * bbr - pi * bbi, vi = pr * bbi + pi * bbr;
                s += c_re[((size_t)g * CGD + c) * CS + p] * vr - c_im[((size_t)g * CGD + c) * CS + p] * vi; }
            if (d == 0 && c == cp) s += dvec[g * CGD + c];
        }
        ((bf16_t*)(tab + S5_KT))[(size_t)g * 4096 + e] = f2bf(s); return;
    }
    e -= 4096;
    if (e < 16384) {
        const int n = e >> 7, k = e & 127, ri = n >> 6, p = n & 63, sp = k >> 4, cp = k & 15;
        const float lr = a_re[g * CS + p], li = a_im[g * CS + p], zr = lr * dt, zi = li * dt;
        const float sh = __sinf(0.5f * zi); const float nr = expm1f(zr) * __cosf(zi) - 2.0f * sh * sh, ni = __expf(zr) * __sinf(zi), den = lr * lr + li * li;
        const float cr = (nr * lr + ni * li) / den, ci = (ni * lr - nr * li) / den;
        const float br = b_re[((size_t)g * CS + p) * CGD + cp], bi = b_im[((size_t)g * CS + p) * CGD + cp]; const float bbr = cr * br - ci * bi, bbi = cr * bi + ci * br;
        const float d = (float)(7 - sp); const float mag = __expf(zr * d), pr = mag * __cosf(zi * d), pi = mag * __sinf(zi * d);
        ((bf16_t*)(tab + S5_ET))[(size_t)g * 16384 + e] = f2bf(ri ? (pr * bbi + pi * bbr) : (pr * bbr - pi * bbi)); return;
    }
    e -= 16384;
    if (e < 16384) {
        const int n = e >> 7, k = e & 127, tp = n >> 4, c = n & 15, ri = k >> 6, p = k & 63;
        const float lr = a_re[g * CS + p], li = a_im[g * CS + p], zr = lr * dt, zi = li * dt;
        const float d = (float)(tp + 1); const float mag = __expf(zr * d), pr = mag * __cosf(zi * d), pi = mag * __sinf(zi * d);
        const float cre = c_re[((size_t)g * CGD + c) * CS + p], cim = c_im[((size_t)g * CGD + c) * CS + p];
        ((bf16_t*)(tab + S5_FT))[(size_t)g * 16384 + e] = f2bf(ri ? -(cre * pi + cim * pr) : (cre * pr - cim * pi)); return;
    }
    e -= 16384;
    { const int p = e; const float lr = a_re[g * CS + p], li = a_im[g * CS + p], zr = lr * dt, zi = li * dt; float* o = (float*)(tab + S5_LAMP) + ((size_t)g * CS + p) * 8;
      float mag = expf(zr); o[0] = mag * cosf(zi); o[1] = mag * sinf(zi);
      mag = expf(zr * 8.f); o[2] = mag * cosf(zi * 8.f); o[3] = mag * sinf(zi * 8.f);
      mag = expf(zr * 128.f); o[4] = mag * cosf(zi * 128.f); o[5] = mag * sinf(zi * 128.f); o[6] = 0.f; o[7] = 0.f; }
}

template <class TT> __device__ __forceinline__ TT ldg(const void* ubase, unsigned voff) { return *(const TT*)((const char*)ubase + voff); }
template <int PASS>
__device__ __forceinline__ void s5_group(int unit, int g, bool first, float& kr, float& ki, int wave, int lane, const bf16_t* Z, bf16_t* Y, const unsigned char* tab, float* SEND, float* SEND2, float* SE, LAS unsigned char* lds) {
    const int ln = lane & 15, q = lane >> 4; const int t0 = unit * 128;
    const char* KTg = (const char*)(tab + S5_KT) + (size_t)g * 8192; const char* ETg = (const char*)(tab + S5_ET) + (size_t)g * 32768; const char* FTg = (const char*)(tab + S5_FT) + (size_t)g * 32768;
    const float* LAMPg = (const float*)(tab + S5_LAMP) + (size_t)g * CS * 8;
    const unsigned vo128 = (unsigned)(ln * 128 + 8 * q) * 2u;
    const unsigned vo32 = (unsigned)(ln * 32 + 8 * q) * 2u;
    LAS float* Sb = (LAS float*)(lds + wave * S5_WSCR); LAS bf16_t* Tb = (LAS bf16_t*)(lds + wave * S5_WSCR); LAS bf16_t* yst = (LAS bf16_t*)(lds + S5_YST);
    char* seb = (char*)(SE + ((size_t)unit * CG + g) * 16 * 128); const unsigned vl = (unsigned)lane * 4u;
    char* ylb = (char*)(Y + (size_t)t0 * D + AW + BW + g * 16); const unsigned vy = (unsigned)((ln * 8) * D + 4 * q) * 2u;
    const float lur = LAMPg[lane * 8 + 4], lui = LAMPg[lane * 8 + 5], l8r = LAMPg[lane * 8 + 2], l8i = LAMPg[lane * 8 + 3];
    float cr = 0.f, ci = 0.f;
    if (PASS == 1) {
        if (!first) { cr = kr; ci = ki; }
        bf16x8 X0, X1, X2, X3;
        { const char* zb = (const char*)(Z + (size_t)t0 * INC + ZC + g * 16); const unsigned vz = (unsigned)((ln * 8 + (q >> 1)) * INC + 8 * (q & 1)) * 2u;
          X0 = ldg<bf16x8>(zb, vz); X1 = ldg<bf16x8>(zb + 2 * INC * 2, vz); X2 = ldg<bf16x8>(zb + 4 * INC * 2, vz); X3 = ldg<bf16x8>(zb + 6 * INC * 2, vz); }
        { LAS float* sw = Sb + (4 * q) * 128 + ln; const char* eb = ETg;
#pragma unroll 1
          for (int jh = 0; jh < 2; ++jh) { bf16x8 ef[4][4];
#pragma unroll
            for (int j = 0; j < 4; ++j)
#pragma unroll
              for (int ks = 0; ks < 4; ++ks) ef[j][ks] = ldg<bf16x8>(eb + j * 4096 + ks * 64, vo128);
#pragma unroll
            for (int j = 0; j < 4; ++j) { f32x4 se = (f32x4){0.f, 0.f, 0.f, 0.f};
              se = mfma16(X0, ef[j][0], se); se = mfma16(X1, ef[j][1], se); se = mfma16(X2, ef[j][2], se); se = mfma16(X3, ef[j][3], se);
              LAS float* s2 = sw + 16 * j; s2[0] = se[0]; s2[128] = se[1]; s2[256] = se[2]; s2[384] = se[3]; }
            eb += 16384; sw += 64; } }
        asm volatile("" ::: "memory");
        { const char* kb = KTg; char* yq = ylb;
#pragma unroll 1
          for (int th = 0; th < 4; ++th) {
              const bf16x8 ka = ldg<bf16x8>(kb, vo32), kc = ldg<bf16x8>(kb + 1024, vo32);
              f32x4 acc0 = (f32x4){0.f, 0.f, 0.f, 0.f}, acc1 = (f32x4){0.f, 0.f, 0.f, 0.f};
              acc0 = mfma16(ka, X0, acc0); acc1 = mfma16(kc, X0, acc1);
              if (th >= 1) { acc0 = mfma16(ldg<bf16x8>(kb - 2048, vo32), X1, acc0); acc1 = mfma16(ldg<bf16x8>(kb - 1024, vo32), X1, acc1); }
              if (th >= 2) { acc0 = mfma16(ldg<bf16x8>(kb - 4096, vo32), X2, acc0); acc1 = mfma16(ldg<bf16x8>(kb - 3072, vo32), X2, acc1); }
              if (th >= 3) { acc0 = mfma16(ldg<bf16x8>(kb - 6144, vo32), X3, acc0); acc1 = mfma16(ldg<bf16x8>(kb - 5120, vo32), X3, acc1); }
              u32x2 w; w.x = cvt_pk_bf16(acc0[0], acc0[1]); w.y = cvt_pk_bf16(acc0[2], acc0[3]); *(u32x2*)(yq + vy) = w;
              w.x = cvt_pk_bf16(acc1[0], acc1[1]); w.y = cvt_pk_bf16(acc1[2], acc1[3]); *(u32x2*)(yq + (size_t)D * 2 + vy) = w;
              kb += 2048; yq += (size_t)2 * D * 2; } }
        asm volatile("" ::: "memory");
        float sr = cr, si = ci;
#pragma unroll
        for (int s = 0; s < 16; ++s) { const float er = Sb[s * 128 + lane], ei = Sb[s * 128 + 64 + lane];
            *(float*)(seb + s * 512 + vl) = er; *(float*)(seb + s * 512 + 256 + vl) = ei;
            const float nr = l8r * sr - l8i * si + er, ni = l8r * si + l8i * sr + ei; sr = nr; si = ni; }
        kr = sr; ki = si;
        float* dst = first ? SEND + (((size_t)unit * CG + g) * 2) * CS + lane : SEND2 + (((size_t)(unit >> 1) * CG + g) * 2) * CS + lane;
        dst[0] = sr; dst[CS] = si; asm volatile("" ::: "memory"); return;
    }
    if (first) { const int pr = unit >> 1, p0 = pr - (pr % (UPB128 / 2)); const float l2r = lur * lur - lui * lui, l2i = 2.0f * lur * lui;
        const char* sb = (const char*)(SEND2 + (((size_t)p0 * CG + g) * 2) * CS);
#pragma unroll 8
        for (int j = p0; j < pr; ++j) { const float sr = ldg<float>(sb, vl), si = ldg<float>(sb + CS * 4, vl); sb += (size_t)CG * 2 * CS * 4;
            const float nr = l2r * cr - l2i * ci + sr, ni = l2r * ci + l2i * cr + si; cr = nr; ci = ni; } }
    else { const float sr = SEND[(((size_t)(unit - 1) * CG + g) * 2 + 0) * CS + lane], si = SEND[(((size_t)(unit - 1) * CG + g) * 2 + 1) * CS + lane];
        cr = lur * kr - lui * ki + sr; ci = lur * ki + lui * kr + si; }
    kr = cr; ki = ci;
    { float sre[16], sim[16];
#pragma unroll
      for (int s = 0; s < 16; ++s) { sre[s] = ldg<float>(seb + s * 512, vl); sim[s] = ldg<float>(seb + s * 512 + 256, vl); }
      float sr = cr, si = ci;
#pragma unroll
      for (int s = 0; s < 16; ++s) { Tb[s * 128 + lane] = f2bf(sr); Tb[s * 128 + 64 + lane] = f2bf(si);
          const float nr = l8r * sr - l8i * si + sre[s], ni = l8r * si + l8i * sr + sim[s]; sr = nr; si = ni; } }
    asm volatile("" ::: "memory");
    const bf16x8 T0 = *(const LAS bf16x8*)(Tb + ln * 128 + 8 * q), T1 = *(const LAS bf16x8*)(Tb + ln * 128 + 32 + 8 * q), T2 = *(const LAS bf16x8*)(Tb + ln * 128 + 64 + 8 * q), T3 = *(const LAS bf16x8*)(Tb + ln * 128 + 96 + 8 * q);
    { LAS bf16_t* yw = yst + (ln * 8) * YST_LD + g * 16 + 4 * q; const char* fb = FTg; const char* yq = ylb;
#pragma unroll 2
      for (int th = 0; th < 4; ++th) { bf16x8 ff[2][4]; u32x2 yl[2];
#pragma unroll
          for (int j = 0; j < 2; ++j) { yl[j] = ldg<u32x2>(yq + (size_t)j * D * 2, vy);
#pragma unroll
              for (int ks = 0; ks < 4; ++ks) ff[j][ks] = ldg<bf16x8>(fb + j * 4096 + ks * 64, vo128); }
#pragma unroll
          for (int j = 0; j < 2; ++j) {
              f32x4 acc; acc[0] = __uint_as_float(yl[j].x << 16); acc[1] = __uint_as_float(yl[j].x & 0xffff0000u); acc[2] = __uint_as_float(yl[j].y << 16); acc[3] = __uint_as_float(yl[j].y & 0xffff0000u);
              acc = mfma16(ff[j][0], T0, acc); acc = mfma16(ff[j][1], T1, acc); acc = mfma16(ff[j][2], T2, acc); acc = mfma16(ff[j][3], T3, acc);
              u32x2 w; w.x = cvt_pk_bf16(gelu_fast(acc[0]), gelu_fast(acc[1])); w.y = cvt_pk_bf16(gelu_fast(acc[2]), gelu_fast(acc[3]));
              *(LAS u32x2*)(yw + j * YST_LD) = w; }
          fb += 8192; yq += (size_t)2 * D * 2; yw += 2 * YST_LD; } }
    asm volatile("s_waitcnt lgkmcnt(0)" ::: "memory");
}
__device__ __forceinline__ void s5_pair1(int pr, int g, int wave, int lane, const bf16_t* Z, bf16_t* Y, const unsigned char* tab, float* SEND, float* SEND2, float* SE, LAS unsigned char* lds) {
    const int ln = lane & 15, q = lane >> 4; const int t0 = pr * 256;
    const char* KTg = (const char*)(tab + S5_KT) + (size_t)g * 8192; const char* ETg = (const char*)(tab + S5_ET) + (size_t)g * 32768;
    const float* LAMPg = (const float*)(tab + S5_LAMP) + (size_t)g * CS * 8;
    const unsigned vo128 = (unsigned)(ln * 128 + 8 * q) * 2u, vo32 = (unsigned)(ln * 32 + 8 * q) * 2u, vl = (unsigned)lane * 4u;
    LAS float* SbA = (LAS float*)(lds + wave * 16384); LAS float* SbB = SbA + 2048;
    bf16x8 XA0, XA1, XA2, XA3, XB0, XB1, XB2, XB3;
    { const char* zb = (const char*)(Z + (size_t)t0 * INC + ZC + g * 16); const unsigned vz = (unsigned)((ln * 8 + (q >> 1)) * INC + 8 * (q & 1)) * 2u;
      XA0 = ldg<bf16x8>(zb, vz); XA1 = ldg<bf16x8>(zb + 2 * INC * 2, vz); XA2 = ldg<bf16x8>(zb + 4 * INC * 2, vz); XA3 = ldg<bf16x8>(zb + 6 * INC * 2, vz);
      const char* zc = zb + (size_t)128 * INC * 2;
      XB0 = ldg<bf16x8>(zc, vz); XB1 = ldg<bf16x8>(zc + 2 * INC * 2, vz); XB2 = ldg<bf16x8>(zc + 4 * INC * 2, vz); XB3 = ldg<bf16x8>(zc + 6 * INC * 2, vz); }
    { LAS float* sw = SbA + (4 * q) * 128 + ln; const char* eb = ETg;
#pragma unroll
      for (int jh = 0; jh < 2; ++jh) { bf16x8 ef[4][4];
#pragma unroll
        for (int j = 0; j < 4; ++j)
#pragma unroll
          for (int ks = 0; ks < 4; ++ks) ef[j][ks] = ldg<bf16x8>(eb + j * 4096 + ks * 64, vo128);
#pragma unroll
        for (int j = 0; j < 4; ++j) { f32x4 sa = (f32x4){0.f, 0.f, 0.f, 0.f}, sb = (f32x4){0.f, 0.f, 0.f, 0.f};
          sa = mfma16(XA0, ef[j][0], sa); sb = mfma16(XB0, ef[j][0], sb); sa = mfma16(XA1, ef[j][1], sa); sb = mfma16(XB1, ef[j][1], sb);
          sa = mfma16(XA2, ef[j][2], sa); sb = mfma16(XB2, ef[j][2], sb); sa = mfma16(XA3, ef[j][3], sa); sb = mfma16(XB3, ef[j][3], sb);
          LAS float* s2 = sw + 16 * j; s2[0] = sa[0]; s2[128] = sa[1]; s2[256] = sa[2]; s2[384] = sa[3]; s2[2048] = sb[0]; s2[2048 + 128] = sb[1]; s2[2048 + 256] = sb[2]; s2[2048 + 384] = sb[3]; }
        eb += 16384; sw += 64; } }
    asm volatile("" ::: "memory");
    { const char* kb = KTg; char* yq = (char*)(Y + (size_t)t0 * D + AW + BW + g * 16); const unsigned vy = (unsigned)((ln * 8) * D + 4 * q) * 2u;
#pragma unroll 1
      for (int th = 0; th < 4; ++th) {
          const bf16x8 ka = ldg<bf16x8>(kb, vo32), kc = ldg<bf16x8>(kb + 1024, vo32);
          f32x4 a0 = (f32x4){0.f, 0.f, 0.f, 0.f}, a1 = a0, b0 = a0, b1 = a0;
          a0 = mfma16(ka, XA0, a0); a1 = mfma16(kc, XA0, a1); b0 = mfma16(ka, XB0, b0); b1 = mfma16(kc, XB0, b1);
          if (th >= 1) { const bf16x8 k0 = ldg<bf16x8>(kb - 2048, vo32), k1 = ldg<bf16x8>(kb - 1024, vo32); a0 = mfma16(k0, XA1, a0); a1 = mfma16(k1, XA1, a1); b0 = mfma16(k0, XB1, b0); b1 = mfma16(k1, XB1, b1); }
          if (th >= 2) { const bf16x8 k0 = ldg<bf16x8>(kb - 4096, vo32), k1 = ldg<bf16x8>(kb - 3072, vo32); a0 = mfma16(k0, XA2, a0); a1 = mfma16(k1, XA2, a1); b0 = mfma16(k0, XB2, b0); b1 = mfma16(k1, XB2, b1); }
          if (th >= 3) { const bf16x8 k0 = ldg<bf16x8>(kb - 6144, vo32), k1 = ldg<bf16x8>(kb - 5120, vo32); a0 = mfma16(k0, XA3, a0); a1 = mfma16(k1, XA3, a1); b0 = mfma16(k0, XB3, b0); b1 = mfma16(k1, XB3, b1); }
          u32x2 w; w.x = cvt_pk_bf16(a0[0], a0[1]); w.y = cvt_pk_bf16(a0[2], a0[3]); *(u32x2*)(yq + vy) = w;
          w.x = cvt_pk_bf16(a1[0], a1[1]); w.y = cvt_pk_bf16(a1[2], a1[3]); *(u32x2*)(yq + (size_t)D * 2 + vy) = w;
          w.x = cvt_pk_bf16(b0[0], b0[1]); w.y = cvt_pk_bf16(b0[2], b0[3]); *(u32x2*)(yq + (size_t)128 * D * 2 + vy) = w;
          w.x = cvt_pk_bf16(b1[0], b1[1]); w.y = cvt_pk_bf16(b1[2], b1[3]); *(u32x2*)(yq + (size_t)129 * D * 2 + vy) = w;
          kb += 2048; yq += (size_t)2 * D * 2; } }
    asm volatile("" ::: "memory");
    const float l8r = LAMPg[lane * 8 + 2], l8i = LAMPg[lane * 8 + 3];
    float sr = 0.f, si = 0.f;
    { char* seb = (char*)(SE + ((size_t)(2 * pr) * CG + g) * 16 * 128);
#pragma unroll
      for (int s = 0; s < 16; ++s) { const float er = SbA[s * 128 + lane], ei = SbA[s * 128 + 64 + lane];
          *(float*)(seb + s * 512 + vl) = er; *(float*)(seb + s * 512 + 256 + vl) = ei;
          const float nr = l8r * sr - l8i * si + er, ni = l8r * si + l8i * sr + ei; sr = nr; si = ni; }
      float* dst = SEND + (((size_t)(2 * pr) * CG + g) * 2) * CS + lane; dst[0] = sr; dst[CS] = si; }
    { char* seb = (char*)(SE + ((size_t)(2 * pr + 1) * CG + g) * 16 * 128);
#pragma unroll
      for (int s = 0; s < 16; ++s) { const float er = SbB[s * 128 + lane], ei = SbB[s * 128 + 64 + lane];
          *(float*)(seb + s * 512 + vl) = er; *(float*)(seb + s * 512 + 256 + vl) = ei;
          const float nr = l8r * sr - l8i * si + er, ni = l8r * si + l8i * sr + ei; sr = nr; si = ni; }
      float* dst = SEND2 + (((size_t)pr * CG + g) * 2) * CS + lane; dst[0] = sr; dst[CS] = si; }
    asm volatile("s_waitcnt lgkmcnt(0)" ::: "memory");
}
constexpr int S5_PSG = 133120;
__device__ __forceinline__ void s5_glu(int unit, int wave, int lane, const bf16_t* WGLU, const float* glu_b, const float* mo_gc, bf16_t* Y, LAS unsigned char* lds) {
    const int ln = lane & 15, q = lane >> 4; LAS bf16_t* yst = (LAS bf16_t*)(lds + S5_YST); LAS float* PSg = (LAS float*)(lds + S5_PSG);
    bf16x8 wf[2][8];
    { const char* wb = (const char*)(WGLU + (size_t)(32 * wave) * 256); const unsigned vw = (unsigned)(ln * 256 + 8 * q) * 2u;
#pragma unroll
      for (int j = 0; j < 2; ++j)
#pragma unroll
          for (int ks = 0; ks < 8; ++ks) wf[j][ks] = ldg<bf16x8>(wb + j * 8192 + ks * 64, vw); }
    const f32x4 gb0 = *(const f32x4*)(glu_b + 32 * wave + 4 * q), gb1 = *(const f32x4*)(glu_b + 32 * wave + 16 + 4 * q);
    LAS bf16_t* op = (LAS bf16_t*)(lds + wave * S5_WSCR) + ln * 32 + 4 * q;
    { const LAS bf16_t* yrow = yst + ln * YST_LD; LAS float* psw = PSg + ln * 8 + wave; LAS bf16_t* ow = op;
#pragma unroll 4
      for (int tt = 0; tt < 8; ++tt) {
        f32x4 a0 = (f32x4){0.f, 0.f, 0.f, 0.f}, a1 = (f32x4){0.f, 0.f, 0.f, 0.f};
#pragma unroll
        for (int ks = 0; ks < 8; ++ks) { const bf16x8 yf = *(const LAS bf16x8*)(yrow + 32 * ks + 8 * q); a0 = mfma16(wf[0][ks], yf, a0); a1 = mfma16(wf[1][ks], yf, a1); }
        const u32x2 y0 = *(const LAS u32x2*)(yrow + 32 * wave + 4 * q), y1 = *(const LAS u32x2*)(yrow + 32 * wave + 16 + 4 * q);
        float o[8];
        o[0] = __uint_as_float(y0.x << 16) * sigmoid_fast(a0[0] + gb0[0]); o[1] = __uint_as_float(y0.x & 0xffff0000u) * sigmoid_fast(a0[1] + gb0[1]); o[2] = __uint_as_float(y0.y << 16) * sigmoid_fast(a0[2] + gb0[2]); o[3] = __uint_as_float(y0.y & 0xffff0000u) * sigmoid_fast(a0[3] + gb0[3]);
        o[4] = __uint_as_float(y1.x << 16) * sigmoid_fast(a1[0] + gb1[0]); o[5] = __uint_as_float(y1.x & 0xffff0000u) * sigmoid_fast(a1[1] + gb1[1]); o[6] = __uint_as_float(y1.y << 16) * sigmoid_fast(a1[2] + gb1[2]); o[7] = __uint_as_float(y1.y & 0xffff0000u) * sigmoid_fast(a1[3] + gb1[3]);
        float ss = ((o[0] * o[0] + o[1] * o[1]) + (o[2] * o[2] + o[3] * o[3])) + ((o[4] * o[4] + o[5] * o[5]) + (o[6] * o[6] + o[7] * o[7]));
        ss = add_x16_x32(ss);
        if (q == 0) *psw = ss;
        u32x2 w; w.x = cvt_pk_bf16(o[0], o[1]); w.y = cvt_pk_bf16(o[2], o[3]); *(LAS u32x2*)(ow) = w; w.x = cvt_pk_bf16(o[4], o[5]); w.y = cvt_pk_bf16(o[6], o[7]); *(LAS u32x2*)(ow + 16) = w;
        yrow += 16 * YST_LD; psw += 16 * 8; ow += 16 * 32; } }
    asm volatile("s_waitcnt lgkmcnt(0)" ::: "memory");
    __syncthreads();
    { const int p = lane & 31, rsel = lane >> 5; const f32x4 g0 = *(const f32x4*)(mo_gc + 8 * p), g1 = *(const f32x4*)(mo_gc + 8 * p + 4);
      const LAS unsigned char* src = lds + (p >> 2) * S5_WSCR + (p & 3) * 16; bf16_t* yb = Y + (size_t)(unit * 128) * D + AW + BW + 8 * p;
#pragma unroll 4
      for (int it = 0; it < 8; ++it) { const int row = 16 * wave + 2 * it + rsel; const LAS f32x4* pp = (const LAS f32x4*)(PSg + row * 8); const f32x4 p0 = pp[0], p1 = pp[1];
        const float rs = __builtin_amdgcn_rsqf((((p0[0] + p0[1]) + (p0[2] + p0[3])) + ((p1[0] + p1[1]) + (p1[2] + p1[3]))) * (1.0f / CW) + EPS);
        const u32x4 a = *(const LAS u32x4*)(src + row * 64); u32x4 w;
        w.x = cvt_pk_bf16(__uint_as_float(a.x << 16) * rs * g0[0], __uint_as_float(a.x & 0xffff0000u) * rs * g0[1]); w.y = cvt_pk_bf16(__uint_as_float(a.y << 16) * rs * g0[2], __uint_as_float(a.y & 0xffff0000u) * rs * g0[3]);
        w.z = cvt_pk_bf16(__uint_as_float(a.z << 16) * rs * g1[0], __uint_as_float(a.z & 0xffff0000u) * rs * g1[1]); w.w = cvt_pk_bf16(__uint_as_float(a.w << 16) * rs * g1[2], __uint_as_float(a.w & 0xffff0000u) * rs * g1[3]);
        *(u32x4*)(yb + (size_t)row * D) = w; } }
}

constexpr int XC_LD = 392;
constexpr int RG_XC = 0, RG_PS = 100352, RG_CAR = 112640, RG_RSB = 114176, RG_PT = 114688, RG_HC = 116224;
template <int CTRL> __device__ __forceinline__ float dpp0(float v) { return __int_as_float(__builtin_amdgcn_update_dpp(0, __float_as_int(v), CTRL, 0xf, 0xf, true)); }
template <int CTRL> __device__ __forceinline__ float dppf(float old, float v) { return __int_as_float(__builtin_amdgcn_update_dpp(__float_as_int(old), __float_as_int(v), CTRL, 0xf, 0xf, false)); }
__device__ __forceinline__ void bf8_to_f32(const u32x4 o, float (&v)[8]) {
    v[0] = __uint_as_float(o.x << 16); v[1] = __uint_as_float(o.x & 0xffff0000u); v[2] = __uint_as_float(o.y << 16); v[3] = __uint_as_float(o.y & 0xffff0000u);
    v[4] = __uint_as_float(o.z << 16); v[5] = __uint_as_float(o.z & 0xffff0000u); v[6] = __uint_as_float(o.w << 16); v[7] = __uint_as_float(o.w & 0xffff0000u);
}
__device__ __forceinline__ float bcast15(float v) { return __int_as_float(__builtin_amdgcn_ds_swizzle(__float_as_int(v), 0x1F0)); }
template <int PASS>
__device__ __forceinline__ void rglru_unit(int unit, bool first, float& cprev, int tid, int wave, int lane, const bf16_t* Z, bf16_t* Y, const bf16_t* WRG, const bf16_t* WIG,
                                           const float* conv_w, const float* conv_b, const float* rg_b, const float* ig_b, const float* lam, const float* mo_gb,
                                           float* SUMA, float* SUMH, float* SUMA2, float* SUMH2, bf16_t* HL, bf16_t* PP, LAS unsigned char* lds) {
    LAS bf16_t* xcl = (LAS bf16_t*)(lds + RG_XC); LAS float* PS = (LAS float*)(lds + RG_PS); LAS float* CAR = (LAS float*)(lds + RG_CAR); LAS float* RSB = (LAS float*)(lds + RG_RSB); LAS float* PT = (LAS float*)(lds + RG_PT); LAS float* HC = (LAS float*)(lds + RG_HC);
    const int t0 = unit * 128; const int ln = lane & 15, q = lane >> 4;
    if (tid < 384) {
        const int c0 = (tid % 48) * 8, tg = tid / 48; const int tb = t0 + tg * 16, s0 = tb % SEQ;
        float w0[8], w1[8], w2[8], w3[8], bb[8];
#pragma unroll
        for (int hh = 0; hh < 2; ++hh) { const f32x4 a0 = *(const f32x4*)(conv_w + 0 * BW + c0 + 4 * hh), a1 = *(const f32x4*)(conv_w + 1 * BW + c0 + 4 * hh), a2 = *(const f32x4*)(conv_w + 2 * BW + c0 + 4 * hh), a3 = *(const f32x4*)(conv_w + 3 * BW + c0 + 4 * hh), a4 = *(const f32x4*)(conv_b + c0 + 4 * hh);
#pragma unroll
            for (int j = 0; j < 4; ++j) { w0[4 * hh + j] = a0[j]; w1[4 * hh + j] = a1[j]; w2[4 * hh + j] = a2[j]; w3[4 * hh + j] = a3[j]; bb[4 * hh + j] = a4[j]; } }
        float xm1[8], xm2[8], xm3[8];
        const bf16_t* zp = Z + (size_t)tb * INC + ZX + c0;
        { const u32x4 z4 = {0u, 0u, 0u, 0u}; const u32x4 o1 = s0 >= 1 ? *(const u32x4*)(zp - INC) : z4, o2 = s0 >= 2 ? *(const u32x4*)(zp - 2 * INC) : z4, o3 = s0 >= 3 ? *(const u32x4*)(zp - 3 * INC) : z4;
          bf8_to_f32(o1, xm1); bf8_to_f32(o2, xm2); bf8_to_f32(o3, xm3); }
        LAS bf16_t* xw = xcl + (tg * 16) * XC_LD + c0;
#pragma unroll 4
        for (int i = 0; i < 16; ++i) { float x0[8]; bf8_to_f32(*(const u32x4*)(zp), x0); float v[8];
#pragma unroll
            for (int j = 0; j < 8; ++j) { v[j] = bb[j] + w3[j] * x0[j] + w2[j] * xm1[j] + w1[j] * xm2[j] + w0[j] * xm3[j]; xm3[j] = xm2[j]; xm2[j] = xm1[j]; xm1[j] = x0[j]; }
            u32x4 w; w.x = cvt_pk_bf16(v[0], v[1]); w.y = cvt_pk_bf16(v[2], v[3]); w.z = cvt_pk_bf16(v[4], v[5]); w.w = cvt_pk_bf16(v[6], v[7]);
            *(LAS u32x4*)(xw) = w; zp += INC; xw += XC_LD; }
        if (PASS == 2) { const int c = tid; float h;
            if (first) { const int pr = unit >> 1, p0 = pr - (pr % (UPB128 / 2)); h = 0.f; const float* pa = SUMA2 + (size_t)p0 * BW + c; const float* ph = SUMH2 + (size_t)p0 * BW + c;
#pragma unroll 8
                for (int j = p0; j < pr; ++j) { h = fmaf(*pa, h, *ph); pa += BW; ph += BW; } }
            else h = fmaf(SUMA[(size_t)(unit - 1) * BW + c], cprev, SUMH[(size_t)(unit - 1) * BW + c]);
            cprev = h; CAR[c] = h; }
    }
    __syncthreads();
#pragma unroll 1
    for (int ci = 0; ci < 3; ++ci) {
        const int combo = wave + 8 * ci, h = combo >> 2, jt = combo & 3, cb = h * 64 + jt * 16;
        const bf16_t* wr = WRG + ((size_t)(h * 64 + jt * 16 + ln)) * 64 + 8 * q; const bf16_t* wi = WIG + ((size_t)(h * 64 + jt * 16 + ln)) * 64 + 8 * q;
        const bf16x8 RG0 = *(const bf16x8*)(wr), RG1 = *(const bf16x8*)(wr + 32), IG0 = *(const bf16x8*)(wi), IG1 = *(const bf16x8*)(wi + 32);
        const f32x4 rgb4 = *(const f32x4*)(rg_b + cb + 4 * q), igb4 = *(const f32x4*)(ig_b + cb + 4 * q), lam4 = *(const f32x4*)(lam + cb + 4 * q);
        const float m1 = ln < 1 ? 1.f : 0.f, m2 = ln < 2 ? 1.f : 0.f, m4 = ln < 4 ? 1.f : 0.f, m8 = ln < 8 ? 1.f : 0.f;
        float spc[4], car[4], ptot[4];
#pragma unroll
        for (int r = 0; r < 4; ++r) { spc[r] = -8.0f * 1.4426950408889634f * log1pf(expf(-lam4[r])); car[r] = PASS == 2 ? CAR[cb + 4 * q + r] : (first ? 0.f : HC[cb + 4 * q + r]); ptot[r] = (PASS == 1 && !first) ? PT[cb + 4 * q + r] : 1.f; }
        const LAS bf16_t* xb = xcl + ln * XC_LD + h * 64 + 8 * q; const LAS bf16_t* xv = xcl + ln * XC_LD + cb + 4 * q;
        const bf16_t* zg = Z + (size_t)(t0 + ln) * INC + ZG + cb + 4 * q; bf16_t* yo = Y + (size_t)(t0 + ln) * D + AW + cb + 4 * q; LAS float* psw = PS + ln * 24 + combo;
        bf16_t* hlo = HL + (size_t)(t0 + ln) * BW + cb + 4 * q; bf16_t* ppo = PP + (size_t)(t0 + ln) * BW + cb + 4 * q;
#pragma unroll 1
        for (int tt = 0; tt < 8; ++tt) {
            const bf16x8 B0 = *(const LAS bf16x8*)(xb), B1 = *(const LAS bf16x8*)(xb + 32);
            f32x4 ar = (f32x4){0.f, 0.f, 0.f, 0.f}, ai = (f32x4){0.f, 0.f, 0.f, 0.f};
            ar = mfma16(RG0, B0, ar); ar = mfma16(RG1, B1, ar); ai = mfma16(IG0, B0, ai); ai = mfma16(IG1, B1, ai);
            const u32x2 xq = *(const LAS u32x2*)(xv); float xc4[4] = {__uint_as_float(xq.x << 16), __uint_as_float(xq.x & 0xffff0000u), __uint_as_float(xq.y << 16), __uint_as_float(xq.y & 0xffff0000u)};
            float hv[4], pv[4];
#pragma unroll
            for (int r = 0; r < 4; ++r) {
                const float rr = sigmoid_fast(ar[r] + rgb4[r]), ii = sigmoid_fast(ai[r] + igb4[r]);
                float A = __builtin_amdgcn_exp2f(spc[r] * rr);
                float Bv = __builtin_amdgcn_sqrtf(fmaxf(1.0f - A * A, 0.f)) * (ii * xc4[r]);
                if (ln == 0) { Bv = fmaf(A, car[r], Bv); A *= ptot[r]; }
                { const float As = dpp0<0x111>(A) + m1, Bs = dpp0<0x111>(Bv); Bv = fmaf(A, Bs, Bv); A *= As; }
                { const float As = dpp0<0x112>(A) + m2, Bs = dpp0<0x112>(Bv); Bv = fmaf(A, Bs, Bv); A *= As; }
                { const float As = dpp0<0x114>(A) + m4, Bs = dpp0<0x114>(Bv); Bv = fmaf(A, Bs, Bv); A *= As; }
                { const float As = dpp0<0x118>(A) + m8, Bs = dpp0<0x118>(Bv); Bv = fmaf(A, Bs, Bv); A *= As; }
                hv[r] = Bv; pv[r] = A; car[r] = dppf<0x121>(Bv, Bv); ptot[r] = dppf<0x121>(A, A);
            }
            if (PASS == 1) { u32x2 w; w.x = cvt_pk_bf16(hv[0], hv[1]); w.y = cvt_pk_bf16(hv[2], hv[3]); *(u32x2*)(hlo) = w; w.x = cvt_pk_bf16(pv[0], pv[1]); w.y = cvt_pk_bf16(pv[2], pv[3]); *(u32x2*)(ppo) = w; hlo += 16 * BW; ppo += 16 * BW; }
            if (PASS == 2) { const u32x2 gq = *(const u32x2*)(zg);
                const float y0 = hv[0] * __uint_as_float(gq.x << 16), y1 = hv[1] * __uint_as_float(gq.x & 0xffff0000u), y2 = hv[2] * __uint_as_float(gq.y << 16), y3 = hv[3] * __uint_as_float(gq.y & 0xffff0000u);
                u32x2 w; w.x = cvt_pk_bf16(y0, y1); w.y = cvt_pk_bf16(y2, y3); *(u32x2*)(yo) = w;
                float ss = (y0 * y0 + y1 * y1) + (y2 * y2 + y3 * y3); ss += __shfl_xor(ss, 16); ss += __shfl_xor(ss, 32);
                if (q == 0) *psw = ss; }
            xb += 16 * XC_LD; xv += 16 * XC_LD; zg += 16 * INC; yo += 16 * D; psw += 16 * 24;
        }
        if (PASS == 1 && ln == 0) {
            float* da = first ? SUMA + (size_t)unit * BW : SUMA2 + (size_t)(unit >> 1) * BW; float* dh = first ? SUMH + (size_t)unit * BW : SUMH2 + (size_t)(unit >> 1) * BW;
#pragma unroll
            for (int r = 0; r < 4; ++r) { da[cb + 4 * q + r] = ptot[r]; dh[cb + 4 * q + r] = car[r]; if (first) { PT[cb + 4 * q + r] = ptot[r]; HC[cb + 4 * q + r] = car[r]; } } }
    }
    if (PASS == 2) {
        asm volatile("s_waitcnt vmcnt(0)" ::: "memory");
        __syncthreads();
        if (tid < 128) { float s = 0.f;
#pragma unroll
            for (int k = 0; k < 24; ++k) s += PS[tid * 24 + k];
            RSB[tid] = __builtin_amdgcn_rsqf(s * (1.0f / BW) + EPS); }
        __syncthreads();
#pragma unroll 2
        for (int k = 0; k < 12; ++k) { const int idx = tid + 512 * k, tl = idx / 48, c0 = (idx % 48) * 8; const float rs = RSB[tl];
            bf16_t* yp = Y + (size_t)(t0 + tl) * D + AW + c0; float v[8]; bf8_to_f32(*(const u32x4*)(yp), v);
            const f32x4 g0 = *(const f32x4*)(mo_gb + c0), g1 = *(const f32x4*)(mo_gb + c0 + 4);
            u32x4 w; w.x = cvt_pk_bf16(v[0] * rs * g0[0], v[1] * rs * g0[1]); w.y = cvt_pk_bf16(v[2] * rs * g0[2], v[3] * rs * g0[3]); w.z = cvt_pk_bf16(v[4] * rs * g1[0], v[5] * rs * g1[1]); w.w = cvt_pk_bf16(v[6] * rs * g1[2], v[7] * rs * g1[3]);
            *(u32x4*)(yp) = w; }
    }
    __syncthreads();
}

__device__ __forceinline__ void rglru_fix_pair(int pr, int tid, int wave, int lane, const bf16_t* Z, bf16_t* Y, const bf16_t* HL, const bf16_t* PP, const float* SUMA2, const float* SUMH2, const float* mo_gb, LAS unsigned char* lds) {
    LAS float* CAR = (LAS float*)(lds + RG_CAR);
    if (tid < 384) { const int c = tid, p0 = pr - (pr % (UPB128 / 2)); float h = 0.f; const float* pa = SUMA2 + (size_t)p0 * BW + c; const float* ph = SUMH2 + (size_t)p0 * BW + c;
#pragma unroll 8
        for (int j = p0; j < pr; ++j) { h = fmaf(*pa, h, *ph); pa += BW; ph += BW; }
        CAR[c] = h; }
    __syncthreads();
    {
        typedef unsigned u32x3 __attribute__((ext_vector_type(3)));
        const int c0 = lane * 6; float hin[6], gch[6];
#pragma unroll
        for (int e = 0; e < 6; ++e) { hin[e] = CAR[c0 + e]; gch[e] = mo_gb[c0 + e]; }
#pragma unroll 2
        for (int i = 0; i < 32; ++i) { const size_t t = (size_t)pr * 256 + wave * 32 + i;
            const u32x3 h3 = *(const u32x3*)(HL + t * BW + c0), p3 = *(const u32x3*)(PP + t * BW + c0), g3 = *(const u32x3*)(Z + t * INC + ZG + c0);
            float y[6]; float ss = 0.f;
#pragma unroll
            for (int e = 0; e < 3; ++e) { const unsigned hh = h3[e], pq = p3[e], gq = g3[e];
                y[2 * e] = fmaf(__uint_as_float(pq << 16), hin[2 * e], __uint_as_float(hh << 16)) * gelu_fast(__uint_as_float(gq << 16));
                y[2 * e + 1] = fmaf(__uint_as_float(pq & 0xffff0000u), hin[2 * e + 1], __uint_as_float(hh & 0xffff0000u)) * gelu_fast(__uint_as_float(gq & 0xffff0000u));
                ss += y[2 * e] * y[2 * e] + y[2 * e + 1] * y[2 * e + 1]; }
            ss = wave_sum(ss);
            const float rs = __builtin_amdgcn_rsqf(ss * (1.0f / BW) + EPS);
            u32x3 w; w.x = cvt_pk_bf16(y[0] * rs * gch[0], y[1] * rs * gch[1]); w.y = cvt_pk_bf16(y[2] * rs * gch[2], y[3] * rs * gch[3]); w.z = cvt_pk_bf16(y[4] * rs * gch[4], y[5] * rs * gch[5]);
            *(u32x3*)(Y + t * D + AW + c0) = w; }
    }
    __syncthreads();
}

constexpr int VT_LD = 136;
__device__ __forceinline__ void mixa_unit(int unit, int tid, int wave, int lane, const bf16_t* Z, bf16_t* Y, const bf16_t* WSP, const float* a_sb, const float* vg, const float* mo_ga, LAS unsigned char* lds) {
    LAS bf16_t* vT = (LAS bf16_t*)lds; const int t0 = unit * 128; const int ln = lane & 15, q = lane >> 4;
    { const int j = tid >> 2, part = tid & 3; const bf16_t* zp = Z + (size_t)(t0 + j) * INC + ZV + part * 8;
      u32x4 raw[12]; float ss = 0.f;
#pragma unroll
      for (int k = 0; k < 12; ++k) { const u32x4 rw = *(const u32x4*)(zp + 32 * k); float v[8]; bf8_to_f32(rw, v);
#pragma unroll
          for (int e = 0; e < 8; ++e) { v[e] = gelu_fast(v[e]); ss += v[e] * v[e]; }
          raw[k].x = cvt_pk_bf16(v[0], v[1]); raw[k].y = cvt_pk_bf16(v[2], v[3]); raw[k].z = cvt_pk_bf16(v[4], v[5]); raw[k].w = cvt_pk_bf16(v[6], v[7]); }
      ss += x_xor1(ss); ss += x_xor2(ss);
      const float rs = __builtin_amdgcn_rsqf(ss * (1.0f / AW) + EPS);
      LAS bf16_t* vw = vT + (part * 8) * VT_LD + j; const float* gp = vg + part * 8;
#pragma unroll
      for (int k = 0; k < 12; ++k) { float v[8]; bf8_to_f32(raw[k], v); const f32x4 g0 = *(const f32x4*)(gp + 32 * k), g1 = *(const f32x4*)(gp + 32 * k + 4);
#pragma unroll
          for (int e = 0; e < 8; ++e) vw[(32 * k + e) * VT_LD] = f2bf(v[e] * rs * (e < 4 ? g0[e] : g1[e - 4])); } }
    __syncthreads();
    const bool full = wave >= 4;
    float ss = 0.f;
    const int tl = 16 * wave + ln;
    const char* ub = (const char*)(Z + (size_t)t0 * INC + ZU); const unsigned vu = (unsigned)(tl * INC + 4 * q) * 2u;
    const char* wb = (const char*)WSP; const unsigned vw = (unsigned)(tl * 128 + 8 * q) * 2u;
    const bf16x8 z8 = {0, 0, 0, 0, 0, 0, 0, 0};
    bf16x8 Wn0 = ldg<bf16x8>(wb, vw), Wn1 = ldg<bf16x8>(wb + 64, vw), Wn2 = z8, Wn3 = z8;
    if (full) { Wn2 = ldg<bf16x8>(wb + 128, vw); Wn3 = ldg<bf16x8>(wb + 192, vw); }
    u32x2 un0 = ldg<u32x2>(ub, vu), un1 = ldg<u32x2>(ub + 32, vu), un2 = ldg<u32x2>(ub + 64, vu), un3 = ldg<u32x2>(ub + 96, vu); float bn = a_sb[tl];
    const LAS bf16_t* ap = vT + ln * VT_LD + 8 * q;
    u32x2 val[24];
#pragma unroll
    for (int h = 0; h < 6; ++h) {
        const bf16x8 W0 = Wn0, W1 = Wn1, W2 = Wn2, W3 = Wn3; const u32x2 uc[4] = {un0, un1, un2, un3}; const float b = bn;
        if (h < 5) { const char* wq = wb + (size_t)(h + 1) * 128 * 128 * 2; const char* uq2 = ub + (h + 1) * 128;
            Wn0 = ldg<bf16x8>(wq, vw); Wn1 = ldg<bf16x8>(wq + 64, vw); if (full) { Wn2 = ldg<bf16x8>(wq + 128, vw); Wn3 = ldg<bf16x8>(wq + 192, vw); }
            un0 = ldg<u32x2>(uq2, vu); un1 = ldg<u32x2>(uq2 + 32, vu); un2 = ldg<u32x2>(uq2 + 64, vu); un3 = ldg<u32x2>(uq2 + 96, vu); bn = a_sb[(h + 1) * 128 + tl]; }
        asm volatile("" ::: "memory");
#pragma unroll
        for (int dt = 0; dt < 4; ++dt) { f32x4 acc = (f32x4){0.f, 0.f, 0.f, 0.f};
            const LAS bf16_t* aq = ap + (h * 64 + 16 * dt) * VT_LD;
            const bf16x8 a0 = *(const LAS bf16x8*)(aq), a1 = *(const LAS bf16x8*)(aq + 32), a2 = *(const LAS bf16x8*)(aq + 64), a3 = *(const LAS bf16x8*)(aq + 96);
            acc = mfma16(a0, W0, acc); acc = mfma16(a1, W1, acc); acc = mfma16(a2, W2, acc); acc = mfma16(a3, W3, acc);
            const u32x2 u2 = uc[dt];
            const float v0 = gelu_fast(__uint_as_float(u2.x << 16)) * (acc[0] + b), v1 = gelu_fast(__uint_as_float(u2.x & 0xffff0000u)) * (acc[1] + b), v2 = gelu_fast(__uint_as_float(u2.y << 16)) * (acc[2] + b), v3 = gelu_fast(__uint_as_float(u2.y & 0xffff0000u)) * (acc[3] + b);
            ss += (v0 * v0 + v1 * v1) + (v2 * v2 + v3 * v3);
            u32x2 pk; pk.x = cvt_pk_bf16(v0, v1); pk.y = cvt_pk_bf16(v2, v3); val[h * 4 + dt] = pk; }
    }
    ss = add_x16_x32(ss);
    const float rs = __builtin_amdgcn_rsqf(ss * (1.0f / AW) + EPS);
    __syncthreads();
    { LAS unsigned char* scr = lds + wave * (16 * 784);
      const char* gb = (const char*)mo_ga; const unsigned vg4 = (unsigned)(4 * q) * 4u; LAS unsigned char* sw = scr + ln * 784 + q * 8;
#pragma unroll
      for (int k = 0; k < 24; ++k) { const f32x4 gg = ldg<f32x4>(gb + k * 64, vg4); const u32x2 pk = val[k];
          u32x2 w; w.x = cvt_pk_bf16(__uint_as_float(pk.x << 16) * rs * gg[0], __uint_as_float(pk.x & 0xffff0000u) * rs * gg[1]); w.y = cvt_pk_bf16(__uint_as_float(pk.y << 16) * rs * gg[2], __uint_as_float(pk.y & 0xffff0000u) * rs * gg[3]);
          *(LAS u32x2*)(sw + k * 32) = w; }
      asm volatile("s_waitcnt lgkmcnt(0)" ::: "memory");
      bf16_t* yr = Y + (size_t)(t0 + 16 * wave) * D;
      { int row = lane >= 48 ? 1 : 0, cp = lane >= 48 ? lane - 48 : lane;
#pragma unroll 2
        for (int i = 0; i < 12; ++i) { const unsigned so = (unsigned)(row * 784 + cp * 16), go = (unsigned)(row * D + cp * 8) * 2u;
            const u32x4 v = *(const LAS u32x4*)(scr + so); *(u32x4*)((char*)yr + go) = v;
            cp += 16; row += 1; if (cp >= 48) { cp -= 48; row += 1; } } } }
    __syncthreads();
}

__device__ __forceinline__ void router_unit(int unit, int wave, int lane, const bf16_t* HB, const float* SSQ, const bf16_t* WRT, const float* rgb, const float* reb,
                                            int* CLS, float* G2, LAS unsigned char* lds, LAS int* hist) {
    const int ln = lane & 15, q = lane >> 4; const int t0 = unit * UT + wave * 32;
    LAS float* LG = (LAS float*)(lds + wave * 8192);
    f32x4 acc[2][3];
#pragma unroll
    for (int tt = 0; tt < 2; ++tt)
#pragma unroll
        for (int j = 0; j < 3; ++j) acc[tt][j] = (f32x4){0.f, 0.f, 0.f, 0.f};
    constexpr int WLD = 2064;
    { const int tid = wave * 64 + lane; const u32x4* src = (const u32x4*)WRT; u32x4 sv[12];
#pragma unroll
      for (int i = 0; i < 12; ++i) sv[i] = src[tid + 512 * i];
      __syncthreads();
#pragma unroll
      for (int i = 0; i < 12; ++i) { const int pc = tid + 512 * i; *(LAS u32x4*)(lds + (pc >> 7) * WLD + (pc & 127) * 16) = sv[i]; } }
    __syncthreads();
    const bf16_t* hp0 = HB + (size_t)(t0 + ln) * D + 8 * q; const bf16_t* hp1 = hp0 + (size_t)16 * D; const LAS unsigned char* wl = lds + ln * WLD + q * 16;
#pragma unroll 8
    for (int ks = 0; ks < 32; ++ks) {
        const bf16x8 b0 = *(const bf16x8*)(hp0), b1 = *(const bf16x8*)(hp1);
        const bf16x8 a0 = *(const LAS bf16x8*)(wl), a1 = *(const LAS bf16x8*)(wl + 16 * WLD), a2 = *(const LAS bf16x8*)(wl + 32 * WLD);
        acc[0][0] = mfma16(a0, b0, acc[0][0]); acc[0][1] = mfma16(a1, b0, acc[0][1]); acc[0][2] = mfma16(a2, b0, acc[0][2]);
        acc[1][0] = mfma16(a0, b1, acc[1][0]); acc[1][1] = mfma16(a1, b1, acc[1][1]); acc[1][2] = mfma16(a2, b1, acc[1][2]);
        hp0 += 32; hp1 += 32; wl += 64; }
    __syncthreads();
#pragma unroll
    for (int tt = 0; tt < 2; ++tt)
#pragma unroll
        for (int j = 0; j < 3; ++j) *(LAS f32x4*)(LG + (16 * tt + ln) * 48 + 16 * j + 4 * q) = acc[tt][j];
    asm volatile("s_waitcnt lgkmcnt(0)" ::: "memory");
    if (lane < 32) { const int t = t0 + lane; const LAS float* lg = LG + lane * 48;
        const f32x4* sp = (const f32x4*)(SSQ + (size_t)t * 16); const f32x4 s0 = sp[0], s1 = sp[1], s2 = sp[2], s3 = sp[3];
        const float sq = ((s0[0] + s0[1]) + (s0[2] + s0[3])) + ((s1[0] + s1[1]) + (s1[2] + s1[3])) + ((s2[0] + s2[1]) + (s2[2] + s2[3])) + ((s3[0] + s3[1]) + (s3[2] + s3[3]));
        const float r = rsqrtf(sq * (1.0f / D) + EPS);
        float gl[4];
#pragma unroll
        for (int j = 0; j < 4; ++j) gl[j] = r * (lg[j] + lg[16 + j]) + rgb[j];
        int gs = 0; float gm = gl[0];
#pragma unroll
        for (int j = 1; j < 4; ++j) if (gl[j] > gm) { gm = gl[j]; gs = j; }
        float den = 0.f;
#pragma unroll
        for (int j = 0; j < 4; ++j) den += expf(gl[j] - gm);
        const float gwt = 1.0f / den;
        float el[4];
#pragma unroll
        for (int j = 0; j < 4; ++j) { float v;
            if (gs < 3) v = lg[4 + 4 * gs + j] + lg[16 + 4 + 4 * gs + j]; else v = lg[32 + j] + lg[36 + j];
            el[j] = r * v + reb[gs * 4 + j]; }
        int i0 = 0; float v0 = el[0];
#pragma unroll
        for (int j = 1; j < 4; ++j) if (el[j] > v0) { v0 = el[j]; i0 = j; }
        int i1 = 0; float v1 = -3.0e38f;
#pragma unroll
        for (int j = 0; j < 4; ++j) if (j != i0 && el[j] > v1) { v1 = el[j]; i1 = j; }
        const float e1 = expf(v1 - v0); const float w0 = gwt / (1.0f + e1), w1 = gwt * e1 / (1.0f + e1);
        const int lo = i0 < i1 ? i0 : i1, hi = i0 < i1 ? i1 : i0; const int cls = gs * 6 + pair_idx(lo, hi);
        CLS[t] = cls; G2[(size_t)t * 2 + 0] = i0 < i1 ? w0 : w1; G2[(size_t)t * 2 + 1] = i0 < i1 ? w1 : w0;
        __hip_atomic_fetch_add(hist + cls, 1, __ATOMIC_RELAXED, __HIP_MEMORY_SCOPE_WORKGROUP); }
}

__device__ __forceinline__ void tr_item8(const float* W, int ldw, int k0, int scol0, unsigned char* WT, int ldo, int drow0, int dk0, LAS float* scr, int lane) {
#pragma unroll 8
    for (int i = 0; i < 32; ++i) { const int kk = 2 * i + (lane >> 5); scr[kk * 33 + (lane & 31)] = W[(size_t)(k0 + kk) * ldw + scol0 + (lane & 31)] * pg8::FS_W; }
    asm volatile("s_waitcnt lgkmcnt(0)" ::: "memory");
    const int c = lane & 7;
#pragma unroll
    for (int j = 0; j < 4; ++j) { const int n = (lane >> 3) + 8 * j; const LAS float* s = scr + (8 * c) * 33 + n;
        u32x2 o; o.x = pk_fp8x4(s[0 * 33], s[1 * 33], s[2 * 33], s[3 * 33]); o.y = pk_fp8x4(s[4 * 33], s[5 * 33], s[6 * 33], s[7 * 33]);
        *(u32x2*)(WT + (size_t)(drow0 + n) * ldo + dk0 + 8 * c) = o; }
    asm volatile("s_waitcnt lgkmcnt(0)" ::: "memory");
}
struct TrP { const float* src; const float* gk; unsigned char* dst; int ldw, ldo, fp8; };
__device__ __forceinline__ void tr_load(const TrP& P, int lane, float (&v)[32]) {
#pragma unroll
    for (int i = 0; i < 8; ++i) { const int kk = 8 * i + (lane >> 3); f32x4 x = *(const f32x4*)(P.src + (size_t)kk * P.ldw + 4 * (lane & 7)); if (P.gk) x *= P.gk[kk]; v[4 * i] = x[0]; v[4 * i + 1] = x[1]; v[4 * i + 2] = x[2]; v[4 * i + 3] = x[3]; }
}
__device__ __forceinline__ void tr_store(const TrP& P, int lane, const float (&v)[32], LAS float* scr) {
    const float sc = P.fp8 ? pg8::FS_W : 1.0f;
#pragma unroll
    for (int i = 0; i < 8; ++i)
#pragma unroll
        for (int e = 0; e < 4; ++e) scr[(8 * i + (lane >> 3)) * 33 + 4 * (lane & 7) + e] = v[4 * i + e] * sc;
    asm volatile("s_waitcnt lgkmcnt(0)" ::: "memory");
    const int c = lane & 7;
#pragma unroll
    for (int j = 0; j < 4; ++j) { const int n = (lane >> 3) + 8 * j; const LAS float* s = scr + (8 * c) * 33 + n;
        if (P.fp8) { u32x2 o; o.x = pk_fp8x4(s[0 * 33], s[1 * 33], s[2 * 33], s[3 * 33]); o.y = pk_fp8x4(s[4 * 33], s[5 * 33], s[6 * 33], s[7 * 33]); *(u32x2*)(P.dst + (size_t)n * P.ldo + 8 * c) = o; }
        else { u32x4 o; o.x = cvt_pk_bf16(s[0 * 33], s[1 * 33]); o.y = cvt_pk_bf16(s[2 * 33], s[3 * 33]); o.z = cvt_pk_bf16(s[4 * 33], s[5 * 33]); o.w = cvt_pk_bf16(s[6 * 33], s[7 * 33]); *(u32x4*)(P.dst + (size_t)n * P.ldo + 16 * c) = o; } }
    asm volatile("s_waitcnt lgkmcnt(0)" ::: "memory");
}
struct Args { const float* in[34]; float* out; unsigned char* ws; };

__global__ void __launch_bounds__(512, 2) mega_fwd(Args a) {
    extern __shared__ __attribute__((aligned(16))) unsigned char lds_raw[];
    LAS unsigned char* lds = (LAS unsigned char*)lds_raw;
    volatile LAS unsigned* LW = (volatile LAS unsigned*)(lds + LDSCTL_OFF);
    volatile LAS int* LWI = (volatile LAS int*)(lds + LDSCTL_OFF);
    const int G = gridDim.x, bid0 = blockIdx.x; const int wave_s0 = __builtin_amdgcn_readfirstlane(threadIdx.x >> 6);
#define PHASE_IDS() int wv_ = wave_s0, bd_ = bid0; asm volatile("" : "+s"(wv_), "+s"(bd_)); const int wave_s = wv_, bid = bd_;     \
    const int lane = fresh_lane(), wave = wave_s, tid = wave * 64 + lane; const int gw = bid * 8 + wave, NGW = G * 8; \
    const size_t gt = (size_t)bid * 512 + tid, NGT = (size_t)G * 512; (void)lane; (void)wave; (void)gw; (void)NGW; (void)gt; (void)NGT
#define WSB() ({ unsigned char* _w = a.ws; asm volatile("" : "+s"(_w)); _w; })
#define INP(i) ({ int _k = (i); asm volatile("" : "+s"(_k)); a.in[_k]; })
    for (int u = threadIdx.x; u < (LDS_PF - LDSCTL_OFF) / 4; u += 512) LW[u] = 0u;
    __syncthreads();
    XcdBarrier bar = xcd_barrier_post((unsigned*)(a.ws + WS_CTL) + CW_BAR, LW + LW_BAR);

    {
        PHASE_IDS(); unsigned char* ws = WSB(); bf16_t* WIN = (bf16_t*)(ws + WS_WIN); bf16_t* WOUT = (bf16_t*)(ws + WS_WOUT); bf16_t* WGU = (bf16_t*)(ws + WS_WGU); bf16_t* WD2 = (bf16_t*)(ws + WS_WD2);
        bf16_t* HB = (bf16_t*)(ws + WS_HB); float* SSQ = (float*)(ws + WS_SSQ);
        LAS float* scr = (LAS float*)(lds + wave * 16384);
        constexpr int I_IN = 16 * 56, I_OUT = 16 * 32, I_GU = 2 * 16 * 256, I_D8 = 16 * 256, I_GLU = 32, I_RG = 24, I_L = I_IN + I_OUT + I_GU + I_D8 + I_GLU + I_RG;
        const float* i_win = INP(2); const float* i_g = INP(1); const float* i_wout = INP(24); const float* i_wg = INP(30); const float* i_wu = INP(31); const float* i_wd = INP(32);
        const float* i_glu = INP(21); const float* i_rg = INP(8); const float* i_ig = INP(10);
#define TR_DECODE(P, it) do { const int l = (it) / I_L; int r = (it) % I_L; P.gk = nullptr; P.fp8 = 0; \
            if (r < I_IN) { const int kb = r / 56, nb = r % 56, j0 = nb * 32; const int sc = j0 < 768 ? j0 : (j0 < 1152 ? j0 + 384 : (j0 < 1536 ? j0 - 384 : j0));     \
                P.src = i_win + (size_t)l * D * INC + (size_t)kb * 64 * INC + sc; P.ldw = INC; P.gk = i_g + (size_t)l * D + kb * 64; P.dst = (unsigned char*)(WIN + (size_t)l * INC * D + (size_t)j0 * D + kb * 64); P.ldo = D * 2; } \
            else if ((r -= I_IN) < I_OUT) { const int kb = r / 32, nb = r % 32; P.src = i_wout + (size_t)l * D * D + (size_t)kb * 64 * D + nb * 32; P.ldw = D; P.dst = (unsigned char*)(WOUT + (size_t)l * D * D + (size_t)nb * 32 * D + kb * 64); P.ldo = D * 2; } \
            else if ((r -= I_OUT) < I_GU) { const int which = r / (16 * 256), e = (r / 256) % 16, q = r % 256, kb = q / 16, nb = q % 16, n0 = nb * 32;     \
                P.src = (which ? i_wu : i_wg) + ((size_t)l * NE + e) * D * DE + (size_t)kb * 64 * DE + n0; P.ldw = DE; P.fp8 = 1; \
                P.dst = (unsigned char*)WGU + ((size_t)l * NE + e) * 1024 * 1024 + (size_t)((n0 / 128) * 256 + which * 128 + (n0 % 128)) * 1024 + kb * 64; P.ldo = 1024; } \
            else if ((r -= I_GU) < I_D8) { const int e = r / 256, q = r % 256, kb = q / 32, nb = q % 32;        \
                P.src = i_wd + ((size_t)l * NE + e) * DE * D + (size_t)kb * 64 * D + nb * 32; P.ldw = D; P.fp8 = 1; P.dst = ws + WS_WD8 + ((size_t)l * NE + e) * 1024 * 512 + (size_t)nb * 32 * 512 + kb * 64; P.ldo = 512; } \
            else if ((r -= I_D8) < I_GLU) { const int kb = r / 8, nb = r % 8; P.src = i_glu + (size_t)l * CW * CW + (size_t)kb * 64 * CW + nb * 32; P.ldw = CW; P.dst = (unsigned char*)((bf16_t*)(ws + WS_WGLU) + (size_t)l * CW * CW + (size_t)nb * 32 * CW + kb * 64); P.ldo = CW * 2; } \
            else { r -= I_GLU; const int gate = r / 12, h = (r / 2) % 6, nb = r & 1; \
                P.src = (gate ? i_ig : i_rg) + ((size_t)l * 6 + h) * 64 * 64 + nb * 32; P.ldw = 64; P.dst = (unsigned char*)((bf16_t*)(ws + WS_WRG) + (((size_t)l * 2 + gate) * 6 + h) * 64 * 64 + (size_t)nb * 32 * 64); P.ldo = 64 * 2; } } while (0)
        { TrP Pa, Pb; float va[32], vb[32]; int it = gw;
          if (it < 2 * I_L) { TR_DECODE(Pa, it); tr_load(Pa, lane, va); }
#pragma unroll 1
          while (it < 2 * I_L) {
              const int it1 = it + NGW; if (it1 < 2 * I_L) { TR_DECODE(Pb, it1); tr_load(Pb, lane, vb); }
              tr_store(Pa, lane, va, scr);
              if (it1 >= 2 * I_L) break;
              const int it2 = it1 + NGW; if (it2 < 2 * I_L) { TR_DECODE(Pa, it2); tr_load(Pa, lane, va); }
              tr_store(Pb, lane, vb, scr);
              it = it2; } }
#undef TR_DECODE
        { const float* s_are = INP(13); const float* s_aim = INP(14); const float* s_ldt = INP(15); const float* s_bre = INP(16); const float* s_bim = INP(17); const float* s_cre = INP(18); const float* s_cim = INP(19); const float* s_d = INP(20);
          for (size_t e = gt; e < (size_t)2 * CG * 256; e += NGT) { const int l = (int)(e / (CG * 256)), g = (int)((e / 256) % CG), c = (int)((e >> 4) & 15), cp = (int)(e & 15);
              s5_kt_pair(g, c, cp, s_are + (size_t)l * CG * CS, s_aim + (size_t)l * CG * CS, s_ldt + (size_t)l * CG, s_bre + (size_t)l * CG * CS * CGD, s_bim + (size_t)l * CG * CS * CGD,
                         s_cre + (size_t)l * CG * CGD * CS, s_cim + (size_t)l * CG * CGD * CS, s_d + (size_t)l * CW, ws + WS_S5 + (size_t)l * S5_L_STRIDE); }
          for (size_t e = gt; e < (size_t)2 * CG * 2048; e += NGT) { const int l = (int)(e / (CG * 2048)), g = (int)((e / 2048) % CG), r = (int)(e & 2047);
              s5_et_task(g, r >> 10, (r >> 4) & 63, r & 15, s_are + (size_t)l * CG * CS, s_aim + (size_t)l * CG * CS, s_ldt + (size_t)l * CG, s_bre + (size_t)l * CG * CS * CGD, s_bim + (size_t)l * CG * CS * CGD, ws + WS_S5 + (size_t)l * S5_L_STRIDE);
              s5_ft_task(g, r >> 7, (r >> 6) & 1, r & 63, s_are + (size_t)l * CG * CS, s_aim + (size_t)l * CG * CS, s_ldt + (size_t)l * CG, s_cre + (size_t)l * CG * CGD * CS, s_cim + (size_t)l * CG * CGD * CS, ws + WS_S5 + (size_t)l * S5_L_STRIDE); }
          for (size_t e = gt; e < (size_t)2 * CG * 64; e += NGT) { const int l = (int)(e / (CG * 64)), g = (int)((e / 64) % CG), el = 4096 + 32768 + (int)(e % 64);
              s5_table_elem(g, el, s_are + (size_t)l * CG * CS, s_aim + (size_t)l * CG * CS, s_ldt + (size_t)l * CG, s_bre + (size_t)l * CG * CS * CGD, s_bim + (size_t)l * CG * CS * CGD,
                            s_cre + (size_t)l * CG * CGD * CS, s_cim + (size_t)l * CG * CGD * CS, s_d + (size_t)l * CW, ws + WS_S5 + (size_t)l * S5_L_STRIDE); } }
        { const float* sw = INP(4); bf16_t* wsp = (bf16_t*)(ws + WS_WSP); for (size_t e = gt; e < (size_t)2 * 6 * 128 * 128; e += NGT) wsp[e] = f2bf(sw[e]); }
        { const float* fg = INP(25); const float* rgw = INP(26); const float* rew = INP(28); bf16_t* wrt = (bf16_t*)(ws + WS_WRT);
          for (size_t e = gt; e < (size_t)2 * 48 * D; e += NGT) { const int l = (int)(e / (48 * D)), n = (int)((e / D) % 48), k = (int)(e % D);
              int j = -1, lo = 0; if (n < 16) j = n; else if (n < 32) { j = n - 16; lo = 1; } else if (n < 36) j = 16 + (n - 32); else if (n < 40) { j = 16 + (n - 36); lo = 1; }
              float v = 0.f;
              if (j >= 0) { const float w = fg[(size_t)l * D + k] * (j < 4 ? rgw[((size_t)l * D + k) * 4 + j] : rew[(((size_t)l * 4 + ((j - 4) >> 2)) * D + k) * 4 + ((j - 4) & 3)]);
                  const float hi = bf2f(f2bf(w)); v = lo ? (w - hi) : w; }
              wrt[e] = f2bf(v); } }
        const float* xin = INP(0);
#pragma unroll 1
        for (int t = gw * 2; t < T; t += NGW * 2) {
            const f32x4* xr = (const f32x4*)(xin + (size_t)t * D) + lane; f32x4 v[2][4]; float s0 = 0.f, s1 = 0.f;
#pragma unroll
            for (int j = 0; j < 4; ++j) { v[0][j] = xr[64 * j]; v[1][j] = xr[256 + 64 * j]; }
#pragma unroll
            for (int j = 0; j < 4; ++j) { s0 += (v[0][j][0] * v[0][j][0] + v[0][j][1] * v[0][j][1]) + (v[0][j][2] * v[0][j][2] + v[0][j][3] * v[0][j][3]); s1 += (v[1][j][0] * v[1][j][0] + v[1][j][1] * v[1][j][1]) + (v[1][j][2] * v[1][j][2] + v[1][j][3] * v[1][j][3]); }
            u32x2* o8 = (u32x2*)(HB + (size_t)t * D) + lane;
#pragma unroll
            for (int j = 0; j < 4; ++j) { u32x2 w; w.x = cvt_pk_bf16(v[0][j][0], v[0][j][1]); w.y = cvt_pk_bf16(v[0][j][2], v[0][j][3]); o8[64 * j] = w; w.x = cvt_pk_bf16(v[1][j][0], v[1][j][1]); w.y = cvt_pk_bf16(v[1][j][2], v[1][j][3]); o8[256 + 64 * j] = w; }
            s0 = wave_sum(s0); s1 = wave_sum(s1);
            if (lane < 32) SSQ[(size_t)t * 16 + lane] = lane == 0 ? s0 : (lane == 16 ? s1 : 0.f);
        }
    }
    xcd_barrier(bar);

    for (int l = 0; l < DEPTH; ++l) {
        { PHASE_IDS(); unsigned char* ws = WSB(); bf16_t* WIN = (bf16_t*)(ws + WS_WIN); bf16_t* HB = (bf16_t*)(ws + WS_HB); float* SSQ = (float*)(ws + WS_SSQ); bf16_t* Z = (bf16_t*)(ws + WS_Z);
          pg8::StaticOrder<T, INC> S; S.init(HB, WIN + (size_t)l * INC * D, G, bid);
          pg8::EpiZ E{Z, SSQ, lds + LDS_PF};
          pg8::gemm_phase<pg8::EpiZ, pg8::StaticOrder<T, INC>, true, true>(lds, wave_s, S, E); }
        xcd_barrier(bar);

        {
            PHASE_IDS(); unsigned char* ws = WSB(); const bf16_t* Z = (const bf16_t*)(ws + WS_Z);
            const float* conv_w = INP(6) + (size_t)l * 4 * BW; const float* conv_b = INP(7) + (size_t)l * BW; const float* rg_b = INP(9) + (size_t)l * BW;
            const float* ig_b = INP(11) + (size_t)l * BW; const float* lam = INP(12) + (size_t)l * BW;
            __syncthreads();
            { const bf16_t* WRG = (const bf16_t*)(ws + WS_WRG) + ((size_t)l * 2 + 0) * 6 * 4096; const bf16_t* WIG = (const bf16_t*)(ws + WS_WRG) + ((size_t)l * 2 + 1) * 6 * 4096;
              for (int pr = bid; pr < NU128 / 2; pr += G) { float cp = 0.f;
                  rglru_unit<1>(2 * pr, true, cp, tid, wave, lane, Z, nullptr, WRG, WIG, conv_w, conv_b, rg_b, ig_b, lam, nullptr, (float*)(ws + WS_SUMA), (float*)(ws + WS_SUMH), (float*)(ws + WS_SUMA2), (float*)(ws + WS_SUMH2), (bf16_t*)(ws + WS_HL), (bf16_t*)(ws + WS_PP), lds);
                  rglru_unit<1>(2 * pr + 1, false, cp, tid, wave, lane, Z, nullptr, WRG, WIG, conv_w, conv_b, rg_b, ig_b, lam, nullptr, (float*)(ws + WS_SUMA), (float*)(ws + WS_SUMH), (float*)(ws + WS_SUMA2), (float*)(ws + WS_SUMH2), (bf16_t*)(ws + WS_HL), (bf16_t*)(ws + WS_PP), lds); } }
            for (int pr = bid; pr < NU128 / 2; pr += G) { const unsigned char* tab = ws + WS_S5 + (size_t)l * S5_L_STRIDE;
                s5_pair1(pr, 2 * wave, wave, lane, Z, (bf16_t*)(ws + WS_Y), tab, (float*)(ws + WS_SEND), (float*)(ws + WS_SEND2), (float*)(ws + WS_SE), lds);
                s5_pair1(pr, 2 * wave + 1, wave, lane, Z, (bf16_t*)(ws + WS_Y), tab, (float*)(ws + WS_SEND), (float*)(ws + WS_SEND2), (float*)(ws + WS_SE), lds); }
            __syncthreads();
            { const bf16_t* WSP = (const bf16_t*)(ws + WS_WSP) + (size_t)l * 6 * 128 * 128; const float* a_sb = INP(5) + (size_t)l * 6 * 128; const float* vg = INP(3) + (size_t)l * AW; const float* mo_ga = INP(23) + (size_t)l * D;
              for (int u = bid; u < NU128; u += G) mixa_unit(u, tid, wave, lane, Z, (bf16_t*)(ws + WS_Y), WSP, a_sb, vg, mo_ga, lds); }
        }
        xcd_barrier(bar);

        {
            PHASE_IDS(); unsigned char* ws = WSB(); const bf16_t* Z = (const bf16_t*)(ws + WS_Z); bf16_t* Y = (bf16_t*)(ws + WS_Y);
            const float* a_v_norm_g = INP(3) + (size_t)l * AW; const float* a_sw = INP(4) + (size_t)l * 6 * 128 * 128; const float* a_sb = INP(5) + (size_t)l * 6 * 128;
        }

        { PHASE_IDS(); unsigned char* ws = WSB(); const bf16_t* Z = (const bf16_t*)(ws + WS_Z); bf16_t* Y = (bf16_t*)(ws + WS_Y);
          { const float* mo_gb = INP(23) + (size_t)l * D + AW;
            __syncthreads();
            for (int pr = bid; pr < NU128 / 2; pr += G) rglru_fix_pair(pr, tid, wave, lane, Z, Y, (const bf16_t*)(ws + WS_HL), (const bf16_t*)(ws + WS_PP), (const float*)(ws + WS_SUMA2), (const float*)(ws + WS_SUMH2), mo_gb, lds); }
          { const bf16_t* WGLU = (const bf16_t*)(ws + WS_WGLU) + (size_t)l * CW * CW; const float* glu_b = INP(22) + (size_t)l * CW; const float* mo_gc = INP(23) + (size_t)l * D + AW + BW;
            for (int pr = bid; pr < NU128 / 2; pr += G) { float k0r = 0.f, k0i = 0.f, k1r = 0.f, k1i = 0.f; const unsigned char* tab = ws + WS_S5 + (size_t)l * S5_L_STRIDE;
#pragma unroll 1
                for (int ui = 0; ui < 2; ++ui) { const int u = 2 * pr + ui; __syncthreads();
                    s5_group<2>(u, 2 * wave, ui == 0, k0r, k0i, wave, lane, Z, Y, tab, (float*)(ws + WS_SEND), (float*)(ws + WS_SEND2), (float*)(ws + WS_SE), lds);
                    s5_group<2>(u, 2 * wave + 1, ui == 0, k1r, k1i, wave, lane, Z, Y, tab, (float*)(ws + WS_SEND), (float*)(ws + WS_SEND2), (float*)(ws + WS_SE), lds);
                    __syncthreads(); s5_glu(u, wave, lane, WGLU, glu_b, mo_gc, Y, lds); } } } }
        asm volatile("s_waitcnt vmcnt(0)" ::: "memory"); __syncthreads();
        if (wave_s0 == 0) { __builtin_amdgcn_fence(__ATOMIC_ACQUIRE, "agent"); asm volatile("s_waitcnt vmcnt(0)" ::: "memory"); }
        __syncthreads();

        { PHASE_IDS(); unsigned char* ws = WSB(); bf16_t* WOUT = (bf16_t*)(ws + WS_WOUT); bf16_t* HB = (bf16_t*)(ws + WS_HB); float* SSQ = (float*)(ws + WS_SSQ); bf16_t* Y = (bf16_t*)(ws + WS_Y);
          pg8::PanelOrder<T, 4> S; S.init(Y, WOUT + (size_t)l * D * D, G, bid);
          pg8::EpiRes<false> E{HB, SSQ, nullptr, lds + LDS_PF};
          pg8::gemm_phase<pg8::EpiRes<false>, pg8::PanelOrder<T, 4>, true, true>(lds, wave_s, S, E); }
        asm volatile("s_waitcnt vmcnt(0)" ::: "memory"); __syncthreads();
        if (wave_s0 == 0) { __builtin_amdgcn_fence(__ATOMIC_ACQUIRE, "agent"); asm volatile("s_waitcnt vmcnt(0)" ::: "memory"); }
        __syncthreads();

        { PHASE_IDS(); unsigned char* ws = WSB(); const bf16_t* HB = (const bf16_t*)(ws + WS_HB); const float* SSQ = (const float*)(ws + WS_SSQ); int* CLS = (int*)(ws + WS_CLS); float* G2 = (float*)(ws + WS_G2); int* HIST = (int*)(ws + WS_HIST);
          const float* rgb = INP(27) + (size_t)l * 4; const float* reb = INP(29) + (size_t)l * 16;
        if (l == 0) {
            for (int rr = gw; rr < 2 * NCLS * 2 * 1024 / 2; rr += NGW) { const int row = 2 * rr + (lane >> 5), n = row & 1023, half = (row >> 10) & 1, cls = (row >> 11) % NCLS, ll = row / (2048 * NCLS);
                const int g = cls / 6, pi = cls % 6, e = g * 4 + (half ? pair_hi(pi) : pair_lo(pi));
                const u32x4 v = *(const u32x4*)(ws + WS_WD8 + ((size_t)ll * NE + e) * 1024 * 512 + (size_t)n * 512 + (lane & 31) * 16);
                *(u32x4*)(ws + WS_WD2 + ((size_t)ll * NCLS + cls) * 1024 * 1024 + (size_t)n * 1024 + half * 512 + (lane & 31) * 16) = v; } }
        for (int u = bid; u < NU; u += G) {
            router_unit(u, wave, lane, HB, SSQ, (const bf16_t*)(ws + WS_WRT) + (size_t)l * 48 * D, rgb, reb, CLS, G2, lds, (LAS int*)(lds + LDSCTL_OFF) + LW_HIST);
            __syncthreads();
            if (tid < 32) { HIST[u * 32 + tid] = tid < NCLS ? LWI[LW_HIST + tid] : 0; LWI[LW_HIST + tid] = 0; }
            __syncthreads();
        } }
        xcd_barrier(bar);

        { PHASE_IDS(); unsigned char* ws = WSB(); const bf16_t* HB = (const bf16_t*)(ws + WS_HB); const float* SSQ = (const float*)(ws + WS_SSQ); const int* CLS = (const int*)(ws + WS_CLS); const float* G2 = (const float*)(ws + WS_G2); const int* HIST = (const int*)(ws + WS_HIST);
          int* CTOT = (int*)(ws + WS_CTOT); int* ROWTOK = (int*)(ws + WS_ROWTOK); float* ROWG = (float*)(ws + WS_ROWG); bf16_t* HBS = (bf16_t*)(ws + WS_HBS); const float* ffn_g = INP(25) + (size_t)l * D;
        for (int u = bid; u < NU; u += G) {
            { const int c = tid & 31, part = tid >> 5; int tot = 0, pre = 0;
_Pragma("unroll 16")
              for (int k = part * 16; k < part * 16 + 16; ++k) { const int v = HIST[k * 32 + c]; tot += v; pre += k < u ? v : 0; }
              ((volatile LAS int*)lds)[tid] = tot; ((volatile LAS int*)lds)[512 + tid] = pre; }
            __syncthreads();
            if (tid < NCLS) { int tot = 0, pre = 0;
_Pragma("unroll")
                for (int k = 0; k < 16; ++k) { tot += ((volatile LAS int*)lds)[k * 32 + tid]; pre += ((volatile LAS int*)lds)[512 + k * 32 + tid]; } LWI[LW_TOT + tid] = tot; LWI[LW_BASE + tid] = pre; }
            __syncthreads();
            if (tid == 0) { int ps = 0;
_Pragma("unroll 1")
                for (int c = 0; c < NCLS; ++c) { const int tot = LWI[LW_TOT + c]; LWI[LW_BASE + c] += ps; LWI[LW_TST + c] = ps; ps += ((tot + 255) >> 8) << 8; if (bid == 0) CTOT[c] = tot; } LWI[LW_TST + NCLS] = ps; }
            int mycls = 0, rank = 0;
            if (tid < UT) { mycls = CLS[u * UT + tid];
_Pragma("unroll 4")
                for (int c = 0; c < NCLS; ++c) { const unsigned long long m = __ballot(mycls == c); const int below = __builtin_amdgcn_mbcnt_hi((unsigned)(m >> 32), __builtin_amdgcn_mbcnt_lo((unsigned)m, 0u));
                    if (mycls == c) rank = below; if (lane == 0) ((volatile LAS int*)lds)[1024 + wave * 32 + c] = __popcll(m); } }
            __syncthreads();
            if (tid < UT) { const int cls = mycls;
                for (int w = 0; w < wave; ++w) rank += ((volatile LAS int*)lds)[1024 + w * 32 + cls];
                const int dest = LWI[LW_BASE + cls] + rank; LWI[LW_DEST + tid] = dest; const int t = u * UT + tid;
                ROWTOK[dest] = t; ROWG[(size_t)dest * 2 + 0] = G2[(size_t)t * 2 + 0]; ROWG[(size_t)dest * 2 + 1] = G2[(size_t)t * 2 + 1]; }
            __syncthreads();
            { f32x4 gq[4];
#pragma unroll
              for (int j = 0; j < 4; ++j) gq[j] = *(const f32x4*)(ffn_g + (j >> 1) * 512 + lane * 8 + 4 * (j & 1));
#pragma unroll 1
              for (int i = 0; i < 32; i += 4) {
                  const int tl0 = wave * 32 + i, t0r = u * UT + tl0;
                  float sq = SSQ[(size_t)t0r * 16 + lane]; sq += x_xor1(sq); sq += x_xor2(sq); sq += x_hmir(sq); sq += x_mir(sq);
                  u32x4 o[4][2]; int dst[4];
#pragma unroll
                  for (int j = 0; j < 4; ++j) { o[j][0] = *(const u32x4*)(HB + (size_t)(t0r + j) * D + lane * 8); o[j][1] = *(const u32x4*)(HB + (size_t)(t0r + j) * D + 512 + lane * 8); dst[j] = LWI[LW_DEST + tl0 + j]; }
#pragma unroll
                  for (int j = 0; j < 4; ++j) { const float r4 = rsqrtf(__builtin_amdgcn_readlane(sq, 16 * j) * (1.0f / D) + EPS) * pg8::FS_H; u32x4 w;
#pragma unroll
                      for (int hh = 0; hh < 2; ++hh) { const u32x4 oo = o[j][hh]; const f32x4 g0 = gq[2 * hh], g1 = gq[2 * hh + 1];
                          const unsigned lo = pk_fp8x4(__uint_as_float(oo.x << 16) * r4 * g0[0], __uint_as_float(oo.x & 0xffff0000u) * r4 * g0[1], __uint_as_float(oo.y << 16) * r4 * g0[2], __uint_as_float(oo.y & 0xffff0000u) * r4 * g0[3]);
                          const unsigned hi = pk_fp8x4(__uint_as_float(oo.z << 16) * r4 * g1[0], __uint_as_float(oo.z & 0xffff0000u) * r4 * g1[1], __uint_as_float(oo.w << 16) * r4 * g1[2], __uint_as_float(oo.w & 0xffff0000u) * r4 * g1[3]);
                          if (hh == 0) { w.x = lo; w.y = hi; } else { w.z = lo; w.w = hi; } }
                      *(u32x2*)((unsigned char*)HBS + (size_t)dst[j] * D + lane * 8) = (u32x2){w.x, w.y}; *(u32x2*)((unsigned char*)HBS + (size_t)dst[j] * D + 512 + lane * 8) = (u32x2){w.z, w.w}; } } }
            if (u == bid)
_Pragma("unroll 1")
            for (int c = bid; c < NCLS; c += G) { const int tot = LWI[LW_TOT + c], r0 = LWI[LW_TST + c] + tot, r1 = LWI[LW_TST + c + 1];
                unsigned zz = 0u; asm volatile("" : "+v"(zz));
                for (int r = r0 + wave; r < r1; r += 8) { if (lane == 0) { ROWTOK[r] = -1; ROWG[(size_t)r * 2] = __uint_as_float(zz); ROWG[(size_t)r * 2 + 1] = __uint_as_float(zz); }
                    *(u32x4*)((unsigned char*)HBS + (size_t)r * D + lane * 16) = (u32x4){zz, zz, zz, zz}; } }
            __syncthreads();
        } }
        xcd_barrier(bar);

        { PHASE_IDS(); unsigned char* ws = WSB(); const int* CTOT = (const int*)(ws + WS_CTOT); bf16_t* HBS = (bf16_t*)(ws + WS_HBS); bf16_t* WGU = (bf16_t*)(ws + WS_WGU); bf16_t* ACT = (bf16_t*)(ws + WS_ACT); const float* ROWG = (const float*)(ws + WS_ROWG);
        if (wave == 0) {
            const int vt = lane < NCLS ? (CTOT[lane] + 255) >> 8 : 0; int tst = 0, ntile = 0;
_Pragma("unroll")
            for (int k = 0; k < NCLS; ++k) { const int vk = __builtin_amdgcn_readlane(vt, k); tst += (k < lane) ? vk : 0; ntile += vk; }
            if (lane <= NCLS) LWI[LW_TST + lane] = tst;
            if (lane < 32) { const long L = (long)lane * G + bid; int e = -1;
            int mtu = -1, pnu = 0, mtd = -1, pnd = 0;
            if (L < (long)ntile * 8) { const int nwg = ntile * 8, qq = nwg / 8, rr = nwg % 8, xcd = (int)(L % 8), off = (int)(L / 8); const int Lr = (xcd < rr ? xcd * (qq + 1) : rr * (qq + 1) + (xcd - rr) * qq) + off; mtu = Lr / 8; pnu = Lr % 8; }
            if (L < (long)ntile * 4) { const int nwg = ntile * 4, qq = nwg / 8, rr = nwg % 8, xcd = (int)(L % 8), off = (int)(L / 8); const int Lr = (xcd < rr ? xcd * (qq + 1) : rr * (qq + 1) + (xcd - rr) * qq) + off; mtd = Lr / 4; pnd = Lr % 4; }
            int clsu = 0, clsd = 0;
_Pragma("unroll")
            for (int k = 1; k < NCLS; ++k) { const int sk = __builtin_amdgcn_readlane(tst, k); clsu += (sk <= mtu) ? 1 : 0; clsd += (sk <= mtd) ? 1 : 0; }
            e = mtu >= 0 ? ((clsu << 24) | (pnu << 16) | mtu) : -1; LWI[LW_UTAB + lane] = e;
            e = mtd >= 0 ? ((clsd << 24) | (pnd << 16) | mtd) : -1; LWI[LW_DTAB + lane] = e; } }
        __syncthreads();
        { pg8::MoeOrder<8, true, 1024> S{LWI + LW_UTAB, l, (const char*)HBS, (const char*)WGU};
          pg8::EpiUp E{(unsigned char*)ACT, ROWG, lds + LDS_PF};
          pg8::gemm_phase<pg8::EpiUp, pg8::MoeOrder<8, true, 1024>, true, true, 512, true>(lds, wave_s, S, E); } }
        xcd_barrier(bar);

        { PHASE_IDS(); unsigned char* ws = WSB(); bf16_t* ACT = (bf16_t*)(ws + WS_ACT); bf16_t* WD2 = (bf16_t*)(ws + WS_WD2); bf16_t* HB = (bf16_t*)(ws + WS_HB); float* SSQ = (float*)(ws + WS_SSQ); const int* ROWTOK = (const int*)(ws + WS_ROWTOK);
          pg8::MoeOrder<4, false, 1024> S{LWI + LW_DTAB, l, (const char*)ACT, (const char*)WD2};
          pg8::EpiRes<true> E{HB, SSQ, ROWTOK, lds + LDS_PF};
          pg8::gemm_phase<pg8::EpiRes<true>, pg8::MoeOrder<4, false, 1024>, true, true, 512, true>(lds, wave_s, S, E); }
        xcd_barrier(bar);
    }

    { PHASE_IDS(); unsigned char* ws = WSB(); const bf16_t* HB = (const bf16_t*)(ws + WS_HB); const float* SSQ = (const float*)(ws + WS_SSQ); const float* fg = INP(33); float* outp = a.out;
    { f32x4 gq[4];
#pragma unroll
      for (int q = 0; q < 4; ++q) gq[q] = *(const f32x4*)(fg + 256 * q + 4 * lane);
#pragma unroll 1
      for (int t0r = gw * 4; t0r < T; t0r += NGW * 4) {
          float sq = SSQ[(size_t)t0r * 16 + lane]; sq += x_xor1(sq); sq += x_xor2(sq); sq += x_hmir(sq); sq += x_mir(sq);
          u32x2 o[4][4];
#pragma unroll
          for (int j = 0; j < 4; ++j)
#pragma unroll
              for (int q = 0; q < 4; ++q) o[j][q] = *(const u32x2*)(HB + (size_t)(t0r + j) * D + 256 * q + 4 * lane);
#pragma unroll
          for (int j = 0; j < 4; ++j) { const float r = rsqrtf(__builtin_amdgcn_readlane(sq, 16 * j) * (1.0f / D) + EPS); float* orow = outp + (size_t)(t0r + j) * D + 4 * lane;
#pragma unroll
              for (int q = 0; q < 4; ++q) { const u32x2 oo = o[j][q]; const f32x4 g0 = gq[q]; f32x4 w0;
                  w0[0] = __uint_as_float(oo.x << 16) * r * g0[0]; w0[1] = __uint_as_float(oo.x & 0xffff0000u) * r * g0[1]; w0[2] = __uint_as_float(oo.y << 16) * r * g0[2]; w0[3] = __uint_as_float(oo.y & 0xffff0000u) * r * g0[3];
                  *(f32x4*)(orow + 256 * q) = w0; } } } }
}
}

extern "C" void kernel_launch(void* const* d_in, const int* in_sizes, int n_in, void* d_out, int out_size, void* d_ws, size_t ws_size, hipStream_t stream) {
    static int grid = 0;
    if (grid == 0) {
        if (n_in != 34 || in_sizes[0] != T * D || out_size != T * D || ws_size < WS_END) { fprintf(stderr, "kernel_launch: unexpected shapes (n_in %d, ws %zu)\n", n_in, ws_size); grid = -1; return; }
        int dev = 0, cus = 0, per_cu = 0;
        if (hipGetDevice(&dev) != hipSuccess || hipDeviceGetAttribute(&cus, hipDeviceAttributeMultiprocessorCount, dev) != hipSuccess) { grid = -1; return; }
        if (hipFuncSetAttribute((const void*)mega_fwd, hipFuncAttributeMaxDynamicSharedMemorySize, LDS_BYTES) != hipSuccess) { fprintf(stderr, "kernel_launch: hipFuncSetAttribute failed\n"); grid = -1; return; }
        if (hipOccupancyMaxActiveBlocksPerMultiprocessor(&per_cu, (const void*)mega_fwd, 512, LDS_BYTES) != hipSuccess || per_cu < 1) { fprintf(stderr, "kernel_launch: occupancy query says %d\n", per_cu); }
        (void)hipGetLastError();
        grid = cus;
    }
    if (grid < 0) return;
    (void)hipMemsetAsync((char*)d_ws + WS_CTL, 0, CTL_ZERO_BYTES, stream);
    Args a{};
    for (int i = 0; i < 34; ++i) a.in[i] = (const float*)d_in[i];
    a.out = (float*)d_out; a.ws = (unsigned char*)d_ws;
    hipLaunchKernelGGL(mega_fwd, dim3(grid), dim3(512), LDS_BYTES, stream, a);
}
```

```cpp
#include <hip/hip_runtime.h>
#include <cstdio>
#include <cstdint>

#define LAS __attribute__((address_space(3)))
typedef unsigned short bf16_t;
typedef short bf16x8 __attribute__((ext_vector_type(8)));
typedef float f32x4 __attribute__((ext_vector_type(4)));
typedef float f32x2 __attribute__((ext_vector_type(2)));
typedef unsigned u32x4 __attribute__((ext_vector_type(4)));
typedef unsigned u32x2 __attribute__((ext_vector_type(2)));
typedef int i32x4 __attribute__((ext_vector_type(4)));
typedef int i32x8 __attribute__((ext_vector_type(8)));

constexpr int D = 1024, BATCH = 8, SEQ = 8192, T = BATCH * SEQ, DEPTH = 2;
constexpr int AW = 384, BW = 384, CW = 256, HD = 64, ABLK = 128, CHUNK = 64;
constexpr int INC = 1792;
constexpr int ZU = 0, ZV = 384, ZG = 768, ZX = 1152, ZC = 1536, ZGELU_END = 1152;
constexpr int CG = 16, CGD = 16, CS = 64;
constexpr int NE = 16, DE = 512, NCLS = 24;
constexpr float EPS = 1e-6f;
constexpr int UT = 256;
constexpr int NU = T / UT;
constexpr int MAXROWS = T + NCLS * 256;

constexpr size_t MiB = 1u << 20;
constexpr size_t WS_CTL = 0, CTL_ZERO_BYTES = 1 * MiB;
constexpr size_t WS_WIN = 2 * MiB;
constexpr size_t WS_WOUT = 10 * MiB;
constexpr size_t WS_WGLU = 14 * MiB;
constexpr size_t WS_WRG = 15 * MiB;
constexpr size_t WS_WSP = 15 * MiB + 256 * 1024;
constexpr size_t WS_WRT = 15 * MiB + 768 * 1024;
constexpr size_t WS_WGU = 16 * MiB;
constexpr size_t WS_WD8 = 48 * MiB;
constexpr size_t WS_WD2 = 80 * MiB;
constexpr size_t WS_SSQ = 176 * MiB;
constexpr size_t WS_RS = 180 * MiB;
constexpr size_t WS_CLS = WS_RS + 256 * 1024;
constexpr size_t WS_G2 = WS_CLS + 256 * 1024;
constexpr size_t WS_HIST = 181 * MiB;
constexpr size_t WS_CTOT = WS_HIST + 64 * 1024;
constexpr size_t WS_ROWTOK = WS_HIST + 256 * 1024;
constexpr size_t WS_ROWG = 182 * MiB;
constexpr size_t WS_SUMA = 183 * MiB;
constexpr size_t WS_SUMH = 191 * MiB;
constexpr size_t WS_S5 = 184 * MiB;
constexpr size_t WS_SEND = 187 * MiB;
constexpr size_t WS_HB = 192 * MiB;
constexpr size_t WS_Z = 320 * MiB;
constexpr size_t WS_HBS = WS_Z;
constexpr size_t WS_Y = 544 * MiB;
constexpr size_t WS_ACT = 672 * MiB;
constexpr size_t WS_HL = 672 * MiB;
constexpr size_t WS_PP = 736 * MiB;
constexpr size_t WS_SE = 800 * MiB;
constexpr size_t WS_AV = 672 * MiB;
constexpr size_t WS_BV = 768 * MiB;
constexpr size_t WS_SEND2 = 864 * MiB;
constexpr size_t WS_SUMA2 = 866 * MiB;
constexpr size_t WS_SUMH2 = 867 * MiB;
constexpr size_t WS_HBU = 868 * MiB;
constexpr size_t WS_END = 932 * MiB;
constexpr int CW_BAR = 4096;

constexpr int RING_BYTES = 131072;
constexpr int LDSCTL_OFF = 143360;
constexpr int LDS_PF = 147456;
constexpr int LDS_BYTES = 163840;
constexpr int LW_BAR = 8, LW_TST = 64, LW_HIST = 96, LW_TOT = 128, LW_BASE = 160, LW_CLS = 256  , LW_DEST = 512  , LW_UTAB = 768  , LW_DTAB = 800  ;

__device__ __forceinline__ float bf2f(bf16_t v) { return __uint_as_float(((unsigned)v) << 16); }
__device__ __forceinline__ unsigned cvt_pk_bf16(float lo, float hi) { unsigned r; asm volatile("v_cvt_pk_bf16_f32 %0, %1, %2" : "=v"(r) : "v"(lo), "v"(hi)); return r; }
__device__ __forceinline__ bf16_t f2bf(float v) { return (bf16_t)(cvt_pk_bf16(v, 0.f) & 0xffffu); }
__device__ __forceinline__ unsigned pk_fp8x4(float a, float b, float c, float d) {
    a = fminf(fmaxf(a, -448.f), 448.f); b = fminf(fmaxf(b, -448.f), 448.f); c = fminf(fmaxf(c, -448.f), 448.f); d = fminf(fmaxf(d, -448.f), 448.f);
    int r = __builtin_amdgcn_cvt_pk_fp8_f32(a, b, 0, false); r = __builtin_amdgcn_cvt_pk_fp8_f32(c, d, r, true); return (unsigned)r; }
__device__ __forceinline__ int fresh_lane() { unsigned z = 0u; asm volatile("" : "+s"(z)); return (int)__builtin_amdgcn_mbcnt_hi(~0u, __builtin_amdgcn_mbcnt_lo(~0u, z)); }
__device__ __forceinline__ float x_xor1(float v) { return __int_as_float(__builtin_amdgcn_update_dpp(0, __float_as_int(v), 0xB1, 0xf, 0xf, true)); }
__device__ __forceinline__ float x_xor2(float v) { return __int_as_float(__builtin_amdgcn_update_dpp(0, __float_as_int(v), 0x4E, 0xf, 0xf, true)); }
__device__ __forceinline__ float x_hmir(float v) { return __int_as_float(__builtin_amdgcn_update_dpp(0, __float_as_int(v), 0x141, 0xf, 0xf, true)); }
__device__ __forceinline__ float x_mir(float v) { return __int_as_float(__builtin_amdgcn_update_dpp(0, __float_as_int(v), 0x140, 0xf, 0xf, true)); }
__device__ __forceinline__ float x_xor16(float v) { return __int_as_float(__builtin_amdgcn_ds_swizzle(__float_as_int(v), 0x401F)); }
__device__ __forceinline__ float add_xor32(float v) { const auto r = __builtin_amdgcn_permlane32_swap(__float_as_uint(v), __float_as_uint(v), false, false); return __uint_as_float(r[0]) + __uint_as_float(r[1]); }
__device__ __forceinline__ float add_x16_x32(float v) { v += x_xor16(v); return add_xor32(v); }
__device__ __forceinline__ float wave_sum(float v) { v += x_xor1(v); v += x_xor2(v); v += x_hmir(v); v += x_mir(v); v += x_xor16(v); return add_xor32(v); }
__device__ __forceinline__ float gelu_fast(float x) {
    const float u2 = 1.5957691216057308f * (x + 0.044715f * x * x * x);
    const float e = __builtin_amdgcn_exp2f(-1.4426950408889634f * u2);
    return x * __builtin_amdgcn_rcpf(1.0f + e);
}
__device__ __forceinline__ float sigmoid_fast(float x) { return __builtin_amdgcn_rcpf(1.0f + __builtin_amdgcn_exp2f(-1.4426950408889634f * x)); }
__device__ __forceinline__ float sigmoid_f(float x) { return 1.0f / (1.0f + expf(-x)); }
__device__ __forceinline__ int pair_lo(int pi) { return pi < 3 ? 0 : (pi < 5 ? 1 : 2); }
__device__ __forceinline__ int pair_hi(int pi) { return pi < 3 ? pi + 1 : (pi < 5 ? pi - 1 : 3); }
__device__ __forceinline__ int pair_idx(int lo, int hi) { return lo == 0 ? hi - 1 : (lo == 1 ? hi + 1 : 5); }

#define XB_TMO      128
#define XB_XCNT(j)  (256  + 64 * (j))
#define XB_XSUB(j)  (1280 + 64 * (j))
#define XB_XGEN(j)  (2304 + 64 * (j))
#define XB_TOP      3328
#define XB_TOPGEN   3392
#define XCD_BAR_WORDS 3456
#define XB_SPIN_CAP (1u << 18)
__device__ __forceinline__ unsigned xb_ld(unsigned* p)              { return __hip_atomic_load(p, __ATOMIC_RELAXED, __HIP_MEMORY_SCOPE_AGENT); }
__device__ __forceinline__ unsigned xb_add(unsigned* p, unsigned v) { return __hip_atomic_fetch_add(p, v, __ATOMIC_RELAXED, __HIP_MEMORY_SCOPE_AGENT); }
__device__ __forceinline__ unsigned xb_xcc_id() { return (unsigned)__builtin_amdgcn_s_getreg((3 << 11) | 20) & 0xFu; }
#define XB_SPIN(cond, bar) do { unsigned _sp = 0; while (cond) { __builtin_amdgcn_s_sleep(1); \
    if ((++_sp & 255u) == 0u) { if (xb_ld(&(bar)[XB_TMO])) break; if (_sp > XB_SPIN_CAP) { atomicAdd(&(bar)[XB_TMO], 1u); break; } } } } while (0)
struct XcdBarrier { unsigned* bar; unsigned x; volatile LAS unsigned* st; };
__device__ __forceinline__ XcdBarrier xcd_barrier_post(unsigned* bar, volatile LAS unsigned* st) {
    XcdBarrier b; b.bar = bar; b.x = xb_xcc_id(); b.st = st;
    if (threadIdx.x == 0) (void)xb_add(&bar[XB_XCNT(b.x)], 1u);
    return b;
}
__device__ __forceinline__ void xcd_barrier_complete(unsigned* bar, unsigned x, unsigned& nloc, unsigned& nx) {
    const unsigned G = gridDim.x * gridDim.y * gridDim.z;
    unsigned sum, cnt, mine, sp = 0u;
    for (;;) {
        sum = 0u; cnt = 0u; mine = 0u;
#pragma unroll
        for (unsigned j = 0; j < 16; ++j) { const unsigned c = xb_ld(&bar[XB_XCNT(j)]); sum += c; cnt += (c > 0u) ? 1u : 0u; mine = (j == x) ? c : mine; }
        if (sum == G) break;
        __builtin_amdgcn_s_sleep(1);
        if ((++sp & 255u) == 0u) { if (xb_ld(&bar[XB_TMO])) break; if (sp > XB_SPIN_CAP) { atomicAdd(&bar[XB_TMO], 1u); break; } }
    }
    nloc = mine > 0u ? mine : 1u; nx = cnt > 0u ? cnt : 1u;
}
__device__ __forceinline__ void xcd_barrier(const XcdBarrier& b) {
    asm volatile("s_waitcnt vmcnt(0)" ::: "memory");
    __syncthreads();
    if (threadIdx.x == 0) {
        unsigned* bar = b.bar; asm volatile("" : "+s"(bar));
        __builtin_amdgcn_s_waitcnt(0);
        unsigned bx0 = b.x; asm volatile("" : "+s"(bx0));
        unsigned nloc = b.st[0], nx = b.st[1];
        if (nloc == 0u) { xcd_barrier_complete(bar, bx0, nloc, nx); b.st[0] = nloc; b.st[1] = nx; }
        unsigned bx = b.x; asm volatile("" : "+s"(bx));
        const unsigned old = xb_add(&bar[XB_XSUB(bx)], 1u);
        const unsigned gen = old / nloc;
        if (old + 1u == (gen + 1u) * nloc) {
            __builtin_amdgcn_fence(__ATOMIC_RELEASE, "agent");
            asm volatile("s_waitcnt vmcnt(0)" ::: "memory");
            const unsigned og = xb_add(&bar[XB_TOP], 1u);
            const unsigned tg = og / nx;
            if (og + 1u == (tg + 1u) * nx) xb_add(&bar[XB_TOPGEN], 1u);
            else XB_SPIN(xb_ld(&bar[XB_TOPGEN]) == tg, bar);
            __builtin_amdgcn_fence(__ATOMIC_ACQUIRE, "agent");
            xb_add(&bar[XB_XGEN(bx)], 1u);
            asm volatile("s_waitcnt vmcnt(0)" ::: "memory");
        } else {
            XB_SPIN(xb_ld(&bar[XB_XGEN(bx)]) == gen, bar);
            __builtin_amdgcn_fence(__ATOMIC_ACQUIRE, "agent");
            asm volatile("s_waitcnt vmcnt(0)" ::: "memory");
        }
    }
    __syncthreads();
}

namespace pg8 {
#define PG8_LAS __attribute__((address_space(3)))
constexpr int BM = 256, BK = 64, HALF = 128, HTB = HALF * BK * 2, STAGE_BYTES = 8 * HTB, NXCD = 8, WGM = 4;
__host__ __device__ __forceinline__ int lds_byte(int r, int c) { const int st = (r >> 4) * 2 + (c >> 5), rr = r & 15, cc = c & 31, ob = rr * 64 + cc * 2; return st * 1024 + (ob ^ (((ob >> 9) & 1) << 5)); }
__host__ __device__ __forceinline__ void stage_rc(int b, int& R, int& C) { const int st = b / 1024, sb = b % 1024, swz = sb ^ (((sb >> 9) & 1) << 5); R = (st >> 1) * 16 + swz / 64; C = (st & 1) * 32 + (swz % 64) / 2; }
__host__ __device__ __forceinline__ int perm32(int rho) { const int n = rho >> 4, i = rho & 15; return 8 * (i >> 2) + 4 * n + (i & 3); }
struct Unit { int pm, pn; const char* A; const char* B; };

template <int M_, int NN> struct PanelOrder {
    static constexpr int nM = M_ / BM; static constexpr size_t tstep = (size_t)BM * 1024 * 2;
    int G, c; const char* A; const char* Bt;
    __device__ void init(const void* A_, const void* Bt_, int G_, int c_) { G = G_; c = c_; A = (const char*)A_; Bt = (const char*)Bt_; }
    __device__ bool next(int i, Unit& u) const { const int pm = c + (i / NN) * G; if (pm >= nM) return false; u.pm = pm; u.pn = i % NN; u.A = A + (size_t)pm * tstep; u.B = Bt + (size_t)u.pn * tstep; return true; }
    static constexpr bool GATHER = false;
    __device__ __forceinline__ void a_ready(const Unit&) const {}
    __device__ __forceinline__ void done(const Unit&) const {}
};
template <int M_, int N_> struct StaticOrder {
    static constexpr int nM = M_ / BM, nN = N_ / BM, nwg = nM * nN; static constexpr size_t tstep = (size_t)BM * 1024 * 2;
    int G, c; const char* A; const char* Bt;
    __device__ void init(const void* A_, const void* Bt_, int G_, int c_) { G = G_; c = c_; A = (const char*)A_; Bt = (const char*)Bt_; }
    __device__ bool next(int i, Unit& u) const {
        const long L = (long)i * G + c; if (L >= nwg) return false;
        int wgid = (int)L; { constexpr int q = nwg / NXCD, r = nwg % NXCD; const int xcd = wgid % NXCD, off = wgid / NXCD; wgid = (xcd < r ? xcd * (q + 1) : r * (q + 1) + (xcd - r) * q) + off; }
        constexpr int nig = WGM * nN; const int gid = wgid / nig, fm = gid * WGM, gsz = (nM - fm) < WGM ? (nM - fm) : WGM;
        u.pm = fm + ((wgid % nig) % gsz); u.pn = (wgid % nig) / gsz; u.A = A + (size_t)u.pm * tstep; u.B = Bt + (size_t)u.pn * tstep; return true;
    }
    static constexpr bool GATHER = false;
    __device__ __forceinline__ void a_ready(const Unit&) const {}
    __device__ __forceinline__ void done(const Unit&) const {}
};
template <class Epi, class Sched, bool ALIGN_EPI = false, bool SP2 = false, int KB = 1024, bool FP8 = false>
__device__ __forceinline__ void gemm_phase(PG8_LAS unsigned char* lds, const int wave_s, const Sched& S, const Epi& E) { const int Kdim = 0;
    const int lane = fresh_lane(), wid = wave_s, tid = wid * 64 + lane, wr = wid >> 2, wc = wid & 3, fr = lane & 15, fq = lane >> 4;
    constexpr int K = KB, nt = K / BK; (void)Kdim;
    unsigned voffA, voffB;
    { int R, C; stage_rc(tid * 16, R, C); const int Rb = Epi::PERM ? ((R & ~31) + perm32(R & 31)) : R; voffA = (unsigned)(R * K + C) * 2u; voffB = (unsigned)(Rb * K + C) * 2u; }
    unsigned voffAg[4];
    (void)voffAg;
    constexpr size_t kstep = (size_t)(BK * 2);
    constexpr size_t hstep = (size_t)HALF * K * 2;
    constexpr size_t tstep = 2 * hstep; (void)tstep;
    const unsigned ldsw = (unsigned)wid * 1024u; const unsigned ldsb = (unsigned)(size_t)lds + ldsw;
    const int aoff = lds_byte(wr * 64 + fr, fq * 8), boff = lds_byte(wc * 32 + fr, fq * 8);
#define PG8_SA(b, h) (((b) * 2 + (h)) * HTB)
#define PG8_SB(b, h) ((4 + (b) * 2 + (h)) * HTB)
#define PG8_STAGE(bufoff, gbase, voff) do { _Pragma("unroll") for (int _i = 0; _i < 2; ++_i) { unsigned _keep; \
        asm volatile("s_mov_b32 %0, m0\n\ts_mov_b32 m0, %3\n\ts_nop 0\n\tglobal_load_lds_dwordx4 %1, %2\n\ts_mov_b32 m0, %0" : "=&s"(_keep) \
            : "v"(voff), "s"((const char*)(gbase) + (size_t)_i * (64 * K * 2)), "s"(ldsb + (unsigned)((bufoff) + _i * 8192)) : "memory"); } } while (0)
#define PG8_STAGE_A(bufoff, gbase, h) do { if constexpr (Sched::GATHER) { _Pragma("unroll") for (int _i = 0; _i < 2; ++_i) { unsigned _keep; \
        asm volatile("s_mov_b32 %0, m0\n\ts_mov_b32 m0, %3\n\ts_nop 0\n\tglobal_load_lds_dwordx4 %1, %2\n\ts_mov_b32 m0, %0" : "=&s"(_keep) \
            : "v"(voffAg[2 * (h) + _i]), "s"((const char*)(gbase)), "s"(ldsb + (unsigned)((bufoff) + _i * 8192)) : "memory"); } } \
        else PG8_STAGE(bufoff, (gbase) + (h) * hstep, voffA); } while (0)
#define PG8_LDA(dst, b, h) do { if constexpr (FP8) { _Pragma("unroll") for (int m = 0; m < 4; ++m) { const i32x4 _lo = *(const PG8_LAS i32x4*)(lds + PG8_SA(b, h) + aoff + m * 2048), _hi = *(const PG8_LAS i32x4*)(lds + PG8_SA(b, h) + aoff + m * 2048 + 1024); \
            dst##8[m] = __builtin_shufflevector(_lo, _hi, 0, 1, 2, 3, 4, 5, 6, 7); } } \
        else { _Pragma("unroll") for (int m = 0; m < 4; ++m) _Pragma("unroll") for (int k = 0; k < 2; ++k) dst[m][k] = *(const PG8_LAS bf16x8*)(lds + PG8_SA(b, h) + aoff + m * 2048 + k * 1024); } } while (0)
#define PG8_LDB(dst, b, h) do { if constexpr (FP8) { _Pragma("unroll") for (int n = 0; n < 2; ++n) { const i32x4 _lo = *(const PG8_LAS i32x4*)(lds + PG8_SB(b, h) + boff + n * 2048), _hi = *(const PG8_LAS i32x4*)(lds + PG8_SB(b, h) + boff + n * 2048 + 1024); \
            dst##8[n] = __builtin_shufflevector(_lo, _hi, 0, 1, 2, 3, 4, 5, 6, 7); } } \
        else { _Pragma("unroll") for (int n = 0; n < 2; ++n) _Pragma("unroll") for (int k = 0; k < 2; ++k) dst[n][k] = *(const PG8_LAS bf16x8*)(lds + PG8_SB(b, h) + boff + n * 2048 + k * 1024); } } while (0)
#define PG8_MMA(ai, bj, At, Bt) do { __builtin_amdgcn_s_setprio(1); \
        if constexpr (FP8) { _Pragma("unroll") for (int m = 0; m < 4; ++m) _Pragma("unroll") for (int n = 0; n < 2; ++n) \
            acc[ai][bj][m][n] = __builtin_amdgcn_mfma_scale_f32_16x16x128_f8f6f4(Bt##8[n], At##8[m], acc[ai][bj][m][n], 0, 0, 0, Epi::SCALE_W, 0, Epi::SCALE_A); } \
        else { _Pragma("unroll") for (int m = 0; m < 4; ++m) _Pragma("unroll") for (int n = 0; n < 2; ++n) _Pragma("unroll") for (int k = 0; k < 2; ++k) \
            acc[ai][bj][m][n] = __builtin_amdgcn_mfma_f32_16x16x32_bf16(Bt[n][k], At[m][k], acc[ai][bj][m][n], 0, 0, 0); } \
        __builtin_amdgcn_s_setprio(0); } while (0)
#define PG8_WAIT_V(n) asm volatile("s_waitcnt vmcnt(" #n ")" ::: "memory")
#define PG8_WAIT_L(n) asm volatile("s_waitcnt lgkmcnt(" #n ")" ::: "memory")
#define PG8_BAR __builtin_amdgcn_s_barrier()
#define PG8_SCHED __builtin_amdgcn_sched_barrier(0)
    Unit cur, nxt; int ui = 0;
    if (!S.next(0, cur)) return;
    f32x4 acc[2][2][4][2];
#pragma unroll
    for (int a = 0; a < 2; ++a)
#pragma unroll
        for (int b = 0; b < 2; ++b)
#pragma unroll
            for (int m = 0; m < 4; ++m)
#pragma unroll
                for (int n = 0; n < 2; ++n) acc[a][b][m][n] = (f32x4){0.f, 0.f, 0.f, 0.f};
    bf16x8 At[4][2], B0[2][2], B1[2][2]; i32x8 At8[4], B08[2], B18[2]; (void)At; (void)B0; (void)B1; (void)At8; (void)B08; (void)B18;
    const char* cA = cur.A; const char* cB = cur.B;
    if constexpr (Sched::GATHER) {
        int R_, C_; stage_rc(tid * 16, R_, C_); int tk[4];
#pragma unroll
        for (int j = 0; j < 4; ++j) tk[j] = S.rowtok[(size_t)cur.pm * BM + R_ + 64 * j];
#pragma unroll
        for (int j = 0; j < 4; ++j) voffAg[j] = (unsigned)(tk[j] < 0 ? 0 : tk[j]) * (unsigned)(K * 2) + (unsigned)(C_ * 2); }
    S.a_ready(cur);
    if constexpr (SP2) {
        PG8_STAGE(PG8_SB(0, 0), cB, voffB); PG8_STAGE(PG8_SB(0, 1), cB + hstep, voffB); PG8_STAGE_A(PG8_SA(0, 0), cA, 0); PG8_STAGE_A(PG8_SA(0, 1), cA, 1);
        if (wr == 1) PG8_BAR;
        PG8_WAIT_V(2); PG8_BAR;
        PG8_STAGE(PG8_SB(1, 0), cB + kstep, voffB); PG8_STAGE_A(PG8_SA(1, 0), cA + kstep, 0); PG8_STAGE(PG8_SB(1, 1), cB + hstep + kstep, voffB);
        PG8_WAIT_V(6); PG8_BAR;
    } else {
        PG8_STAGE(PG8_SB(0, 0), cB, voffB); PG8_STAGE_A(PG8_SA(0, 0), cA, 0); PG8_STAGE(PG8_SB(0, 1), cB + hstep, voffB); PG8_STAGE_A(PG8_SA(0, 1), cA, 1);
        if (wr == 1) PG8_BAR;
        PG8_WAIT_V(4); PG8_BAR;
        PG8_STAGE(PG8_SB(1, 0), cB + kstep, voffB); PG8_STAGE_A(PG8_SA(1, 0), cA + kstep, 0); PG8_STAGE(PG8_SB(1, 1), cB + hstep + kstep, voffB);
        PG8_WAIT_V(6); PG8_BAR;
    }
    for (;;) {
        const bool has_next = S.next(ui + 1, nxt);
        const char* nA = has_next ? nxt.A : cA; const char* nB = has_next ? nxt.B : cB;
_Pragma("unroll 1")
        for (int t = 0; t < nt; t += 2) {
            const bool last = (t == nt - 2);
            const char* a1 = cA + (size_t)(t + 1) * kstep;
            const char* a2 = last ? nA : cA + (size_t)(t + 2) * kstep; const char* b2 = last ? nB : cB + (size_t)(t + 2) * kstep;
            const char* a3 = a2 + kstep; const char* b3 = b2 + kstep;
            if (last && has_next) S.a_ready(nxt);
            if constexpr (Sched::GATHER) { if (t == 2 && has_next) E.prefetch_tok(S.rowtok, nxt.pm, (unsigned)(size_t)lds + (unsigned)LDS_PF, wid); }
            if constexpr (Epi::PF) { if (t == 2) E.prefetch(cur, (unsigned)(size_t)lds + (unsigned)LDS_PF, wid); }
            if constexpr (SP2) {
            PG8_LDB(B0, 0, 0); PG8_LDB(B1, 0, 1); PG8_SCHED; PG8_LDA(At, 0, 0); PG8_STAGE_A(PG8_SA(1, 1), a1, 1);
            PG8_WAIT_V(8); PG8_WAIT_L(0); PG8_BAR; PG8_MMA(0, 0, At, B0); PG8_MMA(0, 1, At, B1); PG8_BAR; PG8_SCHED;
            if constexpr (Sched::GATHER) { if (last && has_next) {
                int R_, C_; stage_rc((wid * 64 + fresh_lane()) * 16, R_, C_); const PG8_LAS int* tkp = (const PG8_LAS int*)(lds + LDS_PF + 2048) + R_;
#pragma unroll
                for (int j = 0; j < 4; ++j) { const int tk = tkp[64 * j]; voffAg[j] = (unsigned)(tk < 0 ? 0 : tk) * (unsigned)(K * 2) + (unsigned)(C_ * 2); } } }
            PG8_LDA(At, 0, 1); PG8_STAGE(PG8_SB(0, 0), b2, voffB); PG8_STAGE(PG8_SB(0, 1), b2 + hstep, voffB); PG8_STAGE_A(PG8_SA(0, 0), a2, 0);
            PG8_WAIT_V(8); PG8_WAIT_L(0); PG8_BAR; PG8_MMA(1, 0, At, B0); PG8_MMA(1, 1, At, B1); PG8_BAR; PG8_SCHED;
            PG8_LDB(B0, 1, 0); PG8_LDB(B1, 1, 1); PG8_SCHED; PG8_LDA(At, 1, 0); PG8_STAGE_A(PG8_SA(0, 1), a2, 1);
            PG8_WAIT_V(8); PG8_WAIT_L(0); PG8_BAR; PG8_MMA(0, 0, At, B0); PG8_MMA(0, 1, At, B1); PG8_BAR; PG8_SCHED;
            PG8_LDA(At, 1, 1); PG8_STAGE(PG8_SB(1, 0), b3, voffB); PG8_STAGE(PG8_SB(1, 1), b3 + hstep, voffB); PG8_STAGE_A(PG8_SA(1, 0), a3, 0);
            PG8_WAIT_V(8); PG8_WAIT_L(0); PG8_BAR; PG8_MMA(1, 0, At, B0); PG8_MMA(1, 1, At, B1); PG8_BAR; PG8_SCHED;
            } else {
            PG8_LDB(B0, 0, 0); PG8_SCHED; PG8_LDA(At, 0, 0); PG8_STAGE_A(PG8_SA(1, 1), a1, 1);
            PG8_WAIT_L(8); PG8_BAR; PG8_WAIT_L(0); PG8_MMA(0, 0, At, B0); PG8_BAR; PG8_SCHED;
            PG8_LDB(B1, 0, 1); PG8_STAGE(PG8_SB(0, 0), b2, voffB);
            PG8_BAR; PG8_WAIT_L(0); PG8_MMA(0, 1, At, B1); PG8_BAR;
            PG8_LDA(At, 0, 1); PG8_STAGE_A(PG8_SA(0, 0), a2, 0);
            PG8_BAR; PG8_WAIT_L(0); PG8_MMA(1, 0, At, B0); PG8_BAR; PG8_SCHED;
            PG8_STAGE(PG8_SB(0, 1), b2 + hstep, voffB);
            PG8_WAIT_V(6); PG8_BAR; PG8_MMA(1, 1, At, B1); PG8_BAR;
            PG8_LDB(B0, 1, 0); PG8_SCHED; PG8_LDA(At, 1, 0); PG8_STAGE_A(PG8_SA(0, 1), a2, 1);
            PG8_WAIT_L(8); PG8_BAR; PG8_WAIT_L(0); PG8_MMA(0, 0, At, B0); PG8_BAR; PG8_SCHED;
            PG8_LDB(B1, 1, 1); PG8_STAGE(PG8_SB(1, 0), b3, voffB);
            PG8_BAR; PG8_WAIT_L(0); PG8_MMA(0, 1, At, B1); PG8_BAR;
            PG8_LDA(At, 1, 1); PG8_STAGE_A(PG8_SA(1, 0), a3, 0);
            PG8_BAR; PG8_WAIT_L(0); PG8_MMA(1, 0, At, B0); PG8_BAR; PG8_SCHED;
            PG8_STAGE(PG8_SB(1, 1), b3 + hstep, voffB);
            PG8_WAIT_V(6); PG8_BAR; PG8_MMA(1, 1, At, B1); PG8_BAR;
            }
        }
        if constexpr (ALIGN_EPI) { if (wr == 0) PG8_BAR; }
        if constexpr (!Epi::AFTER_DRAIN) { E(acc, cur, wr, wc, fr, fq); S.done(cur); }
        if (!has_next) break;
#pragma unroll
        for (int a = 0; a < 2; ++a)
#pragma unroll
            for (int b = 0; b < 2; ++b)
#pragma unroll
                for (int m = 0; m < 4; ++m)
#pragma unroll
                    for (int n = 0; n < 2; ++n) acc[a][b][m][n] = (f32x4){0.f, 0.f, 0.f, 0.f};
        cur = nxt; cA = nA; cB = nB; ++ui;
        if constexpr (ALIGN_EPI) { if (wr == 1) PG8_BAR; }
    }
    PG8_WAIT_V(0);
    if constexpr (!ALIGN_EPI) { if (wr == 0) PG8_BAR; }
    PG8_BAR;
    if constexpr (Epi::AFTER_DRAIN) { E.fused(acc, cur, wr, wc, fr, fq, lds, wid, lane); S.done(cur); }
#undef PG8_SA
#undef PG8_SB
#undef PG8_STAGE
#undef PG8_STAGE_A
#undef PG8_LDA
#undef PG8_LDB
#undef PG8_MMA
#undef PG8_WAIT_V
#undef PG8_WAIT_L
#undef PG8_BAR
#undef PG8_SCHED
}

template <int NP, bool UP, int ROWB> struct MoeOrder {
    const volatile LAS int* tab; int layer; const char* A; const char* W; const int* rowtok;
    __device__ bool next(int i, Unit& u) const {
        const int e = tab[i]; if (e < 0) return false;
        const int mt = e & 0xffff, pn = (e >> 16) & 0xff, cls = e >> 24;
        u.pm = mt; u.pn = pn; u.A = UP ? A : A + (size_t)mt * ((size_t)BM * ROWB);
        if (UP) { const int g = cls / 6, pi = cls % 6, s = pn >> 2, ex = g * 4 + (s ? pair_hi(pi) : pair_lo(pi));
            u.B = W + ((size_t)(layer * NE + ex) * 1024 + (size_t)(pn & 3) * 256) * ROWB; }
        else u.B = W + ((size_t)(layer * NCLS + cls) * 1024 + (size_t)pn * 256) * ROWB;
        return true;
    }
    static constexpr bool GATHER = UP;
    __device__ __forceinline__ void a_ready(const Unit&) const {}
    __device__ __forceinline__ void done(const Unit&) const {}
};

struct EpiZ {
    static constexpr bool PERM = true, AFTER_DRAIN = false, PF = true;
    bf16_t* Z; const float* ssq; const PG8_LAS unsigned char* pf;
    __device__ __forceinline__ void prefetch(const Unit& u, unsigned lds_addr, int wid) const {
        const char* g = (const char*)(ssq + (size_t)u.pm * BM * 16) + wid * 1024; const unsigned vo = (unsigned)fresh_lane() * 16u;
#pragma unroll
        for (int i = 0; i < 2; ++i) { unsigned keep;
            asm volatile("s_mov_b32 %0, m0\n\ts_mov_b32 m0, %3\n\ts_nop 0\n\tglobal_load_lds_dwordx4 %1, %2\n\ts_mov_b32 m0, %0" : "=&s"(keep) : "v"(vo), "s"(g + i * 8192), "s"(lds_addr + (unsigned)(wid * 1024 + i * 8192)) : "memory"); } }
    __device__ __forceinline__ void operator()(const f32x4 (&acc)[2][2][4][2], const Unit& u, int wr, int wc, int fr, int fq) const {
        { const int ln_ = fresh_lane(); fr = ln_ & 15; fq = ln_ >> 4; }
        const int row0 = u.pm * BM + wr * 64 + fr, col0 = u.pn * BM + wc * 32 + 8 * fq;
        float rr[2][4];
#pragma unroll
        for (int ai = 0; ai < 2; ++ai) {
            f32x4 sp[4];
#pragma unroll
            for (int m = 0; m < 4; ++m) sp[m] = *(const PG8_LAS f32x4*)(pf + (ai * HALF + wr * 64 + m * 16 + fr) * 64 + 16 * fq);
#pragma unroll
            for (int m = 0; m < 4; ++m) { float t = (sp[m][0] + sp[m][1]) + (sp[m][2] + sp[m][3]); t = add_x16_x32(t); rr[ai][m] = __builtin_amdgcn_rsqf(t * (1.0f / D) + EPS); }
        }
#pragma unroll
        for (int ai = 0; ai < 2; ++ai)
#pragma unroll
            for (int m = 0; m < 4; ++m) { const int row = row0 + ai * HALF + m * 16; const float r = rr[ai][m];
                bf16_t* rowp = Z + (size_t)row * INC + col0;
#pragma unroll
                for (int bj = 0; bj < 2; ++bj) { f32x4 v0 = acc[ai][bj][m][0] * r, v1 = acc[ai][bj][m][1] * r;
                    u32x4 w; w.x = cvt_pk_bf16(v0[0], v0[1]); w.y = cvt_pk_bf16(v0[2], v0[3]); w.z = cvt_pk_bf16(v1[0], v1[1]); w.w = cvt_pk_bf16(v1[2], v1[3]);
                    *(u32x4*)(rowp + bj * HALF) = w; } }
    }
};
template <bool SCATTER> struct EpiRes {
    static constexpr bool PERM = true, AFTER_DRAIN = false, PF = SCATTER; static constexpr int SCALE_W = 0x7b7b7b7b, SCALE_A = 0x7b7b7b7b;
    bf16_t* H; float* ssq; const int* rowtok; const PG8_LAS unsigned char* pf;
    __device__ __forceinline__ void prefetch(const Unit& u, unsigned lds_addr, int wid) const {
        if (wid < 4) { const char* g = (const char*)(rowtok + (size_t)u.pm * BM) + wid * 256; const unsigned vo = (unsigned)fresh_lane() * 4u; unsigned keep;
            asm volatile("s_mov_b32 %0, m0\n\ts_mov_b32 m0, %3\n\ts_nop 0\n\tglobal_load_lds_dword %1, %2\n\ts_mov_b32 m0, %0" : "=&s"(keep) : "v"(vo), "s"(g), "s"(lds_addr + (unsigned)(wid * 256)) : "memory"); } }
    __device__ __forceinline__ void operator()(const f32x4 (&acc)[2][2][4][2], const Unit& u, int wr, int wc, int fr, int fq) const {
        { const int ln_ = fresh_lane(); fr = ln_ & 15; fq = ln_ >> 4; }
        const int row0 = u.pm * BM + wr * 64 + fr, col0 = u.pn * BM + wc * 32 + 8 * fq;
        int tokv[2][4];
#pragma unroll
        for (int ai = 0; ai < 2; ++ai)
#pragma unroll
            for (int m = 0; m < 4; ++m) { const int row = row0 + ai * HALF + m * 16; tokv[ai][m] = SCATTER ? *(const PG8_LAS int*)(pf + (ai * HALF + wr * 64 + m * 16 + fr) * 4) : row; }
#pragma unroll
        for (int ai = 0; ai < 2; ++ai) {
            u32x4 o[4][2];
#pragma unroll
            for (int m = 0; m < 4; ++m) { const int tok = tokv[ai][m]; const bf16_t* rowp = H + (size_t)(tok < 0 ? 0 : tok) * D + col0; o[m][0] = *(const u32x4*)(rowp); o[m][1] = *(const u32x4*)(rowp + HALF); }
#pragma unroll
            for (int m = 0; m < 4; ++m) { const int tok = tokv[ai][m]; float s = 0.f; bf16_t* rowp = H + (size_t)(tok < 0 ? 0 : tok) * D + col0;
#pragma unroll
                for (int bj = 0; bj < 2; ++bj) { const u32x4 oo = o[m][bj];
                    f32x4 v0 = acc[ai][bj][m][0], v1 = acc[ai][bj][m][1];
                    v0[0] += __uint_as_float(oo.x << 16); v0[1] += __uint_as_float(oo.x & 0xffff0000u); v0[2] += __uint_as_float(oo.y << 16); v0[3] += __uint_as_float(oo.y & 0xffff0000u);
                    v1[0] += __uint_as_float(oo.z << 16); v1[1] += __uint_as_float(oo.z & 0xffff0000u); v1[2] += __uint_as_float(oo.w << 16); v1[3] += __uint_as_float(oo.w & 0xffff0000u);
                    s += (v0[0] * v0[0] + v0[1] * v0[1]) + (v0[2] * v0[2] + v0[3] * v0[3]) + (v1[0] * v1[0] + v1[1] * v1[1]) + (v1[2] * v1[2] + v1[3] * v1[3]);
                    u32x4 w; w.x = cvt_pk_bf16(v0[0], v0[1]); w.y = cvt_pk_bf16(v0[2], v0[3]); w.z = cvt_pk_bf16(v1[0], v1[1]); w.w = cvt_pk_bf16(v1[2], v1[3]);
                    if (tok >= 0) *(u32x4*)(rowp + bj * HALF) = w; }
                s = add_x16_x32(s);
                if (fq == 0 && tok >= 0) ssq[(size_t)tok * 16 + u.pn * 4 + wc] = s; }
            asm volatile("" ::: "memory"); }
    }
};
constexpr int SC_W = 0x7b7b7b7b, SC_H = 0x7b7b7b7b, SC_ACT = 0x7b7b7b7b;
constexpr float FS_W = 16.f, FS_H = 16.f, FS_ACT = 16.f;
struct EpiUp {
    static constexpr bool PERM = true, AFTER_DRAIN = false, PF = true; static constexpr int SCALE_W = SC_W, SCALE_A = SC_H;
    unsigned char* ACT; const float* rowg; const PG8_LAS unsigned char* pf;
    __device__ __forceinline__ void prefetch_tok(const int* rowtok, int pm, unsigned lds_addr, int wid) const {
        if (wid < 4) { const char* g = (const char*)(rowtok + (size_t)pm * BM) + wid * 256; const unsigned vo = (unsigned)fresh_lane() * 4u; unsigned keep;
            asm volatile("s_mov_b32 %0, m0\n\ts_mov_b32 m0, %3\n\ts_nop 0\n\tglobal_load_lds_dword %1, %2\n\ts_mov_b32 m0, %0" : "=&s"(keep) : "v"(vo), "s"(g), "s"(lds_addr + 2048u + (unsigned)(wid * 256)) : "memory"); } }
    __device__ __forceinline__ void prefetch(const Unit& u, unsigned lds_addr, int wid) const {
        const char* g = (const char*)(rowg + (size_t)u.pm * BM * 2) + wid * 256; const unsigned vo = (unsigned)fresh_lane() * 4u; unsigned keep;
        asm volatile("s_mov_b32 %0, m0\n\ts_mov_b32 m0, %3\n\ts_nop 0\n\tglobal_load_lds_dword %1, %2\n\ts_mov_b32 m0, %0" : "=&s"(keep) : "v"(vo), "s"(g), "s"(lds_addr + (unsigned)(wid * 256)) : "memory"); }
    __device__ __forceinline__ void operator()(const f32x4 (&acc)[2][2][4][2], const Unit& u, int wr, int wc, int fr, int fq) const {
        { const int ln_ = fresh_lane(); fr = ln_ & 15; fq = ln_ >> 4; }
        const int row0 = u.pm * BM + wr * 64 + fr, s = u.pn >> 2, col0 = s * 512 + (u.pn & 3) * 128 + wc * 32 + 8 * fq;
        float gt[2][4];
#pragma unroll
        for (int ai = 0; ai < 2; ++ai)
#pragma unroll
            for (int m = 0; m < 4; ++m) gt[ai][m] = *(const PG8_LAS float*)(pf + ((ai * HALF + wr * 64 + m * 16 + fr) * 2 + s) * 4);
#pragma unroll
        for (int ai = 0; ai < 2; ++ai)
#pragma unroll
            for (int m = 0; m < 4; ++m) { const int row = row0 + ai * HALF + m * 16; const float g1 = gt[ai][m];
                float o[8];
#pragma unroll
                for (int n = 0; n < 2; ++n)
#pragma unroll
                    for (int j = 0; j < 4; ++j) { const float g = acc[ai][0][m][n][j], up = acc[ai][1][m][n][j]; o[n * 4 + j] = g * __builtin_amdgcn_rcpf(1.0f + __builtin_amdgcn_exp2f(-g)) * up * g1; }
                u32x2 w; w.x = pk_fp8x4(o[0], o[1], o[2], o[3]); w.y = pk_fp8x4(o[4], o[5], o[6], o[7]);
                *(u32x2*)(ACT + (size_t)row * 1024 + col0) = w; }
    }
};
}

__device__ __forceinline__ void tr_item(const float* W, int ldw, int k0, int scol0, const float* gk, bf16_t* WT, int ldo, int drow0, int dk0, LAS float* scr, int lane) {
#pragma unroll 8
    for (int i = 0; i < 32; ++i) { const int kk = 2 * i + (lane >> 5); float v = W[(size_t)(k0 + kk) * ldw + scol0 + (lane & 31)]; if (gk) v *= gk[k0 + kk]; scr[kk * 33 + (lane & 31)] = v; }
    asm volatile("s_waitcnt lgkmcnt(0)" ::: "memory");
    const int c = lane & 7;
#pragma unroll
    for (int j = 0; j < 4; ++j) { const int n = (lane >> 3) + 8 * j; const LAS float* s = scr + (8 * c) * 33 + n;
        u32x4 o; o.x = cvt_pk_bf16(s[0 * 33], s[1 * 33]); o.y = cvt_pk_bf16(s[2 * 33], s[3 * 33]); o.z = cvt_pk_bf16(s[4 * 33], s[5 * 33]); o.w = cvt_pk_bf16(s[6 * 33], s[7 * 33]);
        *(u32x4*)(WT + (size_t)(drow0 + n) * ldo + dk0 + 8 * c) = o; }
    asm volatile("s_waitcnt lgkmcnt(0)" ::: "memory");
}

constexpr size_t S5_L_STRIDE = 1310720, S5_KT = 0, S5_ET = 131072, S5_FT = 655360, S5_LAMP = 1179648;
constexpr int S5_WSCR = 8192, S5_YST = 65536, YST_LD = 264;
constexpr int NU128 = T / 128, UPB128 = SEQ / 128;
__device__ __forceinline__ f32x4 mfma16(bf16x8 a, bf16x8 b, f32x4 c) { return __builtin_amdgcn_mfma_f32_16x16x32_bf16(a, b, c, 0, 0, 0); }

__device__ __forceinline__ void s5_kt_pair(int g, int c, int cp, const float* a_re, const float* a_im, const float* log_dt, const float* b_re, const float* b_im,
                                           const float* c_re, const float* c_im, const float* dvec, unsigned char* tab) {
    const float dt = __expf(log_dt[g]); float km[8];
#pragma unroll
    for (int d = 0; d < 8; ++d) km[d] = 0.f;
#pragma unroll 2
    for (int p = 0; p < CS; ++p) { const float lr = a_re[g * CS + p], li = a_im[g * CS + p], zr = lr * dt, zi = li * dt;
        const float sh = __sinf(0.5f * zi), cz = __cosf(zi), sz = __sinf(zi), ez = __expf(zr); const float nr = expm1f(zr) * cz - 2.0f * sh * sh, ni = ez * sz, den = lr * lr + li * li;
        const float cr = (nr * lr + ni * li) / den, ci = (ni * lr - nr * li) / den;
        const float br = b_re[((size_t)g * CS + p) * CGD + cp], bi = b_im[((size_t)g * CS + p) * CGD + cp]; const float bbr = cr * br - ci * bi, bbi = cr * bi + ci * br;
        const float cre = c_re[((size_t)g * CGD + c) * CS + p], cim = c_im[((size_t)g * CGD + c) * CS + p];
        float vr = cre * bbr - cim * bbi, vi = cre * bbi + cim * bbr;
        const float lbr = ez * cz, lbi = ez * sz;
#pragma unroll
        for (int d = 0; d < 8; ++d) { km[d] += vr; const float t = vr * lbr - vi * lbi; vi = vr * lbi + vi * lbr; vr = t; } }
    if (c == cp) km[0] += dvec[g * CGD + c];
    bf16_t* kt = (bf16_t*)(tab + S5_KT) + (size_t)g * 4096;
#pragma unroll
    for (int dd = 0; dd < 8; ++dd) { kt[(dd * 16 + c) * 32 + cp] = f2bf(km[dd]); kt[(dd * 16 + c) * 32 + 16 + cp] = dd >= 1 ? f2bf(km[dd - 1]) : (bf16_t)0; }
}
__device__ __forceinline__ void s5_kt_wave(int g, int c, int cp, int lane, const float* a_re, const float* a_im, const float* log_dt, const float* b_re, const float* b_im,
                                           const float* c_re, const float* c_im, const float* dvec, unsigned char* tab) {
    const float dt = __expf(log_dt[g]); const int p = lane; float km[8];
    { const float lr = a_re[g * CS + p], li = a_im[g * CS + p], zr = lr * dt, zi = li * dt;
      const float sh = __sinf(0.5f * zi), cz = __cosf(zi), sz = __sinf(zi), ez = __expf(zr); const float nr = expm1f(zr) * cz - 2.0f * sh * sh, ni = ez * sz, den = lr * lr + li * li;
      const float cr = (nr * lr + ni * li) / den, ci = (ni * lr - nr * li) / den;
      const float br = b_re[((size_t)g * CS + p) * CGD + cp], bi = b_im[((size_t)g * CS + p) * CGD + cp]; const float bbr = cr * br - ci * bi, bbi = cr * bi + ci * br;
      const float cre = c_re[((size_t)g * CGD + c) * CS + p], cim = c_im[((size_t)g * CGD + c) * CS + p];
      float vr = cre * bbr - cim * bbi, vi = cre * bbi + cim * bbr;
      const float lbr = ez * cz, lbi = ez * sz;
#pragma unroll
      for (int d = 0; d < 8; ++d) { km[d] = vr; const float t = vr * lbr - vi * lbi; vi = vr * lbi + vi * lbr; vr = t; } }
#pragma unroll
    for (int d = 0; d < 8; ++d) km[d] = wave_sum(km[d]);
    if (c == cp) km[0] += dvec[g * CGD + c];
    if (lane == 0) { bf16_t* kt = (bf16_t*)(tab + S5_KT) + (size_t)g * 4096;
#pragma unroll
        for (int dd = 0; dd < 8; ++dd) { kt[(dd * 16 + c) * 32 + cp] = f2bf(km[dd]); kt[(dd * 16 + c) * 32 + 16 + cp] = dd >= 1 ? f2bf(km[dd - 1]) : (bf16_t)0; } }
}
__device__ __forceinline__ void s5_et_task(int g, int ri, int p, int cp, const float* a_re, const float* a_im, const float* log_dt, const float* b_re, const float* b_im, unsigned char* tab) {
    const float dt = __expf(log_dt[g]); const float lr = a_re[g * CS + p], li = a_im[g * CS + p], zr = lr * dt, zi = li * dt;
    const float sh = __sinf(0.5f * zi), cz = __cosf(zi), sz = __sinf(zi), ez = __expf(zr); const float nr = expm1f(zr) * cz - 2.0f * sh * sh, ni = ez * sz, den = lr * lr + li * li;
    const float cr = (nr * lr + ni * li) / den, ci = (ni * lr - nr * li) / den;
    const float br = b_re[((size_t)g * CS + p) * CGD + cp], bi = b_im[((size_t)g * CS + p) * CGD + cp]; float vr = cr * br - ci * bi, vi = cr * bi + ci * br;
    const float lbr = ez * cz, lbi = ez * sz; bf16_t* et = (bf16_t*)(tab + S5_ET) + (size_t)g * 16384 + (size_t)(ri * 64 + p) * 128 + cp;
#pragma unroll
    for (int sp = 7; sp >= 0; --sp) { et[sp * 16] = f2bf(ri ? vi : vr); const float t = vr * lbr - vi * lbi; vi = vr * lbi + vi * lbr; vr = t; }
}
__device__ __forceinline__ void s5_ft_task(int g, int c, int ri, int p, const float* a_re, const float* a_im, const float* log_dt, const float* c_re, const float* c_im, unsigned char* tab) {
    const float dt = __expf(log_dt[g]); const float lr = a_re[g * CS + p], li = a_im[g * CS + p], zr = lr * dt, zi = li * dt; const float ez = __expf(zr), lbr = ez * __cosf(zi), lbi = ez * __sinf(zi);
    const float cre = c_re[((size_t)g * CGD + c) * CS + p], cim = c_im[((size_t)g * CGD + c) * CS + p]; float vr = cre * lbr - cim * lbi, vi = cre * lbi + cim * lbr;
    bf16_t* ft = (bf16_t*)(tab + S5_FT) + (size_t)g * 16384 + (size_t)c * 128 + ri * 64 + p;
#pragma unroll
    for (int tp = 0; tp < 8; ++tp) { ft[(size_t)tp * 16 * 128] = f2bf(ri ? -vi : vr); const float t = vr * lbr - vi * lbi; vi = vr * lbi + vi * lbr; vr = t; }
}
__device__ __forceinline__ void s5_table_elem(int g, int e, const float* a_re, const float* a_im, const float* log_dt, const float* b_re, const float* b_im,
                                              const float* c_re, const float* c_im, const float* dvec, unsigned char* tab) {
    const float dt = __expf(log_dt[g]);
    if (e < 4096) {
        const int dd = e >> 9, c = (e >> 5) & 15, ee = (e >> 4) & 1, cp = e & 15, d = dd - ee; float s = 0.f;
        if (d >= 0) {
            for (int p = 0; p < CS; ++p) { const float lr = a_re[g * CS + p], li = a_im[g * CS + p], zr = lr * dt, zi = li * dt;
                const float sh = __sinf(0.5f * zi); const float nr = expm1f(zr) * __cosf(zi) - 2.0f * sh * sh, ni = __expf(zr) * __sinf(zi), den = lr * lr + li * li;
                const float cr = (nr * lr + ni * li) / den, ci = (ni * lr - nr * li) / den;
                const float br = b_re[((size_t)g * CS + p) * CGD + cp], bi = b_im[((size_t)g * CS + p) * CGD + cp]; const float bbr = cr * br - ci * bi, bbi = cr * bi + ci * br;
                const float mag = __expf(zr * (float)d), pr = mag * __cosf(zi * (float)d), pi = mag * __sinf(zi * (float)d);
                const float vr = pr * bbr - pi * bbi, vi = pr * bbi + pi * bbr;
                s += c_re[((size_t)g * CGD + c) * CS + p] * vr - c_im[((size_t)g * CGD + c) * CS + p] * vi; }
            if (d == 0 && c == cp) s += dvec[g * CGD + c];
        }
        ((bf16_t*)(tab + S5_KT))[(size_t)g * 4096 + e] = f2bf(s); return;
    }
    e -= 4096;
    if (e < 16384) {
        const int n = e >> 7, k = e & 127, ri = n >> 6, p = n & 63, sp = k >> 4, cp = k & 15;
        const float lr = a_re[g * CS + p], li = a_im[g * CS + p], zr = lr * dt, zi = li * dt;
        const float sh = __sinf(0.5f * zi); const float nr = expm1f(zr) * __cosf(zi) - 2.0f * sh * sh, ni = __expf(zr) * __sinf(zi), den = lr * lr + li * li;
        const float cr = (nr * lr + ni * li) / den, ci = (ni * lr - nr * li) / den;
        const float br = b_re[((size_t)g * CS + p) * CGD + cp], bi = b_im[((size_t)g * CS + p) * CGD + cp]; const float bbr = cr * br - ci * bi, bbi = cr * bi + ci * br;
        const float d = (float)(7 - sp); const float mag = __expf(zr * d), pr = mag * __cosf(zi * d), pi = mag * __sinf(zi * d);
        ((bf16_t*)(tab + S5_ET))[(size_t)g * 16384 + e] = f2bf(ri ? (pr * bbi + pi * bbr) : (pr * bbr - pi * bbi)); return;
    }
    e -= 16384;
    if (e < 16384) {
        const int n = e >> 7, k = e & 127, tp = n >> 4, c = n & 15, ri = k >> 6, p = k & 63;
        const float lr = a_re[g * CS + p], li = a_im[g * CS + p], zr = lr * dt, zi = li * dt;
        const float d = (float)(tp + 1); const float mag = __expf(zr * d), pr = mag * __cosf(zi * d), pi = mag * __sinf(zi * d);
        const float cre = c_re[((size_t)g * CGD + c) * CS + p], cim = c_im[((size_t)g * CGD + c) * CS + p];
        ((bf16_t*)(tab + S5_FT))[(size_t)g * 16384 + e] = f2bf(ri ? -(cre * pi + cim * pr) : (cre * pr - cim * pi)); return;
    }
    e -= 16384;
    { const int p = e; const float lr = a_re[g * CS + p], li = a_im[g * CS + p], zr = lr * dt, zi = li * dt; float* o = (float*)(tab + S5_LAMP) + ((size_t)g * CS + p) * 8;
      float mag = expf(zr); o[0] = mag * cosf(zi); o[1] = mag * sinf(zi);
      mag = expf(zr * 8.f); o[2] = mag * cosf(zi * 8.f); o[3] = mag * sinf(zi * 8.f);
      mag = expf(zr * 128.f); o[4] = mag * cosf(zi * 128.f); o[5] = mag * sinf(zi * 128.f); o[6] = 0.f; o[7] = 0.f; }
}

template <class TT> __device__ __forceinline__ TT ldg(const void* ubase, unsigned voff) { return *(const TT*)((const char*)ubase + voff); }
template <int PASS>
__device__ __forceinline__ void s5_group(int unit, int g, bool first, float& kr, float& ki, int wave, int lane, const bf16_t* Z, bf16_t* Y, const unsigned char* tab, float* SEND, float* SEND2, float* SE, LAS unsigned char* lds) {
    const int ln = lane & 15, q = lane >> 4; const int t0 = unit * 128;
    const char* KTg = (const char*)(tab + S5_KT) + (size_t)g * 8192; const char* ETg = (const char*)(tab + S5_ET) + (size_t)g * 32768; const char* FTg = (const char*)(tab + S5_FT) + (size_t)g * 32768;
    const float* LAMPg = (const float*)(tab + S5_LAMP) + (size_t)g * CS * 8;
    const unsigned vo128 = (unsigned)(ln * 128 + 8 * q) * 2u;
    const unsigned vo32 = (unsigned)(ln * 32 + 8 * q) * 2u;
    LAS float* Sb = (LAS float*)(lds + wave * S5_WSCR); LAS bf16_t* Tb = (LAS bf16_t*)(lds + wave * S5_WSCR); LAS bf16_t* yst = (LAS bf16_t*)(lds + S5_YST);
    char* seb = (char*)(SE + ((size_t)unit * CG + g) * 16 * 128); const unsigned vl = (unsigned)lane * 4u;
    char* ylb = (char*)(Y + (size_t)t0 * D + AW + BW + g * 16); const unsigned vy = (unsigned)((ln * 8) * D + 4 * q) * 2u;
    const float lur = LAMPg[lane * 8 + 4], lui = LAMPg[lane * 8 + 5], l8r = LAMPg[lane * 8 + 2], l8i = LAMPg[lane * 8 + 3];
    float cr = 0.f, ci = 0.f;
    if (PASS == 1) {
        if (!first) { cr = kr; ci = ki; }
        bf16x8 X0, X1, X2, X3;
        { const char* zb = (const char*)(Z + (size_t)t0 * INC + ZC + g * 16); const unsigned vz = (unsigned)((ln * 8 + (q >> 1)) * INC + 8 * (q & 1)) * 2u;
          X0 = ldg<bf16x8>(zb, vz); X1 = ldg<bf16x8>(zb + 2 * INC * 2, vz); X2 = ldg<bf16x8>(zb + 4 * INC * 2, vz); X3 = ldg<bf16x8>(zb + 6 * INC * 2, vz); }
        { LAS float* sw = Sb + (4 * q) * 128 + ln; const char* eb = ETg;
#pragma unroll 1
          for (int jh = 0; jh < 2; ++jh) { bf16x8 ef[4][4];
#pragma unroll
            for (int j = 0; j < 4; ++j)
#pragma unroll
              for (int ks = 0; ks < 4; ++ks) ef[j][ks] = ldg<bf16x8>(eb + j * 4096 + ks * 64, vo128);
#pragma unroll
            for (int j = 0; j < 4; ++j) { f32x4 se = (f32x4){0.f, 0.f, 0.f, 0.f};
              se = mfma16(X0, ef[j][0], se); se = mfma16(X1, ef[j][1], se); se = mfma16(X2, ef[j][2], se); se = mfma16(X3, ef[j][3], se);
              LAS float* s2 = sw + 16 * j; s2[0] = se[0]; s2[128] = se[1]; s2[256] = se[2]; s2[384] = se[3]; }
            eb += 16384; sw += 64; } }
        asm volatile("" ::: "memory");
        { const char* kb = KTg; char* yq = ylb;
#pragma unroll 1
          for (int th = 0; th < 4; ++th) {
              const bf16x8 ka = ldg<bf16x8>(kb, vo32), kc = ldg<bf16x8>(kb + 1024, vo32);
              f32x4 acc0 = (f32x4){0.f, 0.f, 0.f, 0.f}, acc1 = (f32x4){0.f, 0.f, 0.f, 0.f};
              acc0 = mfma16(ka, X0, acc0); acc1 = mfma16(kc, X0, acc1);
              if (th >= 1) { acc0 = mfma16(ldg<bf16x8>(kb - 2048, vo32), X1, acc0); acc1 = mfma16(ldg<bf16x8>(kb - 1024, vo32), X1, acc1); }
              if (th >= 2) { acc0 = mfma16(ldg<bf16x8>(kb - 4096, vo32), X2, acc0); acc1 = mfma16(ldg<bf16x8>(kb - 3072, vo32), X2, acc1); }
              if (th >= 3) { acc0 = mfma16(ldg<bf16x8>(kb - 6144, vo32), X3, acc0); acc1 = mfma16(ldg<bf16x8>(kb - 5120, vo32), X3, acc1); }
              u32x2 w; w.x = cvt_pk_bf16(acc0[0], acc0[1]); w.y = cvt_pk_bf16(acc0[2], acc0[3]); *(u32x2*)(yq + vy) = w;
              w.x = cvt_pk_bf16(acc1[0], acc1[1]); w.y = cvt_pk_bf16(acc1[2], acc1[3]); *(u32x2*)(yq + (size_t)D * 2 + vy) = w;
              kb += 2048; yq += (size_t)2 * D * 2; } }
        asm volatile("" ::: "memory");
        float sr = cr, si = ci;
#pragma unroll
        for (int s = 0; s < 16; ++s) { const float er = Sb[s * 128 + lane], ei = Sb[s * 128 + 64 + lane];
            *(float*)(seb + s * 512 + vl) = er; *(float*)(seb + s * 512 + 256 + vl) = ei;
            const float nr = l8r * sr - l8i * si + er, ni = l8r * si + l8i * sr + ei; sr = nr; si = ni; }
        kr = sr; ki = si;
        float* dst = first ? SEND + (((size_t)unit * CG + g) * 2) * CS + lane : SEND2 + (((size_t)(unit >> 1) * CG + g) * 2) * CS + lane;
        dst[0] = sr; dst[CS] = si; asm volatile("" ::: "memory"); return;
    }
    if (first) { const int pr = unit >> 1, p0 = pr - (pr % (UPB128 / 2)); const float l2r = lur * lur - lui * lui, l2i = 2.0f * lur * lui;
        const char* sb = (const char*)(SEND2 + (((size_t)p0 * CG + g) * 2) * CS);
#pragma unroll 8
        for (int j = p0; j < pr; ++j) { const float sr = ldg<float>(sb, vl), si = ldg<float>(sb + CS * 4, vl); sb += (size_t)CG * 2 * CS * 4;
            const float nr = l2r * cr - l2i * ci + sr, ni = l2r * ci + l2i * cr + si; cr = nr; ci = ni; } }
    else { const float sr = SEND[(((size_t)(unit - 1) * CG + g) * 2 + 0) * CS + lane], si = SEND[(((size_t)(unit - 1) * CG + g) * 2 + 1) * CS + lane];
        cr = lur * kr - lui * ki + sr; ci = lur * ki + lui * kr + si; }
    kr = cr; ki = ci;
    { float sre[16], sim[16];
#pragma unroll
      for (int s = 0; s < 16; ++s) { sre[s] = ldg<float>(seb + s * 512, vl); sim[s] = ldg<float>(seb + s * 512 + 256, vl); }
      float sr = cr, si = ci;
#pragma unroll
      for (int s = 0; s < 16; ++s) { Tb[s * 128 + lane] = f2bf(sr); Tb[s * 128 + 64 + lane] = f2bf(si);
          const float nr = l8r * sr - l8i * si + sre[s], ni = l8r * si + l8i * sr + sim[s]; sr = nr; si = ni; } }
    asm volatile("" ::: "memory");
    const bf16x8 T0 = *(const LAS bf16x8*)(Tb + ln * 128 + 8 * q), T1 = *(const LAS bf16x8*)(Tb + ln * 128 + 32 + 8 * q), T2 = *(const LAS bf16x8*)(Tb + ln * 128 + 64 + 8 * q), T3 = *(const LAS bf16x8*)(Tb + ln * 128 + 96 + 8 * q);
    { LAS bf16_t* yw = yst + (ln * 8) * YST_LD + g * 16 + 4 * q; const char* fb = FTg; const char* yq = ylb;
#pragma unroll 2
      for (int th = 0; th < 4; ++th) { bf16x8 ff[2][4]; u32x2 yl[2];
#pragma unroll
          for (int j = 0; j < 2; ++j) { yl[j] = ldg<u32x2>(yq + (size_t)j * D * 2, vy);
#pragma unroll
              for (int ks = 0; ks < 4; ++ks) ff[j][ks] = ldg<bf16x8>(fb + j * 4096 + ks * 64, vo128); }
#pragma unroll
          for (int j = 0; j < 2; ++j) {
              f32x4 acc; acc[0] = __uint_as_float(yl[j].x << 16); acc[1] = __uint_as_float(yl[j].x & 0xffff0000u); acc[2] = __uint_as_float(yl[j].y << 16); acc[3] = __uint_as_float(yl[j].y & 0xffff0000u);
              acc = mfma16(ff[j][0], T0, acc); acc = mfma16(ff[j][1], T1, acc); acc = mfma16(ff[j][2], T2, acc); acc = mfma16(ff[j][3], T3, acc);
              u32x2 w; w.x = cvt_pk_bf16(gelu_fast(acc[0]), gelu_fast(acc[1])); w.y = cvt_pk_bf16(gelu_fast(acc[2]), gelu_fast(acc[3]));
              *(LAS u32x2*)(yw + j * YST_LD) = w; }
          fb += 8192; yq += (size_t)2 * D * 2; yw += 2 * YST_LD; } }
    asm volatile("s_waitcnt lgkmcnt(0)" ::: "memory");
}
__device__ __forceinline__ void s5_p2x2(int unit, int g0, bool first, float& k0r, float& k0i, float& k1r, float& k1i, int wave, int lane, const bf16_t* Z, const unsigned char* tab,
                                        const float* SEND, const float* SEND2, const float* SE, LAS unsigned char* lds) {
    const int ln = lane & 15, q = lane >> 4; const int t0 = unit * 128;
    const unsigned vo128 = (unsigned)(ln * 128 + 8 * q) * 2u; unsigned vl = (unsigned)lane * 4u; asm volatile("" : "+v"(vl));
    LAS bf16_t* Tb = (LAS bf16_t*)(lds + wave * S5_WSCR); LAS bf16_t* yst = (LAS bf16_t*)(lds + S5_YST);
    float lur[2], lui[2], l8r[2], l8i[2], cr[2] = {0.f, 0.f}, ci[2] = {0.f, 0.f};
#pragma unroll
    for (int gi = 0; gi < 2; ++gi) { const float* LAMPg = (const float*)(tab + S5_LAMP) + (size_t)(g0 + gi) * CS * 8; lur[gi] = LAMPg[lane * 8 + 4]; lui[gi] = LAMPg[lane * 8 + 5]; l8r[gi] = LAMPg[lane * 8 + 2]; l8i[gi] = LAMPg[lane * 8 + 3]; }
    float sre[2][16], sim[2][16]; bf16x8 Xf[2][4]; float snr[2] = {0.f, 0.f}, sni[2] = {0.f, 0.f};
    { const char* seb = (const char*)(SE + ((size_t)unit * CG + g0) * 16 * 128);
#pragma unroll
        for (int sp = 0; sp < 8; ++sp) { const unsigned r2 = ldg<unsigned>(seb + sp * 512, vl), i2 = ldg<unsigned>(seb + sp * 512 + 256, vl);
            sre[0][2 * sp] = __uint_as_float(r2 << 16); sre[0][2 * sp + 1] = __uint_as_float(r2 & 0xffff0000u); sim[0][2 * sp] = __uint_as_float(i2 << 16); sim[0][2 * sp + 1] = __uint_as_float(i2 & 0xffff0000u); } }
#pragma unroll
    for (int gi = 0; gi < 2; ++gi) { const char* zb = (const char*)(Z + (size_t)t0 * INC + ZC + (g0 + gi) * 16); const unsigned vz = (unsigned)((ln * 8 + (q >> 1)) * INC + 8 * (q & 1)) * 2u;
#pragma unroll
        for (int ks = 0; ks < 4; ++ks) Xf[gi][ks] = ldg<bf16x8>(zb + (size_t)(2 * ks) * INC * 2, vz); }
    if (!first) {
#pragma unroll
        for (int gi = 0; gi < 2; ++gi) { const char* sb_ = (const char*)(SEND + (((size_t)(unit - 1) * CG + g0 + gi) * 2) * CS); snr[gi] = ldg<float>(sb_, vl); sni[gi] = ldg<float>(sb_ + CS * 4, vl); } }
    if (first) { const int pr = unit >> 1, len = pr % (UPB128 / 2), p0 = pr - len;
        float l2r[2], l2i[2];
#pragma unroll
        for (int gi = 0; gi < 2; ++gi) { l2r[gi] = lur[gi] * lur[gi] - lui[gi] * lui[gi]; l2i[gi] = 2.0f * lur[gi] * lui[gi]; }
#pragma unroll 1
        for (int j0 = 0; j0 < len; j0 += 8) { float br[2][8], bi[2][8];
#pragma unroll
            for (int k = 0; k < 8; ++k) { const int jj = (j0 + k < len) ? j0 + k : len - 1;
#pragma unroll
                for (int gi = 0; gi < 2; ++gi) { const char* sj = (const char*)(SEND2 + (((size_t)(p0 + jj) * CG + g0 + gi) * 2) * CS); br[gi][k] = ldg<float>(sj, vl); bi[gi][k] = ldg<float>(sj + CS * 4, vl); } }
#pragma unroll
            for (int k = 0; k < 8; ++k) { const bool v = j0 + k < len;
#pragma unroll
                for (int gi = 0; gi < 2; ++gi) { const float nr = l2r[gi] * cr[gi] - l2i[gi] * ci[gi] + br[gi][k], ni = l2r[gi] * ci[gi] + l2i[gi] * cr[gi] + bi[gi][k]; cr[gi] = v ? nr : cr[gi]; ci[gi] = v ? ni : ci[gi]; } } } }
    else { cr[0] = lur[0] * k0r - lui[0] * k0i + snr[0]; ci[0] = lur[0] * k0i + lui[0] * k0r + sni[0]; cr[1] = lur[1] * k1r - lui[1] * k1i + snr[1]; ci[1] = lur[1] * k1i + lui[1] * k1r + sni[1]; }
    k0r = cr[0]; k0i = ci[0]; k1r = cr[1]; k1i = ci[1];
    unsigned pk1r[8], pk1i[8];
#pragma unroll
    for (int gi = 0; gi < 2; ++gi) { const int g = g0 + gi; const char* FTg = (const char*)(tab + S5_FT) + (size_t)g * 32768; const char* KTg = (const char*)(tab + S5_KT) + (size_t)g * 8192;
      if (gi == 1) {
#pragma unroll
          for (int sp = 0; sp < 8; ++sp) { sre[1][2 * sp] = __uint_as_float(pk1r[sp] << 16); sre[1][2 * sp + 1] = __uint_as_float(pk1r[sp] & 0xffff0000u); sim[1][2 * sp] = __uint_as_float(pk1i[sp] << 16); sim[1][2 * sp + 1] = __uint_as_float(pk1i[sp] & 0xffff0000u); } }
      bf16x8 kt[8];
      { float sr = cr[gi], si = ci[gi];
#pragma unroll
        for (int s = 0; s < 16; ++s) { Tb[s * 128 + lane] = f2bf(sr); Tb[s * 128 + 64 + lane] = f2bf(si);
            const float nr = l8r[gi] * sr - l8i[gi] * si + sre[gi][s], ni = l8r[gi] * si + l8i[gi] * sr + sim[gi][s]; sr = nr; si = ni; } }
      asm volatile("" ::: "memory");
      if (gi == 0) { const char* seb = (const char*)(SE + ((size_t)unit * CG + g0 + 1) * 16 * 128);
#pragma unroll
          for (int sp = 0; sp < 8; ++sp) { pk1r[sp] = ldg<unsigned>(seb + sp * 512, vl); pk1i[sp] = ldg<unsigned>(seb + sp * 512 + 256, vl); } }
      const bf16x8 T0 = *(const LAS bf16x8*)(Tb + ln * 128 + 8 * q), T1 = *(const LAS bf16x8*)(Tb + ln * 128 + 32 + 8 * q), T2 = *(const LAS bf16x8*)(Tb + ln * 128 + 64 + 8 * q), T3 = *(const LAS bf16x8*)(Tb + ln * 128 + 96 + 8 * q);
      asm volatile("s_waitcnt lgkmcnt(0)" ::: "memory");
      { LAS bf16_t* yw = yst + (ln * 8) * YST_LD + g * 16 + 4 * q; const char* fb = FTg;
#pragma unroll
        for (int th = 0; th < 4; ++th) { bf16x8 ff[2][4];
            if (th == 0 || th == 2) {
#pragma unroll
                for (int dd = 0; dd < 4; ++dd) kt[2 * th + dd] = ldg<bf16x8>(KTg + (2 * th + dd) * 1024, (unsigned)(ln * 32 + 8 * q) * 2u); }
#pragma unroll
            for (int j = 0; j < 2; ++j)
#pragma unroll
                for (int ks = 0; ks < 4; ++ks) ff[j][ks] = ldg<bf16x8>(fb + j * 4096 + ks * 64, vo128);
#pragma unroll
            for (int j = 0; j < 2; ++j) { f32x4 acc = (f32x4){0.f, 0.f, 0.f, 0.f};
#pragma unroll
                for (int ks = 0; ks < 4; ++ks) { const int dd = 2 * th + j - 2 * ks; if (dd >= 0) acc = mfma16(kt[dd & 7], Xf[gi][ks], acc); }
                acc = mfma16(ff[j][0], T0, acc); acc = mfma16(ff[j][1], T1, acc); acc = mfma16(ff[j][2], T2, acc); acc = mfma16(ff[j][3], T3, acc);
                u32x2 w; w.x = cvt_pk_bf16(gelu_fast(acc[0]), gelu_fast(acc[1])); w.y = cvt_pk_bf16(gelu_fast(acc[2]), gelu_fast(acc[3]));
                *(LAS u32x2*)(yw + j * YST_LD) = w; }
            fb += 8192; yw += 2 * YST_LD; if (th & 1) asm volatile("" ::: "memory"); } } }
    asm volatile("s_waitcnt lgkmcnt(0)" ::: "memory");
}
__device__ __forceinline__ void s5_pair1(int pr, int g, int wave, int lane, const bf16_t* Z, bf16_t* Y, const unsigned char* tab, float* SEND, float* SEND2, float* SE, LAS unsigned char* lds) {
    const int ln = lane & 15, q = lane >> 4; const int t0 = pr * 256;
    const char* KTg = (const char*)(tab + S5_KT) + (size_t)g * 8192; const char* ETg = (const char*)(tab + S5_ET) + (size_t)g * 32768;
    const float* LAMPg = (const float*)(tab + S5_LAMP) + (size_t)g * CS * 8;
    const unsigned vo128 = (unsigned)(ln * 128 + 8 * q) * 2u, vo32 = (unsigned)(ln * 32 + 8 * q) * 2u, vl = (unsigned)lane * 4u;
    LAS float* SbA = (LAS float*)(lds + wave * 16384); LAS float* SbB = SbA + 2048;
    bf16x8 XA0, XA1, XA2, XA3, XB0, XB1, XB2, XB3;
    { const char* zb = (const char*)(Z + (size_t)t0 * INC + ZC + g * 16); const unsigned vz = (unsigned)((ln * 8 + (q >> 1)) * INC + 8 * (q & 1)) * 2u;
      XA0 = ldg<bf16x8>(zb, vz); XA1 = ldg<bf16x8>(zb + 2 * INC * 2, vz); XA2 = ldg<bf16x8>(zb + 4 * INC * 2, vz); XA3 = ldg<bf16x8>(zb + 6 * INC * 2, vz);
      const char* zc = zb + (size_t)128 * INC * 2;
      XB0 = ldg<bf16x8>(zc, vz); XB1 = ldg<bf16x8>(zc + 2 * INC * 2, vz); XB2 = ldg<bf16x8>(zc + 4 * INC * 2, vz); XB3 = ldg<bf16x8>(zc + 6 * INC * 2, vz); }
    { LAS float* sw = SbA + (4 * q) * 128 + ln; const char* eb = ETg;
#pragma unroll
      for (int jh = 0; jh < 2; ++jh) { bf16x8 ef[4][4];
#pragma unroll
        for (int j = 0; j < 4; ++j)
#pragma unroll
          for (int ks = 0; ks < 4; ++ks) ef[j][ks] = ldg<bf16x8>(eb + j * 4096 + ks * 64, vo128);
#pragma unroll
        for (int j = 0; j < 4; ++j) { f32x4 sa = (f32x4){0.f, 0.f, 0.f, 0.f}, sb = (f32x4){0.f, 0.f, 0.f, 0.f};
          sa = mfma16(XA0, ef[j][0], sa); sb = mfma16(XB0, ef[j][0], sb); sa = mfma16(XA1, ef[j][1], sa); sb = mfma16(XB1, ef[j][1], sb);
          sa = mfma16(XA2, ef[j][2], sa); sb = mfma16(XB2, ef[j][2], sb); sa = mfma16(XA3, ef[j][3], sa); sb = mfma16(XB3, ef[j][3], sb);
          LAS float* s2 = sw + 16 * j; s2[0] = sa[0]; s2[128] = sa[1]; s2[256] = sa[2]; s2[384] = sa[3]; s2[2048] = sb[0]; s2[2048 + 128] = sb[1]; s2[2048 + 256] = sb[2]; s2[2048 + 384] = sb[3]; }
        eb += 16384; sw += 64; } }
    asm volatile("" ::: "memory");
    asm volatile("" ::: "memory");
    const float l8r = LAMPg[lane * 8 + 2], l8i = LAMPg[lane * 8 + 3];
    float sr = 0.f, si = 0.f, per = 0.f, pei = 0.f;
    { char* seb = (char*)(SE + ((size_t)(2 * pr) * CG + g) * 16 * 128);
#pragma unroll
      for (int s = 0; s < 16; ++s) { const float er = SbA[s * 128 + lane], ei = SbA[s * 128 + 64 + lane];
          if (s & 1) { *(unsigned*)(seb + (s >> 1) * 512 + vl) = cvt_pk_bf16(per, er); *(unsigned*)(seb + (s >> 1) * 512 + 256 + vl) = cvt_pk_bf16(pei, ei); } per = er; pei = ei;
          const float nr = l8r * sr - l8i * si + er, ni = l8r * si + l8i * sr + ei; sr = nr; si = ni; }
      float* dst = SEND + (((size_t)(2 * pr) * CG + g) * 2) * CS + lane; dst[0] = sr; dst[CS] = si; }
    { char* seb = (char*)(SE + ((size_t)(2 * pr + 1) * CG + g) * 16 * 128);
#pragma unroll
      for (int s = 0; s < 16; ++s) { const float er = SbB[s * 128 + lane], ei = SbB[s * 128 + 64 + lane];
          if (s & 1) { *(unsigned*)(seb + (s >> 1) * 512 + vl) = cvt_pk_bf16(per, er); *(unsigned*)(seb + (s >> 1) * 512 + 256 + vl) = cvt_pk_bf16(pei, ei); } per = er; pei = ei;
          const float nr = l8r * sr - l8i * si + er, ni = l8r * si + l8i * sr + ei; sr = nr; si = ni; }
      float* dst = SEND2 + (((size_t)pr * CG + g) * 2) * CS + lane; dst[0] = sr; dst[CS] = si; }
    asm volatile("s_waitcnt lgkmcnt(0)" ::: "memory");
}
constexpr int S5_PSG = 133120;
__device__ __forceinline__ void s5_glu(int unit, int wave, int lane, const bf16_t* WGLU, const float* glu_b, const float* mo_gc, bf16_t* Y, LAS unsigned char* lds) {
    const int ln = lane & 15, q = lane >> 4; LAS bf16_t* yst = (LAS bf16_t*)(lds + S5_YST); LAS float* PSg = (LAS float*)(lds + S5_PSG);
    bf16x8 wf[2][8];
    { const char* wb = (const char*)(WGLU + (size_t)(32 * wave) * 256); const unsigned vw = (unsigned)(ln * 256 + 8 * q) * 2u;
#pragma unroll
      for (int j = 0; j < 2; ++j)
#pragma unroll
          for (int ks = 0; ks < 8; ++ks) wf[j][ks] = ldg<bf16x8>(wb + j * 8192 + ks * 64, vw); }
    const f32x4 gb0 = *(const f32x4*)(glu_b + 32 * wave + 4 * q), gb1 = *(const f32x4*)(glu_b + 32 * wave + 16 + 4 * q);
    LAS bf16_t* op = (LAS bf16_t*)(lds + wave * S5_WSCR) + ln * 32 + 4 * q;
    { const LAS bf16_t* yrow = yst + ln * YST_LD; LAS float* psw = PSg + ln * 8 + wave; LAS bf16_t* ow = op;
#pragma unroll 4
      for (int tt = 0; tt < 8; ++tt) {
        f32x4 a0 = (f32x4){0.f, 0.f, 0.f, 0.f}, a1 = (f32x4){0.f, 0.f, 0.f, 0.f};
#pragma unroll
        for (int ks = 0; ks < 8; ++ks) { const bf16x8 yf = *(const LAS bf16x8*)(yrow + 32 * ks + 8 * q); a0 = mfma16(wf[0][ks], yf, a0); a1 = mfma16(wf[1][ks], yf, a1); }
        const u32x2 y0 = *(const LAS u32x2*)(yrow + 32 * wave + 4 * q), y1 = *(const LAS u32x2*)(yrow + 32 * wave + 16 + 4 * q);
        float o[8];
        o[0] = __uint_as_float(y0.x << 16) * sigmoid_fast(a0[0] + gb0[0]); o[1] = __uint_as_float(y0.x & 0xffff0000u) * sigmoid_fast(a0[1] + gb0[1]); o[2] = __uint_as_float(y0.y << 16) * sigmoid_fast(a0[2] + gb0[2]); o[3] = __uint_as_float(y0.y & 0xffff0000u) * sigmoid_fast(a0[3] + gb0[3]);
        o[4] = __uint_as_float(y1.x << 16) * sigmoid_fast(a1[0] + gb1[0]); o[5] = __uint_as_float(y1.x & 0xffff0000u) * sigmoid_fast(a1[1] + gb1[1]); o[6] = __uint_as_float(y1.y << 16) * sigmoid_fast(a1[2] + gb1[2]); o[7] = __uint_as_float(y1.y & 0xffff0000u) * sigmoid_fast(a1[3] + gb1[3]);
        float ss = ((o[0] * o[0] + o[1] * o[1]) + (o[2] * o[2] + o[3] * o[3])) + ((o[4] * o[4] + o[5] * o[5]) + (o[6] * o[6] + o[7] * o[7]));
        ss = add_x16_x32(ss);
        if (q == 0) *psw = ss;
        u32x2 w; w.x = cvt_pk_bf16(o[0], o[1]); w.y = cvt_pk_bf16(o[2], o[3]); *(LAS u32x2*)(ow) = w; w.x = cvt_pk_bf16(o[4], o[5]); w.y = cvt_pk_bf16(o[6], o[7]); *(LAS u32x2*)(ow + 16) = w;
        yrow += 16 * YST_LD; psw += 16 * 8; ow += 16 * 32; } }
    asm volatile("s_waitcnt lgkmcnt(0)" ::: "memory");
    __syncthreads();
    { const int p = lane & 31, rsel = lane >> 5; (void)mo_gc;
      const LAS unsigned char* src = lds + (p >> 2) * S5_WSCR + (p & 3) * 16; bf16_t* yb = Y + (size_t)(unit * 128) * D + AW + BW + 8 * p;
#pragma unroll 4
      for (int it = 0; it < 8; ++it) { const int row = 16 * wave + 2 * it + rsel; const LAS f32x4* pp = (const LAS f32x4*)(PSg + row * 8); const f32x4 p0 = pp[0], p1 = pp[1];
        const float rs = __builtin_amdgcn_rsqf((((p0[0] + p0[1]) + (p0[2] + p0[3])) + ((p1[0] + p1[1]) + (p1[2] + p1[3]))) * (1.0f / CW) + EPS);
        const u32x4 a = *(const LAS u32x4*)(src + row * 64); u32x4 w;
        w.x = cvt_pk_bf16(__uint_as_float(a.x << 16) * rs, __uint_as_float(a.x & 0xffff0000u) * rs); w.y = cvt_pk_bf16(__uint_as_float(a.y << 16) * rs, __uint_as_float(a.y & 0xffff0000u) * rs);
        w.z = cvt_pk_bf16(__uint_as_float(a.z << 16) * rs, __uint_as_float(a.z & 0xffff0000u) * rs); w.w = cvt_pk_bf16(__uint_as_float(a.w << 16) * rs, __uint_as_float(a.w & 0xffff0000u) * rs);
        *(u32x4*)(yb + (size_t)row * D) = w; } }
}

constexpr int XC_LD = 392;
constexpr int RG_XC = 0, RG_PS = 100352, RG_CAR = 112640, RG_RSB = 114176, RG_PT = 114688, RG_HC = 116224;
template <int CTRL> __device__ __forceinline__ float dpp0(float v) { return __int_as_float(__builtin_amdgcn_update_dpp(0, __float_as_int(v), CTRL, 0xf, 0xf, true)); }
template <int CTRL> __device__ __forceinline__ float dppf(float old, float v) { return __int_as_float(__builtin_amdgcn_update_dpp(__float_as_int(old), __float_as_int(v), CTRL, 0xf, 0xf, false)); }
__device__ __forceinline__ void bf8_to_f32(const u32x4 o, float (&v)[8]) {
    v[0] = __uint_as_float(o.x << 16); v[1] = __uint_as_float(o.x & 0xffff0000u); v[2] = __uint_as_float(o.y << 16); v[3] = __uint_as_float(o.y & 0xffff0000u);
    v[4] = __uint_as_float(o.z << 16); v[5] = __uint_as_float(o.z & 0xffff0000u); v[6] = __uint_as_float(o.w << 16); v[7] = __uint_as_float(o.w & 0xffff0000u);
}
__device__ __forceinline__ float bcast15(float v) { return __int_as_float(__builtin_amdgcn_ds_swizzle(__float_as_int(v), 0x1F0)); }
struct TrP { const float* src; const float* gk; unsigned char* dst; unsigned char* dst2; unsigned char* dst3; int ldw, ldo, fp8; float wsc; };
__device__ __forceinline__ void tr_load_w(const TrP& P, int lane, f32x4 (&v)[16], float (&gv)[4]) {
    const int ln = lane & 15, q = lane >> 4;
#pragma unroll
    for (int b = 0; b < 4; ++b) { const int kk = 16 * (ln >> 2) + 4 * b + (ln & 3); gv[b] = (P.gk ? P.gk[kk] : 1.0f) * (P.wsc * (1.0f / pg8::FS_W));
#pragma unroll
        for (int gp = 0; gp < 2; ++gp) { const float* sp = P.src + (size_t)kk * P.ldw + 32 * gp + 4 * q; v[(b * 2 + gp) * 2] = *(const f32x4*)(sp); v[(b * 2 + gp) * 2 + 1] = *(const f32x4*)(sp + 16); } }
}
__device__ __forceinline__ void tr_store_w(const TrP& P, int lane, const f32x4 (&v)[16], const float (&gv)[4]) {
    const int c = lane & 15, fq = lane >> 4;
    bf16x8 Bs[2];
#pragma unroll
    for (int hf = 0; hf < 2; ++hf)
#pragma unroll
        for (int e = 0; e < 8; ++e) Bs[hf][e] = (short)((fq == (c >> 2) && e == (c & 3) + 4 * hf) ? 0x4180 : 0);
#pragma unroll
    for (int gp = 0; gp < 2; ++gp) { bf16x8 A[4];
#pragma unroll
        for (int b = 0; b < 4; ++b) { const f32x4 x0 = v[(b * 2 + gp) * 2] * gv[b], x1 = v[(b * 2 + gp) * 2 + 1] * gv[b];
            u32x4 pk; pk.x = cvt_pk_bf16(x0[0], x0[1]); pk.y = cvt_pk_bf16(x0[2], x0[3]); pk.z = cvt_pk_bf16(x1[0], x1[1]); pk.w = cvt_pk_bf16(x1[2], x1[3]); A[b] = __builtin_bit_cast(bf16x8, pk); }
#pragma unroll
        for (int hf = 0; hf < 2; ++hf) { u32x4 w;
#pragma unroll
            for (int b = 0; b < 4; ++b) { const f32x4 d = mfma16(A[b], Bs[hf], (f32x4){0.f, 0.f, 0.f, 0.f}); w[b] = pk_fp8x4(d[0], d[1], d[2], d[3]); }
            const size_t off = (size_t)(32 * gp + 16 * hf + c) * P.ldo + 16 * fq;
            *(u32x4*)(P.dst + off) = w; if (P.dst2) { *(u32x4*)(P.dst2 + off) = w; *(u32x4*)(P.dst3 + off) = w; } } }
}
constexpr int I_GU = 2 * 16 * 128, I_D8 = 16 * 128, I_W = I_GU + I_D8;
struct TrCtx { const float* i_wg; const float* i_wu; const float* i_wd; const float* i_fg; unsigned char* WGU; unsigned char* ws; int layer; };
#define TR_DECODE_W(P, it) do { const int l = (it) / I_W; int r = (it) % I_W; P.fp8 = 1; P.dst2 = nullptr; P.dst3 = nullptr; P.gk = nullptr; P.wsc = pg8::FS_W; \
            if (r < I_GU) { const int which = r / (16 * 128), e = (r / 128) % 16, q = r % 128, kb = q / 8, nb = q % 8, n0 = nb * 64;     \
                P.src = (which ? i_wu : i_wg) + ((size_t)l * NE + e) * D * DE + (size_t)kb * 64 * DE + n0; P.ldw = DE; P.gk = i_fg + (size_t)l * D + kb * 64;     \
                if (!which) P.wsc = pg8::FS_W * 1.4426950408889634f;     \
                P.dst = (unsigned char*)WGU + ((size_t)l * NE + e) * 1024 * 1024 + (size_t)((n0 / 128) * 256 + which * 128 + (n0 % 128)) * 1024 + kb * 64; P.ldo = 1024; } \
            else { r -= I_GU; const int e = r / 128, q = r % 128, kb = q / 16, nb = q % 16;        \
                P.src = i_wd + ((size_t)l * NE + e) * DE * D + (size_t)kb * 64 * D + nb * 64; P.ldw = D; P.ldo = 1024; \
                { const int g_ = e >> 2, j_ = e & 3; int cnt_ = 0; \
                  _Pragma("unroll") for (int pi_ = 0; pi_ < 6; ++pi_) { const int lo_ = pair_lo(pi_), hi_ = pair_hi(pi_); if (lo_ == j_ || hi_ == j_) { \
                      unsigned char* d_ = ws + WS_WD2 + (((size_t)l * NCLS + g_ * 6 + pi_) * 1024 + (size_t)nb * 64) * 1024 + (hi_ == j_ ? 512 : 0) + kb * 64; \
                      if (cnt_ == 0) P.dst = d_; else if (cnt_ == 1) P.dst2 = d_; else P.dst3 = d_; ++cnt_; } } } } } while (0)
template <int PASS>
__device__ __forceinline__ void rglru_unit(int unit, bool first, float& cprev, int tid, int wave, int lane, const bf16_t* Z, bf16_t* Y, const bf16_t* WRG, const bf16_t* WIG,
                                           const float* conv_w, const float* conv_b, const float* rg_b, const float* ig_b, const float* lam, const float* mo_gb,
                                           float* SUMA, float* SUMH, float* SUMA2, float* SUMH2, bf16_t* HL, bf16_t* PP, LAS unsigned char* lds, bool tr_on = false, const TrCtx* tcx = nullptr) {
    LAS bf16_t* xcl = (LAS bf16_t*)(lds + RG_XC); LAS float* PS = (LAS float*)(lds + RG_PS); LAS float* CAR = (LAS float*)(lds + RG_CAR); LAS float* RSB = (LAS float*)(lds + RG_RSB); LAS float* PT = (LAS float*)(lds + RG_PT); LAS float* HC = (LAS float*)(lds + RG_HC);
    const int t0 = unit * 128; const int ln = lane & 15, q = lane >> 4;
    if (tid < 384) {
        const int c0 = (tid % 48) * 8, tg = tid / 48; const int tb = t0 + tg * 16, s0 = tb % SEQ;
        float w0[8], w1[8], w2[8], w3[8], bb[8];
#pragma unroll
        for (int hh = 0; hh < 2; ++hh) { const f32x4 a0 = *(const f32x4*)(conv_w + 0 * BW + c0 + 4 * hh), a1 = *(const f32x4*)(conv_w + 1 * BW + c0 + 4 * hh), a2 = *(const f32x4*)(conv_w + 2 * BW + c0 + 4 * hh), a3 = *(const f32x4*)(conv_w + 3 * BW + c0 + 4 * hh), a4 = *(const f32x4*)(conv_b + c0 + 4 * hh);
#pragma unroll
            for (int j = 0; j < 4; ++j) { w0[4 * hh + j] = a0[j]; w1[4 * hh + j] = a1[j]; w2[4 * hh + j] = a2[j]; w3[4 * hh + j] = a3[j]; bb[4 * hh + j] = a4[j]; } }
        float xm1[8], xm2[8], xm3[8];
        const bf16_t* zp = Z + (size_t)tb * INC + ZX + c0;
        { const u32x4 z4 = {0u, 0u, 0u, 0u}; const u32x4 o1 = s0 >= 1 ? *(const u32x4*)(zp - INC) : z4, o2 = s0 >= 2 ? *(const u32x4*)(zp - 2 * INC) : z4, o3 = s0 >= 3 ? *(const u32x4*)(zp - 3 * INC) : z4;
          bf8_to_f32(o1, xm1); bf8_to_f32(o2, xm2); bf8_to_f32(o3, xm3); }
        LAS bf16_t* xw = xcl + (tg * 16) * XC_LD + c0;
#pragma unroll 4
        for (int i = 0; i < 16; ++i) { float x0[8]; bf8_to_f32(*(const u32x4*)(zp), x0); float v[8];
#pragma unroll
            for (int j = 0; j < 8; ++j) { v[j] = bb[j] + w3[j] * x0[j] + w2[j] * xm1[j] + w1[j] * xm2[j] + w0[j] * xm3[j]; xm3[j] = xm2[j]; xm2[j] = xm1[j]; xm1[j] = x0[j]; }
            u32x4 w; w.x = cvt_pk_bf16(v[0], v[1]); w.y = cvt_pk_bf16(v[2], v[3]); w.z = cvt_pk_bf16(v[4], v[5]); w.w = cvt_pk_bf16(v[6], v[7]);
            *(LAS u32x4*)(xw) = w; zp += INC; xw += XC_LD; }
        if (PASS == 2) { const int c = tid; float h;
            if (first) { const int pr = unit >> 1, p0 = pr - (pr % (UPB128 / 2)); h = 0.f; const float* pa = SUMA2 + (size_t)p0 * BW + c; const float* ph = SUMH2 + (size_t)p0 * BW + c;
#pragma unroll 8
                for (int j = p0; j < pr; ++j) { h = fmaf(*pa, h, *ph); pa += BW; ph += BW; } }
            else h = fmaf(SUMA[(size_t)(unit - 1) * BW + c], cprev, SUMH[(size_t)(unit - 1) * BW + c]);
            cprev = h; CAR[c] = h; }
    }
    __syncthreads();
#pragma unroll 1
    for (int ci = 0; ci < 3; ++ci) {
        const int combo = wave + 8 * ci, h = combo >> 2, jt = combo & 3, cb = h * 64 + jt * 16;
        const bf16_t* wr = WRG + ((size_t)(h * 64 + jt * 16 + ln)) * 64 + 8 * q; const bf16_t* wi = WIG + ((size_t)(h * 64 + jt * 16 + ln)) * 64 + 8 * q;
        const bf16x8 RG0 = *(const bf16x8*)(wr), RG1 = *(const bf16x8*)(wr + 32), IG0 = *(const bf16x8*)(wi), IG1 = *(const bf16x8*)(wi + 32);
        const f32x4 rgb4 = *(const f32x4*)(rg_b + cb + 4 * q), igb4 = *(const f32x4*)(ig_b + cb + 4 * q), lam4 = *(const f32x4*)(lam + cb + 4 * q);
        const float m1 = ln < 1 ? 1.f : 0.f, m2 = ln < 2 ? 1.f : 0.f, m4 = ln < 4 ? 1.f : 0.f, m8 = ln < 8 ? 1.f : 0.f;
        float spc[4], car[4], ptot[4];
#pragma unroll
        for (int r = 0; r < 4; ++r) { spc[r] = -8.0f * 1.4426950408889634f * log1pf(expf(-lam4[r])); car[r] = PASS == 2 ? CAR[cb + 4 * q + r] : (first ? 0.f : HC[cb + 4 * q + r]); ptot[r] = (PASS == 1 && !first) ? PT[cb + 4 * q + r] : 1.f; }
        const LAS bf16_t* xb = xcl + ln * XC_LD + h * 64 + 8 * q; const LAS bf16_t* xv = xcl + ln * XC_LD + cb + 4 * q;
        const bf16_t* zg = Z + (size_t)(t0 + ln) * INC + ZG + cb + 4 * q; bf16_t* yo = Y + (size_t)(t0 + ln) * D + AW + cb + 4 * q; LAS float* psw = PS + ln * 24 + combo;
        bf16_t* hlo = HL + (size_t)(t0 + ln) * BW + cb + 4 * q; bf16_t* ppo = PP + (size_t)(t0 + ln) * BW + cb + 4 * q;
        TrP tP; f32x4 tv[16]; float tg[4];
        const bool tr_me = PASS == 1 && tr_on && (tcx->layer == 0 ? ci < 2 : ci == 0);
        if (tr_me) { const float* i_wg = tcx->i_wg; const float* i_wu = tcx->i_wu; const float* i_wd = tcx->i_wd; const float* i_fg = tcx->i_fg; unsigned char* WGU = tcx->WGU; unsigned char* ws = tcx->ws;
            const int it_ = tcx->layer == 0 ? (unit * 2 + ci) * 8 + wave : 8192 + unit * 8 + wave; TR_DECODE_W(tP, it_); tr_load_w(tP, lane, tv, tg); }
#pragma unroll 1
        for (int tt = 0; tt < 8; ++tt) {
            const bf16x8 B0 = *(const LAS bf16x8*)(xb), B1 = *(const LAS bf16x8*)(xb + 32);
            f32x4 ar = (f32x4){0.f, 0.f, 0.f, 0.f}, ai = (f32x4){0.f, 0.f, 0.f, 0.f};
            ar = mfma16(RG0, B0, ar); ar = mfma16(RG1, B1, ar); ai = mfma16(IG0, B0, ai); ai = mfma16(IG1, B1, ai);
            const u32x2 xq = *(const LAS u32x2*)(xv); float xc4[4] = {__uint_as_float(xq.x << 16), __uint_as_float(xq.x & 0xffff0000u), __uint_as_float(xq.y << 16), __uint_as_float(xq.y & 0xffff0000u)};
            float hv[4], pv[4];
#pragma unroll
            for (int r = 0; r < 4; ++r) {
                const float rr = sigmoid_fast(ar[r] + rgb4[r]), ii = sigmoid_fast(ai[r] + igb4[r]);
                float A = __builtin_amdgcn_exp2f(spc[r] * rr);
                float Bv = __builtin_amdgcn_sqrtf(fmaxf(1.0f - A * A, 0.f)) * (ii * xc4[r]);
                if (ln == 0) { Bv = fmaf(A, car[r], Bv); A *= ptot[r]; }
                { const float As = dpp0<0x111>(A) + m1, Bs = dpp0<0x111>(Bv); Bv = fmaf(A, Bs, Bv); A *= As; }
                { const float As = dpp0<0x112>(A) + m2, Bs = dpp0<0x112>(Bv); Bv = fmaf(A, Bs, Bv); A *= As; }
                { const float As = dpp0<0x114>(A) + m4, Bs = dpp0<0x114>(Bv); Bv = fmaf(A, Bs, Bv); A *= As; }
                { const float As = dpp0<0x118>(A) + m8, Bs = dpp0<0x118>(Bv); Bv = fmaf(A, Bs, Bv); A *= As; }
                hv[r] = Bv; pv[r] = A; car[r] = dppf<0x121>(Bv, Bv); ptot[r] = dppf<0x121>(A, A);
            }
            if (PASS == 1) { u32x2 w; w.x = cvt_pk_bf16(hv[0], hv[1]); w.y = cvt_pk_bf16(hv[2], hv[3]); *(u32x2*)(hlo) = w; w.x = cvt_pk_bf16(pv[0], pv[1]); w.y = cvt_pk_bf16(pv[2], pv[3]); *(u32x2*)(ppo) = w; hlo += 16 * BW; ppo += 16 * BW; }
            if (PASS == 2) { const u32x2 gq = *(const u32x2*)(zg);
                const float y0 = hv[0] * __uint_as_float(gq.x << 16), y1 = hv[1] * __uint_as_float(gq.x & 0xffff0000u), y2 = hv[2] * __uint_as_float(gq.y << 16), y3 = hv[3] * __uint_as_float(gq.y & 0xffff0000u);
                u32x2 w; w.x = cvt_pk_bf16(y0, y1); w.y = cvt_pk_bf16(y2, y3); *(u32x2*)(yo) = w;
                float ss = (y0 * y0 + y1 * y1) + (y2 * y2 + y3 * y3); ss += __shfl_xor(ss, 16); ss += __shfl_xor(ss, 32);
                if (q == 0) *psw = ss; }
            xb += 16 * XC_LD; xv += 16 * XC_LD; zg += 16 * INC; yo += 16 * D; psw += 16 * 24;
        }
        if (tr_me) tr_store_w(tP, lane, tv, tg);
        if (PASS == 1 && ln == 0) {
            float* da = first ? SUMA + (size_t)unit * BW : SUMA2 + (size_t)(unit >> 1) * BW; float* dh = first ? SUMH + (size_t)unit * BW : SUMH2 + (size_t)(unit >> 1) * BW;
#pragma unroll
            for (int r = 0; r < 4; ++r) { da[cb + 4 * q + r] = ptot[r]; dh[cb + 4 * q + r] = car[r]; if (first) { PT[cb + 4 * q + r] = ptot[r]; HC[cb + 4 * q + r] = car[r]; } } }
    }
    if (PASS == 2) {
        asm volatile("s_waitcnt vmcnt(0)" ::: "memory");
        __syncthreads();
        if (tid < 128) { float s = 0.f;
#pragma unroll
            for (int k = 0; k < 24; ++k) s += PS[tid * 24 + k];
            RSB[tid] = __builtin_amdgcn_rsqf(s * (1.0f / BW) + EPS); }
        __syncthreads();
#pragma unroll 2
        for (int k = 0; k < 12; ++k) { const int idx = tid + 512 * k, tl = idx / 48, c0 = (idx % 48) * 8; const float rs = RSB[tl];
            bf16_t* yp = Y + (size_t)(t0 + tl) * D + AW + c0; float v[8]; bf8_to_f32(*(const u32x4*)(yp), v);
            const f32x4 g0 = *(const f32x4*)(mo_gb + c0), g1 = *(const f32x4*)(mo_gb + c0 + 4);
            u32x4 w; w.x = cvt_pk_bf16(v[0] * rs * g0[0], v[1] * rs * g0[1]); w.y = cvt_pk_bf16(v[2] * rs * g0[2], v[3] * rs * g0[3]); w.z = cvt_pk_bf16(v[4] * rs * g1[0], v[5] * rs * g1[1]); w.w = cvt_pk_bf16(v[6] * rs * g1[2], v[7] * rs * g1[3]);
            *(u32x4*)(yp) = w; }
    }
    __syncthreads();
}

__device__ __forceinline__ void rglru_fix_pair(int pr, int tid, int wave, int lane, const bf16_t* Z, bf16_t* Y, const bf16_t* HL, const bf16_t* PP, const float* SUMA2, const float* SUMH2, const float* mo_gb, LAS unsigned char* lds) {
    LAS float* CAR = (LAS float*)(lds + RG_CAR);
    if (tid < 384) { const int c = tid, p0 = pr - (pr % (UPB128 / 2)); float h = 0.f; const float* pa = SUMA2 + (size_t)p0 * BW + c; const float* ph = SUMH2 + (size_t)p0 * BW + c;
#pragma unroll 8
        for (int j = p0; j < pr; ++j) { h = fmaf(*pa, h, *ph); pa += BW; ph += BW; }
        CAR[c] = h; }
    __syncthreads();
    {
        typedef unsigned u32x3 __attribute__((ext_vector_type(3)));
        const int c0 = lane * 6; float hin[6], gch[6];
#pragma unroll
        for (int e = 0; e < 6; ++e) hin[e] = CAR[c0 + e]; (void)gch; (void)mo_gb;
#pragma unroll 2
        for (int i = 0; i < 32; ++i) { const size_t t = (size_t)pr * 256 + wave * 32 + i;
            const u32x3 h3 = *(const u32x3*)(HL + t * BW + c0), p3 = *(const u32x3*)(PP + t * BW + c0), g3 = *(const u32x3*)(Z + t * INC + ZG + c0);
            float y[6]; float ss = 0.f;
#pragma unroll
            for (int e = 0; e < 3; ++e) { const unsigned hh = h3[e], pq = p3[e], gq = g3[e];
                y[2 * e] = fmaf(__uint_as_float(pq << 16), hin[2 * e], __uint_as_float(hh << 16)) * gelu_fast(__uint_as_float(gq << 16));
                y[2 * e + 1] = fmaf(__uint_as_float(pq & 0xffff0000u), hin[2 * e + 1], __uint_as_float(hh & 0xffff0000u)) * gelu_fast(__uint_as_float(gq & 0xffff0000u));
                ss += y[2 * e] * y[2 * e] + y[2 * e + 1] * y[2 * e + 1]; }
            ss = wave_sum(ss);
            const float rs = __builtin_amdgcn_rsqf(ss * (1.0f / BW) + EPS);
            u32x3 w; w.x = cvt_pk_bf16(y[0] * rs, y[1] * rs); w.y = cvt_pk_bf16(y[2] * rs, y[3] * rs); w.z = cvt_pk_bf16(y[4] * rs, y[5] * rs);
            *(u32x3*)(Y + t * D + AW + c0) = w; }
    }
    __syncthreads();
}

constexpr int VT_LD = 136;
__device__ __forceinline__ void mixa_unit(int unit, int tid, int wave, int lane, const bf16_t* Z, bf16_t* Y, const bf16_t* WSP, const float* a_sb, const float* vg, const float* mo_ga, LAS unsigned char* lds) {
    LAS bf16_t* vT = (LAS bf16_t*)lds; const int t0 = unit * 128; const int ln = lane & 15, q = lane >> 4;
    { const int j = tid >> 2, part = tid & 3; const bf16_t* zp = Z + (size_t)(t0 + j) * INC + ZV + part * 8;
      u32x4 raw[12]; float ss = 0.f;
#pragma unroll
      for (int k = 0; k < 12; ++k) { const u32x4 rw = *(const u32x4*)(zp + 32 * k); float v[8]; bf8_to_f32(rw, v);
#pragma unroll
          for (int e = 0; e < 8; ++e) { v[e] = gelu_fast(v[e]); ss += v[e] * v[e]; }
          raw[k].x = cvt_pk_bf16(v[0], v[1]); raw[k].y = cvt_pk_bf16(v[2], v[3]); raw[k].z = cvt_pk_bf16(v[4], v[5]); raw[k].w = cvt_pk_bf16(v[6], v[7]); }
      ss += x_xor1(ss); ss += x_xor2(ss);
      const float rs = __builtin_amdgcn_rsqf(ss * (1.0f / AW) + EPS);
      LAS bf16_t* vw = vT + (part * 8) * VT_LD + j; const float* gp = vg + part * 8;
#pragma unroll
      for (int k = 0; k < 12; ++k) { float v[8]; bf8_to_f32(raw[k], v); const f32x4 g0 = *(const f32x4*)(gp + 32 * k), g1 = *(const f32x4*)(gp + 32 * k + 4);
#pragma unroll
          for (int e = 0; e < 8; ++e) vw[(32 * k + e) * VT_LD] = f2bf(v[e] * rs * (e < 4 ? g0[e] : g1[e - 4])); } }
    __syncthreads();
    const bool full = wave >= 4;
    float ss = 0.f;
    const int tl = 16 * wave + ln;
    const char* ub = (const char*)(Z + (size_t)t0 * INC + ZU); const unsigned vu = (unsigned)(tl * INC + 4 * q) * 2u;
    const char* wb = (const char*)WSP; const unsigned vw = (unsigned)(tl * 128 + 8 * q) * 2u;
    const bf16x8 z8 = {0, 0, 0, 0, 0, 0, 0, 0};
    bf16x8 Wn0 = ldg<bf16x8>(wb, vw), Wn1 = ldg<bf16x8>(wb + 64, vw), Wn2 = z8, Wn3 = z8;
    if (full) { Wn2 = ldg<bf16x8>(wb + 128, vw); Wn3 = ldg<bf16x8>(wb + 192, vw); }
    u32x2 un0 = ldg<u32x2>(ub, vu), un1 = ldg<u32x2>(ub + 32, vu), un2 = ldg<u32x2>(ub + 64, vu), un3 = ldg<u32x2>(ub + 96, vu); float bn = a_sb[tl];
    const LAS bf16_t* ap = vT + ln * VT_LD + 8 * q;
    u32x2 val[24];
#pragma unroll
    for (int h = 0; h < 6; ++h) {
        const bf16x8 W0 = Wn0, W1 = Wn1, W2 = Wn2, W3 = Wn3; const u32x2 uc[4] = {un0, un1, un2, un3}; const float b = bn;
        if (h < 5) { const char* wq = wb + (size_t)(h + 1) * 128 * 128 * 2; const char* uq2 = ub + (h + 1) * 128;
            Wn0 = ldg<bf16x8>(wq, vw); Wn1 = ldg<bf16x8>(wq + 64, vw); if (full) { Wn2 = ldg<bf16x8>(wq + 128, vw); Wn3 = ldg<bf16x8>(wq + 192, vw); }
            un0 = ldg<u32x2>(uq2, vu); un1 = ldg<u32x2>(uq2 + 32, vu); un2 = ldg<u32x2>(uq2 + 64, vu); un3 = ldg<u32x2>(uq2 + 96, vu); bn = a_sb[(h + 1) * 128 + tl]; }
        asm volatile("" ::: "memory");
#pragma unroll
        for (int dt = 0; dt < 4; ++dt) { f32x4 acc = (f32x4){0.f, 0.f, 0.f, 0.f};
            const LAS bf16_t* aq = ap + (h * 64 + 16 * dt) * VT_LD;
            const bf16x8 a0 = *(const LAS bf16x8*)(aq), a1 = *(const LAS bf16x8*)(aq + 32), a2 = *(const LAS bf16x8*)(aq + 64), a3 = *(const LAS bf16x8*)(aq + 96);
            acc = mfma16(a0, W0, acc); acc = mfma16(a1, W1, acc); acc = mfma16(a2, W2, acc); acc = mfma16(a3, W3, acc);
            const u32x2 u2 = uc[dt];
            const float v0 = gelu_fast(__uint_as_float(u2.x << 16)) * (acc[0] + b), v1 = gelu_fast(__uint_as_float(u2.x & 0xffff0000u)) * (acc[1] + b), v2 = gelu_fast(__uint_as_float(u2.y << 16)) * (acc[2] + b), v3 = gelu_fast(__uint_as_float(u2.y & 0xffff0000u)) * (acc[3] + b);
            ss += (v0 * v0 + v1 * v1) + (v2 * v2 + v3 * v3);
            u32x2 pk; pk.x = cvt_pk_bf16(v0, v1); pk.y = cvt_pk_bf16(v2, v3); val[h * 4 + dt] = pk; }
    }
    ss = add_x16_x32(ss);
    const float rs = __builtin_amdgcn_rsqf(ss * (1.0f / AW) + EPS);
    __syncthreads();
    { LAS unsigned char* scr = lds + wave * (16 * 784);
      LAS unsigned char* sw = scr + ln * 784 + q * 8; (void)mo_ga;
#pragma unroll
      for (int k = 0; k < 24; ++k) { const u32x2 pk = val[k];
          u32x2 w; w.x = cvt_pk_bf16(__uint_as_float(pk.x << 16) * rs, __uint_as_float(pk.x & 0xffff0000u) * rs); w.y = cvt_pk_bf16(__uint_as_float(pk.y << 16) * rs, __uint_as_float(pk.y & 0xffff0000u) * rs);
          *(LAS u32x2*)(sw + k * 32) = w; }
      asm volatile("s_waitcnt lgkmcnt(0)" ::: "memory");
      bf16_t* yr = Y + (size_t)(t0 + 16 * wave) * D;
      { int row = lane >= 48 ? 1 : 0, cp = lane >= 48 ? lane - 48 : lane;
#pragma unroll 2
        for (int i = 0; i < 12; ++i) { const unsigned so = (unsigned)(row * 784 + cp * 16), go = (unsigned)(row * D + cp * 8) * 2u;
            const u32x4 v = *(const LAS u32x4*)(scr + so); *(u32x4*)((char*)yr + go) = v;
            cp += 16; row += 1; if (cp >= 48) { cp -= 48; row += 1; } } } }
    __syncthreads();
}

__device__ __forceinline__ void router_unit(int unit, int wave, int lane, const bf16_t* HB, const float* SSQ, const bf16_t* WRT, const float* rgb, const float* reb,
                                            int* CLS, float* G2, unsigned char* HBU, LAS unsigned char* lds, LAS int* hist) {
    const int ln = lane & 15, q = lane >> 4; const int t0 = unit * UT + wave * 32;
    LAS float* LG = (LAS float*)(lds + wave * 8192);
    f32x4 acc[2][3];
#pragma unroll
    for (int tt = 0; tt < 2; ++tt)
#pragma unroll
        for (int j = 0; j < 3; ++j) acc[tt][j] = (f32x4){0.f, 0.f, 0.f, 0.f};
    constexpr int WLD = 2064;
    { const int tid = wave * 64 + lane; const u32x4* src = (const u32x4*)WRT; u32x4 sv[12];
#pragma unroll
      for (int i = 0; i < 12; ++i) sv[i] = src[tid + 512 * i];
      __syncthreads();
#pragma unroll
      for (int i = 0; i < 12; ++i) { const int pc = tid + 512 * i; *(LAS u32x4*)(lds + (pc >> 7) * WLD + (pc & 127) * 16) = sv[i]; } }
    __syncthreads();
    float rsA, rsB;
    { const f32x4 sa = *(const f32x4*)(SSQ + (size_t)(t0 + ln) * 16 + 4 * q), sb = *(const f32x4*)(SSQ + (size_t)(t0 + 16 + ln) * 16 + 4 * q);
      rsA = __builtin_amdgcn_rsqf(add_x16_x32((sa[0] + sa[1]) + (sa[2] + sa[3])) * (1.0f / D) + EPS) * pg8::FS_H; rsB = __builtin_amdgcn_rsqf(add_x16_x32((sb[0] + sb[1]) + (sb[2] + sb[3])) * (1.0f / D) + EPS) * pg8::FS_H; }
    const bf16_t* hp0 = HB + (size_t)(t0 + ln) * D + 16 * q; const bf16_t* hp1 = hp0 + (size_t)16 * D; const LAS unsigned char* wl = lds + ln * WLD + q * 32;
    unsigned char* ho0 = HBU + (size_t)(t0 + ln) * D + 16 * q; unsigned char* ho1 = ho0 + (size_t)16 * D;
#pragma unroll 4
    for (int s = 0; s < 16; ++s) {
        const bf16x8 b0 = *(const bf16x8*)(hp0), b1 = *(const bf16x8*)(hp1), c0 = *(const bf16x8*)(hp0 + 8), c1 = *(const bf16x8*)(hp1 + 8);
        { const bf16x8 a0 = *(const LAS bf16x8*)(wl), a1 = *(const LAS bf16x8*)(wl + 16 * WLD), a2 = *(const LAS bf16x8*)(wl + 32 * WLD);
          acc[0][0] = mfma16(a0, b0, acc[0][0]); acc[0][1] = mfma16(a1, b0, acc[0][1]); acc[0][2] = mfma16(a2, b0, acc[0][2]);
          acc[1][0] = mfma16(a0, b1, acc[1][0]); acc[1][1] = mfma16(a1, b1, acc[1][1]); acc[1][2] = mfma16(a2, b1, acc[1][2]); }
        { const bf16x8 a0 = *(const LAS bf16x8*)(wl + 16), a1 = *(const LAS bf16x8*)(wl + 16 * WLD + 16), a2 = *(const LAS bf16x8*)(wl + 32 * WLD + 16);
          acc[0][0] = mfma16(a0, c0, acc[0][0]); acc[0][1] = mfma16(a1, c0, acc[0][1]); acc[0][2] = mfma16(a2, c0, acc[0][2]);
          acc[1][0] = mfma16(a0, c1, acc[1][0]); acc[1][1] = mfma16(a1, c1, acc[1][1]); acc[1][2] = mfma16(a2, c1, acc[1][2]); }
        { const u32x4 xb = __builtin_bit_cast(u32x4, b0), xc = __builtin_bit_cast(u32x4, c0); u32x4 w;
          w.x = pk_fp8x4(__uint_as_float(xb.x << 16) * rsA, __uint_as_float(xb.x & 0xffff0000u) * rsA, __uint_as_float(xb.y << 16) * rsA, __uint_as_float(xb.y & 0xffff0000u) * rsA);
          w.y = pk_fp8x4(__uint_as_float(xb.z << 16) * rsA, __uint_as_float(xb.z & 0xffff0000u) * rsA, __uint_as_float(xb.w << 16) * rsA, __uint_as_float(xb.w & 0xffff0000u) * rsA);
          w.z = pk_fp8x4(__uint_as_float(xc.x << 16) * rsA, __uint_as_float(xc.x & 0xffff0000u) * rsA, __uint_as_float(xc.y << 16) * rsA, __uint_as_float(xc.y & 0xffff0000u) * rsA);
          w.w = pk_fp8x4(__uint_as_float(xc.z << 16) * rsA, __uint_as_float(xc.z & 0xffff0000u) * rsA, __uint_as_float(xc.w << 16) * rsA, __uint_as_float(xc.w & 0xffff0000u) * rsA);
          *(u32x4*)(ho0) = w; }
        { const u32x4 xb = __builtin_bit_cast(u32x4, b1), xc = __builtin_bit_cast(u32x4, c1); u32x4 w;
          w.x = pk_fp8x4(__uint_as_float(xb.x << 16) * rsB, __uint_as_float(xb.x & 0xffff0000u) * rsB, __uint_as_float(xb.y << 16) * rsB, __uint_as_float(xb.y & 0xffff0000u) * rsB);
          w.y = pk_fp8x4(__uint_as_float(xb.z << 16) * rsB, __uint_as_float(xb.z & 0xffff0000u) * rsB, __uint_as_float(xb.w << 16) * rsB, __uint_as_float(xb.w & 0xffff0000u) * rsB);
          w.z = pk_fp8x4(__uint_as_float(xc.x << 16) * rsB, __uint_as_float(xc.x & 0xffff0000u) * rsB, __uint_as_float(xc.y << 16) * rsB, __uint_as_float(xc.y & 0xffff0000u) * rsB);
          w.w = pk_fp8x4(__uint_as_float(xc.z << 16) * rsB, __uint_as_float(xc.z & 0xffff0000u) * rsB, __uint_as_float(xc.w << 16) * rsB, __uint_as_float(xc.w & 0xffff0000u) * rsB);
          *(u32x4*)(ho1) = w; }
        hp0 += 64; hp1 += 64; wl += 128; ho0 += 64; ho1 += 64; }
    __syncthreads();
#pragma unroll
    for (int tt = 0; tt < 2; ++tt)
#pragma unroll
        for (int j = 0; j < 3; ++j) *(LAS f32x4*)(LG + (16 * tt + ln) * 48 + 16 * j + 4 * q) = acc[tt][j];
    asm volatile("s_waitcnt lgkmcnt(0)" ::: "memory");
    if (lane < 32) { const int t = t0 + lane; const LAS float* lg = LG + lane * 48;
        const f32x4* sp = (const f32x4*)(SSQ + (size_t)t * 16); const f32x4 s0 = sp[0], s1 = sp[1], s2 = sp[2], s3 = sp[3];
        const float sq = ((s0[0] + s0[1]) + (s0[2] + s0[3])) + ((s1[0] + s1[1]) + (s1[2] + s1[3])) + ((s2[0] + s2[1]) + (s2[2] + s2[3])) + ((s3[0] + s3[1]) + (s3[2] + s3[3]));
        const float r = rsqrtf(sq * (1.0f / D) + EPS);
        float gl[4];
#pragma unroll
        for (int j = 0; j < 4; ++j) gl[j] = r * (lg[j] + lg[16 + j]) + rgb[j];
        int gs = 0; float gm = gl[0];
#pragma unroll
        for (int j = 1; j < 4; ++j) if (gl[j] > gm) { gm = gl[j]; gs = j; }
        float den = 0.f;
#pragma unroll
        for (int j = 0; j < 4; ++j) den += expf(gl[j] - gm);
        const float gwt = 1.0f / den;
        float el[4];
#pragma unroll
        for (int j = 0; j < 4; ++j) { float v;
            if (gs < 3) v = lg[4 + 4 * gs + j] + lg[16 + 4 + 4 * gs + j]; else v = lg[32 + j] + lg[36 + j];
            el[j] = r * v + reb[gs * 4 + j]; }
        int i0 = 0; float v0 = el[0];
#pragma unroll
        for (int j = 1; j < 4; ++j) if (el[j] > v0) { v0 = el[j]; i0 = j; }
        int i1 = 0; float v1 = -3.0e38f;
#pragma unroll
        for (int j = 0; j < 4; ++j) if (j != i0 && el[j] > v1) { v1 = el[j]; i1 = j; }
        const float e1 = expf(v1 - v0); const float w0 = gwt / (1.0f + e1), w1 = gwt * e1 / (1.0f + e1);
        const int lo = i0 < i1 ? i0 : i1, hi = i0 < i1 ? i1 : i0; const int cls = gs * 6 + pair_idx(lo, hi);
        CLS[t] = cls; G2[(size_t)t * 2 + 0] = i0 < i1 ? w0 : w1; G2[(size_t)t * 2 + 1] = i0 < i1 ? w1 : w0;
        __hip_atomic_fetch_add(hist + cls, 1, __ATOMIC_RELAXED, __HIP_MEMORY_SCOPE_WORKGROUP); }
}

__device__ __forceinline__ void tr_item8(const float* W, int ldw, int k0, int scol0, unsigned char* WT, int ldo, int drow0, int dk0, LAS float* scr, int lane) {
#pragma unroll 8
    for (int i = 0; i < 32; ++i) { const int kk = 2 * i + (lane >> 5); scr[kk * 33 + (lane & 31)] = W[(size_t)(k0 + kk) * ldw + scol0 + (lane & 31)] * pg8::FS_W; }
    asm volatile("s_waitcnt lgkmcnt(0)" ::: "memory");
    const int c = lane & 7;
#pragma unroll
    for (int j = 0; j < 4; ++j) { const int n = (lane >> 3) + 8 * j; const LAS float* s = scr + (8 * c) * 33 + n;
        u32x2 o; o.x = pk_fp8x4(s[0 * 33], s[1 * 33], s[2 * 33], s[3 * 33]); o.y = pk_fp8x4(s[4 * 33], s[5 * 33], s[6 * 33], s[7 * 33]);
        *(u32x2*)(WT + (size_t)(drow0 + n) * ldo + dk0 + 8 * c) = o; }
    asm volatile("s_waitcnt lgkmcnt(0)" ::: "memory");
}
__device__ __forceinline__ void tr_load(const TrP& P, int lane, float (&v)[32]) {
#pragma unroll
    for (int i = 0; i < 8; ++i) { const int kk = 8 * i + (lane >> 3); f32x4 x = *(const f32x4*)(P.src + (size_t)kk * P.ldw + 4 * (lane & 7)); if (P.gk) x *= P.gk[kk]; v[4 * i] = x[0]; v[4 * i + 1] = x[1]; v[4 * i + 2] = x[2]; v[4 * i + 3] = x[3]; }
}
__device__ __forceinline__ void tr_store(const TrP& P, int lane, const float (&v)[32], LAS float* scr) {
    const float sc = P.fp8 ? pg8::FS_W : 1.0f;
#pragma unroll
    for (int i = 0; i < 8; ++i)
#pragma unroll
        for (int e = 0; e < 4; ++e) scr[(8 * i + (lane >> 3)) * 33 + 4 * (lane & 7) + e] = v[4 * i + e] * sc;
    asm volatile("s_waitcnt lgkmcnt(0)" ::: "memory");
    const int c = lane & 7;
#pragma unroll
    for (int j = 0; j < 4; ++j) { const int n = (lane >> 3) + 8 * j; const LAS float* s = scr + (8 * c) * 33 + n;
        if (P.fp8) { u32x2 o; o.x = pk_fp8x4(s[0 * 33], s[1 * 33], s[2 * 33], s[3 * 33]); o.y = pk_fp8x4(s[4 * 33], s[5 * 33], s[6 * 33], s[7 * 33]); *(u32x2*)(P.dst + (size_t)n * P.ldo + 8 * c) = o; if (P.dst2) { *(u32x2*)(P.dst2 + (size_t)n * P.ldo + 8 * c) = o; *(u32x2*)(P.dst3 + (size_t)n * P.ldo + 8 * c) = o; } }
        else { u32x4 o; o.x = cvt_pk_bf16(s[0 * 33], s[1 * 33]); o.y = cvt_pk_bf16(s[2 * 33], s[3 * 33]); o.z = cvt_pk_bf16(s[4 * 33], s[5 * 33]); o.w = cvt_pk_bf16(s[6 * 33], s[7 * 33]); *(u32x4*)(P.dst + (size_t)n * P.ldo + 16 * c) = o; } }
    asm volatile("s_waitcnt lgkmcnt(0)" ::: "memory");
}
struct Args { const float* in[34]; float* out; unsigned char* ws; };

__global__ void __launch_bounds__(512, 2) mega_fwd(Args a) {
    extern __shared__ __attribute__((aligned(16))) unsigned char lds_raw[];
    LAS unsigned char* lds = (LAS unsigned char*)lds_raw;
    volatile LAS unsigned* LW = (volatile LAS unsigned*)(lds + LDSCTL_OFF);
    volatile LAS int* LWI = (volatile LAS int*)(lds + LDSCTL_OFF);
    const int G = gridDim.x, bid0 = blockIdx.x; const int wave_s0 = __builtin_amdgcn_readfirstlane(threadIdx.x >> 6);
#define PHASE_IDS() int wv_ = wave_s0, bd_ = bid0; asm volatile("" : "+s"(wv_), "+s"(bd_)); const int wave_s = wv_, bid = bd_;     \
    const int lane = fresh_lane(), wave = wave_s, tid = wave * 64 + lane; const int gw = bid * 8 + wave, NGW = G * 8; \
    const size_t gt = (size_t)bid * 512 + tid, NGT = (size_t)G * 512; (void)lane; (void)wave; (void)gw; (void)NGW; (void)gt; (void)NGT
#define GASP __attribute__((address_space(1)))
#define WSB() ({ GASP unsigned char* _w = (GASP unsigned char*)a.ws; asm volatile("" : "+s"(_w)); (unsigned char*)_w; })
#define INP(i) ({ int _k = (i); asm volatile("" : "+s"(_k)); (const float*)(GASP const float*)a.in[_k]; })
    for (int u = threadIdx.x; u < (LDS_PF - LDSCTL_OFF) / 4; u += 512) LW[u] = 0u;
    __syncthreads();
    XcdBarrier bar = xcd_barrier_post((unsigned*)(a.ws + WS_CTL) + CW_BAR, LW + LW_BAR);

    {
        PHASE_IDS(); unsigned char* ws = WSB(); bf16_t* WIN = (bf16_t*)(ws + WS_WIN); bf16_t* WOUT = (bf16_t*)(ws + WS_WOUT); bf16_t* WGU = (bf16_t*)(ws + WS_WGU); bf16_t* WD2 = (bf16_t*)(ws + WS_WD2);
        bf16_t* HB = (bf16_t*)(ws + WS_HB); float* SSQ = (float*)(ws + WS_SSQ);
        LAS float* scr = (LAS float*)(lds + wave * 16896);
        constexpr int I_IN = 16 * 56, I_OUT = 16 * 32, I_GLU = 32, I_RG = 24, I_L = I_IN + I_OUT + I_GLU + I_RG;
        const float* i_win = INP(2); const float* i_g = INP(1); const float* i_wout = INP(24); const float* i_wg = INP(30); const float* i_wu = INP(31); const float* i_wd = INP(32); const float* i_fg = INP(25); const float* i_mog = INP(23);
        const float* i_glu = INP(21); const float* i_rg = INP(8); const float* i_ig = INP(10);
#define TR_DECODE(P, it) do { const int l = (it) / I_L; int r = (it) % I_L; P.gk = nullptr; P.fp8 = 0; P.dst2 = nullptr; P.dst3 = nullptr; \
            if (r < I_IN) { const int kb = r / 56, nb = r % 56, j0 = nb * 32; const int sc = j0 < 768 ? j0 : (j0 < 1152 ? j0 + 384 : (j0 < 1536 ? j0 - 384 : j0));     \
                P.src = i_win + (size_t)l * D * INC + (size_t)kb * 64 * INC + sc; P.ldw = INC; P.gk = i_g + (size_t)l * D + kb * 64; P.dst = (unsigned char*)(WIN + (size_t)l * INC * D + (size_t)j0 * D + kb * 64); P.ldo = D * 2; } \
            else if ((r -= I_IN) < I_OUT) { const int kb = r / 32, nb = r % 32; P.src = i_wout + (size_t)l * D * D + (size_t)kb * 64 * D + nb * 32; P.ldw = D; P.gk = i_mog + (size_t)l * D + kb * 64;     P.dst = (unsigned char*)(WOUT + (size_t)l * D * D + (size_t)nb * 32 * D + kb * 64); P.ldo = D * 2; } \
            else if ((r -= I_OUT) < I_GLU) { const int kb = r / 8, nb = r % 8; P.src = i_glu + (size_t)l * CW * CW + (size_t)kb * 64 * CW + nb * 32; P.ldw = CW; P.dst = (unsigned char*)((bf16_t*)(ws + WS_WGLU) + (size_t)l * CW * CW + (size_t)nb * 32 * CW + kb * 64); P.ldo = CW * 2; } \
            else { r -= I_GLU; const int gate = r / 12, h = (r / 2) % 6, nb = r & 1; \
                P.src = (gate ? i_ig : i_rg) + ((size_t)l * 6 + h) * 64 * 64 + nb * 32; P.ldw = 64; P.dst = (unsigned char*)((bf16_t*)(ws + WS_WRG) + (((size_t)l * 2 + gate) * 6 + h) * 64 * 64 + (size_t)nb * 32 * 64); P.ldo = 64 * 2; } } while (0)
        { TrP Pa, Pb; float va[32], vb[32]; int it = gw;
          if (it < 2 * I_L) { TR_DECODE(Pa, it); tr_load(Pa, lane, va); }
#pragma unroll 1
          while (it < 2 * I_L) {
              const int it1 = it + NGW; if (it1 < 2 * I_L) { TR_DECODE(Pb, it1); tr_load(Pb, lane, vb); }
              tr_store(Pa, lane, va, scr);
              if (it1 >= 2 * I_L) break;
              const int it2 = it1 + NGW; if (it2 < 2 * I_L) { TR_DECODE(Pa, it2); tr_load(Pa, lane, va); }
              tr_store(Pb, lane, vb, scr);
              it = it2; } }
#undef TR_DECODE
        { const float* s_are = INP(13); const float* s_aim = INP(14); const float* s_ldt = INP(15); const float* s_bre = INP(16); const float* s_bim = INP(17); const float* s_cre = INP(18); const float* s_cim = INP(19); const float* s_d = INP(20);
          for (int e = gw; e < 2 * CG * 256; e += NGW) { const int l = e / (CG * 256), g = (e / 256) % CG, c = (e >> 4) & 15, cp = e & 15;
              s5_kt_wave(g, c, cp, lane, s_are + (size_t)l * CG * CS, s_aim + (size_t)l * CG * CS, s_ldt + (size_t)l * CG, s_bre + (size_t)l * CG * CS * CGD, s_bim + (size_t)l * CG * CS * CGD,
                         s_cre + (size_t)l * CG * CGD * CS, s_cim + (size_t)l * CG * CGD * CS, s_d + (size_t)l * CW, ws + WS_S5 + (size_t)l * S5_L_STRIDE); }
          for (size_t e2 = gt; e2 < (size_t)4 * CG * 2048; e2 += NGT) { const size_t e = e2 & ((size_t)2 * CG * 2048 - 1); const bool is_ft = e2 >= (size_t)2 * CG * 2048;
              const int l = (int)(e / (CG * 2048)), g = (int)((e / 2048) % CG), r = (int)(e & 2047);
              if (!is_ft) s5_et_task(g, r >> 10, (r >> 4) & 63, r & 15, s_are + (size_t)l * CG * CS, s_aim + (size_t)l * CG * CS, s_ldt + (size_t)l * CG, s_bre + (size_t)l * CG * CS * CGD, s_bim + (size_t)l * CG * CS * CGD, ws + WS_S5 + (size_t)l * S5_L_STRIDE);
              else s5_ft_task(g, r >> 7, (r >> 6) & 1, r & 63, s_are + (size_t)l * CG * CS, s_aim + (size_t)l * CG * CS, s_ldt + (size_t)l * CG, s_cre + (size_t)l * CG * CGD * CS, s_cim + (size_t)l * CG * CGD * CS, ws + WS_S5 + (size_t)l * S5_L_STRIDE); }
          for (size_t e = gt; e < (size_t)2 * CG * 64; e += NGT) { const int l = (int)(e / (CG * 64)), g = (int)((e / 64) % CG), el = 4096 + 32768 + (int)(e % 64);
              s5_table_elem(g, el, s_are + (size_t)l * CG * CS, s_aim + (size_t)l * CG * CS, s_ldt + (size_t)l * CG, s_bre + (size_t)l * CG * CS * CGD, s_bim + (size_t)l * CG * CS * CGD,
                            s_cre + (size_t)l * CG * CGD * CS, s_cim + (size_t)l * CG * CGD * CS, s_d + (size_t)l * CW, ws + WS_S5 + (size_t)l * S5_L_STRIDE); } }
        { const float* sw = INP(4); bf16_t* wsp = (bf16_t*)(ws + WS_WSP); for (size_t e = gt; e < (size_t)2 * 6 * 128 * 128; e += NGT) wsp[e] = f2bf(sw[e]); }
        { const float* fg = INP(25); const float* rgw = INP(26); const float* rew = INP(28); bf16_t* wrt = (bf16_t*)(ws + WS_WRT);
          for (size_t e = gt; e < (size_t)2 * 48 * D; e += NGT) { const int l = (int)(e / (48 * D)), n = (int)((e / D) % 48), k = (int)(e % D);
              int j = -1, lo = 0; if (n < 16) j = n; else if (n < 32) { j = n - 16; lo = 1; } else if (n < 36) j = 16 + (n - 32); else if (n < 40) { j = 16 + (n - 36); lo = 1; }
              float v = 0.f;
              if (j >= 0) { const float w = fg[(size_t)l * D + k] * (j < 4 ? rgw[((size_t)l * D + k) * 4 + j] : rew[(((size_t)l * 4 + ((j - 4) >> 2)) * D + k) * 4 + ((j - 4) & 3)]);
                  const float hi = bf2f(f2bf(w)); v = lo ? (w - hi) : w; }
              wrt[e] = f2bf(v); } }
        const float* xin = INP(0);
#pragma unroll 1
        for (int t = gw * 2; t < T; t += NGW * 2) {
            const f32x4* xr = (const f32x4*)(xin + (size_t)t * D) + lane; f32x4 v[2][4]; float s0 = 0.f, s1 = 0.f;
#pragma unroll
            for (int j = 0; j < 4; ++j) { v[0][j] = xr[64 * j]; v[1][j] = xr[256 + 64 * j]; }
#pragma unroll
            for (int j = 0; j < 4; ++j) { s0 += (v[0][j][0] * v[0][j][0] + v[0][j][1] * v[0][j][1]) + (v[0][j][2] * v[0][j][2] + v[0][j][3] * v[0][j][3]); s1 += (v[1][j][0] * v[1][j][0] + v[1][j][1] * v[1][j][1]) + (v[1][j][2] * v[1][j][2] + v[1][j][3] * v[1][j][3]); }
            u32x2* o8 = (u32x2*)(HB + (size_t)t * D) + lane;
#pragma unroll
            for (int j = 0; j < 4; ++j) { u32x2 w; w.x = cvt_pk_bf16(v[0][j][0], v[0][j][1]); w.y = cvt_pk_bf16(v[0][j][2], v[0][j][3]); o8[64 * j] = w; w.x = cvt_pk_bf16(v[1][j][0], v[1][j][1]); w.y = cvt_pk_bf16(v[1][j][2], v[1][j][3]); o8[256 + 64 * j] = w; }
            s0 = wave_sum(s0); s1 = wave_sum(s1);
            if (lane < 32) SSQ[(size_t)t * 16 + lane] = lane == 0 ? s0 : (lane == 16 ? s1 : 0.f);
        }
    }
    xcd_barrier(bar);

    for (int l = 0; l < DEPTH; ++l) {
        { PHASE_IDS(); unsigned char* ws = WSB(); bf16_t* WIN = (bf16_t*)(ws + WS_WIN); bf16_t* HB = (bf16_t*)(ws + WS_HB); float* SSQ = (float*)(ws + WS_SSQ); bf16_t* Z = (bf16_t*)(ws + WS_Z);
          pg8::StaticOrder<T, INC> S; S.init(HB, WIN + (size_t)l * INC * D, G, bid);
          pg8::EpiZ E{Z, SSQ, lds + LDS_PF};
          pg8::gemm_phase<pg8::EpiZ, pg8::StaticOrder<T, INC>, true, true>(lds, wave_s, S, E); }
        xcd_barrier(bar);

        {
            PHASE_IDS(); unsigned char* ws = WSB(); const bf16_t* Z = (const bf16_t*)(ws + WS_Z);
            const float* conv_w = INP(6) + (size_t)l * 4 * BW; const float* conv_b = INP(7) + (size_t)l * BW; const float* rg_b = INP(9) + (size_t)l * BW;
            const float* ig_b = INP(11) + (size_t)l * BW; const float* lam = INP(12) + (size_t)l * BW;
            __syncthreads();
            { const bf16_t* WRG = (const bf16_t*)(ws + WS_WRG) + ((size_t)l * 2 + 0) * 6 * 4096; const bf16_t* WIG = (const bf16_t*)(ws + WS_WRG) + ((size_t)l * 2 + 1) * 6 * 4096;
              const TrCtx tcx{INP(30), INP(31), INP(32), INP(25), ws + WS_WGU, ws, l};
              for (int pr = bid; pr < NU128 / 2; pr += G) { float cp = 0.f;
                  rglru_unit<1>(2 * pr, true, cp, tid, wave, lane, Z, nullptr, WRG, WIG, conv_w, conv_b, rg_b, ig_b, lam, nullptr, (float*)(ws + WS_SUMA), (float*)(ws + WS_SUMH), (float*)(ws + WS_SUMA2), (float*)(ws + WS_SUMH2), (bf16_t*)(ws + WS_HL), (bf16_t*)(ws + WS_PP), lds, true, &tcx);
                  rglru_unit<1>(2 * pr + 1, false, cp, tid, wave, lane, Z, nullptr, WRG, WIG, conv_w, conv_b, rg_b, ig_b, lam, nullptr, (float*)(ws + WS_SUMA), (float*)(ws + WS_SUMH), (float*)(ws + WS_SUMA2), (float*)(ws + WS_SUMH2), (bf16_t*)(ws + WS_HL), (bf16_t*)(ws + WS_PP), lds, true, &tcx); } }
            for (int pr = bid; pr < NU128 / 2; pr += G) { const unsigned char* tab = ws + WS_S5 + (size_t)l * S5_L_STRIDE;
                s5_pair1(pr, 2 * wave, wave, lane, Z, (bf16_t*)(ws + WS_Y), tab, (float*)(ws + WS_SEND), (float*)(ws + WS_SEND2), (float*)(ws + WS_SE), lds);
                s5_pair1(pr, 2 * wave + 1, wave, lane, Z, (bf16_t*)(ws + WS_Y), tab, (float*)(ws + WS_SEND), (float*)(ws + WS_SEND2), (float*)(ws + WS_SE), lds); }
            __syncthreads();
            { const bf16_t* WSP = (const bf16_t*)(ws + WS_WSP) + (size_t)l * 6 * 128 * 128; const float* a_sb = INP(5) + (size_t)l * 6 * 128; const float* vg = INP(3) + (size_t)l * AW; const float* mo_ga = INP(23) + (size_t)l * D;
              for (int u = bid; u < NU128; u += G) mixa_unit(u, tid, wave, lane, Z, (bf16_t*)(ws + WS_Y), WSP, a_sb, vg, mo_ga, lds); }
        }
        xcd_barrier(bar);

        {
            PHASE_IDS(); unsigned char* ws = WSB(); const bf16_t* Z = (const bf16_t*)(ws + WS_Z); bf16_t* Y = (bf16_t*)(ws + WS_Y);
            const float* a_v_norm_g = INP(3) + (size_t)l * AW; const float* a_sw = INP(4) + (size_t)l * 6 * 128 * 128; const float* a_sb = INP(5) + (size_t)l * 6 * 128;
        }

        { PHASE_IDS(); unsigned char* ws = WSB(); const bf16_t* Z = (const bf16_t*)(ws + WS_Z); bf16_t* Y = (bf16_t*)(ws + WS_Y);
          { const float* mo_gb = INP(23) + (size_t)l * D + AW;
            __syncthreads();
            for (int pr = bid; pr < NU128 / 2; pr += G) rglru_fix_pair(pr, tid, wave, lane, Z, Y, (const bf16_t*)(ws + WS_HL), (const bf16_t*)(ws + WS_PP), (const float*)(ws + WS_SUMA2), (const float*)(ws + WS_SUMH2), mo_gb, lds); }
          { const bf16_t* WGLU = (const bf16_t*)(ws + WS_WGLU) + (size_t)l * CW * CW; const float* glu_b = INP(22) + (size_t)l * CW; const float* mo_gc = INP(23) + (size_t)l * D + AW + BW;
            for (int pr = bid; pr < NU128 / 2; pr += G) { float k0r = 0.f, k0i = 0.f, k1r = 0.f, k1i = 0.f; const unsigned char* tab = ws + WS_S5 + (size_t)l * S5_L_STRIDE;
#pragma unroll 1
                for (int ui = 0; ui < 2; ++ui) { const int u = 2 * pr + ui; __syncthreads();
                    s5_p2x2(u, 2 * wave, ui == 0, k0r, k0i, k1r, k1i, wave, lane, Z, tab, (const float*)(ws + WS_SEND), (const float*)(ws + WS_SEND2), (const float*)(ws + WS_SE), lds);
                    __syncthreads();
                    { const bf16_t* wg_ = WGLU; const float* gb_ = glu_b; const float* gc_ = mo_gc; bf16_t* y_ = Y; asm volatile("" : "+s"(wg_), "+s"(gb_), "+s"(gc_), "+s"(y_));
                      s5_glu(u, wave, lane, wg_, gb_, gc_, y_, lds); } } } } }
        asm volatile("s_waitcnt vmcnt(0)" ::: "memory"); __syncthreads();
        if (wave_s0 == 0) { __builtin_amdgcn_fence(__ATOMIC_ACQUIRE, "agent"); asm volatile("s_waitcnt vmcnt(0)" ::: "memory"); }
        __syncthreads();

        { PHASE_IDS(); unsigned char* ws = WSB(); bf16_t* WOUT = (bf16_t*)(ws + WS_WOUT); bf16_t* HB = (bf16_t*)(ws + WS_HB); float* SSQ = (float*)(ws + WS_SSQ); bf16_t* Y = (bf16_t*)(ws + WS_Y);
          pg8::PanelOrder<T, 4> S; S.init(Y, WOUT + (size_t)l * D * D, G, bid);
          pg8::EpiRes<false> E{HB, SSQ, nullptr, lds + LDS_PF};
          pg8::gemm_phase<pg8::EpiRes<false>, pg8::PanelOrder<T, 4>, true, true>(lds, wave_s, S, E); }
        asm volatile("s_waitcnt vmcnt(0)" ::: "memory"); __syncthreads();
        if (wave_s0 == 0) { __builtin_amdgcn_fence(__ATOMIC_ACQUIRE, "agent"); asm volatile("s_waitcnt vmcnt(0)" ::: "memory"); }
        __syncthreads();

        { PHASE_IDS(); unsigned char* ws = WSB(); const bf16_t* HB = (const bf16_t*)(ws + WS_HB); const float* SSQ = (const float*)(ws + WS_SSQ); int* CLS = (int*)(ws + WS_CLS); float* G2 = (float*)(ws + WS_G2); int* HIST = (int*)(ws + WS_HIST);
          const float* rgb = INP(27) + (size_t)l * 4; const float* reb = INP(29) + (size_t)l * 16;
        for (int u = bid; u < NU; u += G) {
            router_unit(u, wave, lane, HB, SSQ, (const bf16_t*)(ws + WS_WRT) + (size_t)l * 48 * D, rgb, reb, CLS, G2, ws + WS_HBU, lds, (LAS int*)(lds + LDSCTL_OFF) + LW_HIST);
            __syncthreads();
            if (tid < 32) { HIST[u * 32 + tid] = tid < NCLS ? LWI[LW_HIST + tid] : 0; LWI[LW_HIST + tid] = 0; }
            __syncthreads();
        } }
        xcd_barrier(bar);

        { PHASE_IDS(); unsigned char* ws = WSB(); const bf16_t* HB = (const bf16_t*)(ws + WS_HB); const float* SSQ = (const float*)(ws + WS_SSQ); const int* CLS = (const int*)(ws + WS_CLS); const float* G2 = (const float*)(ws + WS_G2); const int* HIST = (const int*)(ws + WS_HIST);
          int* CTOT = (int*)(ws + WS_CTOT); int* ROWTOK = (int*)(ws + WS_ROWTOK); float* ROWG = (float*)(ws + WS_ROWG); bf16_t* HBS = (bf16_t*)(ws + WS_HBS); const float* ffn_g = INP(25) + (size_t)l * D;
        for (int u = bid; u < NU; u += G) {
            { const int c = tid & 31, part = tid >> 5; int tot = 0, pre = 0;
_Pragma("unroll 16")
              for (int k = part * 16; k < part * 16 + 16; ++k) { const int v = HIST[k * 32 + c]; tot += v; pre += k < u ? v : 0; }
              ((volatile LAS int*)lds)[tid] = tot; ((volatile LAS int*)lds)[512 + tid] = pre; }
            __syncthreads();
            if (tid < NCLS) { int tot = 0, pre = 0;
_Pragma("unroll")
                for (int k = 0; k < 16; ++k) { tot += ((volatile LAS int*)lds)[k * 32 + tid]; pre += ((volatile LAS int*)lds)[512 + k * 32 + tid]; } LWI[LW_TOT + tid] = tot; LWI[LW_BASE + tid] = pre; }
            __syncthreads();
            if (tid == 0) { int ps = 0;
_Pragma("unroll 1")
                for (int c = 0; c < NCLS; ++c) { const int tot = LWI[LW_TOT + c]; LWI[LW_BASE + c] += ps; LWI[LW_TST + c] = ps; ps += ((tot + 255) >> 8) << 8; if (bid == 0) CTOT[c] = tot; } LWI[LW_TST + NCLS] = ps; }
            int mycls = 0, rank = 0;
            if (tid < UT) { mycls = CLS[u * UT + tid];
_Pragma("unroll 4")
                for (int c = 0; c < NCLS; ++c) { const unsigned long long m = __ballot(mycls == c); const int below = __builtin_amdgcn_mbcnt_hi((unsigned)(m >> 32), __builtin_amdgcn_mbcnt_lo((unsigned)m, 0u));
                    if (mycls == c) rank = below; if (lane == 0) ((volatile LAS int*)lds)[1024 + wave * 32 + c] = __popcll(m); } }
            __syncthreads();
            if (tid < UT) { const int cls = mycls;
                for (int w = 0; w < wave; ++w) rank += ((volatile LAS int*)lds)[1024 + w * 32 + cls];
                const int dest = LWI[LW_BASE + cls] + rank; LWI[LW_DEST + tid] = dest; const int t = u * UT + tid;
                ROWTOK[dest] = t; ROWG[(size_t)dest * 2 + 0] = G2[(size_t)t * 2 + 0] * (pg8::FS_ACT * 0.6931471805599453f); ROWG[(size_t)dest * 2 + 1] = G2[(size_t)t * 2 + 1] * (pg8::FS_ACT * 0.6931471805599453f); }
            __syncthreads();
            if (u == bid)
_Pragma("unroll 1")
            for (int c = bid; c < NCLS; c += G) { const int tot = LWI[LW_TOT + c], r0 = LWI[LW_TST + c] + tot, r1 = LWI[LW_TST + c + 1];
                unsigned zz = 0u; asm volatile("" : "+v"(zz));
                for (int r = r0 + wave; r < r1; r += 8) { if (lane == 0) { ROWTOK[r] = -1; ROWG[(size_t)r * 2] = __uint_as_float(zz); ROWG[(size_t)r * 2 + 1] = __uint_as_float(zz); } } }
            __syncthreads();
        } }
        xcd_barrier(bar);

        { PHASE_IDS(); unsigned char* ws = WSB(); const int* CTOT = (const int*)(ws + WS_CTOT); bf16_t* HBS = (bf16_t*)(ws + WS_HBS); bf16_t* WGU = (bf16_t*)(ws + WS_WGU); bf16_t* ACT = (bf16_t*)(ws + WS_ACT); const float* ROWG = (const float*)(ws + WS_ROWG);
        if (wave == 0) {
            const int vt = lane < NCLS ? (CTOT[lane] + 255) >> 8 : 0; int tst = 0, ntile = 0;
_Pragma("unroll")
            for (int k = 0; k < NCLS; ++k) { const int vk = __builtin_amdgcn_readlane(vt, k); tst += (k < lane) ? vk : 0; ntile += vk; }
            if (lane <= NCLS) LWI[LW_TST + lane] = tst;
            if (lane < 32) { const long L = (long)lane * G + bid; int e = -1;
            int mtu = -1, pnu = 0, mtd = -1, pnd = 0;
            if (L < (long)ntile * 8) { const int nwg = ntile * 8, qq = nwg / 8, rr = nwg % 8, xcd = (int)(L % 8), off = (int)(L / 8); const int Lr = (xcd < rr ? xcd * (qq + 1) : rr * (qq + 1) + (xcd - rr) * qq) + off; mtu = Lr / 8; pnu = Lr % 8; }
            if (L < (long)ntile * 4) { const int nwg = ntile * 4, qq = nwg / 8, rr = nwg % 8, xcd = (int)(L % 8), off = (int)(L / 8); const int Lr = (xcd < rr ? xcd * (qq + 1) : rr * (qq + 1) + (xcd - rr) * qq) + off; mtd = Lr / 4; pnd = Lr % 4; }
            int clsu = 0, clsd = 0;
_Pragma("unroll")
            for (int k = 1; k < NCLS; ++k) { const int sk = __builtin_amdgcn_readlane(tst, k); clsu += (sk <= mtu) ? 1 : 0; clsd += (sk <= mtd) ? 1 : 0; }
            e = mtu >= 0 ? ((clsu << 24) | (pnu << 16) | mtu) : -1; LWI[LW_UTAB + lane] = e;
            e = mtd >= 0 ? ((clsd << 24) | (pnd << 16) | mtd) : -1; LWI[LW_DTAB + lane] = e; } }
        __syncthreads();
        { pg8::MoeOrder<8, true, 1024> S{LWI + LW_UTAB, l, (const char*)(ws + WS_HBU), (const char*)WGU, (const int*)(ws + WS_ROWTOK)};
          pg8::EpiUp E{(unsigned char*)ACT, ROWG, lds + LDS_PF};
          pg8::gemm_phase<pg8::EpiUp, pg8::MoeOrder<8, true, 1024>, true, true, 512, true>(lds, wave_s, S, E); } }
        xcd_barrier(bar);

        { PHASE_IDS(); unsigned char* ws = WSB(); bf16_t* ACT = (bf16_t*)(ws + WS_ACT); bf16_t* WD2 = (bf16_t*)(ws + WS_WD2); bf16_t* HB = (bf16_t*)(ws + WS_HB); float* SSQ = (float*)(ws + WS_SSQ); const int* ROWTOK = (const int*)(ws + WS_ROWTOK);
          pg8::MoeOrder<4, false, 1024> S{LWI + LW_DTAB, l, (const char*)ACT, (const char*)WD2, nullptr};
          pg8::EpiRes<true> E{HB, SSQ, ROWTOK, lds + LDS_PF};
          pg8::gemm_phase<pg8::EpiRes<true>, pg8::MoeOrder<4, false, 1024>, true, true, 512, true>(lds, wave_s, S, E); }
        xcd_barrier(bar);
    }

    { PHASE_IDS(); unsigned char* ws = WSB(); const bf16_t* HB = (const bf16_t*)(ws + WS_HB); const float* SSQ = (const float*)(ws + WS_SSQ); const float* fg = INP(33); float* outp = (float*)(GASP float*)a.out;
    { f32x4 gq[4];
#pragma unroll
      for (int q = 0; q < 4; ++q) gq[q] = *(const f32x4*)(fg + 256 * q + 4 * lane);
#pragma unroll 1
      for (int t0r = gw * 4; t0r < T; t0r += NGW * 4) {
          float sq = SSQ[(size_t)t0r * 16 + lane]; sq += x_xor1(sq); sq += x_xor2(sq); sq += x_hmir(sq); sq += x_mir(sq);
          u32x2 o[4][4];
#pragma unroll
          for (int j = 0; j < 4; ++j)
#pragma unroll
              for (int q = 0; q < 4; ++q) o[j][q] = *(const u32x2*)(HB + (size_t)(t0r + j) * D + 256 * q + 4 * lane);
#pragma unroll
          for (int j = 0; j < 4; ++j) { const float r = rsqrtf(__builtin_amdgcn_readlane(sq, 16 * j) * (1.0f / D) + EPS); float* orow = outp + (size_t)(t0r + j) * D + 4 * lane;
#pragma unroll
              for (int q = 0; q < 4; ++q) { const u32x2 oo = o[j][q]; const f32x4 g0 = gq[q]; f32x4 w0;
                  w0[0] = __uint_as_float(oo.x << 16) * r * g0[0]; w0[1] = __uint_as_float(oo.x & 0xffff0000u) * r * g0[1]; w0[2] = __uint_as_float(oo.y << 16) * r * g0[2]; w0[3] = __uint_as_float(oo.y & 0xffff0000u) * r * g0[3];
                  *(f32x4*)(orow + 256 * q) = w0; } } } }
}
}

extern "C" void kernel_launch(void* const* d_in, const int* in_sizes, int n_in, void* d_out, int out_size, void* d_ws, size_t ws_size, hipStream_t stream) {
    static int grid = 0;
    if (grid == 0) {
        if (n_in != 34 || in_sizes[0] != T * D || out_size != T * D || ws_size < WS_END) { fprintf(stderr, "kernel_launch: unexpected shapes (n_in %d, ws %zu)\n", n_in, ws_size); grid = -1; return; }
        int dev = 0, cus = 0, per_cu = 0;
        if (hipGetDevice(&dev) != hipSuccess || hipDeviceGetAttribute(&cus, hipDeviceAttributeMultiprocessorCount, dev) != hipSuccess) { grid = -1; return; }
        if (hipFuncSetAttribute((const void*)mega_fwd, hipFuncAttributeMaxDynamicSharedMemorySize, LDS_BYTES) != hipSuccess) { fprintf(stderr, "kernel_launch: hipFuncSetAttribute failed\n"); grid = -1; return; }
        if (hipOccupancyMaxActiveBlocksPerMultiprocessor(&per_cu, (const void*)mega_fwd, 512, LDS_BYTES) != hipSuccess || per_cu < 1) { fprintf(stderr, "kernel_launch: occupancy query says %d\n", per_cu); }
        (void)hipGetLastError();
        grid = cus;
    }
    if (grid < 0) return;
    (void)hipMemsetAsync((char*)d_ws + WS_CTL + (size_t)CW_BAR * 4, 0, (size_t)16384, stream);
    Args a{};
    for (int i = 0; i < 34; ++i) a.in[i] = (const float*)d_in[i];
    a.out = (float*)d_out; a.ws = (unsigned char*)d_ws;
    hipLaunchKernelGGL(mega_fwd, dim3(grid), dim3(512), LDS_BYTES, stream, a);
}
```
